# Optimizing an MI355X kernel written in HIP

```python
import math
import jax, jax.numpy as jnp
from jax import lax
import numpy as np

D_MODEL = 1024
BATCH = 4
SEQ = 4096
DEPTH = 1

CHUNK = 64
EPS = 1e-6
GDN_HEADS = 8
GDN_DK = 128
GDN_DV = 128
GDN_QK = GDN_HEADS * GDN_DK
GDN_V = GDN_HEADS * GDN_DV
CONV_W = 4
RWKV_HEAD = 64
RWKV_WIDTH = D_MODEL
RWKV_HEADS = RWKV_WIDTH // RWKV_HEAD
DECAY_LORA = 64
AAA_LORA = 64
GATE_LORA = 128
RWKV_GN_EPS = 64e-5
GDN_QKV_COLS = 2 * GDN_QK + GDN_V
RWKV_COLS = 3 * RWKV_WIDTH + DECAY_LORA + AAA_LORA + GATE_LORA
IN_WIDTHS = (GDN_QKV_COLS, GDN_V, GDN_HEADS, GDN_HEADS, RWKV_COLS, D_MODEL, D_MODEL)
N_IN_COLS = GDN_QKV_COLS + GDN_V + 2 * GDN_HEADS + RWKV_COLS + 2 * D_MODEL
N_EXPERTS = 32
TOP_K = 4
D_FF = D_MODEL
SWIGLU_ALPHA = 1.702
SWIGLU_LIMIT = 7.0
MOE_BLOCK = 128

kernel_name = "hybrid_gdn_rwkv7_moe_block"


def _split(t, widths):
    offs = [int(o) for o in np.cumsum(widths)[:-1]]
    return jnp.split(t, offs, axis=-1)


def _rmsnorm(x, w, eps=EPS):
    xf = x.astype(jnp.float32)
    y = xf * lax.rsqrt(jnp.mean(xf * xf, axis=-1, keepdims=True) + eps)
    return (y * w.astype(jnp.float32)).astype(x.dtype)


def _l2norm(x):
    xf = x.astype(jnp.float32)
    return xf * lax.rsqrt(jnp.sum(xf * xf, axis=-1, keepdims=True) + EPS)


def _shift1(t):
    return jnp.pad(t, ((0, 0), (1, 0), (0, 0)))[:, :-1]


def _causal_dwconv(x, w):
    S = x.shape[1]
    xp = jnp.pad(x, ((0, 0), (CONV_W - 1, 0), (0, 0)))
    y = w[0] * xp[:, 0:S]
    for j in range(1, CONV_W):
        y = y + w[j] * xp[:, j:j + S]
    return y


def _gated_delta_chunked(q, k, v, g, beta):
    f32 = jnp.float32
    Bsz, S, H, _ = q.shape
    nc = S // CHUNK

    def to_chunks(t):
        return t.astype(f32).reshape(Bsz, nc, CHUNK, H, -1).transpose(0, 3, 1, 2, 4)

    q, k, v = to_chunks(q), to_chunks(k), to_chunks(v)
    g = g.astype(f32).reshape(Bsz, nc, CHUNK, H).transpose(0, 3, 1, 2)
    beta = beta.astype(f32).reshape(Bsz, nc, CHUNK, H).transpose(0, 3, 1, 2)
    gc = jnp.cumsum(g, axis=-1)
    idx = jnp.arange(CHUNK)
    incl = idx[:, None] >= idx[None, :]
    strict = idx[:, None] > idx[None, :]
    diff = gc[..., :, None] - gc[..., None, :]
    decay = jnp.where(incl, jnp.exp(jnp.where(incl, diff, 0.0)), 0.0)
    k_beta = k * beta[..., None]
    m = jnp.where(strict, jnp.einsum('bhnik,bhnjk->bhnij', k_beta, k) * decay, 0.0)
    eye = jnp.eye(CHUNK, dtype=f32)
    t_inv = lax.linalg.triangular_solve(eye + m, jnp.broadcast_to(eye, m.shape),
                                        left_side=True, lower=True, unit_diagonal=True)
    u = jnp.matmul(t_inv, v * beta[..., None])
    w = jnp.matmul(t_inv, k_beta * jnp.exp(gc)[..., None])
    attn = jnp.einsum('bhnik,bhnjk->bhnij', q, k) * decay
    q_dec = q * jnp.exp(gc)[..., None]
    k_dec = k * jnp.exp(gc[..., -1:] - gc)[..., None]
    g_last = jnp.exp(gc[..., -1])

    def step(state, inp):
        u_c, w_c, a_c, qd_c, kd_c, gl_c = inp
        v_new = u_c - jnp.matmul(w_c, state)
        o = jnp.matmul(qd_c, state) + jnp.matmul(a_c, v_new)
        state = state * gl_c[..., None, None] + jnp.einsum('bhck,bhcv->bhkv', kd_c, v_new)
        return state, o

    xs = tuple(jnp.moveaxis(t, 2, 0) for t in (u, w, attn, q_dec, k_dec, g_last))
    s0 = jnp.zeros((Bsz, H, q.shape[-1], v.shape[-1]), f32)
    _, o = lax.scan(step, s0, xs)
    return o.transpose(1, 0, 3, 2, 4).reshape(Bsz, S, H, -1)


def _gdn_branch(qkv, z, b, a, conv_w, A_log, dt_bias, norm_w):
    Bsz, S, _ = qkv.shape
    f32 = jnp.float32
    qkv = jax.nn.silu(_causal_dwconv(qkv, conv_w))
    q, k, v = _split(qkv, (GDN_QK, GDN_QK, GDN_V))
    q = _l2norm(q.reshape(Bsz, S, GDN_HEADS, GDN_DK)) * (GDN_DK ** -0.5)
    k = _l2norm(k.reshape(Bsz, S, GDN_HEADS, GDN_DK))
    v = v.reshape(Bsz, S, GDN_HEADS, GDN_DV)
    beta = jax.nn.sigmoid(b.astype(f32))
    g = -jnp.exp(A_log.astype(f32)) * jax.nn.softplus(a.astype(f32) + dt_bias.astype(f32))
    o = _gated_delta_chunked(q, k, v, g, beta)
    o = _rmsnorm(o, norm_w) * jax.nn.silu(z.reshape(Bsz, S, GDN_HEADS, GDN_DV).astype(f32))
    return o.reshape(Bsz, S, GDN_V)


def _rwkv7_scan(r, w, k, v, kk, a):
    f32 = jnp.float32
    Bsz, _, H, N = r.shape
    xs = tuple(jnp.moveaxis(t.astype(f32), 1, 0) for t in (r, w, k, v, kk, a))

    def step(state, inp):
        r_t, w_t, k_t, v_t, kk_t, a_t = inp
        sk = jnp.einsum('bhvk,bhk->bhv', state, kk_t)
        state = (state * w_t[:, :, None, :]
                 - sk[..., None] * (kk_t * a_t)[:, :, None, :]
                 + v_t[..., None] * k_t[:, :, None, :])
        return state, jnp.einsum('bhvk,bhk->bhv', state, r_t)

    _, o = lax.scan(step, jnp.zeros((Bsz, H, N, N), f32), xs)
    return jnp.moveaxis(o, 0, 1)


def _rwkv7_branch(p, mu, w0, w2, a0, a2, g2, k_k, k_a, r_k, ln_w, ln_b):
    Bsz, S, _ = p.shape
    f32 = jnp.float32
    p = p.astype(f32)
    p = p + (_shift1(p) - p) * mu
    r, k, v, xw, xa, xg = _split(p, (RWKV_WIDTH, RWKV_WIDTH, RWKV_WIDTH, DECAY_LORA, AAA_LORA, GATE_LORA))
    w_log = -jax.nn.softplus(-(w0 + jnp.tanh(xw) @ w2)) - 0.5
    decay = jnp.exp(-jnp.exp(w_log))
    aa = jax.nn.sigmoid(a0 + xa @ a2)
    gg = jax.nn.sigmoid(xg) @ g2
    hs = lambda t: t.reshape(Bsz, S, RWKV_HEADS, RWKV_HEAD)
    kk = _l2norm(hs(k * k_k))
    k = k * (1.0 + (aa - 1.0) * k_a)
    r_h, k_h, v_h, aa_h = hs(r), hs(k), hs(v), hs(aa)
    o = _rwkv7_scan(r_h, hs(decay), k_h, v_h, kk, aa_h)
    mean = jnp.mean(o, axis=-1, keepdims=True)
    var = jnp.mean(jnp.square(o - mean), axis=-1, keepdims=True)
    o = ((o - mean) * lax.rsqrt(var + RWKV_GN_EPS)).reshape(Bsz, S, RWKV_WIDTH) * ln_w + ln_b
    bonus = jnp.sum(r_h * k_h * r_k, axis=-1, keepdims=True) * v_h
    return (o + bonus.reshape(Bsz, S, RWKV_WIDTH)) * gg


def _clamped_swiglu(gu):
    glu, lin = gu[..., ::2], gu[..., 1::2]
    glu = jnp.minimum(glu, SWIGLU_LIMIT)
    lin = jnp.clip(lin, -SWIGLU_LIMIT, SWIGLU_LIMIT)
    return glu * jax.nn.sigmoid(SWIGLU_ALPHA * glu) * (lin + 1.0)


def _moe(h, router_w, router_b, w_gu, b_gu, w_down, b_down):
    Bsz, S, D = h.shape
    f32 = jnp.float32
    xt = h.reshape(-1, D)
    T = xt.shape[0]
    logits = (xt @ router_w + router_b).astype(f32)
    top_val, top_idx = lax.top_k(logits, TOP_K)
    gate = jax.nn.softmax(top_val, axis=-1)
    A = T * TOP_K
    flat_e = top_idx.reshape(A)
    flat_tok = jnp.arange(A, dtype=jnp.int32) // TOP_K
    flat_gate = gate.reshape(A)
    order = jnp.argsort(flat_e)
    sorted_e = flat_e[order]
    counts = jnp.bincount(flat_e, length=N_EXPERTS)
    padded = ((counts + MOE_BLOCK - 1) // MOE_BLOCK) * MOE_BLOCK
    start_sorted = jnp.cumsum(counts) - counts
    end_padded = jnp.cumsum(padded)
    start_padded = end_padded - padded
    dest = start_padded[sorted_e] + (jnp.arange(A, dtype=jnp.int32) - start_sorted[sorted_e])
    n_blocks = -(-A // MOE_BLOCK) + N_EXPERTS
    P = n_blocks * MOE_BLOCK
    slot_tok = jnp.zeros((P,), jnp.int32).at[dest].set(flat_tok[order])
    slot_gate = jnp.zeros((P,), f32).at[dest].set(flat_gate[order])
    block_start = jnp.arange(n_blocks, dtype=jnp.int32) * MOE_BLOCK
    block_expert = jnp.minimum(jnp.searchsorted(end_padded, block_start, side='right'), N_EXPERTS - 1)
    xb = xt[slot_tok].reshape(n_blocks, MOE_BLOCK, D)

    def expert_block(args):
        xblk, e = args
        gu = xblk @ w_gu[e] + b_gu[e]
        return _clamped_swiglu(gu) @ w_down[e] + b_down[e]

    yb = lax.map(expert_block, (xb, block_expert)).reshape(P, D)
    y = jax.ops.segment_sum(yb.astype(f32) * slot_gate[:, None], slot_tok, num_segments=T)
    return y.reshape(Bsz, S, D).astype(h.dtype)


def setup_inputs(seed: int = 0) -> dict:
    key = jax.random.key(seed)
    ks = jax.random.split(key, 32)
    f32 = jnp.float32
    L, D = DEPTH, D_MODEL
    nrm = lambda k, shape, s: jax.random.normal(k, shape, f32) * s
    dt = jnp.exp(jax.random.uniform(ks[4], (L, GDN_HEADS), f32, math.log(1e-3), math.log(1e-1)))
    w0_base = jnp.linspace(-6.0, -1.0, RWKV_WIDTH, dtype=f32)
    return {
        "x": nrm(ks[0], (BATCH, SEQ, D), 1.0),
        "norm_mix": 1.0 + nrm(ks[1], (L, D), 0.1),
        "w_in": nrm(ks[2], (L, D, N_IN_COLS), D ** -0.5),
        "gdn_conv": nrm(ks[3], (L, CONV_W, GDN_QKV_COLS), CONV_W ** -0.5),
        "gdn_A_log": jnp.log(jax.random.uniform(ks[5], (L, GDN_HEADS), f32, 1.0, 16.0)),
        "gdn_dt_bias": dt + jnp.log(-jnp.expm1(-dt)),
        "gdn_norm": 1.0 + nrm(ks[6], (L, GDN_DV), 0.1),
        "rwkv_mu": jax.random.uniform(ks[7], (L, RWKV_COLS), f32),
        "rwkv_w0": w0_base + nrm(ks[8], (L, RWKV_WIDTH), 0.1),
        "rwkv_w2": nrm(ks[9], (L, DECAY_LORA, RWKV_WIDTH), 0.1),
        "rwkv_a0": nrm(ks[10], (L, RWKV_WIDTH), 0.1),
        "rwkv_a2": nrm(ks[11], (L, AAA_LORA, RWKV_WIDTH), AAA_LORA ** -0.5),
        "rwkv_g2": nrm(ks[12], (L, GATE_LORA, RWKV_WIDTH), GATE_LORA ** -0.5),
        "rwkv_k_k": 0.85 + nrm(ks[13], (L, RWKV_WIDTH), 0.05),
        "rwkv_k_a": 1.0 + nrm(ks[14], (L, RWKV_WIDTH), 0.05),
        "rwkv_r_k": nrm(ks[15], (L, RWKV_HEADS, RWKV_HEAD), 0.1),
        "rwkv_ln_w": 1.0 + nrm(ks[16], (L, RWKV_WIDTH), 0.1),
        "rwkv_ln_b": nrm(ks[17], (L, RWKV_WIDTH), 0.02),
        "proj_a": nrm(ks[18], (L, GDN_V, D), GDN_V ** -0.5),
        "proj_b": nrm(ks[19], (L, RWKV_WIDTH, D), RWKV_WIDTH ** -0.5),
        "w_out": nrm(ks[20], (L, D, D), D ** -0.5),
        "norm_ffn": 1.0 + nrm(ks[21], (L, D), 0.1),
        "router_w": nrm(ks[22], (L, D, N_EXPERTS), D ** -0.5),
        "router_b": nrm(ks[23], (L, N_EXPERTS), 0.01),
        "w_gate_up": nrm(ks[24], (L, N_EXPERTS, D, 2 * D_FF), D ** -0.5),
        "b_gate_up": nrm(ks[25], (L, N_EXPERTS, 2 * D_FF), 0.02),
        "w_down": nrm(ks[26], (L, N_EXPERTS, D_FF, D), D_FF ** -0.5),
        "b_down": nrm(ks[27], (L, N_EXPERTS, D), 0.02),
        "norm_final": 1.0 + nrm(ks[28], (D,), 0.1),
    }


def reference(x, norm_mix, w_in, gdn_conv, gdn_A_log, gdn_dt_bias, gdn_norm,
              rwkv_mu, rwkv_w0, rwkv_w2, rwkv_a0, rwkv_a2, rwkv_g2, rwkv_k_k, rwkv_k_a,
              rwkv_r_k, rwkv_ln_w, rwkv_ln_b, proj_a, proj_b, w_out, norm_ffn,
              router_w, router_b, w_gate_up, b_gate_up, w_down, b_down, norm_final):
    for l in range(DEPTH):
        h = _rmsnorm(x, norm_mix[l])
        p = h @ w_in[l]
        gdn_qkv, gdn_z, gdn_b, gdn_a, rwkv_p, gate_a, gate_b = _split(p, IN_WIDTHS)
        y_a = _gdn_branch(gdn_qkv, gdn_z, gdn_b, gdn_a, gdn_conv[l], gdn_A_log[l],
                          gdn_dt_bias[l], gdn_norm[l])
        y_b = _rwkv7_branch(rwkv_p, rwkv_mu[l], rwkv_w0[l], rwkv_w2[l], rwkv_a0[l], rwkv_a2[l],
                            rwkv_g2[l], rwkv_k_k[l], rwkv_k_a[l], rwkv_r_k[l],
                            rwkv_ln_w[l], rwkv_ln_b[l])
        merged = (jax.nn.sigmoid(gate_a.astype(jnp.float32)) * (y_a @ proj_a[l])
                  + jax.nn.sigmoid(gate_b.astype(jnp.float32)) * (y_b @ proj_b[l]))
        x = x + (merged @ w_out[l]).astype(x.dtype)
        h = _rmsnorm(x, norm_ffn[l])
        x = x + _moe(h, router_w[l], router_b[l], w_gate_up[l], b_gate_up[l], w_down[l], b_down[l])
    return _rmsnorm(x, norm_final)
```

```cpp
#include <hip/hip_runtime.h>
#include <hip/hip_cooperative_groups.h>
#include <cstdint>
#include <cstdio>
namespace cg = cooperative_groups;

#ifndef MK_ONE_LAUNCH
#define MK_ONE_LAUNCH 0
#endif

#define LAS __attribute__((address_space(3)))
constexpr int NTHREADS = 512;
constexpr int NWAVES = 8;
constexpr int LDS_BYTES = 139264;
constexpr int MISC_OFF = 131072;

constexpr int T = 16384, SEQ = 4096, D = 1024;
constexpr int NCOL_IN = 9488;
constexpr int NEXP = 32;
constexpr int MAXTILES = 288;
constexpr int MAXSLOTS = MAXTILES * 256;

enum { I_X = 0, I_NORM_MIX, I_W_IN, I_GDN_CONV, I_GDN_ALOG, I_GDN_DTB, I_GDN_NORM, I_MU, I_W0, I_W2, I_A0, I_A2, I_G2, I_KK, I_KA, I_RK,
       I_LNW, I_LNB, I_PROJ_A, I_PROJ_B, I_W_OUT, I_NORM_FFN, I_ROUTER_W, I_ROUTER_B, I_W_GU, I_B_GU, I_W_DOWN, I_B_DOWN, I_NORM_FINAL };

constexpr size_t MiB = 1u << 20;
constexpr size_t WS_CTL = 0, CTL_BYTES = 65536;
constexpr size_t WS_BETA = 1 * MiB;
constexpr size_t WS_GG = WS_BETA + 512 * 1024;
constexpr size_t WS_SC = 2 * MiB;
constexpr size_t WS_TE = 3 * MiB;
constexpr size_t WS_TG = WS_TE + 256 * 1024;
constexpr size_t WS_TP = WS_TG + 256 * 1024;
constexpr size_t WS_TSLOT = WS_TP + 256 * 1024;
constexpr size_t WS_SGATE = 4 * MiB;
constexpr size_t WS_TILE_E = 5 * MiB;
constexpr size_t WS_NT = WS_TILE_E + 4096;
constexpr size_t WS_HB = 8 * MiB;
constexpr size_t WS_H2 = WS_HB;
constexpr size_t WS_ZS = 40 * MiB;
constexpr size_t WS_GATES = 72 * MiB;
constexpr size_t WS_ALORA = 136 * MiB;
constexpr size_t WS_LW = 144 * MiB;
constexpr size_t WS_AA = 208 * MiB;
constexpr size_t WS_GGR = 272 * MiB;
constexpr size_t WS_VP = 304 * MiB;
constexpr size_t WS_Q = 336 * MiB;
constexpr size_t WS_QKVC = WS_Q;
constexpr size_t WS_RP = WS_Q, WS_KF = WS_Q + 64 * MiB, WS_KKN = WS_Q + 128 * MiB;
constexpr size_t WS_YA = WS_Q, WS_YB = WS_Q + 32 * MiB, WS_G2 = WS_Q + 64 * MiB, WS_X1 = WS_Q + 128 * MiB;
constexpr size_t WS_GQKV = 528 * MiB;
constexpr size_t WS_OG = WS_GQKV, WS_ORW = WS_GQKV + 64 * MiB;
constexpr size_t WS_RKV = 720 * MiB;
constexpr size_t WS_LIN = 912 * MiB;
constexpr size_t WS_DEC = 928 * MiB;
constexpr size_t WS_XB = 528 * MiB;
constexpr size_t WS_ACT = 672 * MiB;
constexpr size_t WS_YS = 816 * MiB;
constexpr size_t WS_END = 992 * MiB;
constexpr int CW_BAR = 1024;
constexpr int CW_CNT = 256;

#define XB_TMO      128
#define XB_XCNT(j)  (256  + 64 * (j))
#define XB_XSUB(j)  (1280 + 64 * (j))
#define XB_XGEN(j)  (2304 + 64 * (j))
#define XB_TOP      3328
#define XB_TOPGEN   3392
#define XCD_BAR_WORDS 3456
#define XB_SPIN_CAP (1u << 24)
__device__ __forceinline__ unsigned xb_ld(unsigned* p)              { return __hip_atomic_load(p, __ATOMIC_RELAXED, __HIP_MEMORY_SCOPE_AGENT); }
__device__ __forceinline__ unsigned xb_add(unsigned* p, unsigned v) { return __hip_atomic_fetch_add(p, v, __ATOMIC_RELAXED, __HIP_MEMORY_SCOPE_AGENT); }
__device__ __forceinline__ unsigned xb_xcc_id() { return (unsigned)__builtin_amdgcn_s_getreg((3 << 11) | 20) & 0xFu; }
#define XB_SPIN(cond, bar) do { unsigned _sp = 0; while (cond) { __builtin_amdgcn_s_sleep(1); \
    if ((++_sp & 255u) == 0u) { if (xb_ld(&(bar)[XB_TMO])) break; if (_sp > XB_SPIN_CAP) { atomicAdd(&(bar)[XB_TMO], 1u); break; } } } } while (0)
struct XcdBarrier { unsigned* bar; unsigned x; volatile LAS unsigned* st; };
__device__ __forceinline__ XcdBarrier xcd_barrier_post(unsigned* bar, volatile LAS unsigned* st) {
    XcdBarrier b; b.bar = bar; b.x = xb_xcc_id(); b.st = st;
    if (threadIdx.x == 0) (void)xb_add(&bar[XB_XCNT(b.x)], 1u);
    return b;
}
__device__ __forceinline__ void xcd_barrier_complete(unsigned* bar, unsigned x, unsigned& nloc, unsigned& nx) {
    const unsigned G = gridDim.x * gridDim.y * gridDim.z;
    unsigned sum, cnt, mine, sp = 0u;
    for (;;) {
        sum = 0u; cnt = 0u; mine = 0u;
#pragma unroll
        for (unsigned j = 0; j < 16; ++j) { const unsigned c = xb_ld(&bar[XB_XCNT(j)]); sum += c; cnt += (c > 0u) ? 1u : 0u; mine = (j == x) ? c : mine; }
        if (sum == G) break;
        __builtin_amdgcn_s_sleep(1);
        if ((++sp & 255u) == 0u) { if (xb_ld(&bar[XB_TMO])) break; if (sp > XB_SPIN_CAP) { atomicAdd(&bar[XB_TMO], 1u); break; } }
    }
    nloc = mine > 0u ? mine : 1u; nx = cnt > 0u ? cnt : 1u;
}
__device__ __forceinline__ void xcd_barrier(const XcdBarrier& b) {
    asm volatile("s_waitcnt vmcnt(0)" ::: "memory");
    __syncthreads();
    if (threadIdx.x == 0) {
        unsigned* bar = b.bar;
        __builtin_amdgcn_s_waitcnt(0);
        unsigned nloc = b.st[0], nx = b.st[1];
        if (nloc == 0u) { xcd_barrier_complete(bar, b.x, nloc, nx); b.st[0] = nloc; b.st[1] = nx; }
        const unsigned old = xb_add(&bar[XB_XSUB(b.x)], 1u);
        const unsigned gen = old / nloc;
        if (old + 1u == (gen + 1u) * nloc) {
            __builtin_amdgcn_fence(__ATOMIC_RELEASE, "agent");
            asm volatile("s_waitcnt vmcnt(0)" ::: "memory");
            const unsigned og = xb_add(&bar[XB_TOP], 1u);
            const unsigned tg = og / nx;
            if (og + 1u == (tg + 1u) * nx) xb_add(&bar[XB_TOPGEN], 1u);
            else XB_SPIN(xb_ld(&bar[XB_TOPGEN]) == tg, bar);
            __builtin_amdgcn_fence(__ATOMIC_ACQUIRE, "agent");
            xb_add(&bar[XB_XGEN(b.x)], 1u);
            asm volatile("s_waitcnt vmcnt(0)" ::: "memory");
        } else {
            XB_SPIN(xb_ld(&bar[XB_XGEN(b.x)]) == gen, bar);
            __builtin_amdgcn_fence(__ATOMIC_ACQUIRE, "agent");
            asm volatile("s_waitcnt vmcnt(0)" ::: "memory");
        }
    }
    __syncthreads();
}

typedef unsigned short bf16;
__device__ __forceinline__ bf16 f2bf(float f) { unsigned u = __float_as_uint(f); u += 0x7fffu + ((u >> 16) & 1u); return (bf16)(u >> 16); }
__device__ __forceinline__ float bf2f(unsigned b) { return __uint_as_float(b << 16); }
__device__ __forceinline__ unsigned pk2(float lo, float hi) { return (unsigned)f2bf(lo) | ((unsigned)f2bf(hi) << 16); }
__device__ __forceinline__ float bflo(unsigned w) { return __uint_as_float(w << 16); }
__device__ __forceinline__ float bfhi(unsigned w) { return __uint_as_float(w & 0xffff0000u); }
__device__ __forceinline__ float sigm(float x) { return 1.f / (1.f + expf(-x)); }
__device__ __forceinline__ float softplusf(float x) { return x > 20.f ? x : log1pf(expf(x)); }
__device__ __forceinline__ float wsum(float v) {
#pragma unroll
    for (int o = 32; o > 0; o >>= 1) v += __shfl_xor(v, o);
    return v;
}

struct Params { const float* in[29]; float* out; unsigned char* ws; int ph_lo, ph_hi, li, coop; };

struct Ctx {
    const Params& P; int tid, lane, wave, gwave, nwaves; size_t gtid, nthreads; unsigned char* lds;
    template <class Tp> __device__ __forceinline__ Tp* ws(size_t off) const { return (Tp*)(P.ws + off); }
};

__device__ void ph_rms0(const Ctx& c) {
    const float* x = c.P.in[I_X]; const float* nw = c.P.in[I_NORM_MIX]; const float* win = c.P.in[I_W_IN];
    const float* alog = c.P.in[I_GDN_ALOG]; const float* dtb = c.P.in[I_GDN_DTB];
    bf16* HB = c.ws<bf16>(WS_HB); float* BETA = c.ws<float>(WS_BETA); float* GGv = c.ws<float>(WS_GG);
    if (blockIdx.x == 0 && c.tid < NEXP) c.ws<unsigned>(WS_CTL)[CW_CNT + c.tid] = 0u;
    const int lane = c.lane;
    for (int t = c.gwave; t < T; t += c.nwaves) {
        float4 v[4]; float ss = 0.f;
#pragma unroll
        for (int i = 0; i < 4; ++i) { v[i] = ((const float4*)(x + (size_t)t * D))[lane + 64 * i]; ss += v[i].x * v[i].x + v[i].y * v[i].y + v[i].z * v[i].z + v[i].w * v[i].w; }
        ss = wsum(ss);
        const float rstd = rsqrtf(ss * (1.f / 1024.f) + 1e-6f);
        float acc[16];
#pragma unroll
        for (int j = 0; j < 16; ++j) acc[j] = 0.f;
#pragma unroll
        for (int i = 0; i < 4; ++i) {
            const float4 w4 = ((const float4*)nw)[lane + 64 * i];
            float h[4] = {v[i].x * rstd * w4.x, v[i].y * rstd * w4.y, v[i].z * rstd * w4.z, v[i].w * rstd * w4.w};
            uint2 st; st.x = pk2(h[0], h[1]); st.y = pk2(h[2], h[3]);
            *(uint2*)(HB + (size_t)t * D + 4 * (lane + 64 * i)) = st;
#pragma unroll
            for (int ii = 0; ii < 4; ++ii) {
                const int k = 4 * (lane + 64 * i) + ii;
                const float4* wr = (const float4*)(win + (size_t)k * NCOL_IN + 4096);
#pragma unroll
                for (int q = 0; q < 4; ++q) { const float4 w = wr[q]; acc[4 * q + 0] += h[ii] * w.x; acc[4 * q + 1] += h[ii] * w.y; acc[4 * q + 2] += h[ii] * w.z; acc[4 * q + 3] += h[ii] * w.w; }
            }
        }
        float mine = 0.f;
#pragma unroll
        for (int j = 0; j < 16; ++j) { const float s = wsum(acc[j]); mine = (lane == j) ? s : mine; }
        if (lane < 8) BETA[t * 8 + lane] = sigm(mine);
        else if (lane < 16) { const int h = lane - 8; GGv[t * 8 + h] = -expf(alog[h]) * softplusf(mine + dtb[h]); }
    }
}

struct TileInfo { const bf16* A; int lda; const float* B; int ldb; int kmask; int row0; int col0; int aux; };

template <class TF, class EP>
__device__ void ngemm(const Ctx& c, int ntiles, const TF& tf, const EP& ep, int K) {
    float* As = (float*)c.lds;
    float* Bs = As + 16 * 132;
    const int tid = c.tid, ty = tid >> 4, tx = tid & 15;
    const int ar = tid >> 2, ak = (tid & 3) * 4;
    const int bk = tid >> 5, bc = (tid & 31) * 4;
    for (int tile = blockIdx.x; tile < ntiles; tile += gridDim.x) {
        TileInfo ti; tf(tile, ti);
        float acc[4][8];
#pragma unroll
        for (int r = 0; r < 4; ++r)
#pragma unroll
            for (int j = 0; j < 8; ++j) acc[r][j] = 0.f;
        const bf16* ap = ti.A + (size_t)ar * ti.lda + ak;
        for (int k0 = 0; k0 < K; k0 += 16) {
            const uint2 av = *(const uint2*)(ap + k0);
            const float4 bv = *(const float4*)(ti.B + (size_t)((k0 + bk) & ti.kmask) * ti.ldb + bc);
            __syncthreads();
            As[(ak + 0) * 132 + ar] = bflo(av.x); As[(ak + 1) * 132 + ar] = bfhi(av.x);
            As[(ak + 2) * 132 + ar] = bflo(av.y); As[(ak + 3) * 132 + ar] = bfhi(av.y);
            *(float4*)(Bs + bk * 132 + bc) = bv;
            __syncthreads();
#pragma unroll
            for (int k = 0; k < 16; ++k) {
                const float4 a = *(const float4*)(As + k * 132 + ty * 4);
                const float4 b0 = *(const float4*)(Bs + k * 132 + tx * 8), b1 = *(const float4*)(Bs + k * 132 + tx * 8 + 4);
                const float av4[4] = {a.x, a.y, a.z, a.w};
                const float bv8[8] = {b0.x, b0.y, b0.z, b0.w, b1.x, b1.y, b1.z, b1.w};
#pragma unroll
                for (int r = 0; r < 4; ++r)
#pragma unroll
                    for (int j = 0; j < 8; ++j) acc[r][j] += av4[r] * bv8[j];
            }
        }
#pragma unroll
        for (int r = 0; r < 4; ++r) ep.store8(ti.row0 + ty * 4 + r, ti.col0 + tx * 8, acc[r], ti.aux);
    }
}

struct EpiInProj {
    float* GQKV; bf16* ZS; float* RKV; float* LIN; bf16* GATES;
    __device__ __forceinline__ void store8(int row, int col, const float (&v)[8], int) const {
        if (col < 3072) { float* p = GQKV + (size_t)row * 3072 + col; *(float4*)p = make_float4(v[0], v[1], v[2], v[3]); *(float4*)(p + 4) = make_float4(v[4], v[5], v[6], v[7]); }
        else if (col < 4096) { uint4 w; w.x = pk2(v[0] * sigm(v[0]), v[1] * sigm(v[1])); w.y = pk2(v[2] * sigm(v[2]), v[3] * sigm(v[3])); w.z = pk2(v[4] * sigm(v[4]), v[5] * sigm(v[5])); w.w = pk2(v[6] * sigm(v[6]), v[7] * sigm(v[7]));
            *(uint4*)(ZS + (size_t)row * 1024 + (col - 3072)) = w; }
        else if (col < 7168) { float* p = RKV + (size_t)row * 3072 + (col - 4096); *(float4*)p = make_float4(v[0], v[1], v[2], v[3]); *(float4*)(p + 4) = make_float4(v[4], v[5], v[6], v[7]); }
        else if (col < 7424) { float* p = LIN + (size_t)row * 256 + (col - 7168); *(float4*)p = make_float4(v[0], v[1], v[2], v[3]); *(float4*)(p + 4) = make_float4(v[4], v[5], v[6], v[7]); }
        else { uint4 w; w.x = pk2(sigm(v[0]), sigm(v[1])); w.y = pk2(sigm(v[2]), sigm(v[3])); w.z = pk2(sigm(v[4]), sigm(v[5])); w.w = pk2(sigm(v[6]), sigm(v[7]));
            *(uint4*)(GATES + (size_t)row * 2048 + (col - 7424)) = w; }
    }
};
struct EpiG2 {
    const bf16* GATES; bf16* G2;
    __device__ __forceinline__ void store8(int row, int col, const float (&v)[8], int) const {
        const uint4 g = *(const uint4*)(GATES + (size_t)row * 2048 + col);
        uint4 w; w.x = pk2(v[0] * bflo(g.x), v[1] * bfhi(g.x)); w.y = pk2(v[2] * bflo(g.y), v[3] * bfhi(g.y)); w.z = pk2(v[4] * bflo(g.z), v[5] * bfhi(g.z)); w.w = pk2(v[6] * bflo(g.w), v[7] * bfhi(g.w));
        *(uint4*)(G2 + (size_t)row * 2048 + col) = w;
    }
};
struct EpiX1 {
    const float* X; float* X1;
    __device__ __forceinline__ void store8(int row, int col, const float (&v)[8], int) const {
        const float* xp = X + (size_t)row * 1024 + col; float* op = X1 + (size_t)row * 1024 + col;
        const float4 a = *(const float4*)xp, b = *(const float4*)(xp + 4);
        *(float4*)op = make_float4(a.x + v[0], a.y + v[1], a.z + v[2], a.w + v[3]); *(float4*)(op + 4) = make_float4(b.x + v[4], b.y + v[5], b.z + v[6], b.w + v[7]);
    }
};
struct EpiAct {
    const float* BGU; bf16* ACT;
    __device__ __forceinline__ void store8(int row, int col, const float (&v)[8], int e) const {
        const float* bp = BGU + (size_t)e * 2048 + col;
        const float4 b0 = *(const float4*)bp, b1 = *(const float4*)(bp + 4);
        const float bb[8] = {b0.x, b0.y, b0.z, b0.w, b1.x, b1.y, b1.z, b1.w};
        float o[4];
#pragma unroll
        for (int p = 0; p < 4; ++p) { float glu = v[2 * p] + bb[2 * p], lin = v[2 * p + 1] + bb[2 * p + 1]; glu = fminf(glu, 7.f); lin = fminf(fmaxf(lin, -7.f), 7.f); o[p] = glu * sigm(1.702f * glu) * (lin + 1.f); }
        uint2 w; w.x = pk2(o[0], o[1]); w.y = pk2(o[2], o[3]);
        *(uint2*)(ACT + (size_t)row * 1024 + (col >> 1)) = w;
    }
};
struct EpiYS {
    const float* BD; const float* SGATE; bf16* YS;
    __device__ __forceinline__ void store8(int row, int col, const float (&v)[8], int e) const {
        const float* bp = BD + (size_t)e * 1024 + col; const float g = SGATE[row];
        const float4 b0 = *(const float4*)bp, b1 = *(const float4*)(bp + 4);
        uint4 w; w.x = pk2((v[0] + b0.x) * g, (v[1] + b0.y) * g); w.y = pk2((v[2] + b0.z) * g, (v[3] + b0.w) * g); w.z = pk2((v[4] + b1.x) * g, (v[5] + b1.y) * g); w.w = pk2((v[6] + b1.z) * g, (v[7] + b1.w) * g);
        *(uint4*)(YS + (size_t)row * 1024 + col) = w;
    }
};

struct TfInProj { const bf16* HB; const float* W;
    __device__ __forceinline__ void operator()(int tile, TileInfo& ti) const { const int tm = tile / 74, tn = tile % 74; ti.A = HB + (size_t)tm * 128 * 1024; ti.lda = 1024; ti.col0 = tn * 128; ti.row0 = tm * 128;
        ti.B = W + ti.col0 + (ti.col0 >= 4096 ? 16 : 0); ti.ldb = NCOL_IN; ti.kmask = 0x7fffffff; ti.aux = 0; } };
struct TfG2 { const bf16* YA; const bf16* YB; const float* PA; const float* PB;
    __device__ __forceinline__ void operator()(int tile, TileInfo& ti) const { const int tm = tile / 16, tn = tile % 16; ti.A = (tn < 8 ? YA : YB) + (size_t)tm * 128 * 1024; ti.lda = 1024; ti.col0 = tn * 128; ti.row0 = tm * 128;
        ti.B = (tn < 8 ? PA + tn * 128 : PB + (tn - 8) * 128); ti.ldb = 1024; ti.kmask = 0x7fffffff; ti.aux = 0; } };
struct TfX1 { const bf16* G2; const float* WO;
    __device__ __forceinline__ void operator()(int tile, TileInfo& ti) const { const int tm = tile / 8, tn = tile % 8; ti.A = G2 + (size_t)tm * 128 * 2048; ti.lda = 2048; ti.col0 = tn * 128; ti.row0 = tm * 128;
        ti.B = WO + tn * 128; ti.ldb = 1024; ti.kmask = 1023; ti.aux = 0; } };
struct TfMoe { const bf16* A; const float* W; const int* TILE_E; int ntn; int ldb; size_t wstride;
    __device__ __forceinline__ void operator()(int tile, TileInfo& ti) const { const int mt = tile / ntn, tn = tile % ntn; const int e = TILE_E[mt >> 1]; ti.A = A + (size_t)mt * 128 * 1024; ti.lda = 1024; ti.col0 = tn * 128; ti.row0 = mt * 128;
        ti.B = W + (size_t)e * wstride + tn * 128; ti.ldb = ldb; ti.kmask = 0x7fffffff; ti.aux = e; } };

__device__ void ph_gconv(const Ctx& c) {
    const float* GQKV = c.ws<float>(WS_GQKV); float* QKVC = c.ws<float>(WS_QKVC); const float* cw = c.P.in[I_GDN_CONV];
    for (size_t idx = c.gtid; idx < (size_t)T * 768; idx += c.nthreads) {
        const int t = (int)(idx / 768), c4 = (int)(idx % 768) * 4, s = t & (SEQ - 1);
        float4 a = make_float4(0.f, 0.f, 0.f, 0.f);
#pragma unroll
        for (int j = 0; j < 4; ++j) {
            if (s - 3 + j >= 0) { const float4 xv = *(const float4*)(GQKV + (size_t)(t - 3 + j) * 3072 + c4); const float4 w = *(const float4*)(cw + j * 3072 + c4);
                a.x += w.x * xv.x; a.y += w.y * xv.y; a.z += w.z * xv.z; a.w += w.w * xv.w; }
        }
        a.x *= sigm(a.x); a.y *= sigm(a.y); a.z *= sigm(a.z); a.w *= sigm(a.w);
        *(float4*)(QKVC + (size_t)t * 3072 + c4) = a;
    }
}
__device__ void ph_gl2(const Ctx& c) {
    float* QKVC = c.ws<float>(WS_QKVC);
    for (int it = c.gwave; it < T * 16; it += c.nwaves) {
        const int t = it >> 4, vec = it & 15;
        float2* p = (float2*)(QKVC + (size_t)t * 3072 + vec * 128) + c.lane;
        float2 v = *p; const float ss = wsum(v.x * v.x + v.y * v.y);
        const float sc = rsqrtf(ss + 1e-6f) * (vec < 8 ? 0.08838834764831845f : 1.f);
        v.x *= sc; v.y *= sc; *p = v;
    }
}
__device__ void ph_gscan(const Ctx& c) {
    if (c.wave >= 2 || blockIdx.x >= 64) return;
    const float* QKVC = c.ws<float>(WS_QKVC); const float* BETA = c.ws<float>(WS_BETA); const float* GGv = c.ws<float>(WS_GG); float* OG = c.ws<float>(WS_OG);
    const int w = blockIdx.x * 2 + c.wave, pair = w >> 2, b = pair >> 3, h = pair & 7, i = (w & 3) * 32 + (c.lane >> 1), half = c.lane & 1;
    float s[64];
#pragma unroll
    for (int k = 0; k < 64; ++k) s[k] = 0.f;
    for (int t = 0; t < SEQ; ++t) {
        const size_t tok = (size_t)b * SEQ + t;
        const float* qp = QKVC + tok * 3072 + h * 128 + half * 64; const float* kp = qp + 1024; const float* vp = QKVC + tok * 3072 + 2048 + h * 128;
        const float eg = expf(GGv[tok * 8 + h]), beta = BETA[tok * 8 + h];
        float d = 0.f;
#pragma unroll
        for (int ch = 0; ch < 4; ++ch) {
            float kv[16];
#pragma unroll
            for (int q = 0; q < 4; ++q) { const float4 x = *(const float4*)(kp + ch * 16 + q * 4); kv[4 * q] = x.x; kv[4 * q + 1] = x.y; kv[4 * q + 2] = x.z; kv[4 * q + 3] = x.w; }
#pragma unroll
            for (int k = 0; k < 16; ++k) { s[ch * 16 + k] *= eg; d += s[ch * 16 + k] * kv[k]; }
            asm volatile("" ::: "memory");
        }
        d += __shfl_xor(d, 1);
        const float vn = beta * (vp[i] - d);
        float o = 0.f;
#pragma unroll
        for (int ch = 0; ch < 4; ++ch) {
            float kv[16], qv[16];
#pragma unroll
            for (int q = 0; q < 4; ++q) { const float4 x = *(const float4*)(kp + ch * 16 + q * 4); kv[4 * q] = x.x; kv[4 * q + 1] = x.y; kv[4 * q + 2] = x.z; kv[4 * q + 3] = x.w;
                                          const float4 y = *(const float4*)(qp + ch * 16 + q * 4); qv[4 * q] = y.x; qv[4 * q + 1] = y.y; qv[4 * q + 2] = y.z; qv[4 * q + 3] = y.w; }
#pragma unroll
            for (int k = 0; k < 16; ++k) { s[ch * 16 + k] += vn * kv[k]; o += s[ch * 16 + k] * qv[k]; }
            asm volatile("" ::: "memory");
        }
        o += __shfl_xor(o, 1);
        if (half == 0) OG[tok * 1024 + h * 128 + i] = o;
    }
}

__device__ void ph_loraprep(const Ctx& c) {
    const float* LIN = c.ws<float>(WS_LIN); bf16* AL = c.ws<bf16>(WS_ALORA); const float* mu = c.P.in[I_MU];
    for (size_t idx = c.gtid; idx < (size_t)T * 256; idx += c.nthreads) {
        const int t = (int)(idx >> 8), cc = (int)(idx & 255);
        const float x = LIN[idx], xp = (t & (SEQ - 1)) ? LIN[idx - 256] : 0.f;
        const float xs = x + (xp - x) * mu[3072 + cc];
        const float r = cc < 64 ? tanhf(xs) : (cc < 128 ? xs : sigm(xs));
        AL[idx] = f2bf(r);
    }
}
__device__ void ph_lora_naive(const Ctx& c) {
    const bf16* AL = c.ws<bf16>(WS_ALORA); float* LW = c.ws<float>(WS_LW); float* AA = c.ws<float>(WS_AA); bf16* GGR = c.ws<bf16>(WS_GGR);
    const float* w0 = c.P.in[I_W0]; const float* w2 = c.P.in[I_W2]; const float* a0 = c.P.in[I_A0]; const float* a2 = c.P.in[I_A2]; const float* g2 = c.P.in[I_G2];
    for (size_t idx = c.gtid; idx < (size_t)T * 1024; idx += c.nthreads) {
        const int t = (int)(idx >> 10), cc = (int)(idx & 1023);
        const bf16* al = AL + (size_t)t * 256;
        float d1 = 0.f, d2 = 0.f, d3 = 0.f;
        for (int j = 0; j < 64; ++j) { d1 += bf2f(al[j]) * w2[j * 1024 + cc]; d2 += bf2f(al[64 + j]) * a2[j * 1024 + cc]; }
        for (int j = 0; j < 128; ++j) d3 += bf2f(al[128 + j]) * g2[j * 1024 + cc];
        const float wlog = -softplusf(-(w0[cc] + d1)) - 0.5f;
        LW[idx] = -expf(wlog);
        AA[idx] = sigm(a0[cc] + d2);
        GGR[idx] = f2bf(d3);
    }
}
__device__ void ph_rprep(const Ctx& c) {
    const float* RKV = c.ws<float>(WS_RKV); const float* AA = c.ws<float>(WS_AA); const float* LW = c.ws<float>(WS_LW);
    float* RP = c.ws<float>(WS_RP); float* KF = c.ws<float>(WS_KF); float* KKN = c.ws<float>(WS_KKN); float* DEC = c.ws<float>(WS_DEC); bf16* VP = c.ws<bf16>(WS_VP); float* SC = c.ws<float>(WS_SC);
    const float* mu = c.P.in[I_MU]; const float* k_k = c.P.in[I_KK]; const float* k_a = c.P.in[I_KA]; const float* r_k = c.P.in[I_RK];
    for (int it = c.gwave; it < T * 16; it += c.nwaves) {
        const int t = it >> 4, h = it & 15, cc = h * 64 + c.lane;
        const bool first = (t & (SEQ - 1)) == 0;
        const float* cur = RKV + (size_t)t * 3072; const float* prv = cur - 3072;
        const float r0 = cur[cc], k0 = cur[1024 + cc], v0 = cur[2048 + cc];
        const float rp = first ? 0.f : prv[cc], kp = first ? 0.f : prv[1024 + cc], vp = first ? 0.f : prv[2048 + cc];
        const float r = r0 + (rp - r0) * mu[cc], k = k0 + (kp - k0) * mu[1024 + cc], v = v0 + (vp - v0) * mu[2048 + cc];
        const float kkv = k * k_k[cc];
        const float ss = wsum(kkv * kkv);
        const float kk = kkv * rsqrtf(ss + 1e-6f);
        const float aa = AA[(size_t)t * 1024 + cc];
        const float kf = k * (1.f + (aa - 1.f) * k_a[cc]);
        const float sc = wsum(r * kf * r_k[cc]);
        const size_t o = (size_t)t * 1024 + cc;
        RP[o] = r; KF[o] = kf; KKN[o] = kk; DEC[o] = expf(LW[o]); VP[o] = f2bf(v);
        if (c.lane == 0) SC[t * 16 + h] = sc;
    }
}
__device__ void ph_rscan(const Ctx& c) {
    if (c.wave != 0 || blockIdx.x >= 64) return;
    const float* RP = c.ws<float>(WS_RP); const float* KF = c.ws<float>(WS_KF); const float* KKN = c.ws<float>(WS_KKN); const float* DEC = c.ws<float>(WS_DEC); const float* AA = c.ws<float>(WS_AA);
    const bf16* VP = c.ws<bf16>(WS_VP); float* ORW = c.ws<float>(WS_ORW);
    const int b = blockIdx.x >> 4, h = blockIdx.x & 15, i = c.lane;
    float s[64];
#pragma unroll
    for (int k = 0; k < 64; ++k) s[k] = 0.f;
    for (int t = 0; t < SEQ; ++t) {
        const size_t o = ((size_t)b * SEQ + t) * 1024 + h * 64;
        const float* rp = RP + o; const float* kf = KF + o; const float* kk = KKN + o; const float* dc = DEC + o; const float* aa = AA + o;
        float sk = 0.f;
#pragma unroll
        for (int ch = 0; ch < 4; ++ch) {
            float kv[16];
#pragma unroll
            for (int q = 0; q < 4; ++q) { const float4 x = *(const float4*)(kk + ch * 16 + q * 4); kv[4 * q] = x.x; kv[4 * q + 1] = x.y; kv[4 * q + 2] = x.z; kv[4 * q + 3] = x.w; }
#pragma unroll
            for (int k = 0; k < 16; ++k) sk += s[ch * 16 + k] * kv[k];
            asm volatile("" ::: "memory");
        }
        const float vi = bf2f(VP[o + i]);
        float out = 0.f;
#pragma unroll
        for (int ch = 0; ch < 16; ++ch) {
            const float4 k4 = *(const float4*)(kk + ch * 4), d4 = *(const float4*)(dc + ch * 4), a4 = *(const float4*)(aa + ch * 4), f4 = *(const float4*)(kf + ch * 4), r4 = *(const float4*)(rp + ch * 4);
            s[ch * 4 + 0] = s[ch * 4 + 0] * d4.x - sk * (k4.x * a4.x) + vi * f4.x; out += s[ch * 4 + 0] * r4.x;
            s[ch * 4 + 1] = s[ch * 4 + 1] * d4.y - sk * (k4.y * a4.y) + vi * f4.y; out += s[ch * 4 + 1] * r4.y;
            s[ch * 4 + 2] = s[ch * 4 + 2] * d4.z - sk * (k4.z * a4.z) + vi * f4.z; out += s[ch * 4 + 2] * r4.z;
            s[ch * 4 + 3] = s[ch * 4 + 3] * d4.w - sk * (k4.w * a4.w) + vi * f4.w; out += s[ch * 4 + 3] * r4.w;
            if ((ch & 1) == 1) asm volatile("" ::: "memory");
        }
        ORW[o + i] = out;
    }
}

__device__ void ph_post(const Ctx& c) {
    const float* OG = c.ws<float>(WS_OG); const float* ORW = c.ws<float>(WS_ORW); const bf16* ZS = c.ws<bf16>(WS_ZS); const bf16* VP = c.ws<bf16>(WS_VP); const bf16* GGR = c.ws<bf16>(WS_GGR);
    const float* SC = c.ws<float>(WS_SC); bf16* YA = c.ws<bf16>(WS_YA); bf16* YB = c.ws<bf16>(WS_YB);
    const float* gnw = c.P.in[I_GDN_NORM]; const float* lnw = c.P.in[I_LNW]; const float* lnb = c.P.in[I_LNB];
    const int lane = c.lane, c0 = lane * 16;
    for (int t = c.gwave; t < T; t += c.nwaves) {
        {
            float o[16];
#pragma unroll
            for (int q = 0; q < 4; ++q) { const float4 v = *(const float4*)(OG + (size_t)t * 1024 + c0 + 4 * q); o[4 * q] = v.x; o[4 * q + 1] = v.y; o[4 * q + 2] = v.z; o[4 * q + 3] = v.w; }
            float ss = 0.f;
#pragma unroll
            for (int j = 0; j < 16; ++j) ss += o[j] * o[j];
            ss += __shfl_xor(ss, 1); ss += __shfl_xor(ss, 2); ss += __shfl_xor(ss, 4);
            const float rstd = rsqrtf(ss * (1.f / 128.f) + 1e-6f);
            const uint4 z0 = *(const uint4*)(ZS + (size_t)t * 1024 + c0), z1 = *(const uint4*)(ZS + (size_t)t * 1024 + c0 + 8);
            const unsigned zz[8] = {z0.x, z0.y, z0.z, z0.w, z1.x, z1.y, z1.z, z1.w};
            unsigned w[8];
#pragma unroll
            for (int j = 0; j < 8; ++j) { const int cc = (c0 + 2 * j) & 127; w[j] = pk2(o[2 * j] * rstd * gnw[cc] * bflo(zz[j]), o[2 * j + 1] * rstd * gnw[cc + 1] * bfhi(zz[j])); }
            *(uint4*)(YA + (size_t)t * 1024 + c0) = make_uint4(w[0], w[1], w[2], w[3]); *(uint4*)(YA + (size_t)t * 1024 + c0 + 8) = make_uint4(w[4], w[5], w[6], w[7]);
        }
        {
            float o[16];
#pragma unroll
            for (int q = 0; q < 4; ++q) { const float4 v = *(const float4*)(ORW + (size_t)t * 1024 + c0 + 4 * q); o[4 * q] = v.x; o[4 * q + 1] = v.y; o[4 * q + 2] = v.z; o[4 * q + 3] = v.w; }
            float sm = 0.f;
#pragma unroll
            for (int j = 0; j < 16; ++j) sm += o[j];
            sm += __shfl_xor(sm, 1); sm += __shfl_xor(sm, 2);
            const float mean = sm * (1.f / 64.f);
            float sv = 0.f;
#pragma unroll
            for (int j = 0; j < 16; ++j) { const float dd = o[j] - mean; sv += dd * dd; }
            sv += __shfl_xor(sv, 1); sv += __shfl_xor(sv, 2);
            const float rstd = rsqrtf(sv * (1.f / 64.f) + 64e-5f);
            const float sc = SC[t * 16 + (c0 >> 6)];
            const uint4 v0 = *(const uint4*)(VP + (size_t)t * 1024 + c0), v1 = *(const uint4*)(VP + (size_t)t * 1024 + c0 + 8);
            const uint4 g0 = *(const uint4*)(GGR + (size_t)t * 1024 + c0), g1 = *(const uint4*)(GGR + (size_t)t * 1024 + c0 + 8);
            const unsigned vv[8] = {v0.x, v0.y, v0.z, v0.w, v1.x, v1.y, v1.z, v1.w};
            const unsigned gg[8] = {g0.x, g0.y, g0.z, g0.w, g1.x, g1.y, g1.z, g1.w};
            unsigned w[8];
#pragma unroll
            for (int j = 0; j < 8; ++j) { const int cc = c0 + 2 * j;
                const float y0 = ((o[2 * j] - mean) * rstd * lnw[cc] + lnb[cc] + sc * bflo(vv[j])) * bflo(gg[j]);
                const float y1 = ((o[2 * j + 1] - mean) * rstd * lnw[cc + 1] + lnb[cc + 1] + sc * bfhi(vv[j])) * bfhi(gg[j]);
                w[j] = pk2(y0, y1); }
            *(uint4*)(YB + (size_t)t * 1024 + c0) = make_uint4(w[0], w[1], w[2], w[3]); *(uint4*)(YB + (size_t)t * 1024 + c0 + 8) = make_uint4(w[4], w[5], w[6], w[7]);
        }
    }
}

__device__ void ph_router(const Ctx& c) {
    const float* X1 = c.ws<float>(WS_X1); const float* nw = c.P.in[I_NORM_FFN]; const float* rw = c.P.in[I_ROUTER_W]; const float* rb = c.P.in[I_ROUTER_B];
    bf16* H2 = c.ws<bf16>(WS_H2); int* TE = c.ws<int>(WS_TE); float* TG = c.ws<float>(WS_TG); int* TP = c.ws<int>(WS_TP); unsigned* CNT = c.ws<unsigned>(WS_CTL) + CW_CNT;
    const int lane = c.lane;
    for (int t = c.gwave; t < T; t += c.nwaves) {
        float4 v[4]; float ss = 0.f;
#pragma unroll
        for (int i = 0; i < 4; ++i) { v[i] = ((const float4*)(X1 + (size_t)t * D))[lane + 64 * i]; ss += v[i].x * v[i].x + v[i].y * v[i].y + v[i].z * v[i].z + v[i].w * v[i].w; }
        ss = wsum(ss);
        const float rstd = rsqrtf(ss * (1.f / 1024.f) + 1e-6f);
        float lg[32];
#pragma unroll
        for (int j = 0; j < 32; ++j) lg[j] = 0.f;
#pragma unroll
        for (int i = 0; i < 4; ++i) {
            const float4 w4 = ((const float4*)nw)[lane + 64 * i];
            const float h[4] = {v[i].x * rstd * w4.x, v[i].y * rstd * w4.y, v[i].z * rstd * w4.z, v[i].w * rstd * w4.w};
            uint2 st; st.x = pk2(h[0], h[1]); st.y = pk2(h[2], h[3]);
            *(uint2*)(H2 + (size_t)t * D + 4 * (lane + 64 * i)) = st;
#pragma unroll
            for (int ii = 0; ii < 4; ++ii) {
                const float4* wr = (const float4*)(rw + (size_t)(4 * (lane + 64 * i) + ii) * 32);
#pragma unroll
                for (int q = 0; q < 8; ++q) { const float4 w = wr[q]; lg[4 * q] += h[ii] * w.x; lg[4 * q + 1] += h[ii] * w.y; lg[4 * q + 2] += h[ii] * w.z; lg[4 * q + 3] += h[ii] * w.w; }
            }
        }
#pragma unroll
        for (int j = 0; j < 32; ++j) lg[j] = wsum(lg[j]) + rb[j];
        int e0 = 0, e1 = 0, e2 = 0, e3 = 0; float v0 = -3e38f, v1 = -3e38f, v2 = -3e38f, v3 = -3e38f;
#pragma unroll
        for (int j = 0; j < 32; ++j) if (lg[j] > v0) { v0 = lg[j]; e0 = j; }
#pragma unroll
        for (int j = 0; j < 32; ++j) if (j != e0 && lg[j] > v1) { v1 = lg[j]; e1 = j; }
#pragma unroll
        for (int j = 0; j < 32; ++j) if (j != e0 && j != e1 && lg[j] > v2) { v2 = lg[j]; e2 = j; }
#pragma unroll
        for (int j = 0; j < 32; ++j) if (j != e0 && j != e1 && j != e2 && lg[j] > v3) { v3 = lg[j]; e3 = j; }
        const float x1 = expf(v1 - v0), x2 = expf(v2 - v0), x3 = expf(v3 - v0), inv = 1.f / (1.f + x1 + x2 + x3);
        if (lane < 4) {
            const int me = lane == 0 ? e0 : (lane == 1 ? e1 : (lane == 2 ? e2 : e3));
            const float mg = (lane == 0 ? 1.f : (lane == 1 ? x1 : (lane == 2 ? x2 : x3))) * inv;
            const unsigned pos = atomicAdd(&CNT[me], 1u);
            TE[t * 4 + lane] = me; TG[t * 4 + lane] = mg; TP[t * 4 + lane] = (int)pos;
        }
    }
}

__device__ void ph_dispatch(const Ctx& c) {
    int* tb = (int*)c.lds;
    const unsigned* CNT = c.ws<unsigned>(WS_CTL) + CW_CNT;
    int* TILE_E = c.ws<int>(WS_TILE_E); int* NT = c.ws<int>(WS_NT);
    const int* TE = c.ws<int>(WS_TE); const float* TG = c.ws<float>(WS_TG); const int* TP = c.ws<int>(WS_TP); int* TSLOT = c.ws<int>(WS_TSLOT);
    float* SGATE = c.ws<float>(WS_SGATE); const bf16* H2 = c.ws<bf16>(WS_H2); bf16* XB = c.ws<bf16>(WS_XB);
    if (c.tid == 0) { int acc = 0; for (int e = 0; e < NEXP; ++e) { const int n = (int)__hip_atomic_load(&CNT[e], __ATOMIC_RELAXED, __HIP_MEMORY_SCOPE_AGENT); tb[e] = acc; tb[64 + e] = n; acc += (n + 255) >> 8; } tb[32] = acc; }
    __syncthreads();
    if (blockIdx.x == 0) {
        for (int tile = c.tid; tile < tb[32]; tile += NTHREADS) { int e = 0; for (int q = 0; q < NEXP; ++q) if (tile >= tb[q]) e = q; TILE_E[tile] = e; }
        if (c.tid == 0) *NT = tb[32];
    }
    for (int idx = c.gwave; idx < T * 4; idx += c.nwaves) {
        const int t = idx >> 2, e = TE[idx], pos = TP[idx];
        const int slot = tb[e] * 256 + pos;
        if (c.lane == 0) { TSLOT[idx] = slot; SGATE[slot] = TG[idx]; }
        const uint4* src = (const uint4*)(H2 + (size_t)t * 1024); uint4* dst = (uint4*)(XB + (size_t)slot * 1024);
        dst[c.lane] = src[c.lane]; dst[c.lane + 64] = src[c.lane + 64];
    }
    for (int e = 0; e < NEXP; ++e) {
        const int n = tb[64 + e], cap = (tb[e + 1] - tb[e]) * 256;
        for (int r = n + c.gwave; r < cap; r += c.nwaves) {
            const int slot = tb[e] * 256 + r;
            uint4* dst = (uint4*)(XB + (size_t)slot * 1024);
            dst[c.lane] = make_uint4(0, 0, 0, 0); dst[c.lane + 64] = make_uint4(0, 0, 0, 0);
            if (c.lane == 0) SGATE[slot] = 0.f;
        }
    }
}

__device__ void ph_combine(const Ctx& c) {
    const float* X1 = c.ws<float>(WS_X1); const bf16* YS = c.ws<bf16>(WS_YS); const int* TSLOT = c.ws<int>(WS_TSLOT); const float* nw = c.P.in[I_NORM_FINAL]; float* out = c.P.out;
    const int lane = c.lane;
    for (int t = c.gwave; t < T; t += c.nwaves) {
        const int s0 = TSLOT[t * 4], s1 = TSLOT[t * 4 + 1], s2 = TSLOT[t * 4 + 2], s3 = TSLOT[t * 4 + 3];
        float4 v[4]; float ss = 0.f;
#pragma unroll
        for (int i = 0; i < 4; ++i) {
            const int col = 4 * (lane + 64 * i);
            v[i] = *(const float4*)(X1 + (size_t)t * D + col);
            const uint2 a = *(const uint2*)(YS + (size_t)s0 * 1024 + col), b = *(const uint2*)(YS + (size_t)s1 * 1024 + col), cc = *(const uint2*)(YS + (size_t)s2 * 1024 + col), d = *(const uint2*)(YS + (size_t)s3 * 1024 + col);
            v[i].x += bflo(a.x) + bflo(b.x) + bflo(cc.x) + bflo(d.x); v[i].y += bfhi(a.x) + bfhi(b.x) + bfhi(cc.x) + bfhi(d.x);
            v[i].z += bflo(a.y) + bflo(b.y) + bflo(cc.y) + bflo(d.y); v[i].w += bfhi(a.y) + bfhi(b.y) + bfhi(cc.y) + bfhi(d.y);
            ss += v[i].x * v[i].x + v[i].y * v[i].y + v[i].z * v[i].z + v[i].w * v[i].w;
        }
        ss = wsum(ss);
        const float rstd = rsqrtf(ss * (1.f / 1024.f) + 1e-6f);
#pragma unroll
        for (int i = 0; i < 4; ++i) { const float4 w4 = ((const float4*)nw)[lane + 64 * i];
            *(float4*)(out + (size_t)t * D + 4 * (lane + 64 * i)) = make_float4(v[i].x * rstd * w4.x, v[i].y * rstd * w4.y, v[i].z * rstd * w4.z, v[i].w * rstd * w4.w); }
    }
}

enum { PH_RMS0 = 0, PH_INPROJ, PH_GCONV, PH_GL2, PH_GSCAN, PH_RPREP, PH_RSCAN, PH_POST, PH_G2, PH_X1, PH_ROUTER, PH_DISPATCH, PH_MOE1, PH_MOE2, PH_COMBINE, PH_COUNT };

template <unsigned PHMASK>
__global__ void __launch_bounds__(NTHREADS) mk(Params P) {
    extern __shared__ __attribute__((aligned(16))) unsigned char lds[];
    volatile LAS unsigned* misc = (volatile LAS unsigned*)((LAS unsigned char*)lds + MISC_OFF);
    if (threadIdx.x < 64) misc[threadIdx.x] = 0u;
    __syncthreads();
    unsigned* ctl = (unsigned*)(P.ws + WS_CTL);
    XcdBarrier bar = xcd_barrier_post(ctl + CW_BAR + P.li * XCD_BAR_WORDS, misc);
    Ctx c{P, (int)threadIdx.x, (int)(threadIdx.x & 63), (int)(threadIdx.x >> 6), (int)(blockIdx.x * NWAVES + (threadIdx.x >> 6)), (int)(gridDim.x * NWAVES),
          (size_t)blockIdx.x * NTHREADS + threadIdx.x, (size_t)gridDim.x * NTHREADS, lds};
    bool first_seam = true;
#define IN(k) (((PHMASK >> (k)) & 1u) && P.ph_lo <= (k) && (k) < P.ph_hi)
#define SEAM(k) do { if ((k) + 1 < P.ph_hi) { if (first_seam && P.coop) { cg::this_grid().sync(); } else xcd_barrier(bar); first_seam = false; } } while (0)
    if (IN(PH_RMS0)) { ph_rms0(c); SEAM(PH_RMS0); }
    if (IN(PH_INPROJ)) {
        TfInProj tf{c.ws<bf16>(WS_HB), P.in[I_W_IN]};
        EpiInProj ep{c.ws<float>(WS_GQKV), c.ws<bf16>(WS_ZS), c.ws<float>(WS_RKV), c.ws<float>(WS_LIN), c.ws<bf16>(WS_GATES)};
        ngemm(c, 128 * 74, tf, ep, 1024); SEAM(PH_INPROJ);
    }
    if (IN(PH_GCONV)) { ph_gconv(c); ph_loraprep(c); SEAM(PH_GCONV); }
    if (IN(PH_GL2)) { ph_gl2(c); ph_lora_naive(c); SEAM(PH_GL2); }
    if (IN(PH_GSCAN)) { ph_gscan(c); SEAM(PH_GSCAN); }
    if (IN(PH_RPREP)) { ph_rprep(c); SEAM(PH_RPREP); }
    if (IN(PH_RSCAN)) { ph_rscan(c); SEAM(PH_RSCAN); }
    if (IN(PH_POST)) { ph_post(c); SEAM(PH_POST); }
    if (IN(PH_G2)) {
        TfG2 tf{c.ws<bf16>(WS_YA), c.ws<bf16>(WS_YB), P.in[I_PROJ_A], P.in[I_PROJ_B]};
        EpiG2 ep{c.ws<bf16>(WS_GATES), c.ws<bf16>(WS_G2)};
        ngemm(c, 128 * 16, tf, ep, 1024); SEAM(PH_G2);
    }
    if (IN(PH_X1)) {
        TfX1 tf{c.ws<bf16>(WS_G2), P.in[I_W_OUT]};
        EpiX1 ep{P.in[I_X], c.ws<float>(WS_X1)};
        ngemm(c, 128 * 8, tf, ep, 2048); SEAM(PH_X1);
    }
    if (IN(PH_ROUTER)) { ph_router(c); SEAM(PH_ROUTER); }
    if (IN(PH_DISPATCH)) { ph_dispatch(c); SEAM(PH_DISPATCH); }
    if (IN(PH_MOE1)) {
        const int nt = *c.ws<int>(WS_NT);
        TfMoe tf{c.ws<bf16>(WS_XB), P.in[I_W_GU], c.ws<int>(WS_TILE_E), 16, 2048, (size_t)1024 * 2048};
        EpiAct ep{P.in[I_B_GU], c.ws<bf16>(WS_ACT)};
        ngemm(c, nt * 2 * 16, tf, ep, 1024); SEAM(PH_MOE1);
    }
    if (IN(PH_MOE2)) {
        const int nt = *c.ws<int>(WS_NT);
        TfMoe tf{c.ws<bf16>(WS_ACT), P.in[I_W_DOWN], c.ws<int>(WS_TILE_E), 8, 1024, (size_t)1024 * 1024};
        EpiYS ep{P.in[I_B_DOWN], c.ws<float>(WS_SGATE), c.ws<bf16>(WS_YS)};
        ngemm(c, nt * 2 * 8, tf, ep, 1024); SEAM(PH_MOE2);
    }
    if (IN(PH_COMBINE)) { ph_combine(c); }
#undef IN
#undef SEAM
}

template <unsigned M> static void launch_one(const Params& p, int grid, hipStream_t stream) {
    static bool attr = false;
    if (!attr) { (void)hipFuncSetAttribute((const void*)mk<M>, hipFuncAttributeMaxDynamicSharedMemorySize, LDS_BYTES); attr = true; }
    hipLaunchKernelGGL(mk<M>, dim3(grid), dim3(NTHREADS), LDS_BYTES, stream, p);
}
template <int PH> static void launch_chain(Params& p, int grid, hipStream_t stream) {
    if constexpr (PH < PH_COUNT) { p.ph_lo = PH; p.ph_hi = PH + 1; p.li = 0; p.coop = 0; launch_one<(1u << PH)>(p, grid, stream); launch_chain<PH + 1>(p, grid, stream); }
}

extern "C" void kernel_launch(void* const* d_in, const int* in_sizes, int n_in, void* d_out, int out_size, void* d_ws, size_t ws_size, hipStream_t stream) {
    static int grid = 0;
    if (grid == 0) {
        int dev = 0, cus = 0, per_cu = 0;
        (void)hipGetDevice(&dev);
        (void)hipDeviceGetAttribute(&cus, hipDeviceAttributeMultiprocessorCount, dev);
#if MK_ONE_LAUNCH
        (void)hipFuncSetAttribute((const void*)mk<0xffffffffu>, hipFuncAttributeMaxDynamicSharedMemorySize, LDS_BYTES);
        (void)hipOccupancyMaxActiveBlocksPerMultiprocessor(&per_cu, (const void*)mk<0xffffffffu>, NTHREADS, LDS_BYTES);
#else
        per_cu = 1;
#endif
        if (n_in != 29 || ws_size < WS_END || per_cu < 1 || cus < 64) { fprintf(stderr, "kernel_launch: unexpected setup n_in %d ws %zu per_cu %d cus %d\n", n_in, ws_size, per_cu, cus); grid = -1; return; }
        grid = cus;
    }
    if (grid < 0) return;
    (void)hipMemsetAsync((char*)d_ws + WS_CTL, 0, CTL_BYTES, stream);
    Params p{};
    for (int i = 0; i < 29; ++i) p.in[i] = (const float*)d_in[i];
    p.out = (float*)d_out; p.ws = (unsigned char*)d_ws;
#if MK_ONE_LAUNCH
    p.ph_lo = 0; p.ph_hi = PH_COUNT; p.li = 0; p.coop = 1;
    void* args[] = {&p};
    hipError_t e = hipLaunchCooperativeKernel((const void*)mk<0xffffffffu>, dim3(grid), dim3(NTHREADS), args, LDS_BYTES, stream);
    if (e != hipSuccess) fprintf(stderr, "cooperative launch failed: %s (grid %d)\n", hipGetErrorString(e), grid);
#else
    launch_chain<0>(p, grid, stream);
#endif
}
```

```cpp
#include <hip/hip_runtime.h>
#include <hip/hip_cooperative_groups.h>
#include <cstdint>
#include <cstdio>
namespace cg = cooperative_groups;

#ifndef MK_ONE_LAUNCH
#define MK_ONE_LAUNCH 1
#endif

#define LAS __attribute__((address_space(3)))
#ifndef FAST_INPROJ
#define FAST_INPROJ 1
#endif
#ifndef FAST_MIX
#define FAST_MIX 1
#endif
constexpr int NTHREADS = 512;
constexpr int NWAVES = 8;
constexpr int LDS_BYTES = 155648;
constexpr int MISC_OFF = 153600;

constexpr int T = 16384, SEQ = 4096, D = 1024;
constexpr int NCOL_IN = 9488;
constexpr int NEXP = 32;
constexpr int MAXTILES = 288;
constexpr int MAXSLOTS = MAXTILES * 256;

enum { I_X = 0, I_NORM_MIX, I_W_IN, I_GDN_CONV, I_GDN_ALOG, I_GDN_DTB, I_GDN_NORM, I_MU, I_W0, I_W2, I_A0, I_A2, I_G2, I_KK, I_KA, I_RK,
       I_LNW, I_LNB, I_PROJ_A, I_PROJ_B, I_W_OUT, I_NORM_FFN, I_ROUTER_W, I_ROUTER_B, I_W_GU, I_B_GU, I_W_DOWN, I_B_DOWN, I_NORM_FINAL };

constexpr size_t MiB = 1u << 20;
constexpr size_t WS_CTL = 0, CTL_BYTES = 65536;
constexpr size_t WS_BETA = 1 * MiB;
constexpr size_t WS_GG = WS_BETA + 512 * 1024;
constexpr size_t WS_SC = 2 * MiB;
constexpr size_t WS_TE = 3 * MiB;
constexpr size_t WS_TG = WS_TE + 256 * 1024;
constexpr size_t WS_TP = WS_TG + 256 * 1024;
constexpr size_t WS_TSLOT = WS_TP + 256 * 1024;
constexpr size_t WS_SGATE = 4 * MiB;
constexpr size_t WS_TILE_E = 5 * MiB;
constexpr size_t WS_NT = WS_TILE_E + 4096;
constexpr size_t WS_HB = 8 * MiB;
constexpr size_t WS_H2 = WS_HB;
constexpr size_t WS_ZS = 40 * MiB;
constexpr size_t WS_GATES = 72 * MiB;
constexpr size_t WS_ALORA = 136 * MiB;
constexpr size_t WS_LW = 144 * MiB;
constexpr size_t WS_AA = 208 * MiB;
constexpr size_t WS_GGR = 272 * MiB;
constexpr size_t WS_VP = 304 * MiB;
constexpr size_t WS_Q = 336 * MiB;
constexpr size_t WS_QKVC = WS_Q;
constexpr size_t WS_RP = WS_Q, WS_KF = WS_Q + 64 * MiB, WS_KKN = WS_Q + 128 * MiB;
constexpr size_t WS_YA = WS_Q, WS_YB = WS_Q + 32 * MiB, WS_G2 = WS_Q + 64 * MiB, WS_X1 = WS_Q + 128 * MiB;
constexpr size_t WS_GQKV = 528 * MiB;
#if FAST_MIX
constexpr size_t WS_OG = 720 * MiB, WS_ORW = 784 * MiB;
#else
constexpr size_t WS_OG = WS_GQKV, WS_ORW = WS_GQKV + 64 * MiB;
#endif
constexpr size_t WS_RKV = 720 * MiB;
constexpr size_t WS_LIN = 912 * MiB;
constexpr size_t WS_DEC = 928 * MiB;
constexpr size_t WS_XB = 528 * MiB;
constexpr size_t WS_ACT = 672 * MiB;
constexpr size_t WS_YS = 816 * MiB;
constexpr size_t WS_WIN_T = 992 * MiB;
constexpr size_t WS_PROJ_T = 512 * MiB;
constexpr size_t WS_WOUT_T = 516 * MiB;
constexpr size_t WS_WGU_T = 72 * MiB;
constexpr size_t WS_WDN_T = 200 * MiB;
constexpr size_t WS_GA1 = 336 * MiB, WS_GX0 = 368 * MiB, WS_GA2 = 432 * MiB, WS_GA3 = 464 * MiB, WS_GA4 = 480 * MiB;
constexpr size_t WS_GGL = 6 * MiB;
constexpr size_t WS_RX0 = 528 * MiB, WS_RO0 = 592 * MiB, WS_RS0 = 656 * MiB;
constexpr size_t WS_RA1 = 8 * MiB, WS_RA2 = 928 * MiB, WS_RA3 = 960 * MiB, WS_RA4 = 992 * MiB;
constexpr size_t WS_RDSC = 7 * MiB;
constexpr size_t WS_END = 1024 * MiB;
constexpr int CW_BAR = 1024;
constexpr int CW_CNT = 256;

#define XB_TMO      128
#define XB_XCNT(j)  (256  + 64 * (j))
#define XB_XSUB(j)  (1280 + 64 * (j))
#define XB_XGEN(j)  (2304 + 64 * (j))
#define XB_TOP      3328
#define XB_TOPGEN   3392
#define XCD_BAR_WORDS 3456
#define XB_SPIN_CAP (1u << 24)
__device__ __forceinline__ unsigned xb_ld(unsigned* p)              { return __hip_atomic_load(p, __ATOMIC_RELAXED, __HIP_MEMORY_SCOPE_AGENT); }
__device__ __forceinline__ unsigned xb_add(unsigned* p, unsigned v) { return __hip_atomic_fetch_add(p, v, __ATOMIC_RELAXED, __HIP_MEMORY_SCOPE_AGENT); }
__device__ __forceinline__ unsigned xb_xcc_id() { return (unsigned)__builtin_amdgcn_s_getreg((3 << 11) | 20) & 0xFu; }
#define XB_SPIN(cond, bar) do { unsigned _sp = 0; while (cond) { __builtin_amdgcn_s_sleep(1); \
    if ((++_sp & 255u) == 0u) { if (xb_ld(&(bar)[XB_TMO])) break; if (_sp > XB_SPIN_CAP) { atomicAdd(&(bar)[XB_TMO], 1u); break; } } } } while (0)
struct XcdBarrier { unsigned* bar; unsigned x; volatile LAS unsigned* st; };
__device__ __forceinline__ XcdBarrier xcd_barrier_post(unsigned* bar, volatile LAS unsigned* st) {
    XcdBarrier b; b.bar = bar; b.x = xb_xcc_id(); b.st = st;
    if (threadIdx.x == 0) (void)xb_add(&bar[XB_XCNT(b.x)], 1u);
    return b;
}
__device__ __forceinline__ void xcd_barrier_complete(unsigned* bar, unsigned x, unsigned& nloc, unsigned& nx) {
    const unsigned G = gridDim.x * gridDim.y * gridDim.z;
    unsigned sum, cnt, mine, sp = 0u;
    for (;;) {
        sum = 0u; cnt = 0u; mine = 0u;
#pragma unroll
        for (unsigned j = 0; j < 16; ++j) { const unsigned c = xb_ld(&bar[XB_XCNT(j)]); sum += c; cnt += (c > 0u) ? 1u : 0u; mine = (j == x) ? c : mine; }
        if (sum == G) break;
        __builtin_amdgcn_s_sleep(1);
        if ((++sp & 255u) == 0u) { if (xb_ld(&bar[XB_TMO])) break; if (sp > XB_SPIN_CAP) { atomicAdd(&bar[XB_TMO], 1u); break; } }
    }
    nloc = mine > 0u ? mine : 1u; nx = cnt > 0u ? cnt : 1u;
}
__device__ __forceinline__ void xcd_barrier(const XcdBarrier& b) {
    asm volatile("s_waitcnt vmcnt(0)" ::: "memory");
    __syncthreads();
    if (threadIdx.x == 0) {
        unsigned* bar = b.bar;
        __builtin_amdgcn_s_waitcnt(0);
        unsigned nloc = b.st[0], nx = b.st[1];
        if (nloc == 0u) { xcd_barrier_complete(bar, b.x, nloc, nx); b.st[0] = nloc; b.st[1] = nx; }
        const unsigned old = xb_add(&bar[XB_XSUB(b.x)], 1u);
        const unsigned gen = old / nloc;
        if (old + 1u == (gen + 1u) * nloc) {
            __builtin_amdgcn_fence(__ATOMIC_RELEASE, "agent");
            asm volatile("s_waitcnt vmcnt(0)" ::: "memory");
            const unsigned og = xb_add(&bar[XB_TOP], 1u);
            const unsigned tg = og / nx;
            if (og + 1u == (tg + 1u) * nx) xb_add(&bar[XB_TOPGEN], 1u);
            else XB_SPIN(xb_ld(&bar[XB_TOPGEN]) == tg, bar);
            __builtin_amdgcn_fence(__ATOMIC_ACQUIRE, "agent");
            xb_add(&bar[XB_XGEN(b.x)], 1u);
            asm volatile("s_waitcnt vmcnt(0)" ::: "memory");
        } else {
            XB_SPIN(xb_ld(&bar[XB_XGEN(b.x)]) == gen, bar);
            __builtin_amdgcn_fence(__ATOMIC_ACQUIRE, "agent");
            asm volatile("s_waitcnt vmcnt(0)" ::: "memory");
        }
    }
    __syncthreads();
}

typedef unsigned short bf16;
__device__ __forceinline__ bf16 f2bf(float f) { unsigned u = __float_as_uint(f); u += 0x7fffu + ((u >> 16) & 1u); return (bf16)(u >> 16); }
__device__ __forceinline__ float bf2f(unsigned b) { return __uint_as_float(b << 16); }
__device__ __forceinline__ unsigned pk2(float lo, float hi) { return (unsigned)f2bf(lo) | ((unsigned)f2bf(hi) << 16); }
__device__ __forceinline__ float bflo(unsigned w) { return __uint_as_float(w << 16); }
__device__ __forceinline__ float bfhi(unsigned w) { return __uint_as_float(w & 0xffff0000u); }
__device__ __forceinline__ float sigm(float x) { return 1.f / (1.f + expf(-x)); }
__device__ __forceinline__ float softplusf(float x) { return x > 20.f ? x : log1pf(expf(x)); }
__device__ __forceinline__ float wsum(float v) {
#pragma unroll
    for (int o = 32; o > 0; o >>= 1) v += __shfl_xor(v, o);
    return v;
}

struct Params { const float* in[29]; float* out; unsigned char* ws; int ph_lo, ph_hi, li, coop; };

struct Ctx {
    const Params& P; int tid, lane, wave, gwave, nwaves; size_t gtid, nthreads; unsigned char* lds;
    template <class Tp> __device__ __forceinline__ Tp* ws(size_t off) const { return (Tp*)(P.ws + off); }
};

__device__ void ph_rms0(const Ctx& c) {
    const float* x = c.P.in[I_X]; const float* nw = c.P.in[I_NORM_MIX]; const float* win = c.P.in[I_W_IN];
    const float* alog = c.P.in[I_GDN_ALOG]; const float* dtb = c.P.in[I_GDN_DTB];
    bf16* HB = c.ws<bf16>(WS_HB); float* BETA = c.ws<float>(WS_BETA); float* GGv = c.ws<float>(WS_GG);
    if (blockIdx.x == 0 && c.tid < NEXP) c.ws<unsigned>(WS_CTL)[CW_CNT + c.tid] = 0u;
    const int lane = c.lane;
    for (int t = c.gwave; t < T; t += c.nwaves) {
        float4 v[4]; float ss = 0.f;
#pragma unroll
        for (int i = 0; i < 4; ++i) { v[i] = ((const float4*)(x + (size_t)t * D))[lane + 64 * i]; ss += v[i].x * v[i].x + v[i].y * v[i].y + v[i].z * v[i].z + v[i].w * v[i].w; }
        ss = wsum(ss);
        const float rstd = rsqrtf(ss * (1.f / 1024.f) + 1e-6f);
        float acc[16];
#pragma unroll
        for (int j = 0; j < 16; ++j) acc[j] = 0.f;
#pragma unroll
        for (int i = 0; i < 4; ++i) {
            const float4 w4 = ((const float4*)nw)[lane + 64 * i];
            float h[4] = {v[i].x * rstd * w4.x, v[i].y * rstd * w4.y, v[i].z * rstd * w4.z, v[i].w * rstd * w4.w};
            uint2 st; st.x = pk2(h[0], h[1]); st.y = pk2(h[2], h[3]);
            *(uint2*)(HB + (size_t)t * D + 4 * (lane + 64 * i)) = st;
#pragma unroll
            for (int ii = 0; ii < 4; ++ii) {
                const int k = 4 * (lane + 64 * i) + ii;
                const float4* wr = (const float4*)(win + (size_t)k * NCOL_IN + 4096);
#pragma unroll
                for (int q = 0; q < 4; ++q) { const float4 w = wr[q]; acc[4 * q + 0] += h[ii] * w.x; acc[4 * q + 1] += h[ii] * w.y; acc[4 * q + 2] += h[ii] * w.z; acc[4 * q + 3] += h[ii] * w.w; }
            }
        }
        float mine = 0.f;
#pragma unroll
        for (int j = 0; j < 16; ++j) { const float s = wsum(acc[j]); mine = (lane == j) ? s : mine; }
        if (lane < 8) BETA[t * 8 + lane] = sigm(mine);
        else if (lane < 16) { const int h = lane - 8; GGv[t * 8 + h] = -expf(alog[h]) * softplusf(mine + dtb[h]); }
    }
}

struct TileInfo { const bf16* A; int lda; const float* B; int ldb; int kmask; int row0; int col0; int aux; };

template <class TF, class EP>
__device__ void ngemm(const Ctx& c, int ntiles, const TF& tf, const EP& ep, int K) {
    float* As = (float*)c.lds;
    float* Bs = As + 16 * 132;
    const int tid = c.tid, ty = tid >> 4, tx = tid & 15;
    const int ar = tid >> 2, ak = (tid & 3) * 4;
    const int bk = tid >> 5, bc = (tid & 31) * 4;
    for (int tile = blockIdx.x; tile < ntiles; tile += gridDim.x) {
        TileInfo ti; tf(tile, ti);
        float acc[4][8];
#pragma unroll
        for (int r = 0; r < 4; ++r)
#pragma unroll
            for (int j = 0; j < 8; ++j) acc[r][j] = 0.f;
        const bf16* ap = ti.A + (size_t)ar * ti.lda + ak;
        for (int k0 = 0; k0 < K; k0 += 16) {
            const uint2 av = *(const uint2*)(ap + k0);
            const float4 bv = *(const float4*)(ti.B + (size_t)((k0 + bk) & ti.kmask) * ti.ldb + bc);
            __syncthreads();
            As[(ak + 0) * 132 + ar] = bflo(av.x); As[(ak + 1) * 132 + ar] = bfhi(av.x);
            As[(ak + 2) * 132 + ar] = bflo(av.y); As[(ak + 3) * 132 + ar] = bfhi(av.y);
            *(float4*)(Bs + bk * 132 + bc) = bv;
            __syncthreads();
#pragma unroll
            for (int k = 0; k < 16; ++k) {
                const float4 a = *(const float4*)(As + k * 132 + ty * 4);
                const float4 b0 = *(const float4*)(Bs + k * 132 + tx * 8), b1 = *(const float4*)(Bs + k * 132 + tx * 8 + 4);
                const float av4[4] = {a.x, a.y, a.z, a.w};
                const float bv8[8] = {b0.x, b0.y, b0.z, b0.w, b1.x, b1.y, b1.z, b1.w};
#pragma unroll
                for (int r = 0; r < 4; ++r)
#pragma unroll
                    for (int j = 0; j < 8; ++j) acc[r][j] += av4[r] * bv8[j];
            }
        }
#pragma unroll
        for (int r = 0; r < 4; ++r) ep.store8(ti.row0 + ty * 4 + r, ti.col0 + tx * 8, acc[r], ti.aux);
    }
}

struct EpiInProj {
    float* GQKV; bf16* ZS; float* RKV; float* LIN; bf16* GATES;
    __device__ __forceinline__ void store8(int row, int col, const float (&v)[8], int) const {
        if (col < 3072) { float* p = GQKV + (size_t)row * 3072 + col; *(float4*)p = make_float4(v[0], v[1], v[2], v[3]); *(float4*)(p + 4) = make_float4(v[4], v[5], v[6], v[7]); }
        else if (col < 4096) { uint4 w; w.x = pk2(v[0] * sigm(v[0]), v[1] * sigm(v[1])); w.y = pk2(v[2] * sigm(v[2]), v[3] * sigm(v[3])); w.z = pk2(v[4] * sigm(v[4]), v[5] * sigm(v[5])); w.w = pk2(v[6] * sigm(v[6]), v[7] * sigm(v[7]));
            *(uint4*)(ZS + (size_t)row * 1024 + (col - 3072)) = w; }
        else if (col < 7168) { float* p = RKV + (size_t)row * 3072 + (col - 4096); *(float4*)p = make_float4(v[0], v[1], v[2], v[3]); *(float4*)(p + 4) = make_float4(v[4], v[5], v[6], v[7]); }
        else if (col < 7424) { float* p = LIN + (size_t)row * 256 + (col - 7168); *(float4*)p = make_float4(v[0], v[1], v[2], v[3]); *(float4*)(p + 4) = make_float4(v[4], v[5], v[6], v[7]); }
        else { uint4 w; w.x = pk2(sigm(v[0]), sigm(v[1])); w.y = pk2(sigm(v[2]), sigm(v[3])); w.z = pk2(sigm(v[4]), sigm(v[5])); w.w = pk2(sigm(v[6]), sigm(v[7]));
            *(uint4*)(GATES + (size_t)row * 2048 + (col - 7424)) = w; }
    }
};
struct EpiG2 {
    const bf16* GATES; bf16* G2;
    __device__ __forceinline__ void store8(int row, int col, const float (&v)[8], int) const {
        const uint4 g = *(const uint4*)(GATES + (size_t)row * 2048 + col);
        uint4 w; w.x = pk2(v[0] * bflo(g.x), v[1] * bfhi(g.x)); w.y = pk2(v[2] * bflo(g.y), v[3] * bfhi(g.y)); w.z = pk2(v[4] * bflo(g.z), v[5] * bfhi(g.z)); w.w = pk2(v[6] * bflo(g.w), v[7] * bfhi(g.w));
        *(uint4*)(G2 + (size_t)row * 2048 + col) = w;
    }
};
struct EpiX1 {
    const float* X; float* X1;
    __device__ __forceinline__ void store8(int row, int col, const float (&v)[8], int) const {
        const float* xp = X + (size_t)row * 1024 + col; float* op = X1 + (size_t)row * 1024 + col;
        const float4 a = *(const float4*)xp, b = *(const float4*)(xp + 4);
        *(float4*)op = make_float4(a.x + v[0], a.y + v[1], a.z + v[2], a.w + v[3]); *(float4*)(op + 4) = make_float4(b.x + v[4], b.y + v[5], b.z + v[6], b.w + v[7]);
    }
};
struct EpiAct {
    const float* BGU; bf16* ACT;
    __device__ __forceinline__ void store8(int row, int col, const float (&v)[8], int e) const {
        const float* bp = BGU + (size_t)e * 2048 + col;
        const float4 b0 = *(const float4*)bp, b1 = *(const float4*)(bp + 4);
        const float bb[8] = {b0.x, b0.y, b0.z, b0.w, b1.x, b1.y, b1.z, b1.w};
        float o[4];
#pragma unroll
        for (int p = 0; p < 4; ++p) { float glu = v[2 * p] + bb[2 * p], lin = v[2 * p + 1] + bb[2 * p + 1]; glu = fminf(glu, 7.f); lin = fminf(fmaxf(lin, -7.f), 7.f); o[p] = glu * sigm(1.702f * glu) * (lin + 1.f); }
        uint2 w; w.x = pk2(o[0], o[1]); w.y = pk2(o[2], o[3]);
        *(uint2*)(ACT + (size_t)row * 1024 + (col >> 1)) = w;
    }
};
struct EpiYS {
    const float* BD; const float* SGATE; bf16* YS;
    __device__ __forceinline__ void store8(int row, int col, const float (&v)[8], int e) const {
        const float* bp = BD + (size_t)e * 1024 + col; const float g = SGATE[row];
        const float4 b0 = *(const float4*)bp, b1 = *(const float4*)(bp + 4);
        uint4 w; w.x = pk2((v[0] + b0.x) * g, (v[1] + b0.y) * g); w.y = pk2((v[2] + b0.z) * g, (v[3] + b0.w) * g); w.z = pk2((v[4] + b1.x) * g, (v[5] + b1.y) * g); w.w = pk2((v[6] + b1.z) * g, (v[7] + b1.w) * g);
        *(uint4*)(YS + (size_t)row * 1024 + col) = w;
    }
};

struct TfInProj { const bf16* HB; const float* W;
    __device__ __forceinline__ void operator()(int tile, TileInfo& ti) const { const int tm = tile / 74, tn = tile % 74; ti.A = HB + (size_t)tm * 128 * 1024; ti.lda = 1024; ti.col0 = tn * 128; ti.row0 = tm * 128;
        ti.B = W + ti.col0 + (ti.col0 >= 4096 ? 16 : 0); ti.ldb = NCOL_IN; ti.kmask = 0x7fffffff; ti.aux = 0; } };
struct TfG2 { const bf16* YA; const bf16* YB; const float* PA; const float* PB;
    __device__ __forceinline__ void operator()(int tile, TileInfo& ti) const { const int tm = tile / 16, tn = tile % 16; ti.A = (tn < 8 ? YA : YB) + (size_t)tm * 128 * 1024; ti.lda = 1024; ti.col0 = tn * 128; ti.row0 = tm * 128;
        ti.B = (tn < 8 ? PA + tn * 128 : PB + (tn - 8) * 128); ti.ldb = 1024; ti.kmask = 0x7fffffff; ti.aux = 0; } };
struct TfX1 { const bf16* G2; const float* WO;
    __device__ __forceinline__ void operator()(int tile, TileInfo& ti) const { const int tm = tile / 8, tn = tile % 8; ti.A = G2 + (size_t)tm * 128 * 2048; ti.lda = 2048; ti.col0 = tn * 128; ti.row0 = tm * 128;
        ti.B = WO + tn * 128; ti.ldb = 1024; ti.kmask = 1023; ti.aux = 0; } };
struct TfMoe { const bf16* A; const float* W; const int* TILE_E; int ntn; int ldb; size_t wstride;
    __device__ __forceinline__ void operator()(int tile, TileInfo& ti) const { const int mt = tile / ntn, tn = tile % ntn; const int e = TILE_E[mt >> 1]; ti.A = A + (size_t)mt * 128 * 1024; ti.lda = 1024; ti.col0 = tn * 128; ti.row0 = mt * 128;
        ti.B = W + (size_t)e * wstride + tn * 128; ti.ldb = ldb; ti.kmask = 0x7fffffff; ti.aux = e; } };


namespace pg8 {
typedef short bf16x8 __attribute__((ext_vector_type(8)));
typedef float f32x4 __attribute__((ext_vector_type(4)));
constexpr int BM = 256, BK = 64, HALF = 128, HTB = HALF * BK * 2, NXCD = 8, WGM = 8;
__host__ __device__ __forceinline__ int lds_byte(int r, int c) { const int st = (r >> 4) * 2 + (c >> 5), rr = r & 15, cc = c & 31, ob = rr * 64 + cc * 2; return st * 1024 + (ob ^ (((ob >> 9) & 1) << 5)); }
__host__ __device__ __forceinline__ void stage_rc(int b, int& R, int& C) { const int st = b / 1024, sb = b % 1024, swz = sb ^ (((sb >> 9) & 1) << 5); R = (st >> 1) * 16 + swz / 64; C = (st & 1) * 32 + (swz % 64) / 2; }
__host__ __device__ __forceinline__ int perm32(int rho) { const int n = rho >> 4, i = rho & 15; return 8 * (i >> 2) + 4 * n + (i & 3); }
struct Unit { const char* a; const char* b; int row0, col0, aux; };
__device__ __forceinline__ void tile_order(int L, int nM, int nN, int& pm, int& pn) {
    const int nwg = nM * nN; int wgid = L; { const int q = nwg / NXCD, r = nwg % NXCD, xcd = wgid % NXCD, off = wgid / NXCD; wgid = (xcd < r ? xcd * (q + 1) : r * (q + 1) + (xcd - r) * q) + off; }
    const int nig = WGM * nN, gid = wgid / nig, fm = gid * WGM, gsz = (nM - fm) < WGM ? (nM - fm) : WGM;
    pm = fm + ((wgid % nig) % gsz); pn = (wgid % nig) / gsz;
}
template <class Epi>
__device__ __forceinline__ void epi_apply(const Epi& E, const f32x4 (&acc)[2][2][4][2], const Unit& u, int wr, int wc, int fr, int fq) {
#pragma unroll
    for (int ai = 0; ai < 2; ++ai)
#pragma unroll
        for (int m = 0; m < 4; ++m)
#pragma unroll
            for (int bj = 0; bj < 2; ++bj) {
                const f32x4 x0 = acc[ai][bj][m][0], x1 = acc[ai][bj][m][1];
                const float v[8] = {x0[0], x0[1], x0[2], x0[3], x1[0], x1[1], x1[2], x1[3]};
                E.store8(u.row0 + ai * HALF + wr * 64 + m * 16 + fr, u.col0 + bj * HALF + wc * 32 + 8 * fq, v, u.aux);
            }
}
template <class Epi, class Sched>
__device__ __forceinline__ void gemm_phase(LAS unsigned char* lds, const int K, const Sched& S, const Epi& E) {
    const int tid = threadIdx.x, wid = __builtin_amdgcn_readfirstlane(tid >> 6), lane = tid & 63, wr = wid >> 2, wc = wid & 3, fr = lane & 15, fq = lane >> 4;
    const int nt = K / BK;
    unsigned voffA[2], voffB[2];
#pragma unroll
    for (int i = 0; i < 2; ++i) { int R, C; stage_rc(tid * 16 + i * 8192, R, C); const int Rb = (R & ~31) + perm32(R & 31);
        voffA[i] = (unsigned)(R * K + C) * 2u; voffB[i] = (unsigned)(Rb * K + C) * 2u; }
    const size_t kstep = (size_t)(BK * 2);
    const size_t hstep = (size_t)HALF * K * 2;
    const unsigned ldsw = (unsigned)wid * 1024u;
    const int aoff = lds_byte(wr * 64 + fr, fq * 8), boff = lds_byte(wc * 32 + fr, fq * 8);
#define PG8_SA(b, h) (((b) * 2 + (h)) * HTB)
#define PG8_SB(b, h) ((4 + (b) * 2 + (h)) * HTB)
#define PG8_STAGE(bufoff, gbase, voff) do { _Pragma("unroll") for (int _i = 0; _i < 2; ++_i) \
        __builtin_amdgcn_global_load_lds((const unsigned*)((const char*)(gbase) + (voff)[_i]), (LAS unsigned*)(lds + (bufoff) + ldsw + _i * 8192), 16, 0, 0); } while (0)
#define PG8_LDA(dst, b, h) do { _Pragma("unroll") for (int m = 0; m < 4; ++m) _Pragma("unroll") for (int k = 0; k < 2; ++k) dst[m][k] = *(const LAS bf16x8*)(lds + PG8_SA(b, h) + aoff + m * 2048 + k * 1024); } while (0)
#define PG8_LDB(dst, b, h) do { _Pragma("unroll") for (int n = 0; n < 2; ++n) _Pragma("unroll") for (int k = 0; k < 2; ++k) dst[n][k] = *(const LAS bf16x8*)(lds + PG8_SB(b, h) + boff + n * 2048 + k * 1024); } while (0)
#define PG8_MMA(ai, bj, At, Bt) do { __builtin_amdgcn_s_setprio(1); _Pragma("unroll") for (int m = 0; m < 4; ++m) _Pragma("unroll") for (int n = 0; n < 2; ++n) _Pragma("unroll") for (int k = 0; k < 2; ++k) \
        acc[ai][bj][m][n] = __builtin_amdgcn_mfma_f32_16x16x32_bf16(Bt[n][k], At[m][k], acc[ai][bj][m][n], 0, 0, 0); __builtin_amdgcn_s_setprio(0); } while (0)
#define PG8_WAIT_V(n) asm volatile("s_waitcnt vmcnt(" #n ")" ::: "memory")
#define PG8_WAIT_L(n) asm volatile("s_waitcnt lgkmcnt(" #n ")" ::: "memory")
#define PG8_BAR __builtin_amdgcn_s_barrier()
#define PG8_SCHED __builtin_amdgcn_sched_barrier(0)
    Unit cur, nxt; int ui = 0;
    if (!S.next(0, cur)) return;
    f32x4 acc[2][2][4][2];
#pragma unroll
    for (int a = 0; a < 2; ++a)
#pragma unroll
        for (int b = 0; b < 2; ++b)
#pragma unroll
            for (int m = 0; m < 4; ++m)
#pragma unroll
                for (int n = 0; n < 2; ++n) acc[a][b][m][n] = (f32x4){0.f, 0.f, 0.f, 0.f};
    bf16x8 At[4][2], B0[2][2], B1[2][2];
    const char* cA = cur.a; const char* cB = cur.b;
    PG8_STAGE(PG8_SB(0, 0), cB, voffB); PG8_STAGE(PG8_SA(0, 0), cA, voffA); PG8_STAGE(PG8_SB(0, 1), cB + hstep, voffB); PG8_STAGE(PG8_SA(0, 1), cA + hstep, voffA);
    if (wr == 1) PG8_BAR;
    PG8_WAIT_V(4); PG8_BAR;
    PG8_STAGE(PG8_SB(1, 0), cB + kstep, voffB); PG8_STAGE(PG8_SA(1, 0), cA + kstep, voffA); PG8_STAGE(PG8_SB(1, 1), cB + hstep + kstep, voffB);
    PG8_WAIT_V(6); PG8_BAR;
    for (;;) {
        const bool has_next = S.next(ui + 1, nxt);
        const char* nA = has_next ? nxt.a : cA; const char* nB = has_next ? nxt.b : cB;
        for (int t = 0; t < nt; t += 2) {
            const bool last = (t == nt - 2);
            const char* a1 = cA + (size_t)(t + 1) * kstep;
            const char* a2 = last ? nA : cA + (size_t)(t + 2) * kstep; const char* b2 = last ? nB : cB + (size_t)(t + 2) * kstep;
            const char* a3 = a2 + kstep; const char* b3 = b2 + kstep;
            PG8_LDB(B0, 0, 0); PG8_SCHED; PG8_LDA(At, 0, 0); PG8_STAGE(PG8_SA(1, 1), a1 + hstep, voffA);
            PG8_WAIT_L(8); PG8_BAR; PG8_WAIT_L(0); PG8_MMA(0, 0, At, B0); PG8_BAR; PG8_SCHED;
            PG8_LDB(B1, 0, 1); PG8_STAGE(PG8_SB(0, 0), b2, voffB);
            PG8_BAR; PG8_WAIT_L(0); PG8_MMA(0, 1, At, B1); PG8_BAR;
            PG8_LDA(At, 0, 1); PG8_STAGE(PG8_SA(0, 0), a2, voffA);
            PG8_BAR; PG8_WAIT_L(0); PG8_MMA(1, 0, At, B0); PG8_BAR; PG8_SCHED;
            PG8_STAGE(PG8_SB(0, 1), b2 + hstep, voffB);
            PG8_WAIT_V(6); PG8_BAR; PG8_MMA(1, 1, At, B1); PG8_BAR;
            PG8_LDB(B0, 1, 0); PG8_SCHED; PG8_LDA(At, 1, 0); PG8_STAGE(PG8_SA(0, 1), a2 + hstep, voffA);
            PG8_WAIT_L(8); PG8_BAR; PG8_WAIT_L(0); PG8_MMA(0, 0, At, B0); PG8_BAR; PG8_SCHED;
            PG8_LDB(B1, 1, 1); PG8_STAGE(PG8_SB(1, 0), b3, voffB);
            PG8_BAR; PG8_WAIT_L(0); PG8_MMA(0, 1, At, B1); PG8_BAR;
            PG8_LDA(At, 1, 1); PG8_STAGE(PG8_SA(1, 0), a3, voffA);
            PG8_BAR; PG8_WAIT_L(0); PG8_MMA(1, 0, At, B0); PG8_BAR; PG8_SCHED;
            PG8_STAGE(PG8_SB(1, 1), b3 + hstep, voffB);
            PG8_WAIT_V(6); PG8_BAR; PG8_MMA(1, 1, At, B1); PG8_BAR;
        }
        epi_apply(E, acc, cur, wr, wc, fr, fq);
        if (!has_next) break;
#pragma unroll
        for (int a = 0; a < 2; ++a)
#pragma unroll
            for (int b = 0; b < 2; ++b)
#pragma unroll
                for (int m = 0; m < 4; ++m)
#pragma unroll
                    for (int n = 0; n < 2; ++n) acc[a][b][m][n] = (f32x4){0.f, 0.f, 0.f, 0.f};
        cur = nxt; cA = nA; cB = nB; ++ui;
    }
    PG8_WAIT_V(0);
    if (wr == 0) PG8_BAR;
    PG8_BAR;
#undef PG8_SA
#undef PG8_SB
#undef PG8_STAGE
#undef PG8_LDA
#undef PG8_LDB
#undef PG8_MMA
#undef PG8_WAIT_V
#undef PG8_WAIT_L
#undef PG8_BAR
#undef PG8_SCHED
}
}

struct SchedInProj { const char* A; const char* Bt; int G, c;
    __device__ __forceinline__ bool next(int i, pg8::Unit& u) const { const int L = i * G + c; if (L >= 64 * 37) return false; int pm, pn; pg8::tile_order(L, 64, 37, pm, pn);
        u.a = A + (size_t)pm * (256 * 1024 * 2); u.b = Bt + (size_t)pn * (256 * 1024 * 2); u.row0 = pm * 256; u.col0 = pn * 256; u.aux = 0; return true; } };

struct WJob { const float* src; int ld_src; int K; int ncols; bf16* dst; int ld_dst; int nb; size_t sstride, dstride; };
__device__ __forceinline__ void wconv_job(const Ctx& c, const WJob& j) {
    float* tl = (float*)c.lds;
    const int ntk = j.K >> 6, ntn = j.ncols >> 6, per = ntk * ntn, ntiles = per * j.nb;
    const int rk = c.tid >> 3, rseg = (c.tid & 7) * 8;
    for (int tile = blockIdx.x; tile < ntiles; tile += gridDim.x) {
        const int bi = tile / per, tt = tile % per, tk = tt % ntk, tn = tt / ntk;
        const float* sp = j.src + (size_t)bi * j.sstride + (size_t)(tk * 64 + rk) * j.ld_src + tn * 64 + rseg;
        const float4 a = *(const float4*)sp, b = *(const float4*)(sp + 4);
        __syncthreads();
        float* row = tl + rk * 65 + rseg;
        row[0] = a.x; row[1] = a.y; row[2] = a.z; row[3] = a.w; row[4] = b.x; row[5] = b.y; row[6] = b.z; row[7] = b.w;
        __syncthreads();
        const float* col = tl + rseg * 65 + rk;
        uint4 w; w.x = pk2(col[0], col[65]); w.y = pk2(col[130], col[195]); w.z = pk2(col[260], col[325]); w.w = pk2(col[390], col[455]);
        *(uint4*)(j.dst + (size_t)bi * j.dstride + (size_t)(tn * 64 + rk) * j.ld_dst + tk * 64 + rseg) = w;
    }
}
struct SchedG2 { const char* YA; const char* YB; const char* Bt; int G, c;
    __device__ __forceinline__ bool next(int i, pg8::Unit& u) const { const int L = i * G + c; if (L >= 64 * 8) return false; int pm, pn; pg8::tile_order(L, 64, 8, pm, pn);
        u.a = (pn < 4 ? YA : YB) + (size_t)pm * (256 * 1024 * 2); u.b = Bt + (size_t)pn * (256 * 1024 * 2); u.row0 = pm * 256; u.col0 = pn * 256; u.aux = 0; return true; } };
struct SchedX1 { const char* A; const char* Bt; int G, c;
    __device__ __forceinline__ bool next(int i, pg8::Unit& u) const { const int L = i * G + c; if (L >= 64 * 4) return false; int pm, pn; pg8::tile_order(L, 64, 4, pm, pn);
        u.a = A + (size_t)pm * (256 * 2048 * 2); u.b = Bt + (size_t)pn * (256 * 2048 * 2); u.row0 = pm * 256; u.col0 = pn * 256; u.aux = 0; return true; } };
struct SchedMoe { const char* A; const char* Bt; const int* TILE_E; int NT, NPN, G, c;
    __device__ __forceinline__ bool next(int i, pg8::Unit& u) const { const int L = i * G + c; if (L >= NT * NPN) return false; const int tile = L / NPN, pn = L % NPN; const int e = TILE_E[tile];
        u.a = A + (size_t)tile * (256 * 1024 * 2); u.b = Bt + (size_t)(e * NPN + pn) * (256 * 1024 * 2); u.row0 = tile * 256; u.col0 = pn * 256; u.aux = e; return true; } };

__device__ void ph_gconv(const Ctx& c) {
    const float* GQKV = c.ws<float>(WS_GQKV); float* QKVC = c.ws<float>(WS_QKVC); const float* cw = c.P.in[I_GDN_CONV];
    for (size_t idx = c.gtid; idx < (size_t)T * 768; idx += c.nthreads) {
        const int t = (int)(idx / 768), c4 = (int)(idx % 768) * 4, s = t & (SEQ - 1);
        float4 a = make_float4(0.f, 0.f, 0.f, 0.f);
#pragma unroll
        for (int j = 0; j < 4; ++j) {
            if (s - 3 + j >= 0) { const float4 xv = *(const float4*)(GQKV + (size_t)(t - 3 + j) * 3072 + c4); const float4 w = *(const float4*)(cw + j * 3072 + c4);
                a.x += w.x * xv.x; a.y += w.y * xv.y; a.z += w.z * xv.z; a.w += w.w * xv.w; }
        }
        a.x *= sigm(a.x); a.y *= sigm(a.y); a.z *= sigm(a.z); a.w *= sigm(a.w);
        *(float4*)(QKVC + (size_t)t * 3072 + c4) = a;
    }
}
__device__ void ph_gl2(const Ctx& c) {
    float* QKVC = c.ws<float>(WS_QKVC);
    for (int it = c.gwave; it < T * 16; it += c.nwaves) {
        const int t = it >> 4, vec = it & 15;
        float2* p = (float2*)(QKVC + (size_t)t * 3072 + vec * 128) + c.lane;
        float2 v = *p; const float ss = wsum(v.x * v.x + v.y * v.y);
        const float sc = rsqrtf(ss + 1e-6f) * (vec < 8 ? 0.08838834764831845f : 1.f);
        v.x *= sc; v.y *= sc; *p = v;
    }
}
__device__ void ph_gscan(const Ctx& c) {
    if (c.wave >= 4 || blockIdx.x >= 64) return;
    const float* QKVC = c.ws<float>(WS_QKVC); const float* BETA = c.ws<float>(WS_BETA); const float* GGv = c.ws<float>(WS_GG); float* OG = c.ws<float>(WS_OG);
    const int w = blockIdx.x * 4 + c.wave, pair = w >> 3, b = pair >> 3, h = pair & 7, i = (w & 7) * 16 + (c.lane >> 2), qt = c.lane & 3;
    float s[32];
#pragma unroll
    for (int k = 0; k < 32; ++k) s[k] = 0.f;
    for (int t = 0; t < SEQ; ++t) {
        const size_t tok = (size_t)b * SEQ + t;
        const float* qp = QKVC + tok * 3072 + h * 128 + qt * 32; const float* kp = qp + 1024; const float* vp = QKVC + tok * 3072 + 2048 + h * 128;
        const float eg = expf(GGv[tok * 8 + h]), beta = BETA[tok * 8 + h];
        float kv[32];
#pragma unroll
        for (int q = 0; q < 8; ++q) { const float4 x = *(const float4*)(kp + q * 4); kv[4 * q] = x.x; kv[4 * q + 1] = x.y; kv[4 * q + 2] = x.z; kv[4 * q + 3] = x.w; }
        float d = 0.f;
#pragma unroll
        for (int k = 0; k < 32; ++k) { s[k] *= eg; d += s[k] * kv[k]; }
        d += __shfl_xor(d, 1); d += __shfl_xor(d, 2);
        const float vn = beta * (vp[i] - d);
        float o = 0.f;
#pragma unroll
        for (int q = 0; q < 8; ++q) { const float4 y = *(const float4*)(qp + q * 4);
            s[4 * q] += vn * kv[4 * q]; o += s[4 * q] * y.x; s[4 * q + 1] += vn * kv[4 * q + 1]; o += s[4 * q + 1] * y.y;
            s[4 * q + 2] += vn * kv[4 * q + 2]; o += s[4 * q + 2] * y.z; s[4 * q + 3] += vn * kv[4 * q + 3]; o += s[4 * q + 3] * y.w; }
        o += __shfl_xor(o, 1); o += __shfl_xor(o, 2);
        if (qt == 0) OG[tok * 1024 + h * 128 + i] = o;
    }
}

__device__ void ph_loraprep(const Ctx& c) {
    const float* LIN = c.ws<float>(WS_LIN); bf16* AL = c.ws<bf16>(WS_ALORA); const float* mu = c.P.in[I_MU];
    for (size_t idx = c.gtid; idx < (size_t)T * 256; idx += c.nthreads) {
        const int t = (int)(idx >> 8), cc = (int)(idx & 255);
        const float x = LIN[idx], xp = (t & (SEQ - 1)) ? LIN[idx - 256] : 0.f;
        const float xs = x + (xp - x) * mu[3072 + cc];
        const float r = cc < 64 ? tanhf(xs) : (cc < 128 ? xs : sigm(xs));
        AL[idx] = f2bf(r);
    }
}
__device__ void ph_lora_naive(const Ctx& c) {
    const bf16* AL = c.ws<bf16>(WS_ALORA); float* LW = c.ws<float>(WS_LW); float* AA = c.ws<float>(WS_AA); bf16* GGR = c.ws<bf16>(WS_GGR);
    const float* w0 = c.P.in[I_W0]; const float* w2 = c.P.in[I_W2]; const float* a0 = c.P.in[I_A0]; const float* a2 = c.P.in[I_A2]; const float* g2 = c.P.in[I_G2];
    for (size_t idx = c.gtid; idx < (size_t)T * 1024; idx += c.nthreads) {
        const int t = (int)(idx >> 10), cc = (int)(idx & 1023);
        const bf16* al = AL + (size_t)t * 256;
        float d1 = 0.f, d2 = 0.f, d3 = 0.f;
        for (int j = 0; j < 64; ++j) { d1 += bf2f(al[j]) * w2[j * 1024 + cc]; d2 += bf2f(al[64 + j]) * a2[j * 1024 + cc]; }
        for (int j = 0; j < 128; ++j) d3 += bf2f(al[128 + j]) * g2[j * 1024 + cc];
        const float wlog = -softplusf(-(w0[cc] + d1)) - 0.5f;
        LW[idx] = -expf(wlog);
        AA[idx] = sigm(a0[cc] + d2);
        GGR[idx] = f2bf(d3);
    }
}
__device__ void ph_rprep(const Ctx& c) {
    const float* RKV = c.ws<float>(WS_RKV); const float* AA = c.ws<float>(WS_AA); const float* LW = c.ws<float>(WS_LW);
    float* RP = c.ws<float>(WS_RP); float* KF = c.ws<float>(WS_KF); float* KKN = c.ws<float>(WS_KKN); float* DEC = c.ws<float>(WS_DEC); bf16* VP = c.ws<bf16>(WS_VP); float* SC = c.ws<float>(WS_SC);
    const float* mu = c.P.in[I_MU]; const float* k_k = c.P.in[I_KK]; const float* k_a = c.P.in[I_KA]; const float* r_k = c.P.in[I_RK];
    for (int it = c.gwave; it < T * 16; it += c.nwaves) {
        const int t = it >> 4, h = it & 15, cc = h * 64 + c.lane;
        const bool first = (t & (SEQ - 1)) == 0;
        const float* cur = RKV + (size_t)t * 3072; const float* prv = cur - 3072;
        const float r0 = cur[cc], k0 = cur[1024 + cc], v0 = cur[2048 + cc];
        const float rp = first ? 0.f : prv[cc], kp = first ? 0.f : prv[1024 + cc], vp = first ? 0.f : prv[2048 + cc];
        const float r = r0 + (rp - r0) * mu[cc], k = k0 + (kp - k0) * mu[1024 + cc], v = v0 + (vp - v0) * mu[2048 + cc];
        const float kkv = k * k_k[cc];
        const float ss = wsum(kkv * kkv);
        const float kk = kkv * rsqrtf(ss + 1e-6f);
        const float aa = AA[(size_t)t * 1024 + cc];
        const float kf = k * (1.f + (aa - 1.f) * k_a[cc]);
        const float sc = wsum(r * kf * r_k[cc]);
        const size_t o = (size_t)t * 1024 + cc;
        RP[o] = r; KF[o] = kf; KKN[o] = kk; DEC[o] = expf(LW[o]); VP[o] = f2bf(v);
        if (c.lane == 0) SC[t * 16 + h] = sc;
    }
}
__device__ void ph_rscan(const Ctx& c) {
    if (c.wave != 0 || blockIdx.x >= 64) return;
    const float* RP = c.ws<float>(WS_RP); const float* KF = c.ws<float>(WS_KF); const float* KKN = c.ws<float>(WS_KKN); const float* DEC = c.ws<float>(WS_DEC); const float* AA = c.ws<float>(WS_AA);
    const bf16* VP = c.ws<bf16>(WS_VP); float* ORW = c.ws<float>(WS_ORW);
    const int b = blockIdx.x >> 4, h = blockIdx.x & 15, i = c.lane;
    float s[64];
#pragma unroll
    for (int k = 0; k < 64; ++k) s[k] = 0.f;
    for (int t = 0; t < SEQ; ++t) {
        const size_t o = ((size_t)b * SEQ + t) * 1024 + h * 64;
        const float* rp = RP + o; const float* kf = KF + o; const float* kk = KKN + o; const float* dc = DEC + o; const float* aa = AA + o;
        float sk = 0.f;
#pragma unroll
        for (int ch = 0; ch < 4; ++ch) {
            float kv[16];
#pragma unroll
            for (int q = 0; q < 4; ++q) { const float4 x = *(const float4*)(kk + ch * 16 + q * 4); kv[4 * q] = x.x; kv[4 * q + 1] = x.y; kv[4 * q + 2] = x.z; kv[4 * q + 3] = x.w; }
#pragma unroll
            for (int k = 0; k < 16; ++k) sk += s[ch * 16 + k] * kv[k];
            asm volatile("" ::: "memory");
        }
        const float vi = bf2f(VP[o + i]);
        float out = 0.f;
#pragma unroll
        for (int ch = 0; ch < 16; ++ch) {
            const float4 k4 = *(const float4*)(kk + ch * 4), d4 = *(const float4*)(dc + ch * 4), a4 = *(const float4*)(aa + ch * 4), f4 = *(const float4*)(kf + ch * 4), r4 = *(const float4*)(rp + ch * 4);
            s[ch * 4 + 0] = s[ch * 4 + 0] * d4.x - sk * (k4.x * a4.x) + vi * f4.x; out += s[ch * 4 + 0] * r4.x;
            s[ch * 4 + 1] = s[ch * 4 + 1] * d4.y - sk * (k4.y * a4.y) + vi * f4.y; out += s[ch * 4 + 1] * r4.y;
            s[ch * 4 + 2] = s[ch * 4 + 2] * d4.z - sk * (k4.z * a4.z) + vi * f4.z; out += s[ch * 4 + 2] * r4.z;
            s[ch * 4 + 3] = s[ch * 4 + 3] * d4.w - sk * (k4.w * a4.w) + vi * f4.w; out += s[ch * 4 + 3] * r4.w;
            if ((ch & 1) == 1) asm volatile("" ::: "memory");
        }
        ORW[o + i] = out;
    }
}

__device__ void ph_post(const Ctx& c) {
    const float* OG = c.ws<float>(WS_OG); const float* ORW = c.ws<float>(WS_ORW); const bf16* ZS = c.ws<bf16>(WS_ZS); const bf16* VP = c.ws<bf16>(WS_VP); const bf16* GGR = c.ws<bf16>(WS_GGR);
    const float* SC = c.ws<float>(WS_SC); bf16* YA = c.ws<bf16>(WS_YA); bf16* YB = c.ws<bf16>(WS_YB);
    const float* gnw = c.P.in[I_GDN_NORM]; const float* lnw = c.P.in[I_LNW]; const float* lnb = c.P.in[I_LNB];
    const int lane = c.lane, c0 = lane * 16;
    for (int t = c.gwave; t < T; t += c.nwaves) {
        {
            float o[16];
#pragma unroll
            for (int q = 0; q < 4; ++q) { const float4 v = *(const float4*)(OG + (size_t)t * 1024 + c0 + 4 * q); o[4 * q] = v.x; o[4 * q + 1] = v.y; o[4 * q + 2] = v.z; o[4 * q + 3] = v.w; }
            float ss = 0.f;
#pragma unroll
            for (int j = 0; j < 16; ++j) ss += o[j] * o[j];
            ss += __shfl_xor(ss, 1); ss += __shfl_xor(ss, 2); ss += __shfl_xor(ss, 4);
            const float rstd = rsqrtf(ss * (1.f / 128.f) + 1e-6f);
            const uint4 z0 = *(const uint4*)(ZS + (size_t)t * 1024 + c0), z1 = *(const uint4*)(ZS + (size_t)t * 1024 + c0 + 8);
            const unsigned zz[8] = {z0.x, z0.y, z0.z, z0.w, z1.x, z1.y, z1.z, z1.w};
            unsigned w[8];
#pragma unroll
            for (int j = 0; j < 8; ++j) { const int cc = (c0 + 2 * j) & 127; w[j] = pk2(o[2 * j] * rstd * gnw[cc] * bflo(zz[j]), o[2 * j + 1] * rstd * gnw[cc + 1] * bfhi(zz[j])); }
            *(uint4*)(YA + (size_t)t * 1024 + c0) = make_uint4(w[0], w[1], w[2], w[3]); *(uint4*)(YA + (size_t)t * 1024 + c0 + 8) = make_uint4(w[4], w[5], w[6], w[7]);
        }
        {
            float o[16];
#pragma unroll
            for (int q = 0; q < 4; ++q) { const float4 v = *(const float4*)(ORW + (size_t)t * 1024 + c0 + 4 * q); o[4 * q] = v.x; o[4 * q + 1] = v.y; o[4 * q + 2] = v.z; o[4 * q + 3] = v.w; }
            float sm = 0.f;
#pragma unroll
            for (int j = 0; j < 16; ++j) sm += o[j];
            sm += __shfl_xor(sm, 1); sm += __shfl_xor(sm, 2);
            const float mean = sm * (1.f / 64.f);
            float sv = 0.f;
#pragma unroll
            for (int j = 0; j < 16; ++j) { const float dd = o[j] - mean; sv += dd * dd; }
            sv += __shfl_xor(sv, 1); sv += __shfl_xor(sv, 2);
            const float rstd = rsqrtf(sv * (1.f / 64.f) + 64e-5f);
            const float sc = SC[t * 16 + (c0 >> 6)];
            const uint4 v0 = *(const uint4*)(VP + (size_t)t * 1024 + c0), v1 = *(const uint4*)(VP + (size_t)t * 1024 + c0 + 8);
            const uint4 g0 = *(const uint4*)(GGR + (size_t)t * 1024 + c0), g1 = *(const uint4*)(GGR + (size_t)t * 1024 + c0 + 8);
            const unsigned vv[8] = {v0.x, v0.y, v0.z, v0.w, v1.x, v1.y, v1.z, v1.w};
            const unsigned gg[8] = {g0.x, g0.y, g0.z, g0.w, g1.x, g1.y, g1.z, g1.w};
            unsigned w[8];
#pragma unroll
            for (int j = 0; j < 8; ++j) { const int cc = c0 + 2 * j;
                const float y0 = ((o[2 * j] - mean) * rstd * lnw[cc] + lnb[cc] + sc * bflo(vv[j])) * bflo(gg[j]);
                const float y1 = ((o[2 * j + 1] - mean) * rstd * lnw[cc + 1] + lnb[cc + 1] + sc * bfhi(vv[j])) * bfhi(gg[j]);
                w[j] = pk2(y0, y1); }
            *(uint4*)(YB + (size_t)t * 1024 + c0) = make_uint4(w[0], w[1], w[2], w[3]); *(uint4*)(YB + (size_t)t * 1024 + c0 + 8) = make_uint4(w[4], w[5], w[6], w[7]);
        }
    }
}

__device__ void ph_router(const Ctx& c) {
    const float* X1 = c.ws<float>(WS_X1); const float* nw = c.P.in[I_NORM_FFN]; const float* rw = c.P.in[I_ROUTER_W]; const float* rb = c.P.in[I_ROUTER_B];
    bf16* H2 = c.ws<bf16>(WS_H2); int* TE = c.ws<int>(WS_TE); float* TG = c.ws<float>(WS_TG); int* TP = c.ws<int>(WS_TP); unsigned* CNT = c.ws<unsigned>(WS_CTL) + CW_CNT;
    const int lane = c.lane;
    for (int t = c.gwave; t < T; t += c.nwaves) {
        float4 v[4]; float ss = 0.f;
#pragma unroll
        for (int i = 0; i < 4; ++i) { v[i] = ((const float4*)(X1 + (size_t)t * D))[lane + 64 * i]; ss += v[i].x * v[i].x + v[i].y * v[i].y + v[i].z * v[i].z + v[i].w * v[i].w; }
        ss = wsum(ss);
        const float rstd = rsqrtf(ss * (1.f / 1024.f) + 1e-6f);
        float lg[32];
#pragma unroll
        for (int j = 0; j < 32; ++j) lg[j] = 0.f;
#pragma unroll
        for (int i = 0; i < 4; ++i) {
            const float4 w4 = ((const float4*)nw)[lane + 64 * i];
            const float h[4] = {v[i].x * rstd * w4.x, v[i].y * rstd * w4.y, v[i].z * rstd * w4.z, v[i].w * rstd * w4.w};
            uint2 st; st.x = pk2(h[0], h[1]); st.y = pk2(h[2], h[3]);
            *(uint2*)(H2 + (size_t)t * D + 4 * (lane + 64 * i)) = st;
#pragma unroll
            for (int ii = 0; ii < 4; ++ii) {
                const float4* wr = (const float4*)(rw + (size_t)(4 * (lane + 64 * i) + ii) * 32);
#pragma unroll
                for (int q = 0; q < 8; ++q) { const float4 w = wr[q]; lg[4 * q] += h[ii] * w.x; lg[4 * q + 1] += h[ii] * w.y; lg[4 * q + 2] += h[ii] * w.z; lg[4 * q + 3] += h[ii] * w.w; }
            }
        }
#pragma unroll
        for (int j = 0; j < 32; ++j) lg[j] = wsum(lg[j]) + rb[j];
        int e0 = 0, e1 = 0, e2 = 0, e3 = 0; float v0 = -3e38f, v1 = -3e38f, v2 = -3e38f, v3 = -3e38f;
#pragma unroll
        for (int j = 0; j < 32; ++j) if (lg[j] > v0) { v0 = lg[j]; e0 = j; }
#pragma unroll
        for (int j = 0; j < 32; ++j) if (j != e0 && lg[j] > v1) { v1 = lg[j]; e1 = j; }
#pragma unroll
        for (int j = 0; j < 32; ++j) if (j != e0 && j != e1 && lg[j] > v2) { v2 = lg[j]; e2 = j; }
#pragma unroll
        for (int j = 0; j < 32; ++j) if (j != e0 && j != e1 && j != e2 && lg[j] > v3) { v3 = lg[j]; e3 = j; }
        const float x1 = expf(v1 - v0), x2 = expf(v2 - v0), x3 = expf(v3 - v0), inv = 1.f / (1.f + x1 + x2 + x3);
        if (lane < 4) {
            const int me = lane == 0 ? e0 : (lane == 1 ? e1 : (lane == 2 ? e2 : e3));
            const float mg = (lane == 0 ? 1.f : (lane == 1 ? x1 : (lane == 2 ? x2 : x3))) * inv;
            const unsigned pos = atomicAdd(&CNT[me], 1u);
            TE[t * 4 + lane] = me; TG[t * 4 + lane] = mg; TP[t * 4 + lane] = (int)pos;
        }
    }
}

__device__ void ph_dispatch(const Ctx& c) {
    int* tb = (int*)c.lds;
    const unsigned* CNT = c.ws<unsigned>(WS_CTL) + CW_CNT;
    int* TILE_E = c.ws<int>(WS_TILE_E); int* NT = c.ws<int>(WS_NT);
    const int* TE = c.ws<int>(WS_TE); const float* TG = c.ws<float>(WS_TG); const int* TP = c.ws<int>(WS_TP); int* TSLOT = c.ws<int>(WS_TSLOT);
    float* SGATE = c.ws<float>(WS_SGATE); const bf16* H2 = c.ws<bf16>(WS_H2); bf16* XB = c.ws<bf16>(WS_XB);
    if (c.tid == 0) { int acc = 0; for (int e = 0; e < NEXP; ++e) { const int n = (int)__hip_atomic_load(&CNT[e], __ATOMIC_RELAXED, __HIP_MEMORY_SCOPE_AGENT); tb[e] = acc; tb[64 + e] = n; acc += (n + 255) >> 8; } tb[32] = acc; }
    __syncthreads();
    if (blockIdx.x == 0) {
        for (int tile = c.tid; tile < tb[32]; tile += NTHREADS) { int e = 0; for (int q = 0; q < NEXP; ++q) if (tile >= tb[q]) e = q; TILE_E[tile] = e; }
        if (c.tid == 0) *NT = tb[32];
    }
    for (int idx = c.gwave; idx < T * 4; idx += c.nwaves) {
        const int t = idx >> 2, e = TE[idx], pos = TP[idx];
        const int slot = tb[e] * 256 + pos;
        if (c.lane == 0) { TSLOT[idx] = slot; SGATE[slot] = TG[idx]; }
        const uint4* src = (const uint4*)(H2 + (size_t)t * 1024); uint4* dst = (uint4*)(XB + (size_t)slot * 1024);
        dst[c.lane] = src[c.lane]; dst[c.lane + 64] = src[c.lane + 64];
    }
    for (int e = 0; e < NEXP; ++e) {
        const int n = tb[64 + e], cap = (tb[e + 1] - tb[e]) * 256;
        for (int r = n + c.gwave; r < cap; r += c.nwaves) {
            const int slot = tb[e] * 256 + r;
            uint4* dst = (uint4*)(XB + (size_t)slot * 1024);
            dst[c.lane] = make_uint4(0, 0, 0, 0); dst[c.lane + 64] = make_uint4(0, 0, 0, 0);
            if (c.lane == 0) SGATE[slot] = 0.f;
        }
    }
}

__device__ void ph_combine(const Ctx& c) {
    const float* X1 = c.ws<float>(WS_X1); const bf16* YS = c.ws<bf16>(WS_YS); const int* TSLOT = c.ws<int>(WS_TSLOT); const float* nw = c.P.in[I_NORM_FINAL]; float* out = c.P.out;
    const int lane = c.lane;
    for (int t = c.gwave; t < T; t += c.nwaves) {
        const int s0 = TSLOT[t * 4], s1 = TSLOT[t * 4 + 1], s2 = TSLOT[t * 4 + 2], s3 = TSLOT[t * 4 + 3];
        float4 v[4]; float ss = 0.f;
#pragma unroll
        for (int i = 0; i < 4; ++i) {
            const int col = 4 * (lane + 64 * i);
            v[i] = *(const float4*)(X1 + (size_t)t * D + col);
            const uint2 a = *(const uint2*)(YS + (size_t)s0 * 1024 + col), b = *(const uint2*)(YS + (size_t)s1 * 1024 + col), cc = *(const uint2*)(YS + (size_t)s2 * 1024 + col), d = *(const uint2*)(YS + (size_t)s3 * 1024 + col);
            v[i].x += bflo(a.x) + bflo(b.x) + bflo(cc.x) + bflo(d.x); v[i].y += bfhi(a.x) + bfhi(b.x) + bfhi(cc.x) + bfhi(d.x);
            v[i].z += bflo(a.y) + bflo(b.y) + bflo(cc.y) + bflo(d.y); v[i].w += bfhi(a.y) + bfhi(b.y) + bfhi(cc.y) + bfhi(d.y);
            ss += v[i].x * v[i].x + v[i].y * v[i].y + v[i].z * v[i].z + v[i].w * v[i].w;
        }
        ss = wsum(ss);
        const float rstd = rsqrtf(ss * (1.f / 1024.f) + 1e-6f);
#pragma unroll
        for (int i = 0; i < 4; ++i) { const float4 w4 = ((const float4*)nw)[lane + 64 * i];
            *(float4*)(out + (size_t)t * D + 4 * (lane + 64 * i)) = make_float4(v[i].x * rstd * w4.x, v[i].y * rstd * w4.y, v[i].z * rstd * w4.z, v[i].w * rstd * w4.w); }
    }
}


typedef short bf16x8_t __attribute__((ext_vector_type(8)));
typedef float f32x4_t __attribute__((ext_vector_type(4)));
#define MFMA16(a, b, c) __builtin_amdgcn_mfma_f32_16x16x32_bf16((a), (b), (c), 0, 0, 0)

constexpr int GCL_HALF_BYTES = 71680;
__device__ __forceinline__ void ph_gcl(const Ctx& c) {
    const float* GQKV = c.ws<float>(WS_GQKV); const float* BETA = c.ws<float>(WS_BETA); const float* GGv = c.ws<float>(WS_GG); const float* cw = c.P.in[I_GDN_CONV];
    bf16* GA1 = c.ws<bf16>(WS_GA1); float* GX0 = c.ws<float>(WS_GX0); bf16* GA2 = c.ws<bf16>(WS_GA2); bf16* GA3 = c.ws<bf16>(WS_GA3); bf16* GA4 = c.ws<bf16>(WS_GA4); float* GGL = c.ws<float>(WS_GGL);
    for (int it0 = blockIdx.x * 2; it0 < 2048; it0 += gridDim.x * 2) {
        int tv = c.tid; asm volatile("" : "+v"(tv));
        const int half = tv >> 8, ht = tv & 255, lane = tv & 63, w4 = __builtin_amdgcn_readfirstlane((tv >> 6) & 3);
        unsigned char* base = c.lds + half * GCL_HALF_BYTES;
        bf16* QB = (bf16*)base;
        bf16* KB = QB + 64 * 136;
        bf16* VB = KB + 64 * 136;
        float* MM = (float*)(VB + 64 * 136);
        float* GC = MM + 64 * 64;
        float* BT = GC + 64;
        float* BE = BT + 64;
        const int item = it0 + half, n = item & 63, bh = item >> 6, h = bh & 7, b = bh >> 3;
        const int t0 = b * SEQ + n * 64;
        __syncthreads();
        if (w4 == 0) {
            float g = GGv[(size_t)(t0 + lane) * 8 + h]; const float be = BETA[(size_t)(t0 + lane) * 8 + h];
#pragma unroll
            for (int o = 1; o < 64; o <<= 1) { const float u = __shfl_up(g, o); if (lane >= o) g += u; }
            GC[lane] = g; BT[lane] = be; BE[lane] = be * expf(g);
        }
        __syncthreads();
        {
            const int r = ht >> 2, seg = ht & 3, s = n * 64 + r;
            const float egc = expf(GC[r]);
#pragma unroll
            for (int mat = 0; mat < 3; ++mat) {
                const int col0 = mat * 1024 + h * 128 + seg * 32;
                float acc[32];
#pragma unroll
                for (int i = 0; i < 32; ++i) acc[i] = 0.f;
#pragma unroll
                for (int j = 0; j < 4; ++j) {
                    if (s - 3 + j >= 0) {
                        const float* xp = GQKV + (size_t)(t0 + r - 3 + j) * 3072 + col0; const float* wp = cw + j * 3072 + col0;
#pragma unroll
                        for (int q = 0; q < 8; ++q) { const float4 xv = *(const float4*)(xp + 4 * q); const float4 wv = *(const float4*)(wp + 4 * q);
                            acc[4 * q] += wv.x * xv.x; acc[4 * q + 1] += wv.y * xv.y; acc[4 * q + 2] += wv.z * xv.z; acc[4 * q + 3] += wv.w * xv.w; }
                    }
                    asm volatile("" ::: "memory");
                }
                float ss = 0.f;
#pragma unroll
                for (int i = 0; i < 32; ++i) { acc[i] *= sigm(acc[i]); ss += acc[i] * acc[i]; }
                float sc = 1.f;
                if (mat < 2) { ss += __shfl_xor(ss, 1); ss += __shfl_xor(ss, 2); sc = rsqrtf(ss + 1e-6f) * (mat == 0 ? 0.08838834764831845f : 1.f); }
                bf16* dst = (mat == 0 ? QB : (mat == 1 ? KB : VB)) + r * 136 + seg * 32;
#pragma unroll
                for (int q = 0; q < 4; ++q) { uint4 w; w.x = pk2(acc[8 * q] * sc, acc[8 * q + 1] * sc); w.y = pk2(acc[8 * q + 2] * sc, acc[8 * q + 3] * sc); w.z = pk2(acc[8 * q + 4] * sc, acc[8 * q + 5] * sc); w.w = pk2(acc[8 * q + 6] * sc, acc[8 * q + 7] * sc);
                    *(uint4*)(dst + 8 * q) = w; }
                if (mat == 0) {
                    bf16* gd = GA2 + ((size_t)item * 64 + r) * 128 + seg * 32; const float s2 = sc * egc;
#pragma unroll
                    for (int q = 0; q < 4; ++q) { uint4 w; w.x = pk2(acc[8 * q] * s2, acc[8 * q + 1] * s2); w.y = pk2(acc[8 * q + 2] * s2, acc[8 * q + 3] * s2); w.z = pk2(acc[8 * q + 4] * s2, acc[8 * q + 5] * s2); w.w = pk2(acc[8 * q + 6] * s2, acc[8 * q + 7] * s2);
                        *(uint4*)(gd + 8 * q) = w; }
                }
            }
        }
        __syncthreads();
        {
            const int fr = lane & 15, fq = lane >> 4, a0 = w4 * 16;
            bf16x8_t ka[4];
#pragma unroll
            for (int kb = 0; kb < 4; ++kb) ka[kb] = *(const bf16x8_t*)(KB + (a0 + fr) * 136 + kb * 32 + fq * 8);
#pragma unroll
            for (int bt = 0; bt < 4; ++bt) {
                f32x4_t c1 = {0.f, 0.f, 0.f, 0.f}, c2 = {0.f, 0.f, 0.f, 0.f};
#pragma unroll
                for (int kb = 0; kb < 4; ++kb) {
                    const bf16x8_t kbf = *(const bf16x8_t*)(KB + (bt * 16 + fr) * 136 + kb * 32 + fq * 8);
                    const bf16x8_t qbf = *(const bf16x8_t*)(QB + (bt * 16 + fr) * 136 + kb * 32 + fq * 8);
                    c1 = MFMA16(ka[kb], kbf, c1); c2 = MFMA16(ka[kb], qbf, c2);
                }
                const int i = bt * 16 + fr, j0 = a0 + 4 * fq;
                const float gi = GC[i], bi = BT[i];
                float m[4], at[4];
#pragma unroll
                for (int rg = 0; rg < 4; ++rg) { const int j = j0 + rg; const float dec = expf(fminf(gi - GC[j], 0.f));
                    m[rg] = (i > j) ? bi * c1[rg] * dec : 0.f; at[rg] = (i >= j) ? c2[rg] * dec : 0.f; }
                *(float4*)(MM + i * 64 + j0) = make_float4(m[0], m[1], m[2], m[3]);
                uint2 w; w.x = pk2(at[0], at[1]); w.y = pk2(at[2], at[3]);
                *(uint2*)(GA3 + ((size_t)item * 64 + i) * 64 + j0) = w;
            }
        }
        __syncthreads();
        {
            const int cc = ht & 127; const bool isw = ht >= 128;
            const bf16* srcp = (isw ? KB : VB) + cc; const float* scl = isw ? BE : BT;
            float x[64];
#pragma unroll
            for (int i = 0; i < 64; ++i) x[i] = 0.f;
#pragma unroll
            for (int i = 0; i < 64; ++i) {
                float acc = scl[i] * bf2f(srcp[i * 136]);
#pragma unroll
                for (int j4 = 0; j4 < (i + 3) / 4; ++j4) { const float4 mv = *(const float4*)(MM + i * 64 + 4 * j4);
                    acc -= mv.x * x[4 * j4]; acc -= mv.y * x[4 * j4 + 1]; acc -= mv.z * x[4 * j4 + 2]; acc -= mv.w * x[4 * j4 + 3]; }
                x[i] = acc;
                asm volatile("" ::: "memory");
            }
            if (!isw) {
                float* up = GX0 + ((size_t)item * 128 + cc) * 64;
#pragma unroll
                for (int q = 0; q < 16; ++q) *(float4*)(up + 4 * q) = make_float4(x[4 * q], x[4 * q + 1], x[4 * q + 2], x[4 * q + 3]);
            } else {
                bf16* wp = GA1 + (size_t)item * 64 * 128 + cc;
#pragma unroll
                for (int i = 0; i < 64; ++i) wp[i * 128] = f2bf(-x[i]);
            }
        }
        {
            const int dk = ht & 127, hh = ht >> 7; const float g63 = GC[63];
            unsigned w[16];
#pragma unroll
            for (int q = 0; q < 16; ++q) { const int ta = hh * 32 + 2 * q;
                w[q] = pk2(bf2f(KB[ta * 136 + dk]) * expf(g63 - GC[ta]), bf2f(KB[(ta + 1) * 136 + dk]) * expf(g63 - GC[ta + 1])); }
            uint4* dp = (uint4*)(GA4 + ((size_t)item * 128 + dk) * 64 + hh * 32);
            dp[0] = make_uint4(w[0], w[1], w[2], w[3]); dp[1] = make_uint4(w[4], w[5], w[6], w[7]); dp[2] = make_uint4(w[8], w[9], w[10], w[11]); dp[3] = make_uint4(w[12], w[13], w[14], w[15]);
            if (ht == 0) GGL[item] = expf(g63);
        }
    }
}

constexpr int RCL_HALF_BYTES = 75776;
__device__ __forceinline__ void ph_rcl(const Ctx& c) {
    const float* RKV = c.ws<float>(WS_RKV); const float* LW = c.ws<float>(WS_LW); const float* AAg = c.ws<float>(WS_AA);
    const float* mu = c.P.in[I_MU]; const float* k_k = c.P.in[I_KK]; const float* k_a = c.P.in[I_KA]; const float* r_k = c.P.in[I_RK];
    bf16* VP = c.ws<bf16>(WS_VP); float* SC = c.ws<float>(WS_SC);
    bf16* RA1 = c.ws<bf16>(WS_RA1); float* RX0 = c.ws<float>(WS_RX0); bf16* RA2 = c.ws<bf16>(WS_RA2); bf16* RA3 = c.ws<bf16>(WS_RA3); float* RO0 = c.ws<float>(WS_RO0);
    bf16* RA4 = c.ws<bf16>(WS_RA4); float* RS0 = c.ws<float>(WS_RS0); float* RDSC = c.ws<float>(WS_RDSC);
    for (int it0 = blockIdx.x * 2; it0 < 4096; it0 += gridDim.x * 2) {
        int tv = c.tid; asm volatile("" : "+v"(tv));
        const int half = tv >> 8, ht = tv & 255, lane = tv & 63, w4 = __builtin_amdgcn_readfirstlane((tv >> 6) & 3);
        unsigned char* base = c.lds + half * RCL_HALF_BYTES;
        bf16* AT = (bf16*)base;
        bf16* VT = AT + 64 * 72;
        bf16* KDT = VT + 64 * 72;
        float* AAB = (float*)(KDT + 64 * 72);
        float* TOT = AAB + 64 * 64;
        unsigned char* RX = (unsigned char*)(TOT + 256);
        bf16* RT = (bf16*)RX;
        bf16* BTL = RT + 64 * 72;
        bf16* KT = BTL + 64 * 72;
        bf16* AAK = (bf16*)RX;
        bf16* ARK = AAK + 64 * 72;
        float* RHS2 = (float*)RX;
        const int item = it0 + half, n = item & 63, bh = item >> 6, h = bh & 15, b = bh >> 4;
        const int t0 = b * SEQ + n * 64;
        __syncthreads();
        {
            const int ch = ht & 63, tq = ht >> 6;
            float run = 0.f;
#pragma unroll
            for (int i = 0; i < 16; ++i) { run += LW[(size_t)(t0 + tq * 16 + i) * 1024 + h * 64 + ch]; AAB[(tq * 16 + i) * 64 + ch] = run; }
            TOT[tq * 64 + ch] = run;
        }
        __syncthreads();
        {
            const int r = ht >> 2, seg = ht & 3, c0 = seg * 16, t = t0 + r; const bool first = (n == 0 && r == 0);
            const float* cur = RKV + (size_t)t * 3072 + h * 64 + c0; const float* prv = cur - 3072;
            float rr[16], kf[16], vv[16], kkv[16], aa[16];
            float ss = 0.f, scs = 0.f;
#pragma unroll
            for (int q = 0; q < 4; ++q) {
                const float4 r0 = *(const float4*)(cur + 4 * q), k0 = *(const float4*)(cur + 1024 + 4 * q), v0 = *(const float4*)(cur + 2048 + 4 * q);
                float4 rp = make_float4(0.f, 0.f, 0.f, 0.f), kp = rp, vp = rp;
                if (!first) { rp = *(const float4*)(prv + 4 * q); kp = *(const float4*)(prv + 1024 + 4 * q); vp = *(const float4*)(prv + 2048 + 4 * q); }
                const float4 mr = *(const float4*)(mu + h * 64 + c0 + 4 * q), mk = *(const float4*)(mu + 1024 + h * 64 + c0 + 4 * q), mv = *(const float4*)(mu + 2048 + h * 64 + c0 + 4 * q);
                const float4 kkw = *(const float4*)(k_k + h * 64 + c0 + 4 * q), kaw = *(const float4*)(k_a + h * 64 + c0 + 4 * q), rkw = *(const float4*)(r_k + h * 64 + c0 + 4 * q);
                const float4 a4 = *(const float4*)(AAg + (size_t)t * 1024 + h * 64 + c0 + 4 * q);
                const float r0a[4] = {r0.x, r0.y, r0.z, r0.w}, k0a[4] = {k0.x, k0.y, k0.z, k0.w}, v0a[4] = {v0.x, v0.y, v0.z, v0.w};
                const float rpa[4] = {rp.x, rp.y, rp.z, rp.w}, kpa[4] = {kp.x, kp.y, kp.z, kp.w}, vpa[4] = {vp.x, vp.y, vp.z, vp.w};
                const float mra[4] = {mr.x, mr.y, mr.z, mr.w}, mka[4] = {mk.x, mk.y, mk.z, mk.w}, mva[4] = {mv.x, mv.y, mv.z, mv.w};
                const float kka[4] = {kkw.x, kkw.y, kkw.z, kkw.w}, kaa[4] = {kaw.x, kaw.y, kaw.z, kaw.w}, rka[4] = {rkw.x, rkw.y, rkw.z, rkw.w}, aaa[4] = {a4.x, a4.y, a4.z, a4.w};
#pragma unroll
                for (int e = 0; e < 4; ++e) { const int i = 4 * q + e;
                    rr[i] = r0a[e] + (rpa[e] - r0a[e]) * mra[e]; const float kx = k0a[e] + (kpa[e] - k0a[e]) * mka[e]; vv[i] = v0a[e] + (vpa[e] - v0a[e]) * mva[e];
                    kkv[i] = kx * kka[e]; ss += kkv[i] * kkv[i]; aa[i] = aaa[e]; kf[i] = kx * (1.f + (aaa[e] - 1.f) * kaa[e]); scs += rr[i] * kf[i] * rka[e]; }
                asm volatile("" ::: "memory");
            }
            ss += __shfl_xor(ss, 1); ss += __shfl_xor(ss, 2); scs += __shfl_xor(scs, 1); scs += __shfl_xor(scs, 2);
            const float rn = rsqrtf(ss + 1e-6f);
            if (seg == 0) SC[(size_t)t * 16 + h] = scs;
            const int tq = r >> 4;
            unsigned wat[8], wbt[8], wkt[8], wrt[8], wvp[8];
            float atv[16], btv[16], ktv[16], rtv[16];
#pragma unroll
            for (int i = 0; i < 16; ++i) {
                const int ch = c0 + i;
                float off = 0.f;
#pragma unroll
                for (int q = 0; q < 3; ++q) off += (q < tq) ? TOT[q * 64 + ch] : 0.f;
                const float tot = TOT[ch] + TOT[64 + ch] + TOT[128 + ch] + TOT[192 + ch];
                const float cs = AAB[r * 64 + ch] + off;
                const float lwv = LW[(size_t)t * 1024 + h * 64 + ch];
                const float kk = kkv[i] * rn;
                const float e2 = expf(-cs), e4 = expf(tot - cs);
                atv[i] = kk * expf(cs - lwv); btv[i] = -kk * aa[i] * e2; ktv[i] = kf[i] * e2; rtv[i] = rr[i] * expf(cs);
                VT[ch * 72 + r] = f2bf(vv[i]);
                KDT[ch * 72 + r] = f2bf(kf[i] * e4);
                RA4[((size_t)item * 64 + ch) * 64 + r] = f2bf(-kk * aa[i] * e4);
                if (r == 63) RDSC[(size_t)item * 64 + ch] = expf(tot);
            }
#pragma unroll
            for (int q = 0; q < 8; ++q) { wat[q] = pk2(atv[2 * q], atv[2 * q + 1]); wbt[q] = pk2(btv[2 * q], btv[2 * q + 1]); wkt[q] = pk2(ktv[2 * q], ktv[2 * q + 1]); wrt[q] = pk2(rtv[2 * q], rtv[2 * q + 1]); wvp[q] = pk2(vv[2 * q], vv[2 * q + 1]); }
            *(uint4*)(AT + r * 72 + c0) = make_uint4(wat[0], wat[1], wat[2], wat[3]); *(uint4*)(AT + r * 72 + c0 + 8) = make_uint4(wat[4], wat[5], wat[6], wat[7]);
            *(uint4*)(BTL + r * 72 + c0) = make_uint4(wbt[0], wbt[1], wbt[2], wbt[3]); *(uint4*)(BTL + r * 72 + c0 + 8) = make_uint4(wbt[4], wbt[5], wbt[6], wbt[7]);
            *(uint4*)(KT + r * 72 + c0) = make_uint4(wkt[0], wkt[1], wkt[2], wkt[3]); *(uint4*)(KT + r * 72 + c0 + 8) = make_uint4(wkt[4], wkt[5], wkt[6], wkt[7]);
            *(uint4*)(RT + r * 72 + c0) = make_uint4(wrt[0], wrt[1], wrt[2], wrt[3]); *(uint4*)(RT + r * 72 + c0 + 8) = make_uint4(wrt[4], wrt[5], wrt[6], wrt[7]);
            bf16* a2p = RA2 + ((size_t)item * 64 + r) * 64 + c0;
            *(uint4*)a2p = make_uint4(wrt[0], wrt[1], wrt[2], wrt[3]); *(uint4*)(a2p + 8) = make_uint4(wrt[4], wrt[5], wrt[6], wrt[7]);
            bf16* vpp = VP + (size_t)t * 1024 + h * 64 + c0;
            *(uint4*)vpp = make_uint4(wvp[0], wvp[1], wvp[2], wvp[3]); *(uint4*)(vpp + 8) = make_uint4(wvp[4], wvp[5], wvp[6], wvp[7]);
        }
        __syncthreads();
        const int fr = lane & 15, fq = lane >> 4;
        f32x4_t cab[4], cak[4], crb[4], crk[4];
        {
            const int j0t = w4 * 16;
            bf16x8_t bj[2], kj[2];
#pragma unroll
            for (int kb = 0; kb < 2; ++kb) { bj[kb] = *(const bf16x8_t*)(BTL + (j0t + fr) * 72 + kb * 32 + fq * 8); kj[kb] = *(const bf16x8_t*)(KT + (j0t + fr) * 72 + kb * 32 + fq * 8); }
#pragma unroll
            for (int it = 0; it < 4; ++it) {
                cab[it] = (f32x4_t){0.f, 0.f, 0.f, 0.f}; cak[it] = cab[it]; crb[it] = cab[it]; crk[it] = cab[it];
#pragma unroll
                for (int kb = 0; kb < 2; ++kb) {
                    const bf16x8_t ai = *(const bf16x8_t*)(AT + (it * 16 + fr) * 72 + kb * 32 + fq * 8);
                    const bf16x8_t ri = *(const bf16x8_t*)(RT + (it * 16 + fr) * 72 + kb * 32 + fq * 8);
                    cab[it] = MFMA16(bj[kb], ai, cab[it]); cak[it] = MFMA16(kj[kb], ai, cak[it]); crb[it] = MFMA16(bj[kb], ri, crb[it]); crk[it] = MFMA16(kj[kb], ri, crk[it]);
                }
            }
        }
        __syncthreads();
        {
            const int j0 = w4 * 16 + 4 * fq;
#pragma unroll
            for (int it = 0; it < 4; ++it) {
                const int i = it * 16 + fr;
                float vab[4], vak[4], vrb[4], vrk[4];
#pragma unroll
                for (int rg = 0; rg < 4; ++rg) { const int j = j0 + rg; const bool st = i > j, in = i >= j;
                    vab[rg] = st ? cab[it][rg] : 0.f; vak[rg] = st ? cak[it][rg] : 0.f; vrb[rg] = in ? crb[it][rg] : 0.f; vrk[rg] = in ? crk[it][rg] : 0.f; }
                *(float4*)(AAB + i * 64 + j0) = make_float4(vab[0], vab[1], vab[2], vab[3]);
                uint2 w; w.x = pk2(vak[0], vak[1]); w.y = pk2(vak[2], vak[3]); *(uint2*)(AAK + i * 72 + j0) = w;
                w.x = pk2(vrk[0], vrk[1]); w.y = pk2(vrk[2], vrk[3]); *(uint2*)(ARK + i * 72 + j0) = w;
                w.x = pk2(vrb[0], vrb[1]); w.y = pk2(vrb[2], vrb[3]); *(uint2*)(RA3 + ((size_t)item * 64 + i) * 64 + j0) = w;
            }
        }
        __syncthreads();
        f32x4_t cav[4], cov[4], ckv[4];
        {
            const int r0t = w4 * 16;
            bf16x8_t fa[2], fo[2], fk[2];
#pragma unroll
            for (int kb = 0; kb < 2; ++kb) { fa[kb] = *(const bf16x8_t*)(AAK + (r0t + fr) * 72 + kb * 32 + fq * 8); fo[kb] = *(const bf16x8_t*)(ARK + (r0t + fr) * 72 + kb * 32 + fq * 8); fk[kb] = *(const bf16x8_t*)(KDT + (r0t + fr) * 72 + kb * 32 + fq * 8); }
#pragma unroll
            for (int vt = 0; vt < 4; ++vt) {
                cav[vt] = (f32x4_t){0.f, 0.f, 0.f, 0.f}; cov[vt] = cav[vt]; ckv[vt] = cav[vt];
#pragma unroll
                for (int kb = 0; kb < 2; ++kb) { const bf16x8_t vb = *(const bf16x8_t*)(VT + (vt * 16 + fr) * 72 + kb * 32 + fq * 8);
                    cav[vt] = MFMA16(fa[kb], vb, cav[vt]); cov[vt] = MFMA16(fo[kb], vb, cov[vt]); ckv[vt] = MFMA16(fk[kb], vb, ckv[vt]); }
            }
        }
        __syncthreads();
        {
            const int r0 = w4 * 16 + 4 * fq;
#pragma unroll
            for (int vt = 0; vt < 4; ++vt) {
                const int v = vt * 16 + fr;
#pragma unroll
                for (int rg = 0; rg < 4; ++rg) RHS2[v * 65 + r0 + rg] = cav[vt][rg];
                *(float4*)(RO0 + ((size_t)item * 64 + v) * 64 + r0) = make_float4(cov[vt][0], cov[vt][1], cov[vt][2], cov[vt][3]);
                *(float4*)(RS0 + ((size_t)item * 64 + v) * 64 + r0) = make_float4(ckv[vt][0], ckv[vt][1], ckv[vt][2], ckv[vt][3]);
            }
        }
        __syncthreads();
        if (ht < 128) {
            const int cc = ht & 63; const bool isu = ht >= 64;
            float x[64];
#pragma unroll
            for (int i = 0; i < 64; ++i) x[i] = 0.f;
#pragma unroll
            for (int i = 0; i < 64; ++i) {
                const float rv = RHS2[(isu ? cc : 0) * 65 + i], av = bf2f(AT[i * 72 + (isu ? 0 : cc)]);
                float acc = isu ? rv : av;
#pragma unroll
                for (int j4 = 0; j4 < (i + 3) / 4; ++j4) { const float4 mv = *(const float4*)(AAB + i * 64 + 4 * j4);
                    acc += mv.x * x[4 * j4]; acc += mv.y * x[4 * j4 + 1]; acc += mv.z * x[4 * j4 + 2]; acc += mv.w * x[4 * j4 + 3]; }
                x[i] = acc;
                asm volatile("" ::: "memory");
            }
            if (isu) {
                float* up = RX0 + ((size_t)item * 64 + cc) * 64;
#pragma unroll
                for (int q = 0; q < 16; ++q) *(float4*)(up + 4 * q) = make_float4(x[4 * q], x[4 * q + 1], x[4 * q + 2], x[4 * q + 3]);
            } else {
                bf16* wp = RA1 + (size_t)item * 64 * 64 + cc;
#pragma unroll
                for (int i = 0; i < 64; ++i) wp[i * 64] = f2bf(x[i]);
            }
        }
    }
}

template <int DK, bool RW>
struct ScanArgs { const bf16* A1; const float* X0; const bf16* A2; const bf16* A3; const float* O0; const bf16* A4; const float* S0; const float* DSC; float* OUT; int item0; int vs; int tok0; int ocol0; };
template <int DK, bool RW>
__device__ __forceinline__ void scan_run(const Ctx& c, const ScanArgs<DK, RW>& a) {
    constexpr int KB = DK / 32;
    constexpr int NST = DK / 64;
    constexpr int NV = RW ? 64 : 128;
    constexpr int SROW = DK + 8;
    bf16* ST = (bf16*)c.lds;
    bf16* XT = ST + 2 * 32 * SROW;
    const int lane = c.lane, w = c.wave, fr = lane & 15, fq = lane >> 4;
    const int tm = w >> 1, tn = w & 1;
    const int dkt = (NST == 2) ? w : (w >> 1);
    for (int i = c.tid; i < 32 * SROW / 2; i += NTHREADS) ((unsigned*)ST)[i] = 0u;
    f32x4_t accS[NST];
#pragma unroll
    for (int s = 0; s < NST; ++s) accS[s] = (f32x4_t){0.f, 0.f, 0.f, 0.f};
    bf16x8_t a1f[KB], a2f[KB], a3f[2], a4f[2]; f32x4_t x0v, o0v, s0v[NST], dscv;
#define SCAN_LOAD(IT) do { const size_t it_ = (size_t)(IT); \
        _Pragma("unroll") for (int kb = 0; kb < KB; ++kb) { a1f[kb] = *(const bf16x8_t*)(a.A1 + (it_ * 64 + tm * 16 + fr) * DK + kb * 32 + fq * 8); a2f[kb] = *(const bf16x8_t*)(a.A2 + (it_ * 64 + tm * 16 + fr) * DK + kb * 32 + fq * 8); } \
        _Pragma("unroll") for (int kb = 0; kb < 2; ++kb) { a3f[kb] = *(const bf16x8_t*)(a.A3 + (it_ * 64 + tm * 16 + fr) * 64 + kb * 32 + fq * 8); a4f[kb] = *(const bf16x8_t*)(a.A4 + (it_ * DK + dkt * 16 + fr) * 64 + kb * 32 + fq * 8); } \
        x0v = *(const f32x4_t*)(a.X0 + (it_ * NV + a.vs * 32 + tn * 16 + fr) * 64 + tm * 16 + 4 * fq); \
        if (RW) { o0v = *(const f32x4_t*)(a.O0 + (it_ * NV + a.vs * 32 + tn * 16 + fr) * 64 + tm * 16 + 4 * fq); \
                  _Pragma("unroll") for (int s = 0; s < NST; ++s) s0v[s] = *(const f32x4_t*)(a.S0 + (it_ * 64 + a.vs * 32 + (NST == 2 ? s : tn) * 16 + fr) * DK + dkt * 16 + 4 * fq); \
                  dscv = *(const f32x4_t*)(a.DSC + it_ * DK + dkt * 16 + 4 * fq); } \
        else { const float g_ = a.DSC[it_]; dscv = (f32x4_t){g_, g_, g_, g_}; o0v = (f32x4_t){0.f, 0.f, 0.f, 0.f}; _Pragma("unroll") for (int s = 0; s < NST; ++s) s0v[s] = (f32x4_t){0.f, 0.f, 0.f, 0.f}; } \
    } while (0)
    SCAN_LOAD(a.item0);
    int cur = 0;
    for (int n = 0; n < 64; ++n) {
        bf16x8_t b1[KB], b2[KB], b3[2], b4[2];
#pragma unroll
        for (int kb = 0; kb < KB; ++kb) { b1[kb] = a1f[kb]; b2[kb] = a2f[kb]; }
        b3[0] = a3f[0]; b3[1] = a3f[1]; b4[0] = a4f[0]; b4[1] = a4f[1];
        f32x4_t accX = x0v, accO = o0v; const f32x4_t dv = dscv; f32x4_t sv[NST];
#pragma unroll
        for (int s = 0; s < NST; ++s) sv[s] = s0v[s];
        if (n + 1 < 64) SCAN_LOAD(a.item0 + n + 1);
        __syncthreads();
        const bf16* Sc = ST + cur * 32 * SROW; bf16* Sn = ST + (cur ^ 1) * 32 * SROW;
        bf16x8_t sf[KB];
#pragma unroll
        for (int kb = 0; kb < KB; ++kb) sf[kb] = *(const bf16x8_t*)(Sc + (tn * 16 + fr) * SROW + kb * 32 + fq * 8);
#pragma unroll
        for (int kb = 0; kb < KB; ++kb) accX = MFMA16(b1[kb], sf[kb], accX);
        { uint2 wv; wv.x = pk2(accX[0], accX[1]); wv.y = pk2(accX[2], accX[3]); *(uint2*)(XT + (tn * 16 + fr) * 72 + tm * 16 + 4 * fq) = wv; }
#pragma unroll
        for (int kb = 0; kb < KB; ++kb) accO = MFMA16(b2[kb], sf[kb], accO);
        __syncthreads();
        bf16x8_t xf[2];
#pragma unroll
        for (int kb = 0; kb < 2; ++kb) xf[kb] = *(const bf16x8_t*)(XT + (tn * 16 + fr) * 72 + kb * 32 + fq * 8);
        accO = MFMA16(b3[0], xf[0], accO); accO = MFMA16(b3[1], xf[1], accO);
        {
            float* op = a.OUT + (size_t)(a.tok0 + n * 64 + tm * 16 + 4 * fq) * 1024 + a.ocol0 + tn * 16 + fr;
            op[0] = accO[0]; op[1024] = accO[1]; op[2048] = accO[2]; op[3072] = accO[3];
        }
#pragma unroll
        for (int s = 0; s < NST; ++s) {
            const int vt = (NST == 2) ? s : tn;
            bf16x8_t xg[2];
            if (vt == tn) { xg[0] = xf[0]; xg[1] = xf[1]; }
            else {
#pragma unroll
                for (int kb = 0; kb < 2; ++kb) xg[kb] = *(const bf16x8_t*)(XT + (vt * 16 + fr) * 72 + kb * 32 + fq * 8);
            }
            f32x4_t t = accS[s] * dv + sv[s];
            t = MFMA16(b4[0], xg[0], t); t = MFMA16(b4[1], xg[1], t);
            accS[s] = t;
            uint2 wv; wv.x = pk2(t[0], t[1]); wv.y = pk2(t[2], t[3]);
            *(uint2*)(Sn + (vt * 16 + fr) * SROW + dkt * 16 + 4 * fq) = wv;
        }
        cur ^= 1;
    }
#undef SCAN_LOAD
    __syncthreads();
}

__device__ __forceinline__ void ph_scan(const Ctx& c) {
    for (int wk = blockIdx.x; wk < 256; wk += gridDim.x) {
        if (wk < 128) {
            const int pair = wk >> 2, vs = wk & 3, b = pair >> 3, h = pair & 7;
            ScanArgs<128, false> a{c.ws<bf16>(WS_GA1), c.ws<float>(WS_GX0), c.ws<bf16>(WS_GA2), c.ws<bf16>(WS_GA3), nullptr, c.ws<bf16>(WS_GA4), nullptr, c.ws<float>(WS_GGL),
                                   c.ws<float>(WS_OG), pair * 64, vs, b * SEQ, h * 128 + vs * 32};
            scan_run<128, false>(c, a);
        } else {
            const int pair = (wk - 128) >> 1, vs = wk & 1, b = pair >> 4, h = pair & 15;
            ScanArgs<64, true> a{c.ws<bf16>(WS_RA1), c.ws<float>(WS_RX0), c.ws<bf16>(WS_RA2), c.ws<bf16>(WS_RA3), c.ws<float>(WS_RO0), c.ws<bf16>(WS_RA4), c.ws<float>(WS_RS0), c.ws<float>(WS_RDSC),
                                 c.ws<float>(WS_ORW), pair * 64, vs, b * SEQ, h * 64 + vs * 32};
            scan_run<64, true>(c, a);
        }
    }
}

enum { PH_RMS0 = 0, PH_INPROJ, PH_GCONV, PH_GL2, PH_GSCAN, PH_RPREP, PH_RSCAN, PH_POST, PH_G2, PH_X1, PH_ROUTER, PH_DISPATCH, PH_MOE1, PH_MOE2, PH_COMBINE, PH_COUNT };

template <unsigned PHMASK>
__global__ void __launch_bounds__(NTHREADS) mk(Params P) {
    extern __shared__ __attribute__((aligned(16))) unsigned char lds[];
    volatile LAS unsigned* misc = (volatile LAS unsigned*)((LAS unsigned char*)lds + MISC_OFF);
    if (threadIdx.x < 64) misc[threadIdx.x] = 0u;
    __syncthreads();
    unsigned* ctl = (unsigned*)(P.ws + WS_CTL);
    XcdBarrier bar = xcd_barrier_post(ctl + CW_BAR + P.li * XCD_BAR_WORDS, misc);
    Ctx c{P, (int)threadIdx.x, (int)(threadIdx.x & 63), (int)(threadIdx.x >> 6), (int)(blockIdx.x * NWAVES + (threadIdx.x >> 6)), (int)(gridDim.x * NWAVES),
          (size_t)blockIdx.x * NTHREADS + threadIdx.x, (size_t)gridDim.x * NTHREADS, lds};
    bool first_seam = true;
#define IN(k) (((PHMASK >> (k)) & 1u) && P.ph_lo <= (k) && (k) < P.ph_hi)
#define SEAM(k) do { if ((k) + 1 < P.ph_hi) { if (first_seam && P.coop) { cg::this_grid().sync(); } else xcd_barrier(bar); first_seam = false; } } while (0)
    if (IN(PH_RMS0)) {
        ph_rms0(c);
        { WJob j{P.in[I_W_IN], NCOL_IN, 1024, 4096, c.ws<bf16>(WS_WIN_T), 1024, 1, 0, 0}; wconv_job(c, j); }
        { WJob j{P.in[I_W_IN] + 4112, NCOL_IN, 1024, 5376, c.ws<bf16>(WS_WIN_T) + (size_t)4096 * 1024, 1024, 1, 0, 0}; wconv_job(c, j); }
        { WJob j{P.in[I_PROJ_A], 1024, 1024, 1024, c.ws<bf16>(WS_PROJ_T), 1024, 1, 0, 0}; wconv_job(c, j); }
        { WJob j{P.in[I_PROJ_B], 1024, 1024, 1024, c.ws<bf16>(WS_PROJ_T) + (size_t)1024 * 1024, 1024, 1, 0, 0}; wconv_job(c, j); }
        { WJob j{P.in[I_W_OUT], 1024, 1024, 1024, c.ws<bf16>(WS_WOUT_T), 2048, 2, 0, 1024}; wconv_job(c, j); }
        SEAM(PH_RMS0);
    }
    if (IN(PH_INPROJ)) {
        EpiInProj ep{c.ws<float>(WS_GQKV), c.ws<bf16>(WS_ZS), c.ws<float>(WS_RKV), c.ws<float>(WS_LIN), c.ws<bf16>(WS_GATES)};
#if FAST_INPROJ
        SchedInProj sc{(const char*)c.ws<bf16>(WS_HB), (const char*)c.ws<bf16>(WS_WIN_T), (int)gridDim.x, (int)blockIdx.x};
        pg8::gemm_phase((LAS unsigned char*)lds, 1024, sc, ep);
#else
        TfInProj tf{c.ws<bf16>(WS_HB), P.in[I_W_IN]};
        ngemm(c, 128 * 74, tf, ep, 1024);
#endif
        SEAM(PH_INPROJ);
    }
#if FAST_MIX
    if (IN(PH_GCONV)) { ph_gcl(c); ph_loraprep(c); SEAM(PH_GCONV); }
    if (IN(PH_GL2)) { ph_lora_naive(c); SEAM(PH_GL2); }
    if (IN(PH_GSCAN)) { ph_rcl(c); SEAM(PH_GSCAN); }
    if (IN(PH_RPREP)) { ph_scan(c); SEAM(PH_RPREP); }
    if (IN(PH_RSCAN)) { SEAM(PH_RSCAN); }
#else
    if (IN(PH_GCONV)) { ph_gconv(c); ph_loraprep(c); SEAM(PH_GCONV); }
    if (IN(PH_GL2)) { ph_gl2(c); ph_lora_naive(c); SEAM(PH_GL2); }
    if (IN(PH_GSCAN)) { ph_gscan(c); SEAM(PH_GSCAN); }
    if (IN(PH_RPREP)) { ph_rprep(c); SEAM(PH_RPREP); }
    if (IN(PH_RSCAN)) { ph_rscan(c); SEAM(PH_RSCAN); }
#endif
    if (IN(PH_POST)) { ph_post(c); SEAM(PH_POST); }
    if (IN(PH_G2)) {
        EpiG2 ep{c.ws<bf16>(WS_GATES), c.ws<bf16>(WS_G2)};
        SchedG2 sc{(const char*)c.ws<bf16>(WS_YA), (const char*)c.ws<bf16>(WS_YB), (const char*)c.ws<bf16>(WS_PROJ_T), (int)gridDim.x, (int)blockIdx.x};
        pg8::gemm_phase((LAS unsigned char*)lds, 1024, sc, ep);
        SEAM(PH_G2);
    }
    if (IN(PH_X1)) {
        EpiX1 ep{P.in[I_X], c.ws<float>(WS_X1)};
        SchedX1 sc{(const char*)c.ws<bf16>(WS_G2), (const char*)c.ws<bf16>(WS_WOUT_T), (int)gridDim.x, (int)blockIdx.x};
        pg8::gemm_phase((LAS unsigned char*)lds, 2048, sc, ep);
        SEAM(PH_X1);
    }
    if (IN(PH_ROUTER)) {
        ph_router(c);
        { WJob j{P.in[I_W_GU], 2048, 1024, 2048, c.ws<bf16>(WS_WGU_T), 1024, 32, (size_t)1024 * 2048, (size_t)2048 * 1024}; wconv_job(c, j); }
        { WJob j{P.in[I_W_DOWN], 1024, 1024, 1024, c.ws<bf16>(WS_WDN_T), 1024, 32, (size_t)1024 * 1024, (size_t)1024 * 1024}; wconv_job(c, j); }
        SEAM(PH_ROUTER);
    }
    if (IN(PH_DISPATCH)) { ph_dispatch(c); SEAM(PH_DISPATCH); }
    if (IN(PH_MOE1)) {
        const int nt = *c.ws<int>(WS_NT);
        EpiAct ep{P.in[I_B_GU], c.ws<bf16>(WS_ACT)};
        SchedMoe sc{(const char*)c.ws<bf16>(WS_XB), (const char*)c.ws<bf16>(WS_WGU_T), c.ws<int>(WS_TILE_E), nt, 8, (int)gridDim.x, (int)blockIdx.x};
        pg8::gemm_phase((LAS unsigned char*)lds, 1024, sc, ep);
        SEAM(PH_MOE1);
    }
    if (IN(PH_MOE2)) {
        const int nt = *c.ws<int>(WS_NT);
        EpiYS ep{P.in[I_B_DOWN], c.ws<float>(WS_SGATE), c.ws<bf16>(WS_YS)};
        SchedMoe sc{(const char*)c.ws<bf16>(WS_ACT), (const char*)c.ws<bf16>(WS_WDN_T), c.ws<int>(WS_TILE_E), nt, 4, (int)gridDim.x, (int)blockIdx.x};
        pg8::gemm_phase((LAS unsigned char*)lds, 1024, sc, ep);
        SEAM(PH_MOE2);
    }
    if (IN(PH_COMBINE)) { ph_combine(c); }
#undef IN
#undef SEAM
}

template <unsigned M> static void launch_one(const Params& p, int grid, hipStream_t stream) {
    static bool attr = false;
    if (!attr) { (void)hipFuncSetAttribute((const void*)mk<M>, hipFuncAttributeMaxDynamicSharedMemorySize, LDS_BYTES); attr = true; }
    hipLaunchKernelGGL(mk<M>, dim3(grid), dim3(NTHREADS), LDS_BYTES, stream, p);
}
template <int PH> static void launch_chain(Params& p, int grid, hipStream_t stream) {
    if constexpr (PH < PH_COUNT) { p.ph_lo = PH; p.ph_hi = PH + 1; p.li = 0; p.coop = 0; launch_one<(1u << PH)>(p, grid, stream); launch_chain<PH + 1>(p, grid, stream); }
}

extern "C" void kernel_launch(void* const* d_in, const int* in_sizes, int n_in, void* d_out, int out_size, void* d_ws, size_t ws_size, hipStream_t stream) {
    static int grid = 0;
    if (grid == 0) {
        int dev = 0, cus = 0, per_cu = 0;
        (void)hipGetDevice(&dev);
        (void)hipDeviceGetAttribute(&cus, hipDeviceAttributeMultiprocessorCount, dev);
#if MK_ONE_LAUNCH
        (void)hipFuncSetAttribute((const void*)mk<0xffffffffu>, hipFuncAttributeMaxDynamicSharedMemorySize, LDS_BYTES);
        (void)hipOccupancyMaxActiveBlocksPerMultiprocessor(&per_cu, (const void*)mk<0xffffffffu>, NTHREADS, LDS_BYTES);
#else
        per_cu = 1;
#endif
        if (n_in != 29 || ws_size < WS_END || per_cu < 1 || cus < 64) { fprintf(stderr, "kernel_launch: unexpected setup n_in %d ws %zu per_cu %d cus %d\n", n_in, ws_size, per_cu, cus); grid = -1; return; }
        grid = cus;
    }
    if (grid < 0) return;
    (void)hipMemsetAsync((char*)d_ws + WS_CTL, 0, CTL_BYTES, stream);
    Params p{};
    for (int i = 0; i < 29; ++i) p.in[i] = (const float*)d_in[i];
    p.out = (float*)d_out; p.ws = (unsigned char*)d_ws;
#if MK_ONE_LAUNCH
    p.ph_lo = 0; p.ph_hi = PH_COUNT; p.li = 0; p.coop = 1;
    void* args[] = {&p};
    hipError_t e = hipLaunchCooperativeKernel((const void*)mk<0xffffffffu>, dim3(grid), dim3(NTHREADS), args, LDS_BYTES, stream);
    if (e != hipSuccess) fprintf(stderr, "cooperative launch failed: %s (grid %d)\n", hipGetErrorString(e), grid);
#else
    launch_chain<0>(p, grid, stream);
#endif
}
```

```cpp
#include <hip/hip_runtime.h>
#include <hip/hip_cooperative_groups.h>
#include <cstdint>
#include <cstdio>
namespace cg = cooperative_groups;

#ifndef MK_ONE_LAUNCH
#define MK_ONE_LAUNCH 1
#endif

#define LAS __attribute__((address_space(3)))
#ifndef FAST_INPROJ
#define FAST_INPROJ 1
#endif
#ifndef FAST_MIX
#define FAST_MIX 1
#endif
#define PROBE_REP -1
constexpr int NTHREADS = 512;
constexpr int NWAVES = 8;
constexpr int LDS_BYTES = 155648;
constexpr int MISC_OFF = 153600;

constexpr int T = 16384, SEQ = 4096, D = 1024;
constexpr int NCOL_IN = 9488;
constexpr int NEXP = 32;
constexpr int MAXTILES = 288;
constexpr int MAXSLOTS = MAXTILES * 256;

enum { I_X = 0, I_NORM_MIX, I_W_IN, I_GDN_CONV, I_GDN_ALOG, I_GDN_DTB, I_GDN_NORM, I_MU, I_W0, I_W2, I_A0, I_A2, I_G2, I_KK, I_KA, I_RK,
       I_LNW, I_LNB, I_PROJ_A, I_PROJ_B, I_W_OUT, I_NORM_FFN, I_ROUTER_W, I_ROUTER_B, I_W_GU, I_B_GU, I_W_DOWN, I_B_DOWN, I_NORM_FINAL };

constexpr size_t MiB = 1u << 20;
constexpr size_t WS_CTL = 0, CTL_BYTES = 65536;
constexpr size_t WS_BETA = 1 * MiB;
constexpr size_t WS_GG = WS_BETA + 512 * 1024;
constexpr size_t WS_SC = 2 * MiB;
constexpr size_t WS_TE = 3 * MiB;
constexpr size_t WS_TG = WS_TE + 256 * 1024;
constexpr size_t WS_TP = WS_TG + 256 * 1024;
constexpr size_t WS_TSLOT = WS_TP + 256 * 1024;
constexpr size_t WS_SGATE = 4 * MiB;
constexpr size_t WS_TILE_E = 5 * MiB;
constexpr size_t WS_NT = WS_TILE_E + 4096;
constexpr size_t WS_HB = 8 * MiB;
constexpr size_t WS_H2 = WS_HB;
constexpr size_t WS_ZS = 40 * MiB;
constexpr size_t WS_GATES = 72 * MiB;
constexpr size_t WS_ALORA = 136 * MiB;
constexpr size_t WS_LW = 144 * MiB;
constexpr size_t WS_AA = 208 * MiB;
constexpr size_t WS_GGR = 272 * MiB;
constexpr size_t WS_VP = 304 * MiB;
constexpr size_t WS_Q = 336 * MiB;
constexpr size_t WS_QKVC = WS_Q;
constexpr size_t WS_RP = WS_Q, WS_KF = WS_Q + 64 * MiB, WS_KKN = WS_Q + 128 * MiB;
constexpr size_t WS_YA = WS_Q, WS_YB = WS_Q + 32 * MiB, WS_G2 = WS_Q + 64 * MiB, WS_X1 = WS_Q + 128 * MiB;
constexpr size_t WS_GQKV = 528 * MiB;
#if FAST_MIX
constexpr size_t WS_OG = 720 * MiB, WS_ORW = 784 * MiB;
#else
constexpr size_t WS_OG = WS_GQKV, WS_ORW = WS_GQKV + 64 * MiB;
#endif
constexpr size_t WS_RKV = 720 * MiB;
constexpr size_t WS_LIN = 912 * MiB;
constexpr size_t WS_DEC = 928 * MiB;
constexpr size_t WS_XB = 528 * MiB;
constexpr size_t WS_ACT = 672 * MiB;
constexpr size_t WS_YS = 816 * MiB;
constexpr size_t WS_WIN_T = 992 * MiB;
constexpr size_t WS_PROJ_T = 144 * MiB;
constexpr size_t WS_WOUT_T = 148 * MiB;
constexpr size_t WS_WGU_T = 72 * MiB;
constexpr size_t WS_WDN_T = 200 * MiB;
constexpr size_t WS_GA1 = 336 * MiB, WS_GX0 = 368 * MiB, WS_GA2 = 432 * MiB, WS_GA3 = 464 * MiB, WS_GA4 = 480 * MiB;
constexpr size_t WS_GGL = 6 * MiB;
constexpr size_t WS_RX0 = 528 * MiB, WS_RO0 = 592 * MiB, WS_RS0 = 656 * MiB;
constexpr size_t WS_RA1 = 8 * MiB, WS_RA2 = 928 * MiB, WS_RA3 = 960 * MiB, WS_RA4 = 992 * MiB;
constexpr size_t WS_RDSC = 7 * MiB;
constexpr size_t WS_LORA_T = 1012 * MiB;
constexpr size_t WS_END = 1024 * MiB;
constexpr int CW_BAR = 1024;
constexpr int CW_CNT = 256;

#define XB_TMO      128
#define XB_XCNT(j)  (256  + 64 * (j))
#define XB_XSUB(j)  (1280 + 64 * (j))
#define XB_XGEN(j)  (2304 + 64 * (j))
#define XB_TOP      3328
#define XB_TOPGEN   3392
#define XCD_BAR_WORDS 3456
#define XB_SPIN_CAP (1u << 24)
__device__ __forceinline__ unsigned xb_ld(unsigned* p)              { return __hip_atomic_load(p, __ATOMIC_RELAXED, __HIP_MEMORY_SCOPE_AGENT); }
__device__ __forceinline__ unsigned xb_add(unsigned* p, unsigned v) { return __hip_atomic_fetch_add(p, v, __ATOMIC_RELAXED, __HIP_MEMORY_SCOPE_AGENT); }
__device__ __forceinline__ unsigned xb_xcc_id() { return (unsigned)__builtin_amdgcn_s_getreg((3 << 11) | 20) & 0xFu; }
#define XB_SPIN(cond, bar) do { unsigned _sp = 0; while (cond) { __builtin_amdgcn_s_sleep(1); \
    if ((++_sp & 255u) == 0u) { if (xb_ld(&(bar)[XB_TMO])) break; if (_sp > XB_SPIN_CAP) { atomicAdd(&(bar)[XB_TMO], 1u); break; } } } } while (0)
struct XcdBarrier { unsigned* bar; unsigned x; volatile LAS unsigned* st; };
__device__ __forceinline__ XcdBarrier xcd_barrier_post(unsigned* bar, volatile LAS unsigned* st) {
    XcdBarrier b; b.bar = bar; b.x = xb_xcc_id(); b.st = st;
    if (threadIdx.x == 0) (void)xb_add(&bar[XB_XCNT(b.x)], 1u);
    return b;
}
__device__ __forceinline__ void xcd_barrier_complete(unsigned* bar, unsigned x, unsigned& nloc, unsigned& nx) {
    const unsigned G = gridDim.x * gridDim.y * gridDim.z;
    unsigned sum, cnt, mine, sp = 0u;
    for (;;) {
        sum = 0u; cnt = 0u; mine = 0u;
#pragma unroll
        for (unsigned j = 0; j < 16; ++j) { const unsigned c = xb_ld(&bar[XB_XCNT(j)]); sum += c; cnt += (c > 0u) ? 1u : 0u; mine = (j == x) ? c : mine; }
        if (sum == G) break;
        __builtin_amdgcn_s_sleep(1);
        if ((++sp & 255u) == 0u) { if (xb_ld(&bar[XB_TMO])) break; if (sp > XB_SPIN_CAP) { atomicAdd(&bar[XB_TMO], 1u); break; } }
    }
    nloc = mine > 0u ? mine : 1u; nx = cnt > 0u ? cnt : 1u;
}
__device__ __forceinline__ void xcd_barrier(const XcdBarrier& b) {
    asm volatile("s_waitcnt vmcnt(0)" ::: "memory");
    __syncthreads();
    if (threadIdx.x == 0) {
        unsigned* bar = b.bar;
        __builtin_amdgcn_s_waitcnt(0);
        unsigned nloc = b.st[0], nx = b.st[1];
        if (nloc == 0u) { xcd_barrier_complete(bar, b.x, nloc, nx); b.st[0] = nloc; b.st[1] = nx; }
        const unsigned old = xb_add(&bar[XB_XSUB(b.x)], 1u);
        const unsigned gen = old / nloc;
        if (old + 1u == (gen + 1u) * nloc) {
            __builtin_amdgcn_fence(__ATOMIC_RELEASE, "agent");
            asm volatile("s_waitcnt vmcnt(0)" ::: "memory");
            const unsigned og = xb_add(&bar[XB_TOP], 1u);
            const unsigned tg = og / nx;
            if (og + 1u == (tg + 1u) * nx) xb_add(&bar[XB_TOPGEN], 1u);
            else XB_SPIN(xb_ld(&bar[XB_TOPGEN]) == tg, bar);
            __builtin_amdgcn_fence(__ATOMIC_ACQUIRE, "agent");
            xb_add(&bar[XB_XGEN(b.x)], 1u);
            asm volatile("s_waitcnt vmcnt(0)" ::: "memory");
        } else {
            XB_SPIN(xb_ld(&bar[XB_XGEN(b.x)]) == gen, bar);
            __builtin_amdgcn_fence(__ATOMIC_ACQUIRE, "agent");
            asm volatile("s_waitcnt vmcnt(0)" ::: "memory");
        }
    }
    __syncthreads();
}

typedef unsigned short bf16;
__device__ __forceinline__ bf16 f2bf(float f) { unsigned u = __float_as_uint(f); u += 0x7fffu + ((u >> 16) & 1u); return (bf16)(u >> 16); }
__device__ __forceinline__ float bf2f(unsigned b) { return __uint_as_float(b << 16); }
__device__ __forceinline__ unsigned pk2(float lo, float hi) { return (unsigned)f2bf(lo) | ((unsigned)f2bf(hi) << 16); }
__device__ __forceinline__ float bflo(unsigned w) { return __uint_as_float(w << 16); }
__device__ __forceinline__ float bfhi(unsigned w) { return __uint_as_float(w & 0xffff0000u); }
__device__ __forceinline__ float sigm(float x) { return 1.f / (1.f + expf(-x)); }
__device__ __forceinline__ float fsigm(float x) { return __builtin_amdgcn_rcpf(1.f + __expf(-x)); }
__device__ __forceinline__ float softplusf(float x) { return x > 20.f ? x : log1pf(expf(x)); }
__device__ __forceinline__ float wsum(float v) {
#pragma unroll
    for (int o = 32; o > 0; o >>= 1) v += __shfl_xor(v, o);
    return v;
}

struct Params { const float* in[29]; float* out; unsigned char* ws; int ph_lo, ph_hi, li, coop; };

struct Ctx {
    const Params& P; int tid, lane, wave, gwave, nwaves; size_t gtid, nthreads; unsigned char* lds;
    template <class Tp> __device__ __forceinline__ Tp* ws(size_t off) const { return (Tp*)(P.ws + off); }
};

__device__ __forceinline__ void ph_rms0(const Ctx& c) {
    const float* x = c.P.in[I_X]; const float* nw = c.P.in[I_NORM_MIX]; const float* win = c.P.in[I_W_IN];
    const float* alog = c.P.in[I_GDN_ALOG]; const float* dtb = c.P.in[I_GDN_DTB];
    bf16* HB = c.ws<bf16>(WS_HB); float* BETA = c.ws<float>(WS_BETA); float* GGv = c.ws<float>(WS_GG);
    if (blockIdx.x == 0 && c.tid < NEXP) c.ws<unsigned>(WS_CTL)[CW_CNT + c.tid] = 0u;
    float4* tab = (float4*)c.lds;
    __syncthreads();
    for (int i = c.tid; i < 4096; i += NTHREADS) { const int k = i >> 2; tab[((k & 3) * 256 + (k >> 2)) * 5 + (i & 3)] = *(const float4*)(win + (size_t)k * NCOL_IN + 4096 + (i & 3) * 4); }
    __syncthreads();
    const int lane = c.lane;
    for (int t = c.gwave; t < T; t += c.nwaves) {
        float4 v[4]; float ss = 0.f;
#pragma unroll
        for (int i = 0; i < 4; ++i) { v[i] = ((const float4*)(x + (size_t)t * D))[lane + 64 * i]; ss += v[i].x * v[i].x + v[i].y * v[i].y + v[i].z * v[i].z + v[i].w * v[i].w; }
        ss = wsum(ss);
        const float rstd = rsqrtf(ss * (1.f / 1024.f) + 1e-6f);
        float acc[16];
#pragma unroll
        for (int j = 0; j < 16; ++j) acc[j] = 0.f;
#pragma unroll
        for (int i = 0; i < 4; ++i) {
            const float4 w4 = ((const float4*)nw)[lane + 64 * i];
            float h[4] = {v[i].x * rstd * w4.x, v[i].y * rstd * w4.y, v[i].z * rstd * w4.z, v[i].w * rstd * w4.w};
            uint2 st; st.x = pk2(h[0], h[1]); st.y = pk2(h[2], h[3]);
            *(uint2*)(HB + (size_t)t * D + 4 * (lane + 64 * i)) = st;
#pragma unroll
            for (int ii = 0; ii < 4; ++ii) {
                const int k = 4 * (lane + 64 * i) + ii;
#pragma unroll
                for (int q = 0; q < 4; ++q) { const float4 w = tab[(ii * 256 + (k >> 2)) * 5 + q]; acc[4 * q + 0] += h[ii] * w.x; acc[4 * q + 1] += h[ii] * w.y; acc[4 * q + 2] += h[ii] * w.z; acc[4 * q + 3] += h[ii] * w.w; }
                if (ii & 1) asm volatile("" ::: "memory");
            }
        }
        float mine = 0.f;
#pragma unroll
        for (int j = 0; j < 16; ++j) { const float s = wsum(acc[j]); mine = (lane == j) ? s : mine; }
        if (lane < 8) BETA[t * 8 + lane] = sigm(mine);
        else if (lane < 16) { const int h = lane - 8; GGv[t * 8 + h] = -expf(alog[h]) * softplusf(mine + dtb[h]); }
    }
    __syncthreads();
}

struct TileInfo { const bf16* A; int lda; const float* B; int ldb; int kmask; int row0; int col0; int aux; };

template <class TF, class EP>
__device__ __forceinline__ void ngemm(const Ctx& c, int ntiles, const TF& tf, const EP& ep, int K) {
    float* As = (float*)c.lds;
    float* Bs = As + 16 * 132;
    const int tid = c.tid, ty = tid >> 4, tx = tid & 15;
    const int ar = tid >> 2, ak = (tid & 3) * 4;
    const int bk = tid >> 5, bc = (tid & 31) * 4;
    for (int tile = blockIdx.x; tile < ntiles; tile += gridDim.x) {
        TileInfo ti; tf(tile, ti);
        float acc[4][8];
#pragma unroll
        for (int r = 0; r < 4; ++r)
#pragma unroll
            for (int j = 0; j < 8; ++j) acc[r][j] = 0.f;
        const bf16* ap = ti.A + (size_t)ar * ti.lda + ak;
        for (int k0 = 0; k0 < K; k0 += 16) {
            const uint2 av = *(const uint2*)(ap + k0);
            const float4 bv = *(const float4*)(ti.B + (size_t)((k0 + bk) & ti.kmask) * ti.ldb + bc);
            __syncthreads();
            As[(ak + 0) * 132 + ar] = bflo(av.x); As[(ak + 1) * 132 + ar] = bfhi(av.x);
            As[(ak + 2) * 132 + ar] = bflo(av.y); As[(ak + 3) * 132 + ar] = bfhi(av.y);
            *(float4*)(Bs + bk * 132 + bc) = bv;
            __syncthreads();
#pragma unroll
            for (int k = 0; k < 16; ++k) {
                const float4 a = *(const float4*)(As + k * 132 + ty * 4);
                const float4 b0 = *(const float4*)(Bs + k * 132 + tx * 8), b1 = *(const float4*)(Bs + k * 132 + tx * 8 + 4);
                const float av4[4] = {a.x, a.y, a.z, a.w};
                const float bv8[8] = {b0.x, b0.y, b0.z, b0.w, b1.x, b1.y, b1.z, b1.w};
#pragma unroll
                for (int r = 0; r < 4; ++r)
#pragma unroll
                    for (int j = 0; j < 8; ++j) acc[r][j] += av4[r] * bv8[j];
            }
        }
#pragma unroll
        for (int r = 0; r < 4; ++r) ep.store8(ti.row0 + ty * 4 + r, ti.col0 + tx * 8, acc[r], ti.aux);
    }
}

struct EpiInProj {
    float* GQKV; bf16* ZS; float* RKV; float* LIN; bf16* GATES;
    __device__ __forceinline__ void store8(int row, int col, const float (&v)[8], int) const {
        if (col < 3072) { float* p = GQKV + (size_t)row * 3072 + col; *(float4*)p = make_float4(v[0], v[1], v[2], v[3]); *(float4*)(p + 4) = make_float4(v[4], v[5], v[6], v[7]); }
        else if (col < 4096) { uint4 w; w.x = pk2(v[0] * fsigm(v[0]), v[1] * fsigm(v[1])); w.y = pk2(v[2] * fsigm(v[2]), v[3] * fsigm(v[3])); w.z = pk2(v[4] * fsigm(v[4]), v[5] * fsigm(v[5])); w.w = pk2(v[6] * fsigm(v[6]), v[7] * fsigm(v[7]));
            *(uint4*)(ZS + (size_t)row * 1024 + (col - 3072)) = w; }
        else if (col < 7168) { float* p = RKV + (size_t)row * 3072 + (col - 4096); *(float4*)p = make_float4(v[0], v[1], v[2], v[3]); *(float4*)(p + 4) = make_float4(v[4], v[5], v[6], v[7]); }
        else if (col < 7424) { float* p = LIN + (size_t)row * 256 + (col - 7168); *(float4*)p = make_float4(v[0], v[1], v[2], v[3]); *(float4*)(p + 4) = make_float4(v[4], v[5], v[6], v[7]); }
        else { uint4 w; w.x = pk2(fsigm(v[0]), fsigm(v[1])); w.y = pk2(fsigm(v[2]), fsigm(v[3])); w.z = pk2(fsigm(v[4]), fsigm(v[5])); w.w = pk2(fsigm(v[6]), fsigm(v[7]));
            *(uint4*)(GATES + (size_t)row * 2048 + (col - 7424)) = w; }
    }
};
struct EpiG2 {
    const bf16* GATES; bf16* G2;
    __device__ __forceinline__ void store8(int row, int col, const float (&v)[8], int) const {
        const uint4 g = *(const uint4*)(GATES + (size_t)row * 2048 + col);
        uint4 w; w.x = pk2(v[0] * bflo(g.x), v[1] * bfhi(g.x)); w.y = pk2(v[2] * bflo(g.y), v[3] * bfhi(g.y)); w.z = pk2(v[4] * bflo(g.z), v[5] * bfhi(g.z)); w.w = pk2(v[6] * bflo(g.w), v[7] * bfhi(g.w));
        *(uint4*)(G2 + (size_t)row * 2048 + col) = w;
    }
};
struct EpiX1 {
    const float* X; float* X1;
    __device__ __forceinline__ void store8(int row, int col, const float (&v)[8], int) const {
        const float* xp = X + (size_t)row * 1024 + col; float* op = X1 + (size_t)row * 1024 + col;
        const float4 a = *(const float4*)xp, b = *(const float4*)(xp + 4);
        *(float4*)op = make_float4(a.x + v[0], a.y + v[1], a.z + v[2], a.w + v[3]); *(float4*)(op + 4) = make_float4(b.x + v[4], b.y + v[5], b.z + v[6], b.w + v[7]);
    }
};
struct EpiAct {
    const float* BGU; bf16* ACT;
    __device__ __forceinline__ void store8(int row, int col, const float (&v)[8], int e) const {
        const float* bp = BGU + (size_t)e * 2048 + col;
        const float4 b0 = *(const float4*)bp, b1 = *(const float4*)(bp + 4);
        const float bb[8] = {b0.x, b0.y, b0.z, b0.w, b1.x, b1.y, b1.z, b1.w};
        float o[4];
#pragma unroll
        for (int p = 0; p < 4; ++p) { float glu = v[2 * p] + bb[2 * p], lin = v[2 * p + 1] + bb[2 * p + 1]; glu = fminf(glu, 7.f); lin = fminf(fmaxf(lin, -7.f), 7.f); o[p] = glu * fsigm(1.702f * glu) * (lin + 1.f); }
        uint2 w; w.x = pk2(o[0], o[1]); w.y = pk2(o[2], o[3]);
        *(uint2*)(ACT + (size_t)row * 1024 + (col >> 1)) = w;
    }
};
struct EpiYS {
    const float* BD; const float* SGATE; bf16* YS;
    __device__ __forceinline__ void store8(int row, int col, const float (&v)[8], int e) const {
        const float* bp = BD + (size_t)e * 1024 + col; const float g = SGATE[row];
        const float4 b0 = *(const float4*)bp, b1 = *(const float4*)(bp + 4);
        uint4 w; w.x = pk2((v[0] + b0.x) * g, (v[1] + b0.y) * g); w.y = pk2((v[2] + b0.z) * g, (v[3] + b0.w) * g); w.z = pk2((v[4] + b1.x) * g, (v[5] + b1.y) * g); w.w = pk2((v[6] + b1.z) * g, (v[7] + b1.w) * g);
        *(uint4*)(YS + (size_t)row * 1024 + col) = w;
    }
};

struct TfInProj { const bf16* HB; const float* W;
    __device__ __forceinline__ void operator()(int tile, TileInfo& ti) const { const int tm = tile / 74, tn = tile % 74; ti.A = HB + (size_t)tm * 128 * 1024; ti.lda = 1024; ti.col0 = tn * 128; ti.row0 = tm * 128;
        ti.B = W + ti.col0 + (ti.col0 >= 4096 ? 16 : 0); ti.ldb = NCOL_IN; ti.kmask = 0x7fffffff; ti.aux = 0; } };
struct TfG2 { const bf16* YA; const bf16* YB; const float* PA; const float* PB;
    __device__ __forceinline__ void operator()(int tile, TileInfo& ti) const { const int tm = tile / 16, tn = tile % 16; ti.A = (tn < 8 ? YA : YB) + (size_t)tm * 128 * 1024; ti.lda = 1024; ti.col0 = tn * 128; ti.row0 = tm * 128;
        ti.B = (tn < 8 ? PA + tn * 128 : PB + (tn - 8) * 128); ti.ldb = 1024; ti.kmask = 0x7fffffff; ti.aux = 0; } };
struct TfX1 { const bf16* G2; const float* WO;
    __device__ __forceinline__ void operator()(int tile, TileInfo& ti) const { const int tm = tile / 8, tn = tile % 8; ti.A = G2 + (size_t)tm * 128 * 2048; ti.lda = 2048; ti.col0 = tn * 128; ti.row0 = tm * 128;
        ti.B = WO + tn * 128; ti.ldb = 1024; ti.kmask = 1023; ti.aux = 0; } };
struct TfMoe { const bf16* A; const float* W; const int* TILE_E; int ntn; int ldb; size_t wstride;
    __device__ __forceinline__ void operator()(int tile, TileInfo& ti) const { const int mt = tile / ntn, tn = tile % ntn; const int e = TILE_E[mt >> 1]; ti.A = A + (size_t)mt * 128 * 1024; ti.lda = 1024; ti.col0 = tn * 128; ti.row0 = mt * 128;
        ti.B = W + (size_t)e * wstride + tn * 128; ti.ldb = ldb; ti.kmask = 0x7fffffff; ti.aux = e; } };


namespace pg8 {
typedef short bf16x8 __attribute__((ext_vector_type(8)));
typedef float f32x4 __attribute__((ext_vector_type(4)));
constexpr int BM = 256, BK = 64, HALF = 128, HTB = HALF * BK * 2, NXCD = 8, WGM = 8;
__host__ __device__ __forceinline__ int lds_byte(int r, int c) { const int st = (r >> 4) * 2 + (c >> 5), rr = r & 15, cc = c & 31, ob = rr * 64 + cc * 2; return st * 1024 + (ob ^ (((ob >> 9) & 1) << 5)); }
__host__ __device__ __forceinline__ void stage_rc(int b, int& R, int& C) { const int st = b / 1024, sb = b % 1024, swz = sb ^ (((sb >> 9) & 1) << 5); R = (st >> 1) * 16 + swz / 64; C = (st & 1) * 32 + (swz % 64) / 2; }
__host__ __device__ __forceinline__ int perm32(int rho) { const int n = rho >> 4, i = rho & 15; return 8 * (i >> 2) + 4 * n + (i & 3); }
struct Unit { const char* a; const char* b; int row0, col0, aux; };
__device__ __forceinline__ void tile_order(int L, int nM, int nN, int& pm, int& pn) {
    const int nwg = nM * nN; int wgid = L; { const int q = nwg / NXCD, r = nwg % NXCD, xcd = wgid % NXCD, off = wgid / NXCD; wgid = (xcd < r ? xcd * (q + 1) : r * (q + 1) + (xcd - r) * q) + off; }
    const int nig = WGM * nN, gid = wgid / nig, fm = gid * WGM, gsz = (nM - fm) < WGM ? (nM - fm) : WGM;
    pm = fm + ((wgid % nig) % gsz); pn = (wgid % nig) / gsz;
}
template <class Epi>
__device__ __forceinline__ void epi_apply(const Epi& E, const f32x4 (&acc)[2][2][4][2], const Unit& u, int wr, int wc, int fr, int fq) {
#pragma unroll
    for (int ai = 0; ai < 2; ++ai)
#pragma unroll
        for (int m = 0; m < 4; ++m)
#pragma unroll
            for (int bj = 0; bj < 2; ++bj) {
                const f32x4 x0 = acc[ai][bj][m][0], x1 = acc[ai][bj][m][1];
                const float v[8] = {x0[0], x0[1], x0[2], x0[3], x1[0], x1[1], x1[2], x1[3]};
                E.store8(u.row0 + ai * HALF + wr * 64 + m * 16 + fr, u.col0 + bj * HALF + wc * 32 + 8 * fq, v, u.aux);
                asm volatile("" ::: "memory");
            }
}
template <class Epi, class Sched>
__device__ __forceinline__ void gemm_phase(LAS unsigned char* lds, const int K_, const Sched& S, const Epi& E, const int tid) {
    int K = K_; asm volatile("" : "+s"(K));
    const int wid = __builtin_amdgcn_readfirstlane(tid >> 6), lane = tid & 63, wr = wid >> 2, wc = wid & 3, fr = lane & 15, fq = lane >> 4;
    const int nt = K / BK;
    unsigned voffA[2], voffB[2];
#pragma unroll
    for (int i = 0; i < 2; ++i) { int R, C; stage_rc(tid * 16 + i * 8192, R, C); const int Rb = (R & ~31) + perm32(R & 31);
        voffA[i] = (unsigned)(R * K + C) * 2u; voffB[i] = (unsigned)(Rb * K + C) * 2u; }
    const size_t kstep = (size_t)(BK * 2);
    const size_t hstep = (size_t)HALF * K * 2;
    const unsigned ldsw = (unsigned)wid * 1024u;
    const int aoff = lds_byte(wr * 64 + fr, fq * 8), boff = lds_byte(wc * 32 + fr, fq * 8);
#define PG8_SA(b, h) (((b) * 2 + (h)) * HTB)
#define PG8_SB(b, h) ((4 + (b) * 2 + (h)) * HTB)
#define PG8_STAGE(bufoff, gbase, voff) do { _Pragma("unroll") for (int _i = 0; _i < 2; ++_i) \
        __builtin_amdgcn_global_load_lds((const unsigned*)((const char*)(gbase) + (voff)[_i]), (LAS unsigned*)(lds + (bufoff) + ldsw + _i * 8192), 16, 0, 0); } while (0)
#define PG8_LDA(dst, b, h) do { _Pragma("unroll") for (int m = 0; m < 4; ++m) _Pragma("unroll") for (int k = 0; k < 2; ++k) dst[m][k] = *(const LAS bf16x8*)(lds + PG8_SA(b, h) + aoff + m * 2048 + k * 1024); } while (0)
#define PG8_LDB(dst, b, h) do { _Pragma("unroll") for (int n = 0; n < 2; ++n) _Pragma("unroll") for (int k = 0; k < 2; ++k) dst[n][k] = *(const LAS bf16x8*)(lds + PG8_SB(b, h) + boff + n * 2048 + k * 1024); } while (0)
#define PG8_MMA(ai, bj, At, Bt) do { __builtin_amdgcn_s_setprio(1); _Pragma("unroll") for (int m = 0; m < 4; ++m) _Pragma("unroll") for (int n = 0; n < 2; ++n) _Pragma("unroll") for (int k = 0; k < 2; ++k) \
        acc[ai][bj][m][n] = __builtin_amdgcn_mfma_f32_16x16x32_bf16(Bt[n][k], At[m][k], acc[ai][bj][m][n], 0, 0, 0); __builtin_amdgcn_s_setprio(0); } while (0)
#define PG8_WAIT_V(n) asm volatile("s_waitcnt vmcnt(" #n ")" ::: "memory")
#define PG8_WAIT_L(n) asm volatile("s_waitcnt lgkmcnt(" #n ")" ::: "memory")
#define PG8_BAR __builtin_amdgcn_s_barrier()
#define PG8_SCHED __builtin_amdgcn_sched_barrier(0)
    Unit cur, nxt; int ui = 0;
    if (!S.next(0, cur)) return;
    f32x4 acc[2][2][4][2];
#pragma unroll
    for (int a = 0; a < 2; ++a)
#pragma unroll
        for (int b = 0; b < 2; ++b)
#pragma unroll
            for (int m = 0; m < 4; ++m)
#pragma unroll
                for (int n = 0; n < 2; ++n) acc[a][b][m][n] = (f32x4){0.f, 0.f, 0.f, 0.f};
    bf16x8 At[4][2], B0[2][2], B1[2][2];
    const char* cA = cur.a; const char* cB = cur.b;
    PG8_STAGE(PG8_SB(0, 0), cB, voffB); PG8_STAGE(PG8_SA(0, 0), cA, voffA); PG8_STAGE(PG8_SB(0, 1), cB + hstep, voffB); PG8_STAGE(PG8_SA(0, 1), cA + hstep, voffA);
    if (wr == 1) PG8_BAR;
    PG8_WAIT_V(4); PG8_BAR;
    PG8_STAGE(PG8_SB(1, 0), cB + kstep, voffB); PG8_STAGE(PG8_SA(1, 0), cA + kstep, voffA); PG8_STAGE(PG8_SB(1, 1), cB + hstep + kstep, voffB);
    PG8_WAIT_V(6); PG8_BAR;
    for (;;) {
        const bool has_next = S.next(ui + 1, nxt);
        const char* nA = has_next ? nxt.a : cA; const char* nB = has_next ? nxt.b : cB;
#pragma unroll 1
        for (int t = 0; t < nt; t += 2) {
            const bool last = (t == nt - 2);
            const char* a1 = cA + (size_t)(t + 1) * kstep;
            const char* a2 = last ? nA : cA + (size_t)(t + 2) * kstep; const char* b2 = last ? nB : cB + (size_t)(t + 2) * kstep;
            const char* a3 = a2 + kstep; const char* b3 = b2 + kstep;
            PG8_LDB(B0, 0, 0); PG8_SCHED; PG8_LDA(At, 0, 0); PG8_STAGE(PG8_SA(1, 1), a1 + hstep, voffA);
            PG8_WAIT_L(8); PG8_BAR; PG8_WAIT_L(0); PG8_MMA(0, 0, At, B0); PG8_BAR; PG8_SCHED;
            PG8_LDB(B1, 0, 1); PG8_STAGE(PG8_SB(0, 0), b2, voffB);
            PG8_BAR; PG8_WAIT_L(0); PG8_MMA(0, 1, At, B1); PG8_BAR;
            PG8_LDA(At, 0, 1); PG8_STAGE(PG8_SA(0, 0), a2, voffA);
            PG8_BAR; PG8_WAIT_L(0); PG8_MMA(1, 0, At, B0); PG8_BAR; PG8_SCHED;
            PG8_STAGE(PG8_SB(0, 1), b2 + hstep, voffB);
            PG8_WAIT_V(6); PG8_BAR; PG8_MMA(1, 1, At, B1); PG8_BAR;
            PG8_LDB(B0, 1, 0); PG8_SCHED; PG8_LDA(At, 1, 0); PG8_STAGE(PG8_SA(0, 1), a2 + hstep, voffA);
            PG8_WAIT_L(8); PG8_BAR; PG8_WAIT_L(0); PG8_MMA(0, 0, At, B0); PG8_BAR; PG8_SCHED;
            PG8_LDB(B1, 1, 1); PG8_STAGE(PG8_SB(1, 0), b3, voffB);
            PG8_BAR; PG8_WAIT_L(0); PG8_MMA(0, 1, At, B1); PG8_BAR;
            PG8_LDA(At, 1, 1); PG8_STAGE(PG8_SA(1, 0), a3, voffA);
            PG8_BAR; PG8_WAIT_L(0); PG8_MMA(1, 0, At, B0); PG8_BAR; PG8_SCHED;
            PG8_STAGE(PG8_SB(1, 1), b3 + hstep, voffB);
            PG8_WAIT_V(6); PG8_BAR; PG8_MMA(1, 1, At, B1); PG8_BAR;
        }
        epi_apply(E, acc, cur, wr, wc, fr, fq);
        if (!has_next) break;
#pragma unroll
        for (int a = 0; a < 2; ++a)
#pragma unroll
            for (int b = 0; b < 2; ++b)
#pragma unroll
                for (int m = 0; m < 4; ++m)
#pragma unroll
                    for (int n = 0; n < 2; ++n) acc[a][b][m][n] = (f32x4){0.f, 0.f, 0.f, 0.f};
        cur = nxt; cA = nA; cB = nB; ++ui;
    }
    PG8_WAIT_V(0);
    if (wr == 0) PG8_BAR;
    PG8_BAR;
#undef PG8_SA
#undef PG8_SB
#undef PG8_STAGE
#undef PG8_LDA
#undef PG8_LDB
#undef PG8_MMA
#undef PG8_WAIT_V
#undef PG8_WAIT_L
#undef PG8_BAR
#undef PG8_SCHED
}
}

struct SchedInProj { const char* A; const char* Bt; int G, c;
    __device__ __forceinline__ bool next(int i, pg8::Unit& u) const { const int L = i * G + c; if (L >= 64 * 37) return false; int pm, pn; pg8::tile_order(L, 64, 37, pm, pn);
        u.a = A + (size_t)pm * (256 * 1024 * 2); u.b = Bt + (size_t)pn * (256 * 1024 * 2); u.row0 = pm * 256; u.col0 = pn * 256; u.aux = 0; return true; } };

struct WJob { const float* src; int ld_src; int K; int ncols; bf16* dst; int ld_dst; int nb; size_t sstride, dstride; };
__device__ __forceinline__ void wconv_job(const Ctx& c, const WJob& j) {
    float* tl = (float*)c.lds;
    const int ntk = j.K >> 6, ntn = j.ncols >> 6, per = ntk * ntn, ntiles = per * j.nb;
    const int rk = c.tid >> 3, rseg = (c.tid & 7) * 8;
    for (int tile = blockIdx.x; tile < ntiles; tile += gridDim.x) {
        const int bi = tile / per, tt = tile % per, tk = tt % ntk, tn = tt / ntk;
        const float* sp = j.src + (size_t)bi * j.sstride + (size_t)(tk * 64 + rk) * j.ld_src + tn * 64 + rseg;
        const float4 a = *(const float4*)sp, b = *(const float4*)(sp + 4);
        __syncthreads();
        float* row = tl + rk * 65 + rseg;
        row[0] = a.x; row[1] = a.y; row[2] = a.z; row[3] = a.w; row[4] = b.x; row[5] = b.y; row[6] = b.z; row[7] = b.w;
        __syncthreads();
        const float* col = tl + rseg * 65 + rk;
        uint4 w; w.x = pk2(col[0], col[65]); w.y = pk2(col[130], col[195]); w.z = pk2(col[260], col[325]); w.w = pk2(col[390], col[455]);
        *(uint4*)(j.dst + (size_t)bi * j.dstride + (size_t)(tn * 64 + rk) * j.ld_dst + tk * 64 + rseg) = w;
    }
}
struct SchedG2 { const char* YA; const char* YB; const char* Bt; int G, c;
    __device__ __forceinline__ bool next(int i, pg8::Unit& u) const { const int L = i * G + c; if (L >= 64 * 8) return false; int pm, pn; pg8::tile_order(L, 64, 8, pm, pn);
        u.a = (pn < 4 ? YA : YB) + (size_t)pm * (256 * 1024 * 2); u.b = Bt + (size_t)pn * (256 * 1024 * 2); u.row0 = pm * 256; u.col0 = pn * 256; u.aux = 0; return true; } };
struct SchedX1 { const char* A; const char* Bt; int G, c;
    __device__ __forceinline__ bool next(int i, pg8::Unit& u) const { const int L = i * G + c; if (L >= 64 * 4) return false; int pm, pn; pg8::tile_order(L, 64, 4, pm, pn);
        u.a = A + (size_t)pm * (256 * 2048 * 2); u.b = Bt + (size_t)pn * (256 * 2048 * 2); u.row0 = pm * 256; u.col0 = pn * 256; u.aux = 0; return true; } };
struct SchedMoe { const char* A; const char* Bt; const int* TILE_E; int NT, NPN, G, c;
    __device__ __forceinline__ bool next(int i, pg8::Unit& u) const { const int L = i * G + c; if (L >= NT * NPN) return false; const int tile = L / NPN, pn = L % NPN; const int e = TILE_E[tile];
        u.a = A + (size_t)tile * (256 * 1024 * 2); u.b = Bt + (size_t)(e * NPN + pn) * (256 * 1024 * 2); u.row0 = tile * 256; u.col0 = pn * 256; u.aux = e; return true; } };


struct EpiLora {
    const float* w0; const float* a0; float* LW; float* AA; bf16* GGR;
    __device__ __forceinline__ void store8(int row, int col, const float (&v)[8], int) const {
        if (col < 1024) { float o[8];
#pragma unroll
            for (int i = 0; i < 8; ++i) o[i] = -0.6065306597126334f * fsigm(w0[col + i] + v[i]);
            float* p = LW + (size_t)row * 1024 + col; *(float4*)p = make_float4(o[0], o[1], o[2], o[3]); *(float4*)(p + 4) = make_float4(o[4], o[5], o[6], o[7]); }
        else if (col < 2048) { const int cc = col - 1024; float o[8];
#pragma unroll
            for (int i = 0; i < 8; ++i) o[i] = fsigm(a0[cc + i] + v[i]);
            float* p = AA + (size_t)row * 1024 + cc; *(float4*)p = make_float4(o[0], o[1], o[2], o[3]); *(float4*)(p + 4) = make_float4(o[4], o[5], o[6], o[7]); }
        else { uint4 w; w.x = pk2(v[0], v[1]); w.y = pk2(v[2], v[3]); w.z = pk2(v[4], v[5]); w.w = pk2(v[6], v[7]); *(uint4*)(GGR + (size_t)row * 1024 + (col - 2048)) = w; }
    }
};
struct SchedLora { const char* A; const char* Bt; int G, c;
    __device__ __forceinline__ bool next(int i, pg8::Unit& u) const { const int L = i * G + c; if (L >= 64 * 12) return false; int pm, pn; pg8::tile_order(L, 64, 12, pm, pn);
        u.a = A + (size_t)pm * (256 * 256 * 2); u.b = Bt + (size_t)pn * (256 * 256 * 2); u.row0 = pm * 256; u.col0 = pn * 256; u.aux = 0; return true; } };
__device__ __forceinline__ void lora_zero(const Ctx& c) {
    uint4* LT = c.ws<uint4>(WS_LORA_T);
    for (size_t idx = c.gtid; idx < (size_t)3072 * 32; idx += c.nthreads) {
        const int row = (int)(idx >> 5), k8 = (int)(idx & 31) * 8;
        const bool data = row < 1024 ? (k8 < 64) : (row < 2048 ? (k8 >= 64 && k8 < 128) : (k8 >= 128));
        if (!data) LT[idx] = make_uint4(0, 0, 0, 0);
    }
}

__device__ __forceinline__ void ph_gconv(const Ctx& c) {
    const float* GQKV = c.ws<float>(WS_GQKV); float* QKVC = c.ws<float>(WS_QKVC); const float* cw = c.P.in[I_GDN_CONV];
    for (size_t idx = c.gtid; idx < (size_t)T * 768; idx += c.nthreads) {
        const int t = (int)(idx / 768), c4 = (int)(idx % 768) * 4, s = t & (SEQ - 1);
        float4 a = make_float4(0.f, 0.f, 0.f, 0.f);
#pragma unroll
        for (int j = 0; j < 4; ++j) {
            if (s - 3 + j >= 0) { const float4 xv = *(const float4*)(GQKV + (size_t)(t - 3 + j) * 3072 + c4); const float4 w = *(const float4*)(cw + j * 3072 + c4);
                a.x += w.x * xv.x; a.y += w.y * xv.y; a.z += w.z * xv.z; a.w += w.w * xv.w; }
        }
        a.x *= sigm(a.x); a.y *= sigm(a.y); a.z *= sigm(a.z); a.w *= sigm(a.w);
        *(float4*)(QKVC + (size_t)t * 3072 + c4) = a;
    }
}
__device__ __forceinline__ void ph_gl2(const Ctx& c) {
    float* QKVC = c.ws<float>(WS_QKVC);
    for (int it = c.gwave; it < T * 16; it += c.nwaves) {
        const int t = it >> 4, vec = it & 15;
        float2* p = (float2*)(QKVC + (size_t)t * 3072 + vec * 128) + c.lane;
        float2 v = *p; const float ss = wsum(v.x * v.x + v.y * v.y);
        const float sc = rsqrtf(ss + 1e-6f) * (vec < 8 ? 0.08838834764831845f : 1.f);
        v.x *= sc; v.y *= sc; *p = v;
    }
}
__device__ __forceinline__ void ph_gscan(const Ctx& c) {
    if (c.wave >= 4 || blockIdx.x >= 64) return;
    const float* QKVC = c.ws<float>(WS_QKVC); const float* BETA = c.ws<float>(WS_BETA); const float* GGv = c.ws<float>(WS_GG); float* OG = c.ws<float>(WS_OG);
    const int w = blockIdx.x * 4 + c.wave, pair = w >> 3, b = pair >> 3, h = pair & 7, i = (w & 7) * 16 + (c.lane >> 2), qt = c.lane & 3;
    float s[32];
#pragma unroll
    for (int k = 0; k < 32; ++k) s[k] = 0.f;
    for (int t = 0; t < SEQ; ++t) {
        const size_t tok = (size_t)b * SEQ + t;
        const float* qp = QKVC + tok * 3072 + h * 128 + qt * 32; const float* kp = qp + 1024; const float* vp = QKVC + tok * 3072 + 2048 + h * 128;
        const float eg = expf(GGv[tok * 8 + h]), beta = BETA[tok * 8 + h];
        float kv[32];
#pragma unroll
        for (int q = 0; q < 8; ++q) { const float4 x = *(const float4*)(kp + q * 4); kv[4 * q] = x.x; kv[4 * q + 1] = x.y; kv[4 * q + 2] = x.z; kv[4 * q + 3] = x.w; }
        float d = 0.f;
#pragma unroll
        for (int k = 0; k < 32; ++k) { s[k] *= eg; d += s[k] * kv[k]; }
        d += __shfl_xor(d, 1); d += __shfl_xor(d, 2);
        const float vn = beta * (vp[i] - d);
        float o = 0.f;
#pragma unroll
        for (int q = 0; q < 8; ++q) { const float4 y = *(const float4*)(qp + q * 4);
            s[4 * q] += vn * kv[4 * q]; o += s[4 * q] * y.x; s[4 * q + 1] += vn * kv[4 * q + 1]; o += s[4 * q + 1] * y.y;
            s[4 * q + 2] += vn * kv[4 * q + 2]; o += s[4 * q + 2] * y.z; s[4 * q + 3] += vn * kv[4 * q + 3]; o += s[4 * q + 3] * y.w; }
        o += __shfl_xor(o, 1); o += __shfl_xor(o, 2);
        if (qt == 0) OG[tok * 1024 + h * 128 + i] = o;
    }
}

__device__ __forceinline__ void ph_loraprep(const Ctx& c) {
    const float* LIN = c.ws<float>(WS_LIN); bf16* AL = c.ws<bf16>(WS_ALORA); const float* mu = c.P.in[I_MU];
    for (size_t idx = c.gtid; idx < (size_t)T * 256; idx += c.nthreads) {
        const int t = (int)(idx >> 8), cc = (int)(idx & 255);
        const float x = LIN[idx], xp = (t & (SEQ - 1)) ? LIN[idx - 256] : 0.f;
        const float xs = x + (xp - x) * mu[3072 + cc];
        const float r = cc < 64 ? tanhf(xs) : (cc < 128 ? xs : sigm(xs));
        AL[idx] = f2bf(r);
    }
}
__device__ __forceinline__ void ph_lora_naive(const Ctx& c) {
    const bf16* AL = c.ws<bf16>(WS_ALORA); float* LW = c.ws<float>(WS_LW); float* AA = c.ws<float>(WS_AA); bf16* GGR = c.ws<bf16>(WS_GGR);
    const float* w0 = c.P.in[I_W0]; const float* w2 = c.P.in[I_W2]; const float* a0 = c.P.in[I_A0]; const float* a2 = c.P.in[I_A2]; const float* g2 = c.P.in[I_G2];
    for (size_t idx = c.gtid; idx < (size_t)T * 1024; idx += c.nthreads) {
        const int t = (int)(idx >> 10), cc = (int)(idx & 1023);
        const bf16* al = AL + (size_t)t * 256;
        float d1 = 0.f, d2 = 0.f, d3 = 0.f;
        for (int j = 0; j < 64; ++j) { d1 += bf2f(al[j]) * w2[j * 1024 + cc]; d2 += bf2f(al[64 + j]) * a2[j * 1024 + cc]; }
        for (int j = 0; j < 128; ++j) d3 += bf2f(al[128 + j]) * g2[j * 1024 + cc];
        const float wlog = -softplusf(-(w0[cc] + d1)) - 0.5f;
        LW[idx] = -expf(wlog);
        AA[idx] = sigm(a0[cc] + d2);
        GGR[idx] = f2bf(d3);
    }
}
__device__ __forceinline__ void ph_rprep(const Ctx& c) {
    const float* RKV = c.ws<float>(WS_RKV); const float* AA = c.ws<float>(WS_AA); const float* LW = c.ws<float>(WS_LW);
    float* RP = c.ws<float>(WS_RP); float* KF = c.ws<float>(WS_KF); float* KKN = c.ws<float>(WS_KKN); float* DEC = c.ws<float>(WS_DEC); bf16* VP = c.ws<bf16>(WS_VP); float* SC = c.ws<float>(WS_SC);
    const float* mu = c.P.in[I_MU]; const float* k_k = c.P.in[I_KK]; const float* k_a = c.P.in[I_KA]; const float* r_k = c.P.in[I_RK];
    for (int it = c.gwave; it < T * 16; it += c.nwaves) {
        const int t = it >> 4, h = it & 15, cc = h * 64 + c.lane;
        const bool first = (t & (SEQ - 1)) == 0;
        const float* cur = RKV + (size_t)t * 3072; const float* prv = cur - 3072;
        const float r0 = cur[cc], k0 = cur[1024 + cc], v0 = cur[2048 + cc];
        const float rp = first ? 0.f : prv[cc], kp = first ? 0.f : prv[1024 + cc], vp = first ? 0.f : prv[2048 + cc];
        const float r = r0 + (rp - r0) * mu[cc], k = k0 + (kp - k0) * mu[1024 + cc], v = v0 + (vp - v0) * mu[2048 + cc];
        const float kkv = k * k_k[cc];
        const float ss = wsum(kkv * kkv);
        const float kk = kkv * rsqrtf(ss + 1e-6f);
        const float aa = AA[(size_t)t * 1024 + cc];
        const float kf = k * (1.f + (aa - 1.f) * k_a[cc]);
        const float sc = wsum(r * kf * r_k[cc]);
        const size_t o = (size_t)t * 1024 + cc;
        RP[o] = r; KF[o] = kf; KKN[o] = kk; DEC[o] = expf(LW[o]); VP[o] = f2bf(v);
        if (c.lane == 0) SC[t * 16 + h] = sc;
    }
}
__device__ __forceinline__ void ph_rscan(const Ctx& c) {
    if (c.wave != 0 || blockIdx.x >= 64) return;
    const float* RP = c.ws<float>(WS_RP); const float* KF = c.ws<float>(WS_KF); const float* KKN = c.ws<float>(WS_KKN); const float* DEC = c.ws<float>(WS_DEC); const float* AA = c.ws<float>(WS_AA);
    const bf16* VP = c.ws<bf16>(WS_VP); float* ORW = c.ws<float>(WS_ORW);
    const int b = blockIdx.x >> 4, h = blockIdx.x & 15, i = c.lane;
    float s[64];
#pragma unroll
    for (int k = 0; k < 64; ++k) s[k] = 0.f;
    for (int t = 0; t < SEQ; ++t) {
        const size_t o = ((size_t)b * SEQ + t) * 1024 + h * 64;
        const float* rp = RP + o; const float* kf = KF + o; const float* kk = KKN + o; const float* dc = DEC + o; const float* aa = AA + o;
        float sk = 0.f;
#pragma unroll
        for (int ch = 0; ch < 4; ++ch) {
            float kv[16];
#pragma unroll
            for (int q = 0; q < 4; ++q) { const float4 x = *(const float4*)(kk + ch * 16 + q * 4); kv[4 * q] = x.x; kv[4 * q + 1] = x.y; kv[4 * q + 2] = x.z; kv[4 * q + 3] = x.w; }
#pragma unroll
            for (int k = 0; k < 16; ++k) sk += s[ch * 16 + k] * kv[k];
            asm volatile("" ::: "memory");
        }
        const float vi = bf2f(VP[o + i]);
        float out = 0.f;
#pragma unroll
        for (int ch = 0; ch < 16; ++ch) {
            const float4 k4 = *(const float4*)(kk + ch * 4), d4 = *(const float4*)(dc + ch * 4), a4 = *(const float4*)(aa + ch * 4), f4 = *(const float4*)(kf + ch * 4), r4 = *(const float4*)(rp + ch * 4);
            s[ch * 4 + 0] = s[ch * 4 + 0] * d4.x - sk * (k4.x * a4.x) + vi * f4.x; out += s[ch * 4 + 0] * r4.x;
            s[ch * 4 + 1] = s[ch * 4 + 1] * d4.y - sk * (k4.y * a4.y) + vi * f4.y; out += s[ch * 4 + 1] * r4.y;
            s[ch * 4 + 2] = s[ch * 4 + 2] * d4.z - sk * (k4.z * a4.z) + vi * f4.z; out += s[ch * 4 + 2] * r4.z;
            s[ch * 4 + 3] = s[ch * 4 + 3] * d4.w - sk * (k4.w * a4.w) + vi * f4.w; out += s[ch * 4 + 3] * r4.w;
            if ((ch & 1) == 1) asm volatile("" ::: "memory");
        }
        ORW[o + i] = out;
    }
}

__device__ __forceinline__ void ph_post(const Ctx& c) {
    const float* OG = c.ws<float>(WS_OG); const float* ORW = c.ws<float>(WS_ORW); const bf16* ZS = c.ws<bf16>(WS_ZS); const bf16* VP = c.ws<bf16>(WS_VP); const bf16* GGR = c.ws<bf16>(WS_GGR);
    const float* SC = c.ws<float>(WS_SC); bf16* YA = c.ws<bf16>(WS_YA); bf16* YB = c.ws<bf16>(WS_YB);
    const float* gnw = c.P.in[I_GDN_NORM]; const float* lnw = c.P.in[I_LNW]; const float* lnb = c.P.in[I_LNB];
    const int lane = c.lane, c0 = lane * 16;
    for (int t = c.gwave; t < T; t += c.nwaves) {
        {
            float o[16];
#pragma unroll
            for (int q = 0; q < 4; ++q) { const float4 v = *(const float4*)(OG + (size_t)t * 1024 + c0 + 4 * q); o[4 * q] = v.x; o[4 * q + 1] = v.y; o[4 * q + 2] = v.z; o[4 * q + 3] = v.w; }
            float ss = 0.f;
#pragma unroll
            for (int j = 0; j < 16; ++j) ss += o[j] * o[j];
            ss += __shfl_xor(ss, 1); ss += __shfl_xor(ss, 2); ss += __shfl_xor(ss, 4);
            const float rstd = rsqrtf(ss * (1.f / 128.f) + 1e-6f);
            const uint4 z0 = *(const uint4*)(ZS + (size_t)t * 1024 + c0), z1 = *(const uint4*)(ZS + (size_t)t * 1024 + c0 + 8);
            const unsigned zz[8] = {z0.x, z0.y, z0.z, z0.w, z1.x, z1.y, z1.z, z1.w};
            unsigned w[8];
#pragma unroll
            for (int j = 0; j < 8; ++j) { const int cc = (c0 + 2 * j) & 127; w[j] = pk2(o[2 * j] * rstd * gnw[cc] * bflo(zz[j]), o[2 * j + 1] * rstd * gnw[cc + 1] * bfhi(zz[j])); }
            *(uint4*)(YA + (size_t)t * 1024 + c0) = make_uint4(w[0], w[1], w[2], w[3]); *(uint4*)(YA + (size_t)t * 1024 + c0 + 8) = make_uint4(w[4], w[5], w[6], w[7]);
        }
        {
            float o[16];
#pragma unroll
            for (int q = 0; q < 4; ++q) { const float4 v = *(const float4*)(ORW + (size_t)t * 1024 + c0 + 4 * q); o[4 * q] = v.x; o[4 * q + 1] = v.y; o[4 * q + 2] = v.z; o[4 * q + 3] = v.w; }
            float sm = 0.f;
#pragma unroll
            for (int j = 0; j < 16; ++j) sm += o[j];
            sm += __shfl_xor(sm, 1); sm += __shfl_xor(sm, 2);
            const float mean = sm * (1.f / 64.f);
            float sv = 0.f;
#pragma unroll
            for (int j = 0; j < 16; ++j) { const float dd = o[j] - mean; sv += dd * dd; }
            sv += __shfl_xor(sv, 1); sv += __shfl_xor(sv, 2);
            const float rstd = rsqrtf(sv * (1.f / 64.f) + 64e-5f);
            const float sc = SC[t * 16 + (c0 >> 6)];
            const uint4 v0 = *(const uint4*)(VP + (size_t)t * 1024 + c0), v1 = *(const uint4*)(VP + (size_t)t * 1024 + c0 + 8);
            const uint4 g0 = *(const uint4*)(GGR + (size_t)t * 1024 + c0), g1 = *(const uint4*)(GGR + (size_t)t * 1024 + c0 + 8);
            const unsigned vv[8] = {v0.x, v0.y, v0.z, v0.w, v1.x, v1.y, v1.z, v1.w};
            const unsigned gg[8] = {g0.x, g0.y, g0.z, g0.w, g1.x, g1.y, g1.z, g1.w};
            unsigned w[8];
#pragma unroll
            for (int j = 0; j < 8; ++j) { const int cc = c0 + 2 * j;
                const float y0 = ((o[2 * j] - mean) * rstd * lnw[cc] + lnb[cc] + sc * bflo(vv[j])) * bflo(gg[j]);
                const float y1 = ((o[2 * j + 1] - mean) * rstd * lnw[cc + 1] + lnb[cc + 1] + sc * bfhi(vv[j])) * bfhi(gg[j]);
                w[j] = pk2(y0, y1); }
            *(uint4*)(YB + (size_t)t * 1024 + c0) = make_uint4(w[0], w[1], w[2], w[3]); *(uint4*)(YB + (size_t)t * 1024 + c0 + 8) = make_uint4(w[4], w[5], w[6], w[7]);
        }
    }
}

__device__ __forceinline__ void ph_router(const Ctx& c) {
    const float* X1 = c.ws<float>(WS_X1); const float* nw = c.P.in[I_NORM_FFN]; const float* rw = c.P.in[I_ROUTER_W]; const float* rb = c.P.in[I_ROUTER_B];
    bf16* H2 = c.ws<bf16>(WS_H2); int* TE = c.ws<int>(WS_TE); float* TG = c.ws<float>(WS_TG); int* TP = c.ws<int>(WS_TP); unsigned* CNT = c.ws<unsigned>(WS_CTL) + CW_CNT;
    const int lane = c.lane;
    float4* tab = (float4*)c.lds;
    __syncthreads();
    for (int i = c.tid; i < 8192; i += NTHREADS) { const int k = i >> 3; tab[((k & 3) * 256 + (k >> 2)) * 9 + (i & 7)] = ((const float4*)rw)[i]; }
    __syncthreads();
    for (int t = c.gwave; t < T; t += c.nwaves) {
        float4 v[4]; float ss = 0.f;
#pragma unroll
        for (int i = 0; i < 4; ++i) { v[i] = ((const float4*)(X1 + (size_t)t * D))[lane + 64 * i]; ss += v[i].x * v[i].x + v[i].y * v[i].y + v[i].z * v[i].z + v[i].w * v[i].w; }
        ss = wsum(ss);
        const float rstd = rsqrtf(ss * (1.f / 1024.f) + 1e-6f);
        float lg[32];
#pragma unroll
        for (int j = 0; j < 32; ++j) lg[j] = 0.f;
#pragma unroll
        for (int i = 0; i < 4; ++i) {
            const float4 w4 = ((const float4*)nw)[lane + 64 * i];
            const float h[4] = {v[i].x * rstd * w4.x, v[i].y * rstd * w4.y, v[i].z * rstd * w4.z, v[i].w * rstd * w4.w};
            uint2 st; st.x = pk2(h[0], h[1]); st.y = pk2(h[2], h[3]);
            *(uint2*)(H2 + (size_t)t * D + 4 * (lane + 64 * i)) = st;
#pragma unroll
            for (int ii = 0; ii < 4; ++ii) {
                const float4* wr = tab + (size_t)(ii * 256 + lane + 64 * i) * 9;
#pragma unroll
                for (int q = 0; q < 8; ++q) { const float4 w = wr[q]; lg[4 * q] += h[ii] * w.x; lg[4 * q + 1] += h[ii] * w.y; lg[4 * q + 2] += h[ii] * w.z; lg[4 * q + 3] += h[ii] * w.w; }
                asm volatile("" ::: "memory");
            }
        }
#pragma unroll
        for (int j = 0; j < 32; ++j) lg[j] = wsum(lg[j]) + rb[j];
        int e0 = 0, e1 = 0, e2 = 0, e3 = 0; float v0 = -3e38f, v1 = -3e38f, v2 = -3e38f, v3 = -3e38f;
#pragma unroll
        for (int j = 0; j < 32; ++j) if (lg[j] > v0) { v0 = lg[j]; e0 = j; }
#pragma unroll
        for (int j = 0; j < 32; ++j) if (j != e0 && lg[j] > v1) { v1 = lg[j]; e1 = j; }
#pragma unroll
        for (int j = 0; j < 32; ++j) if (j != e0 && j != e1 && lg[j] > v2) { v2 = lg[j]; e2 = j; }
#pragma unroll
        for (int j = 0; j < 32; ++j) if (j != e0 && j != e1 && j != e2 && lg[j] > v3) { v3 = lg[j]; e3 = j; }
        const float x1 = expf(v1 - v0), x2 = expf(v2 - v0), x3 = expf(v3 - v0), inv = 1.f / (1.f + x1 + x2 + x3);
        if (lane < 4) {
            const int me = lane == 0 ? e0 : (lane == 1 ? e1 : (lane == 2 ? e2 : e3));
            const float mg = (lane == 0 ? 1.f : (lane == 1 ? x1 : (lane == 2 ? x2 : x3))) * inv;
            const unsigned pos = atomicAdd(&CNT[me], 1u);
            TE[t * 4 + lane] = me; TG[t * 4 + lane] = mg; TP[t * 4 + lane] = (int)pos;
        }
    }
    __syncthreads();
}

__device__ __forceinline__ void ph_dispatch(const Ctx& c) {
    int* tb = (int*)c.lds;
    const unsigned* CNT = c.ws<unsigned>(WS_CTL) + CW_CNT;
    int* TILE_E = c.ws<int>(WS_TILE_E); int* NT = c.ws<int>(WS_NT);
    const int* TE = c.ws<int>(WS_TE); const float* TG = c.ws<float>(WS_TG); const int* TP = c.ws<int>(WS_TP); int* TSLOT = c.ws<int>(WS_TSLOT);
    float* SGATE = c.ws<float>(WS_SGATE); const bf16* H2 = c.ws<bf16>(WS_H2); bf16* XB = c.ws<bf16>(WS_XB);
    if (c.tid == 0) { int acc = 0; for (int e = 0; e < NEXP; ++e) { const int n = (int)__hip_atomic_load(&CNT[e], __ATOMIC_RELAXED, __HIP_MEMORY_SCOPE_AGENT); tb[e] = acc; tb[64 + e] = n; acc += (n + 255) >> 8; } tb[32] = acc; }
    __syncthreads();
    if (blockIdx.x == 0) {
        for (int tile = c.tid; tile < tb[32]; tile += NTHREADS) { int e = 0; for (int q = 0; q < NEXP; ++q) if (tile >= tb[q]) e = q; TILE_E[tile] = e; }
        if (c.tid == 0) *NT = tb[32];
    }
    for (int idx = c.gwave; idx < T * 4; idx += c.nwaves) {
        const int t = idx >> 2, e = TE[idx], pos = TP[idx];
        const int slot = tb[e] * 256 + pos;
        if (c.lane == 0) { TSLOT[idx] = slot; SGATE[slot] = TG[idx]; }
        const uint4* src = (const uint4*)(H2 + (size_t)t * 1024); uint4* dst = (uint4*)(XB + (size_t)slot * 1024);
        dst[c.lane] = src[c.lane]; dst[c.lane + 64] = src[c.lane + 64];
    }
    for (int e = 0; e < NEXP; ++e) {
        const int n = tb[64 + e], cap = (tb[e + 1] - tb[e]) * 256;
        for (int r = n + c.gwave; r < cap; r += c.nwaves) {
            const int slot = tb[e] * 256 + r;
            uint4* dst = (uint4*)(XB + (size_t)slot * 1024);
            dst[c.lane] = make_uint4(0, 0, 0, 0); dst[c.lane + 64] = make_uint4(0, 0, 0, 0);
            if (c.lane == 0) SGATE[slot] = 0.f;
        }
    }
}

__device__ __forceinline__ void ph_combine(const Ctx& c) {
    const float* X1 = c.ws<float>(WS_X1); const bf16* YS = c.ws<bf16>(WS_YS); const int* TSLOT = c.ws<int>(WS_TSLOT); const float* nw = c.P.in[I_NORM_FINAL]; float* out = c.P.out;
    const int lane = c.lane;
    for (int t = c.gwave; t < T; t += c.nwaves) {
        const int s0 = TSLOT[t * 4], s1 = TSLOT[t * 4 + 1], s2 = TSLOT[t * 4 + 2], s3 = TSLOT[t * 4 + 3];
        float4 v[4]; float ss = 0.f;
#pragma unroll
        for (int i = 0; i < 4; ++i) {
            const int col = 4 * (lane + 64 * i);
            v[i] = *(const float4*)(X1 + (size_t)t * D + col);
            const uint2 a = *(const uint2*)(YS + (size_t)s0 * 1024 + col), b = *(const uint2*)(YS + (size_t)s1 * 1024 + col), cc = *(const uint2*)(YS + (size_t)s2 * 1024 + col), d = *(const uint2*)(YS + (size_t)s3 * 1024 + col);
            v[i].x += bflo(a.x) + bflo(b.x) + bflo(cc.x) + bflo(d.x); v[i].y += bfhi(a.x) + bfhi(b.x) + bfhi(cc.x) + bfhi(d.x);
            v[i].z += bflo(a.y) + bflo(b.y) + bflo(cc.y) + bflo(d.y); v[i].w += bfhi(a.y) + bfhi(b.y) + bfhi(cc.y) + bfhi(d.y);
            ss += v[i].x * v[i].x + v[i].y * v[i].y + v[i].z * v[i].z + v[i].w * v[i].w;
        }
        ss = wsum(ss);
        const float rstd = rsqrtf(ss * (1.f / 1024.f) + 1e-6f);
#pragma unroll
        for (int i = 0; i < 4; ++i) { const float4 w4 = ((const float4*)nw)[lane + 64 * i];
            *(float4*)(out + (size_t)t * D + 4 * (lane + 64 * i)) = make_float4(v[i].x * rstd * w4.x, v[i].y * rstd * w4.y, v[i].z * rstd * w4.z, v[i].w * rstd * w4.w); }
    }
}


typedef short bf16x8_t __attribute__((ext_vector_type(8)));
typedef float f32x4_t __attribute__((ext_vector_type(4)));
#define MFMA16(a, b, c) __builtin_amdgcn_mfma_f32_16x16x32_bf16((a), (b), (c), 0, 0, 0)

constexpr int GCL_HALF_BYTES = 71680;
__device__ __forceinline__ void ph_gcl(const Ctx& c) {
    const float* GQKV = c.ws<float>(WS_GQKV); const float* BETA = c.ws<float>(WS_BETA); const float* GGv = c.ws<float>(WS_GG); const float* cw = c.P.in[I_GDN_CONV];
    bf16* GA1 = c.ws<bf16>(WS_GA1); float* GX0 = c.ws<float>(WS_GX0); bf16* GA2 = c.ws<bf16>(WS_GA2); bf16* GA3 = c.ws<bf16>(WS_GA3); bf16* GA4 = c.ws<bf16>(WS_GA4); float* GGL = c.ws<float>(WS_GGL);
    for (int it0 = blockIdx.x * 2; it0 < 2048; it0 += gridDim.x * 2) {
        int tv = c.tid; asm volatile("" : "+v"(tv));
        const int half = tv >> 8, ht = tv & 255, lane = tv & 63, w4 = __builtin_amdgcn_readfirstlane((tv >> 6) & 3);
        unsigned char* base = c.lds + half * GCL_HALF_BYTES;
        bf16* QB = (bf16*)base;
        bf16* KB = QB + 64 * 136;
        bf16* VB = KB + 64 * 136;
        float* MM = (float*)(VB + 64 * 136);
        float* GC = MM + 64 * 64;
        float* BT = GC + 64;
        float* BE = BT + 64;
        const int item = it0 + half, n = item & 63, bh = item >> 6, h = bh & 7, b = bh >> 3;
        const int t0 = b * SEQ + n * 64;
        __syncthreads();
        if (w4 == 0) {
            float g = GGv[(size_t)(t0 + lane) * 8 + h]; const float be = BETA[(size_t)(t0 + lane) * 8 + h];
#pragma unroll
            for (int o = 1; o < 64; o <<= 1) { const float u = __shfl_up(g, o); if (lane >= o) g += u; }
            GC[lane] = g; BT[lane] = be; BE[lane] = be * expf(g);
        }
        __syncthreads();
        {
            const int r = ht >> 2, seg = ht & 3, s = n * 64 + r;
            const float egc = expf(GC[r]);
#pragma unroll
            for (int mat = 0; mat < 3; ++mat) {
                const int col0 = mat * 1024 + h * 128 + seg * 32;
                float acc[32];
#pragma unroll
                for (int i = 0; i < 32; ++i) acc[i] = 0.f;
#pragma unroll
                for (int j = 0; j < 4; ++j) {
                    if (s - 3 + j >= 0) {
                        const float* xp = GQKV + (size_t)(t0 + r - 3 + j) * 3072 + col0; const float* wp = cw + j * 3072 + col0;
#pragma unroll
                        for (int q = 0; q < 8; ++q) { const float4 xv = *(const float4*)(xp + 4 * q); const float4 wv = *(const float4*)(wp + 4 * q);
                            acc[4 * q] += wv.x * xv.x; acc[4 * q + 1] += wv.y * xv.y; acc[4 * q + 2] += wv.z * xv.z; acc[4 * q + 3] += wv.w * xv.w; }
                    }
                    asm volatile("" ::: "memory");
                }
                float ss = 0.f;
#pragma unroll
                for (int i = 0; i < 32; ++i) { acc[i] *= sigm(acc[i]); ss += acc[i] * acc[i]; }
                float sc = 1.f;
                if (mat < 2) { ss += __shfl_xor(ss, 1); ss += __shfl_xor(ss, 2); sc = rsqrtf(ss + 1e-6f) * (mat == 0 ? 0.08838834764831845f : 1.f); }
                bf16* dst = (mat == 0 ? QB : (mat == 1 ? KB : VB)) + r * 136 + seg * 32;
#pragma unroll
                for (int q = 0; q < 4; ++q) { uint4 w; w.x = pk2(acc[8 * q] * sc, acc[8 * q + 1] * sc); w.y = pk2(acc[8 * q + 2] * sc, acc[8 * q + 3] * sc); w.z = pk2(acc[8 * q + 4] * sc, acc[8 * q + 5] * sc); w.w = pk2(acc[8 * q + 6] * sc, acc[8 * q + 7] * sc);
                    *(uint4*)(dst + 8 * q) = w; }
                if (mat == 0) {
                    bf16* gd = GA2 + ((size_t)item * 64 + r) * 128 + seg * 32; const float s2 = sc * egc;
#pragma unroll
                    for (int q = 0; q < 4; ++q) { uint4 w; w.x = pk2(acc[8 * q] * s2, acc[8 * q + 1] * s2); w.y = pk2(acc[8 * q + 2] * s2, acc[8 * q + 3] * s2); w.z = pk2(acc[8 * q + 4] * s2, acc[8 * q + 5] * s2); w.w = pk2(acc[8 * q + 6] * s2, acc[8 * q + 7] * s2);
                        *(uint4*)(gd + 8 * q) = w; }
                }
            }
        }
        __syncthreads();
        {
            const int fr = lane & 15, fq = lane >> 4, a0 = w4 * 16;
            bf16x8_t ka[4];
#pragma unroll
            for (int kb = 0; kb < 4; ++kb) ka[kb] = *(const bf16x8_t*)(KB + (a0 + fr) * 136 + kb * 32 + fq * 8);
#pragma unroll
            for (int bt = 0; bt < 4; ++bt) {
                f32x4_t c1 = {0.f, 0.f, 0.f, 0.f}, c2 = {0.f, 0.f, 0.f, 0.f};
#pragma unroll
                for (int kb = 0; kb < 4; ++kb) {
                    const bf16x8_t kbf = *(const bf16x8_t*)(KB + (bt * 16 + fr) * 136 + kb * 32 + fq * 8);
                    const bf16x8_t qbf = *(const bf16x8_t*)(QB + (bt * 16 + fr) * 136 + kb * 32 + fq * 8);
                    c1 = MFMA16(ka[kb], kbf, c1); c2 = MFMA16(ka[kb], qbf, c2);
                }
                const int i = bt * 16 + fr, j0 = a0 + 4 * fq;
                const float gi = GC[i], bi = BT[i];
                float m[4], at[4];
#pragma unroll
                for (int rg = 0; rg < 4; ++rg) { const int j = j0 + rg; const float dec = expf(fminf(gi - GC[j], 0.f));
                    m[rg] = (i > j) ? bi * c1[rg] * dec : 0.f; at[rg] = (i >= j) ? c2[rg] * dec : 0.f; }
                *(float4*)(MM + i * 64 + j0) = make_float4(m[0], m[1], m[2], m[3]);
                uint2 w; w.x = pk2(at[0], at[1]); w.y = pk2(at[2], at[3]);
                *(uint2*)(GA3 + ((size_t)item * 64 + i) * 64 + j0) = w;
            }
        }
        __syncthreads();
        {
            const int cc = ht & 127; const bool isw = ht >= 128;
            const bf16* srcp = (isw ? KB : VB) + cc; const float* scl = isw ? BE : BT;
            float x[64];
#pragma unroll
            for (int i = 0; i < 64; ++i) x[i] = 0.f;
#pragma unroll
            for (int i = 0; i < 64; ++i) {
                float acc = scl[i] * bf2f(srcp[i * 136]);
#pragma unroll
                for (int j4 = 0; j4 < (i + 3) / 4; ++j4) { const float4 mv = *(const float4*)(MM + i * 64 + 4 * j4);
                    acc -= mv.x * x[4 * j4]; acc -= mv.y * x[4 * j4 + 1]; acc -= mv.z * x[4 * j4 + 2]; acc -= mv.w * x[4 * j4 + 3]; }
                x[i] = acc;
                asm volatile("" ::: "memory");
            }
            if (!isw) {
                float* up = GX0 + ((size_t)item * 128 + cc) * 64;
#pragma unroll
                for (int q = 0; q < 16; ++q) *(float4*)(up + 4 * q) = make_float4(x[4 * q], x[4 * q + 1], x[4 * q + 2], x[4 * q + 3]);
            } else {
                bf16* wp = GA1 + (size_t)item * 64 * 128 + cc;
#pragma unroll
                for (int i = 0; i < 64; ++i) wp[i * 128] = f2bf(-x[i]);
            }
        }
        {
            const int dk = ht & 127, hh = ht >> 7; const float g63 = GC[63];
            unsigned w[16];
#pragma unroll
            for (int q = 0; q < 16; ++q) { const int ta = hh * 32 + 2 * q;
                w[q] = pk2(bf2f(KB[ta * 136 + dk]) * expf(g63 - GC[ta]), bf2f(KB[(ta + 1) * 136 + dk]) * expf(g63 - GC[ta + 1])); }
            uint4* dp = (uint4*)(GA4 + ((size_t)item * 128 + dk) * 64 + hh * 32);
            dp[0] = make_uint4(w[0], w[1], w[2], w[3]); dp[1] = make_uint4(w[4], w[5], w[6], w[7]); dp[2] = make_uint4(w[8], w[9], w[10], w[11]); dp[3] = make_uint4(w[12], w[13], w[14], w[15]);
            if (ht == 0) GGL[item] = expf(g63);
        }
    }
}

constexpr int RCL_HALF_BYTES = 75776;
__device__ __forceinline__ void ph_rcl(const Ctx& c) {
    const float* RKV = c.ws<float>(WS_RKV); const float* LW = c.ws<float>(WS_LW); const float* AAg = c.ws<float>(WS_AA);
    const float* mu = c.P.in[I_MU]; const float* k_k = c.P.in[I_KK]; const float* k_a = c.P.in[I_KA]; const float* r_k = c.P.in[I_RK];
    bf16* VP = c.ws<bf16>(WS_VP); float* SC = c.ws<float>(WS_SC);
    bf16* RA1 = c.ws<bf16>(WS_RA1); float* RX0 = c.ws<float>(WS_RX0); bf16* RA2 = c.ws<bf16>(WS_RA2); bf16* RA3 = c.ws<bf16>(WS_RA3); float* RO0 = c.ws<float>(WS_RO0);
    bf16* RA4 = c.ws<bf16>(WS_RA4); float* RS0 = c.ws<float>(WS_RS0); float* RDSC = c.ws<float>(WS_RDSC);
    for (int it0 = blockIdx.x * 2; it0 < 4096; it0 += gridDim.x * 2) {
        int tv = c.tid; asm volatile("" : "+v"(tv));
        const int half = tv >> 8, ht = tv & 255, lane = tv & 63, w4 = __builtin_amdgcn_readfirstlane((tv >> 6) & 3);
        unsigned char* base = c.lds + half * RCL_HALF_BYTES;
        bf16* AT = (bf16*)base;
        bf16* VT = AT + 64 * 72;
        bf16* KDT = VT + 64 * 72;
        float* AAB = (float*)(KDT + 64 * 72);
        float* TOT = AAB + 64 * 64;
        unsigned char* RX = (unsigned char*)(TOT + 256);
        bf16* RT = (bf16*)RX;
        bf16* BTL = RT + 64 * 72;
        bf16* KT = BTL + 64 * 72;
        bf16* AAK = (bf16*)RX;
        bf16* ARK = AAK + 64 * 72;
        float* RHS2 = (float*)RX;
        const int item = it0 + half, n = item & 63, bh = item >> 6, h = bh & 15, b = bh >> 4;
        const int t0 = b * SEQ + n * 64;
        __syncthreads();
        {
            const int ch = ht & 63, tq = ht >> 6;
            float run = 0.f;
#pragma unroll
            for (int i = 0; i < 16; ++i) { run += LW[(size_t)(t0 + tq * 16 + i) * 1024 + h * 64 + ch]; AAB[(tq * 16 + i) * 64 + ch] = run; }
            TOT[tq * 64 + ch] = run;
        }
        __syncthreads();
        {
            const int r = ht >> 2, seg = ht & 3, c0 = seg * 16, t = t0 + r; const bool first = (n == 0 && r == 0);
            const float* cur = RKV + (size_t)t * 3072 + h * 64 + c0; const float* prv = cur - 3072;
            float rr[16], kf[16], vv[16], kkv[16], aa[16];
            float ss = 0.f, scs = 0.f;
#pragma unroll
            for (int q = 0; q < 4; ++q) {
                const float4 r0 = *(const float4*)(cur + 4 * q), k0 = *(const float4*)(cur + 1024 + 4 * q), v0 = *(const float4*)(cur + 2048 + 4 * q);
                float4 rp = make_float4(0.f, 0.f, 0.f, 0.f), kp = rp, vp = rp;
                if (!first) { rp = *(const float4*)(prv + 4 * q); kp = *(const float4*)(prv + 1024 + 4 * q); vp = *(const float4*)(prv + 2048 + 4 * q); }
                const float4 mr = *(const float4*)(mu + h * 64 + c0 + 4 * q), mk = *(const float4*)(mu + 1024 + h * 64 + c0 + 4 * q), mv = *(const float4*)(mu + 2048 + h * 64 + c0 + 4 * q);
                const float4 kkw = *(const float4*)(k_k + h * 64 + c0 + 4 * q), kaw = *(const float4*)(k_a + h * 64 + c0 + 4 * q), rkw = *(const float4*)(r_k + h * 64 + c0 + 4 * q);
                const float4 a4 = *(const float4*)(AAg + (size_t)t * 1024 + h * 64 + c0 + 4 * q);
                const float r0a[4] = {r0.x, r0.y, r0.z, r0.w}, k0a[4] = {k0.x, k0.y, k0.z, k0.w}, v0a[4] = {v0.x, v0.y, v0.z, v0.w};
                const float rpa[4] = {rp.x, rp.y, rp.z, rp.w}, kpa[4] = {kp.x, kp.y, kp.z, kp.w}, vpa[4] = {vp.x, vp.y, vp.z, vp.w};
                const float mra[4] = {mr.x, mr.y, mr.z, mr.w}, mka[4] = {mk.x, mk.y, mk.z, mk.w}, mva[4] = {mv.x, mv.y, mv.z, mv.w};
                const float kka[4] = {kkw.x, kkw.y, kkw.z, kkw.w}, kaa[4] = {kaw.x, kaw.y, kaw.z, kaw.w}, rka[4] = {rkw.x, rkw.y, rkw.z, rkw.w}, aaa[4] = {a4.x, a4.y, a4.z, a4.w};
#pragma unroll
                for (int e = 0; e < 4; ++e) { const int i = 4 * q + e;
                    rr[i] = r0a[e] + (rpa[e] - r0a[e]) * mra[e]; const float kx = k0a[e] + (kpa[e] - k0a[e]) * mka[e]; vv[i] = v0a[e] + (vpa[e] - v0a[e]) * mva[e];
                    kkv[i] = kx * kka[e]; ss += kkv[i] * kkv[i]; aa[i] = aaa[e]; kf[i] = kx * (1.f + (aaa[e] - 1.f) * kaa[e]); scs += rr[i] * kf[i] * rka[e]; }
                asm volatile("" ::: "memory");
            }
            ss += __shfl_xor(ss, 1); ss += __shfl_xor(ss, 2); scs += __shfl_xor(scs, 1); scs += __shfl_xor(scs, 2);
            const float rn = rsqrtf(ss + 1e-6f);
            if (seg == 0) SC[(size_t)t * 16 + h] = scs;
            const int tq = r >> 4;
            unsigned wat[8], wbt[8], wkt[8], wrt[8], wvp[8];
            float atv[16], btv[16], ktv[16], rtv[16];
#pragma unroll
            for (int i = 0; i < 16; ++i) {
                const int ch = c0 + i;
                float off = 0.f;
#pragma unroll
                for (int q = 0; q < 3; ++q) off += (q < tq) ? TOT[q * 64 + ch] : 0.f;
                const float tot = TOT[ch] + TOT[64 + ch] + TOT[128 + ch] + TOT[192 + ch];
                const float cs = AAB[r * 64 + ch] + off;
                const float lwv = LW[(size_t)t * 1024 + h * 64 + ch];
                const float kk = kkv[i] * rn;
                const float e2 = expf(-cs), e4 = expf(tot - cs);
                atv[i] = kk * expf(cs - lwv); btv[i] = -kk * aa[i] * e2; ktv[i] = kf[i] * e2; rtv[i] = rr[i] * expf(cs);
                VT[ch * 72 + r] = f2bf(vv[i]);
                KDT[ch * 72 + r] = f2bf(kf[i] * e4);
                RA4[((size_t)item * 64 + ch) * 64 + r] = f2bf(-kk * aa[i] * e4);
                if (r == 63) RDSC[(size_t)item * 64 + ch] = expf(tot);
            }
#pragma unroll
            for (int q = 0; q < 8; ++q) { wat[q] = pk2(atv[2 * q], atv[2 * q + 1]); wbt[q] = pk2(btv[2 * q], btv[2 * q + 1]); wkt[q] = pk2(ktv[2 * q], ktv[2 * q + 1]); wrt[q] = pk2(rtv[2 * q], rtv[2 * q + 1]); wvp[q] = pk2(vv[2 * q], vv[2 * q + 1]); }
            *(uint4*)(AT + r * 72 + c0) = make_uint4(wat[0], wat[1], wat[2], wat[3]); *(uint4*)(AT + r * 72 + c0 + 8) = make_uint4(wat[4], wat[5], wat[6], wat[7]);
            *(uint4*)(BTL + r * 72 + c0) = make_uint4(wbt[0], wbt[1], wbt[2], wbt[3]); *(uint4*)(BTL + r * 72 + c0 + 8) = make_uint4(wbt[4], wbt[5], wbt[6], wbt[7]);
            *(uint4*)(KT + r * 72 + c0) = make_uint4(wkt[0], wkt[1], wkt[2], wkt[3]); *(uint4*)(KT + r * 72 + c0 + 8) = make_uint4(wkt[4], wkt[5], wkt[6], wkt[7]);
            *(uint4*)(RT + r * 72 + c0) = make_uint4(wrt[0], wrt[1], wrt[2], wrt[3]); *(uint4*)(RT + r * 72 + c0 + 8) = make_uint4(wrt[4], wrt[5], wrt[6], wrt[7]);
            bf16* a2p = RA2 + ((size_t)item * 64 + r) * 64 + c0;
            *(uint4*)a2p = make_uint4(wrt[0], wrt[1], wrt[2], wrt[3]); *(uint4*)(a2p + 8) = make_uint4(wrt[4], wrt[5], wrt[6], wrt[7]);
            bf16* vpp = VP + (size_t)t * 1024 + h * 64 + c0;
            *(uint4*)vpp = make_uint4(wvp[0], wvp[1], wvp[2], wvp[3]); *(uint4*)(vpp + 8) = make_uint4(wvp[4], wvp[5], wvp[6], wvp[7]);
        }
        __syncthreads();
        const int fr = lane & 15, fq = lane >> 4;
        f32x4_t cab[4], cak[4], crb[4], crk[4];
        {
            const int j0t = w4 * 16;
            bf16x8_t bj[2], kj[2];
#pragma unroll
            for (int kb = 0; kb < 2; ++kb) { bj[kb] = *(const bf16x8_t*)(BTL + (j0t + fr) * 72 + kb * 32 + fq * 8); kj[kb] = *(const bf16x8_t*)(KT + (j0t + fr) * 72 + kb * 32 + fq * 8); }
#pragma unroll
            for (int it = 0; it < 4; ++it) {
                cab[it] = (f32x4_t){0.f, 0.f, 0.f, 0.f}; cak[it] = cab[it]; crb[it] = cab[it]; crk[it] = cab[it];
#pragma unroll
                for (int kb = 0; kb < 2; ++kb) {
                    const bf16x8_t ai = *(const bf16x8_t*)(AT + (it * 16 + fr) * 72 + kb * 32 + fq * 8);
                    const bf16x8_t ri = *(const bf16x8_t*)(RT + (it * 16 + fr) * 72 + kb * 32 + fq * 8);
                    cab[it] = MFMA16(bj[kb], ai, cab[it]); cak[it] = MFMA16(kj[kb], ai, cak[it]); crb[it] = MFMA16(bj[kb], ri, crb[it]); crk[it] = MFMA16(kj[kb], ri, crk[it]);
                }
            }
        }
        __syncthreads();
        {
            const int j0 = w4 * 16 + 4 * fq;
#pragma unroll
            for (int it = 0; it < 4; ++it) {
                const int i = it * 16 + fr;
                float vab[4], vak[4], vrb[4], vrk[4];
#pragma unroll
                for (int rg = 0; rg < 4; ++rg) { const int j = j0 + rg; const bool st = i > j, in = i >= j;
                    vab[rg] = st ? cab[it][rg] : 0.f; vak[rg] = st ? cak[it][rg] : 0.f; vrb[rg] = in ? crb[it][rg] : 0.f; vrk[rg] = in ? crk[it][rg] : 0.f; }
                *(float4*)(AAB + i * 64 + j0) = make_float4(vab[0], vab[1], vab[2], vab[3]);
                uint2 w; w.x = pk2(vak[0], vak[1]); w.y = pk2(vak[2], vak[3]); *(uint2*)(AAK + i * 72 + j0) = w;
                w.x = pk2(vrk[0], vrk[1]); w.y = pk2(vrk[2], vrk[3]); *(uint2*)(ARK + i * 72 + j0) = w;
                w.x = pk2(vrb[0], vrb[1]); w.y = pk2(vrb[2], vrb[3]); *(uint2*)(RA3 + ((size_t)item * 64 + i) * 64 + j0) = w;
            }
        }
        __syncthreads();
        f32x4_t cav[4], cov[4], ckv[4];
        {
            const int r0t = w4 * 16;
            bf16x8_t fa[2], fo[2], fk[2];
#pragma unroll
            for (int kb = 0; kb < 2; ++kb) { fa[kb] = *(const bf16x8_t*)(AAK + (r0t + fr) * 72 + kb * 32 + fq * 8); fo[kb] = *(const bf16x8_t*)(ARK + (r0t + fr) * 72 + kb * 32 + fq * 8); fk[kb] = *(const bf16x8_t*)(KDT + (r0t + fr) * 72 + kb * 32 + fq * 8); }
#pragma unroll
            for (int vt = 0; vt < 4; ++vt) {
                cav[vt] = (f32x4_t){0.f, 0.f, 0.f, 0.f}; cov[vt] = cav[vt]; ckv[vt] = cav[vt];
#pragma unroll
                for (int kb = 0; kb < 2; ++kb) { const bf16x8_t vb = *(const bf16x8_t*)(VT + (vt * 16 + fr) * 72 + kb * 32 + fq * 8);
                    cav[vt] = MFMA16(fa[kb], vb, cav[vt]); cov[vt] = MFMA16(fo[kb], vb, cov[vt]); ckv[vt] = MFMA16(fk[kb], vb, ckv[vt]); }
            }
        }
        __syncthreads();
        {
            const int r0 = w4 * 16 + 4 * fq;
#pragma unroll
            for (int vt = 0; vt < 4; ++vt) {
                const int v = vt * 16 + fr;
#pragma unroll
                for (int rg = 0; rg < 4; ++rg) RHS2[v * 65 + r0 + rg] = cav[vt][rg];
                *(float4*)(RO0 + ((size_t)item * 64 + v) * 64 + r0) = make_float4(cov[vt][0], cov[vt][1], cov[vt][2], cov[vt][3]);
                *(float4*)(RS0 + ((size_t)item * 64 + v) * 64 + r0) = make_float4(ckv[vt][0], ckv[vt][1], ckv[vt][2], ckv[vt][3]);
            }
        }
        __syncthreads();
        if (ht < 128) {
            const int cc = ht & 63; const bool isu = ht >= 64;
            float x[64];
#pragma unroll
            for (int i = 0; i < 64; ++i) x[i] = 0.f;
#pragma unroll
            for (int i = 0; i < 64; ++i) {
                const float rv = RHS2[(isu ? cc : 0) * 65 + i], av = bf2f(AT[i * 72 + (isu ? 0 : cc)]);
                float acc = isu ? rv : av;
#pragma unroll
                for (int j4 = 0; j4 < (i + 3) / 4; ++j4) { const float4 mv = *(const float4*)(AAB + i * 64 + 4 * j4);
                    acc += mv.x * x[4 * j4]; acc += mv.y * x[4 * j4 + 1]; acc += mv.z * x[4 * j4 + 2]; acc += mv.w * x[4 * j4 + 3]; }
                x[i] = acc;
                asm volatile("" ::: "memory");
            }
            if (isu) {
                float* up = RX0 + ((size_t)item * 64 + cc) * 64;
#pragma unroll
                for (int q = 0; q < 16; ++q) *(float4*)(up + 4 * q) = make_float4(x[4 * q], x[4 * q + 1], x[4 * q + 2], x[4 * q + 3]);
            } else {
                bf16* wp = RA1 + (size_t)item * 64 * 64 + cc;
#pragma unroll
                for (int i = 0; i < 64; ++i) wp[i * 64] = f2bf(x[i]);
            }
        }
    }
}

template <int DK, bool RW>
struct ScanArgs { const bf16* A1; const float* X0; const bf16* A2; const bf16* A3; const float* O0; const bf16* A4; const float* S0; const float* DSC; float* OUT; int item0; int vs; int tok0; int ocol0; };
template <int DK, bool RW>
__device__ __forceinline__ void scan_run(const Ctx& c, const ScanArgs<DK, RW>& a) {
    constexpr int KB = DK / 32;
    constexpr int NST = DK / 64;
    constexpr int NV = RW ? 64 : 128;
    constexpr int SROW = DK + 8;
    bf16* ST = (bf16*)c.lds;
    bf16* XT = ST + 2 * 32 * SROW;
    const int lane = c.lane, w = c.wave, fr = lane & 15, fq = lane >> 4;
    const int tm = w >> 1, tn = w & 1;
    const int dkt = (NST == 2) ? w : (w >> 1);
    for (int i = c.tid; i < 32 * SROW / 2; i += NTHREADS) ((unsigned*)ST)[i] = 0u;
    f32x4_t accS[NST];
#pragma unroll
    for (int s = 0; s < NST; ++s) accS[s] = (f32x4_t){0.f, 0.f, 0.f, 0.f};
    bf16x8_t a1f[KB], a2f[KB], a3f[2], a4f[2]; f32x4_t x0v, o0v, s0v[NST], dscv;
#define SCAN_LOAD(IT) do { const size_t it_ = (size_t)(IT); \
        _Pragma("unroll") for (int kb = 0; kb < KB; ++kb) { a1f[kb] = *(const bf16x8_t*)(a.A1 + (it_ * 64 + tm * 16 + fr) * DK + kb * 32 + fq * 8); a2f[kb] = *(const bf16x8_t*)(a.A2 + (it_ * 64 + tm * 16 + fr) * DK + kb * 32 + fq * 8); } \
        _Pragma("unroll") for (int kb = 0; kb < 2; ++kb) { a3f[kb] = *(const bf16x8_t*)(a.A3 + (it_ * 64 + tm * 16 + fr) * 64 + kb * 32 + fq * 8); a4f[kb] = *(const bf16x8_t*)(a.A4 + (it_ * DK + dkt * 16 + fr) * 64 + kb * 32 + fq * 8); } \
        x0v = *(const f32x4_t*)(a.X0 + (it_ * NV + a.vs * 32 + tn * 16 + fr) * 64 + tm * 16 + 4 * fq); \
        if (RW) { o0v = *(const f32x4_t*)(a.O0 + (it_ * NV + a.vs * 32 + tn * 16 + fr) * 64 + tm * 16 + 4 * fq); \
                  _Pragma("unroll") for (int s = 0; s < NST; ++s) s0v[s] = *(const f32x4_t*)(a.S0 + (it_ * 64 + a.vs * 32 + (NST == 2 ? s : tn) * 16 + fr) * DK + dkt * 16 + 4 * fq); \
                  dscv = *(const f32x4_t*)(a.DSC + it_ * DK + dkt * 16 + 4 * fq); } \
        else { const float g_ = a.DSC[it_]; dscv = (f32x4_t){g_, g_, g_, g_}; o0v = (f32x4_t){0.f, 0.f, 0.f, 0.f}; _Pragma("unroll") for (int s = 0; s < NST; ++s) s0v[s] = (f32x4_t){0.f, 0.f, 0.f, 0.f}; } \
    } while (0)
    SCAN_LOAD(a.item0);
    int cur = 0;
    for (int n = 0; n < 64; ++n) {
        bf16x8_t b1[KB], b2[KB], b3[2], b4[2];
#pragma unroll
        for (int kb = 0; kb < KB; ++kb) { b1[kb] = a1f[kb]; b2[kb] = a2f[kb]; }
        b3[0] = a3f[0]; b3[1] = a3f[1]; b4[0] = a4f[0]; b4[1] = a4f[1];
        f32x4_t accX = x0v, accO = o0v; const f32x4_t dv = dscv; f32x4_t sv[NST];
#pragma unroll
        for (int s = 0; s < NST; ++s) sv[s] = s0v[s];
        if (n + 1 < 64) SCAN_LOAD(a.item0 + n + 1);
        __syncthreads();
        const bf16* Sc = ST + cur * 32 * SROW; bf16* Sn = ST + (cur ^ 1) * 32 * SROW;
        bf16x8_t sf[KB];
#pragma unroll
        for (int kb = 0; kb < KB; ++kb) sf[kb] = *(const bf16x8_t*)(Sc + (tn * 16 + fr) * SROW + kb * 32 + fq * 8);
#pragma unroll
        for (int kb = 0; kb < KB; ++kb) accX = MFMA16(b1[kb], sf[kb], accX);
        { uint2 wv; wv.x = pk2(accX[0], accX[1]); wv.y = pk2(accX[2], accX[3]); *(uint2*)(XT + (tn * 16 + fr) * 72 + tm * 16 + 4 * fq) = wv; }
#pragma unroll
        for (int kb = 0; kb < KB; ++kb) accO = MFMA16(b2[kb], sf[kb], accO);
        __syncthreads();
        bf16x8_t xf[2];
#pragma unroll
        for (int kb = 0; kb < 2; ++kb) xf[kb] = *(const bf16x8_t*)(XT + (tn * 16 + fr) * 72 + kb * 32 + fq * 8);
        accO = MFMA16(b3[0], xf[0], accO); accO = MFMA16(b3[1], xf[1], accO);
        {
            float* op = a.OUT + (size_t)(a.tok0 + n * 64 + tm * 16 + 4 * fq) * 1024 + a.ocol0 + tn * 16 + fr;
            op[0] = accO[0]; op[1024] = accO[1]; op[2048] = accO[2]; op[3072] = accO[3];
        }
#pragma unroll
        for (int s = 0; s < NST; ++s) {
            const int vt = (NST == 2) ? s : tn;
            bf16x8_t xg[2];
            if (vt == tn) { xg[0] = xf[0]; xg[1] = xf[1]; }
            else {
#pragma unroll
                for (int kb = 0; kb < 2; ++kb) xg[kb] = *(const bf16x8_t*)(XT + (vt * 16 + fr) * 72 + kb * 32 + fq * 8);
            }
            f32x4_t t = accS[s] * dv + sv[s];
            t = MFMA16(b4[0], xg[0], t); t = MFMA16(b4[1], xg[1], t);
            accS[s] = t;
            uint2 wv; wv.x = pk2(t[0], t[1]); wv.y = pk2(t[2], t[3]);
            *(uint2*)(Sn + (vt * 16 + fr) * SROW + dkt * 16 + 4 * fq) = wv;
        }
        cur ^= 1;
    }
#undef SCAN_LOAD
    __syncthreads();
}

__device__ __forceinline__ void ph_scan(const Ctx& c) {
    for (int wk = blockIdx.x; wk < 256; wk += gridDim.x) {
        if (wk < 128) {
            const int pair = wk >> 2, vs = wk & 3, b = pair >> 3, h = pair & 7;
            ScanArgs<128, false> a{c.ws<bf16>(WS_GA1), c.ws<float>(WS_GX0), c.ws<bf16>(WS_GA2), c.ws<bf16>(WS_GA3), nullptr, c.ws<bf16>(WS_GA4), nullptr, c.ws<float>(WS_GGL),
                                   c.ws<float>(WS_OG), pair * 64, vs, b * SEQ, h * 128 + vs * 32};
            scan_run<128, false>(c, a);
        } else {
            const int pair = (wk - 128) >> 1, vs = wk & 1, b = pair >> 4, h = pair & 15;
            ScanArgs<64, true> a{c.ws<bf16>(WS_RA1), c.ws<float>(WS_RX0), c.ws<bf16>(WS_RA2), c.ws<bf16>(WS_RA3), c.ws<float>(WS_RO0), c.ws<bf16>(WS_RA4), c.ws<float>(WS_RS0), c.ws<float>(WS_RDSC),
                                 c.ws<float>(WS_ORW), pair * 64, vs, b * SEQ, h * 64 + vs * 32};
            scan_run<64, true>(c, a);
        }
    }
}

enum { PH_RMS0 = 0, PH_INPROJ, PH_GCL, PH_LORA, PH_RCL, PH_SCAN, PH_POST, PH_G2, PH_X1, PH_ROUTER, PH_DISPATCH, PH_MOE1, PH_MOE2, PH_COMBINE, PH_COUNT };

template <unsigned PHMASK>
__global__ void __launch_bounds__(NTHREADS) mk(Params P) {
    extern __shared__ __attribute__((aligned(16))) unsigned char lds[];
    volatile LAS unsigned* misc = (volatile LAS unsigned*)((LAS unsigned char*)lds + MISC_OFF);
    if (threadIdx.x < 64) misc[threadIdx.x] = 0u;
    __syncthreads();
    unsigned* ctl = (unsigned*)(P.ws + WS_CTL);
    XcdBarrier bar = xcd_barrier_post(ctl + CW_BAR + P.li * XCD_BAR_WORDS, misc);
#define MKCTX() int tv_ = threadIdx.x; asm volatile("" : "+v"(tv_)); const int wv_ = __builtin_amdgcn_readfirstlane(tv_ >> 6); \
    Ctx c{P, tv_, tv_ & 63, wv_, (int)(blockIdx.x * NWAVES + wv_), (int)(gridDim.x * NWAVES), (size_t)blockIdx.x * NTHREADS + tv_, (size_t)gridDim.x * NTHREADS, lds}
    bool first_seam = true;
#define IN(k) (((PHMASK >> (k)) & 1u) && P.ph_lo <= (k) && (k) < P.ph_hi)
#define SEAM(k) do { if ((k) + 1 < P.ph_hi) { if (first_seam && P.coop) { cg::this_grid().sync(); } else xcd_barrier(bar); first_seam = false; } } while (0)
#define REP(k) for (int rep_ = 0; rep_ < ((k) == PROBE_REP ? 2 : 1); ++rep_)
    if (IN(PH_RMS0)) { MKCTX();
        REP(PH_RMS0) {
        ph_rms0(c);
        { WJob j{P.in[I_W_IN], NCOL_IN, 1024, 4096, c.ws<bf16>(WS_WIN_T), 1024, 1, 0, 0}; wconv_job(c, j); }
        { WJob j{P.in[I_W_IN] + 4112, NCOL_IN, 1024, 5376, c.ws<bf16>(WS_WIN_T) + (size_t)4096 * 1024, 1024, 1, 0, 0}; wconv_job(c, j); }
        lora_zero(c);
        { WJob j{P.in[I_W2], 1024, 64, 1024, c.ws<bf16>(WS_LORA_T), 256, 1, 0, 0}; wconv_job(c, j); }
        { WJob j{P.in[I_A2], 1024, 64, 1024, c.ws<bf16>(WS_LORA_T) + (size_t)1024 * 256 + 64, 256, 1, 0, 0}; wconv_job(c, j); }
        { WJob j{P.in[I_G2], 1024, 128, 1024, c.ws<bf16>(WS_LORA_T) + (size_t)2048 * 256 + 128, 256, 1, 0, 0}; wconv_job(c, j); }
        }
        SEAM(PH_RMS0);
    }
    if (IN(PH_INPROJ)) { MKCTX();
        REP(PH_INPROJ) {
        EpiInProj ep{c.ws<float>(WS_GQKV), c.ws<bf16>(WS_ZS), c.ws<float>(WS_RKV), c.ws<float>(WS_LIN), c.ws<bf16>(WS_GATES)};
        SchedInProj sc{(const char*)c.ws<bf16>(WS_HB), (const char*)c.ws<bf16>(WS_WIN_T), (int)gridDim.x, (int)blockIdx.x};
        pg8::gemm_phase((LAS unsigned char*)lds, 1024, sc, ep, c.tid);
        }
        SEAM(PH_INPROJ);
    }
    if (IN(PH_GCL)) { MKCTX(); REP(PH_GCL) { ph_gcl(c); ph_loraprep(c); } SEAM(PH_GCL); }
    if (IN(PH_LORA)) { MKCTX();
        REP(PH_LORA) {
        EpiLora ep{P.in[I_W0], P.in[I_A0], c.ws<float>(WS_LW), c.ws<float>(WS_AA), c.ws<bf16>(WS_GGR)};
        SchedLora sc{(const char*)c.ws<bf16>(WS_ALORA), (const char*)c.ws<bf16>(WS_LORA_T), (int)gridDim.x, (int)blockIdx.x};
        pg8::gemm_phase((LAS unsigned char*)lds, 256, sc, ep, c.tid);
        }
        SEAM(PH_LORA);
    }
    if (IN(PH_RCL)) { MKCTX(); REP(PH_RCL) { ph_rcl(c); } SEAM(PH_RCL); }
    if (IN(PH_SCAN)) { MKCTX(); REP(PH_SCAN) { ph_scan(c); } SEAM(PH_SCAN); }
    if (IN(PH_POST)) { MKCTX();
        REP(PH_POST) {
        ph_post(c);
        { WJob j{P.in[I_PROJ_A], 1024, 1024, 1024, c.ws<bf16>(WS_PROJ_T), 1024, 1, 0, 0}; wconv_job(c, j); }
        { WJob j{P.in[I_PROJ_B], 1024, 1024, 1024, c.ws<bf16>(WS_PROJ_T) + (size_t)1024 * 1024, 1024, 1, 0, 0}; wconv_job(c, j); }
        { WJob j{P.in[I_W_OUT], 1024, 1024, 1024, c.ws<bf16>(WS_WOUT_T), 2048, 2, 0, 1024}; wconv_job(c, j); }
        }
        SEAM(PH_POST);
    }
    if (IN(PH_G2)) { MKCTX();
        REP(PH_G2) {
        EpiG2 ep{c.ws<bf16>(WS_GATES), c.ws<bf16>(WS_G2)};
        SchedG2 sc{(const char*)c.ws<bf16>(WS_YA), (const char*)c.ws<bf16>(WS_YB), (const char*)c.ws<bf16>(WS_PROJ_T), (int)gridDim.x, (int)blockIdx.x};
        pg8::gemm_phase((LAS unsigned char*)lds, 1024, sc, ep, c.tid);
        }
        SEAM(PH_G2);
    }
    if (IN(PH_X1)) { MKCTX();
        REP(PH_X1) {
        EpiX1 ep{P.in[I_X], c.ws<float>(WS_X1)};
        SchedX1 sc{(const char*)c.ws<bf16>(WS_G2), (const char*)c.ws<bf16>(WS_WOUT_T), (int)gridDim.x, (int)blockIdx.x};
        pg8::gemm_phase((LAS unsigned char*)lds, 2048, sc, ep, c.tid);
        }
        SEAM(PH_X1);
    }
    if (IN(PH_ROUTER)) { MKCTX();
        ph_router(c);
        REP(PH_ROUTER) {
        { WJob j{P.in[I_W_GU], 2048, 1024, 2048, c.ws<bf16>(WS_WGU_T), 1024, 32, (size_t)1024 * 2048, (size_t)2048 * 1024}; wconv_job(c, j); }
        { WJob j{P.in[I_W_DOWN], 1024, 1024, 1024, c.ws<bf16>(WS_WDN_T), 1024, 32, (size_t)1024 * 1024, (size_t)1024 * 1024}; wconv_job(c, j); }
        }
        SEAM(PH_ROUTER);
    }
    if (IN(PH_DISPATCH)) { MKCTX(); REP(PH_DISPATCH) { ph_dispatch(c); } SEAM(PH_DISPATCH); }
    if (IN(PH_MOE1)) { MKCTX();
        REP(PH_MOE1) {
        const int nt = *c.ws<int>(WS_NT);
        EpiAct ep{P.in[I_B_GU], c.ws<bf16>(WS_ACT)};
        SchedMoe sc{(const char*)c.ws<bf16>(WS_XB), (const char*)c.ws<bf16>(WS_WGU_T), c.ws<int>(WS_TILE_E), nt, 8, (int)gridDim.x, (int)blockIdx.x};
        pg8::gemm_phase((LAS unsigned char*)lds, 1024, sc, ep, c.tid);
        }
        SEAM(PH_MOE1);
    }
    if (IN(PH_MOE2)) { MKCTX();
        REP(PH_MOE2) {
        const int nt = *c.ws<int>(WS_NT);
        EpiYS ep{P.in[I_B_DOWN], c.ws<float>(WS_SGATE), c.ws<bf16>(WS_YS)};
        SchedMoe sc{(const char*)c.ws<bf16>(WS_ACT), (const char*)c.ws<bf16>(WS_WDN_T), c.ws<int>(WS_TILE_E), nt, 4, (int)gridDim.x, (int)blockIdx.x};
        pg8::gemm_phase((LAS unsigned char*)lds, 1024, sc, ep, c.tid);
        }
        SEAM(PH_MOE2);
    }
    if (IN(PH_COMBINE)) { MKCTX(); REP(PH_COMBINE) { ph_combine(c); } }
#undef IN
#undef SEAM
#undef REP
#undef MKCTX
}

template <unsigned M> static void launch_one(const Params& p, int grid, hipStream_t stream) {
    static bool attr = false;
    if (!attr) { (void)hipFuncSetAttribute((const void*)mk<M>, hipFuncAttributeMaxDynamicSharedMemorySize, LDS_BYTES); attr = true; }
    hipLaunchKernelGGL(mk<M>, dim3(grid), dim3(NTHREADS), LDS_BYTES, stream, p);
}
template <int PH> static void launch_chain(Params& p, int grid, hipStream_t stream) {
    if constexpr (PH < PH_COUNT) { p.ph_lo = PH; p.ph_hi = PH + 1; p.li = 0; p.coop = 0; launch_one<(1u << PH)>(p, grid, stream); launch_chain<PH + 1>(p, grid, stream); }
}

extern "C" void kernel_launch(void* const* d_in, const int* in_sizes, int n_in, void* d_out, int out_size, void* d_ws, size_t ws_size, hipStream_t stream) {
    static int grid = 0;
    if (grid == 0) {
        int dev = 0, cus = 0, per_cu = 0;
        (void)hipGetDevice(&dev);
        (void)hipDeviceGetAttribute(&cus, hipDeviceAttributeMultiprocessorCount, dev);
#if MK_ONE_LAUNCH
        (void)hipFuncSetAttribute((const void*)mk<0xffffffffu>, hipFuncAttributeMaxDynamicSharedMemorySize, LDS_BYTES);
        (void)hipOccupancyMaxActiveBlocksPerMultiprocessor(&per_cu, (const void*)mk<0xffffffffu>, NTHREADS, LDS_BYTES);
#else
        per_cu = 1;
#endif
        if (n_in != 29 || ws_size < WS_END || per_cu < 1 || cus < 64) { fprintf(stderr, "kernel_launch: unexpected setup n_in %d ws %zu per_cu %d cus %d\n", n_in, ws_size, per_cu, cus); grid = -1; return; }
        grid = cus;
    }
    if (grid < 0) return;
    (void)hipMemsetAsync((char*)d_ws + WS_CTL, 0, CTL_BYTES, stream);
    Params p{};
    for (int i = 0; i < 29; ++i) p.in[i] = (const float*)d_in[i];
    p.out = (float*)d_out; p.ws = (unsigned char*)d_ws;
#if MK_ONE_LAUNCH
    p.ph_lo = 0; p.ph_hi = PH_COUNT; p.li = 0; p.coop = 1;
    void* args[] = {&p};
    hipError_t e = hipLaunchCooperativeKernel((const void*)mk<0xffffffffu>, dim3(grid), dim3(NTHREADS), args, LDS_BYTES, stream);
    if (e != hipSuccess) fprintf(stderr, "cooperative launch failed: %s (grid %d)\n", hipGetErrorString(e), grid);
#else
    launch_chain<0>(p, grid, stream);
#endif
}
```

```cpp
#include <hip/hip_runtime.h>
#include <hip/hip_cooperative_groups.h>
#include <cstdint>
#include <cstdio>
namespace cg = cooperative_groups;

#ifndef MK_ONE_LAUNCH
#define MK_ONE_LAUNCH 1
#endif

#define LAS __attribute__((address_space(3)))
#ifndef FAST_INPROJ
#define FAST_INPROJ 1
#endif
#ifndef FAST_MIX
#define FAST_MIX 1
#endif
#define PROBE_REP -1
constexpr int NTHREADS = 512;
constexpr int NWAVES = 8;
constexpr int LDS_BYTES = 155648;
constexpr int MISC_OFF = 153600;

constexpr int T = 16384, SEQ = 4096, D = 1024;
constexpr int NCOL_IN = 9488;
constexpr int NEXP = 32;
constexpr int MAXTILES = 288;
constexpr int MAXSLOTS = MAXTILES * 256;

enum { I_X = 0, I_NORM_MIX, I_W_IN, I_GDN_CONV, I_GDN_ALOG, I_GDN_DTB, I_GDN_NORM, I_MU, I_W0, I_W2, I_A0, I_A2, I_G2, I_KK, I_KA, I_RK,
       I_LNW, I_LNB, I_PROJ_A, I_PROJ_B, I_W_OUT, I_NORM_FFN, I_ROUTER_W, I_ROUTER_B, I_W_GU, I_B_GU, I_W_DOWN, I_B_DOWN, I_NORM_FINAL };

constexpr size_t MiB = 1u << 20;
constexpr size_t WS_CTL = 0, CTL_BYTES = 65536;
constexpr size_t WS_BETA = 1 * MiB;
constexpr size_t WS_GG = WS_BETA + 512 * 1024;
constexpr size_t WS_SC = 2 * MiB;
constexpr size_t WS_TE = 3 * MiB;
constexpr size_t WS_TG = WS_TE + 256 * 1024;
constexpr size_t WS_TP = WS_TG + 256 * 1024;
constexpr size_t WS_TSLOT = WS_TP + 256 * 1024;
constexpr size_t WS_SGATE = 4 * MiB;
constexpr size_t WS_TILE_E = 5 * MiB;
constexpr size_t WS_NT = WS_TILE_E + 4096;
constexpr size_t WS_HB = 8 * MiB;
constexpr size_t WS_H2 = WS_HB;
constexpr size_t WS_ZS = 40 * MiB;
constexpr size_t WS_GATES = 72 * MiB;
constexpr size_t WS_ALORA = 136 * MiB;
constexpr size_t WS_LW = 144 * MiB;
constexpr size_t WS_AA = 208 * MiB;
constexpr size_t WS_GGR = 272 * MiB;
constexpr size_t WS_VP = 304 * MiB;
constexpr size_t WS_Q = 336 * MiB;
constexpr size_t WS_QKVC = WS_Q;
constexpr size_t WS_RP = WS_Q, WS_KF = WS_Q + 64 * MiB, WS_KKN = WS_Q + 128 * MiB;
constexpr size_t WS_YA = WS_Q, WS_YB = WS_Q + 32 * MiB, WS_G2 = WS_Q + 64 * MiB, WS_X1 = WS_Q + 128 * MiB;
constexpr size_t WS_GQKV = 528 * MiB;
constexpr size_t WS_OG = 720 * MiB, WS_ORW = 784 * MiB;
constexpr size_t WS_RKV = 720 * MiB;
constexpr size_t WS_LIN = 912 * MiB;
constexpr size_t WS_DEC = 928 * MiB;
constexpr size_t WS_XB = 528 * MiB;
constexpr size_t WS_ACT = 672 * MiB;
constexpr size_t WS_YS = 816 * MiB;
constexpr size_t WS_WIN_T = 992 * MiB;
constexpr size_t WS_PROJ_T = 144 * MiB;
constexpr size_t WS_WOUT_T = 148 * MiB;
constexpr size_t WS_WGU_T = 72 * MiB;
constexpr size_t WS_WDN_T = 200 * MiB;
constexpr size_t WS_GA1 = 336 * MiB, WS_GX0 = 368 * MiB, WS_GA2 = 432 * MiB, WS_GA3 = 464 * MiB, WS_GA4 = 480 * MiB;
constexpr size_t WS_GGL = 6 * MiB;
constexpr size_t WS_RX0 = 528 * MiB, WS_RO0 = 592 * MiB, WS_RS0 = 656 * MiB;
constexpr size_t WS_RA1 = 8 * MiB, WS_RA2 = 928 * MiB, WS_RA3 = 960 * MiB, WS_RA4 = 992 * MiB;
constexpr size_t WS_RDSC = 7 * MiB;
constexpr size_t WS_LORA_T = 1012 * MiB;
constexpr size_t WS_END = 1024 * MiB;
constexpr int CW_BAR = 1024;
constexpr int CW_CNT = 256;

#define XB_TMO      128
#define XB_XCNT(j)  (256  + 64 * (j))
#define XB_XSUB(j)  (1280 + 64 * (j))
#define XB_XGEN(j)  (2304 + 64 * (j))
#define XB_TOP      3328
#define XB_TOPGEN   3392
#define XCD_BAR_WORDS 3456
#define XB_SPIN_CAP (1u << 24)
__device__ __forceinline__ unsigned xb_ld(unsigned* p)              { return __hip_atomic_load(p, __ATOMIC_RELAXED, __HIP_MEMORY_SCOPE_AGENT); }
__device__ __forceinline__ unsigned xb_add(unsigned* p, unsigned v) { return __hip_atomic_fetch_add(p, v, __ATOMIC_RELAXED, __HIP_MEMORY_SCOPE_AGENT); }
__device__ __forceinline__ unsigned xb_xcc_id() { return (unsigned)__builtin_amdgcn_s_getreg((3 << 11) | 20) & 0xFu; }
#define XB_SPIN(cond, bar) do { unsigned _sp = 0; while (cond) { __builtin_amdgcn_s_sleep(1); \
    if ((++_sp & 255u) == 0u) { if (xb_ld(&(bar)[XB_TMO])) break; if (_sp > XB_SPIN_CAP) { atomicAdd(&(bar)[XB_TMO], 1u); break; } } } } while (0)
struct XcdBarrier { unsigned* bar; unsigned x; volatile LAS unsigned* st; };
__device__ __forceinline__ XcdBarrier xcd_barrier_post(unsigned* bar, volatile LAS unsigned* st) {
    XcdBarrier b; b.bar = bar; b.x = xb_xcc_id(); b.st = st;
    if (threadIdx.x == 0) (void)xb_add(&bar[XB_XCNT(b.x)], 1u);
    return b;
}
__device__ __forceinline__ void xcd_barrier_complete(unsigned* bar, unsigned x, unsigned& nloc, unsigned& nx) {
    const unsigned G = gridDim.x * gridDim.y * gridDim.z;
    unsigned sum, cnt, mine, sp = 0u;
    for (;;) {
        sum = 0u; cnt = 0u; mine = 0u;
#pragma unroll
        for (unsigned j = 0; j < 16; ++j) { const unsigned c = xb_ld(&bar[XB_XCNT(j)]); sum += c; cnt += (c > 0u) ? 1u : 0u; mine = (j == x) ? c : mine; }
        if (sum == G) break;
        __builtin_amdgcn_s_sleep(1);
        if ((++sp & 255u) == 0u) { if (xb_ld(&bar[XB_TMO])) break; if (sp > XB_SPIN_CAP) { atomicAdd(&bar[XB_TMO], 1u); break; } }
    }
    nloc = mine > 0u ? mine : 1u; nx = cnt > 0u ? cnt : 1u;
}
__device__ __forceinline__ void xcd_barrier(const XcdBarrier& b) {
    asm volatile("s_waitcnt vmcnt(0)" ::: "memory");
    __syncthreads();
    if (threadIdx.x == 0) {
        unsigned* bar = b.bar;
        __builtin_amdgcn_s_waitcnt(0);
        unsigned nloc = b.st[0], nx = b.st[1];
        if (nloc == 0u) { xcd_barrier_complete(bar, b.x, nloc, nx); b.st[0] = nloc; b.st[1] = nx; }
        const unsigned old = xb_add(&bar[XB_XSUB(b.x)], 1u);
        const unsigned gen = old / nloc;
        if (old + 1u == (gen + 1u) * nloc) {
            __builtin_amdgcn_fence(__ATOMIC_RELEASE, "agent");
            asm volatile("s_waitcnt vmcnt(0)" ::: "memory");
            const unsigned og = xb_add(&bar[XB_TOP], 1u);
            const unsigned tg = og / nx;
            if (og + 1u == (tg + 1u) * nx) xb_add(&bar[XB_TOPGEN], 1u);
            else XB_SPIN(xb_ld(&bar[XB_TOPGEN]) == tg, bar);
            __builtin_amdgcn_fence(__ATOMIC_ACQUIRE, "agent");
            xb_add(&bar[XB_XGEN(b.x)], 1u);
            asm volatile("s_waitcnt vmcnt(0)" ::: "memory");
        } else {
            XB_SPIN(xb_ld(&bar[XB_XGEN(b.x)]) == gen, bar);
            __builtin_amdgcn_fence(__ATOMIC_ACQUIRE, "agent");
            asm volatile("s_waitcnt vmcnt(0)" ::: "memory");
        }
    }
    __syncthreads();
}

typedef unsigned short bf16;
__device__ __forceinline__ bf16 f2bf(float f) { unsigned u = __float_as_uint(f); u += 0x7fffu + ((u >> 16) & 1u); return (bf16)(u >> 16); }
__device__ __forceinline__ float bf2f(unsigned b) { return __uint_as_float(b << 16); }
__device__ __forceinline__ unsigned pk2(float lo, float hi) { return (unsigned)f2bf(lo) | ((unsigned)f2bf(hi) << 16); }
__device__ __forceinline__ float bflo(unsigned w) { return __uint_as_float(w << 16); }
__device__ __forceinline__ float bfhi(unsigned w) { return __uint_as_float(w & 0xffff0000u); }
__device__ __forceinline__ float sigm(float x) { return 1.f / (1.f + expf(-x)); }
__device__ __forceinline__ float fsigm(float x) { return __builtin_amdgcn_rcpf(1.f + __expf(-x)); }
__device__ __forceinline__ float softplusf(float x) { return x > 20.f ? x : log1pf(expf(x)); }
__device__ __forceinline__ float wsum(float v) {
#pragma unroll
    for (int o = 32; o > 0; o >>= 1) v += __shfl_xor(v, o);
    return v;
}

struct Params { const float* in[29]; float* out; unsigned char* ws; int ph_lo, ph_hi, li, coop; };

struct Ctx {
    const Params& P; int tid, lane, wave, gwave, nwaves; size_t gtid, nthreads; unsigned char* lds;
    template <class Tp> __device__ __forceinline__ Tp* ws(size_t off) const { return (Tp*)(P.ws + off); }
};

__device__ __forceinline__ void ph_rms0(const Ctx& c) {
    const float* x = c.P.in[I_X]; const float* nw = c.P.in[I_NORM_MIX]; const float* win = c.P.in[I_W_IN];
    const float* alog = c.P.in[I_GDN_ALOG]; const float* dtb = c.P.in[I_GDN_DTB];
    bf16* HB = c.ws<bf16>(WS_HB); float* BETA = c.ws<float>(WS_BETA); float* GGv = c.ws<float>(WS_GG);
    if (blockIdx.x == 0 && c.tid < NEXP) c.ws<unsigned>(WS_CTL)[CW_CNT + c.tid] = 0u;
    float4* tab = (float4*)c.lds;
    __syncthreads();
    for (int i = c.tid; i < 4096; i += NTHREADS) { const int k = i >> 2; tab[((k & 3) * 256 + (k >> 2)) * 5 + (i & 3)] = *(const float4*)(win + (size_t)k * NCOL_IN + 4096 + (i & 3) * 4); }
    __syncthreads();
    const int lane = c.lane;
    for (int t = c.gwave; t < T; t += c.nwaves) {
        float4 v[4]; float ss = 0.f;
#pragma unroll
        for (int i = 0; i < 4; ++i) { v[i] = ((const float4*)(x + (size_t)t * D))[lane + 64 * i]; ss += v[i].x * v[i].x + v[i].y * v[i].y + v[i].z * v[i].z + v[i].w * v[i].w; }
        ss = wsum(ss);
        const float rstd = rsqrtf(ss * (1.f / 1024.f) + 1e-6f);
        float acc[16];
#pragma unroll
        for (int j = 0; j < 16; ++j) acc[j] = 0.f;
#pragma unroll
        for (int i = 0; i < 4; ++i) {
            const float4 w4 = ((const float4*)nw)[lane + 64 * i];
            float h[4] = {v[i].x * rstd * w4.x, v[i].y * rstd * w4.y, v[i].z * rstd * w4.z, v[i].w * rstd * w4.w};
            uint2 st; st.x = pk2(h[0], h[1]); st.y = pk2(h[2], h[3]);
            *(uint2*)(HB + (size_t)t * D + 4 * (lane + 64 * i)) = st;
#pragma unroll
            for (int ii = 0; ii < 4; ++ii) {
                const int k = 4 * (lane + 64 * i) + ii;
#pragma unroll
                for (int q = 0; q < 4; ++q) { const float4 w = tab[(ii * 256 + (k >> 2)) * 5 + q]; acc[4 * q + 0] += h[ii] * w.x; acc[4 * q + 1] += h[ii] * w.y; acc[4 * q + 2] += h[ii] * w.z; acc[4 * q + 3] += h[ii] * w.w; }
                if (ii & 1) asm volatile("" ::: "memory");
            }
        }
        float mine = 0.f;
#pragma unroll
        for (int j = 0; j < 16; ++j) { const float s = wsum(acc[j]); mine = (lane == j) ? s : mine; }
        if (lane < 8) BETA[t * 8 + lane] = sigm(mine);
        else if (lane < 16) { const int h = lane - 8; GGv[t * 8 + h] = -expf(alog[h]) * softplusf(mine + dtb[h]); }
    }
    __syncthreads();
}

struct TileInfo { const bf16* A; int lda; const float* B; int ldb; int kmask; int row0; int col0; int aux; };

template <class TF, class EP>
__device__ __forceinline__ void ngemm(const Ctx& c, int ntiles, const TF& tf, const EP& ep, int K) {
    float* As = (float*)c.lds;
    float* Bs = As + 16 * 132;
    const int tid = c.tid, ty = tid >> 4, tx = tid & 15;
    const int ar = tid >> 2, ak = (tid & 3) * 4;
    const int bk = tid >> 5, bc = (tid & 31) * 4;
    for (int tile = blockIdx.x; tile < ntiles; tile += gridDim.x) {
        TileInfo ti; tf(tile, ti);
        float acc[4][8];
#pragma unroll
        for (int r = 0; r < 4; ++r)
#pragma unroll
            for (int j = 0; j < 8; ++j) acc[r][j] = 0.f;
        const bf16* ap = ti.A + (size_t)ar * ti.lda + ak;
        for (int k0 = 0; k0 < K; k0 += 16) {
            const uint2 av = *(const uint2*)(ap + k0);
            const float4 bv = *(const float4*)(ti.B + (size_t)((k0 + bk) & ti.kmask) * ti.ldb + bc);
            __syncthreads();
            As[(ak + 0) * 132 + ar] = bflo(av.x); As[(ak + 1) * 132 + ar] = bfhi(av.x);
            As[(ak + 2) * 132 + ar] = bflo(av.y); As[(ak + 3) * 132 + ar] = bfhi(av.y);
            *(float4*)(Bs + bk * 132 + bc) = bv;
            __syncthreads();
#pragma unroll
            for (int k = 0; k < 16; ++k) {
                const float4 a = *(const float4*)(As + k * 132 + ty * 4);
                const float4 b0 = *(const float4*)(Bs + k * 132 + tx * 8), b1 = *(const float4*)(Bs + k * 132 + tx * 8 + 4);
                const float av4[4] = {a.x, a.y, a.z, a.w};
                const float bv8[8] = {b0.x, b0.y, b0.z, b0.w, b1.x, b1.y, b1.z, b1.w};
#pragma unroll
                for (int r = 0; r < 4; ++r)
#pragma unroll
                    for (int j = 0; j < 8; ++j) acc[r][j] += av4[r] * bv8[j];
            }
        }
#pragma unroll
        for (int r = 0; r < 4; ++r) ep.store8(ti.row0 + ty * 4 + r, ti.col0 + tx * 8, acc[r], ti.aux);
    }
}

struct EpiInProj {
    bf16* GQKV; bf16* ZS; bf16* RKV; float* LIN; bf16* GATES;
    __device__ __forceinline__ void store8(int row, int col, const float (&v)[8], int) const {
        if (col < 3072) { uint4 w; w.x = pk2(v[0], v[1]); w.y = pk2(v[2], v[3]); w.z = pk2(v[4], v[5]); w.w = pk2(v[6], v[7]); *(uint4*)(GQKV + (size_t)row * 3072 + col) = w; }
        else if (col < 4096) { uint4 w; w.x = pk2(v[0] * fsigm(v[0]), v[1] * fsigm(v[1])); w.y = pk2(v[2] * fsigm(v[2]), v[3] * fsigm(v[3])); w.z = pk2(v[4] * fsigm(v[4]), v[5] * fsigm(v[5])); w.w = pk2(v[6] * fsigm(v[6]), v[7] * fsigm(v[7]));
            *(uint4*)(ZS + (size_t)row * 1024 + (col - 3072)) = w; }
        else if (col < 7168) { uint4 w; w.x = pk2(v[0], v[1]); w.y = pk2(v[2], v[3]); w.z = pk2(v[4], v[5]); w.w = pk2(v[6], v[7]); *(uint4*)(RKV + (size_t)row * 3072 + (col - 4096)) = w; }
        else if (col < 7424) { float* p = LIN + (size_t)row * 256 + (col - 7168); *(float4*)p = make_float4(v[0], v[1], v[2], v[3]); *(float4*)(p + 4) = make_float4(v[4], v[5], v[6], v[7]); }
        else { uint4 w; w.x = pk2(fsigm(v[0]), fsigm(v[1])); w.y = pk2(fsigm(v[2]), fsigm(v[3])); w.z = pk2(fsigm(v[4]), fsigm(v[5])); w.w = pk2(fsigm(v[6]), fsigm(v[7]));
            *(uint4*)(GATES + (size_t)row * 2048 + (col - 7424)) = w; }
    }
};
struct EpiG2 {
    const bf16* GATES; bf16* G2;
    __device__ __forceinline__ void store8(int row, int col, const float (&v)[8], int) const {
        const uint4 g = *(const uint4*)(GATES + (size_t)row * 2048 + col);
        uint4 w; w.x = pk2(v[0] * bflo(g.x), v[1] * bfhi(g.x)); w.y = pk2(v[2] * bflo(g.y), v[3] * bfhi(g.y)); w.z = pk2(v[4] * bflo(g.z), v[5] * bfhi(g.z)); w.w = pk2(v[6] * bflo(g.w), v[7] * bfhi(g.w));
        *(uint4*)(G2 + (size_t)row * 2048 + col) = w;
    }
};
struct EpiX1 {
    const float* X; float* X1;
    __device__ __forceinline__ void store8(int row, int col, const float (&v)[8], int) const {
        const float* xp = X + (size_t)row * 1024 + col; float* op = X1 + (size_t)row * 1024 + col;
        const float4 a = *(const float4*)xp, b = *(const float4*)(xp + 4);
        *(float4*)op = make_float4(a.x + v[0], a.y + v[1], a.z + v[2], a.w + v[3]); *(float4*)(op + 4) = make_float4(b.x + v[4], b.y + v[5], b.z + v[6], b.w + v[7]);
    }
};
struct EpiAct {
    const float* BGU; bf16* ACT;
    __device__ __forceinline__ void store8(int row, int col, const float (&v)[8], int e) const {
        const float* bp = BGU + (size_t)e * 2048 + col;
        const float4 b0 = *(const float4*)bp, b1 = *(const float4*)(bp + 4);
        const float bb[8] = {b0.x, b0.y, b0.z, b0.w, b1.x, b1.y, b1.z, b1.w};
        float o[4];
#pragma unroll
        for (int p = 0; p < 4; ++p) { float glu = v[2 * p] + bb[2 * p], lin = v[2 * p + 1] + bb[2 * p + 1]; glu = fminf(glu, 7.f); lin = fminf(fmaxf(lin, -7.f), 7.f); o[p] = glu * fsigm(1.702f * glu) * (lin + 1.f); }
        uint2 w; w.x = pk2(o[0], o[1]); w.y = pk2(o[2], o[3]);
        *(uint2*)(ACT + (size_t)row * 1024 + (col >> 1)) = w;
    }
};
struct EpiYS {
    const float* BD; const float* SGATE; bf16* YS;
    __device__ __forceinline__ void store8(int row, int col, const float (&v)[8], int e) const {
        const float* bp = BD + (size_t)e * 1024 + col; const float g = SGATE[row];
        const float4 b0 = *(const float4*)bp, b1 = *(const float4*)(bp + 4);
        uint4 w; w.x = pk2((v[0] + b0.x) * g, (v[1] + b0.y) * g); w.y = pk2((v[2] + b0.z) * g, (v[3] + b0.w) * g); w.z = pk2((v[4] + b1.x) * g, (v[5] + b1.y) * g); w.w = pk2((v[6] + b1.z) * g, (v[7] + b1.w) * g);
        *(uint4*)(YS + (size_t)row * 1024 + col) = w;
    }
};

struct TfInProj { const bf16* HB; const float* W;
    __device__ __forceinline__ void operator()(int tile, TileInfo& ti) const { const int tm = tile / 74, tn = tile % 74; ti.A = HB + (size_t)tm * 128 * 1024; ti.lda = 1024; ti.col0 = tn * 128; ti.row0 = tm * 128;
        ti.B = W + ti.col0 + (ti.col0 >= 4096 ? 16 : 0); ti.ldb = NCOL_IN; ti.kmask = 0x7fffffff; ti.aux = 0; } };
struct TfG2 { const bf16* YA; const bf16* YB; const float* PA; const float* PB;
    __device__ __forceinline__ void operator()(int tile, TileInfo& ti) const { const int tm = tile / 16, tn = tile % 16; ti.A = (tn < 8 ? YA : YB) + (size_t)tm * 128 * 1024; ti.lda = 1024; ti.col0 = tn * 128; ti.row0 = tm * 128;
        ti.B = (tn < 8 ? PA + tn * 128 : PB + (tn - 8) * 128); ti.ldb = 1024; ti.kmask = 0x7fffffff; ti.aux = 0; } };
struct TfX1 { const bf16* G2; const float* WO;
    __device__ __forceinline__ void operator()(int tile, TileInfo& ti) const { const int tm = tile / 8, tn = tile % 8; ti.A = G2 + (size_t)tm * 128 * 2048; ti.lda = 2048; ti.col0 = tn * 128; ti.row0 = tm * 128;
        ti.B = WO + tn * 128; ti.ldb = 1024; ti.kmask = 1023; ti.aux = 0; } };
struct TfMoe { const bf16* A; const float* W; const int* TILE_E; int ntn; int ldb; size_t wstride;
    __device__ __forceinline__ void operator()(int tile, TileInfo& ti) const { const int mt = tile / ntn, tn = tile % ntn; const int e = TILE_E[mt >> 1]; ti.A = A + (size_t)mt * 128 * 1024; ti.lda = 1024; ti.col0 = tn * 128; ti.row0 = mt * 128;
        ti.B = W + (size_t)e * wstride + tn * 128; ti.ldb = ldb; ti.kmask = 0x7fffffff; ti.aux = e; } };


namespace pg8 {
typedef short bf16x8 __attribute__((ext_vector_type(8)));
typedef float f32x4 __attribute__((ext_vector_type(4)));
constexpr int BM = 256, BK = 64, HALF = 128, HTB = HALF * BK * 2, NXCD = 8, WGM = 8;
__host__ __device__ __forceinline__ int lds_byte(int r, int c) { const int st = (r >> 4) * 2 + (c >> 5), rr = r & 15, cc = c & 31, ob = rr * 64 + cc * 2; return st * 1024 + (ob ^ (((ob >> 9) & 1) << 5)); }
__host__ __device__ __forceinline__ void stage_rc(int b, int& R, int& C) { const int st = b / 1024, sb = b % 1024, swz = sb ^ (((sb >> 9) & 1) << 5); R = (st >> 1) * 16 + swz / 64; C = (st & 1) * 32 + (swz % 64) / 2; }
__host__ __device__ __forceinline__ int perm32(int rho) { const int n = rho >> 4, i = rho & 15; return 8 * (i >> 2) + 4 * n + (i & 3); }
struct Unit { const char* a; const char* b; int row0, col0, aux; };
__device__ __forceinline__ void tile_order(int L, int nM, int nN, int& pm, int& pn) {
    const int nwg = nM * nN; int wgid = L; { const int q = nwg / NXCD, r = nwg % NXCD, xcd = wgid % NXCD, off = wgid / NXCD; wgid = (xcd < r ? xcd * (q + 1) : r * (q + 1) + (xcd - r) * q) + off; }
    const int nig = WGM * nN, gid = wgid / nig, fm = gid * WGM, gsz = (nM - fm) < WGM ? (nM - fm) : WGM;
    pm = fm + ((wgid % nig) % gsz); pn = (wgid % nig) / gsz;
}
template <class Epi>
__device__ __forceinline__ void epi_apply(const Epi& E, const f32x4 (&acc)[2][2][4][2], const Unit& u, int wr, int wc, int fr, int fq) {
#pragma unroll
    for (int ai = 0; ai < 2; ++ai)
#pragma unroll
        for (int m = 0; m < 4; ++m)
#pragma unroll
            for (int bj = 0; bj < 2; ++bj) {
                const f32x4 x0 = acc[ai][bj][m][0], x1 = acc[ai][bj][m][1];
                const float v[8] = {x0[0], x0[1], x0[2], x0[3], x1[0], x1[1], x1[2], x1[3]};
                E.store8(u.row0 + ai * HALF + wr * 64 + m * 16 + fr, u.col0 + bj * HALF + wc * 32 + 8 * fq, v, u.aux);
                asm volatile("" ::: "memory");
            }
}
template <class Epi, class Sched>
__device__ __forceinline__ void gemm_phase(LAS unsigned char* lds, const int K_, const Sched& S, const Epi& E, const int tid) {
    int K = K_; asm volatile("" : "+s"(K));
    const int wid = __builtin_amdgcn_readfirstlane(tid >> 6), lane = tid & 63, wr = wid >> 2, wc = wid & 3, fr = lane & 15, fq = lane >> 4;
    const int nt = K / BK;
    unsigned voffA[2], voffB[2];
#pragma unroll
    for (int i = 0; i < 2; ++i) { int R, C; stage_rc(tid * 16 + i * 8192, R, C); const int Rb = (R & ~31) + perm32(R & 31);
        voffA[i] = (unsigned)(R * K + C) * 2u; voffB[i] = (unsigned)(Rb * K + C) * 2u; }
    const size_t kstep = (size_t)(BK * 2);
    const size_t hstep = (size_t)HALF * K * 2;
    const unsigned ldsw = (unsigned)wid * 1024u;
    const int aoff = lds_byte(wr * 64 + fr, fq * 8), boff = lds_byte(wc * 32 + fr, fq * 8);
#define PG8_SA(b, h) (((b) * 2 + (h)) * HTB)
#define PG8_SB(b, h) ((4 + (b) * 2 + (h)) * HTB)
#define PG8_STAGE(bufoff, gbase, voff) do { _Pragma("unroll") for (int _i = 0; _i < 2; ++_i) \
        __builtin_amdgcn_global_load_lds((const unsigned*)((const char*)(gbase) + (voff)[_i]), (LAS unsigned*)(lds + (bufoff) + ldsw + _i * 8192), 16, 0, 0); } while (0)
#define PG8_LDA(dst, b, h) do { _Pragma("unroll") for (int m = 0; m < 4; ++m) _Pragma("unroll") for (int k = 0; k < 2; ++k) dst[m][k] = *(const LAS bf16x8*)(lds + PG8_SA(b, h) + aoff + m * 2048 + k * 1024); } while (0)
#define PG8_LDB(dst, b, h) do { _Pragma("unroll") for (int n = 0; n < 2; ++n) _Pragma("unroll") for (int k = 0; k < 2; ++k) dst[n][k] = *(const LAS bf16x8*)(lds + PG8_SB(b, h) + boff + n * 2048 + k * 1024); } while (0)
#define PG8_MMA(ai, bj, At, Bt) do { __builtin_amdgcn_s_setprio(1); _Pragma("unroll") for (int m = 0; m < 4; ++m) _Pragma("unroll") for (int n = 0; n < 2; ++n) _Pragma("unroll") for (int k = 0; k < 2; ++k) \
        acc[ai][bj][m][n] = __builtin_amdgcn_mfma_f32_16x16x32_bf16(Bt[n][k], At[m][k], acc[ai][bj][m][n], 0, 0, 0); __builtin_amdgcn_s_setprio(0); } while (0)
#define PG8_WAIT_V(n) asm volatile("s_waitcnt vmcnt(" #n ")" ::: "memory")
#define PG8_WAIT_L(n) asm volatile("s_waitcnt lgkmcnt(" #n ")" ::: "memory")
#define PG8_BAR __builtin_amdgcn_s_barrier()
#define PG8_SCHED __builtin_amdgcn_sched_barrier(0)
    Unit cur, nxt; int ui = 0;
    if (!S.next(0, cur)) return;
    f32x4 acc[2][2][4][2];
#pragma unroll
    for (int a = 0; a < 2; ++a)
#pragma unroll
        for (int b = 0; b < 2; ++b)
#pragma unroll
            for (int m = 0; m < 4; ++m)
#pragma unroll
                for (int n = 0; n < 2; ++n) acc[a][b][m][n] = (f32x4){0.f, 0.f, 0.f, 0.f};
    bf16x8 At[4][2], B0[2][2], B1[2][2];
    const char* cA = cur.a; const char* cB = cur.b;
    PG8_STAGE(PG8_SB(0, 0), cB, voffB); PG8_STAGE(PG8_SA(0, 0), cA, voffA); PG8_STAGE(PG8_SB(0, 1), cB + hstep, voffB); PG8_STAGE(PG8_SA(0, 1), cA + hstep, voffA);
    if (wr == 1) PG8_BAR;
    PG8_WAIT_V(4); PG8_BAR;
    PG8_STAGE(PG8_SB(1, 0), cB + kstep, voffB); PG8_STAGE(PG8_SA(1, 0), cA + kstep, voffA); PG8_STAGE(PG8_SB(1, 1), cB + hstep + kstep, voffB);
    PG8_WAIT_V(6); PG8_BAR;
    for (;;) {
        const bool has_next = S.next(ui + 1, nxt);
        const char* nA = has_next ? nxt.a : cA; const char* nB = has_next ? nxt.b : cB;
#pragma unroll 1
        for (int t = 0; t < nt; t += 2) {
            const bool last = (t == nt - 2);
            const char* a1 = cA + (size_t)(t + 1) * kstep;
            const char* a2 = last ? nA : cA + (size_t)(t + 2) * kstep; const char* b2 = last ? nB : cB + (size_t)(t + 2) * kstep;
            const char* a3 = a2 + kstep; const char* b3 = b2 + kstep;
            PG8_LDB(B0, 0, 0); PG8_SCHED; PG8_LDA(At, 0, 0); PG8_STAGE(PG8_SA(1, 1), a1 + hstep, voffA);
            PG8_WAIT_L(8); PG8_BAR; PG8_WAIT_L(0); PG8_MMA(0, 0, At, B0); PG8_BAR; PG8_SCHED;
            PG8_LDB(B1, 0, 1); PG8_STAGE(PG8_SB(0, 0), b2, voffB);
            PG8_BAR; PG8_WAIT_L(0); PG8_MMA(0, 1, At, B1); PG8_BAR;
            PG8_LDA(At, 0, 1); PG8_STAGE(PG8_SA(0, 0), a2, voffA);
            PG8_BAR; PG8_WAIT_L(0); PG8_MMA(1, 0, At, B0); PG8_BAR; PG8_SCHED;
            PG8_STAGE(PG8_SB(0, 1), b2 + hstep, voffB);
            PG8_WAIT_V(6); PG8_BAR; PG8_MMA(1, 1, At, B1); PG8_BAR;
            PG8_LDB(B0, 1, 0); PG8_SCHED; PG8_LDA(At, 1, 0); PG8_STAGE(PG8_SA(0, 1), a2 + hstep, voffA);
            PG8_WAIT_L(8); PG8_BAR; PG8_WAIT_L(0); PG8_MMA(0, 0, At, B0); PG8_BAR; PG8_SCHED;
            PG8_LDB(B1, 1, 1); PG8_STAGE(PG8_SB(1, 0), b3, voffB);
            PG8_BAR; PG8_WAIT_L(0); PG8_MMA(0, 1, At, B1); PG8_BAR;
            PG8_LDA(At, 1, 1); PG8_STAGE(PG8_SA(1, 0), a3, voffA);
            PG8_BAR; PG8_WAIT_L(0); PG8_MMA(1, 0, At, B0); PG8_BAR; PG8_SCHED;
            PG8_STAGE(PG8_SB(1, 1), b3 + hstep, voffB);
            PG8_WAIT_V(6); PG8_BAR; PG8_MMA(1, 1, At, B1); PG8_BAR;
        }
        epi_apply(E, acc, cur, wr, wc, fr, fq);
        if (!has_next) break;
#pragma unroll
        for (int a = 0; a < 2; ++a)
#pragma unroll
            for (int b = 0; b < 2; ++b)
#pragma unroll
                for (int m = 0; m < 4; ++m)
#pragma unroll
                    for (int n = 0; n < 2; ++n) acc[a][b][m][n] = (f32x4){0.f, 0.f, 0.f, 0.f};
        cur = nxt; cA = nA; cB = nB; ++ui;
    }
    PG8_WAIT_V(0);
    if (wr == 0) PG8_BAR;
    PG8_BAR;
#undef PG8_SA
#undef PG8_SB
#undef PG8_STAGE
#undef PG8_LDA
#undef PG8_LDB
#undef PG8_MMA
#undef PG8_WAIT_V
#undef PG8_WAIT_L
#undef PG8_BAR
#undef PG8_SCHED
}
}

struct SchedInProj { const char* A; const char* Bt; int G, c;
    __device__ __forceinline__ bool next(int i, pg8::Unit& u) const { const int L = i * G + c; if (L >= 64 * 37) return false; int pm, pn; pg8::tile_order(L, 64, 37, pm, pn);
        u.a = A + (size_t)pm * (256 * 1024 * 2); u.b = Bt + (size_t)pn * (256 * 1024 * 2); u.row0 = pm * 256; u.col0 = pn * 256; u.aux = 0; return true; } };

struct WJob { const float* src; int ld_src; int K; int ncols; bf16* dst; int ld_dst; int nb; size_t sstride, dstride; };
__device__ __forceinline__ void wconv_job(const Ctx& c, const WJob& j) {
    float* tl = (float*)c.lds;
    const int ntk = j.K >> 6, ntn = j.ncols >> 6, per = ntk * ntn, ntiles = per * j.nb;
    const int rk = c.tid >> 3, rseg = (c.tid & 7) * 8;
    for (int tile = blockIdx.x; tile < ntiles; tile += gridDim.x) {
        const int bi = tile / per, tt = tile % per, tk = tt % ntk, tn = tt / ntk;
        const float* sp = j.src + (size_t)bi * j.sstride + (size_t)(tk * 64 + rk) * j.ld_src + tn * 64 + rseg;
        const float4 a = *(const float4*)sp, b = *(const float4*)(sp + 4);
        __syncthreads();
        float* row = tl + rk * 65 + rseg;
        row[0] = a.x; row[1] = a.y; row[2] = a.z; row[3] = a.w; row[4] = b.x; row[5] = b.y; row[6] = b.z; row[7] = b.w;
        __syncthreads();
        const float* col = tl + rseg * 65 + rk;
        uint4 w; w.x = pk2(col[0], col[65]); w.y = pk2(col[130], col[195]); w.z = pk2(col[260], col[325]); w.w = pk2(col[390], col[455]);
        *(uint4*)(j.dst + (size_t)bi * j.dstride + (size_t)(tn * 64 + rk) * j.ld_dst + tk * 64 + rseg) = w;
    }
}
struct SchedG2 { const char* YA; const char* YB; const char* Bt; int G, c;
    __device__ __forceinline__ bool next(int i, pg8::Unit& u) const { const int L = i * G + c; if (L >= 64 * 8) return false; int pm, pn; pg8::tile_order(L, 64, 8, pm, pn);
        u.a = (pn < 4 ? YA : YB) + (size_t)pm * (256 * 1024 * 2); u.b = Bt + (size_t)pn * (256 * 1024 * 2); u.row0 = pm * 256; u.col0 = pn * 256; u.aux = 0; return true; } };
struct SchedX1 { const char* A; const char* Bt; int G, c;
    __device__ __forceinline__ bool next(int i, pg8::Unit& u) const { const int L = i * G + c; if (L >= 64 * 4) return false; int pm, pn; pg8::tile_order(L, 64, 4, pm, pn);
        u.a = A + (size_t)pm * (256 * 2048 * 2); u.b = Bt + (size_t)pn * (256 * 2048 * 2); u.row0 = pm * 256; u.col0 = pn * 256; u.aux = 0; return true; } };
struct SchedMoe { const char* A; const char* Bt; const int* TILE_E; int NT, NPN, G, c;
    __device__ __forceinline__ bool next(int i, pg8::Unit& u) const { const int L = i * G + c; if (L >= NT * NPN) return false; const int tile = L / NPN, pn = L % NPN; const int e = TILE_E[tile];
        u.a = A + (size_t)tile * (256 * 1024 * 2); u.b = Bt + (size_t)(e * NPN + pn) * (256 * 1024 * 2); u.row0 = tile * 256; u.col0 = pn * 256; u.aux = e; return true; } };


struct EpiLora {
    const float* w0; const float* a0; float* LW; float* AA; bf16* GGR;
    __device__ __forceinline__ void store8(int row, int col, const float (&v)[8], int) const {
        if (col < 1024) { float o[8];
#pragma unroll
            for (int i = 0; i < 8; ++i) o[i] = -0.6065306597126334f * fsigm(w0[col + i] + v[i]);
            float* p = LW + (size_t)row * 1024 + col; *(float4*)p = make_float4(o[0], o[1], o[2], o[3]); *(float4*)(p + 4) = make_float4(o[4], o[5], o[6], o[7]); }
        else if (col < 2048) { const int cc = col - 1024; float o[8];
#pragma unroll
            for (int i = 0; i < 8; ++i) o[i] = fsigm(a0[cc + i] + v[i]);
            float* p = AA + (size_t)row * 1024 + cc; *(float4*)p = make_float4(o[0], o[1], o[2], o[3]); *(float4*)(p + 4) = make_float4(o[4], o[5], o[6], o[7]); }
        else { uint4 w; w.x = pk2(v[0], v[1]); w.y = pk2(v[2], v[3]); w.z = pk2(v[4], v[5]); w.w = pk2(v[6], v[7]); *(uint4*)(GGR + (size_t)row * 1024 + (col - 2048)) = w; }
    }
};
struct SchedLora { const char* A; const char* Bt; int G, c;
    __device__ __forceinline__ bool next(int i, pg8::Unit& u) const { const int L = i * G + c; if (L >= 64 * 12) return false; int pm, pn; pg8::tile_order(L, 64, 12, pm, pn);
        u.a = A + (size_t)pm * (256 * 256 * 2); u.b = Bt + (size_t)pn * (256 * 256 * 2); u.row0 = pm * 256; u.col0 = pn * 256; u.aux = 0; return true; } };
__device__ __forceinline__ void lora_zero(const Ctx& c) {
    uint4* LT = c.ws<uint4>(WS_LORA_T);
    for (size_t idx = c.gtid; idx < (size_t)3072 * 32; idx += c.nthreads) {
        const int row = (int)(idx >> 5), k8 = (int)(idx & 31) * 8;
        const bool data = row < 1024 ? (k8 < 64) : (row < 2048 ? (k8 >= 64 && k8 < 128) : (k8 >= 128));
        if (!data) LT[idx] = make_uint4(0, 0, 0, 0);
    }
}

__device__ __forceinline__ void ph_loraprep(const Ctx& c) {
    const float* LIN = c.ws<float>(WS_LIN); bf16* AL = c.ws<bf16>(WS_ALORA); const float* mu = c.P.in[I_MU];
    for (size_t idx = c.gtid; idx < (size_t)T * 256; idx += c.nthreads) {
        const int t = (int)(idx >> 8), cc = (int)(idx & 255);
        const float x = LIN[idx], xp = (t & (SEQ - 1)) ? LIN[idx - 256] : 0.f;
        const float xs = x + (xp - x) * mu[3072 + cc];
        const float r = cc < 64 ? tanhf(xs) : (cc < 128 ? xs : sigm(xs));
        AL[idx] = f2bf(r);
    }
}
__device__ __forceinline__ void ph_post(const Ctx& c) {
    const float* OG = c.ws<float>(WS_OG); const float* ORW = c.ws<float>(WS_ORW); const bf16* ZS = c.ws<bf16>(WS_ZS); const bf16* VP = c.ws<bf16>(WS_VP); const bf16* GGR = c.ws<bf16>(WS_GGR);
    const float* SC = c.ws<float>(WS_SC); bf16* YA = c.ws<bf16>(WS_YA); bf16* YB = c.ws<bf16>(WS_YB);
    const float* gnw = c.P.in[I_GDN_NORM]; const float* lnw = c.P.in[I_LNW]; const float* lnb = c.P.in[I_LNB];
    const int lane = c.lane, c0 = lane * 16;
    for (int t = c.gwave; t < T; t += c.nwaves) {
        {
            float o[16];
#pragma unroll
            for (int q = 0; q < 4; ++q) { const float4 v = *(const float4*)(OG + (size_t)t * 1024 + c0 + 4 * q); o[4 * q] = v.x; o[4 * q + 1] = v.y; o[4 * q + 2] = v.z; o[4 * q + 3] = v.w; }
            float ss = 0.f;
#pragma unroll
            for (int j = 0; j < 16; ++j) ss += o[j] * o[j];
            ss += __shfl_xor(ss, 1); ss += __shfl_xor(ss, 2); ss += __shfl_xor(ss, 4);
            const float rstd = rsqrtf(ss * (1.f / 128.f) + 1e-6f);
            const uint4 z0 = *(const uint4*)(ZS + (size_t)t * 1024 + c0), z1 = *(const uint4*)(ZS + (size_t)t * 1024 + c0 + 8);
            const unsigned zz[8] = {z0.x, z0.y, z0.z, z0.w, z1.x, z1.y, z1.z, z1.w};
            unsigned w[8];
#pragma unroll
            for (int j = 0; j < 8; ++j) { const int cc = (c0 + 2 * j) & 127; w[j] = pk2(o[2 * j] * rstd * gnw[cc] * bflo(zz[j]), o[2 * j + 1] * rstd * gnw[cc + 1] * bfhi(zz[j])); }
            *(uint4*)(YA + (size_t)t * 1024 + c0) = make_uint4(w[0], w[1], w[2], w[3]); *(uint4*)(YA + (size_t)t * 1024 + c0 + 8) = make_uint4(w[4], w[5], w[6], w[7]);
        }
        {
            float o[16];
#pragma unroll
            for (int q = 0; q < 4; ++q) { const float4 v = *(const float4*)(ORW + (size_t)t * 1024 + c0 + 4 * q); o[4 * q] = v.x; o[4 * q + 1] = v.y; o[4 * q + 2] = v.z; o[4 * q + 3] = v.w; }
            float sm = 0.f;
#pragma unroll
            for (int j = 0; j < 16; ++j) sm += o[j];
            sm += __shfl_xor(sm, 1); sm += __shfl_xor(sm, 2);
            const float mean = sm * (1.f / 64.f);
            float sv = 0.f;
#pragma unroll
            for (int j = 0; j < 16; ++j) { const float dd = o[j] - mean; sv += dd * dd; }
            sv += __shfl_xor(sv, 1); sv += __shfl_xor(sv, 2);
            const float rstd = rsqrtf(sv * (1.f / 64.f) + 64e-5f);
            const float sc = SC[t * 16 + (c0 >> 6)];
            const uint4 v0 = *(const uint4*)(VP + (size_t)t * 1024 + c0), v1 = *(const uint4*)(VP + (size_t)t * 1024 + c0 + 8);
            const uint4 g0 = *(const uint4*)(GGR + (size_t)t * 1024 + c0), g1 = *(const uint4*)(GGR + (size_t)t * 1024 + c0 + 8);
            const unsigned vv[8] = {v0.x, v0.y, v0.z, v0.w, v1.x, v1.y, v1.z, v1.w};
            const unsigned gg[8] = {g0.x, g0.y, g0.z, g0.w, g1.x, g1.y, g1.z, g1.w};
            unsigned w[8];
#pragma unroll
            for (int j = 0; j < 8; ++j) { const int cc = c0 + 2 * j;
                const float y0 = ((o[2 * j] - mean) * rstd * lnw[cc] + lnb[cc] + sc * bflo(vv[j])) * bflo(gg[j]);
                const float y1 = ((o[2 * j + 1] - mean) * rstd * lnw[cc + 1] + lnb[cc + 1] + sc * bfhi(vv[j])) * bfhi(gg[j]);
                w[j] = pk2(y0, y1); }
            *(uint4*)(YB + (size_t)t * 1024 + c0) = make_uint4(w[0], w[1], w[2], w[3]); *(uint4*)(YB + (size_t)t * 1024 + c0 + 8) = make_uint4(w[4], w[5], w[6], w[7]);
        }
    }
}

__device__ __forceinline__ void ph_router(const Ctx& c) {
    const float* X1 = c.ws<float>(WS_X1); const float* nw = c.P.in[I_NORM_FFN]; const float* rw = c.P.in[I_ROUTER_W]; const float* rb = c.P.in[I_ROUTER_B];
    bf16* H2 = c.ws<bf16>(WS_H2); int* TE = c.ws<int>(WS_TE); float* TG = c.ws<float>(WS_TG); int* TP = c.ws<int>(WS_TP); unsigned* CNT = c.ws<unsigned>(WS_CTL) + CW_CNT;
    const int lane = c.lane;
    float4* tab = (float4*)c.lds;
    __syncthreads();
    for (int i = c.tid; i < 8192; i += NTHREADS) { const int k = i >> 3; tab[((k & 3) * 256 + (k >> 2)) * 9 + (i & 7)] = ((const float4*)rw)[i]; }
    __syncthreads();
    for (int t = c.gwave; t < T; t += c.nwaves) {
        float4 v[4]; float ss = 0.f;
#pragma unroll
        for (int i = 0; i < 4; ++i) { v[i] = ((const float4*)(X1 + (size_t)t * D))[lane + 64 * i]; ss += v[i].x * v[i].x + v[i].y * v[i].y + v[i].z * v[i].z + v[i].w * v[i].w; }
        ss = wsum(ss);
        const float rstd = rsqrtf(ss * (1.f / 1024.f) + 1e-6f);
        float lg[32];
#pragma unroll
        for (int j = 0; j < 32; ++j) lg[j] = 0.f;
#pragma unroll
        for (int i = 0; i < 4; ++i) {
            const float4 w4 = ((const float4*)nw)[lane + 64 * i];
            const float h[4] = {v[i].x * rstd * w4.x, v[i].y * rstd * w4.y, v[i].z * rstd * w4.z, v[i].w * rstd * w4.w};
            uint2 st; st.x = pk2(h[0], h[1]); st.y = pk2(h[2], h[3]);
            *(uint2*)(H2 + (size_t)t * D + 4 * (lane + 64 * i)) = st;
#pragma unroll
            for (int ii = 0; ii < 4; ++ii) {
                const float4* wr = tab + (size_t)(ii * 256 + lane + 64 * i) * 9;
#pragma unroll
                for (int q = 0; q < 8; ++q) { const float4 w = wr[q]; lg[4 * q] += h[ii] * w.x; lg[4 * q + 1] += h[ii] * w.y; lg[4 * q + 2] += h[ii] * w.z; lg[4 * q + 3] += h[ii] * w.w; }
                asm volatile("" ::: "memory");
            }
        }
#pragma unroll
        for (int j = 0; j < 32; ++j) lg[j] = wsum(lg[j]) + rb[j];
        int e0 = 0, e1 = 0, e2 = 0, e3 = 0; float v0 = -3e38f, v1 = -3e38f, v2 = -3e38f, v3 = -3e38f;
#pragma unroll
        for (int j = 0; j < 32; ++j) if (lg[j] > v0) { v0 = lg[j]; e0 = j; }
#pragma unroll
        for (int j = 0; j < 32; ++j) if (j != e0 && lg[j] > v1) { v1 = lg[j]; e1 = j; }
#pragma unroll
        for (int j = 0; j < 32; ++j) if (j != e0 && j != e1 && lg[j] > v2) { v2 = lg[j]; e2 = j; }
#pragma unroll
        for (int j = 0; j < 32; ++j) if (j != e0 && j != e1 && j != e2 && lg[j] > v3) { v3 = lg[j]; e3 = j; }
        const float x1 = expf(v1 - v0), x2 = expf(v2 - v0), x3 = expf(v3 - v0), inv = 1.f / (1.f + x1 + x2 + x3);
        if (lane < 4) {
            const int me = lane == 0 ? e0 : (lane == 1 ? e1 : (lane == 2 ? e2 : e3));
            const float mg = (lane == 0 ? 1.f : (lane == 1 ? x1 : (lane == 2 ? x2 : x3))) * inv;
            const unsigned pos = atomicAdd(&CNT[me], 1u);
            TE[t * 4 + lane] = me; TG[t * 4 + lane] = mg; TP[t * 4 + lane] = (int)pos;
        }
    }
    __syncthreads();
}

__device__ __forceinline__ void ph_dispatch(const Ctx& c) {
    int* tb = (int*)c.lds;
    const unsigned* CNT = c.ws<unsigned>(WS_CTL) + CW_CNT;
    int* TILE_E = c.ws<int>(WS_TILE_E); int* NT = c.ws<int>(WS_NT);
    const int* TE = c.ws<int>(WS_TE); const float* TG = c.ws<float>(WS_TG); const int* TP = c.ws<int>(WS_TP); int* TSLOT = c.ws<int>(WS_TSLOT);
    float* SGATE = c.ws<float>(WS_SGATE); const bf16* H2 = c.ws<bf16>(WS_H2); bf16* XB = c.ws<bf16>(WS_XB);
    if (c.tid == 0) { int acc = 0; for (int e = 0; e < NEXP; ++e) { const int n = (int)__hip_atomic_load(&CNT[e], __ATOMIC_RELAXED, __HIP_MEMORY_SCOPE_AGENT); tb[e] = acc; tb[64 + e] = n; acc += (n + 255) >> 8; } tb[32] = acc; }
    __syncthreads();
    if (blockIdx.x == 0) {
        for (int tile = c.tid; tile < tb[32]; tile += NTHREADS) { int e = 0; for (int q = 0; q < NEXP; ++q) if (tile >= tb[q]) e = q; TILE_E[tile] = e; }
        if (c.tid == 0) *NT = tb[32];
    }
    for (int idx = c.gwave; idx < T * 4; idx += c.nwaves) {
        const int t = idx >> 2, e = TE[idx], pos = TP[idx];
        const int slot = tb[e] * 256 + pos;
        if (c.lane == 0) { TSLOT[idx] = slot; SGATE[slot] = TG[idx]; }
        const uint4* src = (const uint4*)(H2 + (size_t)t * 1024); uint4* dst = (uint4*)(XB + (size_t)slot * 1024);
        dst[c.lane] = src[c.lane]; dst[c.lane + 64] = src[c.lane + 64];
    }
    for (int e = 0; e < NEXP; ++e) {
        const int n = tb[64 + e], cap = (tb[e + 1] - tb[e]) * 256;
        for (int r = n + c.gwave; r < cap; r += c.nwaves) {
            const int slot = tb[e] * 256 + r;
            uint4* dst = (uint4*)(XB + (size_t)slot * 1024);
            dst[c.lane] = make_uint4(0, 0, 0, 0); dst[c.lane + 64] = make_uint4(0, 0, 0, 0);
            if (c.lane == 0) SGATE[slot] = 0.f;
        }
    }
}

__device__ __forceinline__ void ph_combine(const Ctx& c) {
    const float* X1 = c.ws<float>(WS_X1); const bf16* YS = c.ws<bf16>(WS_YS); const int* TSLOT = c.ws<int>(WS_TSLOT); const float* nw = c.P.in[I_NORM_FINAL]; float* out = c.P.out;
    const int lane = c.lane;
    for (int t = c.gwave; t < T; t += c.nwaves) {
        const int s0 = TSLOT[t * 4], s1 = TSLOT[t * 4 + 1], s2 = TSLOT[t * 4 + 2], s3 = TSLOT[t * 4 + 3];
        float4 v[4]; float ss = 0.f;
#pragma unroll
        for (int i = 0; i < 4; ++i) {
            const int col = 4 * (lane + 64 * i);
            v[i] = *(const float4*)(X1 + (size_t)t * D + col);
            const uint2 a = *(const uint2*)(YS + (size_t)s0 * 1024 + col), b = *(const uint2*)(YS + (size_t)s1 * 1024 + col), cc = *(const uint2*)(YS + (size_t)s2 * 1024 + col), d = *(const uint2*)(YS + (size_t)s3 * 1024 + col);
            v[i].x += bflo(a.x) + bflo(b.x) + bflo(cc.x) + bflo(d.x); v[i].y += bfhi(a.x) + bfhi(b.x) + bfhi(cc.x) + bfhi(d.x);
            v[i].z += bflo(a.y) + bflo(b.y) + bflo(cc.y) + bflo(d.y); v[i].w += bfhi(a.y) + bfhi(b.y) + bfhi(cc.y) + bfhi(d.y);
            ss += v[i].x * v[i].x + v[i].y * v[i].y + v[i].z * v[i].z + v[i].w * v[i].w;
        }
        ss = wsum(ss);
        const float rstd = rsqrtf(ss * (1.f / 1024.f) + 1e-6f);
#pragma unroll
        for (int i = 0; i < 4; ++i) { const float4 w4 = ((const float4*)nw)[lane + 64 * i];
            *(float4*)(out + (size_t)t * D + 4 * (lane + 64 * i)) = make_float4(v[i].x * rstd * w4.x, v[i].y * rstd * w4.y, v[i].z * rstd * w4.z, v[i].w * rstd * w4.w); }
    }
}


typedef short bf16x8_t __attribute__((ext_vector_type(8)));
typedef float f32x4_t __attribute__((ext_vector_type(4)));
#define MFMA16(a, b, c) __builtin_amdgcn_mfma_f32_16x16x32_bf16((a), (b), (c), 0, 0, 0)


__device__ __forceinline__ int frag_off(int row, int k, int KBn) { return (((row >> 4) * KBn + (k >> 5)) * 512) + (((k >> 3) & 3) * 128) + ((row & 15) * 8) + (k & 7); }
__device__ __forceinline__ int cfrag_off(int v, int r, int NRT) { return ((((v >> 4) * NRT + (r >> 4)) * 64 + ((r >> 2) & 3) * 16 + (v & 15)) * 4) + (r & 3); }

constexpr int GCL_HALF_BYTES = 71680;
__device__ __forceinline__ void ph_gcl(const Ctx& c) {
    const bf16* GQKV = c.ws<bf16>(WS_GQKV); const float* BETA = c.ws<float>(WS_BETA); const float* GGv = c.ws<float>(WS_GG); const float* cw = c.P.in[I_GDN_CONV];
    bf16* GA1 = c.ws<bf16>(WS_GA1); float* GX0 = c.ws<float>(WS_GX0); bf16* GA2 = c.ws<bf16>(WS_GA2); bf16* GA3 = c.ws<bf16>(WS_GA3); bf16* GA4 = c.ws<bf16>(WS_GA4); float* GGL = c.ws<float>(WS_GGL);
    for (int it0 = blockIdx.x * 2; it0 < 2048; it0 += gridDim.x * 2) {
        int tv = c.tid; asm volatile("" : "+v"(tv));
        const int half = tv >> 8, ht = tv & 255, lane = tv & 63, w4 = __builtin_amdgcn_readfirstlane((tv >> 6) & 3);
        unsigned char* base = c.lds + half * GCL_HALF_BYTES;
        bf16* QB = (bf16*)base;
        bf16* KB = QB + 64 * 136;
        bf16* VB = KB + 64 * 136;
        float* MM = (float*)(VB + 64 * 136);
        float* GC = MM + 64 * 64;
        float* BT = GC + 64;
        float* BE = BT + 64;
        const int item = it0 + half, n = item & 63, bh = item >> 6, h = bh & 7, b = bh >> 3;
        const int t0 = b * SEQ + n * 64;
        __syncthreads();
        if (w4 == 0) {
            float g = GGv[(size_t)(t0 + lane) * 8 + h]; const float be = BETA[(size_t)(t0 + lane) * 8 + h];
#pragma unroll
            for (int o = 1; o < 64; o <<= 1) { const float u = __shfl_up(g, o); if (lane >= o) g += u; }
            GC[lane] = g; BT[lane] = be; BE[lane] = be * expf(g);
        }
        __syncthreads();
        {
            const int cg = ht & 15, rg = ht >> 4, r0 = rg * 4;
#pragma unroll
            for (int mat = 0; mat < 3; ++mat) {
                const int col0 = mat * 1024 + h * 128 + cg * 8;
                float4 xa[7], xb[7], wa[4], wb[4];
#pragma unroll
                for (int li = 0; li < 7; ++li) {
                    const bool valid = (n > 0) || (r0 - 3 + li >= 0);
                    uint4 xr = make_uint4(0, 0, 0, 0);
                    if (valid) xr = *(const uint4*)(GQKV + (size_t)(t0 + r0 - 3 + li) * 3072 + col0);
                    xa[li] = make_float4(bflo(xr.x), bfhi(xr.x), bflo(xr.y), bfhi(xr.y));
                    xb[li] = make_float4(bflo(xr.z), bfhi(xr.z), bflo(xr.w), bfhi(xr.w));
                }
#pragma unroll
                for (int j = 0; j < 4; ++j) { wa[j] = *(const float4*)(cw + j * 3072 + col0); wb[j] = *(const float4*)(cw + j * 3072 + col0 + 4); }
#pragma unroll
                for (int rr = 0; rr < 4; ++rr) {
                    float o[8] = {0.f, 0.f, 0.f, 0.f, 0.f, 0.f, 0.f, 0.f};
#pragma unroll
                    for (int j = 0; j < 4; ++j) { const float4 a = xa[rr + j], bq = xb[rr + j];
                        o[0] += wa[j].x * a.x; o[1] += wa[j].y * a.y; o[2] += wa[j].z * a.z; o[3] += wa[j].w * a.w;
                        o[4] += wb[j].x * bq.x; o[5] += wb[j].y * bq.y; o[6] += wb[j].z * bq.z; o[7] += wb[j].w * bq.w; }
                    float ss = 0.f;
#pragma unroll
                    for (int e = 0; e < 8; ++e) { o[e] *= fsigm(o[e]); ss += o[e] * o[e]; }
                    float sc = 1.f;
                    if (mat < 2) { ss += __shfl_xor(ss, 1); ss += __shfl_xor(ss, 2); ss += __shfl_xor(ss, 4); ss += __shfl_xor(ss, 8); sc = rsqrtf(ss + 1e-6f) * (mat == 0 ? 0.08838834764831845f : 1.f); }
                    const int r = r0 + rr;
                    uint4 w; w.x = pk2(o[0] * sc, o[1] * sc); w.y = pk2(o[2] * sc, o[3] * sc); w.z = pk2(o[4] * sc, o[5] * sc); w.w = pk2(o[6] * sc, o[7] * sc);
                    *(uint4*)((mat == 0 ? QB : (mat == 1 ? KB : VB)) + r * 136 + cg * 8) = w;
                    if (mat == 0) {
                        const float s2 = sc * expf(GC[r]);
                        w.x = pk2(o[0] * s2, o[1] * s2); w.y = pk2(o[2] * s2, o[3] * s2); w.z = pk2(o[4] * s2, o[5] * s2); w.w = pk2(o[6] * s2, o[7] * s2);
                        *(uint4*)(GA2 + (size_t)item * 64 * 128 + frag_off(r, cg * 8, 4)) = w;
                    }
                }
            }
        }
        __syncthreads();
        {
            const int fr = lane & 15, fq = lane >> 4, a0 = w4 * 16;
            bf16x8_t ka[4];
#pragma unroll
            for (int kb = 0; kb < 4; ++kb) ka[kb] = *(const bf16x8_t*)(KB + (a0 + fr) * 136 + kb * 32 + fq * 8);
#pragma unroll
            for (int bt = 0; bt < 4; ++bt) {
                f32x4_t c1 = {0.f, 0.f, 0.f, 0.f}, c2 = {0.f, 0.f, 0.f, 0.f};
#pragma unroll
                for (int kb = 0; kb < 4; ++kb) {
                    const bf16x8_t kbf = *(const bf16x8_t*)(KB + (bt * 16 + fr) * 136 + kb * 32 + fq * 8);
                    const bf16x8_t qbf = *(const bf16x8_t*)(QB + (bt * 16 + fr) * 136 + kb * 32 + fq * 8);
                    c1 = MFMA16(ka[kb], kbf, c1); c2 = MFMA16(ka[kb], qbf, c2);
                }
                const int i = bt * 16 + fr, j0 = a0 + 4 * fq;
                const float gi = GC[i], bi = BT[i];
                float m[4], at[4];
#pragma unroll
                for (int rg = 0; rg < 4; ++rg) { const int j = j0 + rg; const float dec = expf(fminf(gi - GC[j], 0.f));
                    m[rg] = (i > j) ? bi * c1[rg] * dec : 0.f; at[rg] = (i >= j) ? c2[rg] * dec : 0.f; }
                *(float4*)(MM + i * 64 + j0) = make_float4(m[0], m[1], m[2], m[3]);
                uint2 w; w.x = pk2(at[0], at[1]); w.y = pk2(at[2], at[3]);
                *(uint2*)(GA3 + (size_t)item * 64 * 64 + frag_off(i, j0, 2)) = w;
            }
        }
        __syncthreads();
        {
            const int cc = ht & 127; const bool isw = ht >= 128;
            const bf16* srcp = (isw ? KB : VB) + cc; const float* scl = isw ? BE : BT;
            float x[64];
#pragma unroll
            for (int i = 0; i < 64; ++i) x[i] = 0.f;
#pragma unroll
            for (int i = 0; i < 64; ++i) {
                float acc = scl[i] * bf2f(srcp[i * 136]);
#pragma unroll
                for (int j4 = 0; j4 < (i + 3) / 4; ++j4) { const float4 mv = *(const float4*)(MM + i * 64 + 4 * j4);
                    acc -= mv.x * x[4 * j4]; acc -= mv.y * x[4 * j4 + 1]; acc -= mv.z * x[4 * j4 + 2]; acc -= mv.w * x[4 * j4 + 3]; }
                x[i] = acc;
                asm volatile("" ::: "memory");
            }
            if (!isw) {
                float* up = GX0 + (size_t)item * 128 * 64;
#pragma unroll
                for (int q = 0; q < 16; ++q) *(float4*)(up + cfrag_off(cc, 4 * q, 4)) = make_float4(x[4 * q], x[4 * q + 1], x[4 * q + 2], x[4 * q + 3]);
            }
            __syncthreads();
            if (isw) {
                bf16* a1s = (bf16*)MM;
#pragma unroll
                for (int i = 0; i < 64; ++i) a1s[i * 128 + cc] = f2bf(-x[i]);
            }
        }
        __syncthreads();
        {
            const bf16* a1s = (const bf16*)MM; bf16* wp = GA1 + (size_t)item * 64 * 128;
#pragma unroll
            for (int q = 0; q < 4; ++q) { const int p = ht + 256 * q, fr = p & 15, fq = (p >> 4) & 3, kb = (p >> 6) & 3, rt = p >> 8;
                *(uint4*)(wp + p * 8) = *(const uint4*)(a1s + (rt * 16 + fr) * 128 + kb * 32 + fq * 8); }
        }
        {
            const int dk = ht & 127, hh = ht >> 7; const float g63 = GC[63];
            unsigned w[16];
#pragma unroll
            for (int q = 0; q < 16; ++q) { const int ta = hh * 32 + 2 * q;
                w[q] = pk2(bf2f(KB[ta * 136 + dk]) * expf(g63 - GC[ta]), bf2f(KB[(ta + 1) * 136 + dk]) * expf(g63 - GC[ta + 1])); }
            bf16* dp = GA4 + (size_t)item * 128 * 64;
            *(uint4*)(dp + frag_off(dk, hh * 32, 2)) = make_uint4(w[0], w[1], w[2], w[3]); *(uint4*)(dp + frag_off(dk, hh * 32 + 8, 2)) = make_uint4(w[4], w[5], w[6], w[7]);
            *(uint4*)(dp + frag_off(dk, hh * 32 + 16, 2)) = make_uint4(w[8], w[9], w[10], w[11]); *(uint4*)(dp + frag_off(dk, hh * 32 + 24, 2)) = make_uint4(w[12], w[13], w[14], w[15]);
            if (ht == 0) GGL[item] = expf(g63);
        }
    }
}

constexpr int RCL_HALF_BYTES = 75776;
__device__ __forceinline__ void ph_rcl(const Ctx& c) {
    const bf16* RKV = c.ws<bf16>(WS_RKV); const float* LW = c.ws<float>(WS_LW); const float* AAg = c.ws<float>(WS_AA);
    const float* mu = c.P.in[I_MU]; const float* k_k = c.P.in[I_KK]; const float* k_a = c.P.in[I_KA]; const float* r_k = c.P.in[I_RK];
    bf16* VP = c.ws<bf16>(WS_VP); float* SC = c.ws<float>(WS_SC);
    bf16* RA1 = c.ws<bf16>(WS_RA1); float* RX0 = c.ws<float>(WS_RX0); bf16* RA2 = c.ws<bf16>(WS_RA2); bf16* RA3 = c.ws<bf16>(WS_RA3); float* RO0 = c.ws<float>(WS_RO0);
    bf16* RA4 = c.ws<bf16>(WS_RA4); float* RS0 = c.ws<float>(WS_RS0); float* RDSC = c.ws<float>(WS_RDSC);
    for (int it0 = blockIdx.x * 2; it0 < 4096; it0 += gridDim.x * 2) {
        int tv = c.tid; asm volatile("" : "+v"(tv));
        const int half = tv >> 8, ht = tv & 255, lane = tv & 63, w4 = __builtin_amdgcn_readfirstlane((tv >> 6) & 3);
        unsigned char* base = c.lds + half * RCL_HALF_BYTES;
        bf16* AT = (bf16*)base;
        bf16* VT = AT + 64 * 72;
        bf16* KDT = VT + 64 * 72;
        float* AAB = (float*)(KDT + 64 * 72);
        float* TOT = AAB + 64 * 64;
        unsigned char* RX = (unsigned char*)(TOT + 256);
        bf16* RT = (bf16*)RX;
        bf16* BTL = RT + 64 * 72;
        bf16* KT = BTL + 64 * 72;
        bf16* AAK = (bf16*)RX;
        bf16* ARK = AAK + 64 * 72;
        float* RHS2 = (float*)RX;
        const int item = it0 + half, n = item & 63, bh = item >> 6, h = bh & 15, b = bh >> 4;
        const int t0 = b * SEQ + n * 64;
        __syncthreads();
        {
            const int ch = ht & 63, tq = ht >> 6;
            float run = 0.f;
#pragma unroll
            for (int i = 0; i < 16; ++i) { run += LW[(size_t)(t0 + tq * 16 + i) * 1024 + h * 64 + ch]; AAB[(tq * 16 + i) * 64 + ch] = run; }
            TOT[tq * 64 + ch] = run;
        }
        __syncthreads();
        {
            const int r = ht >> 2, seg = ht & 3, c0 = seg * 16, t = t0 + r; const bool first = (n == 0 && r == 0);
            const bf16* cur = RKV + (size_t)t * 3072 + h * 64 + c0; const bf16* prv = cur - 3072;
            float rr[16], kf[16], vv[16], kkv[16], aa[16], lwl[16];
            float ss = 0.f, scs = 0.f;
            float4 cr[4], ck[4], cv[4], pr[4], pk[4], pv[4], a4v[4], l4v[4];
            {
                uint4 ur[2], uk[2], uv[2], qr[2], qk[2], qv[2];
#pragma unroll
                for (int g = 0; g < 2; ++g) {
                    ur[g] = *(const uint4*)(cur + 8 * g); uk[g] = *(const uint4*)(cur + 1024 + 8 * g); uv[g] = *(const uint4*)(cur + 2048 + 8 * g);
                    qr[g] = make_uint4(0, 0, 0, 0); qk[g] = qr[g]; qv[g] = qr[g];
                    if (!first) { qr[g] = *(const uint4*)(prv + 8 * g); qk[g] = *(const uint4*)(prv + 1024 + 8 * g); qv[g] = *(const uint4*)(prv + 2048 + 8 * g); }
                }
#pragma unroll
                for (int q = 0; q < 4; ++q) {
                    a4v[q] = *(const float4*)(AAg + (size_t)t * 1024 + h * 64 + c0 + 4 * q);
                    l4v[q] = *(const float4*)(LW + (size_t)t * 1024 + h * 64 + c0 + 4 * q);
                }
#pragma unroll
                for (int g = 0; g < 2; ++g) {
                    cr[2 * g] = make_float4(bflo(ur[g].x), bfhi(ur[g].x), bflo(ur[g].y), bfhi(ur[g].y)); cr[2 * g + 1] = make_float4(bflo(ur[g].z), bfhi(ur[g].z), bflo(ur[g].w), bfhi(ur[g].w));
                    ck[2 * g] = make_float4(bflo(uk[g].x), bfhi(uk[g].x), bflo(uk[g].y), bfhi(uk[g].y)); ck[2 * g + 1] = make_float4(bflo(uk[g].z), bfhi(uk[g].z), bflo(uk[g].w), bfhi(uk[g].w));
                    cv[2 * g] = make_float4(bflo(uv[g].x), bfhi(uv[g].x), bflo(uv[g].y), bfhi(uv[g].y)); cv[2 * g + 1] = make_float4(bflo(uv[g].z), bfhi(uv[g].z), bflo(uv[g].w), bfhi(uv[g].w));
                    pr[2 * g] = make_float4(bflo(qr[g].x), bfhi(qr[g].x), bflo(qr[g].y), bfhi(qr[g].y)); pr[2 * g + 1] = make_float4(bflo(qr[g].z), bfhi(qr[g].z), bflo(qr[g].w), bfhi(qr[g].w));
                    pk[2 * g] = make_float4(bflo(qk[g].x), bfhi(qk[g].x), bflo(qk[g].y), bfhi(qk[g].y)); pk[2 * g + 1] = make_float4(bflo(qk[g].z), bfhi(qk[g].z), bflo(qk[g].w), bfhi(qk[g].w));
                    pv[2 * g] = make_float4(bflo(qv[g].x), bfhi(qv[g].x), bflo(qv[g].y), bfhi(qv[g].y)); pv[2 * g + 1] = make_float4(bflo(qv[g].z), bfhi(qv[g].z), bflo(qv[g].w), bfhi(qv[g].w));
                }
            }
#pragma unroll
            for (int q = 0; q < 4; ++q) {
                const float4 r0 = cr[q], k0 = ck[q], v0 = cv[q], rp = pr[q], kp = pk[q], vp = pv[q], a4 = a4v[q], l4 = l4v[q];
                const float4 mr = *(const float4*)(mu + h * 64 + c0 + 4 * q), mk = *(const float4*)(mu + 1024 + h * 64 + c0 + 4 * q), mv = *(const float4*)(mu + 2048 + h * 64 + c0 + 4 * q);
                const float4 kkw = *(const float4*)(k_k + h * 64 + c0 + 4 * q), kaw = *(const float4*)(k_a + h * 64 + c0 + 4 * q), rkw = *(const float4*)(r_k + h * 64 + c0 + 4 * q);
                const float r0a[4] = {r0.x, r0.y, r0.z, r0.w}, k0a[4] = {k0.x, k0.y, k0.z, k0.w}, v0a[4] = {v0.x, v0.y, v0.z, v0.w};
                const float rpa[4] = {rp.x, rp.y, rp.z, rp.w}, kpa[4] = {kp.x, kp.y, kp.z, kp.w}, vpa[4] = {vp.x, vp.y, vp.z, vp.w};
                const float mra[4] = {mr.x, mr.y, mr.z, mr.w}, mka[4] = {mk.x, mk.y, mk.z, mk.w}, mva[4] = {mv.x, mv.y, mv.z, mv.w};
                const float kka[4] = {kkw.x, kkw.y, kkw.z, kkw.w}, kaa[4] = {kaw.x, kaw.y, kaw.z, kaw.w}, rka[4] = {rkw.x, rkw.y, rkw.z, rkw.w}, aaa[4] = {a4.x, a4.y, a4.z, a4.w}, lwa[4] = {l4.x, l4.y, l4.z, l4.w};
#pragma unroll
                for (int e = 0; e < 4; ++e) { const int i = 4 * q + e;
                    rr[i] = r0a[e] + (rpa[e] - r0a[e]) * mra[e]; const float kx = k0a[e] + (kpa[e] - k0a[e]) * mka[e]; vv[i] = v0a[e] + (vpa[e] - v0a[e]) * mva[e];
                    kkv[i] = kx * kka[e]; ss += kkv[i] * kkv[i]; aa[i] = aaa[e]; lwl[i] = lwa[e]; kf[i] = kx * (1.f + (aaa[e] - 1.f) * kaa[e]); scs += rr[i] * kf[i] * rka[e]; }
                asm volatile("" ::: "memory");
            }
            ss += __shfl_xor(ss, 1); ss += __shfl_xor(ss, 2); scs += __shfl_xor(scs, 1); scs += __shfl_xor(scs, 2);
            const float rn = rsqrtf(ss + 1e-6f);
            if (seg == 0) SC[(size_t)t * 16 + h] = scs;
            const int tq = r >> 4;
            unsigned wat[8], wbt[8], wkt[8], wrt[8], wvp[8];
            float atv[16], btv[16], ktv[16], rtv[16];
#pragma unroll
            for (int i = 0; i < 16; ++i) {
                const int ch = c0 + i;
                float off = 0.f;
#pragma unroll
                for (int q = 0; q < 3; ++q) off += (q < tq) ? TOT[q * 64 + ch] : 0.f;
                const float tot = TOT[ch] + TOT[64 + ch] + TOT[128 + ch] + TOT[192 + ch];
                const float cs = AAB[r * 64 + ch] + off;
                const float lwv = lwl[i];
                const float kk = kkv[i] * rn;
                const float e2 = expf(-cs), e4 = expf(tot - cs);
                atv[i] = kk * expf(cs - lwv); btv[i] = -kk * aa[i] * e2; ktv[i] = kf[i] * e2; rtv[i] = rr[i] * expf(cs);
                VT[ch * 72 + r] = f2bf(vv[i]);
                KDT[ch * 72 + r] = f2bf(kf[i] * e4);
                RA4[(size_t)item * 64 * 64 + frag_off(ch, r, 2)] = f2bf(-kk * aa[i] * e4);
                if (r == 63) RDSC[(size_t)item * 64 + ch] = expf(tot);
            }
#pragma unroll
            for (int q = 0; q < 8; ++q) { wat[q] = pk2(atv[2 * q], atv[2 * q + 1]); wbt[q] = pk2(btv[2 * q], btv[2 * q + 1]); wkt[q] = pk2(ktv[2 * q], ktv[2 * q + 1]); wrt[q] = pk2(rtv[2 * q], rtv[2 * q + 1]); wvp[q] = pk2(vv[2 * q], vv[2 * q + 1]); }
            *(uint4*)(AT + r * 72 + c0) = make_uint4(wat[0], wat[1], wat[2], wat[3]); *(uint4*)(AT + r * 72 + c0 + 8) = make_uint4(wat[4], wat[5], wat[6], wat[7]);
            *(uint4*)(BTL + r * 72 + c0) = make_uint4(wbt[0], wbt[1], wbt[2], wbt[3]); *(uint4*)(BTL + r * 72 + c0 + 8) = make_uint4(wbt[4], wbt[5], wbt[6], wbt[7]);
            *(uint4*)(KT + r * 72 + c0) = make_uint4(wkt[0], wkt[1], wkt[2], wkt[3]); *(uint4*)(KT + r * 72 + c0 + 8) = make_uint4(wkt[4], wkt[5], wkt[6], wkt[7]);
            *(uint4*)(RT + r * 72 + c0) = make_uint4(wrt[0], wrt[1], wrt[2], wrt[3]); *(uint4*)(RT + r * 72 + c0 + 8) = make_uint4(wrt[4], wrt[5], wrt[6], wrt[7]);
            bf16* a2p = RA2 + (size_t)item * 64 * 64;
            *(uint4*)(a2p + frag_off(r, c0, 2)) = make_uint4(wrt[0], wrt[1], wrt[2], wrt[3]); *(uint4*)(a2p + frag_off(r, c0 + 8, 2)) = make_uint4(wrt[4], wrt[5], wrt[6], wrt[7]);
            bf16* vpp = VP + (size_t)t * 1024 + h * 64 + c0;
            *(uint4*)vpp = make_uint4(wvp[0], wvp[1], wvp[2], wvp[3]); *(uint4*)(vpp + 8) = make_uint4(wvp[4], wvp[5], wvp[6], wvp[7]);
        }
        __syncthreads();
        const int fr = lane & 15, fq = lane >> 4;
        f32x4_t cab[4], cak[4], crb[4], crk[4];
        {
            const int j0t = w4 * 16;
            bf16x8_t bj[2], kj[2];
#pragma unroll
            for (int kb = 0; kb < 2; ++kb) { bj[kb] = *(const bf16x8_t*)(BTL + (j0t + fr) * 72 + kb * 32 + fq * 8); kj[kb] = *(const bf16x8_t*)(KT + (j0t + fr) * 72 + kb * 32 + fq * 8); }
#pragma unroll
            for (int it = 0; it < 4; ++it) {
                cab[it] = (f32x4_t){0.f, 0.f, 0.f, 0.f}; cak[it] = cab[it]; crb[it] = cab[it]; crk[it] = cab[it];
#pragma unroll
                for (int kb = 0; kb < 2; ++kb) {
                    const bf16x8_t ai = *(const bf16x8_t*)(AT + (it * 16 + fr) * 72 + kb * 32 + fq * 8);
                    const bf16x8_t ri = *(const bf16x8_t*)(RT + (it * 16 + fr) * 72 + kb * 32 + fq * 8);
                    cab[it] = MFMA16(bj[kb], ai, cab[it]); cak[it] = MFMA16(kj[kb], ai, cak[it]); crb[it] = MFMA16(bj[kb], ri, crb[it]); crk[it] = MFMA16(kj[kb], ri, crk[it]);
                }
            }
        }
        __syncthreads();
        {
            const int j0 = w4 * 16 + 4 * fq;
#pragma unroll
            for (int it = 0; it < 4; ++it) {
                const int i = it * 16 + fr;
                float vab[4], vak[4], vrb[4], vrk[4];
#pragma unroll
                for (int rg = 0; rg < 4; ++rg) { const int j = j0 + rg; const bool st = i > j, in = i >= j;
                    vab[rg] = st ? cab[it][rg] : 0.f; vak[rg] = st ? cak[it][rg] : 0.f; vrb[rg] = in ? crb[it][rg] : 0.f; vrk[rg] = in ? crk[it][rg] : 0.f; }
                *(float4*)(AAB + i * 64 + j0) = make_float4(vab[0], vab[1], vab[2], vab[3]);
                uint2 w; w.x = pk2(vak[0], vak[1]); w.y = pk2(vak[2], vak[3]); *(uint2*)(AAK + i * 72 + j0) = w;
                w.x = pk2(vrk[0], vrk[1]); w.y = pk2(vrk[2], vrk[3]); *(uint2*)(ARK + i * 72 + j0) = w;
                w.x = pk2(vrb[0], vrb[1]); w.y = pk2(vrb[2], vrb[3]); *(uint2*)(RA3 + (size_t)item * 64 * 64 + frag_off(i, j0, 2)) = w;
            }
        }
        __syncthreads();
        f32x4_t cav[4], cov[4], ckv[4];
        {
            const int r0t = w4 * 16;
            bf16x8_t fa[2], fo[2], fk[2];
#pragma unroll
            for (int kb = 0; kb < 2; ++kb) { fa[kb] = *(const bf16x8_t*)(AAK + (r0t + fr) * 72 + kb * 32 + fq * 8); fo[kb] = *(const bf16x8_t*)(ARK + (r0t + fr) * 72 + kb * 32 + fq * 8); fk[kb] = *(const bf16x8_t*)(KDT + (r0t + fr) * 72 + kb * 32 + fq * 8); }
#pragma unroll
            for (int vt = 0; vt < 4; ++vt) {
                cav[vt] = (f32x4_t){0.f, 0.f, 0.f, 0.f}; cov[vt] = cav[vt]; ckv[vt] = cav[vt];
#pragma unroll
                for (int kb = 0; kb < 2; ++kb) { const bf16x8_t vb = *(const bf16x8_t*)(VT + (vt * 16 + fr) * 72 + kb * 32 + fq * 8);
                    cav[vt] = MFMA16(fa[kb], vb, cav[vt]); cov[vt] = MFMA16(fo[kb], vb, cov[vt]); ckv[vt] = MFMA16(fk[kb], vb, ckv[vt]); }
            }
        }
        __syncthreads();
        {
            const int r0 = w4 * 16 + 4 * fq;
#pragma unroll
            for (int vt = 0; vt < 4; ++vt) {
                const int v = vt * 16 + fr;
#pragma unroll
                for (int rg = 0; rg < 4; ++rg) RHS2[v * 65 + r0 + rg] = cav[vt][rg];
                *(float4*)(RO0 + (size_t)item * 64 * 64 + cfrag_off(v, r0, 4)) = make_float4(cov[vt][0], cov[vt][1], cov[vt][2], cov[vt][3]);
                *(float4*)(RS0 + (size_t)item * 64 * 64 + cfrag_off(v, r0, 4)) = make_float4(ckv[vt][0], ckv[vt][1], ckv[vt][2], ckv[vt][3]);
            }
        }
        __syncthreads();
        if (ht < 128) {
            const int cc = ht & 63; const bool isu = ht >= 64;
            float x[64];
#pragma unroll
            for (int i = 0; i < 64; ++i) x[i] = 0.f;
#pragma unroll
            for (int i = 0; i < 64; ++i) {
                const float rv = RHS2[(isu ? cc : 0) * 65 + i], av = bf2f(AT[i * 72 + (isu ? 0 : cc)]);
                float acc = isu ? rv : av;
#pragma unroll
                for (int j4 = 0; j4 < (i + 3) / 4; ++j4) { const float4 mv = *(const float4*)(AAB + i * 64 + 4 * j4);
                    acc += mv.x * x[4 * j4]; acc += mv.y * x[4 * j4 + 1]; acc += mv.z * x[4 * j4 + 2]; acc += mv.w * x[4 * j4 + 3]; }
                x[i] = acc;
                asm volatile("" ::: "memory");
            }
            if (isu) {
                float* up = RX0 + (size_t)item * 64 * 64;
#pragma unroll
                for (int q = 0; q < 16; ++q) *(float4*)(up + cfrag_off(cc, 4 * q, 4)) = make_float4(x[4 * q], x[4 * q + 1], x[4 * q + 2], x[4 * q + 3]);
            }
            asm volatile("s_waitcnt lgkmcnt(0)" ::: "memory");
            if (!isu) {
#pragma unroll
                for (int i = 0; i < 64; ++i) AT[i * 72 + cc] = f2bf(x[i]);
            }
        }
        __syncthreads();
        {
            bf16* wp = RA1 + (size_t)item * 64 * 64;
#pragma unroll
            for (int q = 0; q < 2; ++q) { const int p = ht + 256 * q, fr = p & 15, fq = (p >> 4) & 3, kb = (p >> 6) & 1, rt = p >> 7;
                *(uint4*)(wp + p * 8) = *(const uint4*)(AT + (rt * 16 + fr) * 72 + kb * 32 + fq * 8); }
        }
    }
}

template <int DK, bool RW>
struct ScanArgs { const bf16* A1; const float* X0; const bf16* A2; const bf16* A3; const float* O0; const bf16* A4; const float* S0; const float* DSC; float* OUT; int item0; int vs; int tok0; int ocol0; };
#define LBAR() do { asm volatile("s_waitcnt lgkmcnt(0)" ::: "memory"); __builtin_amdgcn_s_barrier(); asm volatile("" ::: "memory"); } while (0)
template <int DK, bool RW>
__device__ __forceinline__ void scan_run(const Ctx& c, const ScanArgs<DK, RW>& a) {
    constexpr int KB = DK / 32;
    constexpr int NST = DK / 64;
    constexpr int NV = RW ? 64 : 128;
    constexpr int SROW = DK + 8;
    bf16* ST = (bf16*)c.lds;
    bf16* XT = ST + 2 * 32 * SROW;
    const int lane = c.lane, w = c.wave, fr = lane & 15, fq = lane >> 4;
    const int tm = w >> 1, tn = w & 1;
    const int dkt = (NST == 2) ? w : (w >> 1);
    for (int i = c.tid; i < 32 * SROW / 2; i += NTHREADS) ((unsigned*)ST)[i] = 0u;
    f32x4_t accS[NST];
#pragma unroll
    for (int s = 0; s < NST; ++s) accS[s] = (f32x4_t){0.f, 0.f, 0.f, 0.f};
    bf16x8_t a1f[KB], a2f[KB], a3f[2], a4f[2]; f32x4_t x0v, o0v, s0v[NST], dscv;
#define SCAN_LOAD(IT) do { const size_t it_ = (size_t)(IT); \
        _Pragma("unroll") for (int kb = 0; kb < KB; ++kb) { a1f[kb] = *(const bf16x8_t*)(a.A1 + it_ * 64 * DK + ((tm * KB + kb) * 64 + lane) * 8); a2f[kb] = *(const bf16x8_t*)(a.A2 + it_ * 64 * DK + ((tm * KB + kb) * 64 + lane) * 8); } \
        _Pragma("unroll") for (int kb = 0; kb < 2; ++kb) { a3f[kb] = *(const bf16x8_t*)(a.A3 + it_ * 64 * 64 + ((tm * 2 + kb) * 64 + lane) * 8); a4f[kb] = *(const bf16x8_t*)(a.A4 + it_ * DK * 64 + ((dkt * 2 + kb) * 64 + lane) * 8); } \
        x0v = *(const f32x4_t*)(a.X0 + it_ * NV * 64 + (((a.vs * 2 + tn) * 4 + tm) * 64 + lane) * 4); \
        if (RW) { o0v = *(const f32x4_t*)(a.O0 + it_ * NV * 64 + (((a.vs * 2 + tn) * 4 + tm) * 64 + lane) * 4); \
                  _Pragma("unroll") for (int s = 0; s < NST; ++s) s0v[s] = *(const f32x4_t*)(a.S0 + it_ * 64 * DK + (((a.vs * 2 + (NST == 2 ? s : tn)) * (DK / 16) + dkt) * 64 + lane) * 4); \
                  dscv = *(const f32x4_t*)(a.DSC + it_ * DK + dkt * 16 + 4 * fq); } \
        else { const float g_ = a.DSC[it_]; dscv = (f32x4_t){g_, g_, g_, g_}; o0v = (f32x4_t){0.f, 0.f, 0.f, 0.f}; _Pragma("unroll") for (int s = 0; s < NST; ++s) s0v[s] = (f32x4_t){0.f, 0.f, 0.f, 0.f}; } \
    } while (0)
    SCAN_LOAD(a.item0);
    int cur = 0;
    for (int n = 0; n < 64; ++n) {
        bf16x8_t b1[KB], b2[KB], b3[2], b4[2];
#pragma unroll
        for (int kb = 0; kb < KB; ++kb) { b1[kb] = a1f[kb]; b2[kb] = a2f[kb]; }
        b3[0] = a3f[0]; b3[1] = a3f[1]; b4[0] = a4f[0]; b4[1] = a4f[1];
        f32x4_t accX = x0v, accO = o0v; const f32x4_t dv = dscv; f32x4_t sv[NST];
#pragma unroll
        for (int s = 0; s < NST; ++s) sv[s] = s0v[s];
        if (n + 1 < 64) SCAN_LOAD(a.item0 + n + 1);
        LBAR();
        const bf16* Sc = ST + cur * 32 * SROW; bf16* Sn = ST + (cur ^ 1) * 32 * SROW;
        bf16x8_t sf[KB];
#pragma unroll
        for (int kb = 0; kb < KB; ++kb) sf[kb] = *(const bf16x8_t*)(Sc + (tn * 16 + fr) * SROW + kb * 32 + fq * 8);
#pragma unroll
        for (int kb = 0; kb < KB; ++kb) accX = MFMA16(b1[kb], sf[kb], accX);
        { uint2 wv; wv.x = pk2(accX[0], accX[1]); wv.y = pk2(accX[2], accX[3]); *(uint2*)(XT + (tn * 16 + fr) * 72 + tm * 16 + 4 * fq) = wv; }
#pragma unroll
        for (int kb = 0; kb < KB; ++kb) accO = MFMA16(b2[kb], sf[kb], accO);
        LBAR();
        bf16x8_t xf[2];
#pragma unroll
        for (int kb = 0; kb < 2; ++kb) xf[kb] = *(const bf16x8_t*)(XT + (tn * 16 + fr) * 72 + kb * 32 + fq * 8);
        accO = MFMA16(b3[0], xf[0], accO); accO = MFMA16(b3[1], xf[1], accO);
        {
            float* op = a.OUT + (size_t)(a.tok0 + n * 64 + tm * 16 + 4 * fq) * 1024 + a.ocol0 + tn * 16 + fr;
            op[0] = accO[0]; op[1024] = accO[1]; op[2048] = accO[2]; op[3072] = accO[3];
        }
#pragma unroll
        for (int s = 0; s < NST; ++s) {
            const int vt = (NST == 2) ? s : tn;
            bf16x8_t xg[2];
            if (vt == tn) { xg[0] = xf[0]; xg[1] = xf[1]; }
            else {
#pragma unroll
                for (int kb = 0; kb < 2; ++kb) xg[kb] = *(const bf16x8_t*)(XT + (vt * 16 + fr) * 72 + kb * 32 + fq * 8);
            }
            f32x4_t t = accS[s] * dv + sv[s];
            t = MFMA16(b4[0], xg[0], t); t = MFMA16(b4[1], xg[1], t);
            accS[s] = t;
            uint2 wv; wv.x = pk2(t[0], t[1]); wv.y = pk2(t[2], t[3]);
            *(uint2*)(Sn + (vt * 16 + fr) * SROW + dkt * 16 + 4 * fq) = wv;
        }
        cur ^= 1;
    }
#undef SCAN_LOAD
    __syncthreads();
}

__device__ __forceinline__ void ph_scan(const Ctx& c) {
    for (int wk = blockIdx.x; wk < 256; wk += gridDim.x) {
        const int xcd = wk & 7, j = wk >> 3;
        if (j < 16) {
            const int pair = xcd * 4 + (j >> 2), vs = j & 3, b = pair >> 3, h = pair & 7;
            ScanArgs<128, false> a{c.ws<bf16>(WS_GA1), c.ws<float>(WS_GX0), c.ws<bf16>(WS_GA2), c.ws<bf16>(WS_GA3), nullptr, c.ws<bf16>(WS_GA4), nullptr, c.ws<float>(WS_GGL),
                                   c.ws<float>(WS_OG), pair * 64, vs, b * SEQ, h * 128 + vs * 32};
            scan_run<128, false>(c, a);
        } else {
            const int pair = xcd * 8 + ((j - 16) >> 1), vs = (j - 16) & 1, b = pair >> 4, h = pair & 15;
            ScanArgs<64, true> a{c.ws<bf16>(WS_RA1), c.ws<float>(WS_RX0), c.ws<bf16>(WS_RA2), c.ws<bf16>(WS_RA3), c.ws<float>(WS_RO0), c.ws<bf16>(WS_RA4), c.ws<float>(WS_RS0), c.ws<float>(WS_RDSC),
                                 c.ws<float>(WS_ORW), pair * 64, vs, b * SEQ, h * 64 + vs * 32};
            scan_run<64, true>(c, a);
        }
    }
}

enum { PH_RMS0 = 0, PH_INPROJ, PH_GCL, PH_LORA, PH_RCL, PH_SCAN, PH_POST, PH_G2, PH_X1, PH_ROUTER, PH_DISPATCH, PH_MOE1, PH_MOE2, PH_COMBINE, PH_COUNT };

template <unsigned PHMASK>
__global__ void __launch_bounds__(NTHREADS) mk(Params P) {
    extern __shared__ __attribute__((aligned(16))) unsigned char lds[];
    volatile LAS unsigned* misc = (volatile LAS unsigned*)((LAS unsigned char*)lds + MISC_OFF);
    if (threadIdx.x < 64) misc[threadIdx.x] = 0u;
    __syncthreads();
    unsigned* ctl = (unsigned*)(P.ws + WS_CTL);
    XcdBarrier bar = xcd_barrier_post(ctl + CW_BAR + P.li * XCD_BAR_WORDS, misc);
#define MKCTX() int tv_ = threadIdx.x; asm volatile("" : "+v"(tv_)); const int wv_ = __builtin_amdgcn_readfirstlane(tv_ >> 6); \
    Ctx c{P, tv_, tv_ & 63, wv_, (int)(blockIdx.x * NWAVES + wv_), (int)(gridDim.x * NWAVES), (size_t)blockIdx.x * NTHREADS + tv_, (size_t)gridDim.x * NTHREADS, lds}
    bool first_seam = true;
#define IN(k) (((PHMASK >> (k)) & 1u) && P.ph_lo <= (k) && (k) < P.ph_hi)
#define SEAM(k) do { if ((k) + 1 < P.ph_hi) { if (first_seam && P.coop) { cg::this_grid().sync(); } else xcd_barrier(bar); first_seam = false; } } while (0)
#define REP(k) for (int rep_ = 0; rep_ < ((k) == PROBE_REP ? 2 : 1); ++rep_)
    if (IN(PH_RMS0)) { MKCTX();
        REP(PH_RMS0) {
        ph_rms0(c);
        { WJob j{P.in[I_W_IN], NCOL_IN, 1024, 4096, c.ws<bf16>(WS_WIN_T), 1024, 1, 0, 0}; wconv_job(c, j); }
        { WJob j{P.in[I_W_IN] + 4112, NCOL_IN, 1024, 5376, c.ws<bf16>(WS_WIN_T) + (size_t)4096 * 1024, 1024, 1, 0, 0}; wconv_job(c, j); }
        lora_zero(c);
        { WJob j{P.in[I_W2], 1024, 64, 1024, c.ws<bf16>(WS_LORA_T), 256, 1, 0, 0}; wconv_job(c, j); }
        { WJob j{P.in[I_A2], 1024, 64, 1024, c.ws<bf16>(WS_LORA_T) + (size_t)1024 * 256 + 64, 256, 1, 0, 0}; wconv_job(c, j); }
        { WJob j{P.in[I_G2], 1024, 128, 1024, c.ws<bf16>(WS_LORA_T) + (size_t)2048 * 256 + 128, 256, 1, 0, 0}; wconv_job(c, j); }
        }
        SEAM(PH_RMS0);
    }
    if (IN(PH_INPROJ)) { MKCTX();
        REP(PH_INPROJ) {
        EpiInProj ep{c.ws<bf16>(WS_GQKV), c.ws<bf16>(WS_ZS), c.ws<bf16>(WS_RKV), c.ws<float>(WS_LIN), c.ws<bf16>(WS_GATES)};
        SchedInProj sc{(const char*)c.ws<bf16>(WS_HB), (const char*)c.ws<bf16>(WS_WIN_T), (int)gridDim.x, (int)blockIdx.x};
        pg8::gemm_phase((LAS unsigned char*)lds, 1024, sc, ep, c.tid);
        }
        SEAM(PH_INPROJ);
    }
    if (IN(PH_GCL)) { MKCTX(); REP(PH_GCL) { ph_gcl(c); ph_loraprep(c); } SEAM(PH_GCL); }
    if (IN(PH_LORA)) { MKCTX();
        REP(PH_LORA) {
        EpiLora ep{P.in[I_W0], P.in[I_A0], c.ws<float>(WS_LW), c.ws<float>(WS_AA), c.ws<bf16>(WS_GGR)};
        SchedLora sc{(const char*)c.ws<bf16>(WS_ALORA), (const char*)c.ws<bf16>(WS_LORA_T), (int)gridDim.x, (int)blockIdx.x};
        pg8::gemm_phase((LAS unsigned char*)lds, 256, sc, ep, c.tid);
        }
        SEAM(PH_LORA);
    }
    if (IN(PH_RCL)) { MKCTX(); REP(PH_RCL) { ph_rcl(c); } SEAM(PH_RCL); }
    if (IN(PH_SCAN)) { MKCTX(); REP(PH_SCAN) { ph_scan(c); } SEAM(PH_SCAN); }
    if (IN(PH_POST)) { MKCTX();
        REP(PH_POST) {
        ph_post(c);
        { WJob j{P.in[I_PROJ_A], 1024, 1024, 1024, c.ws<bf16>(WS_PROJ_T), 1024, 1, 0, 0}; wconv_job(c, j); }
        { WJob j{P.in[I_PROJ_B], 1024, 1024, 1024, c.ws<bf16>(WS_PROJ_T) + (size_t)1024 * 1024, 1024, 1, 0, 0}; wconv_job(c, j); }
        { WJob j{P.in[I_W_OUT], 1024, 1024, 1024, c.ws<bf16>(WS_WOUT_T), 2048, 2, 0, 1024}; wconv_job(c, j); }
        }
        SEAM(PH_POST);
    }
    if (IN(PH_G2)) { MKCTX();
        REP(PH_G2) {
        EpiG2 ep{c.ws<bf16>(WS_GATES), c.ws<bf16>(WS_G2)};
        SchedG2 sc{(const char*)c.ws<bf16>(WS_YA), (const char*)c.ws<bf16>(WS_YB), (const char*)c.ws<bf16>(WS_PROJ_T), (int)gridDim.x, (int)blockIdx.x};
        pg8::gemm_phase((LAS unsigned char*)lds, 1024, sc, ep, c.tid);
        }
        SEAM(PH_G2);
    }
    if (IN(PH_X1)) { MKCTX();
        REP(PH_X1) {
        EpiX1 ep{P.in[I_X], c.ws<float>(WS_X1)};
        SchedX1 sc{(const char*)c.ws<bf16>(WS_G2), (const char*)c.ws<bf16>(WS_WOUT_T), (int)gridDim.x, (int)blockIdx.x};
        pg8::gemm_phase((LAS unsigned char*)lds, 2048, sc, ep, c.tid);
        }
        SEAM(PH_X1);
    }
    if (IN(PH_ROUTER)) { MKCTX();
        ph_router(c);
        REP(PH_ROUTER) {
        { WJob j{P.in[I_W_GU], 2048, 1024, 2048, c.ws<bf16>(WS_WGU_T), 1024, 32, (size_t)1024 * 2048, (size_t)2048 * 1024}; wconv_job(c, j); }
        { WJob j{P.in[I_W_DOWN], 1024, 1024, 1024, c.ws<bf16>(WS_WDN_T), 1024, 32, (size_t)1024 * 1024, (size_t)1024 * 1024}; wconv_job(c, j); }
        }
        SEAM(PH_ROUTER);
    }
    if (IN(PH_DISPATCH)) { MKCTX(); REP(PH_DISPATCH) { ph_dispatch(c); } SEAM(PH_DISPATCH); }
    if (IN(PH_MOE1)) { MKCTX();
        REP(PH_MOE1) {
        const int nt = *c.ws<int>(WS_NT);
        EpiAct ep{P.in[I_B_GU], c.ws<bf16>(WS_ACT)};
        SchedMoe sc{(const char*)c.ws<bf16>(WS_XB), (const char*)c.ws<bf16>(WS_WGU_T), c.ws<int>(WS_TILE_E), nt, 8, (int)gridDim.x, (int)blockIdx.x};
        pg8::gemm_phase((LAS unsigned char*)lds, 1024, sc, ep, c.tid);
        }
        SEAM(PH_MOE1);
    }
    if (IN(PH_MOE2)) { MKCTX();
        REP(PH_MOE2) {
        const int nt = *c.ws<int>(WS_NT);
        EpiYS ep{P.in[I_B_DOWN], c.ws<float>(WS_SGATE), c.ws<bf16>(WS_YS)};
        SchedMoe sc{(const char*)c.ws<bf16>(WS_ACT), (const char*)c.ws<bf16>(WS_WDN_T), c.ws<int>(WS_TILE_E), nt, 4, (int)gridDim.x, (int)blockIdx.x};
        pg8::gemm_phase((LAS unsigned char*)lds, 1024, sc, ep, c.tid);
        }
        SEAM(PH_MOE2);
    }
    if (IN(PH_COMBINE)) { MKCTX(); REP(PH_COMBINE) { ph_combine(c); } }
#undef IN
#undef SEAM
#undef REP
#undef MKCTX
}

template <unsigned M> static void launch_one(const Params& p, int grid, hipStream_t stream) {
    static bool attr = false;
    if (!attr) { (void)hipFuncSetAttribute((const void*)mk<M>, hipFuncAttributeMaxDynamicSharedMemorySize, LDS_BYTES); attr = true; }
    hipLaunchKernelGGL(mk<M>, dim3(grid), dim3(NTHREADS), LDS_BYTES, stream, p);
}
template <int PH> static void launch_chain(Params& p, int grid, hipStream_t stream) {
    if constexpr (PH < PH_COUNT) { p.ph_lo = PH; p.ph_hi = PH + 1; p.li = 0; p.coop = 0; launch_one<(1u << PH)>(p, grid, stream); launch_chain<PH + 1>(p, grid, stream); }
}

extern "C" void kernel_launch(void* const* d_in, const int* in_sizes, int n_in, void* d_out, int out_size, void* d_ws, size_t ws_size, hipStream_t stream) {
    static int grid = 0;
    if (grid == 0) {
        int dev = 0, cus = 0, per_cu = 0;
        (void)hipGetDevice(&dev);
        (void)hipDeviceGetAttribute(&cus, hipDeviceAttributeMultiprocessorCount, dev);
#if MK_ONE_LAUNCH
        (void)hipFuncSetAttribute((const void*)mk<0xffffffffu>, hipFuncAttributeMaxDynamicSharedMemorySize, LDS_BYTES);
        (void)hipOccupancyMaxActiveBlocksPerMultiprocessor(&per_cu, (const void*)mk<0xffffffffu>, NTHREADS, LDS_BYTES);
#else
        per_cu = 1;
#endif
        if (n_in != 29 || ws_size < WS_END || per_cu < 1 || cus < 64) { fprintf(stderr, "kernel_launch: unexpected setup n_in %d ws %zu per_cu %d cus %d\n", n_in, ws_size, per_cu, cus); grid = -1; return; }
        grid = cus;
    }
    if (grid < 0) return;
    (void)hipMemsetAsync((char*)d_ws + WS_CTL, 0, CTL_BYTES, stream);
    Params p{};
    for (int i = 0; i < 29; ++i) p.in[i] = (const float*)d_in[i];
    p.out = (float*)d_out; p.ws = (unsigned char*)d_ws;
#if MK_ONE_LAUNCH
    p.ph_lo = 0; p.ph_hi = PH_COUNT; p.li = 0; p.coop = 1;
    void* args[] = {&p};
    hipError_t e = hipLaunchCooperativeKernel((const void*)mk<0xffffffffu>, dim3(grid), dim3(NTHREADS), args, LDS_BYTES, stream);
    if (e != hipSuccess) fprintf(stderr, "cooperative launch failed: %s (grid %d)\n", hipGetErrorString(e), grid);
#else
    launch_chain<0>(p, grid, stream);
#endif
}
```

```cpp
#include <hip/hip_runtime.h>
#include <hip/hip_cooperative_groups.h>
#include <cstdint>
#include <cstdio>
namespace cg = cooperative_groups;

#ifndef MK_ONE_LAUNCH
#define MK_ONE_LAUNCH 1
#endif

#define LAS __attribute__((address_space(3)))
#ifndef FAST_INPROJ
#define FAST_INPROJ 1
#endif
#ifndef FAST_MIX
#define FAST_MIX 1
#endif
#define PROBE_REP -1
constexpr int NTHREADS = 512;
constexpr int NWAVES = 8;
constexpr int LDS_BYTES = 155648;
constexpr int MISC_OFF = 153600;

constexpr int T = 16384, SEQ = 4096, D = 1024;
constexpr int NCOL_IN = 9488;
constexpr int NEXP = 32;
constexpr int MAXTILES = 288;
constexpr int MAXSLOTS = MAXTILES * 256;

enum { I_X = 0, I_NORM_MIX, I_W_IN, I_GDN_CONV, I_GDN_ALOG, I_GDN_DTB, I_GDN_NORM, I_MU, I_W0, I_W2, I_A0, I_A2, I_G2, I_KK, I_KA, I_RK,
       I_LNW, I_LNB, I_PROJ_A, I_PROJ_B, I_W_OUT, I_NORM_FFN, I_ROUTER_W, I_ROUTER_B, I_W_GU, I_B_GU, I_W_DOWN, I_B_DOWN, I_NORM_FINAL };

constexpr size_t MiB = 1u << 20;
constexpr size_t WS_CTL = 0, CTL_BYTES = 65536;
constexpr size_t WS_BETA = 1 * MiB;
constexpr size_t WS_GG = WS_BETA + 512 * 1024;
constexpr size_t WS_SC = 2 * MiB;
constexpr size_t WS_TE = 3 * MiB;
constexpr size_t WS_TG = WS_TE + 256 * 1024;
constexpr size_t WS_TP = WS_TG + 256 * 1024;
constexpr size_t WS_TSLOT = WS_TP + 256 * 1024;
constexpr size_t WS_SGATE = 4 * MiB;
constexpr size_t WS_TILE_E = 5 * MiB;
constexpr size_t WS_NT = WS_TILE_E + 4096;
constexpr size_t WS_HB = 8 * MiB;
constexpr size_t WS_H2 = WS_HB;
constexpr size_t WS_ZS = 40 * MiB;
constexpr size_t WS_GATES = 72 * MiB;
constexpr size_t WS_ALORA = 136 * MiB;
constexpr size_t WS_LW = 144 * MiB;
constexpr size_t WS_AA = 208 * MiB;
constexpr size_t WS_GGR = 272 * MiB;
constexpr size_t WS_VP = 304 * MiB;
constexpr size_t WS_Q = 336 * MiB;
constexpr size_t WS_QKVC = WS_Q;
constexpr size_t WS_RP = WS_Q, WS_KF = WS_Q + 64 * MiB, WS_KKN = WS_Q + 128 * MiB;
constexpr size_t WS_YA = WS_Q, WS_YB = WS_Q + 32 * MiB, WS_G2 = WS_Q + 64 * MiB, WS_X1 = WS_Q + 128 * MiB;
constexpr size_t WS_GQKV = 528 * MiB;
constexpr size_t WS_OG = 720 * MiB, WS_ORW = 784 * MiB;
constexpr size_t WS_RKV = 720 * MiB;
constexpr size_t WS_LIN = 912 * MiB;
constexpr size_t WS_DEC = 928 * MiB;
constexpr size_t WS_XB = 528 * MiB;
constexpr size_t WS_ACT = 672 * MiB;
constexpr size_t WS_YS = 816 * MiB;
constexpr size_t WS_WIN_T = 992 * MiB;
constexpr size_t WS_PROJ_T = 144 * MiB;
constexpr size_t WS_WOUT_T = 148 * MiB;
constexpr size_t WS_WGU_T = 72 * MiB;
constexpr size_t WS_WDN_T = 200 * MiB;
constexpr size_t WS_GA1 = 336 * MiB, WS_GX0 = 368 * MiB, WS_GA2 = 432 * MiB, WS_GA3 = 464 * MiB, WS_GA4 = 480 * MiB;
constexpr size_t WS_GGL = 6 * MiB;
constexpr size_t WS_RX0 = 528 * MiB, WS_RO0 = 592 * MiB, WS_RS0 = 656 * MiB;
constexpr size_t WS_RA1 = 8 * MiB, WS_RA2 = 928 * MiB, WS_RA3 = 960 * MiB, WS_RA4 = 992 * MiB;
constexpr size_t WS_RDSC = 7 * MiB;
constexpr size_t WS_LORA_T = 1012 * MiB;
constexpr size_t WS_END = 1024 * MiB;
constexpr int CW_BAR = 1024;
constexpr int CW_CNT = 256;

#define XB_TMO      128
#define XB_XCNT(j)  (256  + 64 * (j))
#define XB_XSUB(j)  (1280 + 64 * (j))
#define XB_XGEN(j)  (2304 + 64 * (j))
#define XB_TOP      3328
#define XB_TOPGEN   3392
#define XCD_BAR_WORDS 3456
#define XB_SPIN_CAP (1u << 24)
__device__ __forceinline__ unsigned xb_ld(unsigned* p)              { return __hip_atomic_load(p, __ATOMIC_RELAXED, __HIP_MEMORY_SCOPE_AGENT); }
__device__ __forceinline__ unsigned xb_add(unsigned* p, unsigned v) { return __hip_atomic_fetch_add(p, v, __ATOMIC_RELAXED, __HIP_MEMORY_SCOPE_AGENT); }
__device__ __forceinline__ unsigned xb_xcc_id() { return (unsigned)__builtin_amdgcn_s_getreg((3 << 11) | 20) & 0xFu; }
#define XB_SPIN(cond, bar) do { unsigned _sp = 0; while (cond) { __builtin_amdgcn_s_sleep(1); \
    if ((++_sp & 255u) == 0u) { if (xb_ld(&(bar)[XB_TMO])) break; if (_sp > XB_SPIN_CAP) { atomicAdd(&(bar)[XB_TMO], 1u); break; } } } } while (0)
struct XcdBarrier { unsigned* bar; unsigned x; volatile LAS unsigned* st; };
__device__ __forceinline__ XcdBarrier xcd_barrier_post(unsigned* bar, volatile LAS unsigned* st) {
    XcdBarrier b; b.bar = bar; b.x = xb_xcc_id(); b.st = st;
    if (threadIdx.x == 0) (void)xb_add(&bar[XB_XCNT(b.x)], 1u);
    return b;
}
__device__ __forceinline__ void xcd_barrier_complete(unsigned* bar, unsigned x, unsigned& nloc, unsigned& nx) {
    const unsigned G = gridDim.x * gridDim.y * gridDim.z;
    unsigned sum, cnt, mine, sp = 0u;
    for (;;) {
        sum = 0u; cnt = 0u; mine = 0u;
#pragma unroll
        for (unsigned j = 0; j < 16; ++j) { const unsigned c = xb_ld(&bar[XB_XCNT(j)]); sum += c; cnt += (c > 0u) ? 1u : 0u; mine = (j == x) ? c : mine; }
        if (sum == G) break;
        __builtin_amdgcn_s_sleep(1);
        if ((++sp & 255u) == 0u) { if (xb_ld(&bar[XB_TMO])) break; if (sp > XB_SPIN_CAP) { atomicAdd(&bar[XB_TMO], 1u); break; } }
    }
    nloc = mine > 0u ? mine : 1u; nx = cnt > 0u ? cnt : 1u;
}
__device__ __forceinline__ void xcd_barrier(const XcdBarrier& b) {
    asm volatile("s_waitcnt vmcnt(0)" ::: "memory");
    __syncthreads();
    if (threadIdx.x == 0) {
        unsigned* bar = b.bar;
        __builtin_amdgcn_s_waitcnt(0);
        unsigned nloc = b.st[0], nx = b.st[1];
        if (nloc == 0u) { xcd_barrier_complete(bar, b.x, nloc, nx); b.st[0] = nloc; b.st[1] = nx; }
        const unsigned old = xb_add(&bar[XB_XSUB(b.x)], 1u);
        const unsigned gen = old / nloc;
        if (old + 1u == (gen + 1u) * nloc) {
            __builtin_amdgcn_fence(__ATOMIC_RELEASE, "agent");
            asm volatile("s_waitcnt vmcnt(0)" ::: "memory");
            const unsigned og = xb_add(&bar[XB_TOP], 1u);
            const unsigned tg = og / nx;
            if (og + 1u == (tg + 1u) * nx) xb_add(&bar[XB_TOPGEN], 1u);
            else XB_SPIN(xb_ld(&bar[XB_TOPGEN]) == tg, bar);
            __builtin_amdgcn_fence(__ATOMIC_ACQUIRE, "agent");
            xb_add(&bar[XB_XGEN(b.x)], 1u);
            asm volatile("s_waitcnt vmcnt(0)" ::: "memory");
        } else {
            XB_SPIN(xb_ld(&bar[XB_XGEN(b.x)]) == gen, bar);
            __builtin_amdgcn_fence(__ATOMIC_ACQUIRE, "agent");
            asm volatile("s_waitcnt vmcnt(0)" ::: "memory");
        }
    }
    __syncthreads();
}

typedef unsigned short bf16;
__device__ __forceinline__ bf16 f2bf(float f) { unsigned u = __float_as_uint(f); u += 0x7fffu + ((u >> 16) & 1u); return (bf16)(u >> 16); }
__device__ __forceinline__ float bf2f(unsigned b) { return __uint_as_float(b << 16); }
__device__ __forceinline__ unsigned pk2(float lo, float hi) { return (unsigned)f2bf(lo) | ((unsigned)f2bf(hi) << 16); }
__device__ __forceinline__ float bflo(unsigned w) { return __uint_as_float(w << 16); }
__device__ __forceinline__ float bfhi(unsigned w) { return __uint_as_float(w & 0xffff0000u); }
__device__ __forceinline__ float sigm(float x) { return 1.f / (1.f + expf(-x)); }
__device__ __forceinline__ float fsigm(float x) { return __builtin_amdgcn_rcpf(1.f + __expf(-x)); }
__device__ __forceinline__ float softplusf(float x) { return x > 20.f ? x : log1pf(expf(x)); }
__device__ __forceinline__ float wsum(float v) {
#pragma unroll
    for (int o = 32; o > 0; o >>= 1) v += __shfl_xor(v, o);
    return v;
}

struct Params { const float* in[29]; float* out; unsigned char* ws; int ph_lo, ph_hi, li, coop; };

struct Ctx {
    const Params& P; int tid, lane, wave, gwave, nwaves; size_t gtid, nthreads; unsigned char* lds;
    template <class Tp> __device__ __forceinline__ Tp* ws(size_t off) const { return (Tp*)(P.ws + off); }
};

__device__ __forceinline__ void ph_rms0(const Ctx& c) {
    const float* x = c.P.in[I_X]; const float* nw = c.P.in[I_NORM_MIX]; const float* win = c.P.in[I_W_IN];
    const float* alog = c.P.in[I_GDN_ALOG]; const float* dtb = c.P.in[I_GDN_DTB];
    bf16* HB = c.ws<bf16>(WS_HB); float* BETA = c.ws<float>(WS_BETA); float* GGv = c.ws<float>(WS_GG);
    if (blockIdx.x == 0 && c.tid < NEXP) c.ws<unsigned>(WS_CTL)[CW_CNT + c.tid] = 0u;
    float4* tab = (float4*)c.lds;
    __syncthreads();
    for (int i = c.tid; i < 4096; i += NTHREADS) { const int k = i >> 2; tab[((k & 3) * 256 + (k >> 2)) * 5 + (i & 3)] = *(const float4*)(win + (size_t)k * NCOL_IN + 4096 + (i & 3) * 4); }
    __syncthreads();
    const int lane = c.lane;
    for (int t = c.gwave; t < T; t += c.nwaves) {
        float4 v[4]; float ss = 0.f;
#pragma unroll
        for (int i = 0; i < 4; ++i) { v[i] = ((const float4*)(x + (size_t)t * D))[lane + 64 * i]; ss += v[i].x * v[i].x + v[i].y * v[i].y + v[i].z * v[i].z + v[i].w * v[i].w; }
        ss = wsum(ss);
        const float rstd = rsqrtf(ss * (1.f / 1024.f) + 1e-6f);
        float acc[16];
#pragma unroll
        for (int j = 0; j < 16; ++j) acc[j] = 0.f;
#pragma unroll
        for (int i = 0; i < 4; ++i) {
            const float4 w4 = ((const float4*)nw)[lane + 64 * i];
            float h[4] = {v[i].x * rstd * w4.x, v[i].y * rstd * w4.y, v[i].z * rstd * w4.z, v[i].w * rstd * w4.w};
            uint2 st; st.x = pk2(h[0], h[1]); st.y = pk2(h[2], h[3]);
            *(uint2*)(HB + (size_t)t * D + 4 * (lane + 64 * i)) = st;
#pragma unroll
            for (int ii = 0; ii < 4; ++ii) {
                const int k = 4 * (lane + 64 * i) + ii;
#pragma unroll
                for (int q = 0; q < 4; ++q) { const float4 w = tab[(ii * 256 + (k >> 2)) * 5 + q]; acc[4 * q + 0] += h[ii] * w.x; acc[4 * q + 1] += h[ii] * w.y; acc[4 * q + 2] += h[ii] * w.z; acc[4 * q + 3] += h[ii] * w.w; }
                if (ii & 1) asm volatile("" ::: "memory");
            }
        }
        float mine = 0.f;
#pragma unroll
        for (int j = 0; j < 16; ++j) { const float s = wsum(acc[j]); mine = (lane == j) ? s : mine; }
        if (lane < 8) BETA[t * 8 + lane] = sigm(mine);
        else if (lane < 16) { const int h = lane - 8; GGv[t * 8 + h] = -expf(alog[h]) * softplusf(mine + dtb[h]); }
    }
    __syncthreads();
}

struct TileInfo { const bf16* A; int lda; const float* B; int ldb; int kmask; int row0; int col0; int aux; };

template <class TF, class EP>
__device__ __forceinline__ void ngemm(const Ctx& c, int ntiles, const TF& tf, const EP& ep, int K) {
    float* As = (float*)c.lds;
    float* Bs = As + 16 * 132;
    const int tid = c.tid, ty = tid >> 4, tx = tid & 15;
    const int ar = tid >> 2, ak = (tid & 3) * 4;
    const int bk = tid >> 5, bc = (tid & 31) * 4;
    for (int tile = blockIdx.x; tile < ntiles; tile += gridDim.x) {
        TileInfo ti; tf(tile, ti);
        float acc[4][8];
#pragma unroll
        for (int r = 0; r < 4; ++r)
#pragma unroll
            for (int j = 0; j < 8; ++j) acc[r][j] = 0.f;
        const bf16* ap = ti.A + (size_t)ar * ti.lda + ak;
        for (int k0 = 0; k0 < K; k0 += 16) {
            const uint2 av = *(const uint2*)(ap + k0);
            const float4 bv = *(const float4*)(ti.B + (size_t)((k0 + bk) & ti.kmask) * ti.ldb + bc);
            __syncthreads();
            As[(ak + 0) * 132 + ar] = bflo(av.x); As[(ak + 1) * 132 + ar] = bfhi(av.x);
            As[(ak + 2) * 132 + ar] = bflo(av.y); As[(ak + 3) * 132 + ar] = bfhi(av.y);
            *(float4*)(Bs + bk * 132 + bc) = bv;
            __syncthreads();
#pragma unroll
            for (int k = 0; k < 16; ++k) {
                const float4 a = *(const float4*)(As + k * 132 + ty * 4);
                const float4 b0 = *(const float4*)(Bs + k * 132 + tx * 8), b1 = *(const float4*)(Bs + k * 132 + tx * 8 + 4);
                const float av4[4] = {a.x, a.y, a.z, a.w};
                const float bv8[8] = {b0.x, b0.y, b0.z, b0.w, b1.x, b1.y, b1.z, b1.w};
#pragma unroll
                for (int r = 0; r < 4; ++r)
#pragma unroll
                    for (int j = 0; j < 8; ++j) acc[r][j] += av4[r] * bv8[j];
            }
        }
#pragma unroll
        for (int r = 0; r < 4; ++r) ep.store8(ti.row0 + ty * 4 + r, ti.col0 + tx * 8, acc[r], ti.aux);
    }
}

struct EpiInProj {
    bf16* GQKV; bf16* ZS; bf16* RKV; float* LIN; bf16* GATES;
    __device__ __forceinline__ void store8(int row, int col, const float (&v)[8], int) const {
        if (col < 3072) { uint4 w; w.x = pk2(v[0], v[1]); w.y = pk2(v[2], v[3]); w.z = pk2(v[4], v[5]); w.w = pk2(v[6], v[7]); *(uint4*)(GQKV + (size_t)row * 3072 + col) = w; }
        else if (col < 4096) { uint4 w; w.x = pk2(v[0] * fsigm(v[0]), v[1] * fsigm(v[1])); w.y = pk2(v[2] * fsigm(v[2]), v[3] * fsigm(v[3])); w.z = pk2(v[4] * fsigm(v[4]), v[5] * fsigm(v[5])); w.w = pk2(v[6] * fsigm(v[6]), v[7] * fsigm(v[7]));
            *(uint4*)(ZS + (size_t)row * 1024 + (col - 3072)) = w; }
        else if (col < 7168) { uint4 w; w.x = pk2(v[0], v[1]); w.y = pk2(v[2], v[3]); w.z = pk2(v[4], v[5]); w.w = pk2(v[6], v[7]); *(uint4*)(RKV + (size_t)row * 3072 + (col - 4096)) = w; }
        else if (col < 7424) { float* p = LIN + (size_t)row * 256 + (col - 7168); *(float4*)p = make_float4(v[0], v[1], v[2], v[3]); *(float4*)(p + 4) = make_float4(v[4], v[5], v[6], v[7]); }
        else { uint4 w; w.x = pk2(fsigm(v[0]), fsigm(v[1])); w.y = pk2(fsigm(v[2]), fsigm(v[3])); w.z = pk2(fsigm(v[4]), fsigm(v[5])); w.w = pk2(fsigm(v[6]), fsigm(v[7]));
            *(uint4*)(GATES + (size_t)row * 2048 + (col - 7424)) = w; }
    }
};
struct EpiG2 {
    const bf16* GATES; bf16* G2;
    __device__ __forceinline__ void store8(int row, int col, const float (&v)[8], int) const {
        const uint4 g = *(const uint4*)(GATES + (size_t)row * 2048 + col);
        uint4 w; w.x = pk2(v[0] * bflo(g.x), v[1] * bfhi(g.x)); w.y = pk2(v[2] * bflo(g.y), v[3] * bfhi(g.y)); w.z = pk2(v[4] * bflo(g.z), v[5] * bfhi(g.z)); w.w = pk2(v[6] * bflo(g.w), v[7] * bfhi(g.w));
        *(uint4*)(G2 + (size_t)row * 2048 + col) = w;
    }
};
struct EpiX1 {
    const float* X; float* X1;
    __device__ __forceinline__ void store8(int row, int col, const float (&v)[8], int) const {
        const float* xp = X + (size_t)row * 1024 + col; float* op = X1 + (size_t)row * 1024 + col;
        const float4 a = *(const float4*)xp, b = *(const float4*)(xp + 4);
        *(float4*)op = make_float4(a.x + v[0], a.y + v[1], a.z + v[2], a.w + v[3]); *(float4*)(op + 4) = make_float4(b.x + v[4], b.y + v[5], b.z + v[6], b.w + v[7]);
    }
};
struct EpiAct {
    const float* BGU; bf16* ACT;
    __device__ __forceinline__ void store8(int row, int col, const float (&v)[8], int e) const {
        const float* bp = BGU + (size_t)e * 2048 + col;
        const float4 b0 = *(const float4*)bp, b1 = *(const float4*)(bp + 4);
        const float bb[8] = {b0.x, b0.y, b0.z, b0.w, b1.x, b1.y, b1.z, b1.w};
        float o[4];
#pragma unroll
        for (int p = 0; p < 4; ++p) { float glu = v[2 * p] + bb[2 * p], lin = v[2 * p + 1] + bb[2 * p + 1]; glu = fminf(glu, 7.f); lin = fminf(fmaxf(lin, -7.f), 7.f); o[p] = glu * fsigm(1.702f * glu) * (lin + 1.f); }
        uint2 w; w.x = pk2(o[0], o[1]); w.y = pk2(o[2], o[3]);
        *(uint2*)(ACT + (size_t)row * 1024 + (col >> 1)) = w;
    }
};
struct EpiYS {
    const float* BD; const float* SGATE; bf16* YS;
    __device__ __forceinline__ void store8(int row, int col, const float (&v)[8], int e) const {
        const float* bp = BD + (size_t)e * 1024 + col; const float g = SGATE[row];
        const float4 b0 = *(const float4*)bp, b1 = *(const float4*)(bp + 4);
        uint4 w; w.x = pk2((v[0] + b0.x) * g, (v[1] + b0.y) * g); w.y = pk2((v[2] + b0.z) * g, (v[3] + b0.w) * g); w.z = pk2((v[4] + b1.x) * g, (v[5] + b1.y) * g); w.w = pk2((v[6] + b1.z) * g, (v[7] + b1.w) * g);
        *(uint4*)(YS + (size_t)row * 1024 + col) = w;
    }
};

struct TfInProj { const bf16* HB; const float* W;
    __device__ __forceinline__ void operator()(int tile, TileInfo& ti) const { const int tm = tile / 74, tn = tile % 74; ti.A = HB + (size_t)tm * 128 * 1024; ti.lda = 1024; ti.col0 = tn * 128; ti.row0 = tm * 128;
        ti.B = W + ti.col0 + (ti.col0 >= 4096 ? 16 : 0); ti.ldb = NCOL_IN; ti.kmask = 0x7fffffff; ti.aux = 0; } };
struct TfG2 { const bf16* YA; const bf16* YB; const float* PA; const float* PB;
    __device__ __forceinline__ void operator()(int tile, TileInfo& ti) const { const int tm = tile / 16, tn = tile % 16; ti.A = (tn < 8 ? YA : YB) + (size_t)tm * 128 * 1024; ti.lda = 1024; ti.col0 = tn * 128; ti.row0 = tm * 128;
        ti.B = (tn < 8 ? PA + tn * 128 : PB + (tn - 8) * 128); ti.ldb = 1024; ti.kmask = 0x7fffffff; ti.aux = 0; } };
struct TfX1 { const bf16* G2; const float* WO;
    __device__ __forceinline__ void operator()(int tile, TileInfo& ti) const { const int tm = tile / 8, tn = tile % 8; ti.A = G2 + (size_t)tm * 128 * 2048; ti.lda = 2048; ti.col0 = tn * 128; ti.row0 = tm * 128;
        ti.B = WO + tn * 128; ti.ldb = 1024; ti.kmask = 1023; ti.aux = 0; } };
struct TfMoe { const bf16* A; const float* W; const int* TILE_E; int ntn; int ldb; size_t wstride;
    __device__ __forceinline__ void operator()(int tile, TileInfo& ti) const { const int mt = tile / ntn, tn = tile % ntn; const int e = TILE_E[mt >> 1]; ti.A = A + (size_t)mt * 128 * 1024; ti.lda = 1024; ti.col0 = tn * 128; ti.row0 = mt * 128;
        ti.B = W + (size_t)e * wstride + tn * 128; ti.ldb = ldb; ti.kmask = 0x7fffffff; ti.aux = e; } };


namespace pg8 {
typedef short bf16x8 __attribute__((ext_vector_type(8)));
typedef float f32x4 __attribute__((ext_vector_type(4)));
constexpr int BM = 256, BK = 64, HALF = 128, HTB = HALF * BK * 2, NXCD = 8, WGM = 8;
__host__ __device__ __forceinline__ int lds_byte(int r, int c) { const int st = (r >> 4) * 2 + (c >> 5), rr = r & 15, cc = c & 31, ob = rr * 64 + cc * 2; return st * 1024 + (ob ^ (((ob >> 9) & 1) << 5)); }
__host__ __device__ __forceinline__ void stage_rc(int b, int& R, int& C) { const int st = b / 1024, sb = b % 1024, swz = sb ^ (((sb >> 9) & 1) << 5); R = (st >> 1) * 16 + swz / 64; C = (st & 1) * 32 + (swz % 64) / 2; }
__host__ __device__ __forceinline__ int perm32(int rho) { const int n = rho >> 4, i = rho & 15; return 8 * (i >> 2) + 4 * n + (i & 3); }
struct Unit { const char* a; const char* b; int row0, col0, aux; };
__device__ __forceinline__ void tile_order(int L, int nM, int nN, int& pm, int& pn) {
    const int nwg = nM * nN; int wgid = L; { const int q = nwg / NXCD, r = nwg % NXCD, xcd = wgid % NXCD, off = wgid / NXCD; wgid = (xcd < r ? xcd * (q + 1) : r * (q + 1) + (xcd - r) * q) + off; }
    const int nig = WGM * nN, gid = wgid / nig, fm = gid * WGM, gsz = (nM - fm) < WGM ? (nM - fm) : WGM;
    pm = fm + ((wgid % nig) % gsz); pn = (wgid % nig) / gsz;
}
template <class Epi>
__device__ __forceinline__ void epi_apply(const Epi& E, const f32x4 (&acc)[2][2][4][2], const Unit& u, int wr, int wc, int fr, int fq) {
#pragma unroll
    for (int ai = 0; ai < 2; ++ai)
#pragma unroll
        for (int m = 0; m < 4; ++m)
#pragma unroll
            for (int bj = 0; bj < 2; ++bj) {
                const f32x4 x0 = acc[ai][bj][m][0], x1 = acc[ai][bj][m][1];
                const float v[8] = {x0[0], x0[1], x0[2], x0[3], x1[0], x1[1], x1[2], x1[3]};
                E.store8(u.row0 + ai * HALF + wr * 64 + m * 16 + fr, u.col0 + bj * HALF + wc * 32 + 8 * fq, v, u.aux);
                asm volatile("" ::: "memory");
            }
}
template <class Epi, class Sched>
__device__ __forceinline__ void gemm_phase(LAS unsigned char* lds, const int K_, const Sched& S, const Epi& E, const int tid) {
    int K = K_; asm volatile("" : "+s"(K));
    const int wid = __builtin_amdgcn_readfirstlane(tid >> 6), lane = tid & 63, wr = wid >> 2, wc = wid & 3, fr = lane & 15, fq = lane >> 4;
    const int nt = K / BK;
    unsigned voffA[2], voffB[2];
#pragma unroll
    for (int i = 0; i < 2; ++i) { int R, C; stage_rc(tid * 16 + i * 8192, R, C); const int Rb = (R & ~31) + perm32(R & 31);
        voffA[i] = (unsigned)(R * K + C) * 2u; voffB[i] = (unsigned)(Rb * K + C) * 2u; }
    const size_t kstep = (size_t)(BK * 2);
    const size_t hstep = (size_t)HALF * K * 2;
    const unsigned ldsw = (unsigned)wid * 1024u;
    const int aoff = lds_byte(wr * 64 + fr, fq * 8), boff = lds_byte(wc * 32 + fr, fq * 8);
#define PG8_SA(b, h) (((b) * 2 + (h)) * HTB)
#define PG8_SB(b, h) ((4 + (b) * 2 + (h)) * HTB)
#define PG8_STAGE(bufoff, gbase, voff) do { _Pragma("unroll") for (int _i = 0; _i < 2; ++_i) \
        __builtin_amdgcn_global_load_lds((const unsigned*)((const char*)(gbase) + (voff)[_i]), (LAS unsigned*)(lds + (bufoff) + ldsw + _i * 8192), 16, 0, 0); } while (0)
#define PG8_LDA(dst, b, h) do { _Pragma("unroll") for (int m = 0; m < 4; ++m) _Pragma("unroll") for (int k = 0; k < 2; ++k) dst[m][k] = *(const LAS bf16x8*)(lds + PG8_SA(b, h) + aoff + m * 2048 + k * 1024); } while (0)
#define PG8_LDB(dst, b, h) do { _Pragma("unroll") for (int n = 0; n < 2; ++n) _Pragma("unroll") for (int k = 0; k < 2; ++k) dst[n][k] = *(const LAS bf16x8*)(lds + PG8_SB(b, h) + boff + n * 2048 + k * 1024); } while (0)
#define PG8_MMA(ai, bj, At, Bt) do { __builtin_amdgcn_s_setprio(1); _Pragma("unroll") for (int m = 0; m < 4; ++m) _Pragma("unroll") for (int n = 0; n < 2; ++n) _Pragma("unroll") for (int k = 0; k < 2; ++k) \
        acc[ai][bj][m][n] = __builtin_amdgcn_mfma_f32_16x16x32_bf16(Bt[n][k], At[m][k], acc[ai][bj][m][n], 0, 0, 0); __builtin_amdgcn_s_setprio(0); } while (0)
#define PG8_WAIT_V(n) asm volatile("s_waitcnt vmcnt(" #n ")" ::: "memory")
#define PG8_WAIT_L(n) asm volatile("s_waitcnt lgkmcnt(" #n ")" ::: "memory")
#define PG8_BAR __builtin_amdgcn_s_barrier()
#define PG8_SCHED __builtin_amdgcn_sched_barrier(0)
    Unit cur, nxt; int ui = 0;
    if (!S.next(0, cur)) return;
    f32x4 acc[2][2][4][2];
#pragma unroll
    for (int a = 0; a < 2; ++a)
#pragma unroll
        for (int b = 0; b < 2; ++b)
#pragma unroll
            for (int m = 0; m < 4; ++m)
#pragma unroll
                for (int n = 0; n < 2; ++n) acc[a][b][m][n] = (f32x4){0.f, 0.f, 0.f, 0.f};
    bf16x8 At[4][2], B0[2][2], B1[2][2];
    const char* cA = cur.a; const char* cB = cur.b;
    PG8_STAGE(PG8_SB(0, 0), cB, voffB); PG8_STAGE(PG8_SA(0, 0), cA, voffA); PG8_STAGE(PG8_SB(0, 1), cB + hstep, voffB); PG8_STAGE(PG8_SA(0, 1), cA + hstep, voffA);
    if (wr == 1) PG8_BAR;
    PG8_WAIT_V(4); PG8_BAR;
    PG8_STAGE(PG8_SB(1, 0), cB + kstep, voffB); PG8_STAGE(PG8_SA(1, 0), cA + kstep, voffA); PG8_STAGE(PG8_SB(1, 1), cB + hstep + kstep, voffB);
    PG8_WAIT_V(6); PG8_BAR;
    for (;;) {
        const bool has_next = S.next(ui + 1, nxt);
        const char* nA = has_next ? nxt.a : cA; const char* nB = has_next ? nxt.b : cB;
#pragma unroll 1
        for (int t = 0; t < nt; t += 2) {
            const bool last = (t == nt - 2);
            const char* a1 = cA + (size_t)(t + 1) * kstep;
            const char* a2 = last ? nA : cA + (size_t)(t + 2) * kstep; const char* b2 = last ? nB : cB + (size_t)(t + 2) * kstep;
            const char* a3 = a2 + kstep; const char* b3 = b2 + kstep;
            PG8_LDB(B0, 0, 0); PG8_SCHED; PG8_LDA(At, 0, 0); PG8_STAGE(PG8_SA(1, 1), a1 + hstep, voffA);
            PG8_WAIT_L(8); PG8_BAR; PG8_WAIT_L(0); PG8_MMA(0, 0, At, B0); PG8_BAR; PG8_SCHED;
            PG8_LDB(B1, 0, 1); PG8_STAGE(PG8_SB(0, 0), b2, voffB);
            PG8_BAR; PG8_WAIT_L(0); PG8_MMA(0, 1, At, B1); PG8_BAR;
            PG8_LDA(At, 0, 1); PG8_STAGE(PG8_SA(0, 0), a2, voffA);
            PG8_BAR; PG8_WAIT_L(0); PG8_MMA(1, 0, At, B0); PG8_BAR; PG8_SCHED;
            PG8_STAGE(PG8_SB(0, 1), b2 + hstep, voffB);
            PG8_WAIT_V(6); PG8_BAR; PG8_MMA(1, 1, At, B1); PG8_BAR;
            PG8_LDB(B0, 1, 0); PG8_SCHED; PG8_LDA(At, 1, 0); PG8_STAGE(PG8_SA(0, 1), a2 + hstep, voffA);
            PG8_WAIT_L(8); PG8_BAR; PG8_WAIT_L(0); PG8_MMA(0, 0, At, B0); PG8_BAR; PG8_SCHED;
            PG8_LDB(B1, 1, 1); PG8_STAGE(PG8_SB(1, 0), b3, voffB);
            PG8_BAR; PG8_WAIT_L(0); PG8_MMA(0, 1, At, B1); PG8_BAR;
            PG8_LDA(At, 1, 1); PG8_STAGE(PG8_SA(1, 0), a3, voffA);
            PG8_BAR; PG8_WAIT_L(0); PG8_MMA(1, 0, At, B0); PG8_BAR; PG8_SCHED;
            PG8_STAGE(PG8_SB(1, 1), b3 + hstep, voffB);
            PG8_WAIT_V(6); PG8_BAR; PG8_MMA(1, 1, At, B1); PG8_BAR;
        }
        epi_apply(E, acc, cur, wr, wc, fr, fq);
        if (!has_next) break;
#pragma unroll
        for (int a = 0; a < 2; ++a)
#pragma unroll
            for (int b = 0; b < 2; ++b)
#pragma unroll
                for (int m = 0; m < 4; ++m)
#pragma unroll
                    for (int n = 0; n < 2; ++n) acc[a][b][m][n] = (f32x4){0.f, 0.f, 0.f, 0.f};
        cur = nxt; cA = nA; cB = nB; ++ui;
    }
    PG8_WAIT_V(0);
    if (wr == 0) PG8_BAR;
    PG8_BAR;
#undef PG8_SA
#undef PG8_SB
#undef PG8_STAGE
#undef PG8_LDA
#undef PG8_LDB
#undef PG8_MMA
#undef PG8_WAIT_V
#undef PG8_WAIT_L
#undef PG8_BAR
#undef PG8_SCHED
}
}

struct SchedInProj { const char* A; const char* Bt; int G, c;
    __device__ __forceinline__ bool next(int i, pg8::Unit& u) const { const int L = i * G + c; if (L >= 64 * 37) return false; int pm, pn; pg8::tile_order(L, 64, 37, pm, pn);
        u.a = A + (size_t)pm * (256 * 1024 * 2); u.b = Bt + (size_t)pn * (256 * 1024 * 2); u.row0 = pm * 256; u.col0 = pn * 256; u.aux = 0; return true; } };

struct WJob { const float* src; int ld_src; int K; int ncols; bf16* dst; int ld_dst; int nb; size_t sstride, dstride; };
__device__ __forceinline__ void wconv_job(const Ctx& c, const WJob& j) {
    float* tl = (float*)c.lds;
    const int ntk = j.K >> 6, ntn = j.ncols >> 6, per = ntk * ntn, ntiles = per * j.nb;
    const int rk = c.tid >> 3, rseg = (c.tid & 7) * 8;
    for (int tile = blockIdx.x; tile < ntiles; tile += gridDim.x) {
        const int bi = tile / per, tt = tile % per, tk = tt % ntk, tn = tt / ntk;
        const float* sp = j.src + (size_t)bi * j.sstride + (size_t)(tk * 64 + rk) * j.ld_src + tn * 64 + rseg;
        const float4 a = *(const float4*)sp, b = *(const float4*)(sp + 4);
        __syncthreads();
        float* row = tl + rk * 65 + rseg;
        row[0] = a.x; row[1] = a.y; row[2] = a.z; row[3] = a.w; row[4] = b.x; row[5] = b.y; row[6] = b.z; row[7] = b.w;
        __syncthreads();
        const float* col = tl + rseg * 65 + rk;
        uint4 w; w.x = pk2(col[0], col[65]); w.y = pk2(col[130], col[195]); w.z = pk2(col[260], col[325]); w.w = pk2(col[390], col[455]);
        *(uint4*)(j.dst + (size_t)bi * j.dstride + (size_t)(tn * 64 + rk) * j.ld_dst + tk * 64 + rseg) = w;
    }
}
struct SchedG2 { const char* YA; const char* YB; const char* Bt; int G, c;
    __device__ __forceinline__ bool next(int i, pg8::Unit& u) const { const int L = i * G + c; if (L >= 64 * 8) return false; int pm, pn; pg8::tile_order(L, 64, 8, pm, pn);
        u.a = (pn < 4 ? YA : YB) + (size_t)pm * (256 * 1024 * 2); u.b = Bt + (size_t)pn * (256 * 1024 * 2); u.row0 = pm * 256; u.col0 = pn * 256; u.aux = 0; return true; } };
struct SchedX1 { const char* A; const char* Bt; int G, c;
    __device__ __forceinline__ bool next(int i, pg8::Unit& u) const { const int L = i * G + c; if (L >= 64 * 4) return false; int pm, pn; pg8::tile_order(L, 64, 4, pm, pn);
        u.a = A + (size_t)pm * (256 * 2048 * 2); u.b = Bt + (size_t)pn * (256 * 2048 * 2); u.row0 = pm * 256; u.col0 = pn * 256; u.aux = 0; return true; } };
struct SchedMoe { const char* A; const char* Bt; const int* TILE_E; int NT, NPN, G, c;
    __device__ __forceinline__ bool next(int i, pg8::Unit& u) const { const int L = i * G + c; if (L >= NT * NPN) return false; const int tile = L / NPN, pn = L % NPN; const int e = TILE_E[tile];
        u.a = A + (size_t)tile * (256 * 1024 * 2); u.b = Bt + (size_t)(e * NPN + pn) * (256 * 1024 * 2); u.row0 = tile * 256; u.col0 = pn * 256; u.aux = e; return true; } };


struct EpiLora {
    const float* w0; const float* a0; float* LW; float* AA; bf16* GGR;
    __device__ __forceinline__ void store8(int row, int col, const float (&v)[8], int) const {
        if (col < 1024) { float o[8];
#pragma unroll
            for (int i = 0; i < 8; ++i) o[i] = -0.6065306597126334f * fsigm(w0[col + i] + v[i]);
            float* p = LW + (size_t)row * 1024 + col; *(float4*)p = make_float4(o[0], o[1], o[2], o[3]); *(float4*)(p + 4) = make_float4(o[4], o[5], o[6], o[7]); }
        else if (col < 2048) { const int cc = col - 1024; float o[8];
#pragma unroll
            for (int i = 0; i < 8; ++i) o[i] = fsigm(a0[cc + i] + v[i]);
            float* p = AA + (size_t)row * 1024 + cc; *(float4*)p = make_float4(o[0], o[1], o[2], o[3]); *(float4*)(p + 4) = make_float4(o[4], o[5], o[6], o[7]); }
        else { uint4 w; w.x = pk2(v[0], v[1]); w.y = pk2(v[2], v[3]); w.z = pk2(v[4], v[5]); w.w = pk2(v[6], v[7]); *(uint4*)(GGR + (size_t)row * 1024 + (col - 2048)) = w; }
    }
};
struct SchedLora { const char* A; const char* Bt; int G, c;
    __device__ __forceinline__ bool next(int i, pg8::Unit& u) const { const int L = i * G + c; if (L >= 64 * 12) return false; int pm, pn; pg8::tile_order(L, 64, 12, pm, pn);
        u.a = A + (size_t)pm * (256 * 256 * 2); u.b = Bt + (size_t)pn * (256 * 256 * 2); u.row0 = pm * 256; u.col0 = pn * 256; u.aux = 0; return true; } };
__device__ __forceinline__ void lora_zero(const Ctx& c) {
    uint4* LT = c.ws<uint4>(WS_LORA_T);
    for (size_t idx = c.gtid; idx < (size_t)3072 * 32; idx += c.nthreads) {
        const int row = (int)(idx >> 5), k8 = (int)(idx & 31) * 8;
        const bool data = row < 1024 ? (k8 < 64) : (row < 2048 ? (k8 >= 64 && k8 < 128) : (k8 >= 128));
        if (!data) LT[idx] = make_uint4(0, 0, 0, 0);
    }
}

__device__ __forceinline__ void ph_loraprep(const Ctx& c) {
    const float* LIN = c.ws<float>(WS_LIN); bf16* AL = c.ws<bf16>(WS_ALORA); const float* mu = c.P.in[I_MU];
    for (size_t idx = c.gtid; idx < (size_t)T * 256; idx += c.nthreads) {
        const int t = (int)(idx >> 8), cc = (int)(idx & 255);
        const float x = LIN[idx], xp = (t & (SEQ - 1)) ? LIN[idx - 256] : 0.f;
        const float xs = x + (xp - x) * mu[3072 + cc];
        const float r = cc < 64 ? tanhf(xs) : (cc < 128 ? xs : sigm(xs));
        AL[idx] = f2bf(r);
    }
}
__device__ __forceinline__ void ph_post(const Ctx& c) {
    const float* OG = c.ws<float>(WS_OG); const float* ORW = c.ws<float>(WS_ORW); const bf16* ZS = c.ws<bf16>(WS_ZS); const bf16* VP = c.ws<bf16>(WS_VP); const bf16* GGR = c.ws<bf16>(WS_GGR);
    const float* SC = c.ws<float>(WS_SC); bf16* YA = c.ws<bf16>(WS_YA); bf16* YB = c.ws<bf16>(WS_YB);
    const float* gnw = c.P.in[I_GDN_NORM]; const float* lnw = c.P.in[I_LNW]; const float* lnb = c.P.in[I_LNB];
    const int lane = c.lane, c0 = lane * 16;
    for (int t = c.gwave; t < T; t += c.nwaves) {
        {
            float o[16];
#pragma unroll
            for (int q = 0; q < 4; ++q) { const float4 v = *(const float4*)(OG + (size_t)t * 1024 + c0 + 4 * q); o[4 * q] = v.x; o[4 * q + 1] = v.y; o[4 * q + 2] = v.z; o[4 * q + 3] = v.w; }
            float ss = 0.f;
#pragma unroll
            for (int j = 0; j < 16; ++j) ss += o[j] * o[j];
            ss += __shfl_xor(ss, 1); ss += __shfl_xor(ss, 2); ss += __shfl_xor(ss, 4);
            const float rstd = rsqrtf(ss * (1.f / 128.f) + 1e-6f);
            const uint4 z0 = *(const uint4*)(ZS + (size_t)t * 1024 + c0), z1 = *(const uint4*)(ZS + (size_t)t * 1024 + c0 + 8);
            const unsigned zz[8] = {z0.x, z0.y, z0.z, z0.w, z1.x, z1.y, z1.z, z1.w};
            unsigned w[8];
#pragma unroll
            for (int j = 0; j < 8; ++j) { const int cc = (c0 + 2 * j) & 127; w[j] = pk2(o[2 * j] * rstd * gnw[cc] * bflo(zz[j]), o[2 * j + 1] * rstd * gnw[cc + 1] * bfhi(zz[j])); }
            *(uint4*)(YA + (size_t)t * 1024 + c0) = make_uint4(w[0], w[1], w[2], w[3]); *(uint4*)(YA + (size_t)t * 1024 + c0 + 8) = make_uint4(w[4], w[5], w[6], w[7]);
        }
        {
            float o[16];
#pragma unroll
            for (int q = 0; q < 4; ++q) { const float4 v = *(const float4*)(ORW + (size_t)t * 1024 + c0 + 4 * q); o[4 * q] = v.x; o[4 * q + 1] = v.y; o[4 * q + 2] = v.z; o[4 * q + 3] = v.w; }
            float sm = 0.f;
#pragma unroll
            for (int j = 0; j < 16; ++j) sm += o[j];
            sm += __shfl_xor(sm, 1); sm += __shfl_xor(sm, 2);
            const float mean = sm * (1.f / 64.f);
            float sv = 0.f;
#pragma unroll
            for (int j = 0; j < 16; ++j) { const float dd = o[j] - mean; sv += dd * dd; }
            sv += __shfl_xor(sv, 1); sv += __shfl_xor(sv, 2);
            const float rstd = rsqrtf(sv * (1.f / 64.f) + 64e-5f);
            const float sc = SC[t * 16 + (c0 >> 6)];
            const uint4 v0 = *(const uint4*)(VP + (size_t)t * 1024 + c0), v1 = *(const uint4*)(VP + (size_t)t * 1024 + c0 + 8);
            const uint4 g0 = *(const uint4*)(GGR + (size_t)t * 1024 + c0), g1 = *(const uint4*)(GGR + (size_t)t * 1024 + c0 + 8);
            const unsigned vv[8] = {v0.x, v0.y, v0.z, v0.w, v1.x, v1.y, v1.z, v1.w};
            const unsigned gg[8] = {g0.x, g0.y, g0.z, g0.w, g1.x, g1.y, g1.z, g1.w};
            unsigned w[8];
#pragma unroll
            for (int j = 0; j < 8; ++j) { const int cc = c0 + 2 * j;
                const float y0 = ((o[2 * j] - mean) * rstd * lnw[cc] + lnb[cc] + sc * bflo(vv[j])) * bflo(gg[j]);
                const float y1 = ((o[2 * j + 1] - mean) * rstd * lnw[cc + 1] + lnb[cc + 1] + sc * bfhi(vv[j])) * bfhi(gg[j]);
                w[j] = pk2(y0, y1); }
            *(uint4*)(YB + (size_t)t * 1024 + c0) = make_uint4(w[0], w[1], w[2], w[3]); *(uint4*)(YB + (size_t)t * 1024 + c0 + 8) = make_uint4(w[4], w[5], w[6], w[7]);
        }
    }
}

__device__ __forceinline__ void ph_router(const Ctx& c) {
    const float* X1 = c.ws<float>(WS_X1); const float* nw = c.P.in[I_NORM_FFN]; const float* rw = c.P.in[I_ROUTER_W]; const float* rb = c.P.in[I_ROUTER_B];
    bf16* H2 = c.ws<bf16>(WS_H2); int* TE = c.ws<int>(WS_TE); float* TG = c.ws<float>(WS_TG); int* TP = c.ws<int>(WS_TP); unsigned* CNT = c.ws<unsigned>(WS_CTL) + CW_CNT;
    const int lane = c.lane;
    float4* tab = (float4*)c.lds;
    unsigned* lcnt = (unsigned*)(c.lds + 147456);
    __syncthreads();
    if (c.tid < 32) lcnt[c.tid] = 0u;
    for (int i = c.tid; i < 8192; i += NTHREADS) { const int k = i >> 3; tab[((k & 3) * 256 + (k >> 2)) * 9 + (i & 7)] = ((const float4*)rw)[i]; }
    __syncthreads();
    for (int t = c.gwave; t < T; t += c.nwaves) {
        float4 v[4]; float ss = 0.f;
#pragma unroll
        for (int i = 0; i < 4; ++i) { v[i] = ((const float4*)(X1 + (size_t)t * D))[lane + 64 * i]; ss += v[i].x * v[i].x + v[i].y * v[i].y + v[i].z * v[i].z + v[i].w * v[i].w; }
        ss = wsum(ss);
        const float rstd = rsqrtf(ss * (1.f / 1024.f) + 1e-6f);
        float lg[32];
#pragma unroll
        for (int j = 0; j < 32; ++j) lg[j] = 0.f;
#pragma unroll
        for (int i = 0; i < 4; ++i) {
            const float4 w4 = ((const float4*)nw)[lane + 64 * i];
            const float h[4] = {v[i].x * rstd * w4.x, v[i].y * rstd * w4.y, v[i].z * rstd * w4.z, v[i].w * rstd * w4.w};
            uint2 st; st.x = pk2(h[0], h[1]); st.y = pk2(h[2], h[3]);
            *(uint2*)(H2 + (size_t)t * D + 4 * (lane + 64 * i)) = st;
#pragma unroll
            for (int ii = 0; ii < 4; ++ii) {
                const float4* wr = tab + (size_t)(ii * 256 + lane + 64 * i) * 9;
#pragma unroll
                for (int q = 0; q < 8; ++q) { const float4 w = wr[q]; lg[4 * q] += h[ii] * w.x; lg[4 * q + 1] += h[ii] * w.y; lg[4 * q + 2] += h[ii] * w.z; lg[4 * q + 3] += h[ii] * w.w; }
                asm volatile("" ::: "memory");
            }
        }
#pragma unroll
        for (int j = 0; j < 32; ++j) lg[j] = wsum(lg[j]) + rb[j];
        int e0 = 0, e1 = 0, e2 = 0, e3 = 0; float v0 = -3e38f, v1 = -3e38f, v2 = -3e38f, v3 = -3e38f;
#pragma unroll
        for (int j = 0; j < 32; ++j) if (lg[j] > v0) { v0 = lg[j]; e0 = j; }
#pragma unroll
        for (int j = 0; j < 32; ++j) if (j != e0 && lg[j] > v1) { v1 = lg[j]; e1 = j; }
#pragma unroll
        for (int j = 0; j < 32; ++j) if (j != e0 && j != e1 && lg[j] > v2) { v2 = lg[j]; e2 = j; }
#pragma unroll
        for (int j = 0; j < 32; ++j) if (j != e0 && j != e1 && j != e2 && lg[j] > v3) { v3 = lg[j]; e3 = j; }
        const float x1 = expf(v1 - v0), x2 = expf(v2 - v0), x3 = expf(v3 - v0), inv = 1.f / (1.f + x1 + x2 + x3);
        if (lane < 4) {
            const int me = lane == 0 ? e0 : (lane == 1 ? e1 : (lane == 2 ? e2 : e3));
            const float mg = (lane == 0 ? 1.f : (lane == 1 ? x1 : (lane == 2 ? x2 : x3))) * inv;
            const unsigned pos = atomicAdd(&lcnt[me], 1u);
            TE[t * 4 + lane] = me; TG[t * 4 + lane] = mg; TP[t * 4 + lane] = (int)pos;
        }
    }
    __syncthreads();
    if (c.tid < 32) lcnt[32 + c.tid] = atomicAdd(&CNT[c.tid], lcnt[c.tid]);
    __syncthreads();
    if (lane < 4) for (int t = c.gwave; t < T; t += c.nwaves) TP[t * 4 + lane] += (int)lcnt[32 + TE[t * 4 + lane]];
    __syncthreads();
}

__device__ __forceinline__ void ph_dispatch(const Ctx& c) {
    int* tb = (int*)c.lds;
    const unsigned* CNT = c.ws<unsigned>(WS_CTL) + CW_CNT;
    int* TILE_E = c.ws<int>(WS_TILE_E); int* NT = c.ws<int>(WS_NT);
    const int* TE = c.ws<int>(WS_TE); const float* TG = c.ws<float>(WS_TG); const int* TP = c.ws<int>(WS_TP); int* TSLOT = c.ws<int>(WS_TSLOT);
    float* SGATE = c.ws<float>(WS_SGATE); const bf16* H2 = c.ws<bf16>(WS_H2); bf16* XB = c.ws<bf16>(WS_XB);
    if (c.tid == 0) { int acc = 0; for (int e = 0; e < NEXP; ++e) { const int n = (int)__hip_atomic_load(&CNT[e], __ATOMIC_RELAXED, __HIP_MEMORY_SCOPE_AGENT); tb[e] = acc; tb[64 + e] = n; acc += (n + 255) >> 8; } tb[32] = acc; }
    __syncthreads();
    if (blockIdx.x == 0) {
        for (int tile = c.tid; tile < tb[32]; tile += NTHREADS) { int e = 0; for (int q = 0; q < NEXP; ++q) if (tile >= tb[q]) e = q; TILE_E[tile] = e; }
        if (c.tid == 0) *NT = tb[32];
    }
    for (int idx = c.gwave; idx < T * 4; idx += c.nwaves) {
        const int t = idx >> 2, e = TE[idx], pos = TP[idx];
        const int slot = tb[e] * 256 + pos;
        if (c.lane == 0) { TSLOT[idx] = slot; SGATE[slot] = TG[idx]; }
        const uint4* src = (const uint4*)(H2 + (size_t)t * 1024); uint4* dst = (uint4*)(XB + (size_t)slot * 1024);
        dst[c.lane] = src[c.lane]; dst[c.lane + 64] = src[c.lane + 64];
    }
    for (int e = 0; e < NEXP; ++e) {
        const int n = tb[64 + e], cap = (tb[e + 1] - tb[e]) * 256;
        for (int r = n + c.gwave; r < cap; r += c.nwaves) {
            const int slot = tb[e] * 256 + r;
            uint4* dst = (uint4*)(XB + (size_t)slot * 1024);
            dst[c.lane] = make_uint4(0, 0, 0, 0); dst[c.lane + 64] = make_uint4(0, 0, 0, 0);
            if (c.lane == 0) SGATE[slot] = 0.f;
        }
    }
}

__device__ __forceinline__ void ph_combine(const Ctx& c) {
    const float* X1 = c.ws<float>(WS_X1); const bf16* YS = c.ws<bf16>(WS_YS); const int* TSLOT = c.ws<int>(WS_TSLOT); const float* nw = c.P.in[I_NORM_FINAL]; float* out = c.P.out;
    const int lane = c.lane;
    for (int t = c.gwave; t < T; t += c.nwaves) {
        const int s0 = TSLOT[t * 4], s1 = TSLOT[t * 4 + 1], s2 = TSLOT[t * 4 + 2], s3 = TSLOT[t * 4 + 3];
        float4 v[4]; float ss = 0.f;
#pragma unroll
        for (int i = 0; i < 4; ++i) {
            const int col = 4 * (lane + 64 * i);
            v[i] = *(const float4*)(X1 + (size_t)t * D + col);
            const uint2 a = *(const uint2*)(YS + (size_t)s0 * 1024 + col), b = *(const uint2*)(YS + (size_t)s1 * 1024 + col), cc = *(const uint2*)(YS + (size_t)s2 * 1024 + col), d = *(const uint2*)(YS + (size_t)s3 * 1024 + col);
            v[i].x += bflo(a.x) + bflo(b.x) + bflo(cc.x) + bflo(d.x); v[i].y += bfhi(a.x) + bfhi(b.x) + bfhi(cc.x) + bfhi(d.x);
            v[i].z += bflo(a.y) + bflo(b.y) + bflo(cc.y) + bflo(d.y); v[i].w += bfhi(a.y) + bfhi(b.y) + bfhi(cc.y) + bfhi(d.y);
            ss += v[i].x * v[i].x + v[i].y * v[i].y + v[i].z * v[i].z + v[i].w * v[i].w;
        }
        ss = wsum(ss);
        const float rstd = rsqrtf(ss * (1.f / 1024.f) + 1e-6f);
#pragma unroll
        for (int i = 0; i < 4; ++i) { const float4 w4 = ((const float4*)nw)[lane + 64 * i];
            *(float4*)(out + (size_t)t * D + 4 * (lane + 64 * i)) = make_float4(v[i].x * rstd * w4.x, v[i].y * rstd * w4.y, v[i].z * rstd * w4.z, v[i].w * rstd * w4.w); }
    }
}


typedef short bf16x8_t __attribute__((ext_vector_type(8)));
typedef float f32x4_t __attribute__((ext_vector_type(4)));
#define MFMA16(a, b, c) __builtin_amdgcn_mfma_f32_16x16x32_bf16((a), (b), (c), 0, 0, 0)


__device__ __forceinline__ int frag_off(int row, int k, int KBn) { return (((row >> 4) * KBn + (k >> 5)) * 512) + (((k >> 3) & 3) * 128) + ((row & 15) * 8) + (k & 7); }
__device__ __forceinline__ int cfrag_off(int v, int r, int NRT) { return ((((v >> 4) * NRT + (r >> 4)) * 64 + ((r >> 2) & 3) * 16 + (v & 15)) * 4) + (r & 3); }

constexpr int GCL_HALF_BYTES = 71680;
__device__ __forceinline__ void ph_gcl(const Ctx& c) {
    const bf16* GQKV = c.ws<bf16>(WS_GQKV); const float* BETA = c.ws<float>(WS_BETA); const float* GGv = c.ws<float>(WS_GG); const float* cw = c.P.in[I_GDN_CONV];
    bf16* GA1 = c.ws<bf16>(WS_GA1); float* GX0 = c.ws<float>(WS_GX0); bf16* GA2 = c.ws<bf16>(WS_GA2); bf16* GA3 = c.ws<bf16>(WS_GA3); bf16* GA4 = c.ws<bf16>(WS_GA4); float* GGL = c.ws<float>(WS_GGL);
    for (int it0 = blockIdx.x * 2; it0 < 2048; it0 += gridDim.x * 2) {
        int tv = c.tid; asm volatile("" : "+v"(tv));
        const int half = tv >> 8, ht = tv & 255, lane = tv & 63, w4 = __builtin_amdgcn_readfirstlane((tv >> 6) & 3);
        unsigned char* base = c.lds + half * GCL_HALF_BYTES;
        bf16* QB = (bf16*)base;
        bf16* KB = QB + 64 * 136;
        bf16* VB = KB + 64 * 136;
        float* MM = (float*)(VB + 64 * 136);
        float* GC = MM + 64 * 64;
        float* BT = GC + 64;
        float* BE = BT + 64;
        const int item = it0 + half, n = item & 63, bh = item >> 6, h = bh & 7, b = bh >> 3;
        const int t0 = b * SEQ + n * 64;
        __syncthreads();
        if (w4 == 0) {
            float g = GGv[(size_t)(t0 + lane) * 8 + h]; const float be = BETA[(size_t)(t0 + lane) * 8 + h];
#pragma unroll
            for (int o = 1; o < 64; o <<= 1) { const float u = __shfl_up(g, o); if (lane >= o) g += u; }
            GC[lane] = g; BT[lane] = be; BE[lane] = be * __expf(g);
        }
        __syncthreads();
        {
            const int cg = ht & 15, rg = ht >> 4, r0 = rg * 4;
#pragma unroll
            for (int mat = 0; mat < 3; ++mat) {
                const int col0 = mat * 1024 + h * 128 + cg * 8;
                float4 xa[7], xb[7], wa[4], wb[4];
#pragma unroll
                for (int li = 0; li < 7; ++li) {
                    const bool valid = (n > 0) || (r0 - 3 + li >= 0);
                    uint4 xr = make_uint4(0, 0, 0, 0);
                    if (valid) xr = *(const uint4*)(GQKV + (size_t)(t0 + r0 - 3 + li) * 3072 + col0);
                    xa[li] = make_float4(bflo(xr.x), bfhi(xr.x), bflo(xr.y), bfhi(xr.y));
                    xb[li] = make_float4(bflo(xr.z), bfhi(xr.z), bflo(xr.w), bfhi(xr.w));
                }
#pragma unroll
                for (int j = 0; j < 4; ++j) { wa[j] = *(const float4*)(cw + j * 3072 + col0); wb[j] = *(const float4*)(cw + j * 3072 + col0 + 4); }
#pragma unroll
                for (int rr = 0; rr < 4; ++rr) {
                    float o[8] = {0.f, 0.f, 0.f, 0.f, 0.f, 0.f, 0.f, 0.f};
#pragma unroll
                    for (int j = 0; j < 4; ++j) { const float4 a = xa[rr + j], bq = xb[rr + j];
                        o[0] += wa[j].x * a.x; o[1] += wa[j].y * a.y; o[2] += wa[j].z * a.z; o[3] += wa[j].w * a.w;
                        o[4] += wb[j].x * bq.x; o[5] += wb[j].y * bq.y; o[6] += wb[j].z * bq.z; o[7] += wb[j].w * bq.w; }
                    float ss = 0.f;
#pragma unroll
                    for (int e = 0; e < 8; ++e) { o[e] *= fsigm(o[e]); ss += o[e] * o[e]; }
                    float sc = 1.f;
                    if (mat < 2) { ss += __shfl_xor(ss, 1); ss += __shfl_xor(ss, 2); ss += __shfl_xor(ss, 4); ss += __shfl_xor(ss, 8); sc = rsqrtf(ss + 1e-6f) * (mat == 0 ? 0.08838834764831845f : 1.f); }
                    const int r = r0 + rr;
                    uint4 w; w.x = pk2(o[0] * sc, o[1] * sc); w.y = pk2(o[2] * sc, o[3] * sc); w.z = pk2(o[4] * sc, o[5] * sc); w.w = pk2(o[6] * sc, o[7] * sc);
                    *(uint4*)((mat == 0 ? QB : (mat == 1 ? KB : VB)) + r * 136 + cg * 8) = w;
                    if (mat == 0) {
                        const float s2 = sc * __expf(GC[r]);
                        w.x = pk2(o[0] * s2, o[1] * s2); w.y = pk2(o[2] * s2, o[3] * s2); w.z = pk2(o[4] * s2, o[5] * s2); w.w = pk2(o[6] * s2, o[7] * s2);
                        *(uint4*)(GA2 + (size_t)item * 64 * 128 + frag_off(r, cg * 8, 4)) = w;
                    }
                }
            }
        }
        __syncthreads();
        {
            const int fr = lane & 15, fq = lane >> 4, a0 = w4 * 16;
            bf16x8_t ka[4];
#pragma unroll
            for (int kb = 0; kb < 4; ++kb) ka[kb] = *(const bf16x8_t*)(KB + (a0 + fr) * 136 + kb * 32 + fq * 8);
#pragma unroll
            for (int bt = 0; bt < 4; ++bt) {
                f32x4_t c1 = {0.f, 0.f, 0.f, 0.f}, c2 = {0.f, 0.f, 0.f, 0.f};
#pragma unroll
                for (int kb = 0; kb < 4; ++kb) {
                    const bf16x8_t kbf = *(const bf16x8_t*)(KB + (bt * 16 + fr) * 136 + kb * 32 + fq * 8);
                    const bf16x8_t qbf = *(const bf16x8_t*)(QB + (bt * 16 + fr) * 136 + kb * 32 + fq * 8);
                    c1 = MFMA16(ka[kb], kbf, c1); c2 = MFMA16(ka[kb], qbf, c2);
                }
                const int i = bt * 16 + fr, j0 = a0 + 4 * fq;
                const float gi = GC[i], bi = BT[i];
                float m[4], at[4];
#pragma unroll
                for (int rg = 0; rg < 4; ++rg) { const int j = j0 + rg; const float dec = __expf(fminf(gi - GC[j], 0.f));
                    m[rg] = (i > j) ? bi * c1[rg] * dec : 0.f; at[rg] = (i >= j) ? c2[rg] * dec : 0.f; }
                *(float4*)(MM + i * 64 + j0) = make_float4(m[0], m[1], m[2], m[3]);
                uint2 w; w.x = pk2(at[0], at[1]); w.y = pk2(at[2], at[3]);
                *(uint2*)(GA3 + (size_t)item * 64 * 64 + frag_off(i, j0, 2)) = w;
            }
        }
        __syncthreads();
        {
            const int cc = ht & 127; const bool isw = ht >= 128;
            const bf16* srcp = (isw ? KB : VB) + cc; const float* scl = isw ? BE : BT;
            float x[64];
#pragma unroll
            for (int i = 0; i < 64; ++i) x[i] = 0.f;
#pragma unroll
            for (int i = 0; i < 64; ++i) {
                float acc = scl[i] * bf2f(srcp[i * 136]), ac1 = 0.f, ac2 = 0.f, ac3 = 0.f;
#pragma unroll
                for (int j4 = 0; j4 < (i + 3) / 4; ++j4) { const float4 mv = *(const float4*)(MM + i * 64 + 4 * j4);
                    acc -= mv.x * x[4 * j4]; ac1 -= mv.y * x[4 * j4 + 1]; ac2 -= mv.z * x[4 * j4 + 2]; ac3 -= mv.w * x[4 * j4 + 3]; }
                x[i] = (acc + ac1) + (ac2 + ac3);
                asm volatile("" ::: "memory");
            }
            if (!isw) {
                float* up = GX0 + (size_t)item * 128 * 64;
#pragma unroll
                for (int q = 0; q < 16; ++q) *(float4*)(up + cfrag_off(cc, 4 * q, 4)) = make_float4(x[4 * q], x[4 * q + 1], x[4 * q + 2], x[4 * q + 3]);
            }
            __syncthreads();
            if (isw) {
                bf16* a1s = (bf16*)MM;
#pragma unroll
                for (int i = 0; i < 64; ++i) a1s[i * 128 + cc] = f2bf(-x[i]);
            }
        }
        __syncthreads();
        {
            const bf16* a1s = (const bf16*)MM; bf16* wp = GA1 + (size_t)item * 64 * 128;
#pragma unroll
            for (int q = 0; q < 4; ++q) { const int p = ht + 256 * q, fr = p & 15, fq = (p >> 4) & 3, kb = (p >> 6) & 3, rt = p >> 8;
                *(uint4*)(wp + p * 8) = *(const uint4*)(a1s + (rt * 16 + fr) * 128 + kb * 32 + fq * 8); }
        }
        {
            const int dk = ht & 127, hh = ht >> 7; const float g63 = GC[63];
            unsigned w[16];
#pragma unroll
            for (int q = 0; q < 16; ++q) { const int ta = hh * 32 + 2 * q;
                w[q] = pk2(bf2f(KB[ta * 136 + dk]) * __expf(g63 - GC[ta]), bf2f(KB[(ta + 1) * 136 + dk]) * __expf(g63 - GC[ta + 1])); }
            bf16* dp = GA4 + (size_t)item * 128 * 64;
            *(uint4*)(dp + frag_off(dk, hh * 32, 2)) = make_uint4(w[0], w[1], w[2], w[3]); *(uint4*)(dp + frag_off(dk, hh * 32 + 8, 2)) = make_uint4(w[4], w[5], w[6], w[7]);
            *(uint4*)(dp + frag_off(dk, hh * 32 + 16, 2)) = make_uint4(w[8], w[9], w[10], w[11]); *(uint4*)(dp + frag_off(dk, hh * 32 + 24, 2)) = make_uint4(w[12], w[13], w[14], w[15]);
            if (ht == 0) GGL[item] = __expf(g63);
        }
    }
}

constexpr int RCL_HALF_BYTES = 75776;
__device__ __forceinline__ void ph_rcl(const Ctx& c) {
    const bf16* RKV = c.ws<bf16>(WS_RKV); const float* LW = c.ws<float>(WS_LW); const float* AAg = c.ws<float>(WS_AA);
    const float* mu = c.P.in[I_MU]; const float* k_k = c.P.in[I_KK]; const float* k_a = c.P.in[I_KA]; const float* r_k = c.P.in[I_RK];
    bf16* VP = c.ws<bf16>(WS_VP); float* SC = c.ws<float>(WS_SC);
    bf16* RA1 = c.ws<bf16>(WS_RA1); float* RX0 = c.ws<float>(WS_RX0); bf16* RA2 = c.ws<bf16>(WS_RA2); bf16* RA3 = c.ws<bf16>(WS_RA3); float* RO0 = c.ws<float>(WS_RO0);
    bf16* RA4 = c.ws<bf16>(WS_RA4); float* RS0 = c.ws<float>(WS_RS0); float* RDSC = c.ws<float>(WS_RDSC);
    for (int it0 = blockIdx.x * 2; it0 < 4096; it0 += gridDim.x * 2) {
        int tv = c.tid; asm volatile("" : "+v"(tv));
        const int half = tv >> 8, ht = tv & 255, lane = tv & 63, w4 = __builtin_amdgcn_readfirstlane((tv >> 6) & 3);
        unsigned char* base = c.lds + half * RCL_HALF_BYTES;
        bf16* AT = (bf16*)base;
        bf16* VT = AT + 64 * 72;
        bf16* KDT = VT + 64 * 72;
        float* AAB = (float*)(KDT + 64 * 72);
        float* TOT = AAB + 64 * 64;
        unsigned char* RX = (unsigned char*)(TOT + 256);
        bf16* RT = (bf16*)RX;
        bf16* BTL = RT + 64 * 72;
        bf16* KT = BTL + 64 * 72;
        bf16* AAK = (bf16*)RX;
        bf16* ARK = AAK + 64 * 72;
        float* RHS2 = (float*)RX;
        const int item = it0 + half, n = item & 63, bh = item >> 6, h = bh & 15, b = bh >> 4;
        const int t0 = b * SEQ + n * 64;
        __syncthreads();
        {
            const int ch = ht & 63, tq = ht >> 6;
            float run = 0.f;
#pragma unroll
            for (int i = 0; i < 16; ++i) { run += LW[(size_t)(t0 + tq * 16 + i) * 1024 + h * 64 + ch]; AAB[(tq * 16 + i) * 64 + ch] = run; }
            TOT[tq * 64 + ch] = run;
        }
        __syncthreads();
        {
            const int r = ht >> 2, seg = ht & 3, c0 = seg * 16, t = t0 + r; const bool first = (n == 0 && r == 0);
            const bf16* cur = RKV + (size_t)t * 3072 + h * 64 + c0; const bf16* prv = cur - 3072;
            float rr[16], kf[16], vv[16], kkv[16], aa[16], lwl[16];
            float ss = 0.f, scs = 0.f;
            float4 cr[4], ck[4], cv[4], pr[4], pk[4], pv[4], a4v[4], l4v[4];
            {
                uint4 ur[2], uk[2], uv[2], qr[2], qk[2], qv[2];
#pragma unroll
                for (int g = 0; g < 2; ++g) {
                    ur[g] = *(const uint4*)(cur + 8 * g); uk[g] = *(const uint4*)(cur + 1024 + 8 * g); uv[g] = *(const uint4*)(cur + 2048 + 8 * g);
                    qr[g] = make_uint4(0, 0, 0, 0); qk[g] = qr[g]; qv[g] = qr[g];
                    if (!first) { qr[g] = *(const uint4*)(prv + 8 * g); qk[g] = *(const uint4*)(prv + 1024 + 8 * g); qv[g] = *(const uint4*)(prv + 2048 + 8 * g); }
                }
#pragma unroll
                for (int q = 0; q < 4; ++q) {
                    a4v[q] = *(const float4*)(AAg + (size_t)t * 1024 + h * 64 + c0 + 4 * q);
                    l4v[q] = *(const float4*)(LW + (size_t)t * 1024 + h * 64 + c0 + 4 * q);
                }
#pragma unroll
                for (int g = 0; g < 2; ++g) {
                    cr[2 * g] = make_float4(bflo(ur[g].x), bfhi(ur[g].x), bflo(ur[g].y), bfhi(ur[g].y)); cr[2 * g + 1] = make_float4(bflo(ur[g].z), bfhi(ur[g].z), bflo(ur[g].w), bfhi(ur[g].w));
                    ck[2 * g] = make_float4(bflo(uk[g].x), bfhi(uk[g].x), bflo(uk[g].y), bfhi(uk[g].y)); ck[2 * g + 1] = make_float4(bflo(uk[g].z), bfhi(uk[g].z), bflo(uk[g].w), bfhi(uk[g].w));
                    cv[2 * g] = make_float4(bflo(uv[g].x), bfhi(uv[g].x), bflo(uv[g].y), bfhi(uv[g].y)); cv[2 * g + 1] = make_float4(bflo(uv[g].z), bfhi(uv[g].z), bflo(uv[g].w), bfhi(uv[g].w));
                    pr[2 * g] = make_float4(bflo(qr[g].x), bfhi(qr[g].x), bflo(qr[g].y), bfhi(qr[g].y)); pr[2 * g + 1] = make_float4(bflo(qr[g].z), bfhi(qr[g].z), bflo(qr[g].w), bfhi(qr[g].w));
                    pk[2 * g] = make_float4(bflo(qk[g].x), bfhi(qk[g].x), bflo(qk[g].y), bfhi(qk[g].y)); pk[2 * g + 1] = make_float4(bflo(qk[g].z), bfhi(qk[g].z), bflo(qk[g].w), bfhi(qk[g].w));
                    pv[2 * g] = make_float4(bflo(qv[g].x), bfhi(qv[g].x), bflo(qv[g].y), bfhi(qv[g].y)); pv[2 * g + 1] = make_float4(bflo(qv[g].z), bfhi(qv[g].z), bflo(qv[g].w), bfhi(qv[g].w));
                }
            }
#pragma unroll
            for (int q = 0; q < 4; ++q) {
                const float4 r0 = cr[q], k0 = ck[q], v0 = cv[q], rp = pr[q], kp = pk[q], vp = pv[q], a4 = a4v[q], l4 = l4v[q];
                const float4 mr = *(const float4*)(mu + h * 64 + c0 + 4 * q), mk = *(const float4*)(mu + 1024 + h * 64 + c0 + 4 * q), mv = *(const float4*)(mu + 2048 + h * 64 + c0 + 4 * q);
                const float4 kkw = *(const float4*)(k_k + h * 64 + c0 + 4 * q), kaw = *(const float4*)(k_a + h * 64 + c0 + 4 * q), rkw = *(const float4*)(r_k + h * 64 + c0 + 4 * q);
                const float r0a[4] = {r0.x, r0.y, r0.z, r0.w}, k0a[4] = {k0.x, k0.y, k0.z, k0.w}, v0a[4] = {v0.x, v0.y, v0.z, v0.w};
                const float rpa[4] = {rp.x, rp.y, rp.z, rp.w}, kpa[4] = {kp.x, kp.y, kp.z, kp.w}, vpa[4] = {vp.x, vp.y, vp.z, vp.w};
                const float mra[4] = {mr.x, mr.y, mr.z, mr.w}, mka[4] = {mk.x, mk.y, mk.z, mk.w}, mva[4] = {mv.x, mv.y, mv.z, mv.w};
                const float kka[4] = {kkw.x, kkw.y, kkw.z, kkw.w}, kaa[4] = {kaw.x, kaw.y, kaw.z, kaw.w}, rka[4] = {rkw.x, rkw.y, rkw.z, rkw.w}, aaa[4] = {a4.x, a4.y, a4.z, a4.w}, lwa[4] = {l4.x, l4.y, l4.z, l4.w};
#pragma unroll
                for (int e = 0; e < 4; ++e) { const int i = 4 * q + e;
                    rr[i] = r0a[e] + (rpa[e] - r0a[e]) * mra[e]; const float kx = k0a[e] + (kpa[e] - k0a[e]) * mka[e]; vv[i] = v0a[e] + (vpa[e] - v0a[e]) * mva[e];
                    kkv[i] = kx * kka[e]; ss += kkv[i] * kkv[i]; aa[i] = aaa[e]; lwl[i] = lwa[e]; kf[i] = kx * (1.f + (aaa[e] - 1.f) * kaa[e]); scs += rr[i] * kf[i] * rka[e]; }
                asm volatile("" ::: "memory");
            }
            ss += __shfl_xor(ss, 1); ss += __shfl_xor(ss, 2); scs += __shfl_xor(scs, 1); scs += __shfl_xor(scs, 2);
            const float rn = rsqrtf(ss + 1e-6f);
            if (seg == 0) SC[(size_t)t * 16 + h] = scs;
            const int tq = r >> 4;
            unsigned wat[8], wbt[8], wkt[8], wrt[8], wvp[8];
            float atv[16], btv[16], ktv[16], rtv[16];
#pragma unroll
            for (int i = 0; i < 16; ++i) {
                const int ch = c0 + i;
                float off = 0.f;
#pragma unroll
                for (int q = 0; q < 3; ++q) off += (q < tq) ? TOT[q * 64 + ch] : 0.f;
                const float tot = TOT[ch] + TOT[64 + ch] + TOT[128 + ch] + TOT[192 + ch];
                const float cs = AAB[r * 64 + ch] + off;
                const float lwv = lwl[i];
                const float kk = kkv[i] * rn;
                const float e2 = __expf(-cs), e4 = __expf(tot - cs);
                atv[i] = kk * __expf(cs - lwv); btv[i] = -kk * aa[i] * e2; ktv[i] = kf[i] * e2; rtv[i] = rr[i] * __expf(cs);
                VT[ch * 72 + r] = f2bf(vv[i]);
                KDT[ch * 72 + r] = f2bf(kf[i] * e4);
                RA4[(size_t)item * 64 * 64 + frag_off(ch, r, 2)] = f2bf(-kk * aa[i] * e4);
                if (r == 63) RDSC[(size_t)item * 64 + ch] = __expf(tot);
            }
#pragma unroll
            for (int q = 0; q < 8; ++q) { wat[q] = pk2(atv[2 * q], atv[2 * q + 1]); wbt[q] = pk2(btv[2 * q], btv[2 * q + 1]); wkt[q] = pk2(ktv[2 * q], ktv[2 * q + 1]); wrt[q] = pk2(rtv[2 * q], rtv[2 * q + 1]); wvp[q] = pk2(vv[2 * q], vv[2 * q + 1]); }
            *(uint4*)(AT + r * 72 + c0) = make_uint4(wat[0], wat[1], wat[2], wat[3]); *(uint4*)(AT + r * 72 + c0 + 8) = make_uint4(wat[4], wat[5], wat[6], wat[7]);
            *(uint4*)(BTL + r * 72 + c0) = make_uint4(wbt[0], wbt[1], wbt[2], wbt[3]); *(uint4*)(BTL + r * 72 + c0 + 8) = make_uint4(wbt[4], wbt[5], wbt[6], wbt[7]);
            *(uint4*)(KT + r * 72 + c0) = make_uint4(wkt[0], wkt[1], wkt[2], wkt[3]); *(uint4*)(KT + r * 72 + c0 + 8) = make_uint4(wkt[4], wkt[5], wkt[6], wkt[7]);
            *(uint4*)(RT + r * 72 + c0) = make_uint4(wrt[0], wrt[1], wrt[2], wrt[3]); *(uint4*)(RT + r * 72 + c0 + 8) = make_uint4(wrt[4], wrt[5], wrt[6], wrt[7]);
            bf16* a2p = RA2 + (size_t)item * 64 * 64;
            *(uint4*)(a2p + frag_off(r, c0, 2)) = make_uint4(wrt[0], wrt[1], wrt[2], wrt[3]); *(uint4*)(a2p + frag_off(r, c0 + 8, 2)) = make_uint4(wrt[4], wrt[5], wrt[6], wrt[7]);
            bf16* vpp = VP + (size_t)t * 1024 + h * 64 + c0;
            *(uint4*)vpp = make_uint4(wvp[0], wvp[1], wvp[2], wvp[3]); *(uint4*)(vpp + 8) = make_uint4(wvp[4], wvp[5], wvp[6], wvp[7]);
        }
        __syncthreads();
        const int fr = lane & 15, fq = lane >> 4;
        f32x4_t cab[4], cak[4], crb[4], crk[4];
        {
            const int j0t = w4 * 16;
            bf16x8_t bj[2], kj[2];
#pragma unroll
            for (int kb = 0; kb < 2; ++kb) { bj[kb] = *(const bf16x8_t*)(BTL + (j0t + fr) * 72 + kb * 32 + fq * 8); kj[kb] = *(const bf16x8_t*)(KT + (j0t + fr) * 72 + kb * 32 + fq * 8); }
#pragma unroll
            for (int it = 0; it < 4; ++it) {
                cab[it] = (f32x4_t){0.f, 0.f, 0.f, 0.f}; cak[it] = cab[it]; crb[it] = cab[it]; crk[it] = cab[it];
#pragma unroll
                for (int kb = 0; kb < 2; ++kb) {
                    const bf16x8_t ai = *(const bf16x8_t*)(AT + (it * 16 + fr) * 72 + kb * 32 + fq * 8);
                    const bf16x8_t ri = *(const bf16x8_t*)(RT + (it * 16 + fr) * 72 + kb * 32 + fq * 8);
                    cab[it] = MFMA16(bj[kb], ai, cab[it]); cak[it] = MFMA16(kj[kb], ai, cak[it]); crb[it] = MFMA16(bj[kb], ri, crb[it]); crk[it] = MFMA16(kj[kb], ri, crk[it]);
                }
            }
        }
        __syncthreads();
        {
            const int j0 = w4 * 16 + 4 * fq;
#pragma unroll
            for (int it = 0; it < 4; ++it) {
                const int i = it * 16 + fr;
                float vab[4], vak[4], vrb[4], vrk[4];
#pragma unroll
                for (int rg = 0; rg < 4; ++rg) { const int j = j0 + rg; const bool st = i > j, in = i >= j;
                    vab[rg] = st ? cab[it][rg] : 0.f; vak[rg] = st ? cak[it][rg] : 0.f; vrb[rg] = in ? crb[it][rg] : 0.f; vrk[rg] = in ? crk[it][rg] : 0.f; }
                *(float4*)(AAB + i * 64 + j0) = make_float4(vab[0], vab[1], vab[2], vab[3]);
                uint2 w; w.x = pk2(vak[0], vak[1]); w.y = pk2(vak[2], vak[3]); *(uint2*)(AAK + i * 72 + j0) = w;
                w.x = pk2(vrk[0], vrk[1]); w.y = pk2(vrk[2], vrk[3]); *(uint2*)(ARK + i * 72 + j0) = w;
                w.x = pk2(vrb[0], vrb[1]); w.y = pk2(vrb[2], vrb[3]); *(uint2*)(RA3 + (size_t)item * 64 * 64 + frag_off(i, j0, 2)) = w;
            }
        }
        __syncthreads();
        f32x4_t cav[4], cov[4], ckv[4];
        {
            const int r0t = w4 * 16;
            bf16x8_t fa[2], fo[2], fk[2];
#pragma unroll
            for (int kb = 0; kb < 2; ++kb) { fa[kb] = *(const bf16x8_t*)(AAK + (r0t + fr) * 72 + kb * 32 + fq * 8); fo[kb] = *(const bf16x8_t*)(ARK + (r0t + fr) * 72 + kb * 32 + fq * 8); fk[kb] = *(const bf16x8_t*)(KDT + (r0t + fr) * 72 + kb * 32 + fq * 8); }
#pragma unroll
            for (int vt = 0; vt < 4; ++vt) {
                cav[vt] = (f32x4_t){0.f, 0.f, 0.f, 0.f}; cov[vt] = cav[vt]; ckv[vt] = cav[vt];
#pragma unroll
                for (int kb = 0; kb < 2; ++kb) { const bf16x8_t vb = *(const bf16x8_t*)(VT + (vt * 16 + fr) * 72 + kb * 32 + fq * 8);
                    cav[vt] = MFMA16(fa[kb], vb, cav[vt]); cov[vt] = MFMA16(fo[kb], vb, cov[vt]); ckv[vt] = MFMA16(fk[kb], vb, ckv[vt]); }
            }
        }
        __syncthreads();
        {
            const int r0 = w4 * 16 + 4 * fq;
#pragma unroll
            for (int vt = 0; vt < 4; ++vt) {
                const int v = vt * 16 + fr;
#pragma unroll
                for (int rg = 0; rg < 4; ++rg) RHS2[v * 65 + r0 + rg] = cav[vt][rg];
                *(float4*)(RO0 + (size_t)item * 64 * 64 + cfrag_off(v, r0, 4)) = make_float4(cov[vt][0], cov[vt][1], cov[vt][2], cov[vt][3]);
                *(float4*)(RS0 + (size_t)item * 64 * 64 + cfrag_off(v, r0, 4)) = make_float4(ckv[vt][0], ckv[vt][1], ckv[vt][2], ckv[vt][3]);
            }
        }
        __syncthreads();
        if (ht < 128) {
            const int cc = ht & 63; const bool isu = ht >= 64;
            float x[64];
#pragma unroll
            for (int i = 0; i < 64; ++i) x[i] = 0.f;
#pragma unroll
            for (int i = 0; i < 64; ++i) {
                const float rv = RHS2[(isu ? cc : 0) * 65 + i], av = bf2f(AT[i * 72 + (isu ? 0 : cc)]);
                float acc = isu ? rv : av, ac1 = 0.f, ac2 = 0.f, ac3 = 0.f;
#pragma unroll
                for (int j4 = 0; j4 < (i + 3) / 4; ++j4) { const float4 mv = *(const float4*)(AAB + i * 64 + 4 * j4);
                    acc += mv.x * x[4 * j4]; ac1 += mv.y * x[4 * j4 + 1]; ac2 += mv.z * x[4 * j4 + 2]; ac3 += mv.w * x[4 * j4 + 3]; }
                x[i] = (acc + ac1) + (ac2 + ac3);
                asm volatile("" ::: "memory");
            }
            if (isu) {
                float* up = RX0 + (size_t)item * 64 * 64;
#pragma unroll
                for (int q = 0; q < 16; ++q) *(float4*)(up + cfrag_off(cc, 4 * q, 4)) = make_float4(x[4 * q], x[4 * q + 1], x[4 * q + 2], x[4 * q + 3]);
            }
            asm volatile("s_waitcnt lgkmcnt(0)" ::: "memory");
            if (!isu) {
#pragma unroll
                for (int i = 0; i < 64; ++i) AT[i * 72 + cc] = f2bf(x[i]);
            }
        }
        __syncthreads();
        {
            bf16* wp = RA1 + (size_t)item * 64 * 64;
#pragma unroll
            for (int q = 0; q < 2; ++q) { const int p = ht + 256 * q, fr = p & 15, fq = (p >> 4) & 3, kb = (p >> 6) & 1, rt = p >> 7;
                *(uint4*)(wp + p * 8) = *(const uint4*)(AT + (rt * 16 + fr) * 72 + kb * 32 + fq * 8); }
        }
    }
}

template <int DK, bool RW>
struct ScanArgs { const bf16* A1; const float* X0; const bf16* A2; const bf16* A3; const float* O0; const bf16* A4; const float* S0; const float* DSC; float* OUT; int item0; int vs; int tok0; int ocol0; };
#define LBAR() do { asm volatile("s_waitcnt lgkmcnt(0)" ::: "memory"); __builtin_amdgcn_s_barrier(); asm volatile("" ::: "memory"); } while (0)
template <int DK, bool RW>
__device__ __forceinline__ void scan_run(const Ctx& c, const ScanArgs<DK, RW>& a) {
    constexpr int KB = DK / 32;
    constexpr int NST = DK / 64;
    constexpr int NV = RW ? 64 : 128;
    constexpr int SROW = DK + 8;
    bf16* ST = (bf16*)c.lds;
    bf16* XT = ST + 2 * 32 * SROW;
    const int lane = c.lane, w = c.wave, fr = lane & 15, fq = lane >> 4;
    const int tm = w >> 1, tn = w & 1;
    const int dkt = (NST == 2) ? w : (w >> 1);
    for (int i = c.tid; i < 32 * SROW / 2; i += NTHREADS) ((unsigned*)ST)[i] = 0u;
    f32x4_t accS[NST];
#pragma unroll
    for (int s = 0; s < NST; ++s) accS[s] = (f32x4_t){0.f, 0.f, 0.f, 0.f};
    bf16x8_t a1f[KB], a2f[KB], a3f[2], a4f[2]; f32x4_t x0v, o0v, s0v[NST], dscv;
#define SCAN_LOAD(IT) do { const size_t it_ = (size_t)(IT); \
        _Pragma("unroll") for (int kb = 0; kb < KB; ++kb) { a1f[kb] = *(const bf16x8_t*)(a.A1 + it_ * 64 * DK + ((tm * KB + kb) * 64 + lane) * 8); a2f[kb] = *(const bf16x8_t*)(a.A2 + it_ * 64 * DK + ((tm * KB + kb) * 64 + lane) * 8); } \
        _Pragma("unroll") for (int kb = 0; kb < 2; ++kb) { a3f[kb] = *(const bf16x8_t*)(a.A3 + it_ * 64 * 64 + ((tm * 2 + kb) * 64 + lane) * 8); a4f[kb] = *(const bf16x8_t*)(a.A4 + it_ * DK * 64 + ((dkt * 2 + kb) * 64 + lane) * 8); } \
        x0v = *(const f32x4_t*)(a.X0 + it_ * NV * 64 + (((a.vs * 2 + tn) * 4 + tm) * 64 + lane) * 4); \
        if (RW) { o0v = *(const f32x4_t*)(a.O0 + it_ * NV * 64 + (((a.vs * 2 + tn) * 4 + tm) * 64 + lane) * 4); \
                  _Pragma("unroll") for (int s = 0; s < NST; ++s) s0v[s] = *(const f32x4_t*)(a.S0 + it_ * 64 * DK + (((a.vs * 2 + (NST == 2 ? s : tn)) * (DK / 16) + dkt) * 64 + lane) * 4); \
                  dscv = *(const f32x4_t*)(a.DSC + it_ * DK + dkt * 16 + 4 * fq); } \
        else { const float g_ = a.DSC[it_]; dscv = (f32x4_t){g_, g_, g_, g_}; o0v = (f32x4_t){0.f, 0.f, 0.f, 0.f}; _Pragma("unroll") for (int s = 0; s < NST; ++s) s0v[s] = (f32x4_t){0.f, 0.f, 0.f, 0.f}; } \
    } while (0)
    SCAN_LOAD(a.item0);
    int cur = 0;
    for (int n = 0; n < 64; ++n) {
        bf16x8_t b1[KB], b2[KB], b3[2], b4[2];
#pragma unroll
        for (int kb = 0; kb < KB; ++kb) { b1[kb] = a1f[kb]; b2[kb] = a2f[kb]; }
        b3[0] = a3f[0]; b3[1] = a3f[1]; b4[0] = a4f[0]; b4[1] = a4f[1];
        f32x4_t accX = x0v, accO = o0v; const f32x4_t dv = dscv; f32x4_t sv[NST];
#pragma unroll
        for (int s = 0; s < NST; ++s) sv[s] = s0v[s];
        if (n + 1 < 64) SCAN_LOAD(a.item0 + n + 1);
        LBAR();
        const bf16* Sc = ST + cur * 32 * SROW; bf16* Sn = ST + (cur ^ 1) * 32 * SROW;
        bf16x8_t sf[KB];
#pragma unroll
        for (int kb = 0; kb < KB; ++kb) sf[kb] = *(const bf16x8_t*)(Sc + (tn * 16 + fr) * SROW + kb * 32 + fq * 8);
#pragma unroll
        for (int kb = 0; kb < KB; ++kb) accX = MFMA16(b1[kb], sf[kb], accX);
        { uint2 wv; wv.x = pk2(accX[0], accX[1]); wv.y = pk2(accX[2], accX[3]); *(uint2*)(XT + (tn * 16 + fr) * 72 + tm * 16 + 4 * fq) = wv; }
#pragma unroll
        for (int kb = 0; kb < KB; ++kb) accO = MFMA16(b2[kb], sf[kb], accO);
        LBAR();
        bf16x8_t xf[2];
#pragma unroll
        for (int kb = 0; kb < 2; ++kb) xf[kb] = *(const bf16x8_t*)(XT + (tn * 16 + fr) * 72 + kb * 32 + fq * 8);
        accO = MFMA16(b3[0], xf[0], accO); accO = MFMA16(b3[1], xf[1], accO);
        {
            float* op = a.OUT + (size_t)(a.tok0 + n * 64 + tm * 16 + 4 * fq) * 1024 + a.ocol0 + tn * 16 + fr;
            op[0] = accO[0]; op[1024] = accO[1]; op[2048] = accO[2]; op[3072] = accO[3];
        }
#pragma unroll
        for (int s = 0; s < NST; ++s) {
            const int vt = (NST == 2) ? s : tn;
            bf16x8_t xg[2];
            if (vt == tn) { xg[0] = xf[0]; xg[1] = xf[1]; }
            else {
#pragma unroll
                for (int kb = 0; kb < 2; ++kb) xg[kb] = *(const bf16x8_t*)(XT + (vt * 16 + fr) * 72 + kb * 32 + fq * 8);
            }
            f32x4_t t = accS[s] * dv + sv[s];
            t = MFMA16(b4[0], xg[0], t); t = MFMA16(b4[1], xg[1], t);
            accS[s] = t;
            uint2 wv; wv.x = pk2(t[0], t[1]); wv.y = pk2(t[2], t[3]);
            *(uint2*)(Sn + (vt * 16 + fr) * SROW + dkt * 16 + 4 * fq) = wv;
        }
        cur ^= 1;
    }
#undef SCAN_LOAD
    __syncthreads();
}

__device__ __forceinline__ void ph_scan(const Ctx& c) {
    for (int wk = blockIdx.x; wk < 256; wk += gridDim.x) {
        const int xcd = wk & 7, j = wk >> 3;
        if (j < 16) {
            const int pair = xcd * 4 + (j >> 2), vs = j & 3, b = pair >> 3, h = pair & 7;
            ScanArgs<128, false> a{c.ws<bf16>(WS_GA1), c.ws<float>(WS_GX0), c.ws<bf16>(WS_GA2), c.ws<bf16>(WS_GA3), nullptr, c.ws<bf16>(WS_GA4), nullptr, c.ws<float>(WS_GGL),
                                   c.ws<float>(WS_OG), pair * 64, vs, b * SEQ, h * 128 + vs * 32};
            scan_run<128, false>(c, a);
        } else {
            const int pair = xcd * 8 + ((j - 16) >> 1), vs = (j - 16) & 1, b = pair >> 4, h = pair & 15;
            ScanArgs<64, true> a{c.ws<bf16>(WS_RA1), c.ws<float>(WS_RX0), c.ws<bf16>(WS_RA2), c.ws<bf16>(WS_RA3), c.ws<float>(WS_RO0), c.ws<bf16>(WS_RA4), c.ws<float>(WS_RS0), c.ws<float>(WS_RDSC),
                                 c.ws<float>(WS_ORW), pair * 64, vs, b * SEQ, h * 64 + vs * 32};
            scan_run<64, true>(c, a);
        }
    }
}

enum { PH_RMS0 = 0, PH_INPROJ, PH_GCL, PH_LORA, PH_RCL, PH_SCAN, PH_POST, PH_G2, PH_X1, PH_ROUTER, PH_DISPATCH, PH_MOE1, PH_MOE2, PH_COMBINE, PH_COUNT };

template <unsigned PHMASK>
__global__ void __launch_bounds__(NTHREADS) mk(Params P) {
    extern __shared__ __attribute__((aligned(16))) unsigned char lds[];
    volatile LAS unsigned* misc = (volatile LAS unsigned*)((LAS unsigned char*)lds + MISC_OFF);
    if (threadIdx.x < 64) misc[threadIdx.x] = 0u;
    __syncthreads();
    unsigned* ctl = (unsigned*)(P.ws + WS_CTL);
    XcdBarrier bar = xcd_barrier_post(ctl + CW_BAR + P.li * XCD_BAR_WORDS, misc);
#define MKCTX() int tv_ = threadIdx.x; asm volatile("" : "+v"(tv_)); const int wv_ = __builtin_amdgcn_readfirstlane(tv_ >> 6); \
    Ctx c{P, tv_, tv_ & 63, wv_, (int)(blockIdx.x * NWAVES + wv_), (int)(gridDim.x * NWAVES), (size_t)blockIdx.x * NTHREADS + tv_, (size_t)gridDim.x * NTHREADS, lds}
    bool first_seam = true;
#define IN(k) (((PHMASK >> (k)) & 1u) && P.ph_lo <= (k) && (k) < P.ph_hi)
#define SEAM(k) do { if ((k) + 1 < P.ph_hi) { if (first_seam && P.coop) { cg::this_grid().sync(); } else xcd_barrier(bar); first_seam = false; } } while (0)
#define REP(k) for (int rep_ = 0; rep_ < ((k) == PROBE_REP ? 2 : 1); ++rep_)
    if (IN(PH_RMS0)) { MKCTX();
        REP(PH_RMS0) {
        ph_rms0(c);
        { WJob j{P.in[I_W_IN], NCOL_IN, 1024, 4096, c.ws<bf16>(WS_WIN_T), 1024, 1, 0, 0}; wconv_job(c, j); }
        { WJob j{P.in[I_W_IN] + 4112, NCOL_IN, 1024, 5376, c.ws<bf16>(WS_WIN_T) + (size_t)4096 * 1024, 1024, 1, 0, 0}; wconv_job(c, j); }
        lora_zero(c);
        { WJob j{P.in[I_W2], 1024, 64, 1024, c.ws<bf16>(WS_LORA_T), 256, 1, 0, 0}; wconv_job(c, j); }
        { WJob j{P.in[I_A2], 1024, 64, 1024, c.ws<bf16>(WS_LORA_T) + (size_t)1024 * 256 + 64, 256, 1, 0, 0}; wconv_job(c, j); }
        { WJob j{P.in[I_G2], 1024, 128, 1024, c.ws<bf16>(WS_LORA_T) + (size_t)2048 * 256 + 128, 256, 1, 0, 0}; wconv_job(c, j); }
        }
        SEAM(PH_RMS0);
    }
    if (IN(PH_INPROJ)) { MKCTX();
        REP(PH_INPROJ) {
        EpiInProj ep{c.ws<bf16>(WS_GQKV), c.ws<bf16>(WS_ZS), c.ws<bf16>(WS_RKV), c.ws<float>(WS_LIN), c.ws<bf16>(WS_GATES)};
        SchedInProj sc{(const char*)c.ws<bf16>(WS_HB), (const char*)c.ws<bf16>(WS_WIN_T), (int)gridDim.x, (int)blockIdx.x};
        pg8::gemm_phase((LAS unsigned char*)lds, 1024, sc, ep, c.tid);
        }
        SEAM(PH_INPROJ);
    }
    if (IN(PH_GCL)) { MKCTX(); REP(PH_GCL) { ph_gcl(c); ph_loraprep(c); } SEAM(PH_GCL); }
    if (IN(PH_LORA)) { MKCTX();
        REP(PH_LORA) {
        EpiLora ep{P.in[I_W0], P.in[I_A0], c.ws<float>(WS_LW), c.ws<float>(WS_AA), c.ws<bf16>(WS_GGR)};
        SchedLora sc{(const char*)c.ws<bf16>(WS_ALORA), (const char*)c.ws<bf16>(WS_LORA_T), (int)gridDim.x, (int)blockIdx.x};
        pg8::gemm_phase((LAS unsigned char*)lds, 256, sc, ep, c.tid);
        }
        SEAM(PH_LORA);
    }
    if (IN(PH_RCL)) { MKCTX(); REP(PH_RCL) { ph_rcl(c); } SEAM(PH_RCL); }
    if (IN(PH_SCAN)) { MKCTX(); REP(PH_SCAN) { ph_scan(c); } SEAM(PH_SCAN); }
    if (IN(PH_POST)) { MKCTX();
        REP(PH_POST) {
        ph_post(c);
        { WJob j{P.in[I_PROJ_A], 1024, 1024, 1024, c.ws<bf16>(WS_PROJ_T), 1024, 1, 0, 0}; wconv_job(c, j); }
        { WJob j{P.in[I_PROJ_B], 1024, 1024, 1024, c.ws<bf16>(WS_PROJ_T) + (size_t)1024 * 1024, 1024, 1, 0, 0}; wconv_job(c, j); }
        { WJob j{P.in[I_W_OUT], 1024, 1024, 1024, c.ws<bf16>(WS_WOUT_T), 2048, 2, 0, 1024}; wconv_job(c, j); }
        }
        SEAM(PH_POST);
    }
    if (IN(PH_G2)) { MKCTX();
        REP(PH_G2) {
        EpiG2 ep{c.ws<bf16>(WS_GATES), c.ws<bf16>(WS_G2)};
        SchedG2 sc{(const char*)c.ws<bf16>(WS_YA), (const char*)c.ws<bf16>(WS_YB), (const char*)c.ws<bf16>(WS_PROJ_T), (int)gridDim.x, (int)blockIdx.x};
        pg8::gemm_phase((LAS unsigned char*)lds, 1024, sc, ep, c.tid);
        }
        SEAM(PH_G2);
    }
    if (IN(PH_X1)) { MKCTX();
        REP(PH_X1) {
        EpiX1 ep{P.in[I_X], c.ws<float>(WS_X1)};
        SchedX1 sc{(const char*)c.ws<bf16>(WS_G2), (const char*)c.ws<bf16>(WS_WOUT_T), (int)gridDim.x, (int)blockIdx.x};
        pg8::gemm_phase((LAS unsigned char*)lds, 2048, sc, ep, c.tid);
        }
        SEAM(PH_X1);
    }
    if (IN(PH_ROUTER)) { MKCTX();
        ph_router(c);
        REP(PH_ROUTER) {
        { WJob j{P.in[I_W_GU], 2048, 1024, 2048, c.ws<bf16>(WS_WGU_T), 1024, 32, (size_t)1024 * 2048, (size_t)2048 * 1024}; wconv_job(c, j); }
        { WJob j{P.in[I_W_DOWN], 1024, 1024, 1024, c.ws<bf16>(WS_WDN_T), 1024, 32, (size_t)1024 * 1024, (size_t)1024 * 1024}; wconv_job(c, j); }
        }
        SEAM(PH_ROUTER);
    }
    if (IN(PH_DISPATCH)) { MKCTX(); REP(PH_DISPATCH) { ph_dispatch(c); } SEAM(PH_DISPATCH); }
    if (IN(PH_MOE1)) { MKCTX();
        REP(PH_MOE1) {
        const int nt = *c.ws<int>(WS_NT);
        EpiAct ep{P.in[I_B_GU], c.ws<bf16>(WS_ACT)};
        SchedMoe sc{(const char*)c.ws<bf16>(WS_XB), (const char*)c.ws<bf16>(WS_WGU_T), c.ws<int>(WS_TILE_E), nt, 8, (int)gridDim.x, (int)blockIdx.x};
        pg8::gemm_phase((LAS unsigned char*)lds, 1024, sc, ep, c.tid);
        }
        SEAM(PH_MOE1);
    }
    if (IN(PH_MOE2)) { MKCTX();
        REP(PH_MOE2) {
        const int nt = *c.ws<int>(WS_NT);
        EpiYS ep{P.in[I_B_DOWN], c.ws<float>(WS_SGATE), c.ws<bf16>(WS_YS)};
        SchedMoe sc{(const char*)c.ws<bf16>(WS_ACT), (const char*)c.ws<bf16>(WS_WDN_T), c.ws<int>(WS_TILE_E), nt, 4, (int)gridDim.x, (int)blockIdx.x};
        pg8::gemm_phase((LAS unsigned char*)lds, 1024, sc, ep, c.tid);
        }
        SEAM(PH_MOE2);
    }
    if (IN(PH_COMBINE)) { MKCTX(); REP(PH_COMBINE) { ph_combine(c); } }
#undef IN
#undef SEAM
#undef REP
#undef MKCTX
}

template <unsigned M> static void launch_one(const Params& p, int grid, hipStream_t stream) {
    static bool attr = false;
    if (!attr) { (void)hipFuncSetAttribute((const void*)mk<M>, hipFuncAttributeMaxDynamicSharedMemorySize, LDS_BYTES); attr = true; }
    hipLaunchKernelGGL(mk<M>, dim3(grid), dim3(NTHREADS), LDS_BYTES, stream, p);
}
template <int PH> static void launch_chain(Params& p, int grid, hipStream_t stream) {
    if constexpr (PH < PH_COUNT) { p.ph_lo = PH; p.ph_hi = PH + 1; p.li = 0; p.coop = 0; launch_one<(1u << PH)>(p, grid, stream); launch_chain<PH + 1>(p, grid, stream); }
}

extern "C" void kernel_launch(void* const* d_in, const int* in_sizes, int n_in, void* d_out, int out_size, void* d_ws, size_t ws_size, hipStream_t stream) {
    static int grid = 0;
    if (grid == 0) {
        int dev = 0, cus = 0, per_cu = 0;
        (void)hipGetDevice(&dev);
        (void)hipDeviceGetAttribute(&cus, hipDeviceAttributeMultiprocessorCount, dev);
#if MK_ONE_LAUNCH
        (void)hipFuncSetAttribute((const void*)mk<0xffffffffu>, hipFuncAttributeMaxDynamicSharedMemorySize, LDS_BYTES);
        (void)hipOccupancyMaxActiveBlocksPerMultiprocessor(&per_cu, (const void*)mk<0xffffffffu>, NTHREADS, LDS_BYTES);
#else
        per_cu = 1;
#endif
        if (n_in != 29 || ws_size < WS_END || per_cu < 1 || cus < 64) { fprintf(stderr, "kernel_launch: unexpected setup n_in %d ws %zu per_cu %d cus %d\n", n_in, ws_size, per_cu, cus); grid = -1; return; }
        grid = cus;
    }
    if (grid < 0) return;
    (void)hipMemsetAsync((char*)d_ws + WS_CTL, 0, CTL_BYTES, stream);
    Params p{};
    for (int i = 0; i < 29; ++i) p.in[i] = (const float*)d_in[i];
    p.out = (float*)d_out; p.ws = (unsigned char*)d_ws;
#if MK_ONE_LAUNCH
    p.ph_lo = 0; p.ph_hi = PH_COUNT; p.li = 0; p.coop = 1;
    void* args[] = {&p};
    hipError_t e = hipLaunchCooperativeKernel((const void*)mk<0xffffffffu>, dim3(grid), dim3(NTHREADS), args, LDS_BYTES, stream);
    if (e != hipSuccess) fprintf(stderr, "cooperative launch failed: %s (grid %d)\n", hipGetErrorString(e), grid);
#else
    launch_chain<0>(p, grid, stream);
#endif
}
```

```cpp
#include <hip/hip_runtime.h>
#include <hip/hip_cooperative_groups.h>
#include <cstdint>
#include <cstdio>
namespace cg = cooperative_groups;

#ifndef MK_ONE_LAUNCH
#define MK_ONE_LAUNCH 1
#endif

#define LAS __attribute__((address_space(3)))
#ifndef FAST_INPROJ
#define FAST_INPROJ 1
#endif
#ifndef FAST_MIX
#define FAST_MIX 1
#endif
#define PROBE_REP -1
constexpr int NTHREADS = 512;
constexpr int NWAVES = 8;
constexpr int LDS_BYTES = 155648;
constexpr int MISC_OFF = 153600;

constexpr int T = 16384, SEQ = 4096, D = 1024;
constexpr int NCOL_IN = 9488;
constexpr int NEXP = 32;
constexpr int MAXTILES = 288;
constexpr int MAXSLOTS = MAXTILES * 256;

enum { I_X = 0, I_NORM_MIX, I_W_IN, I_GDN_CONV, I_GDN_ALOG, I_GDN_DTB, I_GDN_NORM, I_MU, I_W0, I_W2, I_A0, I_A2, I_G2, I_KK, I_KA, I_RK,
       I_LNW, I_LNB, I_PROJ_A, I_PROJ_B, I_W_OUT, I_NORM_FFN, I_ROUTER_W, I_ROUTER_B, I_W_GU, I_B_GU, I_W_DOWN, I_B_DOWN, I_NORM_FINAL };

constexpr size_t MiB = 1u << 20;
constexpr size_t WS_CTL = 0, CTL_BYTES = 65536;
constexpr size_t WS_BETA = 1 * MiB;
constexpr size_t WS_GG = WS_BETA + 512 * 1024;
constexpr size_t WS_SC = 2 * MiB;
constexpr size_t WS_TE = 3 * MiB;
constexpr size_t WS_TG = WS_TE + 256 * 1024;
constexpr size_t WS_TP = WS_TG + 256 * 1024;
constexpr size_t WS_TSLOT = WS_TP + 256 * 1024;
constexpr size_t WS_SGATE = 4 * MiB;
constexpr size_t WS_SLOT_TOK = 4 * MiB + 512 * 1024;
constexpr size_t WS_TILE_E = 5 * MiB;
constexpr size_t WS_NT = WS_TILE_E + 4096;
constexpr size_t WS_HB = 8 * MiB;
constexpr size_t WS_H2 = WS_HB;
constexpr size_t WS_ZS = 40 * MiB;
constexpr size_t WS_GATES = 72 * MiB;
constexpr size_t WS_ALORA = 136 * MiB;
constexpr size_t WS_LW = 144 * MiB;
constexpr size_t WS_AA = 208 * MiB;
constexpr size_t WS_GGR = 272 * MiB;
constexpr size_t WS_VP = 304 * MiB;
constexpr size_t WS_Q = 336 * MiB;
constexpr size_t WS_QKVC = WS_Q;
constexpr size_t WS_RP = WS_Q, WS_KF = WS_Q + 64 * MiB, WS_KKN = WS_Q + 128 * MiB;
constexpr size_t WS_YA = WS_Q, WS_YB = WS_Q + 32 * MiB, WS_G2 = WS_Q + 64 * MiB, WS_X1 = WS_Q + 128 * MiB;
constexpr size_t WS_GQKV = 528 * MiB;
constexpr size_t WS_OG = 720 * MiB, WS_ORW = 784 * MiB;
constexpr size_t WS_RKV = 720 * MiB;
constexpr size_t WS_LIN = 912 * MiB;
constexpr size_t WS_DEC = 928 * MiB;
constexpr size_t WS_XB = 528 * MiB;
constexpr size_t WS_ACT = 672 * MiB;
constexpr size_t WS_YS = 816 * MiB;
constexpr size_t WS_WIN_T = 992 * MiB;
constexpr size_t WS_PROJ_T = 144 * MiB;
constexpr size_t WS_WOUT_T = 148 * MiB;
constexpr size_t WS_WGU_T = 72 * MiB;
constexpr size_t WS_WDN_T = 200 * MiB;
constexpr size_t WS_GA1 = 336 * MiB, WS_GX0 = 368 * MiB, WS_GA2 = 432 * MiB, WS_GA3 = 464 * MiB, WS_GA4 = 480 * MiB;
constexpr size_t WS_GGL = 6 * MiB;
constexpr size_t WS_RX0 = 528 * MiB, WS_RO0 = 592 * MiB, WS_RS0 = 656 * MiB;
constexpr size_t WS_RA1 = 8 * MiB, WS_RA2 = 928 * MiB, WS_RA3 = 960 * MiB, WS_RA4 = 992 * MiB;
constexpr size_t WS_RDSC = 7 * MiB;
constexpr size_t WS_LORA_T = 1012 * MiB;
constexpr size_t WS_END = 1024 * MiB;
constexpr int CW_BAR = 1024;
constexpr int CW_CNT = 256;

#define XB_TMO      128
#define XB_XCNT(j)  (256  + 64 * (j))
#define XB_XSUB(j)  (1280 + 64 * (j))
#define XB_XGEN(j)  (2304 + 64 * (j))
#define XB_TOP      3328
#define XB_TOPGEN   3392
#define XCD_BAR_WORDS 3456
#define XB_SPIN_CAP (1u << 24)
__device__ __forceinline__ unsigned xb_ld(unsigned* p)              { return __hip_atomic_load(p, __ATOMIC_RELAXED, __HIP_MEMORY_SCOPE_AGENT); }
__device__ __forceinline__ unsigned xb_add(unsigned* p, unsigned v) { return __hip_atomic_fetch_add(p, v, __ATOMIC_RELAXED, __HIP_MEMORY_SCOPE_AGENT); }
__device__ __forceinline__ unsigned xb_xcc_id() { return (unsigned)__builtin_amdgcn_s_getreg((3 << 11) | 20) & 0xFu; }
#define XB_SPIN(cond, bar) do { unsigned _sp = 0; while (cond) { __builtin_amdgcn_s_sleep(1); \
    if ((++_sp & 255u) == 0u) { if (xb_ld(&(bar)[XB_TMO])) break; if (_sp > XB_SPIN_CAP) { atomicAdd(&(bar)[XB_TMO], 1u); break; } } } } while (0)
struct XcdBarrier { unsigned* bar; unsigned x; volatile LAS unsigned* st; };
__device__ __forceinline__ XcdBarrier xcd_barrier_post(unsigned* bar, volatile LAS unsigned* st) {
    XcdBarrier b; b.bar = bar; b.x = xb_xcc_id(); b.st = st;
    if (threadIdx.x == 0) (void)xb_add(&bar[XB_XCNT(b.x)], 1u);
    return b;
}
__device__ __forceinline__ void xcd_barrier_complete(unsigned* bar, unsigned x, unsigned& nloc, unsigned& nx) {
    const unsigned G = gridDim.x * gridDim.y * gridDim.z;
    unsigned sum, cnt, mine, sp = 0u;
    for (;;) {
        sum = 0u; cnt = 0u; mine = 0u;
#pragma unroll
        for (unsigned j = 0; j < 16; ++j) { const unsigned c = xb_ld(&bar[XB_XCNT(j)]); sum += c; cnt += (c > 0u) ? 1u : 0u; mine = (j == x) ? c : mine; }
        if (sum == G) break;
        __builtin_amdgcn_s_sleep(1);
        if ((++sp & 255u) == 0u) { if (xb_ld(&bar[XB_TMO])) break; if (sp > XB_SPIN_CAP) { atomicAdd(&bar[XB_TMO], 1u); break; } }
    }
    nloc = mine > 0u ? mine : 1u; nx = cnt > 0u ? cnt : 1u;
}
__device__ __forceinline__ void xcd_barrier(const XcdBarrier& b) {
    asm volatile("s_waitcnt vmcnt(0)" ::: "memory");
    __syncthreads();
    if (threadIdx.x == 0) {
        unsigned* bar = b.bar;
        __builtin_amdgcn_s_waitcnt(0);
        unsigned nloc = b.st[0], nx = b.st[1];
        if (nloc == 0u) { xcd_barrier_complete(bar, b.x, nloc, nx); b.st[0] = nloc; b.st[1] = nx; }
        const unsigned old = xb_add(&bar[XB_XSUB(b.x)], 1u);
        const unsigned gen = old / nloc;
        if (old + 1u == (gen + 1u) * nloc) {
            __builtin_amdgcn_fence(__ATOMIC_RELEASE, "agent");
            asm volatile("s_waitcnt vmcnt(0)" ::: "memory");
            const unsigned og = xb_add(&bar[XB_TOP], 1u);
            const unsigned tg = og / nx;
            if (og + 1u == (tg + 1u) * nx) xb_add(&bar[XB_TOPGEN], 1u);
            else XB_SPIN(xb_ld(&bar[XB_TOPGEN]) == tg, bar);
            __builtin_amdgcn_fence(__ATOMIC_ACQUIRE, "agent");
            xb_add(&bar[XB_XGEN(b.x)], 1u);
            asm volatile("s_waitcnt vmcnt(0)" ::: "memory");
        } else {
            XB_SPIN(xb_ld(&bar[XB_XGEN(b.x)]) == gen, bar);
            __builtin_amdgcn_fence(__ATOMIC_ACQUIRE, "agent");
            asm volatile("s_waitcnt vmcnt(0)" ::: "memory");
        }
    }
    __syncthreads();
}

typedef unsigned short bf16;
__device__ __forceinline__ bf16 f2bf(float f) { unsigned u = __float_as_uint(f); u += 0x7fffu + ((u >> 16) & 1u); return (bf16)(u >> 16); }
__device__ __forceinline__ float bf2f(unsigned b) { return __uint_as_float(b << 16); }
__device__ __forceinline__ unsigned pk2(float lo, float hi) { return (unsigned)f2bf(lo) | ((unsigned)f2bf(hi) << 16); }
__device__ __forceinline__ float bflo(unsigned w) { return __uint_as_float(w << 16); }
__device__ __forceinline__ float bfhi(unsigned w) { return __uint_as_float(w & 0xffff0000u); }
__device__ __forceinline__ float sigm(float x) { return 1.f / (1.f + expf(-x)); }
__device__ __forceinline__ float fsigm(float x) { return __builtin_amdgcn_rcpf(1.f + __expf(-x)); }
__device__ __forceinline__ float softplusf(float x) { return x > 20.f ? x : log1pf(expf(x)); }
__device__ __forceinline__ float dpp_xor1(float v) { return __int_as_float(__builtin_amdgcn_update_dpp(0, __float_as_int(v), 0xB1, 0xF, 0xF, false)); }
__device__ __forceinline__ float wsum(float v) {
#pragma unroll
    for (int o = 32; o > 0; o >>= 1) v += __shfl_xor(v, o);
    return v;
}

struct Params { const float* in[29]; float* out; unsigned char* ws; int ph_lo, ph_hi, li, coop; };

struct Ctx {
    const Params& P; int tid, lane, wave, gwave, nwaves; size_t gtid, nthreads; unsigned char* lds;
    template <class Tp> __device__ __forceinline__ Tp* ws(size_t off) const { return (Tp*)(P.ws + off); }
};

__device__ __forceinline__ void ph_rms0(const Ctx& c) {
    const float* x = c.P.in[I_X]; const float* nw = c.P.in[I_NORM_MIX]; const float* win = c.P.in[I_W_IN];
    const float* alog = c.P.in[I_GDN_ALOG]; const float* dtb = c.P.in[I_GDN_DTB];
    bf16* HB = c.ws<bf16>(WS_HB); float* BETA = c.ws<float>(WS_BETA); float* GGv = c.ws<float>(WS_GG);
    if (blockIdx.x == 0 && c.tid < NEXP) c.ws<unsigned>(WS_CTL)[CW_CNT + c.tid] = 0u;
    float4* tab = (float4*)c.lds;
    __syncthreads();
    for (int i = c.tid; i < 4096; i += NTHREADS) { const int k = i >> 2; tab[((k & 3) * 256 + (k >> 2)) * 5 + (i & 3)] = *(const float4*)(win + (size_t)k * NCOL_IN + 4096 + (i & 3) * 4); }
    __syncthreads();
    const int lane = c.lane;
    for (int t = c.gwave; t < T; t += c.nwaves) {
        float4 v[4]; float ss = 0.f;
#pragma unroll
        for (int i = 0; i < 4; ++i) { v[i] = ((const float4*)(x + (size_t)t * D))[lane + 64 * i]; ss += v[i].x * v[i].x + v[i].y * v[i].y + v[i].z * v[i].z + v[i].w * v[i].w; }
        ss = wsum(ss);
        const float rstd = rsqrtf(ss * (1.f / 1024.f) + 1e-6f);
        float acc[16];
#pragma unroll
        for (int j = 0; j < 16; ++j) acc[j] = 0.f;
#pragma unroll
        for (int i = 0; i < 4; ++i) {
            const float4 w4 = ((const float4*)nw)[lane + 64 * i];
            float h[4] = {v[i].x * rstd * w4.x, v[i].y * rstd * w4.y, v[i].z * rstd * w4.z, v[i].w * rstd * w4.w};
            uint2 st; st.x = pk2(h[0], h[1]); st.y = pk2(h[2], h[3]);
            *(uint2*)(HB + (size_t)t * D + 4 * (lane + 64 * i)) = st;
#pragma unroll
            for (int ii = 0; ii < 4; ++ii) {
                const int k = 4 * (lane + 64 * i) + ii;
#pragma unroll
                for (int q = 0; q < 4; ++q) { const float4 w = tab[(ii * 256 + (k >> 2)) * 5 + q]; acc[4 * q + 0] += h[ii] * w.x; acc[4 * q + 1] += h[ii] * w.y; acc[4 * q + 2] += h[ii] * w.z; acc[4 * q + 3] += h[ii] * w.w; }
                if (ii & 1) asm volatile("" ::: "memory");
            }
        }
        float mine = 0.f;
#pragma unroll
        for (int j = 0; j < 16; ++j) { const float s = wsum(acc[j]); mine = (lane == j) ? s : mine; }
        if (lane < 8) BETA[t * 8 + lane] = sigm(mine);
        else if (lane < 16) { const int h = lane - 8; GGv[t * 8 + h] = -expf(alog[h]) * softplusf(mine + dtb[h]); }
    }
    __syncthreads();
}

struct NoLd {};
struct EpiInProj {
    typedef NoLd Ld; static constexpr int MB = 1;
    bf16* GQKV; bf16* ZS; bf16* RKV; float* LIN; bf16* GATES;
    __device__ __forceinline__ void load(Ld&, int, int, int) const {}
    __device__ __forceinline__ void store8(int row, int col, const float (&v)[8], int, const Ld&) const {
        if (col < 3072) { uint4 w; w.x = pk2(v[0], v[1]); w.y = pk2(v[2], v[3]); w.z = pk2(v[4], v[5]); w.w = pk2(v[6], v[7]); *(uint4*)(GQKV + (size_t)row * 3072 + col) = w; }
        else if (col < 4096) { uint4 w; w.x = pk2(v[0] * fsigm(v[0]), v[1] * fsigm(v[1])); w.y = pk2(v[2] * fsigm(v[2]), v[3] * fsigm(v[3])); w.z = pk2(v[4] * fsigm(v[4]), v[5] * fsigm(v[5])); w.w = pk2(v[6] * fsigm(v[6]), v[7] * fsigm(v[7]));
            *(uint4*)(ZS + (size_t)row * 1024 + (col - 3072)) = w; }
        else if (col < 7168) { uint4 w; w.x = pk2(v[0], v[1]); w.y = pk2(v[2], v[3]); w.z = pk2(v[4], v[5]); w.w = pk2(v[6], v[7]); *(uint4*)(RKV + (size_t)row * 3072 + (col - 4096)) = w; }
        else if (col < 7424) { float* p = LIN + (size_t)row * 256 + (col - 7168); *(float4*)p = make_float4(v[0], v[1], v[2], v[3]); *(float4*)(p + 4) = make_float4(v[4], v[5], v[6], v[7]); }
        else { uint4 w; w.x = pk2(fsigm(v[0]), fsigm(v[1])); w.y = pk2(fsigm(v[2]), fsigm(v[3])); w.z = pk2(fsigm(v[4]), fsigm(v[5])); w.w = pk2(fsigm(v[6]), fsigm(v[7]));
            *(uint4*)(GATES + (size_t)row * 2048 + (col - 7424)) = w; }
    }
};
struct EpiG2 {
    struct Ld { uint4 g; uint4 p; }; static constexpr int MB = 1;
    const bf16* GATES; bf16* MG;
    __device__ __forceinline__ void load(Ld& l, int row, int col, int) const { l.g = *(const uint4*)(GATES + (size_t)row * 2048 + col); const uint4 q = *(const uint4*)(MG + (size_t)row * 1024 + (col & 1023)); const bool b = col >= 1024; l.p = make_uint4(b ? q.x : 0u, b ? q.y : 0u, b ? q.z : 0u, b ? q.w : 0u); }
    __device__ __forceinline__ void store8(int row, int col, const float (&v)[8], int, const Ld& l) const {
        const uint4 g = l.g, p = l.p;
        uint4 w; w.x = pk2(v[0] * bflo(g.x) + bflo(p.x), v[1] * bfhi(g.x) + bfhi(p.x)); w.y = pk2(v[2] * bflo(g.y) + bflo(p.y), v[3] * bfhi(g.y) + bfhi(p.y));
        w.z = pk2(v[4] * bflo(g.z) + bflo(p.z), v[5] * bfhi(g.z) + bfhi(p.z)); w.w = pk2(v[6] * bflo(g.w) + bflo(p.w), v[7] * bfhi(g.w) + bfhi(p.w));
        *(uint4*)(MG + (size_t)row * 1024 + (col & 1023)) = w;
    }
};
struct EpiX1 {
    struct Ld { float4 a, b; }; static constexpr int MB = 2;
    const float* X; float* X1;
    __device__ __forceinline__ void load(Ld& l, int row, int col, int) const { const float* xp = X + (size_t)row * 1024 + col; l.a = *(const float4*)xp; l.b = *(const float4*)(xp + 4); }
    __device__ __forceinline__ void store8(int row, int col, const float (&v)[8], int, const Ld& l) const {
        float* op = X1 + (size_t)row * 1024 + col;
        const float4 a = l.a, b = l.b;
        *(float4*)op = make_float4(a.x + v[0], a.y + v[1], a.z + v[2], a.w + v[3]); *(float4*)(op + 4) = make_float4(b.x + v[4], b.y + v[5], b.z + v[6], b.w + v[7]);
    }
};
struct EpiAct {
    struct Ld { float4 b0, b1; }; static constexpr int MB = 4;
    const float* BGU; bf16* ACT;
    __device__ __forceinline__ void load(Ld& l, int, int col, int e) const { const float* bp = BGU + (size_t)e * 2048 + col; l.b0 = *(const float4*)bp; l.b1 = *(const float4*)(bp + 4); }
    __device__ __forceinline__ void store8(int row, int col, const float (&v)[8], int e, const Ld& l) const {
        const float4 b0 = l.b0, b1 = l.b1;
        const float bb[8] = {b0.x, b0.y, b0.z, b0.w, b1.x, b1.y, b1.z, b1.w};
        float o[4];
#pragma unroll
        for (int p = 0; p < 4; ++p) { float glu = v[2 * p] + bb[2 * p], lin = v[2 * p + 1] + bb[2 * p + 1]; glu = fminf(glu, 7.f); lin = fminf(fmaxf(lin, -7.f), 7.f); o[p] = glu * fsigm(1.702f * glu) * (lin + 1.f); }
        uint2 w; w.x = pk2(o[0], o[1]); w.y = pk2(o[2], o[3]);
        *(uint2*)(ACT + (size_t)row * 1024 + (col >> 1)) = w;
    }
};
struct EpiYS {
    struct Ld { float4 b0, b1; float g; }; static constexpr int MB = 4;
    const float* BD; const float* SGATE; bf16* YS;
    __device__ __forceinline__ void load(Ld& l, int row, int col, int e) const { const float* bp = BD + (size_t)e * 1024 + col; l.g = SGATE[row]; l.b0 = *(const float4*)bp; l.b1 = *(const float4*)(bp + 4); }
    __device__ __forceinline__ void store8(int row, int col, const float (&v)[8], int e, const Ld& l) const {
        const float g = l.g; const float4 b0 = l.b0, b1 = l.b1;
        uint4 w; w.x = pk2((v[0] + b0.x) * g, (v[1] + b0.y) * g); w.y = pk2((v[2] + b0.z) * g, (v[3] + b0.w) * g); w.z = pk2((v[4] + b1.x) * g, (v[5] + b1.y) * g); w.w = pk2((v[6] + b1.z) * g, (v[7] + b1.w) * g);
        *(uint4*)(YS + (size_t)row * 1024 + col) = w;
    }
};


namespace pg8 {
typedef short bf16x8 __attribute__((ext_vector_type(8)));
typedef float f32x4 __attribute__((ext_vector_type(4)));
constexpr int BM = 256, BK = 64, HALF = 128, HTB = HALF * BK * 2, NXCD = 8, WGM = 8;
__host__ __device__ __forceinline__ int lds_byte(int r, int c) { const int st = (r >> 4) * 2 + (c >> 5), rr = r & 15, cc = c & 31, ob = rr * 64 + cc * 2; return st * 1024 + (ob ^ (((ob >> 9) & 1) << 5)); }
__host__ __device__ __forceinline__ void stage_rc(int b, int& R, int& C) { const int st = b / 1024, sb = b % 1024, swz = sb ^ (((sb >> 9) & 1) << 5); R = (st >> 1) * 16 + swz / 64; C = (st & 1) * 32 + (swz % 64) / 2; }
__host__ __device__ __forceinline__ int perm32(int rho) { const int n = rho >> 4, i = rho & 15; return 8 * (i >> 2) + 4 * n + (i & 3); }
struct Unit { const char* a; const char* b; const int* rowmap; int row0, col0, aux; };
__device__ __forceinline__ void tile_order(int L, int nM, int nN, int& pm, int& pn) {
    const int nwg = nM * nN; int wgid = L; { const int q = nwg / NXCD, r = nwg % NXCD, xcd = wgid % NXCD, off = wgid / NXCD; wgid = (xcd < r ? xcd * (q + 1) : r * (q + 1) + (xcd - r) * q) + off; }
    const int nig = WGM * nN, gid = wgid / nig, fm = gid * WGM, gsz = (nM - fm) < WGM ? (nM - fm) : WGM;
    pm = fm + ((wgid % nig) % gsz); pn = (wgid % nig) / gsz;
}
template <class Epi>
__device__ __forceinline__ void epi_apply(const Epi& E, const f32x4 (&acc)[2][2][4][2], const Unit& u, int wr, int wc, int fr, int fq) {
    constexpr int MB = Epi::MB;
#pragma unroll
    for (int ai = 0; ai < 2; ++ai)
#pragma unroll
        for (int mp = 0; mp < 4 / MB; ++mp) {
            typename Epi::Ld ld[MB][2];
#pragma unroll
            for (int mm = 0; mm < MB; ++mm)
#pragma unroll
                for (int bj = 0; bj < 2; ++bj) E.load(ld[mm][bj], u.row0 + ai * HALF + wr * 64 + (mp * MB + mm) * 16 + fr, u.col0 + bj * HALF + wc * 32 + 8 * fq, u.aux);
#pragma unroll
            for (int mm = 0; mm < MB; ++mm)
#pragma unroll
                for (int bj = 0; bj < 2; ++bj) {
                    const int m = mp * MB + mm;
                    const f32x4 x0 = acc[ai][bj][m][0], x1 = acc[ai][bj][m][1];
                    const float v[8] = {x0[0], x0[1], x0[2], x0[3], x1[0], x1[1], x1[2], x1[3]};
                    E.store8(u.row0 + ai * HALF + wr * 64 + m * 16 + fr, u.col0 + bj * HALF + wc * 32 + 8 * fq, v, u.aux, ld[mm][bj]);
                }
            asm volatile("" ::: "memory");
        }
}
template <bool GATHER, class Epi, class Sched>
__device__ __forceinline__ void gemm_phase_t(LAS unsigned char* lds, const int K_, const Sched& S, const Epi& E, const int tid) {
    int K = K_; asm volatile("" : "+s"(K));
    const int wid = __builtin_amdgcn_readfirstlane(tid >> 6), lane = tid & 63, wr = wid >> 2, wc = wid & 3, fr = lane & 15, fq = lane >> 4;
    const int nt = K / BK;
    unsigned voffA[2], voffB[2];
#pragma unroll
    for (int i = 0; i < 2; ++i) { int R, C; stage_rc(tid * 16 + i * 8192, R, C); const int Rb = (R & ~31) + perm32(R & 31);
        voffA[i] = (unsigned)(R * K + C) * 2u; voffB[i] = (unsigned)(Rb * K + C) * 2u; }
    const size_t kstep = (size_t)(BK * 2);
    const size_t hstep = (size_t)HALF * K * 2;
    const unsigned ldsw = (unsigned)wid * 1024u;
    const int aoff = lds_byte(wr * 64 + fr, fq * 8), boff = lds_byte(wc * 32 + fr, fq * 8);
#define PG8_SA(b, h) (((b) * 2 + (h)) * HTB)
#define PG8_SB(b, h) ((4 + (b) * 2 + (h)) * HTB)
#define PG8_STAGE(bufoff, gbase, voff) do { _Pragma("unroll") for (int _i = 0; _i < 2; ++_i) \
        __builtin_amdgcn_global_load_lds((const unsigned*)((const char*)(gbase) + (voff)[_i]), (LAS unsigned*)(lds + (bufoff) + ldsw + _i * 8192), 16, 0, 0); } while (0)
#define PG8_LDA(dst, b, h) do { _Pragma("unroll") for (int m = 0; m < 4; ++m) _Pragma("unroll") for (int k = 0; k < 2; ++k) dst[m][k] = *(const LAS bf16x8*)(lds + PG8_SA(b, h) + aoff + m * 2048 + k * 1024); } while (0)
#define PG8_LDB(dst, b, h) do { _Pragma("unroll") for (int n = 0; n < 2; ++n) _Pragma("unroll") for (int k = 0; k < 2; ++k) dst[n][k] = *(const LAS bf16x8*)(lds + PG8_SB(b, h) + boff + n * 2048 + k * 1024); } while (0)
#define PG8_MMA(ai, bj, At, Bt) do { __builtin_amdgcn_s_setprio(1); _Pragma("unroll") for (int m = 0; m < 4; ++m) _Pragma("unroll") for (int n = 0; n < 2; ++n) _Pragma("unroll") for (int k = 0; k < 2; ++k) \
        acc[ai][bj][m][n] = __builtin_amdgcn_mfma_f32_16x16x32_bf16(Bt[n][k], At[m][k], acc[ai][bj][m][n], 0, 0, 0); __builtin_amdgcn_s_setprio(0); } while (0)
#define PG8_WAIT_V(n) asm volatile("s_waitcnt vmcnt(" #n ")" ::: "memory")
#define PG8_WAIT_L(n) asm volatile("s_waitcnt lgkmcnt(" #n ")" ::: "memory")
#define PG8_BAR __builtin_amdgcn_s_barrier()
#define PG8_SCHED __builtin_amdgcn_sched_barrier(0)
    Unit cur, nxt; int ui = 0;
    if (!S.next(0, cur)) return;
    f32x4 acc[2][2][4][2];
#pragma unroll
    for (int a = 0; a < 2; ++a)
#pragma unroll
        for (int b = 0; b < 2; ++b)
#pragma unroll
            for (int m = 0; m < 4; ++m)
#pragma unroll
                for (int n = 0; n < 2; ++n) acc[a][b][m][n] = (f32x4){0.f, 0.f, 0.f, 0.f};
    bf16x8 At[4][2], B0[2][2], B1[2][2];
    const char* cA = cur.a; const char* cB = cur.b;
    unsigned oc_lo[2] = {0u, 0u}, oc_hi[2] = {0u, 0u}, on_lo[2] = {0u, 0u}, on_hi[2] = {0u, 0u};
#define PG8_ROWOFF(U, LO, HI) do { _Pragma("unroll") for (int _i = 0; _i < 2; ++_i) { int R_, C_; stage_rc(tid * 16 + _i * 8192, R_, C_); \
        LO[_i] = (unsigned)((U).rowmap[R_] * K + C_) * 2u; HI[_i] = (unsigned)((U).rowmap[R_ + 128] * K + C_) * 2u; } } while (0)
    if constexpr (GATHER) PG8_ROWOFF(cur, oc_lo, oc_hi);
    PG8_STAGE(PG8_SB(0, 0), cB, voffB);
    if constexpr (GATHER) PG8_STAGE(PG8_SA(0, 0), cA, oc_lo); else PG8_STAGE(PG8_SA(0, 0), cA, voffA);
    PG8_STAGE(PG8_SB(0, 1), cB + hstep, voffB);
    if constexpr (GATHER) PG8_STAGE(PG8_SA(0, 1), cA, oc_hi); else PG8_STAGE(PG8_SA(0, 1), cA + hstep, voffA);
    if (wr == 1) PG8_BAR;
    PG8_WAIT_V(4); PG8_BAR;
    PG8_STAGE(PG8_SB(1, 0), cB + kstep, voffB);
    if constexpr (GATHER) PG8_STAGE(PG8_SA(1, 0), cA + kstep, oc_lo); else PG8_STAGE(PG8_SA(1, 0), cA + kstep, voffA);
    PG8_STAGE(PG8_SB(1, 1), cB + hstep + kstep, voffB);
    PG8_WAIT_V(6); PG8_BAR;
    for (;;) {
        const bool has_next = S.next(ui + 1, nxt);
        const char* nA = has_next ? nxt.a : cA; const char* nB = has_next ? nxt.b : cB;
        if constexpr (GATHER) { if (has_next) PG8_ROWOFF(nxt, on_lo, on_hi); else { on_lo[0] = oc_lo[0]; on_lo[1] = oc_lo[1]; on_hi[0] = oc_hi[0]; on_hi[1] = oc_hi[1]; } }
#pragma unroll 1
        for (int t = 0; t < nt; t += 2) {
            const bool last = (t == nt - 2);
            const char* a1 = cA + (size_t)(t + 1) * kstep;
            const char* a2 = last ? nA : cA + (size_t)(t + 2) * kstep; const char* b2 = last ? nB : cB + (size_t)(t + 2) * kstep;
            const char* a3 = a2 + kstep; const char* b3 = b2 + kstep;
            unsigned o2lo[2], o2hi[2];
            o2lo[0] = last ? on_lo[0] : oc_lo[0]; o2lo[1] = last ? on_lo[1] : oc_lo[1]; o2hi[0] = last ? on_hi[0] : oc_hi[0]; o2hi[1] = last ? on_hi[1] : oc_hi[1];
            PG8_LDB(B0, 0, 0); PG8_SCHED; PG8_LDA(At, 0, 0); if constexpr (GATHER) PG8_STAGE(PG8_SA(1, 1), a1, oc_hi); else PG8_STAGE(PG8_SA(1, 1), a1 + hstep, voffA);
            PG8_WAIT_L(8); PG8_BAR; PG8_WAIT_L(0); PG8_MMA(0, 0, At, B0); PG8_BAR; PG8_SCHED;
            PG8_LDB(B1, 0, 1); PG8_STAGE(PG8_SB(0, 0), b2, voffB);
            PG8_BAR; PG8_WAIT_L(0); PG8_MMA(0, 1, At, B1); PG8_BAR;
            PG8_LDA(At, 0, 1); if constexpr (GATHER) PG8_STAGE(PG8_SA(0, 0), a2, o2lo); else PG8_STAGE(PG8_SA(0, 0), a2, voffA);
            PG8_BAR; PG8_WAIT_L(0); PG8_MMA(1, 0, At, B0); PG8_BAR; PG8_SCHED;
            PG8_STAGE(PG8_SB(0, 1), b2 + hstep, voffB);
            PG8_WAIT_V(6); PG8_BAR; PG8_MMA(1, 1, At, B1); PG8_BAR;
            PG8_LDB(B0, 1, 0); PG8_SCHED; PG8_LDA(At, 1, 0); if constexpr (GATHER) PG8_STAGE(PG8_SA(0, 1), a2, o2hi); else PG8_STAGE(PG8_SA(0, 1), a2 + hstep, voffA);
            PG8_WAIT_L(8); PG8_BAR; PG8_WAIT_L(0); PG8_MMA(0, 0, At, B0); PG8_BAR; PG8_SCHED;
            PG8_LDB(B1, 1, 1); PG8_STAGE(PG8_SB(1, 0), b3, voffB);
            PG8_BAR; PG8_WAIT_L(0); PG8_MMA(0, 1, At, B1); PG8_BAR;
            PG8_LDA(At, 1, 1); if constexpr (GATHER) PG8_STAGE(PG8_SA(1, 0), a3, o2lo); else PG8_STAGE(PG8_SA(1, 0), a3, voffA);
            PG8_BAR; PG8_WAIT_L(0); PG8_MMA(1, 0, At, B0); PG8_BAR; PG8_SCHED;
            PG8_STAGE(PG8_SB(1, 1), b3 + hstep, voffB);
            PG8_WAIT_V(6); PG8_BAR; PG8_MMA(1, 1, At, B1); PG8_BAR;
        }
        epi_apply(E, acc, cur, wr, wc, fr, fq);
        if (!has_next) break;
#pragma unroll
        for (int a = 0; a < 2; ++a)
#pragma unroll
            for (int b = 0; b < 2; ++b)
#pragma unroll
                for (int m = 0; m < 4; ++m)
#pragma unroll
                    for (int n = 0; n < 2; ++n) acc[a][b][m][n] = (f32x4){0.f, 0.f, 0.f, 0.f};
        cur = nxt; cA = nA; cB = nB; ++ui;
        if constexpr (GATHER) { oc_lo[0] = on_lo[0]; oc_lo[1] = on_lo[1]; oc_hi[0] = on_hi[0]; oc_hi[1] = on_hi[1]; }
    }
    PG8_WAIT_V(0);
    if (wr == 0) PG8_BAR;
    PG8_BAR;
#undef PG8_ROWOFF
#undef PG8_SA
#undef PG8_SB
#undef PG8_STAGE
#undef PG8_LDA
#undef PG8_LDB
#undef PG8_MMA
#undef PG8_WAIT_V
#undef PG8_WAIT_L
#undef PG8_BAR
#undef PG8_SCHED
}
template <class Epi, class Sched>
__device__ __forceinline__ void gemm_phase(LAS unsigned char* lds, const int K, const Sched& S, const Epi& E, const int tid) { gemm_phase_t<false>(lds, K, S, E, tid); }
}

struct SchedInProj { const char* A; const char* Bt; int G, c;
    __device__ __forceinline__ bool next(int i, pg8::Unit& u) const { const int L = i * G + c; if (L >= 64 * 37) return false; int pm, pn; pg8::tile_order(L, 64, 37, pm, pn);
        u.a = A + (size_t)pm * (256 * 1024 * 2); u.b = Bt + (size_t)pn * (256 * 1024 * 2); u.row0 = pm * 256; u.col0 = pn * 256; u.aux = 0; u.rowmap = nullptr; return true; } };

struct WJob { const float* src; int ld_src; int K; int ncols; bf16* dst; int ld_dst; int nb; size_t sstride, dstride; };
__device__ __forceinline__ void wconv_job(const Ctx& c, const WJob& j) {
    float* tl = (float*)c.lds;
    const int ntk = j.K >> 6, ntn = j.ncols >> 6, per = ntk * ntn, ntiles = per * j.nb;
    const int rk = c.tid >> 3, rseg = (c.tid & 7) * 8;
    for (int tile = blockIdx.x; tile < ntiles; tile += gridDim.x) {
        const int bi = tile / per, tt = tile % per, tk = tt % ntk, tn = tt / ntk;
        const float* sp = j.src + (size_t)bi * j.sstride + (size_t)(tk * 64 + rk) * j.ld_src + tn * 64 + rseg;
        const float4 a = *(const float4*)sp, b = *(const float4*)(sp + 4);
        __syncthreads();
        float* row = tl + rk * 65 + rseg;
        row[0] = a.x; row[1] = a.y; row[2] = a.z; row[3] = a.w; row[4] = b.x; row[5] = b.y; row[6] = b.z; row[7] = b.w;
        __syncthreads();
        const float* col = tl + rseg * 65 + rk;
        uint4 w; w.x = pk2(col[0], col[65]); w.y = pk2(col[130], col[195]); w.z = pk2(col[260], col[325]); w.w = pk2(col[390], col[455]);
        *(uint4*)(j.dst + (size_t)bi * j.dstride + (size_t)(tn * 64 + rk) * j.ld_dst + tk * 64 + rseg) = w;
    }
}
struct SchedG2 { const char* YA; const char* Bt; int G, c;
    __device__ __forceinline__ bool next(int i, pg8::Unit& u) const { const int L = (i >> 1) * G + c, ab = i & 1; if (L >= 64 * 4) return false; int pm, pn; pg8::tile_order(L, 64, 4, pm, pn);
        u.a = YA + (size_t)ab * (WS_YB - WS_YA) + (size_t)pm * (256 * 1024 * 2); u.b = Bt + (size_t)(ab * 4 + pn) * (256 * 1024 * 2); u.row0 = pm * 256; u.col0 = ab * 1024 + pn * 256; u.aux = 0; u.rowmap = nullptr; return true; } };
struct SchedX1 { const char* A; const char* Bt; int G, c;
    __device__ __forceinline__ bool next(int i, pg8::Unit& u) const { const int L = i * G + c; if (L >= 64 * 4) return false; int pm, pn; pg8::tile_order(L, 64, 4, pm, pn);
        u.a = A + (size_t)pm * (256 * 1024 * 2); u.b = Bt + (size_t)pn * (256 * 1024 * 2); u.row0 = pm * 256; u.col0 = pn * 256; u.aux = 0; u.rowmap = nullptr; return true; } };
struct SchedMoe { const char* A; const char* Bt; const int* TILE_E; const int* SLOT_TOK; int NT, NPN, G, c;
    __device__ __forceinline__ bool next(int i, pg8::Unit& u) const { const int L = i * G + c; if (L >= NT * NPN) return false; const int tile = L / NPN, pn = L % NPN; const int e = TILE_E[tile];
        u.a = SLOT_TOK ? A : A + (size_t)tile * (256 * 1024 * 2); u.rowmap = SLOT_TOK ? SLOT_TOK + tile * 256 : nullptr;
        u.b = Bt + (size_t)(e * NPN + pn) * (256 * 1024 * 2); u.row0 = tile * 256; u.col0 = pn * 256; u.aux = e; return true; } };

struct EpiLora {
    typedef NoLd Ld; static constexpr int MB = 1;
    const float* w0; const float* a0; float* LW; float* AA; bf16* GGR;
    __device__ __forceinline__ void load(Ld&, int, int, int) const {}
    __device__ __forceinline__ void store8(int row, int col, const float (&v)[8], int, const Ld&) const {
        const float* bp = col < 1024 ? w0 + col : a0 + ((col - 1024) & 1023);
        const float4 b0 = *(const float4*)bp, b1 = *(const float4*)(bp + 4);
        const float bb[8] = {b0.x, b0.y, b0.z, b0.w, b1.x, b1.y, b1.z, b1.w};
        if (col < 1024) { float o[8];
#pragma unroll
            for (int i = 0; i < 8; ++i) o[i] = -0.6065306597126334f * fsigm(bb[i] + v[i]);
            float* p = LW + (size_t)row * 1024 + col; *(float4*)p = make_float4(o[0], o[1], o[2], o[3]); *(float4*)(p + 4) = make_float4(o[4], o[5], o[6], o[7]); }
        else if (col < 2048) { const int cc = col - 1024; float o[8];
#pragma unroll
            for (int i = 0; i < 8; ++i) o[i] = fsigm(bb[i] + v[i]);
            float* p = AA + (size_t)row * 1024 + cc; *(float4*)p = make_float4(o[0], o[1], o[2], o[3]); *(float4*)(p + 4) = make_float4(o[4], o[5], o[6], o[7]); }
        else { uint4 w; w.x = pk2(v[0], v[1]); w.y = pk2(v[2], v[3]); w.z = pk2(v[4], v[5]); w.w = pk2(v[6], v[7]); *(uint4*)(GGR + (size_t)row * 1024 + (col - 2048)) = w; }
    }
};
struct SchedLora { const char* A; const char* Bt; int G, c;
    __device__ __forceinline__ bool next(int i, pg8::Unit& u) const { const int L = i * G + c; if (L >= 64 * 12) return false; int pm, pn; pg8::tile_order(L, 64, 12, pm, pn);
        u.a = A + (size_t)pm * (256 * 256 * 2); u.b = Bt + (size_t)pn * (256 * 256 * 2); u.row0 = pm * 256; u.col0 = pn * 256; u.aux = 0; u.rowmap = nullptr; return true; } };
__device__ __forceinline__ void lora_zero(const Ctx& c) {
    uint4* LT = c.ws<uint4>(WS_LORA_T);
    for (size_t idx = c.gtid; idx < (size_t)3072 * 32; idx += c.nthreads) {
        const int row = (int)(idx >> 5), k8 = (int)(idx & 31) * 8;
        const bool data = row < 1024 ? (k8 < 64) : (row < 2048 ? (k8 >= 64 && k8 < 128) : (k8 >= 128));
        if (!data) LT[idx] = make_uint4(0, 0, 0, 0);
    }
}

__device__ __forceinline__ void ph_loraprep(const Ctx& c) {
    const float* LIN = c.ws<float>(WS_LIN); bf16* AL = c.ws<bf16>(WS_ALORA); const float* mu = c.P.in[I_MU];
    for (size_t idx = c.gtid; idx < (size_t)T * 256; idx += c.nthreads) {
        const int t = (int)(idx >> 8), cc = (int)(idx & 255);
        const float x = LIN[idx], xp = (t & (SEQ - 1)) ? LIN[idx - 256] : 0.f;
        const float xs = x + (xp - x) * mu[3072 + cc];
        const float r = cc < 64 ? tanhf(xs) : (cc < 128 ? xs : sigm(xs));
        AL[idx] = f2bf(r);
    }
}
__device__ __forceinline__ void ph_post(const Ctx& c) {
    const float* OG = c.ws<float>(WS_OG); const float* ORW = c.ws<float>(WS_ORW); const bf16* ZS = c.ws<bf16>(WS_ZS); const bf16* VP = c.ws<bf16>(WS_VP); const bf16* GGR = c.ws<bf16>(WS_GGR);
    const float* SC = c.ws<float>(WS_SC); bf16* YA = c.ws<bf16>(WS_YA); bf16* YB = c.ws<bf16>(WS_YB);
    const float* gnw = c.P.in[I_GDN_NORM]; const float* lnw = c.P.in[I_LNW]; const float* lnb = c.P.in[I_LNB];
    const int lane = c.lane, c0 = lane * 16;
    for (int t = c.gwave; t < T; t += c.nwaves) {
        {
            float o[16];
#pragma unroll
            for (int q = 0; q < 4; ++q) { const float4 v = *(const float4*)(OG + (size_t)t * 1024 + c0 + 4 * q); o[4 * q] = v.x; o[4 * q + 1] = v.y; o[4 * q + 2] = v.z; o[4 * q + 3] = v.w; }
            float ss = 0.f;
#pragma unroll
            for (int j = 0; j < 16; ++j) ss += o[j] * o[j];
            ss += __shfl_xor(ss, 1); ss += __shfl_xor(ss, 2); ss += __shfl_xor(ss, 4);
            const float rstd = rsqrtf(ss * (1.f / 128.f) + 1e-6f);
            const uint4 z0 = *(const uint4*)(ZS + (size_t)t * 1024 + c0), z1 = *(const uint4*)(ZS + (size_t)t * 1024 + c0 + 8);
            const unsigned zz[8] = {z0.x, z0.y, z0.z, z0.w, z1.x, z1.y, z1.z, z1.w};
            unsigned w[8];
#pragma unroll
            for (int j = 0; j < 8; ++j) { const int cc = (c0 + 2 * j) & 127; w[j] = pk2(o[2 * j] * rstd * gnw[cc] * bflo(zz[j]), o[2 * j + 1] * rstd * gnw[cc + 1] * bfhi(zz[j])); }
            *(uint4*)(YA + (size_t)t * 1024 + c0) = make_uint4(w[0], w[1], w[2], w[3]); *(uint4*)(YA + (size_t)t * 1024 + c0 + 8) = make_uint4(w[4], w[5], w[6], w[7]);
        }
        {
            float o[16];
#pragma unroll
            for (int q = 0; q < 4; ++q) { const float4 v = *(const float4*)(ORW + (size_t)t * 1024 + c0 + 4 * q); o[4 * q] = v.x; o[4 * q + 1] = v.y; o[4 * q + 2] = v.z; o[4 * q + 3] = v.w; }
            float sm = 0.f;
#pragma unroll
            for (int j = 0; j < 16; ++j) sm += o[j];
            sm += __shfl_xor(sm, 1); sm += __shfl_xor(sm, 2);
            const float mean = sm * (1.f / 64.f);
            float sv = 0.f;
#pragma unroll
            for (int j = 0; j < 16; ++j) { const float dd = o[j] - mean; sv += dd * dd; }
            sv += __shfl_xor(sv, 1); sv += __shfl_xor(sv, 2);
            const float rstd = rsqrtf(sv * (1.f / 64.f) + 64e-5f);
            const float sc = SC[t * 16 + (c0 >> 6)];
            const uint4 v0 = *(const uint4*)(VP + (size_t)t * 1024 + c0), v1 = *(const uint4*)(VP + (size_t)t * 1024 + c0 + 8);
            const uint4 g0 = *(const uint4*)(GGR + (size_t)t * 1024 + c0), g1 = *(const uint4*)(GGR + (size_t)t * 1024 + c0 + 8);
            const unsigned vv[8] = {v0.x, v0.y, v0.z, v0.w, v1.x, v1.y, v1.z, v1.w};
            const unsigned gg[8] = {g0.x, g0.y, g0.z, g0.w, g1.x, g1.y, g1.z, g1.w};
            unsigned w[8];
#pragma unroll
            for (int j = 0; j < 8; ++j) { const int cc = c0 + 2 * j;
                const float y0 = ((o[2 * j] - mean) * rstd * lnw[cc] + lnb[cc] + sc * bflo(vv[j])) * bflo(gg[j]);
                const float y1 = ((o[2 * j + 1] - mean) * rstd * lnw[cc + 1] + lnb[cc + 1] + sc * bfhi(vv[j])) * bfhi(gg[j]);
                w[j] = pk2(y0, y1); }
            *(uint4*)(YB + (size_t)t * 1024 + c0) = make_uint4(w[0], w[1], w[2], w[3]); *(uint4*)(YB + (size_t)t * 1024 + c0 + 8) = make_uint4(w[4], w[5], w[6], w[7]);
        }
    }
}

__device__ __forceinline__ void ph_router(const Ctx& c) {
    const float* X1 = c.ws<float>(WS_X1); const float* nw = c.P.in[I_NORM_FFN]; const float* rw = c.P.in[I_ROUTER_W]; const float* rb = c.P.in[I_ROUTER_B];
    bf16* H2 = c.ws<bf16>(WS_H2); int* TE = c.ws<int>(WS_TE); float* TG = c.ws<float>(WS_TG); int* TP = c.ws<int>(WS_TP); unsigned* CNT = c.ws<unsigned>(WS_CTL) + CW_CNT;
    const int lane = c.lane;
    float4* tab = (float4*)c.lds;
    unsigned* lcnt = (unsigned*)(c.lds + 147456);
    __syncthreads();
    if (c.tid < 32) lcnt[c.tid] = 0u;
    for (int i = c.tid; i < 8192; i += NTHREADS) { const int k = i >> 3; tab[((k & 3) * 256 + (k >> 2)) * 9 + (i & 7)] = ((const float4*)rw)[i]; }
    __syncthreads();
    for (int t = c.gwave; t < T; t += c.nwaves) {
        float4 v[4]; float ss = 0.f;
#pragma unroll
        for (int i = 0; i < 4; ++i) { v[i] = ((const float4*)(X1 + (size_t)t * D))[lane + 64 * i]; ss += v[i].x * v[i].x + v[i].y * v[i].y + v[i].z * v[i].z + v[i].w * v[i].w; }
        ss = wsum(ss);
        const float rstd = rsqrtf(ss * (1.f / 1024.f) + 1e-6f);
        float lg[32];
#pragma unroll
        for (int j = 0; j < 32; ++j) lg[j] = 0.f;
#pragma unroll
        for (int i = 0; i < 4; ++i) {
            const float4 w4 = ((const float4*)nw)[lane + 64 * i];
            const float h[4] = {v[i].x * rstd * w4.x, v[i].y * rstd * w4.y, v[i].z * rstd * w4.z, v[i].w * rstd * w4.w};
            uint2 st; st.x = pk2(h[0], h[1]); st.y = pk2(h[2], h[3]);
            *(uint2*)(H2 + (size_t)t * D + 4 * (lane + 64 * i)) = st;
#pragma unroll
            for (int ii = 0; ii < 4; ++ii) {
                const float4* wr = tab + (size_t)(ii * 256 + lane + 64 * i) * 9;
#pragma unroll
                for (int q = 0; q < 8; ++q) { const float4 w = wr[q]; lg[4 * q] += h[ii] * w.x; lg[4 * q + 1] += h[ii] * w.y; lg[4 * q + 2] += h[ii] * w.z; lg[4 * q + 3] += h[ii] * w.w; }
                asm volatile("" ::: "memory");
            }
        }
#pragma unroll
        for (int j = 0; j < 32; ++j) lg[j] = wsum(lg[j]) + rb[j];
        int e0 = 0, e1 = 0, e2 = 0, e3 = 0; float v0 = -3e38f, v1 = -3e38f, v2 = -3e38f, v3 = -3e38f;
#pragma unroll
        for (int j = 0; j < 32; ++j) if (lg[j] > v0) { v0 = lg[j]; e0 = j; }
#pragma unroll
        for (int j = 0; j < 32; ++j) if (j != e0 && lg[j] > v1) { v1 = lg[j]; e1 = j; }
#pragma unroll
        for (int j = 0; j < 32; ++j) if (j != e0 && j != e1 && lg[j] > v2) { v2 = lg[j]; e2 = j; }
#pragma unroll
        for (int j = 0; j < 32; ++j) if (j != e0 && j != e1 && j != e2 && lg[j] > v3) { v3 = lg[j]; e3 = j; }
        const float x1 = expf(v1 - v0), x2 = expf(v2 - v0), x3 = expf(v3 - v0), inv = 1.f / (1.f + x1 + x2 + x3);
        if (lane < 4) {
            const int me = lane == 0 ? e0 : (lane == 1 ? e1 : (lane == 2 ? e2 : e3));
            const float mg = (lane == 0 ? 1.f : (lane == 1 ? x1 : (lane == 2 ? x2 : x3))) * inv;
            const unsigned pos = atomicAdd(&lcnt[me], 1u);
            TE[t * 4 + lane] = me; TG[t * 4 + lane] = mg; TP[t * 4 + lane] = (int)pos;
        }
    }
    __syncthreads();
    if (c.tid < 32) lcnt[32 + c.tid] = atomicAdd(&CNT[c.tid], lcnt[c.tid]);
    __syncthreads();
    if (lane < 4) for (int t = c.gwave; t < T; t += c.nwaves) TP[t * 4 + lane] += (int)lcnt[32 + TE[t * 4 + lane]];
    __syncthreads();
}

__device__ __forceinline__ void ph_dispatch(const Ctx& c) {
    int* tb = (int*)c.lds;
    const unsigned* CNT = c.ws<unsigned>(WS_CTL) + CW_CNT;
    int* TILE_E = c.ws<int>(WS_TILE_E); int* NT = c.ws<int>(WS_NT);
    const int* TE = c.ws<int>(WS_TE); const float* TG = c.ws<float>(WS_TG); const int* TP = c.ws<int>(WS_TP); int* TSLOT = c.ws<int>(WS_TSLOT);
    float* SGATE = c.ws<float>(WS_SGATE); const bf16* H2 = c.ws<bf16>(WS_H2); bf16* XB = c.ws<bf16>(WS_XB);
    if (c.tid == 0) { int acc = 0; for (int e = 0; e < NEXP; ++e) { const int n = (int)__hip_atomic_load(&CNT[e], __ATOMIC_RELAXED, __HIP_MEMORY_SCOPE_AGENT); tb[e] = acc; tb[64 + e] = n; acc += (n + 255) >> 8; } tb[32] = acc; }
    __syncthreads();
    if (blockIdx.x == 0) {
        for (int tile = c.tid; tile < tb[32]; tile += NTHREADS) { int e = 0; for (int q = 0; q < NEXP; ++q) if (tile >= tb[q]) e = q; TILE_E[tile] = e; }
        if (c.tid == 0) *NT = tb[32];
    }
    int* SLOT_TOK = c.ws<int>(WS_SLOT_TOK);
    for (size_t idx = c.gtid; idx < (size_t)T * 4; idx += c.nthreads) {
        const int t = (int)(idx >> 2), e = TE[idx], pos = TP[idx];
        const int slot = tb[e] * 256 + pos;
        TSLOT[idx] = slot; SGATE[slot] = TG[idx]; SLOT_TOK[slot] = t;
    }
    for (int e = 0; e < NEXP; ++e) {
        const int n = tb[64 + e], cap = (tb[e + 1] - tb[e]) * 256;
        for (int r = n + (int)c.gtid; r < cap; r += (int)c.nthreads) { const int slot = tb[e] * 256 + r; SLOT_TOK[slot] = 0; SGATE[slot] = 0.f; }
    }
}

__device__ __forceinline__ void ph_combine(const Ctx& c) {
    const float* X1 = c.ws<float>(WS_X1); const bf16* YS = c.ws<bf16>(WS_YS); const int* TSLOT = c.ws<int>(WS_TSLOT); const float* nw = c.P.in[I_NORM_FINAL]; float* out = c.P.out;
    const int lane = c.lane;
    for (int t = c.gwave; t < T; t += c.nwaves) {
        const int s0 = TSLOT[t * 4], s1 = TSLOT[t * 4 + 1], s2 = TSLOT[t * 4 + 2], s3 = TSLOT[t * 4 + 3];
        float4 v[4]; float ss = 0.f;
#pragma unroll
        for (int i = 0; i < 4; ++i) {
            const int col = 4 * (lane + 64 * i);
            v[i] = *(const float4*)(X1 + (size_t)t * D + col);
            const uint2 a = *(const uint2*)(YS + (size_t)s0 * 1024 + col), b = *(const uint2*)(YS + (size_t)s1 * 1024 + col), cc = *(const uint2*)(YS + (size_t)s2 * 1024 + col), d = *(const uint2*)(YS + (size_t)s3 * 1024 + col);
            v[i].x += bflo(a.x) + bflo(b.x) + bflo(cc.x) + bflo(d.x); v[i].y += bfhi(a.x) + bfhi(b.x) + bfhi(cc.x) + bfhi(d.x);
            v[i].z += bflo(a.y) + bflo(b.y) + bflo(cc.y) + bflo(d.y); v[i].w += bfhi(a.y) + bfhi(b.y) + bfhi(cc.y) + bfhi(d.y);
            ss += v[i].x * v[i].x + v[i].y * v[i].y + v[i].z * v[i].z + v[i].w * v[i].w;
        }
        ss = wsum(ss);
        const float rstd = rsqrtf(ss * (1.f / 1024.f) + 1e-6f);
#pragma unroll
        for (int i = 0; i < 4; ++i) { const float4 w4 = ((const float4*)nw)[lane + 64 * i];
            *(float4*)(out + (size_t)t * D + 4 * (lane + 64 * i)) = make_float4(v[i].x * rstd * w4.x, v[i].y * rstd * w4.y, v[i].z * rstd * w4.z, v[i].w * rstd * w4.w); }
    }
}


typedef short bf16x8_t __attribute__((ext_vector_type(8)));
typedef float f32x4_t __attribute__((ext_vector_type(4)));
#define MFMA16(a, b, c) __builtin_amdgcn_mfma_f32_16x16x32_bf16((a), (b), (c), 0, 0, 0)


__device__ __forceinline__ int frag_off(int row, int k, int KBn) { return (((row >> 4) * KBn + (k >> 5)) * 512) + (((k >> 3) & 3) * 128) + ((row & 15) * 8) + (k & 7); }
__device__ __forceinline__ int cfrag_off(int v, int r, int NRT) { return ((((v >> 4) * NRT + (r >> 4)) * 64 + ((r >> 2) & 3) * 16 + (v & 15)) * 4) + (r & 3); }

constexpr int GCL_HALF_BYTES = 71680;
__device__ __forceinline__ void ph_gcl(const Ctx& c) {
    const bf16* GQKV = c.ws<bf16>(WS_GQKV); const float* BETA = c.ws<float>(WS_BETA); const float* GGv = c.ws<float>(WS_GG); const float* cw = c.P.in[I_GDN_CONV];
    bf16* GA1 = c.ws<bf16>(WS_GA1); float* GX0 = c.ws<float>(WS_GX0); bf16* GA2 = c.ws<bf16>(WS_GA2); bf16* GA3 = c.ws<bf16>(WS_GA3); bf16* GA4 = c.ws<bf16>(WS_GA4); float* GGL = c.ws<float>(WS_GGL);
    for (int it0 = blockIdx.x * 2; it0 < 2048; it0 += gridDim.x * 2) {
        int tv = c.tid; asm volatile("" : "+v"(tv));
        const int half = tv >> 8, ht = tv & 255, lane = tv & 63, w4 = __builtin_amdgcn_readfirstlane((tv >> 6) & 3);
        unsigned char* base = c.lds + half * GCL_HALF_BYTES;
        bf16* QB = (bf16*)base;
        bf16* KB = QB + 64 * 136;
        bf16* VB = KB + 64 * 136;
        float* MM = (float*)(VB + 64 * 136);
        float* GC = MM + 64 * 64;
        float* BT = GC + 64;
        float* BE = BT + 64;
        const int item = it0 + half, n = item & 63, bh = item >> 6, h = bh & 7, b = bh >> 3;
        const int t0 = b * SEQ + n * 64;
        __syncthreads();
        if (w4 == 0) {
            float g = GGv[(size_t)(t0 + lane) * 8 + h]; const float be = BETA[(size_t)(t0 + lane) * 8 + h];
#pragma unroll
            for (int o = 1; o < 64; o <<= 1) { const float u = __shfl_up(g, o); if (lane >= o) g += u; }
            GC[lane] = g; BT[lane] = be; BE[lane] = be * __expf(g);
        }
        __syncthreads();
        {
            const int cg = ht & 15, rg = ht >> 4, r0 = rg * 4;
#pragma unroll
            for (int mat = 0; mat < 3; ++mat) {
                const int col0 = mat * 1024 + h * 128 + cg * 8;
                float4 xa[7], xb[7], wa[4], wb[4];
#pragma unroll
                for (int li = 0; li < 7; ++li) {
                    const bool valid = (n > 0) || (r0 - 3 + li >= 0);
                    uint4 xr = make_uint4(0, 0, 0, 0);
                    if (valid) xr = *(const uint4*)(GQKV + (size_t)(t0 + r0 - 3 + li) * 3072 + col0);
                    xa[li] = make_float4(bflo(xr.x), bfhi(xr.x), bflo(xr.y), bfhi(xr.y));
                    xb[li] = make_float4(bflo(xr.z), bfhi(xr.z), bflo(xr.w), bfhi(xr.w));
                }
#pragma unroll
                for (int j = 0; j < 4; ++j) { wa[j] = *(const float4*)(cw + j * 3072 + col0); wb[j] = *(const float4*)(cw + j * 3072 + col0 + 4); }
#pragma unroll
                for (int rr = 0; rr < 4; ++rr) {
                    float o[8] = {0.f, 0.f, 0.f, 0.f, 0.f, 0.f, 0.f, 0.f};
#pragma unroll
                    for (int j = 0; j < 4; ++j) { const float4 a = xa[rr + j], bq = xb[rr + j];
                        o[0] += wa[j].x * a.x; o[1] += wa[j].y * a.y; o[2] += wa[j].z * a.z; o[3] += wa[j].w * a.w;
                        o[4] += wb[j].x * bq.x; o[5] += wb[j].y * bq.y; o[6] += wb[j].z * bq.z; o[7] += wb[j].w * bq.w; }
                    float ss = 0.f;
#pragma unroll
                    for (int e = 0; e < 8; ++e) { o[e] *= fsigm(o[e]); ss += o[e] * o[e]; }
                    float sc = 1.f;
                    if (mat < 2) { ss += __shfl_xor(ss, 1); ss += __shfl_xor(ss, 2); ss += __shfl_xor(ss, 4); ss += __shfl_xor(ss, 8); sc = rsqrtf(ss + 1e-6f) * (mat == 0 ? 0.08838834764831845f : 1.f); }
                    const int r = r0 + rr;
                    uint4 w; w.x = pk2(o[0] * sc, o[1] * sc); w.y = pk2(o[2] * sc, o[3] * sc); w.z = pk2(o[4] * sc, o[5] * sc); w.w = pk2(o[6] * sc, o[7] * sc);
                    *(uint4*)((mat == 0 ? QB : (mat == 1 ? KB : VB)) + r * 136 + cg * 8) = w;
                    if (mat == 0) {
                        const float s2 = sc * __expf(GC[r]);
                        w.x = pk2(o[0] * s2, o[1] * s2); w.y = pk2(o[2] * s2, o[3] * s2); w.z = pk2(o[4] * s2, o[5] * s2); w.w = pk2(o[6] * s2, o[7] * s2);
                        *(uint4*)(GA2 + (size_t)item * 64 * 128 + frag_off(r, cg * 8, 4)) = w;
                    }
                }
            }
        }
        __syncthreads();
        {
            const int fr = lane & 15, fq = lane >> 4, a0 = w4 * 16;
            bf16x8_t ka[4];
#pragma unroll
            for (int kb = 0; kb < 4; ++kb) ka[kb] = *(const bf16x8_t*)(KB + (a0 + fr) * 136 + kb * 32 + fq * 8);
#pragma unroll
            for (int bt = 0; bt < 4; ++bt) {
                f32x4_t c1 = {0.f, 0.f, 0.f, 0.f}, c2 = {0.f, 0.f, 0.f, 0.f};
#pragma unroll
                for (int kb = 0; kb < 4; ++kb) {
                    const bf16x8_t kbf = *(const bf16x8_t*)(KB + (bt * 16 + fr) * 136 + kb * 32 + fq * 8);
                    const bf16x8_t qbf = *(const bf16x8_t*)(QB + (bt * 16 + fr) * 136 + kb * 32 + fq * 8);
                    c1 = MFMA16(ka[kb], kbf, c1); c2 = MFMA16(ka[kb], qbf, c2);
                }
                const int i = bt * 16 + fr, j0 = a0 + 4 * fq;
                const float gi = GC[i], bi = BT[i];
                float m[4], at[4];
#pragma unroll
                for (int rg = 0; rg < 4; ++rg) { const int j = j0 + rg; const float dec = __expf(fminf(gi - GC[j], 0.f));
                    m[rg] = (i > j) ? bi * c1[rg] * dec : 0.f; at[rg] = (i >= j) ? c2[rg] * dec : 0.f; }
                *(float4*)(MM + i * 64 + j0) = make_float4(m[0], m[1], m[2], m[3]);
                uint2 w; w.x = pk2(at[0], at[1]); w.y = pk2(at[2], at[3]);
                *(uint2*)(GA3 + (size_t)item * 64 * 64 + frag_off(i, j0, 2)) = w;
            }
        }
        __syncthreads();
        {
            const int cc = ht & 127; const bool isw = ht >= 128;
            const bf16* srcp = (isw ? KB : VB) + cc; const float* scl = isw ? BE : BT;
            float x[64];
#pragma unroll
            for (int i = 0; i < 64; ++i) x[i] = 0.f;
            float4 mc[16], mn[16];
#pragma unroll
            for (int q = 0; q < 16; ++q) { mc[q] = make_float4(0.f, 0.f, 0.f, 0.f); mn[q] = mc[q]; }
            float rhs_n = scl[0] * bf2f(srcp[0]);
#pragma unroll
            for (int i = 0; i < 64; ++i) {
                const float rhs = rhs_n;
                if (i + 1 < 64) {
#pragma unroll
                    for (int j4 = 0; j4 < (i + 4) / 4; ++j4) mn[j4] = *(const float4*)(MM + (i + 1) * 64 + 4 * j4);
                    rhs_n = scl[i + 1] * bf2f(srcp[(i + 1) * 136]);
                }
                float acc = rhs, ac1 = 0.f, ac2 = 0.f, ac3 = 0.f;
#pragma unroll
                for (int j4 = 0; j4 < (i + 3) / 4; ++j4) { acc -= mc[j4].x * x[4 * j4]; ac1 -= mc[j4].y * x[4 * j4 + 1]; ac2 -= mc[j4].z * x[4 * j4 + 2]; ac3 -= mc[j4].w * x[4 * j4 + 3]; }
                x[i] = (acc + ac1) + (ac2 + ac3);
#pragma unroll
                for (int j4 = 0; j4 < 16; ++j4) mc[j4] = mn[j4];
                asm volatile("" ::: "memory");
            }
            if (!isw) {
                float* up = GX0 + (size_t)item * 128 * 64;
#pragma unroll
                for (int q = 0; q < 16; ++q) *(float4*)(up + cfrag_off(cc, 4 * q, 4)) = make_float4(x[4 * q], x[4 * q + 1], x[4 * q + 2], x[4 * q + 3]);
            }
            __syncthreads();
            if (isw) {
                bf16* a1s = (bf16*)MM;
#pragma unroll
                for (int i = 0; i < 64; ++i) a1s[i * 128 + cc] = f2bf(-x[i]);
            }
        }
        __syncthreads();
        {
            const bf16* a1s = (const bf16*)MM; bf16* wp = GA1 + (size_t)item * 64 * 128;
#pragma unroll
            for (int q = 0; q < 4; ++q) { const int p = ht + 256 * q, fr = p & 15, fq = (p >> 4) & 3, kb = (p >> 6) & 3, rt = p >> 8;
                *(uint4*)(wp + p * 8) = *(const uint4*)(a1s + (rt * 16 + fr) * 128 + kb * 32 + fq * 8); }
        }
        {
            const int dk = ht & 127, hh = ht >> 7; const float g63 = GC[63];
            unsigned w[16];
#pragma unroll
            for (int q = 0; q < 16; ++q) { const int ta = hh * 32 + 2 * q;
                w[q] = pk2(bf2f(KB[ta * 136 + dk]) * __expf(g63 - GC[ta]), bf2f(KB[(ta + 1) * 136 + dk]) * __expf(g63 - GC[ta + 1])); }
            bf16* dp = GA4 + (size_t)item * 128 * 64;
            *(uint4*)(dp + frag_off(dk, hh * 32, 2)) = make_uint4(w[0], w[1], w[2], w[3]); *(uint4*)(dp + frag_off(dk, hh * 32 + 8, 2)) = make_uint4(w[4], w[5], w[6], w[7]);
            *(uint4*)(dp + frag_off(dk, hh * 32 + 16, 2)) = make_uint4(w[8], w[9], w[10], w[11]); *(uint4*)(dp + frag_off(dk, hh * 32 + 24, 2)) = make_uint4(w[12], w[13], w[14], w[15]);
            if (ht == 0) GGL[item] = __expf(g63);
        }
    }
}

constexpr int RCL_HALF_BYTES = 75776;
__device__ __forceinline__ void ph_rcl(const Ctx& c) {
    const bf16* RKV = c.ws<bf16>(WS_RKV); const float* LW = c.ws<float>(WS_LW); const float* AAg = c.ws<float>(WS_AA);
    const float* mu = c.P.in[I_MU]; const float* k_k = c.P.in[I_KK]; const float* k_a = c.P.in[I_KA]; const float* r_k = c.P.in[I_RK];
    bf16* VP = c.ws<bf16>(WS_VP); float* SC = c.ws<float>(WS_SC);
    bf16* RA1 = c.ws<bf16>(WS_RA1); float* RX0 = c.ws<float>(WS_RX0); bf16* RA2 = c.ws<bf16>(WS_RA2); bf16* RA3 = c.ws<bf16>(WS_RA3); float* RO0 = c.ws<float>(WS_RO0);
    bf16* RA4 = c.ws<bf16>(WS_RA4); float* RS0 = c.ws<float>(WS_RS0); float* RDSC = c.ws<float>(WS_RDSC);
    for (int it0 = blockIdx.x * 2; it0 < 4096; it0 += gridDim.x * 2) {
        int tv = c.tid; asm volatile("" : "+v"(tv));
        const int half = tv >> 8, ht = tv & 255, lane = tv & 63, w4 = __builtin_amdgcn_readfirstlane((tv >> 6) & 3);
        unsigned char* base = c.lds + half * RCL_HALF_BYTES;
        bf16* AT = (bf16*)base;
        bf16* VT = AT + 64 * 72;
        bf16* KDT = VT + 64 * 72;
        float* AAB = (float*)(KDT + 64 * 72);
        float* TOT = AAB + 64 * 64;
        unsigned char* RX = (unsigned char*)(TOT + 256);
        bf16* RT = (bf16*)RX;
        bf16* BTL = RT + 64 * 72;
        bf16* KT = BTL + 64 * 72;
        bf16* AAK = (bf16*)RX;
        bf16* ARK = AAK + 64 * 72;
        float* RHS2 = (float*)RX;
        const int item = it0 + half, n = item & 63, bh = item >> 6, h = bh & 15, b = bh >> 4;
        const int t0 = b * SEQ + n * 64;
        __syncthreads();
        const int r = ht >> 2, seg = ht & 3, c0 = seg * 16, t = t0 + r; const bool first = (n == 0 && r == 0);
        float rr[16], kf[16], vv[16], kkv[16], aa[16], lwl[16];
        float ss = 0.f, scs = 0.f;
        {
            const bf16* cur = RKV + (size_t)t * 3072 + h * 64 + c0; const bf16* prv = cur - 3072;
            uint4 ur[2], uk[2], uv[2], qr[2], qk[2], qv[2];
            float4 a4v[4], l4v[4], mr[4], mk[4], mv[4], kkw[4], kaw[4], rkw[4];
#pragma unroll
            for (int g = 0; g < 2; ++g) {
                ur[g] = *(const uint4*)(cur + 8 * g); uk[g] = *(const uint4*)(cur + 1024 + 8 * g); uv[g] = *(const uint4*)(cur + 2048 + 8 * g);
                qr[g] = make_uint4(0, 0, 0, 0); qk[g] = qr[g]; qv[g] = qr[g];
                if (!first) { qr[g] = *(const uint4*)(prv + 8 * g); qk[g] = *(const uint4*)(prv + 1024 + 8 * g); qv[g] = *(const uint4*)(prv + 2048 + 8 * g); }
            }
#pragma unroll
            for (int q = 0; q < 4; ++q) {
                l4v[q] = *(const float4*)(LW + (size_t)t * 1024 + h * 64 + c0 + 4 * q);
                a4v[q] = *(const float4*)(AAg + (size_t)t * 1024 + h * 64 + c0 + 4 * q);
                mr[q] = *(const float4*)(mu + h * 64 + c0 + 4 * q); mk[q] = *(const float4*)(mu + 1024 + h * 64 + c0 + 4 * q); mv[q] = *(const float4*)(mu + 2048 + h * 64 + c0 + 4 * q);
                kkw[q] = *(const float4*)(k_k + h * 64 + c0 + 4 * q); kaw[q] = *(const float4*)(k_a + h * 64 + c0 + 4 * q); rkw[q] = *(const float4*)(r_k + h * 64 + c0 + 4 * q);
            }
#pragma unroll
            for (int q = 0; q < 4; ++q) *(float4*)(AAB + r * 64 + c0 + 4 * q) = l4v[q];
            __syncthreads();
            {
                const int ch = ht & 63, tq = ht >> 6;
                float run = 0.f;
#pragma unroll
                for (int i = 0; i < 16; ++i) { run += AAB[(tq * 16 + i) * 64 + ch]; AAB[(tq * 16 + i) * 64 + ch] = run; }
                TOT[tq * 64 + ch] = run;
            }
            __syncthreads();
#pragma unroll
            for (int q = 0; q < 4; ++q) {
                const int g = q >> 1; const bool hi = q & 1;
                const unsigned r_a = hi ? ur[g].z : ur[g].x, r_b = hi ? ur[g].w : ur[g].y, k_a_ = hi ? uk[g].z : uk[g].x, k_b_ = hi ? uk[g].w : uk[g].y, v_a = hi ? uv[g].z : uv[g].x, v_b = hi ? uv[g].w : uv[g].y;
                const unsigned pr_a = hi ? qr[g].z : qr[g].x, pr_b = hi ? qr[g].w : qr[g].y, pk_a = hi ? qk[g].z : qk[g].x, pk_b = hi ? qk[g].w : qk[g].y, pv_a = hi ? qv[g].z : qv[g].x, pv_b = hi ? qv[g].w : qv[g].y;
                const float r0a[4] = {bflo(r_a), bfhi(r_a), bflo(r_b), bfhi(r_b)}, k0a[4] = {bflo(k_a_), bfhi(k_a_), bflo(k_b_), bfhi(k_b_)}, v0a[4] = {bflo(v_a), bfhi(v_a), bflo(v_b), bfhi(v_b)};
                const float rpa[4] = {bflo(pr_a), bfhi(pr_a), bflo(pr_b), bfhi(pr_b)}, kpa[4] = {bflo(pk_a), bfhi(pk_a), bflo(pk_b), bfhi(pk_b)}, vpa[4] = {bflo(pv_a), bfhi(pv_a), bflo(pv_b), bfhi(pv_b)};
                const float mra[4] = {mr[q].x, mr[q].y, mr[q].z, mr[q].w}, mka[4] = {mk[q].x, mk[q].y, mk[q].z, mk[q].w}, mva[4] = {mv[q].x, mv[q].y, mv[q].z, mv[q].w};
                const float kka[4] = {kkw[q].x, kkw[q].y, kkw[q].z, kkw[q].w}, kaa[4] = {kaw[q].x, kaw[q].y, kaw[q].z, kaw[q].w}, rka[4] = {rkw[q].x, rkw[q].y, rkw[q].z, rkw[q].w};
                const float aaa[4] = {a4v[q].x, a4v[q].y, a4v[q].z, a4v[q].w}, lwa[4] = {l4v[q].x, l4v[q].y, l4v[q].z, l4v[q].w};
#pragma unroll
                for (int e = 0; e < 4; ++e) { const int i = 4 * q + e;
                    rr[i] = r0a[e] + (rpa[e] - r0a[e]) * mra[e]; const float kx = k0a[e] + (kpa[e] - k0a[e]) * mka[e]; vv[i] = v0a[e] + (vpa[e] - v0a[e]) * mva[e];
                    kkv[i] = kx * kka[e]; ss += kkv[i] * kkv[i]; aa[i] = aaa[e]; lwl[i] = lwa[e]; kf[i] = kx * (1.f + (aaa[e] - 1.f) * kaa[e]); scs += rr[i] * kf[i] * rka[e]; }
            }
        }
        {
            ss += __shfl_xor(ss, 1); ss += __shfl_xor(ss, 2); scs += __shfl_xor(scs, 1); scs += __shfl_xor(scs, 2);
            const float rn = rsqrtf(ss + 1e-6f);
            if (seg == 0) SC[(size_t)t * 16 + h] = scs;
            const int tq = r >> 4;
            unsigned wat[8], wbt[8], wkt[8], wrt[8], wvp[8];
            float atv[16], btv[16], ktv[16], rtv[16];
#pragma unroll
            for (int i = 0; i < 16; ++i) {
                const int ch = c0 + i;
                float off = 0.f;
#pragma unroll
                for (int q = 0; q < 3; ++q) off += (q < tq) ? TOT[q * 64 + ch] : 0.f;
                const float tot = TOT[ch] + TOT[64 + ch] + TOT[128 + ch] + TOT[192 + ch];
                const float cs = AAB[r * 64 + ch] + off;
                const float lwv = lwl[i];
                const float kk = kkv[i] * rn;
                const float e2 = __expf(-cs), e4 = __expf(tot - cs);
                atv[i] = kk * __expf(cs - lwv); btv[i] = -kk * aa[i] * e2; ktv[i] = kf[i] * e2; rtv[i] = rr[i] * __expf(cs);
                VT[ch * 72 + r] = f2bf(vv[i]);
                KDT[ch * 72 + r] = f2bf(kf[i] * e4);
                RA4[(size_t)item * 64 * 64 + frag_off(ch, r, 2)] = f2bf(-kk * aa[i] * e4);
                if (r == 63) RDSC[(size_t)item * 64 + ch] = __expf(tot);
            }
#pragma unroll
            for (int q = 0; q < 8; ++q) { wat[q] = pk2(atv[2 * q], atv[2 * q + 1]); wbt[q] = pk2(btv[2 * q], btv[2 * q + 1]); wkt[q] = pk2(ktv[2 * q], ktv[2 * q + 1]); wrt[q] = pk2(rtv[2 * q], rtv[2 * q + 1]); wvp[q] = pk2(vv[2 * q], vv[2 * q + 1]); }
            *(uint4*)(AT + r * 72 + c0) = make_uint4(wat[0], wat[1], wat[2], wat[3]); *(uint4*)(AT + r * 72 + c0 + 8) = make_uint4(wat[4], wat[5], wat[6], wat[7]);
            *(uint4*)(BTL + r * 72 + c0) = make_uint4(wbt[0], wbt[1], wbt[2], wbt[3]); *(uint4*)(BTL + r * 72 + c0 + 8) = make_uint4(wbt[4], wbt[5], wbt[6], wbt[7]);
            *(uint4*)(KT + r * 72 + c0) = make_uint4(wkt[0], wkt[1], wkt[2], wkt[3]); *(uint4*)(KT + r * 72 + c0 + 8) = make_uint4(wkt[4], wkt[5], wkt[6], wkt[7]);
            *(uint4*)(RT + r * 72 + c0) = make_uint4(wrt[0], wrt[1], wrt[2], wrt[3]); *(uint4*)(RT + r * 72 + c0 + 8) = make_uint4(wrt[4], wrt[5], wrt[6], wrt[7]);
            bf16* a2p = RA2 + (size_t)item * 64 * 64;
            *(uint4*)(a2p + frag_off(r, c0, 2)) = make_uint4(wrt[0], wrt[1], wrt[2], wrt[3]); *(uint4*)(a2p + frag_off(r, c0 + 8, 2)) = make_uint4(wrt[4], wrt[5], wrt[6], wrt[7]);
            bf16* vpp = VP + (size_t)t * 1024 + h * 64 + c0;
            *(uint4*)vpp = make_uint4(wvp[0], wvp[1], wvp[2], wvp[3]); *(uint4*)(vpp + 8) = make_uint4(wvp[4], wvp[5], wvp[6], wvp[7]);
        }
        __syncthreads();
        const int fr = lane & 15, fq = lane >> 4;
        f32x4_t cab[4], cak[4], crb[4], crk[4];
        {
            const int j0t = w4 * 16;
            bf16x8_t bj[2], kj[2];
#pragma unroll
            for (int kb = 0; kb < 2; ++kb) { bj[kb] = *(const bf16x8_t*)(BTL + (j0t + fr) * 72 + kb * 32 + fq * 8); kj[kb] = *(const bf16x8_t*)(KT + (j0t + fr) * 72 + kb * 32 + fq * 8); }
#pragma unroll
            for (int it = 0; it < 4; ++it) {
                cab[it] = (f32x4_t){0.f, 0.f, 0.f, 0.f}; cak[it] = cab[it]; crb[it] = cab[it]; crk[it] = cab[it];
#pragma unroll
                for (int kb = 0; kb < 2; ++kb) {
                    const bf16x8_t ai = *(const bf16x8_t*)(AT + (it * 16 + fr) * 72 + kb * 32 + fq * 8);
                    const bf16x8_t ri = *(const bf16x8_t*)(RT + (it * 16 + fr) * 72 + kb * 32 + fq * 8);
                    cab[it] = MFMA16(bj[kb], ai, cab[it]); cak[it] = MFMA16(kj[kb], ai, cak[it]); crb[it] = MFMA16(bj[kb], ri, crb[it]); crk[it] = MFMA16(kj[kb], ri, crk[it]);
                }
            }
        }
        __syncthreads();
        {
            const int j0 = w4 * 16 + 4 * fq;
#pragma unroll
            for (int it = 0; it < 4; ++it) {
                const int i = it * 16 + fr;
                float vab[4], vak[4], vrb[4], vrk[4];
#pragma unroll
                for (int rg = 0; rg < 4; ++rg) { const int j = j0 + rg; const bool st = i > j, in = i >= j;
                    vab[rg] = st ? cab[it][rg] : 0.f; vak[rg] = st ? cak[it][rg] : 0.f; vrb[rg] = in ? crb[it][rg] : 0.f; vrk[rg] = in ? crk[it][rg] : 0.f; }
                *(float4*)(AAB + i * 64 + j0) = make_float4(vab[0], vab[1], vab[2], vab[3]);
                uint2 w; w.x = pk2(vak[0], vak[1]); w.y = pk2(vak[2], vak[3]); *(uint2*)(AAK + i * 72 + j0) = w;
                w.x = pk2(vrk[0], vrk[1]); w.y = pk2(vrk[2], vrk[3]); *(uint2*)(ARK + i * 72 + j0) = w;
                w.x = pk2(vrb[0], vrb[1]); w.y = pk2(vrb[2], vrb[3]); *(uint2*)(RA3 + (size_t)item * 64 * 64 + frag_off(i, j0, 2)) = w;
            }
        }
        __syncthreads();
        f32x4_t cav[4], cov[4], ckv[4];
        {
            const int r0t = w4 * 16;
            bf16x8_t fa[2], fo[2], fk[2];
#pragma unroll
            for (int kb = 0; kb < 2; ++kb) { fa[kb] = *(const bf16x8_t*)(AAK + (r0t + fr) * 72 + kb * 32 + fq * 8); fo[kb] = *(const bf16x8_t*)(ARK + (r0t + fr) * 72 + kb * 32 + fq * 8); fk[kb] = *(const bf16x8_t*)(KDT + (r0t + fr) * 72 + kb * 32 + fq * 8); }
#pragma unroll
            for (int vt = 0; vt < 4; ++vt) {
                cav[vt] = (f32x4_t){0.f, 0.f, 0.f, 0.f}; cov[vt] = cav[vt]; ckv[vt] = cav[vt];
#pragma unroll
                for (int kb = 0; kb < 2; ++kb) { const bf16x8_t vb = *(const bf16x8_t*)(VT + (vt * 16 + fr) * 72 + kb * 32 + fq * 8);
                    cav[vt] = MFMA16(fa[kb], vb, cav[vt]); cov[vt] = MFMA16(fo[kb], vb, cov[vt]); ckv[vt] = MFMA16(fk[kb], vb, ckv[vt]); }
            }
        }
        __syncthreads();
        {
            const int r0 = w4 * 16 + 4 * fq;
#pragma unroll
            for (int vt = 0; vt < 4; ++vt) {
                const int v = vt * 16 + fr;
#pragma unroll
                for (int rg = 0; rg < 4; ++rg) RHS2[v * 65 + r0 + rg] = cav[vt][rg];
                *(float4*)(RO0 + (size_t)item * 64 * 64 + cfrag_off(v, r0, 4)) = make_float4(cov[vt][0], cov[vt][1], cov[vt][2], cov[vt][3]);
                *(float4*)(RS0 + (size_t)item * 64 * 64 + cfrag_off(v, r0, 4)) = make_float4(ckv[vt][0], ckv[vt][1], ckv[vt][2], ckv[vt][3]);
            }
        }
        __syncthreads();
        {
            const int col = ht >> 1, p = ht & 1, cc = col & 63; const bool isu = col >= 64;
            float xs[32];
#pragma unroll
            for (int i = 0; i < 32; ++i) xs[i] = 0.f;
            float4 mc[8], mn[8];
#pragma unroll
            for (int q = 0; q < 8; ++q) { mc[q] = make_float4(0.f, 0.f, 0.f, 0.f); mn[q] = mc[q]; }
            float rhs_n; { const float rv = RHS2[(isu ? cc : 0) * 65], av = bf2f(AT[(isu ? 0 : cc)]); rhs_n = isu ? rv : av; }
#pragma unroll
            for (int i = 0; i < 64; ++i) {
                const float rhs = rhs_n;
                if (i + 1 < 64) {
#pragma unroll
                    for (int q = 0; q < (i + 8) / 8; ++q) mn[q] = *(const float4*)(AAB + (i + 1) * 64 + 8 * q + 4 * p);
                    const float rv = RHS2[(isu ? cc : 0) * 65 + i + 1], av = bf2f(AT[(i + 1) * 72 + (isu ? 0 : cc)]); rhs_n = isu ? rv : av;
                }
                float a0 = 0.f, a1 = 0.f, a2 = 0.f, a3 = 0.f;
#pragma unroll
                for (int q = 0; q < (i + 7) / 8; ++q) { a0 += mc[q].x * xs[4 * q]; a1 += mc[q].y * xs[4 * q + 1]; a2 += mc[q].z * xs[4 * q + 2]; a3 += mc[q].w * xs[4 * q + 3]; }
                float tot = (a0 + a1) + (a2 + a3);
                tot += dpp_xor1(tot);
                const float xi = rhs + tot;
                const int g = i >> 2, slot = (g >> 1) * 4 + (i & 3);
                xs[slot] = (p == (g & 1)) ? xi : xs[slot];
#pragma unroll
                for (int q = 0; q < 8; ++q) mc[q] = mn[q];
                asm volatile("" ::: "memory");
            }
            if (isu) {
                float* up = RX0 + (size_t)item * 64 * 64;
#pragma unroll
                for (int q = 0; q < 8; ++q) *(float4*)(up + cfrag_off(cc, 4 * (2 * q + p), 4)) = make_float4(xs[4 * q], xs[4 * q + 1], xs[4 * q + 2], xs[4 * q + 3]);
            }
            __syncthreads();
            if (!isu) {
#pragma unroll
                for (int q = 0; q < 8; ++q)
#pragma unroll
                    for (int e = 0; e < 4; ++e) AT[(4 * (2 * q + p) + e) * 72 + cc] = f2bf(xs[4 * q + e]);
            }
        }
        __syncthreads();
        {
            bf16* wp = RA1 + (size_t)item * 64 * 64;
#pragma unroll
            for (int q = 0; q < 2; ++q) { const int p = ht + 256 * q, fr = p & 15, fq = (p >> 4) & 3, kb = (p >> 6) & 1, rt = p >> 7;
                *(uint4*)(wp + p * 8) = *(const uint4*)(AT + (rt * 16 + fr) * 72 + kb * 32 + fq * 8); }
        }
    }
}

template <int DK, bool RW>
struct ScanArgs { const bf16* A1; const float* X0; const bf16* A2; const bf16* A3; const float* O0; const bf16* A4; const float* S0; const float* DSC; float* OUT; int item0; int vs; int tok0; int ocol0; };
#define LBAR() do { asm volatile("s_waitcnt lgkmcnt(0)" ::: "memory"); __builtin_amdgcn_s_barrier(); asm volatile("" ::: "memory"); } while (0)
template <int DK, bool RW>
__device__ __forceinline__ void scan_run(const Ctx& c, const ScanArgs<DK, RW>& a) {
    constexpr int KB = DK / 32;
    constexpr int NST = DK / 64;
    constexpr int NV = RW ? 64 : 128;
    constexpr int SROW = DK + 8;
    bf16* ST = (bf16*)c.lds;
    bf16* XT = ST + 2 * 32 * SROW;
    const int lane = c.lane, w = c.wave, fr = lane & 15, fq = lane >> 4;
    const int tm = w >> 1, tn = w & 1;
    const int dkt = (NST == 2) ? w : (w >> 1);
    for (int i = c.tid; i < 32 * SROW / 2; i += NTHREADS) ((unsigned*)ST)[i] = 0u;
    f32x4_t accS[NST];
#pragma unroll
    for (int s = 0; s < NST; ++s) accS[s] = (f32x4_t){0.f, 0.f, 0.f, 0.f};
    bf16x8_t a1f[KB], a2f[KB], a3f[2], a4f[2]; f32x4_t x0v, o0v, s0v[NST], dscv;
#define SCAN_LOAD(IT) do { const size_t it_ = (size_t)(IT); \
        _Pragma("unroll") for (int kb = 0; kb < KB; ++kb) { a1f[kb] = *(const bf16x8_t*)(a.A1 + it_ * 64 * DK + ((tm * KB + kb) * 64 + lane) * 8); a2f[kb] = *(const bf16x8_t*)(a.A2 + it_ * 64 * DK + ((tm * KB + kb) * 64 + lane) * 8); } \
        _Pragma("unroll") for (int kb = 0; kb < 2; ++kb) { a3f[kb] = *(const bf16x8_t*)(a.A3 + it_ * 64 * 64 + ((tm * 2 + kb) * 64 + lane) * 8); a4f[kb] = *(const bf16x8_t*)(a.A4 + it_ * DK * 64 + ((dkt * 2 + kb) * 64 + lane) * 8); } \
        x0v = *(const f32x4_t*)(a.X0 + it_ * NV * 64 + (((a.vs * 2 + tn) * 4 + tm) * 64 + lane) * 4); \
        if (RW) { o0v = *(const f32x4_t*)(a.O0 + it_ * NV * 64 + (((a.vs * 2 + tn) * 4 + tm) * 64 + lane) * 4); \
                  _Pragma("unroll") for (int s = 0; s < NST; ++s) s0v[s] = *(const f32x4_t*)(a.S0 + it_ * 64 * DK + (((a.vs * 2 + (NST == 2 ? s : tn)) * (DK / 16) + dkt) * 64 + lane) * 4); \
                  dscv = *(const f32x4_t*)(a.DSC + it_ * DK + dkt * 16 + 4 * fq); } \
        else { const float g_ = a.DSC[it_]; dscv = (f32x4_t){g_, g_, g_, g_}; o0v = (f32x4_t){0.f, 0.f, 0.f, 0.f}; _Pragma("unroll") for (int s = 0; s < NST; ++s) s0v[s] = (f32x4_t){0.f, 0.f, 0.f, 0.f}; } \
    } while (0)
    SCAN_LOAD(a.item0);
    int cur = 0;
    for (int n = 0; n < 64; ++n) {
        bf16x8_t b1[KB], b2[KB], b3[2], b4[2];
#pragma unroll
        for (int kb = 0; kb < KB; ++kb) { b1[kb] = a1f[kb]; b2[kb] = a2f[kb]; }
        b3[0] = a3f[0]; b3[1] = a3f[1]; b4[0] = a4f[0]; b4[1] = a4f[1];
        f32x4_t accX = x0v, accO = o0v; const f32x4_t dv = dscv; f32x4_t sv[NST];
#pragma unroll
        for (int s = 0; s < NST; ++s) sv[s] = s0v[s];
        if (n + 1 < 64) SCAN_LOAD(a.item0 + n + 1);
        LBAR();
        const bf16* Sc = ST + cur * 32 * SROW; bf16* Sn = ST + (cur ^ 1) * 32 * SROW;
        bf16x8_t sf[KB];
#pragma unroll
        for (int kb = 0; kb < KB; ++kb) sf[kb] = *(const bf16x8_t*)(Sc + (tn * 16 + fr) * SROW + kb * 32 + fq * 8);
#pragma unroll
        for (int kb = 0; kb < KB; ++kb) accX = MFMA16(b1[kb], sf[kb], accX);
        { uint2 wv; wv.x = pk2(accX[0], accX[1]); wv.y = pk2(accX[2], accX[3]); *(uint2*)(XT + (tn * 16 + fr) * 72 + tm * 16 + 4 * fq) = wv; }
#pragma unroll
        for (int kb = 0; kb < KB; ++kb) accO = MFMA16(b2[kb], sf[kb], accO);
        LBAR();
        bf16x8_t xf[2];
#pragma unroll
        for (int kb = 0; kb < 2; ++kb) xf[kb] = *(const bf16x8_t*)(XT + (tn * 16 + fr) * 72 + kb * 32 + fq * 8);
        accO = MFMA16(b3[0], xf[0], accO); accO = MFMA16(b3[1], xf[1], accO);
        {
            float* op = a.OUT + (size_t)(a.tok0 + n * 64 + tm * 16 + 4 * fq) * 1024 + a.ocol0 + tn * 16 + fr;
            op[0] = accO[0]; op[1024] = accO[1]; op[2048] = accO[2]; op[3072] = accO[3];
        }
#pragma unroll
        for (int s = 0; s < NST; ++s) {
            const int vt = (NST == 2) ? s : tn;
            bf16x8_t xg[2];
            if (vt == tn) { xg[0] = xf[0]; xg[1] = xf[1]; }
            else {
#pragma unroll
                for (int kb = 0; kb < 2; ++kb) xg[kb] = *(const bf16x8_t*)(XT + (vt * 16 + fr) * 72 + kb * 32 + fq * 8);
            }
            f32x4_t t = accS[s] * dv + sv[s];
            t = MFMA16(b4[0], xg[0], t); t = MFMA16(b4[1], xg[1], t);
            accS[s] = t;
            uint2 wv; wv.x = pk2(t[0], t[1]); wv.y = pk2(t[2], t[3]);
            *(uint2*)(Sn + (vt * 16 + fr) * SROW + dkt * 16 + 4 * fq) = wv;
        }
        cur ^= 1;
    }
#undef SCAN_LOAD
    __syncthreads();
}

__device__ __forceinline__ void ph_scan(const Ctx& c) {
    for (int wk = blockIdx.x; wk < 256; wk += gridDim.x) {
        const int xcd = wk & 7, j = wk >> 3;
        if (j < 16) {
            const int pair = xcd * 4 + (j >> 2), vs = j & 3, b = pair >> 3, h = pair & 7;
            ScanArgs<128, false> a{c.ws<bf16>(WS_GA1), c.ws<float>(WS_GX0), c.ws<bf16>(WS_GA2), c.ws<bf16>(WS_GA3), nullptr, c.ws<bf16>(WS_GA4), nullptr, c.ws<float>(WS_GGL),
                                   c.ws<float>(WS_OG), pair * 64, vs, b * SEQ, h * 128 + vs * 32};
            scan_run<128, false>(c, a);
        } else {
            const int pair = xcd * 8 + ((j - 16) >> 1), vs = (j - 16) & 1, b = pair >> 4, h = pair & 15;
            ScanArgs<64, true> a{c.ws<bf16>(WS_RA1), c.ws<float>(WS_RX0), c.ws<bf16>(WS_RA2), c.ws<bf16>(WS_RA3), c.ws<float>(WS_RO0), c.ws<bf16>(WS_RA4), c.ws<float>(WS_RS0), c.ws<float>(WS_RDSC),
                                 c.ws<float>(WS_ORW), pair * 64, vs, b * SEQ, h * 64 + vs * 32};
            scan_run<64, true>(c, a);
        }
    }
}

enum { PH_RMS0 = 0, PH_INPROJ, PH_GCL, PH_LORA, PH_RCL, PH_SCAN, PH_POST, PH_G2, PH_X1, PH_ROUTER, PH_DISPATCH, PH_MOE1, PH_MOE2, PH_COMBINE, PH_COUNT };

template <unsigned PHMASK>
__global__ void __launch_bounds__(NTHREADS) mk(Params P) {
    extern __shared__ __attribute__((aligned(16))) unsigned char lds[];
    volatile LAS unsigned* misc = (volatile LAS unsigned*)((LAS unsigned char*)lds + MISC_OFF);
    if (threadIdx.x < 64) misc[threadIdx.x] = 0u;
    __syncthreads();
    unsigned* ctl = (unsigned*)(P.ws + WS_CTL);
    XcdBarrier bar = xcd_barrier_post(ctl + CW_BAR + P.li * XCD_BAR_WORDS, misc);
#define MKCTX() int tv_ = threadIdx.x; asm volatile("" : "+v"(tv_)); const int wv_ = __builtin_amdgcn_readfirstlane(tv_ >> 6); \
    Ctx c{P, tv_, tv_ & 63, wv_, (int)(blockIdx.x * NWAVES + wv_), (int)(gridDim.x * NWAVES), (size_t)blockIdx.x * NTHREADS + tv_, (size_t)gridDim.x * NTHREADS, lds}
    bool first_seam = true;
#define IN(k) (((PHMASK >> (k)) & 1u) && P.ph_lo <= (k) && (k) < P.ph_hi)
#define SEAM(k) do { if ((k) + 1 < P.ph_hi) { if (first_seam && P.coop) { cg::this_grid().sync(); } else xcd_barrier(bar); first_seam = false; } } while (0)
#define REP(k) for (int rep_ = 0; rep_ < ((k) == PROBE_REP ? 2 : 1); ++rep_)
    if (IN(PH_RMS0)) { MKCTX();
        REP(PH_RMS0) {
        ph_rms0(c);
        { WJob j{P.in[I_W_IN], NCOL_IN, 1024, 4096, c.ws<bf16>(WS_WIN_T), 1024, 1, 0, 0}; wconv_job(c, j); }
        { WJob j{P.in[I_W_IN] + 4112, NCOL_IN, 1024, 5376, c.ws<bf16>(WS_WIN_T) + (size_t)4096 * 1024, 1024, 1, 0, 0}; wconv_job(c, j); }
        lora_zero(c);
        { WJob j{P.in[I_W2], 1024, 64, 1024, c.ws<bf16>(WS_LORA_T), 256, 1, 0, 0}; wconv_job(c, j); }
        { WJob j{P.in[I_A2], 1024, 64, 1024, c.ws<bf16>(WS_LORA_T) + (size_t)1024 * 256 + 64, 256, 1, 0, 0}; wconv_job(c, j); }
        { WJob j{P.in[I_G2], 1024, 128, 1024, c.ws<bf16>(WS_LORA_T) + (size_t)2048 * 256 + 128, 256, 1, 0, 0}; wconv_job(c, j); }
        }
        SEAM(PH_RMS0);
    }
    if (IN(PH_INPROJ)) { MKCTX();
        REP(PH_INPROJ) {
        EpiInProj ep{c.ws<bf16>(WS_GQKV), c.ws<bf16>(WS_ZS), c.ws<bf16>(WS_RKV), c.ws<float>(WS_LIN), c.ws<bf16>(WS_GATES)};
        SchedInProj sc{(const char*)c.ws<bf16>(WS_HB), (const char*)c.ws<bf16>(WS_WIN_T), (int)gridDim.x, (int)blockIdx.x};
        pg8::gemm_phase((LAS unsigned char*)lds, 1024, sc, ep, c.tid);
        }
        SEAM(PH_INPROJ);
    }
    if (IN(PH_GCL)) { MKCTX(); REP(PH_GCL) { ph_gcl(c); ph_loraprep(c); } SEAM(PH_GCL); }
    if (IN(PH_LORA)) { MKCTX();
        REP(PH_LORA) {
        EpiLora ep{P.in[I_W0], P.in[I_A0], c.ws<float>(WS_LW), c.ws<float>(WS_AA), c.ws<bf16>(WS_GGR)};
        SchedLora sc{(const char*)c.ws<bf16>(WS_ALORA), (const char*)c.ws<bf16>(WS_LORA_T), (int)gridDim.x, (int)blockIdx.x};
        pg8::gemm_phase((LAS unsigned char*)lds, 256, sc, ep, c.tid);
        }
        SEAM(PH_LORA);
    }
    if (IN(PH_RCL)) { MKCTX(); REP(PH_RCL) { ph_rcl(c); } SEAM(PH_RCL); }
    if (IN(PH_SCAN)) { MKCTX(); REP(PH_SCAN) { ph_scan(c); } SEAM(PH_SCAN); }
    if (IN(PH_POST)) { MKCTX();
        REP(PH_POST) {
        ph_post(c);
        { WJob j{P.in[I_PROJ_A], 1024, 1024, 1024, c.ws<bf16>(WS_PROJ_T), 1024, 1, 0, 0}; wconv_job(c, j); }
        { WJob j{P.in[I_PROJ_B], 1024, 1024, 1024, c.ws<bf16>(WS_PROJ_T) + (size_t)1024 * 1024, 1024, 1, 0, 0}; wconv_job(c, j); }
        { WJob j{P.in[I_W_OUT], 1024, 1024, 1024, c.ws<bf16>(WS_WOUT_T), 1024, 1, 0, 0}; wconv_job(c, j); }
        }
        SEAM(PH_POST);
    }
    if (IN(PH_G2)) { MKCTX();
        REP(PH_G2) {
        EpiG2 ep{c.ws<bf16>(WS_GATES), c.ws<bf16>(WS_G2)};
        SchedG2 sc{(const char*)c.ws<bf16>(WS_YA), (const char*)c.ws<bf16>(WS_PROJ_T), (int)gridDim.x, (int)blockIdx.x};
        pg8::gemm_phase((LAS unsigned char*)lds, 1024, sc, ep, c.tid);
        }
        SEAM(PH_G2);
    }
    if (IN(PH_X1)) { MKCTX();
        REP(PH_X1) {
        EpiX1 ep{P.in[I_X], c.ws<float>(WS_X1)};
        SchedX1 sc{(const char*)c.ws<bf16>(WS_G2), (const char*)c.ws<bf16>(WS_WOUT_T), (int)gridDim.x, (int)blockIdx.x};
        pg8::gemm_phase((LAS unsigned char*)lds, 1024, sc, ep, c.tid);
        }
        SEAM(PH_X1);
    }
    if (IN(PH_ROUTER)) { MKCTX();
        ph_router(c);
        REP(PH_ROUTER) {
        { WJob j{P.in[I_W_GU], 2048, 1024, 2048, c.ws<bf16>(WS_WGU_T), 1024, 32, (size_t)1024 * 2048, (size_t)2048 * 1024}; wconv_job(c, j); }
        { WJob j{P.in[I_W_DOWN], 1024, 1024, 1024, c.ws<bf16>(WS_WDN_T), 1024, 32, (size_t)1024 * 1024, (size_t)1024 * 1024}; wconv_job(c, j); }
        }
        SEAM(PH_ROUTER);
    }
    if (IN(PH_DISPATCH)) { MKCTX(); REP(PH_DISPATCH) { ph_dispatch(c); } SEAM(PH_DISPATCH); }
    if (IN(PH_MOE1)) { MKCTX();
        REP(PH_MOE1) {
        const int nt = *c.ws<int>(WS_NT);
        EpiAct ep{P.in[I_B_GU], c.ws<bf16>(WS_ACT)};
        SchedMoe sc{(const char*)c.ws<bf16>(WS_H2), (const char*)c.ws<bf16>(WS_WGU_T), c.ws<int>(WS_TILE_E), c.ws<int>(WS_SLOT_TOK), nt, 8, (int)gridDim.x, (int)blockIdx.x};
        pg8::gemm_phase_t<true>((LAS unsigned char*)lds, 1024, sc, ep, c.tid);
        }
        SEAM(PH_MOE1);
    }
    if (IN(PH_MOE2)) { MKCTX();
        REP(PH_MOE2) {
        const int nt = *c.ws<int>(WS_NT);
        EpiYS ep{P.in[I_B_DOWN], c.ws<float>(WS_SGATE), c.ws<bf16>(WS_YS)};
        SchedMoe sc{(const char*)c.ws<bf16>(WS_ACT), (const char*)c.ws<bf16>(WS_WDN_T), c.ws<int>(WS_TILE_E), nullptr, nt, 4, (int)gridDim.x, (int)blockIdx.x};
        pg8::gemm_phase((LAS unsigned char*)lds, 1024, sc, ep, c.tid);
        }
        SEAM(PH_MOE2);
    }
    if (IN(PH_COMBINE)) { MKCTX(); REP(PH_COMBINE) { ph_combine(c); } }
#undef IN
#undef SEAM
#undef REP
#undef MKCTX
}

template <unsigned M> static void launch_one(const Params& p, int grid, hipStream_t stream) {
    static bool attr = false;
    if (!attr) { (void)hipFuncSetAttribute((const void*)mk<M>, hipFuncAttributeMaxDynamicSharedMemorySize, LDS_BYTES); attr = true; }
    hipLaunchKernelGGL(mk<M>, dim3(grid), dim3(NTHREADS), LDS_BYTES, stream, p);
}
template <int PH> static void launch_chain(Params& p, int grid, hipStream_t stream) {
    if constexpr (PH < PH_COUNT) { p.ph_lo = PH; p.ph_hi = PH + 1; p.li = 0; p.coop = 0; launch_one<(1u << PH)>(p, grid, stream); launch_chain<PH + 1>(p, grid, stream); }
}

extern "C" void kernel_launch(void* const* d_in, const int* in_sizes, int n_in, void* d_out, int out_size, void* d_ws, size_t ws_size, hipStream_t stream) {
    static int grid = 0;
    if (grid == 0) {
        int dev = 0, cus = 0, per_cu = 0;
        (void)hipGetDevice(&dev);
        (void)hipDeviceGetAttribute(&cus, hipDeviceAttributeMultiprocessorCount, dev);
#if MK_ONE_LAUNCH
        (void)hipFuncSetAttribute((const void*)mk<0xffffffffu>, hipFuncAttributeMaxDynamicSharedMemorySize, LDS_BYTES);
        (void)hipOccupancyMaxActiveBlocksPerMultiprocessor(&per_cu, (const void*)mk<0xffffffffu>, NTHREADS, LDS_BYTES);
#else
        per_cu = 1;
#endif
        if (n_in != 29 || ws_size < WS_END || per_cu < 1 || cus < 64) { fprintf(stderr, "kernel_launch: unexpected setup n_in %d ws %zu per_cu %d cus %d\n", n_in, ws_size, per_cu, cus); grid = -1; return; }
        grid = cus;
    }
    if (grid < 0) return;
    (void)hipMemsetAsync((char*)d_ws + WS_CTL, 0, CTL_BYTES, stream);
    Params p{};
    for (int i = 0; i < 29; ++i) p.in[i] = (const float*)d_in[i];
    p.out = (float*)d_out; p.ws = (unsigned char*)d_ws;
#if MK_ONE_LAUNCH
    p.ph_lo = 0; p.ph_hi = PH_COUNT; p.li = 0; p.coop = 1;
    void* args[] = {&p};
    hipError_t e = hipLaunchCooperativeKernel((const void*)mk<0xffffffffu>, dim3(grid), dim3(NTHREADS), args, LDS_BYTES, stream);
    if (e != hipSuccess) fprintf(stderr, "cooperative launch failed: %s (grid %d)\n", hipGetErrorString(e), grid);
#else
    launch_chain<0>(p, grid, stream);
#endif
}
```

```cpp
#include <hip/hip_runtime.h>
#include <hip/hip_cooperative_groups.h>
#include <cstdint>
#include <cstdio>
namespace cg = cooperative_groups;

#ifndef MK_ONE_LAUNCH
#define MK_ONE_LAUNCH 1
#endif

#define LAS __attribute__((address_space(3)))
#ifndef FAST_INPROJ
#define FAST_INPROJ 1
#endif
#ifndef FAST_MIX
#define FAST_MIX 1
#endif
#define PROBE_REP -1
constexpr int NTHREADS = 512;
constexpr int NWAVES = 8;
constexpr int LDS_BYTES = 155648;
constexpr int MISC_OFF = 153600;

constexpr int T = 16384, SEQ = 4096, D = 1024;
constexpr int NCOL_IN = 9488;
constexpr int NEXP = 32;
constexpr int MAXTILES = 288;
constexpr int MAXSLOTS = MAXTILES * 256;

enum { I_X = 0, I_NORM_MIX, I_W_IN, I_GDN_CONV, I_GDN_ALOG, I_GDN_DTB, I_GDN_NORM, I_MU, I_W0, I_W2, I_A0, I_A2, I_G2, I_KK, I_KA, I_RK,
       I_LNW, I_LNB, I_PROJ_A, I_PROJ_B, I_W_OUT, I_NORM_FFN, I_ROUTER_W, I_ROUTER_B, I_W_GU, I_B_GU, I_W_DOWN, I_B_DOWN, I_NORM_FINAL };

constexpr size_t MiB = 1u << 20;
constexpr size_t WS_CTL = 0, CTL_BYTES = 65536;
constexpr size_t WS_BETA = 1 * MiB;
constexpr size_t WS_GG = WS_BETA + 512 * 1024;
constexpr size_t WS_SC = 2 * MiB;
constexpr size_t WS_TE = 3 * MiB;
constexpr size_t WS_TG = WS_TE + 256 * 1024;
constexpr size_t WS_TP = WS_TG + 256 * 1024;
constexpr size_t WS_TSLOT = WS_TP + 256 * 1024;
constexpr size_t WS_SGATE = 4 * MiB;
constexpr size_t WS_SLOT_TOK = 4 * MiB + 512 * 1024;
constexpr size_t WS_TILE_E = 5 * MiB;
constexpr size_t WS_NT = WS_TILE_E + 4096;
constexpr size_t WS_HB = 8 * MiB;
constexpr size_t WS_H2 = WS_HB;
constexpr size_t WS_ZS = 40 * MiB;
constexpr size_t WS_GATES = 72 * MiB;
constexpr size_t WS_ALORA = 136 * MiB;
constexpr size_t WS_LW = 144 * MiB;
constexpr size_t WS_AA = 208 * MiB;
constexpr size_t WS_GGR = 272 * MiB;
constexpr size_t WS_VP = 304 * MiB;
constexpr size_t WS_Q = 336 * MiB;
constexpr size_t WS_QKVC = WS_Q;
constexpr size_t WS_RP = WS_Q, WS_KF = WS_Q + 64 * MiB, WS_KKN = WS_Q + 128 * MiB;
constexpr size_t WS_YA = WS_Q, WS_YB = WS_Q + 32 * MiB, WS_G2 = WS_Q + 64 * MiB, WS_X1 = WS_Q + 128 * MiB;
constexpr size_t WS_GQKV = 528 * MiB;
constexpr size_t WS_OG = 720 * MiB, WS_ORW = 784 * MiB;
constexpr size_t WS_RKV = 720 * MiB;
constexpr size_t WS_LIN = 912 * MiB;
constexpr size_t WS_DEC = 928 * MiB;
constexpr size_t WS_XB = 528 * MiB;
constexpr size_t WS_ACT = 672 * MiB;
constexpr size_t WS_YS = 816 * MiB;
constexpr size_t WS_WIN_T = 992 * MiB;
constexpr size_t WS_PROJ_T = 144 * MiB;
constexpr size_t WS_WOUT_T = 148 * MiB;
constexpr size_t WS_WGU_T = 72 * MiB;
constexpr size_t WS_WDN_T = 200 * MiB;
constexpr size_t WS_GA1 = 336 * MiB, WS_GX0 = 368 * MiB, WS_GA2 = 432 * MiB, WS_GA3 = 464 * MiB, WS_GA4 = 480 * MiB;
constexpr size_t WS_GGL = 6 * MiB;
constexpr size_t WS_RX0 = 528 * MiB, WS_RO0 = 592 * MiB, WS_RS0 = 656 * MiB;
constexpr size_t WS_RA1 = 8 * MiB, WS_RA2 = 928 * MiB, WS_RA3 = 960 * MiB, WS_RA4 = 992 * MiB;
constexpr size_t WS_RDSC = 7 * MiB;
constexpr size_t WS_LORA_T = 1012 * MiB;
constexpr size_t WS_END = 1024 * MiB;
constexpr int CW_BAR = 1024;
constexpr int CW_CNT = 256;

#define XB_TMO      128
#define XB_XCNT(j)  (256  + 64 * (j))
#define XB_XSUB(j)  (1280 + 64 * (j))
#define XB_XGEN(j)  (2304 + 64 * (j))
#define XB_TOP      3328
#define XB_TOPGEN   3392
#define XCD_BAR_WORDS 3456
#define XB_SPIN_CAP (1u << 24)
__device__ __forceinline__ unsigned xb_ld(unsigned* p)              { return __hip_atomic_load(p, __ATOMIC_RELAXED, __HIP_MEMORY_SCOPE_AGENT); }
__device__ __forceinline__ unsigned xb_add(unsigned* p, unsigned v) { return __hip_atomic_fetch_add(p, v, __ATOMIC_RELAXED, __HIP_MEMORY_SCOPE_AGENT); }
__device__ __forceinline__ unsigned xb_xcc_id() { return (unsigned)__builtin_amdgcn_s_getreg((3 << 11) | 20) & 0xFu; }
#define XB_SPIN(cond, bar) do { unsigned _sp = 0; while (cond) { __builtin_amdgcn_s_sleep(1); \
    if ((++_sp & 255u) == 0u) { if (xb_ld(&(bar)[XB_TMO])) break; if (_sp > XB_SPIN_CAP) { atomicAdd(&(bar)[XB_TMO], 1u); break; } } } } while (0)
struct XcdBarrier { unsigned* bar; unsigned x; volatile LAS unsigned* st; };
__device__ __forceinline__ XcdBarrier xcd_barrier_post(unsigned* bar, volatile LAS unsigned* st) {
    XcdBarrier b; b.bar = bar; b.x = xb_xcc_id(); b.st = st;
    if (threadIdx.x == 0) (void)xb_add(&bar[XB_XCNT(b.x)], 1u);
    return b;
}
__device__ __forceinline__ void xcd_barrier_complete(unsigned* bar, unsigned x, unsigned& nloc, unsigned& nx) {
    const unsigned G = gridDim.x * gridDim.y * gridDim.z;
    unsigned sum, cnt, mine, sp = 0u;
    for (;;) {
        sum = 0u; cnt = 0u; mine = 0u;
#pragma unroll
        for (unsigned j = 0; j < 16; ++j) { const unsigned c = xb_ld(&bar[XB_XCNT(j)]); sum += c; cnt += (c > 0u) ? 1u : 0u; mine = (j == x) ? c : mine; }
        if (sum == G) break;
        __builtin_amdgcn_s_sleep(1);
        if ((++sp & 255u) == 0u) { if (xb_ld(&bar[XB_TMO])) break; if (sp > XB_SPIN_CAP) { atomicAdd(&bar[XB_TMO], 1u); break; } }
    }
    nloc = mine > 0u ? mine : 1u; nx = cnt > 0u ? cnt : 1u;
}
__device__ __forceinline__ void xcd_barrier(const XcdBarrier& b) {
    asm volatile("s_waitcnt vmcnt(0)" ::: "memory");
    __syncthreads();
    if (threadIdx.x == 0) {
        unsigned* bar = b.bar;
        __builtin_amdgcn_s_waitcnt(0);
        unsigned nloc = b.st[0], nx = b.st[1];
        if (nloc == 0u) { xcd_barrier_complete(bar, b.x, nloc, nx); b.st[0] = nloc; b.st[1] = nx; }
        const unsigned old = xb_add(&bar[XB_XSUB(b.x)], 1u);
        const unsigned gen = old / nloc;
        if (old + 1u == (gen + 1u) * nloc) {
            __builtin_amdgcn_fence(__ATOMIC_RELEASE, "agent");
            asm volatile("s_waitcnt vmcnt(0)" ::: "memory");
            const unsigned og = xb_add(&bar[XB_TOP], 1u);
            const unsigned tg = og / nx;
            if (og + 1u == (tg + 1u) * nx) xb_add(&bar[XB_TOPGEN], 1u);
            else XB_SPIN(xb_ld(&bar[XB_TOPGEN]) == tg, bar);
            __builtin_amdgcn_fence(__ATOMIC_ACQUIRE, "agent");
            xb_add(&bar[XB_XGEN(b.x)], 1u);
            asm volatile("s_waitcnt vmcnt(0)" ::: "memory");
        } else {
            XB_SPIN(xb_ld(&bar[XB_XGEN(b.x)]) == gen, bar);
            __builtin_amdgcn_fence(__ATOMIC_ACQUIRE, "agent");
            asm volatile("s_waitcnt vmcnt(0)" ::: "memory");
        }
    }
    __syncthreads();
}

typedef unsigned short bf16;
__device__ __forceinline__ bf16 f2bf(float f) { unsigned u = __float_as_uint(f); u += 0x7fffu + ((u >> 16) & 1u); return (bf16)(u >> 16); }
__device__ __forceinline__ float bf2f(unsigned b) { return __uint_as_float(b << 16); }
__device__ __forceinline__ unsigned pk2(float lo, float hi) { return (unsigned)f2bf(lo) | ((unsigned)f2bf(hi) << 16); }
__device__ __forceinline__ float bflo(unsigned w) { return __uint_as_float(w << 16); }
__device__ __forceinline__ float bfhi(unsigned w) { return __uint_as_float(w & 0xffff0000u); }
__device__ __forceinline__ float sigm(float x) { return 1.f / (1.f + expf(-x)); }
__device__ __forceinline__ float fsigm(float x) { return __builtin_amdgcn_rcpf(1.f + __expf(-x)); }
__device__ __forceinline__ float softplusf(float x) { return x > 20.f ? x : log1pf(expf(x)); }
__device__ __forceinline__ float dpp_xor1(float v) { return __int_as_float(__builtin_amdgcn_update_dpp(0, __float_as_int(v), 0xB1, 0xF, 0xF, false)); }
__device__ __forceinline__ float wsum(float v) {
#pragma unroll
    for (int o = 32; o > 0; o >>= 1) v += __shfl_xor(v, o);
    return v;
}

struct Params { const float* in[29]; float* out; unsigned char* ws; int ph_lo, ph_hi, li, coop; };

struct Ctx {
    const Params& P; int tid, lane, wave, gwave, nwaves; size_t gtid, nthreads; unsigned char* lds;
    template <class Tp> __device__ __forceinline__ Tp* ws(size_t off) const { return (Tp*)(P.ws + off); }
};

__device__ __forceinline__ void ph_rms0(const Ctx& c) {
    const float* x = c.P.in[I_X]; const float* nw = c.P.in[I_NORM_MIX]; const float* win = c.P.in[I_W_IN];
    const float* alog = c.P.in[I_GDN_ALOG]; const float* dtb = c.P.in[I_GDN_DTB];
    bf16* HB = c.ws<bf16>(WS_HB); float* BETA = c.ws<float>(WS_BETA); float* GGv = c.ws<float>(WS_GG);
    if (blockIdx.x == 0 && c.tid < NEXP) c.ws<unsigned>(WS_CTL)[CW_CNT + c.tid] = 0u;
    float4* tab = (float4*)c.lds;
    __syncthreads();
    for (int i = c.tid; i < 4096; i += NTHREADS) { const int k = i >> 2; tab[((k & 3) * 256 + (k >> 2)) * 5 + (i & 3)] = *(const float4*)(win + (size_t)k * NCOL_IN + 4096 + (i & 3) * 4); }
    __syncthreads();
    const int lane = c.lane;
    for (int t = c.gwave; t < T; t += c.nwaves) {
        float4 v[4]; float ss = 0.f;
#pragma unroll
        for (int i = 0; i < 4; ++i) { v[i] = ((const float4*)(x + (size_t)t * D))[lane + 64 * i]; ss += v[i].x * v[i].x + v[i].y * v[i].y + v[i].z * v[i].z + v[i].w * v[i].w; }
        ss = wsum(ss);
        const float rstd = rsqrtf(ss * (1.f / 1024.f) + 1e-6f);
        float acc[16];
#pragma unroll
        for (int j = 0; j < 16; ++j) acc[j] = 0.f;
#pragma unroll
        for (int i = 0; i < 4; ++i) {
            const float4 w4 = ((const float4*)nw)[lane + 64 * i];
            float h[4] = {v[i].x * rstd * w4.x, v[i].y * rstd * w4.y, v[i].z * rstd * w4.z, v[i].w * rstd * w4.w};
            uint2 st; st.x = pk2(h[0], h[1]); st.y = pk2(h[2], h[3]);
            *(uint2*)(HB + (size_t)t * D + 4 * (lane + 64 * i)) = st;
#pragma unroll
            for (int ii = 0; ii < 4; ++ii) {
                const int k = 4 * (lane + 64 * i) + ii;
#pragma unroll
                for (int q = 0; q < 4; ++q) { const float4 w = tab[(ii * 256 + (k >> 2)) * 5 + q]; acc[4 * q + 0] += h[ii] * w.x; acc[4 * q + 1] += h[ii] * w.y; acc[4 * q + 2] += h[ii] * w.z; acc[4 * q + 3] += h[ii] * w.w; }
                if (ii & 1) asm volatile("" ::: "memory");
            }
        }
        float mine = 0.f;
#pragma unroll
        for (int j = 0; j < 16; ++j) { const float s = wsum(acc[j]); mine = (lane == j) ? s : mine; }
        if (lane < 8) BETA[t * 8 + lane] = sigm(mine);
        else if (lane < 16) { const int h = lane - 8; GGv[t * 8 + h] = -expf(alog[h]) * softplusf(mine + dtb[h]); }
    }
    __syncthreads();
}

struct NoLd {};
struct EpiInProj {
    typedef NoLd Ld; static constexpr int MB = 1;
    bf16* GQKV; bf16* ZS; bf16* RKV; float* LIN; bf16* GATES;
    __device__ __forceinline__ void load(Ld&, int, int, int) const {}
    __device__ __forceinline__ void store8(int row, int col, const float (&v)[8], int, const Ld&) const {
        if (col < 3072) { uint4 w; w.x = pk2(v[0], v[1]); w.y = pk2(v[2], v[3]); w.z = pk2(v[4], v[5]); w.w = pk2(v[6], v[7]); *(uint4*)(GQKV + (size_t)row * 3072 + col) = w; }
        else if (col < 4096) { uint4 w; w.x = pk2(v[0] * fsigm(v[0]), v[1] * fsigm(v[1])); w.y = pk2(v[2] * fsigm(v[2]), v[3] * fsigm(v[3])); w.z = pk2(v[4] * fsigm(v[4]), v[5] * fsigm(v[5])); w.w = pk2(v[6] * fsigm(v[6]), v[7] * fsigm(v[7]));
            *(uint4*)(ZS + (size_t)row * 1024 + (col - 3072)) = w; }
        else if (col < 7168) { uint4 w; w.x = pk2(v[0], v[1]); w.y = pk2(v[2], v[3]); w.z = pk2(v[4], v[5]); w.w = pk2(v[6], v[7]); *(uint4*)(RKV + (size_t)row * 3072 + (col - 4096)) = w; }
        else if (col < 7424) { float* p = LIN + (size_t)row * 256 + (col - 7168); *(float4*)p = make_float4(v[0], v[1], v[2], v[3]); *(float4*)(p + 4) = make_float4(v[4], v[5], v[6], v[7]); }
        else { uint4 w; w.x = pk2(fsigm(v[0]), fsigm(v[1])); w.y = pk2(fsigm(v[2]), fsigm(v[3])); w.z = pk2(fsigm(v[4]), fsigm(v[5])); w.w = pk2(fsigm(v[6]), fsigm(v[7]));
            *(uint4*)(GATES + (size_t)row * 2048 + (col - 7424)) = w; }
    }
};
struct EpiG2 {
    struct Ld { uint4 g; uint4 p; }; static constexpr int MB = 1;
    const bf16* GATES; bf16* MG;
    __device__ __forceinline__ void load(Ld& l, int row, int col, int) const { l.g = *(const uint4*)(GATES + (size_t)row * 2048 + col); const uint4 q = *(const uint4*)(MG + (size_t)row * 1024 + (col & 1023)); const bool b = col >= 1024; l.p = make_uint4(b ? q.x : 0u, b ? q.y : 0u, b ? q.z : 0u, b ? q.w : 0u); }
    __device__ __forceinline__ void store8(int row, int col, const float (&v)[8], int, const Ld& l) const {
        const uint4 g = l.g, p = l.p;
        uint4 w; w.x = pk2(v[0] * bflo(g.x) + bflo(p.x), v[1] * bfhi(g.x) + bfhi(p.x)); w.y = pk2(v[2] * bflo(g.y) + bflo(p.y), v[3] * bfhi(g.y) + bfhi(p.y));
        w.z = pk2(v[4] * bflo(g.z) + bflo(p.z), v[5] * bfhi(g.z) + bfhi(p.z)); w.w = pk2(v[6] * bflo(g.w) + bflo(p.w), v[7] * bfhi(g.w) + bfhi(p.w));
        *(uint4*)(MG + (size_t)row * 1024 + (col & 1023)) = w;
    }
};
struct EpiX1 {
    struct Ld { float4 a, b; }; static constexpr int MB = 2;
    const float* X; float* X1;
    __device__ __forceinline__ void load(Ld& l, int row, int col, int) const { const float* xp = X + (size_t)row * 1024 + col; l.a = *(const float4*)xp; l.b = *(const float4*)(xp + 4); }
    __device__ __forceinline__ void store8(int row, int col, const float (&v)[8], int, const Ld& l) const {
        float* op = X1 + (size_t)row * 1024 + col;
        const float4 a = l.a, b = l.b;
        *(float4*)op = make_float4(a.x + v[0], a.y + v[1], a.z + v[2], a.w + v[3]); *(float4*)(op + 4) = make_float4(b.x + v[4], b.y + v[5], b.z + v[6], b.w + v[7]);
    }
};
struct EpiAct {
    struct Ld { float4 b0, b1; }; static constexpr int MB = 4;
    const float* BGU; bf16* ACT;
    __device__ __forceinline__ void load(Ld& l, int, int col, int e) const { const float* bp = BGU + (size_t)e * 2048 + col; l.b0 = *(const float4*)bp; l.b1 = *(const float4*)(bp + 4); }
    __device__ __forceinline__ void store8(int row, int col, const float (&v)[8], int e, const Ld& l) const {
        const float4 b0 = l.b0, b1 = l.b1;
        const float bb[8] = {b0.x, b0.y, b0.z, b0.w, b1.x, b1.y, b1.z, b1.w};
        float o[4];
#pragma unroll
        for (int p = 0; p < 4; ++p) { float glu = v[2 * p] + bb[2 * p], lin = v[2 * p + 1] + bb[2 * p + 1]; glu = fminf(glu, 7.f); lin = fminf(fmaxf(lin, -7.f), 7.f); o[p] = glu * fsigm(1.702f * glu) * (lin + 1.f); }
        uint2 w; w.x = pk2(o[0], o[1]); w.y = pk2(o[2], o[3]);
        *(uint2*)(ACT + (size_t)row * 1024 + (col >> 1)) = w;
    }
};
struct EpiYS {
    struct Ld { float4 b0, b1; float g; }; static constexpr int MB = 4;
    const float* BD; const float* SGATE; bf16* YS;
    __device__ __forceinline__ void load(Ld& l, int row, int col, int e) const { const float* bp = BD + (size_t)e * 1024 + col; l.g = SGATE[row]; l.b0 = *(const float4*)bp; l.b1 = *(const float4*)(bp + 4); }
    __device__ __forceinline__ void store8(int row, int col, const float (&v)[8], int e, const Ld& l) const {
        const float g = l.g; const float4 b0 = l.b0, b1 = l.b1;
        uint4 w; w.x = pk2((v[0] + b0.x) * g, (v[1] + b0.y) * g); w.y = pk2((v[2] + b0.z) * g, (v[3] + b0.w) * g); w.z = pk2((v[4] + b1.x) * g, (v[5] + b1.y) * g); w.w = pk2((v[6] + b1.z) * g, (v[7] + b1.w) * g);
        *(uint4*)(YS + (size_t)row * 1024 + col) = w;
    }
};


namespace pg8 {
typedef short bf16x8 __attribute__((ext_vector_type(8)));
typedef float f32x4 __attribute__((ext_vector_type(4)));
constexpr int BM = 256, BK = 64, HALF = 128, HTB = HALF * BK * 2, NXCD = 8, WGM = 8;
__host__ __device__ __forceinline__ int lds_byte(int r, int c) { const int st = (r >> 4) * 2 + (c >> 5), rr = r & 15, cc = c & 31, ob = rr * 64 + cc * 2; return st * 1024 + (ob ^ (((ob >> 9) & 1) << 5)); }
__host__ __device__ __forceinline__ void stage_rc(int b, int& R, int& C) { const int st = b / 1024, sb = b % 1024, swz = sb ^ (((sb >> 9) & 1) << 5); R = (st >> 1) * 16 + swz / 64; C = (st & 1) * 32 + (swz % 64) / 2; }
__host__ __device__ __forceinline__ int perm32(int rho) { const int n = rho >> 4, i = rho & 15; return 8 * (i >> 2) + 4 * n + (i & 3); }
struct Unit { const char* a; const char* b; const int* rowmap; int row0, col0, aux; };
__device__ __forceinline__ void tile_order(int L, int nM, int nN, int& pm, int& pn) {
    const int nwg = nM * nN; int wgid = L; { const int q = nwg / NXCD, r = nwg % NXCD, xcd = wgid % NXCD, off = wgid / NXCD; wgid = (xcd < r ? xcd * (q + 1) : r * (q + 1) + (xcd - r) * q) + off; }
    const int nig = WGM * nN, gid = wgid / nig, fm = gid * WGM, gsz = (nM - fm) < WGM ? (nM - fm) : WGM;
    pm = fm + ((wgid % nig) % gsz); pn = (wgid % nig) / gsz;
}
template <class Epi>
__device__ __forceinline__ void epi_apply(const Epi& E, const f32x4 (&acc)[2][2][4][2], const Unit& u, int wr, int wc, int fr, int fq) {
    constexpr int MB = Epi::MB;
#pragma unroll
    for (int ai = 0; ai < 2; ++ai)
#pragma unroll
        for (int mp = 0; mp < 4 / MB; ++mp) {
            typename Epi::Ld ld[MB][2];
#pragma unroll
            for (int mm = 0; mm < MB; ++mm)
#pragma unroll
                for (int bj = 0; bj < 2; ++bj) E.load(ld[mm][bj], u.row0 + ai * HALF + wr * 64 + (mp * MB + mm) * 16 + fr, u.col0 + bj * HALF + wc * 32 + 8 * fq, u.aux);
#pragma unroll
            for (int mm = 0; mm < MB; ++mm)
#pragma unroll
                for (int bj = 0; bj < 2; ++bj) {
                    const int m = mp * MB + mm;
                    const f32x4 x0 = acc[ai][bj][m][0], x1 = acc[ai][bj][m][1];
                    const float v[8] = {x0[0], x0[1], x0[2], x0[3], x1[0], x1[1], x1[2], x1[3]};
                    E.store8(u.row0 + ai * HALF + wr * 64 + m * 16 + fr, u.col0 + bj * HALF + wc * 32 + 8 * fq, v, u.aux, ld[mm][bj]);
                }
            asm volatile("" ::: "memory");
        }
}
template <bool GATHER, class Epi, class Sched>
__device__ __forceinline__ void gemm_phase_t(LAS unsigned char* lds, const int K_, const Sched& S, const Epi& E, const int tid) {
    int K = K_; asm volatile("" : "+s"(K));
    const int wid = __builtin_amdgcn_readfirstlane(tid >> 6), lane = tid & 63, wr = wid >> 2, wc = wid & 3, fr = lane & 15, fq = lane >> 4;
    const int nt = K / BK;
    unsigned voffA[2], voffB[2];
#pragma unroll
    for (int i = 0; i < 2; ++i) { int R, C; stage_rc(tid * 16 + i * 8192, R, C); const int Rb = (R & ~31) + perm32(R & 31);
        voffA[i] = (unsigned)(R * K + C) * 2u; voffB[i] = (unsigned)(Rb * K + C) * 2u; }
    const size_t kstep = (size_t)(BK * 2);
    const size_t hstep = (size_t)HALF * K * 2;
    const unsigned ldsw = (unsigned)wid * 1024u;
    const int aoff = lds_byte(wr * 64 + fr, fq * 8), boff = lds_byte(wc * 32 + fr, fq * 8);
#define PG8_SA(b, h) (((b) * 2 + (h)) * HTB)
#define PG8_SB(b, h) ((4 + (b) * 2 + (h)) * HTB)
#define PG8_STAGE(bufoff, gbase, voff) do { _Pragma("unroll") for (int _i = 0; _i < 2; ++_i) \
        __builtin_amdgcn_global_load_lds((const unsigned*)((const char*)(gbase) + (voff)[_i]), (LAS unsigned*)(lds + (bufoff) + ldsw + _i * 8192), 16, 0, 0); } while (0)
#define PG8_LDA(dst, b, h) do { _Pragma("unroll") for (int m = 0; m < 4; ++m) _Pragma("unroll") for (int k = 0; k < 2; ++k) dst[m][k] = *(const LAS bf16x8*)(lds + PG8_SA(b, h) + aoff + m * 2048 + k * 1024); } while (0)
#define PG8_LDB(dst, b, h) do { _Pragma("unroll") for (int n = 0; n < 2; ++n) _Pragma("unroll") for (int k = 0; k < 2; ++k) dst[n][k] = *(const LAS bf16x8*)(lds + PG8_SB(b, h) + boff + n * 2048 + k * 1024); } while (0)
#define PG8_MMA(ai, bj, At, Bt) do { __builtin_amdgcn_s_setprio(1); _Pragma("unroll") for (int m = 0; m < 4; ++m) _Pragma("unroll") for (int n = 0; n < 2; ++n) _Pragma("unroll") for (int k = 0; k < 2; ++k) \
        acc[ai][bj][m][n] = __builtin_amdgcn_mfma_f32_16x16x32_bf16(Bt[n][k], At[m][k], acc[ai][bj][m][n], 0, 0, 0); __builtin_amdgcn_s_setprio(0); } while (0)
#define PG8_WAIT_V(n) asm volatile("s_waitcnt vmcnt(" #n ")" ::: "memory")
#define PG8_WAIT_L(n) asm volatile("s_waitcnt lgkmcnt(" #n ")" ::: "memory")
#define PG8_BAR __builtin_amdgcn_s_barrier()
#define PG8_SCHED __builtin_amdgcn_sched_barrier(0)
    Unit cur, nxt; int ui = 0;
    if (!S.next(0, cur)) return;
    f32x4 acc[2][2][4][2];
#pragma unroll
    for (int a = 0; a < 2; ++a)
#pragma unroll
        for (int b = 0; b < 2; ++b)
#pragma unroll
            for (int m = 0; m < 4; ++m)
#pragma unroll
                for (int n = 0; n < 2; ++n) acc[a][b][m][n] = (f32x4){0.f, 0.f, 0.f, 0.f};
    bf16x8 At[4][2], B0[2][2], B1[2][2];
    const char* cA = cur.a; const char* cB = cur.b;
    unsigned oc_lo[2] = {0u, 0u}, oc_hi[2] = {0u, 0u}, on_lo[2] = {0u, 0u}, on_hi[2] = {0u, 0u};
#define PG8_ROWOFF(U, LO, HI) do { _Pragma("unroll") for (int _i = 0; _i < 2; ++_i) { int R_, C_; stage_rc(tid * 16 + _i * 8192, R_, C_); \
        LO[_i] = (unsigned)((U).rowmap[R_] * K + C_) * 2u; HI[_i] = (unsigned)((U).rowmap[R_ + 128] * K + C_) * 2u; } } while (0)
    if constexpr (GATHER) PG8_ROWOFF(cur, oc_lo, oc_hi);
    PG8_STAGE(PG8_SB(0, 0), cB, voffB);
    if constexpr (GATHER) PG8_STAGE(PG8_SA(0, 0), cA, oc_lo); else PG8_STAGE(PG8_SA(0, 0), cA, voffA);
    PG8_STAGE(PG8_SB(0, 1), cB + hstep, voffB);
    if constexpr (GATHER) PG8_STAGE(PG8_SA(0, 1), cA, oc_hi); else PG8_STAGE(PG8_SA(0, 1), cA + hstep, voffA);
    if (wr == 1) PG8_BAR;
    PG8_WAIT_V(4); PG8_BAR;
    PG8_STAGE(PG8_SB(1, 0), cB + kstep, voffB);
    if constexpr (GATHER) PG8_STAGE(PG8_SA(1, 0), cA + kstep, oc_lo); else PG8_STAGE(PG8_SA(1, 0), cA + kstep, voffA);
    PG8_STAGE(PG8_SB(1, 1), cB + hstep + kstep, voffB);
    PG8_WAIT_V(6); PG8_BAR;
    for (;;) {
        const bool has_next = S.next(ui + 1, nxt);
        const char* nA = has_next ? nxt.a : cA; const char* nB = has_next ? nxt.b : cB;
        if constexpr (GATHER) { if (has_next) PG8_ROWOFF(nxt, on_lo, on_hi); else { on_lo[0] = oc_lo[0]; on_lo[1] = oc_lo[1]; on_hi[0] = oc_hi[0]; on_hi[1] = oc_hi[1]; } }
#pragma unroll 1
        for (int t = 0; t < nt; t += 2) {
            const bool last = (t == nt - 2);
            const char* a1 = cA + (size_t)(t + 1) * kstep;
            const char* a2 = last ? nA : cA + (size_t)(t + 2) * kstep; const char* b2 = last ? nB : cB + (size_t)(t + 2) * kstep;
            const char* a3 = a2 + kstep; const char* b3 = b2 + kstep;
            unsigned o2lo[2], o2hi[2];
            o2lo[0] = last ? on_lo[0] : oc_lo[0]; o2lo[1] = last ? on_lo[1] : oc_lo[1]; o2hi[0] = last ? on_hi[0] : oc_hi[0]; o2hi[1] = last ? on_hi[1] : oc_hi[1];
            PG8_LDB(B0, 0, 0); PG8_SCHED; PG8_LDA(At, 0, 0); if constexpr (GATHER) PG8_STAGE(PG8_SA(1, 1), a1, oc_hi); else PG8_STAGE(PG8_SA(1, 1), a1 + hstep, voffA);
            PG8_WAIT_L(8); PG8_BAR; PG8_WAIT_L(0); PG8_MMA(0, 0, At, B0); PG8_BAR; PG8_SCHED;
            PG8_LDB(B1, 0, 1); PG8_STAGE(PG8_SB(0, 0), b2, voffB);
            PG8_BAR; PG8_WAIT_L(0); PG8_MMA(0, 1, At, B1); PG8_BAR;
            PG8_LDA(At, 0, 1); if constexpr (GATHER) PG8_STAGE(PG8_SA(0, 0), a2, o2lo); else PG8_STAGE(PG8_SA(0, 0), a2, voffA);
            PG8_BAR; PG8_WAIT_L(0); PG8_MMA(1, 0, At, B0); PG8_BAR; PG8_SCHED;
            PG8_STAGE(PG8_SB(0, 1), b2 + hstep, voffB);
            PG8_WAIT_V(6); PG8_BAR; PG8_MMA(1, 1, At, B1); PG8_BAR;
            PG8_LDB(B0, 1, 0); PG8_SCHED; PG8_LDA(At, 1, 0); if constexpr (GATHER) PG8_STAGE(PG8_SA(0, 1), a2, o2hi); else PG8_STAGE(PG8_SA(0, 1), a2 + hstep, voffA);
            PG8_WAIT_L(8); PG8_BAR; PG8_WAIT_L(0); PG8_MMA(0, 0, At, B0); PG8_BAR; PG8_SCHED;
            PG8_LDB(B1, 1, 1); PG8_STAGE(PG8_SB(1, 0), b3, voffB);
            PG8_BAR; PG8_WAIT_L(0); PG8_MMA(0, 1, At, B1); PG8_BAR;
            PG8_LDA(At, 1, 1); if constexpr (GATHER) PG8_STAGE(PG8_SA(1, 0), a3, o2lo); else PG8_STAGE(PG8_SA(1, 0), a3, voffA);
            PG8_BAR; PG8_WAIT_L(0); PG8_MMA(1, 0, At, B0); PG8_BAR; PG8_SCHED;
            PG8_STAGE(PG8_SB(1, 1), b3 + hstep, voffB);
            PG8_WAIT_V(6); PG8_BAR; PG8_MMA(1, 1, At, B1); PG8_BAR;
        }
        epi_apply(E, acc, cur, wr, wc, fr, fq);
        if (!has_next) break;
#pragma unroll
        for (int a = 0; a < 2; ++a)
#pragma unroll
            for (int b = 0; b < 2; ++b)
#pragma unroll
                for (int m = 0; m < 4; ++m)
#pragma unroll
                    for (int n = 0; n < 2; ++n) acc[a][b][m][n] = (f32x4){0.f, 0.f, 0.f, 0.f};
        cur = nxt; cA = nA; cB = nB; ++ui;
        if constexpr (GATHER) { oc_lo[0] = on_lo[0]; oc_lo[1] = on_lo[1]; oc_hi[0] = on_hi[0]; oc_hi[1] = on_hi[1]; }
    }
    PG8_WAIT_V(0);
    if (wr == 0) PG8_BAR;
    PG8_BAR;
#undef PG8_ROWOFF
#undef PG8_SA
#undef PG8_SB
#undef PG8_STAGE
#undef PG8_LDA
#undef PG8_LDB
#undef PG8_MMA
#undef PG8_WAIT_V
#undef PG8_WAIT_L
#undef PG8_BAR
#undef PG8_SCHED
}
template <class Epi, class Sched>
__device__ __forceinline__ void gemm_phase(LAS unsigned char* lds, const int K, const Sched& S, const Epi& E, const int tid) { gemm_phase_t<false>(lds, K, S, E, tid); }
}

struct SchedInProj { const char* A; const char* Bt; int G, c;
    __device__ __forceinline__ bool next(int i, pg8::Unit& u) const { const int L = i * G + c; if (L >= 64 * 37) return false; int pm, pn; pg8::tile_order(L, 64, 37, pm, pn);
        u.a = A + (size_t)pm * (256 * 1024 * 2); u.b = Bt + (size_t)pn * (256 * 1024 * 2); u.row0 = pm * 256; u.col0 = pn * 256; u.aux = 0; u.rowmap = nullptr; return true; } };

struct WJob { const float* src; int ld_src; int K; int ncols; bf16* dst; int ld_dst; int nb; size_t sstride, dstride; };
__device__ __forceinline__ void wconv_job(const Ctx& c, const WJob& j) {
    float* tl = (float*)c.lds;
    const int ntk = j.K >> 6, ntn = j.ncols >> 6, per = ntk * ntn, ntiles = per * j.nb;
    const int rk = c.tid >> 3, rseg = (c.tid & 7) * 8;
    for (int tile = blockIdx.x; tile < ntiles; tile += gridDim.x) {
        const int bi = tile / per, tt = tile % per, tk = tt % ntk, tn = tt / ntk;
        const float* sp = j.src + (size_t)bi * j.sstride + (size_t)(tk * 64 + rk) * j.ld_src + tn * 64 + rseg;
        const float4 a = *(const float4*)sp, b = *(const float4*)(sp + 4);
        __syncthreads();
        float* row = tl + rk * 65 + rseg;
        row[0] = a.x; row[1] = a.y; row[2] = a.z; row[3] = a.w; row[4] = b.x; row[5] = b.y; row[6] = b.z; row[7] = b.w;
        __syncthreads();
        const float* col = tl + rseg * 65 + rk;
        uint4 w; w.x = pk2(col[0], col[65]); w.y = pk2(col[130], col[195]); w.z = pk2(col[260], col[325]); w.w = pk2(col[390], col[455]);
        *(uint4*)(j.dst + (size_t)bi * j.dstride + (size_t)(tn * 64 + rk) * j.ld_dst + tk * 64 + rseg) = w;
    }
}
struct SchedG2 { const char* YA; const char* Bt; int G, c;
    __device__ __forceinline__ bool next(int i, pg8::Unit& u) const { const int L = (i >> 1) * G + c, ab = i & 1; if (L >= 64 * 4) return false; int pm, pn; pg8::tile_order(L, 64, 4, pm, pn);
        u.a = YA + (size_t)ab * (WS_YB - WS_YA) + (size_t)pm * (256 * 1024 * 2); u.b = Bt + (size_t)(ab * 4 + pn) * (256 * 1024 * 2); u.row0 = pm * 256; u.col0 = ab * 1024 + pn * 256; u.aux = 0; u.rowmap = nullptr; return true; } };
struct SchedX1 { const char* A; const char* Bt; int G, c;
    __device__ __forceinline__ bool next(int i, pg8::Unit& u) const { const int L = i * G + c; if (L >= 64 * 4) return false; int pm, pn; pg8::tile_order(L, 64, 4, pm, pn);
        u.a = A + (size_t)pm * (256 * 1024 * 2); u.b = Bt + (size_t)pn * (256 * 1024 * 2); u.row0 = pm * 256; u.col0 = pn * 256; u.aux = 0; u.rowmap = nullptr; return true; } };
struct SchedMoe { const char* A; const char* Bt; const int* TILE_E; const int* SLOT_TOK; int NT, NPN, G, c;
    __device__ __forceinline__ bool next(int i, pg8::Unit& u) const { const int L = i * G + c; if (L >= NT * NPN) return false; const int tile = L / NPN, pn = L % NPN; const int e = TILE_E[tile];
        u.a = SLOT_TOK ? A : A + (size_t)tile * (256 * 1024 * 2); u.rowmap = SLOT_TOK ? SLOT_TOK + tile * 256 : nullptr;
        u.b = Bt + (size_t)(e * NPN + pn) * (256 * 1024 * 2); u.row0 = tile * 256; u.col0 = pn * 256; u.aux = e; return true; } };

struct EpiLora {
    typedef NoLd Ld; static constexpr int MB = 1;
    const float* w0; const float* a0; float* LW; float* AA; bf16* GGR;
    __device__ __forceinline__ void load(Ld&, int, int, int) const {}
    __device__ __forceinline__ void store8(int row, int col, const float (&v)[8], int, const Ld&) const {
        const float* bp = col < 1024 ? w0 + col : a0 + ((col - 1024) & 1023);
        const float4 b0 = *(const float4*)bp, b1 = *(const float4*)(bp + 4);
        const float bb[8] = {b0.x, b0.y, b0.z, b0.w, b1.x, b1.y, b1.z, b1.w};
        if (col < 1024) { float o[8];
#pragma unroll
            for (int i = 0; i < 8; ++i) o[i] = -0.6065306597126334f * fsigm(bb[i] + v[i]);
            float* p = LW + (size_t)row * 1024 + col; *(float4*)p = make_float4(o[0], o[1], o[2], o[3]); *(float4*)(p + 4) = make_float4(o[4], o[5], o[6], o[7]); }
        else if (col < 2048) { const int cc = col - 1024; float o[8];
#pragma unroll
            for (int i = 0; i < 8; ++i) o[i] = fsigm(bb[i] + v[i]);
            float* p = AA + (size_t)row * 1024 + cc; *(float4*)p = make_float4(o[0], o[1], o[2], o[3]); *(float4*)(p + 4) = make_float4(o[4], o[5], o[6], o[7]); }
        else { uint4 w; w.x = pk2(v[0], v[1]); w.y = pk2(v[2], v[3]); w.z = pk2(v[4], v[5]); w.w = pk2(v[6], v[7]); *(uint4*)(GGR + (size_t)row * 1024 + (col - 2048)) = w; }
    }
};
struct SchedLora { const char* A; const char* Bt; int G, c;
    __device__ __forceinline__ bool next(int i, pg8::Unit& u) const { const int L = i * G + c; if (L >= 64 * 12) return false; int pm, pn; pg8::tile_order(L, 64, 12, pm, pn);
        u.a = A + (size_t)pm * (256 * 256 * 2); u.b = Bt + (size_t)pn * (256 * 256 * 2); u.row0 = pm * 256; u.col0 = pn * 256; u.aux = 0; u.rowmap = nullptr; return true; } };
__device__ __forceinline__ void lora_zero(const Ctx& c) {
    uint4* LT = c.ws<uint4>(WS_LORA_T);
    for (size_t idx = c.gtid; idx < (size_t)3072 * 32; idx += c.nthreads) {
        const int row = (int)(idx >> 5), k8 = (int)(idx & 31) * 8;
        const bool data = row < 1024 ? (k8 < 64) : (row < 2048 ? (k8 >= 64 && k8 < 128) : (k8 >= 128));
        if (!data) LT[idx] = make_uint4(0, 0, 0, 0);
    }
}

__device__ __forceinline__ void ph_loraprep(const Ctx& c) {
    const float* LIN = c.ws<float>(WS_LIN); bf16* AL = c.ws<bf16>(WS_ALORA); const float* mu = c.P.in[I_MU];
    for (size_t idx = c.gtid; idx < (size_t)T * 256; idx += c.nthreads) {
        const int t = (int)(idx >> 8), cc = (int)(idx & 255);
        const float x = LIN[idx], xp = (t & (SEQ - 1)) ? LIN[idx - 256] : 0.f;
        const float xs = x + (xp - x) * mu[3072 + cc];
        const float r = cc < 64 ? tanhf(xs) : (cc < 128 ? xs : sigm(xs));
        AL[idx] = f2bf(r);
    }
}
__device__ __forceinline__ void ph_post(const Ctx& c) {
    const float* OG = c.ws<float>(WS_OG); const float* ORW = c.ws<float>(WS_ORW); const bf16* ZS = c.ws<bf16>(WS_ZS); const bf16* VP = c.ws<bf16>(WS_VP); const bf16* GGR = c.ws<bf16>(WS_GGR);
    const float* SC = c.ws<float>(WS_SC); bf16* YA = c.ws<bf16>(WS_YA); bf16* YB = c.ws<bf16>(WS_YB);
    const float* gnw = c.P.in[I_GDN_NORM]; const float* lnw = c.P.in[I_LNW]; const float* lnb = c.P.in[I_LNB];
    const int lane = c.lane, c0 = lane * 16;
    for (int t = c.gwave; t < T; t += c.nwaves) {
        {
            float o[16];
#pragma unroll
            for (int q = 0; q < 4; ++q) { const float4 v = *(const float4*)(OG + (size_t)t * 1024 + c0 + 4 * q); o[4 * q] = v.x; o[4 * q + 1] = v.y; o[4 * q + 2] = v.z; o[4 * q + 3] = v.w; }
            float ss = 0.f;
#pragma unroll
            for (int j = 0; j < 16; ++j) ss += o[j] * o[j];
            ss += __shfl_xor(ss, 1); ss += __shfl_xor(ss, 2); ss += __shfl_xor(ss, 4);
            const float rstd = rsqrtf(ss * (1.f / 128.f) + 1e-6f);
            const uint4 z0 = *(const uint4*)(ZS + (size_t)t * 1024 + c0), z1 = *(const uint4*)(ZS + (size_t)t * 1024 + c0 + 8);
            const unsigned zz[8] = {z0.x, z0.y, z0.z, z0.w, z1.x, z1.y, z1.z, z1.w};
            unsigned w[8];
#pragma unroll
            for (int j = 0; j < 8; ++j) { const int cc = (c0 + 2 * j) & 127; w[j] = pk2(o[2 * j] * rstd * gnw[cc] * bflo(zz[j]), o[2 * j + 1] * rstd * gnw[cc + 1] * bfhi(zz[j])); }
            *(uint4*)(YA + (size_t)t * 1024 + c0) = make_uint4(w[0], w[1], w[2], w[3]); *(uint4*)(YA + (size_t)t * 1024 + c0 + 8) = make_uint4(w[4], w[5], w[6], w[7]);
        }
        {
            float o[16];
#pragma unroll
            for (int q = 0; q < 4; ++q) { const float4 v = *(const float4*)(ORW + (size_t)t * 1024 + c0 + 4 * q); o[4 * q] = v.x; o[4 * q + 1] = v.y; o[4 * q + 2] = v.z; o[4 * q + 3] = v.w; }
            float sm = 0.f;
#pragma unroll
            for (int j = 0; j < 16; ++j) sm += o[j];
            sm += __shfl_xor(sm, 1); sm += __shfl_xor(sm, 2);
            const float mean = sm * (1.f / 64.f);
            float sv = 0.f;
#pragma unroll
            for (int j = 0; j < 16; ++j) { const float dd = o[j] - mean; sv += dd * dd; }
            sv += __shfl_xor(sv, 1); sv += __shfl_xor(sv, 2);
            const float rstd = rsqrtf(sv * (1.f / 64.f) + 64e-5f);
            const float sc = SC[t * 16 + (c0 >> 6)];
            const uint4 v0 = *(const uint4*)(VP + (size_t)t * 1024 + c0), v1 = *(const uint4*)(VP + (size_t)t * 1024 + c0 + 8);
            const uint4 g0 = *(const uint4*)(GGR + (size_t)t * 1024 + c0), g1 = *(const uint4*)(GGR + (size_t)t * 1024 + c0 + 8);
            const unsigned vv[8] = {v0.x, v0.y, v0.z, v0.w, v1.x, v1.y, v1.z, v1.w};
            const unsigned gg[8] = {g0.x, g0.y, g0.z, g0.w, g1.x, g1.y, g1.z, g1.w};
            unsigned w[8];
#pragma unroll
            for (int j = 0; j < 8; ++j) { const int cc = c0 + 2 * j;
                const float y0 = ((o[2 * j] - mean) * rstd * lnw[cc] + lnb[cc] + sc * bflo(vv[j])) * bflo(gg[j]);
                const float y1 = ((o[2 * j + 1] - mean) * rstd * lnw[cc + 1] + lnb[cc + 1] + sc * bfhi(vv[j])) * bfhi(gg[j]);
                w[j] = pk2(y0, y1); }
            *(uint4*)(YB + (size_t)t * 1024 + c0) = make_uint4(w[0], w[1], w[2], w[3]); *(uint4*)(YB + (size_t)t * 1024 + c0 + 8) = make_uint4(w[4], w[5], w[6], w[7]);
        }
    }
}

__device__ __forceinline__ void ph_router(const Ctx& c) {
    const float* X1 = c.ws<float>(WS_X1); const float* nw = c.P.in[I_NORM_FFN]; const float* rw = c.P.in[I_ROUTER_W]; const float* rb = c.P.in[I_ROUTER_B];
    bf16* H2 = c.ws<bf16>(WS_H2); int* TE = c.ws<int>(WS_TE); float* TG = c.ws<float>(WS_TG); int* TP = c.ws<int>(WS_TP); unsigned* CNT = c.ws<unsigned>(WS_CTL) + CW_CNT;
    const int lane = c.lane;
    float4* tab = (float4*)c.lds;
    unsigned* lcnt = (unsigned*)(c.lds + 147456);
    __syncthreads();
    if (c.tid < 32) lcnt[c.tid] = 0u;
    for (int i = c.tid; i < 8192; i += NTHREADS) { const int k = i >> 3; tab[((k & 3) * 256 + (k >> 2)) * 9 + (i & 7)] = ((const float4*)rw)[i]; }
    __syncthreads();
    for (int t = c.gwave; t < T; t += c.nwaves) {
        float4 v[4]; float ss = 0.f;
#pragma unroll
        for (int i = 0; i < 4; ++i) { v[i] = ((const float4*)(X1 + (size_t)t * D))[lane + 64 * i]; ss += v[i].x * v[i].x + v[i].y * v[i].y + v[i].z * v[i].z + v[i].w * v[i].w; }
        ss = wsum(ss);
        const float rstd = rsqrtf(ss * (1.f / 1024.f) + 1e-6f);
        float lg[32];
#pragma unroll
        for (int j = 0; j < 32; ++j) lg[j] = 0.f;
#pragma unroll
        for (int i = 0; i < 4; ++i) {
            const float4 w4 = ((const float4*)nw)[lane + 64 * i];
            const float h[4] = {v[i].x * rstd * w4.x, v[i].y * rstd * w4.y, v[i].z * rstd * w4.z, v[i].w * rstd * w4.w};
            uint2 st; st.x = pk2(h[0], h[1]); st.y = pk2(h[2], h[3]);
            *(uint2*)(H2 + (size_t)t * D + 4 * (lane + 64 * i)) = st;
#pragma unroll
            for (int ii = 0; ii < 4; ++ii) {
                const float4* wr = tab + (size_t)(ii * 256 + lane + 64 * i) * 9;
#pragma unroll
                for (int q = 0; q < 8; ++q) { const float4 w = wr[q]; lg[4 * q] += h[ii] * w.x; lg[4 * q + 1] += h[ii] * w.y; lg[4 * q + 2] += h[ii] * w.z; lg[4 * q + 3] += h[ii] * w.w; }
                asm volatile("" ::: "memory");
            }
        }
#pragma unroll
        for (int j = 0; j < 32; ++j) lg[j] = wsum(lg[j]) + rb[j];
        int e0 = 0, e1 = 0, e2 = 0, e3 = 0; float v0 = -3e38f, v1 = -3e38f, v2 = -3e38f, v3 = -3e38f;
#pragma unroll
        for (int j = 0; j < 32; ++j) if (lg[j] > v0) { v0 = lg[j]; e0 = j; }
#pragma unroll
        for (int j = 0; j < 32; ++j) if (j != e0 && lg[j] > v1) { v1 = lg[j]; e1 = j; }
#pragma unroll
        for (int j = 0; j < 32; ++j) if (j != e0 && j != e1 && lg[j] > v2) { v2 = lg[j]; e2 = j; }
#pragma unroll
        for (int j = 0; j < 32; ++j) if (j != e0 && j != e1 && j != e2 && lg[j] > v3) { v3 = lg[j]; e3 = j; }
        const float x1 = expf(v1 - v0), x2 = expf(v2 - v0), x3 = expf(v3 - v0), inv = 1.f / (1.f + x1 + x2 + x3);
        if (lane < 4) {
            const int me = lane == 0 ? e0 : (lane == 1 ? e1 : (lane == 2 ? e2 : e3));
            const float mg = (lane == 0 ? 1.f : (lane == 1 ? x1 : (lane == 2 ? x2 : x3))) * inv;
            const unsigned pos = atomicAdd(&lcnt[me], 1u);
            TE[t * 4 + lane] = me; TG[t * 4 + lane] = mg; TP[t * 4 + lane] = (int)pos;
        }
    }
    __syncthreads();
    if (c.tid < 32) lcnt[32 + c.tid] = atomicAdd(&CNT[c.tid], lcnt[c.tid]);
    __syncthreads();
    if (lane < 4) for (int t = c.gwave; t < T; t += c.nwaves) TP[t * 4 + lane] += (int)lcnt[32 + TE[t * 4 + lane]];
    __syncthreads();
}

__device__ __forceinline__ void ph_dispatch(const Ctx& c) {
    int* tb = (int*)c.lds;
    const unsigned* CNT = c.ws<unsigned>(WS_CTL) + CW_CNT;
    int* TILE_E = c.ws<int>(WS_TILE_E); int* NT = c.ws<int>(WS_NT);
    const int* TE = c.ws<int>(WS_TE); const float* TG = c.ws<float>(WS_TG); const int* TP = c.ws<int>(WS_TP); int* TSLOT = c.ws<int>(WS_TSLOT);
    float* SGATE = c.ws<float>(WS_SGATE); const bf16* H2 = c.ws<bf16>(WS_H2); bf16* XB = c.ws<bf16>(WS_XB);
    if (c.tid == 0) { int acc = 0; for (int e = 0; e < NEXP; ++e) { const int n = (int)__hip_atomic_load(&CNT[e], __ATOMIC_RELAXED, __HIP_MEMORY_SCOPE_AGENT); tb[e] = acc; tb[64 + e] = n; acc += (n + 255) >> 8; } tb[32] = acc; }
    __syncthreads();
    if (blockIdx.x == 0) {
        for (int tile = c.tid; tile < tb[32]; tile += NTHREADS) { int e = 0; for (int q = 0; q < NEXP; ++q) if (tile >= tb[q]) e = q; TILE_E[tile] = e; }
        if (c.tid == 0) *NT = tb[32];
    }
    int* SLOT_TOK = c.ws<int>(WS_SLOT_TOK);
    for (size_t idx = c.gtid; idx < (size_t)T * 4; idx += c.nthreads) {
        const int t = (int)(idx >> 2), e = TE[idx], pos = TP[idx];
        const int slot = tb[e] * 256 + pos;
        TSLOT[idx] = slot; SGATE[slot] = TG[idx]; SLOT_TOK[slot] = t;
    }
    for (int e = 0; e < NEXP; ++e) {
        const int n = tb[64 + e], cap = (tb[e + 1] - tb[e]) * 256;
        for (int r = n + (int)c.gtid; r < cap; r += (int)c.nthreads) { const int slot = tb[e] * 256 + r; SLOT_TOK[slot] = 0; SGATE[slot] = 0.f; }
    }
}

__device__ __forceinline__ void ph_combine(const Ctx& c) {
    const float* X1 = c.ws<float>(WS_X1); const bf16* YS = c.ws<bf16>(WS_YS); const int* TSLOT = c.ws<int>(WS_TSLOT); const float* nw = c.P.in[I_NORM_FINAL]; float* out = c.P.out;
    const int lane = c.lane;
    for (int t = c.gwave; t < T; t += c.nwaves) {
        const int s0 = TSLOT[t * 4], s1 = TSLOT[t * 4 + 1], s2 = TSLOT[t * 4 + 2], s3 = TSLOT[t * 4 + 3];
        float4 v[4]; float ss = 0.f;
#pragma unroll
        for (int i = 0; i < 4; ++i) {
            const int col = 4 * (lane + 64 * i);
            v[i] = *(const float4*)(X1 + (size_t)t * D + col);
            const uint2 a = *(const uint2*)(YS + (size_t)s0 * 1024 + col), b = *(const uint2*)(YS + (size_t)s1 * 1024 + col), cc = *(const uint2*)(YS + (size_t)s2 * 1024 + col), d = *(const uint2*)(YS + (size_t)s3 * 1024 + col);
            v[i].x += bflo(a.x) + bflo(b.x) + bflo(cc.x) + bflo(d.x); v[i].y += bfhi(a.x) + bfhi(b.x) + bfhi(cc.x) + bfhi(d.x);
            v[i].z += bflo(a.y) + bflo(b.y) + bflo(cc.y) + bflo(d.y); v[i].w += bfhi(a.y) + bfhi(b.y) + bfhi(cc.y) + bfhi(d.y);
            ss += v[i].x * v[i].x + v[i].y * v[i].y + v[i].z * v[i].z + v[i].w * v[i].w;
        }
        ss = wsum(ss);
        const float rstd = rsqrtf(ss * (1.f / 1024.f) + 1e-6f);
#pragma unroll
        for (int i = 0; i < 4; ++i) { const float4 w4 = ((const float4*)nw)[lane + 64 * i];
            *(float4*)(out + (size_t)t * D + 4 * (lane + 64 * i)) = make_float4(v[i].x * rstd * w4.x, v[i].y * rstd * w4.y, v[i].z * rstd * w4.z, v[i].w * rstd * w4.w); }
    }
}


typedef short bf16x8_t __attribute__((ext_vector_type(8)));
typedef float f32x4_t __attribute__((ext_vector_type(4)));
#define MFMA16(a, b, c) __builtin_amdgcn_mfma_f32_16x16x32_bf16((a), (b), (c), 0, 0, 0)


__device__ __forceinline__ int frag_off(int row, int k, int KBn) { return (((row >> 4) * KBn + (k >> 5)) * 512) + (((k >> 3) & 3) * 128) + ((row & 15) * 8) + (k & 7); }
__device__ __forceinline__ int cfrag_off(int v, int r, int NRT) { return ((((v >> 4) * NRT + (r >> 4)) * 64 + ((r >> 2) & 3) * 16 + (v & 15)) * 4) + (r & 3); }

constexpr int GCL_HALF_BYTES = 71680;
__device__ __forceinline__ void ph_gcl(const Ctx& c) {
    const bf16* GQKV = c.ws<bf16>(WS_GQKV); const float* BETA = c.ws<float>(WS_BETA); const float* GGv = c.ws<float>(WS_GG); const float* cw = c.P.in[I_GDN_CONV];
    bf16* GA1 = c.ws<bf16>(WS_GA1); float* GX0 = c.ws<float>(WS_GX0); bf16* GA2 = c.ws<bf16>(WS_GA2); bf16* GA3 = c.ws<bf16>(WS_GA3); bf16* GA4 = c.ws<bf16>(WS_GA4); float* GGL = c.ws<float>(WS_GGL);
    for (int it0 = blockIdx.x * 2; it0 < 2048; it0 += gridDim.x * 2) {
        int tv = c.tid; asm volatile("" : "+v"(tv));
        const int half = tv >> 8, ht = tv & 255, lane = tv & 63, w4 = __builtin_amdgcn_readfirstlane((tv >> 6) & 3);
        unsigned char* base = c.lds + half * GCL_HALF_BYTES;
        bf16* QB = (bf16*)base;
        bf16* KB = QB + 64 * 136;
        bf16* VB = KB + 64 * 136;
        float* MM = (float*)(VB + 64 * 136);
        float* GC = MM + 64 * 64;
        float* BT = GC + 64;
        float* BE = BT + 64;
        const int item = it0 + half, n = item & 63, bh = item >> 6, h = bh & 7, b = bh >> 3;
        const int t0 = b * SEQ + n * 64;
        __syncthreads();
        if (w4 == 0) {
            float g = GGv[(size_t)(t0 + lane) * 8 + h]; const float be = BETA[(size_t)(t0 + lane) * 8 + h];
#pragma unroll
            for (int o = 1; o < 64; o <<= 1) { const float u = __shfl_up(g, o); if (lane >= o) g += u; }
            GC[lane] = g; BT[lane] = be; BE[lane] = be * __expf(g);
        }
        __syncthreads();
        {
            const int cg = ht & 15, rg = ht >> 4, r0 = rg * 4;
#pragma unroll
            for (int mat = 0; mat < 3; ++mat) {
                const int col0 = mat * 1024 + h * 128 + cg * 8;
                float4 xa[7], xb[7], wa[4], wb[4];
#pragma unroll
                for (int li = 0; li < 7; ++li) {
                    const bool valid = (n > 0) || (r0 - 3 + li >= 0);
                    uint4 xr = make_uint4(0, 0, 0, 0);
                    if (valid) xr = *(const uint4*)(GQKV + (size_t)(t0 + r0 - 3 + li) * 3072 + col0);
                    xa[li] = make_float4(bflo(xr.x), bfhi(xr.x), bflo(xr.y), bfhi(xr.y));
                    xb[li] = make_float4(bflo(xr.z), bfhi(xr.z), bflo(xr.w), bfhi(xr.w));
                }
#pragma unroll
                for (int j = 0; j < 4; ++j) { wa[j] = *(const float4*)(cw + j * 3072 + col0); wb[j] = *(const float4*)(cw + j * 3072 + col0 + 4); }
#pragma unroll
                for (int rr = 0; rr < 4; ++rr) {
                    float o[8] = {0.f, 0.f, 0.f, 0.f, 0.f, 0.f, 0.f, 0.f};
#pragma unroll
                    for (int j = 0; j < 4; ++j) { const float4 a = xa[rr + j], bq = xb[rr + j];
                        o[0] += wa[j].x * a.x; o[1] += wa[j].y * a.y; o[2] += wa[j].z * a.z; o[3] += wa[j].w * a.w;
                        o[4] += wb[j].x * bq.x; o[5] += wb[j].y * bq.y; o[6] += wb[j].z * bq.z; o[7] += wb[j].w * bq.w; }
                    float ss = 0.f;
#pragma unroll
                    for (int e = 0; e < 8; ++e) { o[e] *= fsigm(o[e]); ss += o[e] * o[e]; }
                    float sc = 1.f;
                    if (mat < 2) { ss += __shfl_xor(ss, 1); ss += __shfl_xor(ss, 2); ss += __shfl_xor(ss, 4); ss += __shfl_xor(ss, 8); sc = rsqrtf(ss + 1e-6f) * (mat == 0 ? 0.08838834764831845f : 1.f); }
                    const int r = r0 + rr;
                    uint4 w; w.x = pk2(o[0] * sc, o[1] * sc); w.y = pk2(o[2] * sc, o[3] * sc); w.z = pk2(o[4] * sc, o[5] * sc); w.w = pk2(o[6] * sc, o[7] * sc);
                    *(uint4*)((mat == 0 ? QB : (mat == 1 ? KB : VB)) + r * 136 + cg * 8) = w;
                    if (mat == 0) {
                        const float s2 = sc * __expf(GC[r]);
                        w.x = pk2(o[0] * s2, o[1] * s2); w.y = pk2(o[2] * s2, o[3] * s2); w.z = pk2(o[4] * s2, o[5] * s2); w.w = pk2(o[6] * s2, o[7] * s2);
                        *(uint4*)(GA2 + (size_t)item * 64 * 128 + frag_off(r, cg * 8, 4)) = w;
                    }
                }
            }
        }
        __syncthreads();
        {
            const int fr = lane & 15, fq = lane >> 4, a0 = w4 * 16;
            bf16x8_t ka[4];
#pragma unroll
            for (int kb = 0; kb < 4; ++kb) ka[kb] = *(const bf16x8_t*)(KB + (a0 + fr) * 136 + kb * 32 + fq * 8);
#pragma unroll
            for (int bt = 0; bt < 4; ++bt) {
                f32x4_t c1 = {0.f, 0.f, 0.f, 0.f}, c2 = {0.f, 0.f, 0.f, 0.f};
#pragma unroll
                for (int kb = 0; kb < 4; ++kb) {
                    const bf16x8_t kbf = *(const bf16x8_t*)(KB + (bt * 16 + fr) * 136 + kb * 32 + fq * 8);
                    const bf16x8_t qbf = *(const bf16x8_t*)(QB + (bt * 16 + fr) * 136 + kb * 32 + fq * 8);
                    c1 = MFMA16(ka[kb], kbf, c1); c2 = MFMA16(ka[kb], qbf, c2);
                }
                const int i = bt * 16 + fr, j0 = a0 + 4 * fq;
                const float gi = GC[i], bi = BT[i];
                float m[4], at[4];
#pragma unroll
                for (int rg = 0; rg < 4; ++rg) { const int j = j0 + rg; const float dec = __expf(fminf(gi - GC[j], 0.f));
                    m[rg] = (i > j) ? bi * c1[rg] * dec : 0.f; at[rg] = (i >= j) ? c2[rg] * dec : 0.f; }
                *(float4*)(MM + i * 64 + j0) = make_float4(m[0], m[1], m[2], m[3]);
                uint2 w; w.x = pk2(at[0], at[1]); w.y = pk2(at[2], at[3]);
                *(uint2*)(GA3 + (size_t)item * 64 * 64 + frag_off(i, j0, 2)) = w;
            }
        }
        __syncthreads();
        {
            const int cc = ht & 127; const bool isw = ht >= 128;
            const bf16* srcp = (isw ? KB : VB) + cc; const float* scl = isw ? BE : BT;
            float x[64];
#pragma unroll
            for (int i = 0; i < 64; ++i) x[i] = 0.f;
            float4 mc[16], mn[16];
#pragma unroll
            for (int q = 0; q < 16; ++q) { mc[q] = make_float4(0.f, 0.f, 0.f, 0.f); mn[q] = mc[q]; }
            float rhs_n = scl[0] * bf2f(srcp[0]);
#pragma unroll
            for (int i = 0; i < 64; ++i) {
                const float rhs = rhs_n;
                if (i + 1 < 64) {
#pragma unroll
                    for (int j4 = 0; j4 < (i + 4) / 4; ++j4) mn[j4] = *(const float4*)(MM + (i + 1) * 64 + 4 * j4);
                    rhs_n = scl[i + 1] * bf2f(srcp[(i + 1) * 136]);
                }
                float acc = rhs, ac1 = 0.f, ac2 = 0.f, ac3 = 0.f;
#pragma unroll
                for (int j4 = 0; j4 < (i + 3) / 4; ++j4) { acc -= mc[j4].x * x[4 * j4]; ac1 -= mc[j4].y * x[4 * j4 + 1]; ac2 -= mc[j4].z * x[4 * j4 + 2]; ac3 -= mc[j4].w * x[4 * j4 + 3]; }
                x[i] = (acc + ac1) + (ac2 + ac3);
#pragma unroll
                for (int j4 = 0; j4 < 16; ++j4) mc[j4] = mn[j4];
                asm volatile("" ::: "memory");
            }
            if (!isw) {
                float* up = GX0 + (size_t)item * 128 * 64;
#pragma unroll
                for (int q = 0; q < 16; ++q) *(float4*)(up + cfrag_off(cc, 4 * q, 4)) = make_float4(x[4 * q], x[4 * q + 1], x[4 * q + 2], x[4 * q + 3]);
            }
            __syncthreads();
            if (isw) {
                bf16* a1s = (bf16*)MM;
#pragma unroll
                for (int i = 0; i < 64; ++i) a1s[i * 128 + cc] = f2bf(-x[i]);
            }
        }
        __syncthreads();
        {
            const bf16* a1s = (const bf16*)MM; bf16* wp = GA1 + (size_t)item * 64 * 128;
#pragma unroll
            for (int q = 0; q < 4; ++q) { const int p = ht + 256 * q, fr = p & 15, fq = (p >> 4) & 3, kb = (p >> 6) & 3, rt = p >> 8;
                *(uint4*)(wp + p * 8) = *(const uint4*)(a1s + (rt * 16 + fr) * 128 + kb * 32 + fq * 8); }
        }
        {
            const int dk = ht & 127, hh = ht >> 7; const float g63 = GC[63];
            unsigned w[16];
#pragma unroll
            for (int q = 0; q < 16; ++q) { const int ta = hh * 32 + 2 * q;
                w[q] = pk2(bf2f(KB[ta * 136 + dk]) * __expf(g63 - GC[ta]), bf2f(KB[(ta + 1) * 136 + dk]) * __expf(g63 - GC[ta + 1])); }
            bf16* dp = GA4 + (size_t)item * 128 * 64;
            *(uint4*)(dp + frag_off(dk, hh * 32, 2)) = make_uint4(w[0], w[1], w[2], w[3]); *(uint4*)(dp + frag_off(dk, hh * 32 + 8, 2)) = make_uint4(w[4], w[5], w[6], w[7]);
            *(uint4*)(dp + frag_off(dk, hh * 32 + 16, 2)) = make_uint4(w[8], w[9], w[10], w[11]); *(uint4*)(dp + frag_off(dk, hh * 32 + 24, 2)) = make_uint4(w[12], w[13], w[14], w[15]);
            if (ht == 0) GGL[item] = __expf(g63);
        }
    }
}

constexpr int RCL_HALF_BYTES = 75776;
__device__ __forceinline__ void ph_rcl(const Ctx& c) {
    const bf16* RKV = c.ws<bf16>(WS_RKV); const float* LW = c.ws<float>(WS_LW); const float* AAg = c.ws<float>(WS_AA);
    const float* mu = c.P.in[I_MU]; const float* k_k = c.P.in[I_KK]; const float* k_a = c.P.in[I_KA]; const float* r_k = c.P.in[I_RK];
    bf16* VP = c.ws<bf16>(WS_VP); float* SC = c.ws<float>(WS_SC);
    bf16* RA1 = c.ws<bf16>(WS_RA1); float* RX0 = c.ws<float>(WS_RX0); bf16* RA2 = c.ws<bf16>(WS_RA2); bf16* RA3 = c.ws<bf16>(WS_RA3); float* RO0 = c.ws<float>(WS_RO0);
    bf16* RA4 = c.ws<bf16>(WS_RA4); float* RS0 = c.ws<float>(WS_RS0); float* RDSC = c.ws<float>(WS_RDSC);
    for (int it0 = blockIdx.x * 2; it0 < 4096; it0 += gridDim.x * 2) {
        int tv = c.tid; asm volatile("" : "+v"(tv));
        const int half = tv >> 8, ht = tv & 255, lane = tv & 63, w4 = __builtin_amdgcn_readfirstlane((tv >> 6) & 3);
        unsigned char* base = c.lds + half * RCL_HALF_BYTES;
        bf16* AT = (bf16*)base;
        bf16* VT = AT + 64 * 72;
        bf16* KDT = VT + 64 * 72;
        float* AAB = (float*)(KDT + 64 * 72);
        float* TOT = AAB + 64 * 64;
        unsigned char* RX = (unsigned char*)(TOT + 256);
        bf16* RT = (bf16*)RX;
        bf16* BTL = RT + 64 * 72;
        bf16* KT = BTL + 64 * 72;
        bf16* AAK = (bf16*)RX;
        bf16* ARK = AAK + 64 * 72;
        float* RHS2 = (float*)RX;
        const int item = it0 + half, n = item & 63, bh = item >> 6, h = bh & 15, b = bh >> 4;
        const int t0 = b * SEQ + n * 64;
        __syncthreads();
        const int r = ht >> 2, seg = ht & 3, c0 = seg * 16, t = t0 + r; const bool first = (n == 0 && r == 0);
        float rr[16], kf[16], vv[16], kkv[16], aa[16], lwl[16];
        float ss = 0.f, scs = 0.f;
        {
            const bf16* cur = RKV + (size_t)t * 3072 + h * 64 + c0; const bf16* prv = cur - 3072;
            uint4 ur[2], uk[2], uv[2], qr[2], qk[2], qv[2];
            float4 a4v[4], l4v[4], mr[4], mk[4], mv[4], kkw[4], kaw[4], rkw[4];
#pragma unroll
            for (int g = 0; g < 2; ++g) {
                ur[g] = *(const uint4*)(cur + 8 * g); uk[g] = *(const uint4*)(cur + 1024 + 8 * g); uv[g] = *(const uint4*)(cur + 2048 + 8 * g);
                qr[g] = make_uint4(0, 0, 0, 0); qk[g] = qr[g]; qv[g] = qr[g];
                if (!first) { qr[g] = *(const uint4*)(prv + 8 * g); qk[g] = *(const uint4*)(prv + 1024 + 8 * g); qv[g] = *(const uint4*)(prv + 2048 + 8 * g); }
            }
#pragma unroll
            for (int q = 0; q < 4; ++q) {
                l4v[q] = *(const float4*)(LW + (size_t)t * 1024 + h * 64 + c0 + 4 * q);
                a4v[q] = *(const float4*)(AAg + (size_t)t * 1024 + h * 64 + c0 + 4 * q);
                mr[q] = *(const float4*)(mu + h * 64 + c0 + 4 * q); mk[q] = *(const float4*)(mu + 1024 + h * 64 + c0 + 4 * q); mv[q] = *(const float4*)(mu + 2048 + h * 64 + c0 + 4 * q);
                kkw[q] = *(const float4*)(k_k + h * 64 + c0 + 4 * q); kaw[q] = *(const float4*)(k_a + h * 64 + c0 + 4 * q); rkw[q] = *(const float4*)(r_k + h * 64 + c0 + 4 * q);
            }
#pragma unroll
            for (int q = 0; q < 4; ++q) *(float4*)(AAB + r * 64 + c0 + 4 * q) = l4v[q];
            __syncthreads();
            {
                const int ch = ht & 63, tq = ht >> 6;
                float run = 0.f;
#pragma unroll
                for (int i = 0; i < 16; ++i) { run += AAB[(tq * 16 + i) * 64 + ch]; AAB[(tq * 16 + i) * 64 + ch] = run; }
                TOT[tq * 64 + ch] = run;
            }
            __syncthreads();
#pragma unroll
            for (int q = 0; q < 4; ++q) {
                const int g = q >> 1; const bool hi = q & 1;
                const unsigned r_a = hi ? ur[g].z : ur[g].x, r_b = hi ? ur[g].w : ur[g].y, k_a_ = hi ? uk[g].z : uk[g].x, k_b_ = hi ? uk[g].w : uk[g].y, v_a = hi ? uv[g].z : uv[g].x, v_b = hi ? uv[g].w : uv[g].y;
                const unsigned pr_a = hi ? qr[g].z : qr[g].x, pr_b = hi ? qr[g].w : qr[g].y, pk_a = hi ? qk[g].z : qk[g].x, pk_b = hi ? qk[g].w : qk[g].y, pv_a = hi ? qv[g].z : qv[g].x, pv_b = hi ? qv[g].w : qv[g].y;
                const float r0a[4] = {bflo(r_a), bfhi(r_a), bflo(r_b), bfhi(r_b)}, k0a[4] = {bflo(k_a_), bfhi(k_a_), bflo(k_b_), bfhi(k_b_)}, v0a[4] = {bflo(v_a), bfhi(v_a), bflo(v_b), bfhi(v_b)};
                const float rpa[4] = {bflo(pr_a), bfhi(pr_a), bflo(pr_b), bfhi(pr_b)}, kpa[4] = {bflo(pk_a), bfhi(pk_a), bflo(pk_b), bfhi(pk_b)}, vpa[4] = {bflo(pv_a), bfhi(pv_a), bflo(pv_b), bfhi(pv_b)};
                const float mra[4] = {mr[q].x, mr[q].y, mr[q].z, mr[q].w}, mka[4] = {mk[q].x, mk[q].y, mk[q].z, mk[q].w}, mva[4] = {mv[q].x, mv[q].y, mv[q].z, mv[q].w};
                const float kka[4] = {kkw[q].x, kkw[q].y, kkw[q].z, kkw[q].w}, kaa[4] = {kaw[q].x, kaw[q].y, kaw[q].z, kaw[q].w}, rka[4] = {rkw[q].x, rkw[q].y, rkw[q].z, rkw[q].w};
                const float aaa[4] = {a4v[q].x, a4v[q].y, a4v[q].z, a4v[q].w}, lwa[4] = {l4v[q].x, l4v[q].y, l4v[q].z, l4v[q].w};
#pragma unroll
                for (int e = 0; e < 4; ++e) { const int i = 4 * q + e;
                    rr[i] = r0a[e] + (rpa[e] - r0a[e]) * mra[e]; const float kx = k0a[e] + (kpa[e] - k0a[e]) * mka[e]; vv[i] = v0a[e] + (vpa[e] - v0a[e]) * mva[e];
                    kkv[i] = kx * kka[e]; ss += kkv[i] * kkv[i]; aa[i] = aaa[e]; lwl[i] = lwa[e]; kf[i] = kx * (1.f + (aaa[e] - 1.f) * kaa[e]); scs += rr[i] * kf[i] * rka[e]; }
            }
        }
        {
            ss += __shfl_xor(ss, 1); ss += __shfl_xor(ss, 2); scs += __shfl_xor(scs, 1); scs += __shfl_xor(scs, 2);
            const float rn = rsqrtf(ss + 1e-6f);
            if (seg == 0) SC[(size_t)t * 16 + h] = scs;
            const int tq = r >> 4;
            unsigned wat[8], wbt[8], wkt[8], wrt[8], wvp[8];
            float atv[16], btv[16], ktv[16], rtv[16];
#pragma unroll
            for (int i = 0; i < 16; ++i) {
                const int ch = c0 + i;
                float off = 0.f;
#pragma unroll
                for (int q = 0; q < 3; ++q) off += (q < tq) ? TOT[q * 64 + ch] : 0.f;
                const float tot = TOT[ch] + TOT[64 + ch] + TOT[128 + ch] + TOT[192 + ch];
                const float cs = AAB[r * 64 + ch] + off;
                const float lwv = lwl[i];
                const float kk = kkv[i] * rn;
                const float e2 = __expf(-cs), e4 = __expf(tot - cs);
                atv[i] = kk * __expf(cs - lwv); btv[i] = -kk * aa[i] * e2; ktv[i] = kf[i] * e2; rtv[i] = rr[i] * __expf(cs);
                VT[ch * 72 + r] = f2bf(vv[i]);
                KDT[ch * 72 + r] = f2bf(kf[i] * e4);
                RA4[(size_t)item * 64 * 64 + frag_off(ch, r, 2)] = f2bf(-kk * aa[i] * e4);
                if (r == 63) RDSC[(size_t)item * 64 + ch] = __expf(tot);
            }
#pragma unroll
            for (int q = 0; q < 8; ++q) { wat[q] = pk2(atv[2 * q], atv[2 * q + 1]); wbt[q] = pk2(btv[2 * q], btv[2 * q + 1]); wkt[q] = pk2(ktv[2 * q], ktv[2 * q + 1]); wrt[q] = pk2(rtv[2 * q], rtv[2 * q + 1]); wvp[q] = pk2(vv[2 * q], vv[2 * q + 1]); }
            *(uint4*)(AT + r * 72 + c0) = make_uint4(wat[0], wat[1], wat[2], wat[3]); *(uint4*)(AT + r * 72 + c0 + 8) = make_uint4(wat[4], wat[5], wat[6], wat[7]);
            *(uint4*)(BTL + r * 72 + c0) = make_uint4(wbt[0], wbt[1], wbt[2], wbt[3]); *(uint4*)(BTL + r * 72 + c0 + 8) = make_uint4(wbt[4], wbt[5], wbt[6], wbt[7]);
            *(uint4*)(KT + r * 72 + c0) = make_uint4(wkt[0], wkt[1], wkt[2], wkt[3]); *(uint4*)(KT + r * 72 + c0 + 8) = make_uint4(wkt[4], wkt[5], wkt[6], wkt[7]);
            *(uint4*)(RT + r * 72 + c0) = make_uint4(wrt[0], wrt[1], wrt[2], wrt[3]); *(uint4*)(RT + r * 72 + c0 + 8) = make_uint4(wrt[4], wrt[5], wrt[6], wrt[7]);
            bf16* a2p = RA2 + (size_t)item * 64 * 64;
            *(uint4*)(a2p + frag_off(r, c0, 2)) = make_uint4(wrt[0], wrt[1], wrt[2], wrt[3]); *(uint4*)(a2p + frag_off(r, c0 + 8, 2)) = make_uint4(wrt[4], wrt[5], wrt[6], wrt[7]);
            bf16* vpp = VP + (size_t)t * 1024 + h * 64 + c0;
            *(uint4*)vpp = make_uint4(wvp[0], wvp[1], wvp[2], wvp[3]); *(uint4*)(vpp + 8) = make_uint4(wvp[4], wvp[5], wvp[6], wvp[7]);
        }
        __syncthreads();
        const int fr = lane & 15, fq = lane >> 4;
        f32x4_t cab[4], cak[4], crb[4], crk[4];
        {
            const int j0t = w4 * 16;
            bf16x8_t bj[2], kj[2];
#pragma unroll
            for (int kb = 0; kb < 2; ++kb) { bj[kb] = *(const bf16x8_t*)(BTL + (j0t + fr) * 72 + kb * 32 + fq * 8); kj[kb] = *(const bf16x8_t*)(KT + (j0t + fr) * 72 + kb * 32 + fq * 8); }
#pragma unroll
            for (int it = 0; it < 4; ++it) {
                cab[it] = (f32x4_t){0.f, 0.f, 0.f, 0.f}; cak[it] = cab[it]; crb[it] = cab[it]; crk[it] = cab[it];
#pragma unroll
                for (int kb = 0; kb < 2; ++kb) {
                    const bf16x8_t ai = *(const bf16x8_t*)(AT + (it * 16 + fr) * 72 + kb * 32 + fq * 8);
                    const bf16x8_t ri = *(const bf16x8_t*)(RT + (it * 16 + fr) * 72 + kb * 32 + fq * 8);
                    cab[it] = MFMA16(bj[kb], ai, cab[it]); cak[it] = MFMA16(kj[kb], ai, cak[it]); crb[it] = MFMA16(bj[kb], ri, crb[it]); crk[it] = MFMA16(kj[kb], ri, crk[it]);
                }
            }
        }
        __syncthreads();
        {
            const int j0 = w4 * 16 + 4 * fq;
#pragma unroll
            for (int it = 0; it < 4; ++it) {
                const int i = it * 16 + fr;
                float vab[4], vak[4], vrb[4], vrk[4];
#pragma unroll
                for (int rg = 0; rg < 4; ++rg) { const int j = j0 + rg; const bool st = i > j, in = i >= j;
                    vab[rg] = st ? cab[it][rg] : 0.f; vak[rg] = st ? cak[it][rg] : 0.f; vrb[rg] = in ? crb[it][rg] : 0.f; vrk[rg] = in ? crk[it][rg] : 0.f; }
                *(float4*)(AAB + i * 64 + j0) = make_float4(vab[0], vab[1], vab[2], vab[3]);
                uint2 w; w.x = pk2(vak[0], vak[1]); w.y = pk2(vak[2], vak[3]); *(uint2*)(AAK + i * 72 + j0) = w;
                w.x = pk2(vrk[0], vrk[1]); w.y = pk2(vrk[2], vrk[3]); *(uint2*)(ARK + i * 72 + j0) = w;
                w.x = pk2(vrb[0], vrb[1]); w.y = pk2(vrb[2], vrb[3]); *(uint2*)(RA3 + (size_t)item * 64 * 64 + frag_off(i, j0, 2)) = w;
            }
        }
        __syncthreads();
        f32x4_t cav[4], cov[4], ckv[4];
        {
            const int r0t = w4 * 16;
            bf16x8_t fa[2], fo[2], fk[2];
#pragma unroll
            for (int kb = 0; kb < 2; ++kb) { fa[kb] = *(const bf16x8_t*)(AAK + (r0t + fr) * 72 + kb * 32 + fq * 8); fo[kb] = *(const bf16x8_t*)(ARK + (r0t + fr) * 72 + kb * 32 + fq * 8); fk[kb] = *(const bf16x8_t*)(KDT + (r0t + fr) * 72 + kb * 32 + fq * 8); }
#pragma unroll
            for (int vt = 0; vt < 4; ++vt) {
                cav[vt] = (f32x4_t){0.f, 0.f, 0.f, 0.f}; cov[vt] = cav[vt]; ckv[vt] = cav[vt];
#pragma unroll
                for (int kb = 0; kb < 2; ++kb) { const bf16x8_t vb = *(const bf16x8_t*)(VT + (vt * 16 + fr) * 72 + kb * 32 + fq * 8);
                    cav[vt] = MFMA16(fa[kb], vb, cav[vt]); cov[vt] = MFMA16(fo[kb], vb, cov[vt]); ckv[vt] = MFMA16(fk[kb], vb, ckv[vt]); }
            }
        }
        __syncthreads();
        {
            const int r0 = w4 * 16 + 4 * fq;
#pragma unroll
            for (int vt = 0; vt < 4; ++vt) {
                const int v = vt * 16 + fr;
#pragma unroll
                for (int rg = 0; rg < 4; ++rg) RHS2[v * 65 + r0 + rg] = cav[vt][rg];
                *(float4*)(RO0 + (size_t)item * 64 * 64 + cfrag_off(v, r0, 4)) = make_float4(cov[vt][0], cov[vt][1], cov[vt][2], cov[vt][3]);
                *(float4*)(RS0 + (size_t)item * 64 * 64 + cfrag_off(v, r0, 4)) = make_float4(ckv[vt][0], ckv[vt][1], ckv[vt][2], ckv[vt][3]);
            }
        }
        __syncthreads();
        {
            const int col = ht >> 1, p = ht & 1, cc = col & 63; const bool isu = col >= 64;
            float xs[32];
#pragma unroll
            for (int i = 0; i < 32; ++i) xs[i] = 0.f;
            float4 mc[8], mn[8];
#pragma unroll
            for (int q = 0; q < 8; ++q) { mc[q] = make_float4(0.f, 0.f, 0.f, 0.f); mn[q] = mc[q]; }
            float rhs_n; { const float rv = RHS2[(isu ? cc : 0) * 65], av = bf2f(AT[(isu ? 0 : cc)]); rhs_n = isu ? rv : av; }
#pragma unroll
            for (int i = 0; i < 64; ++i) {
                const float rhs = rhs_n;
                if (i + 1 < 64) {
#pragma unroll
                    for (int q = 0; q < (i + 8) / 8; ++q) mn[q] = *(const float4*)(AAB + (i + 1) * 64 + 8 * q + 4 * p);
                    const float rv = RHS2[(isu ? cc : 0) * 65 + i + 1], av = bf2f(AT[(i + 1) * 72 + (isu ? 0 : cc)]); rhs_n = isu ? rv : av;
                }
                float a0 = 0.f, a1 = 0.f, a2 = 0.f, a3 = 0.f;
#pragma unroll
                for (int q = 0; q < (i + 7) / 8; ++q) { a0 += mc[q].x * xs[4 * q]; a1 += mc[q].y * xs[4 * q + 1]; a2 += mc[q].z * xs[4 * q + 2]; a3 += mc[q].w * xs[4 * q + 3]; }
                float tot = (a0 + a1) + (a2 + a3);
                tot += dpp_xor1(tot);
                const float xi = rhs + tot;
                const int g = i >> 2, slot = (g >> 1) * 4 + (i & 3);
                xs[slot] = (p == (g & 1)) ? xi : xs[slot];
#pragma unroll
                for (int q = 0; q < 8; ++q) mc[q] = mn[q];
                asm volatile("" ::: "memory");
            }
            if (isu) {
                float* up = RX0 + (size_t)item * 64 * 64;
#pragma unroll
                for (int q = 0; q < 8; ++q) *(float4*)(up + cfrag_off(cc, 4 * (2 * q + p), 4)) = make_float4(xs[4 * q], xs[4 * q + 1], xs[4 * q + 2], xs[4 * q + 3]);
            }
            __syncthreads();
            if (!isu) {
#pragma unroll
                for (int q = 0; q < 8; ++q)
#pragma unroll
                    for (int e = 0; e < 4; ++e) AT[(4 * (2 * q + p) + e) * 72 + cc] = f2bf(xs[4 * q + e]);
            }
        }
        __syncthreads();
        {
            bf16* wp = RA1 + (size_t)item * 64 * 64;
#pragma unroll
            for (int q = 0; q < 2; ++q) { const int p = ht + 256 * q, fr = p & 15, fq = (p >> 4) & 3, kb = (p >> 6) & 1, rt = p >> 7;
                *(uint4*)(wp + p * 8) = *(const uint4*)(AT + (rt * 16 + fr) * 72 + kb * 32 + fq * 8); }
        }
    }
}

template <int DK, bool RW>
struct ScanArgs { const bf16* A1; const float* X0; const bf16* A2; const bf16* A3; const float* O0; const bf16* A4; const float* S0; const float* DSC; float* OUT; int item0; int vs; int tok0; int ocol0; };
#define LBAR() do { asm volatile("s_waitcnt lgkmcnt(0)" ::: "memory"); __builtin_amdgcn_s_barrier(); asm volatile("" ::: "memory"); } while (0)
template <int DK, bool RW>
__device__ __forceinline__ void scan_run(const Ctx& c, const ScanArgs<DK, RW>& a) {
    constexpr int KB = DK / 32;
    constexpr int NST = DK / 64;
    constexpr int NV = RW ? 64 : 128;
    constexpr int SROW = DK + 8;
    bf16* ST = (bf16*)c.lds;
    bf16* XT = ST + 2 * 32 * SROW;
    const int lane = c.lane, w = c.wave, fr = lane & 15, fq = lane >> 4;
    const int tm = w >> 1, tn = w & 1;
    const int dkt = (NST == 2) ? w : (w >> 1);
    for (int i = c.tid; i < 32 * SROW / 2; i += NTHREADS) ((unsigned*)ST)[i] = 0u;
    f32x4_t accS[NST];
#pragma unroll
    for (int s = 0; s < NST; ++s) accS[s] = (f32x4_t){0.f, 0.f, 0.f, 0.f};
    bf16x8_t a1f[KB], a2f[KB], a3f[2], a4f[2]; f32x4_t x0v, o0v, s0v[NST], dscv;
#define SCAN_LOAD(IT) do { const size_t it_ = (size_t)(IT); \
        _Pragma("unroll") for (int kb = 0; kb < KB; ++kb) { a1f[kb] = *(const bf16x8_t*)(a.A1 + it_ * 64 * DK + ((tm * KB + kb) * 64 + lane) * 8); a2f[kb] = *(const bf16x8_t*)(a.A2 + it_ * 64 * DK + ((tm * KB + kb) * 64 + lane) * 8); } \
        _Pragma("unroll") for (int kb = 0; kb < 2; ++kb) { a3f[kb] = *(const bf16x8_t*)(a.A3 + it_ * 64 * 64 + ((tm * 2 + kb) * 64 + lane) * 8); a4f[kb] = *(const bf16x8_t*)(a.A4 + it_ * DK * 64 + ((dkt * 2 + kb) * 64 + lane) * 8); } \
        x0v = *(const f32x4_t*)(a.X0 + it_ * NV * 64 + (((a.vs * 2 + tn) * 4 + tm) * 64 + lane) * 4); \
        if (RW) { o0v = *(const f32x4_t*)(a.O0 + it_ * NV * 64 + (((a.vs * 2 + tn) * 4 + tm) * 64 + lane) * 4); \
                  _Pragma("unroll") for (int s = 0; s < NST; ++s) s0v[s] = *(const f32x4_t*)(a.S0 + it_ * 64 * DK + (((a.vs * 2 + (NST == 2 ? s : tn)) * (DK / 16) + dkt) * 64 + lane) * 4); \
                  dscv = *(const f32x4_t*)(a.DSC + it_ * DK + dkt * 16 + 4 * fq); } \
        else { const float g_ = a.DSC[it_]; dscv = (f32x4_t){g_, g_, g_, g_}; o0v = (f32x4_t){0.f, 0.f, 0.f, 0.f}; _Pragma("unroll") for (int s = 0; s < NST; ++s) s0v[s] = (f32x4_t){0.f, 0.f, 0.f, 0.f}; } \
    } while (0)
    SCAN_LOAD(a.item0);
    int cur = 0;
    for (int n = 0; n < 64; ++n) {
        bf16x8_t b1[KB], b2[KB], b3[2], b4[2];
#pragma unroll
        for (int kb = 0; kb < KB; ++kb) { b1[kb] = a1f[kb]; b2[kb] = a2f[kb]; }
        b3[0] = a3f[0]; b3[1] = a3f[1]; b4[0] = a4f[0]; b4[1] = a4f[1];
        f32x4_t accX = x0v, accO = o0v; const f32x4_t dv = dscv; f32x4_t sv[NST];
#pragma unroll
        for (int s = 0; s < NST; ++s) sv[s] = s0v[s];
        if (n + 1 < 64) SCAN_LOAD(a.item0 + n + 1);
        LBAR();
        const bf16* Sc = ST + cur * 32 * SROW; bf16* Sn = ST + (cur ^ 1) * 32 * SROW;
        bf16x8_t sf[KB];
#pragma unroll
        for (int kb = 0; kb < KB; ++kb) sf[kb] = *(const bf16x8_t*)(Sc + (tn * 16 + fr) * SROW + kb * 32 + fq * 8);
#pragma unroll
        for (int kb = 0; kb < KB; ++kb) accX = MFMA16(b1[kb], sf[kb], accX);
        { uint2 wv; wv.x = pk2(accX[0], accX[1]); wv.y = pk2(accX[2], accX[3]); *(uint2*)(XT + (tn * 16 + fr) * 72 + tm * 16 + 4 * fq) = wv; }
#pragma unroll
        for (int kb = 0; kb < KB; ++kb) accO = MFMA16(b2[kb], sf[kb], accO);
        LBAR();
        bf16x8_t xf[2];
#pragma unroll
        for (int kb = 0; kb < 2; ++kb) xf[kb] = *(const bf16x8_t*)(XT + (tn * 16 + fr) * 72 + kb * 32 + fq * 8);
        accO = MFMA16(b3[0], xf[0], accO); accO = MFMA16(b3[1], xf[1], accO);
        {
            float* op = a.OUT + (size_t)(a.tok0 + n * 64 + tm * 16 + 4 * fq) * 1024 + a.ocol0 + tn * 16 + fr;
            op[0] = accO[0]; op[1024] = accO[1]; op[2048] = accO[2]; op[3072] = accO[3];
        }
#pragma unroll
        for (int s = 0; s < NST; ++s) {
            const int vt = (NST == 2) ? s : tn;
            bf16x8_t xg[2];
            if (vt == tn) { xg[0] = xf[0]; xg[1] = xf[1]; }
            else {
#pragma unroll
                for (int kb = 0; kb < 2; ++kb) xg[kb] = *(const bf16x8_t*)(XT + (vt * 16 + fr) * 72 + kb * 32 + fq * 8);
            }
            f32x4_t t = accS[s] * dv + sv[s];
            t = MFMA16(b4[0], xg[0], t); t = MFMA16(b4[1], xg[1], t);
            accS[s] = t;
            uint2 wv; wv.x = pk2(t[0], t[1]); wv.y = pk2(t[2], t[3]);
            *(uint2*)(Sn + (vt * 16 + fr) * SROW + dkt * 16 + 4 * fq) = wv;
        }
        cur ^= 1;
    }
#undef SCAN_LOAD
    __syncthreads();
}

__device__ __forceinline__ void ph_scan(const Ctx& c) {
    for (int wk = blockIdx.x; wk < 256; wk += gridDim.x) {
        const int xcd = wk & 7, j = wk >> 3;
        if (j < 16) {
            const int pair = xcd * 4 + (j >> 2), vs = j & 3, b = pair >> 3, h = pair & 7;
            ScanArgs<128, false> a{c.ws<bf16>(WS_GA1), c.ws<float>(WS_GX0), c.ws<bf16>(WS_GA2), c.ws<bf16>(WS_GA3), nullptr, c.ws<bf16>(WS_GA4), nullptr, c.ws<float>(WS_GGL),
                                   c.ws<float>(WS_OG), pair * 64, vs, b * SEQ, h * 128 + vs * 32};
            scan_run<128, false>(c, a);
        } else {
            const int pair = xcd * 8 + ((j - 16) >> 1), vs = (j - 16) & 1, b = pair >> 4, h = pair & 15;
            ScanArgs<64, true> a{c.ws<bf16>(WS_RA1), c.ws<float>(WS_RX0), c.ws<bf16>(WS_RA2), c.ws<bf16>(WS_RA3), c.ws<float>(WS_RO0), c.ws<bf16>(WS_RA4), c.ws<float>(WS_RS0), c.ws<float>(WS_RDSC),
                                 c.ws<float>(WS_ORW), pair * 64, vs, b * SEQ, h * 64 + vs * 32};
            scan_run<64, true>(c, a);
        }
    }
}

enum { PH_RMS0 = 0, PH_INPROJ, PH_GCL, PH_LORA, PH_RCL, PH_SCAN, PH_POST, PH_G2, PH_X1, PH_ROUTER, PH_DISPATCH, PH_MOE1, PH_MOE2, PH_COMBINE, PH_COUNT };

template <unsigned PHMASK>
__global__ void __launch_bounds__(NTHREADS) mk(Params P) {
    extern __shared__ __attribute__((aligned(16))) unsigned char lds[];
    volatile LAS unsigned* misc = (volatile LAS unsigned*)((LAS unsigned char*)lds + MISC_OFF);
    if (threadIdx.x < 64) misc[threadIdx.x] = 0u;
    __syncthreads();
    unsigned* ctl = (unsigned*)(P.ws + WS_CTL);
    XcdBarrier bar = xcd_barrier_post(ctl + CW_BAR + P.li * XCD_BAR_WORDS, misc);
#define MKCTX() int tv_ = threadIdx.x; asm volatile("" : "+v"(tv_)); const int wv_ = __builtin_amdgcn_readfirstlane(tv_ >> 6); \
    Ctx c{P, tv_, tv_ & 63, wv_, (int)(blockIdx.x * NWAVES + wv_), (int)(gridDim.x * NWAVES), (size_t)blockIdx.x * NTHREADS + tv_, (size_t)gridDim.x * NTHREADS, lds}
    bool first_seam = true;
#define IN(k) (((PHMASK >> (k)) & 1u) && P.ph_lo <= (k) && (k) < P.ph_hi)
#define SEAM(k) do { if ((k) + 1 < P.ph_hi) { xcd_barrier(bar); first_seam = false; } } while (0)
#define REP(k) for (int rep_ = 0; rep_ < ((k) == PROBE_REP ? 2 : 1); ++rep_)
    if (IN(PH_RMS0)) { MKCTX();
        REP(PH_RMS0) {
        ph_rms0(c);
        { WJob j{P.in[I_W_IN], NCOL_IN, 1024, 4096, c.ws<bf16>(WS_WIN_T), 1024, 1, 0, 0}; wconv_job(c, j); }
        { WJob j{P.in[I_W_IN] + 4112, NCOL_IN, 1024, 5376, c.ws<bf16>(WS_WIN_T) + (size_t)4096 * 1024, 1024, 1, 0, 0}; wconv_job(c, j); }
        lora_zero(c);
        { WJob j{P.in[I_W2], 1024, 64, 1024, c.ws<bf16>(WS_LORA_T), 256, 1, 0, 0}; wconv_job(c, j); }
        { WJob j{P.in[I_A2], 1024, 64, 1024, c.ws<bf16>(WS_LORA_T) + (size_t)1024 * 256 + 64, 256, 1, 0, 0}; wconv_job(c, j); }
        { WJob j{P.in[I_G2], 1024, 128, 1024, c.ws<bf16>(WS_LORA_T) + (size_t)2048 * 256 + 128, 256, 1, 0, 0}; wconv_job(c, j); }
        }
        SEAM(PH_RMS0);
    }
    if (IN(PH_INPROJ)) { MKCTX();
        REP(PH_INPROJ) {
        EpiInProj ep{c.ws<bf16>(WS_GQKV), c.ws<bf16>(WS_ZS), c.ws<bf16>(WS_RKV), c.ws<float>(WS_LIN), c.ws<bf16>(WS_GATES)};
        SchedInProj sc{(const char*)c.ws<bf16>(WS_HB), (const char*)c.ws<bf16>(WS_WIN_T), (int)gridDim.x, (int)blockIdx.x};
        pg8::gemm_phase((LAS unsigned char*)lds, 1024, sc, ep, c.tid);
        }
        SEAM(PH_INPROJ);
    }
    if (IN(PH_GCL)) { MKCTX(); REP(PH_GCL) { ph_gcl(c); ph_loraprep(c); } SEAM(PH_GCL); }
    if (IN(PH_LORA)) { MKCTX();
        REP(PH_LORA) {
        EpiLora ep{P.in[I_W0], P.in[I_A0], c.ws<float>(WS_LW), c.ws<float>(WS_AA), c.ws<bf16>(WS_GGR)};
        SchedLora sc{(const char*)c.ws<bf16>(WS_ALORA), (const char*)c.ws<bf16>(WS_LORA_T), (int)gridDim.x, (int)blockIdx.x};
        pg8::gemm_phase((LAS unsigned char*)lds, 256, sc, ep, c.tid);
        }
        SEAM(PH_LORA);
    }
    if (IN(PH_RCL)) { MKCTX(); REP(PH_RCL) { ph_rcl(c); } SEAM(PH_RCL); }
    if (IN(PH_SCAN)) { MKCTX(); REP(PH_SCAN) { ph_scan(c); } SEAM(PH_SCAN); }
    if (IN(PH_POST)) { MKCTX();
        REP(PH_POST) {
        ph_post(c);
        { WJob j{P.in[I_PROJ_A], 1024, 1024, 1024, c.ws<bf16>(WS_PROJ_T), 1024, 1, 0, 0}; wconv_job(c, j); }
        { WJob j{P.in[I_PROJ_B], 1024, 1024, 1024, c.ws<bf16>(WS_PROJ_T) + (size_t)1024 * 1024, 1024, 1, 0, 0}; wconv_job(c, j); }
        { WJob j{P.in[I_W_OUT], 1024, 1024, 1024, c.ws<bf16>(WS_WOUT_T), 1024, 1, 0, 0}; wconv_job(c, j); }
        }
        SEAM(PH_POST);
    }
    if (IN(PH_G2)) { MKCTX();
        REP(PH_G2) {
        EpiG2 ep{c.ws<bf16>(WS_GATES), c.ws<bf16>(WS_G2)};
        SchedG2 sc{(const char*)c.ws<bf16>(WS_YA), (const char*)c.ws<bf16>(WS_PROJ_T), (int)gridDim.x, (int)blockIdx.x};
        pg8::gemm_phase((LAS unsigned char*)lds, 1024, sc, ep, c.tid);
        }
        SEAM(PH_G2);
    }
    if (IN(PH_X1)) { MKCTX();
        REP(PH_X1) {
        EpiX1 ep{P.in[I_X], c.ws<float>(WS_X1)};
        SchedX1 sc{(const char*)c.ws<bf16>(WS_G2), (const char*)c.ws<bf16>(WS_WOUT_T), (int)gridDim.x, (int)blockIdx.x};
        pg8::gemm_phase((LAS unsigned char*)lds, 1024, sc, ep, c.tid);
        }
        SEAM(PH_X1);
    }
    if (IN(PH_ROUTER)) { MKCTX();
        ph_router(c);
        REP(PH_ROUTER) {
        { WJob j{P.in[I_W_GU], 2048, 1024, 2048, c.ws<bf16>(WS_WGU_T), 1024, 32, (size_t)1024 * 2048, (size_t)2048 * 1024}; wconv_job(c, j); }
        { WJob j{P.in[I_W_DOWN], 1024, 1024, 1024, c.ws<bf16>(WS_WDN_T), 1024, 32, (size_t)1024 * 1024, (size_t)1024 * 1024}; wconv_job(c, j); }
        }
        SEAM(PH_ROUTER);
    }
    if (IN(PH_DISPATCH)) { MKCTX(); REP(PH_DISPATCH) { ph_dispatch(c); } SEAM(PH_DISPATCH); }
    if (IN(PH_MOE1)) { MKCTX();
        REP(PH_MOE1) {
        const int nt = *c.ws<int>(WS_NT);
        EpiAct ep{P.in[I_B_GU], c.ws<bf16>(WS_ACT)};
        SchedMoe sc{(const char*)c.ws<bf16>(WS_H2), (const char*)c.ws<bf16>(WS_WGU_T), c.ws<int>(WS_TILE_E), c.ws<int>(WS_SLOT_TOK), nt, 8, (int)gridDim.x, (int)blockIdx.x};
        pg8::gemm_phase_t<true>((LAS unsigned char*)lds, 1024, sc, ep, c.tid);
        }
        SEAM(PH_MOE1);
    }
    if (IN(PH_MOE2)) { MKCTX();
        REP(PH_MOE2) {
        const int nt = *c.ws<int>(WS_NT);
        EpiYS ep{P.in[I_B_DOWN], c.ws<float>(WS_SGATE), c.ws<bf16>(WS_YS)};
        SchedMoe sc{(const char*)c.ws<bf16>(WS_ACT), (const char*)c.ws<bf16>(WS_WDN_T), c.ws<int>(WS_TILE_E), nullptr, nt, 4, (int)gridDim.x, (int)blockIdx.x};
        pg8::gemm_phase((LAS unsigned char*)lds, 1024, sc, ep, c.tid);
        }
        SEAM(PH_MOE2);
    }
    if (IN(PH_COMBINE)) { MKCTX(); REP(PH_COMBINE) { ph_combine(c); } }
#undef IN
#undef SEAM
#undef REP
#undef MKCTX
}

template <unsigned M> static void launch_one(const Params& p, int grid, hipStream_t stream) {
    static bool attr = false;
    if (!attr) { (void)hipFuncSetAttribute((const void*)mk<M>, hipFuncAttributeMaxDynamicSharedMemorySize, LDS_BYTES); attr = true; }
    hipLaunchKernelGGL(mk<M>, dim3(grid), dim3(NTHREADS), LDS_BYTES, stream, p);
}
template <int PH> static void launch_chain(Params& p, int grid, hipStream_t stream) {
    if constexpr (PH < PH_COUNT) { p.ph_lo = PH; p.ph_hi = PH + 1; p.li = 0; p.coop = 0; launch_one<(1u << PH)>(p, grid, stream); launch_chain<PH + 1>(p, grid, stream); }
}

extern "C" void kernel_launch(void* const* d_in, const int* in_sizes, int n_in, void* d_out, int out_size, void* d_ws, size_t ws_size, hipStream_t stream) {
    static int grid = 0;
    if (grid == 0) {
        int dev = 0, cus = 0, per_cu = 0;
        (void)hipGetDevice(&dev);
        (void)hipDeviceGetAttribute(&cus, hipDeviceAttributeMultiprocessorCount, dev);
#if MK_ONE_LAUNCH
        (void)hipFuncSetAttribute((const void*)mk<0xffffffffu>, hipFuncAttributeMaxDynamicSharedMemorySize, LDS_BYTES);
        (void)hipOccupancyMaxActiveBlocksPerMultiprocessor(&per_cu, (const void*)mk<0xffffffffu>, NTHREADS, LDS_BYTES);
#else
        per_cu = 1;
#endif
        if (n_in != 29 || ws_size < WS_END || per_cu < 1 || cus < 64) { fprintf(stderr, "kernel_launch: unexpected setup n_in %d ws %zu per_cu %d cus %d\n", n_in, ws_size, per_cu, cus); grid = -1; return; }
        grid = cus;
    }
    if (grid < 0) return;
    (void)hipMemsetAsync((char*)d_ws + WS_CTL, 0, CTL_BYTES, stream);
    Params p{};
    for (int i = 0; i < 29; ++i) p.in[i] = (const float*)d_in[i];
    p.out = (float*)d_out; p.ws = (unsigned char*)d_ws;
#if MK_ONE_LAUNCH
    p.ph_lo = 0; p.ph_hi = PH_COUNT; p.li = 0; p.coop = 1;
    void* args[] = {&p};
    hipError_t e = hipLaunchCooperativeKernel((const void*)mk<0xffffffffu>, dim3(grid), dim3(NTHREADS), args, LDS_BYTES, stream);
    if (e != hipSuccess) fprintf(stderr, "cooperative launch failed: %s (grid %d)\n", hipGetErrorString(e), grid);
#else
    launch_chain<0>(p, grid, stream);
#endif
}
```

```cpp
#include <hip/hip_runtime.h>
#include <hip/hip_cooperative_groups.h>
#include <cstdint>
#include <cstdio>
namespace cg = cooperative_groups;

#ifndef MK_ONE_LAUNCH
#define MK_ONE_LAUNCH 1
#endif

#define LAS __attribute__((address_space(3)))
#ifndef FAST_INPROJ
#define FAST_INPROJ 1
#endif
#ifndef FAST_MIX
#define FAST_MIX 1
#endif
#define PROBE_REP -1
constexpr int NTHREADS = 512;
constexpr int NWAVES = 8;
constexpr int LDS_BYTES = 155648;
constexpr int MISC_OFF = 153600;

constexpr int T = 16384, SEQ = 4096, D = 1024;
constexpr int NCOL_IN = 9488;
constexpr int NEXP = 32;
constexpr int MAXTILES = 288;
constexpr int MAXSLOTS = MAXTILES * 256;

enum { I_X = 0, I_NORM_MIX, I_W_IN, I_GDN_CONV, I_GDN_ALOG, I_GDN_DTB, I_GDN_NORM, I_MU, I_W0, I_W2, I_A0, I_A2, I_G2, I_KK, I_KA, I_RK,
       I_LNW, I_LNB, I_PROJ_A, I_PROJ_B, I_W_OUT, I_NORM_FFN, I_ROUTER_W, I_ROUTER_B, I_W_GU, I_B_GU, I_W_DOWN, I_B_DOWN, I_NORM_FINAL };

constexpr size_t MiB = 1u << 20;
constexpr size_t WS_CTL = 0, CTL_BYTES = 65536;
constexpr size_t WS_BETA = 1 * MiB;
constexpr size_t WS_GG = WS_BETA + 512 * 1024;
constexpr size_t WS_SC = 2 * MiB;
constexpr size_t WS_TE = 3 * MiB;
constexpr size_t WS_TG = WS_TE + 256 * 1024;
constexpr size_t WS_TP = WS_TG + 256 * 1024;
constexpr size_t WS_TSLOT = WS_TP + 256 * 1024;
constexpr size_t WS_SGATE = 4 * MiB;
constexpr size_t WS_SLOT_TOK = 4 * MiB + 512 * 1024;
constexpr size_t WS_TILE_E = 5 * MiB;
constexpr size_t WS_NT = WS_TILE_E + 4096;
constexpr size_t WS_HB = 8 * MiB;
constexpr size_t WS_H2 = WS_HB;
constexpr size_t WS_ZS = 40 * MiB;
constexpr size_t WS_GATES = 72 * MiB;
constexpr size_t WS_ALORA = 136 * MiB;
constexpr size_t WS_LW = 144 * MiB;
constexpr size_t WS_AA = 208 * MiB;
constexpr size_t WS_GGR = 272 * MiB;
constexpr size_t WS_VP = 304 * MiB;
constexpr size_t WS_Q = 336 * MiB;
constexpr size_t WS_QKVC = WS_Q;
constexpr size_t WS_RP = WS_Q, WS_KF = WS_Q + 64 * MiB, WS_KKN = WS_Q + 128 * MiB;
constexpr size_t WS_YA = WS_Q, WS_YB = WS_Q + 32 * MiB, WS_G2 = WS_Q + 64 * MiB, WS_X1 = WS_Q + 128 * MiB;
constexpr size_t WS_GQKV = 528 * MiB;
constexpr size_t WS_OG = 720 * MiB, WS_ORW = 784 * MiB;
constexpr size_t WS_RKV = 720 * MiB;
constexpr size_t WS_LIN = 912 * MiB;
constexpr size_t WS_DEC = 928 * MiB;
constexpr size_t WS_XB = 528 * MiB;
constexpr size_t WS_ACT = 672 * MiB;
constexpr size_t WS_YS = 816 * MiB;
constexpr size_t WS_WIN_T = 992 * MiB;
constexpr size_t WS_PROJ_T = 144 * MiB;
constexpr size_t WS_WOUT_T = 148 * MiB;
constexpr size_t WS_WGU_T = 72 * MiB;
constexpr size_t WS_WDN_T = 200 * MiB;
constexpr size_t WS_GA1 = 336 * MiB, WS_GX0 = 368 * MiB, WS_GA2 = 432 * MiB, WS_GA3 = 464 * MiB, WS_GA4 = 480 * MiB;
constexpr size_t WS_GGL = 6 * MiB;
constexpr size_t WS_RX0 = 528 * MiB, WS_RO0 = 592 * MiB, WS_RS0 = 656 * MiB;
constexpr size_t WS_RA1 = 8 * MiB, WS_RA2 = 928 * MiB, WS_RA3 = 960 * MiB, WS_RA4 = 992 * MiB;
constexpr size_t WS_RDSC = 7 * MiB;
constexpr size_t WS_LORA_T = 1012 * MiB;
constexpr size_t WS_END = 1024 * MiB;
constexpr int CW_BAR = 1024;
constexpr int CW_CNT = 256;

#define XB_TMO      128
#define XB_XCNT(j)  (256  + 64 * (j))
#define XB_XSUB(j)  (1280 + 64 * (j))
#define XB_XGEN(j)  (2304 + 64 * (j))
#define XB_TOP      3328
#define XB_TOPGEN   3392
#define XCD_BAR_WORDS 3456
#define XB_SPIN_CAP (1u << 24)
__device__ __forceinline__ unsigned xb_ld(unsigned* p)              { return __hip_atomic_load(p, __ATOMIC_RELAXED, __HIP_MEMORY_SCOPE_AGENT); }
__device__ __forceinline__ unsigned xb_add(unsigned* p, unsigned v) { return __hip_atomic_fetch_add(p, v, __ATOMIC_RELAXED, __HIP_MEMORY_SCOPE_AGENT); }
__device__ __forceinline__ unsigned xb_xcc_id() { return (unsigned)__builtin_amdgcn_s_getreg((3 << 11) | 20) & 0xFu; }
#define XB_SPIN(cond, bar) do { unsigned _sp = 0; while (cond) { __builtin_amdgcn_s_sleep(1); \
    if ((++_sp & 255u) == 0u) { if (xb_ld(&(bar)[XB_TMO])) break; if (_sp > XB_SPIN_CAP) { atomicAdd(&(bar)[XB_TMO], 1u); break; } } } } while (0)
struct XcdBarrier { unsigned* bar; unsigned x; volatile LAS unsigned* st; };
__device__ __forceinline__ XcdBarrier xcd_barrier_post(unsigned* bar, volatile LAS unsigned* st) {
    XcdBarrier b; b.bar = bar; b.x = xb_xcc_id(); b.st = st;
    if (threadIdx.x == 0) (void)xb_add(&bar[XB_XCNT(b.x)], 1u);
    return b;
}
__device__ __forceinline__ void xcd_barrier_complete(unsigned* bar, unsigned x, unsigned& nloc, unsigned& nx) {
    const unsigned G = gridDim.x * gridDim.y * gridDim.z;
    unsigned sum, cnt, mine, sp = 0u;
    for (;;) {
        sum = 0u; cnt = 0u; mine = 0u;
#pragma unroll
        for (unsigned j = 0; j < 16; ++j) { const unsigned c = xb_ld(&bar[XB_XCNT(j)]); sum += c; cnt += (c > 0u) ? 1u : 0u; mine = (j == x) ? c : mine; }
        if (sum == G) break;
        __builtin_amdgcn_s_sleep(1);
        if ((++sp & 255u) == 0u) { if (xb_ld(&bar[XB_TMO])) break; if (sp > XB_SPIN_CAP) { atomicAdd(&bar[XB_TMO], 1u); break; } }
    }
    nloc = mine > 0u ? mine : 1u; nx = cnt > 0u ? cnt : 1u;
}
__device__ __forceinline__ void xcd_barrier(const XcdBarrier& b) {
    asm volatile("s_waitcnt vmcnt(0)" ::: "memory");
    __syncthreads();
    if (threadIdx.x == 0) {
        unsigned* bar = b.bar;
        __builtin_amdgcn_s_waitcnt(0);
        unsigned nloc = b.st[0], nx = b.st[1];
        if (nloc == 0u) { xcd_barrier_complete(bar, b.x, nloc, nx); b.st[0] = nloc; b.st[1] = nx; }
        const unsigned old = xb_add(&bar[XB_XSUB(b.x)], 1u);
        const unsigned gen = old / nloc;
        if (old + 1u == (gen + 1u) * nloc) {
            __builtin_amdgcn_fence(__ATOMIC_RELEASE, "agent");
            asm volatile("s_waitcnt vmcnt(0)" ::: "memory");
            const unsigned og = xb_add(&bar[XB_TOP], 1u);
            const unsigned tg = og / nx;
            if (og + 1u == (tg + 1u) * nx) xb_add(&bar[XB_TOPGEN], 1u);
            else XB_SPIN(xb_ld(&bar[XB_TOPGEN]) == tg, bar);
            __builtin_amdgcn_fence(__ATOMIC_ACQUIRE, "agent");
            xb_add(&bar[XB_XGEN(b.x)], 1u);
            asm volatile("s_waitcnt vmcnt(0)" ::: "memory");
        } else {
            XB_SPIN(xb_ld(&bar[XB_XGEN(b.x)]) == gen, bar);
            __builtin_amdgcn_fence(__ATOMIC_ACQUIRE, "agent");
            asm volatile("s_waitcnt vmcnt(0)" ::: "memory");
        }
    }
    __syncthreads();
}

typedef unsigned short bf16;
__device__ __forceinline__ bf16 f2bf(float f) { unsigned u = __float_as_uint(f); u += 0x7fffu + ((u >> 16) & 1u); return (bf16)(u >> 16); }
__device__ __forceinline__ float bf2f(unsigned b) { return __uint_as_float(b << 16); }
__device__ __forceinline__ unsigned pk2(float lo, float hi) { return (unsigned)f2bf(lo) | ((unsigned)f2bf(hi) << 16); }
__device__ __forceinline__ float bflo(unsigned w) { return __uint_as_float(w << 16); }
__device__ __forceinline__ float bfhi(unsigned w) { return __uint_as_float(w & 0xffff0000u); }
__device__ __forceinline__ float sigm(float x) { return 1.f / (1.f + expf(-x)); }
__device__ __forceinline__ float fsigm(float x) { return __builtin_amdgcn_rcpf(1.f + __expf(-x)); }
__device__ __forceinline__ float softplusf(float x) { return x > 20.f ? x : log1pf(expf(x)); }
__device__ __forceinline__ float dpp_xor1(float v) { return __int_as_float(__builtin_amdgcn_update_dpp(0, __float_as_int(v), 0xB1, 0xF, 0xF, false)); }
__device__ __forceinline__ float wsum(float v) {
#pragma unroll
    for (int o = 32; o > 0; o >>= 1) v += __shfl_xor(v, o);
    return v;
}

struct Params { const float* in[29]; float* out; unsigned char* ws; int ph_lo, ph_hi, li, coop; };

struct Ctx {
    const Params& P; int tid, lane, wave, gwave, nwaves; size_t gtid, nthreads; unsigned char* lds;
    template <class Tp> __device__ __forceinline__ Tp* ws(size_t off) const { return (Tp*)(P.ws + off); }
};

__device__ __forceinline__ void ph_rms0(const Ctx& c) {
    const float* x = c.P.in[I_X]; const float* nw = c.P.in[I_NORM_MIX]; const float* win = c.P.in[I_W_IN];
    const float* alog = c.P.in[I_GDN_ALOG]; const float* dtb = c.P.in[I_GDN_DTB];
    bf16* HB = c.ws<bf16>(WS_HB); float* BETA = c.ws<float>(WS_BETA); float* GGv = c.ws<float>(WS_GG);
    if (blockIdx.x == 0 && c.tid < NEXP) c.ws<unsigned>(WS_CTL)[CW_CNT + c.tid] = 0u;
    float4* tab = (float4*)c.lds;
    __syncthreads();
    for (int i = c.tid; i < 4096; i += NTHREADS) { const int k = i >> 2; tab[((k & 3) * 256 + (k >> 2)) * 5 + (i & 3)] = *(const float4*)(win + (size_t)k * NCOL_IN + 4096 + (i & 3) * 4); }
    __syncthreads();
    const int lane = c.lane;
    for (int t = c.gwave; t < T; t += c.nwaves) {
        float4 v[4]; float ss = 0.f;
#pragma unroll
        for (int i = 0; i < 4; ++i) { v[i] = ((const float4*)(x + (size_t)t * D))[lane + 64 * i]; ss += v[i].x * v[i].x + v[i].y * v[i].y + v[i].z * v[i].z + v[i].w * v[i].w; }
        ss = wsum(ss);
        const float rstd = rsqrtf(ss * (1.f / 1024.f) + 1e-6f);
        float acc[16];
#pragma unroll
        for (int j = 0; j < 16; ++j) acc[j] = 0.f;
#pragma unroll
        for (int i = 0; i < 4; ++i) {
            const float4 w4 = ((const float4*)nw)[lane + 64 * i];
            float h[4] = {v[i].x * rstd * w4.x, v[i].y * rstd * w4.y, v[i].z * rstd * w4.z, v[i].w * rstd * w4.w};
            uint2 st; st.x = pk2(h[0], h[1]); st.y = pk2(h[2], h[3]);
            *(uint2*)(HB + (size_t)t * D + 4 * (lane + 64 * i)) = st;
#pragma unroll
            for (int ii = 0; ii < 4; ++ii) {
                const int k = 4 * (lane + 64 * i) + ii;
#pragma unroll
                for (int q = 0; q < 4; ++q) { const float4 w = tab[(ii * 256 + (k >> 2)) * 5 + q]; acc[4 * q + 0] += h[ii] * w.x; acc[4 * q + 1] += h[ii] * w.y; acc[4 * q + 2] += h[ii] * w.z; acc[4 * q + 3] += h[ii] * w.w; }
                if (ii & 1) asm volatile("" ::: "memory");
            }
        }
        float mine = 0.f;
#pragma unroll
        for (int j = 0; j < 16; ++j) { const float s = wsum(acc[j]); mine = (lane == j) ? s : mine; }
        if (lane < 8) BETA[t * 8 + lane] = sigm(mine);
        else if (lane < 16) { const int h = lane - 8; GGv[t * 8 + h] = -expf(alog[h]) * softplusf(mine + dtb[h]); }
    }
    __syncthreads();
}

struct NoLd {};
struct EpiInProj {
    typedef NoLd Ld; static constexpr int MB = 1;
    bf16* GQKV; bf16* ZS; bf16* RKV; float* LIN; bf16* GATES;
    __device__ __forceinline__ void load(Ld&, int, int, int) const {}
    __device__ __forceinline__ void store8(int row, int col, const float (&v)[8], int, const Ld&) const {
        if (col < 3072) { uint4 w; w.x = pk2(v[0], v[1]); w.y = pk2(v[2], v[3]); w.z = pk2(v[4], v[5]); w.w = pk2(v[6], v[7]); *(uint4*)(GQKV + (size_t)row * 3072 + col) = w; }
        else if (col < 4096) { uint4 w; w.x = pk2(v[0] * fsigm(v[0]), v[1] * fsigm(v[1])); w.y = pk2(v[2] * fsigm(v[2]), v[3] * fsigm(v[3])); w.z = pk2(v[4] * fsigm(v[4]), v[5] * fsigm(v[5])); w.w = pk2(v[6] * fsigm(v[6]), v[7] * fsigm(v[7]));
            *(uint4*)(ZS + (size_t)row * 1024 + (col - 3072)) = w; }
        else if (col < 7168) { uint4 w; w.x = pk2(v[0], v[1]); w.y = pk2(v[2], v[3]); w.z = pk2(v[4], v[5]); w.w = pk2(v[6], v[7]); *(uint4*)(RKV + (size_t)row * 3072 + (col - 4096)) = w; }
        else if (col < 7424) { float* p = LIN + (size_t)row * 256 + (col - 7168); *(float4*)p = make_float4(v[0], v[1], v[2], v[3]); *(float4*)(p + 4) = make_float4(v[4], v[5], v[6], v[7]); }
        else { uint4 w; w.x = pk2(fsigm(v[0]), fsigm(v[1])); w.y = pk2(fsigm(v[2]), fsigm(v[3])); w.z = pk2(fsigm(v[4]), fsigm(v[5])); w.w = pk2(fsigm(v[6]), fsigm(v[7]));
            *(uint4*)(GATES + (size_t)row * 2048 + (col - 7424)) = w; }
    }
};
struct EpiG2 {
    struct Ld { uint4 g; uint4 p; }; static constexpr int MB = 1;
    const bf16* GATES; bf16* MG;
    __device__ __forceinline__ void load(Ld& l, int row, int col, int) const { l.g = *(const uint4*)(GATES + (size_t)row * 2048 + col); const uint4 q = *(const uint4*)(MG + (size_t)row * 1024 + (col & 1023)); const bool b = col >= 1024; l.p = make_uint4(b ? q.x : 0u, b ? q.y : 0u, b ? q.z : 0u, b ? q.w : 0u); }
    __device__ __forceinline__ void store8(int row, int col, const float (&v)[8], int, const Ld& l) const {
        const uint4 g = l.g, p = l.p;
        uint4 w; w.x = pk2(v[0] * bflo(g.x) + bflo(p.x), v[1] * bfhi(g.x) + bfhi(p.x)); w.y = pk2(v[2] * bflo(g.y) + bflo(p.y), v[3] * bfhi(g.y) + bfhi(p.y));
        w.z = pk2(v[4] * bflo(g.z) + bflo(p.z), v[5] * bfhi(g.z) + bfhi(p.z)); w.w = pk2(v[6] * bflo(g.w) + bflo(p.w), v[7] * bfhi(g.w) + bfhi(p.w));
        *(uint4*)(MG + (size_t)row * 1024 + (col & 1023)) = w;
    }
};
struct EpiX1 {
    struct Ld { float4 a, b; }; static constexpr int MB = 2;
    const float* X; float* X1;
    __device__ __forceinline__ void load(Ld& l, int row, int col, int) const { const float* xp = X + (size_t)row * 1024 + col; l.a = *(const float4*)xp; l.b = *(const float4*)(xp + 4); }
    __device__ __forceinline__ void store8(int row, int col, const float (&v)[8], int, const Ld& l) const {
        float* op = X1 + (size_t)row * 1024 + col;
        const float4 a = l.a, b = l.b;
        *(float4*)op = make_float4(a.x + v[0], a.y + v[1], a.z + v[2], a.w + v[3]); *(float4*)(op + 4) = make_float4(b.x + v[4], b.y + v[5], b.z + v[6], b.w + v[7]);
    }
};
struct EpiAct {
    struct Ld { float4 b0, b1; }; static constexpr int MB = 4;
    const float* BGU; bf16* ACT;
    __device__ __forceinline__ void load(Ld& l, int, int col, int e) const { const float* bp = BGU + (size_t)e * 2048 + col; l.b0 = *(const float4*)bp; l.b1 = *(const float4*)(bp + 4); }
    __device__ __forceinline__ void store8(int row, int col, const float (&v)[8], int e, const Ld& l) const {
        const float4 b0 = l.b0, b1 = l.b1;
        const float bb[8] = {b0.x, b0.y, b0.z, b0.w, b1.x, b1.y, b1.z, b1.w};
        float o[4];
#pragma unroll
        for (int p = 0; p < 4; ++p) { float glu = v[2 * p] + bb[2 * p], lin = v[2 * p + 1] + bb[2 * p + 1]; glu = fminf(glu, 7.f); lin = fminf(fmaxf(lin, -7.f), 7.f); o[p] = glu * fsigm(1.702f * glu) * (lin + 1.f); }
        uint2 w; w.x = pk2(o[0], o[1]); w.y = pk2(o[2], o[3]);
        *(uint2*)(ACT + (size_t)row * 1024 + (col >> 1)) = w;
    }
};
struct EpiYS {
    struct Ld { float4 b0, b1; float g; }; static constexpr int MB = 4;
    const float* BD; const float* SGATE; bf16* YS;
    __device__ __forceinline__ void load(Ld& l, int row, int col, int e) const { const float* bp = BD + (size_t)e * 1024 + col; l.g = SGATE[row]; l.b0 = *(const float4*)bp; l.b1 = *(const float4*)(bp + 4); }
    __device__ __forceinline__ void store8(int row, int col, const float (&v)[8], int e, const Ld& l) const {
        const float g = l.g; const float4 b0 = l.b0, b1 = l.b1;
        uint4 w; w.x = pk2((v[0] + b0.x) * g, (v[1] + b0.y) * g); w.y = pk2((v[2] + b0.z) * g, (v[3] + b0.w) * g); w.z = pk2((v[4] + b1.x) * g, (v[5] + b1.y) * g); w.w = pk2((v[6] + b1.z) * g, (v[7] + b1.w) * g);
        *(uint4*)(YS + (size_t)row * 1024 + col) = w;
    }
};


namespace pg8 {
typedef short bf16x8 __attribute__((ext_vector_type(8)));
typedef float f32x4 __attribute__((ext_vector_type(4)));
constexpr int BM = 256, BK = 64, HALF = 128, HTB = HALF * BK * 2, NXCD = 8, WGM = 8;
__host__ __device__ __forceinline__ int lds_byte(int r, int c) { const int st = (r >> 4) * 2 + (c >> 5), rr = r & 15, cc = c & 31, ob = rr * 64 + cc * 2; return st * 1024 + (ob ^ (((ob >> 9) & 1) << 5)); }
__host__ __device__ __forceinline__ void stage_rc(int b, int& R, int& C) { const int st = b / 1024, sb = b % 1024, swz = sb ^ (((sb >> 9) & 1) << 5); R = (st >> 1) * 16 + swz / 64; C = (st & 1) * 32 + (swz % 64) / 2; }
__host__ __device__ __forceinline__ int perm32(int rho) { const int n = rho >> 4, i = rho & 15; return 8 * (i >> 2) + 4 * n + (i & 3); }
struct Unit { const char* a; const char* b; const int* rowmap; int row0, col0, aux; };
__device__ __forceinline__ void tile_order(int L, int nM, int nN, int& pm, int& pn) {
    const int nwg = nM * nN; int wgid = L; { const int q = nwg / NXCD, r = nwg % NXCD, xcd = wgid % NXCD, off = wgid / NXCD; wgid = (xcd < r ? xcd * (q + 1) : r * (q + 1) + (xcd - r) * q) + off; }
    const int nig = WGM * nN, gid = wgid / nig, fm = gid * WGM, gsz = (nM - fm) < WGM ? (nM - fm) : WGM;
    pm = fm + ((wgid % nig) % gsz); pn = (wgid % nig) / gsz;
}
template <class Epi>
__device__ __forceinline__ void epi_apply(const Epi& E, const f32x4 (&acc)[2][2][4][2], const Unit& u, int wr, int wc, int fr, int fq) {
    constexpr int MB = Epi::MB;
#pragma unroll
    for (int ai = 0; ai < 2; ++ai)
#pragma unroll
        for (int mp = 0; mp < 4 / MB; ++mp) {
            typename Epi::Ld ld[MB][2];
#pragma unroll
            for (int mm = 0; mm < MB; ++mm)
#pragma unroll
                for (int bj = 0; bj < 2; ++bj) E.load(ld[mm][bj], u.row0 + ai * HALF + wr * 64 + (mp * MB + mm) * 16 + fr, u.col0 + bj * HALF + wc * 32 + 8 * fq, u.aux);
#pragma unroll
            for (int mm = 0; mm < MB; ++mm)
#pragma unroll
                for (int bj = 0; bj < 2; ++bj) {
                    const int m = mp * MB + mm;
                    const f32x4 x0 = acc[ai][bj][m][0], x1 = acc[ai][bj][m][1];
                    const float v[8] = {x0[0], x0[1], x0[2], x0[3], x1[0], x1[1], x1[2], x1[3]};
                    E.store8(u.row0 + ai * HALF + wr * 64 + m * 16 + fr, u.col0 + bj * HALF + wc * 32 + 8 * fq, v, u.aux, ld[mm][bj]);
                }
            asm volatile("" ::: "memory");
        }
}
template <bool GATHER, class Epi, class Sched>
__device__ __forceinline__ void gemm_phase_t(LAS unsigned char* lds, const int K_, const Sched& S, const Epi& E, const int tid) {
    int K = K_; asm volatile("" : "+s"(K));
    const int wid = __builtin_amdgcn_readfirstlane(tid >> 6), lane = tid & 63, wr = wid >> 2, wc = wid & 3, fr = lane & 15, fq = lane >> 4;
    const int nt = K / BK;
    unsigned voffA[2], voffB[2];
#pragma unroll
    for (int i = 0; i < 2; ++i) { int R, C; stage_rc(tid * 16 + i * 8192, R, C); const int Rb = (R & ~31) + perm32(R & 31);
        voffA[i] = (unsigned)(R * K + C) * 2u; voffB[i] = (unsigned)(Rb * K + C) * 2u; }
    const size_t kstep = (size_t)(BK * 2);
    const size_t hstep = (size_t)HALF * K * 2;
    const unsigned ldsw = (unsigned)wid * 1024u;
    const int aoff = lds_byte(wr * 64 + fr, fq * 8), boff = lds_byte(wc * 32 + fr, fq * 8);
#define PG8_SA(b, h) (((b) * 2 + (h)) * HTB)
#define PG8_SB(b, h) ((4 + (b) * 2 + (h)) * HTB)
#define PG8_STAGE(bufoff, gbase, voff) do { _Pragma("unroll") for (int _i = 0; _i < 2; ++_i) \
        __builtin_amdgcn_global_load_lds((const unsigned*)((const char*)(gbase) + (voff)[_i]), (LAS unsigned*)(lds + (bufoff) + ldsw + _i * 8192), 16, 0, 0); } while (0)
#define PG8_LDA(dst, b, h) do { _Pragma("unroll") for (int m = 0; m < 4; ++m) _Pragma("unroll") for (int k = 0; k < 2; ++k) dst[m][k] = *(const LAS bf16x8*)(lds + PG8_SA(b, h) + aoff + m * 2048 + k * 1024); } while (0)
#define PG8_LDB(dst, b, h) do { _Pragma("unroll") for (int n = 0; n < 2; ++n) _Pragma("unroll") for (int k = 0; k < 2; ++k) dst[n][k] = *(const LAS bf16x8*)(lds + PG8_SB(b, h) + boff + n * 2048 + k * 1024); } while (0)
#define PG8_MMA(ai, bj, At, Bt) do { __builtin_amdgcn_s_setprio(1); _Pragma("unroll") for (int m = 0; m < 4; ++m) _Pragma("unroll") for (int n = 0; n < 2; ++n) _Pragma("unroll") for (int k = 0; k < 2; ++k) \
        acc[ai][bj][m][n] = __builtin_amdgcn_mfma_f32_16x16x32_bf16(Bt[n][k], At[m][k], acc[ai][bj][m][n], 0, 0, 0); __builtin_amdgcn_s_setprio(0); } while (0)
#define PG8_WAIT_V(n) asm volatile("s_waitcnt vmcnt(" #n ")" ::: "memory")
#define PG8_WAIT_L(n) asm volatile("s_waitcnt lgkmcnt(" #n ")" ::: "memory")
#define PG8_BAR __builtin_amdgcn_s_barrier()
#define PG8_SCHED __builtin_amdgcn_sched_barrier(0)
    Unit cur, nxt; int ui = 0;
    if (!S.next(0, cur)) return;
    f32x4 acc[2][2][4][2];
#pragma unroll
    for (int a = 0; a < 2; ++a)
#pragma unroll
        for (int b = 0; b < 2; ++b)
#pragma unroll
            for (int m = 0; m < 4; ++m)
#pragma unroll
                for (int n = 0; n < 2; ++n) acc[a][b][m][n] = (f32x4){0.f, 0.f, 0.f, 0.f};
    bf16x8 At[4][2], B0[2][2], B1[2][2];
    const char* cA = cur.a; const char* cB = cur.b;
    unsigned oc_lo[2] = {0u, 0u}, oc_hi[2] = {0u, 0u}, on_lo[2] = {0u, 0u}, on_hi[2] = {0u, 0u};
#define PG8_ROWOFF(U, LO, HI) do { _Pragma("unroll") for (int _i = 0; _i < 2; ++_i) { int R_, C_; stage_rc(tid * 16 + _i * 8192, R_, C_); \
        LO[_i] = (unsigned)((U).rowmap[R_] * K + C_) * 2u; HI[_i] = (unsigned)((U).rowmap[R_ + 128] * K + C_) * 2u; } } while (0)
    if constexpr (GATHER) PG8_ROWOFF(cur, oc_lo, oc_hi);
    PG8_STAGE(PG8_SB(0, 0), cB, voffB);
    if constexpr (GATHER) PG8_STAGE(PG8_SA(0, 0), cA, oc_lo); else PG8_STAGE(PG8_SA(0, 0), cA, voffA);
    PG8_STAGE(PG8_SB(0, 1), cB + hstep, voffB);
    if constexpr (GATHER) PG8_STAGE(PG8_SA(0, 1), cA, oc_hi); else PG8_STAGE(PG8_SA(0, 1), cA + hstep, voffA);
    if (wr == 1) PG8_BAR;
    PG8_WAIT_V(4); PG8_BAR;
    PG8_STAGE(PG8_SB(1, 0), cB + kstep, voffB);
    if constexpr (GATHER) PG8_STAGE(PG8_SA(1, 0), cA + kstep, oc_lo); else PG8_STAGE(PG8_SA(1, 0), cA + kstep, voffA);
    PG8_STAGE(PG8_SB(1, 1), cB + hstep + kstep, voffB);
    PG8_WAIT_V(6); PG8_BAR;
    for (;;) {
        const bool has_next = S.next(ui + 1, nxt);
        const char* nA = has_next ? nxt.a : cA; const char* nB = has_next ? nxt.b : cB;
        if constexpr (GATHER) { if (has_next) PG8_ROWOFF(nxt, on_lo, on_hi); else { on_lo[0] = oc_lo[0]; on_lo[1] = oc_lo[1]; on_hi[0] = oc_hi[0]; on_hi[1] = oc_hi[1]; } }
#pragma unroll 1
        for (int t = 0; t < nt; t += 2) {
            const bool last = (t == nt - 2);
            const char* a1 = cA + (size_t)(t + 1) * kstep;
            const char* a2 = last ? nA : cA + (size_t)(t + 2) * kstep; const char* b2 = last ? nB : cB + (size_t)(t + 2) * kstep;
            const char* a3 = a2 + kstep; const char* b3 = b2 + kstep;
            unsigned o2lo[2], o2hi[2];
            o2lo[0] = last ? on_lo[0] : oc_lo[0]; o2lo[1] = last ? on_lo[1] : oc_lo[1]; o2hi[0] = last ? on_hi[0] : oc_hi[0]; o2hi[1] = last ? on_hi[1] : oc_hi[1];
            PG8_LDB(B0, 0, 0); PG8_SCHED; PG8_LDA(At, 0, 0); if constexpr (GATHER) PG8_STAGE(PG8_SA(1, 1), a1, oc_hi); else PG8_STAGE(PG8_SA(1, 1), a1 + hstep, voffA);
            PG8_WAIT_L(8); PG8_BAR; PG8_WAIT_L(0); PG8_MMA(0, 0, At, B0); PG8_BAR; PG8_SCHED;
            PG8_LDB(B1, 0, 1); PG8_STAGE(PG8_SB(0, 0), b2, voffB);
            PG8_BAR; PG8_WAIT_L(0); PG8_MMA(0, 1, At, B1); PG8_BAR;
            PG8_LDA(At, 0, 1); if constexpr (GATHER) PG8_STAGE(PG8_SA(0, 0), a2, o2lo); else PG8_STAGE(PG8_SA(0, 0), a2, voffA);
            PG8_BAR; PG8_WAIT_L(0); PG8_MMA(1, 0, At, B0); PG8_BAR; PG8_SCHED;
            PG8_STAGE(PG8_SB(0, 1), b2 + hstep, voffB);
            PG8_WAIT_V(6); PG8_BAR; PG8_MMA(1, 1, At, B1); PG8_BAR;
            PG8_LDB(B0, 1, 0); PG8_SCHED; PG8_LDA(At, 1, 0); if constexpr (GATHER) PG8_STAGE(PG8_SA(0, 1), a2, o2hi); else PG8_STAGE(PG8_SA(0, 1), a2 + hstep, voffA);
            PG8_WAIT_L(8); PG8_BAR; PG8_WAIT_L(0); PG8_MMA(0, 0, At, B0); PG8_BAR; PG8_SCHED;
            PG8_LDB(B1, 1, 1); PG8_STAGE(PG8_SB(1, 0), b3, voffB);
            PG8_BAR; PG8_WAIT_L(0); PG8_MMA(0, 1, At, B1); PG8_BAR;
            PG8_LDA(At, 1, 1); if constexpr (GATHER) PG8_STAGE(PG8_SA(1, 0), a3, o2lo); else PG8_STAGE(PG8_SA(1, 0), a3, voffA);
            PG8_BAR; PG8_WAIT_L(0); PG8_MMA(1, 0, At, B0); PG8_BAR; PG8_SCHED;
            PG8_STAGE(PG8_SB(1, 1), b3 + hstep, voffB);
            PG8_WAIT_V(6); PG8_BAR; PG8_MMA(1, 1, At, B1); PG8_BAR;
        }
        epi_apply(E, acc, cur, wr, wc, fr, fq);
        if (!has_next) break;
#pragma unroll
        for (int a = 0; a < 2; ++a)
#pragma unroll
            for (int b = 0; b < 2; ++b)
#pragma unroll
                for (int m = 0; m < 4; ++m)
#pragma unroll
                    for (int n = 0; n < 2; ++n) acc[a][b][m][n] = (f32x4){0.f, 0.f, 0.f, 0.f};
        cur = nxt; cA = nA; cB = nB; ++ui;
        if constexpr (GATHER) { oc_lo[0] = on_lo[0]; oc_lo[1] = on_lo[1]; oc_hi[0] = on_hi[0]; oc_hi[1] = on_hi[1]; }
    }
    PG8_WAIT_V(0);
    if (wr == 0) PG8_BAR;
    PG8_BAR;
#undef PG8_ROWOFF
#undef PG8_SA
#undef PG8_SB
#undef PG8_STAGE
#undef PG8_LDA
#undef PG8_LDB
#undef PG8_MMA
#undef PG8_WAIT_V
#undef PG8_WAIT_L
#undef PG8_BAR
#undef PG8_SCHED
}
template <class Epi, class Sched>
__device__ __forceinline__ void gemm_phase(LAS unsigned char* lds, const int K, const Sched& S, const Epi& E, const int tid) { gemm_phase_t<false>(lds, K, S, E, tid); }
}

struct SchedInProj { const char* A; const char* Bt; int G, c;
    __device__ __forceinline__ bool next(int i, pg8::Unit& u) const { const int L = i * G + c; if (L >= 64 * 37) return false; int pm, pn; pg8::tile_order(L, 64, 37, pm, pn);
        u.a = A + (size_t)pm * (256 * 1024 * 2); u.b = Bt + (size_t)pn * (256 * 1024 * 2); u.row0 = pm * 256; u.col0 = pn * 256; u.aux = 0; u.rowmap = nullptr; return true; } };

struct WJob { const float* src; int ld_src; int K; int ncols; bf16* dst; int ld_dst; int nb; size_t sstride, dstride; };
__device__ __forceinline__ void wconv_job(const Ctx& c, const WJob& j) {
    float* tl = (float*)c.lds;
    const int ntk = j.K >> 6, ntn = j.ncols >> 6, per = ntk * ntn, ntiles = per * j.nb;
    const int rk = c.tid >> 3, rseg = (c.tid & 7) * 8;
    for (int tile = blockIdx.x; tile < ntiles; tile += gridDim.x) {
        const int bi = tile / per, tt = tile % per, tk = tt % ntk, tn = tt / ntk;
        const float* sp = j.src + (size_t)bi * j.sstride + (size_t)(tk * 64 + rk) * j.ld_src + tn * 64 + rseg;
        const float4 a = *(const float4*)sp, b = *(const float4*)(sp + 4);
        __syncthreads();
        float* row = tl + rk * 65 + rseg;
        row[0] = a.x; row[1] = a.y; row[2] = a.z; row[3] = a.w; row[4] = b.x; row[5] = b.y; row[6] = b.z; row[7] = b.w;
        __syncthreads();
        const float* col = tl + rseg * 65 + rk;
        uint4 w; w.x = pk2(col[0], col[65]); w.y = pk2(col[130], col[195]); w.z = pk2(col[260], col[325]); w.w = pk2(col[390], col[455]);
        *(uint4*)(j.dst + (size_t)bi * j.dstride + (size_t)(tn * 64 + rk) * j.ld_dst + tk * 64 + rseg) = w;
    }
}
struct SchedG2 { const char* YA; const char* Bt; int G, c;
    __device__ __forceinline__ bool next(int i, pg8::Unit& u) const { const int L = (i >> 1) * G + c, ab = i & 1; if (L >= 64 * 4) return false; int pm, pn; pg8::tile_order(L, 64, 4, pm, pn);
        u.a = YA + (size_t)ab * (WS_YB - WS_YA) + (size_t)pm * (256 * 1024 * 2); u.b = Bt + (size_t)(ab * 4 + pn) * (256 * 1024 * 2); u.row0 = pm * 256; u.col0 = ab * 1024 + pn * 256; u.aux = 0; u.rowmap = nullptr; return true; } };
struct SchedX1 { const char* A; const char* Bt; int G, c;
    __device__ __forceinline__ bool next(int i, pg8::Unit& u) const { const int L = i * G + c; if (L >= 64 * 4) return false; int pm, pn; pg8::tile_order(L, 64, 4, pm, pn);
        u.a = A + (size_t)pm * (256 * 1024 * 2); u.b = Bt + (size_t)pn * (256 * 1024 * 2); u.row0 = pm * 256; u.col0 = pn * 256; u.aux = 0; u.rowmap = nullptr; return true; } };
struct SchedMoe { const char* A; const char* Bt; const int* TILE_E; const int* SLOT_TOK; int NT, NPN, G, c;
    __device__ __forceinline__ bool next(int i, pg8::Unit& u) const { const int L = i * G + c; if (L >= NT * NPN) return false; const int tile = L / NPN, pn = L % NPN; const int e = TILE_E[tile];
        u.a = SLOT_TOK ? A : A + (size_t)tile * (256 * 1024 * 2); u.rowmap = SLOT_TOK ? SLOT_TOK + tile * 256 : nullptr;
        u.b = Bt + (size_t)(e * NPN + pn) * (256 * 1024 * 2); u.row0 = tile * 256; u.col0 = pn * 256; u.aux = e; return true; } };

struct EpiLora {
    typedef NoLd Ld; static constexpr int MB = 1;
    const float* w0; const float* a0; float* LW; float* AA; bf16* GGR;
    __device__ __forceinline__ void load(Ld&, int, int, int) const {}
    __device__ __forceinline__ void store8(int row, int col, const float (&v)[8], int, const Ld&) const {
        const float* bp = col < 1024 ? w0 + col : a0 + ((col - 1024) & 1023);
        const float4 b0 = *(const float4*)bp, b1 = *(const float4*)(bp + 4);
        const float bb[8] = {b0.x, b0.y, b0.z, b0.w, b1.x, b1.y, b1.z, b1.w};
        if (col < 1024) { float o[8];
#pragma unroll
            for (int i = 0; i < 8; ++i) o[i] = -0.6065306597126334f * fsigm(bb[i] + v[i]);
            float* p = LW + (size_t)row * 1024 + col; *(float4*)p = make_float4(o[0], o[1], o[2], o[3]); *(float4*)(p + 4) = make_float4(o[4], o[5], o[6], o[7]); }
        else if (col < 2048) { const int cc = col - 1024; float o[8];
#pragma unroll
            for (int i = 0; i < 8; ++i) o[i] = fsigm(bb[i] + v[i]);
            float* p = AA + (size_t)row * 1024 + cc; *(float4*)p = make_float4(o[0], o[1], o[2], o[3]); *(float4*)(p + 4) = make_float4(o[4], o[5], o[6], o[7]); }
        else { uint4 w; w.x = pk2(v[0], v[1]); w.y = pk2(v[2], v[3]); w.z = pk2(v[4], v[5]); w.w = pk2(v[6], v[7]); *(uint4*)(GGR + (size_t)row * 1024 + (col - 2048)) = w; }
    }
};
struct SchedLora { const char* A; const char* Bt; int G, c;
    __device__ __forceinline__ bool next(int i, pg8::Unit& u) const { const int L = i * G + c; if (L >= 64 * 12) return false; int pm, pn; pg8::tile_order(L, 64, 12, pm, pn);
        u.a = A + (size_t)pm * (256 * 256 * 2); u.b = Bt + (size_t)pn * (256 * 256 * 2); u.row0 = pm * 256; u.col0 = pn * 256; u.aux = 0; u.rowmap = nullptr; return true; } };
__device__ __forceinline__ void lora_zero(const Ctx& c) {
    uint4* LT = c.ws<uint4>(WS_LORA_T);
    for (size_t idx = c.gtid; idx < (size_t)3072 * 32; idx += c.nthreads) {
        const int row = (int)(idx >> 5), k8 = (int)(idx & 31) * 8;
        const bool data = row < 1024 ? (k8 < 64) : (row < 2048 ? (k8 >= 64 && k8 < 128) : (k8 >= 128));
        if (!data) LT[idx] = make_uint4(0, 0, 0, 0);
    }
}

__device__ __forceinline__ void ph_loraprep(const Ctx& c) {
    const float* LIN = c.ws<float>(WS_LIN); bf16* AL = c.ws<bf16>(WS_ALORA); const float* mu = c.P.in[I_MU];
    for (size_t idx = c.gtid; idx < (size_t)T * 256; idx += c.nthreads) {
        const int t = (int)(idx >> 8), cc = (int)(idx & 255);
        const float x = LIN[idx], xp = (t & (SEQ - 1)) ? LIN[idx - 256] : 0.f;
        const float xs = x + (xp - x) * mu[3072 + cc];
        const float r = cc < 64 ? tanhf(xs) : (cc < 128 ? xs : sigm(xs));
        AL[idx] = f2bf(r);
    }
}
__device__ __forceinline__ void ph_post(const Ctx& c) {
    const float* OG = c.ws<float>(WS_OG); const float* ORW = c.ws<float>(WS_ORW); const bf16* ZS = c.ws<bf16>(WS_ZS); const bf16* VP = c.ws<bf16>(WS_VP); const bf16* GGR = c.ws<bf16>(WS_GGR);
    const float* SC = c.ws<float>(WS_SC); bf16* YA = c.ws<bf16>(WS_YA); bf16* YB = c.ws<bf16>(WS_YB);
    const float* gnw = c.P.in[I_GDN_NORM]; const float* lnw = c.P.in[I_LNW]; const float* lnb = c.P.in[I_LNB];
    const int lane = c.lane, c0 = lane * 16;
    for (int t = c.gwave; t < T; t += c.nwaves) {
        {
            float o[16];
#pragma unroll
            for (int q = 0; q < 4; ++q) { const float4 v = *(const float4*)(OG + (size_t)t * 1024 + c0 + 4 * q); o[4 * q] = v.x; o[4 * q + 1] = v.y; o[4 * q + 2] = v.z; o[4 * q + 3] = v.w; }
            float ss = 0.f;
#pragma unroll
            for (int j = 0; j < 16; ++j) ss += o[j] * o[j];
            ss += __shfl_xor(ss, 1); ss += __shfl_xor(ss, 2); ss += __shfl_xor(ss, 4);
            const float rstd = rsqrtf(ss * (1.f / 128.f) + 1e-6f);
            const uint4 z0 = *(const uint4*)(ZS + (size_t)t * 1024 + c0), z1 = *(const uint4*)(ZS + (size_t)t * 1024 + c0 + 8);
            const unsigned zz[8] = {z0.x, z0.y, z0.z, z0.w, z1.x, z1.y, z1.z, z1.w};
            unsigned w[8];
#pragma unroll
            for (int j = 0; j < 8; ++j) { const int cc = (c0 + 2 * j) & 127; w[j] = pk2(o[2 * j] * rstd * gnw[cc] * bflo(zz[j]), o[2 * j + 1] * rstd * gnw[cc + 1] * bfhi(zz[j])); }
            *(uint4*)(YA + (size_t)t * 1024 + c0) = make_uint4(w[0], w[1], w[2], w[3]); *(uint4*)(YA + (size_t)t * 1024 + c0 + 8) = make_uint4(w[4], w[5], w[6], w[7]);
        }
        {
            float o[16];
#pragma unroll
            for (int q = 0; q < 4; ++q) { const float4 v = *(const float4*)(ORW + (size_t)t * 1024 + c0 + 4 * q); o[4 * q] = v.x; o[4 * q + 1] = v.y; o[4 * q + 2] = v.z; o[4 * q + 3] = v.w; }
            float sm = 0.f;
#pragma unroll
            for (int j = 0; j < 16; ++j) sm += o[j];
            sm += __shfl_xor(sm, 1); sm += __shfl_xor(sm, 2);
            const float mean = sm * (1.f / 64.f);
            float sv = 0.f;
#pragma unroll
            for (int j = 0; j < 16; ++j) { const float dd = o[j] - mean; sv += dd * dd; }
            sv += __shfl_xor(sv, 1); sv += __shfl_xor(sv, 2);
            const float rstd = rsqrtf(sv * (1.f / 64.f) + 64e-5f);
            const float sc = SC[t * 16 + (c0 >> 6)];
            const uint4 v0 = *(const uint4*)(VP + (size_t)t * 1024 + c0), v1 = *(const uint4*)(VP + (size_t)t * 1024 + c0 + 8);
            const uint4 g0 = *(const uint4*)(GGR + (size_t)t * 1024 + c0), g1 = *(const uint4*)(GGR + (size_t)t * 1024 + c0 + 8);
            const unsigned vv[8] = {v0.x, v0.y, v0.z, v0.w, v1.x, v1.y, v1.z, v1.w};
            const unsigned gg[8] = {g0.x, g0.y, g0.z, g0.w, g1.x, g1.y, g1.z, g1.w};
            unsigned w[8];
#pragma unroll
            for (int j = 0; j < 8; ++j) { const int cc = c0 + 2 * j;
                const float y0 = ((o[2 * j] - mean) * rstd * lnw[cc] + lnb[cc] + sc * bflo(vv[j])) * bflo(gg[j]);
                const float y1 = ((o[2 * j + 1] - mean) * rstd * lnw[cc + 1] + lnb[cc + 1] + sc * bfhi(vv[j])) * bfhi(gg[j]);
                w[j] = pk2(y0, y1); }
            *(uint4*)(YB + (size_t)t * 1024 + c0) = make_uint4(w[0], w[1], w[2], w[3]); *(uint4*)(YB + (size_t)t * 1024 + c0 + 8) = make_uint4(w[4], w[5], w[6], w[7]);
        }
    }
}

__device__ __forceinline__ void ph_router(const Ctx& c) {
    const float* X1 = c.ws<float>(WS_X1); const float* nw = c.P.in[I_NORM_FFN]; const float* rw = c.P.in[I_ROUTER_W]; const float* rb = c.P.in[I_ROUTER_B];
    bf16* H2 = c.ws<bf16>(WS_H2); int* TE = c.ws<int>(WS_TE); float* TG = c.ws<float>(WS_TG); int* TP = c.ws<int>(WS_TP); unsigned* CNT = c.ws<unsigned>(WS_CTL) + CW_CNT;
    const int lane = c.lane;
    float4* tab = (float4*)c.lds;
    unsigned* lcnt = (unsigned*)(c.lds + 147456);
    __syncthreads();
    if (c.tid < 32) lcnt[c.tid] = 0u;
    for (int i = c.tid; i < 8192; i += NTHREADS) { const int k = i >> 3; tab[((k & 3) * 256 + (k >> 2)) * 9 + (i & 7)] = ((const float4*)rw)[i]; }
    __syncthreads();
    for (int t = c.gwave; t < T; t += c.nwaves) {
        float4 v[4]; float ss = 0.f;
#pragma unroll
        for (int i = 0; i < 4; ++i) { v[i] = ((const float4*)(X1 + (size_t)t * D))[lane + 64 * i]; ss += v[i].x * v[i].x + v[i].y * v[i].y + v[i].z * v[i].z + v[i].w * v[i].w; }
        ss = wsum(ss);
        const float rstd = rsqrtf(ss * (1.f / 1024.f) + 1e-6f);
        float lg[32];
#pragma unroll
        for (int j = 0; j < 32; ++j) lg[j] = 0.f;
#pragma unroll
        for (int i = 0; i < 4; ++i) {
            const float4 w4 = ((const float4*)nw)[lane + 64 * i];
            const float h[4] = {v[i].x * rstd * w4.x, v[i].y * rstd * w4.y, v[i].z * rstd * w4.z, v[i].w * rstd * w4.w};
            uint2 st; st.x = pk2(h[0], h[1]); st.y = pk2(h[2], h[3]);
            *(uint2*)(H2 + (size_t)t * D + 4 * (lane + 64 * i)) = st;
#pragma unroll
            for (int ii = 0; ii < 4; ++ii) {
                const float4* wr = tab + (size_t)(ii * 256 + lane + 64 * i) * 9;
#pragma unroll
                for (int q = 0; q < 8; ++q) { const float4 w = wr[q]; lg[4 * q] += h[ii] * w.x; lg[4 * q + 1] += h[ii] * w.y; lg[4 * q + 2] += h[ii] * w.z; lg[4 * q + 3] += h[ii] * w.w; }
                asm volatile("" ::: "memory");
            }
        }
#pragma unroll
        for (int j = 0; j < 32; ++j) lg[j] = wsum(lg[j]) + rb[j];
        int e0 = 0, e1 = 0, e2 = 0, e3 = 0; float v0 = -3e38f, v1 = -3e38f, v2 = -3e38f, v3 = -3e38f;
#pragma unroll
        for (int j = 0; j < 32; ++j) if (lg[j] > v0) { v0 = lg[j]; e0 = j; }
#pragma unroll
        for (int j = 0; j < 32; ++j) if (j != e0 && lg[j] > v1) { v1 = lg[j]; e1 = j; }
#pragma unroll
        for (int j = 0; j < 32; ++j) if (j != e0 && j != e1 && lg[j] > v2) { v2 = lg[j]; e2 = j; }
#pragma unroll
        for (int j = 0; j < 32; ++j) if (j != e0 && j != e1 && j != e2 && lg[j] > v3) { v3 = lg[j]; e3 = j; }
        const float x1 = expf(v1 - v0), x2 = expf(v2 - v0), x3 = expf(v3 - v0), inv = 1.f / (1.f + x1 + x2 + x3);
        if (lane < 4) {
            const int me = lane == 0 ? e0 : (lane == 1 ? e1 : (lane == 2 ? e2 : e3));
            const float mg = (lane == 0 ? 1.f : (lane == 1 ? x1 : (lane == 2 ? x2 : x3))) * inv;
            const unsigned pos = atomicAdd(&lcnt[me], 1u);
            TE[t * 4 + lane] = me; TG[t * 4 + lane] = mg; TP[t * 4 + lane] = (int)pos;
        }
    }
    __syncthreads();
    if (c.tid < 32) lcnt[32 + c.tid] = atomicAdd(&CNT[c.tid], lcnt[c.tid]);
    __syncthreads();
    if (lane < 4) for (int t = c.gwave; t < T; t += c.nwaves) TP[t * 4 + lane] += (int)lcnt[32 + TE[t * 4 + lane]];
    __syncthreads();
}

__device__ __forceinline__ void ph_dispatch(const Ctx& c) {
    int* tb = (int*)c.lds;
    const unsigned* CNT = c.ws<unsigned>(WS_CTL) + CW_CNT;
    int* TILE_E = c.ws<int>(WS_TILE_E); int* NT = c.ws<int>(WS_NT);
    const int* TE = c.ws<int>(WS_TE); const float* TG = c.ws<float>(WS_TG); const int* TP = c.ws<int>(WS_TP); int* TSLOT = c.ws<int>(WS_TSLOT);
    float* SGATE = c.ws<float>(WS_SGATE); const bf16* H2 = c.ws<bf16>(WS_H2); bf16* XB = c.ws<bf16>(WS_XB);
    if (c.tid == 0) { int acc = 0; for (int e = 0; e < NEXP; ++e) { const int n = (int)__hip_atomic_load(&CNT[e], __ATOMIC_RELAXED, __HIP_MEMORY_SCOPE_AGENT); tb[e] = acc; tb[64 + e] = n; acc += (n + 255) >> 8; } tb[32] = acc; }
    __syncthreads();
    if (blockIdx.x == 0) {
        for (int tile = c.tid; tile < tb[32]; tile += NTHREADS) { int e = 0; for (int q = 0; q < NEXP; ++q) if (tile >= tb[q]) e = q; TILE_E[tile] = e; }
        if (c.tid == 0) *NT = tb[32];
    }
    int* SLOT_TOK = c.ws<int>(WS_SLOT_TOK);
    for (size_t idx = c.gtid; idx < (size_t)T * 4; idx += c.nthreads) {
        const int t = (int)(idx >> 2), e = TE[idx], pos = TP[idx];
        const int slot = tb[e] * 256 + pos;
        TSLOT[idx] = slot; SGATE[slot] = TG[idx]; SLOT_TOK[slot] = t;
    }
    for (int e = 0; e < NEXP; ++e) {
        const int n = tb[64 + e], cap = (tb[e + 1] - tb[e]) * 256;
        for (int r = n + (int)c.gtid; r < cap; r += (int)c.nthreads) { const int slot = tb[e] * 256 + r; SLOT_TOK[slot] = 0; SGATE[slot] = 0.f; }
    }
}

__device__ __forceinline__ void ph_combine(const Ctx& c) {
    const float* X1 = c.ws<float>(WS_X1); const bf16* YS = c.ws<bf16>(WS_YS); const int* TSLOT = c.ws<int>(WS_TSLOT); const float* nw = c.P.in[I_NORM_FINAL]; float* out = c.P.out;
    const int lane = c.lane;
    for (int t = c.gwave; t < T; t += c.nwaves) {
        const int s0 = TSLOT[t * 4], s1 = TSLOT[t * 4 + 1], s2 = TSLOT[t * 4 + 2], s3 = TSLOT[t * 4 + 3];
        float4 v[4]; float ss = 0.f;
#pragma unroll
        for (int i = 0; i < 4; ++i) {
            const int col = 4 * (lane + 64 * i);
            v[i] = *(const float4*)(X1 + (size_t)t * D + col);
            const uint2 a = *(const uint2*)(YS + (size_t)s0 * 1024 + col), b = *(const uint2*)(YS + (size_t)s1 * 1024 + col), cc = *(const uint2*)(YS + (size_t)s2 * 1024 + col), d = *(const uint2*)(YS + (size_t)s3 * 1024 + col);
            v[i].x += bflo(a.x) + bflo(b.x) + bflo(cc.x) + bflo(d.x); v[i].y += bfhi(a.x) + bfhi(b.x) + bfhi(cc.x) + bfhi(d.x);
            v[i].z += bflo(a.y) + bflo(b.y) + bflo(cc.y) + bflo(d.y); v[i].w += bfhi(a.y) + bfhi(b.y) + bfhi(cc.y) + bfhi(d.y);
            ss += v[i].x * v[i].x + v[i].y * v[i].y + v[i].z * v[i].z + v[i].w * v[i].w;
        }
        ss = wsum(ss);
        const float rstd = rsqrtf(ss * (1.f / 1024.f) + 1e-6f);
#pragma unroll
        for (int i = 0; i < 4; ++i) { const float4 w4 = ((const float4*)nw)[lane + 64 * i];
            *(float4*)(out + (size_t)t * D + 4 * (lane + 64 * i)) = make_float4(v[i].x * rstd * w4.x, v[i].y * rstd * w4.y, v[i].z * rstd * w4.z, v[i].w * rstd * w4.w); }
    }
}


typedef short bf16x8_t __attribute__((ext_vector_type(8)));
typedef float f32x4_t __attribute__((ext_vector_type(4)));
#define MFMA16(a, b, c) __builtin_amdgcn_mfma_f32_16x16x32_bf16((a), (b), (c), 0, 0, 0)


__device__ __forceinline__ int frag_off(int row, int k, int KBn) { return (((row >> 4) * KBn + (k >> 5)) * 512) + (((k >> 3) & 3) * 128) + ((row & 15) * 8) + (k & 7); }
__device__ __forceinline__ int cfrag_off(int v, int r, int NRT) { return ((((v >> 4) * NRT + (r >> 4)) * 64 + ((r >> 2) & 3) * 16 + (v & 15)) * 4) + (r & 3); }

constexpr int GCL_HALF_BYTES = 71680;
__device__ __forceinline__ void ph_gcl(const Ctx& c) {
    const bf16* GQKV = c.ws<bf16>(WS_GQKV); const float* BETA = c.ws<float>(WS_BETA); const float* GGv = c.ws<float>(WS_GG); const float* cw = c.P.in[I_GDN_CONV];
    bf16* GA1 = c.ws<bf16>(WS_GA1); bf16* GX0 = c.ws<bf16>(WS_GX0); bf16* GA2 = c.ws<bf16>(WS_GA2); bf16* GA3 = c.ws<bf16>(WS_GA3); bf16* GA4 = c.ws<bf16>(WS_GA4); float* GGL = c.ws<float>(WS_GGL);
    for (int it0 = blockIdx.x * 2; it0 < 2048; it0 += gridDim.x * 2) {
        int tv = c.tid; asm volatile("" : "+v"(tv));
        const int half = tv >> 8, ht = tv & 255, lane = tv & 63, w4 = __builtin_amdgcn_readfirstlane((tv >> 6) & 3);
        unsigned char* base = c.lds + half * GCL_HALF_BYTES;
        bf16* QB = (bf16*)base;
        bf16* KB = QB + 64 * 136;
        bf16* VB = KB + 64 * 136;
        float* MM = (float*)(VB + 64 * 136);
        float* GC = MM + 64 * 64;
        float* BT = GC + 64;
        float* BE = BT + 64;
        const int item = it0 + half, n = item & 63, bh = item >> 6, h = bh & 7, b = bh >> 3;
        const int t0 = b * SEQ + n * 64;
        __syncthreads();
        if (w4 == 0) {
            float g = GGv[(size_t)(t0 + lane) * 8 + h]; const float be = BETA[(size_t)(t0 + lane) * 8 + h];
#pragma unroll
            for (int o = 1; o < 64; o <<= 1) { const float u = __shfl_up(g, o); if (lane >= o) g += u; }
            GC[lane] = g; BT[lane] = be; BE[lane] = be * __expf(g);
        }
        __syncthreads();
        {
            const int cg = ht & 15, rg = ht >> 4, r0 = rg * 4;
#pragma unroll
            for (int mat = 0; mat < 3; ++mat) {
                const int col0 = mat * 1024 + h * 128 + cg * 8;
                float4 xa[7], xb[7], wa[4], wb[4];
#pragma unroll
                for (int li = 0; li < 7; ++li) {
                    const bool valid = (n > 0) || (r0 - 3 + li >= 0);
                    uint4 xr = make_uint4(0, 0, 0, 0);
                    if (valid) xr = *(const uint4*)(GQKV + (size_t)(t0 + r0 - 3 + li) * 3072 + col0);
                    xa[li] = make_float4(bflo(xr.x), bfhi(xr.x), bflo(xr.y), bfhi(xr.y));
                    xb[li] = make_float4(bflo(xr.z), bfhi(xr.z), bflo(xr.w), bfhi(xr.w));
                }
#pragma unroll
                for (int j = 0; j < 4; ++j) { wa[j] = *(const float4*)(cw + j * 3072 + col0); wb[j] = *(const float4*)(cw + j * 3072 + col0 + 4); }
#pragma unroll
                for (int rr = 0; rr < 4; ++rr) {
                    float o[8] = {0.f, 0.f, 0.f, 0.f, 0.f, 0.f, 0.f, 0.f};
#pragma unroll
                    for (int j = 0; j < 4; ++j) { const float4 a = xa[rr + j], bq = xb[rr + j];
                        o[0] += wa[j].x * a.x; o[1] += wa[j].y * a.y; o[2] += wa[j].z * a.z; o[3] += wa[j].w * a.w;
                        o[4] += wb[j].x * bq.x; o[5] += wb[j].y * bq.y; o[6] += wb[j].z * bq.z; o[7] += wb[j].w * bq.w; }
                    float ss = 0.f;
#pragma unroll
                    for (int e = 0; e < 8; ++e) { o[e] *= fsigm(o[e]); ss += o[e] * o[e]; }
                    float sc = 1.f;
                    if (mat < 2) { ss += __shfl_xor(ss, 1); ss += __shfl_xor(ss, 2); ss += __shfl_xor(ss, 4); ss += __shfl_xor(ss, 8); sc = rsqrtf(ss + 1e-6f) * (mat == 0 ? 0.08838834764831845f : 1.f); }
                    const int r = r0 + rr;
                    uint4 w; w.x = pk2(o[0] * sc, o[1] * sc); w.y = pk2(o[2] * sc, o[3] * sc); w.z = pk2(o[4] * sc, o[5] * sc); w.w = pk2(o[6] * sc, o[7] * sc);
                    *(uint4*)((mat == 0 ? QB : (mat == 1 ? KB : VB)) + r * 136 + cg * 8) = w;
                    if (mat == 0) {
                        const float s2 = sc * __expf(GC[r]);
                        w.x = pk2(o[0] * s2, o[1] * s2); w.y = pk2(o[2] * s2, o[3] * s2); w.z = pk2(o[4] * s2, o[5] * s2); w.w = pk2(o[6] * s2, o[7] * s2);
                        *(uint4*)(GA2 + (size_t)item * 64 * 128 + frag_off(r, cg * 8, 4)) = w;
                    }
                }
            }
        }
        __syncthreads();
        {
            const int fr = lane & 15, fq = lane >> 4, a0 = w4 * 16;
            bf16x8_t ka[4];
#pragma unroll
            for (int kb = 0; kb < 4; ++kb) ka[kb] = *(const bf16x8_t*)(KB + (a0 + fr) * 136 + kb * 32 + fq * 8);
#pragma unroll
            for (int bt = 0; bt < 4; ++bt) {
                f32x4_t c1 = {0.f, 0.f, 0.f, 0.f}, c2 = {0.f, 0.f, 0.f, 0.f};
#pragma unroll
                for (int kb = 0; kb < 4; ++kb) {
                    const bf16x8_t kbf = *(const bf16x8_t*)(KB + (bt * 16 + fr) * 136 + kb * 32 + fq * 8);
                    const bf16x8_t qbf = *(const bf16x8_t*)(QB + (bt * 16 + fr) * 136 + kb * 32 + fq * 8);
                    c1 = MFMA16(ka[kb], kbf, c1); c2 = MFMA16(ka[kb], qbf, c2);
                }
                const int i = bt * 16 + fr, j0 = a0 + 4 * fq;
                const float gi = GC[i], bi = BT[i];
                float m[4], at[4];
#pragma unroll
                for (int rg = 0; rg < 4; ++rg) { const int j = j0 + rg; const float dec = __expf(fminf(gi - GC[j], 0.f));
                    m[rg] = (i > j) ? bi * c1[rg] * dec : 0.f; at[rg] = (i >= j) ? c2[rg] * dec : 0.f; }
                *(float4*)(MM + i * 64 + j0) = make_float4(m[0], m[1], m[2], m[3]);
                uint2 w; w.x = pk2(at[0], at[1]); w.y = pk2(at[2], at[3]);
                *(uint2*)(GA3 + (size_t)item * 64 * 64 + frag_off(i, j0, 2)) = w;
            }
        }
        __syncthreads();
        {
            const int cc = ht & 127; const bool isw = ht >= 128;
            const bf16* srcp = (isw ? KB : VB) + cc; const float* scl = isw ? BE : BT;
            float x[64];
#pragma unroll
            for (int i = 0; i < 64; ++i) x[i] = 0.f;
            float4 mc[16], mn[16];
#pragma unroll
            for (int q = 0; q < 16; ++q) { mc[q] = make_float4(0.f, 0.f, 0.f, 0.f); mn[q] = mc[q]; }
            float rhs_n = scl[0] * bf2f(srcp[0]);
#pragma unroll
            for (int i = 0; i < 64; ++i) {
                const float rhs = rhs_n;
                if (i + 1 < 64) {
#pragma unroll
                    for (int j4 = 0; j4 < (i + 4) / 4; ++j4) mn[j4] = *(const float4*)(MM + (i + 1) * 64 + 4 * j4);
                    rhs_n = scl[i + 1] * bf2f(srcp[(i + 1) * 136]);
                }
                float acc = rhs, ac1 = 0.f, ac2 = 0.f, ac3 = 0.f;
#pragma unroll
                for (int j4 = 0; j4 < (i + 3) / 4; ++j4) { acc -= mc[j4].x * x[4 * j4]; ac1 -= mc[j4].y * x[4 * j4 + 1]; ac2 -= mc[j4].z * x[4 * j4 + 2]; ac3 -= mc[j4].w * x[4 * j4 + 3]; }
                x[i] = (acc + ac1) + (ac2 + ac3);
#pragma unroll
                for (int j4 = 0; j4 < 16; ++j4) mc[j4] = mn[j4];
                asm volatile("" ::: "memory");
            }
            if (!isw) {
                bf16* up = GX0 + (size_t)item * 128 * 64;
#pragma unroll
                for (int q = 0; q < 16; ++q) { uint2 w; w.x = pk2(x[4 * q], x[4 * q + 1]); w.y = pk2(x[4 * q + 2], x[4 * q + 3]); *(uint2*)(up + cfrag_off(cc, 4 * q, 4)) = w; }
            }
            __syncthreads();
            if (isw) {
                bf16* a1s = (bf16*)MM;
#pragma unroll
                for (int i = 0; i < 64; ++i) a1s[i * 128 + cc] = f2bf(-x[i]);
            }
        }
        __syncthreads();
        {
            const bf16* a1s = (const bf16*)MM; bf16* wp = GA1 + (size_t)item * 64 * 128;
#pragma unroll
            for (int q = 0; q < 4; ++q) { const int p = ht + 256 * q, fr = p & 15, fq = (p >> 4) & 3, kb = (p >> 6) & 3, rt = p >> 8;
                *(uint4*)(wp + p * 8) = *(const uint4*)(a1s + (rt * 16 + fr) * 128 + kb * 32 + fq * 8); }
        }
        {
            const int dk = ht & 127, hh = ht >> 7; const float g63 = GC[63];
            unsigned w[16];
#pragma unroll
            for (int q = 0; q < 16; ++q) { const int ta = hh * 32 + 2 * q;
                w[q] = pk2(bf2f(KB[ta * 136 + dk]) * __expf(g63 - GC[ta]), bf2f(KB[(ta + 1) * 136 + dk]) * __expf(g63 - GC[ta + 1])); }
            bf16* dp = GA4 + (size_t)item * 128 * 64;
            *(uint4*)(dp + frag_off(dk, hh * 32, 2)) = make_uint4(w[0], w[1], w[2], w[3]); *(uint4*)(dp + frag_off(dk, hh * 32 + 8, 2)) = make_uint4(w[4], w[5], w[6], w[7]);
            *(uint4*)(dp + frag_off(dk, hh * 32 + 16, 2)) = make_uint4(w[8], w[9], w[10], w[11]); *(uint4*)(dp + frag_off(dk, hh * 32 + 24, 2)) = make_uint4(w[12], w[13], w[14], w[15]);
            if (ht == 0) GGL[item] = __expf(g63);
        }
    }
}

constexpr int RCL_HALF_BYTES = 75776;
__device__ __forceinline__ void ph_rcl(const Ctx& c) {
    const bf16* RKV = c.ws<bf16>(WS_RKV); const float* LW = c.ws<float>(WS_LW); const float* AAg = c.ws<float>(WS_AA);
    const float* mu = c.P.in[I_MU]; const float* k_k = c.P.in[I_KK]; const float* k_a = c.P.in[I_KA]; const float* r_k = c.P.in[I_RK];
    bf16* VP = c.ws<bf16>(WS_VP); float* SC = c.ws<float>(WS_SC);
    bf16* RA1 = c.ws<bf16>(WS_RA1); bf16* RX0 = c.ws<bf16>(WS_RX0); bf16* RA2 = c.ws<bf16>(WS_RA2); bf16* RA3 = c.ws<bf16>(WS_RA3); bf16* RO0 = c.ws<bf16>(WS_RO0);
    bf16* RA4 = c.ws<bf16>(WS_RA4); bf16* RS0 = c.ws<bf16>(WS_RS0); float* RDSC = c.ws<float>(WS_RDSC);
    for (int it0 = blockIdx.x * 2; it0 < 4096; it0 += gridDim.x * 2) {
        int tv = c.tid; asm volatile("" : "+v"(tv));
        const int half = tv >> 8, ht = tv & 255, lane = tv & 63, w4 = __builtin_amdgcn_readfirstlane((tv >> 6) & 3);
        unsigned char* base = c.lds + half * RCL_HALF_BYTES;
        bf16* AT = (bf16*)base;
        bf16* VT = AT + 64 * 72;
        bf16* KDT = VT + 64 * 72;
        float* AAB = (float*)(KDT + 64 * 72);
        float* TOT = AAB + 64 * 64;
        unsigned char* RX = (unsigned char*)(TOT + 256);
        bf16* RT = (bf16*)RX;
        bf16* BTL = RT + 64 * 72;
        bf16* KT = BTL + 64 * 72;
        bf16* AAK = (bf16*)RX;
        bf16* ARK = AAK + 64 * 72;
        float* RHS2 = (float*)RX;
        const int item = it0 + half, n = item & 63, bh = item >> 6, h = bh & 15, b = bh >> 4;
        const int t0 = b * SEQ + n * 64;
        __syncthreads();
        const int r = ht >> 2, seg = ht & 3, c0 = seg * 16, t = t0 + r; const bool first = (n == 0 && r == 0);
        float rr[16], kf[16], vv[16], kkv[16], aa[16], lwl[16];
        float ss = 0.f, scs = 0.f;
        {
            const bf16* cur = RKV + (size_t)t * 3072 + h * 64 + c0; const bf16* prv = cur - 3072;
            uint4 ur[2], uk[2], uv[2], qr[2], qk[2], qv[2];
            float4 a4v[4], l4v[4], mr[4], mk[4], mv[4], kkw[4], kaw[4], rkw[4];
#pragma unroll
            for (int g = 0; g < 2; ++g) {
                ur[g] = *(const uint4*)(cur + 8 * g); uk[g] = *(const uint4*)(cur + 1024 + 8 * g); uv[g] = *(const uint4*)(cur + 2048 + 8 * g);
                qr[g] = make_uint4(0, 0, 0, 0); qk[g] = qr[g]; qv[g] = qr[g];
                if (!first) { qr[g] = *(const uint4*)(prv + 8 * g); qk[g] = *(const uint4*)(prv + 1024 + 8 * g); qv[g] = *(const uint4*)(prv + 2048 + 8 * g); }
            }
#pragma unroll
            for (int q = 0; q < 4; ++q) {
                l4v[q] = *(const float4*)(LW + (size_t)t * 1024 + h * 64 + c0 + 4 * q);
                a4v[q] = *(const float4*)(AAg + (size_t)t * 1024 + h * 64 + c0 + 4 * q);
                mr[q] = *(const float4*)(mu + h * 64 + c0 + 4 * q); mk[q] = *(const float4*)(mu + 1024 + h * 64 + c0 + 4 * q); mv[q] = *(const float4*)(mu + 2048 + h * 64 + c0 + 4 * q);
                kkw[q] = *(const float4*)(k_k + h * 64 + c0 + 4 * q); kaw[q] = *(const float4*)(k_a + h * 64 + c0 + 4 * q); rkw[q] = *(const float4*)(r_k + h * 64 + c0 + 4 * q);
            }
#pragma unroll
            for (int q = 0; q < 4; ++q) *(float4*)(AAB + r * 64 + c0 + 4 * q) = l4v[q];
            __syncthreads();
            {
                const int ch = ht & 63, tq = ht >> 6;
                float run = 0.f;
#pragma unroll
                for (int i = 0; i < 16; ++i) { run += AAB[(tq * 16 + i) * 64 + ch]; AAB[(tq * 16 + i) * 64 + ch] = run; }
                TOT[tq * 64 + ch] = run;
            }
            __syncthreads();
#pragma unroll
            for (int q = 0; q < 4; ++q) {
                const int g = q >> 1; const bool hi = q & 1;
                const unsigned r_a = hi ? ur[g].z : ur[g].x, r_b = hi ? ur[g].w : ur[g].y, k_a_ = hi ? uk[g].z : uk[g].x, k_b_ = hi ? uk[g].w : uk[g].y, v_a = hi ? uv[g].z : uv[g].x, v_b = hi ? uv[g].w : uv[g].y;
                const unsigned pr_a = hi ? qr[g].z : qr[g].x, pr_b = hi ? qr[g].w : qr[g].y, pk_a = hi ? qk[g].z : qk[g].x, pk_b = hi ? qk[g].w : qk[g].y, pv_a = hi ? qv[g].z : qv[g].x, pv_b = hi ? qv[g].w : qv[g].y;
                const float r0a[4] = {bflo(r_a), bfhi(r_a), bflo(r_b), bfhi(r_b)}, k0a[4] = {bflo(k_a_), bfhi(k_a_), bflo(k_b_), bfhi(k_b_)}, v0a[4] = {bflo(v_a), bfhi(v_a), bflo(v_b), bfhi(v_b)};
                const float rpa[4] = {bflo(pr_a), bfhi(pr_a), bflo(pr_b), bfhi(pr_b)}, kpa[4] = {bflo(pk_a), bfhi(pk_a), bflo(pk_b), bfhi(pk_b)}, vpa[4] = {bflo(pv_a), bfhi(pv_a), bflo(pv_b), bfhi(pv_b)};
                const float mra[4] = {mr[q].x, mr[q].y, mr[q].z, mr[q].w}, mka[4] = {mk[q].x, mk[q].y, mk[q].z, mk[q].w}, mva[4] = {mv[q].x, mv[q].y, mv[q].z, mv[q].w};
                const float kka[4] = {kkw[q].x, kkw[q].y, kkw[q].z, kkw[q].w}, kaa[4] = {kaw[q].x, kaw[q].y, kaw[q].z, kaw[q].w}, rka[4] = {rkw[q].x, rkw[q].y, rkw[q].z, rkw[q].w};
                const float aaa[4] = {a4v[q].x, a4v[q].y, a4v[q].z, a4v[q].w}, lwa[4] = {l4v[q].x, l4v[q].y, l4v[q].z, l4v[q].w};
#pragma unroll
                for (int e = 0; e < 4; ++e) { const int i = 4 * q + e;
                    rr[i] = r0a[e] + (rpa[e] - r0a[e]) * mra[e]; const float kx = k0a[e] + (kpa[e] - k0a[e]) * mka[e]; vv[i] = v0a[e] + (vpa[e] - v0a[e]) * mva[e];
                    kkv[i] = kx * kka[e]; ss += kkv[i] * kkv[i]; aa[i] = aaa[e]; lwl[i] = lwa[e]; kf[i] = kx * (1.f + (aaa[e] - 1.f) * kaa[e]); scs += rr[i] * kf[i] * rka[e]; }
            }
        }
        {
            ss += __shfl_xor(ss, 1); ss += __shfl_xor(ss, 2); scs += __shfl_xor(scs, 1); scs += __shfl_xor(scs, 2);
            const float rn = rsqrtf(ss + 1e-6f);
            if (seg == 0) SC[(size_t)t * 16 + h] = scs;
            const int tq = r >> 4;
            unsigned wat[8], wbt[8], wkt[8], wrt[8], wvp[8];
            float atv[16], btv[16], ktv[16], rtv[16];
#pragma unroll
            for (int i = 0; i < 16; ++i) {
                const int ch = c0 + i;
                float off = 0.f;
#pragma unroll
                for (int q = 0; q < 3; ++q) off += (q < tq) ? TOT[q * 64 + ch] : 0.f;
                const float tot = TOT[ch] + TOT[64 + ch] + TOT[128 + ch] + TOT[192 + ch];
                const float cs = AAB[r * 64 + ch] + off;
                const float lwv = lwl[i];
                const float kk = kkv[i] * rn;
                const float e2 = __expf(-cs), e4 = __expf(tot - cs);
                atv[i] = kk * __expf(cs - lwv); btv[i] = -kk * aa[i] * e2; ktv[i] = kf[i] * e2; rtv[i] = rr[i] * __expf(cs);
                VT[ch * 72 + r] = f2bf(vv[i]);
                KDT[ch * 72 + r] = f2bf(kf[i] * e4);
                RA4[(size_t)item * 64 * 64 + frag_off(ch, r, 2)] = f2bf(-kk * aa[i] * e4);
                if (r == 63) RDSC[(size_t)item * 64 + ch] = __expf(tot);
            }
#pragma unroll
            for (int q = 0; q < 8; ++q) { wat[q] = pk2(atv[2 * q], atv[2 * q + 1]); wbt[q] = pk2(btv[2 * q], btv[2 * q + 1]); wkt[q] = pk2(ktv[2 * q], ktv[2 * q + 1]); wrt[q] = pk2(rtv[2 * q], rtv[2 * q + 1]); wvp[q] = pk2(vv[2 * q], vv[2 * q + 1]); }
            *(uint4*)(AT + r * 72 + c0) = make_uint4(wat[0], wat[1], wat[2], wat[3]); *(uint4*)(AT + r * 72 + c0 + 8) = make_uint4(wat[4], wat[5], wat[6], wat[7]);
            *(uint4*)(BTL + r * 72 + c0) = make_uint4(wbt[0], wbt[1], wbt[2], wbt[3]); *(uint4*)(BTL + r * 72 + c0 + 8) = make_uint4(wbt[4], wbt[5], wbt[6], wbt[7]);
            *(uint4*)(KT + r * 72 + c0) = make_uint4(wkt[0], wkt[1], wkt[2], wkt[3]); *(uint4*)(KT + r * 72 + c0 + 8) = make_uint4(wkt[4], wkt[5], wkt[6], wkt[7]);
            *(uint4*)(RT + r * 72 + c0) = make_uint4(wrt[0], wrt[1], wrt[2], wrt[3]); *(uint4*)(RT + r * 72 + c0 + 8) = make_uint4(wrt[4], wrt[5], wrt[6], wrt[7]);
            bf16* a2p = RA2 + (size_t)item * 64 * 64;
            *(uint4*)(a2p + frag_off(r, c0, 2)) = make_uint4(wrt[0], wrt[1], wrt[2], wrt[3]); *(uint4*)(a2p + frag_off(r, c0 + 8, 2)) = make_uint4(wrt[4], wrt[5], wrt[6], wrt[7]);
            bf16* vpp = VP + (size_t)t * 1024 + h * 64 + c0;
            *(uint4*)vpp = make_uint4(wvp[0], wvp[1], wvp[2], wvp[3]); *(uint4*)(vpp + 8) = make_uint4(wvp[4], wvp[5], wvp[6], wvp[7]);
        }
        __syncthreads();
        const int fr = lane & 15, fq = lane >> 4;
        f32x4_t cab[4], cak[4], crb[4], crk[4];
        {
            const int j0t = w4 * 16;
            bf16x8_t bj[2], kj[2];
#pragma unroll
            for (int kb = 0; kb < 2; ++kb) { bj[kb] = *(const bf16x8_t*)(BTL + (j0t + fr) * 72 + kb * 32 + fq * 8); kj[kb] = *(const bf16x8_t*)(KT + (j0t + fr) * 72 + kb * 32 + fq * 8); }
#pragma unroll
            for (int it = 0; it < 4; ++it) {
                cab[it] = (f32x4_t){0.f, 0.f, 0.f, 0.f}; cak[it] = cab[it]; crb[it] = cab[it]; crk[it] = cab[it];
#pragma unroll
                for (int kb = 0; kb < 2; ++kb) {
                    const bf16x8_t ai = *(const bf16x8_t*)(AT + (it * 16 + fr) * 72 + kb * 32 + fq * 8);
                    const bf16x8_t ri = *(const bf16x8_t*)(RT + (it * 16 + fr) * 72 + kb * 32 + fq * 8);
                    cab[it] = MFMA16(bj[kb], ai, cab[it]); cak[it] = MFMA16(kj[kb], ai, cak[it]); crb[it] = MFMA16(bj[kb], ri, crb[it]); crk[it] = MFMA16(kj[kb], ri, crk[it]);
                }
            }
        }
        __syncthreads();
        {
            const int j0 = w4 * 16 + 4 * fq;
#pragma unroll
            for (int it = 0; it < 4; ++it) {
                const int i = it * 16 + fr;
                float vab[4], vak[4], vrb[4], vrk[4];
#pragma unroll
                for (int rg = 0; rg < 4; ++rg) { const int j = j0 + rg; const bool st = i > j, in = i >= j;
                    vab[rg] = st ? cab[it][rg] : 0.f; vak[rg] = st ? cak[it][rg] : 0.f; vrb[rg] = in ? crb[it][rg] : 0.f; vrk[rg] = in ? crk[it][rg] : 0.f; }
                *(float4*)(AAB + i * 64 + j0) = make_float4(vab[0], vab[1], vab[2], vab[3]);
                uint2 w; w.x = pk2(vak[0], vak[1]); w.y = pk2(vak[2], vak[3]); *(uint2*)(AAK + i * 72 + j0) = w;
                w.x = pk2(vrk[0], vrk[1]); w.y = pk2(vrk[2], vrk[3]); *(uint2*)(ARK + i * 72 + j0) = w;
                w.x = pk2(vrb[0], vrb[1]); w.y = pk2(vrb[2], vrb[3]); *(uint2*)(RA3 + (size_t)item * 64 * 64 + frag_off(i, j0, 2)) = w;
            }
        }
        __syncthreads();
        f32x4_t cav[4], cov[4], ckv[4];
        {
            const int r0t = w4 * 16;
            bf16x8_t fa[2], fo[2], fk[2];
#pragma unroll
            for (int kb = 0; kb < 2; ++kb) { fa[kb] = *(const bf16x8_t*)(AAK + (r0t + fr) * 72 + kb * 32 + fq * 8); fo[kb] = *(const bf16x8_t*)(ARK + (r0t + fr) * 72 + kb * 32 + fq * 8); fk[kb] = *(const bf16x8_t*)(KDT + (r0t + fr) * 72 + kb * 32 + fq * 8); }
#pragma unroll
            for (int vt = 0; vt < 4; ++vt) {
                cav[vt] = (f32x4_t){0.f, 0.f, 0.f, 0.f}; cov[vt] = cav[vt]; ckv[vt] = cav[vt];
#pragma unroll
                for (int kb = 0; kb < 2; ++kb) { const bf16x8_t vb = *(const bf16x8_t*)(VT + (vt * 16 + fr) * 72 + kb * 32 + fq * 8);
                    cav[vt] = MFMA16(fa[kb], vb, cav[vt]); cov[vt] = MFMA16(fo[kb], vb, cov[vt]); ckv[vt] = MFMA16(fk[kb], vb, ckv[vt]); }
            }
        }
        __syncthreads();
        {
            const int r0 = w4 * 16 + 4 * fq;
#pragma unroll
            for (int vt = 0; vt < 4; ++vt) {
                const int v = vt * 16 + fr;
#pragma unroll
                for (int rg = 0; rg < 4; ++rg) RHS2[v * 65 + r0 + rg] = cav[vt][rg];
                { uint2 w; w.x = pk2(cov[vt][0], cov[vt][1]); w.y = pk2(cov[vt][2], cov[vt][3]); *(uint2*)(RO0 + (size_t)item * 64 * 64 + cfrag_off(v, r0, 4)) = w; }
                { uint2 w; w.x = pk2(ckv[vt][0], ckv[vt][1]); w.y = pk2(ckv[vt][2], ckv[vt][3]); *(uint2*)(RS0 + (size_t)item * 64 * 64 + cfrag_off(v, r0, 4)) = w; }
            }
        }
        __syncthreads();
        {
            const int col = ht >> 1, p = ht & 1, cc = col & 63; const bool isu = col >= 64;
            float xs[32];
#pragma unroll
            for (int i = 0; i < 32; ++i) xs[i] = 0.f;
            float4 mc[8], mn[8];
#pragma unroll
            for (int q = 0; q < 8; ++q) { mc[q] = make_float4(0.f, 0.f, 0.f, 0.f); mn[q] = mc[q]; }
            float rhs_n; { const float rv = RHS2[(isu ? cc : 0) * 65], av = bf2f(AT[(isu ? 0 : cc)]); rhs_n = isu ? rv : av; }
#pragma unroll
            for (int i = 0; i < 64; ++i) {
                const float rhs = rhs_n;
                if (i + 1 < 64) {
#pragma unroll
                    for (int q = 0; q < (i + 8) / 8; ++q) mn[q] = *(const float4*)(AAB + (i + 1) * 64 + 8 * q + 4 * p);
                    const float rv = RHS2[(isu ? cc : 0) * 65 + i + 1], av = bf2f(AT[(i + 1) * 72 + (isu ? 0 : cc)]); rhs_n = isu ? rv : av;
                }
                float a0 = 0.f, a1 = 0.f, a2 = 0.f, a3 = 0.f;
#pragma unroll
                for (int q = 0; q < (i + 7) / 8; ++q) { a0 += mc[q].x * xs[4 * q]; a1 += mc[q].y * xs[4 * q + 1]; a2 += mc[q].z * xs[4 * q + 2]; a3 += mc[q].w * xs[4 * q + 3]; }
                float tot = (a0 + a1) + (a2 + a3);
                tot += dpp_xor1(tot);
                const float xi = rhs + tot;
                const int g = i >> 2, slot = (g >> 1) * 4 + (i & 3);
                xs[slot] = (p == (g & 1)) ? xi : xs[slot];
#pragma unroll
                for (int q = 0; q < 8; ++q) mc[q] = mn[q];
                asm volatile("" ::: "memory");
            }
            if (isu) {
                bf16* up = RX0 + (size_t)item * 64 * 64;
#pragma unroll
                for (int q = 0; q < 8; ++q) { uint2 w; w.x = pk2(xs[4 * q], xs[4 * q + 1]); w.y = pk2(xs[4 * q + 2], xs[4 * q + 3]); *(uint2*)(up + cfrag_off(cc, 4 * (2 * q + p), 4)) = w; }
            }
            __syncthreads();
            if (!isu) {
#pragma unroll
                for (int q = 0; q < 8; ++q)
#pragma unroll
                    for (int e = 0; e < 4; ++e) AT[(4 * (2 * q + p) + e) * 72 + cc] = f2bf(xs[4 * q + e]);
            }
        }
        __syncthreads();
        {
            bf16* wp = RA1 + (size_t)item * 64 * 64;
#pragma unroll
            for (int q = 0; q < 2; ++q) { const int p = ht + 256 * q, fr = p & 15, fq = (p >> 4) & 3, kb = (p >> 6) & 1, rt = p >> 7;
                *(uint4*)(wp + p * 8) = *(const uint4*)(AT + (rt * 16 + fr) * 72 + kb * 32 + fq * 8); }
        }
    }
}

template <int DK, bool RW>
struct ScanArgs { const bf16* A1; const bf16* X0; const bf16* A2; const bf16* A3; const bf16* O0; const bf16* A4; const bf16* S0; const float* DSC; float* OUT; int item0; int vs; int tok0; int ocol0; };
#define LBAR() do { asm volatile("s_waitcnt lgkmcnt(0)" ::: "memory"); __builtin_amdgcn_s_barrier(); asm volatile("" ::: "memory"); } while (0)
template <int DK, bool RW>
__device__ __forceinline__ void scan_run(const Ctx& c, const ScanArgs<DK, RW>& a) {
    constexpr int KB = DK / 32;
    constexpr int NST = DK / 64;
    constexpr int NV = RW ? 64 : 128;
    constexpr int SROW = DK + 8;
    bf16* ST = (bf16*)c.lds;
    bf16* XT = ST + 2 * 32 * SROW;
    const int lane = c.lane, w = c.wave, fr = lane & 15, fq = lane >> 4;
    const int tm = w >> 1, tn = w & 1;
    const int dkt = (NST == 2) ? w : (w >> 1);
    for (int i = c.tid; i < 32 * SROW / 2; i += NTHREADS) ((unsigned*)ST)[i] = 0u;
    f32x4_t accS[NST];
#pragma unroll
    for (int s = 0; s < NST; ++s) accS[s] = (f32x4_t){0.f, 0.f, 0.f, 0.f};
    bf16x8_t a1f[KB], a2f[KB], a3f[2], a4f[2]; f32x4_t x0v, o0v, s0v[NST], dscv;
#define SCAN_LOAD(IT) do { const size_t it_ = (size_t)(IT); \
        _Pragma("unroll") for (int kb = 0; kb < KB; ++kb) { a1f[kb] = *(const bf16x8_t*)(a.A1 + it_ * 64 * DK + ((tm * KB + kb) * 64 + lane) * 8); a2f[kb] = *(const bf16x8_t*)(a.A2 + it_ * 64 * DK + ((tm * KB + kb) * 64 + lane) * 8); } \
        _Pragma("unroll") for (int kb = 0; kb < 2; ++kb) { a3f[kb] = *(const bf16x8_t*)(a.A3 + it_ * 64 * 64 + ((tm * 2 + kb) * 64 + lane) * 8); a4f[kb] = *(const bf16x8_t*)(a.A4 + it_ * DK * 64 + ((dkt * 2 + kb) * 64 + lane) * 8); } \
        { const uint2 q_ = *(const uint2*)(a.X0 + it_ * NV * 64 + (((a.vs * 2 + tn) * 4 + tm) * 64 + lane) * 4); x0v = (f32x4_t){bflo(q_.x), bfhi(q_.x), bflo(q_.y), bfhi(q_.y)}; } \
        if (RW) { { const uint2 q_ = *(const uint2*)(a.O0 + it_ * NV * 64 + (((a.vs * 2 + tn) * 4 + tm) * 64 + lane) * 4); o0v = (f32x4_t){bflo(q_.x), bfhi(q_.x), bflo(q_.y), bfhi(q_.y)}; } \
                  _Pragma("unroll") for (int s = 0; s < NST; ++s) { const uint2 q_ = *(const uint2*)(a.S0 + it_ * 64 * DK + (((a.vs * 2 + (NST == 2 ? s : tn)) * (DK / 16) + dkt) * 64 + lane) * 4); s0v[s] = (f32x4_t){bflo(q_.x), bfhi(q_.x), bflo(q_.y), bfhi(q_.y)}; } \
                  dscv = *(const f32x4_t*)(a.DSC + it_ * DK + dkt * 16 + 4 * fq); } \
        else { const float g_ = a.DSC[it_]; dscv = (f32x4_t){g_, g_, g_, g_}; o0v = (f32x4_t){0.f, 0.f, 0.f, 0.f}; _Pragma("unroll") for (int s = 0; s < NST; ++s) s0v[s] = (f32x4_t){0.f, 0.f, 0.f, 0.f}; } \
    } while (0)
    SCAN_LOAD(a.item0);
    int cur = 0;
    for (int n = 0; n < 64; ++n) {
        bf16x8_t b1[KB], b2[KB], b3[2], b4[2];
#pragma unroll
        for (int kb = 0; kb < KB; ++kb) { b1[kb] = a1f[kb]; b2[kb] = a2f[kb]; }
        b3[0] = a3f[0]; b3[1] = a3f[1]; b4[0] = a4f[0]; b4[1] = a4f[1];
        f32x4_t accX = x0v, accO = o0v; const f32x4_t dv = dscv; f32x4_t sv[NST];
#pragma unroll
        for (int s = 0; s < NST; ++s) sv[s] = s0v[s];
        if (n + 1 < 64) SCAN_LOAD(a.item0 + n + 1);
        LBAR();
        const bf16* Sc = ST + cur * 32 * SROW; bf16* Sn = ST + (cur ^ 1) * 32 * SROW;
        bf16x8_t sf[KB];
#pragma unroll
        for (int kb = 0; kb < KB; ++kb) sf[kb] = *(const bf16x8_t*)(Sc + (tn * 16 + fr) * SROW + kb * 32 + fq * 8);
#pragma unroll
        for (int kb = 0; kb < KB; ++kb) accX = MFMA16(b1[kb], sf[kb], accX);
        { uint2 wv; wv.x = pk2(accX[0], accX[1]); wv.y = pk2(accX[2], accX[3]); *(uint2*)(XT + (tn * 16 + fr) * 72 + tm * 16 + 4 * fq) = wv; }
#pragma unroll
        for (int kb = 0; kb < KB; ++kb) accO = MFMA16(b2[kb], sf[kb], accO);
        LBAR();
        bf16x8_t xf[2];
#pragma unroll
        for (int kb = 0; kb < 2; ++kb) xf[kb] = *(const bf16x8_t*)(XT + (tn * 16 + fr) * 72 + kb * 32 + fq * 8);
        accO = MFMA16(b3[0], xf[0], accO); accO = MFMA16(b3[1], xf[1], accO);
        {
            float* op = a.OUT + (size_t)(a.tok0 + n * 64 + tm * 16 + 4 * fq) * 1024 + a.ocol0 + tn * 16 + fr;
            op[0] = accO[0]; op[1024] = accO[1]; op[2048] = accO[2]; op[3072] = accO[3];
        }
#pragma unroll
        for (int s = 0; s < NST; ++s) {
            const int vt = (NST == 2) ? s : tn;
            bf16x8_t xg[2];
            if (vt == tn) { xg[0] = xf[0]; xg[1] = xf[1]; }
            else {
#pragma unroll
                for (int kb = 0; kb < 2; ++kb) xg[kb] = *(const bf16x8_t*)(XT + (vt * 16 + fr) * 72 + kb * 32 + fq * 8);
            }
            f32x4_t t = accS[s] * dv + sv[s];
            t = MFMA16(b4[0], xg[0], t); t = MFMA16(b4[1], xg[1], t);
            accS[s] = t;
            uint2 wv; wv.x = pk2(t[0], t[1]); wv.y = pk2(t[2], t[3]);
            *(uint2*)(Sn + (vt * 16 + fr) * SROW + dkt * 16 + 4 * fq) = wv;
        }
        cur ^= 1;
    }
#undef SCAN_LOAD
    __syncthreads();
}

__device__ __forceinline__ void ph_scan(const Ctx& c) {
    for (int wk = blockIdx.x; wk < 256; wk += gridDim.x) {
        const int xcd = wk & 7, j = wk >> 3;
        if (j < 16) {
            const int pair = xcd * 4 + (j >> 2), vs = j & 3, b = pair >> 3, h = pair & 7;
            ScanArgs<128, false> a{c.ws<bf16>(WS_GA1), c.ws<bf16>(WS_GX0), c.ws<bf16>(WS_GA2), c.ws<bf16>(WS_GA3), nullptr, c.ws<bf16>(WS_GA4), nullptr, c.ws<float>(WS_GGL),
                                   c.ws<float>(WS_OG), pair * 64, vs, b * SEQ, h * 128 + vs * 32};
            scan_run<128, false>(c, a);
        } else {
            const int pair = xcd * 8 + ((j - 16) >> 1), vs = (j - 16) & 1, b = pair >> 4, h = pair & 15;
            ScanArgs<64, true> a{c.ws<bf16>(WS_RA1), c.ws<bf16>(WS_RX0), c.ws<bf16>(WS_RA2), c.ws<bf16>(WS_RA3), c.ws<bf16>(WS_RO0), c.ws<bf16>(WS_RA4), c.ws<bf16>(WS_RS0), c.ws<float>(WS_RDSC),
                                 c.ws<float>(WS_ORW), pair * 64, vs, b * SEQ, h * 64 + vs * 32};
            scan_run<64, true>(c, a);
        }
    }
}

enum { PH_RMS0 = 0, PH_INPROJ, PH_GCL, PH_LORA, PH_RCL, PH_SCAN, PH_POST, PH_G2, PH_X1, PH_ROUTER, PH_DISPATCH, PH_MOE1, PH_MOE2, PH_COMBINE, PH_COUNT };

template <unsigned PHMASK>
__global__ void __launch_bounds__(NTHREADS) mk(Params P) {
    extern __shared__ __attribute__((aligned(16))) unsigned char lds[];
    volatile LAS unsigned* misc = (volatile LAS unsigned*)((LAS unsigned char*)lds + MISC_OFF);
    if (threadIdx.x < 64) misc[threadIdx.x] = 0u;
    __syncthreads();
    unsigned* ctl = (unsigned*)(P.ws + WS_CTL);
    XcdBarrier bar = xcd_barrier_post(ctl + CW_BAR + P.li * XCD_BAR_WORDS, misc);
#define MKCTX() int tv_ = threadIdx.x; asm volatile("" : "+v"(tv_)); const int wv_ = __builtin_amdgcn_readfirstlane(tv_ >> 6); \
    Ctx c{P, tv_, tv_ & 63, wv_, (int)(blockIdx.x * NWAVES + wv_), (int)(gridDim.x * NWAVES), (size_t)blockIdx.x * NTHREADS + tv_, (size_t)gridDim.x * NTHREADS, lds}
    bool first_seam = true;
#define IN(k) (((PHMASK >> (k)) & 1u) && P.ph_lo <= (k) && (k) < P.ph_hi)
#define SEAM(k) do { if ((k) + 1 < P.ph_hi) { xcd_barrier(bar); first_seam = false; } } while (0)
#define REP(k) for (int rep_ = 0; rep_ < ((k) == PROBE_REP ? 2 : 1); ++rep_)
    if (IN(PH_RMS0)) { MKCTX();
        REP(PH_RMS0) {
        ph_rms0(c);
        { WJob j{P.in[I_W_IN], NCOL_IN, 1024, 4096, c.ws<bf16>(WS_WIN_T), 1024, 1, 0, 0}; wconv_job(c, j); }
        { WJob j{P.in[I_W_IN] + 4112, NCOL_IN, 1024, 5376, c.ws<bf16>(WS_WIN_T) + (size_t)4096 * 1024, 1024, 1, 0, 0}; wconv_job(c, j); }
        lora_zero(c);
        { WJob j{P.in[I_W2], 1024, 64, 1024, c.ws<bf16>(WS_LORA_T), 256, 1, 0, 0}; wconv_job(c, j); }
        { WJob j{P.in[I_A2], 1024, 64, 1024, c.ws<bf16>(WS_LORA_T) + (size_t)1024 * 256 + 64, 256, 1, 0, 0}; wconv_job(c, j); }
        { WJob j{P.in[I_G2], 1024, 128, 1024, c.ws<bf16>(WS_LORA_T) + (size_t)2048 * 256 + 128, 256, 1, 0, 0}; wconv_job(c, j); }
        }
        SEAM(PH_RMS0);
    }
    if (IN(PH_INPROJ)) { MKCTX();
        REP(PH_INPROJ) {
        EpiInProj ep{c.ws<bf16>(WS_GQKV), c.ws<bf16>(WS_ZS), c.ws<bf16>(WS_RKV), c.ws<float>(WS_LIN), c.ws<bf16>(WS_GATES)};
        SchedInProj sc{(const char*)c.ws<bf16>(WS_HB), (const char*)c.ws<bf16>(WS_WIN_T), (int)gridDim.x, (int)blockIdx.x};
        pg8::gemm_phase((LAS unsigned char*)lds, 1024, sc, ep, c.tid);
        }
        SEAM(PH_INPROJ);
    }
    if (IN(PH_GCL)) { MKCTX(); REP(PH_GCL) { ph_gcl(c); ph_loraprep(c); } SEAM(PH_GCL); }
    if (IN(PH_LORA)) { MKCTX();
        REP(PH_LORA) {
        EpiLora ep{P.in[I_W0], P.in[I_A0], c.ws<float>(WS_LW), c.ws<float>(WS_AA), c.ws<bf16>(WS_GGR)};
        SchedLora sc{(const char*)c.ws<bf16>(WS_ALORA), (const char*)c.ws<bf16>(WS_LORA_T), (int)gridDim.x, (int)blockIdx.x};
        pg8::gemm_phase((LAS unsigned char*)lds, 256, sc, ep, c.tid);
        }
        SEAM(PH_LORA);
    }
    if (IN(PH_RCL)) { MKCTX(); REP(PH_RCL) { ph_rcl(c); } SEAM(PH_RCL); }
    if (IN(PH_SCAN)) { MKCTX(); REP(PH_SCAN) { ph_scan(c); } SEAM(PH_SCAN); }
    if (IN(PH_POST)) { MKCTX();
        REP(PH_POST) {
        ph_post(c);
        { WJob j{P.in[I_PROJ_A], 1024, 1024, 1024, c.ws<bf16>(WS_PROJ_T), 1024, 1, 0, 0}; wconv_job(c, j); }
        { WJob j{P.in[I_PROJ_B], 1024, 1024, 1024, c.ws<bf16>(WS_PROJ_T) + (size_t)1024 * 1024, 1024, 1, 0, 0}; wconv_job(c, j); }
        { WJob j{P.in[I_W_OUT], 1024, 1024, 1024, c.ws<bf16>(WS_WOUT_T), 1024, 1, 0, 0}; wconv_job(c, j); }
        }
        SEAM(PH_POST);
    }
    if (IN(PH_G2)) { MKCTX();
        REP(PH_G2) {
        EpiG2 ep{c.ws<bf16>(WS_GATES), c.ws<bf16>(WS_G2)};
        SchedG2 sc{(const char*)c.ws<bf16>(WS_YA), (const char*)c.ws<bf16>(WS_PROJ_T), (int)gridDim.x, (int)blockIdx.x};
        pg8::gemm_phase((LAS unsigned char*)lds, 1024, sc, ep, c.tid);
        }
        SEAM(PH_G2);
    }
    if (IN(PH_X1)) { MKCTX();
        REP(PH_X1) {
        EpiX1 ep{P.in[I_X], c.ws<float>(WS_X1)};
        SchedX1 sc{(const char*)c.ws<bf16>(WS_G2), (const char*)c.ws<bf16>(WS_WOUT_T), (int)gridDim.x, (int)blockIdx.x};
        pg8::gemm_phase((LAS unsigned char*)lds, 1024, sc, ep, c.tid);
        }
        SEAM(PH_X1);
    }
    if (IN(PH_ROUTER)) { MKCTX();
        ph_router(c);
        REP(PH_ROUTER) {
        { WJob j{P.in[I_W_GU], 2048, 1024, 2048, c.ws<bf16>(WS_WGU_T), 1024, 32, (size_t)1024 * 2048, (size_t)2048 * 1024}; wconv_job(c, j); }
        { WJob j{P.in[I_W_DOWN], 1024, 1024, 1024, c.ws<bf16>(WS_WDN_T), 1024, 32, (size_t)1024 * 1024, (size_t)1024 * 1024}; wconv_job(c, j); }
        }
        SEAM(PH_ROUTER);
    }
    if (IN(PH_DISPATCH)) { MKCTX(); REP(PH_DISPATCH) { ph_dispatch(c); } SEAM(PH_DISPATCH); }
    if (IN(PH_MOE1)) { MKCTX();
        REP(PH_MOE1) {
        const int nt = *c.ws<int>(WS_NT);
        EpiAct ep{P.in[I_B_GU], c.ws<bf16>(WS_ACT)};
        SchedMoe sc{(const char*)c.ws<bf16>(WS_H2), (const char*)c.ws<bf16>(WS_WGU_T), c.ws<int>(WS_TILE_E), c.ws<int>(WS_SLOT_TOK), nt, 8, (int)gridDim.x, (int)blockIdx.x};
        pg8::gemm_phase_t<true>((LAS unsigned char*)lds, 1024, sc, ep, c.tid);
        }
        SEAM(PH_MOE1);
    }
    if (IN(PH_MOE2)) { MKCTX();
        REP(PH_MOE2) {
        const int nt = *c.ws<int>(WS_NT);
        EpiYS ep{P.in[I_B_DOWN], c.ws<float>(WS_SGATE), c.ws<bf16>(WS_YS)};
        SchedMoe sc{(const char*)c.ws<bf16>(WS_ACT), (const char*)c.ws<bf16>(WS_WDN_T), c.ws<int>(WS_TILE_E), nullptr, nt, 4, (int)gridDim.x, (int)blockIdx.x};
        pg8::gemm_phase((LAS unsigned char*)lds, 1024, sc, ep, c.tid);
        }
        SEAM(PH_MOE2);
    }
    if (IN(PH_COMBINE)) { MKCTX(); REP(PH_COMBINE) { ph_combine(c); } }
#undef IN
#undef SEAM
#undef REP
#undef MKCTX
}

template <unsigned M> static void launch_one(const Params& p, int grid, hipStream_t stream) {
    static bool attr = false;
    if (!attr) { (void)hipFuncSetAttribute((const void*)mk<M>, hipFuncAttributeMaxDynamicSharedMemorySize, LDS_BYTES); attr = true; }
    hipLaunchKernelGGL(mk<M>, dim3(grid), dim3(NTHREADS), LDS_BYTES, stream, p);
}
template <int PH> static void launch_chain(Params& p, int grid, hipStream_t stream) {
    if constexpr (PH < PH_COUNT) { p.ph_lo = PH; p.ph_hi = PH + 1; p.li = 0; p.coop = 0; launch_one<(1u << PH)>(p, grid, stream); launch_chain<PH + 1>(p, grid, stream); }
}

extern "C" void kernel_launch(void* const* d_in, const int* in_sizes, int n_in, void* d_out, int out_size, void* d_ws, size_t ws_size, hipStream_t stream) {
    static int grid = 0;
    if (grid == 0) {
        int dev = 0, cus = 0, per_cu = 0;
        (void)hipGetDevice(&dev);
        (void)hipDeviceGetAttribute(&cus, hipDeviceAttributeMultiprocessorCount, dev);
#if MK_ONE_LAUNCH
        (void)hipFuncSetAttribute((const void*)mk<0xffffffffu>, hipFuncAttributeMaxDynamicSharedMemorySize, LDS_BYTES);
        (void)hipOccupancyMaxActiveBlocksPerMultiprocessor(&per_cu, (const void*)mk<0xffffffffu>, NTHREADS, LDS_BYTES);
#else
        per_cu = 1;
#endif
        if (n_in != 29 || ws_size < WS_END || per_cu < 1 || cus < 64) { fprintf(stderr, "kernel_launch: unexpected setup n_in %d ws %zu per_cu %d cus %d\n", n_in, ws_size, per_cu, cus); grid = -1; return; }
        grid = cus;
    }
    if (grid < 0) return;
    (void)hipMemsetAsync((char*)d_ws + WS_CTL, 0, CTL_BYTES, stream);
    Params p{};
    for (int i = 0; i < 29; ++i) p.in[i] = (const float*)d_in[i];
    p.out = (float*)d_out; p.ws = (unsigned char*)d_ws;
#if MK_ONE_LAUNCH
    p.ph_lo = 0; p.ph_hi = PH_COUNT; p.li = 0; p.coop = 1;
    void* args[] = {&p};
    hipError_t e = hipLaunchCooperativeKernel((const void*)mk<0xffffffffu>, dim3(grid), dim3(NTHREADS), args, LDS_BYTES, stream);
    if (e != hipSuccess) fprintf(stderr, "cooperative launch failed: %s (grid %d)\n", hipGetErrorString(e), grid);
#else
    launch_chain<0>(p, grid, stream);
#endif
}
```

```cpp
#include <hip/hip_runtime.h>
#include <hip/hip_cooperative_groups.h>
#include <cstdint>
#include <cstdio>
namespace cg = cooperative_groups;

#ifndef MK_ONE_LAUNCH
#define MK_ONE_LAUNCH 1
#endif

#define LAS __attribute__((address_space(3)))
#ifndef FAST_INPROJ
#define FAST_INPROJ 1
#endif
#ifndef FAST_MIX
#define FAST_MIX 1
#endif
#define PROBE_REP -1
constexpr int NTHREADS = 512;
constexpr int NWAVES = 8;
constexpr int LDS_BYTES = 155648;
constexpr int MISC_OFF = 153600;

constexpr int T = 16384, SEQ = 4096, D = 1024;
constexpr int NCOL_IN = 9488;
constexpr int NEXP = 32;
constexpr int MAXTILES = 288;
constexpr int MAXSLOTS = MAXTILES * 256;

enum { I_X = 0, I_NORM_MIX, I_W_IN, I_GDN_CONV, I_GDN_ALOG, I_GDN_DTB, I_GDN_NORM, I_MU, I_W0, I_W2, I_A0, I_A2, I_G2, I_KK, I_KA, I_RK,
       I_LNW, I_LNB, I_PROJ_A, I_PROJ_B, I_W_OUT, I_NORM_FFN, I_ROUTER_W, I_ROUTER_B, I_W_GU, I_B_GU, I_W_DOWN, I_B_DOWN, I_NORM_FINAL };

constexpr size_t MiB = 1u << 20;
constexpr size_t WS_CTL = 0, CTL_BYTES = 65536;
constexpr size_t WS_BETA = 1 * MiB;
constexpr size_t WS_GG = WS_BETA + 512 * 1024;
constexpr size_t WS_SC = 2 * MiB;
constexpr size_t WS_TE = 3 * MiB;
constexpr size_t WS_TG = WS_TE + 256 * 1024;
constexpr size_t WS_TP = WS_TG + 256 * 1024;
constexpr size_t WS_TSLOT = WS_TP + 256 * 1024;
constexpr size_t WS_SGATE = 4 * MiB;
constexpr size_t WS_SLOT_TOK = 4 * MiB + 512 * 1024;
constexpr size_t WS_TILE_E = 5 * MiB;
constexpr size_t WS_NT = WS_TILE_E + 4096;
constexpr size_t WS_HB = 8 * MiB;
constexpr size_t WS_H2 = WS_HB;
constexpr size_t WS_ZS = 40 * MiB;
constexpr size_t WS_GATES = 72 * MiB;
constexpr size_t WS_ALORA = 136 * MiB;
constexpr size_t WS_LW = 144 * MiB;
constexpr size_t WS_AA = 208 * MiB;
constexpr size_t WS_GGR = 272 * MiB;
constexpr size_t WS_VP = 304 * MiB;
constexpr size_t WS_Q = 336 * MiB;
constexpr size_t WS_QKVC = WS_Q;
constexpr size_t WS_RP = WS_Q, WS_KF = WS_Q + 64 * MiB, WS_KKN = WS_Q + 128 * MiB;
constexpr size_t WS_YA = WS_Q, WS_YB = WS_Q + 32 * MiB, WS_G2 = WS_Q + 64 * MiB, WS_X1 = WS_Q + 128 * MiB;
constexpr size_t WS_GQKV = 528 * MiB;
constexpr size_t WS_OG = 720 * MiB, WS_ORW = 784 * MiB;
constexpr size_t WS_RKV = 720 * MiB;
constexpr size_t WS_LIN = 912 * MiB;
constexpr size_t WS_DEC = 928 * MiB;
constexpr size_t WS_XB = 528 * MiB;
constexpr size_t WS_ACT = 672 * MiB;
constexpr size_t WS_YS = 816 * MiB;
constexpr size_t WS_WIN_T = 992 * MiB;
constexpr size_t WS_PROJ_T = 144 * MiB;
constexpr size_t WS_WOUT_T = 148 * MiB;
constexpr size_t WS_WGU_T = 72 * MiB;
constexpr size_t WS_WDN_T = 200 * MiB;
constexpr size_t WS_GA1 = 336 * MiB, WS_GX0 = 368 * MiB, WS_GA2 = 432 * MiB, WS_GA3 = 464 * MiB, WS_GA4 = 480 * MiB;
constexpr size_t WS_GGL = 6 * MiB;
constexpr size_t WS_RX0 = 528 * MiB, WS_RO0 = 592 * MiB, WS_RS0 = 656 * MiB;
constexpr size_t WS_RA1 = 8 * MiB, WS_RA2 = 928 * MiB, WS_RA3 = 960 * MiB, WS_RA4 = 992 * MiB;
constexpr size_t WS_RDSC = 7 * MiB;
constexpr size_t WS_LORA_T = 1012 * MiB;
constexpr size_t WS_END = 1024 * MiB;
constexpr int CW_BAR = 1024;
constexpr int CW_CNT = 256;

#define XB_TMO      128
#define XB_XCNT(j)  (256  + 64 * (j))
#define XB_XSUB(j)  (1280 + 64 * (j))
#define XB_XGEN(j)  (2304 + 64 * (j))
#define XB_TOP      3328
#define XB_TOPGEN   3392
#define XCD_BAR_WORDS 3456
#define XB_SPIN_CAP (1u << 24)
__device__ __forceinline__ unsigned xb_ld(unsigned* p)              { return __hip_atomic_load(p, __ATOMIC_RELAXED, __HIP_MEMORY_SCOPE_AGENT); }
__device__ __forceinline__ unsigned xb_add(unsigned* p, unsigned v) { return __hip_atomic_fetch_add(p, v, __ATOMIC_RELAXED, __HIP_MEMORY_SCOPE_AGENT); }
__device__ __forceinline__ unsigned xb_xcc_id() { return (unsigned)__builtin_amdgcn_s_getreg((3 << 11) | 20) & 0xFu; }
#define XB_SPIN(cond, bar) do { unsigned _sp = 0; while (cond) { __builtin_amdgcn_s_sleep(1); \
    if ((++_sp & 255u) == 0u) { if (xb_ld(&(bar)[XB_TMO])) break; if (_sp > XB_SPIN_CAP) { atomicAdd(&(bar)[XB_TMO], 1u); break; } } } } while (0)
struct XcdBarrier { unsigned* bar; unsigned x; volatile LAS unsigned* st; };
__device__ __forceinline__ XcdBarrier xcd_barrier_post(unsigned* bar, volatile LAS unsigned* st) {
    XcdBarrier b; b.bar = bar; b.x = xb_xcc_id(); b.st = st;
    if (threadIdx.x == 0) (void)xb_add(&bar[XB_XCNT(b.x)], 1u);
    return b;
}
__device__ __forceinline__ void xcd_barrier_complete(unsigned* bar, unsigned x, unsigned& nloc, unsigned& nx) {
    const unsigned G = gridDim.x * gridDim.y * gridDim.z;
    unsigned sum, cnt, mine, sp = 0u;
    for (;;) {
        sum = 0u; cnt = 0u; mine = 0u;
#pragma unroll
        for (unsigned j = 0; j < 16; ++j) { const unsigned c = xb_ld(&bar[XB_XCNT(j)]); sum += c; cnt += (c > 0u) ? 1u : 0u; mine = (j == x) ? c : mine; }
        if (sum == G) break;
        __builtin_amdgcn_s_sleep(1);
        if ((++sp & 255u) == 0u) { if (xb_ld(&bar[XB_TMO])) break; if (sp > XB_SPIN_CAP) { atomicAdd(&bar[XB_TMO], 1u); break; } }
    }
    nloc = mine > 0u ? mine : 1u; nx = cnt > 0u ? cnt : 1u;
}
__device__ __forceinline__ void xcd_barrier(const XcdBarrier& b) {
    asm volatile("s_waitcnt vmcnt(0)" ::: "memory");
    __syncthreads();
    if (threadIdx.x == 0) {
        unsigned* bar = b.bar;
        __builtin_amdgcn_s_waitcnt(0);
        unsigned nloc = b.st[0], nx = b.st[1];
        if (nloc == 0u) { xcd_barrier_complete(bar, b.x, nloc, nx); b.st[0] = nloc; b.st[1] = nx; }
        const unsigned old = xb_add(&bar[XB_XSUB(b.x)], 1u);
        const unsigned gen = old / nloc;
        if (old + 1u == (gen + 1u) * nloc) {
            __builtin_amdgcn_fence(__ATOMIC_RELEASE, "agent");
            asm volatile("s_waitcnt vmcnt(0)" ::: "memory");
            const unsigned og = xb_add(&bar[XB_TOP], 1u);
            const unsigned tg = og / nx;
            if (og + 1u == (tg + 1u) * nx) xb_add(&bar[XB_TOPGEN], 1u);
            else XB_SPIN(xb_ld(&bar[XB_TOPGEN]) == tg, bar);
            __builtin_amdgcn_fence(__ATOMIC_ACQUIRE, "agent");
            xb_add(&bar[XB_XGEN(b.x)], 1u);
            asm volatile("s_waitcnt vmcnt(0)" ::: "memory");
        } else {
            XB_SPIN(xb_ld(&bar[XB_XGEN(b.x)]) == gen, bar);
            __builtin_amdgcn_fence(__ATOMIC_ACQUIRE, "agent");
            asm volatile("s_waitcnt vmcnt(0)" ::: "memory");
        }
    }
    __syncthreads();
}

typedef unsigned short bf16;
__device__ __forceinline__ bf16 f2bf(float f) { unsigned u = __float_as_uint(f); u += 0x7fffu + ((u >> 16) & 1u); return (bf16)(u >> 16); }
__device__ __forceinline__ float bf2f(unsigned b) { return __uint_as_float(b << 16); }
__device__ __forceinline__ unsigned pk2(float lo, float hi) { return (unsigned)f2bf(lo) | ((unsigned)f2bf(hi) << 16); }
__device__ __forceinline__ float bflo(unsigned w) { return __uint_as_float(w << 16); }
__device__ __forceinline__ float bfhi(unsigned w) { return __uint_as_float(w & 0xffff0000u); }
__device__ __forceinline__ float sigm(float x) { return 1.f / (1.f + expf(-x)); }
__device__ __forceinline__ float fsigm(float x) { return __builtin_amdgcn_rcpf(1.f + __expf(-x)); }
__device__ __forceinline__ float softplusf(float x) { return x > 20.f ? x : log1pf(expf(x)); }
__device__ __forceinline__ float dpp_xor1(float v) { return __int_as_float(__builtin_amdgcn_update_dpp(0, __float_as_int(v), 0xB1, 0xF, 0xF, false)); }
__device__ __forceinline__ float wsum(float v) {
#pragma unroll
    for (int o = 32; o > 0; o >>= 1) v += __shfl_xor(v, o);
    return v;
}

struct Params { const float* in[29]; float* out; unsigned char* ws; int ph_lo, ph_hi, li, coop; };

struct Ctx {
    const Params& P; int tid, lane, wave, gwave, nwaves; size_t gtid, nthreads; unsigned char* lds;
    template <class Tp> __device__ __forceinline__ Tp* ws(size_t off) const { return (Tp*)(P.ws + off); }
};

__device__ __forceinline__ void ph_rms0(const Ctx& c) {
    const float* x = c.P.in[I_X]; const float* nw = c.P.in[I_NORM_MIX]; const float* win = c.P.in[I_W_IN];
    const float* alog = c.P.in[I_GDN_ALOG]; const float* dtb = c.P.in[I_GDN_DTB];
    bf16* HB = c.ws<bf16>(WS_HB); float* BETA = c.ws<float>(WS_BETA); float* GGv = c.ws<float>(WS_GG);
    if (blockIdx.x == 0 && c.tid < NEXP) c.ws<unsigned>(WS_CTL)[CW_CNT + c.tid] = 0u;
    float4* tab = (float4*)c.lds;
    __syncthreads();
    for (int i = c.tid; i < 4096; i += NTHREADS) { const int k = i >> 2; tab[((k & 3) * 256 + (k >> 2)) * 5 + (i & 3)] = *(const float4*)(win + (size_t)k * NCOL_IN + 4096 + (i & 3) * 4); }
    __syncthreads();
    const int lane = c.lane;
    for (int t = c.gwave; t < T; t += c.nwaves) {
        float4 v[4]; float ss = 0.f;
#pragma unroll
        for (int i = 0; i < 4; ++i) { v[i] = ((const float4*)(x + (size_t)t * D))[lane + 64 * i]; ss += v[i].x * v[i].x + v[i].y * v[i].y + v[i].z * v[i].z + v[i].w * v[i].w; }
        ss = wsum(ss);
        const float rstd = rsqrtf(ss * (1.f / 1024.f) + 1e-6f);
        float acc[16];
#pragma unroll
        for (int j = 0; j < 16; ++j) acc[j] = 0.f;
#pragma unroll
        for (int i = 0; i < 4; ++i) {
            const float4 w4 = ((const float4*)nw)[lane + 64 * i];
            float h[4] = {v[i].x * rstd * w4.x, v[i].y * rstd * w4.y, v[i].z * rstd * w4.z, v[i].w * rstd * w4.w};
            uint2 st; st.x = pk2(h[0], h[1]); st.y = pk2(h[2], h[3]);
            *(uint2*)(HB + (size_t)t * D + 4 * (lane + 64 * i)) = st;
#pragma unroll
            for (int ii = 0; ii < 4; ++ii) {
                const int k = 4 * (lane + 64 * i) + ii;
#pragma unroll
                for (int q = 0; q < 4; ++q) { const float4 w = tab[(ii * 256 + (k >> 2)) * 5 + q]; acc[4 * q + 0] += h[ii] * w.x; acc[4 * q + 1] += h[ii] * w.y; acc[4 * q + 2] += h[ii] * w.z; acc[4 * q + 3] += h[ii] * w.w; }
                if (ii & 1) asm volatile("" ::: "memory");
            }
        }
        float mine = 0.f;
#pragma unroll
        for (int j = 0; j < 16; ++j) { const float s = wsum(acc[j]); mine = (lane == j) ? s : mine; }
        if (lane < 8) BETA[t * 8 + lane] = sigm(mine);
        else if (lane < 16) { const int h = lane - 8; GGv[t * 8 + h] = -expf(alog[h]) * softplusf(mine + dtb[h]); }
    }
    __syncthreads();
}

struct NoLd {};
struct EpiInProj {
    typedef NoLd Ld; static constexpr int MB = 1;
    bf16* GQKV; bf16* ZS; bf16* RKV; float* LIN; bf16* GATES;
    __device__ __forceinline__ void load(Ld&, int, int, int) const {}
    __device__ __forceinline__ void store8(int row, int col, const float (&v)[8], int, const Ld&) const {
        if (col < 3072) { uint4 w; w.x = pk2(v[0], v[1]); w.y = pk2(v[2], v[3]); w.z = pk2(v[4], v[5]); w.w = pk2(v[6], v[7]); *(uint4*)(GQKV + (size_t)row * 3072 + col) = w; }
        else if (col < 4096) { uint4 w; w.x = pk2(v[0] * fsigm(v[0]), v[1] * fsigm(v[1])); w.y = pk2(v[2] * fsigm(v[2]), v[3] * fsigm(v[3])); w.z = pk2(v[4] * fsigm(v[4]), v[5] * fsigm(v[5])); w.w = pk2(v[6] * fsigm(v[6]), v[7] * fsigm(v[7]));
            *(uint4*)(ZS + (size_t)row * 1024 + (col - 3072)) = w; }
        else if (col < 7168) { uint4 w; w.x = pk2(v[0], v[1]); w.y = pk2(v[2], v[3]); w.z = pk2(v[4], v[5]); w.w = pk2(v[6], v[7]); *(uint4*)(RKV + (size_t)row * 3072 + (col - 4096)) = w; }
        else if (col < 7424) { float* p = LIN + (size_t)row * 256 + (col - 7168); *(float4*)p = make_float4(v[0], v[1], v[2], v[3]); *(float4*)(p + 4) = make_float4(v[4], v[5], v[6], v[7]); }
        else { uint4 w; w.x = pk2(fsigm(v[0]), fsigm(v[1])); w.y = pk2(fsigm(v[2]), fsigm(v[3])); w.z = pk2(fsigm(v[4]), fsigm(v[5])); w.w = pk2(fsigm(v[6]), fsigm(v[7]));
            *(uint4*)(GATES + (size_t)row * 2048 + (col - 7424)) = w; }
    }
};
struct EpiG2 {
    struct Ld { uint4 g; uint4 p; }; static constexpr int MB = 1;
    const bf16* GATES; bf16* MG;
    __device__ __forceinline__ void load(Ld& l, int row, int col, int) const { l.g = *(const uint4*)(GATES + (size_t)row * 2048 + col); const uint4 q = *(const uint4*)(MG + (size_t)row * 1024 + (col & 1023)); const bool b = col >= 1024; l.p = make_uint4(b ? q.x : 0u, b ? q.y : 0u, b ? q.z : 0u, b ? q.w : 0u); }
    __device__ __forceinline__ void store8(int row, int col, const float (&v)[8], int, const Ld& l) const {
        const uint4 g = l.g, p = l.p;
        uint4 w; w.x = pk2(v[0] * bflo(g.x) + bflo(p.x), v[1] * bfhi(g.x) + bfhi(p.x)); w.y = pk2(v[2] * bflo(g.y) + bflo(p.y), v[3] * bfhi(g.y) + bfhi(p.y));
        w.z = pk2(v[4] * bflo(g.z) + bflo(p.z), v[5] * bfhi(g.z) + bfhi(p.z)); w.w = pk2(v[6] * bflo(g.w) + bflo(p.w), v[7] * bfhi(g.w) + bfhi(p.w));
        *(uint4*)(MG + (size_t)row * 1024 + (col & 1023)) = w;
    }
};
struct EpiX1 {
    struct Ld { float4 a, b; }; static constexpr int MB = 2;
    const float* X; float* X1;
    __device__ __forceinline__ void load(Ld& l, int row, int col, int) const { const float* xp = X + (size_t)row * 1024 + col; l.a = *(const float4*)xp; l.b = *(const float4*)(xp + 4); }
    __device__ __forceinline__ void store8(int row, int col, const float (&v)[8], int, const Ld& l) const {
        float* op = X1 + (size_t)row * 1024 + col;
        const float4 a = l.a, b = l.b;
        *(float4*)op = make_float4(a.x + v[0], a.y + v[1], a.z + v[2], a.w + v[3]); *(float4*)(op + 4) = make_float4(b.x + v[4], b.y + v[5], b.z + v[6], b.w + v[7]);
    }
};
struct EpiAct {
    struct Ld { float4 b0, b1; }; static constexpr int MB = 4;
    const float* BGU; bf16* ACT;
    __device__ __forceinline__ void load(Ld& l, int, int col, int e) const { const float* bp = BGU + (size_t)e * 2048 + col; l.b0 = *(const float4*)bp; l.b1 = *(const float4*)(bp + 4); }
    __device__ __forceinline__ void store8(int row, int col, const float (&v)[8], int e, const Ld& l) const {
        const float4 b0 = l.b0, b1 = l.b1;
        const float bb[8] = {b0.x, b0.y, b0.z, b0.w, b1.x, b1.y, b1.z, b1.w};
        float o[4];
#pragma unroll
        for (int p = 0; p < 4; ++p) { float glu = v[2 * p] + bb[2 * p], lin = v[2 * p + 1] + bb[2 * p + 1]; glu = fminf(glu, 7.f); lin = fminf(fmaxf(lin, -7.f), 7.f); o[p] = glu * fsigm(1.702f * glu) * (lin + 1.f); }
        uint2 w; w.x = pk2(o[0], o[1]); w.y = pk2(o[2], o[3]);
        *(uint2*)(ACT + (size_t)row * 1024 + (col >> 1)) = w;
    }
};
struct EpiYS {
    struct Ld { float4 b0, b1; float g; }; static constexpr int MB = 4;
    const float* BD; const float* SGATE; bf16* YS;
    __device__ __forceinline__ void load(Ld& l, int row, int col, int e) const { const float* bp = BD + (size_t)e * 1024 + col; l.g = SGATE[row]; l.b0 = *(const float4*)bp; l.b1 = *(const float4*)(bp + 4); }
    __device__ __forceinline__ void store8(int row, int col, const float (&v)[8], int e, const Ld& l) const {
        const float g = l.g; const float4 b0 = l.b0, b1 = l.b1;
        uint4 w; w.x = pk2((v[0] + b0.x) * g, (v[1] + b0.y) * g); w.y = pk2((v[2] + b0.z) * g, (v[3] + b0.w) * g); w.z = pk2((v[4] + b1.x) * g, (v[5] + b1.y) * g); w.w = pk2((v[6] + b1.z) * g, (v[7] + b1.w) * g);
        *(uint4*)(YS + (size_t)row * 1024 + col) = w;
    }
};


namespace pg8 {
typedef short bf16x8 __attribute__((ext_vector_type(8)));
typedef float f32x4 __attribute__((ext_vector_type(4)));
constexpr int BM = 256, BK = 64, HALF = 128, HTB = HALF * BK * 2, NXCD = 8, WGM = 8;
__host__ __device__ __forceinline__ int lds_byte(int r, int c) { const int st = (r >> 4) * 2 + (c >> 5), rr = r & 15, cc = c & 31, ob = rr * 64 + cc * 2; return st * 1024 + (ob ^ (((ob >> 9) & 1) << 5)); }
__host__ __device__ __forceinline__ void stage_rc(int b, int& R, int& C) { const int st = b / 1024, sb = b % 1024, swz = sb ^ (((sb >> 9) & 1) << 5); R = (st >> 1) * 16 + swz / 64; C = (st & 1) * 32 + (swz % 64) / 2; }
__host__ __device__ __forceinline__ int perm32(int rho) { const int n = rho >> 4, i = rho & 15; return 8 * (i >> 2) + 4 * n + (i & 3); }
struct Unit { const char* a; const char* b; const int* rowmap; int row0, col0, aux; };
__device__ __forceinline__ void tile_order(int L, int nM, int nN, int& pm, int& pn) {
    const int nwg = nM * nN; int wgid = L; { const int q = nwg / NXCD, r = nwg % NXCD, xcd = wgid % NXCD, off = wgid / NXCD; wgid = (xcd < r ? xcd * (q + 1) : r * (q + 1) + (xcd - r) * q) + off; }
    const int nig = WGM * nN, gid = wgid / nig, fm = gid * WGM, gsz = (nM - fm) < WGM ? (nM - fm) : WGM;
    pm = fm + ((wgid % nig) % gsz); pn = (wgid % nig) / gsz;
}
template <class Epi>
__device__ __forceinline__ void epi_apply(const Epi& E, const f32x4 (&acc)[2][2][4][2], const Unit& u, int wr, int wc, int fr, int fq) {
    constexpr int MB = Epi::MB;
#pragma unroll
    for (int ai = 0; ai < 2; ++ai)
#pragma unroll
        for (int mp = 0; mp < 4 / MB; ++mp) {
            typename Epi::Ld ld[MB][2];
#pragma unroll
            for (int mm = 0; mm < MB; ++mm)
#pragma unroll
                for (int bj = 0; bj < 2; ++bj) E.load(ld[mm][bj], u.row0 + ai * HALF + wr * 64 + (mp * MB + mm) * 16 + fr, u.col0 + bj * HALF + wc * 32 + 8 * fq, u.aux);
#pragma unroll
            for (int mm = 0; mm < MB; ++mm)
#pragma unroll
                for (int bj = 0; bj < 2; ++bj) {
                    const int m = mp * MB + mm;
                    const f32x4 x0 = acc[ai][bj][m][0], x1 = acc[ai][bj][m][1];
                    const float v[8] = {x0[0], x0[1], x0[2], x0[3], x1[0], x1[1], x1[2], x1[3]};
                    E.store8(u.row0 + ai * HALF + wr * 64 + m * 16 + fr, u.col0 + bj * HALF + wc * 32 + 8 * fq, v, u.aux, ld[mm][bj]);
                }
            asm volatile("" ::: "memory");
        }
}
template <bool GATHER, class Epi, class Sched>
__device__ __forceinline__ void gemm_phase_t(LAS unsigned char* lds, const int K_, const Sched& S, const Epi& E, const int tid) {
    int K = K_; asm volatile("" : "+s"(K));
    const int wid = __builtin_amdgcn_readfirstlane(tid >> 6), lane = tid & 63, wr = wid >> 2, wc = wid & 3, fr = lane & 15, fq = lane >> 4;
    const int nt = K / BK;
    unsigned voffA[2], voffB[2];
#pragma unroll
    for (int i = 0; i < 2; ++i) { int R, C; stage_rc(tid * 16 + i * 8192, R, C); const int Rb = (R & ~31) + perm32(R & 31);
        voffA[i] = (unsigned)(R * K + C) * 2u; voffB[i] = (unsigned)(Rb * K + C) * 2u; }
    const size_t kstep = (size_t)(BK * 2);
    const size_t hstep = (size_t)HALF * K * 2;
    const unsigned ldsw = (unsigned)wid * 1024u;
    const int aoff = lds_byte(wr * 64 + fr, fq * 8), boff = lds_byte(wc * 32 + fr, fq * 8);
#define PG8_SA(b, h) (((b) * 2 + (h)) * HTB)
#define PG8_SB(b, h) ((4 + (b) * 2 + (h)) * HTB)
#define PG8_STAGE(bufoff, gbase, voff) do { _Pragma("unroll") for (int _i = 0; _i < 2; ++_i) \
        __builtin_amdgcn_global_load_lds((const unsigned*)((const char*)(gbase) + (voff)[_i]), (LAS unsigned*)(lds + (bufoff) + ldsw + _i * 8192), 16, 0, 0); } while (0)
#define PG8_LDA(dst, b, h) do { _Pragma("unroll") for (int m = 0; m < 4; ++m) _Pragma("unroll") for (int k = 0; k < 2; ++k) dst[m][k] = *(const LAS bf16x8*)(lds + PG8_SA(b, h) + aoff + m * 2048 + k * 1024); } while (0)
#define PG8_LDB(dst, b, h) do { _Pragma("unroll") for (int n = 0; n < 2; ++n) _Pragma("unroll") for (int k = 0; k < 2; ++k) dst[n][k] = *(const LAS bf16x8*)(lds + PG8_SB(b, h) + boff + n * 2048 + k * 1024); } while (0)
#define PG8_MMA(ai, bj, At, Bt) do { __builtin_amdgcn_s_setprio(1); _Pragma("unroll") for (int m = 0; m < 4; ++m) _Pragma("unroll") for (int n = 0; n < 2; ++n) _Pragma("unroll") for (int k = 0; k < 2; ++k) \
        acc[ai][bj][m][n] = __builtin_amdgcn_mfma_f32_16x16x32_bf16(Bt[n][k], At[m][k], acc[ai][bj][m][n], 0, 0, 0); __builtin_amdgcn_s_setprio(0); } while (0)
#define PG8_WAIT_V(n) asm volatile("s_waitcnt vmcnt(" #n ")" ::: "memory")
#define PG8_WAIT_L(n) asm volatile("s_waitcnt lgkmcnt(" #n ")" ::: "memory")
#define PG8_BAR __builtin_amdgcn_s_barrier()
#define PG8_SCHED __builtin_amdgcn_sched_barrier(0)
    Unit cur, nxt; int ui = 0;
    if (!S.next(0, cur)) return;
    f32x4 acc[2][2][4][2];
#pragma unroll
    for (int a = 0; a < 2; ++a)
#pragma unroll
        for (int b = 0; b < 2; ++b)
#pragma unroll
            for (int m = 0; m < 4; ++m)
#pragma unroll
                for (int n = 0; n < 2; ++n) acc[a][b][m][n] = (f32x4){0.f, 0.f, 0.f, 0.f};
    bf16x8 At[4][2], B0[2][2], B1[2][2];
    const char* cA = cur.a; const char* cB = cur.b;
    unsigned oc_lo[2] = {0u, 0u}, oc_hi[2] = {0u, 0u}, on_lo[2] = {0u, 0u}, on_hi[2] = {0u, 0u};
#define PG8_ROWOFF(U, LO, HI) do { _Pragma("unroll") for (int _i = 0; _i < 2; ++_i) { int R_, C_; stage_rc(tid * 16 + _i * 8192, R_, C_); \
        LO[_i] = (unsigned)((U).rowmap[R_] * K + C_) * 2u; HI[_i] = (unsigned)((U).rowmap[R_ + 128] * K + C_) * 2u; } } while (0)
    if constexpr (GATHER) PG8_ROWOFF(cur, oc_lo, oc_hi);
    PG8_STAGE(PG8_SB(0, 0), cB, voffB);
    if constexpr (GATHER) PG8_STAGE(PG8_SA(0, 0), cA, oc_lo); else PG8_STAGE(PG8_SA(0, 0), cA, voffA);
    PG8_STAGE(PG8_SB(0, 1), cB + hstep, voffB);
    if constexpr (GATHER) PG8_STAGE(PG8_SA(0, 1), cA, oc_hi); else PG8_STAGE(PG8_SA(0, 1), cA + hstep, voffA);
    if (wr == 1) PG8_BAR;
    PG8_WAIT_V(4); PG8_BAR;
    PG8_STAGE(PG8_SB(1, 0), cB + kstep, voffB);
    if constexpr (GATHER) PG8_STAGE(PG8_SA(1, 0), cA + kstep, oc_lo); else PG8_STAGE(PG8_SA(1, 0), cA + kstep, voffA);
    PG8_STAGE(PG8_SB(1, 1), cB + hstep + kstep, voffB);
    PG8_WAIT_V(6); PG8_BAR;
    for (;;) {
        const bool has_next = S.next(ui + 1, nxt);
        const char* nA = has_next ? nxt.a : cA; const char* nB = has_next ? nxt.b : cB;
        if constexpr (GATHER) { if (has_next) PG8_ROWOFF(nxt, on_lo, on_hi); else { on_lo[0] = oc_lo[0]; on_lo[1] = oc_lo[1]; on_hi[0] = oc_hi[0]; on_hi[1] = oc_hi[1]; } }
#pragma unroll 1
        for (int t = 0; t < nt; t += 2) {
            const bool last = (t == nt - 2);
            const char* a1 = cA + (size_t)(t + 1) * kstep;
            const char* a2 = last ? nA : cA + (size_t)(t + 2) * kstep; const char* b2 = last ? nB : cB + (size_t)(t + 2) * kstep;
            const char* a3 = a2 + kstep; const char* b3 = b2 + kstep;
            unsigned o2lo[2], o2hi[2];
            o2lo[0] = last ? on_lo[0] : oc_lo[0]; o2lo[1] = last ? on_lo[1] : oc_lo[1]; o2hi[0] = last ? on_hi[0] : oc_hi[0]; o2hi[1] = last ? on_hi[1] : oc_hi[1];
            PG8_LDB(B0, 0, 0); PG8_SCHED; PG8_LDA(At, 0, 0); if constexpr (GATHER) PG8_STAGE(PG8_SA(1, 1), a1, oc_hi); else PG8_STAGE(PG8_SA(1, 1), a1 + hstep, voffA);
            PG8_WAIT_L(8); PG8_BAR; PG8_WAIT_L(0); PG8_MMA(0, 0, At, B0); PG8_BAR; PG8_SCHED;
            PG8_LDB(B1, 0, 1); PG8_STAGE(PG8_SB(0, 0), b2, voffB);
            PG8_BAR; PG8_WAIT_L(0); PG8_MMA(0, 1, At, B1); PG8_BAR;
            PG8_LDA(At, 0, 1); if constexpr (GATHER) PG8_STAGE(PG8_SA(0, 0), a2, o2lo); else PG8_STAGE(PG8_SA(0, 0), a2, voffA);
            PG8_BAR; PG8_WAIT_L(0); PG8_MMA(1, 0, At, B0); PG8_BAR; PG8_SCHED;
            PG8_STAGE(PG8_SB(0, 1), b2 + hstep, voffB);
            PG8_WAIT_V(6); PG8_BAR; PG8_MMA(1, 1, At, B1); PG8_BAR;
            PG8_LDB(B0, 1, 0); PG8_SCHED; PG8_LDA(At, 1, 0); if constexpr (GATHER) PG8_STAGE(PG8_SA(0, 1), a2, o2hi); else PG8_STAGE(PG8_SA(0, 1), a2 + hstep, voffA);
            PG8_WAIT_L(8); PG8_BAR; PG8_WAIT_L(0); PG8_MMA(0, 0, At, B0); PG8_BAR; PG8_SCHED;
            PG8_LDB(B1, 1, 1); PG8_STAGE(PG8_SB(1, 0), b3, voffB);
            PG8_BAR; PG8_WAIT_L(0); PG8_MMA(0, 1, At, B1); PG8_BAR;
            PG8_LDA(At, 1, 1); if constexpr (GATHER) PG8_STAGE(PG8_SA(1, 0), a3, o2lo); else PG8_STAGE(PG8_SA(1, 0), a3, voffA);
            PG8_BAR; PG8_WAIT_L(0); PG8_MMA(1, 0, At, B0); PG8_BAR; PG8_SCHED;
            PG8_STAGE(PG8_SB(1, 1), b3 + hstep, voffB);
            PG8_WAIT_V(6); PG8_BAR; PG8_MMA(1, 1, At, B1); PG8_BAR;
        }
        epi_apply(E, acc, cur, wr, wc, fr, fq);
        if (!has_next) break;
#pragma unroll
        for (int a = 0; a < 2; ++a)
#pragma unroll
            for (int b = 0; b < 2; ++b)
#pragma unroll
                for (int m = 0; m < 4; ++m)
#pragma unroll
                    for (int n = 0; n < 2; ++n) acc[a][b][m][n] = (f32x4){0.f, 0.f, 0.f, 0.f};
        cur = nxt; cA = nA; cB = nB; ++ui;
        if constexpr (GATHER) { oc_lo[0] = on_lo[0]; oc_lo[1] = on_lo[1]; oc_hi[0] = on_hi[0]; oc_hi[1] = on_hi[1]; }
    }
    PG8_WAIT_V(0);
    if (wr == 0) PG8_BAR;
    PG8_BAR;
#undef PG8_ROWOFF
#undef PG8_SA
#undef PG8_SB
#undef PG8_STAGE
#undef PG8_LDA
#undef PG8_LDB
#undef PG8_MMA
#undef PG8_WAIT_V
#undef PG8_WAIT_L
#undef PG8_BAR
#undef PG8_SCHED
}
template <class Epi, class Sched>
__device__ __forceinline__ void gemm_phase(LAS unsigned char* lds, const int K, const Sched& S, const Epi& E, const int tid) { gemm_phase_t<false>(lds, K, S, E, tid); }
}

struct SchedInProj { const char* A; const char* Bt; int G, c;
    __device__ __forceinline__ bool next(int i, pg8::Unit& u) const { const int L = i * G + c; if (L >= 64 * 37) return false; int pm, pn; pg8::tile_order(L, 64, 37, pm, pn);
        u.a = A + (size_t)pm * (256 * 1024 * 2); u.b = Bt + (size_t)pn * (256 * 1024 * 2); u.row0 = pm * 256; u.col0 = pn * 256; u.aux = 0; u.rowmap = nullptr; return true; } };

struct WJob { const float* src; int ld_src; int K; int ncols; bf16* dst; int ld_dst; int nb; size_t sstride, dstride; };
__device__ __forceinline__ void wconv_job(const Ctx& c, const WJob& j) {
    float* tl = (float*)c.lds;
    const int ntk = j.K >> 6, ntn = j.ncols >> 6, per = ntk * ntn, ntiles = per * j.nb;
    const int rk = c.tid >> 3, rseg = (c.tid & 7) * 8;
    for (int tile = blockIdx.x; tile < ntiles; tile += gridDim.x) {
        const int bi = tile / per, tt = tile % per, tk = tt % ntk, tn = tt / ntk;
        const float* sp = j.src + (size_t)bi * j.sstride + (size_t)(tk * 64 + rk) * j.ld_src + tn * 64 + rseg;
        const float4 a = *(const float4*)sp, b = *(const float4*)(sp + 4);
        __syncthreads();
        float* row = tl + rk * 65 + rseg;
        row[0] = a.x; row[1] = a.y; row[2] = a.z; row[3] = a.w; row[4] = b.x; row[5] = b.y; row[6] = b.z; row[7] = b.w;
        __syncthreads();
        const float* col = tl + rseg * 65 + rk;
        uint4 w; w.x = pk2(col[0], col[65]); w.y = pk2(col[130], col[195]); w.z = pk2(col[260], col[325]); w.w = pk2(col[390], col[455]);
        *(uint4*)(j.dst + (size_t)bi * j.dstride + (size_t)(tn * 64 + rk) * j.ld_dst + tk * 64 + rseg) = w;
    }
}
struct SchedG2 { const char* YA; const char* Bt; int G, c;
    __device__ __forceinline__ bool next(int i, pg8::Unit& u) const { const int L = (i >> 1) * G + c, ab = i & 1; if (L >= 64 * 4) return false; int pm, pn; pg8::tile_order(L, 64, 4, pm, pn);
        u.a = YA + (size_t)ab * (WS_YB - WS_YA) + (size_t)pm * (256 * 1024 * 2); u.b = Bt + (size_t)(ab * 4 + pn) * (256 * 1024 * 2); u.row0 = pm * 256; u.col0 = ab * 1024 + pn * 256; u.aux = 0; u.rowmap = nullptr; return true; } };
struct SchedX1 { const char* A; const char* Bt; int G, c;
    __device__ __forceinline__ bool next(int i, pg8::Unit& u) const { const int L = i * G + c; if (L >= 64 * 4) return false; int pm, pn; pg8::tile_order(L, 64, 4, pm, pn);
        u.a = A + (size_t)pm * (256 * 1024 * 2); u.b = Bt + (size_t)pn * (256 * 1024 * 2); u.row0 = pm * 256; u.col0 = pn * 256; u.aux = 0; u.rowmap = nullptr; return true; } };
struct SchedMoe { const char* A; const char* Bt; const int* TILE_E; const int* SLOT_TOK; int NT, NPN, G, c;
    __device__ __forceinline__ bool next(int i, pg8::Unit& u) const { const int L = i * G + c; if (L >= NT * NPN) return false; int tile, pn; pg8::tile_order(L, NT, NPN, tile, pn);
        const int e = TILE_E[tile];
        u.a = SLOT_TOK ? A : A + (size_t)tile * (256 * 1024 * 2); u.rowmap = SLOT_TOK ? SLOT_TOK + tile * 256 : nullptr;
        u.b = Bt + (size_t)(e * NPN + pn) * (256 * 1024 * 2); u.row0 = tile * 256; u.col0 = pn * 256; u.aux = e; return true; } };

struct EpiLora {
    typedef NoLd Ld; static constexpr int MB = 1;
    const float* w0; const float* a0; float* LW; float* AA; bf16* GGR;
    __device__ __forceinline__ void load(Ld&, int, int, int) const {}
    __device__ __forceinline__ void store8(int row, int col, const float (&v)[8], int, const Ld&) const {
        const float* bp = col < 1024 ? w0 + col : a0 + ((col - 1024) & 1023);
        const float4 b0 = *(const float4*)bp, b1 = *(const float4*)(bp + 4);
        const float bb[8] = {b0.x, b0.y, b0.z, b0.w, b1.x, b1.y, b1.z, b1.w};
        if (col < 1024) { float o[8];
#pragma unroll
            for (int i = 0; i < 8; ++i) o[i] = -0.6065306597126334f * fsigm(bb[i] + v[i]);
            float* p = LW + (size_t)row * 1024 + col; *(float4*)p = make_float4(o[0], o[1], o[2], o[3]); *(float4*)(p + 4) = make_float4(o[4], o[5], o[6], o[7]); }
        else if (col < 2048) { const int cc = col - 1024; float o[8];
#pragma unroll
            for (int i = 0; i < 8; ++i) o[i] = fsigm(bb[i] + v[i]);
            float* p = AA + (size_t)row * 1024 + cc; *(float4*)p = make_float4(o[0], o[1], o[2], o[3]); *(float4*)(p + 4) = make_float4(o[4], o[5], o[6], o[7]); }
        else { uint4 w; w.x = pk2(v[0], v[1]); w.y = pk2(v[2], v[3]); w.z = pk2(v[4], v[5]); w.w = pk2(v[6], v[7]); *(uint4*)(GGR + (size_t)row * 1024 + (col - 2048)) = w; }
    }
};
struct SchedLora { const char* A; const char* Bt; int G, c;
    __device__ __forceinline__ bool next(int i, pg8::Unit& u) const { const int L = i * G + c; if (L >= 64 * 12) return false; int pm, pn; pg8::tile_order(L, 64, 12, pm, pn);
        u.a = A + (size_t)pm * (256 * 256 * 2); u.b = Bt + (size_t)pn * (256 * 256 * 2); u.row0 = pm * 256; u.col0 = pn * 256; u.aux = 0; u.rowmap = nullptr; return true; } };
__device__ __forceinline__ void lora_zero(const Ctx& c) {
    uint4* LT = c.ws<uint4>(WS_LORA_T);
    for (size_t idx = c.gtid; idx < (size_t)3072 * 32; idx += c.nthreads) {
        const int row = (int)(idx >> 5), k8 = (int)(idx & 31) * 8;
        const bool data = row < 1024 ? (k8 < 64) : (row < 2048 ? (k8 >= 64 && k8 < 128) : (k8 >= 128));
        if (!data) LT[idx] = make_uint4(0, 0, 0, 0);
    }
}

__device__ __forceinline__ void ph_loraprep(const Ctx& c) {
    const float* LIN = c.ws<float>(WS_LIN); bf16* AL = c.ws<bf16>(WS_ALORA); const float* mu = c.P.in[I_MU];
    for (size_t idx = c.gtid; idx < (size_t)T * 256; idx += c.nthreads) {
        const int t = (int)(idx >> 8), cc = (int)(idx & 255);
        const float x = LIN[idx], xp = (t & (SEQ - 1)) ? LIN[idx - 256] : 0.f;
        const float xs = x + (xp - x) * mu[3072 + cc];
        const float r = cc < 64 ? tanhf(xs) : (cc < 128 ? xs : sigm(xs));
        AL[idx] = f2bf(r);
    }
}
__device__ __forceinline__ void ph_post(const Ctx& c) {
    const float* OG = c.ws<float>(WS_OG); const float* ORW = c.ws<float>(WS_ORW); const bf16* ZS = c.ws<bf16>(WS_ZS); const bf16* VP = c.ws<bf16>(WS_VP); const bf16* GGR = c.ws<bf16>(WS_GGR);
    const float* SC = c.ws<float>(WS_SC); bf16* YA = c.ws<bf16>(WS_YA); bf16* YB = c.ws<bf16>(WS_YB);
    const float* gnw = c.P.in[I_GDN_NORM]; const float* lnw = c.P.in[I_LNW]; const float* lnb = c.P.in[I_LNB];
    const int lane = c.lane, c0 = lane * 16;
    for (int t = c.gwave; t < T; t += c.nwaves) {
        {
            float o[16];
#pragma unroll
            for (int q = 0; q < 4; ++q) { const float4 v = *(const float4*)(OG + (size_t)t * 1024 + c0 + 4 * q); o[4 * q] = v.x; o[4 * q + 1] = v.y; o[4 * q + 2] = v.z; o[4 * q + 3] = v.w; }
            float ss = 0.f;
#pragma unroll
            for (int j = 0; j < 16; ++j) ss += o[j] * o[j];
            ss += __shfl_xor(ss, 1); ss += __shfl_xor(ss, 2); ss += __shfl_xor(ss, 4);
            const float rstd = rsqrtf(ss * (1.f / 128.f) + 1e-6f);
            const uint4 z0 = *(const uint4*)(ZS + (size_t)t * 1024 + c0), z1 = *(const uint4*)(ZS + (size_t)t * 1024 + c0 + 8);
            const unsigned zz[8] = {z0.x, z0.y, z0.z, z0.w, z1.x, z1.y, z1.z, z1.w};
            unsigned w[8];
#pragma unroll
            for (int j = 0; j < 8; ++j) { const int cc = (c0 + 2 * j) & 127; w[j] = pk2(o[2 * j] * rstd * gnw[cc] * bflo(zz[j]), o[2 * j + 1] * rstd * gnw[cc + 1] * bfhi(zz[j])); }
            *(uint4*)(YA + (size_t)t * 1024 + c0) = make_uint4(w[0], w[1], w[2], w[3]); *(uint4*)(YA + (size_t)t * 1024 + c0 + 8) = make_uint4(w[4], w[5], w[6], w[7]);
        }
        {
            float o[16];
#pragma unroll
            for (int q = 0; q < 4; ++q) { const float4 v = *(const float4*)(ORW + (size_t)t * 1024 + c0 + 4 * q); o[4 * q] = v.x; o[4 * q + 1] = v.y; o[4 * q + 2] = v.z; o[4 * q + 3] = v.w; }
            float sm = 0.f;
#pragma unroll
            for (int j = 0; j < 16; ++j) sm += o[j];
            sm += __shfl_xor(sm, 1); sm += __shfl_xor(sm, 2);
            const float mean = sm * (1.f / 64.f);
            float sv = 0.f;
#pragma unroll
            for (int j = 0; j < 16; ++j) { const float dd = o[j] - mean; sv += dd * dd; }
            sv += __shfl_xor(sv, 1); sv += __shfl_xor(sv, 2);
            const float rstd = rsqrtf(sv * (1.f / 64.f) + 64e-5f);
            const float sc = SC[t * 16 + (c0 >> 6)];
            const uint4 v0 = *(const uint4*)(VP + (size_t)t * 1024 + c0), v1 = *(const uint4*)(VP + (size_t)t * 1024 + c0 + 8);
            const uint4 g0 = *(const uint4*)(GGR + (size_t)t * 1024 + c0), g1 = *(const uint4*)(GGR + (size_t)t * 1024 + c0 + 8);
            const unsigned vv[8] = {v0.x, v0.y, v0.z, v0.w, v1.x, v1.y, v1.z, v1.w};
            const unsigned gg[8] = {g0.x, g0.y, g0.z, g0.w, g1.x, g1.y, g1.z, g1.w};
            unsigned w[8];
#pragma unroll
            for (int j = 0; j < 8; ++j) { const int cc = c0 + 2 * j;
                const float y0 = ((o[2 * j] - mean) * rstd * lnw[cc] + lnb[cc] + sc * bflo(vv[j])) * bflo(gg[j]);
                const float y1 = ((o[2 * j + 1] - mean) * rstd * lnw[cc + 1] + lnb[cc + 1] + sc * bfhi(vv[j])) * bfhi(gg[j]);
                w[j] = pk2(y0, y1); }
            *(uint4*)(YB + (size_t)t * 1024 + c0) = make_uint4(w[0], w[1], w[2], w[3]); *(uint4*)(YB + (size_t)t * 1024 + c0 + 8) = make_uint4(w[4], w[5], w[6], w[7]);
        }
    }
}

__device__ __forceinline__ void ph_router(const Ctx& c) {
    const float* X1 = c.ws<float>(WS_X1); const float* nw = c.P.in[I_NORM_FFN]; const float* rw = c.P.in[I_ROUTER_W]; const float* rb = c.P.in[I_ROUTER_B];
    bf16* H2 = c.ws<bf16>(WS_H2); int* TE = c.ws<int>(WS_TE); float* TG = c.ws<float>(WS_TG); int* TP = c.ws<int>(WS_TP); unsigned* CNT = c.ws<unsigned>(WS_CTL) + CW_CNT;
    const int lane = c.lane;
    float4* tab = (float4*)c.lds;
    unsigned* lcnt = (unsigned*)(c.lds + 147456);
    __syncthreads();
    if (c.tid < 32) lcnt[c.tid] = 0u;
    for (int i = c.tid; i < 8192; i += NTHREADS) { const int k = i >> 3; tab[((k & 3) * 256 + (k >> 2)) * 9 + (i & 7)] = ((const float4*)rw)[i]; }
    __syncthreads();
    for (int t = c.gwave; t < T; t += c.nwaves) {
        float4 v[4]; float ss = 0.f;
#pragma unroll
        for (int i = 0; i < 4; ++i) { v[i] = ((const float4*)(X1 + (size_t)t * D))[lane + 64 * i]; ss += v[i].x * v[i].x + v[i].y * v[i].y + v[i].z * v[i].z + v[i].w * v[i].w; }
        ss = wsum(ss);
        const float rstd = rsqrtf(ss * (1.f / 1024.f) + 1e-6f);
        float lg[32];
#pragma unroll
        for (int j = 0; j < 32; ++j) lg[j] = 0.f;
#pragma unroll
        for (int i = 0; i < 4; ++i) {
            const float4 w4 = ((const float4*)nw)[lane + 64 * i];
            const float h[4] = {v[i].x * rstd * w4.x, v[i].y * rstd * w4.y, v[i].z * rstd * w4.z, v[i].w * rstd * w4.w};
            uint2 st; st.x = pk2(h[0], h[1]); st.y = pk2(h[2], h[3]);
            *(uint2*)(H2 + (size_t)t * D + 4 * (lane + 64 * i)) = st;
#pragma unroll
            for (int ii = 0; ii < 4; ++ii) {
                const float4* wr = tab + (size_t)(ii * 256 + lane + 64 * i) * 9;
#pragma unroll
                for (int q = 0; q < 8; ++q) { const float4 w = wr[q]; lg[4 * q] += h[ii] * w.x; lg[4 * q + 1] += h[ii] * w.y; lg[4 * q + 2] += h[ii] * w.z; lg[4 * q + 3] += h[ii] * w.w; }
                asm volatile("" ::: "memory");
            }
        }
#pragma unroll
        for (int j = 0; j < 32; ++j) lg[j] = wsum(lg[j]) + rb[j];
        int e0 = 0, e1 = 0, e2 = 0, e3 = 0; float v0 = -3e38f, v1 = -3e38f, v2 = -3e38f, v3 = -3e38f;
#pragma unroll
        for (int j = 0; j < 32; ++j) if (lg[j] > v0) { v0 = lg[j]; e0 = j; }
#pragma unroll
        for (int j = 0; j < 32; ++j) if (j != e0 && lg[j] > v1) { v1 = lg[j]; e1 = j; }
#pragma unroll
        for (int j = 0; j < 32; ++j) if (j != e0 && j != e1 && lg[j] > v2) { v2 = lg[j]; e2 = j; }
#pragma unroll
        for (int j = 0; j < 32; ++j) if (j != e0 && j != e1 && j != e2 && lg[j] > v3) { v3 = lg[j]; e3 = j; }
        const float x1 = expf(v1 - v0), x2 = expf(v2 - v0), x3 = expf(v3 - v0), inv = 1.f / (1.f + x1 + x2 + x3);
        if (lane < 4) {
            const int me = lane == 0 ? e0 : (lane == 1 ? e1 : (lane == 2 ? e2 : e3));
            const float mg = (lane == 0 ? 1.f : (lane == 1 ? x1 : (lane == 2 ? x2 : x3))) * inv;
            const unsigned pos = atomicAdd(&lcnt[me], 1u);
            TE[t * 4 + lane] = me; TG[t * 4 + lane] = mg; TP[t * 4 + lane] = (int)pos;
        }
    }
    __syncthreads();
    if (c.tid < 32) lcnt[32 + c.tid] = atomicAdd(&CNT[c.tid], lcnt[c.tid]);
    __syncthreads();
    if (lane < 4) for (int t = c.gwave; t < T; t += c.nwaves) TP[t * 4 + lane] += (int)lcnt[32 + TE[t * 4 + lane]];
    __syncthreads();
}

__device__ __forceinline__ void ph_dispatch(const Ctx& c) {
    int* tb = (int*)c.lds;
    const unsigned* CNT = c.ws<unsigned>(WS_CTL) + CW_CNT;
    int* TILE_E = c.ws<int>(WS_TILE_E); int* NT = c.ws<int>(WS_NT);
    const int* TE = c.ws<int>(WS_TE); const float* TG = c.ws<float>(WS_TG); const int* TP = c.ws<int>(WS_TP); int* TSLOT = c.ws<int>(WS_TSLOT);
    float* SGATE = c.ws<float>(WS_SGATE); const bf16* H2 = c.ws<bf16>(WS_H2); bf16* XB = c.ws<bf16>(WS_XB);
    if (c.tid == 0) { int acc = 0; for (int e = 0; e < NEXP; ++e) { const int n = (int)__hip_atomic_load(&CNT[e], __ATOMIC_RELAXED, __HIP_MEMORY_SCOPE_AGENT); tb[e] = acc; tb[64 + e] = n; acc += (n + 255) >> 8; } tb[32] = acc; }
    __syncthreads();
    if (blockIdx.x == 0) {
        for (int tile = c.tid; tile < tb[32]; tile += NTHREADS) { int e = 0; for (int q = 0; q < NEXP; ++q) if (tile >= tb[q]) e = q; TILE_E[tile] = e; }
        if (c.tid == 0) *NT = tb[32];
    }
    int* SLOT_TOK = c.ws<int>(WS_SLOT_TOK);
    for (size_t idx = c.gtid; idx < (size_t)T * 4; idx += c.nthreads) {
        const int t = (int)(idx >> 2), e = TE[idx], pos = TP[idx];
        const int slot = tb[e] * 256 + pos;
        TSLOT[idx] = slot; SGATE[slot] = TG[idx]; SLOT_TOK[slot] = t;
    }
    for (int e = 0; e < NEXP; ++e) {
        const int n = tb[64 + e], cap = (tb[e + 1] - tb[e]) * 256;
        for (int r = n + (int)c.gtid; r < cap; r += (int)c.nthreads) { const int slot = tb[e] * 256 + r; SLOT_TOK[slot] = 0; SGATE[slot] = 0.f; }
    }
}

__device__ __forceinline__ void ph_combine(const Ctx& c) {
    const float* X1 = c.ws<float>(WS_X1); const bf16* YS = c.ws<bf16>(WS_YS); const int* TSLOT = c.ws<int>(WS_TSLOT); const float* nw = c.P.in[I_NORM_FINAL]; float* out = c.P.out;
    const int lane = c.lane;
    for (int t = c.gwave; t < T; t += c.nwaves) {
        const int s0 = TSLOT[t * 4], s1 = TSLOT[t * 4 + 1], s2 = TSLOT[t * 4 + 2], s3 = TSLOT[t * 4 + 3];
        float4 v[4]; float ss = 0.f;
#pragma unroll
        for (int i = 0; i < 4; ++i) {
            const int col = 4 * (lane + 64 * i);
            v[i] = *(const float4*)(X1 + (size_t)t * D + col);
            const uint2 a = *(const uint2*)(YS + (size_t)s0 * 1024 + col), b = *(const uint2*)(YS + (size_t)s1 * 1024 + col), cc = *(const uint2*)(YS + (size_t)s2 * 1024 + col), d = *(const uint2*)(YS + (size_t)s3 * 1024 + col);
            v[i].x += bflo(a.x) + bflo(b.x) + bflo(cc.x) + bflo(d.x); v[i].y += bfhi(a.x) + bfhi(b.x) + bfhi(cc.x) + bfhi(d.x);
            v[i].z += bflo(a.y) + bflo(b.y) + bflo(cc.y) + bflo(d.y); v[i].w += bfhi(a.y) + bfhi(b.y) + bfhi(cc.y) + bfhi(d.y);
            ss += v[i].x * v[i].x + v[i].y * v[i].y + v[i].z * v[i].z + v[i].w * v[i].w;
        }
        ss = wsum(ss);
        const float rstd = rsqrtf(ss * (1.f / 1024.f) + 1e-6f);
#pragma unroll
        for (int i = 0; i < 4; ++i) { const float4 w4 = ((const float4*)nw)[lane + 64 * i];
            *(float4*)(out + (size_t)t * D + 4 * (lane + 64 * i)) = make_float4(v[i].x * rstd * w4.x, v[i].y * rstd * w4.y, v[i].z * rstd * w4.z, v[i].w * rstd * w4.w); }
    }
}


typedef short bf16x8_t __attribute__((ext_vector_type(8)));
typedef float f32x4_t __attribute__((ext_vector_type(4)));
#define MFMA16(a, b, c) __builtin_amdgcn_mfma_f32_16x16x32_bf16((a), (b), (c), 0, 0, 0)


__device__ __forceinline__ int frag_off(int row, int k, int KBn) { return (((row >> 4) * KBn + (k >> 5)) * 512) + (((k >> 3) & 3) * 128) + ((row & 15) * 8) + (k & 7); }
__device__ __forceinline__ int cfrag_off(int v, int r, int NRT) { return ((((v >> 4) * NRT + (r >> 4)) * 64 + ((r >> 2) & 3) * 16 + (v & 15)) * 4) + (r & 3); }

constexpr int GCL_HALF_BYTES = 71680;
__device__ __forceinline__ void ph_gcl(const Ctx& c) {
    const bf16* GQKV = c.ws<bf16>(WS_GQKV); const float* BETA = c.ws<float>(WS_BETA); const float* GGv = c.ws<float>(WS_GG); const float* cw = c.P.in[I_GDN_CONV];
    bf16* GA1 = c.ws<bf16>(WS_GA1); bf16* GX0 = c.ws<bf16>(WS_GX0); bf16* GA2 = c.ws<bf16>(WS_GA2); bf16* GA3 = c.ws<bf16>(WS_GA3); bf16* GA4 = c.ws<bf16>(WS_GA4); float* GGL = c.ws<float>(WS_GGL);
    for (int it0 = blockIdx.x * 2; it0 < 2048; it0 += gridDim.x * 2) {
        int tv = c.tid; asm volatile("" : "+v"(tv));
        const int half = tv >> 8, ht = tv & 255, lane = tv & 63, w4 = __builtin_amdgcn_readfirstlane((tv >> 6) & 3);
        unsigned char* base = c.lds + half * GCL_HALF_BYTES;
        bf16* QB = (bf16*)base;
        bf16* KB = QB + 64 * 136;
        bf16* VB = KB + 64 * 136;
        float* MM = (float*)(VB + 64 * 136);
        float* GC = MM + 64 * 64;
        float* BT = GC + 64;
        float* BE = BT + 64;
        const int item = it0 + half, n = item & 63, bh = item >> 6, h = bh & 7, b = bh >> 3;
        const int t0 = b * SEQ + n * 64;
        __syncthreads();
        if (w4 == 0) {
            float g = GGv[(size_t)(t0 + lane) * 8 + h]; const float be = BETA[(size_t)(t0 + lane) * 8 + h];
#pragma unroll
            for (int o = 1; o < 64; o <<= 1) { const float u = __shfl_up(g, o); if (lane >= o) g += u; }
            GC[lane] = g; BT[lane] = be; BE[lane] = be * __expf(g);
        }
        __syncthreads();
        {
            const int cg = ht & 15, rg = ht >> 4, r0 = rg * 4;
#pragma unroll
            for (int mat = 0; mat < 3; ++mat) {
                const int col0 = mat * 1024 + h * 128 + cg * 8;
                float4 xa[7], xb[7], wa[4], wb[4];
#pragma unroll
                for (int li = 0; li < 7; ++li) {
                    const bool valid = (n > 0) || (r0 - 3 + li >= 0);
                    uint4 xr = make_uint4(0, 0, 0, 0);
                    if (valid) xr = *(const uint4*)(GQKV + (size_t)(t0 + r0 - 3 + li) * 3072 + col0);
                    xa[li] = make_float4(bflo(xr.x), bfhi(xr.x), bflo(xr.y), bfhi(xr.y));
                    xb[li] = make_float4(bflo(xr.z), bfhi(xr.z), bflo(xr.w), bfhi(xr.w));
                }
#pragma unroll
                for (int j = 0; j < 4; ++j) { wa[j] = *(const float4*)(cw + j * 3072 + col0); wb[j] = *(const float4*)(cw + j * 3072 + col0 + 4); }
#pragma unroll
                for (int rr = 0; rr < 4; ++rr) {
                    float o[8] = {0.f, 0.f, 0.f, 0.f, 0.f, 0.f, 0.f, 0.f};
#pragma unroll
                    for (int j = 0; j < 4; ++j) { const float4 a = xa[rr + j], bq = xb[rr + j];
                        o[0] += wa[j].x * a.x; o[1] += wa[j].y * a.y; o[2] += wa[j].z * a.z; o[3] += wa[j].w * a.w;
                        o[4] += wb[j].x * bq.x; o[5] += wb[j].y * bq.y; o[6] += wb[j].z * bq.z; o[7] += wb[j].w * bq.w; }
                    float ss = 0.f;
#pragma unroll
                    for (int e = 0; e < 8; ++e) { o[e] *= fsigm(o[e]); ss += o[e] * o[e]; }
                    float sc = 1.f;
                    if (mat < 2) { ss += __shfl_xor(ss, 1); ss += __shfl_xor(ss, 2); ss += __shfl_xor(ss, 4); ss += __shfl_xor(ss, 8); sc = rsqrtf(ss + 1e-6f) * (mat == 0 ? 0.08838834764831845f : 1.f); }
                    const int r = r0 + rr;
                    uint4 w; w.x = pk2(o[0] * sc, o[1] * sc); w.y = pk2(o[2] * sc, o[3] * sc); w.z = pk2(o[4] * sc, o[5] * sc); w.w = pk2(o[6] * sc, o[7] * sc);
                    *(uint4*)((mat == 0 ? QB : (mat == 1 ? KB : VB)) + r * 136 + cg * 8) = w;
                    if (mat == 0) {
                        const float s2 = sc * __expf(GC[r]);
                        w.x = pk2(o[0] * s2, o[1] * s2); w.y = pk2(o[2] * s2, o[3] * s2); w.z = pk2(o[4] * s2, o[5] * s2); w.w = pk2(o[6] * s2, o[7] * s2);
                        *(uint4*)(GA2 + (size_t)item * 64 * 128 + frag_off(r, cg * 8, 4)) = w;
                    }
                }
            }
        }
        __syncthreads();
        {
            const int fr = lane & 15, fq = lane >> 4, a0 = w4 * 16;
            bf16x8_t ka[4];
#pragma unroll
            for (int kb = 0; kb < 4; ++kb) ka[kb] = *(const bf16x8_t*)(KB + (a0 + fr) * 136 + kb * 32 + fq * 8);
#pragma unroll
            for (int bt = 0; bt < 4; ++bt) {
                f32x4_t c1 = {0.f, 0.f, 0.f, 0.f}, c2 = {0.f, 0.f, 0.f, 0.f};
#pragma unroll
                for (int kb = 0; kb < 4; ++kb) {
                    const bf16x8_t kbf = *(const bf16x8_t*)(KB + (bt * 16 + fr) * 136 + kb * 32 + fq * 8);
                    const bf16x8_t qbf = *(const bf16x8_t*)(QB + (bt * 16 + fr) * 136 + kb * 32 + fq * 8);
                    c1 = MFMA16(ka[kb], kbf, c1); c2 = MFMA16(ka[kb], qbf, c2);
                }
                const int i = bt * 16 + fr, j0 = a0 + 4 * fq;
                const float gi = GC[i], bi = BT[i];
                float m[4], at[4];
#pragma unroll
                for (int rg = 0; rg < 4; ++rg) { const int j = j0 + rg; const float dec = __expf(fminf(gi - GC[j], 0.f));
                    m[rg] = (i > j) ? bi * c1[rg] * dec : 0.f; at[rg] = (i >= j) ? c2[rg] * dec : 0.f; }
                *(float4*)(MM + i * 64 + j0) = make_float4(m[0], m[1], m[2], m[3]);
                uint2 w; w.x = pk2(at[0], at[1]); w.y = pk2(at[2], at[3]);
                *(uint2*)(GA3 + (size_t)item * 64 * 64 + frag_off(i, j0, 2)) = w;
            }
        }
        __syncthreads();
        {
            const int cc = ht & 127; const bool isw = ht >= 128;
            const bf16* srcp = (isw ? KB : VB) + cc; const float* scl = isw ? BE : BT;
            float x[64];
#pragma unroll
            for (int i = 0; i < 64; ++i) x[i] = 0.f;
            float4 mc[16], mn[16];
#pragma unroll
            for (int q = 0; q < 16; ++q) { mc[q] = make_float4(0.f, 0.f, 0.f, 0.f); mn[q] = mc[q]; }
            float rhs_n = scl[0] * bf2f(srcp[0]);
#pragma unroll
            for (int i = 0; i < 64; ++i) {
                const float rhs = rhs_n;
                if (i + 1 < 64) {
#pragma unroll
                    for (int j4 = 0; j4 < (i + 4) / 4; ++j4) mn[j4] = *(const float4*)(MM + (i + 1) * 64 + 4 * j4);
                    rhs_n = scl[i + 1] * bf2f(srcp[(i + 1) * 136]);
                }
                float acc = rhs, ac1 = 0.f, ac2 = 0.f, ac3 = 0.f;
#pragma unroll
                for (int j4 = 0; j4 < (i + 3) / 4; ++j4) { acc -= mc[j4].x * x[4 * j4]; ac1 -= mc[j4].y * x[4 * j4 + 1]; ac2 -= mc[j4].z * x[4 * j4 + 2]; ac3 -= mc[j4].w * x[4 * j4 + 3]; }
                x[i] = (acc + ac1) + (ac2 + ac3);
#pragma unroll
                for (int j4 = 0; j4 < 16; ++j4) mc[j4] = mn[j4];
                asm volatile("" ::: "memory");
            }
            if (!isw) {
                bf16* up = GX0 + (size_t)item * 128 * 64;
#pragma unroll
                for (int q = 0; q < 16; ++q) { uint2 w; w.x = pk2(x[4 * q], x[4 * q + 1]); w.y = pk2(x[4 * q + 2], x[4 * q + 3]); *(uint2*)(up + cfrag_off(cc, 4 * q, 4)) = w; }
            }
            __syncthreads();
            if (isw) {
                bf16* a1s = (bf16*)MM;
#pragma unroll
                for (int i = 0; i < 64; ++i) a1s[i * 128 + cc] = f2bf(-x[i]);
            }
        }
        __syncthreads();
        {
            const bf16* a1s = (const bf16*)MM; bf16* wp = GA1 + (size_t)item * 64 * 128;
#pragma unroll
            for (int q = 0; q < 4; ++q) { const int p = ht + 256 * q, fr = p & 15, fq = (p >> 4) & 3, kb = (p >> 6) & 3, rt = p >> 8;
                *(uint4*)(wp + p * 8) = *(const uint4*)(a1s + (rt * 16 + fr) * 128 + kb * 32 + fq * 8); }
        }
        {
            const int dk = ht & 127, hh = ht >> 7; const float g63 = GC[63];
            unsigned w[16];
#pragma unroll
            for (int q = 0; q < 16; ++q) { const int ta = hh * 32 + 2 * q;
                w[q] = pk2(bf2f(KB[ta * 136 + dk]) * __expf(g63 - GC[ta]), bf2f(KB[(ta + 1) * 136 + dk]) * __expf(g63 - GC[ta + 1])); }
            bf16* dp = GA4 + (size_t)item * 128 * 64;
            *(uint4*)(dp + frag_off(dk, hh * 32, 2)) = make_uint4(w[0], w[1], w[2], w[3]); *(uint4*)(dp + frag_off(dk, hh * 32 + 8, 2)) = make_uint4(w[4], w[5], w[6], w[7]);
            *(uint4*)(dp + frag_off(dk, hh * 32 + 16, 2)) = make_uint4(w[8], w[9], w[10], w[11]); *(uint4*)(dp + frag_off(dk, hh * 32 + 24, 2)) = make_uint4(w[12], w[13], w[14], w[15]);
            if (ht == 0) GGL[item] = __expf(g63);
        }
    }
}

constexpr int RCL_HALF_BYTES = 75776;
__device__ __forceinline__ void ph_rcl(const Ctx& c) {
    const bf16* RKV = c.ws<bf16>(WS_RKV); const float* LW = c.ws<float>(WS_LW); const float* AAg = c.ws<float>(WS_AA);
    const float* mu = c.P.in[I_MU]; const float* k_k = c.P.in[I_KK]; const float* k_a = c.P.in[I_KA]; const float* r_k = c.P.in[I_RK];
    bf16* VP = c.ws<bf16>(WS_VP); float* SC = c.ws<float>(WS_SC);
    bf16* RA1 = c.ws<bf16>(WS_RA1); bf16* RX0 = c.ws<bf16>(WS_RX0); bf16* RA2 = c.ws<bf16>(WS_RA2); bf16* RA3 = c.ws<bf16>(WS_RA3); bf16* RO0 = c.ws<bf16>(WS_RO0);
    bf16* RA4 = c.ws<bf16>(WS_RA4); bf16* RS0 = c.ws<bf16>(WS_RS0); float* RDSC = c.ws<float>(WS_RDSC);
    for (int it0 = blockIdx.x * 2; it0 < 4096; it0 += gridDim.x * 2) {
        int tv = c.tid; asm volatile("" : "+v"(tv));
        const int half = tv >> 8, ht = tv & 255, lane = tv & 63, w4 = __builtin_amdgcn_readfirstlane((tv >> 6) & 3);
        unsigned char* base = c.lds + half * RCL_HALF_BYTES;
        bf16* AT = (bf16*)base;
        bf16* VT = AT + 64 * 72;
        bf16* KDT = VT + 64 * 72;
        float* AAB = (float*)(KDT + 64 * 72);
        float* TOT = AAB + 64 * 64;
        unsigned char* RX = (unsigned char*)(TOT + 256);
        bf16* RT = (bf16*)RX;
        bf16* BTL = RT + 64 * 72;
        bf16* KT = BTL + 64 * 72;
        bf16* AAK = (bf16*)RX;
        bf16* ARK = AAK + 64 * 72;
        float* RHS2 = (float*)RX;
        const int item = it0 + half, n = item & 63, bh = item >> 6, h = bh & 15, b = bh >> 4;
        const int t0 = b * SEQ + n * 64;
        __syncthreads();
        const int r = ht >> 2, seg = ht & 3, c0 = seg * 16, t = t0 + r; const bool first = (n == 0 && r == 0);
        float rr[16], kf[16], vv[16], kkv[16], aa[16], lwl[16];
        float ss = 0.f, scs = 0.f;
        {
            const bf16* cur = RKV + (size_t)t * 3072 + h * 64 + c0; const bf16* prv = cur - 3072;
            uint4 ur[2], uk[2], uv[2], qr[2], qk[2], qv[2];
            float4 a4v[4], l4v[4], mr[4], mk[4], mv[4], kkw[4], kaw[4], rkw[4];
#pragma unroll
            for (int g = 0; g < 2; ++g) {
                ur[g] = *(const uint4*)(cur + 8 * g); uk[g] = *(const uint4*)(cur + 1024 + 8 * g); uv[g] = *(const uint4*)(cur + 2048 + 8 * g);
                qr[g] = make_uint4(0, 0, 0, 0); qk[g] = qr[g]; qv[g] = qr[g];
                if (!first) { qr[g] = *(const uint4*)(prv + 8 * g); qk[g] = *(const uint4*)(prv + 1024 + 8 * g); qv[g] = *(const uint4*)(prv + 2048 + 8 * g); }
            }
#pragma unroll
            for (int q = 0; q < 4; ++q) {
                l4v[q] = *(const float4*)(LW + (size_t)t * 1024 + h * 64 + c0 + 4 * q);
                a4v[q] = *(const float4*)(AAg + (size_t)t * 1024 + h * 64 + c0 + 4 * q);
                mr[q] = *(const float4*)(mu + h * 64 + c0 + 4 * q); mk[q] = *(const float4*)(mu + 1024 + h * 64 + c0 + 4 * q); mv[q] = *(const float4*)(mu + 2048 + h * 64 + c0 + 4 * q);
                kkw[q] = *(const float4*)(k_k + h * 64 + c0 + 4 * q); kaw[q] = *(const float4*)(k_a + h * 64 + c0 + 4 * q); rkw[q] = *(const float4*)(r_k + h * 64 + c0 + 4 * q);
            }
#pragma unroll
            for (int q = 0; q < 4; ++q) *(float4*)(AAB + r * 64 + c0 + 4 * q) = l4v[q];
            __syncthreads();
            {
                const int ch = ht & 63, tq = ht >> 6;
                float run = 0.f;
#pragma unroll
                for (int i = 0; i < 16; ++i) { run += AAB[(tq * 16 + i) * 64 + ch]; AAB[(tq * 16 + i) * 64 + ch] = run; }
                TOT[tq * 64 + ch] = run;
            }
            __syncthreads();
#pragma unroll
            for (int q = 0; q < 4; ++q) {
                const int g = q >> 1; const bool hi = q & 1;
                const unsigned r_a = hi ? ur[g].z : ur[g].x, r_b = hi ? ur[g].w : ur[g].y, k_a_ = hi ? uk[g].z : uk[g].x, k_b_ = hi ? uk[g].w : uk[g].y, v_a = hi ? uv[g].z : uv[g].x, v_b = hi ? uv[g].w : uv[g].y;
                const unsigned pr_a = hi ? qr[g].z : qr[g].x, pr_b = hi ? qr[g].w : qr[g].y, pk_a = hi ? qk[g].z : qk[g].x, pk_b = hi ? qk[g].w : qk[g].y, pv_a = hi ? qv[g].z : qv[g].x, pv_b = hi ? qv[g].w : qv[g].y;
                const float r0a[4] = {bflo(r_a), bfhi(r_a), bflo(r_b), bfhi(r_b)}, k0a[4] = {bflo(k_a_), bfhi(k_a_), bflo(k_b_), bfhi(k_b_)}, v0a[4] = {bflo(v_a), bfhi(v_a), bflo(v_b), bfhi(v_b)};
                const float rpa[4] = {bflo(pr_a), bfhi(pr_a), bflo(pr_b), bfhi(pr_b)}, kpa[4] = {bflo(pk_a), bfhi(pk_a), bflo(pk_b), bfhi(pk_b)}, vpa[4] = {bflo(pv_a), bfhi(pv_a), bflo(pv_b), bfhi(pv_b)};
                const float mra[4] = {mr[q].x, mr[q].y, mr[q].z, mr[q].w}, mka[4] = {mk[q].x, mk[q].y, mk[q].z, mk[q].w}, mva[4] = {mv[q].x, mv[q].y, mv[q].z, mv[q].w};
                const float kka[4] = {kkw[q].x, kkw[q].y, kkw[q].z, kkw[q].w}, kaa[4] = {kaw[q].x, kaw[q].y, kaw[q].z, kaw[q].w}, rka[4] = {rkw[q].x, rkw[q].y, rkw[q].z, rkw[q].w};
                const float aaa[4] = {a4v[q].x, a4v[q].y, a4v[q].z, a4v[q].w}, lwa[4] = {l4v[q].x, l4v[q].y, l4v[q].z, l4v[q].w};
#pragma unroll
                for (int e = 0; e < 4; ++e) { const int i = 4 * q + e;
                    rr[i] = r0a[e] + (rpa[e] - r0a[e]) * mra[e]; const float kx = k0a[e] + (kpa[e] - k0a[e]) * mka[e]; vv[i] = v0a[e] + (vpa[e] - v0a[e]) * mva[e];
                    kkv[i] = kx * kka[e]; ss += kkv[i] * kkv[i]; aa[i] = aaa[e]; lwl[i] = lwa[e]; kf[i] = kx * (1.f + (aaa[e] - 1.f) * kaa[e]); scs += rr[i] * kf[i] * rka[e]; }
            }
        }
        {
            ss += __shfl_xor(ss, 1); ss += __shfl_xor(ss, 2); scs += __shfl_xor(scs, 1); scs += __shfl_xor(scs, 2);
            const float rn = rsqrtf(ss + 1e-6f);
            if (seg == 0) SC[(size_t)t * 16 + h] = scs;
            const int tq = r >> 4;
            unsigned wat[8], wbt[8], wkt[8], wrt[8], wvp[8];
            float atv[16], btv[16], ktv[16], rtv[16];
#pragma unroll
            for (int i = 0; i < 16; ++i) {
                const int ch = c0 + i;
                float off = 0.f;
#pragma unroll
                for (int q = 0; q < 3; ++q) off += (q < tq) ? TOT[q * 64 + ch] : 0.f;
                const float tot = TOT[ch] + TOT[64 + ch] + TOT[128 + ch] + TOT[192 + ch];
                const float cs = AAB[r * 64 + ch] + off;
                const float lwv = lwl[i];
                const float kk = kkv[i] * rn;
                const float e2 = __expf(-cs), e4 = __expf(tot - cs);
                atv[i] = kk * __expf(cs - lwv); btv[i] = -kk * aa[i] * e2; ktv[i] = kf[i] * e2; rtv[i] = rr[i] * __expf(cs);
                VT[ch * 72 + r] = f2bf(vv[i]);
                KDT[ch * 72 + r] = f2bf(kf[i] * e4);
                RA4[(size_t)item * 64 * 64 + frag_off(ch, r, 2)] = f2bf(-kk * aa[i] * e4);
                if (r == 63) RDSC[(size_t)item * 64 + ch] = __expf(tot);
            }
#pragma unroll
            for (int q = 0; q < 8; ++q) { wat[q] = pk2(atv[2 * q], atv[2 * q + 1]); wbt[q] = pk2(btv[2 * q], btv[2 * q + 1]); wkt[q] = pk2(ktv[2 * q], ktv[2 * q + 1]); wrt[q] = pk2(rtv[2 * q], rtv[2 * q + 1]); wvp[q] = pk2(vv[2 * q], vv[2 * q + 1]); }
            *(uint4*)(AT + r * 72 + c0) = make_uint4(wat[0], wat[1], wat[2], wat[3]); *(uint4*)(AT + r * 72 + c0 + 8) = make_uint4(wat[4], wat[5], wat[6], wat[7]);
            *(uint4*)(BTL + r * 72 + c0) = make_uint4(wbt[0], wbt[1], wbt[2], wbt[3]); *(uint4*)(BTL + r * 72 + c0 + 8) = make_uint4(wbt[4], wbt[5], wbt[6], wbt[7]);
            *(uint4*)(KT + r * 72 + c0) = make_uint4(wkt[0], wkt[1], wkt[2], wkt[3]); *(uint4*)(KT + r * 72 + c0 + 8) = make_uint4(wkt[4], wkt[5], wkt[6], wkt[7]);
            *(uint4*)(RT + r * 72 + c0) = make_uint4(wrt[0], wrt[1], wrt[2], wrt[3]); *(uint4*)(RT + r * 72 + c0 + 8) = make_uint4(wrt[4], wrt[5], wrt[6], wrt[7]);
            bf16* a2p = RA2 + (size_t)item * 64 * 64;
            *(uint4*)(a2p + frag_off(r, c0, 2)) = make_uint4(wrt[0], wrt[1], wrt[2], wrt[3]); *(uint4*)(a2p + frag_off(r, c0 + 8, 2)) = make_uint4(wrt[4], wrt[5], wrt[6], wrt[7]);
            bf16* vpp = VP + (size_t)t * 1024 + h * 64 + c0;
            *(uint4*)vpp = make_uint4(wvp[0], wvp[1], wvp[2], wvp[3]); *(uint4*)(vpp + 8) = make_uint4(wvp[4], wvp[5], wvp[6], wvp[7]);
        }
        __syncthreads();
        const int fr = lane & 15, fq = lane >> 4;
        f32x4_t cab[4], cak[4], crb[4], crk[4];
        {
            const int j0t = w4 * 16;
            bf16x8_t bj[2], kj[2];
#pragma unroll
            for (int kb = 0; kb < 2; ++kb) { bj[kb] = *(const bf16x8_t*)(BTL + (j0t + fr) * 72 + kb * 32 + fq * 8); kj[kb] = *(const bf16x8_t*)(KT + (j0t + fr) * 72 + kb * 32 + fq * 8); }
#pragma unroll
            for (int it = 0; it < 4; ++it) {
                cab[it] = (f32x4_t){0.f, 0.f, 0.f, 0.f}; cak[it] = cab[it]; crb[it] = cab[it]; crk[it] = cab[it];
#pragma unroll
                for (int kb = 0; kb < 2; ++kb) {
                    const bf16x8_t ai = *(const bf16x8_t*)(AT + (it * 16 + fr) * 72 + kb * 32 + fq * 8);
                    const bf16x8_t ri = *(const bf16x8_t*)(RT + (it * 16 + fr) * 72 + kb * 32 + fq * 8);
                    cab[it] = MFMA16(bj[kb], ai, cab[it]); cak[it] = MFMA16(kj[kb], ai, cak[it]); crb[it] = MFMA16(bj[kb], ri, crb[it]); crk[it] = MFMA16(kj[kb], ri, crk[it]);
                }
            }
        }
        __syncthreads();
        {
            const int j0 = w4 * 16 + 4 * fq;
#pragma unroll
            for (int it = 0; it < 4; ++it) {
                const int i = it * 16 + fr;
                float vab[4], vak[4], vrb[4], vrk[4];
#pragma unroll
                for (int rg = 0; rg < 4; ++rg) { const int j = j0 + rg; const bool st = i > j, in = i >= j;
                    vab[rg] = st ? cab[it][rg] : 0.f; vak[rg] = st ? cak[it][rg] : 0.f; vrb[rg] = in ? crb[it][rg] : 0.f; vrk[rg] = in ? crk[it][rg] : 0.f; }
                *(float4*)(AAB + i * 64 + j0) = make_float4(vab[0], vab[1], vab[2], vab[3]);
                uint2 w; w.x = pk2(vak[0], vak[1]); w.y = pk2(vak[2], vak[3]); *(uint2*)(AAK + i * 72 + j0) = w;
                w.x = pk2(vrk[0], vrk[1]); w.y = pk2(vrk[2], vrk[3]); *(uint2*)(ARK + i * 72 + j0) = w;
                w.x = pk2(vrb[0], vrb[1]); w.y = pk2(vrb[2], vrb[3]); *(uint2*)(RA3 + (size_t)item * 64 * 64 + frag_off(i, j0, 2)) = w;
            }
        }
        __syncthreads();
        f32x4_t cav[4], cov[4], ckv[4];
        {
            const int r0t = w4 * 16;
            bf16x8_t fa[2], fo[2], fk[2];
#pragma unroll
            for (int kb = 0; kb < 2; ++kb) { fa[kb] = *(const bf16x8_t*)(AAK + (r0t + fr) * 72 + kb * 32 + fq * 8); fo[kb] = *(const bf16x8_t*)(ARK + (r0t + fr) * 72 + kb * 32 + fq * 8); fk[kb] = *(const bf16x8_t*)(KDT + (r0t + fr) * 72 + kb * 32 + fq * 8); }
#pragma unroll
            for (int vt = 0; vt < 4; ++vt) {
                cav[vt] = (f32x4_t){0.f, 0.f, 0.f, 0.f}; cov[vt] = cav[vt]; ckv[vt] = cav[vt];
#pragma unroll
                for (int kb = 0; kb < 2; ++kb) { const bf16x8_t vb = *(const bf16x8_t*)(VT + (vt * 16 + fr) * 72 + kb * 32 + fq * 8);
                    cav[vt] = MFMA16(fa[kb], vb, cav[vt]); cov[vt] = MFMA16(fo[kb], vb, cov[vt]); ckv[vt] = MFMA16(fk[kb], vb, ckv[vt]); }
            }
        }
        __syncthreads();
        {
            const int r0 = w4 * 16 + 4 * fq;
#pragma unroll
            for (int vt = 0; vt < 4; ++vt) {
                const int v = vt * 16 + fr;
#pragma unroll
                for (int rg = 0; rg < 4; ++rg) RHS2[v * 65 + r0 + rg] = cav[vt][rg];
                { uint2 w; w.x = pk2(cov[vt][0], cov[vt][1]); w.y = pk2(cov[vt][2], cov[vt][3]); *(uint2*)(RO0 + (size_t)item * 64 * 64 + cfrag_off(v, r0, 4)) = w; }
                { uint2 w; w.x = pk2(ckv[vt][0], ckv[vt][1]); w.y = pk2(ckv[vt][2], ckv[vt][3]); *(uint2*)(RS0 + (size_t)item * 64 * 64 + cfrag_off(v, r0, 4)) = w; }
            }
        }
        __syncthreads();
        {
            const int col = ht >> 1, p = ht & 1, cc = col & 63; const bool isu = col >= 64;
            float xs[32];
#pragma unroll
            for (int i = 0; i < 32; ++i) xs[i] = 0.f;
            float4 mc[8], mn[8];
#pragma unroll
            for (int q = 0; q < 8; ++q) { mc[q] = make_float4(0.f, 0.f, 0.f, 0.f); mn[q] = mc[q]; }
            float rhs_n; { const float rv = RHS2[(isu ? cc : 0) * 65], av = bf2f(AT[(isu ? 0 : cc)]); rhs_n = isu ? rv : av; }
#pragma unroll
            for (int i = 0; i < 64; ++i) {
                const float rhs = rhs_n;
                if (i + 1 < 64) {
#pragma unroll
                    for (int q = 0; q < (i + 8) / 8; ++q) mn[q] = *(const float4*)(AAB + (i + 1) * 64 + 8 * q + 4 * p);
                    const float rv = RHS2[(isu ? cc : 0) * 65 + i + 1], av = bf2f(AT[(i + 1) * 72 + (isu ? 0 : cc)]); rhs_n = isu ? rv : av;
                }
                float a0 = 0.f, a1 = 0.f, a2 = 0.f, a3 = 0.f;
#pragma unroll
                for (int q = 0; q < (i + 7) / 8; ++q) { a0 += mc[q].x * xs[4 * q]; a1 += mc[q].y * xs[4 * q + 1]; a2 += mc[q].z * xs[4 * q + 2]; a3 += mc[q].w * xs[4 * q + 3]; }
                float tot = (a0 + a1) + (a2 + a3);
                tot += dpp_xor1(tot);
                const float xi = rhs + tot;
                const int g = i >> 2, slot = (g >> 1) * 4 + (i & 3);
                xs[slot] = (p == (g & 1)) ? xi : xs[slot];
#pragma unroll
                for (int q = 0; q < 8; ++q) mc[q] = mn[q];
                asm volatile("" ::: "memory");
            }
            if (isu) {
                bf16* up = RX0 + (size_t)item * 64 * 64;
#pragma unroll
                for (int q = 0; q < 8; ++q) { uint2 w; w.x = pk2(xs[4 * q], xs[4 * q + 1]); w.y = pk2(xs[4 * q + 2], xs[4 * q + 3]); *(uint2*)(up + cfrag_off(cc, 4 * (2 * q + p), 4)) = w; }
            }
            __syncthreads();
            if (!isu) {
#pragma unroll
                for (int q = 0; q < 8; ++q)
#pragma unroll
                    for (int e = 0; e < 4; ++e) AT[(4 * (2 * q + p) + e) * 72 + cc] = f2bf(xs[4 * q + e]);
            }
        }
        __syncthreads();
        {
            bf16* wp = RA1 + (size_t)item * 64 * 64;
#pragma unroll
            for (int q = 0; q < 2; ++q) { const int p = ht + 256 * q, fr = p & 15, fq = (p >> 4) & 3, kb = (p >> 6) & 1, rt = p >> 7;
                *(uint4*)(wp + p * 8) = *(const uint4*)(AT + (rt * 16 + fr) * 72 + kb * 32 + fq * 8); }
        }
    }
}

template <int DK, bool RW>
struct ScanArgs { const bf16* A1; const bf16* X0; const bf16* A2; const bf16* A3; const bf16* O0; const bf16* A4; const bf16* S0; const float* DSC; float* OUT; int item0; int vs; int tok0; int ocol0; };
#define LBAR() do { asm volatile("s_waitcnt lgkmcnt(0)" ::: "memory"); __builtin_amdgcn_s_barrier(); asm volatile("" ::: "memory"); } while (0)
template <int DK, bool RW>
__device__ __forceinline__ void scan_run(const Ctx& c, const ScanArgs<DK, RW>& a) {
    constexpr int KB = DK / 32;
    constexpr int NST = DK / 64;
    constexpr int NV = RW ? 64 : 128;
    constexpr int SROW = DK + 8;
    bf16* ST = (bf16*)c.lds;
    bf16* XT = ST + 2 * 32 * SROW;
    const int lane = c.lane, w = c.wave, fr = lane & 15, fq = lane >> 4;
    const int tm = w >> 1, tn = w & 1;
    const int dkt = (NST == 2) ? w : (w >> 1);
    for (int i = c.tid; i < 32 * SROW / 2; i += NTHREADS) ((unsigned*)ST)[i] = 0u;
    f32x4_t accS[NST];
#pragma unroll
    for (int s = 0; s < NST; ++s) accS[s] = (f32x4_t){0.f, 0.f, 0.f, 0.f};
    bf16x8_t a1f[KB], a2f[KB], a3f[2], a4f[2]; f32x4_t x0v, o0v, s0v[NST], dscv;
#define SCAN_LOAD(IT) do { const size_t it_ = (size_t)(IT); \
        _Pragma("unroll") for (int kb = 0; kb < KB; ++kb) { a1f[kb] = *(const bf16x8_t*)(a.A1 + it_ * 64 * DK + ((tm * KB + kb) * 64 + lane) * 8); a2f[kb] = *(const bf16x8_t*)(a.A2 + it_ * 64 * DK + ((tm * KB + kb) * 64 + lane) * 8); } \
        _Pragma("unroll") for (int kb = 0; kb < 2; ++kb) { a3f[kb] = *(const bf16x8_t*)(a.A3 + it_ * 64 * 64 + ((tm * 2 + kb) * 64 + lane) * 8); a4f[kb] = *(const bf16x8_t*)(a.A4 + it_ * DK * 64 + ((dkt * 2 + kb) * 64 + lane) * 8); } \
        { const uint2 q_ = *(const uint2*)(a.X0 + it_ * NV * 64 + (((a.vs * 2 + tn) * 4 + tm) * 64 + lane) * 4); x0v = (f32x4_t){bflo(q_.x), bfhi(q_.x), bflo(q_.y), bfhi(q_.y)}; } \
        if (RW) { { const uint2 q_ = *(const uint2*)(a.O0 + it_ * NV * 64 + (((a.vs * 2 + tn) * 4 + tm) * 64 + lane) * 4); o0v = (f32x4_t){bflo(q_.x), bfhi(q_.x), bflo(q_.y), bfhi(q_.y)}; } \
                  _Pragma("unroll") for (int s = 0; s < NST; ++s) { const uint2 q_ = *(const uint2*)(a.S0 + it_ * 64 * DK + (((a.vs * 2 + (NST == 2 ? s : tn)) * (DK / 16) + dkt) * 64 + lane) * 4); s0v[s] = (f32x4_t){bflo(q_.x), bfhi(q_.x), bflo(q_.y), bfhi(q_.y)}; } \
                  dscv = *(const f32x4_t*)(a.DSC + it_ * DK + dkt * 16 + 4 * fq); } \
        else { const float g_ = a.DSC[it_]; dscv = (f32x4_t){g_, g_, g_, g_}; o0v = (f32x4_t){0.f, 0.f, 0.f, 0.f}; _Pragma("unroll") for (int s = 0; s < NST; ++s) s0v[s] = (f32x4_t){0.f, 0.f, 0.f, 0.f}; } \
    } while (0)
    SCAN_LOAD(a.item0);
    int cur = 0;
    for (int n = 0; n < 64; ++n) {
        bf16x8_t b1[KB], b2[KB], b3[2], b4[2];
#pragma unroll
        for (int kb = 0; kb < KB; ++kb) { b1[kb] = a1f[kb]; b2[kb] = a2f[kb]; }
        b3[0] = a3f[0]; b3[1] = a3f[1]; b4[0] = a4f[0]; b4[1] = a4f[1];
        f32x4_t accX = x0v, accO = o0v; const f32x4_t dv = dscv; f32x4_t sv[NST];
#pragma unroll
        for (int s = 0; s < NST; ++s) sv[s] = s0v[s];
        if (n + 1 < 64) SCAN_LOAD(a.item0 + n + 1);
        LBAR();
        const bf16* Sc = ST + cur * 32 * SROW; bf16* Sn = ST + (cur ^ 1) * 32 * SROW;
        bf16x8_t sf[KB];
#pragma unroll
        for (int kb = 0; kb < KB; ++kb) sf[kb] = *(const bf16x8_t*)(Sc + (tn * 16 + fr) * SROW + kb * 32 + fq * 8);
#pragma unroll
        for (int kb = 0; kb < KB; ++kb) accX = MFMA16(b1[kb], sf[kb], accX);
        { uint2 wv; wv.x = pk2(accX[0], accX[1]); wv.y = pk2(accX[2], accX[3]); *(uint2*)(XT + (tn * 16 + fr) * 72 + tm * 16 + 4 * fq) = wv; }
#pragma unroll
        for (int kb = 0; kb < KB; ++kb) accO = MFMA16(b2[kb], sf[kb], accO);
        LBAR();
        bf16x8_t xf[2];
#pragma unroll
        for (int kb = 0; kb < 2; ++kb) xf[kb] = *(const bf16x8_t*)(XT + (tn * 16 + fr) * 72 + kb * 32 + fq * 8);
        accO = MFMA16(b3[0], xf[0], accO); accO = MFMA16(b3[1], xf[1], accO);
        {
            float* op = a.OUT + (size_t)(a.tok0 + n * 64 + tm * 16 + 4 * fq) * 1024 + a.ocol0 + tn * 16 + fr;
            op[0] = accO[0]; op[1024] = accO[1]; op[2048] = accO[2]; op[3072] = accO[3];
        }
#pragma unroll
        for (int s = 0; s < NST; ++s) {
            const int vt = (NST == 2) ? s : tn;
            bf16x8_t xg[2];
            if (vt == tn) { xg[0] = xf[0]; xg[1] = xf[1]; }
            else {
#pragma unroll
                for (int kb = 0; kb < 2; ++kb) xg[kb] = *(const bf16x8_t*)(XT + (vt * 16 + fr) * 72 + kb * 32 + fq * 8);
            }
            f32x4_t t = accS[s] * dv + sv[s];
            t = MFMA16(b4[0], xg[0], t); t = MFMA16(b4[1], xg[1], t);
            accS[s] = t;
            uint2 wv; wv.x = pk2(t[0], t[1]); wv.y = pk2(t[2], t[3]);
            *(uint2*)(Sn + (vt * 16 + fr) * SROW + dkt * 16 + 4 * fq) = wv;
        }
        cur ^= 1;
    }
#undef SCAN_LOAD
    __syncthreads();
}

__device__ __forceinline__ void ph_scan(const Ctx& c) {
    for (int wk = blockIdx.x; wk < 256; wk += gridDim.x) {
        const int xcd = wk & 7, j = wk >> 3;
        if (j < 16) {
            const int pair = xcd * 4 + (j >> 2), vs = j & 3, b = pair >> 3, h = pair & 7;
            ScanArgs<128, false> a{c.ws<bf16>(WS_GA1), c.ws<bf16>(WS_GX0), c.ws<bf16>(WS_GA2), c.ws<bf16>(WS_GA3), nullptr, c.ws<bf16>(WS_GA4), nullptr, c.ws<float>(WS_GGL),
                                   c.ws<float>(WS_OG), pair * 64, vs, b * SEQ, h * 128 + vs * 32};
            scan_run<128, false>(c, a);
        } else {
            const int pair = xcd * 8 + ((j - 16) >> 1), vs = (j - 16) & 1, b = pair >> 4, h = pair & 15;
            ScanArgs<64, true> a{c.ws<bf16>(WS_RA1), c.ws<bf16>(WS_RX0), c.ws<bf16>(WS_RA2), c.ws<bf16>(WS_RA3), c.ws<bf16>(WS_RO0), c.ws<bf16>(WS_RA4), c.ws<bf16>(WS_RS0), c.ws<float>(WS_RDSC),
                                 c.ws<float>(WS_ORW), pair * 64, vs, b * SEQ, h * 64 + vs * 32};
            scan_run<64, true>(c, a);
        }
    }
}

enum { PH_RMS0 = 0, PH_INPROJ, PH_GCL, PH_LORA, PH_RCL, PH_SCAN, PH_POST, PH_G2, PH_X1, PH_ROUTER, PH_DISPATCH, PH_MOE1, PH_MOE2, PH_COMBINE, PH_COUNT };

template <unsigned PHMASK>
__global__ void __launch_bounds__(NTHREADS) mk(Params P) {
    extern __shared__ __attribute__((aligned(16))) unsigned char lds[];
    volatile LAS unsigned* misc = (volatile LAS unsigned*)((LAS unsigned char*)lds + MISC_OFF);
    if (threadIdx.x < 64) misc[threadIdx.x] = 0u;
    __syncthreads();
    unsigned* ctl = (unsigned*)(P.ws + WS_CTL);
    XcdBarrier bar = xcd_barrier_post(ctl + CW_BAR + P.li * XCD_BAR_WORDS, misc);
#define MKCTX() int tv_ = threadIdx.x; asm volatile("" : "+v"(tv_)); const int wv_ = __builtin_amdgcn_readfirstlane(tv_ >> 6); \
    Ctx c{P, tv_, tv_ & 63, wv_, (int)(blockIdx.x * NWAVES + wv_), (int)(gridDim.x * NWAVES), (size_t)blockIdx.x * NTHREADS + tv_, (size_t)gridDim.x * NTHREADS, lds}
    bool first_seam = true;
#define IN(k) (((PHMASK >> (k)) & 1u) && P.ph_lo <= (k) && (k) < P.ph_hi)
#define SEAM(k) do { if ((k) + 1 < P.ph_hi) { xcd_barrier(bar); first_seam = false; } } while (0)
#define REP(k) for (int rep_ = 0; rep_ < ((k) == PROBE_REP ? 2 : 1); ++rep_)
    if (IN(PH_RMS0)) { MKCTX();
        REP(PH_RMS0) {
        ph_rms0(c);
        { WJob j{P.in[I_W_IN], NCOL_IN, 1024, 4096, c.ws<bf16>(WS_WIN_T), 1024, 1, 0, 0}; wconv_job(c, j); }
        { WJob j{P.in[I_W_IN] + 4112, NCOL_IN, 1024, 5376, c.ws<bf16>(WS_WIN_T) + (size_t)4096 * 1024, 1024, 1, 0, 0}; wconv_job(c, j); }
        lora_zero(c);
        { WJob j{P.in[I_W2], 1024, 64, 1024, c.ws<bf16>(WS_LORA_T), 256, 1, 0, 0}; wconv_job(c, j); }
        { WJob j{P.in[I_A2], 1024, 64, 1024, c.ws<bf16>(WS_LORA_T) + (size_t)1024 * 256 + 64, 256, 1, 0, 0}; wconv_job(c, j); }
        { WJob j{P.in[I_G2], 1024, 128, 1024, c.ws<bf16>(WS_LORA_T) + (size_t)2048 * 256 + 128, 256, 1, 0, 0}; wconv_job(c, j); }
        }
        SEAM(PH_RMS0);
    }
    if (IN(PH_INPROJ)) { MKCTX();
        REP(PH_INPROJ) {
        EpiInProj ep{c.ws<bf16>(WS_GQKV), c.ws<bf16>(WS_ZS), c.ws<bf16>(WS_RKV), c.ws<float>(WS_LIN), c.ws<bf16>(WS_GATES)};
        SchedInProj sc{(const char*)c.ws<bf16>(WS_HB), (const char*)c.ws<bf16>(WS_WIN_T), (int)gridDim.x, (int)blockIdx.x};
        pg8::gemm_phase((LAS unsigned char*)lds, 1024, sc, ep, c.tid);
        }
        SEAM(PH_INPROJ);
    }
    if (IN(PH_GCL)) { MKCTX(); REP(PH_GCL) { ph_gcl(c); ph_loraprep(c); } SEAM(PH_GCL); }
    if (IN(PH_LORA)) { MKCTX();
        REP(PH_LORA) {
        EpiLora ep{P.in[I_W0], P.in[I_A0], c.ws<float>(WS_LW), c.ws<float>(WS_AA), c.ws<bf16>(WS_GGR)};
        SchedLora sc{(const char*)c.ws<bf16>(WS_ALORA), (const char*)c.ws<bf16>(WS_LORA_T), (int)gridDim.x, (int)blockIdx.x};
        pg8::gemm_phase((LAS unsigned char*)lds, 256, sc, ep, c.tid);
        }
        SEAM(PH_LORA);
    }
    if (IN(PH_RCL)) { MKCTX(); REP(PH_RCL) { ph_rcl(c); } SEAM(PH_RCL); }
    if (IN(PH_SCAN)) { MKCTX(); REP(PH_SCAN) { ph_scan(c); } SEAM(PH_SCAN); }
    if (IN(PH_POST)) { MKCTX();
        REP(PH_POST) {
        ph_post(c);
        { WJob j{P.in[I_PROJ_A], 1024, 1024, 1024, c.ws<bf16>(WS_PROJ_T), 1024, 1, 0, 0}; wconv_job(c, j); }
        { WJob j{P.in[I_PROJ_B], 1024, 1024, 1024, c.ws<bf16>(WS_PROJ_T) + (size_t)1024 * 1024, 1024, 1, 0, 0}; wconv_job(c, j); }
        { WJob j{P.in[I_W_OUT], 1024, 1024, 1024, c.ws<bf16>(WS_WOUT_T), 1024, 1, 0, 0}; wconv_job(c, j); }
        }
        SEAM(PH_POST);
    }
    if (IN(PH_G2)) { MKCTX();
        REP(PH_G2) {
        EpiG2 ep{c.ws<bf16>(WS_GATES), c.ws<bf16>(WS_G2)};
        SchedG2 sc{(const char*)c.ws<bf16>(WS_YA), (const char*)c.ws<bf16>(WS_PROJ_T), (int)gridDim.x, (int)blockIdx.x};
        pg8::gemm_phase((LAS unsigned char*)lds, 1024, sc, ep, c.tid);
        }
        SEAM(PH_G2);
    }
    if (IN(PH_X1)) { MKCTX();
        REP(PH_X1) {
        EpiX1 ep{P.in[I_X], c.ws<float>(WS_X1)};
        SchedX1 sc{(const char*)c.ws<bf16>(WS_G2), (const char*)c.ws<bf16>(WS_WOUT_T), (int)gridDim.x, (int)blockIdx.x};
        pg8::gemm_phase((LAS unsigned char*)lds, 1024, sc, ep, c.tid);
        }
        SEAM(PH_X1);
    }
    if (IN(PH_ROUTER)) { MKCTX();
        ph_router(c);
        REP(PH_ROUTER) {
        { WJob j{P.in[I_W_GU], 2048, 1024, 2048, c.ws<bf16>(WS_WGU_T), 1024, 32, (size_t)1024 * 2048, (size_t)2048 * 1024}; wconv_job(c, j); }
        { WJob j{P.in[I_W_DOWN], 1024, 1024, 1024, c.ws<bf16>(WS_WDN_T), 1024, 32, (size_t)1024 * 1024, (size_t)1024 * 1024}; wconv_job(c, j); }
        }
        SEAM(PH_ROUTER);
    }
    if (IN(PH_DISPATCH)) { MKCTX(); REP(PH_DISPATCH) { ph_dispatch(c); } SEAM(PH_DISPATCH); }
    if (IN(PH_MOE1)) { MKCTX();
        REP(PH_MOE1) {
        const int nt = *c.ws<int>(WS_NT);
        EpiAct ep{P.in[I_B_GU], c.ws<bf16>(WS_ACT)};
        SchedMoe sc{(const char*)c.ws<bf16>(WS_H2), (const char*)c.ws<bf16>(WS_WGU_T), c.ws<int>(WS_TILE_E), c.ws<int>(WS_SLOT_TOK), nt, 8, (int)gridDim.x, (int)blockIdx.x};
        pg8::gemm_phase_t<true>((LAS unsigned char*)lds, 1024, sc, ep, c.tid);
        }
        SEAM(PH_MOE1);
    }
    if (IN(PH_MOE2)) { MKCTX();
        REP(PH_MOE2) {
        const int nt = *c.ws<int>(WS_NT);
        EpiYS ep{P.in[I_B_DOWN], c.ws<float>(WS_SGATE), c.ws<bf16>(WS_YS)};
        SchedMoe sc{(const char*)c.ws<bf16>(WS_ACT), (const char*)c.ws<bf16>(WS_WDN_T), c.ws<int>(WS_TILE_E), nullptr, nt, 4, (int)gridDim.x, (int)blockIdx.x};
        pg8::gemm_phase((LAS unsigned char*)lds, 1024, sc, ep, c.tid);
        }
        SEAM(PH_MOE2);
    }
    if (IN(PH_COMBINE)) { MKCTX(); REP(PH_COMBINE) { ph_combine(c); } }
#undef IN
#undef SEAM
#undef REP
#undef MKCTX
}

template <unsigned M> static void launch_one(const Params& p, int grid, hipStream_t stream) {
    static bool attr = false;
    if (!attr) { (void)hipFuncSetAttribute((const void*)mk<M>, hipFuncAttributeMaxDynamicSharedMemorySize, LDS_BYTES); attr = true; }
    hipLaunchKernelGGL(mk<M>, dim3(grid), dim3(NTHREADS), LDS_BYTES, stream, p);
}
template <int PH> static void launch_chain(Params& p, int grid, hipStream_t stream) {
    if constexpr (PH < PH_COUNT) { p.ph_lo = PH; p.ph_hi = PH + 1; p.li = 0; p.coop = 0; launch_one<(1u << PH)>(p, grid, stream); launch_chain<PH + 1>(p, grid, stream); }
}

extern "C" void kernel_launch(void* const* d_in, const int* in_sizes, int n_in, void* d_out, int out_size, void* d_ws, size_t ws_size, hipStream_t stream) {
    static int grid = 0;
    if (grid == 0) {
        int dev = 0, cus = 0, per_cu = 0;
        (void)hipGetDevice(&dev);
        (void)hipDeviceGetAttribute(&cus, hipDeviceAttributeMultiprocessorCount, dev);
#if MK_ONE_LAUNCH
        (void)hipFuncSetAttribute((const void*)mk<0xffffffffu>, hipFuncAttributeMaxDynamicSharedMemorySize, LDS_BYTES);
        (void)hipOccupancyMaxActiveBlocksPerMultiprocessor(&per_cu, (const void*)mk<0xffffffffu>, NTHREADS, LDS_BYTES);
#else
        per_cu = 1;
#endif
        if (n_in != 29 || ws_size < WS_END || per_cu < 1 || cus < 64) { fprintf(stderr, "kernel_launch: unexpected setup n_in %d ws %zu per_cu %d cus %d\n", n_in, ws_size, per_cu, cus); grid = -1; return; }
        grid = cus;
    }
    if (grid < 0) return;
    (void)hipMemsetAsync((char*)d_ws + WS_CTL, 0, CTL_BYTES, stream);
    Params p{};
    for (int i = 0; i < 29; ++i) p.in[i] = (const float*)d_in[i];
    p.out = (float*)d_out; p.ws = (unsigned char*)d_ws;
#if MK_ONE_LAUNCH
    p.ph_lo = 0; p.ph_hi = PH_COUNT; p.li = 0; p.coop = 1;
    void* args[] = {&p};
    hipError_t e = hipLaunchCooperativeKernel((const void*)mk<0xffffffffu>, dim3(grid), dim3(NTHREADS), args, LDS_BYTES, stream);
    if (e != hipSuccess) fprintf(stderr, "cooperative launch failed: %s (grid %d)\n", hipGetErrorString(e), grid);
#else
    launch_chain<0>(p, grid, stream);
#endif
}
```

```cpp
#include <hip/hip_runtime.h>
#include <hip/hip_cooperative_groups.h>
#include <cstdint>
#include <cstdio>
namespace cg = cooperative_groups;

#ifndef MK_ONE_LAUNCH
#define MK_ONE_LAUNCH 1
#endif

#define LAS __attribute__((address_space(3)))
#ifndef FAST_INPROJ
#define FAST_INPROJ 1
#endif
#ifndef FAST_MIX
#define FAST_MIX 1
#endif
#define PROBE_REP -1
constexpr int NTHREADS = 512;
constexpr int NWAVES = 8;
constexpr int LDS_BYTES = 155648;
constexpr int MISC_OFF = 153600;

constexpr int T = 16384, SEQ = 4096, D = 1024;
constexpr int NCOL_IN = 9488;
constexpr int NEXP = 32;
constexpr int MAXTILES = 288;
constexpr int MAXSLOTS = MAXTILES * 256;

enum { I_X = 0, I_NORM_MIX, I_W_IN, I_GDN_CONV, I_GDN_ALOG, I_GDN_DTB, I_GDN_NORM, I_MU, I_W0, I_W2, I_A0, I_A2, I_G2, I_KK, I_KA, I_RK,
       I_LNW, I_LNB, I_PROJ_A, I_PROJ_B, I_W_OUT, I_NORM_FFN, I_ROUTER_W, I_ROUTER_B, I_W_GU, I_B_GU, I_W_DOWN, I_B_DOWN, I_NORM_FINAL };

constexpr size_t MiB = 1u << 20;
constexpr size_t WS_CTL = 0, CTL_BYTES = 65536;
constexpr size_t WS_BETA = 1 * MiB;
constexpr size_t WS_GG = WS_BETA + 512 * 1024;
constexpr size_t WS_SC = 2 * MiB;
constexpr size_t WS_TE = 3 * MiB;
constexpr size_t WS_TG = WS_TE + 256 * 1024;
constexpr size_t WS_TP = WS_TG + 256 * 1024;
constexpr size_t WS_TSLOT = WS_TP + 256 * 1024;
constexpr size_t WS_SGATE = 4 * MiB;
constexpr size_t WS_SLOT_TOK = 4 * MiB + 512 * 1024;
constexpr size_t WS_TILE_E = 5 * MiB;
constexpr size_t WS_NT = WS_TILE_E + 4096;
constexpr size_t WS_HB = 8 * MiB;
constexpr size_t WS_H2 = WS_HB;
constexpr size_t WS_ZS = 40 * MiB;
constexpr size_t WS_GATES = 72 * MiB;
constexpr size_t WS_ALORA = 136 * MiB;
constexpr size_t WS_LW = 144 * MiB;
constexpr size_t WS_AA = 208 * MiB;
constexpr size_t WS_GGR = 272 * MiB;
constexpr size_t WS_VP = 304 * MiB;
constexpr size_t WS_Q = 336 * MiB;
constexpr size_t WS_QKVC = WS_Q;
constexpr size_t WS_RP = WS_Q, WS_KF = WS_Q + 64 * MiB, WS_KKN = WS_Q + 128 * MiB;
constexpr size_t WS_YA = WS_Q, WS_YB = WS_Q + 32 * MiB, WS_G2 = WS_Q + 64 * MiB, WS_X1 = WS_Q + 128 * MiB;
constexpr size_t WS_GQKV = 528 * MiB;
constexpr size_t WS_OG = 720 * MiB, WS_ORW = 784 * MiB;
constexpr size_t WS_RKV = 720 * MiB;
constexpr size_t WS_LIN = 912 * MiB;
constexpr size_t WS_DEC = 928 * MiB;
constexpr size_t WS_XB = 528 * MiB;
constexpr size_t WS_ACT = 672 * MiB;
constexpr size_t WS_YS = 816 * MiB;
constexpr size_t WS_WIN_T = 992 * MiB;
constexpr size_t WS_PROJ_T = 144 * MiB;
constexpr size_t WS_WOUT_T = 148 * MiB;
constexpr size_t WS_WGU_T = 72 * MiB;
constexpr size_t WS_WDN_T = 200 * MiB;
constexpr size_t WS_GA1 = 336 * MiB, WS_GX0 = 368 * MiB, WS_GA2 = 432 * MiB, WS_GA3 = 464 * MiB, WS_GA4 = 480 * MiB;
constexpr size_t WS_GGL = 6 * MiB;
constexpr size_t WS_RX0 = 528 * MiB, WS_RO0 = 592 * MiB, WS_RS0 = 656 * MiB;
constexpr size_t WS_RA1 = 8 * MiB, WS_RA2 = 928 * MiB, WS_RA3 = 960 * MiB, WS_RA4 = 992 * MiB;
constexpr size_t WS_RDSC = 7 * MiB;
constexpr size_t WS_LORA_T = 1012 * MiB;
constexpr size_t WS_END = 1024 * MiB;
constexpr int CW_BAR = 1024;
constexpr int CW_CNT = 256;

#define XB_TMO      128
#define XB_XCNT(j)  (256  + 64 * (j))
#define XB_XSUB(j)  (1280 + 64 * (j))
#define XB_XGEN(j)  (2304 + 64 * (j))
#define XB_TOP      3328
#define XB_TOPGEN   3392
#define XCD_BAR_WORDS 3456
#define XB_SPIN_CAP (1u << 24)
__device__ __forceinline__ unsigned xb_ld(unsigned* p)              { return __hip_atomic_load(p, __ATOMIC_RELAXED, __HIP_MEMORY_SCOPE_AGENT); }
__device__ __forceinline__ unsigned xb_add(unsigned* p, unsigned v) { return __hip_atomic_fetch_add(p, v, __ATOMIC_RELAXED, __HIP_MEMORY_SCOPE_AGENT); }
__device__ __forceinline__ unsigned xb_xcc_id() { return (unsigned)__builtin_amdgcn_s_getreg((3 << 11) | 20) & 0xFu; }
#define XB_SPIN(cond, bar) do { unsigned _sp = 0; while (cond) { __builtin_amdgcn_s_sleep(1); \
    if ((++_sp & 255u) == 0u) { if (xb_ld(&(bar)[XB_TMO])) break; if (_sp > XB_SPIN_CAP) { atomicAdd(&(bar)[XB_TMO], 1u); break; } } } } while (0)
struct XcdBarrier { unsigned* bar; unsigned x; volatile LAS unsigned* st; };
__device__ __forceinline__ XcdBarrier xcd_barrier_post(unsigned* bar, volatile LAS unsigned* st) {
    XcdBarrier b; b.bar = bar; b.x = xb_xcc_id(); b.st = st;
    if (threadIdx.x == 0) (void)xb_add(&bar[XB_XCNT(b.x)], 1u);
    return b;
}
__device__ __forceinline__ void xcd_barrier_complete(unsigned* bar, unsigned x, unsigned& nloc, unsigned& nx) {
    const unsigned G = gridDim.x * gridDim.y * gridDim.z;
    unsigned sum, cnt, mine, sp = 0u;
    for (;;) {
        sum = 0u; cnt = 0u; mine = 0u;
#pragma unroll
        for (unsigned j = 0; j < 16; ++j) { const unsigned c = xb_ld(&bar[XB_XCNT(j)]); sum += c; cnt += (c > 0u) ? 1u : 0u; mine = (j == x) ? c : mine; }
        if (sum == G) break;
        __builtin_amdgcn_s_sleep(1);
        if ((++sp & 255u) == 0u) { if (xb_ld(&bar[XB_TMO])) break; if (sp > XB_SPIN_CAP) { atomicAdd(&bar[XB_TMO], 1u); break; } }
    }
    nloc = mine > 0u ? mine : 1u; nx = cnt > 0u ? cnt : 1u;
}
__device__ __forceinline__ void xcd_barrier(const XcdBarrier& b) {
    asm volatile("s_waitcnt vmcnt(0)" ::: "memory");
    __syncthreads();
    if (threadIdx.x == 0) {
        unsigned* bar = b.bar;
        __builtin_amdgcn_s_waitcnt(0);
        unsigned nloc = b.st[0], nx = b.st[1];
        if (nloc == 0u) { xcd_barrier_complete(bar, b.x, nloc, nx); b.st[0] = nloc; b.st[1] = nx; }
        const unsigned old = xb_add(&bar[XB_XSUB(b.x)], 1u);
        const unsigned gen = old / nloc;
        if (old + 1u == (gen + 1u) * nloc) {
            __builtin_amdgcn_fence(__ATOMIC_RELEASE, "agent");
            asm volatile("s_waitcnt vmcnt(0)" ::: "memory");
            const unsigned og = xb_add(&bar[XB_TOP], 1u);
            const unsigned tg = og / nx;
            if (og + 1u == (tg + 1u) * nx) xb_add(&bar[XB_TOPGEN], 1u);
            else XB_SPIN(xb_ld(&bar[XB_TOPGEN]) == tg, bar);
            __builtin_amdgcn_fence(__ATOMIC_ACQUIRE, "agent");
            xb_add(&bar[XB_XGEN(b.x)], 1u);
            asm volatile("s_waitcnt vmcnt(0)" ::: "memory");
        } else {
            XB_SPIN(xb_ld(&bar[XB_XGEN(b.x)]) == gen, bar);
            __builtin_amdgcn_fence(__ATOMIC_ACQUIRE, "agent");
            asm volatile("s_waitcnt vmcnt(0)" ::: "memory");
        }
    }
    __syncthreads();
}

typedef unsigned short bf16;
__device__ __forceinline__ bf16 f2bf(float f) { unsigned u = __float_as_uint(f); u += 0x7fffu + ((u >> 16) & 1u); return (bf16)(u >> 16); }
__device__ __forceinline__ float bf2f(unsigned b) { return __uint_as_float(b << 16); }
__device__ __forceinline__ unsigned pk2(float lo, float hi) { return (unsigned)f2bf(lo) | ((unsigned)f2bf(hi) << 16); }
__device__ __forceinline__ float bflo(unsigned w) { return __uint_as_float(w << 16); }
__device__ __forceinline__ float bfhi(unsigned w) { return __uint_as_float(w & 0xffff0000u); }
__device__ __forceinline__ float sigm(float x) { return 1.f / (1.f + expf(-x)); }
__device__ __forceinline__ float fsigm(float x) { return __builtin_amdgcn_rcpf(1.f + __expf(-x)); }
__device__ __forceinline__ float softplusf(float x) { return x > 20.f ? x : log1pf(expf(x)); }
__device__ __forceinline__ float dpp_xor1(float v) { return __int_as_float(__builtin_amdgcn_update_dpp(0, __float_as_int(v), 0xB1, 0xF, 0xF, false)); }
__device__ __forceinline__ float wsum(float v) {
#pragma unroll
    for (int o = 32; o > 0; o >>= 1) v += __shfl_xor(v, o);
    return v;
}

struct Params { const float* in[29]; float* out; unsigned char* ws; int ph_lo, ph_hi, li, coop; };

struct Ctx {
    const Params& P; int tid, lane, wave, gwave, nwaves; size_t gtid, nthreads; unsigned char* lds;
    template <class Tp> __device__ __forceinline__ Tp* ws(size_t off) const { return (Tp*)(P.ws + off); }
};

__device__ __forceinline__ void ph_rms0(const Ctx& c) {
    const float* x = c.P.in[I_X]; const float* nw = c.P.in[I_NORM_MIX]; const float* win = c.P.in[I_W_IN];
    const float* alog = c.P.in[I_GDN_ALOG]; const float* dtb = c.P.in[I_GDN_DTB];
    bf16* HB = c.ws<bf16>(WS_HB); float* BETA = c.ws<float>(WS_BETA); float* GGv = c.ws<float>(WS_GG);
    if (blockIdx.x == 0 && c.tid < NEXP) c.ws<unsigned>(WS_CTL)[CW_CNT + c.tid] = 0u;
    float4* tab = (float4*)c.lds;
    __syncthreads();
    for (int i = c.tid; i < 4096; i += NTHREADS) { const int k = i >> 2; tab[((k & 3) * 256 + (k >> 2)) * 5 + (i & 3)] = *(const float4*)(win + (size_t)k * NCOL_IN + 4096 + (i & 3) * 4); }
    __syncthreads();
    const int lane = c.lane;
    for (int t = c.gwave; t < T; t += c.nwaves) {
        float4 v[4]; float ss = 0.f;
#pragma unroll
        for (int i = 0; i < 4; ++i) { v[i] = ((const float4*)(x + (size_t)t * D))[lane + 64 * i]; ss += v[i].x * v[i].x + v[i].y * v[i].y + v[i].z * v[i].z + v[i].w * v[i].w; }
        ss = wsum(ss);
        const float rstd = rsqrtf(ss * (1.f / 1024.f) + 1e-6f);
        float acc[16];
#pragma unroll
        for (int j = 0; j < 16; ++j) acc[j] = 0.f;
#pragma unroll
        for (int i = 0; i < 4; ++i) {
            const float4 w4 = ((const float4*)nw)[lane + 64 * i];
            float h[4] = {v[i].x * rstd * w4.x, v[i].y * rstd * w4.y, v[i].z * rstd * w4.z, v[i].w * rstd * w4.w};
            uint2 st; st.x = pk2(h[0], h[1]); st.y = pk2(h[2], h[3]);
            *(uint2*)(HB + (size_t)t * D + 4 * (lane + 64 * i)) = st;
#pragma unroll
            for (int ii = 0; ii < 4; ++ii) {
                const int k = 4 * (lane + 64 * i) + ii;
#pragma unroll
                for (int q = 0; q < 4; ++q) { const float4 w = tab[(ii * 256 + (k >> 2)) * 5 + q]; acc[4 * q + 0] += h[ii] * w.x; acc[4 * q + 1] += h[ii] * w.y; acc[4 * q + 2] += h[ii] * w.z; acc[4 * q + 3] += h[ii] * w.w; }
                if (ii & 1) asm volatile("" ::: "memory");
            }
        }
        float mine = 0.f;
#pragma unroll
        for (int j = 0; j < 16; ++j) { const float s = wsum(acc[j]); mine = (lane == j) ? s : mine; }
        if (lane < 8) BETA[t * 8 + lane] = sigm(mine);
        else if (lane < 16) { const int h = lane - 8; GGv[t * 8 + h] = -expf(alog[h]) * softplusf(mine + dtb[h]); }
    }
    __syncthreads();
}

struct NoLd {};
struct EpiInProj {
    typedef NoLd Ld; static constexpr int MB = 1;
    bf16* GQKV; bf16* ZS; bf16* RKV; float* LIN; bf16* GATES;
    __device__ __forceinline__ void load(Ld&, int, int, int) const {}
    __device__ __forceinline__ void store8(int row, int col, const float (&v)[8], int, const Ld&) const {
        if (col < 3072) { uint4 w; w.x = pk2(v[0], v[1]); w.y = pk2(v[2], v[3]); w.z = pk2(v[4], v[5]); w.w = pk2(v[6], v[7]); *(uint4*)(GQKV + (size_t)row * 3072 + col) = w; }
        else if (col < 4096) { uint4 w; w.x = pk2(v[0] * fsigm(v[0]), v[1] * fsigm(v[1])); w.y = pk2(v[2] * fsigm(v[2]), v[3] * fsigm(v[3])); w.z = pk2(v[4] * fsigm(v[4]), v[5] * fsigm(v[5])); w.w = pk2(v[6] * fsigm(v[6]), v[7] * fsigm(v[7]));
            *(uint4*)(ZS + (size_t)row * 1024 + (col - 3072)) = w; }
        else if (col < 7168) { uint4 w; w.x = pk2(v[0], v[1]); w.y = pk2(v[2], v[3]); w.z = pk2(v[4], v[5]); w.w = pk2(v[6], v[7]); *(uint4*)(RKV + (size_t)row * 3072 + (col - 4096)) = w; }
        else if (col < 7424) { float* p = LIN + (size_t)row * 256 + (col - 7168); *(float4*)p = make_float4(v[0], v[1], v[2], v[3]); *(float4*)(p + 4) = make_float4(v[4], v[5], v[6], v[7]); }
        else { uint4 w; w.x = pk2(fsigm(v[0]), fsigm(v[1])); w.y = pk2(fsigm(v[2]), fsigm(v[3])); w.z = pk2(fsigm(v[4]), fsigm(v[5])); w.w = pk2(fsigm(v[6]), fsigm(v[7]));
            *(uint4*)(GATES + (size_t)row * 2048 + (col - 7424)) = w; }
    }
};
struct EpiG2 {
    struct Ld { uint4 g; uint4 p; }; static constexpr int MB = 1;
    const bf16* GATES; bf16* MG;
    __device__ __forceinline__ void load(Ld& l, int row, int col, int) const { l.g = *(const uint4*)(GATES + (size_t)row * 2048 + col); const uint4 q = *(const uint4*)(MG + (size_t)row * 1024 + (col & 1023)); const bool b = col >= 1024; l.p = make_uint4(b ? q.x : 0u, b ? q.y : 0u, b ? q.z : 0u, b ? q.w : 0u); }
    __device__ __forceinline__ void store8(int row, int col, const float (&v)[8], int, const Ld& l) const {
        const uint4 g = l.g, p = l.p;
        uint4 w; w.x = pk2(v[0] * bflo(g.x) + bflo(p.x), v[1] * bfhi(g.x) + bfhi(p.x)); w.y = pk2(v[2] * bflo(g.y) + bflo(p.y), v[3] * bfhi(g.y) + bfhi(p.y));
        w.z = pk2(v[4] * bflo(g.z) + bflo(p.z), v[5] * bfhi(g.z) + bfhi(p.z)); w.w = pk2(v[6] * bflo(g.w) + bflo(p.w), v[7] * bfhi(g.w) + bfhi(p.w));
        *(uint4*)(MG + (size_t)row * 1024 + (col & 1023)) = w;
    }
};
struct EpiX1 {
    struct Ld { float4 a, b; }; static constexpr int MB = 2;
    const float* X; float* X1;
    __device__ __forceinline__ void load(Ld& l, int row, int col, int) const { const float* xp = X + (size_t)row * 1024 + col; l.a = *(const float4*)xp; l.b = *(const float4*)(xp + 4); }
    __device__ __forceinline__ void store8(int row, int col, const float (&v)[8], int, const Ld& l) const {
        float* op = X1 + (size_t)row * 1024 + col;
        const float4 a = l.a, b = l.b;
        *(float4*)op = make_float4(a.x + v[0], a.y + v[1], a.z + v[2], a.w + v[3]); *(float4*)(op + 4) = make_float4(b.x + v[4], b.y + v[5], b.z + v[6], b.w + v[7]);
    }
};
struct EpiAct {
    struct Ld { float4 b0, b1; }; static constexpr int MB = 4;
    const float* BGU; bf16* ACT;
    __device__ __forceinline__ void load(Ld& l, int, int col, int e) const { const float* bp = BGU + (size_t)e * 2048 + col; l.b0 = *(const float4*)bp; l.b1 = *(const float4*)(bp + 4); }
    __device__ __forceinline__ void store8(int row, int col, const float (&v)[8], int e, const Ld& l) const {
        const float4 b0 = l.b0, b1 = l.b1;
        const float bb[8] = {b0.x, b0.y, b0.z, b0.w, b1.x, b1.y, b1.z, b1.w};
        float o[4];
#pragma unroll
        for (int p = 0; p < 4; ++p) { float glu = v[2 * p] + bb[2 * p], lin = v[2 * p + 1] + bb[2 * p + 1]; glu = fminf(glu, 7.f); lin = fminf(fmaxf(lin, -7.f), 7.f); o[p] = glu * fsigm(1.702f * glu) * (lin + 1.f); }
        uint2 w; w.x = pk2(o[0], o[1]); w.y = pk2(o[2], o[3]);
        *(uint2*)(ACT + (size_t)row * 1024 + (col >> 1)) = w;
    }
};
struct EpiYS {
    struct Ld { float4 b0, b1; float g; }; static constexpr int MB = 4;
    const float* BD; const float* SGATE; bf16* YS;
    __device__ __forceinline__ void load(Ld& l, int row, int col, int e) const { const float* bp = BD + (size_t)e * 1024 + col; l.g = SGATE[row]; l.b0 = *(const float4*)bp; l.b1 = *(const float4*)(bp + 4); }
    __device__ __forceinline__ void store8(int row, int col, const float (&v)[8], int e, const Ld& l) const {
        const float g = l.g; const float4 b0 = l.b0, b1 = l.b1;
        uint4 w; w.x = pk2((v[0] + b0.x) * g, (v[1] + b0.y) * g); w.y = pk2((v[2] + b0.z) * g, (v[3] + b0.w) * g); w.z = pk2((v[4] + b1.x) * g, (v[5] + b1.y) * g); w.w = pk2((v[6] + b1.z) * g, (v[7] + b1.w) * g);
        *(uint4*)(YS + (size_t)row * 1024 + col) = w;
    }
};


namespace pg8 {
typedef short bf16x8 __attribute__((ext_vector_type(8)));
typedef float f32x4 __attribute__((ext_vector_type(4)));
constexpr int BM = 256, BK = 64, HALF = 128, HTB = HALF * BK * 2, NXCD = 8, WGM = 8;
__host__ __device__ __forceinline__ int lds_byte(int r, int c) { const int st = (r >> 4) * 2 + (c >> 5), rr = r & 15, cc = c & 31, ob = rr * 64 + cc * 2; return st * 1024 + (ob ^ (((ob >> 9) & 1) << 5)); }
__host__ __device__ __forceinline__ void stage_rc(int b, int& R, int& C) { const int st = b / 1024, sb = b % 1024, swz = sb ^ (((sb >> 9) & 1) << 5); R = (st >> 1) * 16 + swz / 64; C = (st & 1) * 32 + (swz % 64) / 2; }
__host__ __device__ __forceinline__ int perm32(int rho) { const int n = rho >> 4, i = rho & 15; return 8 * (i >> 2) + 4 * n + (i & 3); }
struct Unit { const char* a; const char* b; const int* rowmap; int row0, col0, aux; };
__device__ __forceinline__ void tile_order(int L, int nM, int nN, int& pm, int& pn) {
    const int nwg = nM * nN; int wgid = L; { const int q = nwg / NXCD, r = nwg % NXCD, xcd = wgid % NXCD, off = wgid / NXCD; wgid = (xcd < r ? xcd * (q + 1) : r * (q + 1) + (xcd - r) * q) + off; }
    const int nig = WGM * nN, gid = wgid / nig, fm = gid * WGM, gsz = (nM - fm) < WGM ? (nM - fm) : WGM;
    pm = fm + ((wgid % nig) % gsz); pn = (wgid % nig) / gsz;
}
template <class Epi>
__device__ __forceinline__ void epi_apply(const Epi& E, const f32x4 (&acc)[2][2][4][2], const Unit& u, int wr, int wc, int fr, int fq) {
    constexpr int MB = Epi::MB;
#pragma unroll
    for (int ai = 0; ai < 2; ++ai)
#pragma unroll
        for (int mp = 0; mp < 4 / MB; ++mp) {
            typename Epi::Ld ld[MB][2];
#pragma unroll
            for (int mm = 0; mm < MB; ++mm)
#pragma unroll
                for (int bj = 0; bj < 2; ++bj) E.load(ld[mm][bj], u.row0 + ai * HALF + wr * 64 + (mp * MB + mm) * 16 + fr, u.col0 + bj * HALF + wc * 32 + 8 * fq, u.aux);
#pragma unroll
            for (int mm = 0; mm < MB; ++mm)
#pragma unroll
                for (int bj = 0; bj < 2; ++bj) {
                    const int m = mp * MB + mm;
                    const f32x4 x0 = acc[ai][bj][m][0], x1 = acc[ai][bj][m][1];
                    const float v[8] = {x0[0], x0[1], x0[2], x0[3], x1[0], x1[1], x1[2], x1[3]};
                    E.store8(u.row0 + ai * HALF + wr * 64 + m * 16 + fr, u.col0 + bj * HALF + wc * 32 + 8 * fq, v, u.aux, ld[mm][bj]);
                }
            asm volatile("" ::: "memory");
        }
}
template <bool GATHER, class Epi, class Sched>
__device__ __forceinline__ void gemm_phase_t(LAS unsigned char* lds, const int K_, const Sched& S, const Epi& E, const int tid) {
    int K = K_; asm volatile("" : "+s"(K));
    const int wid = __builtin_amdgcn_readfirstlane(tid >> 6), lane = tid & 63, wr = wid >> 2, wc = wid & 3, fr = lane & 15, fq = lane >> 4;
    const int nt = K / BK;
    unsigned voffA[2], voffB[2];
#pragma unroll
    for (int i = 0; i < 2; ++i) { int R, C; stage_rc(tid * 16 + i * 8192, R, C); const int Rb = (R & ~31) + perm32(R & 31);
        voffA[i] = (unsigned)(R * K + C) * 2u; voffB[i] = (unsigned)(Rb * K + C) * 2u; }
    const size_t kstep = (size_t)(BK * 2);
    const size_t hstep = (size_t)HALF * K * 2;
    const unsigned ldsw = (unsigned)wid * 1024u;
    const int aoff = lds_byte(wr * 64 + fr, fq * 8), boff = lds_byte(wc * 32 + fr, fq * 8);
#define PG8_SA(b, h) (((b) * 2 + (h)) * HTB)
#define PG8_SB(b, h) ((4 + (b) * 2 + (h)) * HTB)
#define PG8_STAGE(bufoff, gbase, voff) do { _Pragma("unroll") for (int _i = 0; _i < 2; ++_i) \
        __builtin_amdgcn_global_load_lds((const unsigned*)((const char*)(gbase) + (voff)[_i]), (LAS unsigned*)(lds + (bufoff) + ldsw + _i * 8192), 16, 0, 0); } while (0)
#define PG8_LDA(dst, b, h) do { _Pragma("unroll") for (int m = 0; m < 4; ++m) _Pragma("unroll") for (int k = 0; k < 2; ++k) dst[m][k] = *(const LAS bf16x8*)(lds + PG8_SA(b, h) + aoff + m * 2048 + k * 1024); } while (0)
#define PG8_LDB(dst, b, h) do { _Pragma("unroll") for (int n = 0; n < 2; ++n) _Pragma("unroll") for (int k = 0; k < 2; ++k) dst[n][k] = *(const LAS bf16x8*)(lds + PG8_SB(b, h) + boff + n * 2048 + k * 1024); } while (0)
#define PG8_MMA(ai, bj, At, Bt) do { __builtin_amdgcn_s_setprio(1); _Pragma("unroll") for (int m = 0; m < 4; ++m) _Pragma("unroll") for (int n = 0; n < 2; ++n) _Pragma("unroll") for (int k = 0; k < 2; ++k) \
        acc[ai][bj][m][n] = __builtin_amdgcn_mfma_f32_16x16x32_bf16(Bt[n][k], At[m][k], acc[ai][bj][m][n], 0, 0, 0); __builtin_amdgcn_s_setprio(0); } while (0)
#define PG8_WAIT_V(n) asm volatile("s_waitcnt vmcnt(" #n ")" ::: "memory")
#define PG8_WAIT_L(n) asm volatile("s_waitcnt lgkmcnt(" #n ")" ::: "memory")
#define PG8_BAR __builtin_amdgcn_s_barrier()
#define PG8_SCHED __builtin_amdgcn_sched_barrier(0)
    Unit cur, nxt; int ui = 0;
    if (!S.next(0, cur)) return;
    f32x4 acc[2][2][4][2];
#pragma unroll
    for (int a = 0; a < 2; ++a)
#pragma unroll
        for (int b = 0; b < 2; ++b)
#pragma unroll
            for (int m = 0; m < 4; ++m)
#pragma unroll
                for (int n = 0; n < 2; ++n) acc[a][b][m][n] = (f32x4){0.f, 0.f, 0.f, 0.f};
    bf16x8 At[4][2], B0[2][2], B1[2][2];
    const char* cA = cur.a; const char* cB = cur.b;
    unsigned oc_lo[2] = {0u, 0u}, oc_hi[2] = {0u, 0u}, on_lo[2] = {0u, 0u}, on_hi[2] = {0u, 0u};
#define PG8_ROWOFF(U, LO, HI) do { _Pragma("unroll") for (int _i = 0; _i < 2; ++_i) { int R_, C_; stage_rc(tid * 16 + _i * 8192, R_, C_); \
        LO[_i] = (unsigned)((U).rowmap[R_] * K + C_) * 2u; HI[_i] = (unsigned)((U).rowmap[R_ + 128] * K + C_) * 2u; } } while (0)
    if constexpr (GATHER) PG8_ROWOFF(cur, oc_lo, oc_hi);
    PG8_STAGE(PG8_SB(0, 0), cB, voffB);
    if constexpr (GATHER) PG8_STAGE(PG8_SA(0, 0), cA, oc_lo); else PG8_STAGE(PG8_SA(0, 0), cA, voffA);
    PG8_STAGE(PG8_SB(0, 1), cB + hstep, voffB);
    if constexpr (GATHER) PG8_STAGE(PG8_SA(0, 1), cA, oc_hi); else PG8_STAGE(PG8_SA(0, 1), cA + hstep, voffA);
    if (wr == 1) PG8_BAR;
    PG8_WAIT_V(4); PG8_BAR;
    PG8_STAGE(PG8_SB(1, 0), cB + kstep, voffB);
    if constexpr (GATHER) PG8_STAGE(PG8_SA(1, 0), cA + kstep, oc_lo); else PG8_STAGE(PG8_SA(1, 0), cA + kstep, voffA);
    PG8_STAGE(PG8_SB(1, 1), cB + hstep + kstep, voffB);
    PG8_WAIT_V(6); PG8_BAR;
    for (;;) {
        const bool has_next = S.next(ui + 1, nxt);
        const char* nA = has_next ? nxt.a : cA; const char* nB = has_next ? nxt.b : cB;
        if constexpr (GATHER) { if (has_next) PG8_ROWOFF(nxt, on_lo, on_hi); else { on_lo[0] = oc_lo[0]; on_lo[1] = oc_lo[1]; on_hi[0] = oc_hi[0]; on_hi[1] = oc_hi[1]; } }
#pragma unroll 1
        for (int t = 0; t < nt; t += 2) {
            const bool last = (t == nt - 2);
            const char* a1 = cA + (size_t)(t + 1) * kstep;
            const char* a2 = last ? nA : cA + (size_t)(t + 2) * kstep; const char* b2 = last ? nB : cB + (size_t)(t + 2) * kstep;
            const char* a3 = a2 + kstep; const char* b3 = b2 + kstep;
            unsigned o2lo[2], o2hi[2];
            o2lo[0] = last ? on_lo[0] : oc_lo[0]; o2lo[1] = last ? on_lo[1] : oc_lo[1]; o2hi[0] = last ? on_hi[0] : oc_hi[0]; o2hi[1] = last ? on_hi[1] : oc_hi[1];
            PG8_LDB(B0, 0, 0); PG8_SCHED; PG8_LDA(At, 0, 0); if constexpr (GATHER) PG8_STAGE(PG8_SA(1, 1), a1, oc_hi); else PG8_STAGE(PG8_SA(1, 1), a1 + hstep, voffA);
            PG8_WAIT_L(8); PG8_BAR; PG8_WAIT_L(0); PG8_MMA(0, 0, At, B0); PG8_BAR; PG8_SCHED;
            PG8_LDB(B1, 0, 1); PG8_STAGE(PG8_SB(0, 0), b2, voffB);
            PG8_BAR; PG8_WAIT_L(0); PG8_MMA(0, 1, At, B1); PG8_BAR;
            PG8_LDA(At, 0, 1); if constexpr (GATHER) PG8_STAGE(PG8_SA(0, 0), a2, o2lo); else PG8_STAGE(PG8_SA(0, 0), a2, voffA);
            PG8_BAR; PG8_WAIT_L(0); PG8_MMA(1, 0, At, B0); PG8_BAR; PG8_SCHED;
            PG8_STAGE(PG8_SB(0, 1), b2 + hstep, voffB);
            PG8_WAIT_V(6); PG8_BAR; PG8_MMA(1, 1, At, B1); PG8_BAR;
            PG8_LDB(B0, 1, 0); PG8_SCHED; PG8_LDA(At, 1, 0); if constexpr (GATHER) PG8_STAGE(PG8_SA(0, 1), a2, o2hi); else PG8_STAGE(PG8_SA(0, 1), a2 + hstep, voffA);
            PG8_WAIT_L(8); PG8_BAR; PG8_WAIT_L(0); PG8_MMA(0, 0, At, B0); PG8_BAR; PG8_SCHED;
            PG8_LDB(B1, 1, 1); PG8_STAGE(PG8_SB(1, 0), b3, voffB);
            PG8_BAR; PG8_WAIT_L(0); PG8_MMA(0, 1, At, B1); PG8_BAR;
            PG8_LDA(At, 1, 1); if constexpr (GATHER) PG8_STAGE(PG8_SA(1, 0), a3, o2lo); else PG8_STAGE(PG8_SA(1, 0), a3, voffA);
            PG8_BAR; PG8_WAIT_L(0); PG8_MMA(1, 0, At, B0); PG8_BAR; PG8_SCHED;
            PG8_STAGE(PG8_SB(1, 1), b3 + hstep, voffB);
            PG8_WAIT_V(6); PG8_BAR; PG8_MMA(1, 1, At, B1); PG8_BAR;
        }
        epi_apply(E, acc, cur, wr, wc, fr, fq);
        if (!has_next) break;
#pragma unroll
        for (int a = 0; a < 2; ++a)
#pragma unroll
            for (int b = 0; b < 2; ++b)
#pragma unroll
                for (int m = 0; m < 4; ++m)
#pragma unroll
                    for (int n = 0; n < 2; ++n) acc[a][b][m][n] = (f32x4){0.f, 0.f, 0.f, 0.f};
        cur = nxt; cA = nA; cB = nB; ++ui;
        if constexpr (GATHER) { oc_lo[0] = on_lo[0]; oc_lo[1] = on_lo[1]; oc_hi[0] = on_hi[0]; oc_hi[1] = on_hi[1]; }
    }
    PG8_WAIT_V(0);
    if (wr == 0) PG8_BAR;
    PG8_BAR;
#undef PG8_ROWOFF
#undef PG8_SA
#undef PG8_SB
#undef PG8_STAGE
#undef PG8_LDA
#undef PG8_LDB
#undef PG8_MMA
#undef PG8_WAIT_V
#undef PG8_WAIT_L
#undef PG8_BAR
#undef PG8_SCHED
}
template <class Epi, class Sched>
__device__ __forceinline__ void gemm_phase(LAS unsigned char* lds, const int K, const Sched& S, const Epi& E, const int tid) { gemm_phase_t<false>(lds, K, S, E, tid); }
}

struct SchedInProj { const char* A; const char* Bt; int G, c;
    __device__ __forceinline__ bool next(int i, pg8::Unit& u) const { const int L = i * G + c; if (L >= 64 * 37) return false; int pm, pn; pg8::tile_order(L, 64, 37, pm, pn);
        u.a = A + (size_t)pm * (256 * 1024 * 2); u.b = Bt + (size_t)pn * (256 * 1024 * 2); u.row0 = pm * 256; u.col0 = pn * 256; u.aux = 0; u.rowmap = nullptr; return true; } };

struct WJob { const float* src; int ld_src; int K; int ncols; bf16* dst; int ld_dst; int nb; size_t sstride, dstride; };
__device__ __forceinline__ void wconv_job(const Ctx& c, const WJob& j) {
    float* tl = (float*)c.lds;
    const int ntk = j.K >> 6, ntn = j.ncols >> 6, per = ntk * ntn, ntiles = per * j.nb;
    const int rk = c.tid >> 3, rseg = (c.tid & 7) * 8;
    int tile = blockIdx.x;
    float4 a = make_float4(0.f, 0.f, 0.f, 0.f), b = a;
    if (tile < ntiles) { const int bi = tile / per, tt = tile % per, tk = tt % ntk, tn = tt / ntk;
        const float* sp = j.src + (size_t)bi * j.sstride + (size_t)(tk * 64 + rk) * j.ld_src + tn * 64 + rseg; a = *(const float4*)sp; b = *(const float4*)(sp + 4); }
    for (; tile < ntiles; tile += gridDim.x) {
        const int bi = tile / per, tt = tile % per, tk = tt % ntk, tn = tt / ntk;
        const float4 ca = a, cb = b;
        const int nxt = tile + gridDim.x;
        if (nxt < ntiles) { const int bi2 = nxt / per, tt2 = nxt % per, tk2 = tt2 % ntk, tn2 = tt2 / ntk;
            const float* sp = j.src + (size_t)bi2 * j.sstride + (size_t)(tk2 * 64 + rk) * j.ld_src + tn2 * 64 + rseg; a = *(const float4*)sp; b = *(const float4*)(sp + 4); }
        asm volatile("s_waitcnt lgkmcnt(0)" ::: "memory"); __builtin_amdgcn_s_barrier(); asm volatile("" ::: "memory");
        float* row = tl + rk * 65 + rseg;
        row[0] = ca.x; row[1] = ca.y; row[2] = ca.z; row[3] = ca.w; row[4] = cb.x; row[5] = cb.y; row[6] = cb.z; row[7] = cb.w;
        asm volatile("s_waitcnt lgkmcnt(0)" ::: "memory"); __builtin_amdgcn_s_barrier(); asm volatile("" ::: "memory");
        const float* col = tl + rseg * 65 + rk;
        uint4 w; w.x = pk2(col[0], col[65]); w.y = pk2(col[130], col[195]); w.z = pk2(col[260], col[325]); w.w = pk2(col[390], col[455]);
        *(uint4*)(j.dst + (size_t)bi * j.dstride + (size_t)(tn * 64 + rk) * j.ld_dst + tk * 64 + rseg) = w;
    }
}
struct SchedG2 { const char* YA; const char* Bt; int G, c;
    __device__ __forceinline__ bool next(int i, pg8::Unit& u) const { const int L = (i >> 1) * G + c, ab = i & 1; if (L >= 64 * 4) return false; int pm, pn; pg8::tile_order(L, 64, 4, pm, pn);
        u.a = YA + (size_t)ab * (WS_YB - WS_YA) + (size_t)pm * (256 * 1024 * 2); u.b = Bt + (size_t)(ab * 4 + pn) * (256 * 1024 * 2); u.row0 = pm * 256; u.col0 = ab * 1024 + pn * 256; u.aux = 0; u.rowmap = nullptr; return true; } };
struct SchedX1 { const char* A; const char* Bt; int G, c;
    __device__ __forceinline__ bool next(int i, pg8::Unit& u) const { const int L = i * G + c; if (L >= 64 * 4) return false; int pm, pn; pg8::tile_order(L, 64, 4, pm, pn);
        u.a = A + (size_t)pm * (256 * 1024 * 2); u.b = Bt + (size_t)pn * (256 * 1024 * 2); u.row0 = pm * 256; u.col0 = pn * 256; u.aux = 0; u.rowmap = nullptr; return true; } };
struct SchedMoe { const char* A; const char* Bt; const int* TILE_E; const int* SLOT_TOK; int NT, NPN, G, c;
    __device__ __forceinline__ bool next(int i, pg8::Unit& u) const { const int L = i * G + c; if (L >= NT * NPN) return false; int tile, pn; pg8::tile_order(L, NT, NPN, tile, pn);
        const int e = TILE_E[tile];
        u.a = SLOT_TOK ? A : A + (size_t)tile * (256 * 1024 * 2); u.rowmap = SLOT_TOK ? SLOT_TOK + tile * 256 : nullptr;
        u.b = Bt + (size_t)(e * NPN + pn) * (256 * 1024 * 2); u.row0 = tile * 256; u.col0 = pn * 256; u.aux = e; return true; } };

struct EpiLora {
    typedef NoLd Ld; static constexpr int MB = 1;
    const float* w0; const float* a0; float* LW; float* AA; bf16* GGR;
    __device__ __forceinline__ void load(Ld&, int, int, int) const {}
    __device__ __forceinline__ void store8(int row, int col, const float (&v)[8], int, const Ld&) const {
        const float* bp = col < 1024 ? w0 + col : a0 + ((col - 1024) & 1023);
        const float4 b0 = *(const float4*)bp, b1 = *(const float4*)(bp + 4);
        const float bb[8] = {b0.x, b0.y, b0.z, b0.w, b1.x, b1.y, b1.z, b1.w};
        if (col < 1024) { float o[8];
#pragma unroll
            for (int i = 0; i < 8; ++i) o[i] = -0.6065306597126334f * fsigm(bb[i] + v[i]);
            float* p = LW + (size_t)row * 1024 + col; *(float4*)p = make_float4(o[0], o[1], o[2], o[3]); *(float4*)(p + 4) = make_float4(o[4], o[5], o[6], o[7]); }
        else if (col < 2048) { const int cc = col - 1024; float o[8];
#pragma unroll
            for (int i = 0; i < 8; ++i) o[i] = fsigm(bb[i] + v[i]);
            float* p = AA + (size_t)row * 1024 + cc; *(float4*)p = make_float4(o[0], o[1], o[2], o[3]); *(float4*)(p + 4) = make_float4(o[4], o[5], o[6], o[7]); }
        else { uint4 w; w.x = pk2(v[0], v[1]); w.y = pk2(v[2], v[3]); w.z = pk2(v[4], v[5]); w.w = pk2(v[6], v[7]); *(uint4*)(GGR + (size_t)row * 1024 + (col - 2048)) = w; }
    }
};
struct SchedLora { const char* A; const char* Bt; int G, c;
    __device__ __forceinline__ bool next(int i, pg8::Unit& u) const { const int L = i * G + c; if (L >= 64 * 12) return false; int pm, pn; pg8::tile_order(L, 64, 12, pm, pn);
        u.a = A + (size_t)pm * (256 * 256 * 2); u.b = Bt + (size_t)pn * (256 * 256 * 2); u.row0 = pm * 256; u.col0 = pn * 256; u.aux = 0; u.rowmap = nullptr; return true; } };
__device__ __forceinline__ void lora_zero(const Ctx& c) {
    uint4* LT = c.ws<uint4>(WS_LORA_T);
    for (size_t idx = c.gtid; idx < (size_t)3072 * 32; idx += c.nthreads) {
        const int row = (int)(idx >> 5), k8 = (int)(idx & 31) * 8;
        const bool data = row < 1024 ? (k8 < 64) : (row < 2048 ? (k8 >= 64 && k8 < 128) : (k8 >= 128));
        if (!data) LT[idx] = make_uint4(0, 0, 0, 0);
    }
}

__device__ __forceinline__ void ph_loraprep(const Ctx& c) {
    const float* LIN = c.ws<float>(WS_LIN); bf16* AL = c.ws<bf16>(WS_ALORA); const float* mu = c.P.in[I_MU];
    for (size_t idx = c.gtid; idx < (size_t)T * 256; idx += c.nthreads) {
        const int t = (int)(idx >> 8), cc = (int)(idx & 255);
        const float x = LIN[idx], xp = (t & (SEQ - 1)) ? LIN[idx - 256] : 0.f;
        const float xs = x + (xp - x) * mu[3072 + cc];
        const float r = cc < 64 ? tanhf(xs) : (cc < 128 ? xs : sigm(xs));
        AL[idx] = f2bf(r);
    }
}
__device__ __forceinline__ void ph_post(const Ctx& c) {
    const float* OG = c.ws<float>(WS_OG); const float* ORW = c.ws<float>(WS_ORW); const bf16* ZS = c.ws<bf16>(WS_ZS); const bf16* VP = c.ws<bf16>(WS_VP); const bf16* GGR = c.ws<bf16>(WS_GGR);
    const float* SC = c.ws<float>(WS_SC); bf16* YA = c.ws<bf16>(WS_YA); bf16* YB = c.ws<bf16>(WS_YB);
    const float* gnw = c.P.in[I_GDN_NORM]; const float* lnw = c.P.in[I_LNW]; const float* lnb = c.P.in[I_LNB];
    const int lane = c.lane, c0 = lane * 16;
    for (int t = c.gwave; t < T; t += c.nwaves) {
        {
            float o[16];
#pragma unroll
            for (int q = 0; q < 4; ++q) { const float4 v = *(const float4*)(OG + (size_t)t * 1024 + c0 + 4 * q); o[4 * q] = v.x; o[4 * q + 1] = v.y; o[4 * q + 2] = v.z; o[4 * q + 3] = v.w; }
            float ss = 0.f;
#pragma unroll
            for (int j = 0; j < 16; ++j) ss += o[j] * o[j];
            ss += __shfl_xor(ss, 1); ss += __shfl_xor(ss, 2); ss += __shfl_xor(ss, 4);
            const float rstd = rsqrtf(ss * (1.f / 128.f) + 1e-6f);
            const uint4 z0 = *(const uint4*)(ZS + (size_t)t * 1024 + c0), z1 = *(const uint4*)(ZS + (size_t)t * 1024 + c0 + 8);
            const unsigned zz[8] = {z0.x, z0.y, z0.z, z0.w, z1.x, z1.y, z1.z, z1.w};
            unsigned w[8];
#pragma unroll
            for (int j = 0; j < 8; ++j) { const int cc = (c0 + 2 * j) & 127; w[j] = pk2(o[2 * j] * rstd * gnw[cc] * bflo(zz[j]), o[2 * j + 1] * rstd * gnw[cc + 1] * bfhi(zz[j])); }
            *(uint4*)(YA + (size_t)t * 1024 + c0) = make_uint4(w[0], w[1], w[2], w[3]); *(uint4*)(YA + (size_t)t * 1024 + c0 + 8) = make_uint4(w[4], w[5], w[6], w[7]);
        }
        {
            float o[16];
#pragma unroll
            for (int q = 0; q < 4; ++q) { const float4 v = *(const float4*)(ORW + (size_t)t * 1024 + c0 + 4 * q); o[4 * q] = v.x; o[4 * q + 1] = v.y; o[4 * q + 2] = v.z; o[4 * q + 3] = v.w; }
            float sm = 0.f;
#pragma unroll
            for (int j = 0; j < 16; ++j) sm += o[j];
            sm += __shfl_xor(sm, 1); sm += __shfl_xor(sm, 2);
            const float mean = sm * (1.f / 64.f);
            float sv = 0.f;
#pragma unroll
            for (int j = 0; j < 16; ++j) { const float dd = o[j] - mean; sv += dd * dd; }
            sv += __shfl_xor(sv, 1); sv += __shfl_xor(sv, 2);
            const float rstd = rsqrtf(sv * (1.f / 64.f) + 64e-5f);
            const float sc = SC[t * 16 + (c0 >> 6)];
            const uint4 v0 = *(const uint4*)(VP + (size_t)t * 1024 + c0), v1 = *(const uint4*)(VP + (size_t)t * 1024 + c0 + 8);
            const uint4 g0 = *(const uint4*)(GGR + (size_t)t * 1024 + c0), g1 = *(const uint4*)(GGR + (size_t)t * 1024 + c0 + 8);
            const unsigned vv[8] = {v0.x, v0.y, v0.z, v0.w, v1.x, v1.y, v1.z, v1.w};
            const unsigned gg[8] = {g0.x, g0.y, g0.z, g0.w, g1.x, g1.y, g1.z, g1.w};
            unsigned w[8];
#pragma unroll
            for (int j = 0; j < 8; ++j) { const int cc = c0 + 2 * j;
                const float y0 = ((o[2 * j] - mean) * rstd * lnw[cc] + lnb[cc] + sc * bflo(vv[j])) * bflo(gg[j]);
                const float y1 = ((o[2 * j + 1] - mean) * rstd * lnw[cc + 1] + lnb[cc + 1] + sc * bfhi(vv[j])) * bfhi(gg[j]);
                w[j] = pk2(y0, y1); }
            *(uint4*)(YB + (size_t)t * 1024 + c0) = make_uint4(w[0], w[1], w[2], w[3]); *(uint4*)(YB + (size_t)t * 1024 + c0 + 8) = make_uint4(w[4], w[5], w[6], w[7]);
        }
    }
}

__device__ __forceinline__ void ph_router(const Ctx& c) {
    const float* X1 = c.ws<float>(WS_X1); const float* nw = c.P.in[I_NORM_FFN]; const float* rw = c.P.in[I_ROUTER_W]; const float* rb = c.P.in[I_ROUTER_B];
    bf16* H2 = c.ws<bf16>(WS_H2); int* TE = c.ws<int>(WS_TE); float* TG = c.ws<float>(WS_TG); int* TP = c.ws<int>(WS_TP); unsigned* CNT = c.ws<unsigned>(WS_CTL) + CW_CNT;
    const int lane = c.lane;
    float4* tab = (float4*)c.lds;
    unsigned* lcnt = (unsigned*)(c.lds + 147456);
    __syncthreads();
    if (c.tid < 32) lcnt[c.tid] = 0u;
    for (int i = c.tid; i < 8192; i += NTHREADS) { const int k = i >> 3; tab[((k & 3) * 256 + (k >> 2)) * 9 + (i & 7)] = ((const float4*)rw)[i]; }
    __syncthreads();
    for (int t = c.gwave; t < T; t += c.nwaves) {
        float4 v[4]; float ss = 0.f;
#pragma unroll
        for (int i = 0; i < 4; ++i) { v[i] = ((const float4*)(X1 + (size_t)t * D))[lane + 64 * i]; ss += v[i].x * v[i].x + v[i].y * v[i].y + v[i].z * v[i].z + v[i].w * v[i].w; }
        ss = wsum(ss);
        const float rstd = rsqrtf(ss * (1.f / 1024.f) + 1e-6f);
        float lg[32];
#pragma unroll
        for (int j = 0; j < 32; ++j) lg[j] = 0.f;
#pragma unroll
        for (int i = 0; i < 4; ++i) {
            const float4 w4 = ((const float4*)nw)[lane + 64 * i];
            const float h[4] = {v[i].x * rstd * w4.x, v[i].y * rstd * w4.y, v[i].z * rstd * w4.z, v[i].w * rstd * w4.w};
            uint2 st; st.x = pk2(h[0], h[1]); st.y = pk2(h[2], h[3]);
            *(uint2*)(H2 + (size_t)t * D + 4 * (lane + 64 * i)) = st;
#pragma unroll
            for (int ii = 0; ii < 4; ++ii) {
                const float4* wr = tab + (size_t)(ii * 256 + lane + 64 * i) * 9;
#pragma unroll
                for (int q = 0; q < 8; ++q) { const float4 w = wr[q]; lg[4 * q] += h[ii] * w.x; lg[4 * q + 1] += h[ii] * w.y; lg[4 * q + 2] += h[ii] * w.z; lg[4 * q + 3] += h[ii] * w.w; }
                asm volatile("" ::: "memory");
            }
        }
#pragma unroll
        for (int j = 0; j < 32; ++j) lg[j] = wsum(lg[j]) + rb[j];
        int e0 = 0, e1 = 0, e2 = 0, e3 = 0; float v0 = -3e38f, v1 = -3e38f, v2 = -3e38f, v3 = -3e38f;
#pragma unroll
        for (int j = 0; j < 32; ++j) if (lg[j] > v0) { v0 = lg[j]; e0 = j; }
#pragma unroll
        for (int j = 0; j < 32; ++j) if (j != e0 && lg[j] > v1) { v1 = lg[j]; e1 = j; }
#pragma unroll
        for (int j = 0; j < 32; ++j) if (j != e0 && j != e1 && lg[j] > v2) { v2 = lg[j]; e2 = j; }
#pragma unroll
        for (int j = 0; j < 32; ++j) if (j != e0 && j != e1 && j != e2 && lg[j] > v3) { v3 = lg[j]; e3 = j; }
        const float x1 = expf(v1 - v0), x2 = expf(v2 - v0), x3 = expf(v3 - v0), inv = 1.f / (1.f + x1 + x2 + x3);
        if (lane < 4) {
            const int me = lane == 0 ? e0 : (lane == 1 ? e1 : (lane == 2 ? e2 : e3));
            const float mg = (lane == 0 ? 1.f : (lane == 1 ? x1 : (lane == 2 ? x2 : x3))) * inv;
            const unsigned pos = atomicAdd(&lcnt[me], 1u);
            TE[t * 4 + lane] = me; TG[t * 4 + lane] = mg; TP[t * 4 + lane] = (int)pos;
        }
    }
    __syncthreads();
    if (c.tid < 32) lcnt[32 + c.tid] = atomicAdd(&CNT[c.tid], lcnt[c.tid]);
    __syncthreads();
    if (lane < 4) for (int t = c.gwave; t < T; t += c.nwaves) TP[t * 4 + lane] += (int)lcnt[32 + TE[t * 4 + lane]];
    __syncthreads();
}

__device__ __forceinline__ void ph_dispatch(const Ctx& c) {
    int* tb = (int*)c.lds;
    const unsigned* CNT = c.ws<unsigned>(WS_CTL) + CW_CNT;
    int* TILE_E = c.ws<int>(WS_TILE_E); int* NT = c.ws<int>(WS_NT);
    const int* TE = c.ws<int>(WS_TE); const float* TG = c.ws<float>(WS_TG); const int* TP = c.ws<int>(WS_TP); int* TSLOT = c.ws<int>(WS_TSLOT);
    float* SGATE = c.ws<float>(WS_SGATE); const bf16* H2 = c.ws<bf16>(WS_H2); bf16* XB = c.ws<bf16>(WS_XB);
    if (c.tid == 0) { int acc = 0; for (int e = 0; e < NEXP; ++e) { const int n = (int)__hip_atomic_load(&CNT[e], __ATOMIC_RELAXED, __HIP_MEMORY_SCOPE_AGENT); tb[e] = acc; tb[64 + e] = n; acc += (n + 255) >> 8; } tb[32] = acc; }
    __syncthreads();
    if (blockIdx.x == 0) {
        for (int tile = c.tid; tile < tb[32]; tile += NTHREADS) { int e = 0; for (int q = 0; q < NEXP; ++q) if (tile >= tb[q]) e = q; TILE_E[tile] = e; }
        if (c.tid == 0) *NT = tb[32];
    }
    int* SLOT_TOK = c.ws<int>(WS_SLOT_TOK);
    for (size_t idx = c.gtid; idx < (size_t)T * 4; idx += c.nthreads) {
        const int t = (int)(idx >> 2), e = TE[idx], pos = TP[idx];
        const int slot = tb[e] * 256 + pos;
        TSLOT[idx] = slot; SGATE[slot] = TG[idx]; SLOT_TOK[slot] = t;
    }
    for (int e = 0; e < NEXP; ++e) {
        const int n = tb[64 + e], cap = (tb[e + 1] - tb[e]) * 256;
        for (int r = n + (int)c.gtid; r < cap; r += (int)c.nthreads) { const int slot = tb[e] * 256 + r; SLOT_TOK[slot] = 0; SGATE[slot] = 0.f; }
    }
}

__device__ __forceinline__ void ph_combine(const Ctx& c) {
    const float* X1 = c.ws<float>(WS_X1); const bf16* YS = c.ws<bf16>(WS_YS); const int* TSLOT = c.ws<int>(WS_TSLOT); const float* nw = c.P.in[I_NORM_FINAL]; float* out = c.P.out;
    const int lane = c.lane;
    for (int t = c.gwave; t < T; t += c.nwaves) {
        const int s0 = TSLOT[t * 4], s1 = TSLOT[t * 4 + 1], s2 = TSLOT[t * 4 + 2], s3 = TSLOT[t * 4 + 3];
        float4 v[4]; float ss = 0.f;
#pragma unroll
        for (int i = 0; i < 4; ++i) {
            const int col = 4 * (lane + 64 * i);
            v[i] = *(const float4*)(X1 + (size_t)t * D + col);
            const uint2 a = *(const uint2*)(YS + (size_t)s0 * 1024 + col), b = *(const uint2*)(YS + (size_t)s1 * 1024 + col), cc = *(const uint2*)(YS + (size_t)s2 * 1024 + col), d = *(const uint2*)(YS + (size_t)s3 * 1024 + col);
            v[i].x += bflo(a.x) + bflo(b.x) + bflo(cc.x) + bflo(d.x); v[i].y += bfhi(a.x) + bfhi(b.x) + bfhi(cc.x) + bfhi(d.x);
            v[i].z += bflo(a.y) + bflo(b.y) + bflo(cc.y) + bflo(d.y); v[i].w += bfhi(a.y) + bfhi(b.y) + bfhi(cc.y) + bfhi(d.y);
            ss += v[i].x * v[i].x + v[i].y * v[i].y + v[i].z * v[i].z + v[i].w * v[i].w;
        }
        ss = wsum(ss);
        const float rstd = rsqrtf(ss * (1.f / 1024.f) + 1e-6f);
#pragma unroll
        for (int i = 0; i < 4; ++i) { const float4 w4 = ((const float4*)nw)[lane + 64 * i];
            *(float4*)(out + (size_t)t * D + 4 * (lane + 64 * i)) = make_float4(v[i].x * rstd * w4.x, v[i].y * rstd * w4.y, v[i].z * rstd * w4.z, v[i].w * rstd * w4.w); }
    }
}


typedef short bf16x8_t __attribute__((ext_vector_type(8)));
typedef float f32x4_t __attribute__((ext_vector_type(4)));
#define MFMA16(a, b, c) __builtin_amdgcn_mfma_f32_16x16x32_bf16((a), (b), (c), 0, 0, 0)


__device__ __forceinline__ int frag_off(int row, int k, int KBn) { return (((row >> 4) * KBn + (k >> 5)) * 512) + (((k >> 3) & 3) * 128) + ((row & 15) * 8) + (k & 7); }
__device__ __forceinline__ int cfrag_off(int v, int r, int NRT) { return ((((v >> 4) * NRT + (r >> 4)) * 64 + ((r >> 2) & 3) * 16 + (v & 15)) * 4) + (r & 3); }

constexpr int GCL_HALF_BYTES = 71680;
__device__ __forceinline__ void ph_gcl(const Ctx& c) {
    const bf16* GQKV = c.ws<bf16>(WS_GQKV); const float* BETA = c.ws<float>(WS_BETA); const float* GGv = c.ws<float>(WS_GG); const float* cw = c.P.in[I_GDN_CONV];
    bf16* GA1 = c.ws<bf16>(WS_GA1); bf16* GX0 = c.ws<bf16>(WS_GX0); bf16* GA2 = c.ws<bf16>(WS_GA2); bf16* GA3 = c.ws<bf16>(WS_GA3); bf16* GA4 = c.ws<bf16>(WS_GA4); float* GGL = c.ws<float>(WS_GGL);
    for (int it0 = blockIdx.x * 2; it0 < 2048; it0 += gridDim.x * 2) {
        int tv = c.tid; asm volatile("" : "+v"(tv));
        const int half = tv >> 8, ht = tv & 255, lane = tv & 63, w4 = __builtin_amdgcn_readfirstlane((tv >> 6) & 3);
        unsigned char* base = c.lds + half * GCL_HALF_BYTES;
        bf16* QB = (bf16*)base;
        bf16* KB = QB + 64 * 136;
        bf16* VB = KB + 64 * 136;
        float* MM = (float*)(VB + 64 * 136);
        float* GC = MM + 64 * 64;
        float* BT = GC + 64;
        float* BE = BT + 64;
        const int item = it0 + half, n = item & 63, bh = item >> 6, h = bh & 7, b = bh >> 3;
        const int t0 = b * SEQ + n * 64;
        __syncthreads();
        if (w4 == 0) {
            float g = GGv[(size_t)(t0 + lane) * 8 + h]; const float be = BETA[(size_t)(t0 + lane) * 8 + h];
#pragma unroll
            for (int o = 1; o < 64; o <<= 1) { const float u = __shfl_up(g, o); if (lane >= o) g += u; }
            GC[lane] = g; BT[lane] = be; BE[lane] = be * __expf(g);
        }
        __syncthreads();
        {
            const int cg = ht & 15, rg = ht >> 4, r0 = rg * 4;
#pragma unroll
            for (int mat = 0; mat < 3; ++mat) {
                const int col0 = mat * 1024 + h * 128 + cg * 8;
                float4 xa[7], xb[7], wa[4], wb[4];
#pragma unroll
                for (int li = 0; li < 7; ++li) {
                    const bool valid = (n > 0) || (r0 - 3 + li >= 0);
                    uint4 xr = make_uint4(0, 0, 0, 0);
                    if (valid) xr = *(const uint4*)(GQKV + (size_t)(t0 + r0 - 3 + li) * 3072 + col0);
                    xa[li] = make_float4(bflo(xr.x), bfhi(xr.x), bflo(xr.y), bfhi(xr.y));
                    xb[li] = make_float4(bflo(xr.z), bfhi(xr.z), bflo(xr.w), bfhi(xr.w));
                }
#pragma unroll
                for (int j = 0; j < 4; ++j) { wa[j] = *(const float4*)(cw + j * 3072 + col0); wb[j] = *(const float4*)(cw + j * 3072 + col0 + 4); }
#pragma unroll
                for (int rr = 0; rr < 4; ++rr) {
                    float o[8] = {0.f, 0.f, 0.f, 0.f, 0.f, 0.f, 0.f, 0.f};
#pragma unroll
                    for (int j = 0; j < 4; ++j) { const float4 a = xa[rr + j], bq = xb[rr + j];
                        o[0] += wa[j].x * a.x; o[1] += wa[j].y * a.y; o[2] += wa[j].z * a.z; o[3] += wa[j].w * a.w;
                        o[4] += wb[j].x * bq.x; o[5] += wb[j].y * bq.y; o[6] += wb[j].z * bq.z; o[7] += wb[j].w * bq.w; }
                    float ss = 0.f;
#pragma unroll
                    for (int e = 0; e < 8; ++e) { o[e] *= fsigm(o[e]); ss += o[e] * o[e]; }
                    float sc = 1.f;
                    if (mat < 2) { ss += __shfl_xor(ss, 1); ss += __shfl_xor(ss, 2); ss += __shfl_xor(ss, 4); ss += __shfl_xor(ss, 8); sc = rsqrtf(ss + 1e-6f) * (mat == 0 ? 0.08838834764831845f : 1.f); }
                    const int r = r0 + rr;
                    uint4 w; w.x = pk2(o[0] * sc, o[1] * sc); w.y = pk2(o[2] * sc, o[3] * sc); w.z = pk2(o[4] * sc, o[5] * sc); w.w = pk2(o[6] * sc, o[7] * sc);
                    *(uint4*)((mat == 0 ? QB : (mat == 1 ? KB : VB)) + r * 136 + cg * 8) = w;
                    if (mat == 0) {
                        const float s2 = sc * __expf(GC[r]);
                        w.x = pk2(o[0] * s2, o[1] * s2); w.y = pk2(o[2] * s2, o[3] * s2); w.z = pk2(o[4] * s2, o[5] * s2); w.w = pk2(o[6] * s2, o[7] * s2);
                        *(uint4*)(GA2 + (size_t)item * 64 * 128 + frag_off(r, cg * 8, 4)) = w;
                    }
                }
            }
        }
        __syncthreads();
        {
            const int fr = lane & 15, fq = lane >> 4, a0 = w4 * 16;
            bf16x8_t ka[4];
#pragma unroll
            for (int kb = 0; kb < 4; ++kb) ka[kb] = *(const bf16x8_t*)(KB + (a0 + fr) * 136 + kb * 32 + fq * 8);
#pragma unroll
            for (int bt = 0; bt < 4; ++bt) {
                f32x4_t c1 = {0.f, 0.f, 0.f, 0.f}, c2 = {0.f, 0.f, 0.f, 0.f};
#pragma unroll
                for (int kb = 0; kb < 4; ++kb) {
                    const bf16x8_t kbf = *(const bf16x8_t*)(KB + (bt * 16 + fr) * 136 + kb * 32 + fq * 8);
                    const bf16x8_t qbf = *(const bf16x8_t*)(QB + (bt * 16 + fr) * 136 + kb * 32 + fq * 8);
                    c1 = MFMA16(ka[kb], kbf, c1); c2 = MFMA16(ka[kb], qbf, c2);
                }
                const int i = bt * 16 + fr, j0 = a0 + 4 * fq;
                const float gi = GC[i], bi = BT[i];
                float m[4], at[4];
#pragma unroll
                for (int rg = 0; rg < 4; ++rg) { const int j = j0 + rg; const float dec = __expf(fminf(gi - GC[j], 0.f));
                    m[rg] = (i > j) ? bi * c1[rg] * dec : 0.f; at[rg] = (i >= j) ? c2[rg] * dec : 0.f; }
                *(float4*)(MM + i * 64 + j0) = make_float4(m[0], m[1], m[2], m[3]);
                uint2 w; w.x = pk2(at[0], at[1]); w.y = pk2(at[2], at[3]);
                *(uint2*)(GA3 + (size_t)item * 64 * 64 + frag_off(i, j0, 2)) = w;
            }
        }
        __syncthreads();
        {
            const int cc = ht & 127; const bool isw = ht >= 128;
            const bf16* srcp = (isw ? KB : VB) + cc; const float* scl = isw ? BE : BT;
            float x[64];
#pragma unroll
            for (int i = 0; i < 64; ++i) x[i] = 0.f;
            float4 mc[16], mn[16];
#pragma unroll
            for (int q = 0; q < 16; ++q) { mc[q] = make_float4(0.f, 0.f, 0.f, 0.f); mn[q] = mc[q]; }
            float rhs_n = scl[0] * bf2f(srcp[0]);
#pragma unroll
            for (int i = 0; i < 64; ++i) {
                const float rhs = rhs_n;
                if (i + 1 < 64) {
#pragma unroll
                    for (int j4 = 0; j4 < (i + 4) / 4; ++j4) mn[j4] = *(const float4*)(MM + (i + 1) * 64 + 4 * j4);
                    rhs_n = scl[i + 1] * bf2f(srcp[(i + 1) * 136]);
                }
                float acc = rhs, ac1 = 0.f, ac2 = 0.f, ac3 = 0.f;
#pragma unroll
                for (int j4 = 0; j4 < (i + 3) / 4; ++j4) { acc -= mc[j4].x * x[4 * j4]; ac1 -= mc[j4].y * x[4 * j4 + 1]; ac2 -= mc[j4].z * x[4 * j4 + 2]; ac3 -= mc[j4].w * x[4 * j4 + 3]; }
                x[i] = (acc + ac1) + (ac2 + ac3);
#pragma unroll
                for (int j4 = 0; j4 < 16; ++j4) mc[j4] = mn[j4];
                asm volatile("" ::: "memory");
            }
            if (!isw) {
                bf16* up = GX0 + (size_t)item * 128 * 64;
#pragma unroll
                for (int q = 0; q < 16; ++q) { uint2 w; w.x = pk2(x[4 * q], x[4 * q + 1]); w.y = pk2(x[4 * q + 2], x[4 * q + 3]); *(uint2*)(up + cfrag_off(cc, 4 * q, 4)) = w; }
            }
            __syncthreads();
            if (isw) {
                bf16* a1s = (bf16*)MM;
#pragma unroll
                for (int i = 0; i < 64; ++i) a1s[i * 128 + cc] = f2bf(-x[i]);
            }
        }
        __syncthreads();
        {
            const bf16* a1s = (const bf16*)MM; bf16* wp = GA1 + (size_t)item * 64 * 128;
#pragma unroll
            for (int q = 0; q < 4; ++q) { const int p = ht + 256 * q, fr = p & 15, fq = (p >> 4) & 3, kb = (p >> 6) & 3, rt = p >> 8;
                *(uint4*)(wp + p * 8) = *(const uint4*)(a1s + (rt * 16 + fr) * 128 + kb * 32 + fq * 8); }
        }
        {
            const int dk = ht & 127, hh = ht >> 7; const float g63 = GC[63];
            unsigned w[16];
#pragma unroll
            for (int q = 0; q < 16; ++q) { const int ta = hh * 32 + 2 * q;
                w[q] = pk2(bf2f(KB[ta * 136 + dk]) * __expf(g63 - GC[ta]), bf2f(KB[(ta + 1) * 136 + dk]) * __expf(g63 - GC[ta + 1])); }
            bf16* dp = GA4 + (size_t)item * 128 * 64;
            *(uint4*)(dp + frag_off(dk, hh * 32, 2)) = make_uint4(w[0], w[1], w[2], w[3]); *(uint4*)(dp + frag_off(dk, hh * 32 + 8, 2)) = make_uint4(w[4], w[5], w[6], w[7]);
            *(uint4*)(dp + frag_off(dk, hh * 32 + 16, 2)) = make_uint4(w[8], w[9], w[10], w[11]); *(uint4*)(dp + frag_off(dk, hh * 32 + 24, 2)) = make_uint4(w[12], w[13], w[14], w[15]);
            if (ht == 0) GGL[item] = __expf(g63);
        }
    }
}

constexpr int RCL_HALF_BYTES = 75776;
__device__ __forceinline__ void ph_rcl(const Ctx& c) {
    const bf16* RKV = c.ws<bf16>(WS_RKV); const float* LW = c.ws<float>(WS_LW); const float* AAg = c.ws<float>(WS_AA);
    const float* mu = c.P.in[I_MU]; const float* k_k = c.P.in[I_KK]; const float* k_a = c.P.in[I_KA]; const float* r_k = c.P.in[I_RK];
    bf16* VP = c.ws<bf16>(WS_VP); float* SC = c.ws<float>(WS_SC);
    bf16* RA1 = c.ws<bf16>(WS_RA1); bf16* RX0 = c.ws<bf16>(WS_RX0); bf16* RA2 = c.ws<bf16>(WS_RA2); bf16* RA3 = c.ws<bf16>(WS_RA3); bf16* RO0 = c.ws<bf16>(WS_RO0);
    bf16* RA4 = c.ws<bf16>(WS_RA4); bf16* RS0 = c.ws<bf16>(WS_RS0); float* RDSC = c.ws<float>(WS_RDSC);
    for (int it0 = blockIdx.x * 2; it0 < 4096; it0 += gridDim.x * 2) {
        int tv = c.tid; asm volatile("" : "+v"(tv));
        const int half = tv >> 8, ht = tv & 255, lane = tv & 63, w4 = __builtin_amdgcn_readfirstlane((tv >> 6) & 3);
        unsigned char* base = c.lds + half * RCL_HALF_BYTES;
        bf16* AT = (bf16*)base;
        bf16* VT = AT + 64 * 72;
        bf16* KDT = VT + 64 * 72;
        float* AAB = (float*)(KDT + 64 * 72);
        float* TOT = AAB + 64 * 64;
        unsigned char* RX = (unsigned char*)(TOT + 256);
        bf16* RT = (bf16*)RX;
        bf16* BTL = RT + 64 * 72;
        bf16* KT = BTL + 64 * 72;
        bf16* AAK = (bf16*)RX;
        bf16* ARK = AAK + 64 * 72;
        float* RHS2 = (float*)RX;
        const int item = it0 + half, n = item & 63, bh = item >> 6, h = bh & 15, b = bh >> 4;
        const int t0 = b * SEQ + n * 64;
        __syncthreads();
        const int r = ht >> 2, seg = ht & 3, c0 = seg * 16, t = t0 + r; const bool first = (n == 0 && r == 0);
        float rr[16], kf[16], vv[16], kkv[16], aa[16], lwl[16];
        float ss = 0.f, scs = 0.f;
        {
            const bf16* cur = RKV + (size_t)t * 3072 + h * 64 + c0; const bf16* prv = cur - 3072;
            uint4 ur[2], uk[2], uv[2], qr[2], qk[2], qv[2];
            float4 a4v[4], l4v[4], mr[4], mk[4], mv[4], kkw[4], kaw[4], rkw[4];
#pragma unroll
            for (int g = 0; g < 2; ++g) {
                ur[g] = *(const uint4*)(cur + 8 * g); uk[g] = *(const uint4*)(cur + 1024 + 8 * g); uv[g] = *(const uint4*)(cur + 2048 + 8 * g);
                qr[g] = make_uint4(0, 0, 0, 0); qk[g] = qr[g]; qv[g] = qr[g];
                if (!first) { qr[g] = *(const uint4*)(prv + 8 * g); qk[g] = *(const uint4*)(prv + 1024 + 8 * g); qv[g] = *(const uint4*)(prv + 2048 + 8 * g); }
            }
#pragma unroll
            for (int q = 0; q < 4; ++q) {
                l4v[q] = *(const float4*)(LW + (size_t)t * 1024 + h * 64 + c0 + 4 * q);
                a4v[q] = *(const float4*)(AAg + (size_t)t * 1024 + h * 64 + c0 + 4 * q);
                mr[q] = *(const float4*)(mu + h * 64 + c0 + 4 * q); mk[q] = *(const float4*)(mu + 1024 + h * 64 + c0 + 4 * q); mv[q] = *(const float4*)(mu + 2048 + h * 64 + c0 + 4 * q);
                kkw[q] = *(const float4*)(k_k + h * 64 + c0 + 4 * q); kaw[q] = *(const float4*)(k_a + h * 64 + c0 + 4 * q); rkw[q] = *(const float4*)(r_k + h * 64 + c0 + 4 * q);
            }
#pragma unroll
            for (int q = 0; q < 4; ++q) *(float4*)(AAB + r * 64 + c0 + 4 * q) = l4v[q];
            __syncthreads();
            {
                const int ch = ht & 63, tq = ht >> 6;
                float run = 0.f;
#pragma unroll
                for (int i = 0; i < 16; ++i) { run += AAB[(tq * 16 + i) * 64 + ch]; AAB[(tq * 16 + i) * 64 + ch] = run; }
                TOT[tq * 64 + ch] = run;
            }
            __syncthreads();
#pragma unroll
            for (int q = 0; q < 4; ++q) {
                const int g = q >> 1; const bool hi = q & 1;
                const unsigned r_a = hi ? ur[g].z : ur[g].x, r_b = hi ? ur[g].w : ur[g].y, k_a_ = hi ? uk[g].z : uk[g].x, k_b_ = hi ? uk[g].w : uk[g].y, v_a = hi ? uv[g].z : uv[g].x, v_b = hi ? uv[g].w : uv[g].y;
                const unsigned pr_a = hi ? qr[g].z : qr[g].x, pr_b = hi ? qr[g].w : qr[g].y, pk_a = hi ? qk[g].z : qk[g].x, pk_b = hi ? qk[g].w : qk[g].y, pv_a = hi ? qv[g].z : qv[g].x, pv_b = hi ? qv[g].w : qv[g].y;
                const float r0a[4] = {bflo(r_a), bfhi(r_a), bflo(r_b), bfhi(r_b)}, k0a[4] = {bflo(k_a_), bfhi(k_a_), bflo(k_b_), bfhi(k_b_)}, v0a[4] = {bflo(v_a), bfhi(v_a), bflo(v_b), bfhi(v_b)};
                const float rpa[4] = {bflo(pr_a), bfhi(pr_a), bflo(pr_b), bfhi(pr_b)}, kpa[4] = {bflo(pk_a), bfhi(pk_a), bflo(pk_b), bfhi(pk_b)}, vpa[4] = {bflo(pv_a), bfhi(pv_a), bflo(pv_b), bfhi(pv_b)};
                const float mra[4] = {mr[q].x, mr[q].y, mr[q].z, mr[q].w}, mka[4] = {mk[q].x, mk[q].y, mk[q].z, mk[q].w}, mva[4] = {mv[q].x, mv[q].y, mv[q].z, mv[q].w};
                const float kka[4] = {kkw[q].x, kkw[q].y, kkw[q].z, kkw[q].w}, kaa[4] = {kaw[q].x, kaw[q].y, kaw[q].z, kaw[q].w}, rka[4] = {rkw[q].x, rkw[q].y, rkw[q].z, rkw[q].w};
                const float aaa[4] = {a4v[q].x, a4v[q].y, a4v[q].z, a4v[q].w}, lwa[4] = {l4v[q].x, l4v[q].y, l4v[q].z, l4v[q].w};
#pragma unroll
                for (int e = 0; e < 4; ++e) { const int i = 4 * q + e;
                    rr[i] = r0a[e] + (rpa[e] - r0a[e]) * mra[e]; const float kx = k0a[e] + (kpa[e] - k0a[e]) * mka[e]; vv[i] = v0a[e] + (vpa[e] - v0a[e]) * mva[e];
                    kkv[i] = kx * kka[e]; ss += kkv[i] * kkv[i]; aa[i] = aaa[e]; lwl[i] = lwa[e]; kf[i] = kx * (1.f + (aaa[e] - 1.f) * kaa[e]); scs += rr[i] * kf[i] * rka[e]; }
            }
        }
        {
            ss += __shfl_xor(ss, 1); ss += __shfl_xor(ss, 2); scs += __shfl_xor(scs, 1); scs += __shfl_xor(scs, 2);
            const float rn = rsqrtf(ss + 1e-6f);
            if (seg == 0) SC[(size_t)t * 16 + h] = scs;
            const int tq = r >> 4;
            unsigned wat[8], wbt[8], wkt[8], wrt[8], wvp[8];
            float atv[16], btv[16], ktv[16], rtv[16];
#pragma unroll
            for (int i = 0; i < 16; ++i) {
                const int ch = c0 + i;
                float off = 0.f;
#pragma unroll
                for (int q = 0; q < 3; ++q) off += (q < tq) ? TOT[q * 64 + ch] : 0.f;
                const float tot = TOT[ch] + TOT[64 + ch] + TOT[128 + ch] + TOT[192 + ch];
                const float cs = AAB[r * 64 + ch] + off;
                const float lwv = lwl[i];
                const float kk = kkv[i] * rn;
                const float e2 = __expf(-cs), e4 = __expf(tot - cs);
                atv[i] = kk * __expf(cs - lwv); btv[i] = -kk * aa[i] * e2; ktv[i] = kf[i] * e2; rtv[i] = rr[i] * __expf(cs);
                VT[ch * 72 + r] = f2bf(vv[i]);
                KDT[ch * 72 + r] = f2bf(kf[i] * e4);
                RA4[(size_t)item * 64 * 64 + frag_off(ch, r, 2)] = f2bf(-kk * aa[i] * e4);
                if (r == 63) RDSC[(size_t)item * 64 + ch] = __expf(tot);
            }
#pragma unroll
            for (int q = 0; q < 8; ++q) { wat[q] = pk2(atv[2 * q], atv[2 * q + 1]); wbt[q] = pk2(btv[2 * q], btv[2 * q + 1]); wkt[q] = pk2(ktv[2 * q], ktv[2 * q + 1]); wrt[q] = pk2(rtv[2 * q], rtv[2 * q + 1]); wvp[q] = pk2(vv[2 * q], vv[2 * q + 1]); }
            *(uint4*)(AT + r * 72 + c0) = make_uint4(wat[0], wat[1], wat[2], wat[3]); *(uint4*)(AT + r * 72 + c0 + 8) = make_uint4(wat[4], wat[5], wat[6], wat[7]);
            *(uint4*)(BTL + r * 72 + c0) = make_uint4(wbt[0], wbt[1], wbt[2], wbt[3]); *(uint4*)(BTL + r * 72 + c0 + 8) = make_uint4(wbt[4], wbt[5], wbt[6], wbt[7]);
            *(uint4*)(KT + r * 72 + c0) = make_uint4(wkt[0], wkt[1], wkt[2], wkt[3]); *(uint4*)(KT + r * 72 + c0 + 8) = make_uint4(wkt[4], wkt[5], wkt[6], wkt[7]);
            *(uint4*)(RT + r * 72 + c0) = make_uint4(wrt[0], wrt[1], wrt[2], wrt[3]); *(uint4*)(RT + r * 72 + c0 + 8) = make_uint4(wrt[4], wrt[5], wrt[6], wrt[7]);
            bf16* a2p = RA2 + (size_t)item * 64 * 64;
            *(uint4*)(a2p + frag_off(r, c0, 2)) = make_uint4(wrt[0], wrt[1], wrt[2], wrt[3]); *(uint4*)(a2p + frag_off(r, c0 + 8, 2)) = make_uint4(wrt[4], wrt[5], wrt[6], wrt[7]);
            bf16* vpp = VP + (size_t)t * 1024 + h * 64 + c0;
            *(uint4*)vpp = make_uint4(wvp[0], wvp[1], wvp[2], wvp[3]); *(uint4*)(vpp + 8) = make_uint4(wvp[4], wvp[5], wvp[6], wvp[7]);
        }
        __syncthreads();
        const int fr = lane & 15, fq = lane >> 4;
        f32x4_t cab[4], cak[4], crb[4], crk[4];
        {
            const int j0t = w4 * 16;
            bf16x8_t bj[2], kj[2];
#pragma unroll
            for (int kb = 0; kb < 2; ++kb) { bj[kb] = *(const bf16x8_t*)(BTL + (j0t + fr) * 72 + kb * 32 + fq * 8); kj[kb] = *(const bf16x8_t*)(KT + (j0t + fr) * 72 + kb * 32 + fq * 8); }
#pragma unroll
            for (int it = 0; it < 4; ++it) {
                cab[it] = (f32x4_t){0.f, 0.f, 0.f, 0.f}; cak[it] = cab[it]; crb[it] = cab[it]; crk[it] = cab[it];
#pragma unroll
                for (int kb = 0; kb < 2; ++kb) {
                    const bf16x8_t ai = *(const bf16x8_t*)(AT + (it * 16 + fr) * 72 + kb * 32 + fq * 8);
                    const bf16x8_t ri = *(const bf16x8_t*)(RT + (it * 16 + fr) * 72 + kb * 32 + fq * 8);
                    cab[it] = MFMA16(bj[kb], ai, cab[it]); cak[it] = MFMA16(kj[kb], ai, cak[it]); crb[it] = MFMA16(bj[kb], ri, crb[it]); crk[it] = MFMA16(kj[kb], ri, crk[it]);
                }
            }
        }
        __syncthreads();
        {
            const int j0 = w4 * 16 + 4 * fq;
#pragma unroll
            for (int it = 0; it < 4; ++it) {
                const int i = it * 16 + fr;
                float vab[4], vak[4], vrb[4], vrk[4];
#pragma unroll
                for (int rg = 0; rg < 4; ++rg) { const int j = j0 + rg; const bool st = i > j, in = i >= j;
                    vab[rg] = st ? cab[it][rg] : 0.f; vak[rg] = st ? cak[it][rg] : 0.f; vrb[rg] = in ? crb[it][rg] : 0.f; vrk[rg] = in ? crk[it][rg] : 0.f; }
                *(float4*)(AAB + i * 64 + j0) = make_float4(vab[0], vab[1], vab[2], vab[3]);
                uint2 w; w.x = pk2(vak[0], vak[1]); w.y = pk2(vak[2], vak[3]); *(uint2*)(AAK + i * 72 + j0) = w;
                w.x = pk2(vrk[0], vrk[1]); w.y = pk2(vrk[2], vrk[3]); *(uint2*)(ARK + i * 72 + j0) = w;
                w.x = pk2(vrb[0], vrb[1]); w.y = pk2(vrb[2], vrb[3]); *(uint2*)(RA3 + (size_t)item * 64 * 64 + frag_off(i, j0, 2)) = w;
            }
        }
        __syncthreads();
        f32x4_t cav[4], cov[4], ckv[4];
        {
            const int r0t = w4 * 16;
            bf16x8_t fa[2], fo[2], fk[2];
#pragma unroll
            for (int kb = 0; kb < 2; ++kb) { fa[kb] = *(const bf16x8_t*)(AAK + (r0t + fr) * 72 + kb * 32 + fq * 8); fo[kb] = *(const bf16x8_t*)(ARK + (r0t + fr) * 72 + kb * 32 + fq * 8); fk[kb] = *(const bf16x8_t*)(KDT + (r0t + fr) * 72 + kb * 32 + fq * 8); }
#pragma unroll
            for (int vt = 0; vt < 4; ++vt) {
                cav[vt] = (f32x4_t){0.f, 0.f, 0.f, 0.f}; cov[vt] = cav[vt]; ckv[vt] = cav[vt];
#pragma unroll
                for (int kb = 0; kb < 2; ++kb) { const bf16x8_t vb = *(const bf16x8_t*)(VT + (vt * 16 + fr) * 72 + kb * 32 + fq * 8);
                    cav[vt] = MFMA16(fa[kb], vb, cav[vt]); cov[vt] = MFMA16(fo[kb], vb, cov[vt]); ckv[vt] = MFMA16(fk[kb], vb, ckv[vt]); }
            }
        }
        __syncthreads();
        {
            const int r0 = w4 * 16 + 4 * fq;
#pragma unroll
            for (int vt = 0; vt < 4; ++vt) {
                const int v = vt * 16 + fr;
#pragma unroll
                for (int rg = 0; rg < 4; ++rg) RHS2[v * 65 + r0 + rg] = cav[vt][rg];
                { uint2 w; w.x = pk2(cov[vt][0], cov[vt][1]); w.y = pk2(cov[vt][2], cov[vt][3]); *(uint2*)(RO0 + (size_t)item * 64 * 64 + cfrag_off(v, r0, 4)) = w; }
                { uint2 w; w.x = pk2(ckv[vt][0], ckv[vt][1]); w.y = pk2(ckv[vt][2], ckv[vt][3]); *(uint2*)(RS0 + (size_t)item * 64 * 64 + cfrag_off(v, r0, 4)) = w; }
            }
        }
        __syncthreads();
        {
            const int col = ht >> 1, p = ht & 1, cc = col & 63; const bool isu = col >= 64;
            float xs[32];
#pragma unroll
            for (int i = 0; i < 32; ++i) xs[i] = 0.f;
            float4 mc[8], mn[8];
#pragma unroll
            for (int q = 0; q < 8; ++q) { mc[q] = make_float4(0.f, 0.f, 0.f, 0.f); mn[q] = mc[q]; }
            float rhs_n; { const float rv = RHS2[(isu ? cc : 0) * 65], av = bf2f(AT[(isu ? 0 : cc)]); rhs_n = isu ? rv : av; }
#pragma unroll
            for (int i = 0; i < 64; ++i) {
                const float rhs = rhs_n;
                if (i + 1 < 64) {
#pragma unroll
                    for (int q = 0; q < (i + 8) / 8; ++q) mn[q] = *(const float4*)(AAB + (i + 1) * 64 + 8 * q + 4 * p);
                    const float rv = RHS2[(isu ? cc : 0) * 65 + i + 1], av = bf2f(AT[(i + 1) * 72 + (isu ? 0 : cc)]); rhs_n = isu ? rv : av;
                }
                float a0 = 0.f, a1 = 0.f, a2 = 0.f, a3 = 0.f;
#pragma unroll
                for (int q = 0; q < (i + 7) / 8; ++q) { a0 += mc[q].x * xs[4 * q]; a1 += mc[q].y * xs[4 * q + 1]; a2 += mc[q].z * xs[4 * q + 2]; a3 += mc[q].w * xs[4 * q + 3]; }
                float tot = (a0 + a1) + (a2 + a3);
                tot += dpp_xor1(tot);
                const float xi = rhs + tot;
                const int g = i >> 2, slot = (g >> 1) * 4 + (i & 3);
                xs[slot] = (p == (g & 1)) ? xi : xs[slot];
#pragma unroll
                for (int q = 0; q < 8; ++q) mc[q] = mn[q];
                asm volatile("" ::: "memory");
            }
            if (isu) {
                bf16* up = RX0 + (size_t)item * 64 * 64;
#pragma unroll
                for (int q = 0; q < 8; ++q) { uint2 w; w.x = pk2(xs[4 * q], xs[4 * q + 1]); w.y = pk2(xs[4 * q + 2], xs[4 * q + 3]); *(uint2*)(up + cfrag_off(cc, 4 * (2 * q + p), 4)) = w; }
            }
            __syncthreads();
            if (!isu) {
#pragma unroll
                for (int q = 0; q < 8; ++q)
#pragma unroll
                    for (int e = 0; e < 4; ++e) AT[(4 * (2 * q + p) + e) * 72 + cc] = f2bf(xs[4 * q + e]);
            }
        }
        __syncthreads();
        {
            bf16* wp = RA1 + (size_t)item * 64 * 64;
#pragma unroll
            for (int q = 0; q < 2; ++q) { const int p = ht + 256 * q, fr = p & 15, fq = (p >> 4) & 3, kb = (p >> 6) & 1, rt = p >> 7;
                *(uint4*)(wp + p * 8) = *(const uint4*)(AT + (rt * 16 + fr) * 72 + kb * 32 + fq * 8); }
        }
    }
}

template <int DK, bool RW>
struct ScanArgs { const bf16* A1; const bf16* X0; const bf16* A2; const bf16* A3; const bf16* O0; const bf16* A4; const bf16* S0; const float* DSC; float* OUT; int item0; int vs; int tok0; int ocol0; };
#define LBAR() do { asm volatile("s_waitcnt lgkmcnt(0)" ::: "memory"); __builtin_amdgcn_s_barrier(); asm volatile("" ::: "memory"); } while (0)
template <int DK, bool RW>
__device__ __forceinline__ void scan_run(const Ctx& c, const ScanArgs<DK, RW>& a) {
    constexpr int KB = DK / 32;
    constexpr int NST = DK / 64;
    constexpr int NV = RW ? 64 : 128;
    constexpr int SROW = DK + 8;
    bf16* ST = (bf16*)c.lds;
    bf16* XT = ST + 2 * 32 * SROW;
    const int lane = c.lane, w = c.wave, fr = lane & 15, fq = lane >> 4;
    const int tm = w >> 1, tn = w & 1;
    const int dkt = (NST == 2) ? w : (w >> 1);
    for (int i = c.tid; i < 32 * SROW / 2; i += NTHREADS) ((unsigned*)ST)[i] = 0u;
    f32x4_t accS[NST];
#pragma unroll
    for (int s = 0; s < NST; ++s) accS[s] = (f32x4_t){0.f, 0.f, 0.f, 0.f};
    bf16x8_t a1f[KB], a2f[KB], a3f[2], a4f[2]; f32x4_t x0v, o0v, s0v[NST], dscv;
#define SCAN_LOAD(IT) do { const size_t it_ = (size_t)(IT); \
        _Pragma("unroll") for (int kb = 0; kb < KB; ++kb) { a1f[kb] = *(const bf16x8_t*)(a.A1 + it_ * 64 * DK + ((tm * KB + kb) * 64 + lane) * 8); a2f[kb] = *(const bf16x8_t*)(a.A2 + it_ * 64 * DK + ((tm * KB + kb) * 64 + lane) * 8); } \
        _Pragma("unroll") for (int kb = 0; kb < 2; ++kb) { a3f[kb] = *(const bf16x8_t*)(a.A3 + it_ * 64 * 64 + ((tm * 2 + kb) * 64 + lane) * 8); a4f[kb] = *(const bf16x8_t*)(a.A4 + it_ * DK * 64 + ((dkt * 2 + kb) * 64 + lane) * 8); } \
        { const uint2 q_ = *(const uint2*)(a.X0 + it_ * NV * 64 + (((a.vs * 2 + tn) * 4 + tm) * 64 + lane) * 4); x0v = (f32x4_t){bflo(q_.x), bfhi(q_.x), bflo(q_.y), bfhi(q_.y)}; } \
        if (RW) { { const uint2 q_ = *(const uint2*)(a.O0 + it_ * NV * 64 + (((a.vs * 2 + tn) * 4 + tm) * 64 + lane) * 4); o0v = (f32x4_t){bflo(q_.x), bfhi(q_.x), bflo(q_.y), bfhi(q_.y)}; } \
                  _Pragma("unroll") for (int s = 0; s < NST; ++s) { const uint2 q_ = *(const uint2*)(a.S0 + it_ * 64 * DK + (((a.vs * 2 + (NST == 2 ? s : tn)) * (DK / 16) + dkt) * 64 + lane) * 4); s0v[s] = (f32x4_t){bflo(q_.x), bfhi(q_.x), bflo(q_.y), bfhi(q_.y)}; } \
                  dscv = *(const f32x4_t*)(a.DSC + it_ * DK + dkt * 16 + 4 * fq); } \
        else { const float g_ = a.DSC[it_]; dscv = (f32x4_t){g_, g_, g_, g_}; o0v = (f32x4_t){0.f, 0.f, 0.f, 0.f}; _Pragma("unroll") for (int s = 0; s < NST; ++s) s0v[s] = (f32x4_t){0.f, 0.f, 0.f, 0.f}; } \
    } while (0)
    SCAN_LOAD(a.item0);
    int cur = 0;
    for (int n = 0; n < 64; ++n) {
        bf16x8_t b1[KB], b2[KB], b3[2], b4[2];
#pragma unroll
        for (int kb = 0; kb < KB; ++kb) { b1[kb] = a1f[kb]; b2[kb] = a2f[kb]; }
        b3[0] = a3f[0]; b3[1] = a3f[1]; b4[0] = a4f[0]; b4[1] = a4f[1];
        f32x4_t accX = x0v, accO = o0v; const f32x4_t dv = dscv; f32x4_t sv[NST];
#pragma unroll
        for (int s = 0; s < NST; ++s) sv[s] = s0v[s];
        if (n + 1 < 64) SCAN_LOAD(a.item0 + n + 1);
        LBAR();
        const bf16* Sc = ST + cur * 32 * SROW; bf16* Sn = ST + (cur ^ 1) * 32 * SROW;
        bf16x8_t sf[KB];
#pragma unroll
        for (int kb = 0; kb < KB; ++kb) sf[kb] = *(const bf16x8_t*)(Sc + (tn * 16 + fr) * SROW + kb * 32 + fq * 8);
#pragma unroll
        for (int kb = 0; kb < KB; ++kb) accX = MFMA16(b1[kb], sf[kb], accX);
        { uint2 wv; wv.x = pk2(accX[0], accX[1]); wv.y = pk2(accX[2], accX[3]); *(uint2*)(XT + (tn * 16 + fr) * 72 + tm * 16 + 4 * fq) = wv; }
#pragma unroll
        for (int kb = 0; kb < KB; ++kb) accO = MFMA16(b2[kb], sf[kb], accO);
        LBAR();
        bf16x8_t xf[2];
#pragma unroll
        for (int kb = 0; kb < 2; ++kb) xf[kb] = *(const bf16x8_t*)(XT + (tn * 16 + fr) * 72 + kb * 32 + fq * 8);
        accO = MFMA16(b3[0], xf[0], accO); accO = MFMA16(b3[1], xf[1], accO);
        {
            float* op = a.OUT + (size_t)(a.tok0 + n * 64 + tm * 16 + 4 * fq) * 1024 + a.ocol0 + tn * 16 + fr;
            op[0] = accO[0]; op[1024] = accO[1]; op[2048] = accO[2]; op[3072] = accO[3];
        }
#pragma unroll
        for (int s = 0; s < NST; ++s) {
            const int vt = (NST == 2) ? s : tn;
            bf16x8_t xg[2];
            if (vt == tn) { xg[0] = xf[0]; xg[1] = xf[1]; }
            else {
#pragma unroll
                for (int kb = 0; kb < 2; ++kb) xg[kb] = *(const bf16x8_t*)(XT + (vt * 16 + fr) * 72 + kb * 32 + fq * 8);
            }
            f32x4_t t = accS[s] * dv + sv[s];
            t = MFMA16(b4[0], xg[0], t); t = MFMA16(b4[1], xg[1], t);
            accS[s] = t;
            uint2 wv; wv.x = pk2(t[0], t[1]); wv.y = pk2(t[2], t[3]);
            *(uint2*)(Sn + (vt * 16 + fr) * SROW + dkt * 16 + 4 * fq) = wv;
        }
        cur ^= 1;
    }
#undef SCAN_LOAD
    __syncthreads();
}

__device__ __forceinline__ void ph_scan(const Ctx& c) {
    for (int wk = blockIdx.x; wk < 256; wk += gridDim.x) {
        const int xcd = wk & 7, j = wk >> 3;
        if (j < 16) {
            const int pair = xcd * 4 + (j >> 2), vs = j & 3, b = pair >> 3, h = pair & 7;
            ScanArgs<128, false> a{c.ws<bf16>(WS_GA1), c.ws<bf16>(WS_GX0), c.ws<bf16>(WS_GA2), c.ws<bf16>(WS_GA3), nullptr, c.ws<bf16>(WS_GA4), nullptr, c.ws<float>(WS_GGL),
                                   c.ws<float>(WS_OG), pair * 64, vs, b * SEQ, h * 128 + vs * 32};
            scan_run<128, false>(c, a);
        } else {
            const int pair = xcd * 8 + ((j - 16) >> 1), vs = (j - 16) & 1, b = pair >> 4, h = pair & 15;
            ScanArgs<64, true> a{c.ws<bf16>(WS_RA1), c.ws<bf16>(WS_RX0), c.ws<bf16>(WS_RA2), c.ws<bf16>(WS_RA3), c.ws<bf16>(WS_RO0), c.ws<bf16>(WS_RA4), c.ws<bf16>(WS_RS0), c.ws<float>(WS_RDSC),
                                 c.ws<float>(WS_ORW), pair * 64, vs, b * SEQ, h * 64 + vs * 32};
            scan_run<64, true>(c, a);
        }
    }
}

enum { PH_RMS0 = 0, PH_INPROJ, PH_GCL, PH_LORA, PH_RCL, PH_SCAN, PH_POST, PH_G2, PH_X1, PH_ROUTER, PH_DISPATCH, PH_MOE1, PH_MOE2, PH_COMBINE, PH_COUNT };

template <unsigned PHMASK>
__global__ void __launch_bounds__(NTHREADS) mk(Params P) {
    extern __shared__ __attribute__((aligned(16))) unsigned char lds[];
    volatile LAS unsigned* misc = (volatile LAS unsigned*)((LAS unsigned char*)lds + MISC_OFF);
    if (threadIdx.x < 64) misc[threadIdx.x] = 0u;
    __syncthreads();
    unsigned* ctl = (unsigned*)(P.ws + WS_CTL);
    XcdBarrier bar = xcd_barrier_post(ctl + CW_BAR + P.li * XCD_BAR_WORDS, misc);
#define MKCTX() int tv_ = threadIdx.x; asm volatile("" : "+v"(tv_)); const int wv_ = __builtin_amdgcn_readfirstlane(tv_ >> 6); \
    Ctx c{P, tv_, tv_ & 63, wv_, (int)(blockIdx.x * NWAVES + wv_), (int)(gridDim.x * NWAVES), (size_t)blockIdx.x * NTHREADS + tv_, (size_t)gridDim.x * NTHREADS, lds}
    bool first_seam = true;
#define IN(k) (((PHMASK >> (k)) & 1u) && P.ph_lo <= (k) && (k) < P.ph_hi)
#define SEAM(k) do { if ((k) + 1 < P.ph_hi) { xcd_barrier(bar); first_seam = false; } } while (0)
#define REP(k) for (int rep_ = 0; rep_ < ((k) == PROBE_REP ? 2 : 1); ++rep_)
    if (IN(PH_RMS0)) { MKCTX();
        REP(PH_RMS0) {
        ph_rms0(c);
        { WJob j{P.in[I_W_IN], NCOL_IN, 1024, 4096, c.ws<bf16>(WS_WIN_T), 1024, 1, 0, 0}; wconv_job(c, j); }
        { WJob j{P.in[I_W_IN] + 4112, NCOL_IN, 1024, 5376, c.ws<bf16>(WS_WIN_T) + (size_t)4096 * 1024, 1024, 1, 0, 0}; wconv_job(c, j); }
        lora_zero(c);
        { WJob j{P.in[I_W2], 1024, 64, 1024, c.ws<bf16>(WS_LORA_T), 256, 1, 0, 0}; wconv_job(c, j); }
        { WJob j{P.in[I_A2], 1024, 64, 1024, c.ws<bf16>(WS_LORA_T) + (size_t)1024 * 256 + 64, 256, 1, 0, 0}; wconv_job(c, j); }
        { WJob j{P.in[I_G2], 1024, 128, 1024, c.ws<bf16>(WS_LORA_T) + (size_t)2048 * 256 + 128, 256, 1, 0, 0}; wconv_job(c, j); }
        }
        SEAM(PH_RMS0);
    }
    if (IN(PH_INPROJ)) { MKCTX();
        REP(PH_INPROJ) {
        EpiInProj ep{c.ws<bf16>(WS_GQKV), c.ws<bf16>(WS_ZS), c.ws<bf16>(WS_RKV), c.ws<float>(WS_LIN), c.ws<bf16>(WS_GATES)};
        SchedInProj sc{(const char*)c.ws<bf16>(WS_HB), (const char*)c.ws<bf16>(WS_WIN_T), (int)gridDim.x, (int)blockIdx.x};
        pg8::gemm_phase((LAS unsigned char*)lds, 1024, sc, ep, c.tid);
        }
        SEAM(PH_INPROJ);
    }
    if (IN(PH_GCL)) { MKCTX(); REP(PH_GCL) { ph_gcl(c); ph_loraprep(c); } SEAM(PH_GCL); }
    if (IN(PH_LORA)) { MKCTX();
        REP(PH_LORA) {
        EpiLora ep{P.in[I_W0], P.in[I_A0], c.ws<float>(WS_LW), c.ws<float>(WS_AA), c.ws<bf16>(WS_GGR)};
        SchedLora sc{(const char*)c.ws<bf16>(WS_ALORA), (const char*)c.ws<bf16>(WS_LORA_T), (int)gridDim.x, (int)blockIdx.x};
        pg8::gemm_phase((LAS unsigned char*)lds, 256, sc, ep, c.tid);
        }
        SEAM(PH_LORA);
    }
    if (IN(PH_RCL)) { MKCTX(); REP(PH_RCL) { ph_rcl(c); } SEAM(PH_RCL); }
    if (IN(PH_SCAN)) { MKCTX(); REP(PH_SCAN) { ph_scan(c); } SEAM(PH_SCAN); }
    if (IN(PH_POST)) { MKCTX();
        REP(PH_POST) {
        ph_post(c);
        { WJob j{P.in[I_PROJ_A], 1024, 1024, 1024, c.ws<bf16>(WS_PROJ_T), 1024, 1, 0, 0}; wconv_job(c, j); }
        { WJob j{P.in[I_PROJ_B], 1024, 1024, 1024, c.ws<bf16>(WS_PROJ_T) + (size_t)1024 * 1024, 1024, 1, 0, 0}; wconv_job(c, j); }
        { WJob j{P.in[I_W_OUT], 1024, 1024, 1024, c.ws<bf16>(WS_WOUT_T), 1024, 1, 0, 0}; wconv_job(c, j); }
        }
        SEAM(PH_POST);
    }
    if (IN(PH_G2)) { MKCTX();
        REP(PH_G2) {
        EpiG2 ep{c.ws<bf16>(WS_GATES), c.ws<bf16>(WS_G2)};
        SchedG2 sc{(const char*)c.ws<bf16>(WS_YA), (const char*)c.ws<bf16>(WS_PROJ_T), (int)gridDim.x, (int)blockIdx.x};
        pg8::gemm_phase((LAS unsigned char*)lds, 1024, sc, ep, c.tid);
        }
        SEAM(PH_G2);
    }
    if (IN(PH_X1)) { MKCTX();
        REP(PH_X1) {
        EpiX1 ep{P.in[I_X], c.ws<float>(WS_X1)};
        SchedX1 sc{(const char*)c.ws<bf16>(WS_G2), (const char*)c.ws<bf16>(WS_WOUT_T), (int)gridDim.x, (int)blockIdx.x};
        pg8::gemm_phase((LAS unsigned char*)lds, 1024, sc, ep, c.tid);
        }
        SEAM(PH_X1);
    }
    if (IN(PH_ROUTER)) { MKCTX();
        ph_router(c);
        REP(PH_ROUTER) {
        { WJob j{P.in[I_W_GU], 2048, 1024, 2048, c.ws<bf16>(WS_WGU_T), 1024, 32, (size_t)1024 * 2048, (size_t)2048 * 1024}; wconv_job(c, j); }
        { WJob j{P.in[I_W_DOWN], 1024, 1024, 1024, c.ws<bf16>(WS_WDN_T), 1024, 32, (size_t)1024 * 1024, (size_t)1024 * 1024}; wconv_job(c, j); }
        }
        SEAM(PH_ROUTER);
    }
    if (IN(PH_DISPATCH)) { MKCTX(); REP(PH_DISPATCH) { ph_dispatch(c); } SEAM(PH_DISPATCH); }
    if (IN(PH_MOE1)) { MKCTX();
        REP(PH_MOE1) {
        const int nt = *c.ws<int>(WS_NT);
        EpiAct ep{P.in[I_B_GU], c.ws<bf16>(WS_ACT)};
        SchedMoe sc{(const char*)c.ws<bf16>(WS_H2), (const char*)c.ws<bf16>(WS_WGU_T), c.ws<int>(WS_TILE_E), c.ws<int>(WS_SLOT_TOK), nt, 8, (int)gridDim.x, (int)blockIdx.x};
        pg8::gemm_phase_t<true>((LAS unsigned char*)lds, 1024, sc, ep, c.tid);
        }
        SEAM(PH_MOE1);
    }
    if (IN(PH_MOE2)) { MKCTX();
        REP(PH_MOE2) {
        const int nt = *c.ws<int>(WS_NT);
        EpiYS ep{P.in[I_B_DOWN], c.ws<float>(WS_SGATE), c.ws<bf16>(WS_YS)};
        SchedMoe sc{(const char*)c.ws<bf16>(WS_ACT), (const char*)c.ws<bf16>(WS_WDN_T), c.ws<int>(WS_TILE_E), nullptr, nt, 4, (int)gridDim.x, (int)blockIdx.x};
        pg8::gemm_phase((LAS unsigned char*)lds, 1024, sc, ep, c.tid);
        }
        SEAM(PH_MOE2);
    }
    if (IN(PH_COMBINE)) { MKCTX(); REP(PH_COMBINE) { ph_combine(c); } }
#undef IN
#undef SEAM
#undef REP
#undef MKCTX
}

template <unsigned M> static void launch_one(const Params& p, int grid, hipStream_t stream) {
    static bool attr = false;
    if (!attr) { (void)hipFuncSetAttribute((const void*)mk<M>, hipFuncAttributeMaxDynamicSharedMemorySize, LDS_BYTES); attr = true; }
    hipLaunchKernelGGL(mk<M>, dim3(grid), dim3(NTHREADS), LDS_BYTES, stream, p);
}
template <int PH> static void launch_chain(Params& p, int grid, hipStream_t stream) {
    if constexpr (PH < PH_COUNT) { p.ph_lo = PH; p.ph_hi = PH + 1; p.li = 0; p.coop = 0; launch_one<(1u << PH)>(p, grid, stream); launch_chain<PH + 1>(p, grid, stream); }
}

extern "C" void kernel_launch(void* const* d_in, const int* in_sizes, int n_in, void* d_out, int out_size, void* d_ws, size_t ws_size, hipStream_t stream) {
    static int grid = 0;
    if (grid == 0) {
        int dev = 0, cus = 0, per_cu = 0;
        (void)hipGetDevice(&dev);
        (void)hipDeviceGetAttribute(&cus, hipDeviceAttributeMultiprocessorCount, dev);
#if MK_ONE_LAUNCH
        (void)hipFuncSetAttribute((const void*)mk<0xffffffffu>, hipFuncAttributeMaxDynamicSharedMemorySize, LDS_BYTES);
        (void)hipOccupancyMaxActiveBlocksPerMultiprocessor(&per_cu, (const void*)mk<0xffffffffu>, NTHREADS, LDS_BYTES);
#else
        per_cu = 1;
#endif
        if (n_in != 29 || ws_size < WS_END || per_cu < 1 || cus < 64) { fprintf(stderr, "kernel_launch: unexpected setup n_in %d ws %zu per_cu %d cus %d\n", n_in, ws_size, per_cu, cus); grid = -1; return; }
        grid = cus;
    }
    if (grid < 0) return;
    (void)hipMemsetAsync((char*)d_ws + WS_CTL, 0, CTL_BYTES, stream);
    Params p{};
    for (int i = 0; i < 29; ++i) p.in[i] = (const float*)d_in[i];
    p.out = (float*)d_out; p.ws = (unsigned char*)d_ws;
#if MK_ONE_LAUNCH
    p.ph_lo = 0; p.ph_hi = PH_COUNT; p.li = 0; p.coop = 1;
    void* args[] = {&p};
    hipError_t e = hipLaunchCooperativeKernel((const void*)mk<0xffffffffu>, dim3(grid), dim3(NTHREADS), args, LDS_BYTES, stream);
    if (e != hipSuccess) fprintf(stderr, "cooperative launch failed: %s (grid %d)\n", hipGetErrorString(e), grid);
#else
    launch_chain<0>(p, grid, stream);
#endif
}
```

```cpp
#include <hip/hip_runtime.h>
#include <hip/hip_cooperative_groups.h>
#include <cstdint>
#include <cstdio>
namespace cg = cooperative_groups;

#ifndef MK_ONE_LAUNCH
#define MK_ONE_LAUNCH 1
#endif

#define LAS __attribute__((address_space(3)))
#ifndef FAST_INPROJ
#define FAST_INPROJ 1
#endif
#ifndef FAST_MIX
#define FAST_MIX 1
#endif
#define TS_BEGIN -1
#define TS_END -1
#define PROBE_REP -1
constexpr int NTHREADS = 512;
constexpr int NWAVES = 8;
constexpr int LDS_BYTES = 155648;
constexpr int MISC_OFF = 153600;

constexpr int T = 16384, SEQ = 4096, D = 1024;
constexpr int NCOL_IN = 9488;
constexpr int NEXP = 32;
constexpr int MAXTILES = 288;
constexpr int MAXSLOTS = MAXTILES * 256;

enum { I_X = 0, I_NORM_MIX, I_W_IN, I_GDN_CONV, I_GDN_ALOG, I_GDN_DTB, I_GDN_NORM, I_MU, I_W0, I_W2, I_A0, I_A2, I_G2, I_KK, I_KA, I_RK,
       I_LNW, I_LNB, I_PROJ_A, I_PROJ_B, I_W_OUT, I_NORM_FFN, I_ROUTER_W, I_ROUTER_B, I_W_GU, I_B_GU, I_W_DOWN, I_B_DOWN, I_NORM_FINAL };

constexpr size_t MiB = 1u << 20;
constexpr size_t WS_CTL = 0, CTL_BYTES = 65536;
constexpr size_t WS_BETA = 1 * MiB;
constexpr size_t WS_GG = WS_BETA + 512 * 1024;
constexpr size_t WS_SC = 2 * MiB;
constexpr size_t WS_TE = 3 * MiB;
constexpr size_t WS_TG = WS_TE + 256 * 1024;
constexpr size_t WS_TP = WS_TG + 256 * 1024;
constexpr size_t WS_TSLOT = WS_TP + 256 * 1024;
constexpr size_t WS_SGATE = 4 * MiB;
constexpr size_t WS_SLOT_TOK = 4 * MiB + 512 * 1024;
constexpr size_t WS_TILE_E = 5 * MiB;
constexpr size_t WS_NT = WS_TILE_E + 4096;
constexpr size_t WS_HB = 8 * MiB;
constexpr size_t WS_H2 = WS_HB;
constexpr size_t WS_ZS = 40 * MiB;
constexpr size_t WS_GATES = 72 * MiB;
constexpr size_t WS_ALORA = 136 * MiB;
constexpr size_t WS_LW = 144 * MiB;
constexpr size_t WS_AA = 208 * MiB;
constexpr size_t WS_GGR = 272 * MiB;
constexpr size_t WS_VP = 304 * MiB;
constexpr size_t WS_Q = 336 * MiB;
constexpr size_t WS_QKVC = WS_Q;
constexpr size_t WS_RP = WS_Q, WS_KF = WS_Q + 64 * MiB, WS_KKN = WS_Q + 128 * MiB;
constexpr size_t WS_YA = WS_Q, WS_YB = WS_Q + 32 * MiB, WS_G2 = WS_Q + 64 * MiB, WS_X1 = WS_Q + 128 * MiB;
constexpr size_t WS_GQKV = 528 * MiB;
constexpr size_t WS_OG = 720 * MiB, WS_ORW = 784 * MiB;
constexpr size_t WS_RKV = 720 * MiB;
constexpr size_t WS_LIN = 912 * MiB;
constexpr size_t WS_DEC = 928 * MiB;
constexpr size_t WS_XB = 528 * MiB;
constexpr size_t WS_ACT = 672 * MiB;
constexpr size_t WS_YS = 816 * MiB;
constexpr size_t WS_WIN_T = 992 * MiB;
constexpr size_t WS_PROJ_T = 144 * MiB;
constexpr size_t WS_WOUT_T = 148 * MiB;
constexpr size_t WS_WGU_T = 72 * MiB;
constexpr size_t WS_WDN_T = 200 * MiB;
constexpr size_t WS_GA1 = 336 * MiB, WS_GX0 = 368 * MiB, WS_GA2 = 432 * MiB, WS_GA3 = 464 * MiB, WS_GA4 = 480 * MiB;
constexpr size_t WS_GGL = 6 * MiB;
constexpr size_t WS_RX0 = 528 * MiB, WS_RO0 = 592 * MiB, WS_RS0 = 656 * MiB;
constexpr size_t WS_RA1 = 8 * MiB, WS_RA2 = 928 * MiB, WS_RA3 = 960 * MiB, WS_RA4 = 992 * MiB;
constexpr size_t WS_RDSC = 7 * MiB;
constexpr size_t WS_LORA_T = 1012 * MiB;
constexpr size_t WS_END = 1024 * MiB;
constexpr int CW_BAR = 1024;
constexpr int CW_CNT = 256;
constexpr int CW_TS = 900;

#define XB_TMO      128
#define XB_XCNT(j)  (256  + 64 * (j))
#define XB_XSUB(j)  (1280 + 64 * (j))
#define XB_XGEN(j)  (2304 + 64 * (j))
#define XB_TOP      3328
#define XB_TOPGEN   3392
#define XCD_BAR_WORDS 3456
#define XB_SPIN_CAP (1u << 24)
__device__ __forceinline__ unsigned xb_ld(unsigned* p)              { return __hip_atomic_load(p, __ATOMIC_RELAXED, __HIP_MEMORY_SCOPE_AGENT); }
__device__ __forceinline__ unsigned xb_add(unsigned* p, unsigned v) { return __hip_atomic_fetch_add(p, v, __ATOMIC_RELAXED, __HIP_MEMORY_SCOPE_AGENT); }
__device__ __forceinline__ unsigned xb_xcc_id() { return (unsigned)__builtin_amdgcn_s_getreg((3 << 11) | 20) & 0xFu; }
#define XB_SPIN(cond, bar) do { unsigned _sp = 0; while (cond) { __builtin_amdgcn_s_sleep(1); \
    if ((++_sp & 255u) == 0u) { if (xb_ld(&(bar)[XB_TMO])) break; if (_sp > XB_SPIN_CAP) { atomicAdd(&(bar)[XB_TMO], 1u); break; } } } } while (0)
struct XcdBarrier { unsigned* bar; unsigned x; volatile LAS unsigned* st; };
__device__ __forceinline__ XcdBarrier xcd_barrier_post(unsigned* bar, volatile LAS unsigned* st) {
    XcdBarrier b; b.bar = bar; b.x = xb_xcc_id(); b.st = st;
    if (threadIdx.x == 0) (void)xb_add(&bar[XB_XCNT(b.x)], 1u);
    return b;
}
__device__ __forceinline__ void xcd_barrier_complete(unsigned* bar, unsigned x, unsigned& nloc, unsigned& nx) {
    const unsigned G = gridDim.x * gridDim.y * gridDim.z;
    unsigned sum, cnt, mine, sp = 0u;
    for (;;) {
        sum = 0u; cnt = 0u; mine = 0u;
#pragma unroll
        for (unsigned j = 0; j < 16; ++j) { const unsigned c = xb_ld(&bar[XB_XCNT(j)]); sum += c; cnt += (c > 0u) ? 1u : 0u; mine = (j == x) ? c : mine; }
        if (sum == G) break;
        __builtin_amdgcn_s_sleep(1);
        if ((++sp & 255u) == 0u) { if (xb_ld(&bar[XB_TMO])) break; if (sp > XB_SPIN_CAP) { atomicAdd(&bar[XB_TMO], 1u); break; } }
    }
    nloc = mine > 0u ? mine : 1u; nx = cnt > 0u ? cnt : 1u;
}
__device__ __forceinline__ void xcd_barrier(const XcdBarrier& b) {
    asm volatile("s_waitcnt vmcnt(0)" ::: "memory");
    __syncthreads();
    if (threadIdx.x == 0) {
        unsigned* bar = b.bar;
        __builtin_amdgcn_s_waitcnt(0);
        unsigned nloc = b.st[0], nx = b.st[1];
        if (nloc == 0u) { xcd_barrier_complete(bar, b.x, nloc, nx); b.st[0] = nloc; b.st[1] = nx; }
        const unsigned old = xb_add(&bar[XB_XSUB(b.x)], 1u);
        const unsigned gen = old / nloc;
        if (old + 1u == (gen + 1u) * nloc) {
            __builtin_amdgcn_fence(__ATOMIC_RELEASE, "agent");
            asm volatile("s_waitcnt vmcnt(0)" ::: "memory");
            const unsigned og = xb_add(&bar[XB_TOP], 1u);
            const unsigned tg = og / nx;
            if (og + 1u == (tg + 1u) * nx) xb_add(&bar[XB_TOPGEN], 1u);
            else XB_SPIN(xb_ld(&bar[XB_TOPGEN]) == tg, bar);
            __builtin_amdgcn_fence(__ATOMIC_ACQUIRE, "agent");
            xb_add(&bar[XB_XGEN(b.x)], 1u);
            asm volatile("s_waitcnt vmcnt(0)" ::: "memory");
        } else {
            XB_SPIN(xb_ld(&bar[XB_XGEN(b.x)]) == gen, bar);
            __builtin_amdgcn_fence(__ATOMIC_ACQUIRE, "agent");
            asm volatile("s_waitcnt vmcnt(0)" ::: "memory");
        }
    }
    __syncthreads();
}

typedef unsigned short bf16;
__device__ __forceinline__ bf16 f2bf(float f) { unsigned u = __float_as_uint(f); u += 0x7fffu + ((u >> 16) & 1u); return (bf16)(u >> 16); }
__device__ __forceinline__ float bf2f(unsigned b) { return __uint_as_float(b << 16); }
__device__ __forceinline__ unsigned pk2(float lo, float hi) { return (unsigned)f2bf(lo) | ((unsigned)f2bf(hi) << 16); }
__device__ __forceinline__ float bflo(unsigned w) { return __uint_as_float(w << 16); }
__device__ __forceinline__ float bfhi(unsigned w) { return __uint_as_float(w & 0xffff0000u); }
__device__ __forceinline__ float sigm(float x) { return 1.f / (1.f + expf(-x)); }
__device__ __forceinline__ float fsigm(float x) { return __builtin_amdgcn_rcpf(1.f + __expf(-x)); }
__device__ __forceinline__ float softplusf(float x) { return x > 20.f ? x : log1pf(expf(x)); }
__device__ __forceinline__ float dpp_xor1(float v) { return __int_as_float(__builtin_amdgcn_update_dpp(0, __float_as_int(v), 0xB1, 0xF, 0xF, false)); }
__device__ __forceinline__ float wsum(float v) {
#pragma unroll
    for (int o = 32; o > 0; o >>= 1) v += __shfl_xor(v, o);
    return v;
}

struct Params { const float* in[29]; float* out; unsigned char* ws; int ph_lo, ph_hi, li, coop; };

struct Ctx {
    const Params& P; int tid, lane, wave, gwave, nwaves; size_t gtid, nthreads; unsigned char* lds;
    template <class Tp> __device__ __forceinline__ Tp* ws(size_t off) const { return (Tp*)(P.ws + off); }
};

__device__ __forceinline__ void ph_rms0(const Ctx& c) {
    const float* x = c.P.in[I_X]; const float* nw = c.P.in[I_NORM_MIX]; const float* win = c.P.in[I_W_IN];
    const float* alog = c.P.in[I_GDN_ALOG]; const float* dtb = c.P.in[I_GDN_DTB];
    bf16* HB = c.ws<bf16>(WS_HB); float* BETA = c.ws<float>(WS_BETA); float* GGv = c.ws<float>(WS_GG);
    if (blockIdx.x == 0 && c.tid < NEXP) c.ws<unsigned>(WS_CTL)[CW_CNT + c.tid] = 0u;
    float4* tab = (float4*)c.lds;
    __syncthreads();
    for (int i = c.tid; i < 4096; i += NTHREADS) { const int k = i >> 2; tab[((k & 3) * 256 + (k >> 2)) * 5 + (i & 3)] = *(const float4*)(win + (size_t)k * NCOL_IN + 4096 + (i & 3) * 4); }
    __syncthreads();
    const int lane = c.lane;
    for (int t = c.gwave; t < T; t += c.nwaves) {
        float4 v[4]; float ss = 0.f;
#pragma unroll
        for (int i = 0; i < 4; ++i) { v[i] = ((const float4*)(x + (size_t)t * D))[lane + 64 * i]; ss += v[i].x * v[i].x + v[i].y * v[i].y + v[i].z * v[i].z + v[i].w * v[i].w; }
        ss = wsum(ss);
        const float rstd = rsqrtf(ss * (1.f / 1024.f) + 1e-6f);
        float acc[16];
#pragma unroll
        for (int j = 0; j < 16; ++j) acc[j] = 0.f;
#pragma unroll
        for (int i = 0; i < 4; ++i) {
            const float4 w4 = ((const float4*)nw)[lane + 64 * i];
            float h[4] = {v[i].x * rstd * w4.x, v[i].y * rstd * w4.y, v[i].z * rstd * w4.z, v[i].w * rstd * w4.w};
            uint2 st; st.x = pk2(h[0], h[1]); st.y = pk2(h[2], h[3]);
            *(uint2*)(HB + (size_t)t * D + 4 * (lane + 64 * i)) = st;
#pragma unroll
            for (int ii = 0; ii < 4; ++ii) {
                const int k = 4 * (lane + 64 * i) + ii;
#pragma unroll
                for (int q = 0; q < 4; ++q) { const float4 w = tab[(ii * 256 + (k >> 2)) * 5 + q]; acc[4 * q + 0] += h[ii] * w.x; acc[4 * q + 1] += h[ii] * w.y; acc[4 * q + 2] += h[ii] * w.z; acc[4 * q + 3] += h[ii] * w.w; }
                if (ii & 1) asm volatile("" ::: "memory");
            }
        }
        float mine = 0.f;
#pragma unroll
        for (int j = 0; j < 16; ++j) { const float s = wsum(acc[j]); mine = (lane == j) ? s : mine; }
        if (lane < 8) BETA[t * 8 + lane] = sigm(mine);
        else if (lane < 16) { const int h = lane - 8; GGv[t * 8 + h] = -expf(alog[h]) * softplusf(mine + dtb[h]); }
    }
    __syncthreads();
}

struct NoLd {};
struct EpiInProj {
    typedef NoLd Ld; static constexpr int MB = 1;
    bf16* GQKV; bf16* ZS; bf16* RKV; float* LIN; bf16* GATES;
    __device__ __forceinline__ void load(Ld&, int, int, int) const {}
    __device__ __forceinline__ void store8(int row, int col, const float (&v)[8], int, const Ld&) const {
        if (col < 3072) { uint4 w; w.x = pk2(v[0], v[1]); w.y = pk2(v[2], v[3]); w.z = pk2(v[4], v[5]); w.w = pk2(v[6], v[7]); *(uint4*)(GQKV + (size_t)row * 3072 + col) = w; }
        else if (col < 4096) { uint4 w; w.x = pk2(v[0] * fsigm(v[0]), v[1] * fsigm(v[1])); w.y = pk2(v[2] * fsigm(v[2]), v[3] * fsigm(v[3])); w.z = pk2(v[4] * fsigm(v[4]), v[5] * fsigm(v[5])); w.w = pk2(v[6] * fsigm(v[6]), v[7] * fsigm(v[7]));
            *(uint4*)(ZS + (size_t)row * 1024 + (col - 3072)) = w; }
        else if (col < 7168) { uint4 w; w.x = pk2(v[0], v[1]); w.y = pk2(v[2], v[3]); w.z = pk2(v[4], v[5]); w.w = pk2(v[6], v[7]); *(uint4*)(RKV + (size_t)row * 3072 + (col - 4096)) = w; }
        else if (col < 7424) { float* p = LIN + (size_t)row * 256 + (col - 7168); *(float4*)p = make_float4(v[0], v[1], v[2], v[3]); *(float4*)(p + 4) = make_float4(v[4], v[5], v[6], v[7]); }
        else { uint4 w; w.x = pk2(fsigm(v[0]), fsigm(v[1])); w.y = pk2(fsigm(v[2]), fsigm(v[3])); w.z = pk2(fsigm(v[4]), fsigm(v[5])); w.w = pk2(fsigm(v[6]), fsigm(v[7]));
            *(uint4*)(GATES + (size_t)row * 2048 + (col - 7424)) = w; }
    }
};
struct EpiG2 {
    struct Ld { uint4 g; uint4 p; }; static constexpr int MB = 1;
    const bf16* GATES; bf16* MG;
    __device__ __forceinline__ void load(Ld& l, int row, int col, int) const { l.g = *(const uint4*)(GATES + (size_t)row * 2048 + col); const uint4 q = *(const uint4*)(MG + (size_t)row * 1024 + (col & 1023)); const bool b = col >= 1024; l.p = make_uint4(b ? q.x : 0u, b ? q.y : 0u, b ? q.z : 0u, b ? q.w : 0u); }
    __device__ __forceinline__ void store8(int row, int col, const float (&v)[8], int, const Ld& l) const {
        const uint4 g = l.g, p = l.p;
        uint4 w; w.x = pk2(v[0] * bflo(g.x) + bflo(p.x), v[1] * bfhi(g.x) + bfhi(p.x)); w.y = pk2(v[2] * bflo(g.y) + bflo(p.y), v[3] * bfhi(g.y) + bfhi(p.y));
        w.z = pk2(v[4] * bflo(g.z) + bflo(p.z), v[5] * bfhi(g.z) + bfhi(p.z)); w.w = pk2(v[6] * bflo(g.w) + bflo(p.w), v[7] * bfhi(g.w) + bfhi(p.w));
        *(uint4*)(MG + (size_t)row * 1024 + (col & 1023)) = w;
    }
};
struct EpiX1 {
    struct Ld { float4 a, b; }; static constexpr int MB = 2;
    const float* X; float* X1;
    __device__ __forceinline__ void load(Ld& l, int row, int col, int) const { const float* xp = X + (size_t)row * 1024 + col; l.a = *(const float4*)xp; l.b = *(const float4*)(xp + 4); }
    __device__ __forceinline__ void store8(int row, int col, const float (&v)[8], int, const Ld& l) const {
        float* op = X1 + (size_t)row * 1024 + col;
        const float4 a = l.a, b = l.b;
        *(float4*)op = make_float4(a.x + v[0], a.y + v[1], a.z + v[2], a.w + v[3]); *(float4*)(op + 4) = make_float4(b.x + v[4], b.y + v[5], b.z + v[6], b.w + v[7]);
    }
};
struct EpiAct {
    struct Ld { float4 b0, b1; }; static constexpr int MB = 4;
    const float* BGU; bf16* ACT;
    __device__ __forceinline__ void load(Ld& l, int, int col, int e) const { const float* bp = BGU + (size_t)e * 2048 + col; l.b0 = *(const float4*)bp; l.b1 = *(const float4*)(bp + 4); }
    __device__ __forceinline__ void store8(int row, int col, const float (&v)[8], int e, const Ld& l) const {
        const float4 b0 = l.b0, b1 = l.b1;
        const float bb[8] = {b0.x, b0.y, b0.z, b0.w, b1.x, b1.y, b1.z, b1.w};
        float o[4];
#pragma unroll
        for (int p = 0; p < 4; ++p) { float glu = v[2 * p] + bb[2 * p], lin = v[2 * p + 1] + bb[2 * p + 1]; glu = fminf(glu, 7.f); lin = fminf(fmaxf(lin, -7.f), 7.f); o[p] = glu * fsigm(1.702f * glu) * (lin + 1.f); }
        uint2 w; w.x = pk2(o[0], o[1]); w.y = pk2(o[2], o[3]);
        *(uint2*)(ACT + (size_t)row * 1024 + (col >> 1)) = w;
    }
};
struct EpiYS {
    struct Ld { float4 b0, b1; float g; }; static constexpr int MB = 4;
    const float* BD; const float* SGATE; bf16* YS;
    __device__ __forceinline__ void load(Ld& l, int row, int col, int e) const { const float* bp = BD + (size_t)e * 1024 + col; l.g = SGATE[row]; l.b0 = *(const float4*)bp; l.b1 = *(const float4*)(bp + 4); }
    __device__ __forceinline__ void store8(int row, int col, const float (&v)[8], int e, const Ld& l) const {
        const float g = l.g; const float4 b0 = l.b0, b1 = l.b1;
        uint4 w; w.x = pk2((v[0] + b0.x) * g, (v[1] + b0.y) * g); w.y = pk2((v[2] + b0.z) * g, (v[3] + b0.w) * g); w.z = pk2((v[4] + b1.x) * g, (v[5] + b1.y) * g); w.w = pk2((v[6] + b1.z) * g, (v[7] + b1.w) * g);
        *(uint4*)(YS + (size_t)row * 1024 + col) = w;
    }
};


namespace pg8 {
typedef short bf16x8 __attribute__((ext_vector_type(8)));
typedef float f32x4 __attribute__((ext_vector_type(4)));
constexpr int BM = 256, BK = 64, HALF = 128, HTB = HALF * BK * 2, NXCD = 8, WGM = 8;
__host__ __device__ __forceinline__ int lds_byte(int r, int c) { const int st = (r >> 4) * 2 + (c >> 5), rr = r & 15, cc = c & 31, ob = rr * 64 + cc * 2; return st * 1024 + (ob ^ (((ob >> 9) & 1) << 5)); }
__host__ __device__ __forceinline__ void stage_rc(int b, int& R, int& C) { const int st = b / 1024, sb = b % 1024, swz = sb ^ (((sb >> 9) & 1) << 5); R = (st >> 1) * 16 + swz / 64; C = (st & 1) * 32 + (swz % 64) / 2; }
__host__ __device__ __forceinline__ int perm32(int rho) { const int n = rho >> 4, i = rho & 15; return 8 * (i >> 2) + 4 * n + (i & 3); }
struct Unit { const char* a; const char* b; const int* rowmap; int row0, col0, aux; };
__device__ __forceinline__ void tile_order(int L, int nM, int nN, int& pm, int& pn) {
    const int nwg = nM * nN; int wgid = L; { const int q = nwg / NXCD, r = nwg % NXCD, xcd = wgid % NXCD, off = wgid / NXCD; wgid = (xcd < r ? xcd * (q + 1) : r * (q + 1) + (xcd - r) * q) + off; }
    const int nig = WGM * nN, gid = wgid / nig, fm = gid * WGM, gsz = (nM - fm) < WGM ? (nM - fm) : WGM;
    pm = fm + ((wgid % nig) % gsz); pn = (wgid % nig) / gsz;
}
template <class Epi>
__device__ __forceinline__ void epi_apply(const Epi& E, const f32x4 (&acc)[2][2][4][2], const Unit& u, int wr, int wc, int fr, int fq) {
    constexpr int MB = Epi::MB;
#pragma unroll
    for (int ai = 0; ai < 2; ++ai)
#pragma unroll
        for (int mp = 0; mp < 4 / MB; ++mp) {
            typename Epi::Ld ld[MB][2];
#pragma unroll
            for (int mm = 0; mm < MB; ++mm)
#pragma unroll
                for (int bj = 0; bj < 2; ++bj) E.load(ld[mm][bj], u.row0 + ai * HALF + wr * 64 + (mp * MB + mm) * 16 + fr, u.col0 + bj * HALF + wc * 32 + 8 * fq, u.aux);
#pragma unroll
            for (int mm = 0; mm < MB; ++mm)
#pragma unroll
                for (int bj = 0; bj < 2; ++bj) {
                    const int m = mp * MB + mm;
                    const f32x4 x0 = acc[ai][bj][m][0], x1 = acc[ai][bj][m][1];
                    const float v[8] = {x0[0], x0[1], x0[2], x0[3], x1[0], x1[1], x1[2], x1[3]};
                    E.store8(u.row0 + ai * HALF + wr * 64 + m * 16 + fr, u.col0 + bj * HALF + wc * 32 + 8 * fq, v, u.aux, ld[mm][bj]);
                }
            asm volatile("" ::: "memory");
        }
}
template <bool GATHER, class Epi, class Sched>
__device__ __forceinline__ void gemm_phase_t(LAS unsigned char* lds, const int K_, const Sched& S, const Epi& E, const int tid) {
    int K = K_; asm volatile("" : "+s"(K));
    const int wid = __builtin_amdgcn_readfirstlane(tid >> 6), lane = tid & 63, wr = wid >> 2, wc = wid & 3, fr = lane & 15, fq = lane >> 4;
    const int nt = K / BK;
    unsigned voffA[2], voffB[2];
#pragma unroll
    for (int i = 0; i < 2; ++i) { int R, C; stage_rc(tid * 16 + i * 8192, R, C); const int Rb = (R & ~31) + perm32(R & 31);
        voffA[i] = (unsigned)(R * K + C) * 2u; voffB[i] = (unsigned)(Rb * K + C) * 2u; }
    const size_t kstep = (size_t)(BK * 2);
    const size_t hstep = (size_t)HALF * K * 2;
    const unsigned ldsw = (unsigned)wid * 1024u;
    const int aoff = lds_byte(wr * 64 + fr, fq * 8), boff = lds_byte(wc * 32 + fr, fq * 8);
#define PG8_SA(b, h) (((b) * 2 + (h)) * HTB)
#define PG8_SB(b, h) ((4 + (b) * 2 + (h)) * HTB)
#define PG8_STAGE(bufoff, gbase, voff) do { _Pragma("unroll") for (int _i = 0; _i < 2; ++_i) \
        __builtin_amdgcn_global_load_lds((const unsigned*)((const char*)(gbase) + (voff)[_i]), (LAS unsigned*)(lds + (bufoff) + ldsw + _i * 8192), 16, 0, 0); } while (0)
#define PG8_LDA(dst, b, h) do { _Pragma("unroll") for (int m = 0; m < 4; ++m) _Pragma("unroll") for (int k = 0; k < 2; ++k) dst[m][k] = *(const LAS bf16x8*)(lds + PG8_SA(b, h) + aoff + m * 2048 + k * 1024); } while (0)
#define PG8_LDB(dst, b, h) do { _Pragma("unroll") for (int n = 0; n < 2; ++n) _Pragma("unroll") for (int k = 0; k < 2; ++k) dst[n][k] = *(const LAS bf16x8*)(lds + PG8_SB(b, h) + boff + n * 2048 + k * 1024); } while (0)
#define PG8_MMA(ai, bj, At, Bt) do { __builtin_amdgcn_s_setprio(1); _Pragma("unroll") for (int m = 0; m < 4; ++m) _Pragma("unroll") for (int n = 0; n < 2; ++n) _Pragma("unroll") for (int k = 0; k < 2; ++k) \
        acc[ai][bj][m][n] = __builtin_amdgcn_mfma_f32_16x16x32_bf16(Bt[n][k], At[m][k], acc[ai][bj][m][n], 0, 0, 0); __builtin_amdgcn_s_setprio(0); } while (0)
#define PG8_WAIT_V(n) asm volatile("s_waitcnt vmcnt(" #n ")" ::: "memory")
#define PG8_WAIT_L(n) asm volatile("s_waitcnt lgkmcnt(" #n ")" ::: "memory")
#define PG8_BAR __builtin_amdgcn_s_barrier()
#define PG8_SCHED __builtin_amdgcn_sched_barrier(0)
    Unit cur, nxt; int ui = 0;
    if (!S.next(0, cur)) return;
    f32x4 acc[2][2][4][2];
#pragma unroll
    for (int a = 0; a < 2; ++a)
#pragma unroll
        for (int b = 0; b < 2; ++b)
#pragma unroll
            for (int m = 0; m < 4; ++m)
#pragma unroll
                for (int n = 0; n < 2; ++n) acc[a][b][m][n] = (f32x4){0.f, 0.f, 0.f, 0.f};
    bf16x8 At[4][2], B0[2][2], B1[2][2];
    const char* cA = cur.a; const char* cB = cur.b;
    unsigned oc_lo[2] = {0u, 0u}, oc_hi[2] = {0u, 0u}, on_lo[2] = {0u, 0u}, on_hi[2] = {0u, 0u};
#define PG8_ROWOFF(U, LO, HI) do { _Pragma("unroll") for (int _i = 0; _i < 2; ++_i) { int R_, C_; stage_rc(tid * 16 + _i * 8192, R_, C_); \
        LO[_i] = (unsigned)((U).rowmap[R_] * K + C_) * 2u; HI[_i] = (unsigned)((U).rowmap[R_ + 128] * K + C_) * 2u; } } while (0)
    if constexpr (GATHER) PG8_ROWOFF(cur, oc_lo, oc_hi);
    PG8_STAGE(PG8_SB(0, 0), cB, voffB);
    if constexpr (GATHER) PG8_STAGE(PG8_SA(0, 0), cA, oc_lo); else PG8_STAGE(PG8_SA(0, 0), cA, voffA);
    PG8_STAGE(PG8_SB(0, 1), cB + hstep, voffB);
    if constexpr (GATHER) PG8_STAGE(PG8_SA(0, 1), cA, oc_hi); else PG8_STAGE(PG8_SA(0, 1), cA + hstep, voffA);
    if (wr == 1) PG8_BAR;
    PG8_WAIT_V(4); PG8_BAR;
    PG8_STAGE(PG8_SB(1, 0), cB + kstep, voffB);
    if constexpr (GATHER) PG8_STAGE(PG8_SA(1, 0), cA + kstep, oc_lo); else PG8_STAGE(PG8_SA(1, 0), cA + kstep, voffA);
    PG8_STAGE(PG8_SB(1, 1), cB + hstep + kstep, voffB);
    PG8_WAIT_V(6); PG8_BAR;
    for (;;) {
        const bool has_next = S.next(ui + 1, nxt);
        const char* nA = has_next ? nxt.a : cA; const char* nB = has_next ? nxt.b : cB;
        if constexpr (GATHER) { if (has_next) PG8_ROWOFF(nxt, on_lo, on_hi); else { on_lo[0] = oc_lo[0]; on_lo[1] = oc_lo[1]; on_hi[0] = oc_hi[0]; on_hi[1] = oc_hi[1]; } }
#pragma unroll 1
        for (int t = 0; t < nt; t += 2) {
            const bool last = (t == nt - 2);
            const char* a1 = cA + (size_t)(t + 1) * kstep;
            const char* a2 = last ? nA : cA + (size_t)(t + 2) * kstep; const char* b2 = last ? nB : cB + (size_t)(t + 2) * kstep;
            const char* a3 = a2 + kstep; const char* b3 = b2 + kstep;
            unsigned o2lo[2], o2hi[2];
            o2lo[0] = last ? on_lo[0] : oc_lo[0]; o2lo[1] = last ? on_lo[1] : oc_lo[1]; o2hi[0] = last ? on_hi[0] : oc_hi[0]; o2hi[1] = last ? on_hi[1] : oc_hi[1];
            PG8_LDB(B0, 0, 0); PG8_SCHED; PG8_LDA(At, 0, 0); if constexpr (GATHER) PG8_STAGE(PG8_SA(1, 1), a1, oc_hi); else PG8_STAGE(PG8_SA(1, 1), a1 + hstep, voffA);
            PG8_WAIT_L(8); PG8_BAR; PG8_WAIT_L(0); PG8_MMA(0, 0, At, B0); PG8_BAR; PG8_SCHED;
            PG8_LDB(B1, 0, 1); PG8_STAGE(PG8_SB(0, 0), b2, voffB);
            PG8_BAR; PG8_WAIT_L(0); PG8_MMA(0, 1, At, B1); PG8_BAR;
            PG8_LDA(At, 0, 1); if constexpr (GATHER) PG8_STAGE(PG8_SA(0, 0), a2, o2lo); else PG8_STAGE(PG8_SA(0, 0), a2, voffA);
            PG8_BAR; PG8_WAIT_L(0); PG8_MMA(1, 0, At, B0); PG8_BAR; PG8_SCHED;
            PG8_STAGE(PG8_SB(0, 1), b2 + hstep, voffB);
            PG8_WAIT_V(6); PG8_BAR; PG8_MMA(1, 1, At, B1); PG8_BAR;
            PG8_LDB(B0, 1, 0); PG8_SCHED; PG8_LDA(At, 1, 0); if constexpr (GATHER) PG8_STAGE(PG8_SA(0, 1), a2, o2hi); else PG8_STAGE(PG8_SA(0, 1), a2 + hstep, voffA);
            PG8_WAIT_L(8); PG8_BAR; PG8_WAIT_L(0); PG8_MMA(0, 0, At, B0); PG8_BAR; PG8_SCHED;
            PG8_LDB(B1, 1, 1); PG8_STAGE(PG8_SB(1, 0), b3, voffB);
            PG8_BAR; PG8_WAIT_L(0); PG8_MMA(0, 1, At, B1); PG8_BAR;
            PG8_LDA(At, 1, 1); if constexpr (GATHER) PG8_STAGE(PG8_SA(1, 0), a3, o2lo); else PG8_STAGE(PG8_SA(1, 0), a3, voffA);
            PG8_BAR; PG8_WAIT_L(0); PG8_MMA(1, 0, At, B0); PG8_BAR; PG8_SCHED;
            PG8_STAGE(PG8_SB(1, 1), b3 + hstep, voffB);
            PG8_WAIT_V(6); PG8_BAR; PG8_MMA(1, 1, At, B1); PG8_BAR;
        }
        epi_apply(E, acc, cur, wr, wc, fr, fq);
        if (!has_next) break;
#pragma unroll
        for (int a = 0; a < 2; ++a)
#pragma unroll
            for (int b = 0; b < 2; ++b)
#pragma unroll
                for (int m = 0; m < 4; ++m)
#pragma unroll
                    for (int n = 0; n < 2; ++n) acc[a][b][m][n] = (f32x4){0.f, 0.f, 0.f, 0.f};
        cur = nxt; cA = nA; cB = nB; ++ui;
        if constexpr (GATHER) { oc_lo[0] = on_lo[0]; oc_lo[1] = on_lo[1]; oc_hi[0] = on_hi[0]; oc_hi[1] = on_hi[1]; }
    }
    PG8_WAIT_V(0);
    if (wr == 0) PG8_BAR;
    PG8_BAR;
#undef PG8_ROWOFF
#undef PG8_SA
#undef PG8_SB
#undef PG8_STAGE
#undef PG8_LDA
#undef PG8_LDB
#undef PG8_MMA
#undef PG8_WAIT_V
#undef PG8_WAIT_L
#undef PG8_BAR
#undef PG8_SCHED
}
template <class Epi, class Sched>
__device__ __forceinline__ void gemm_phase(LAS unsigned char* lds, const int K, const Sched& S, const Epi& E, const int tid) { gemm_phase_t<false>(lds, K, S, E, tid); }
}

struct SchedInProj { const char* A; const char* Bt; int G, c;
    __device__ __forceinline__ bool next(int i, pg8::Unit& u) const { const int L = i * G + c; if (L >= 64 * 37) return false; int pm, pn; pg8::tile_order(L, 64, 37, pm, pn);
        u.a = A + (size_t)pm * (256 * 1024 * 2); u.b = Bt + (size_t)pn * (256 * 1024 * 2); u.row0 = pm * 256; u.col0 = pn * 256; u.aux = 0; u.rowmap = nullptr; return true; } };

struct WJob { const float* src; int ld_src; int K; int ncols; bf16* dst; int ld_dst; int nb; size_t sstride, dstride; };
__device__ __forceinline__ void wconv_job(const Ctx& c, const WJob& j) {
    float* tl = (float*)c.lds;
    const int ntk = j.K >> 6, ntn = j.ncols >> 6, per = ntk * ntn, ntiles = per * j.nb;
    const int rk = c.tid >> 3, rseg = (c.tid & 7) * 8;
    int tile = blockIdx.x;
    float4 a = make_float4(0.f, 0.f, 0.f, 0.f), b = a;
    if (tile < ntiles) { const int bi = tile / per, tt = tile % per, tk = tt % ntk, tn = tt / ntk;
        const float* sp = j.src + (size_t)bi * j.sstride + (size_t)(tk * 64 + rk) * j.ld_src + tn * 64 + rseg; a = *(const float4*)sp; b = *(const float4*)(sp + 4); }
    for (; tile < ntiles; tile += gridDim.x) {
        const int bi = tile / per, tt = tile % per, tk = tt % ntk, tn = tt / ntk;
        const float4 ca = a, cb = b;
        const int nxt = tile + gridDim.x;
        if (nxt < ntiles) { const int bi2 = nxt / per, tt2 = nxt % per, tk2 = tt2 % ntk, tn2 = tt2 / ntk;
            const float* sp = j.src + (size_t)bi2 * j.sstride + (size_t)(tk2 * 64 + rk) * j.ld_src + tn2 * 64 + rseg; a = *(const float4*)sp; b = *(const float4*)(sp + 4); }
        asm volatile("s_waitcnt lgkmcnt(0)" ::: "memory"); __builtin_amdgcn_s_barrier(); asm volatile("" ::: "memory");
        float* row = tl + rk * 65 + rseg;
        row[0] = ca.x; row[1] = ca.y; row[2] = ca.z; row[3] = ca.w; row[4] = cb.x; row[5] = cb.y; row[6] = cb.z; row[7] = cb.w;
        asm volatile("s_waitcnt lgkmcnt(0)" ::: "memory"); __builtin_amdgcn_s_barrier(); asm volatile("" ::: "memory");
        const float* col = tl + rseg * 65 + rk;
        uint4 w; w.x = pk2(col[0], col[65]); w.y = pk2(col[130], col[195]); w.z = pk2(col[260], col[325]); w.w = pk2(col[390], col[455]);
        *(uint4*)(j.dst + (size_t)bi * j.dstride + (size_t)(tn * 64 + rk) * j.ld_dst + tk * 64 + rseg) = w;
    }
}
struct SchedG2 { const char* YA; const char* Bt; int G, c;
    __device__ __forceinline__ bool next(int i, pg8::Unit& u) const { const int L = (i >> 1) * G + c, ab = i & 1; if (L >= 64 * 4) return false; int pm, pn; pg8::tile_order(L, 64, 4, pm, pn);
        u.a = YA + (size_t)ab * (WS_YB - WS_YA) + (size_t)pm * (256 * 1024 * 2); u.b = Bt + (size_t)(ab * 4 + pn) * (256 * 1024 * 2); u.row0 = pm * 256; u.col0 = ab * 1024 + pn * 256; u.aux = 0; u.rowmap = nullptr; return true; } };
struct SchedX1 { const char* A; const char* Bt; int G, c;
    __device__ __forceinline__ bool next(int i, pg8::Unit& u) const { const int L = i * G + c; if (L >= 64 * 4) return false; int pm, pn; pg8::tile_order(L, 64, 4, pm, pn);
        u.a = A + (size_t)pm * (256 * 1024 * 2); u.b = Bt + (size_t)pn * (256 * 1024 * 2); u.row0 = pm * 256; u.col0 = pn * 256; u.aux = 0; u.rowmap = nullptr; return true; } };
struct SchedMoe { const char* A; const char* Bt; const int* TILE_E; const int* SLOT_TOK; int NT, NPN, G, c;
    __device__ __forceinline__ bool next(int i, pg8::Unit& u) const { const int L = i * G + c; if (L >= NT * NPN) return false; int tile, pn; pg8::tile_order(L, NT, NPN, tile, pn);
        const int e = TILE_E[tile];
        u.a = SLOT_TOK ? A : A + (size_t)tile * (256 * 1024 * 2); u.rowmap = SLOT_TOK ? SLOT_TOK + tile * 256 : nullptr;
        u.b = Bt + (size_t)(e * NPN + pn) * (256 * 1024 * 2); u.row0 = tile * 256; u.col0 = pn * 256; u.aux = e; return true; } };

struct EpiLora {
    typedef NoLd Ld; static constexpr int MB = 1;
    const float* w0; const float* a0; float* LW; float* AA; bf16* GGR;
    __device__ __forceinline__ void load(Ld&, int, int, int) const {}
    __device__ __forceinline__ void store8(int row, int col, const float (&v)[8], int, const Ld&) const {
        const float* bp = col < 1024 ? w0 + col : a0 + ((col - 1024) & 1023);
        const float4 b0 = *(const float4*)bp, b1 = *(const float4*)(bp + 4);
        const float bb[8] = {b0.x, b0.y, b0.z, b0.w, b1.x, b1.y, b1.z, b1.w};
        if (col < 1024) { float o[8];
#pragma unroll
            for (int i = 0; i < 8; ++i) o[i] = -0.6065306597126334f * fsigm(bb[i] + v[i]);
            float* p = LW + (size_t)row * 1024 + col; *(float4*)p = make_float4(o[0], o[1], o[2], o[3]); *(float4*)(p + 4) = make_float4(o[4], o[5], o[6], o[7]); }
        else if (col < 2048) { const int cc = col - 1024; float o[8];
#pragma unroll
            for (int i = 0; i < 8; ++i) o[i] = fsigm(bb[i] + v[i]);
            float* p = AA + (size_t)row * 1024 + cc; *(float4*)p = make_float4(o[0], o[1], o[2], o[3]); *(float4*)(p + 4) = make_float4(o[4], o[5], o[6], o[7]); }
        else { uint4 w; w.x = pk2(v[0], v[1]); w.y = pk2(v[2], v[3]); w.z = pk2(v[4], v[5]); w.w = pk2(v[6], v[7]); *(uint4*)(GGR + (size_t)row * 1024 + (col - 2048)) = w; }
    }
};
struct SchedLora { const char* A; const char* Bt; int G, c;
    __device__ __forceinline__ bool next(int i, pg8::Unit& u) const { const int L = i * G + c; if (L >= 64 * 12) return false; int pm, pn; pg8::tile_order(L, 64, 12, pm, pn);
        u.a = A + (size_t)pm * (256 * 256 * 2); u.b = Bt + (size_t)pn * (256 * 256 * 2); u.row0 = pm * 256; u.col0 = pn * 256; u.aux = 0; u.rowmap = nullptr; return true; } };
__device__ __forceinline__ void lora_zero(const Ctx& c) {
    uint4* LT = c.ws<uint4>(WS_LORA_T);
    for (size_t idx = c.gtid; idx < (size_t)3072 * 32; idx += c.nthreads) {
        const int row = (int)(idx >> 5), k8 = (int)(idx & 31) * 8;
        const bool data = row < 1024 ? (k8 < 64) : (row < 2048 ? (k8 >= 64 && k8 < 128) : (k8 >= 128));
        if (!data) LT[idx] = make_uint4(0, 0, 0, 0);
    }
}

__device__ __forceinline__ void ph_loraprep(const Ctx& c) {
    const float* LIN = c.ws<float>(WS_LIN); bf16* AL = c.ws<bf16>(WS_ALORA); const float* mu = c.P.in[I_MU];
    for (size_t idx = c.gtid; idx < (size_t)T * 256; idx += c.nthreads) {
        const int t = (int)(idx >> 8), cc = (int)(idx & 255);
        const float x = LIN[idx], xp = (t & (SEQ - 1)) ? LIN[idx - 256] : 0.f;
        const float xs = x + (xp - x) * mu[3072 + cc];
        const float r = cc < 64 ? tanhf(xs) : (cc < 128 ? xs : sigm(xs));
        AL[idx] = f2bf(r);
    }
}
__device__ __forceinline__ void ph_post(const Ctx& c) {
    const float* OG = c.ws<float>(WS_OG); const float* ORW = c.ws<float>(WS_ORW); const bf16* ZS = c.ws<bf16>(WS_ZS); const bf16* VP = c.ws<bf16>(WS_VP); const bf16* GGR = c.ws<bf16>(WS_GGR);
    const float* SC = c.ws<float>(WS_SC); bf16* YA = c.ws<bf16>(WS_YA); bf16* YB = c.ws<bf16>(WS_YB);
    const float* gnw = c.P.in[I_GDN_NORM]; const float* lnw = c.P.in[I_LNW]; const float* lnb = c.P.in[I_LNB];
    const int lane = c.lane, c0 = lane * 16;
    for (int t = c.gwave; t < T; t += c.nwaves) {
        {
            float o[16];
#pragma unroll
            for (int q = 0; q < 4; ++q) { const float4 v = *(const float4*)(OG + (size_t)t * 1024 + c0 + 4 * q); o[4 * q] = v.x; o[4 * q + 1] = v.y; o[4 * q + 2] = v.z; o[4 * q + 3] = v.w; }
            float ss = 0.f;
#pragma unroll
            for (int j = 0; j < 16; ++j) ss += o[j] * o[j];
            ss += __shfl_xor(ss, 1); ss += __shfl_xor(ss, 2); ss += __shfl_xor(ss, 4);
            const float rstd = rsqrtf(ss * (1.f / 128.f) + 1e-6f);
            const uint4 z0 = *(const uint4*)(ZS + (size_t)t * 1024 + c0), z1 = *(const uint4*)(ZS + (size_t)t * 1024 + c0 + 8);
            const unsigned zz[8] = {z0.x, z0.y, z0.z, z0.w, z1.x, z1.y, z1.z, z1.w};
            unsigned w[8];
#pragma unroll
            for (int j = 0; j < 8; ++j) { const int cc = (c0 + 2 * j) & 127; w[j] = pk2(o[2 * j] * rstd * gnw[cc] * bflo(zz[j]), o[2 * j + 1] * rstd * gnw[cc + 1] * bfhi(zz[j])); }
            *(uint4*)(YA + (size_t)t * 1024 + c0) = make_uint4(w[0], w[1], w[2], w[3]); *(uint4*)(YA + (size_t)t * 1024 + c0 + 8) = make_uint4(w[4], w[5], w[6], w[7]);
        }
        {
            float o[16];
#pragma unroll
            for (int q = 0; q < 4; ++q) { const float4 v = *(const float4*)(ORW + (size_t)t * 1024 + c0 + 4 * q); o[4 * q] = v.x; o[4 * q + 1] = v.y; o[4 * q + 2] = v.z; o[4 * q + 3] = v.w; }
            float sm = 0.f;
#pragma unroll
            for (int j = 0; j < 16; ++j) sm += o[j];
            sm += __shfl_xor(sm, 1); sm += __shfl_xor(sm, 2);
            const float mean = sm * (1.f / 64.f);
            float sv = 0.f;
#pragma unroll
            for (int j = 0; j < 16; ++j) { const float dd = o[j] - mean; sv += dd * dd; }
            sv += __shfl_xor(sv, 1); sv += __shfl_xor(sv, 2);
            const float rstd = rsqrtf(sv * (1.f / 64.f) + 64e-5f);
            const float sc = SC[t * 16 + (c0 >> 6)];
            const uint4 v0 = *(const uint4*)(VP + (size_t)t * 1024 + c0), v1 = *(const uint4*)(VP + (size_t)t * 1024 + c0 + 8);
            const uint4 g0 = *(const uint4*)(GGR + (size_t)t * 1024 + c0), g1 = *(const uint4*)(GGR + (size_t)t * 1024 + c0 + 8);
            const unsigned vv[8] = {v0.x, v0.y, v0.z, v0.w, v1.x, v1.y, v1.z, v1.w};
            const unsigned gg[8] = {g0.x, g0.y, g0.z, g0.w, g1.x, g1.y, g1.z, g1.w};
            unsigned w[8];
#pragma unroll
            for (int j = 0; j < 8; ++j) { const int cc = c0 + 2 * j;
                const float y0 = ((o[2 * j] - mean) * rstd * lnw[cc] + lnb[cc] + sc * bflo(vv[j])) * bflo(gg[j]);
                const float y1 = ((o[2 * j + 1] - mean) * rstd * lnw[cc + 1] + lnb[cc + 1] + sc * bfhi(vv[j])) * bfhi(gg[j]);
                w[j] = pk2(y0, y1); }
            *(uint4*)(YB + (size_t)t * 1024 + c0) = make_uint4(w[0], w[1], w[2], w[3]); *(uint4*)(YB + (size_t)t * 1024 + c0 + 8) = make_uint4(w[4], w[5], w[6], w[7]);
        }
    }
}

__device__ __forceinline__ void ph_router(const Ctx& c) {
    const float* X1 = c.ws<float>(WS_X1); const float* nw = c.P.in[I_NORM_FFN]; const float* rw = c.P.in[I_ROUTER_W]; const float* rb = c.P.in[I_ROUTER_B];
    bf16* H2 = c.ws<bf16>(WS_H2); int* TE = c.ws<int>(WS_TE); float* TG = c.ws<float>(WS_TG); int* TP = c.ws<int>(WS_TP); unsigned* CNT = c.ws<unsigned>(WS_CTL) + CW_CNT;
    const int lane = c.lane;
    float4* tab = (float4*)c.lds;
    unsigned* lcnt = (unsigned*)(c.lds + 147456);
    __syncthreads();
    if (c.tid < 32) lcnt[c.tid] = 0u;
    for (int i = c.tid; i < 8192; i += NTHREADS) { const int k = i >> 3; tab[((k & 3) * 256 + (k >> 2)) * 9 + (i & 7)] = ((const float4*)rw)[i]; }
    __syncthreads();
    for (int t = c.gwave; t < T; t += c.nwaves) {
        float4 v[4]; float ss = 0.f;
#pragma unroll
        for (int i = 0; i < 4; ++i) { v[i] = ((const float4*)(X1 + (size_t)t * D))[lane + 64 * i]; ss += v[i].x * v[i].x + v[i].y * v[i].y + v[i].z * v[i].z + v[i].w * v[i].w; }
        ss = wsum(ss);
        const float rstd = rsqrtf(ss * (1.f / 1024.f) + 1e-6f);
        float lg[32];
#pragma unroll
        for (int j = 0; j < 32; ++j) lg[j] = 0.f;
#pragma unroll
        for (int i = 0; i < 4; ++i) {
            const float4 w4 = ((const float4*)nw)[lane + 64 * i];
            const float h[4] = {v[i].x * rstd * w4.x, v[i].y * rstd * w4.y, v[i].z * rstd * w4.z, v[i].w * rstd * w4.w};
            uint2 st; st.x = pk2(h[0], h[1]); st.y = pk2(h[2], h[3]);
            *(uint2*)(H2 + (size_t)t * D + 4 * (lane + 64 * i)) = st;
#pragma unroll
            for (int ii = 0; ii < 4; ++ii) {
                const float4* wr = tab + (size_t)(ii * 256 + lane + 64 * i) * 9;
#pragma unroll
                for (int q = 0; q < 8; ++q) { const float4 w = wr[q]; lg[4 * q] += h[ii] * w.x; lg[4 * q + 1] += h[ii] * w.y; lg[4 * q + 2] += h[ii] * w.z; lg[4 * q + 3] += h[ii] * w.w; }
                asm volatile("" ::: "memory");
            }
        }
#pragma unroll
        for (int j = 0; j < 32; ++j) lg[j] = wsum(lg[j]) + rb[j];
        int e0 = 0, e1 = 0, e2 = 0, e3 = 0; float v0 = -3e38f, v1 = -3e38f, v2 = -3e38f, v3 = -3e38f;
#pragma unroll
        for (int j = 0; j < 32; ++j) if (lg[j] > v0) { v0 = lg[j]; e0 = j; }
#pragma unroll
        for (int j = 0; j < 32; ++j) if (j != e0 && lg[j] > v1) { v1 = lg[j]; e1 = j; }
#pragma unroll
        for (int j = 0; j < 32; ++j) if (j != e0 && j != e1 && lg[j] > v2) { v2 = lg[j]; e2 = j; }
#pragma unroll
        for (int j = 0; j < 32; ++j) if (j != e0 && j != e1 && j != e2 && lg[j] > v3) { v3 = lg[j]; e3 = j; }
        const float x1 = expf(v1 - v0), x2 = expf(v2 - v0), x3 = expf(v3 - v0), inv = 1.f / (1.f + x1 + x2 + x3);
        if (lane < 4) {
            const int me = lane == 0 ? e0 : (lane == 1 ? e1 : (lane == 2 ? e2 : e3));
            const float mg = (lane == 0 ? 1.f : (lane == 1 ? x1 : (lane == 2 ? x2 : x3))) * inv;
            const unsigned pos = atomicAdd(&lcnt[me], 1u);
            TE[t * 4 + lane] = me; TG[t * 4 + lane] = mg; TP[t * 4 + lane] = (int)pos;
        }
    }
    __syncthreads();
    if (c.tid < 32) lcnt[32 + c.tid] = atomicAdd(&CNT[c.tid], lcnt[c.tid]);
    __syncthreads();
    if (lane < 4) for (int t = c.gwave; t < T; t += c.nwaves) TP[t * 4 + lane] += (int)lcnt[32 + TE[t * 4 + lane]];
    __syncthreads();
}

__device__ __forceinline__ void ph_dispatch(const Ctx& c) {
    int* tb = (int*)c.lds;
    const unsigned* CNT = c.ws<unsigned>(WS_CTL) + CW_CNT;
    int* TILE_E = c.ws<int>(WS_TILE_E); int* NT = c.ws<int>(WS_NT);
    const int* TE = c.ws<int>(WS_TE); const float* TG = c.ws<float>(WS_TG); const int* TP = c.ws<int>(WS_TP); int* TSLOT = c.ws<int>(WS_TSLOT);
    float* SGATE = c.ws<float>(WS_SGATE); const bf16* H2 = c.ws<bf16>(WS_H2); bf16* XB = c.ws<bf16>(WS_XB);
    if (c.tid == 0) { int acc = 0; for (int e = 0; e < NEXP; ++e) { const int n = (int)__hip_atomic_load(&CNT[e], __ATOMIC_RELAXED, __HIP_MEMORY_SCOPE_AGENT); tb[e] = acc; tb[64 + e] = n; acc += (n + 255) >> 8; } tb[32] = acc; }
    __syncthreads();
    if (blockIdx.x == 0) {
        for (int tile = c.tid; tile < tb[32]; tile += NTHREADS) { int e = 0; for (int q = 0; q < NEXP; ++q) if (tile >= tb[q]) e = q; TILE_E[tile] = e; }
        if (c.tid == 0) *NT = tb[32];
    }
    int* SLOT_TOK = c.ws<int>(WS_SLOT_TOK);
    for (size_t idx = c.gtid; idx < (size_t)T * 4; idx += c.nthreads) {
        const int t = (int)(idx >> 2), e = TE[idx], pos = TP[idx];
        const int slot = tb[e] * 256 + pos;
        TSLOT[idx] = slot; SGATE[slot] = TG[idx]; SLOT_TOK[slot] = t;
    }
    for (int e = 0; e < NEXP; ++e) {
        const int n = tb[64 + e], cap = (tb[e + 1] - tb[e]) * 256;
        for (int r = n + (int)c.gtid; r < cap; r += (int)c.nthreads) { const int slot = tb[e] * 256 + r; SLOT_TOK[slot] = 0; SGATE[slot] = 0.f; }
    }
}

__device__ __forceinline__ void ph_combine(const Ctx& c) {
    const float* X1 = c.ws<float>(WS_X1); const bf16* YS = c.ws<bf16>(WS_YS); const int* TSLOT = c.ws<int>(WS_TSLOT); const float* nw = c.P.in[I_NORM_FINAL]; float* out = c.P.out;
    const int lane = c.lane;
    for (int t = c.gwave; t < T; t += c.nwaves) {
        const int s0 = TSLOT[t * 4], s1 = TSLOT[t * 4 + 1], s2 = TSLOT[t * 4 + 2], s3 = TSLOT[t * 4 + 3];
        float4 v[4]; float ss = 0.f;
#pragma unroll
        for (int i = 0; i < 4; ++i) {
            const int col = 4 * (lane + 64 * i);
            v[i] = *(const float4*)(X1 + (size_t)t * D + col);
            const uint2 a = *(const uint2*)(YS + (size_t)s0 * 1024 + col), b = *(const uint2*)(YS + (size_t)s1 * 1024 + col), cc = *(const uint2*)(YS + (size_t)s2 * 1024 + col), d = *(const uint2*)(YS + (size_t)s3 * 1024 + col);
            v[i].x += bflo(a.x) + bflo(b.x) + bflo(cc.x) + bflo(d.x); v[i].y += bfhi(a.x) + bfhi(b.x) + bfhi(cc.x) + bfhi(d.x);
            v[i].z += bflo(a.y) + bflo(b.y) + bflo(cc.y) + bflo(d.y); v[i].w += bfhi(a.y) + bfhi(b.y) + bfhi(cc.y) + bfhi(d.y);
            ss += v[i].x * v[i].x + v[i].y * v[i].y + v[i].z * v[i].z + v[i].w * v[i].w;
        }
        ss = wsum(ss);
        const float rstd = rsqrtf(ss * (1.f / 1024.f) + 1e-6f);
#pragma unroll
        for (int i = 0; i < 4; ++i) { const float4 w4 = ((const float4*)nw)[lane + 64 * i];
            *(float4*)(out + (size_t)t * D + 4 * (lane + 64 * i)) = make_float4(v[i].x * rstd * w4.x, v[i].y * rstd * w4.y, v[i].z * rstd * w4.z, v[i].w * rstd * w4.w); }
    }
    if (TS_BEGIN >= 0 && blockIdx.x == 0 && c.tid == 0) { asm volatile("s_waitcnt vmcnt(0)" ::: "memory"); c.P.out[0] = (float)c.ws<unsigned>(WS_CTL)[CW_TS] * 0.01f; }
}


typedef short bf16x8_t __attribute__((ext_vector_type(8)));
typedef float f32x4_t __attribute__((ext_vector_type(4)));
#define MFMA16(a, b, c) __builtin_amdgcn_mfma_f32_16x16x32_bf16((a), (b), (c), 0, 0, 0)


__device__ __forceinline__ int frag_off(int row, int k, int KBn) { return (((row >> 4) * KBn + (k >> 5)) * 512) + (((k >> 3) & 3) * 128) + ((row & 15) * 8) + (k & 7); }
__device__ __forceinline__ int cfrag_off(int v, int r, int NRT) { return ((((v >> 4) * NRT + (r >> 4)) * 64 + ((r >> 2) & 3) * 16 + (v & 15)) * 4) + (r & 3); }

constexpr int GCL_HALF_BYTES = 71680;
__device__ __forceinline__ void ph_gcl(const Ctx& c) {
    const bf16* GQKV = c.ws<bf16>(WS_GQKV); const float* BETA = c.ws<float>(WS_BETA); const float* GGv = c.ws<float>(WS_GG); const float* cw = c.P.in[I_GDN_CONV];
    bf16* GA1 = c.ws<bf16>(WS_GA1); bf16* GX0 = c.ws<bf16>(WS_GX0); bf16* GA2 = c.ws<bf16>(WS_GA2); bf16* GA3 = c.ws<bf16>(WS_GA3); bf16* GA4 = c.ws<bf16>(WS_GA4); float* GGL = c.ws<float>(WS_GGL);
    for (int it0 = blockIdx.x * 2; it0 < 2048; it0 += gridDim.x * 2) {
        int tv = c.tid; asm volatile("" : "+v"(tv));
        const int half = tv >> 8, ht = tv & 255, lane = tv & 63, w4 = __builtin_amdgcn_readfirstlane((tv >> 6) & 3);
        unsigned char* base = c.lds + half * GCL_HALF_BYTES;
        bf16* QB = (bf16*)base;
        bf16* KB = QB + 64 * 136;
        bf16* VB = KB + 64 * 136;
        float* MM = (float*)(VB + 64 * 136);
        float* GC = MM + 64 * 64;
        float* BT = GC + 64;
        float* BE = BT + 64;
        const int item = it0 + half, n = item & 63, bh = item >> 6, h = bh & 7, b = bh >> 3;
        const int t0 = b * SEQ + n * 64;
        __syncthreads();
        if (w4 == 0) {
            float g = GGv[(size_t)(t0 + lane) * 8 + h]; const float be = BETA[(size_t)(t0 + lane) * 8 + h];
#pragma unroll
            for (int o = 1; o < 64; o <<= 1) { const float u = __shfl_up(g, o); if (lane >= o) g += u; }
            GC[lane] = g; BT[lane] = be; BE[lane] = be * __expf(g);
        }
        __syncthreads();
        {
            const int cg = ht & 15, rg = ht >> 4, r0 = rg * 4;
#pragma unroll
            for (int mat = 0; mat < 3; ++mat) {
                const int col0 = mat * 1024 + h * 128 + cg * 8;
                float4 xa[7], xb[7], wa[4], wb[4];
#pragma unroll
                for (int li = 0; li < 7; ++li) {
                    const bool valid = (n > 0) || (r0 - 3 + li >= 0);
                    uint4 xr = make_uint4(0, 0, 0, 0);
                    if (valid) xr = *(const uint4*)(GQKV + (size_t)(t0 + r0 - 3 + li) * 3072 + col0);
                    xa[li] = make_float4(bflo(xr.x), bfhi(xr.x), bflo(xr.y), bfhi(xr.y));
                    xb[li] = make_float4(bflo(xr.z), bfhi(xr.z), bflo(xr.w), bfhi(xr.w));
                }
#pragma unroll
                for (int j = 0; j < 4; ++j) { wa[j] = *(const float4*)(cw + j * 3072 + col0); wb[j] = *(const float4*)(cw + j * 3072 + col0 + 4); }
#pragma unroll
                for (int rr = 0; rr < 4; ++rr) {
                    float o[8] = {0.f, 0.f, 0.f, 0.f, 0.f, 0.f, 0.f, 0.f};
#pragma unroll
                    for (int j = 0; j < 4; ++j) { const float4 a = xa[rr + j], bq = xb[rr + j];
                        o[0] += wa[j].x * a.x; o[1] += wa[j].y * a.y; o[2] += wa[j].z * a.z; o[3] += wa[j].w * a.w;
                        o[4] += wb[j].x * bq.x; o[5] += wb[j].y * bq.y; o[6] += wb[j].z * bq.z; o[7] += wb[j].w * bq.w; }
                    float ss = 0.f;
#pragma unroll
                    for (int e = 0; e < 8; ++e) { o[e] *= fsigm(o[e]); ss += o[e] * o[e]; }
                    float sc = 1.f;
                    if (mat < 2) { ss += __shfl_xor(ss, 1); ss += __shfl_xor(ss, 2); ss += __shfl_xor(ss, 4); ss += __shfl_xor(ss, 8); sc = rsqrtf(ss + 1e-6f) * (mat == 0 ? 0.08838834764831845f : 1.f); }
                    const int r = r0 + rr;
                    uint4 w; w.x = pk2(o[0] * sc, o[1] * sc); w.y = pk2(o[2] * sc, o[3] * sc); w.z = pk2(o[4] * sc, o[5] * sc); w.w = pk2(o[6] * sc, o[7] * sc);
                    *(uint4*)((mat == 0 ? QB : (mat == 1 ? KB : VB)) + r * 136 + cg * 8) = w;
                    if (mat == 0) {
                        const float s2 = sc * __expf(GC[r]);
                        w.x = pk2(o[0] * s2, o[1] * s2); w.y = pk2(o[2] * s2, o[3] * s2); w.z = pk2(o[4] * s2, o[5] * s2); w.w = pk2(o[6] * s2, o[7] * s2);
                        *(uint4*)(GA2 + (size_t)item * 64 * 128 + frag_off(r, cg * 8, 4)) = w;
                    }
                }
            }
        }
        __syncthreads();
        {
            const int fr = lane & 15, fq = lane >> 4, a0 = w4 * 16;
            bf16x8_t ka[4];
#pragma unroll
            for (int kb = 0; kb < 4; ++kb) ka[kb] = *(const bf16x8_t*)(KB + (a0 + fr) * 136 + kb * 32 + fq * 8);
#pragma unroll
            for (int bt = 0; bt < 4; ++bt) {
                f32x4_t c1 = {0.f, 0.f, 0.f, 0.f}, c2 = {0.f, 0.f, 0.f, 0.f};
#pragma unroll
                for (int kb = 0; kb < 4; ++kb) {
                    const bf16x8_t kbf = *(const bf16x8_t*)(KB + (bt * 16 + fr) * 136 + kb * 32 + fq * 8);
                    const bf16x8_t qbf = *(const bf16x8_t*)(QB + (bt * 16 + fr) * 136 + kb * 32 + fq * 8);
                    c1 = MFMA16(ka[kb], kbf, c1); c2 = MFMA16(ka[kb], qbf, c2);
                }
                const int i = bt * 16 + fr, j0 = a0 + 4 * fq;
                const float gi = GC[i], bi = BT[i];
                float m[4], at[4];
#pragma unroll
                for (int rg = 0; rg < 4; ++rg) { const int j = j0 + rg; const float dec = __expf(fminf(gi - GC[j], 0.f));
                    m[rg] = (i > j) ? bi * c1[rg] * dec : 0.f; at[rg] = (i >= j) ? c2[rg] * dec : 0.f; }
                *(float4*)(MM + i * 64 + j0) = make_float4(m[0], m[1], m[2], m[3]);
                uint2 w; w.x = pk2(at[0], at[1]); w.y = pk2(at[2], at[3]);
                *(uint2*)(GA3 + (size_t)item * 64 * 64 + frag_off(i, j0, 2)) = w;
            }
        }
        __syncthreads();
        {
            const int cc = ht & 127; const bool isw = ht >= 128;
            const bf16* srcp = (isw ? KB : VB) + cc; const float* scl = isw ? BE : BT;
            float x[64];
#pragma unroll
            for (int i = 0; i < 64; ++i) x[i] = 0.f;
            float4 mc[16], mn[16];
#pragma unroll
            for (int q = 0; q < 16; ++q) { mc[q] = make_float4(0.f, 0.f, 0.f, 0.f); mn[q] = mc[q]; }
            float rhs_n = scl[0] * bf2f(srcp[0]);
#pragma unroll
            for (int i = 0; i < 64; ++i) {
                const float rhs = rhs_n;
                if (i + 1 < 64) {
#pragma unroll
                    for (int j4 = 0; j4 < (i + 4) / 4; ++j4) mn[j4] = *(const float4*)(MM + (i + 1) * 64 + 4 * j4);
                    rhs_n = scl[i + 1] * bf2f(srcp[(i + 1) * 136]);
                }
                float acc = rhs, ac1 = 0.f, ac2 = 0.f, ac3 = 0.f;
#pragma unroll
                for (int j4 = 0; j4 < (i + 3) / 4; ++j4) { acc -= mc[j4].x * x[4 * j4]; ac1 -= mc[j4].y * x[4 * j4 + 1]; ac2 -= mc[j4].z * x[4 * j4 + 2]; ac3 -= mc[j4].w * x[4 * j4 + 3]; }
                x[i] = (acc + ac1) + (ac2 + ac3);
#pragma unroll
                for (int j4 = 0; j4 < 16; ++j4) mc[j4] = mn[j4];
                asm volatile("" ::: "memory");
            }
            if (!isw) {
                bf16* up = GX0 + (size_t)item * 128 * 64;
#pragma unroll
                for (int q = 0; q < 16; ++q) { uint2 w; w.x = pk2(x[4 * q], x[4 * q + 1]); w.y = pk2(x[4 * q + 2], x[4 * q + 3]); *(uint2*)(up + cfrag_off(cc, 4 * q, 4)) = w; }
            }
            __syncthreads();
            if (isw) {
                bf16* a1s = (bf16*)MM;
#pragma unroll
                for (int i = 0; i < 64; ++i) a1s[i * 128 + cc] = f2bf(-x[i]);
            }
        }
        __syncthreads();
        {
            const bf16* a1s = (const bf16*)MM; bf16* wp = GA1 + (size_t)item * 64 * 128;
#pragma unroll
            for (int q = 0; q < 4; ++q) { const int p = ht + 256 * q, fr = p & 15, fq = (p >> 4) & 3, kb = (p >> 6) & 3, rt = p >> 8;
                *(uint4*)(wp + p * 8) = *(const uint4*)(a1s + (rt * 16 + fr) * 128 + kb * 32 + fq * 8); }
        }
        {
            const int dk = ht & 127, hh = ht >> 7; const float g63 = GC[63];
            unsigned w[16];
#pragma unroll
            for (int q = 0; q < 16; ++q) { const int ta = hh * 32 + 2 * q;
                w[q] = pk2(bf2f(KB[ta * 136 + dk]) * __expf(g63 - GC[ta]), bf2f(KB[(ta + 1) * 136 + dk]) * __expf(g63 - GC[ta + 1])); }
            bf16* dp = GA4 + (size_t)item * 128 * 64;
            *(uint4*)(dp + frag_off(dk, hh * 32, 2)) = make_uint4(w[0], w[1], w[2], w[3]); *(uint4*)(dp + frag_off(dk, hh * 32 + 8, 2)) = make_uint4(w[4], w[5], w[6], w[7]);
            *(uint4*)(dp + frag_off(dk, hh * 32 + 16, 2)) = make_uint4(w[8], w[9], w[10], w[11]); *(uint4*)(dp + frag_off(dk, hh * 32 + 24, 2)) = make_uint4(w[12], w[13], w[14], w[15]);
            if (ht == 0) GGL[item] = __expf(g63);
        }
    }
}

constexpr int RCL_HALF_BYTES = 75776;
__device__ __forceinline__ void ph_rcl(const Ctx& c) {
    const bf16* RKV = c.ws<bf16>(WS_RKV); const float* LW = c.ws<float>(WS_LW); const float* AAg = c.ws<float>(WS_AA);
    const float* mu = c.P.in[I_MU]; const float* k_k = c.P.in[I_KK]; const float* k_a = c.P.in[I_KA]; const float* r_k = c.P.in[I_RK];
    bf16* VP = c.ws<bf16>(WS_VP); float* SC = c.ws<float>(WS_SC);
    bf16* RA1 = c.ws<bf16>(WS_RA1); bf16* RX0 = c.ws<bf16>(WS_RX0); bf16* RA2 = c.ws<bf16>(WS_RA2); bf16* RA3 = c.ws<bf16>(WS_RA3); bf16* RO0 = c.ws<bf16>(WS_RO0);
    bf16* RA4 = c.ws<bf16>(WS_RA4); bf16* RS0 = c.ws<bf16>(WS_RS0); float* RDSC = c.ws<float>(WS_RDSC);
    unsigned long long ts_t0 = 0ull, ts_acc = 0ull;
#define TSMARK(k) do { if (TS_BEGIN >= 0 && blockIdx.x == 0 && c.tid == 0) { const unsigned long long now_ = __builtin_amdgcn_s_memrealtime(); \
        if ((k) == TS_END && ts_t0 != 0ull) ts_acc += now_ - ts_t0; if ((k) == TS_BEGIN) ts_t0 = now_; } } while (0)
    uint4 ur[2], uk[2], uv[2]; float4 a4v[4], l4v[4];
#define RCL_LOAD(ITEM, TID) do { const int it_ = (ITEM), ht_ = (TID) & 255, n_ = it_ & 63, bh_ = it_ >> 6, h_ = bh_ & 15, b_ = bh_ >> 4; \
        const int r_ = ht_ >> 2, c0_ = (ht_ & 3) * 16, t_ = b_ * SEQ + n_ * 64 + r_; \
        const bf16* cur_ = RKV + (size_t)t_ * 3072 + h_ * 64 + c0_; \
        _Pragma("unroll") for (int g = 0; g < 2; ++g) { ur[g] = *(const uint4*)(cur_ + 8 * g); uk[g] = *(const uint4*)(cur_ + 1024 + 8 * g); uv[g] = *(const uint4*)(cur_ + 2048 + 8 * g); } \
        _Pragma("unroll") for (int q = 0; q < 4; ++q) { l4v[q] = *(const float4*)(LW + (size_t)t_ * 1024 + h_ * 64 + c0_ + 4 * q); a4v[q] = *(const float4*)(AAg + (size_t)t_ * 1024 + h_ * 64 + c0_ + 4 * q); } \
    } while (0)
    if ((int)(blockIdx.x * 2) < 4096) RCL_LOAD(blockIdx.x * 2 + (c.tid >> 8), c.tid);
    for (int it0 = blockIdx.x * 2; it0 < 4096; it0 += gridDim.x * 2) {
        int tv = c.tid; asm volatile("" : "+v"(tv));
        const int half = tv >> 8, ht = tv & 255, lane = tv & 63, w4 = __builtin_amdgcn_readfirstlane((tv >> 6) & 3);
        unsigned char* base = c.lds + half * RCL_HALF_BYTES;
        bf16* AT = (bf16*)base;
        bf16* VT = AT + 64 * 72;
        bf16* KDT = VT + 64 * 72;
        float* AAB = (float*)(KDT + 64 * 72);
        float* TOT = AAB + 64 * 64;
        unsigned char* RX = (unsigned char*)(TOT + 256);
        bf16* RT = (bf16*)RX;
        bf16* BTL = RT + 64 * 72;
        bf16* KT = BTL + 64 * 72;
        bf16* AAK = (bf16*)RX;
        bf16* ARK = AAK + 64 * 72;
        float* RHS2 = (float*)RX;
        const int item = it0 + half, n = item & 63, bh = item >> 6, h = bh & 15, b = bh >> 4;
        const int t0 = b * SEQ + n * 64;
        __syncthreads();
        TSMARK(0);
        const int r = ht >> 2, seg = ht & 3, c0 = seg * 16, t = t0 + r; const bool first = (n == 0 && r == 0);
        float rr[16], kf[16], vv[16], kkv[16], aa[16], lwl[16], bdv[16];
        float ss = 0.f, scs = 0.f;
        {
            float4 mr[4], mk[4], mv[4], kkw[4], kaw[4], rkw[4];
            uint4 qr[2], qk[2], qv[2];
            {   const bf16* prv = RKV + (size_t)(t - 1) * 3072 + h * 64 + c0;
#pragma unroll
                for (int g = 0; g < 2; ++g) { qr[g] = make_uint4(0, 0, 0, 0); qk[g] = qr[g]; qv[g] = qr[g];
                    if (!first) { qr[g] = *(const uint4*)(prv + 8 * g); qk[g] = *(const uint4*)(prv + 1024 + 8 * g); qv[g] = *(const uint4*)(prv + 2048 + 8 * g); } } }
#pragma unroll
            for (int q = 0; q < 4; ++q) {
                mr[q] = *(const float4*)(mu + h * 64 + c0 + 4 * q); mk[q] = *(const float4*)(mu + 1024 + h * 64 + c0 + 4 * q); mv[q] = *(const float4*)(mu + 2048 + h * 64 + c0 + 4 * q);
                kkw[q] = *(const float4*)(k_k + h * 64 + c0 + 4 * q); kaw[q] = *(const float4*)(k_a + h * 64 + c0 + 4 * q); rkw[q] = *(const float4*)(r_k + h * 64 + c0 + 4 * q);
            }
#pragma unroll
            for (int q = 0; q < 4; ++q) *(float4*)(AAB + r * 64 + c0 + 4 * q) = l4v[q];
            __syncthreads();
            {
                const int ch = ht & 63, tq = ht >> 6;
                float run = 0.f;
#pragma unroll
                for (int i = 0; i < 16; ++i) { run += AAB[(tq * 16 + i) * 64 + ch]; AAB[(tq * 16 + i) * 64 + ch] = run; }
                TOT[tq * 64 + ch] = run;
            }
            __syncthreads();
            TSMARK(1);
#pragma unroll
            for (int q = 0; q < 4; ++q) {
                const int g = q >> 1; const bool hi = q & 1;
                const unsigned r_a = hi ? ur[g].z : ur[g].x, r_b = hi ? ur[g].w : ur[g].y, k_a_ = hi ? uk[g].z : uk[g].x, k_b_ = hi ? uk[g].w : uk[g].y, v_a = hi ? uv[g].z : uv[g].x, v_b = hi ? uv[g].w : uv[g].y;
                const unsigned pr_a = hi ? qr[g].z : qr[g].x, pr_b = hi ? qr[g].w : qr[g].y, pk_a = hi ? qk[g].z : qk[g].x, pk_b = hi ? qk[g].w : qk[g].y, pv_a = hi ? qv[g].z : qv[g].x, pv_b = hi ? qv[g].w : qv[g].y;
                const float r0a[4] = {bflo(r_a), bfhi(r_a), bflo(r_b), bfhi(r_b)}, k0a[4] = {bflo(k_a_), bfhi(k_a_), bflo(k_b_), bfhi(k_b_)}, v0a[4] = {bflo(v_a), bfhi(v_a), bflo(v_b), bfhi(v_b)};
                const float rpa[4] = {bflo(pr_a), bfhi(pr_a), bflo(pr_b), bfhi(pr_b)}, kpa[4] = {bflo(pk_a), bfhi(pk_a), bflo(pk_b), bfhi(pk_b)}, vpa[4] = {bflo(pv_a), bfhi(pv_a), bflo(pv_b), bfhi(pv_b)};
                const float mra[4] = {mr[q].x, mr[q].y, mr[q].z, mr[q].w}, mka[4] = {mk[q].x, mk[q].y, mk[q].z, mk[q].w}, mva[4] = {mv[q].x, mv[q].y, mv[q].z, mv[q].w};
                const float kka[4] = {kkw[q].x, kkw[q].y, kkw[q].z, kkw[q].w}, kaa[4] = {kaw[q].x, kaw[q].y, kaw[q].z, kaw[q].w}, rka[4] = {rkw[q].x, rkw[q].y, rkw[q].z, rkw[q].w};
                const float aaa[4] = {a4v[q].x, a4v[q].y, a4v[q].z, a4v[q].w}, lwa[4] = {l4v[q].x, l4v[q].y, l4v[q].z, l4v[q].w};
#pragma unroll
                for (int e = 0; e < 4; ++e) { const int i = 4 * q + e;
                    rr[i] = r0a[e] + (rpa[e] - r0a[e]) * mra[e]; const float kx = k0a[e] + (kpa[e] - k0a[e]) * mka[e]; vv[i] = v0a[e] + (vpa[e] - v0a[e]) * mva[e];
                    kkv[i] = kx * kka[e]; ss += kkv[i] * kkv[i]; aa[i] = aaa[e]; lwl[i] = lwa[e]; kf[i] = kx * (1.f + (aaa[e] - 1.f) * kaa[e]); scs += rr[i] * kf[i] * rka[e]; }
            }
        }
        {
            ss += __shfl_xor(ss, 1); ss += __shfl_xor(ss, 2); scs += __shfl_xor(scs, 1); scs += __shfl_xor(scs, 2);
            const float rn = rsqrtf(ss + 1e-6f);
            if (seg == 0) SC[(size_t)t * 16 + h] = scs;
            const int tq = r >> 4;
            unsigned wat[8], wbt[8], wkt[8], wrt[8], wvp[8];
            float atv[16], btv[16], ktv[16], rtv[16];
#pragma unroll
            for (int i = 0; i < 16; ++i) {
                const int ch = c0 + i;
                float off = 0.f;
#pragma unroll
                for (int q = 0; q < 3; ++q) off += (q < tq) ? TOT[q * 64 + ch] : 0.f;
                const float tot = TOT[ch] + TOT[64 + ch] + TOT[128 + ch] + TOT[192 + ch];
                const float cs = AAB[r * 64 + ch] + off;
                const float lwv = lwl[i];
                const float kk = kkv[i] * rn;
                const float e2 = __expf(-cs), e4 = __expf(tot - cs);
                atv[i] = kk * __expf(cs - lwv); btv[i] = -kk * aa[i] * e2; ktv[i] = kf[i] * e2; rtv[i] = rr[i] * __expf(cs);
                VT[ch * 72 + r] = f2bf(vv[i]);
                KDT[ch * 72 + r] = f2bf(kf[i] * e4);
                bdv[i] = -kk * aa[i] * e4;
                if (r == 63) RDSC[(size_t)item * 64 + ch] = __expf(tot);
            }
#pragma unroll
            for (int q = 0; q < 8; ++q) { wat[q] = pk2(atv[2 * q], atv[2 * q + 1]); wbt[q] = pk2(btv[2 * q], btv[2 * q + 1]); wkt[q] = pk2(ktv[2 * q], ktv[2 * q + 1]); wrt[q] = pk2(rtv[2 * q], rtv[2 * q + 1]); wvp[q] = pk2(vv[2 * q], vv[2 * q + 1]); }
            *(uint4*)(AT + r * 72 + c0) = make_uint4(wat[0], wat[1], wat[2], wat[3]); *(uint4*)(AT + r * 72 + c0 + 8) = make_uint4(wat[4], wat[5], wat[6], wat[7]);
            *(uint4*)(BTL + r * 72 + c0) = make_uint4(wbt[0], wbt[1], wbt[2], wbt[3]); *(uint4*)(BTL + r * 72 + c0 + 8) = make_uint4(wbt[4], wbt[5], wbt[6], wbt[7]);
            *(uint4*)(KT + r * 72 + c0) = make_uint4(wkt[0], wkt[1], wkt[2], wkt[3]); *(uint4*)(KT + r * 72 + c0 + 8) = make_uint4(wkt[4], wkt[5], wkt[6], wkt[7]);
            *(uint4*)(RT + r * 72 + c0) = make_uint4(wrt[0], wrt[1], wrt[2], wrt[3]); *(uint4*)(RT + r * 72 + c0 + 8) = make_uint4(wrt[4], wrt[5], wrt[6], wrt[7]);
            bf16* a2p = RA2 + (size_t)item * 64 * 64;
            *(uint4*)(a2p + frag_off(r, c0, 2)) = make_uint4(wrt[0], wrt[1], wrt[2], wrt[3]); *(uint4*)(a2p + frag_off(r, c0 + 8, 2)) = make_uint4(wrt[4], wrt[5], wrt[6], wrt[7]);
            bf16* vpp = VP + (size_t)t * 1024 + h * 64 + c0;
            *(uint4*)vpp = make_uint4(wvp[0], wvp[1], wvp[2], wvp[3]); *(uint4*)(vpp + 8) = make_uint4(wvp[4], wvp[5], wvp[6], wvp[7]);
        }
        __syncthreads();
        TSMARK(2);
        if (it0 + (int)gridDim.x * 2 < 4096) RCL_LOAD(item + (int)gridDim.x * 2, tv);
        {
            bf16* BDS = (bf16*)AAB;
#pragma unroll
            for (int i = 0; i < 16; ++i) BDS[(c0 + i) * 72 + r] = f2bf(bdv[i]);
        }
        const int fr = lane & 15, fq = lane >> 4;
        f32x4_t cab[4], cak[4], crb[4], crk[4];
        {
            const int j0t = w4 * 16;
            bf16x8_t bj[2], kj[2];
#pragma unroll
            for (int kb = 0; kb < 2; ++kb) { bj[kb] = *(const bf16x8_t*)(BTL + (j0t + fr) * 72 + kb * 32 + fq * 8); kj[kb] = *(const bf16x8_t*)(KT + (j0t + fr) * 72 + kb * 32 + fq * 8); }
#pragma unroll
            for (int it = 0; it < 4; ++it) {
                cab[it] = (f32x4_t){0.f, 0.f, 0.f, 0.f}; cak[it] = cab[it]; crb[it] = cab[it]; crk[it] = cab[it];
#pragma unroll
                for (int kb = 0; kb < 2; ++kb) {
                    const bf16x8_t ai = *(const bf16x8_t*)(AT + (it * 16 + fr) * 72 + kb * 32 + fq * 8);
                    const bf16x8_t ri = *(const bf16x8_t*)(RT + (it * 16 + fr) * 72 + kb * 32 + fq * 8);
                    cab[it] = MFMA16(bj[kb], ai, cab[it]); cak[it] = MFMA16(kj[kb], ai, cak[it]); crb[it] = MFMA16(bj[kb], ri, crb[it]); crk[it] = MFMA16(kj[kb], ri, crk[it]);
                }
            }
        }
        __syncthreads();
        {
            const bf16* BDS = (const bf16*)AAB; bf16* bp = RA4 + (size_t)item * 64 * 64;
#pragma unroll
            for (int q = 0; q < 2; ++q) { const int p = ht + 256 * q, pfr = p & 15, pfq = (p >> 4) & 3, pkb = (p >> 6) & 1, prt = p >> 7;
                *(uint4*)(bp + p * 8) = *(const uint4*)(BDS + (prt * 16 + pfr) * 72 + pkb * 32 + pfq * 8); }
        }
        __syncthreads();
        {
            const int j0 = w4 * 16 + 4 * fq;
#pragma unroll
            for (int it = 0; it < 4; ++it) {
                const int i = it * 16 + fr;
                float vab[4], vak[4], vrb[4], vrk[4];
#pragma unroll
                for (int rg = 0; rg < 4; ++rg) { const int j = j0 + rg; const bool st = i > j, in = i >= j;
                    vab[rg] = st ? cab[it][rg] : 0.f; vak[rg] = st ? cak[it][rg] : 0.f; vrb[rg] = in ? crb[it][rg] : 0.f; vrk[rg] = in ? crk[it][rg] : 0.f; }
                *(float4*)(AAB + i * 64 + j0) = make_float4(vab[0], vab[1], vab[2], vab[3]);
                uint2 w; w.x = pk2(vak[0], vak[1]); w.y = pk2(vak[2], vak[3]); *(uint2*)(AAK + i * 72 + j0) = w;
                w.x = pk2(vrk[0], vrk[1]); w.y = pk2(vrk[2], vrk[3]); *(uint2*)(ARK + i * 72 + j0) = w;
                w.x = pk2(vrb[0], vrb[1]); w.y = pk2(vrb[2], vrb[3]); *(uint2*)(RA3 + (size_t)item * 64 * 64 + frag_off(i, j0, 2)) = w;
            }
        }
        __syncthreads();
        f32x4_t cav[4], cov[4], ckv[4];
        {
            const int r0t = w4 * 16;
            bf16x8_t fa[2], fo[2], fk[2];
#pragma unroll
            for (int kb = 0; kb < 2; ++kb) { fa[kb] = *(const bf16x8_t*)(AAK + (r0t + fr) * 72 + kb * 32 + fq * 8); fo[kb] = *(const bf16x8_t*)(ARK + (r0t + fr) * 72 + kb * 32 + fq * 8); fk[kb] = *(const bf16x8_t*)(KDT + (r0t + fr) * 72 + kb * 32 + fq * 8); }
#pragma unroll
            for (int vt = 0; vt < 4; ++vt) {
                cav[vt] = (f32x4_t){0.f, 0.f, 0.f, 0.f}; cov[vt] = cav[vt]; ckv[vt] = cav[vt];
#pragma unroll
                for (int kb = 0; kb < 2; ++kb) { const bf16x8_t vb = *(const bf16x8_t*)(VT + (vt * 16 + fr) * 72 + kb * 32 + fq * 8);
                    cav[vt] = MFMA16(fa[kb], vb, cav[vt]); cov[vt] = MFMA16(fo[kb], vb, cov[vt]); ckv[vt] = MFMA16(fk[kb], vb, ckv[vt]); }
            }
        }
        __syncthreads();
        {
            const int r0 = w4 * 16 + 4 * fq;
#pragma unroll
            for (int vt = 0; vt < 4; ++vt) {
                const int v = vt * 16 + fr;
#pragma unroll
                for (int rg = 0; rg < 4; ++rg) RHS2[v * 65 + r0 + rg] = cav[vt][rg];
                { uint2 w; w.x = pk2(cov[vt][0], cov[vt][1]); w.y = pk2(cov[vt][2], cov[vt][3]); *(uint2*)(RO0 + (size_t)item * 64 * 64 + cfrag_off(v, r0, 4)) = w; }
                { uint2 w; w.x = pk2(ckv[vt][0], ckv[vt][1]); w.y = pk2(ckv[vt][2], ckv[vt][3]); *(uint2*)(RS0 + (size_t)item * 64 * 64 + cfrag_off(v, r0, 4)) = w; }
            }
        }
        __syncthreads();
        TSMARK(3);
        {
            const int col = ht >> 1, p = ht & 1, cc = col & 63; const bool isu = col >= 64;
            float xs[32];
#pragma unroll
            for (int i = 0; i < 32; ++i) xs[i] = 0.f;
            float4 mc[8], mn[8];
#pragma unroll
            for (int q = 0; q < 8; ++q) { mc[q] = make_float4(0.f, 0.f, 0.f, 0.f); mn[q] = mc[q]; }
            float rhs_n; { const float rv = RHS2[(isu ? cc : 0) * 65], av = bf2f(AT[(isu ? 0 : cc)]); rhs_n = isu ? rv : av; }
#pragma unroll
            for (int i = 0; i < 64; ++i) {
                const float rhs = rhs_n;
                if (i + 1 < 64) {
#pragma unroll
                    for (int q = 0; q < (i + 8) / 8; ++q) mn[q] = *(const float4*)(AAB + (i + 1) * 64 + 8 * q + 4 * p);
                    const float rv = RHS2[(isu ? cc : 0) * 65 + i + 1], av = bf2f(AT[(i + 1) * 72 + (isu ? 0 : cc)]); rhs_n = isu ? rv : av;
                }
                float a0 = 0.f, a1 = 0.f, a2 = 0.f, a3 = 0.f;
#pragma unroll
                for (int q = 0; q < (i + 7) / 8; ++q) { a0 += mc[q].x * xs[4 * q]; a1 += mc[q].y * xs[4 * q + 1]; a2 += mc[q].z * xs[4 * q + 2]; a3 += mc[q].w * xs[4 * q + 3]; }
                float tot = (a0 + a1) + (a2 + a3);
                tot += dpp_xor1(tot);
                const float xi = rhs + tot;
                const int g = i >> 2, slot = (g >> 1) * 4 + (i & 3);
                xs[slot] = (p == (g & 1)) ? xi : xs[slot];
#pragma unroll
                for (int q = 0; q < 8; ++q) mc[q] = mn[q];
                asm volatile("" ::: "memory");
            }
            if (isu) {
                bf16* up = RX0 + (size_t)item * 64 * 64;
#pragma unroll
                for (int q = 0; q < 8; ++q) { uint2 w; w.x = pk2(xs[4 * q], xs[4 * q + 1]); w.y = pk2(xs[4 * q + 2], xs[4 * q + 3]); *(uint2*)(up + cfrag_off(cc, 4 * (2 * q + p), 4)) = w; }
            }
            __syncthreads();
            TSMARK(4);
            if (!isu) {
#pragma unroll
                for (int q = 0; q < 8; ++q)
#pragma unroll
                    for (int e = 0; e < 4; ++e) AT[(4 * (2 * q + p) + e) * 72 + cc] = f2bf(xs[4 * q + e]);
            }
        }
        __syncthreads();
        {
            bf16* wp = RA1 + (size_t)item * 64 * 64;
#pragma unroll
            for (int q = 0; q < 2; ++q) { const int p = ht + 256 * q, fr = p & 15, fq = (p >> 4) & 3, kb = (p >> 6) & 1, rt = p >> 7;
                *(uint4*)(wp + p * 8) = *(const uint4*)(AT + (rt * 16 + fr) * 72 + kb * 32 + fq * 8); }
        }
    }
    if (TS_BEGIN >= 0 && blockIdx.x == 0 && c.tid == 0) c.ws<unsigned>(WS_CTL)[CW_TS] = (unsigned)ts_acc;
#undef TSMARK
#undef RCL_LOAD
}

template <int DK, bool RW>
struct ScanArgs { const bf16* A1; const bf16* X0; const bf16* A2; const bf16* A3; const bf16* O0; const bf16* A4; const bf16* S0; const float* DSC; float* OUT; int item0; int vs; int tok0; int ocol0; };
#define LBAR() do { asm volatile("s_waitcnt lgkmcnt(0)" ::: "memory"); __builtin_amdgcn_s_barrier(); asm volatile("" ::: "memory"); } while (0)
template <int DK, bool RW>
__device__ __forceinline__ void scan_run(const Ctx& c, const ScanArgs<DK, RW>& a) {
    constexpr int KB = DK / 32;
    constexpr int NST = DK / 64;
    constexpr int NV = RW ? 64 : 128;
    constexpr int SROW = DK + 8;
    bf16* ST = (bf16*)c.lds;
    bf16* XT = ST + 2 * 32 * SROW;
    const int lane = c.lane, w = c.wave, fr = lane & 15, fq = lane >> 4;
    const int tm = w >> 1, tn = w & 1;
    const int dkt = (NST == 2) ? w : (w >> 1);
    for (int i = c.tid; i < 32 * SROW / 2; i += NTHREADS) ((unsigned*)ST)[i] = 0u;
    f32x4_t accS[NST];
#pragma unroll
    for (int s = 0; s < NST; ++s) accS[s] = (f32x4_t){0.f, 0.f, 0.f, 0.f};
    bf16x8_t a1f[KB], a2f[KB], a3f[2], a4f[2]; f32x4_t x0v, o0v, s0v[NST], dscv;
#define SCAN_LOAD(IT) do { const size_t it_ = (size_t)(IT); \
        _Pragma("unroll") for (int kb = 0; kb < KB; ++kb) { a1f[kb] = *(const bf16x8_t*)(a.A1 + it_ * 64 * DK + ((tm * KB + kb) * 64 + lane) * 8); a2f[kb] = *(const bf16x8_t*)(a.A2 + it_ * 64 * DK + ((tm * KB + kb) * 64 + lane) * 8); } \
        _Pragma("unroll") for (int kb = 0; kb < 2; ++kb) { a3f[kb] = *(const bf16x8_t*)(a.A3 + it_ * 64 * 64 + ((tm * 2 + kb) * 64 + lane) * 8); a4f[kb] = *(const bf16x8_t*)(a.A4 + it_ * DK * 64 + ((dkt * 2 + kb) * 64 + lane) * 8); } \
        { const uint2 q_ = *(const uint2*)(a.X0 + it_ * NV * 64 + (((a.vs * 2 + tn) * 4 + tm) * 64 + lane) * 4); x0v = (f32x4_t){bflo(q_.x), bfhi(q_.x), bflo(q_.y), bfhi(q_.y)}; } \
        if (RW) { { const uint2 q_ = *(const uint2*)(a.O0 + it_ * NV * 64 + (((a.vs * 2 + tn) * 4 + tm) * 64 + lane) * 4); o0v = (f32x4_t){bflo(q_.x), bfhi(q_.x), bflo(q_.y), bfhi(q_.y)}; } \
                  _Pragma("unroll") for (int s = 0; s < NST; ++s) { const uint2 q_ = *(const uint2*)(a.S0 + it_ * 64 * DK + (((a.vs * 2 + (NST == 2 ? s : tn)) * (DK / 16) + dkt) * 64 + lane) * 4); s0v[s] = (f32x4_t){bflo(q_.x), bfhi(q_.x), bflo(q_.y), bfhi(q_.y)}; } \
                  dscv = *(const f32x4_t*)(a.DSC + it_ * DK + dkt * 16 + 4 * fq); } \
        else { const float g_ = a.DSC[it_]; dscv = (f32x4_t){g_, g_, g_, g_}; o0v = (f32x4_t){0.f, 0.f, 0.f, 0.f}; _Pragma("unroll") for (int s = 0; s < NST; ++s) s0v[s] = (f32x4_t){0.f, 0.f, 0.f, 0.f}; } \
    } while (0)
    SCAN_LOAD(a.item0);
    int cur = 0;
    for (int n = 0; n < 64; ++n) {
        bf16x8_t b1[KB], b2[KB], b3[2], b4[2];
#pragma unroll
        for (int kb = 0; kb < KB; ++kb) { b1[kb] = a1f[kb]; b2[kb] = a2f[kb]; }
        b3[0] = a3f[0]; b3[1] = a3f[1]; b4[0] = a4f[0]; b4[1] = a4f[1];
        f32x4_t accX = x0v, accO = o0v; const f32x4_t dv = dscv; f32x4_t sv[NST];
#pragma unroll
        for (int s = 0; s < NST; ++s) sv[s] = s0v[s];
        if (n + 1 < 64) SCAN_LOAD(a.item0 + n + 1);
        LBAR();
        const bf16* Sc = ST + cur * 32 * SROW; bf16* Sn = ST + (cur ^ 1) * 32 * SROW;
        bf16x8_t sf[KB];
#pragma unroll
        for (int kb = 0; kb < KB; ++kb) sf[kb] = *(const bf16x8_t*)(Sc + (tn * 16 + fr) * SROW + kb * 32 + fq * 8);
#pragma unroll
        for (int kb = 0; kb < KB; ++kb) accX = MFMA16(b1[kb], sf[kb], accX);
        { uint2 wv; wv.x = pk2(accX[0], accX[1]); wv.y = pk2(accX[2], accX[3]); *(uint2*)(XT + (tn * 16 + fr) * 72 + tm * 16 + 4 * fq) = wv; }
#pragma unroll
        for (int kb = 0; kb < KB; ++kb) accO = MFMA16(b2[kb], sf[kb], accO);
        LBAR();
        bf16x8_t xf[2];
#pragma unroll
        for (int kb = 0; kb < 2; ++kb) xf[kb] = *(const bf16x8_t*)(XT + (tn * 16 + fr) * 72 + kb * 32 + fq * 8);
        accO = MFMA16(b3[0], xf[0], accO); accO = MFMA16(b3[1], xf[1], accO);
        {
            float* op = a.OUT + (size_t)(a.tok0 + n * 64 + tm * 16 + 4 * fq) * 1024 + a.ocol0 + tn * 16 + fr;
            op[0] = accO[0]; op[1024] = accO[1]; op[2048] = accO[2]; op[3072] = accO[3];
        }
#pragma unroll
        for (int s = 0; s < NST; ++s) {
            const int vt = (NST == 2) ? s : tn;
            bf16x8_t xg[2];
            if (vt == tn) { xg[0] = xf[0]; xg[1] = xf[1]; }
            else {
#pragma unroll
                for (int kb = 0; kb < 2; ++kb) xg[kb] = *(const bf16x8_t*)(XT + (vt * 16 + fr) * 72 + kb * 32 + fq * 8);
            }
            f32x4_t t = accS[s] * dv + sv[s];
            t = MFMA16(b4[0], xg[0], t); t = MFMA16(b4[1], xg[1], t);
            accS[s] = t;
            uint2 wv; wv.x = pk2(t[0], t[1]); wv.y = pk2(t[2], t[3]);
            *(uint2*)(Sn + (vt * 16 + fr) * SROW + dkt * 16 + 4 * fq) = wv;
        }
        cur ^= 1;
    }
#undef SCAN_LOAD
    __syncthreads();
}

__device__ __forceinline__ void ph_scan(const Ctx& c) {
    for (int wk = blockIdx.x; wk < 256; wk += gridDim.x) {
        const int xcd = wk & 7, j = wk >> 3;
        if (j < 16) {
            const int pair = xcd * 4 + (j >> 2), vs = j & 3, b = pair >> 3, h = pair & 7;
            ScanArgs<128, false> a{c.ws<bf16>(WS_GA1), c.ws<bf16>(WS_GX0), c.ws<bf16>(WS_GA2), c.ws<bf16>(WS_GA3), nullptr, c.ws<bf16>(WS_GA4), nullptr, c.ws<float>(WS_GGL),
                                   c.ws<float>(WS_OG), pair * 64, vs, b * SEQ, h * 128 + vs * 32};
            scan_run<128, false>(c, a);
        } else {
            const int pair = xcd * 8 + ((j - 16) >> 1), vs = (j - 16) & 1, b = pair >> 4, h = pair & 15;
            ScanArgs<64, true> a{c.ws<bf16>(WS_RA1), c.ws<bf16>(WS_RX0), c.ws<bf16>(WS_RA2), c.ws<bf16>(WS_RA3), c.ws<bf16>(WS_RO0), c.ws<bf16>(WS_RA4), c.ws<bf16>(WS_RS0), c.ws<float>(WS_RDSC),
                                 c.ws<float>(WS_ORW), pair * 64, vs, b * SEQ, h * 64 + vs * 32};
            scan_run<64, true>(c, a);
        }
    }
}

enum { PH_RMS0 = 0, PH_INPROJ, PH_GCL, PH_LORA, PH_RCL, PH_SCAN, PH_POST, PH_G2, PH_X1, PH_ROUTER, PH_DISPATCH, PH_MOE1, PH_MOE2, PH_COMBINE, PH_COUNT };

template <unsigned PHMASK>
__global__ void __launch_bounds__(NTHREADS) mk(Params P) {
    extern __shared__ __attribute__((aligned(16))) unsigned char lds[];
    volatile LAS unsigned* misc = (volatile LAS unsigned*)((LAS unsigned char*)lds + MISC_OFF);
    if (threadIdx.x < 64) misc[threadIdx.x] = 0u;
    __syncthreads();
    unsigned* ctl = (unsigned*)(P.ws + WS_CTL);
    XcdBarrier bar = xcd_barrier_post(ctl + CW_BAR + P.li * XCD_BAR_WORDS, misc);
#define MKCTX() int tv_ = threadIdx.x; asm volatile("" : "+v"(tv_)); const int wv_ = __builtin_amdgcn_readfirstlane(tv_ >> 6); \
    Ctx c{P, tv_, tv_ & 63, wv_, (int)(blockIdx.x * NWAVES + wv_), (int)(gridDim.x * NWAVES), (size_t)blockIdx.x * NTHREADS + tv_, (size_t)gridDim.x * NTHREADS, lds}
    bool first_seam = true;
#define IN(k) (((PHMASK >> (k)) & 1u) && P.ph_lo <= (k) && (k) < P.ph_hi)
#define SEAM(k) do { if ((k) + 1 < P.ph_hi) { xcd_barrier(bar); first_seam = false; } } while (0)
#define REP(k) for (int rep_ = 0; rep_ < ((k) == PROBE_REP ? 2 : 1); ++rep_)
    if (IN(PH_RMS0)) { MKCTX();
        REP(PH_RMS0) {
        ph_rms0(c);
        { WJob j{P.in[I_W_IN], NCOL_IN, 1024, 4096, c.ws<bf16>(WS_WIN_T), 1024, 1, 0, 0}; wconv_job(c, j); }
        { WJob j{P.in[I_W_IN] + 4112, NCOL_IN, 1024, 5376, c.ws<bf16>(WS_WIN_T) + (size_t)4096 * 1024, 1024, 1, 0, 0}; wconv_job(c, j); }
        lora_zero(c);
        { WJob j{P.in[I_W2], 1024, 64, 1024, c.ws<bf16>(WS_LORA_T), 256, 1, 0, 0}; wconv_job(c, j); }
        { WJob j{P.in[I_A2], 1024, 64, 1024, c.ws<bf16>(WS_LORA_T) + (size_t)1024 * 256 + 64, 256, 1, 0, 0}; wconv_job(c, j); }
        { WJob j{P.in[I_G2], 1024, 128, 1024, c.ws<bf16>(WS_LORA_T) + (size_t)2048 * 256 + 128, 256, 1, 0, 0}; wconv_job(c, j); }
        }
        SEAM(PH_RMS0);
    }
    if (IN(PH_INPROJ)) { MKCTX();
        REP(PH_INPROJ) {
        EpiInProj ep{c.ws<bf16>(WS_GQKV), c.ws<bf16>(WS_ZS), c.ws<bf16>(WS_RKV), c.ws<float>(WS_LIN), c.ws<bf16>(WS_GATES)};
        SchedInProj sc{(const char*)c.ws<bf16>(WS_HB), (const char*)c.ws<bf16>(WS_WIN_T), (int)gridDim.x, (int)blockIdx.x};
        pg8::gemm_phase((LAS unsigned char*)lds, 1024, sc, ep, c.tid);
        }
        SEAM(PH_INPROJ);
    }
    if (IN(PH_GCL)) { MKCTX(); REP(PH_GCL) { ph_gcl(c); ph_loraprep(c); } SEAM(PH_GCL); }
    if (IN(PH_LORA)) { MKCTX();
        REP(PH_LORA) {
        EpiLora ep{P.in[I_W0], P.in[I_A0], c.ws<float>(WS_LW), c.ws<float>(WS_AA), c.ws<bf16>(WS_GGR)};
        SchedLora sc{(const char*)c.ws<bf16>(WS_ALORA), (const char*)c.ws<bf16>(WS_LORA_T), (int)gridDim.x, (int)blockIdx.x};
        pg8::gemm_phase((LAS unsigned char*)lds, 256, sc, ep, c.tid);
        }
        SEAM(PH_LORA);
    }
    if (IN(PH_RCL)) { MKCTX(); REP(PH_RCL) { ph_rcl(c); } SEAM(PH_RCL); }
    if (IN(PH_SCAN)) { MKCTX(); REP(PH_SCAN) { ph_scan(c); } SEAM(PH_SCAN); }
    if (IN(PH_POST)) { MKCTX();
        REP(PH_POST) {
        ph_post(c);
        { WJob j{P.in[I_PROJ_A], 1024, 1024, 1024, c.ws<bf16>(WS_PROJ_T), 1024, 1, 0, 0}; wconv_job(c, j); }
        { WJob j{P.in[I_PROJ_B], 1024, 1024, 1024, c.ws<bf16>(WS_PROJ_T) + (size_t)1024 * 1024, 1024, 1, 0, 0}; wconv_job(c, j); }
        { WJob j{P.in[I_W_OUT], 1024, 1024, 1024, c.ws<bf16>(WS_WOUT_T), 1024, 1, 0, 0}; wconv_job(c, j); }
        }
        SEAM(PH_POST);
    }
    if (IN(PH_G2)) { MKCTX();
        REP(PH_G2) {
        EpiG2 ep{c.ws<bf16>(WS_GATES), c.ws<bf16>(WS_G2)};
        SchedG2 sc{(const char*)c.ws<bf16>(WS_YA), (const char*)c.ws<bf16>(WS_PROJ_T), (int)gridDim.x, (int)blockIdx.x};
        pg8::gemm_phase((LAS unsigned char*)lds, 1024, sc, ep, c.tid);
        }
        SEAM(PH_G2);
    }
    if (IN(PH_X1)) { MKCTX();
        REP(PH_X1) {
        EpiX1 ep{P.in[I_X], c.ws<float>(WS_X1)};
        SchedX1 sc{(const char*)c.ws<bf16>(WS_G2), (const char*)c.ws<bf16>(WS_WOUT_T), (int)gridDim.x, (int)blockIdx.x};
        pg8::gemm_phase((LAS unsigned char*)lds, 1024, sc, ep, c.tid);
        }
        SEAM(PH_X1);
    }
    if (IN(PH_ROUTER)) { MKCTX();
        ph_router(c);
        REP(PH_ROUTER) {
        { WJob j{P.in[I_W_GU], 2048, 1024, 2048, c.ws<bf16>(WS_WGU_T), 1024, 32, (size_t)1024 * 2048, (size_t)2048 * 1024}; wconv_job(c, j); }
        { WJob j{P.in[I_W_DOWN], 1024, 1024, 1024, c.ws<bf16>(WS_WDN_T), 1024, 32, (size_t)1024 * 1024, (size_t)1024 * 1024}; wconv_job(c, j); }
        }
        SEAM(PH_ROUTER);
    }
    if (IN(PH_DISPATCH)) { MKCTX(); REP(PH_DISPATCH) { ph_dispatch(c); } SEAM(PH_DISPATCH); }
    if (IN(PH_MOE1)) { MKCTX();
        REP(PH_MOE1) {
        const int nt = *c.ws<int>(WS_NT);
        EpiAct ep{P.in[I_B_GU], c.ws<bf16>(WS_ACT)};
        SchedMoe sc{(const char*)c.ws<bf16>(WS_H2), (const char*)c.ws<bf16>(WS_WGU_T), c.ws<int>(WS_TILE_E), c.ws<int>(WS_SLOT_TOK), nt, 8, (int)gridDim.x, (int)blockIdx.x};
        pg8::gemm_phase_t<true>((LAS unsigned char*)lds, 1024, sc, ep, c.tid);
        }
        SEAM(PH_MOE1);
    }
    if (IN(PH_MOE2)) { MKCTX();
        REP(PH_MOE2) {
        const int nt = *c.ws<int>(WS_NT);
        EpiYS ep{P.in[I_B_DOWN], c.ws<float>(WS_SGATE), c.ws<bf16>(WS_YS)};
        SchedMoe sc{(const char*)c.ws<bf16>(WS_ACT), (const char*)c.ws<bf16>(WS_WDN_T), c.ws<int>(WS_TILE_E), nullptr, nt, 4, (int)gridDim.x, (int)blockIdx.x};
        pg8::gemm_phase((LAS unsigned char*)lds, 1024, sc, ep, c.tid);
        }
        SEAM(PH_MOE2);
    }
    if (IN(PH_COMBINE)) { MKCTX(); REP(PH_COMBINE) { ph_combine(c); } }
#undef IN
#undef SEAM
#undef REP
#undef MKCTX
}

template <unsigned M> static void launch_one(const Params& p, int grid, hipStream_t stream) {
    static bool attr = false;
    if (!attr) { (void)hipFuncSetAttribute((const void*)mk<M>, hipFuncAttributeMaxDynamicSharedMemorySize, LDS_BYTES); attr = true; }
    hipLaunchKernelGGL(mk<M>, dim3(grid), dim3(NTHREADS), LDS_BYTES, stream, p);
}
template <int PH> static void launch_chain(Params& p, int grid, hipStream_t stream) {
    if constexpr (PH < PH_COUNT) { p.ph_lo = PH; p.ph_hi = PH + 1; p.li = 0; p.coop = 0; launch_one<(1u << PH)>(p, grid, stream); launch_chain<PH + 1>(p, grid, stream); }
}

extern "C" void kernel_launch(void* const* d_in, const int* in_sizes, int n_in, void* d_out, int out_size, void* d_ws, size_t ws_size, hipStream_t stream) {
    static int grid = 0;
    if (grid == 0) {
        int dev = 0, cus = 0, per_cu = 0;
        (void)hipGetDevice(&dev);
        (void)hipDeviceGetAttribute(&cus, hipDeviceAttributeMultiprocessorCount, dev);
#if MK_ONE_LAUNCH
        (void)hipFuncSetAttribute((const void*)mk<0xffffffffu>, hipFuncAttributeMaxDynamicSharedMemorySize, LDS_BYTES);
        (void)hipOccupancyMaxActiveBlocksPerMultiprocessor(&per_cu, (const void*)mk<0xffffffffu>, NTHREADS, LDS_BYTES);
#else
        per_cu = 1;
#endif
        if (n_in != 29 || ws_size < WS_END || per_cu < 1 || cus < 64) { fprintf(stderr, "kernel_launch: unexpected setup n_in %d ws %zu per_cu %d cus %d\n", n_in, ws_size, per_cu, cus); grid = -1; return; }
        grid = cus;
    }
    if (grid < 0) return;
    (void)hipMemsetAsync((char*)d_ws + WS_CTL, 0, CTL_BYTES, stream);
    Params p{};
    for (int i = 0; i < 29; ++i) p.in[i] = (const float*)d_in[i];
    p.out = (float*)d_out; p.ws = (unsigned char*)d_ws;
#if MK_ONE_LAUNCH
    p.ph_lo = 0; p.ph_hi = PH_COUNT; p.li = 0; p.coop = 1;
    void* args[] = {&p};
    hipError_t e = hipLaunchCooperativeKernel((const void*)mk<0xffffffffu>, dim3(grid), dim3(NTHREADS), args, LDS_BYTES, stream);
    if (e != hipSuccess) fprintf(stderr, "cooperative launch failed: %s (grid %d)\n", hipGetErrorString(e), grid);
#else
    launch_chain<0>(p, grid, stream);
#endif
}
```

```cpp
#include <hip/hip_runtime.h>
#include <hip/hip_cooperative_groups.h>
#include <cstdint>
#include <cstdio>
namespace cg = cooperative_groups;

#ifndef MK_ONE_LAUNCH
#define MK_ONE_LAUNCH 1
#endif

#define LAS __attribute__((address_space(3)))
#ifndef FAST_INPROJ
#define FAST_INPROJ 1
#endif
#ifndef FAST_MIX
#define FAST_MIX 1
#endif
#define TS_BEGIN -1
#define TS_END -1
#define PROBE_REP -1
constexpr int NTHREADS = 512;
constexpr int NWAVES = 8;
constexpr int LDS_BYTES = 155648;
constexpr int MISC_OFF = 153600;

constexpr int T = 16384, SEQ = 4096, D = 1024;
constexpr int NCOL_IN = 9488;
constexpr int NEXP = 32;
constexpr int MAXTILES = 288;
constexpr int MAXSLOTS = MAXTILES * 256;

enum { I_X = 0, I_NORM_MIX, I_W_IN, I_GDN_CONV, I_GDN_ALOG, I_GDN_DTB, I_GDN_NORM, I_MU, I_W0, I_W2, I_A0, I_A2, I_G2, I_KK, I_KA, I_RK,
       I_LNW, I_LNB, I_PROJ_A, I_PROJ_B, I_W_OUT, I_NORM_FFN, I_ROUTER_W, I_ROUTER_B, I_W_GU, I_B_GU, I_W_DOWN, I_B_DOWN, I_NORM_FINAL };

constexpr size_t MiB = 1u << 20;
constexpr size_t WS_CTL = 0, CTL_BYTES = 65536;
constexpr size_t WS_BETA = 1 * MiB;
constexpr size_t WS_GG = WS_BETA + 512 * 1024;
constexpr size_t WS_SC = 2 * MiB;
constexpr size_t WS_TE = 3 * MiB;
constexpr size_t WS_TG = WS_TE + 256 * 1024;
constexpr size_t WS_TP = WS_TG + 256 * 1024;
constexpr size_t WS_TSLOT = WS_TP + 256 * 1024;
constexpr size_t WS_SGATE = 4 * MiB;
constexpr size_t WS_SLOT_TOK = 4 * MiB + 512 * 1024;
constexpr size_t WS_TILE_E = 5 * MiB;
constexpr size_t WS_NT = WS_TILE_E + 4096;
constexpr size_t WS_HB = 8 * MiB;
constexpr size_t WS_H2 = WS_HB;
constexpr size_t WS_ZS = 40 * MiB;
constexpr size_t WS_GATES = 72 * MiB;
constexpr size_t WS_ALORA = 136 * MiB;
constexpr size_t WS_LW = 144 * MiB;
constexpr size_t WS_AA = 208 * MiB;
constexpr size_t WS_GGR = 272 * MiB;
constexpr size_t WS_VP = 304 * MiB;
constexpr size_t WS_Q = 336 * MiB;
constexpr size_t WS_QKVC = WS_Q;
constexpr size_t WS_RP = WS_Q, WS_KF = WS_Q + 64 * MiB, WS_KKN = WS_Q + 128 * MiB;
constexpr size_t WS_YA = WS_Q, WS_YB = WS_Q + 32 * MiB, WS_G2 = WS_Q + 64 * MiB, WS_X1 = WS_Q + 128 * MiB;
constexpr size_t WS_GQKV = 528 * MiB;
constexpr size_t WS_OG = 720 * MiB, WS_ORW = 784 * MiB;
constexpr size_t WS_RKV = 720 * MiB;
constexpr size_t WS_LIN = 912 * MiB;
constexpr size_t WS_DEC = 928 * MiB;
constexpr size_t WS_XB = 528 * MiB;
constexpr size_t WS_ACT = 672 * MiB;
constexpr size_t WS_YS = 816 * MiB;
constexpr size_t WS_WIN_T = 992 * MiB;
constexpr size_t WS_PROJ_T = 144 * MiB;
constexpr size_t WS_WOUT_T = 148 * MiB;
constexpr size_t WS_WGU_T = 72 * MiB;
constexpr size_t WS_WDN_T = 200 * MiB;
constexpr size_t WS_GA1 = 336 * MiB, WS_GX0 = 368 * MiB, WS_GA2 = 432 * MiB, WS_GA3 = 464 * MiB, WS_GA4 = 480 * MiB;
constexpr size_t WS_GGL = 6 * MiB;
constexpr size_t WS_RX0 = 528 * MiB, WS_RO0 = 592 * MiB, WS_RS0 = 656 * MiB;
constexpr size_t WS_RA1 = 8 * MiB, WS_RA2 = 928 * MiB, WS_RA3 = 960 * MiB, WS_RA4 = 992 * MiB;
constexpr size_t WS_RDSC = 7 * MiB;
constexpr size_t WS_LORA_T = 1012 * MiB;
constexpr size_t WS_END = 1024 * MiB;
constexpr int CW_BAR = 1024;
constexpr int CW_CNT = 256;
constexpr int CW_TS = 900;

#define XB_TMO      128
#define XB_XCNT(j)  (256  + 64 * (j))
#define XB_XSUB(j)  (1280 + 64 * (j))
#define XB_XGEN(j)  (2304 + 64 * (j))
#define XB_TOP      3328
#define XB_TOPGEN   3392
#define XCD_BAR_WORDS 3456
#define XB_SPIN_CAP (1u << 24)
__device__ __forceinline__ unsigned xb_ld(unsigned* p)              { return __hip_atomic_load(p, __ATOMIC_RELAXED, __HIP_MEMORY_SCOPE_AGENT); }
__device__ __forceinline__ unsigned xb_add(unsigned* p, unsigned v) { return __hip_atomic_fetch_add(p, v, __ATOMIC_RELAXED, __HIP_MEMORY_SCOPE_AGENT); }
__device__ __forceinline__ unsigned xb_xcc_id() { return (unsigned)__builtin_amdgcn_s_getreg((3 << 11) | 20) & 0xFu; }
#define XB_SPIN(cond, bar) do { unsigned _sp = 0; while (cond) { __builtin_amdgcn_s_sleep(1); \
    if ((++_sp & 255u) == 0u) { if (xb_ld(&(bar)[XB_TMO])) break; if (_sp > XB_SPIN_CAP) { atomicAdd(&(bar)[XB_TMO], 1u); break; } } } } while (0)
struct XcdBarrier { unsigned* bar; unsigned x; volatile LAS unsigned* st; };
__device__ __forceinline__ XcdBarrier xcd_barrier_post(unsigned* bar, volatile LAS unsigned* st) {
    XcdBarrier b; b.bar = bar; b.x = xb_xcc_id(); b.st = st;
    if (threadIdx.x == 0) (void)xb_add(&bar[XB_XCNT(b.x)], 1u);
    return b;
}
__device__ __forceinline__ void xcd_barrier_complete(unsigned* bar, unsigned x, unsigned& nloc, unsigned& nx) {
    const unsigned G = gridDim.x * gridDim.y * gridDim.z;
    unsigned sum, cnt, mine, sp = 0u;
    for (;;) {
        sum = 0u; cnt = 0u; mine = 0u;
#pragma unroll
        for (unsigned j = 0; j < 16; ++j) { const unsigned c = xb_ld(&bar[XB_XCNT(j)]); sum += c; cnt += (c > 0u) ? 1u : 0u; mine = (j == x) ? c : mine; }
        if (sum == G) break;
        __builtin_amdgcn_s_sleep(1);
        if ((++sp & 255u) == 0u) { if (xb_ld(&bar[XB_TMO])) break; if (sp > XB_SPIN_CAP) { atomicAdd(&bar[XB_TMO], 1u); break; } }
    }
    nloc = mine > 0u ? mine : 1u; nx = cnt > 0u ? cnt : 1u;
}
__device__ __forceinline__ void xcd_barrier(const XcdBarrier& b) {
    asm volatile("s_waitcnt vmcnt(0)" ::: "memory");
    __syncthreads();
    if (threadIdx.x == 0) {
        unsigned* bar = b.bar;
        __builtin_amdgcn_s_waitcnt(0);
        unsigned nloc = b.st[0], nx = b.st[1];
        if (nloc == 0u) { xcd_barrier_complete(bar, b.x, nloc, nx); b.st[0] = nloc; b.st[1] = nx; }
        const unsigned old = xb_add(&bar[XB_XSUB(b.x)], 1u);
        const unsigned gen = old / nloc;
        if (old + 1u == (gen + 1u) * nloc) {
            __builtin_amdgcn_fence(__ATOMIC_RELEASE, "agent");
            asm volatile("s_waitcnt vmcnt(0)" ::: "memory");
            const unsigned og = xb_add(&bar[XB_TOP], 1u);
            const unsigned tg = og / nx;
            if (og + 1u == (tg + 1u) * nx) xb_add(&bar[XB_TOPGEN], 1u);
            else XB_SPIN(xb_ld(&bar[XB_TOPGEN]) == tg, bar);
            __builtin_amdgcn_fence(__ATOMIC_ACQUIRE, "agent");
            xb_add(&bar[XB_XGEN(b.x)], 1u);
            asm volatile("s_waitcnt vmcnt(0)" ::: "memory");
        } else {
            XB_SPIN(xb_ld(&bar[XB_XGEN(b.x)]) == gen, bar);
            __builtin_amdgcn_fence(__ATOMIC_ACQUIRE, "agent");
            asm volatile("s_waitcnt vmcnt(0)" ::: "memory");
        }
    }
    __syncthreads();
}

typedef unsigned short bf16;
__device__ __forceinline__ bf16 f2bf(float f) { unsigned u = __float_as_uint(f); u += 0x7fffu + ((u >> 16) & 1u); return (bf16)(u >> 16); }
__device__ __forceinline__ float bf2f(unsigned b) { return __uint_as_float(b << 16); }
__device__ __forceinline__ unsigned pk2(float lo, float hi) { return (unsigned)f2bf(lo) | ((unsigned)f2bf(hi) << 16); }
__device__ __forceinline__ float bflo(unsigned w) { return __uint_as_float(w << 16); }
__device__ __forceinline__ float bfhi(unsigned w) { return __uint_as_float(w & 0xffff0000u); }
__device__ __forceinline__ float sigm(float x) { return 1.f / (1.f + expf(-x)); }
__device__ __forceinline__ float fsigm(float x) { return __builtin_amdgcn_rcpf(1.f + __expf(-x)); }
__device__ __forceinline__ float softplusf(float x) { return x > 20.f ? x : log1pf(expf(x)); }
__device__ __forceinline__ float dpp_xor1(float v) { return __int_as_float(__builtin_amdgcn_update_dpp(0, __float_as_int(v), 0xB1, 0xF, 0xF, false)); }
__device__ __forceinline__ float wsum(float v) {
#pragma unroll
    for (int o = 32; o > 0; o >>= 1) v += __shfl_xor(v, o);
    return v;
}

struct Params { const float* in[29]; float* out; unsigned char* ws; int ph_lo, ph_hi, li, coop; };

struct Ctx {
    const Params& P; int tid, lane, wave, gwave, nwaves; size_t gtid, nthreads; unsigned char* lds;
    template <class Tp> __device__ __forceinline__ Tp* ws(size_t off) const { return (Tp*)(P.ws + off); }
};

__device__ __forceinline__ void ph_rms0(const Ctx& c) {
    const float* x = c.P.in[I_X]; const float* nw = c.P.in[I_NORM_MIX]; const float* win = c.P.in[I_W_IN];
    const float* alog = c.P.in[I_GDN_ALOG]; const float* dtb = c.P.in[I_GDN_DTB];
    bf16* HB = c.ws<bf16>(WS_HB); float* BETA = c.ws<float>(WS_BETA); float* GGv = c.ws<float>(WS_GG);
    if (blockIdx.x == 0 && c.tid < NEXP) c.ws<unsigned>(WS_CTL)[CW_CNT + c.tid] = 0u;
    float4* tab = (float4*)c.lds;
    __syncthreads();
    for (int i = c.tid; i < 4096; i += NTHREADS) { const int k = i >> 2; tab[((k & 3) * 256 + (k >> 2)) * 5 + (i & 3)] = *(const float4*)(win + (size_t)k * NCOL_IN + 4096 + (i & 3) * 4); }
    __syncthreads();
    const int lane = c.lane;
    for (int t = c.gwave; t < T; t += c.nwaves) {
        float4 v[4]; float ss = 0.f;
#pragma unroll
        for (int i = 0; i < 4; ++i) { v[i] = ((const float4*)(x + (size_t)t * D))[lane + 64 * i]; ss += v[i].x * v[i].x + v[i].y * v[i].y + v[i].z * v[i].z + v[i].w * v[i].w; }
        ss = wsum(ss);
        const float rstd = rsqrtf(ss * (1.f / 1024.f) + 1e-6f);
        float acc[16];
#pragma unroll
        for (int j = 0; j < 16; ++j) acc[j] = 0.f;
#pragma unroll
        for (int i = 0; i < 4; ++i) {
            const float4 w4 = ((const float4*)nw)[lane + 64 * i];
            float h[4] = {v[i].x * rstd * w4.x, v[i].y * rstd * w4.y, v[i].z * rstd * w4.z, v[i].w * rstd * w4.w};
            uint2 st; st.x = pk2(h[0], h[1]); st.y = pk2(h[2], h[3]);
            *(uint2*)(HB + (size_t)t * D + 4 * (lane + 64 * i)) = st;
#pragma unroll
            for (int ii = 0; ii < 4; ++ii) {
                const int k = 4 * (lane + 64 * i) + ii;
#pragma unroll
                for (int q = 0; q < 4; ++q) { const float4 w = tab[(ii * 256 + (k >> 2)) * 5 + q]; acc[4 * q + 0] += h[ii] * w.x; acc[4 * q + 1] += h[ii] * w.y; acc[4 * q + 2] += h[ii] * w.z; acc[4 * q + 3] += h[ii] * w.w; }
                if (ii & 1) asm volatile("" ::: "memory");
            }
        }
        float mine = 0.f;
#pragma unroll
        for (int j = 0; j < 16; ++j) { const float s = wsum(acc[j]); mine = (lane == j) ? s : mine; }
        if (lane < 8) BETA[t * 8 + lane] = sigm(mine);
        else if (lane < 16) { const int h = lane - 8; GGv[t * 8 + h] = -expf(alog[h]) * softplusf(mine + dtb[h]); }
    }
    __syncthreads();
}

struct NoLd {};
struct EpiInProj {
    typedef NoLd Ld; static constexpr int MB = 1;
    bf16* GQKV; bf16* ZS; bf16* RKV; float* LIN; bf16* GATES;
    __device__ __forceinline__ void load(Ld&, int, int, int) const {}
    __device__ __forceinline__ void store8(int row, int col, const float (&v)[8], int, const Ld&) const {
        if (col < 3072) { uint4 w; w.x = pk2(v[0], v[1]); w.y = pk2(v[2], v[3]); w.z = pk2(v[4], v[5]); w.w = pk2(v[6], v[7]); *(uint4*)(GQKV + (size_t)row * 3072 + col) = w; }
        else if (col < 4096) { uint4 w; w.x = pk2(v[0] * fsigm(v[0]), v[1] * fsigm(v[1])); w.y = pk2(v[2] * fsigm(v[2]), v[3] * fsigm(v[3])); w.z = pk2(v[4] * fsigm(v[4]), v[5] * fsigm(v[5])); w.w = pk2(v[6] * fsigm(v[6]), v[7] * fsigm(v[7]));
            *(uint4*)(ZS + (size_t)row * 1024 + (col - 3072)) = w; }
        else if (col < 7168) { uint4 w; w.x = pk2(v[0], v[1]); w.y = pk2(v[2], v[3]); w.z = pk2(v[4], v[5]); w.w = pk2(v[6], v[7]); *(uint4*)(RKV + (size_t)row * 3072 + (col - 4096)) = w; }
        else if (col < 7424) { float* p = LIN + (size_t)row * 256 + (col - 7168); *(float4*)p = make_float4(v[0], v[1], v[2], v[3]); *(float4*)(p + 4) = make_float4(v[4], v[5], v[6], v[7]); }
        else { uint4 w; w.x = pk2(fsigm(v[0]), fsigm(v[1])); w.y = pk2(fsigm(v[2]), fsigm(v[3])); w.z = pk2(fsigm(v[4]), fsigm(v[5])); w.w = pk2(fsigm(v[6]), fsigm(v[7]));
            *(uint4*)(GATES + (size_t)row * 2048 + (col - 7424)) = w; }
    }
};
struct EpiG2 {
    struct Ld { uint4 g; uint4 p; }; static constexpr int MB = 1;
    const bf16* GATES; bf16* MG;
    __device__ __forceinline__ void load(Ld& l, int row, int col, int) const { l.g = *(const uint4*)(GATES + (size_t)row * 2048 + col); const uint4 q = *(const uint4*)(MG + (size_t)row * 1024 + (col & 1023)); const bool b = col >= 1024; l.p = make_uint4(b ? q.x : 0u, b ? q.y : 0u, b ? q.z : 0u, b ? q.w : 0u); }
    __device__ __forceinline__ void store8(int row, int col, const float (&v)[8], int, const Ld& l) const {
        const uint4 g = l.g, p = l.p;
        uint4 w; w.x = pk2(v[0] * bflo(g.x) + bflo(p.x), v[1] * bfhi(g.x) + bfhi(p.x)); w.y = pk2(v[2] * bflo(g.y) + bflo(p.y), v[3] * bfhi(g.y) + bfhi(p.y));
        w.z = pk2(v[4] * bflo(g.z) + bflo(p.z), v[5] * bfhi(g.z) + bfhi(p.z)); w.w = pk2(v[6] * bflo(g.w) + bflo(p.w), v[7] * bfhi(g.w) + bfhi(p.w));
        *(uint4*)(MG + (size_t)row * 1024 + (col & 1023)) = w;
    }
};
struct EpiX1 {
    struct Ld { float4 a, b; }; static constexpr int MB = 2;
    const float* X; float* X1;
    __device__ __forceinline__ void load(Ld& l, int row, int col, int) const { const float* xp = X + (size_t)row * 1024 + col; l.a = *(const float4*)xp; l.b = *(const float4*)(xp + 4); }
    __device__ __forceinline__ void store8(int row, int col, const float (&v)[8], int, const Ld& l) const {
        float* op = X1 + (size_t)row * 1024 + col;
        const float4 a = l.a, b = l.b;
        *(float4*)op = make_float4(a.x + v[0], a.y + v[1], a.z + v[2], a.w + v[3]); *(float4*)(op + 4) = make_float4(b.x + v[4], b.y + v[5], b.z + v[6], b.w + v[7]);
    }
};
struct EpiAct {
    struct Ld { float4 b0, b1; }; static constexpr int MB = 4;
    const float* BGU; bf16* ACT;
    __device__ __forceinline__ void load(Ld& l, int, int col, int e) const { const float* bp = BGU + (size_t)e * 2048 + col; l.b0 = *(const float4*)bp; l.b1 = *(const float4*)(bp + 4); }
    __device__ __forceinline__ void store8(int row, int col, const float (&v)[8], int e, const Ld& l) const {
        const float4 b0 = l.b0, b1 = l.b1;
        const float bb[8] = {b0.x, b0.y, b0.z, b0.w, b1.x, b1.y, b1.z, b1.w};
        float o[4];
#pragma unroll
        for (int p = 0; p < 4; ++p) { float glu = v[2 * p] + bb[2 * p], lin = v[2 * p + 1] + bb[2 * p + 1]; glu = fminf(glu, 7.f); lin = fminf(fmaxf(lin, -7.f), 7.f); o[p] = glu * fsigm(1.702f * glu) * (lin + 1.f); }
        uint2 w; w.x = pk2(o[0], o[1]); w.y = pk2(o[2], o[3]);
        *(uint2*)(ACT + (size_t)row * 1024 + (col >> 1)) = w;
    }
};
struct EpiYS {
    struct Ld { float4 b0, b1; float g; }; static constexpr int MB = 4;
    const float* BD; const float* SGATE; bf16* YS;
    __device__ __forceinline__ void load(Ld& l, int row, int col, int e) const { const float* bp = BD + (size_t)e * 1024 + col; l.g = SGATE[row]; l.b0 = *(const float4*)bp; l.b1 = *(const float4*)(bp + 4); }
    __device__ __forceinline__ void store8(int row, int col, const float (&v)[8], int e, const Ld& l) const {
        const float g = l.g; const float4 b0 = l.b0, b1 = l.b1;
        uint4 w; w.x = pk2((v[0] + b0.x) * g, (v[1] + b0.y) * g); w.y = pk2((v[2] + b0.z) * g, (v[3] + b0.w) * g); w.z = pk2((v[4] + b1.x) * g, (v[5] + b1.y) * g); w.w = pk2((v[6] + b1.z) * g, (v[7] + b1.w) * g);
        *(uint4*)(YS + (size_t)row * 1024 + col) = w;
    }
};


namespace pg8 {
typedef short bf16x8 __attribute__((ext_vector_type(8)));
typedef float f32x4 __attribute__((ext_vector_type(4)));
constexpr int BM = 256, BK = 64, HALF = 128, HTB = HALF * BK * 2, NXCD = 8, WGM = 8;
__host__ __device__ __forceinline__ int lds_byte(int r, int c) { const int st = (r >> 4) * 2 + (c >> 5), rr = r & 15, cc = c & 31, ob = rr * 64 + cc * 2; return st * 1024 + (ob ^ (((ob >> 9) & 1) << 5)); }
__host__ __device__ __forceinline__ void stage_rc(int b, int& R, int& C) { const int st = b / 1024, sb = b % 1024, swz = sb ^ (((sb >> 9) & 1) << 5); R = (st >> 1) * 16 + swz / 64; C = (st & 1) * 32 + (swz % 64) / 2; }
__host__ __device__ __forceinline__ int perm32(int rho) { const int n = rho >> 4, i = rho & 15; return 8 * (i >> 2) + 4 * n + (i & 3); }
struct Unit { const char* a; const char* b; const int* rowmap; int row0, col0, aux; };
__device__ __forceinline__ void tile_order(int L, int nM, int nN, int& pm, int& pn) {
    const int nwg = nM * nN; int wgid = L; { const int q = nwg / NXCD, r = nwg % NXCD, xcd = wgid % NXCD, off = wgid / NXCD; wgid = (xcd < r ? xcd * (q + 1) : r * (q + 1) + (xcd - r) * q) + off; }
    const int nig = WGM * nN, gid = wgid / nig, fm = gid * WGM, gsz = (nM - fm) < WGM ? (nM - fm) : WGM;
    pm = fm + ((wgid % nig) % gsz); pn = (wgid % nig) / gsz;
}
template <class Epi>
__device__ __forceinline__ void epi_apply(const Epi& E, const f32x4 (&acc)[2][2][4][2], const Unit& u, int wr, int wc, int fr, int fq) {
    constexpr int MB = Epi::MB;
#pragma unroll
    for (int ai = 0; ai < 2; ++ai)
#pragma unroll
        for (int mp = 0; mp < 4 / MB; ++mp) {
            typename Epi::Ld ld[MB][2];
#pragma unroll
            for (int mm = 0; mm < MB; ++mm)
#pragma unroll
                for (int bj = 0; bj < 2; ++bj) E.load(ld[mm][bj], u.row0 + ai * HALF + wr * 64 + (mp * MB + mm) * 16 + fr, u.col0 + bj * HALF + wc * 32 + 8 * fq, u.aux);
#pragma unroll
            for (int mm = 0; mm < MB; ++mm)
#pragma unroll
                for (int bj = 0; bj < 2; ++bj) {
                    const int m = mp * MB + mm;
                    const f32x4 x0 = acc[ai][bj][m][0], x1 = acc[ai][bj][m][1];
                    const float v[8] = {x0[0], x0[1], x0[2], x0[3], x1[0], x1[1], x1[2], x1[3]};
                    E.store8(u.row0 + ai * HALF + wr * 64 + m * 16 + fr, u.col0 + bj * HALF + wc * 32 + 8 * fq, v, u.aux, ld[mm][bj]);
                }
            asm volatile("" ::: "memory");
        }
}
template <bool GATHER, class Epi, class Sched>
__device__ __forceinline__ void gemm_phase_t(LAS unsigned char* lds, const int K_, const Sched& S, const Epi& E, const int tid) {
    int K = K_; asm volatile("" : "+s"(K));
    const int wid = __builtin_amdgcn_readfirstlane(tid >> 6), lane = tid & 63, wr = wid >> 2, wc = wid & 3, fr = lane & 15, fq = lane >> 4;
    const int nt = K / BK;
    unsigned voffA[2], voffB[2];
#pragma unroll
    for (int i = 0; i < 2; ++i) { int R, C; stage_rc(tid * 16 + i * 8192, R, C); const int Rb = (R & ~31) + perm32(R & 31);
        voffA[i] = (unsigned)(R * K + C) * 2u; voffB[i] = (unsigned)(Rb * K + C) * 2u; }
    const size_t kstep = (size_t)(BK * 2);
    const size_t hstep = (size_t)HALF * K * 2;
    const unsigned ldsw = (unsigned)wid * 1024u;
    const int aoff = lds_byte(wr * 64 + fr, fq * 8), boff = lds_byte(wc * 32 + fr, fq * 8);
#define PG8_SA(b, h) (((b) * 2 + (h)) * HTB)
#define PG8_SB(b, h) ((4 + (b) * 2 + (h)) * HTB)
#define PG8_STAGE(bufoff, gbase, voff) do { _Pragma("unroll") for (int _i = 0; _i < 2; ++_i) \
        __builtin_amdgcn_global_load_lds((const unsigned*)((const char*)(gbase) + (voff)[_i]), (LAS unsigned*)(lds + (bufoff) + ldsw + _i * 8192), 16, 0, 0); } while (0)
#define PG8_LDA(dst, b, h) do { _Pragma("unroll") for (int m = 0; m < 4; ++m) _Pragma("unroll") for (int k = 0; k < 2; ++k) dst[m][k] = *(const LAS bf16x8*)(lds + PG8_SA(b, h) + aoff + m * 2048 + k * 1024); } while (0)
#define PG8_LDB(dst, b, h) do { _Pragma("unroll") for (int n = 0; n < 2; ++n) _Pragma("unroll") for (int k = 0; k < 2; ++k) dst[n][k] = *(const LAS bf16x8*)(lds + PG8_SB(b, h) + boff + n * 2048 + k * 1024); } while (0)
#define PG8_MMA(ai, bj, At, Bt) do { __builtin_amdgcn_s_setprio(1); _Pragma("unroll") for (int m = 0; m < 4; ++m) _Pragma("unroll") for (int n = 0; n < 2; ++n) _Pragma("unroll") for (int k = 0; k < 2; ++k) \
        acc[ai][bj][m][n] = __builtin_amdgcn_mfma_f32_16x16x32_bf16(Bt[n][k], At[m][k], acc[ai][bj][m][n], 0, 0, 0); __builtin_amdgcn_s_setprio(0); } while (0)
#define PG8_WAIT_V(n) asm volatile("s_waitcnt vmcnt(" #n ")" ::: "memory")
#define PG8_WAIT_L(n) asm volatile("s_waitcnt lgkmcnt(" #n ")" ::: "memory")
#define PG8_BAR __builtin_amdgcn_s_barrier()
#define PG8_SCHED __builtin_amdgcn_sched_barrier(0)
    Unit cur, nxt; int ui = 0;
    if (!S.next(0, cur)) return;
    f32x4 acc[2][2][4][2];
#pragma unroll
    for (int a = 0; a < 2; ++a)
#pragma unroll
        for (int b = 0; b < 2; ++b)
#pragma unroll
            for (int m = 0; m < 4; ++m)
#pragma unroll
                for (int n = 0; n < 2; ++n) acc[a][b][m][n] = (f32x4){0.f, 0.f, 0.f, 0.f};
    bf16x8 At[4][2], B0[2][2], B1[2][2];
    const char* cA = cur.a; const char* cB = cur.b;
    unsigned oc_lo[2] = {0u, 0u}, oc_hi[2] = {0u, 0u}, on_lo[2] = {0u, 0u}, on_hi[2] = {0u, 0u};
#define PG8_ROWOFF(U, LO, HI) do { _Pragma("unroll") for (int _i = 0; _i < 2; ++_i) { int R_, C_; stage_rc(tid * 16 + _i * 8192, R_, C_); \
        LO[_i] = (unsigned)((U).rowmap[R_] * K + C_) * 2u; HI[_i] = (unsigned)((U).rowmap[R_ + 128] * K + C_) * 2u; } } while (0)
    if constexpr (GATHER) PG8_ROWOFF(cur, oc_lo, oc_hi);
    PG8_STAGE(PG8_SB(0, 0), cB, voffB);
    if constexpr (GATHER) PG8_STAGE(PG8_SA(0, 0), cA, oc_lo); else PG8_STAGE(PG8_SA(0, 0), cA, voffA);
    PG8_STAGE(PG8_SB(0, 1), cB + hstep, voffB);
    if constexpr (GATHER) PG8_STAGE(PG8_SA(0, 1), cA, oc_hi); else PG8_STAGE(PG8_SA(0, 1), cA + hstep, voffA);
    if (wr == 1) PG8_BAR;
    PG8_WAIT_V(4); PG8_BAR;
    PG8_STAGE(PG8_SB(1, 0), cB + kstep, voffB);
    if constexpr (GATHER) PG8_STAGE(PG8_SA(1, 0), cA + kstep, oc_lo); else PG8_STAGE(PG8_SA(1, 0), cA + kstep, voffA);
    PG8_STAGE(PG8_SB(1, 1), cB + hstep + kstep, voffB);
    PG8_WAIT_V(6); PG8_BAR;
    for (;;) {
        const bool has_next = S.next(ui + 1, nxt);
        const char* nA = has_next ? nxt.a : cA; const char* nB = has_next ? nxt.b : cB;
        if constexpr (GATHER) { if (has_next) PG8_ROWOFF(nxt, on_lo, on_hi); else { on_lo[0] = oc_lo[0]; on_lo[1] = oc_lo[1]; on_hi[0] = oc_hi[0]; on_hi[1] = oc_hi[1]; } }
#pragma unroll 1
        for (int t = 0; t < nt; t += 2) {
            const bool last = (t == nt - 2);
            const char* a1 = cA + (size_t)(t + 1) * kstep;
            const char* a2 = last ? nA : cA + (size_t)(t + 2) * kstep; const char* b2 = last ? nB : cB + (size_t)(t + 2) * kstep;
            const char* a3 = a2 + kstep; const char* b3 = b2 + kstep;
            unsigned o2lo[2], o2hi[2];
            o2lo[0] = last ? on_lo[0] : oc_lo[0]; o2lo[1] = last ? on_lo[1] : oc_lo[1]; o2hi[0] = last ? on_hi[0] : oc_hi[0]; o2hi[1] = last ? on_hi[1] : oc_hi[1];
            PG8_LDB(B0, 0, 0); PG8_SCHED; PG8_LDA(At, 0, 0); if constexpr (GATHER) PG8_STAGE(PG8_SA(1, 1), a1, oc_hi); else PG8_STAGE(PG8_SA(1, 1), a1 + hstep, voffA);
            PG8_WAIT_L(8); PG8_BAR; PG8_WAIT_L(0); PG8_MMA(0, 0, At, B0); PG8_BAR; PG8_SCHED;
            PG8_LDB(B1, 0, 1); PG8_STAGE(PG8_SB(0, 0), b2, voffB);
            PG8_BAR; PG8_WAIT_L(0); PG8_MMA(0, 1, At, B1); PG8_BAR;
            PG8_LDA(At, 0, 1); if constexpr (GATHER) PG8_STAGE(PG8_SA(0, 0), a2, o2lo); else PG8_STAGE(PG8_SA(0, 0), a2, voffA);
            PG8_BAR; PG8_WAIT_L(0); PG8_MMA(1, 0, At, B0); PG8_BAR; PG8_SCHED;
            PG8_STAGE(PG8_SB(0, 1), b2 + hstep, voffB);
            PG8_WAIT_V(6); PG8_BAR; PG8_MMA(1, 1, At, B1); PG8_BAR;
            PG8_LDB(B0, 1, 0); PG8_SCHED; PG8_LDA(At, 1, 0); if constexpr (GATHER) PG8_STAGE(PG8_SA(0, 1), a2, o2hi); else PG8_STAGE(PG8_SA(0, 1), a2 + hstep, voffA);
            PG8_WAIT_L(8); PG8_BAR; PG8_WAIT_L(0); PG8_MMA(0, 0, At, B0); PG8_BAR; PG8_SCHED;
            PG8_LDB(B1, 1, 1); PG8_STAGE(PG8_SB(1, 0), b3, voffB);
            PG8_BAR; PG8_WAIT_L(0); PG8_MMA(0, 1, At, B1); PG8_BAR;
            PG8_LDA(At, 1, 1); if constexpr (GATHER) PG8_STAGE(PG8_SA(1, 0), a3, o2lo); else PG8_STAGE(PG8_SA(1, 0), a3, voffA);
            PG8_BAR; PG8_WAIT_L(0); PG8_MMA(1, 0, At, B0); PG8_BAR; PG8_SCHED;
            PG8_STAGE(PG8_SB(1, 1), b3 + hstep, voffB);
            PG8_WAIT_V(6); PG8_BAR; PG8_MMA(1, 1, At, B1); PG8_BAR;
        }
        epi_apply(E, acc, cur, wr, wc, fr, fq);
        if (!has_next) break;
#pragma unroll
        for (int a = 0; a < 2; ++a)
#pragma unroll
            for (int b = 0; b < 2; ++b)
#pragma unroll
                for (int m = 0; m < 4; ++m)
#pragma unroll
                    for (int n = 0; n < 2; ++n) acc[a][b][m][n] = (f32x4){0.f, 0.f, 0.f, 0.f};
        cur = nxt; cA = nA; cB = nB; ++ui;
        if constexpr (GATHER) { oc_lo[0] = on_lo[0]; oc_lo[1] = on_lo[1]; oc_hi[0] = on_hi[0]; oc_hi[1] = on_hi[1]; }
    }
    PG8_WAIT_V(0);
    if (wr == 0) PG8_BAR;
    PG8_BAR;
#undef PG8_ROWOFF
#undef PG8_SA
#undef PG8_SB
#undef PG8_STAGE
#undef PG8_LDA
#undef PG8_LDB
#undef PG8_MMA
#undef PG8_WAIT_V
#undef PG8_WAIT_L
#undef PG8_BAR
#undef PG8_SCHED
}
template <class Epi, class Sched>
__device__ __forceinline__ void gemm_phase(LAS unsigned char* lds, const int K, const Sched& S, const Epi& E, const int tid) { gemm_phase_t<false>(lds, K, S, E, tid); }
}

struct SchedInProj { const char* A; const char* Bt; int G, c;
    __device__ __forceinline__ bool next(int i, pg8::Unit& u) const { const int L = i * G + c; if (L >= 64 * 37) return false; int pm, pn; pg8::tile_order(L, 64, 37, pm, pn);
        u.a = A + (size_t)pm * (256 * 1024 * 2); u.b = Bt + (size_t)pn * (256 * 1024 * 2); u.row0 = pm * 256; u.col0 = pn * 256; u.aux = 0; u.rowmap = nullptr; return true; } };

struct WJob { const float* src; int ld_src; int K; int ncols; bf16* dst; int ld_dst; int nb; size_t sstride, dstride; };
__device__ __forceinline__ void wconv_job(const Ctx& c, const WJob& j) {
    float* tl = (float*)c.lds;
    const int ntk = j.K >> 6, ntn = j.ncols >> 6, per = ntk * ntn, ntiles = per * j.nb;
    const int rk = c.tid >> 3, rseg = (c.tid & 7) * 8;
    int tile = blockIdx.x;
    float4 a = make_float4(0.f, 0.f, 0.f, 0.f), b = a;
    if (tile < ntiles) { const int bi = tile / per, tt = tile % per, tk = tt % ntk, tn = tt / ntk;
        const float* sp = j.src + (size_t)bi * j.sstride + (size_t)(tk * 64 + rk) * j.ld_src + tn * 64 + rseg; a = *(const float4*)sp; b = *(const float4*)(sp + 4); }
    for (; tile < ntiles; tile += gridDim.x) {
        const int bi = tile / per, tt = tile % per, tk = tt % ntk, tn = tt / ntk;
        const float4 ca = a, cb = b;
        const int nxt = tile + gridDim.x;
        if (nxt < ntiles) { const int bi2 = nxt / per, tt2 = nxt % per, tk2 = tt2 % ntk, tn2 = tt2 / ntk;
            const float* sp = j.src + (size_t)bi2 * j.sstride + (size_t)(tk2 * 64 + rk) * j.ld_src + tn2 * 64 + rseg; a = *(const float4*)sp; b = *(const float4*)(sp + 4); }
        asm volatile("s_waitcnt lgkmcnt(0)" ::: "memory"); __builtin_amdgcn_s_barrier(); asm volatile("" ::: "memory");
        float* row = tl + rk * 65 + rseg;
        row[0] = ca.x; row[1] = ca.y; row[2] = ca.z; row[3] = ca.w; row[4] = cb.x; row[5] = cb.y; row[6] = cb.z; row[7] = cb.w;
        asm volatile("s_waitcnt lgkmcnt(0)" ::: "memory"); __builtin_amdgcn_s_barrier(); asm volatile("" ::: "memory");
        const float* col = tl + rseg * 65 + rk;
        uint4 w; w.x = pk2(col[0], col[65]); w.y = pk2(col[130], col[195]); w.z = pk2(col[260], col[325]); w.w = pk2(col[390], col[455]);
        *(uint4*)(j.dst + (size_t)bi * j.dstride + (size_t)(tn * 64 + rk) * j.ld_dst + tk * 64 + rseg) = w;
    }
}
struct SchedG2 { const char* YA; const char* Bt; int G, c;
    __device__ __forceinline__ bool next(int i, pg8::Unit& u) const { const int L = (i >> 1) * G + c, ab = i & 1; if (L >= 64 * 4) return false; int pm, pn; pg8::tile_order(L, 64, 4, pm, pn);
        u.a = YA + (size_t)ab * (WS_YB - WS_YA) + (size_t)pm * (256 * 1024 * 2); u.b = Bt + (size_t)(ab * 4 + pn) * (256 * 1024 * 2); u.row0 = pm * 256; u.col0 = ab * 1024 + pn * 256; u.aux = 0; u.rowmap = nullptr; return true; } };
struct SchedX1 { const char* A; const char* Bt; int G, c;
    __device__ __forceinline__ bool next(int i, pg8::Unit& u) const { const int L = i * G + c; if (L >= 64 * 4) return false; int pm, pn; pg8::tile_order(L, 64, 4, pm, pn);
        u.a = A + (size_t)pm * (256 * 1024 * 2); u.b = Bt + (size_t)pn * (256 * 1024 * 2); u.row0 = pm * 256; u.col0 = pn * 256; u.aux = 0; u.rowmap = nullptr; return true; } };
struct SchedMoe { const char* A; const char* Bt; const int* TILE_E; const int* SLOT_TOK; int NT, NPN, G, c;
    __device__ __forceinline__ bool next(int i, pg8::Unit& u) const { const int L = i * G + c; if (L >= NT * NPN) return false; int tile, pn; pg8::tile_order(L, NT, NPN, tile, pn);
        const int e = TILE_E[tile];
        u.a = SLOT_TOK ? A : A + (size_t)tile * (256 * 1024 * 2); u.rowmap = SLOT_TOK ? SLOT_TOK + tile * 256 : nullptr;
        u.b = Bt + (size_t)(e * NPN + pn) * (256 * 1024 * 2); u.row0 = tile * 256; u.col0 = pn * 256; u.aux = e; return true; } };

struct EpiLora {
    typedef NoLd Ld; static constexpr int MB = 1;
    const float* w0; const float* a0; float* LW; float* AA; bf16* GGR;
    __device__ __forceinline__ void load(Ld&, int, int, int) const {}
    __device__ __forceinline__ void store8(int row, int col, const float (&v)[8], int, const Ld&) const {
        const float* bp = col < 1024 ? w0 + col : a0 + ((col - 1024) & 1023);
        const float4 b0 = *(const float4*)bp, b1 = *(const float4*)(bp + 4);
        const float bb[8] = {b0.x, b0.y, b0.z, b0.w, b1.x, b1.y, b1.z, b1.w};
        if (col < 1024) { float o[8];
#pragma unroll
            for (int i = 0; i < 8; ++i) o[i] = -0.6065306597126334f * fsigm(bb[i] + v[i]);
            float* p = LW + (size_t)row * 1024 + col; *(float4*)p = make_float4(o[0], o[1], o[2], o[3]); *(float4*)(p + 4) = make_float4(o[4], o[5], o[6], o[7]); }
        else if (col < 2048) { const int cc = col - 1024; float o[8];
#pragma unroll
            for (int i = 0; i < 8; ++i) o[i] = fsigm(bb[i] + v[i]);
            float* p = AA + (size_t)row * 1024 + cc; *(float4*)p = make_float4(o[0], o[1], o[2], o[3]); *(float4*)(p + 4) = make_float4(o[4], o[5], o[6], o[7]); }
        else { uint4 w; w.x = pk2(v[0], v[1]); w.y = pk2(v[2], v[3]); w.z = pk2(v[4], v[5]); w.w = pk2(v[6], v[7]); *(uint4*)(GGR + (size_t)row * 1024 + (col - 2048)) = w; }
    }
};
struct SchedLora { const char* A; const char* Bt; int G, c;
    __device__ __forceinline__ bool next(int i, pg8::Unit& u) const { const int L = i * G + c; if (L >= 64 * 12) return false; int pm, pn; pg8::tile_order(L, 64, 12, pm, pn);
        u.a = A + (size_t)pm * (256 * 256 * 2); u.b = Bt + (size_t)pn * (256 * 256 * 2); u.row0 = pm * 256; u.col0 = pn * 256; u.aux = 0; u.rowmap = nullptr; return true; } };
__device__ __forceinline__ void lora_zero(const Ctx& c) {
    uint4* LT = c.ws<uint4>(WS_LORA_T);
    for (size_t idx = c.gtid; idx < (size_t)3072 * 32; idx += c.nthreads) {
        const int row = (int)(idx >> 5), k8 = (int)(idx & 31) * 8;
        const bool data = row < 1024 ? (k8 < 64) : (row < 2048 ? (k8 >= 64 && k8 < 128) : (k8 >= 128));
        if (!data) LT[idx] = make_uint4(0, 0, 0, 0);
    }
}

__device__ __forceinline__ void ph_loraprep(const Ctx& c) {
    const float* LIN = c.ws<float>(WS_LIN); bf16* AL = c.ws<bf16>(WS_ALORA); const float* mu = c.P.in[I_MU];
    for (size_t idx = c.gtid; idx < (size_t)T * 256; idx += c.nthreads) {
        const int t = (int)(idx >> 8), cc = (int)(idx & 255);
        const float x = LIN[idx], xp = (t & (SEQ - 1)) ? LIN[idx - 256] : 0.f;
        const float xs = x + (xp - x) * mu[3072 + cc];
        const float r = cc < 64 ? tanhf(xs) : (cc < 128 ? xs : sigm(xs));
        AL[idx] = f2bf(r);
    }
}
__device__ __forceinline__ void ph_post(const Ctx& c) {
    const bf16* OG = c.ws<bf16>(WS_OG); const bf16* ORW = c.ws<bf16>(WS_ORW); const bf16* ZS = c.ws<bf16>(WS_ZS); const bf16* VP = c.ws<bf16>(WS_VP); const bf16* GGR = c.ws<bf16>(WS_GGR);
    const float* SC = c.ws<float>(WS_SC); bf16* YA = c.ws<bf16>(WS_YA); bf16* YB = c.ws<bf16>(WS_YB);
    const float* gnw = c.P.in[I_GDN_NORM]; const float* lnw = c.P.in[I_LNW]; const float* lnb = c.P.in[I_LNB];
    const int lane = c.lane, c0 = lane * 16;
    for (int t = c.gwave; t < T; t += c.nwaves) {
        {
            float o[16];
#pragma unroll
            for (int q = 0; q < 2; ++q) { const uint4 v = *(const uint4*)(OG + (size_t)t * 1024 + c0 + 8 * q); o[8 * q] = bflo(v.x); o[8 * q + 1] = bfhi(v.x); o[8 * q + 2] = bflo(v.y); o[8 * q + 3] = bfhi(v.y); o[8 * q + 4] = bflo(v.z); o[8 * q + 5] = bfhi(v.z); o[8 * q + 6] = bflo(v.w); o[8 * q + 7] = bfhi(v.w); }
            float ss = 0.f;
#pragma unroll
            for (int j = 0; j < 16; ++j) ss += o[j] * o[j];
            ss += __shfl_xor(ss, 1); ss += __shfl_xor(ss, 2); ss += __shfl_xor(ss, 4);
            const float rstd = rsqrtf(ss * (1.f / 128.f) + 1e-6f);
            const uint4 z0 = *(const uint4*)(ZS + (size_t)t * 1024 + c0), z1 = *(const uint4*)(ZS + (size_t)t * 1024 + c0 + 8);
            const unsigned zz[8] = {z0.x, z0.y, z0.z, z0.w, z1.x, z1.y, z1.z, z1.w};
            unsigned w[8];
#pragma unroll
            for (int j = 0; j < 8; ++j) { const int cc = (c0 + 2 * j) & 127; w[j] = pk2(o[2 * j] * rstd * gnw[cc] * bflo(zz[j]), o[2 * j + 1] * rstd * gnw[cc + 1] * bfhi(zz[j])); }
            *(uint4*)(YA + (size_t)t * 1024 + c0) = make_uint4(w[0], w[1], w[2], w[3]); *(uint4*)(YA + (size_t)t * 1024 + c0 + 8) = make_uint4(w[4], w[5], w[6], w[7]);
        }
        {
            float o[16];
#pragma unroll
            for (int q = 0; q < 2; ++q) { const uint4 v = *(const uint4*)(ORW + (size_t)t * 1024 + c0 + 8 * q); o[8 * q] = bflo(v.x); o[8 * q + 1] = bfhi(v.x); o[8 * q + 2] = bflo(v.y); o[8 * q + 3] = bfhi(v.y); o[8 * q + 4] = bflo(v.z); o[8 * q + 5] = bfhi(v.z); o[8 * q + 6] = bflo(v.w); o[8 * q + 7] = bfhi(v.w); }
            float sm = 0.f;
#pragma unroll
            for (int j = 0; j < 16; ++j) sm += o[j];
            sm += __shfl_xor(sm, 1); sm += __shfl_xor(sm, 2);
            const float mean = sm * (1.f / 64.f);
            float sv = 0.f;
#pragma unroll
            for (int j = 0; j < 16; ++j) { const float dd = o[j] - mean; sv += dd * dd; }
            sv += __shfl_xor(sv, 1); sv += __shfl_xor(sv, 2);
            const float rstd = rsqrtf(sv * (1.f / 64.f) + 64e-5f);
            const float sc = SC[t * 16 + (c0 >> 6)];
            const uint4 v0 = *(const uint4*)(VP + (size_t)t * 1024 + c0), v1 = *(const uint4*)(VP + (size_t)t * 1024 + c0 + 8);
            const uint4 g0 = *(const uint4*)(GGR + (size_t)t * 1024 + c0), g1 = *(const uint4*)(GGR + (size_t)t * 1024 + c0 + 8);
            const unsigned vv[8] = {v0.x, v0.y, v0.z, v0.w, v1.x, v1.y, v1.z, v1.w};
            const unsigned gg[8] = {g0.x, g0.y, g0.z, g0.w, g1.x, g1.y, g1.z, g1.w};
            unsigned w[8];
#pragma unroll
            for (int j = 0; j < 8; ++j) { const int cc = c0 + 2 * j;
                const float y0 = ((o[2 * j] - mean) * rstd * lnw[cc] + lnb[cc] + sc * bflo(vv[j])) * bflo(gg[j]);
                const float y1 = ((o[2 * j + 1] - mean) * rstd * lnw[cc + 1] + lnb[cc + 1] + sc * bfhi(vv[j])) * bfhi(gg[j]);
                w[j] = pk2(y0, y1); }
            *(uint4*)(YB + (size_t)t * 1024 + c0) = make_uint4(w[0], w[1], w[2], w[3]); *(uint4*)(YB + (size_t)t * 1024 + c0 + 8) = make_uint4(w[4], w[5], w[6], w[7]);
        }
    }
}

__device__ __forceinline__ void ph_router(const Ctx& c) {
    const float* X1 = c.ws<float>(WS_X1); const float* nw = c.P.in[I_NORM_FFN]; const float* rw = c.P.in[I_ROUTER_W]; const float* rb = c.P.in[I_ROUTER_B];
    bf16* H2 = c.ws<bf16>(WS_H2); int* TE = c.ws<int>(WS_TE); float* TG = c.ws<float>(WS_TG); int* TP = c.ws<int>(WS_TP); unsigned* CNT = c.ws<unsigned>(WS_CTL) + CW_CNT;
    const int lane = c.lane;
    float4* tab = (float4*)c.lds;
    unsigned* lcnt = (unsigned*)(c.lds + 147456);
    __syncthreads();
    if (c.tid < 32) lcnt[c.tid] = 0u;
    for (int i = c.tid; i < 8192; i += NTHREADS) { const int k = i >> 3; tab[((k & 3) * 256 + (k >> 2)) * 9 + (i & 7)] = ((const float4*)rw)[i]; }
    __syncthreads();
    for (int t = c.gwave; t < T; t += c.nwaves) {
        float4 v[4]; float ss = 0.f;
#pragma unroll
        for (int i = 0; i < 4; ++i) { v[i] = ((const float4*)(X1 + (size_t)t * D))[lane + 64 * i]; ss += v[i].x * v[i].x + v[i].y * v[i].y + v[i].z * v[i].z + v[i].w * v[i].w; }
        ss = wsum(ss);
        const float rstd = rsqrtf(ss * (1.f / 1024.f) + 1e-6f);
        float lg[32];
#pragma unroll
        for (int j = 0; j < 32; ++j) lg[j] = 0.f;
#pragma unroll
        for (int i = 0; i < 4; ++i) {
            const float4 w4 = ((const float4*)nw)[lane + 64 * i];
            const float h[4] = {v[i].x * rstd * w4.x, v[i].y * rstd * w4.y, v[i].z * rstd * w4.z, v[i].w * rstd * w4.w};
            uint2 st; st.x = pk2(h[0], h[1]); st.y = pk2(h[2], h[3]);
            *(uint2*)(H2 + (size_t)t * D + 4 * (lane + 64 * i)) = st;
#pragma unroll
            for (int ii = 0; ii < 4; ++ii) {
                const float4* wr = tab + (size_t)(ii * 256 + lane + 64 * i) * 9;
#pragma unroll
                for (int q = 0; q < 8; ++q) { const float4 w = wr[q]; lg[4 * q] += h[ii] * w.x; lg[4 * q + 1] += h[ii] * w.y; lg[4 * q + 2] += h[ii] * w.z; lg[4 * q + 3] += h[ii] * w.w; }
                asm volatile("" ::: "memory");
            }
        }
#pragma unroll
        for (int j = 0; j < 32; ++j) lg[j] = wsum(lg[j]) + rb[j];
        int e0 = 0, e1 = 0, e2 = 0, e3 = 0; float v0 = -3e38f, v1 = -3e38f, v2 = -3e38f, v3 = -3e38f;
#pragma unroll
        for (int j = 0; j < 32; ++j) if (lg[j] > v0) { v0 = lg[j]; e0 = j; }
#pragma unroll
        for (int j = 0; j < 32; ++j) if (j != e0 && lg[j] > v1) { v1 = lg[j]; e1 = j; }
#pragma unroll
        for (int j = 0; j < 32; ++j) if (j != e0 && j != e1 && lg[j] > v2) { v2 = lg[j]; e2 = j; }
#pragma unroll
        for (int j = 0; j < 32; ++j) if (j != e0 && j != e1 && j != e2 && lg[j] > v3) { v3 = lg[j]; e3 = j; }
        const float x1 = expf(v1 - v0), x2 = expf(v2 - v0), x3 = expf(v3 - v0), inv = 1.f / (1.f + x1 + x2 + x3);
        if (lane < 4) {
            const int me = lane == 0 ? e0 : (lane == 1 ? e1 : (lane == 2 ? e2 : e3));
            const float mg = (lane == 0 ? 1.f : (lane == 1 ? x1 : (lane == 2 ? x2 : x3))) * inv;
            const unsigned pos = atomicAdd(&lcnt[me], 1u);
            TE[t * 4 + lane] = me; TG[t * 4 + lane] = mg; TP[t * 4 + lane] = (int)pos;
        }
    }
    __syncthreads();
    if (c.tid < 32) lcnt[32 + c.tid] = atomicAdd(&CNT[c.tid], lcnt[c.tid]);
    __syncthreads();
    if (lane < 4) for (int t = c.gwave; t < T; t += c.nwaves) TP[t * 4 + lane] += (int)lcnt[32 + TE[t * 4 + lane]];
    __syncthreads();
}

__device__ __forceinline__ void ph_dispatch(const Ctx& c) {
    int* tb = (int*)c.lds;
    const unsigned* CNT = c.ws<unsigned>(WS_CTL) + CW_CNT;
    int* TILE_E = c.ws<int>(WS_TILE_E); int* NT = c.ws<int>(WS_NT);
    const int* TE = c.ws<int>(WS_TE); const float* TG = c.ws<float>(WS_TG); const int* TP = c.ws<int>(WS_TP); int* TSLOT = c.ws<int>(WS_TSLOT);
    float* SGATE = c.ws<float>(WS_SGATE); const bf16* H2 = c.ws<bf16>(WS_H2); bf16* XB = c.ws<bf16>(WS_XB);
    if (c.tid == 0) { int acc = 0; for (int e = 0; e < NEXP; ++e) { const int n = (int)__hip_atomic_load(&CNT[e], __ATOMIC_RELAXED, __HIP_MEMORY_SCOPE_AGENT); tb[e] = acc; tb[64 + e] = n; acc += (n + 255) >> 8; } tb[32] = acc; }
    __syncthreads();
    if (blockIdx.x == 0) {
        for (int tile = c.tid; tile < tb[32]; tile += NTHREADS) { int e = 0; for (int q = 0; q < NEXP; ++q) if (tile >= tb[q]) e = q; TILE_E[tile] = e; }
        if (c.tid == 0) *NT = tb[32];
    }
    int* SLOT_TOK = c.ws<int>(WS_SLOT_TOK);
    for (size_t idx = c.gtid; idx < (size_t)T * 4; idx += c.nthreads) {
        const int t = (int)(idx >> 2), e = TE[idx], pos = TP[idx];
        const int slot = tb[e] * 256 + pos;
        TSLOT[idx] = slot; SGATE[slot] = TG[idx]; SLOT_TOK[slot] = t;
    }
    for (int e = 0; e < NEXP; ++e) {
        const int n = tb[64 + e], cap = (tb[e + 1] - tb[e]) * 256;
        for (int r = n + (int)c.gtid; r < cap; r += (int)c.nthreads) { const int slot = tb[e] * 256 + r; SLOT_TOK[slot] = 0; SGATE[slot] = 0.f; }
    }
}

__device__ __forceinline__ void ph_combine(const Ctx& c) {
    const float* X1 = c.ws<float>(WS_X1); const bf16* YS = c.ws<bf16>(WS_YS); const int* TSLOT = c.ws<int>(WS_TSLOT); const float* nw = c.P.in[I_NORM_FINAL]; float* out = c.P.out;
    const int lane = c.lane;
    for (int t = c.gwave; t < T; t += c.nwaves) {
        const int s0 = TSLOT[t * 4], s1 = TSLOT[t * 4 + 1], s2 = TSLOT[t * 4 + 2], s3 = TSLOT[t * 4 + 3];
        float4 v[4]; float ss = 0.f;
#pragma unroll
        for (int i = 0; i < 4; ++i) {
            const int col = 4 * (lane + 64 * i);
            v[i] = *(const float4*)(X1 + (size_t)t * D + col);
            const uint2 a = *(const uint2*)(YS + (size_t)s0 * 1024 + col), b = *(const uint2*)(YS + (size_t)s1 * 1024 + col), cc = *(const uint2*)(YS + (size_t)s2 * 1024 + col), d = *(const uint2*)(YS + (size_t)s3 * 1024 + col);
            v[i].x += bflo(a.x) + bflo(b.x) + bflo(cc.x) + bflo(d.x); v[i].y += bfhi(a.x) + bfhi(b.x) + bfhi(cc.x) + bfhi(d.x);
            v[i].z += bflo(a.y) + bflo(b.y) + bflo(cc.y) + bflo(d.y); v[i].w += bfhi(a.y) + bfhi(b.y) + bfhi(cc.y) + bfhi(d.y);
            ss += v[i].x * v[i].x + v[i].y * v[i].y + v[i].z * v[i].z + v[i].w * v[i].w;
        }
        ss = wsum(ss);
        const float rstd = rsqrtf(ss * (1.f / 1024.f) + 1e-6f);
#pragma unroll
        for (int i = 0; i < 4; ++i) { const float4 w4 = ((const float4*)nw)[lane + 64 * i];
            *(float4*)(out + (size_t)t * D + 4 * (lane + 64 * i)) = make_float4(v[i].x * rstd * w4.x, v[i].y * rstd * w4.y, v[i].z * rstd * w4.z, v[i].w * rstd * w4.w); }
    }
    if (TS_BEGIN >= 0 && blockIdx.x == 0 && c.tid == 0) { asm volatile("s_waitcnt vmcnt(0)" ::: "memory"); c.P.out[0] = (float)c.ws<unsigned>(WS_CTL)[CW_TS] * 0.01f; }
}


typedef short bf16x8_t __attribute__((ext_vector_type(8)));
typedef float f32x4_t __attribute__((ext_vector_type(4)));
#define MFMA16(a, b, c) __builtin_amdgcn_mfma_f32_16x16x32_bf16((a), (b), (c), 0, 0, 0)


__device__ __forceinline__ int frag_off(int row, int k, int KBn) { return (((row >> 4) * KBn + (k >> 5)) * 512) + (((k >> 3) & 3) * 128) + ((row & 15) * 8) + (k & 7); }
__device__ __forceinline__ int cfrag_off(int v, int r, int NRT) { return ((((v >> 4) * NRT + (r >> 4)) * 64 + ((r >> 2) & 3) * 16 + (v & 15)) * 4) + (r & 3); }

constexpr int GCL_HALF_BYTES = 71680;
__device__ __forceinline__ void ph_gcl(const Ctx& c) {
    const bf16* GQKV = c.ws<bf16>(WS_GQKV); const float* BETA = c.ws<float>(WS_BETA); const float* GGv = c.ws<float>(WS_GG); const float* cw = c.P.in[I_GDN_CONV];
    bf16* GA1 = c.ws<bf16>(WS_GA1); bf16* GX0 = c.ws<bf16>(WS_GX0); bf16* GA2 = c.ws<bf16>(WS_GA2); bf16* GA3 = c.ws<bf16>(WS_GA3); bf16* GA4 = c.ws<bf16>(WS_GA4); float* GGL = c.ws<float>(WS_GGL);
    for (int it0 = blockIdx.x * 2; it0 < 2048; it0 += gridDim.x * 2) {
        int tv = c.tid; asm volatile("" : "+v"(tv));
        const int half = tv >> 8, ht = tv & 255, lane = tv & 63, w4 = __builtin_amdgcn_readfirstlane((tv >> 6) & 3);
        unsigned char* base = c.lds + half * GCL_HALF_BYTES;
        bf16* QB = (bf16*)base;
        bf16* KB = QB + 64 * 136;
        bf16* VB = KB + 64 * 136;
        float* MM = (float*)(VB + 64 * 136);
        float* GC = MM + 64 * 64;
        float* BT = GC + 64;
        float* BE = BT + 64;
        const int item = it0 + half, n = item & 63, bh = item >> 6, h = bh & 7, b = bh >> 3;
        const int t0 = b * SEQ + n * 64;
        __syncthreads();
        if (w4 == 0) {
            float g = GGv[(size_t)(t0 + lane) * 8 + h]; const float be = BETA[(size_t)(t0 + lane) * 8 + h];
#pragma unroll
            for (int o = 1; o < 64; o <<= 1) { const float u = __shfl_up(g, o); if (lane >= o) g += u; }
            GC[lane] = g; BT[lane] = be; BE[lane] = be * __expf(g);
        }
        __syncthreads();
        {
            const int cg = ht & 15, rg = ht >> 4, r0 = rg * 4;
#pragma unroll
            for (int mat = 0; mat < 3; ++mat) {
                const int col0 = mat * 1024 + h * 128 + cg * 8;
                float4 xa[7], xb[7], wa[4], wb[4];
#pragma unroll
                for (int li = 0; li < 7; ++li) {
                    const bool valid = (n > 0) || (r0 - 3 + li >= 0);
                    uint4 xr = make_uint4(0, 0, 0, 0);
                    if (valid) xr = *(const uint4*)(GQKV + (size_t)(t0 + r0 - 3 + li) * 3072 + col0);
                    xa[li] = make_float4(bflo(xr.x), bfhi(xr.x), bflo(xr.y), bfhi(xr.y));
                    xb[li] = make_float4(bflo(xr.z), bfhi(xr.z), bflo(xr.w), bfhi(xr.w));
                }
#pragma unroll
                for (int j = 0; j < 4; ++j) { wa[j] = *(const float4*)(cw + j * 3072 + col0); wb[j] = *(const float4*)(cw + j * 3072 + col0 + 4); }
#pragma unroll
                for (int rr = 0; rr < 4; ++rr) {
                    float o[8] = {0.f, 0.f, 0.f, 0.f, 0.f, 0.f, 0.f, 0.f};
#pragma unroll
                    for (int j = 0; j < 4; ++j) { const float4 a = xa[rr + j], bq = xb[rr + j];
                        o[0] += wa[j].x * a.x; o[1] += wa[j].y * a.y; o[2] += wa[j].z * a.z; o[3] += wa[j].w * a.w;
                        o[4] += wb[j].x * bq.x; o[5] += wb[j].y * bq.y; o[6] += wb[j].z * bq.z; o[7] += wb[j].w * bq.w; }
                    float ss = 0.f;
#pragma unroll
                    for (int e = 0; e < 8; ++e) { o[e] *= fsigm(o[e]); ss += o[e] * o[e]; }
                    float sc = 1.f;
                    if (mat < 2) { ss += __shfl_xor(ss, 1); ss += __shfl_xor(ss, 2); ss += __shfl_xor(ss, 4); ss += __shfl_xor(ss, 8); sc = rsqrtf(ss + 1e-6f) * (mat == 0 ? 0.08838834764831845f : 1.f); }
                    const int r = r0 + rr;
                    uint4 w; w.x = pk2(o[0] * sc, o[1] * sc); w.y = pk2(o[2] * sc, o[3] * sc); w.z = pk2(o[4] * sc, o[5] * sc); w.w = pk2(o[6] * sc, o[7] * sc);
                    *(uint4*)((mat == 0 ? QB : (mat == 1 ? KB : VB)) + r * 136 + cg * 8) = w;
                    if (mat == 0) {
                        const float s2 = sc * __expf(GC[r]);
                        w.x = pk2(o[0] * s2, o[1] * s2); w.y = pk2(o[2] * s2, o[3] * s2); w.z = pk2(o[4] * s2, o[5] * s2); w.w = pk2(o[6] * s2, o[7] * s2);
                        *(uint4*)(GA2 + (size_t)item * 64 * 128 + frag_off(r, cg * 8, 4)) = w;
                    }
                }
            }
        }
        __syncthreads();
        {
            const int fr = lane & 15, fq = lane >> 4, a0 = w4 * 16;
            bf16x8_t ka[4];
#pragma unroll
            for (int kb = 0; kb < 4; ++kb) ka[kb] = *(const bf16x8_t*)(KB + (a0 + fr) * 136 + kb * 32 + fq * 8);
#pragma unroll
            for (int bt = 0; bt < 4; ++bt) {
                f32x4_t c1 = {0.f, 0.f, 0.f, 0.f}, c2 = {0.f, 0.f, 0.f, 0.f};
#pragma unroll
                for (int kb = 0; kb < 4; ++kb) {
                    const bf16x8_t kbf = *(const bf16x8_t*)(KB + (bt * 16 + fr) * 136 + kb * 32 + fq * 8);
                    const bf16x8_t qbf = *(const bf16x8_t*)(QB + (bt * 16 + fr) * 136 + kb * 32 + fq * 8);
                    c1 = MFMA16(ka[kb], kbf, c1); c2 = MFMA16(ka[kb], qbf, c2);
                }
                const int i = bt * 16 + fr, j0 = a0 + 4 * fq;
                const float gi = GC[i], bi = BT[i];
                float m[4], at[4];
#pragma unroll
                for (int rg = 0; rg < 4; ++rg) { const int j = j0 + rg; const float dec = __expf(fminf(gi - GC[j], 0.f));
                    m[rg] = (i > j) ? bi * c1[rg] * dec : 0.f; at[rg] = (i >= j) ? c2[rg] * dec : 0.f; }
                *(float4*)(MM + i * 64 + j0) = make_float4(m[0], m[1], m[2], m[3]);
                uint2 w; w.x = pk2(at[0], at[1]); w.y = pk2(at[2], at[3]);
                *(uint2*)(GA3 + (size_t)item * 64 * 64 + frag_off(i, j0, 2)) = w;
            }
        }
        __syncthreads();
        {
            const int cc = ht & 127; const bool isw = ht >= 128;
            const bf16* srcp = (isw ? KB : VB) + cc; const float* scl = isw ? BE : BT;
            float x[64];
#pragma unroll
            for (int i = 0; i < 64; ++i) x[i] = 0.f;
            float4 mc[16], mn[16];
#pragma unroll
            for (int q = 0; q < 16; ++q) { mc[q] = make_float4(0.f, 0.f, 0.f, 0.f); mn[q] = mc[q]; }
            float rhs_n = scl[0] * bf2f(srcp[0]);
#pragma unroll
            for (int i = 0; i < 64; ++i) {
                const float rhs = rhs_n;
                if (i + 1 < 64) {
#pragma unroll
                    for (int j4 = 0; j4 < (i + 4) / 4; ++j4) mn[j4] = *(const float4*)(MM + (i + 1) * 64 + 4 * j4);
                    rhs_n = scl[i + 1] * bf2f(srcp[(i + 1) * 136]);
                }
                float acc = rhs, ac1 = 0.f, ac2 = 0.f, ac3 = 0.f;
#pragma unroll
                for (int j4 = 0; j4 < (i + 3) / 4; ++j4) { acc -= mc[j4].x * x[4 * j4]; ac1 -= mc[j4].y * x[4 * j4 + 1]; ac2 -= mc[j4].z * x[4 * j4 + 2]; ac3 -= mc[j4].w * x[4 * j4 + 3]; }
                x[i] = (acc + ac1) + (ac2 + ac3);
#pragma unroll
                for (int j4 = 0; j4 < 16; ++j4) mc[j4] = mn[j4];
                asm volatile("" ::: "memory");
            }
            if (!isw) {
                bf16* up = GX0 + (size_t)item * 128 * 64;
#pragma unroll
                for (int q = 0; q < 16; ++q) { uint2 w; w.x = pk2(x[4 * q], x[4 * q + 1]); w.y = pk2(x[4 * q + 2], x[4 * q + 3]); *(uint2*)(up + cfrag_off(cc, 4 * q, 4)) = w; }
            }
            __syncthreads();
            if (isw) {
                bf16* a1s = (bf16*)MM;
#pragma unroll
                for (int i = 0; i < 64; ++i) a1s[i * 128 + cc] = f2bf(-x[i]);
            }
        }
        __syncthreads();
        {
            const bf16* a1s = (const bf16*)MM; bf16* wp = GA1 + (size_t)item * 64 * 128;
#pragma unroll
            for (int q = 0; q < 4; ++q) { const int p = ht + 256 * q, fr = p & 15, fq = (p >> 4) & 3, kb = (p >> 6) & 3, rt = p >> 8;
                *(uint4*)(wp + p * 8) = *(const uint4*)(a1s + (rt * 16 + fr) * 128 + kb * 32 + fq * 8); }
        }
        {
            const int dk = ht & 127, hh = ht >> 7; const float g63 = GC[63];
            unsigned w[16];
#pragma unroll
            for (int q = 0; q < 16; ++q) { const int ta = hh * 32 + 2 * q;
                w[q] = pk2(bf2f(KB[ta * 136 + dk]) * __expf(g63 - GC[ta]), bf2f(KB[(ta + 1) * 136 + dk]) * __expf(g63 - GC[ta + 1])); }
            bf16* dp = GA4 + (size_t)item * 128 * 64;
            *(uint4*)(dp + frag_off(dk, hh * 32, 2)) = make_uint4(w[0], w[1], w[2], w[3]); *(uint4*)(dp + frag_off(dk, hh * 32 + 8, 2)) = make_uint4(w[4], w[5], w[6], w[7]);
            *(uint4*)(dp + frag_off(dk, hh * 32 + 16, 2)) = make_uint4(w[8], w[9], w[10], w[11]); *(uint4*)(dp + frag_off(dk, hh * 32 + 24, 2)) = make_uint4(w[12], w[13], w[14], w[15]);
            if (ht == 0) GGL[item] = __expf(g63);
        }
    }
}

constexpr int RCL_HALF_BYTES = 75776;
__device__ __forceinline__ void ph_rcl(const Ctx& c) {
    const bf16* RKV = c.ws<bf16>(WS_RKV); const float* LW = c.ws<float>(WS_LW); const float* AAg = c.ws<float>(WS_AA);
    const float* mu = c.P.in[I_MU]; const float* k_k = c.P.in[I_KK]; const float* k_a = c.P.in[I_KA]; const float* r_k = c.P.in[I_RK];
    bf16* VP = c.ws<bf16>(WS_VP); float* SC = c.ws<float>(WS_SC);
    bf16* RA1 = c.ws<bf16>(WS_RA1); bf16* RX0 = c.ws<bf16>(WS_RX0); bf16* RA2 = c.ws<bf16>(WS_RA2); bf16* RA3 = c.ws<bf16>(WS_RA3); bf16* RO0 = c.ws<bf16>(WS_RO0);
    bf16* RA4 = c.ws<bf16>(WS_RA4); bf16* RS0 = c.ws<bf16>(WS_RS0); float* RDSC = c.ws<float>(WS_RDSC);
    unsigned long long ts_t0 = 0ull, ts_acc = 0ull;
#define TSMARK(k) do { if (TS_BEGIN >= 0 && blockIdx.x == 0 && c.tid == 0) { const unsigned long long now_ = __builtin_amdgcn_s_memrealtime(); \
        if ((k) == TS_END && ts_t0 != 0ull) ts_acc += now_ - ts_t0; if ((k) == TS_BEGIN) ts_t0 = now_; } } while (0)
    uint4 ur[2], uk[2], uv[2]; float4 a4v[4], l4v[4];
#define RCL_LOAD(ITEM, TID) do { const int it_ = (ITEM), ht_ = (TID) & 255, n_ = it_ & 63, bh_ = it_ >> 6, h_ = bh_ & 15, b_ = bh_ >> 4; \
        const int r_ = ht_ >> 2, c0_ = (ht_ & 3) * 16, t_ = b_ * SEQ + n_ * 64 + r_; \
        const bf16* cur_ = RKV + (size_t)t_ * 3072 + h_ * 64 + c0_; \
        _Pragma("unroll") for (int g = 0; g < 2; ++g) { ur[g] = *(const uint4*)(cur_ + 8 * g); uk[g] = *(const uint4*)(cur_ + 1024 + 8 * g); uv[g] = *(const uint4*)(cur_ + 2048 + 8 * g); } \
        _Pragma("unroll") for (int q = 0; q < 4; ++q) { l4v[q] = *(const float4*)(LW + (size_t)t_ * 1024 + h_ * 64 + c0_ + 4 * q); a4v[q] = *(const float4*)(AAg + (size_t)t_ * 1024 + h_ * 64 + c0_ + 4 * q); } \
    } while (0)
    if ((int)(blockIdx.x * 2) < 4096) RCL_LOAD(blockIdx.x * 2 + (c.tid >> 8), c.tid);
    for (int it0 = blockIdx.x * 2; it0 < 4096; it0 += gridDim.x * 2) {
        int tv = c.tid; asm volatile("" : "+v"(tv));
        const int half = tv >> 8, ht = tv & 255, lane = tv & 63, w4 = __builtin_amdgcn_readfirstlane((tv >> 6) & 3);
        unsigned char* base = c.lds + half * RCL_HALF_BYTES;
        bf16* AT = (bf16*)base;
        bf16* VT = AT + 64 * 72;
        bf16* KDT = VT + 64 * 72;
        float* AAB = (float*)(KDT + 64 * 72);
        float* TOT = AAB + 64 * 64;
        unsigned char* RX = (unsigned char*)(TOT + 256);
        bf16* RT = (bf16*)RX;
        bf16* BTL = RT + 64 * 72;
        bf16* KT = BTL + 64 * 72;
        bf16* AAK = (bf16*)RX;
        bf16* ARK = AAK + 64 * 72;
        float* RHS2 = (float*)RX;
        const int item = it0 + half, n = item & 63, bh = item >> 6, h = bh & 15, b = bh >> 4;
        const int t0 = b * SEQ + n * 64;
        __syncthreads();
        TSMARK(0);
        const int r = ht >> 2, seg = ht & 3, c0 = seg * 16, t = t0 + r; const bool first = (n == 0 && r == 0);
        float rr[16], kf[16], vv[16], kkv[16], aa[16], lwl[16], bdv[16];
        float ss = 0.f, scs = 0.f;
        {
            float4 mr[4], mk[4], mv[4], kkw[4], kaw[4], rkw[4];
            uint4 qr[2], qk[2], qv[2];
            {   const bf16* prv = RKV + (size_t)(t - 1) * 3072 + h * 64 + c0;
#pragma unroll
                for (int g = 0; g < 2; ++g) { qr[g] = make_uint4(0, 0, 0, 0); qk[g] = qr[g]; qv[g] = qr[g];
                    if (!first) { qr[g] = *(const uint4*)(prv + 8 * g); qk[g] = *(const uint4*)(prv + 1024 + 8 * g); qv[g] = *(const uint4*)(prv + 2048 + 8 * g); } } }
#pragma unroll
            for (int q = 0; q < 4; ++q) {
                mr[q] = *(const float4*)(mu + h * 64 + c0 + 4 * q); mk[q] = *(const float4*)(mu + 1024 + h * 64 + c0 + 4 * q); mv[q] = *(const float4*)(mu + 2048 + h * 64 + c0 + 4 * q);
                kkw[q] = *(const float4*)(k_k + h * 64 + c0 + 4 * q); kaw[q] = *(const float4*)(k_a + h * 64 + c0 + 4 * q); rkw[q] = *(const float4*)(r_k + h * 64 + c0 + 4 * q);
            }
#pragma unroll
            for (int q = 0; q < 4; ++q) *(float4*)(AAB + r * 64 + c0 + 4 * q) = l4v[q];
            __syncthreads();
            {
                const int ch = ht & 63, tq = ht >> 6;
                float run = 0.f;
#pragma unroll
                for (int i = 0; i < 16; ++i) { run += AAB[(tq * 16 + i) * 64 + ch]; AAB[(tq * 16 + i) * 64 + ch] = run; }
                TOT[tq * 64 + ch] = run;
            }
            __syncthreads();
            TSMARK(1);
#pragma unroll
            for (int q = 0; q < 4; ++q) {
                const int g = q >> 1; const bool hi = q & 1;
                const unsigned r_a = hi ? ur[g].z : ur[g].x, r_b = hi ? ur[g].w : ur[g].y, k_a_ = hi ? uk[g].z : uk[g].x, k_b_ = hi ? uk[g].w : uk[g].y, v_a = hi ? uv[g].z : uv[g].x, v_b = hi ? uv[g].w : uv[g].y;
                const unsigned pr_a = hi ? qr[g].z : qr[g].x, pr_b = hi ? qr[g].w : qr[g].y, pk_a = hi ? qk[g].z : qk[g].x, pk_b = hi ? qk[g].w : qk[g].y, pv_a = hi ? qv[g].z : qv[g].x, pv_b = hi ? qv[g].w : qv[g].y;
                const float r0a[4] = {bflo(r_a), bfhi(r_a), bflo(r_b), bfhi(r_b)}, k0a[4] = {bflo(k_a_), bfhi(k_a_), bflo(k_b_), bfhi(k_b_)}, v0a[4] = {bflo(v_a), bfhi(v_a), bflo(v_b), bfhi(v_b)};
                const float rpa[4] = {bflo(pr_a), bfhi(pr_a), bflo(pr_b), bfhi(pr_b)}, kpa[4] = {bflo(pk_a), bfhi(pk_a), bflo(pk_b), bfhi(pk_b)}, vpa[4] = {bflo(pv_a), bfhi(pv_a), bflo(pv_b), bfhi(pv_b)};
                const float mra[4] = {mr[q].x, mr[q].y, mr[q].z, mr[q].w}, mka[4] = {mk[q].x, mk[q].y, mk[q].z, mk[q].w}, mva[4] = {mv[q].x, mv[q].y, mv[q].z, mv[q].w};
                const float kka[4] = {kkw[q].x, kkw[q].y, kkw[q].z, kkw[q].w}, kaa[4] = {kaw[q].x, kaw[q].y, kaw[q].z, kaw[q].w}, rka[4] = {rkw[q].x, rkw[q].y, rkw[q].z, rkw[q].w};
                const float aaa[4] = {a4v[q].x, a4v[q].y, a4v[q].z, a4v[q].w}, lwa[4] = {l4v[q].x, l4v[q].y, l4v[q].z, l4v[q].w};
#pragma unroll
                for (int e = 0; e < 4; ++e) { const int i = 4 * q + e;
                    rr[i] = r0a[e] + (rpa[e] - r0a[e]) * mra[e]; const float kx = k0a[e] + (kpa[e] - k0a[e]) * mka[e]; vv[i] = v0a[e] + (vpa[e] - v0a[e]) * mva[e];
                    kkv[i] = kx * kka[e]; ss += kkv[i] * kkv[i]; aa[i] = aaa[e]; lwl[i] = lwa[e]; kf[i] = kx * (1.f + (aaa[e] - 1.f) * kaa[e]); scs += rr[i] * kf[i] * rka[e]; }
            }
        }
        {
            ss += __shfl_xor(ss, 1); ss += __shfl_xor(ss, 2); scs += __shfl_xor(scs, 1); scs += __shfl_xor(scs, 2);
            const float rn = rsqrtf(ss + 1e-6f);
            if (seg == 0) SC[(size_t)t * 16 + h] = scs;
            const int tq = r >> 4;
            unsigned wat[8], wbt[8], wkt[8], wrt[8], wvp[8];
            float atv[16], btv[16], ktv[16], rtv[16];
#pragma unroll
            for (int i = 0; i < 16; ++i) {
                const int ch = c0 + i;
                float off = 0.f;
#pragma unroll
                for (int q = 0; q < 3; ++q) off += (q < tq) ? TOT[q * 64 + ch] : 0.f;
                const float tot = TOT[ch] + TOT[64 + ch] + TOT[128 + ch] + TOT[192 + ch];
                const float cs = AAB[r * 64 + ch] + off;
                const float lwv = lwl[i];
                const float kk = kkv[i] * rn;
                const float e2 = __expf(-cs), e4 = __expf(tot - cs);
                atv[i] = kk * __expf(cs - lwv); btv[i] = -kk * aa[i] * e2; ktv[i] = kf[i] * e2; rtv[i] = rr[i] * __expf(cs);
                VT[ch * 72 + r] = f2bf(vv[i]);
                KDT[ch * 72 + r] = f2bf(kf[i] * e4);
                bdv[i] = -kk * aa[i] * e4;
                if (r == 63) RDSC[(size_t)item * 64 + ch] = __expf(tot);
            }
#pragma unroll
            for (int q = 0; q < 8; ++q) { wat[q] = pk2(atv[2 * q], atv[2 * q + 1]); wbt[q] = pk2(btv[2 * q], btv[2 * q + 1]); wkt[q] = pk2(ktv[2 * q], ktv[2 * q + 1]); wrt[q] = pk2(rtv[2 * q], rtv[2 * q + 1]); wvp[q] = pk2(vv[2 * q], vv[2 * q + 1]); }
            *(uint4*)(AT + r * 72 + c0) = make_uint4(wat[0], wat[1], wat[2], wat[3]); *(uint4*)(AT + r * 72 + c0 + 8) = make_uint4(wat[4], wat[5], wat[6], wat[7]);
            *(uint4*)(BTL + r * 72 + c0) = make_uint4(wbt[0], wbt[1], wbt[2], wbt[3]); *(uint4*)(BTL + r * 72 + c0 + 8) = make_uint4(wbt[4], wbt[5], wbt[6], wbt[7]);
            *(uint4*)(KT + r * 72 + c0) = make_uint4(wkt[0], wkt[1], wkt[2], wkt[3]); *(uint4*)(KT + r * 72 + c0 + 8) = make_uint4(wkt[4], wkt[5], wkt[6], wkt[7]);
            *(uint4*)(RT + r * 72 + c0) = make_uint4(wrt[0], wrt[1], wrt[2], wrt[3]); *(uint4*)(RT + r * 72 + c0 + 8) = make_uint4(wrt[4], wrt[5], wrt[6], wrt[7]);
            bf16* a2p = RA2 + (size_t)item * 64 * 64;
            *(uint4*)(a2p + frag_off(r, c0, 2)) = make_uint4(wrt[0], wrt[1], wrt[2], wrt[3]); *(uint4*)(a2p + frag_off(r, c0 + 8, 2)) = make_uint4(wrt[4], wrt[5], wrt[6], wrt[7]);
            bf16* vpp = VP + (size_t)t * 1024 + h * 64 + c0;
            *(uint4*)vpp = make_uint4(wvp[0], wvp[1], wvp[2], wvp[3]); *(uint4*)(vpp + 8) = make_uint4(wvp[4], wvp[5], wvp[6], wvp[7]);
        }
        __syncthreads();
        TSMARK(2);
        if (it0 + (int)gridDim.x * 2 < 4096) RCL_LOAD(item + (int)gridDim.x * 2, tv);
        {
            bf16* BDS = (bf16*)AAB;
#pragma unroll
            for (int i = 0; i < 16; ++i) BDS[(c0 + i) * 72 + r] = f2bf(bdv[i]);
        }
        const int fr = lane & 15, fq = lane >> 4;
        f32x4_t cab[4], cak[4], crb[4], crk[4];
        {
            const int j0t = w4 * 16;
            bf16x8_t bj[2], kj[2];
#pragma unroll
            for (int kb = 0; kb < 2; ++kb) { bj[kb] = *(const bf16x8_t*)(BTL + (j0t + fr) * 72 + kb * 32 + fq * 8); kj[kb] = *(const bf16x8_t*)(KT + (j0t + fr) * 72 + kb * 32 + fq * 8); }
#pragma unroll
            for (int it = 0; it < 4; ++it) {
                cab[it] = (f32x4_t){0.f, 0.f, 0.f, 0.f}; cak[it] = cab[it]; crb[it] = cab[it]; crk[it] = cab[it];
#pragma unroll
                for (int kb = 0; kb < 2; ++kb) {
                    const bf16x8_t ai = *(const bf16x8_t*)(AT + (it * 16 + fr) * 72 + kb * 32 + fq * 8);
                    const bf16x8_t ri = *(const bf16x8_t*)(RT + (it * 16 + fr) * 72 + kb * 32 + fq * 8);
                    cab[it] = MFMA16(bj[kb], ai, cab[it]); cak[it] = MFMA16(kj[kb], ai, cak[it]); crb[it] = MFMA16(bj[kb], ri, crb[it]); crk[it] = MFMA16(kj[kb], ri, crk[it]);
                }
            }
        }
        __syncthreads();
        {
            const bf16* BDS = (const bf16*)AAB; bf16* bp = RA4 + (size_t)item * 64 * 64;
#pragma unroll
            for (int q = 0; q < 2; ++q) { const int p = ht + 256 * q, pfr = p & 15, pfq = (p >> 4) & 3, pkb = (p >> 6) & 1, prt = p >> 7;
                *(uint4*)(bp + p * 8) = *(const uint4*)(BDS + (prt * 16 + pfr) * 72 + pkb * 32 + pfq * 8); }
        }
        __syncthreads();
        {
            const int j0 = w4 * 16 + 4 * fq;
#pragma unroll
            for (int it = 0; it < 4; ++it) {
                const int i = it * 16 + fr;
                float vab[4], vak[4], vrb[4], vrk[4];
#pragma unroll
                for (int rg = 0; rg < 4; ++rg) { const int j = j0 + rg; const bool st = i > j, in = i >= j;
                    vab[rg] = st ? cab[it][rg] : 0.f; vak[rg] = st ? cak[it][rg] : 0.f; vrb[rg] = in ? crb[it][rg] : 0.f; vrk[rg] = in ? crk[it][rg] : 0.f; }
                *(float4*)(AAB + i * 64 + j0) = make_float4(vab[0], vab[1], vab[2], vab[3]);
                uint2 w; w.x = pk2(vak[0], vak[1]); w.y = pk2(vak[2], vak[3]); *(uint2*)(AAK + i * 72 + j0) = w;
                w.x = pk2(vrk[0], vrk[1]); w.y = pk2(vrk[2], vrk[3]); *(uint2*)(ARK + i * 72 + j0) = w;
                w.x = pk2(vrb[0], vrb[1]); w.y = pk2(vrb[2], vrb[3]); *(uint2*)(RA3 + (size_t)item * 64 * 64 + frag_off(i, j0, 2)) = w;
            }
        }
        __syncthreads();
        f32x4_t cav[4], cov[4], ckv[4];
        {
            const int r0t = w4 * 16;
            bf16x8_t fa[2], fo[2], fk[2];
#pragma unroll
            for (int kb = 0; kb < 2; ++kb) { fa[kb] = *(const bf16x8_t*)(AAK + (r0t + fr) * 72 + kb * 32 + fq * 8); fo[kb] = *(const bf16x8_t*)(ARK + (r0t + fr) * 72 + kb * 32 + fq * 8); fk[kb] = *(const bf16x8_t*)(KDT + (r0t + fr) * 72 + kb * 32 + fq * 8); }
#pragma unroll
            for (int vt = 0; vt < 4; ++vt) {
                cav[vt] = (f32x4_t){0.f, 0.f, 0.f, 0.f}; cov[vt] = cav[vt]; ckv[vt] = cav[vt];
#pragma unroll
                for (int kb = 0; kb < 2; ++kb) { const bf16x8_t vb = *(const bf16x8_t*)(VT + (vt * 16 + fr) * 72 + kb * 32 + fq * 8);
                    cav[vt] = MFMA16(fa[kb], vb, cav[vt]); cov[vt] = MFMA16(fo[kb], vb, cov[vt]); ckv[vt] = MFMA16(fk[kb], vb, ckv[vt]); }
            }
        }
        __syncthreads();
        {
            const int r0 = w4 * 16 + 4 * fq;
#pragma unroll
            for (int vt = 0; vt < 4; ++vt) {
                const int v = vt * 16 + fr;
#pragma unroll
                for (int rg = 0; rg < 4; ++rg) RHS2[v * 65 + r0 + rg] = cav[vt][rg];
                { uint2 w; w.x = pk2(cov[vt][0], cov[vt][1]); w.y = pk2(cov[vt][2], cov[vt][3]); *(uint2*)(RO0 + (size_t)item * 64 * 64 + cfrag_off(v, r0, 4)) = w; }
                { uint2 w; w.x = pk2(ckv[vt][0], ckv[vt][1]); w.y = pk2(ckv[vt][2], ckv[vt][3]); *(uint2*)(RS0 + (size_t)item * 64 * 64 + cfrag_off(v, r0, 4)) = w; }
            }
        }
        __syncthreads();
        TSMARK(3);
        {
            const int col = ht >> 1, p = ht & 1, cc = col & 63; const bool isu = col >= 64;
            float xs[32];
#pragma unroll
            for (int i = 0; i < 32; ++i) xs[i] = 0.f;
            float4 mc[8], mn[8];
#pragma unroll
            for (int q = 0; q < 8; ++q) { mc[q] = make_float4(0.f, 0.f, 0.f, 0.f); mn[q] = mc[q]; }
            float rhs_n; { const float rv = RHS2[(isu ? cc : 0) * 65], av = bf2f(AT[(isu ? 0 : cc)]); rhs_n = isu ? rv : av; }
#pragma unroll
            for (int i = 0; i < 64; ++i) {
                const float rhs = rhs_n;
                if (i + 1 < 64) {
#pragma unroll
                    for (int q = 0; q < (i + 8) / 8; ++q) mn[q] = *(const float4*)(AAB + (i + 1) * 64 + 8 * q + 4 * p);
                    const float rv = RHS2[(isu ? cc : 0) * 65 + i + 1], av = bf2f(AT[(i + 1) * 72 + (isu ? 0 : cc)]); rhs_n = isu ? rv : av;
                }
                float a0 = 0.f, a1 = 0.f, a2 = 0.f, a3 = 0.f;
#pragma unroll
                for (int q = 0; q < (i + 7) / 8; ++q) { a0 += mc[q].x * xs[4 * q]; a1 += mc[q].y * xs[4 * q + 1]; a2 += mc[q].z * xs[4 * q + 2]; a3 += mc[q].w * xs[4 * q + 3]; }
                float tot = (a0 + a1) + (a2 + a3);
                tot += dpp_xor1(tot);
                const float xi = rhs + tot;
                const int g = i >> 2, slot = (g >> 1) * 4 + (i & 3);
                xs[slot] = (p == (g & 1)) ? xi : xs[slot];
#pragma unroll
                for (int q = 0; q < 8; ++q) mc[q] = mn[q];
                asm volatile("" ::: "memory");
            }
            if (isu) {
                bf16* up = RX0 + (size_t)item * 64 * 64;
#pragma unroll
                for (int q = 0; q < 8; ++q) { uint2 w; w.x = pk2(xs[4 * q], xs[4 * q + 1]); w.y = pk2(xs[4 * q + 2], xs[4 * q + 3]); *(uint2*)(up + cfrag_off(cc, 4 * (2 * q + p), 4)) = w; }
            }
            __syncthreads();
            TSMARK(4);
            if (!isu) {
#pragma unroll
                for (int q = 0; q < 8; ++q)
#pragma unroll
                    for (int e = 0; e < 4; ++e) AT[(4 * (2 * q + p) + e) * 72 + cc] = f2bf(xs[4 * q + e]);
            }
        }
        __syncthreads();
        {
            bf16* wp = RA1 + (size_t)item * 64 * 64;
#pragma unroll
            for (int q = 0; q < 2; ++q) { const int p = ht + 256 * q, fr = p & 15, fq = (p >> 4) & 3, kb = (p >> 6) & 1, rt = p >> 7;
                *(uint4*)(wp + p * 8) = *(const uint4*)(AT + (rt * 16 + fr) * 72 + kb * 32 + fq * 8); }
        }
    }
    if (TS_BEGIN >= 0 && blockIdx.x == 0 && c.tid == 0) c.ws<unsigned>(WS_CTL)[CW_TS] = (unsigned)ts_acc;
#undef TSMARK
#undef RCL_LOAD
}

template <int DK, bool RW>
struct ScanArgs { const bf16* A1; const bf16* X0; const bf16* A2; const bf16* A3; const bf16* O0; const bf16* A4; const bf16* S0; const float* DSC; bf16* OUT; int item0; int vs; int tok0; int ocol0; };
#define LBAR() do { asm volatile("s_waitcnt lgkmcnt(0)" ::: "memory"); __builtin_amdgcn_s_barrier(); asm volatile("" ::: "memory"); } while (0)
template <int DK, bool RW>
__device__ __forceinline__ void scan_run(const Ctx& c, const ScanArgs<DK, RW>& a) {
    constexpr int KB = DK / 32;
    constexpr int NST = DK / 64;
    constexpr int NV = RW ? 64 : 128;
    constexpr int SROW = DK + 8;
    bf16* ST = (bf16*)c.lds;
    bf16* XT = ST + 2 * 32 * SROW;
    const int lane = c.lane, w = c.wave, fr = lane & 15, fq = lane >> 4;
    const int tm = w >> 1, tn = w & 1;
    const int dkt = (NST == 2) ? w : (w >> 1);
    for (int i = c.tid; i < 32 * SROW / 2; i += NTHREADS) ((unsigned*)ST)[i] = 0u;
    f32x4_t accS[NST];
#pragma unroll
    for (int s = 0; s < NST; ++s) accS[s] = (f32x4_t){0.f, 0.f, 0.f, 0.f};
    bf16x8_t a1f[KB], a2f[KB], a3f[2], a4f[2]; f32x4_t x0v, o0v, s0v[NST], dscv;
#define SCAN_LOAD(IT) do { const size_t it_ = (size_t)(IT); \
        _Pragma("unroll") for (int kb = 0; kb < KB; ++kb) { a1f[kb] = *(const bf16x8_t*)(a.A1 + it_ * 64 * DK + ((tm * KB + kb) * 64 + lane) * 8); a2f[kb] = *(const bf16x8_t*)(a.A2 + it_ * 64 * DK + ((tm * KB + kb) * 64 + lane) * 8); } \
        _Pragma("unroll") for (int kb = 0; kb < 2; ++kb) { a3f[kb] = *(const bf16x8_t*)(a.A3 + it_ * 64 * 64 + ((tm * 2 + kb) * 64 + lane) * 8); a4f[kb] = *(const bf16x8_t*)(a.A4 + it_ * DK * 64 + ((dkt * 2 + kb) * 64 + lane) * 8); } \
        { const uint2 q_ = *(const uint2*)(a.X0 + it_ * NV * 64 + (((a.vs * 2 + tn) * 4 + tm) * 64 + lane) * 4); x0v = (f32x4_t){bflo(q_.x), bfhi(q_.x), bflo(q_.y), bfhi(q_.y)}; } \
        if (RW) { { const uint2 q_ = *(const uint2*)(a.O0 + it_ * NV * 64 + (((a.vs * 2 + tn) * 4 + tm) * 64 + lane) * 4); o0v = (f32x4_t){bflo(q_.x), bfhi(q_.x), bflo(q_.y), bfhi(q_.y)}; } \
                  _Pragma("unroll") for (int s = 0; s < NST; ++s) { const uint2 q_ = *(const uint2*)(a.S0 + it_ * 64 * DK + (((a.vs * 2 + (NST == 2 ? s : tn)) * (DK / 16) + dkt) * 64 + lane) * 4); s0v[s] = (f32x4_t){bflo(q_.x), bfhi(q_.x), bflo(q_.y), bfhi(q_.y)}; } \
                  dscv = *(const f32x4_t*)(a.DSC + it_ * DK + dkt * 16 + 4 * fq); } \
        else { const float g_ = a.DSC[it_]; dscv = (f32x4_t){g_, g_, g_, g_}; o0v = (f32x4_t){0.f, 0.f, 0.f, 0.f}; _Pragma("unroll") for (int s = 0; s < NST; ++s) s0v[s] = (f32x4_t){0.f, 0.f, 0.f, 0.f}; } \
    } while (0)
    SCAN_LOAD(a.item0);
    int cur = 0;
    for (int n = 0; n < 64; ++n) {
        bf16x8_t b1[KB], b2[KB], b3[2], b4[2];
#pragma unroll
        for (int kb = 0; kb < KB; ++kb) { b1[kb] = a1f[kb]; b2[kb] = a2f[kb]; }
        b3[0] = a3f[0]; b3[1] = a3f[1]; b4[0] = a4f[0]; b4[1] = a4f[1];
        f32x4_t accX = x0v, accO = o0v; const f32x4_t dv = dscv; f32x4_t sv[NST];
#pragma unroll
        for (int s = 0; s < NST; ++s) sv[s] = s0v[s];
        if (n + 1 < 64) SCAN_LOAD(a.item0 + n + 1);
        LBAR();
        const bf16* Sc = ST + cur * 32 * SROW; bf16* Sn = ST + (cur ^ 1) * 32 * SROW;
        bf16x8_t sf[KB];
#pragma unroll
        for (int kb = 0; kb < KB; ++kb) sf[kb] = *(const bf16x8_t*)(Sc + (tn * 16 + fr) * SROW + kb * 32 + fq * 8);
#pragma unroll
        for (int kb = 0; kb < KB; ++kb) accX = MFMA16(b1[kb], sf[kb], accX);
        { uint2 wv; wv.x = pk2(accX[0], accX[1]); wv.y = pk2(accX[2], accX[3]); *(uint2*)(XT + (tn * 16 + fr) * 72 + tm * 16 + 4 * fq) = wv; }
#pragma unroll
        for (int kb = 0; kb < KB; ++kb) accO = MFMA16(b2[kb], sf[kb], accO);
        LBAR();
        bf16x8_t xf[2];
#pragma unroll
        for (int kb = 0; kb < 2; ++kb) xf[kb] = *(const bf16x8_t*)(XT + (tn * 16 + fr) * 72 + kb * 32 + fq * 8);
        accO = MFMA16(b3[0], xf[0], accO); accO = MFMA16(b3[1], xf[1], accO);
        {
            bf16* op = a.OUT + (size_t)(a.tok0 + n * 64 + tm * 16 + 4 * fq) * 1024 + a.ocol0 + tn * 16 + fr;
            op[0] = f2bf(accO[0]); op[1024] = f2bf(accO[1]); op[2048] = f2bf(accO[2]); op[3072] = f2bf(accO[3]);
        }
#pragma unroll
        for (int s = 0; s < NST; ++s) {
            const int vt = (NST == 2) ? s : tn;
            bf16x8_t xg[2];
            if (vt == tn) { xg[0] = xf[0]; xg[1] = xf[1]; }
            else {
#pragma unroll
                for (int kb = 0; kb < 2; ++kb) xg[kb] = *(const bf16x8_t*)(XT + (vt * 16 + fr) * 72 + kb * 32 + fq * 8);
            }
            f32x4_t t = accS[s] * dv + sv[s];
            t = MFMA16(b4[0], xg[0], t); t = MFMA16(b4[1], xg[1], t);
            accS[s] = t;
            uint2 wv; wv.x = pk2(t[0], t[1]); wv.y = pk2(t[2], t[3]);
            *(uint2*)(Sn + (vt * 16 + fr) * SROW + dkt * 16 + 4 * fq) = wv;
        }
        cur ^= 1;
    }
#undef SCAN_LOAD
    __syncthreads();
}

__device__ __forceinline__ void ph_scan(const Ctx& c) {
    for (int wk = blockIdx.x; wk < 256; wk += gridDim.x) {
        const int xcd = wk & 7, j = wk >> 3;
        if (j < 16) {
            const int pair = xcd * 4 + (j >> 2), vs = j & 3, b = pair >> 3, h = pair & 7;
            ScanArgs<128, false> a{c.ws<bf16>(WS_GA1), c.ws<bf16>(WS_GX0), c.ws<bf16>(WS_GA2), c.ws<bf16>(WS_GA3), nullptr, c.ws<bf16>(WS_GA4), nullptr, c.ws<float>(WS_GGL),
                                   c.ws<bf16>(WS_OG), pair * 64, vs, b * SEQ, h * 128 + vs * 32};
            scan_run<128, false>(c, a);
        } else {
            const int pair = xcd * 8 + ((j - 16) >> 1), vs = (j - 16) & 1, b = pair >> 4, h = pair & 15;
            ScanArgs<64, true> a{c.ws<bf16>(WS_RA1), c.ws<bf16>(WS_RX0), c.ws<bf16>(WS_RA2), c.ws<bf16>(WS_RA3), c.ws<bf16>(WS_RO0), c.ws<bf16>(WS_RA4), c.ws<bf16>(WS_RS0), c.ws<float>(WS_RDSC),
                                 c.ws<bf16>(WS_ORW), pair * 64, vs, b * SEQ, h * 64 + vs * 32};
            scan_run<64, true>(c, a);
        }
    }
}

enum { PH_RMS0 = 0, PH_INPROJ, PH_GCL, PH_LORA, PH_RCL, PH_SCAN, PH_POST, PH_G2, PH_X1, PH_ROUTER, PH_DISPATCH, PH_MOE1, PH_MOE2, PH_COMBINE, PH_COUNT };

template <unsigned PHMASK>
__global__ void __launch_bounds__(NTHREADS) mk(Params P) {
    extern __shared__ __attribute__((aligned(16))) unsigned char lds[];
    volatile LAS unsigned* misc = (volatile LAS unsigned*)((LAS unsigned char*)lds + MISC_OFF);
    if (threadIdx.x < 64) misc[threadIdx.x] = 0u;
    __syncthreads();
    unsigned* ctl = (unsigned*)(P.ws + WS_CTL);
    XcdBarrier bar = xcd_barrier_post(ctl + CW_BAR + P.li * XCD_BAR_WORDS, misc);
#define MKCTX() int tv_ = threadIdx.x; asm volatile("" : "+v"(tv_)); const int wv_ = __builtin_amdgcn_readfirstlane(tv_ >> 6); \
    Ctx c{P, tv_, tv_ & 63, wv_, (int)(blockIdx.x * NWAVES + wv_), (int)(gridDim.x * NWAVES), (size_t)blockIdx.x * NTHREADS + tv_, (size_t)gridDim.x * NTHREADS, lds}
    bool first_seam = true;
#define IN(k) (((PHMASK >> (k)) & 1u) && P.ph_lo <= (k) && (k) < P.ph_hi)
#define SEAM(k) do { if ((k) + 1 < P.ph_hi) { xcd_barrier(bar); first_seam = false; } } while (0)
#define REP(k) for (int rep_ = 0; rep_ < ((k) == PROBE_REP ? 2 : 1); ++rep_)
    if (IN(PH_RMS0)) { MKCTX();
        REP(PH_RMS0) {
        ph_rms0(c);
        { WJob j{P.in[I_W_IN], NCOL_IN, 1024, 4096, c.ws<bf16>(WS_WIN_T), 1024, 1, 0, 0}; wconv_job(c, j); }
        { WJob j{P.in[I_W_IN] + 4112, NCOL_IN, 1024, 5376, c.ws<bf16>(WS_WIN_T) + (size_t)4096 * 1024, 1024, 1, 0, 0}; wconv_job(c, j); }
        lora_zero(c);
        { WJob j{P.in[I_W2], 1024, 64, 1024, c.ws<bf16>(WS_LORA_T), 256, 1, 0, 0}; wconv_job(c, j); }
        { WJob j{P.in[I_A2], 1024, 64, 1024, c.ws<bf16>(WS_LORA_T) + (size_t)1024 * 256 + 64, 256, 1, 0, 0}; wconv_job(c, j); }
        { WJob j{P.in[I_G2], 1024, 128, 1024, c.ws<bf16>(WS_LORA_T) + (size_t)2048 * 256 + 128, 256, 1, 0, 0}; wconv_job(c, j); }
        }
        SEAM(PH_RMS0);
    }
    if (IN(PH_INPROJ)) { MKCTX();
        REP(PH_INPROJ) {
        EpiInProj ep{c.ws<bf16>(WS_GQKV), c.ws<bf16>(WS_ZS), c.ws<bf16>(WS_RKV), c.ws<float>(WS_LIN), c.ws<bf16>(WS_GATES)};
        SchedInProj sc{(const char*)c.ws<bf16>(WS_HB), (const char*)c.ws<bf16>(WS_WIN_T), (int)gridDim.x, (int)blockIdx.x};
        pg8::gemm_phase((LAS unsigned char*)lds, 1024, sc, ep, c.tid);
        }
        SEAM(PH_INPROJ);
    }
    if (IN(PH_GCL)) { MKCTX(); REP(PH_GCL) { ph_gcl(c); ph_loraprep(c); } SEAM(PH_GCL); }
    if (IN(PH_LORA)) { MKCTX();
        REP(PH_LORA) {
        EpiLora ep{P.in[I_W0], P.in[I_A0], c.ws<float>(WS_LW), c.ws<float>(WS_AA), c.ws<bf16>(WS_GGR)};
        SchedLora sc{(const char*)c.ws<bf16>(WS_ALORA), (const char*)c.ws<bf16>(WS_LORA_T), (int)gridDim.x, (int)blockIdx.x};
        pg8::gemm_phase((LAS unsigned char*)lds, 256, sc, ep, c.tid);
        }
        SEAM(PH_LORA);
    }
    if (IN(PH_RCL)) { MKCTX(); REP(PH_RCL) { ph_rcl(c); } SEAM(PH_RCL); }
    if (IN(PH_SCAN)) { MKCTX(); REP(PH_SCAN) { ph_scan(c); } SEAM(PH_SCAN); }
    if (IN(PH_POST)) { MKCTX();
        REP(PH_POST) {
        ph_post(c);
        { WJob j{P.in[I_PROJ_A], 1024, 1024, 1024, c.ws<bf16>(WS_PROJ_T), 1024, 1, 0, 0}; wconv_job(c, j); }
        { WJob j{P.in[I_PROJ_B], 1024, 1024, 1024, c.ws<bf16>(WS_PROJ_T) + (size_t)1024 * 1024, 1024, 1, 0, 0}; wconv_job(c, j); }
        { WJob j{P.in[I_W_OUT], 1024, 1024, 1024, c.ws<bf16>(WS_WOUT_T), 1024, 1, 0, 0}; wconv_job(c, j); }
        }
        SEAM(PH_POST);
    }
    if (IN(PH_G2)) { MKCTX();
        REP(PH_G2) {
        EpiG2 ep{c.ws<bf16>(WS_GATES), c.ws<bf16>(WS_G2)};
        SchedG2 sc{(const char*)c.ws<bf16>(WS_YA), (const char*)c.ws<bf16>(WS_PROJ_T), (int)gridDim.x, (int)blockIdx.x};
        pg8::gemm_phase((LAS unsigned char*)lds, 1024, sc, ep, c.tid);
        }
        SEAM(PH_G2);
    }
    if (IN(PH_X1)) { MKCTX();
        REP(PH_X1) {
        EpiX1 ep{P.in[I_X], c.ws<float>(WS_X1)};
        SchedX1 sc{(const char*)c.ws<bf16>(WS_G2), (const char*)c.ws<bf16>(WS_WOUT_T), (int)gridDim.x, (int)blockIdx.x};
        pg8::gemm_phase((LAS unsigned char*)lds, 1024, sc, ep, c.tid);
        }
        SEAM(PH_X1);
    }
    if (IN(PH_ROUTER)) { MKCTX();
        ph_router(c);
        REP(PH_ROUTER) {
        { WJob j{P.in[I_W_GU], 2048, 1024, 2048, c.ws<bf16>(WS_WGU_T), 1024, 32, (size_t)1024 * 2048, (size_t)2048 * 1024}; wconv_job(c, j); }
        { WJob j{P.in[I_W_DOWN], 1024, 1024, 1024, c.ws<bf16>(WS_WDN_T), 1024, 32, (size_t)1024 * 1024, (size_t)1024 * 1024}; wconv_job(c, j); }
        }
        SEAM(PH_ROUTER);
    }
    if (IN(PH_DISPATCH)) { MKCTX(); REP(PH_DISPATCH) { ph_dispatch(c); } SEAM(PH_DISPATCH); }
    if (IN(PH_MOE1)) { MKCTX();
        REP(PH_MOE1) {
        const int nt = *c.ws<int>(WS_NT);
        EpiAct ep{P.in[I_B_GU], c.ws<bf16>(WS_ACT)};
        SchedMoe sc{(const char*)c.ws<bf16>(WS_H2), (const char*)c.ws<bf16>(WS_WGU_T), c.ws<int>(WS_TILE_E), c.ws<int>(WS_SLOT_TOK), nt, 8, (int)gridDim.x, (int)blockIdx.x};
        pg8::gemm_phase_t<true>((LAS unsigned char*)lds, 1024, sc, ep, c.tid);
        }
        SEAM(PH_MOE1);
    }
    if (IN(PH_MOE2)) { MKCTX();
        REP(PH_MOE2) {
        const int nt = *c.ws<int>(WS_NT);
        EpiYS ep{P.in[I_B_DOWN], c.ws<float>(WS_SGATE), c.ws<bf16>(WS_YS)};
        SchedMoe sc{(const char*)c.ws<bf16>(WS_ACT), (const char*)c.ws<bf16>(WS_WDN_T), c.ws<int>(WS_TILE_E), nullptr, nt, 4, (int)gridDim.x, (int)blockIdx.x};
        pg8::gemm_phase((LAS unsigned char*)lds, 1024, sc, ep, c.tid);
        }
        SEAM(PH_MOE2);
    }
    if (IN(PH_COMBINE)) { MKCTX(); REP(PH_COMBINE) { ph_combine(c); } }
#undef IN
#undef SEAM
#undef REP
#undef MKCTX
}

template <unsigned M> static void launch_one(const Params& p, int grid, hipStream_t stream) {
    static bool attr = false;
    if (!attr) { (void)hipFuncSetAttribute((const void*)mk<M>, hipFuncAttributeMaxDynamicSharedMemorySize, LDS_BYTES); attr = true; }
    hipLaunchKernelGGL(mk<M>, dim3(grid), dim3(NTHREADS), LDS_BYTES, stream, p);
}
template <int PH> static void launch_chain(Params& p, int grid, hipStream_t stream) {
    if constexpr (PH < PH_COUNT) { p.ph_lo = PH; p.ph_hi = PH + 1; p.li = 0; p.coop = 0; launch_one<(1u << PH)>(p, grid, stream); launch_chain<PH + 1>(p, grid, stream); }
}

extern "C" void kernel_launch(void* const* d_in, const int* in_sizes, int n_in, void* d_out, int out_size, void* d_ws, size_t ws_size, hipStream_t stream) {
    static int grid = 0;
    if (grid == 0) {
        int dev = 0, cus = 0, per_cu = 0;
        (void)hipGetDevice(&dev);
        (void)hipDeviceGetAttribute(&cus, hipDeviceAttributeMultiprocessorCount, dev);
#if MK_ONE_LAUNCH
        (void)hipFuncSetAttribute((const void*)mk<0xffffffffu>, hipFuncAttributeMaxDynamicSharedMemorySize, LDS_BYTES);
        (void)hipOccupancyMaxActiveBlocksPerMultiprocessor(&per_cu, (const void*)mk<0xffffffffu>, NTHREADS, LDS_BYTES);
#else
        per_cu = 1;
#endif
        if (n_in != 29 || ws_size < WS_END || per_cu < 1 || cus < 64) { fprintf(stderr, "kernel_launch: unexpected setup n_in %d ws %zu per_cu %d cus %d\n", n_in, ws_size, per_cu, cus); grid = -1; return; }
        grid = cus;
    }
    if (grid < 0) return;
    (void)hipMemsetAsync((char*)d_ws + WS_CTL, 0, CTL_BYTES, stream);
    Params p{};
    for (int i = 0; i < 29; ++i) p.in[i] = (const float*)d_in[i];
    p.out = (float*)d_out; p.ws = (unsigned char*)d_ws;
#if MK_ONE_LAUNCH
    p.ph_lo = 0; p.ph_hi = PH_COUNT; p.li = 0; p.coop = 1;
    void* args[] = {&p};
    hipError_t e = hipLaunchCooperativeKernel((const void*)mk<0xffffffffu>, dim3(grid), dim3(NTHREADS), args, LDS_BYTES, stream);
    if (e != hipSuccess) fprintf(stderr, "cooperative launch failed: %s (grid %d)\n", hipGetErrorString(e), grid);
#else
    launch_chain<0>(p, grid, stream);
#endif
}
```

```cpp
#include <hip/hip_runtime.h>
#include <hip/hip_cooperative_groups.h>
#include <cstdint>
#include <cstdio>
namespace cg = cooperative_groups;

#ifndef MK_ONE_LAUNCH
#define MK_ONE_LAUNCH 1
#endif

#define LAS __attribute__((address_space(3)))
#ifndef FAST_INPROJ
#define FAST_INPROJ 1
#endif
#ifndef FAST_MIX
#define FAST_MIX 1
#endif
#define TS_BEGIN -1
#define TS_END -1
#define PROBE_REP -1
constexpr int NTHREADS = 512;
constexpr int NWAVES = 8;
constexpr int LDS_BYTES = 155648;
constexpr int MISC_OFF = 153600;

constexpr int T = 16384, SEQ = 4096, D = 1024;
constexpr int NCOL_IN = 9488;
constexpr int NEXP = 32;
constexpr int MAXTILES = 288;
constexpr int MAXSLOTS = MAXTILES * 256;

enum { I_X = 0, I_NORM_MIX, I_W_IN, I_GDN_CONV, I_GDN_ALOG, I_GDN_DTB, I_GDN_NORM, I_MU, I_W0, I_W2, I_A0, I_A2, I_G2, I_KK, I_KA, I_RK,
       I_LNW, I_LNB, I_PROJ_A, I_PROJ_B, I_W_OUT, I_NORM_FFN, I_ROUTER_W, I_ROUTER_B, I_W_GU, I_B_GU, I_W_DOWN, I_B_DOWN, I_NORM_FINAL };

constexpr size_t MiB = 1u << 20;
constexpr size_t WS_CTL = 0, CTL_BYTES = 65536;
constexpr size_t WS_BETA = 1 * MiB;
constexpr size_t WS_GG = WS_BETA + 512 * 1024;
constexpr size_t WS_SC = 2 * MiB;
constexpr size_t WS_TE = 3 * MiB;
constexpr size_t WS_TG = WS_TE + 256 * 1024;
constexpr size_t WS_TP = WS_TG + 256 * 1024;
constexpr size_t WS_TSLOT = WS_TP + 256 * 1024;
constexpr size_t WS_SGATE = 4 * MiB;
constexpr size_t WS_SLOT_TOK = 4 * MiB + 512 * 1024;
constexpr size_t WS_TILE_E = 5 * MiB;
constexpr size_t WS_NT = WS_TILE_E + 4096;
constexpr size_t WS_HB = 8 * MiB;
constexpr size_t WS_H2 = WS_HB;
constexpr size_t WS_ZS = 40 * MiB;
constexpr size_t WS_GATES = 72 * MiB;
constexpr size_t WS_ALORA = 136 * MiB;
constexpr size_t WS_LW = 144 * MiB;
constexpr size_t WS_AA = 208 * MiB;
constexpr size_t WS_GGR = 272 * MiB;
constexpr size_t WS_VP = 304 * MiB;
constexpr size_t WS_Q = 336 * MiB;
constexpr size_t WS_QKVC = WS_Q;
constexpr size_t WS_RP = WS_Q, WS_KF = WS_Q + 64 * MiB, WS_KKN = WS_Q + 128 * MiB;
constexpr size_t WS_YA = WS_Q, WS_YB = WS_Q + 32 * MiB, WS_G2 = WS_Q + 64 * MiB, WS_X1 = WS_Q + 128 * MiB;
constexpr size_t WS_GQKV = 528 * MiB;
constexpr size_t WS_OG = 720 * MiB, WS_ORW = 784 * MiB;
constexpr size_t WS_RKV = 720 * MiB;
constexpr size_t WS_LIN = 912 * MiB;
constexpr size_t WS_DEC = 928 * MiB;
constexpr size_t WS_XB = 528 * MiB;
constexpr size_t WS_ACT = 672 * MiB;
constexpr size_t WS_YS = 816 * MiB;
constexpr size_t WS_WIN_T = 992 * MiB;
constexpr size_t WS_PROJ_T = 144 * MiB;
constexpr size_t WS_WOUT_T = 148 * MiB;
constexpr size_t WS_WGU_T = 72 * MiB;
constexpr size_t WS_WDN_T = 200 * MiB;
constexpr size_t WS_GA1 = 336 * MiB, WS_GX0 = 368 * MiB, WS_GA2 = 432 * MiB, WS_GA3 = 464 * MiB, WS_GA4 = 480 * MiB;
constexpr size_t WS_GGL = 6 * MiB;
constexpr size_t WS_RX0 = 528 * MiB, WS_RO0 = 592 * MiB, WS_RS0 = 656 * MiB;
constexpr size_t WS_RA1 = 8 * MiB, WS_RA2 = 928 * MiB, WS_RA3 = 960 * MiB, WS_RA4 = 992 * MiB;
constexpr size_t WS_RDSC = 7 * MiB;
constexpr size_t WS_LORA_T = 1012 * MiB;
constexpr size_t WS_END = 1024 * MiB;
constexpr int CW_BAR = 1024;
constexpr int CW_CNT = 256;
constexpr int CW_TS = 900;

#define XB_TMO      128
#define XB_XCNT(j)  (256  + 64 * (j))
#define XB_XSUB(j)  (1280 + 64 * (j))
#define XB_XGEN(j)  (2304 + 64 * (j))
#define XB_TOP      3328
#define XB_TOPGEN   3392
#define XCD_BAR_WORDS 3456
#define XB_SPIN_CAP (1u << 24)
__device__ __forceinline__ unsigned xb_ld(unsigned* p)              { return __hip_atomic_load(p, __ATOMIC_RELAXED, __HIP_MEMORY_SCOPE_AGENT); }
__device__ __forceinline__ unsigned xb_add(unsigned* p, unsigned v) { return __hip_atomic_fetch_add(p, v, __ATOMIC_RELAXED, __HIP_MEMORY_SCOPE_AGENT); }
__device__ __forceinline__ unsigned xb_xcc_id() { return (unsigned)__builtin_amdgcn_s_getreg((3 << 11) | 20) & 0xFu; }
#define XB_SPIN(cond, bar) do { unsigned _sp = 0; while (cond) { __builtin_amdgcn_s_sleep(1); \
    if ((++_sp & 255u) == 0u) { if (xb_ld(&(bar)[XB_TMO])) break; if (_sp > XB_SPIN_CAP) { atomicAdd(&(bar)[XB_TMO], 1u); break; } } } } while (0)
struct XcdBarrier { unsigned* bar; unsigned x; volatile LAS unsigned* st; };
__device__ __forceinline__ XcdBarrier xcd_barrier_post(unsigned* bar, volatile LAS unsigned* st) {
    XcdBarrier b; b.bar = bar; b.x = xb_xcc_id(); b.st = st;
    if (threadIdx.x == 0) (void)xb_add(&bar[XB_XCNT(b.x)], 1u);
    return b;
}
__device__ __forceinline__ void xcd_barrier_complete(unsigned* bar, unsigned x, unsigned& nloc, unsigned& nx) {
    const unsigned G = gridDim.x * gridDim.y * gridDim.z;
    unsigned sum, cnt, mine, sp = 0u;
    for (;;) {
        sum = 0u; cnt = 0u; mine = 0u;
#pragma unroll
        for (unsigned j = 0; j < 16; ++j) { const unsigned c = xb_ld(&bar[XB_XCNT(j)]); sum += c; cnt += (c > 0u) ? 1u : 0u; mine = (j == x) ? c : mine; }
        if (sum == G) break;
        __builtin_amdgcn_s_sleep(1);
        if ((++sp & 255u) == 0u) { if (xb_ld(&bar[XB_TMO])) break; if (sp > XB_SPIN_CAP) { atomicAdd(&bar[XB_TMO], 1u); break; } }
    }
    nloc = mine > 0u ? mine : 1u; nx = cnt > 0u ? cnt : 1u;
}
__device__ __forceinline__ void xcd_barrier(const XcdBarrier& b) {
    asm volatile("s_waitcnt vmcnt(0)" ::: "memory");
    __syncthreads();
    if (threadIdx.x == 0) {
        unsigned* bar = b.bar;
        __builtin_amdgcn_s_waitcnt(0);
        unsigned nloc = b.st[0], nx = b.st[1];
        if (nloc == 0u) { xcd_barrier_complete(bar, b.x, nloc, nx); b.st[0] = nloc; b.st[1] = nx; }
        const unsigned old = xb_add(&bar[XB_XSUB(b.x)], 1u);
        const unsigned gen = old / nloc;
        if (old + 1u == (gen + 1u) * nloc) {
            __builtin_amdgcn_fence(__ATOMIC_RELEASE, "agent");
            asm volatile("s_waitcnt vmcnt(0)" ::: "memory");
            const unsigned og = xb_add(&bar[XB_TOP], 1u);
            const unsigned tg = og / nx;
            if (og + 1u == (tg + 1u) * nx) xb_add(&bar[XB_TOPGEN], 1u);
            else XB_SPIN(xb_ld(&bar[XB_TOPGEN]) == tg, bar);
            __builtin_amdgcn_fence(__ATOMIC_ACQUIRE, "agent");
            xb_add(&bar[XB_XGEN(b.x)], 1u);
            asm volatile("s_waitcnt vmcnt(0)" ::: "memory");
        } else {
            XB_SPIN(xb_ld(&bar[XB_XGEN(b.x)]) == gen, bar);
            __builtin_amdgcn_fence(__ATOMIC_ACQUIRE, "agent");
            asm volatile("s_waitcnt vmcnt(0)" ::: "memory");
        }
    }
    __syncthreads();
}

typedef unsigned short bf16;
typedef __bf16 bf16x2_t __attribute__((ext_vector_type(2)));
__device__ __forceinline__ bf16 f2bf(float f) { return __builtin_bit_cast(unsigned short, (__bf16)f); }
__device__ __forceinline__ float bf2f(unsigned b) { return __uint_as_float(b << 16); }
__device__ __forceinline__ unsigned pk2(float lo, float hi) { bf16x2_t v; v[0] = (__bf16)lo; v[1] = (__bf16)hi; return __builtin_bit_cast(unsigned, v); }
__device__ __forceinline__ float bflo(unsigned w) { return __uint_as_float(w << 16); }
__device__ __forceinline__ float bfhi(unsigned w) { return __uint_as_float(w & 0xffff0000u); }
__device__ __forceinline__ float sigm(float x) { return 1.f / (1.f + expf(-x)); }
__device__ __forceinline__ float fsigm(float x) { return __builtin_amdgcn_rcpf(1.f + __expf(-x)); }
__device__ __forceinline__ float softplusf(float x) { return x > 20.f ? x : log1pf(expf(x)); }
__device__ __forceinline__ float dpp_xor1(float v) { return __int_as_float(__builtin_amdgcn_update_dpp(0, __float_as_int(v), 0xB1, 0xF, 0xF, false)); }
__device__ __forceinline__ float wsum(float v) {
#pragma unroll
    for (int o = 32; o > 0; o >>= 1) v += __shfl_xor(v, o);
    return v;
}

struct Params { const float* in[29]; float* out; unsigned char* ws; int ph_lo, ph_hi, li, coop; };

struct Ctx {
    const Params& P; int tid, lane, wave, gwave, nwaves; size_t gtid, nthreads; unsigned char* lds;
    template <class Tp> __device__ __forceinline__ Tp* ws(size_t off) const { return (Tp*)(P.ws + off); }
};

__device__ __forceinline__ void ph_rms0(const Ctx& c) {
    const float* x = c.P.in[I_X]; const float* nw = c.P.in[I_NORM_MIX]; const float* win = c.P.in[I_W_IN];
    const float* alog = c.P.in[I_GDN_ALOG]; const float* dtb = c.P.in[I_GDN_DTB];
    bf16* HB = c.ws<bf16>(WS_HB); float* BETA = c.ws<float>(WS_BETA); float* GGv = c.ws<float>(WS_GG);
    if (blockIdx.x == 0 && c.tid < NEXP) c.ws<unsigned>(WS_CTL)[CW_CNT + c.tid] = 0u;
    float4* tab = (float4*)c.lds;
    __syncthreads();
    for (int i = c.tid; i < 4096; i += NTHREADS) { const int k = i >> 2; tab[((k & 3) * 256 + (k >> 2)) * 5 + (i & 3)] = *(const float4*)(win + (size_t)k * NCOL_IN + 4096 + (i & 3) * 4); }
    __syncthreads();
    const int lane = c.lane;
    for (int t = c.gwave; t < T; t += c.nwaves) {
        float4 v[4]; float ss = 0.f;
#pragma unroll
        for (int i = 0; i < 4; ++i) { v[i] = ((const float4*)(x + (size_t)t * D))[lane + 64 * i]; ss += v[i].x * v[i].x + v[i].y * v[i].y + v[i].z * v[i].z + v[i].w * v[i].w; }
        ss = wsum(ss);
        const float rstd = rsqrtf(ss * (1.f / 1024.f) + 1e-6f);
        float acc[16];
#pragma unroll
        for (int j = 0; j < 16; ++j) acc[j] = 0.f;
#pragma unroll
        for (int i = 0; i < 4; ++i) {
            const float4 w4 = ((const float4*)nw)[lane + 64 * i];
            float h[4] = {v[i].x * rstd * w4.x, v[i].y * rstd * w4.y, v[i].z * rstd * w4.z, v[i].w * rstd * w4.w};
            uint2 st; st.x = pk2(h[0], h[1]); st.y = pk2(h[2], h[3]);
            *(uint2*)(HB + (size_t)t * D + 4 * (lane + 64 * i)) = st;
#pragma unroll
            for (int ii = 0; ii < 4; ++ii) {
                const int k = 4 * (lane + 64 * i) + ii;
#pragma unroll
                for (int q = 0; q < 4; ++q) { const float4 w = tab[(ii * 256 + (k >> 2)) * 5 + q]; acc[4 * q + 0] += h[ii] * w.x; acc[4 * q + 1] += h[ii] * w.y; acc[4 * q + 2] += h[ii] * w.z; acc[4 * q + 3] += h[ii] * w.w; }
                if (ii & 1) asm volatile("" ::: "memory");
            }
        }
        float mine = 0.f;
#pragma unroll
        for (int j = 0; j < 16; ++j) { const float s = wsum(acc[j]); mine = (lane == j) ? s : mine; }
        if (lane < 8) BETA[t * 8 + lane] = sigm(mine);
        else if (lane < 16) { const int h = lane - 8; GGv[t * 8 + h] = -expf(alog[h]) * softplusf(mine + dtb[h]); }
    }
    __syncthreads();
}

struct NoLd {};
struct EpiInProj {
    typedef NoLd Ld; static constexpr int MB = 1;
    bf16* GQKV; bf16* ZS; bf16* RKV; float* LIN; bf16* GATES;
    __device__ __forceinline__ void load(Ld&, int, int, int) const {}
    __device__ __forceinline__ void store8(int row, int col, const float (&v)[8], int, const Ld&) const {
        if (col < 3072) { uint4 w; w.x = pk2(v[0], v[1]); w.y = pk2(v[2], v[3]); w.z = pk2(v[4], v[5]); w.w = pk2(v[6], v[7]); *(uint4*)(GQKV + (size_t)row * 3072 + col) = w; }
        else if (col < 4096) { uint4 w; w.x = pk2(v[0] * fsigm(v[0]), v[1] * fsigm(v[1])); w.y = pk2(v[2] * fsigm(v[2]), v[3] * fsigm(v[3])); w.z = pk2(v[4] * fsigm(v[4]), v[5] * fsigm(v[5])); w.w = pk2(v[6] * fsigm(v[6]), v[7] * fsigm(v[7]));
            *(uint4*)(ZS + (size_t)row * 1024 + (col - 3072)) = w; }
        else if (col < 7168) { uint4 w; w.x = pk2(v[0], v[1]); w.y = pk2(v[2], v[3]); w.z = pk2(v[4], v[5]); w.w = pk2(v[6], v[7]); *(uint4*)(RKV + (size_t)row * 3072 + (col - 4096)) = w; }
        else if (col < 7424) { float* p = LIN + (size_t)row * 256 + (col - 7168); *(float4*)p = make_float4(v[0], v[1], v[2], v[3]); *(float4*)(p + 4) = make_float4(v[4], v[5], v[6], v[7]); }
        else { uint4 w; w.x = pk2(fsigm(v[0]), fsigm(v[1])); w.y = pk2(fsigm(v[2]), fsigm(v[3])); w.z = pk2(fsigm(v[4]), fsigm(v[5])); w.w = pk2(fsigm(v[6]), fsigm(v[7]));
            *(uint4*)(GATES + (size_t)row * 2048 + (col - 7424)) = w; }
    }
};
struct EpiG2 {
    struct Ld { uint4 g; uint4 p; }; static constexpr int MB = 1;
    const bf16* GATES; bf16* MG;
    __device__ __forceinline__ void load(Ld& l, int row, int col, int) const { l.g = *(const uint4*)(GATES + (size_t)row * 2048 + col); const uint4 q = *(const uint4*)(MG + (size_t)row * 1024 + (col & 1023)); const bool b = col >= 1024; l.p = make_uint4(b ? q.x : 0u, b ? q.y : 0u, b ? q.z : 0u, b ? q.w : 0u); }
    __device__ __forceinline__ void store8(int row, int col, const float (&v)[8], int, const Ld& l) const {
        const uint4 g = l.g, p = l.p;
        uint4 w; w.x = pk2(v[0] * bflo(g.x) + bflo(p.x), v[1] * bfhi(g.x) + bfhi(p.x)); w.y = pk2(v[2] * bflo(g.y) + bflo(p.y), v[3] * bfhi(g.y) + bfhi(p.y));
        w.z = pk2(v[4] * bflo(g.z) + bflo(p.z), v[5] * bfhi(g.z) + bfhi(p.z)); w.w = pk2(v[6] * bflo(g.w) + bflo(p.w), v[7] * bfhi(g.w) + bfhi(p.w));
        *(uint4*)(MG + (size_t)row * 1024 + (col & 1023)) = w;
    }
};
struct EpiX1 {
    struct Ld { float4 a, b; }; static constexpr int MB = 2;
    const float* X; float* X1;
    __device__ __forceinline__ void load(Ld& l, int row, int col, int) const { const float* xp = X + (size_t)row * 1024 + col; l.a = *(const float4*)xp; l.b = *(const float4*)(xp + 4); }
    __device__ __forceinline__ void store8(int row, int col, const float (&v)[8], int, const Ld& l) const {
        float* op = X1 + (size_t)row * 1024 + col;
        const float4 a = l.a, b = l.b;
        *(float4*)op = make_float4(a.x + v[0], a.y + v[1], a.z + v[2], a.w + v[3]); *(float4*)(op + 4) = make_float4(b.x + v[4], b.y + v[5], b.z + v[6], b.w + v[7]);
    }
};
struct EpiAct {
    struct Ld { float4 b0, b1; }; static constexpr int MB = 4;
    const float* BGU; bf16* ACT;
    __device__ __forceinline__ void load(Ld& l, int, int col, int e) const { const float* bp = BGU + (size_t)e * 2048 + col; l.b0 = *(const float4*)bp; l.b1 = *(const float4*)(bp + 4); }
    __device__ __forceinline__ void store8(int row, int col, const float (&v)[8], int e, const Ld& l) const {
        const float4 b0 = l.b0, b1 = l.b1;
        const float bb[8] = {b0.x, b0.y, b0.z, b0.w, b1.x, b1.y, b1.z, b1.w};
        float o[4];
#pragma unroll
        for (int p = 0; p < 4; ++p) { float glu = v[2 * p] + bb[2 * p], lin = v[2 * p + 1] + bb[2 * p + 1]; glu = fminf(glu, 7.f); lin = fminf(fmaxf(lin, -7.f), 7.f); o[p] = glu * fsigm(1.702f * glu) * (lin + 1.f); }
        uint2 w; w.x = pk2(o[0], o[1]); w.y = pk2(o[2], o[3]);
        *(uint2*)(ACT + (size_t)row * 1024 + (col >> 1)) = w;
    }
};
struct EpiYS {
    struct Ld { float4 b0, b1; float g; }; static constexpr int MB = 4;
    const float* BD; const float* SGATE; bf16* YS;
    __device__ __forceinline__ void load(Ld& l, int row, int col, int e) const { const float* bp = BD + (size_t)e * 1024 + col; l.g = SGATE[row]; l.b0 = *(const float4*)bp; l.b1 = *(const float4*)(bp + 4); }
    __device__ __forceinline__ void store8(int row, int col, const float (&v)[8], int e, const Ld& l) const {
        const float g = l.g; const float4 b0 = l.b0, b1 = l.b1;
        uint4 w; w.x = pk2((v[0] + b0.x) * g, (v[1] + b0.y) * g); w.y = pk2((v[2] + b0.z) * g, (v[3] + b0.w) * g); w.z = pk2((v[4] + b1.x) * g, (v[5] + b1.y) * g); w.w = pk2((v[6] + b1.z) * g, (v[7] + b1.w) * g);
        *(uint4*)(YS + (size_t)row * 1024 + col) = w;
    }
};


namespace pg8 {
typedef short bf16x8 __attribute__((ext_vector_type(8)));
typedef float f32x4 __attribute__((ext_vector_type(4)));
constexpr int BM = 256, BK = 64, HALF = 128, HTB = HALF * BK * 2, NXCD = 8, WGM = 8;
__host__ __device__ __forceinline__ int lds_byte(int r, int c) { const int st = (r >> 4) * 2 + (c >> 5), rr = r & 15, cc = c & 31, ob = rr * 64 + cc * 2; return st * 1024 + (ob ^ (((ob >> 9) & 1) << 5)); }
__host__ __device__ __forceinline__ void stage_rc(int b, int& R, int& C) { const int st = b / 1024, sb = b % 1024, swz = sb ^ (((sb >> 9) & 1) << 5); R = (st >> 1) * 16 + swz / 64; C = (st & 1) * 32 + (swz % 64) / 2; }
__host__ __device__ __forceinline__ int perm32(int rho) { const int n = rho >> 4, i = rho & 15; return 8 * (i >> 2) + 4 * n + (i & 3); }
struct Unit { const char* a; const char* b; const int* rowmap; int row0, col0, aux; };
__device__ __forceinline__ void tile_order(int L, int nM, int nN, int& pm, int& pn) {
    const int nwg = nM * nN; int wgid = L; { const int q = nwg / NXCD, r = nwg % NXCD, xcd = wgid % NXCD, off = wgid / NXCD; wgid = (xcd < r ? xcd * (q + 1) : r * (q + 1) + (xcd - r) * q) + off; }
    const int nig = WGM * nN, gid = wgid / nig, fm = gid * WGM, gsz = (nM - fm) < WGM ? (nM - fm) : WGM;
    pm = fm + ((wgid % nig) % gsz); pn = (wgid % nig) / gsz;
}
template <class Epi>
__device__ __forceinline__ void epi_apply(const Epi& E, const f32x4 (&acc)[2][2][4][2], const Unit& u, int wr, int wc, int fr, int fq) {
    constexpr int MB = Epi::MB;
#pragma unroll
    for (int ai = 0; ai < 2; ++ai)
#pragma unroll
        for (int mp = 0; mp < 4 / MB; ++mp) {
            typename Epi::Ld ld[MB][2];
#pragma unroll
            for (int mm = 0; mm < MB; ++mm)
#pragma unroll
                for (int bj = 0; bj < 2; ++bj) E.load(ld[mm][bj], u.row0 + ai * HALF + wr * 64 + (mp * MB + mm) * 16 + fr, u.col0 + bj * HALF + wc * 32 + 8 * fq, u.aux);
#pragma unroll
            for (int mm = 0; mm < MB; ++mm)
#pragma unroll
                for (int bj = 0; bj < 2; ++bj) {
                    const int m = mp * MB + mm;
                    const f32x4 x0 = acc[ai][bj][m][0], x1 = acc[ai][bj][m][1];
                    const float v[8] = {x0[0], x0[1], x0[2], x0[3], x1[0], x1[1], x1[2], x1[3]};
                    E.store8(u.row0 + ai * HALF + wr * 64 + m * 16 + fr, u.col0 + bj * HALF + wc * 32 + 8 * fq, v, u.aux, ld[mm][bj]);
                }
            asm volatile("" ::: "memory");
        }
}
template <bool GATHER, class Epi, class Sched>
__device__ __forceinline__ void gemm_phase_t(LAS unsigned char* lds, const int K_, const Sched& S, const Epi& E, const int tid) {
    int K = K_; asm volatile("" : "+s"(K));
    const int wid = __builtin_amdgcn_readfirstlane(tid >> 6), lane = tid & 63, wr = wid >> 2, wc = wid & 3, fr = lane & 15, fq = lane >> 4;
    const int nt = K / BK;
    unsigned voffA[2], voffB[2];
#pragma unroll
    for (int i = 0; i < 2; ++i) { int R, C; stage_rc(tid * 16 + i * 8192, R, C); const int Rb = (R & ~31) + perm32(R & 31);
        voffA[i] = (unsigned)(R * K + C) * 2u; voffB[i] = (unsigned)(Rb * K + C) * 2u; }
    const size_t kstep = (size_t)(BK * 2);
    const size_t hstep = (size_t)HALF * K * 2;
    const unsigned ldsw = (unsigned)wid * 1024u;
    const int aoff = lds_byte(wr * 64 + fr, fq * 8), boff = lds_byte(wc * 32 + fr, fq * 8);
#define PG8_SA(b, h) (((b) * 2 + (h)) * HTB)
#define PG8_SB(b, h) ((4 + (b) * 2 + (h)) * HTB)
#define PG8_STAGE(bufoff, gbase, voff) do { _Pragma("unroll") for (int _i = 0; _i < 2; ++_i) \
        __builtin_amdgcn_global_load_lds((const unsigned*)((const char*)(gbase) + (voff)[_i]), (LAS unsigned*)(lds + (bufoff) + ldsw + _i * 8192), 16, 0, 0); } while (0)
#define PG8_LDA(dst, b, h) do { _Pragma("unroll") for (int m = 0; m < 4; ++m) _Pragma("unroll") for (int k = 0; k < 2; ++k) dst[m][k] = *(const LAS bf16x8*)(lds + PG8_SA(b, h) + aoff + m * 2048 + k * 1024); } while (0)
#define PG8_LDB(dst, b, h) do { _Pragma("unroll") for (int n = 0; n < 2; ++n) _Pragma("unroll") for (int k = 0; k < 2; ++k) dst[n][k] = *(const LAS bf16x8*)(lds + PG8_SB(b, h) + boff + n * 2048 + k * 1024); } while (0)
#define PG8_MMA(ai, bj, At, Bt) do { __builtin_amdgcn_s_setprio(1); _Pragma("unroll") for (int m = 0; m < 4; ++m) _Pragma("unroll") for (int n = 0; n < 2; ++n) _Pragma("unroll") for (int k = 0; k < 2; ++k) \
        acc[ai][bj][m][n] = __builtin_amdgcn_mfma_f32_16x16x32_bf16(Bt[n][k], At[m][k], acc[ai][bj][m][n], 0, 0, 0); __builtin_amdgcn_s_setprio(0); } while (0)
#define PG8_WAIT_V(n) asm volatile("s_waitcnt vmcnt(" #n ")" ::: "memory")
#define PG8_WAIT_L(n) asm volatile("s_waitcnt lgkmcnt(" #n ")" ::: "memory")
#define PG8_BAR __builtin_amdgcn_s_barrier()
#define PG8_SCHED __builtin_amdgcn_sched_barrier(0)
    Unit cur, nxt; int ui = 0;
    if (!S.next(0, cur)) return;
    f32x4 acc[2][2][4][2];
#pragma unroll
    for (int a = 0; a < 2; ++a)
#pragma unroll
        for (int b = 0; b < 2; ++b)
#pragma unroll
            for (int m = 0; m < 4; ++m)
#pragma unroll
                for (int n = 0; n < 2; ++n) acc[a][b][m][n] = (f32x4){0.f, 0.f, 0.f, 0.f};
    bf16x8 At[4][2], B0[2][2], B1[2][2];
    const char* cA = cur.a; const char* cB = cur.b;
    unsigned oc_lo[2] = {0u, 0u}, oc_hi[2] = {0u, 0u}, on_lo[2] = {0u, 0u}, on_hi[2] = {0u, 0u};
#define PG8_ROWOFF(U, LO, HI) do { _Pragma("unroll") for (int _i = 0; _i < 2; ++_i) { int R_, C_; stage_rc(tid * 16 + _i * 8192, R_, C_); \
        LO[_i] = (unsigned)((U).rowmap[R_] * K + C_) * 2u; HI[_i] = (unsigned)((U).rowmap[R_ + 128] * K + C_) * 2u; } } while (0)
    if constexpr (GATHER) PG8_ROWOFF(cur, oc_lo, oc_hi);
    PG8_STAGE(PG8_SB(0, 0), cB, voffB);
    if constexpr (GATHER) PG8_STAGE(PG8_SA(0, 0), cA, oc_lo); else PG8_STAGE(PG8_SA(0, 0), cA, voffA);
    PG8_STAGE(PG8_SB(0, 1), cB + hstep, voffB);
    if constexpr (GATHER) PG8_STAGE(PG8_SA(0, 1), cA, oc_hi); else PG8_STAGE(PG8_SA(0, 1), cA + hstep, voffA);
    if (wr == 1) PG8_BAR;
    PG8_WAIT_V(4); PG8_BAR;
    PG8_STAGE(PG8_SB(1, 0), cB + kstep, voffB);
    if constexpr (GATHER) PG8_STAGE(PG8_SA(1, 0), cA + kstep, oc_lo); else PG8_STAGE(PG8_SA(1, 0), cA + kstep, voffA);
    PG8_STAGE(PG8_SB(1, 1), cB + hstep + kstep, voffB);
    PG8_WAIT_V(6); PG8_BAR;
    for (;;) {
        const bool has_next = S.next(ui + 1, nxt);
        const char* nA = has_next ? nxt.a : cA; const char* nB = has_next ? nxt.b : cB;
        if constexpr (GATHER) { if (has_next) PG8_ROWOFF(nxt, on_lo, on_hi); else { on_lo[0] = oc_lo[0]; on_lo[1] = oc_lo[1]; on_hi[0] = oc_hi[0]; on_hi[1] = oc_hi[1]; } }
#pragma unroll 1
        for (int t = 0; t < nt; t += 2) {
            const bool last = (t == nt - 2);
            const char* a1 = cA + (size_t)(t + 1) * kstep;
            const char* a2 = last ? nA : cA + (size_t)(t + 2) * kstep; const char* b2 = last ? nB : cB + (size_t)(t + 2) * kstep;
            const char* a3 = a2 + kstep; const char* b3 = b2 + kstep;
            unsigned o2lo[2], o2hi[2];
            o2lo[0] = last ? on_lo[0] : oc_lo[0]; o2lo[1] = last ? on_lo[1] : oc_lo[1]; o2hi[0] = last ? on_hi[0] : oc_hi[0]; o2hi[1] = last ? on_hi[1] : oc_hi[1];
            PG8_LDB(B0, 0, 0); PG8_SCHED; PG8_LDA(At, 0, 0); if constexpr (GATHER) PG8_STAGE(PG8_SA(1, 1), a1, oc_hi); else PG8_STAGE(PG8_SA(1, 1), a1 + hstep, voffA);
            PG8_WAIT_L(8); PG8_BAR; PG8_WAIT_L(0); PG8_MMA(0, 0, At, B0); PG8_BAR; PG8_SCHED;
            PG8_LDB(B1, 0, 1); PG8_STAGE(PG8_SB(0, 0), b2, voffB);
            PG8_BAR; PG8_WAIT_L(0); PG8_MMA(0, 1, At, B1); PG8_BAR;
            PG8_LDA(At, 0, 1); if constexpr (GATHER) PG8_STAGE(PG8_SA(0, 0), a2, o2lo); else PG8_STAGE(PG8_SA(0, 0), a2, voffA);
            PG8_BAR; PG8_WAIT_L(0); PG8_MMA(1, 0, At, B0); PG8_BAR; PG8_SCHED;
            PG8_STAGE(PG8_SB(0, 1), b2 + hstep, voffB);
            PG8_WAIT_V(6); PG8_BAR; PG8_MMA(1, 1, At, B1); PG8_BAR;
            PG8_LDB(B0, 1, 0); PG8_SCHED; PG8_LDA(At, 1, 0); if constexpr (GATHER) PG8_STAGE(PG8_SA(0, 1), a2, o2hi); else PG8_STAGE(PG8_SA(0, 1), a2 + hstep, voffA);
            PG8_WAIT_L(8); PG8_BAR; PG8_WAIT_L(0); PG8_MMA(0, 0, At, B0); PG8_BAR; PG8_SCHED;
            PG8_LDB(B1, 1, 1); PG8_STAGE(PG8_SB(1, 0), b3, voffB);
            PG8_BAR; PG8_WAIT_L(0); PG8_MMA(0, 1, At, B1); PG8_BAR;
            PG8_LDA(At, 1, 1); if constexpr (GATHER) PG8_STAGE(PG8_SA(1, 0), a3, o2lo); else PG8_STAGE(PG8_SA(1, 0), a3, voffA);
            PG8_BAR; PG8_WAIT_L(0); PG8_MMA(1, 0, At, B0); PG8_BAR; PG8_SCHED;
            PG8_STAGE(PG8_SB(1, 1), b3 + hstep, voffB);
            PG8_WAIT_V(6); PG8_BAR; PG8_MMA(1, 1, At, B1); PG8_BAR;
        }
        epi_apply(E, acc, cur, wr, wc, fr, fq);
        if (!has_next) break;
#pragma unroll
        for (int a = 0; a < 2; ++a)
#pragma unroll
            for (int b = 0; b < 2; ++b)
#pragma unroll
                for (int m = 0; m < 4; ++m)
#pragma unroll
                    for (int n = 0; n < 2; ++n) acc[a][b][m][n] = (f32x4){0.f, 0.f, 0.f, 0.f};
        cur = nxt; cA = nA; cB = nB; ++ui;
        if constexpr (GATHER) { oc_lo[0] = on_lo[0]; oc_lo[1] = on_lo[1]; oc_hi[0] = on_hi[0]; oc_hi[1] = on_hi[1]; }
    }
    PG8_WAIT_V(0);
    if (wr == 0) PG8_BAR;
    PG8_BAR;
#undef PG8_ROWOFF
#undef PG8_SA
#undef PG8_SB
#undef PG8_STAGE
#undef PG8_LDA
#undef PG8_LDB
#undef PG8_MMA
#undef PG8_WAIT_V
#undef PG8_WAIT_L
#undef PG8_BAR
#undef PG8_SCHED
}
template <class Epi, class Sched>
__device__ __forceinline__ void gemm_phase(LAS unsigned char* lds, const int K, const Sched& S, const Epi& E, const int tid) { gemm_phase_t<false>(lds, K, S, E, tid); }
}

struct SchedInProj { const char* A; const char* Bt; int G, c;
    __device__ __forceinline__ bool next(int i, pg8::Unit& u) const { const int L = i * G + c; if (L >= 64 * 37) return false; int pm, pn; pg8::tile_order(L, 64, 37, pm, pn);
        u.a = A + (size_t)pm * (256 * 1024 * 2); u.b = Bt + (size_t)pn * (256 * 1024 * 2); u.row0 = pm * 256; u.col0 = pn * 256; u.aux = 0; u.rowmap = nullptr; return true; } };

struct WJob { const float* src; int ld_src; int K; int ncols; bf16* dst; int ld_dst; int nb; size_t sstride, dstride; };
__device__ __forceinline__ void wconv_job(const Ctx& c, const WJob& j) {
    float* tl = (float*)c.lds;
    const int ntk = j.K >> 6, ntn = j.ncols >> 6, per = ntk * ntn, ntiles = per * j.nb;
    const int rk = c.tid >> 3, rseg = (c.tid & 7) * 8;
    int tile = blockIdx.x;
    float4 a = make_float4(0.f, 0.f, 0.f, 0.f), b = a;
    if (tile < ntiles) { const int bi = tile / per, tt = tile % per, tk = tt % ntk, tn = tt / ntk;
        const float* sp = j.src + (size_t)bi * j.sstride + (size_t)(tk * 64 + rk) * j.ld_src + tn * 64 + rseg; a = *(const float4*)sp; b = *(const float4*)(sp + 4); }
    for (; tile < ntiles; tile += gridDim.x) {
        const int bi = tile / per, tt = tile % per, tk = tt % ntk, tn = tt / ntk;
        const float4 ca = a, cb = b;
        const int nxt = tile + gridDim.x;
        if (nxt < ntiles) { const int bi2 = nxt / per, tt2 = nxt % per, tk2 = tt2 % ntk, tn2 = tt2 / ntk;
            const float* sp = j.src + (size_t)bi2 * j.sstride + (size_t)(tk2 * 64 + rk) * j.ld_src + tn2 * 64 + rseg; a = *(const float4*)sp; b = *(const float4*)(sp + 4); }
        asm volatile("s_waitcnt lgkmcnt(0)" ::: "memory"); __builtin_amdgcn_s_barrier(); asm volatile("" ::: "memory");
        float* row = tl + rk * 65 + rseg;
        row[0] = ca.x; row[1] = ca.y; row[2] = ca.z; row[3] = ca.w; row[4] = cb.x; row[5] = cb.y; row[6] = cb.z; row[7] = cb.w;
        asm volatile("s_waitcnt lgkmcnt(0)" ::: "memory"); __builtin_amdgcn_s_barrier(); asm volatile("" ::: "memory");
        const float* col = tl + rseg * 65 + rk;
        uint4 w; w.x = pk2(col[0], col[65]); w.y = pk2(col[130], col[195]); w.z = pk2(col[260], col[325]); w.w = pk2(col[390], col[455]);
        *(uint4*)(j.dst + (size_t)bi * j.dstride + (size_t)(tn * 64 + rk) * j.ld_dst + tk * 64 + rseg) = w;
    }
}
struct SchedG2 { const char* YA; const char* Bt; int G, c;
    __device__ __forceinline__ bool next(int i, pg8::Unit& u) const { const int L = (i >> 1) * G + c, ab = i & 1; if (L >= 64 * 4) return false; int pm, pn; pg8::tile_order(L, 64, 4, pm, pn);
        u.a = YA + (size_t)ab * (WS_YB - WS_YA) + (size_t)pm * (256 * 1024 * 2); u.b = Bt + (size_t)(ab * 4 + pn) * (256 * 1024 * 2); u.row0 = pm * 256; u.col0 = ab * 1024 + pn * 256; u.aux = 0; u.rowmap = nullptr; return true; } };
struct SchedX1 { const char* A; const char* Bt; int G, c;
    __device__ __forceinline__ bool next(int i, pg8::Unit& u) const { const int L = i * G + c; if (L >= 64 * 4) return false; int pm, pn; pg8::tile_order(L, 64, 4, pm, pn);
        u.a = A + (size_t)pm * (256 * 1024 * 2); u.b = Bt + (size_t)pn * (256 * 1024 * 2); u.row0 = pm * 256; u.col0 = pn * 256; u.aux = 0; u.rowmap = nullptr; return true; } };
struct SchedMoe { const char* A; const char* Bt; const int* TILE_E; const int* SLOT_TOK; int NT, NPN, G, c;
    __device__ __forceinline__ bool next(int i, pg8::Unit& u) const { const int L = i * G + c; if (L >= NT * NPN) return false; int tile, pn; pg8::tile_order(L, NT, NPN, tile, pn);
        const int e = TILE_E[tile];
        u.a = SLOT_TOK ? A : A + (size_t)tile * (256 * 1024 * 2); u.rowmap = SLOT_TOK ? SLOT_TOK + tile * 256 : nullptr;
        u.b = Bt + (size_t)(e * NPN + pn) * (256 * 1024 * 2); u.row0 = tile * 256; u.col0 = pn * 256; u.aux = e; return true; } };

struct EpiLora {
    typedef NoLd Ld; static constexpr int MB = 1;
    const float* w0; const float* a0; float* LW; float* AA; bf16* GGR;
    __device__ __forceinline__ void load(Ld&, int, int, int) const {}
    __device__ __forceinline__ void store8(int row, int col, const float (&v)[8], int, const Ld&) const {
        const float* bp = col < 1024 ? w0 + col : a0 + ((col - 1024) & 1023);
        const float4 b0 = *(const float4*)bp, b1 = *(const float4*)(bp + 4);
        const float bb[8] = {b0.x, b0.y, b0.z, b0.w, b1.x, b1.y, b1.z, b1.w};
        if (col < 1024) { float o[8];
#pragma unroll
            for (int i = 0; i < 8; ++i) o[i] = -0.6065306597126334f * fsigm(bb[i] + v[i]);
            float* p = LW + (size_t)row * 1024 + col; *(float4*)p = make_float4(o[0], o[1], o[2], o[3]); *(float4*)(p + 4) = make_float4(o[4], o[5], o[6], o[7]); }
        else if (col < 2048) { const int cc = col - 1024; float o[8];
#pragma unroll
            for (int i = 0; i < 8; ++i) o[i] = fsigm(bb[i] + v[i]);
            float* p = AA + (size_t)row * 1024 + cc; *(float4*)p = make_float4(o[0], o[1], o[2], o[3]); *(float4*)(p + 4) = make_float4(o[4], o[5], o[6], o[7]); }
        else { uint4 w; w.x = pk2(v[0], v[1]); w.y = pk2(v[2], v[3]); w.z = pk2(v[4], v[5]); w.w = pk2(v[6], v[7]); *(uint4*)(GGR + (size_t)row * 1024 + (col - 2048)) = w; }
    }
};
struct SchedLora { const char* A; const char* Bt; int G, c;
    __device__ __forceinline__ bool next(int i, pg8::Unit& u) const { const int L = i * G + c; if (L >= 64 * 12) return false; int pm, pn; pg8::tile_order(L, 64, 12, pm, pn);
        u.a = A + (size_t)pm * (256 * 256 * 2); u.b = Bt + (size_t)pn * (256 * 256 * 2); u.row0 = pm * 256; u.col0 = pn * 256; u.aux = 0; u.rowmap = nullptr; return true; } };
__device__ __forceinline__ void lora_zero(const Ctx& c) {
    uint4* LT = c.ws<uint4>(WS_LORA_T);
    for (size_t idx = c.gtid; idx < (size_t)3072 * 32; idx += c.nthreads) {
        const int row = (int)(idx >> 5), k8 = (int)(idx & 31) * 8;
        const bool data = row < 1024 ? (k8 < 64) : (row < 2048 ? (k8 >= 64 && k8 < 128) : (k8 >= 128));
        if (!data) LT[idx] = make_uint4(0, 0, 0, 0);
    }
}

__device__ __forceinline__ void ph_loraprep(const Ctx& c) {
    const float* LIN = c.ws<float>(WS_LIN); bf16* AL = c.ws<bf16>(WS_ALORA); const float* mu = c.P.in[I_MU];
    for (size_t idx = c.gtid; idx < (size_t)T * 256; idx += c.nthreads) {
        const int t = (int)(idx >> 8), cc = (int)(idx & 255);
        const float x = LIN[idx], xp = (t & (SEQ - 1)) ? LIN[idx - 256] : 0.f;
        const float xs = x + (xp - x) * mu[3072 + cc];
        const float r = cc < 64 ? tanhf(xs) : (cc < 128 ? xs : sigm(xs));
        AL[idx] = f2bf(r);
    }
}
__device__ __forceinline__ void ph_post(const Ctx& c) {
    const bf16* OG = c.ws<bf16>(WS_OG); const bf16* ORW = c.ws<bf16>(WS_ORW); const bf16* ZS = c.ws<bf16>(WS_ZS); const bf16* VP = c.ws<bf16>(WS_VP); const bf16* GGR = c.ws<bf16>(WS_GGR);
    const float* SC = c.ws<float>(WS_SC); bf16* YA = c.ws<bf16>(WS_YA); bf16* YB = c.ws<bf16>(WS_YB);
    const float* gnw = c.P.in[I_GDN_NORM]; const float* lnw = c.P.in[I_LNW]; const float* lnb = c.P.in[I_LNB];
    const int lane = c.lane, c0 = lane * 16;
    for (int t = c.gwave; t < T; t += c.nwaves) {
        {
            float o[16];
#pragma unroll
            for (int q = 0; q < 2; ++q) { const uint4 v = *(const uint4*)(OG + (size_t)t * 1024 + c0 + 8 * q); o[8 * q] = bflo(v.x); o[8 * q + 1] = bfhi(v.x); o[8 * q + 2] = bflo(v.y); o[8 * q + 3] = bfhi(v.y); o[8 * q + 4] = bflo(v.z); o[8 * q + 5] = bfhi(v.z); o[8 * q + 6] = bflo(v.w); o[8 * q + 7] = bfhi(v.w); }
            float ss = 0.f;
#pragma unroll
            for (int j = 0; j < 16; ++j) ss += o[j] * o[j];
            ss += __shfl_xor(ss, 1); ss += __shfl_xor(ss, 2); ss += __shfl_xor(ss, 4);
            const float rstd = rsqrtf(ss * (1.f / 128.f) + 1e-6f);
            const uint4 z0 = *(const uint4*)(ZS + (size_t)t * 1024 + c0), z1 = *(const uint4*)(ZS + (size_t)t * 1024 + c0 + 8);
            const unsigned zz[8] = {z0.x, z0.y, z0.z, z0.w, z1.x, z1.y, z1.z, z1.w};
            unsigned w[8];
#pragma unroll
            for (int j = 0; j < 8; ++j) { const int cc = (c0 + 2 * j) & 127; w[j] = pk2(o[2 * j] * rstd * gnw[cc] * bflo(zz[j]), o[2 * j + 1] * rstd * gnw[cc + 1] * bfhi(zz[j])); }
            *(uint4*)(YA + (size_t)t * 1024 + c0) = make_uint4(w[0], w[1], w[2], w[3]); *(uint4*)(YA + (size_t)t * 1024 + c0 + 8) = make_uint4(w[4], w[5], w[6], w[7]);
        }
        {
            float o[16];
#pragma unroll
            for (int q = 0; q < 2; ++q) { const uint4 v = *(const uint4*)(ORW + (size_t)t * 1024 + c0 + 8 * q); o[8 * q] = bflo(v.x); o[8 * q + 1] = bfhi(v.x); o[8 * q + 2] = bflo(v.y); o[8 * q + 3] = bfhi(v.y); o[8 * q + 4] = bflo(v.z); o[8 * q + 5] = bfhi(v.z); o[8 * q + 6] = bflo(v.w); o[8 * q + 7] = bfhi(v.w); }
            float sm = 0.f;
#pragma unroll
            for (int j = 0; j < 16; ++j) sm += o[j];
            sm += __shfl_xor(sm, 1); sm += __shfl_xor(sm, 2);
            const float mean = sm * (1.f / 64.f);
            float sv = 0.f;
#pragma unroll
            for (int j = 0; j < 16; ++j) { const float dd = o[j] - mean; sv += dd * dd; }
            sv += __shfl_xor(sv, 1); sv += __shfl_xor(sv, 2);
            const float rstd = rsqrtf(sv * (1.f / 64.f) + 64e-5f);
            const float sc = SC[t * 16 + (c0 >> 6)];
            const uint4 v0 = *(const uint4*)(VP + (size_t)t * 1024 + c0), v1 = *(const uint4*)(VP + (size_t)t * 1024 + c0 + 8);
            const uint4 g0 = *(const uint4*)(GGR + (size_t)t * 1024 + c0), g1 = *(const uint4*)(GGR + (size_t)t * 1024 + c0 + 8);
            const unsigned vv[8] = {v0.x, v0.y, v0.z, v0.w, v1.x, v1.y, v1.z, v1.w};
            const unsigned gg[8] = {g0.x, g0.y, g0.z, g0.w, g1.x, g1.y, g1.z, g1.w};
            unsigned w[8];
#pragma unroll
            for (int j = 0; j < 8; ++j) { const int cc = c0 + 2 * j;
                const float y0 = ((o[2 * j] - mean) * rstd * lnw[cc] + lnb[cc] + sc * bflo(vv[j])) * bflo(gg[j]);
                const float y1 = ((o[2 * j + 1] - mean) * rstd * lnw[cc + 1] + lnb[cc + 1] + sc * bfhi(vv[j])) * bfhi(gg[j]);
                w[j] = pk2(y0, y1); }
            *(uint4*)(YB + (size_t)t * 1024 + c0) = make_uint4(w[0], w[1], w[2], w[3]); *(uint4*)(YB + (size_t)t * 1024 + c0 + 8) = make_uint4(w[4], w[5], w[6], w[7]);
        }
    }
}

__device__ __forceinline__ void ph_router(const Ctx& c) {
    const float* X1 = c.ws<float>(WS_X1); const float* nw = c.P.in[I_NORM_FFN]; const float* rw = c.P.in[I_ROUTER_W]; const float* rb = c.P.in[I_ROUTER_B];
    bf16* H2 = c.ws<bf16>(WS_H2); int* TE = c.ws<int>(WS_TE); float* TG = c.ws<float>(WS_TG); int* TP = c.ws<int>(WS_TP); unsigned* CNT = c.ws<unsigned>(WS_CTL) + CW_CNT;
    const int lane = c.lane;
    float4* tab = (float4*)c.lds;
    unsigned* lcnt = (unsigned*)(c.lds + 147456);
    __syncthreads();
    if (c.tid < 32) lcnt[c.tid] = 0u;
    for (int i = c.tid; i < 8192; i += NTHREADS) { const int k = i >> 3; tab[((k & 3) * 256 + (k >> 2)) * 9 + (i & 7)] = ((const float4*)rw)[i]; }
    __syncthreads();
    for (int t = c.gwave; t < T; t += c.nwaves) {
        float4 v[4]; float ss = 0.f;
#pragma unroll
        for (int i = 0; i < 4; ++i) { v[i] = ((const float4*)(X1 + (size_t)t * D))[lane + 64 * i]; ss += v[i].x * v[i].x + v[i].y * v[i].y + v[i].z * v[i].z + v[i].w * v[i].w; }
        ss = wsum(ss);
        const float rstd = rsqrtf(ss * (1.f / 1024.f) + 1e-6f);
        float lg[32];
#pragma unroll
        for (int j = 0; j < 32; ++j) lg[j] = 0.f;
#pragma unroll
        for (int i = 0; i < 4; ++i) {
            const float4 w4 = ((const float4*)nw)[lane + 64 * i];
            const float h[4] = {v[i].x * rstd * w4.x, v[i].y * rstd * w4.y, v[i].z * rstd * w4.z, v[i].w * rstd * w4.w};
            uint2 st; st.x = pk2(h[0], h[1]); st.y = pk2(h[2], h[3]);
            *(uint2*)(H2 + (size_t)t * D + 4 * (lane + 64 * i)) = st;
#pragma unroll
            for (int ii = 0; ii < 4; ++ii) {
                const float4* wr = tab + (size_t)(ii * 256 + lane + 64 * i) * 9;
#pragma unroll
                for (int q = 0; q < 8; ++q) { const float4 w = wr[q]; lg[4 * q] += h[ii] * w.x; lg[4 * q + 1] += h[ii] * w.y; lg[4 * q + 2] += h[ii] * w.z; lg[4 * q + 3] += h[ii] * w.w; }
                asm volatile("" ::: "memory");
            }
        }
#pragma unroll
        for (int j = 0; j < 32; ++j) lg[j] = wsum(lg[j]) + rb[j];
        int e0 = 0, e1 = 0, e2 = 0, e3 = 0; float v0 = -3e38f, v1 = -3e38f, v2 = -3e38f, v3 = -3e38f;
#pragma unroll
        for (int j = 0; j < 32; ++j) if (lg[j] > v0) { v0 = lg[j]; e0 = j; }
#pragma unroll
        for (int j = 0; j < 32; ++j) if (j != e0 && lg[j] > v1) { v1 = lg[j]; e1 = j; }
#pragma unroll
        for (int j = 0; j < 32; ++j) if (j != e0 && j != e1 && lg[j] > v2) { v2 = lg[j]; e2 = j; }
#pragma unroll
        for (int j = 0; j < 32; ++j) if (j != e0 && j != e1 && j != e2 && lg[j] > v3) { v3 = lg[j]; e3 = j; }
        const float x1 = expf(v1 - v0), x2 = expf(v2 - v0), x3 = expf(v3 - v0), inv = 1.f / (1.f + x1 + x2 + x3);
        if (lane < 4) {
            const int me = lane == 0 ? e0 : (lane == 1 ? e1 : (lane == 2 ? e2 : e3));
            const float mg = (lane == 0 ? 1.f : (lane == 1 ? x1 : (lane == 2 ? x2 : x3))) * inv;
            const unsigned pos = atomicAdd(&lcnt[me], 1u);
            TE[t * 4 + lane] = me; TG[t * 4 + lane] = mg; TP[t * 4 + lane] = (int)pos;
        }
    }
    __syncthreads();
    if (c.tid < 32) lcnt[32 + c.tid] = atomicAdd(&CNT[c.tid], lcnt[c.tid]);
    __syncthreads();
    if (lane < 4) for (int t = c.gwave; t < T; t += c.nwaves) TP[t * 4 + lane] += (int)lcnt[32 + TE[t * 4 + lane]];
    __syncthreads();
}

__device__ __forceinline__ void ph_dispatch(const Ctx& c) {
    int* tb = (int*)c.lds;
    const unsigned* CNT = c.ws<unsigned>(WS_CTL) + CW_CNT;
    int* TILE_E = c.ws<int>(WS_TILE_E); int* NT = c.ws<int>(WS_NT);
    const int* TE = c.ws<int>(WS_TE); const float* TG = c.ws<float>(WS_TG); const int* TP = c.ws<int>(WS_TP); int* TSLOT = c.ws<int>(WS_TSLOT);
    float* SGATE = c.ws<float>(WS_SGATE); const bf16* H2 = c.ws<bf16>(WS_H2); bf16* XB = c.ws<bf16>(WS_XB);
    if (c.tid == 0) { int acc = 0; for (int e = 0; e < NEXP; ++e) { const int n = (int)__hip_atomic_load(&CNT[e], __ATOMIC_RELAXED, __HIP_MEMORY_SCOPE_AGENT); tb[e] = acc; tb[64 + e] = n; acc += (n + 255) >> 8; } tb[32] = acc; }
    __syncthreads();
    if (blockIdx.x == 0) {
        for (int tile = c.tid; tile < tb[32]; tile += NTHREADS) { int e = 0; for (int q = 0; q < NEXP; ++q) if (tile >= tb[q]) e = q; TILE_E[tile] = e; }
        if (c.tid == 0) *NT = tb[32];
    }
    int* SLOT_TOK = c.ws<int>(WS_SLOT_TOK);
    for (size_t idx = c.gtid; idx < (size_t)T * 4; idx += c.nthreads) {
        const int t = (int)(idx >> 2), e = TE[idx], pos = TP[idx];
        const int slot = tb[e] * 256 + pos;
        TSLOT[idx] = slot; SGATE[slot] = TG[idx]; SLOT_TOK[slot] = t;
    }
    for (int e = 0; e < NEXP; ++e) {
        const int n = tb[64 + e], cap = (tb[e + 1] - tb[e]) * 256;
        for (int r = n + (int)c.gtid; r < cap; r += (int)c.nthreads) { const int slot = tb[e] * 256 + r; SLOT_TOK[slot] = 0; SGATE[slot] = 0.f; }
    }
}

__device__ __forceinline__ void ph_combine(const Ctx& c) {
    const float* X1 = c.ws<float>(WS_X1); const bf16* YS = c.ws<bf16>(WS_YS); const int* TSLOT = c.ws<int>(WS_TSLOT); const float* nw = c.P.in[I_NORM_FINAL]; float* out = c.P.out;
    const int lane = c.lane;
    for (int t = c.gwave; t < T; t += c.nwaves) {
        const int s0 = TSLOT[t * 4], s1 = TSLOT[t * 4 + 1], s2 = TSLOT[t * 4 + 2], s3 = TSLOT[t * 4 + 3];
        float4 v[4]; float ss = 0.f;
#pragma unroll
        for (int i = 0; i < 4; ++i) {
            const int col = 4 * (lane + 64 * i);
            v[i] = *(const float4*)(X1 + (size_t)t * D + col);
            const uint2 a = *(const uint2*)(YS + (size_t)s0 * 1024 + col), b = *(const uint2*)(YS + (size_t)s1 * 1024 + col), cc = *(const uint2*)(YS + (size_t)s2 * 1024 + col), d = *(const uint2*)(YS + (size_t)s3 * 1024 + col);
            v[i].x += bflo(a.x) + bflo(b.x) + bflo(cc.x) + bflo(d.x); v[i].y += bfhi(a.x) + bfhi(b.x) + bfhi(cc.x) + bfhi(d.x);
            v[i].z += bflo(a.y) + bflo(b.y) + bflo(cc.y) + bflo(d.y); v[i].w += bfhi(a.y) + bfhi(b.y) + bfhi(cc.y) + bfhi(d.y);
            ss += v[i].x * v[i].x + v[i].y * v[i].y + v[i].z * v[i].z + v[i].w * v[i].w;
        }
        ss = wsum(ss);
        const float rstd = rsqrtf(ss * (1.f / 1024.f) + 1e-6f);
#pragma unroll
        for (int i = 0; i < 4; ++i) { const float4 w4 = ((const float4*)nw)[lane + 64 * i];
            *(float4*)(out + (size_t)t * D + 4 * (lane + 64 * i)) = make_float4(v[i].x * rstd * w4.x, v[i].y * rstd * w4.y, v[i].z * rstd * w4.z, v[i].w * rstd * w4.w); }
    }
    if (TS_BEGIN >= 0 && blockIdx.x == 0 && c.tid == 0) { asm volatile("s_waitcnt vmcnt(0)" ::: "memory"); c.P.out[0] = (float)c.ws<unsigned>(WS_CTL)[CW_TS] * 0.01f; }
}


typedef short bf16x8_t __attribute__((ext_vector_type(8)));
typedef float f32x4_t __attribute__((ext_vector_type(4)));
#define MFMA16(a, b, c) __builtin_amdgcn_mfma_f32_16x16x32_bf16((a), (b), (c), 0, 0, 0)


__device__ __forceinline__ int frag_off(int row, int k, int KBn) { return (((row >> 4) * KBn + (k >> 5)) * 512) + (((k >> 3) & 3) * 128) + ((row & 15) * 8) + (k & 7); }
__device__ __forceinline__ int cfrag_off(int v, int r, int NRT) { return ((((v >> 4) * NRT + (r >> 4)) * 64 + ((r >> 2) & 3) * 16 + (v & 15)) * 4) + (r & 3); }

constexpr int GCL_HALF_BYTES = 71680;
__device__ __forceinline__ void ph_gcl(const Ctx& c) {
    const bf16* GQKV = c.ws<bf16>(WS_GQKV); const float* BETA = c.ws<float>(WS_BETA); const float* GGv = c.ws<float>(WS_GG); const float* cw = c.P.in[I_GDN_CONV];
    bf16* GA1 = c.ws<bf16>(WS_GA1); bf16* GX0 = c.ws<bf16>(WS_GX0); bf16* GA2 = c.ws<bf16>(WS_GA2); bf16* GA3 = c.ws<bf16>(WS_GA3); bf16* GA4 = c.ws<bf16>(WS_GA4); float* GGL = c.ws<float>(WS_GGL);
    for (int it0 = blockIdx.x * 2; it0 < 2048; it0 += gridDim.x * 2) {
        int tv = c.tid; asm volatile("" : "+v"(tv));
        const int half = tv >> 8, ht = tv & 255, lane = tv & 63, w4 = __builtin_amdgcn_readfirstlane((tv >> 6) & 3);
        unsigned char* base = c.lds + half * GCL_HALF_BYTES;
        bf16* QB = (bf16*)base;
        bf16* KB = QB + 64 * 136;
        bf16* VB = KB + 64 * 136;
        float* MM = (float*)(VB + 64 * 136);
        float* GC = MM + 64 * 64;
        float* BT = GC + 64;
        float* BE = BT + 64;
        const int item = it0 + half, n = item & 63, bh = item >> 6, h = bh & 7, b = bh >> 3;
        const int t0 = b * SEQ + n * 64;
        __syncthreads();
        if (w4 == 0) {
            float g = GGv[(size_t)(t0 + lane) * 8 + h]; const float be = BETA[(size_t)(t0 + lane) * 8 + h];
#pragma unroll
            for (int o = 1; o < 64; o <<= 1) { const float u = __shfl_up(g, o); if (lane >= o) g += u; }
            GC[lane] = g; BT[lane] = be; BE[lane] = be * __expf(g);
        }
        __syncthreads();
        {
            const int cg = ht & 15, rg = ht >> 4, r0 = rg * 4;
#pragma unroll
            for (int mat = 0; mat < 3; ++mat) {
                const int col0 = mat * 1024 + h * 128 + cg * 8;
                float4 xa[7], xb[7], wa[4], wb[4];
#pragma unroll
                for (int li = 0; li < 7; ++li) {
                    const bool valid = (n > 0) || (r0 - 3 + li >= 0);
                    uint4 xr = make_uint4(0, 0, 0, 0);
                    if (valid) xr = *(const uint4*)(GQKV + (size_t)(t0 + r0 - 3 + li) * 3072 + col0);
                    xa[li] = make_float4(bflo(xr.x), bfhi(xr.x), bflo(xr.y), bfhi(xr.y));
                    xb[li] = make_float4(bflo(xr.z), bfhi(xr.z), bflo(xr.w), bfhi(xr.w));
                }
#pragma unroll
                for (int j = 0; j < 4; ++j) { wa[j] = *(const float4*)(cw + j * 3072 + col0); wb[j] = *(const float4*)(cw + j * 3072 + col0 + 4); }
#pragma unroll
                for (int rr = 0; rr < 4; ++rr) {
                    float o[8] = {0.f, 0.f, 0.f, 0.f, 0.f, 0.f, 0.f, 0.f};
#pragma unroll
                    for (int j = 0; j < 4; ++j) { const float4 a = xa[rr + j], bq = xb[rr + j];
                        o[0] += wa[j].x * a.x; o[1] += wa[j].y * a.y; o[2] += wa[j].z * a.z; o[3] += wa[j].w * a.w;
                        o[4] += wb[j].x * bq.x; o[5] += wb[j].y * bq.y; o[6] += wb[j].z * bq.z; o[7] += wb[j].w * bq.w; }
                    float ss = 0.f;
#pragma unroll
                    for (int e = 0; e < 8; ++e) { o[e] *= fsigm(o[e]); ss += o[e] * o[e]; }
                    float sc = 1.f;
                    if (mat < 2) { ss += __shfl_xor(ss, 1); ss += __shfl_xor(ss, 2); ss += __shfl_xor(ss, 4); ss += __shfl_xor(ss, 8); sc = rsqrtf(ss + 1e-6f) * (mat == 0 ? 0.08838834764831845f : 1.f); }
                    const int r = r0 + rr;
                    uint4 w; w.x = pk2(o[0] * sc, o[1] * sc); w.y = pk2(o[2] * sc, o[3] * sc); w.z = pk2(o[4] * sc, o[5] * sc); w.w = pk2(o[6] * sc, o[7] * sc);
                    *(uint4*)((mat == 0 ? QB : (mat == 1 ? KB : VB)) + r * 136 + cg * 8) = w;
                    if (mat == 0) {
                        const float s2 = sc * __expf(GC[r]);
                        w.x = pk2(o[0] * s2, o[1] * s2); w.y = pk2(o[2] * s2, o[3] * s2); w.z = pk2(o[4] * s2, o[5] * s2); w.w = pk2(o[6] * s2, o[7] * s2);
                        *(uint4*)(GA2 + (size_t)item * 64 * 128 + frag_off(r, cg * 8, 4)) = w;
                    }
                }
            }
        }
        __syncthreads();
        {
            const int fr = lane & 15, fq = lane >> 4, a0 = w4 * 16;
            bf16x8_t ka[4];
#pragma unroll
            for (int kb = 0; kb < 4; ++kb) ka[kb] = *(const bf16x8_t*)(KB + (a0 + fr) * 136 + kb * 32 + fq * 8);
#pragma unroll
            for (int bt = 0; bt < 4; ++bt) {
                f32x4_t c1 = {0.f, 0.f, 0.f, 0.f}, c2 = {0.f, 0.f, 0.f, 0.f};
#pragma unroll
                for (int kb = 0; kb < 4; ++kb) {
                    const bf16x8_t kbf = *(const bf16x8_t*)(KB + (bt * 16 + fr) * 136 + kb * 32 + fq * 8);
                    const bf16x8_t qbf = *(const bf16x8_t*)(QB + (bt * 16 + fr) * 136 + kb * 32 + fq * 8);
                    c1 = MFMA16(ka[kb], kbf, c1); c2 = MFMA16(ka[kb], qbf, c2);
                }
                const int i = bt * 16 + fr, j0 = a0 + 4 * fq;
                const float gi = GC[i], bi = BT[i];
                float m[4], at[4];
#pragma unroll
                for (int rg = 0; rg < 4; ++rg) { const int j = j0 + rg; const float dec = __expf(fminf(gi - GC[j], 0.f));
                    m[rg] = (i > j) ? bi * c1[rg] * dec : 0.f; at[rg] = (i >= j) ? c2[rg] * dec : 0.f; }
                *(float4*)(MM + i * 64 + j0) = make_float4(m[0], m[1], m[2], m[3]);
                uint2 w; w.x = pk2(at[0], at[1]); w.y = pk2(at[2], at[3]);
                *(uint2*)(GA3 + (size_t)item * 64 * 64 + frag_off(i, j0, 2)) = w;
            }
        }
        __syncthreads();
        {
            const int cc = ht & 127; const bool isw = ht >= 128;
            const bf16* srcp = (isw ? KB : VB) + cc; const float* scl = isw ? BE : BT;
            float x[64];
#pragma unroll
            for (int i = 0; i < 64; ++i) x[i] = 0.f;
            float4 mc[16], mn[16];
#pragma unroll
            for (int q = 0; q < 16; ++q) { mc[q] = make_float4(0.f, 0.f, 0.f, 0.f); mn[q] = mc[q]; }
            float rhs_n = scl[0] * bf2f(srcp[0]);
#pragma unroll
            for (int i = 0; i < 64; ++i) {
                const float rhs = rhs_n;
                if (i + 1 < 64) {
#pragma unroll
                    for (int j4 = 0; j4 < (i + 4) / 4; ++j4) mn[j4] = *(const float4*)(MM + (i + 1) * 64 + 4 * j4);
                    rhs_n = scl[i + 1] * bf2f(srcp[(i + 1) * 136]);
                }
                float acc = rhs, ac1 = 0.f, ac2 = 0.f, ac3 = 0.f;
#pragma unroll
                for (int j4 = 0; j4 < (i + 3) / 4; ++j4) { acc -= mc[j4].x * x[4 * j4]; ac1 -= mc[j4].y * x[4 * j4 + 1]; ac2 -= mc[j4].z * x[4 * j4 + 2]; ac3 -= mc[j4].w * x[4 * j4 + 3]; }
                x[i] = (acc + ac1) + (ac2 + ac3);
#pragma unroll
                for (int j4 = 0; j4 < 16; ++j4) mc[j4] = mn[j4];
                asm volatile("" ::: "memory");
            }
            if (!isw) {
                bf16* up = GX0 + (size_t)item * 128 * 64;
#pragma unroll
                for (int q = 0; q < 16; ++q) { uint2 w; w.x = pk2(x[4 * q], x[4 * q + 1]); w.y = pk2(x[4 * q + 2], x[4 * q + 3]); *(uint2*)(up + cfrag_off(cc, 4 * q, 4)) = w; }
            }
            __syncthreads();
            if (isw) {
                bf16* a1s = (bf16*)MM;
#pragma unroll
                for (int i = 0; i < 64; ++i) a1s[i * 128 + cc] = f2bf(-x[i]);
            }
        }
        __syncthreads();
        {
            const bf16* a1s = (const bf16*)MM; bf16* wp = GA1 + (size_t)item * 64 * 128;
#pragma unroll
            for (int q = 0; q < 4; ++q) { const int p = ht + 256 * q, fr = p & 15, fq = (p >> 4) & 3, kb = (p >> 6) & 3, rt = p >> 8;
                *(uint4*)(wp + p * 8) = *(const uint4*)(a1s + (rt * 16 + fr) * 128 + kb * 32 + fq * 8); }
        }
        {
            const int dk = ht & 127, hh = ht >> 7; const float g63 = GC[63];
            unsigned w[16];
#pragma unroll
            for (int q = 0; q < 16; ++q) { const int ta = hh * 32 + 2 * q;
                w[q] = pk2(bf2f(KB[ta * 136 + dk]) * __expf(g63 - GC[ta]), bf2f(KB[(ta + 1) * 136 + dk]) * __expf(g63 - GC[ta + 1])); }
            bf16* dp = GA4 + (size_t)item * 128 * 64;
            *(uint4*)(dp + frag_off(dk, hh * 32, 2)) = make_uint4(w[0], w[1], w[2], w[3]); *(uint4*)(dp + frag_off(dk, hh * 32 + 8, 2)) = make_uint4(w[4], w[5], w[6], w[7]);
            *(uint4*)(dp + frag_off(dk, hh * 32 + 16, 2)) = make_uint4(w[8], w[9], w[10], w[11]); *(uint4*)(dp + frag_off(dk, hh * 32 + 24, 2)) = make_uint4(w[12], w[13], w[14], w[15]);
            if (ht == 0) GGL[item] = __expf(g63);
        }
    }
}

constexpr int RCL_HALF_BYTES = 75776;
__device__ __forceinline__ void ph_rcl(const Ctx& c) {
    const bf16* RKV = c.ws<bf16>(WS_RKV); const float* LW = c.ws<float>(WS_LW); const float* AAg = c.ws<float>(WS_AA);
    const float* mu = c.P.in[I_MU]; const float* k_k = c.P.in[I_KK]; const float* k_a = c.P.in[I_KA]; const float* r_k = c.P.in[I_RK];
    bf16* VP = c.ws<bf16>(WS_VP); float* SC = c.ws<float>(WS_SC);
    bf16* RA1 = c.ws<bf16>(WS_RA1); bf16* RX0 = c.ws<bf16>(WS_RX0); bf16* RA2 = c.ws<bf16>(WS_RA2); bf16* RA3 = c.ws<bf16>(WS_RA3); bf16* RO0 = c.ws<bf16>(WS_RO0);
    bf16* RA4 = c.ws<bf16>(WS_RA4); bf16* RS0 = c.ws<bf16>(WS_RS0); float* RDSC = c.ws<float>(WS_RDSC);
    unsigned long long ts_t0 = 0ull, ts_acc = 0ull;
#define TSMARK(k) do { if (TS_BEGIN >= 0 && blockIdx.x == 0 && c.tid == 0) { const unsigned long long now_ = __builtin_amdgcn_s_memrealtime(); \
        if ((k) == TS_END && ts_t0 != 0ull) ts_acc += now_ - ts_t0; if ((k) == TS_BEGIN) ts_t0 = now_; } } while (0)
    uint4 ur[2], uk[2], uv[2]; float4 a4v[4], l4v[4];
#define RCL_LOAD(ITEM, TID) do { const int it_ = (ITEM), ht_ = (TID) & 255, n_ = it_ & 63, bh_ = it_ >> 6, h_ = bh_ & 15, b_ = bh_ >> 4; \
        const int r_ = ht_ >> 2, c0_ = (ht_ & 3) * 16, t_ = b_ * SEQ + n_ * 64 + r_; \
        const bf16* cur_ = RKV + (size_t)t_ * 3072 + h_ * 64 + c0_; \
        _Pragma("unroll") for (int g = 0; g < 2; ++g) { ur[g] = *(const uint4*)(cur_ + 8 * g); uk[g] = *(const uint4*)(cur_ + 1024 + 8 * g); uv[g] = *(const uint4*)(cur_ + 2048 + 8 * g); } \
        _Pragma("unroll") for (int q = 0; q < 4; ++q) { l4v[q] = *(const float4*)(LW + (size_t)t_ * 1024 + h_ * 64 + c0_ + 4 * q); a4v[q] = *(const float4*)(AAg + (size_t)t_ * 1024 + h_ * 64 + c0_ + 4 * q); } \
    } while (0)
    if ((int)(blockIdx.x * 2) < 4096) RCL_LOAD(blockIdx.x * 2 + (c.tid >> 8), c.tid);
    for (int it0 = blockIdx.x * 2; it0 < 4096; it0 += gridDim.x * 2) {
        int tv = c.tid; asm volatile("" : "+v"(tv));
        const int half = tv >> 8, ht = tv & 255, lane = tv & 63, w4 = __builtin_amdgcn_readfirstlane((tv >> 6) & 3);
        unsigned char* base = c.lds + half * RCL_HALF_BYTES;
        bf16* AT = (bf16*)base;
        bf16* VT = AT + 64 * 72;
        bf16* KDT = VT + 64 * 72;
        float* AAB = (float*)(KDT + 64 * 72);
        float* TOT = AAB + 64 * 64;
        unsigned char* RX = (unsigned char*)(TOT + 256);
        bf16* RT = (bf16*)RX;
        bf16* BTL = RT + 64 * 72;
        bf16* KT = BTL + 64 * 72;
        bf16* AAK = (bf16*)RX;
        bf16* ARK = AAK + 64 * 72;
        float* RHS2 = (float*)RX;
        const int item = it0 + half, n = item & 63, bh = item >> 6, h = bh & 15, b = bh >> 4;
        const int t0 = b * SEQ + n * 64;
        __syncthreads();
        TSMARK(0);
        const int r = ht >> 2, seg = ht & 3, c0 = seg * 16, t = t0 + r; const bool first = (n == 0 && r == 0);
        float rr[16], kf[16], vv[16], kkv[16], aa[16], lwl[16], bdv[16];
        float ss = 0.f, scs = 0.f;
        {
            float4 mr[4], mk[4], mv[4], kkw[4], kaw[4], rkw[4];
            uint4 qr[2], qk[2], qv[2];
            {   const bf16* prv = RKV + (size_t)(t - 1) * 3072 + h * 64 + c0;
#pragma unroll
                for (int g = 0; g < 2; ++g) { qr[g] = make_uint4(0, 0, 0, 0); qk[g] = qr[g]; qv[g] = qr[g];
                    if (!first) { qr[g] = *(const uint4*)(prv + 8 * g); qk[g] = *(const uint4*)(prv + 1024 + 8 * g); qv[g] = *(const uint4*)(prv + 2048 + 8 * g); } } }
#pragma unroll
            for (int q = 0; q < 4; ++q) {
                mr[q] = *(const float4*)(mu + h * 64 + c0 + 4 * q); mk[q] = *(const float4*)(mu + 1024 + h * 64 + c0 + 4 * q); mv[q] = *(const float4*)(mu + 2048 + h * 64 + c0 + 4 * q);
                kkw[q] = *(const float4*)(k_k + h * 64 + c0 + 4 * q); kaw[q] = *(const float4*)(k_a + h * 64 + c0 + 4 * q); rkw[q] = *(const float4*)(r_k + h * 64 + c0 + 4 * q);
            }
#pragma unroll
            for (int q = 0; q < 4; ++q) *(float4*)(AAB + r * 64 + c0 + 4 * q) = l4v[q];
            __syncthreads();
            {
                const int ch = ht & 63, tq = ht >> 6;
                float run = 0.f;
#pragma unroll
                for (int i = 0; i < 16; ++i) { run += AAB[(tq * 16 + i) * 64 + ch]; AAB[(tq * 16 + i) * 64 + ch] = run; }
                TOT[tq * 64 + ch] = run;
            }
            __syncthreads();
            TSMARK(1);
#pragma unroll
            for (int q = 0; q < 4; ++q) {
                const int g = q >> 1; const bool hi = q & 1;
                const unsigned r_a = hi ? ur[g].z : ur[g].x, r_b = hi ? ur[g].w : ur[g].y, k_a_ = hi ? uk[g].z : uk[g].x, k_b_ = hi ? uk[g].w : uk[g].y, v_a = hi ? uv[g].z : uv[g].x, v_b = hi ? uv[g].w : uv[g].y;
                const unsigned pr_a = hi ? qr[g].z : qr[g].x, pr_b = hi ? qr[g].w : qr[g].y, pk_a = hi ? qk[g].z : qk[g].x, pk_b = hi ? qk[g].w : qk[g].y, pv_a = hi ? qv[g].z : qv[g].x, pv_b = hi ? qv[g].w : qv[g].y;
                const float r0a[4] = {bflo(r_a), bfhi(r_a), bflo(r_b), bfhi(r_b)}, k0a[4] = {bflo(k_a_), bfhi(k_a_), bflo(k_b_), bfhi(k_b_)}, v0a[4] = {bflo(v_a), bfhi(v_a), bflo(v_b), bfhi(v_b)};
                const float rpa[4] = {bflo(pr_a), bfhi(pr_a), bflo(pr_b), bfhi(pr_b)}, kpa[4] = {bflo(pk_a), bfhi(pk_a), bflo(pk_b), bfhi(pk_b)}, vpa[4] = {bflo(pv_a), bfhi(pv_a), bflo(pv_b), bfhi(pv_b)};
                const float mra[4] = {mr[q].x, mr[q].y, mr[q].z, mr[q].w}, mka[4] = {mk[q].x, mk[q].y, mk[q].z, mk[q].w}, mva[4] = {mv[q].x, mv[q].y, mv[q].z, mv[q].w};
                const float kka[4] = {kkw[q].x, kkw[q].y, kkw[q].z, kkw[q].w}, kaa[4] = {kaw[q].x, kaw[q].y, kaw[q].z, kaw[q].w}, rka[4] = {rkw[q].x, rkw[q].y, rkw[q].z, rkw[q].w};
                const float aaa[4] = {a4v[q].x, a4v[q].y, a4v[q].z, a4v[q].w}, lwa[4] = {l4v[q].x, l4v[q].y, l4v[q].z, l4v[q].w};
#pragma unroll
                for (int e = 0; e < 4; ++e) { const int i = 4 * q + e;
                    rr[i] = r0a[e] + (rpa[e] - r0a[e]) * mra[e]; const float kx = k0a[e] + (kpa[e] - k0a[e]) * mka[e]; vv[i] = v0a[e] + (vpa[e] - v0a[e]) * mva[e];
                    kkv[i] = kx * kka[e]; ss += kkv[i] * kkv[i]; aa[i] = aaa[e]; lwl[i] = lwa[e]; kf[i] = kx * (1.f + (aaa[e] - 1.f) * kaa[e]); scs += rr[i] * kf[i] * rka[e]; }
            }
        }
        {
            ss += __shfl_xor(ss, 1); ss += __shfl_xor(ss, 2); scs += __shfl_xor(scs, 1); scs += __shfl_xor(scs, 2);
            const float rn = rsqrtf(ss + 1e-6f);
            if (seg == 0) SC[(size_t)t * 16 + h] = scs;
            const int tq = r >> 4;
            unsigned wat[8], wbt[8], wkt[8], wrt[8], wvp[8];
            float atv[16], btv[16], ktv[16], rtv[16];
#pragma unroll
            for (int i = 0; i < 16; ++i) {
                const int ch = c0 + i;
                float off = 0.f;
#pragma unroll
                for (int q = 0; q < 3; ++q) off += (q < tq) ? TOT[q * 64 + ch] : 0.f;
                const float tot = TOT[ch] + TOT[64 + ch] + TOT[128 + ch] + TOT[192 + ch];
                const float cs = AAB[r * 64 + ch] + off;
                const float lwv = lwl[i];
                const float kk = kkv[i] * rn;
                const float e2 = __expf(-cs), e4 = __expf(tot - cs);
                atv[i] = kk * __expf(cs - lwv); btv[i] = -kk * aa[i] * e2; ktv[i] = kf[i] * e2; rtv[i] = rr[i] * __expf(cs);
                VT[ch * 72 + r] = f2bf(vv[i]);
                KDT[ch * 72 + r] = f2bf(kf[i] * e4);
                bdv[i] = -kk * aa[i] * e4;
                if (r == 63) RDSC[(size_t)item * 64 + ch] = __expf(tot);
            }
#pragma unroll
            for (int q = 0; q < 8; ++q) { wat[q] = pk2(atv[2 * q], atv[2 * q + 1]); wbt[q] = pk2(btv[2 * q], btv[2 * q + 1]); wkt[q] = pk2(ktv[2 * q], ktv[2 * q + 1]); wrt[q] = pk2(rtv[2 * q], rtv[2 * q + 1]); wvp[q] = pk2(vv[2 * q], vv[2 * q + 1]); }
            *(uint4*)(AT + r * 72 + c0) = make_uint4(wat[0], wat[1], wat[2], wat[3]); *(uint4*)(AT + r * 72 + c0 + 8) = make_uint4(wat[4], wat[5], wat[6], wat[7]);
            *(uint4*)(BTL + r * 72 + c0) = make_uint4(wbt[0], wbt[1], wbt[2], wbt[3]); *(uint4*)(BTL + r * 72 + c0 + 8) = make_uint4(wbt[4], wbt[5], wbt[6], wbt[7]);
            *(uint4*)(KT + r * 72 + c0) = make_uint4(wkt[0], wkt[1], wkt[2], wkt[3]); *(uint4*)(KT + r * 72 + c0 + 8) = make_uint4(wkt[4], wkt[5], wkt[6], wkt[7]);
            *(uint4*)(RT + r * 72 + c0) = make_uint4(wrt[0], wrt[1], wrt[2], wrt[3]); *(uint4*)(RT + r * 72 + c0 + 8) = make_uint4(wrt[4], wrt[5], wrt[6], wrt[7]);
            bf16* a2p = RA2 + (size_t)item * 64 * 64;
            *(uint4*)(a2p + frag_off(r, c0, 2)) = make_uint4(wrt[0], wrt[1], wrt[2], wrt[3]); *(uint4*)(a2p + frag_off(r, c0 + 8, 2)) = make_uint4(wrt[4], wrt[5], wrt[6], wrt[7]);
            bf16* vpp = VP + (size_t)t * 1024 + h * 64 + c0;
            *(uint4*)vpp = make_uint4(wvp[0], wvp[1], wvp[2], wvp[3]); *(uint4*)(vpp + 8) = make_uint4(wvp[4], wvp[5], wvp[6], wvp[7]);
        }
        __syncthreads();
        TSMARK(2);
        if (it0 + (int)gridDim.x * 2 < 4096) RCL_LOAD(item + (int)gridDim.x * 2, tv);
        {
            bf16* BDS = (bf16*)AAB;
#pragma unroll
            for (int i = 0; i < 16; ++i) BDS[(c0 + i) * 72 + r] = f2bf(bdv[i]);
        }
        const int fr = lane & 15, fq = lane >> 4;
        f32x4_t cab[4], cak[4], crb[4], crk[4];
        {
            const int j0t = w4 * 16;
            bf16x8_t bj[2], kj[2];
#pragma unroll
            for (int kb = 0; kb < 2; ++kb) { bj[kb] = *(const bf16x8_t*)(BTL + (j0t + fr) * 72 + kb * 32 + fq * 8); kj[kb] = *(const bf16x8_t*)(KT + (j0t + fr) * 72 + kb * 32 + fq * 8); }
#pragma unroll
            for (int it = 0; it < 4; ++it) {
                cab[it] = (f32x4_t){0.f, 0.f, 0.f, 0.f}; cak[it] = cab[it]; crb[it] = cab[it]; crk[it] = cab[it];
#pragma unroll
                for (int kb = 0; kb < 2; ++kb) {
                    const bf16x8_t ai = *(const bf16x8_t*)(AT + (it * 16 + fr) * 72 + kb * 32 + fq * 8);
                    const bf16x8_t ri = *(const bf16x8_t*)(RT + (it * 16 + fr) * 72 + kb * 32 + fq * 8);
                    cab[it] = MFMA16(bj[kb], ai, cab[it]); cak[it] = MFMA16(kj[kb], ai, cak[it]); crb[it] = MFMA16(bj[kb], ri, crb[it]); crk[it] = MFMA16(kj[kb], ri, crk[it]);
                }
            }
        }
        __syncthreads();
        {
            const bf16* BDS = (const bf16*)AAB; bf16* bp = RA4 + (size_t)item * 64 * 64;
#pragma unroll
            for (int q = 0; q < 2; ++q) { const int p = ht + 256 * q, pfr = p & 15, pfq = (p >> 4) & 3, pkb = (p >> 6) & 1, prt = p >> 7;
                *(uint4*)(bp + p * 8) = *(const uint4*)(BDS + (prt * 16 + pfr) * 72 + pkb * 32 + pfq * 8); }
        }
        __syncthreads();
        {
            const int j0 = w4 * 16 + 4 * fq;
#pragma unroll
            for (int it = 0; it < 4; ++it) {
                const int i = it * 16 + fr;
                float vab[4], vak[4], vrb[4], vrk[4];
#pragma unroll
                for (int rg = 0; rg < 4; ++rg) { const int j = j0 + rg; const bool st = i > j, in = i >= j;
                    vab[rg] = st ? cab[it][rg] : 0.f; vak[rg] = st ? cak[it][rg] : 0.f; vrb[rg] = in ? crb[it][rg] : 0.f; vrk[rg] = in ? crk[it][rg] : 0.f; }
                *(float4*)(AAB + i * 64 + j0) = make_float4(vab[0], vab[1], vab[2], vab[3]);
                uint2 w; w.x = pk2(vak[0], vak[1]); w.y = pk2(vak[2], vak[3]); *(uint2*)(AAK + i * 72 + j0) = w;
                w.x = pk2(vrk[0], vrk[1]); w.y = pk2(vrk[2], vrk[3]); *(uint2*)(ARK + i * 72 + j0) = w;
                w.x = pk2(vrb[0], vrb[1]); w.y = pk2(vrb[2], vrb[3]); *(uint2*)(RA3 + (size_t)item * 64 * 64 + frag_off(i, j0, 2)) = w;
            }
        }
        __syncthreads();
        f32x4_t cav[4], cov[4], ckv[4];
        {
            const int r0t = w4 * 16;
            bf16x8_t fa[2], fo[2], fk[2];
#pragma unroll
            for (int kb = 0; kb < 2; ++kb) { fa[kb] = *(const bf16x8_t*)(AAK + (r0t + fr) * 72 + kb * 32 + fq * 8); fo[kb] = *(const bf16x8_t*)(ARK + (r0t + fr) * 72 + kb * 32 + fq * 8); fk[kb] = *(const bf16x8_t*)(KDT + (r0t + fr) * 72 + kb * 32 + fq * 8); }
#pragma unroll
            for (int vt = 0; vt < 4; ++vt) {
                cav[vt] = (f32x4_t){0.f, 0.f, 0.f, 0.f}; cov[vt] = cav[vt]; ckv[vt] = cav[vt];
#pragma unroll
                for (int kb = 0; kb < 2; ++kb) { const bf16x8_t vb = *(const bf16x8_t*)(VT + (vt * 16 + fr) * 72 + kb * 32 + fq * 8);
                    cav[vt] = MFMA16(fa[kb], vb, cav[vt]); cov[vt] = MFMA16(fo[kb], vb, cov[vt]); ckv[vt] = MFMA16(fk[kb], vb, ckv[vt]); }
            }
        }
        __syncthreads();
        {
            const int r0 = w4 * 16 + 4 * fq;
#pragma unroll
            for (int vt = 0; vt < 4; ++vt) {
                const int v = vt * 16 + fr;
#pragma unroll
                for (int rg = 0; rg < 4; ++rg) RHS2[v * 65 + r0 + rg] = cav[vt][rg];
                { uint2 w; w.x = pk2(cov[vt][0], cov[vt][1]); w.y = pk2(cov[vt][2], cov[vt][3]); *(uint2*)(RO0 + (size_t)item * 64 * 64 + cfrag_off(v, r0, 4)) = w; }
                { uint2 w; w.x = pk2(ckv[vt][0], ckv[vt][1]); w.y = pk2(ckv[vt][2], ckv[vt][3]); *(uint2*)(RS0 + (size_t)item * 64 * 64 + cfrag_off(v, r0, 4)) = w; }
            }
        }
        __syncthreads();
        TSMARK(3);
        {
            const int col = ht >> 1, p = ht & 1, cc = col & 63; const bool isu = col >= 64;
            float xs[32];
#pragma unroll
            for (int i = 0; i < 32; ++i) xs[i] = 0.f;
            float4 mc[8], mn[8];
#pragma unroll
            for (int q = 0; q < 8; ++q) { mc[q] = make_float4(0.f, 0.f, 0.f, 0.f); mn[q] = mc[q]; }
            float rhs_n; { const float rv = RHS2[(isu ? cc : 0) * 65], av = bf2f(AT[(isu ? 0 : cc)]); rhs_n = isu ? rv : av; }
#pragma unroll
            for (int i = 0; i < 64; ++i) {
                const float rhs = rhs_n;
                if (i + 1 < 64) {
#pragma unroll
                    for (int q = 0; q < (i + 8) / 8; ++q) mn[q] = *(const float4*)(AAB + (i + 1) * 64 + 8 * q + 4 * p);
                    const float rv = RHS2[(isu ? cc : 0) * 65 + i + 1], av = bf2f(AT[(i + 1) * 72 + (isu ? 0 : cc)]); rhs_n = isu ? rv : av;
                }
                float a0 = 0.f, a1 = 0.f, a2 = 0.f, a3 = 0.f;
#pragma unroll
                for (int q = 0; q < (i + 7) / 8; ++q) { a0 += mc[q].x * xs[4 * q]; a1 += mc[q].y * xs[4 * q + 1]; a2 += mc[q].z * xs[4 * q + 2]; a3 += mc[q].w * xs[4 * q + 3]; }
                float tot = (a0 + a1) + (a2 + a3);
                tot += dpp_xor1(tot);
                const float xi = rhs + tot;
                const int g = i >> 2, slot = (g >> 1) * 4 + (i & 3);
                xs[slot] = (p == (g & 1)) ? xi : xs[slot];
#pragma unroll
                for (int q = 0; q < 8; ++q) mc[q] = mn[q];
                asm volatile("" ::: "memory");
            }
            if (isu) {
                bf16* up = RX0 + (size_t)item * 64 * 64;
#pragma unroll
                for (int q = 0; q < 8; ++q) { uint2 w; w.x = pk2(xs[4 * q], xs[4 * q + 1]); w.y = pk2(xs[4 * q + 2], xs[4 * q + 3]); *(uint2*)(up + cfrag_off(cc, 4 * (2 * q + p), 4)) = w; }
            }
            __syncthreads();
            TSMARK(4);
            if (!isu) {
#pragma unroll
                for (int q = 0; q < 8; ++q)
#pragma unroll
                    for (int e = 0; e < 4; ++e) AT[(4 * (2 * q + p) + e) * 72 + cc] = f2bf(xs[4 * q + e]);
            }
        }
        __syncthreads();
        {
            bf16* wp = RA1 + (size_t)item * 64 * 64;
#pragma unroll
            for (int q = 0; q < 2; ++q) { const int p = ht + 256 * q, fr = p & 15, fq = (p >> 4) & 3, kb = (p >> 6) & 1, rt = p >> 7;
                *(uint4*)(wp + p * 8) = *(const uint4*)(AT + (rt * 16 + fr) * 72 + kb * 32 + fq * 8); }
        }
    }
    if (TS_BEGIN >= 0 && blockIdx.x == 0 && c.tid == 0) c.ws<unsigned>(WS_CTL)[CW_TS] = (unsigned)ts_acc;
#undef TSMARK
#undef RCL_LOAD
}

template <int DK, bool RW>
struct ScanArgs { const bf16* A1; const bf16* X0; const bf16* A2; const bf16* A3; const bf16* O0; const bf16* A4; const bf16* S0; const float* DSC; bf16* OUT; int item0; int vs; int tok0; int ocol0; };
#define LBAR() do { asm volatile("s_waitcnt lgkmcnt(0)" ::: "memory"); __builtin_amdgcn_s_barrier(); asm volatile("" ::: "memory"); } while (0)
template <int DK, bool RW>
__device__ __forceinline__ void scan_run(const Ctx& c, const ScanArgs<DK, RW>& a) {
    constexpr int KB = DK / 32;
    constexpr int NST = DK / 64;
    constexpr int NV = RW ? 64 : 128;
    constexpr int SROW = DK + 8;
    bf16* ST = (bf16*)c.lds;
    bf16* XT = ST + 2 * 32 * SROW;
    const int lane = c.lane, w = c.wave, fr = lane & 15, fq = lane >> 4;
    const int tm = w >> 1, tn = w & 1;
    const int dkt = (NST == 2) ? w : (w >> 1);
    for (int i = c.tid; i < 32 * SROW / 2; i += NTHREADS) ((unsigned*)ST)[i] = 0u;
    f32x4_t accS[NST];
#pragma unroll
    for (int s = 0; s < NST; ++s) accS[s] = (f32x4_t){0.f, 0.f, 0.f, 0.f};
    bf16x8_t a1f[KB], a2f[KB], a3f[2], a4f[2]; f32x4_t x0v, o0v, s0v[NST], dscv;
#define SCAN_LOAD(IT) do { const size_t it_ = (size_t)(IT); \
        _Pragma("unroll") for (int kb = 0; kb < KB; ++kb) { a1f[kb] = *(const bf16x8_t*)(a.A1 + it_ * 64 * DK + ((tm * KB + kb) * 64 + lane) * 8); a2f[kb] = *(const bf16x8_t*)(a.A2 + it_ * 64 * DK + ((tm * KB + kb) * 64 + lane) * 8); } \
        _Pragma("unroll") for (int kb = 0; kb < 2; ++kb) { a3f[kb] = *(const bf16x8_t*)(a.A3 + it_ * 64 * 64 + ((tm * 2 + kb) * 64 + lane) * 8); a4f[kb] = *(const bf16x8_t*)(a.A4 + it_ * DK * 64 + ((dkt * 2 + kb) * 64 + lane) * 8); } \
        { const uint2 q_ = *(const uint2*)(a.X0 + it_ * NV * 64 + (((a.vs * 2 + tn) * 4 + tm) * 64 + lane) * 4); x0v = (f32x4_t){bflo(q_.x), bfhi(q_.x), bflo(q_.y), bfhi(q_.y)}; } \
        if (RW) { { const uint2 q_ = *(const uint2*)(a.O0 + it_ * NV * 64 + (((a.vs * 2 + tn) * 4 + tm) * 64 + lane) * 4); o0v = (f32x4_t){bflo(q_.x), bfhi(q_.x), bflo(q_.y), bfhi(q_.y)}; } \
                  _Pragma("unroll") for (int s = 0; s < NST; ++s) { const uint2 q_ = *(const uint2*)(a.S0 + it_ * 64 * DK + (((a.vs * 2 + (NST == 2 ? s : tn)) * (DK / 16) + dkt) * 64 + lane) * 4); s0v[s] = (f32x4_t){bflo(q_.x), bfhi(q_.x), bflo(q_.y), bfhi(q_.y)}; } \
                  dscv = *(const f32x4_t*)(a.DSC + it_ * DK + dkt * 16 + 4 * fq); } \
        else { const float g_ = a.DSC[it_]; dscv = (f32x4_t){g_, g_, g_, g_}; o0v = (f32x4_t){0.f, 0.f, 0.f, 0.f}; _Pragma("unroll") for (int s = 0; s < NST; ++s) s0v[s] = (f32x4_t){0.f, 0.f, 0.f, 0.f}; } \
    } while (0)
    SCAN_LOAD(a.item0);
    int cur = 0;
    for (int n = 0; n < 64; ++n) {
        bf16x8_t b1[KB], b2[KB], b3[2], b4[2];
#pragma unroll
        for (int kb = 0; kb < KB; ++kb) { b1[kb] = a1f[kb]; b2[kb] = a2f[kb]; }
        b3[0] = a3f[0]; b3[1] = a3f[1]; b4[0] = a4f[0]; b4[1] = a4f[1];
        f32x4_t accX = x0v, accO = o0v; const f32x4_t dv = dscv; f32x4_t sv[NST];
#pragma unroll
        for (int s = 0; s < NST; ++s) sv[s] = s0v[s];
        if (n + 1 < 64) SCAN_LOAD(a.item0 + n + 1);
        LBAR();
        const bf16* Sc = ST + cur * 32 * SROW; bf16* Sn = ST + (cur ^ 1) * 32 * SROW;
        bf16x8_t sf[KB];
#pragma unroll
        for (int kb = 0; kb < KB; ++kb) sf[kb] = *(const bf16x8_t*)(Sc + (tn * 16 + fr) * SROW + kb * 32 + fq * 8);
#pragma unroll
        for (int kb = 0; kb < KB; ++kb) accX = MFMA16(b1[kb], sf[kb], accX);
        { uint2 wv; wv.x = pk2(accX[0], accX[1]); wv.y = pk2(accX[2], accX[3]); *(uint2*)(XT + (tn * 16 + fr) * 72 + tm * 16 + 4 * fq) = wv; }
#pragma unroll
        for (int kb = 0; kb < KB; ++kb) accO = MFMA16(b2[kb], sf[kb], accO);
        LBAR();
        bf16x8_t xf[2];
#pragma unroll
        for (int kb = 0; kb < 2; ++kb) xf[kb] = *(const bf16x8_t*)(XT + (tn * 16 + fr) * 72 + kb * 32 + fq * 8);
        accO = MFMA16(b3[0], xf[0], accO); accO = MFMA16(b3[1], xf[1], accO);
        {
            bf16* op = a.OUT + (size_t)(a.tok0 + n * 64 + tm * 16 + 4 * fq) * 1024 + a.ocol0 + tn * 16 + fr;
            op[0] = f2bf(accO[0]); op[1024] = f2bf(accO[1]); op[2048] = f2bf(accO[2]); op[3072] = f2bf(accO[3]);
        }
#pragma unroll
        for (int s = 0; s < NST; ++s) {
            const int vt = (NST == 2) ? s : tn;
            bf16x8_t xg[2];
            if (vt == tn) { xg[0] = xf[0]; xg[1] = xf[1]; }
            else {
#pragma unroll
                for (int kb = 0; kb < 2; ++kb) xg[kb] = *(const bf16x8_t*)(XT + (vt * 16 + fr) * 72 + kb * 32 + fq * 8);
            }
            f32x4_t t = accS[s] * dv + sv[s];
            t = MFMA16(b4[0], xg[0], t); t = MFMA16(b4[1], xg[1], t);
            accS[s] = t;
            uint2 wv; wv.x = pk2(t[0], t[1]); wv.y = pk2(t[2], t[3]);
            *(uint2*)(Sn + (vt * 16 + fr) * SROW + dkt * 16 + 4 * fq) = wv;
        }
        cur ^= 1;
    }
#undef SCAN_LOAD
    __syncthreads();
}

__device__ __forceinline__ void ph_scan(const Ctx& c) {
    for (int wk = blockIdx.x; wk < 256; wk += gridDim.x) {
        const int xcd = wk & 7, j = wk >> 3;
        if (j < 16) {
            const int pair = xcd * 4 + (j >> 2), vs = j & 3, b = pair >> 3, h = pair & 7;
            ScanArgs<128, false> a{c.ws<bf16>(WS_GA1), c.ws<bf16>(WS_GX0), c.ws<bf16>(WS_GA2), c.ws<bf16>(WS_GA3), nullptr, c.ws<bf16>(WS_GA4), nullptr, c.ws<float>(WS_GGL),
                                   c.ws<bf16>(WS_OG), pair * 64, vs, b * SEQ, h * 128 + vs * 32};
            scan_run<128, false>(c, a);
        } else {
            const int pair = xcd * 8 + ((j - 16) >> 1), vs = (j - 16) & 1, b = pair >> 4, h = pair & 15;
            ScanArgs<64, true> a{c.ws<bf16>(WS_RA1), c.ws<bf16>(WS_RX0), c.ws<bf16>(WS_RA2), c.ws<bf16>(WS_RA3), c.ws<bf16>(WS_RO0), c.ws<bf16>(WS_RA4), c.ws<bf16>(WS_RS0), c.ws<float>(WS_RDSC),
                                 c.ws<bf16>(WS_ORW), pair * 64, vs, b * SEQ, h * 64 + vs * 32};
            scan_run<64, true>(c, a);
        }
    }
}

enum { PH_RMS0 = 0, PH_INPROJ, PH_GCL, PH_LORA, PH_RCL, PH_SCAN, PH_POST, PH_G2, PH_X1, PH_ROUTER, PH_DISPATCH, PH_MOE1, PH_MOE2, PH_COMBINE, PH_COUNT };

template <unsigned PHMASK>
__global__ void __launch_bounds__(NTHREADS) mk(Params P) {
    extern __shared__ __attribute__((aligned(16))) unsigned char lds[];
    volatile LAS unsigned* misc = (volatile LAS unsigned*)((LAS unsigned char*)lds + MISC_OFF);
    if (threadIdx.x < 64) misc[threadIdx.x] = 0u;
    __syncthreads();
    unsigned* ctl = (unsigned*)(P.ws + WS_CTL);
    XcdBarrier bar = xcd_barrier_post(ctl + CW_BAR + P.li * XCD_BAR_WORDS, misc);
#define MKCTX() int tv_ = threadIdx.x; asm volatile("" : "+v"(tv_)); const int wv_ = __builtin_amdgcn_readfirstlane(tv_ >> 6); \
    Ctx c{P, tv_, tv_ & 63, wv_, (int)(blockIdx.x * NWAVES + wv_), (int)(gridDim.x * NWAVES), (size_t)blockIdx.x * NTHREADS + tv_, (size_t)gridDim.x * NTHREADS, lds}
    bool first_seam = true;
#define IN(k) (((PHMASK >> (k)) & 1u) && P.ph_lo <= (k) && (k) < P.ph_hi)
#define SEAM(k) do { if ((k) + 1 < P.ph_hi) { xcd_barrier(bar); first_seam = false; } } while (0)
#define REP(k) for (int rep_ = 0; rep_ < ((k) == PROBE_REP ? 2 : 1); ++rep_)
    if (IN(PH_RMS0)) { MKCTX();
        REP(PH_RMS0) {
        ph_rms0(c);
        { WJob j{P.in[I_W_IN], NCOL_IN, 1024, 4096, c.ws<bf16>(WS_WIN_T), 1024, 1, 0, 0}; wconv_job(c, j); }
        { WJob j{P.in[I_W_IN] + 4112, NCOL_IN, 1024, 5376, c.ws<bf16>(WS_WIN_T) + (size_t)4096 * 1024, 1024, 1, 0, 0}; wconv_job(c, j); }
        lora_zero(c);
        { WJob j{P.in[I_W2], 1024, 64, 1024, c.ws<bf16>(WS_LORA_T), 256, 1, 0, 0}; wconv_job(c, j); }
        { WJob j{P.in[I_A2], 1024, 64, 1024, c.ws<bf16>(WS_LORA_T) + (size_t)1024 * 256 + 64, 256, 1, 0, 0}; wconv_job(c, j); }
        { WJob j{P.in[I_G2], 1024, 128, 1024, c.ws<bf16>(WS_LORA_T) + (size_t)2048 * 256 + 128, 256, 1, 0, 0}; wconv_job(c, j); }
        }
        SEAM(PH_RMS0);
    }
    if (IN(PH_INPROJ)) { MKCTX();
        REP(PH_INPROJ) {
        EpiInProj ep{c.ws<bf16>(WS_GQKV), c.ws<bf16>(WS_ZS), c.ws<bf16>(WS_RKV), c.ws<float>(WS_LIN), c.ws<bf16>(WS_GATES)};
        SchedInProj sc{(const char*)c.ws<bf16>(WS_HB), (const char*)c.ws<bf16>(WS_WIN_T), (int)gridDim.x, (int)blockIdx.x};
        pg8::gemm_phase((LAS unsigned char*)lds, 1024, sc, ep, c.tid);
        }
        SEAM(PH_INPROJ);
    }
    if (IN(PH_GCL)) { MKCTX(); REP(PH_GCL) { ph_gcl(c); ph_loraprep(c); } SEAM(PH_GCL); }
    if (IN(PH_LORA)) { MKCTX();
        REP(PH_LORA) {
        EpiLora ep{P.in[I_W0], P.in[I_A0], c.ws<float>(WS_LW), c.ws<float>(WS_AA), c.ws<bf16>(WS_GGR)};
        SchedLora sc{(const char*)c.ws<bf16>(WS_ALORA), (const char*)c.ws<bf16>(WS_LORA_T), (int)gridDim.x, (int)blockIdx.x};
        pg8::gemm_phase((LAS unsigned char*)lds, 256, sc, ep, c.tid);
        }
        SEAM(PH_LORA);
    }
    if (IN(PH_RCL)) { MKCTX(); REP(PH_RCL) { ph_rcl(c); } SEAM(PH_RCL); }
    if (IN(PH_SCAN)) { MKCTX(); REP(PH_SCAN) { ph_scan(c); } SEAM(PH_SCAN); }
    if (IN(PH_POST)) { MKCTX();
        REP(PH_POST) {
        ph_post(c);
        { WJob j{P.in[I_PROJ_A], 1024, 1024, 1024, c.ws<bf16>(WS_PROJ_T), 1024, 1, 0, 0}; wconv_job(c, j); }
        { WJob j{P.in[I_PROJ_B], 1024, 1024, 1024, c.ws<bf16>(WS_PROJ_T) + (size_t)1024 * 1024, 1024, 1, 0, 0}; wconv_job(c, j); }
        { WJob j{P.in[I_W_OUT], 1024, 1024, 1024, c.ws<bf16>(WS_WOUT_T), 1024, 1, 0, 0}; wconv_job(c, j); }
        }
        SEAM(PH_POST);
    }
    if (IN(PH_G2)) { MKCTX();
        REP(PH_G2) {
        EpiG2 ep{c.ws<bf16>(WS_GATES), c.ws<bf16>(WS_G2)};
        SchedG2 sc{(const char*)c.ws<bf16>(WS_YA), (const char*)c.ws<bf16>(WS_PROJ_T), (int)gridDim.x, (int)blockIdx.x};
        pg8::gemm_phase((LAS unsigned char*)lds, 1024, sc, ep, c.tid);
        }
        SEAM(PH_G2);
    }
    if (IN(PH_X1)) { MKCTX();
        REP(PH_X1) {
        EpiX1 ep{P.in[I_X], c.ws<float>(WS_X1)};
        SchedX1 sc{(const char*)c.ws<bf16>(WS_G2), (const char*)c.ws<bf16>(WS_WOUT_T), (int)gridDim.x, (int)blockIdx.x};
        pg8::gemm_phase((LAS unsigned char*)lds, 1024, sc, ep, c.tid);
        }
        SEAM(PH_X1);
    }
    if (IN(PH_ROUTER)) { MKCTX();
        ph_router(c);
        REP(PH_ROUTER) {
        { WJob j{P.in[I_W_GU], 2048, 1024, 2048, c.ws<bf16>(WS_WGU_T), 1024, 32, (size_t)1024 * 2048, (size_t)2048 * 1024}; wconv_job(c, j); }
        { WJob j{P.in[I_W_DOWN], 1024, 1024, 1024, c.ws<bf16>(WS_WDN_T), 1024, 32, (size_t)1024 * 1024, (size_t)1024 * 1024}; wconv_job(c, j); }
        }
        SEAM(PH_ROUTER);
    }
    if (IN(PH_DISPATCH)) { MKCTX(); REP(PH_DISPATCH) { ph_dispatch(c); } SEAM(PH_DISPATCH); }
    if (IN(PH_MOE1)) { MKCTX();
        REP(PH_MOE1) {
        const int nt = *c.ws<int>(WS_NT);
        EpiAct ep{P.in[I_B_GU], c.ws<bf16>(WS_ACT)};
        SchedMoe sc{(const char*)c.ws<bf16>(WS_H2), (const char*)c.ws<bf16>(WS_WGU_T), c.ws<int>(WS_TILE_E), c.ws<int>(WS_SLOT_TOK), nt, 8, (int)gridDim.x, (int)blockIdx.x};
        pg8::gemm_phase_t<true>((LAS unsigned char*)lds, 1024, sc, ep, c.tid);
        }
        SEAM(PH_MOE1);
    }
    if (IN(PH_MOE2)) { MKCTX();
        REP(PH_MOE2) {
        const int nt = *c.ws<int>(WS_NT);
        EpiYS ep{P.in[I_B_DOWN], c.ws<float>(WS_SGATE), c.ws<bf16>(WS_YS)};
        SchedMoe sc{(const char*)c.ws<bf16>(WS_ACT), (const char*)c.ws<bf16>(WS_WDN_T), c.ws<int>(WS_TILE_E), nullptr, nt, 4, (int)gridDim.x, (int)blockIdx.x};
        pg8::gemm_phase((LAS unsigned char*)lds, 1024, sc, ep, c.tid);
        }
        SEAM(PH_MOE2);
    }
    if (IN(PH_COMBINE)) { MKCTX(); REP(PH_COMBINE) { ph_combine(c); } }
#undef IN
#undef SEAM
#undef REP
#undef MKCTX
}

template <unsigned M> static void launch_one(const Params& p, int grid, hipStream_t stream) {
    static bool attr = false;
    if (!attr) { (void)hipFuncSetAttribute((const void*)mk<M>, hipFuncAttributeMaxDynamicSharedMemorySize, LDS_BYTES); attr = true; }
    hipLaunchKernelGGL(mk<M>, dim3(grid), dim3(NTHREADS), LDS_BYTES, stream, p);
}
template <int PH> static void launch_chain(Params& p, int grid, hipStream_t stream) {
    if constexpr (PH < PH_COUNT) { p.ph_lo = PH; p.ph_hi = PH + 1; p.li = 0; p.coop = 0; launch_one<(1u << PH)>(p, grid, stream); launch_chain<PH + 1>(p, grid, stream); }
}

extern "C" void kernel_launch(void* const* d_in, const int* in_sizes, int n_in, void* d_out, int out_size, void* d_ws, size_t ws_size, hipStream_t stream) {
    static int grid = 0;
    if (grid == 0) {
        int dev = 0, cus = 0, per_cu = 0;
        (void)hipGetDevice(&dev);
        (void)hipDeviceGetAttribute(&cus, hipDeviceAttributeMultiprocessorCount, dev);
#if MK_ONE_LAUNCH
        (void)hipFuncSetAttribute((const void*)mk<0xffffffffu>, hipFuncAttributeMaxDynamicSharedMemorySize, LDS_BYTES);
        (void)hipOccupancyMaxActiveBlocksPerMultiprocessor(&per_cu, (const void*)mk<0xffffffffu>, NTHREADS, LDS_BYTES);
#else
        per_cu = 1;
#endif
        if (n_in != 29 || ws_size < WS_END || per_cu < 1 || cus < 64) { fprintf(stderr, "kernel_launch: unexpected setup n_in %d ws %zu per_cu %d cus %d\n", n_in, ws_size, per_cu, cus); grid = -1; return; }
        grid = cus;
    }
    if (grid < 0) return;
    (void)hipMemsetAsync((char*)d_ws + WS_CTL, 0, CTL_BYTES, stream);
    Params p{};
    for (int i = 0; i < 29; ++i) p.in[i] = (const float*)d_in[i];
    p.out = (float*)d_out; p.ws = (unsigned char*)d_ws;
#if MK_ONE_LAUNCH
    p.ph_lo = 0; p.ph_hi = PH_COUNT; p.li = 0; p.coop = 1;
    void* args[] = {&p};
    hipError_t e = hipLaunchCooperativeKernel((const void*)mk<0xffffffffu>, dim3(grid), dim3(NTHREADS), args, LDS_BYTES, stream);
    if (e != hipSuccess) fprintf(stderr, "cooperative launch failed: %s (grid %d)\n", hipGetErrorString(e), grid);
#else
    launch_chain<0>(p, grid, stream);
#endif
}
```

```cpp
#include <hip/hip_runtime.h>
#include <hip/hip_cooperative_groups.h>
#include <cstdint>
#include <cstdio>
namespace cg = cooperative_groups;

#ifndef MK_ONE_LAUNCH
#define MK_ONE_LAUNCH 1
#endif

#define LAS __attribute__((address_space(3)))
#ifndef FAST_INPROJ
#define FAST_INPROJ 1
#endif
#ifndef FAST_MIX
#define FAST_MIX 1
#endif
#define TS_BEGIN -1
#define TS_END -1
#define PROBE_REP -1
constexpr int NTHREADS = 512;
constexpr int NWAVES = 8;
constexpr int LDS_BYTES = 155648;
constexpr int MISC_OFF = 153600;

constexpr int T = 16384, SEQ = 4096, D = 1024;
constexpr int NCOL_IN = 9488;
constexpr int NEXP = 32;
constexpr int MAXTILES = 288;
constexpr int MAXSLOTS = MAXTILES * 256;

enum { I_X = 0, I_NORM_MIX, I_W_IN, I_GDN_CONV, I_GDN_ALOG, I_GDN_DTB, I_GDN_NORM, I_MU, I_W0, I_W2, I_A0, I_A2, I_G2, I_KK, I_KA, I_RK,
       I_LNW, I_LNB, I_PROJ_A, I_PROJ_B, I_W_OUT, I_NORM_FFN, I_ROUTER_W, I_ROUTER_B, I_W_GU, I_B_GU, I_W_DOWN, I_B_DOWN, I_NORM_FINAL };

constexpr size_t MiB = 1u << 20;
constexpr size_t WS_CTL = 0, CTL_BYTES = 65536;
constexpr size_t WS_BETA = 1 * MiB;
constexpr size_t WS_GG = WS_BETA + 512 * 1024;
constexpr size_t WS_SC = 2 * MiB;
constexpr size_t WS_TE = 3 * MiB;
constexpr size_t WS_TG = WS_TE + 256 * 1024;
constexpr size_t WS_TP = WS_TG + 256 * 1024;
constexpr size_t WS_TSLOT = WS_TP + 256 * 1024;
constexpr size_t WS_SGATE = 4 * MiB;
constexpr size_t WS_SLOT_TOK = 4 * MiB + 512 * 1024;
constexpr size_t WS_TILE_E = 5 * MiB;
constexpr size_t WS_NT = WS_TILE_E + 4096;
constexpr size_t WS_HB = 8 * MiB;
constexpr size_t WS_H2 = WS_HB;
constexpr size_t WS_ZS = 40 * MiB;
constexpr size_t WS_GATES = 72 * MiB;
constexpr size_t WS_ALORA = 136 * MiB;
constexpr size_t WS_LW = 144 * MiB;
constexpr size_t WS_AA = 208 * MiB;
constexpr size_t WS_GGR = 272 * MiB;
constexpr size_t WS_VP = 304 * MiB;
constexpr size_t WS_Q = 336 * MiB;
constexpr size_t WS_QKVC = WS_Q;
constexpr size_t WS_RP = WS_Q, WS_KF = WS_Q + 64 * MiB, WS_KKN = WS_Q + 128 * MiB;
constexpr size_t WS_YA = WS_Q, WS_YB = WS_Q + 32 * MiB, WS_G2 = WS_Q + 64 * MiB, WS_X1 = WS_Q + 128 * MiB;
constexpr size_t WS_GQKV = 528 * MiB;
constexpr size_t WS_OG = 720 * MiB, WS_ORW = 784 * MiB;
constexpr size_t WS_RKV = 720 * MiB;
constexpr size_t WS_LIN = 912 * MiB;
constexpr size_t WS_DEC = 928 * MiB;
constexpr size_t WS_XB = 528 * MiB;
constexpr size_t WS_ACT = 672 * MiB;
constexpr size_t WS_YS = 816 * MiB;
constexpr size_t WS_WIN_T = 992 * MiB;
constexpr size_t WS_PROJ_T = 144 * MiB;
constexpr size_t WS_WOUT_T = 148 * MiB;
constexpr size_t WS_WGU_T = 72 * MiB;
constexpr size_t WS_WDN_T = 200 * MiB;
constexpr size_t WS_GA1 = 336 * MiB, WS_GX0 = 368 * MiB, WS_GA2 = 432 * MiB, WS_GA3 = 464 * MiB, WS_GA4 = 480 * MiB;
constexpr size_t WS_GGL = 6 * MiB;
constexpr size_t WS_RX0 = 528 * MiB, WS_RO0 = 592 * MiB, WS_RS0 = 656 * MiB;
constexpr size_t WS_RA1 = 8 * MiB, WS_RA2 = 928 * MiB, WS_RA3 = 960 * MiB, WS_RA4 = 992 * MiB;
constexpr size_t WS_RDSC = 7 * MiB;
constexpr size_t WS_LORA_T = 1012 * MiB;
constexpr size_t WS_END = 1024 * MiB;
constexpr int CW_BAR = 1024;
constexpr int CW_CNT = 256;
constexpr int CW_TS = 900;

#define XB_TMO      128
#define XB_XCNT(j)  (256  + 64 * (j))
#define XB_XSUB(j)  (1280 + 64 * (j))
#define XB_XGEN(j)  (2304 + 64 * (j))
#define XB_TOP      3328
#define XB_TOPGEN   3392
#define XCD_BAR_WORDS 3456
#define XB_SPIN_CAP (1u << 24)
__device__ __forceinline__ unsigned xb_ld(unsigned* p)              { return __hip_atomic_load(p, __ATOMIC_RELAXED, __HIP_MEMORY_SCOPE_AGENT); }
__device__ __forceinline__ unsigned xb_add(unsigned* p, unsigned v) { return __hip_atomic_fetch_add(p, v, __ATOMIC_RELAXED, __HIP_MEMORY_SCOPE_AGENT); }
__device__ __forceinline__ unsigned xb_xcc_id() { return (unsigned)__builtin_amdgcn_s_getreg((3 << 11) | 20) & 0xFu; }
#define XB_SPIN(cond, bar) do { unsigned _sp = 0; while (cond) { __builtin_amdgcn_s_sleep(1); \
    if ((++_sp & 255u) == 0u) { if (xb_ld(&(bar)[XB_TMO])) break; if (_sp > XB_SPIN_CAP) { atomicAdd(&(bar)[XB_TMO], 1u); break; } } } } while (0)
struct XcdBarrier { unsigned* bar; unsigned x; volatile LAS unsigned* st; };
__device__ __forceinline__ XcdBarrier xcd_barrier_post(unsigned* bar, volatile LAS unsigned* st) {
    XcdBarrier b; b.bar = bar; b.x = xb_xcc_id(); b.st = st;
    if (threadIdx.x == 0) (void)xb_add(&bar[XB_XCNT(b.x)], 1u);
    return b;
}
__device__ __forceinline__ void xcd_barrier_complete(unsigned* bar, unsigned x, unsigned& nloc, unsigned& nx) {
    const unsigned G = gridDim.x * gridDim.y * gridDim.z;
    unsigned sum, cnt, mine, sp = 0u;
    for (;;) {
        sum = 0u; cnt = 0u; mine = 0u;
#pragma unroll
        for (unsigned j = 0; j < 16; ++j) { const unsigned c = xb_ld(&bar[XB_XCNT(j)]); sum += c; cnt += (c > 0u) ? 1u : 0u; mine = (j == x) ? c : mine; }
        if (sum == G) break;
        __builtin_amdgcn_s_sleep(1);
        if ((++sp & 255u) == 0u) { if (xb_ld(&bar[XB_TMO])) break; if (sp > XB_SPIN_CAP) { atomicAdd(&bar[XB_TMO], 1u); break; } }
    }
    nloc = mine > 0u ? mine : 1u; nx = cnt > 0u ? cnt : 1u;
}
__device__ __forceinline__ void xcd_barrier(const XcdBarrier& b) {
    asm volatile("s_waitcnt vmcnt(0)" ::: "memory");
    __syncthreads();
    if (threadIdx.x == 0) {
        unsigned* bar = b.bar;
        __builtin_amdgcn_s_waitcnt(0);
        unsigned nloc = b.st[0], nx = b.st[1];
        if (nloc == 0u) { xcd_barrier_complete(bar, b.x, nloc, nx); b.st[0] = nloc; b.st[1] = nx; }
        const unsigned old = xb_add(&bar[XB_XSUB(b.x)], 1u);
        const unsigned gen = old / nloc;
        if (old + 1u == (gen + 1u) * nloc) {
            __builtin_amdgcn_fence(__ATOMIC_RELEASE, "agent");
            asm volatile("s_waitcnt vmcnt(0)" ::: "memory");
            const unsigned og = xb_add(&bar[XB_TOP], 1u);
            const unsigned tg = og / nx;
            if (og + 1u == (tg + 1u) * nx) xb_add(&bar[XB_TOPGEN], 1u);
            else XB_SPIN(xb_ld(&bar[XB_TOPGEN]) == tg, bar);
            __builtin_amdgcn_fence(__ATOMIC_ACQUIRE, "agent");
            xb_add(&bar[XB_XGEN(b.x)], 1u);
            asm volatile("s_waitcnt vmcnt(0)" ::: "memory");
        } else {
            XB_SPIN(xb_ld(&bar[XB_XGEN(b.x)]) == gen, bar);
            __builtin_amdgcn_fence(__ATOMIC_ACQUIRE, "agent");
            asm volatile("s_waitcnt vmcnt(0)" ::: "memory");
        }
    }
    __syncthreads();
}

typedef unsigned short bf16;
typedef __bf16 bf16x2_t __attribute__((ext_vector_type(2)));
__device__ __forceinline__ bf16 f2bf(float f) { return __builtin_bit_cast(unsigned short, (__bf16)f); }
__device__ __forceinline__ float bf2f(unsigned b) { return __uint_as_float(b << 16); }
__device__ __forceinline__ unsigned pk2(float lo, float hi) { bf16x2_t v; v[0] = (__bf16)lo; v[1] = (__bf16)hi; return __builtin_bit_cast(unsigned, v); }
__device__ __forceinline__ float bflo(unsigned w) { return __uint_as_float(w << 16); }
__device__ __forceinline__ float bfhi(unsigned w) { return __uint_as_float(w & 0xffff0000u); }
__device__ __forceinline__ float sigm(float x) { return 1.f / (1.f + expf(-x)); }
__device__ __forceinline__ float fsigm(float x) { return __builtin_amdgcn_rcpf(1.f + __expf(-x)); }
__device__ __forceinline__ float softplusf(float x) { return x > 20.f ? x : log1pf(expf(x)); }
__device__ __forceinline__ float dpp_xor1(float v) { return __int_as_float(__builtin_amdgcn_update_dpp(0, __float_as_int(v), 0xB1, 0xF, 0xF, false)); }
template <int CTRL, int ROWMASK>
__device__ __forceinline__ float dpp_add(float v) { return v + __int_as_float(__builtin_amdgcn_update_dpp(0, __float_as_int(v), CTRL, ROWMASK, 0xF, false)); }
__device__ __forceinline__ float sum4(float v)  { v = dpp_add<0xB1, 0xF>(v); return dpp_add<0x4E, 0xF>(v); }
__device__ __forceinline__ float sum8(float v)  { return dpp_add<0x141, 0xF>(sum4(v)); }
__device__ __forceinline__ float sum16(float v) { return dpp_add<0x140, 0xF>(sum8(v)); }
__device__ __forceinline__ float wsum(float v) {
    v = sum16(v);
    v = dpp_add<0x142, 0xA>(v);
    v = dpp_add<0x143, 0xC>(v);
    return __int_as_float(__builtin_amdgcn_readlane(__float_as_int(v), 63));
}

struct Params { const float* in[29]; float* out; unsigned char* ws; int ph_lo, ph_hi, li, coop; };

struct Ctx {
    const Params& P; int tid, lane, wave, gwave, nwaves; size_t gtid, nthreads; unsigned char* lds;
    template <class Tp> __device__ __forceinline__ Tp* ws(size_t off) const { return (Tp*)(P.ws + off); }
};

__device__ __forceinline__ void ph_rms0(const Ctx& c) {
    const float* x = c.P.in[I_X]; const float* nw = c.P.in[I_NORM_MIX]; const float* win = c.P.in[I_W_IN];
    const float* alog = c.P.in[I_GDN_ALOG]; const float* dtb = c.P.in[I_GDN_DTB];
    bf16* HB = c.ws<bf16>(WS_HB); float* BETA = c.ws<float>(WS_BETA); float* GGv = c.ws<float>(WS_GG);
    if (blockIdx.x == 0 && c.tid < NEXP) c.ws<unsigned>(WS_CTL)[CW_CNT + c.tid] = 0u;
    float4* tab = (float4*)c.lds;
    __syncthreads();
    for (int i = c.tid; i < 4096; i += NTHREADS) { const int k = i >> 2; tab[((k & 3) * 256 + (k >> 2)) * 5 + (i & 3)] = *(const float4*)(win + (size_t)k * NCOL_IN + 4096 + (i & 3) * 4); }
    __syncthreads();
    const int lane = c.lane;
    for (int t = c.gwave; t < T; t += c.nwaves) {
        float4 v[4]; float ss = 0.f;
#pragma unroll
        for (int i = 0; i < 4; ++i) { v[i] = ((const float4*)(x + (size_t)t * D))[lane + 64 * i]; ss += v[i].x * v[i].x + v[i].y * v[i].y + v[i].z * v[i].z + v[i].w * v[i].w; }
        ss = wsum(ss);
        const float rstd = rsqrtf(ss * (1.f / 1024.f) + 1e-6f);
        float acc[16];
#pragma unroll
        for (int j = 0; j < 16; ++j) acc[j] = 0.f;
#pragma unroll
        for (int i = 0; i < 4; ++i) {
            const float4 w4 = ((const float4*)nw)[lane + 64 * i];
            float h[4] = {v[i].x * rstd * w4.x, v[i].y * rstd * w4.y, v[i].z * rstd * w4.z, v[i].w * rstd * w4.w};
            uint2 st; st.x = pk2(h[0], h[1]); st.y = pk2(h[2], h[3]);
            *(uint2*)(HB + (size_t)t * D + 4 * (lane + 64 * i)) = st;
#pragma unroll
            for (int ii = 0; ii < 4; ++ii) {
                const int k = 4 * (lane + 64 * i) + ii;
#pragma unroll
                for (int q = 0; q < 4; ++q) { const float4 w = tab[(ii * 256 + (k >> 2)) * 5 + q]; acc[4 * q + 0] += h[ii] * w.x; acc[4 * q + 1] += h[ii] * w.y; acc[4 * q + 2] += h[ii] * w.z; acc[4 * q + 3] += h[ii] * w.w; }
                if (ii & 1) asm volatile("" ::: "memory");
            }
        }
        float mine = 0.f;
#pragma unroll
        for (int j = 0; j < 16; ++j) { const float s = wsum(acc[j]); mine = (lane == j) ? s : mine; }
        if (lane < 8) BETA[t * 8 + lane] = sigm(mine);
        else if (lane < 16) { const int h = lane - 8; GGv[t * 8 + h] = -expf(alog[h]) * softplusf(mine + dtb[h]); }
    }
    __syncthreads();
}

struct NoLd {};
struct EpiInProj {
    typedef NoLd Ld; static constexpr int MB = 1;
    bf16* GQKV; bf16* ZS; bf16* RKV; float* LIN; bf16* GATES;
    __device__ __forceinline__ void load(Ld&, int, int, int) const {}
    __device__ __forceinline__ void store8(int row, int col, const float (&v)[8], int, const Ld&) const {
        if (col < 3072) { uint4 w; w.x = pk2(v[0], v[1]); w.y = pk2(v[2], v[3]); w.z = pk2(v[4], v[5]); w.w = pk2(v[6], v[7]); *(uint4*)(GQKV + (size_t)row * 3072 + col) = w; }
        else if (col < 4096) { uint4 w; w.x = pk2(v[0] * fsigm(v[0]), v[1] * fsigm(v[1])); w.y = pk2(v[2] * fsigm(v[2]), v[3] * fsigm(v[3])); w.z = pk2(v[4] * fsigm(v[4]), v[5] * fsigm(v[5])); w.w = pk2(v[6] * fsigm(v[6]), v[7] * fsigm(v[7]));
            *(uint4*)(ZS + (size_t)row * 1024 + (col - 3072)) = w; }
        else if (col < 7168) { uint4 w; w.x = pk2(v[0], v[1]); w.y = pk2(v[2], v[3]); w.z = pk2(v[4], v[5]); w.w = pk2(v[6], v[7]); *(uint4*)(RKV + (size_t)row * 3072 + (col - 4096)) = w; }
        else if (col < 7424) { float* p = LIN + (size_t)row * 256 + (col - 7168); *(float4*)p = make_float4(v[0], v[1], v[2], v[3]); *(float4*)(p + 4) = make_float4(v[4], v[5], v[6], v[7]); }
        else { uint4 w; w.x = pk2(fsigm(v[0]), fsigm(v[1])); w.y = pk2(fsigm(v[2]), fsigm(v[3])); w.z = pk2(fsigm(v[4]), fsigm(v[5])); w.w = pk2(fsigm(v[6]), fsigm(v[7]));
            *(uint4*)(GATES + (size_t)row * 2048 + (col - 7424)) = w; }
    }
};
struct EpiG2 {
    struct Ld { uint4 g; uint4 p; }; static constexpr int MB = 1;
    const bf16* GATES; bf16* MG;
    __device__ __forceinline__ void load(Ld& l, int row, int col, int) const { l.g = *(const uint4*)(GATES + (size_t)row * 2048 + col); const uint4 q = *(const uint4*)(MG + (size_t)row * 1024 + (col & 1023)); const bool b = col >= 1024; l.p = make_uint4(b ? q.x : 0u, b ? q.y : 0u, b ? q.z : 0u, b ? q.w : 0u); }
    __device__ __forceinline__ void store8(int row, int col, const float (&v)[8], int, const Ld& l) const {
        const uint4 g = l.g, p = l.p;
        uint4 w; w.x = pk2(v[0] * bflo(g.x) + bflo(p.x), v[1] * bfhi(g.x) + bfhi(p.x)); w.y = pk2(v[2] * bflo(g.y) + bflo(p.y), v[3] * bfhi(g.y) + bfhi(p.y));
        w.z = pk2(v[4] * bflo(g.z) + bflo(p.z), v[5] * bfhi(g.z) + bfhi(p.z)); w.w = pk2(v[6] * bflo(g.w) + bflo(p.w), v[7] * bfhi(g.w) + bfhi(p.w));
        *(uint4*)(MG + (size_t)row * 1024 + (col & 1023)) = w;
    }
};
struct EpiX1 {
    struct Ld { float4 a, b; }; static constexpr int MB = 2;
    const float* X; float* X1;
    __device__ __forceinline__ void load(Ld& l, int row, int col, int) const { const float* xp = X + (size_t)row * 1024 + col; l.a = *(const float4*)xp; l.b = *(const float4*)(xp + 4); }
    __device__ __forceinline__ void store8(int row, int col, const float (&v)[8], int, const Ld& l) const {
        float* op = X1 + (size_t)row * 1024 + col;
        const float4 a = l.a, b = l.b;
        *(float4*)op = make_float4(a.x + v[0], a.y + v[1], a.z + v[2], a.w + v[3]); *(float4*)(op + 4) = make_float4(b.x + v[4], b.y + v[5], b.z + v[6], b.w + v[7]);
    }
};
struct EpiAct {
    struct Ld { float4 b0, b1; }; static constexpr int MB = 4;
    const float* BGU; bf16* ACT;
    __device__ __forceinline__ void load(Ld& l, int, int col, int e) const { const float* bp = BGU + (size_t)e * 2048 + col; l.b0 = *(const float4*)bp; l.b1 = *(const float4*)(bp + 4); }
    __device__ __forceinline__ void store8(int row, int col, const float (&v)[8], int e, const Ld& l) const {
        const float4 b0 = l.b0, b1 = l.b1;
        const float bb[8] = {b0.x, b0.y, b0.z, b0.w, b1.x, b1.y, b1.z, b1.w};
        float o[4];
#pragma unroll
        for (int p = 0; p < 4; ++p) { float glu = v[2 * p] + bb[2 * p], lin = v[2 * p + 1] + bb[2 * p + 1]; glu = fminf(glu, 7.f); lin = fminf(fmaxf(lin, -7.f), 7.f); o[p] = glu * fsigm(1.702f * glu) * (lin + 1.f); }
        uint2 w; w.x = pk2(o[0], o[1]); w.y = pk2(o[2], o[3]);
        *(uint2*)(ACT + (size_t)row * 1024 + (col >> 1)) = w;
    }
};
struct EpiYS {
    struct Ld { float4 b0, b1; float g; }; static constexpr int MB = 4;
    const float* BD; const float* SGATE; bf16* YS;
    __device__ __forceinline__ void load(Ld& l, int row, int col, int e) const { const float* bp = BD + (size_t)e * 1024 + col; l.g = SGATE[row]; l.b0 = *(const float4*)bp; l.b1 = *(const float4*)(bp + 4); }
    __device__ __forceinline__ void store8(int row, int col, const float (&v)[8], int e, const Ld& l) const {
        const float g = l.g; const float4 b0 = l.b0, b1 = l.b1;
        uint4 w; w.x = pk2((v[0] + b0.x) * g, (v[1] + b0.y) * g); w.y = pk2((v[2] + b0.z) * g, (v[3] + b0.w) * g); w.z = pk2((v[4] + b1.x) * g, (v[5] + b1.y) * g); w.w = pk2((v[6] + b1.z) * g, (v[7] + b1.w) * g);
        *(uint4*)(YS + (size_t)row * 1024 + col) = w;
    }
};


namespace pg8 {
typedef short bf16x8 __attribute__((ext_vector_type(8)));
typedef float f32x4 __attribute__((ext_vector_type(4)));
constexpr int BM = 256, BK = 64, HALF = 128, HTB = HALF * BK * 2, NXCD = 8, WGM = 8;
__host__ __device__ __forceinline__ int lds_byte(int r, int c) { const int st = (r >> 4) * 2 + (c >> 5), rr = r & 15, cc = c & 31, ob = rr * 64 + cc * 2; return st * 1024 + (ob ^ (((ob >> 9) & 1) << 5)); }
__host__ __device__ __forceinline__ void stage_rc(int b, int& R, int& C) { const int st = b / 1024, sb = b % 1024, swz = sb ^ (((sb >> 9) & 1) << 5); R = (st >> 1) * 16 + swz / 64; C = (st & 1) * 32 + (swz % 64) / 2; }
__host__ __device__ __forceinline__ int perm32(int rho) { const int n = rho >> 4, i = rho & 15; return 8 * (i >> 2) + 4 * n + (i & 3); }
struct Unit { const char* a; const char* b; const int* rowmap; int row0, col0, aux; };
__device__ __forceinline__ void tile_order(int L, int nM, int nN, int& pm, int& pn) {
    const int nwg = nM * nN; int wgid = L; { const int q = nwg / NXCD, r = nwg % NXCD, xcd = wgid % NXCD, off = wgid / NXCD; wgid = (xcd < r ? xcd * (q + 1) : r * (q + 1) + (xcd - r) * q) + off; }
    const int nig = WGM * nN, gid = wgid / nig, fm = gid * WGM, gsz = (nM - fm) < WGM ? (nM - fm) : WGM;
    pm = fm + ((wgid % nig) % gsz); pn = (wgid % nig) / gsz;
}
template <class Epi>
__device__ __forceinline__ void epi_apply(const Epi& E, const f32x4 (&acc)[2][2][4][2], const Unit& u, int wr, int wc, int fr, int fq) {
    constexpr int MB = Epi::MB;
#pragma unroll
    for (int ai = 0; ai < 2; ++ai)
#pragma unroll
        for (int mp = 0; mp < 4 / MB; ++mp) {
            typename Epi::Ld ld[MB][2];
#pragma unroll
            for (int mm = 0; mm < MB; ++mm)
#pragma unroll
                for (int bj = 0; bj < 2; ++bj) E.load(ld[mm][bj], u.row0 + ai * HALF + wr * 64 + (mp * MB + mm) * 16 + fr, u.col0 + bj * HALF + wc * 32 + 8 * fq, u.aux);
#pragma unroll
            for (int mm = 0; mm < MB; ++mm)
#pragma unroll
                for (int bj = 0; bj < 2; ++bj) {
                    const int m = mp * MB + mm;
                    const f32x4 x0 = acc[ai][bj][m][0], x1 = acc[ai][bj][m][1];
                    const float v[8] = {x0[0], x0[1], x0[2], x0[3], x1[0], x1[1], x1[2], x1[3]};
                    E.store8(u.row0 + ai * HALF + wr * 64 + m * 16 + fr, u.col0 + bj * HALF + wc * 32 + 8 * fq, v, u.aux, ld[mm][bj]);
                }
            asm volatile("" ::: "memory");
        }
}
template <bool GATHER, class Epi, class Sched>
__device__ __forceinline__ void gemm_phase_t(LAS unsigned char* lds, const int K_, const Sched& S, const Epi& E, const int tid) {
    int K = K_; asm volatile("" : "+s"(K));
    const int wid = __builtin_amdgcn_readfirstlane(tid >> 6), lane = tid & 63, wr = wid >> 2, wc = wid & 3, fr = lane & 15, fq = lane >> 4;
    const int nt = K / BK;
    unsigned voffA[2], voffB[2];
#pragma unroll
    for (int i = 0; i < 2; ++i) { int R, C; stage_rc(tid * 16 + i * 8192, R, C); const int Rb = (R & ~31) + perm32(R & 31);
        voffA[i] = (unsigned)(R * K + C) * 2u; voffB[i] = (unsigned)(Rb * K + C) * 2u; }
    const size_t kstep = (size_t)(BK * 2);
    const size_t hstep = (size_t)HALF * K * 2;
    const unsigned ldsw = (unsigned)wid * 1024u;
    const int aoff = lds_byte(wr * 64 + fr, fq * 8), boff = lds_byte(wc * 32 + fr, fq * 8);
#define PG8_SA(b, h) (((b) * 2 + (h)) * HTB)
#define PG8_SB(b, h) ((4 + (b) * 2 + (h)) * HTB)
#define PG8_STAGE(bufoff, gbase, voff) do { _Pragma("unroll") for (int _i = 0; _i < 2; ++_i) \
        __builtin_amdgcn_global_load_lds((const unsigned*)((const char*)(gbase) + (voff)[_i]), (LAS unsigned*)(lds + (bufoff) + ldsw + _i * 8192), 16, 0, 0); } while (0)
#define PG8_LDA(dst, b, h) do { _Pragma("unroll") for (int m = 0; m < 4; ++m) _Pragma("unroll") for (int k = 0; k < 2; ++k) dst[m][k] = *(const LAS bf16x8*)(lds + PG8_SA(b, h) + aoff + m * 2048 + k * 1024); } while (0)
#define PG8_LDB(dst, b, h) do { _Pragma("unroll") for (int n = 0; n < 2; ++n) _Pragma("unroll") for (int k = 0; k < 2; ++k) dst[n][k] = *(const LAS bf16x8*)(lds + PG8_SB(b, h) + boff + n * 2048 + k * 1024); } while (0)
#define PG8_MMA(ai, bj, At, Bt) do { __builtin_amdgcn_s_setprio(1); _Pragma("unroll") for (int m = 0; m < 4; ++m) _Pragma("unroll") for (int n = 0; n < 2; ++n) _Pragma("unroll") for (int k = 0; k < 2; ++k) \
        acc[ai][bj][m][n] = __builtin_amdgcn_mfma_f32_16x16x32_bf16(Bt[n][k], At[m][k], acc[ai][bj][m][n], 0, 0, 0); __builtin_amdgcn_s_setprio(0); } while (0)
#define PG8_WAIT_V(n) asm volatile("s_waitcnt vmcnt(" #n ")" ::: "memory")
#define PG8_WAIT_L(n) asm volatile("s_waitcnt lgkmcnt(" #n ")" ::: "memory")
#define PG8_BAR __builtin_amdgcn_s_barrier()
#define PG8_SCHED __builtin_amdgcn_sched_barrier(0)
    Unit cur, nxt; int ui = 0;
    if (!S.next(0, cur)) return;
    f32x4 acc[2][2][4][2];
#pragma unroll
    for (int a = 0; a < 2; ++a)
#pragma unroll
        for (int b = 0; b < 2; ++b)
#pragma unroll
            for (int m = 0; m < 4; ++m)
#pragma unroll
                for (int n = 0; n < 2; ++n) acc[a][b][m][n] = (f32x4){0.f, 0.f, 0.f, 0.f};
    bf16x8 At[4][2], B0[2][2], B1[2][2];
    const char* cA = cur.a; const char* cB = cur.b;
    unsigned oc_lo[2] = {0u, 0u}, oc_hi[2] = {0u, 0u}, on_lo[2] = {0u, 0u}, on_hi[2] = {0u, 0u};
#define PG8_ROWOFF(U, LO, HI) do { _Pragma("unroll") for (int _i = 0; _i < 2; ++_i) { int R_, C_; stage_rc(tid * 16 + _i * 8192, R_, C_); \
        LO[_i] = (unsigned)((U).rowmap[R_] * K + C_) * 2u; HI[_i] = (unsigned)((U).rowmap[R_ + 128] * K + C_) * 2u; } } while (0)
    if constexpr (GATHER) PG8_ROWOFF(cur, oc_lo, oc_hi);
    PG8_STAGE(PG8_SB(0, 0), cB, voffB);
    if constexpr (GATHER) PG8_STAGE(PG8_SA(0, 0), cA, oc_lo); else PG8_STAGE(PG8_SA(0, 0), cA, voffA);
    PG8_STAGE(PG8_SB(0, 1), cB + hstep, voffB);
    if constexpr (GATHER) PG8_STAGE(PG8_SA(0, 1), cA, oc_hi); else PG8_STAGE(PG8_SA(0, 1), cA + hstep, voffA);
    if (wr == 1) PG8_BAR;
    PG8_WAIT_V(4); PG8_BAR;
    PG8_STAGE(PG8_SB(1, 0), cB + kstep, voffB);
    if constexpr (GATHER) PG8_STAGE(PG8_SA(1, 0), cA + kstep, oc_lo); else PG8_STAGE(PG8_SA(1, 0), cA + kstep, voffA);
    PG8_STAGE(PG8_SB(1, 1), cB + hstep + kstep, voffB);
    PG8_WAIT_V(6); PG8_BAR;
    for (;;) {
        const bool has_next = S.next(ui + 1, nxt);
        const char* nA = has_next ? nxt.a : cA; const char* nB = has_next ? nxt.b : cB;
        if constexpr (GATHER) { if (has_next) PG8_ROWOFF(nxt, on_lo, on_hi); else { on_lo[0] = oc_lo[0]; on_lo[1] = oc_lo[1]; on_hi[0] = oc_hi[0]; on_hi[1] = oc_hi[1]; } }
#pragma unroll 1
        for (int t = 0; t < nt; t += 2) {
            const bool last = (t == nt - 2);
            const char* a1 = cA + (size_t)(t + 1) * kstep;
            const char* a2 = last ? nA : cA + (size_t)(t + 2) * kstep; const char* b2 = last ? nB : cB + (size_t)(t + 2) * kstep;
            const char* a3 = a2 + kstep; const char* b3 = b2 + kstep;
            unsigned o2lo[2], o2hi[2];
            o2lo[0] = last ? on_lo[0] : oc_lo[0]; o2lo[1] = last ? on_lo[1] : oc_lo[1]; o2hi[0] = last ? on_hi[0] : oc_hi[0]; o2hi[1] = last ? on_hi[1] : oc_hi[1];
            PG8_LDB(B0, 0, 0); PG8_SCHED; PG8_LDA(At, 0, 0); if constexpr (GATHER) PG8_STAGE(PG8_SA(1, 1), a1, oc_hi); else PG8_STAGE(PG8_SA(1, 1), a1 + hstep, voffA);
            PG8_WAIT_L(8); PG8_BAR; PG8_WAIT_L(0); PG8_MMA(0, 0, At, B0); PG8_BAR; PG8_SCHED;
            PG8_LDB(B1, 0, 1); PG8_STAGE(PG8_SB(0, 0), b2, voffB);
            PG8_BAR; PG8_WAIT_L(0); PG8_MMA(0, 1, At, B1); PG8_BAR;
            PG8_LDA(At, 0, 1); if constexpr (GATHER) PG8_STAGE(PG8_SA(0, 0), a2, o2lo); else PG8_STAGE(PG8_SA(0, 0), a2, voffA);
            PG8_BAR; PG8_WAIT_L(0); PG8_MMA(1, 0, At, B0); PG8_BAR; PG8_SCHED;
            PG8_STAGE(PG8_SB(0, 1), b2 + hstep, voffB);
            PG8_WAIT_V(6); PG8_BAR; PG8_MMA(1, 1, At, B1); PG8_BAR;
            PG8_LDB(B0, 1, 0); PG8_SCHED; PG8_LDA(At, 1, 0); if constexpr (GATHER) PG8_STAGE(PG8_SA(0, 1), a2, o2hi); else PG8_STAGE(PG8_SA(0, 1), a2 + hstep, voffA);
            PG8_WAIT_L(8); PG8_BAR; PG8_WAIT_L(0); PG8_MMA(0, 0, At, B0); PG8_BAR; PG8_SCHED;
            PG8_LDB(B1, 1, 1); PG8_STAGE(PG8_SB(1, 0), b3, voffB);
            PG8_BAR; PG8_WAIT_L(0); PG8_MMA(0, 1, At, B1); PG8_BAR;
            PG8_LDA(At, 1, 1); if constexpr (GATHER) PG8_STAGE(PG8_SA(1, 0), a3, o2lo); else PG8_STAGE(PG8_SA(1, 0), a3, voffA);
            PG8_BAR; PG8_WAIT_L(0); PG8_MMA(1, 0, At, B0); PG8_BAR; PG8_SCHED;
            PG8_STAGE(PG8_SB(1, 1), b3 + hstep, voffB);
            PG8_WAIT_V(6); PG8_BAR; PG8_MMA(1, 1, At, B1); PG8_BAR;
        }
        epi_apply(E, acc, cur, wr, wc, fr, fq);
        if (!has_next) break;
#pragma unroll
        for (int a = 0; a < 2; ++a)
#pragma unroll
            for (int b = 0; b < 2; ++b)
#pragma unroll
                for (int m = 0; m < 4; ++m)
#pragma unroll
                    for (int n = 0; n < 2; ++n) acc[a][b][m][n] = (f32x4){0.f, 0.f, 0.f, 0.f};
        cur = nxt; cA = nA; cB = nB; ++ui;
        if constexpr (GATHER) { oc_lo[0] = on_lo[0]; oc_lo[1] = on_lo[1]; oc_hi[0] = on_hi[0]; oc_hi[1] = on_hi[1]; }
    }
    PG8_WAIT_V(0);
    if (wr == 0) PG8_BAR;
    PG8_BAR;
#undef PG8_ROWOFF
#undef PG8_SA
#undef PG8_SB
#undef PG8_STAGE
#undef PG8_LDA
#undef PG8_LDB
#undef PG8_MMA
#undef PG8_WAIT_V
#undef PG8_WAIT_L
#undef PG8_BAR
#undef PG8_SCHED
}
template <class Epi, class Sched>
__device__ __forceinline__ void gemm_phase(LAS unsigned char* lds, const int K, const Sched& S, const Epi& E, const int tid) { gemm_phase_t<false>(lds, K, S, E, tid); }
}

struct SchedInProj { const char* A; const char* Bt; int G, c;
    __device__ __forceinline__ bool next(int i, pg8::Unit& u) const { const int L = i * G + c; if (L >= 64 * 37) return false; int pm, pn; pg8::tile_order(L, 64, 37, pm, pn);
        u.a = A + (size_t)pm * (256 * 1024 * 2); u.b = Bt + (size_t)pn * (256 * 1024 * 2); u.row0 = pm * 256; u.col0 = pn * 256; u.aux = 0; u.rowmap = nullptr; return true; } };

struct WJob { const float* src; int ld_src; int K; int ncols; bf16* dst; int ld_dst; int nb; size_t sstride, dstride; };
__device__ __forceinline__ void wconv_job(const Ctx& c, const WJob& j) {
    float* tl = (float*)c.lds;
    const int ntk = j.K >> 6, ntn = j.ncols >> 6, per = ntk * ntn, ntiles = per * j.nb;
    const int rk = c.tid >> 3, rseg = (c.tid & 7) * 8;
    int tile = blockIdx.x;
    float4 a = make_float4(0.f, 0.f, 0.f, 0.f), b = a;
    if (tile < ntiles) { const int bi = tile / per, tt = tile % per, tk = tt % ntk, tn = tt / ntk;
        const float* sp = j.src + (size_t)bi * j.sstride + (size_t)(tk * 64 + rk) * j.ld_src + tn * 64 + rseg; a = *(const float4*)sp; b = *(const float4*)(sp + 4); }
    for (; tile < ntiles; tile += gridDim.x) {
        const int bi = tile / per, tt = tile % per, tk = tt % ntk, tn = tt / ntk;
        const float4 ca = a, cb = b;
        const int nxt = tile + gridDim.x;
        if (nxt < ntiles) { const int bi2 = nxt / per, tt2 = nxt % per, tk2 = tt2 % ntk, tn2 = tt2 / ntk;
            const float* sp = j.src + (size_t)bi2 * j.sstride + (size_t)(tk2 * 64 + rk) * j.ld_src + tn2 * 64 + rseg; a = *(const float4*)sp; b = *(const float4*)(sp + 4); }
        asm volatile("s_waitcnt lgkmcnt(0)" ::: "memory"); __builtin_amdgcn_s_barrier(); asm volatile("" ::: "memory");
        float* row = tl + rk * 65 + rseg;
        row[0] = ca.x; row[1] = ca.y; row[2] = ca.z; row[3] = ca.w; row[4] = cb.x; row[5] = cb.y; row[6] = cb.z; row[7] = cb.w;
        asm volatile("s_waitcnt lgkmcnt(0)" ::: "memory"); __builtin_amdgcn_s_barrier(); asm volatile("" ::: "memory");
        const float* col = tl + rseg * 65 + rk;
        uint4 w; w.x = pk2(col[0], col[65]); w.y = pk2(col[130], col[195]); w.z = pk2(col[260], col[325]); w.w = pk2(col[390], col[455]);
        *(uint4*)(j.dst + (size_t)bi * j.dstride + (size_t)(tn * 64 + rk) * j.ld_dst + tk * 64 + rseg) = w;
    }
}
struct SchedG2 { const char* YA; const char* Bt; int G, c;
    __device__ __forceinline__ bool next(int i, pg8::Unit& u) const { const int L = (i >> 1) * G + c, ab = i & 1; if (L >= 64 * 4) return false; int pm, pn; pg8::tile_order(L, 64, 4, pm, pn);
        u.a = YA + (size_t)ab * (WS_YB - WS_YA) + (size_t)pm * (256 * 1024 * 2); u.b = Bt + (size_t)(ab * 4 + pn) * (256 * 1024 * 2); u.row0 = pm * 256; u.col0 = ab * 1024 + pn * 256; u.aux = 0; u.rowmap = nullptr; return true; } };
struct SchedX1 { const char* A; const char* Bt; int G, c;
    __device__ __forceinline__ bool next(int i, pg8::Unit& u) const { const int L = i * G + c; if (L >= 64 * 4) return false; int pm, pn; pg8::tile_order(L, 64, 4, pm, pn);
        u.a = A + (size_t)pm * (256 * 1024 * 2); u.b = Bt + (size_t)pn * (256 * 1024 * 2); u.row0 = pm * 256; u.col0 = pn * 256; u.aux = 0; u.rowmap = nullptr; return true; } };
struct SchedMoe { const char* A; const char* Bt; const int* TILE_E; const int* SLOT_TOK; int NT, NPN, G, c;
    __device__ __forceinline__ bool next(int i, pg8::Unit& u) const { const int L = i * G + c; if (L >= NT * NPN) return false; int tile, pn; pg8::tile_order(L, NT, NPN, tile, pn);
        const int e = TILE_E[tile];
        u.a = SLOT_TOK ? A : A + (size_t)tile * (256 * 1024 * 2); u.rowmap = SLOT_TOK ? SLOT_TOK + tile * 256 : nullptr;
        u.b = Bt + (size_t)(e * NPN + pn) * (256 * 1024 * 2); u.row0 = tile * 256; u.col0 = pn * 256; u.aux = e; return true; } };

struct EpiLora {
    typedef NoLd Ld; static constexpr int MB = 1;
    const float* w0; const float* a0; float* LW; float* AA; bf16* GGR;
    __device__ __forceinline__ void load(Ld&, int, int, int) const {}
    __device__ __forceinline__ void store8(int row, int col, const float (&v)[8], int, const Ld&) const {
        const float* bp = col < 1024 ? w0 + col : a0 + ((col - 1024) & 1023);
        const float4 b0 = *(const float4*)bp, b1 = *(const float4*)(bp + 4);
        const float bb[8] = {b0.x, b0.y, b0.z, b0.w, b1.x, b1.y, b1.z, b1.w};
        if (col < 1024) { float o[8];
#pragma unroll
            for (int i = 0; i < 8; ++i) o[i] = -0.6065306597126334f * fsigm(bb[i] + v[i]);
            float* p = LW + (size_t)row * 1024 + col; *(float4*)p = make_float4(o[0], o[1], o[2], o[3]); *(float4*)(p + 4) = make_float4(o[4], o[5], o[6], o[7]); }
        else if (col < 2048) { const int cc = col - 1024; float o[8];
#pragma unroll
            for (int i = 0; i < 8; ++i) o[i] = fsigm(bb[i] + v[i]);
            float* p = AA + (size_t)row * 1024 + cc; *(float4*)p = make_float4(o[0], o[1], o[2], o[3]); *(float4*)(p + 4) = make_float4(o[4], o[5], o[6], o[7]); }
        else { uint4 w; w.x = pk2(v[0], v[1]); w.y = pk2(v[2], v[3]); w.z = pk2(v[4], v[5]); w.w = pk2(v[6], v[7]); *(uint4*)(GGR + (size_t)row * 1024 + (col - 2048)) = w; }
    }
};
struct SchedLora { const char* A; const char* Bt; int G, c;
    __device__ __forceinline__ bool next(int i, pg8::Unit& u) const { const int L = i * G + c; if (L >= 64 * 12) return false; int pm, pn; pg8::tile_order(L, 64, 12, pm, pn);
        u.a = A + (size_t)pm * (256 * 256 * 2); u.b = Bt + (size_t)pn * (256 * 256 * 2); u.row0 = pm * 256; u.col0 = pn * 256; u.aux = 0; u.rowmap = nullptr; return true; } };
__device__ __forceinline__ void lora_zero(const Ctx& c) {
    uint4* LT = c.ws<uint4>(WS_LORA_T);
    for (size_t idx = c.gtid; idx < (size_t)3072 * 32; idx += c.nthreads) {
        const int row = (int)(idx >> 5), k8 = (int)(idx & 31) * 8;
        const bool data = row < 1024 ? (k8 < 64) : (row < 2048 ? (k8 >= 64 && k8 < 128) : (k8 >= 128));
        if (!data) LT[idx] = make_uint4(0, 0, 0, 0);
    }
}

__device__ __forceinline__ void ph_loraprep(const Ctx& c) {
    const float* LIN = c.ws<float>(WS_LIN); bf16* AL = c.ws<bf16>(WS_ALORA); const float* mu = c.P.in[I_MU];
    for (size_t idx = c.gtid; idx < (size_t)T * 256; idx += c.nthreads) {
        const int t = (int)(idx >> 8), cc = (int)(idx & 255);
        const float x = LIN[idx], xp = (t & (SEQ - 1)) ? LIN[idx - 256] : 0.f;
        const float xs = x + (xp - x) * mu[3072 + cc];
        const float r = cc < 64 ? tanhf(xs) : (cc < 128 ? xs : sigm(xs));
        AL[idx] = f2bf(r);
    }
}
__device__ __forceinline__ void ph_post(const Ctx& c) {
    const bf16* OG = c.ws<bf16>(WS_OG); const bf16* ORW = c.ws<bf16>(WS_ORW); const bf16* ZS = c.ws<bf16>(WS_ZS); const bf16* VP = c.ws<bf16>(WS_VP); const bf16* GGR = c.ws<bf16>(WS_GGR);
    const float* SC = c.ws<float>(WS_SC); bf16* YA = c.ws<bf16>(WS_YA); bf16* YB = c.ws<bf16>(WS_YB);
    const float* gnw = c.P.in[I_GDN_NORM]; const float* lnw = c.P.in[I_LNW]; const float* lnb = c.P.in[I_LNB];
    const int lane = c.lane, c0 = lane * 16;
    for (int t = c.gwave; t < T; t += c.nwaves) {
        {
            float o[16];
#pragma unroll
            for (int q = 0; q < 2; ++q) { const uint4 v = *(const uint4*)(OG + (size_t)t * 1024 + c0 + 8 * q); o[8 * q] = bflo(v.x); o[8 * q + 1] = bfhi(v.x); o[8 * q + 2] = bflo(v.y); o[8 * q + 3] = bfhi(v.y); o[8 * q + 4] = bflo(v.z); o[8 * q + 5] = bfhi(v.z); o[8 * q + 6] = bflo(v.w); o[8 * q + 7] = bfhi(v.w); }
            float ss = 0.f;
#pragma unroll
            for (int j = 0; j < 16; ++j) ss += o[j] * o[j];
            ss = sum8(ss);
            const float rstd = rsqrtf(ss * (1.f / 128.f) + 1e-6f);
            const uint4 z0 = *(const uint4*)(ZS + (size_t)t * 1024 + c0), z1 = *(const uint4*)(ZS + (size_t)t * 1024 + c0 + 8);
            const unsigned zz[8] = {z0.x, z0.y, z0.z, z0.w, z1.x, z1.y, z1.z, z1.w};
            unsigned w[8];
#pragma unroll
            for (int j = 0; j < 8; ++j) { const int cc = (c0 + 2 * j) & 127; w[j] = pk2(o[2 * j] * rstd * gnw[cc] * bflo(zz[j]), o[2 * j + 1] * rstd * gnw[cc + 1] * bfhi(zz[j])); }
            *(uint4*)(YA + (size_t)t * 1024 + c0) = make_uint4(w[0], w[1], w[2], w[3]); *(uint4*)(YA + (size_t)t * 1024 + c0 + 8) = make_uint4(w[4], w[5], w[6], w[7]);
        }
        {
            float o[16];
#pragma unroll
            for (int q = 0; q < 2; ++q) { const uint4 v = *(const uint4*)(ORW + (size_t)t * 1024 + c0 + 8 * q); o[8 * q] = bflo(v.x); o[8 * q + 1] = bfhi(v.x); o[8 * q + 2] = bflo(v.y); o[8 * q + 3] = bfhi(v.y); o[8 * q + 4] = bflo(v.z); o[8 * q + 5] = bfhi(v.z); o[8 * q + 6] = bflo(v.w); o[8 * q + 7] = bfhi(v.w); }
            float sm = 0.f;
#pragma unroll
            for (int j = 0; j < 16; ++j) sm += o[j];
            sm = sum4(sm);
            const float mean = sm * (1.f / 64.f);
            float sv = 0.f;
#pragma unroll
            for (int j = 0; j < 16; ++j) { const float dd = o[j] - mean; sv += dd * dd; }
            sv = sum4(sv);
            const float rstd = rsqrtf(sv * (1.f / 64.f) + 64e-5f);
            const float sc = SC[t * 16 + (c0 >> 6)];
            const uint4 v0 = *(const uint4*)(VP + (size_t)t * 1024 + c0), v1 = *(const uint4*)(VP + (size_t)t * 1024 + c0 + 8);
            const uint4 g0 = *(const uint4*)(GGR + (size_t)t * 1024 + c0), g1 = *(const uint4*)(GGR + (size_t)t * 1024 + c0 + 8);
            const unsigned vv[8] = {v0.x, v0.y, v0.z, v0.w, v1.x, v1.y, v1.z, v1.w};
            const unsigned gg[8] = {g0.x, g0.y, g0.z, g0.w, g1.x, g1.y, g1.z, g1.w};
            unsigned w[8];
#pragma unroll
            for (int j = 0; j < 8; ++j) { const int cc = c0 + 2 * j;
                const float y0 = ((o[2 * j] - mean) * rstd * lnw[cc] + lnb[cc] + sc * bflo(vv[j])) * bflo(gg[j]);
                const float y1 = ((o[2 * j + 1] - mean) * rstd * lnw[cc + 1] + lnb[cc + 1] + sc * bfhi(vv[j])) * bfhi(gg[j]);
                w[j] = pk2(y0, y1); }
            *(uint4*)(YB + (size_t)t * 1024 + c0) = make_uint4(w[0], w[1], w[2], w[3]); *(uint4*)(YB + (size_t)t * 1024 + c0 + 8) = make_uint4(w[4], w[5], w[6], w[7]);
        }
    }
}

__device__ __forceinline__ void ph_router(const Ctx& c) {
    const float* X1 = c.ws<float>(WS_X1); const float* nw = c.P.in[I_NORM_FFN]; const float* rw = c.P.in[I_ROUTER_W]; const float* rb = c.P.in[I_ROUTER_B];
    bf16* H2 = c.ws<bf16>(WS_H2); int* TE = c.ws<int>(WS_TE); float* TG = c.ws<float>(WS_TG); int* TP = c.ws<int>(WS_TP); unsigned* CNT = c.ws<unsigned>(WS_CTL) + CW_CNT;
    const int lane = c.lane;
    float4* tab = (float4*)c.lds;
    unsigned* lcnt = (unsigned*)(c.lds + 147456);
    __syncthreads();
    if (c.tid < 32) lcnt[c.tid] = 0u;
    for (int i = c.tid; i < 8192; i += NTHREADS) { const int k = i >> 3; tab[((k & 3) * 256 + (k >> 2)) * 9 + (i & 7)] = ((const float4*)rw)[i]; }
    __syncthreads();
    for (int t = c.gwave; t < T; t += c.nwaves) {
        float4 v[4]; float ss = 0.f;
#pragma unroll
        for (int i = 0; i < 4; ++i) { v[i] = ((const float4*)(X1 + (size_t)t * D))[lane + 64 * i]; ss += v[i].x * v[i].x + v[i].y * v[i].y + v[i].z * v[i].z + v[i].w * v[i].w; }
        ss = wsum(ss);
        const float rstd = rsqrtf(ss * (1.f / 1024.f) + 1e-6f);
        float lg[32];
#pragma unroll
        for (int j = 0; j < 32; ++j) lg[j] = 0.f;
#pragma unroll
        for (int i = 0; i < 4; ++i) {
            const float4 w4 = ((const float4*)nw)[lane + 64 * i];
            const float h[4] = {v[i].x * rstd * w4.x, v[i].y * rstd * w4.y, v[i].z * rstd * w4.z, v[i].w * rstd * w4.w};
            uint2 st; st.x = pk2(h[0], h[1]); st.y = pk2(h[2], h[3]);
            *(uint2*)(H2 + (size_t)t * D + 4 * (lane + 64 * i)) = st;
#pragma unroll
            for (int ii = 0; ii < 4; ++ii) {
                const float4* wr = tab + (size_t)(ii * 256 + lane + 64 * i) * 9;
#pragma unroll
                for (int q = 0; q < 8; ++q) { const float4 w = wr[q]; lg[4 * q] += h[ii] * w.x; lg[4 * q + 1] += h[ii] * w.y; lg[4 * q + 2] += h[ii] * w.z; lg[4 * q + 3] += h[ii] * w.w; }
                asm volatile("" ::: "memory");
            }
        }
#pragma unroll
        for (int j = 0; j < 32; ++j) lg[j] = wsum(lg[j]) + rb[j];
        int e0 = 0, e1 = 0, e2 = 0, e3 = 0; float v0 = -3e38f, v1 = -3e38f, v2 = -3e38f, v3 = -3e38f;
#pragma unroll
        for (int j = 0; j < 32; ++j) if (lg[j] > v0) { v0 = lg[j]; e0 = j; }
#pragma unroll
        for (int j = 0; j < 32; ++j) if (j != e0 && lg[j] > v1) { v1 = lg[j]; e1 = j; }
#pragma unroll
        for (int j = 0; j < 32; ++j) if (j != e0 && j != e1 && lg[j] > v2) { v2 = lg[j]; e2 = j; }
#pragma unroll
        for (int j = 0; j < 32; ++j) if (j != e0 && j != e1 && j != e2 && lg[j] > v3) { v3 = lg[j]; e3 = j; }
        const float x1 = expf(v1 - v0), x2 = expf(v2 - v0), x3 = expf(v3 - v0), inv = 1.f / (1.f + x1 + x2 + x3);
        if (lane < 4) {
            const int me = lane == 0 ? e0 : (lane == 1 ? e1 : (lane == 2 ? e2 : e3));
            const float mg = (lane == 0 ? 1.f : (lane == 1 ? x1 : (lane == 2 ? x2 : x3))) * inv;
            const unsigned pos = atomicAdd(&lcnt[me], 1u);
            TE[t * 4 + lane] = me; TG[t * 4 + lane] = mg; TP[t * 4 + lane] = (int)pos;
        }
    }
    __syncthreads();
    if (c.tid < 32) lcnt[32 + c.tid] = atomicAdd(&CNT[c.tid], lcnt[c.tid]);
    __syncthreads();
    if (lane < 4) for (int t = c.gwave; t < T; t += c.nwaves) TP[t * 4 + lane] += (int)lcnt[32 + TE[t * 4 + lane]];
    __syncthreads();
}

__device__ __forceinline__ void ph_dispatch(const Ctx& c) {
    int* tb = (int*)c.lds;
    const unsigned* CNT = c.ws<unsigned>(WS_CTL) + CW_CNT;
    int* TILE_E = c.ws<int>(WS_TILE_E); int* NT = c.ws<int>(WS_NT);
    const int* TE = c.ws<int>(WS_TE); const float* TG = c.ws<float>(WS_TG); const int* TP = c.ws<int>(WS_TP); int* TSLOT = c.ws<int>(WS_TSLOT);
    float* SGATE = c.ws<float>(WS_SGATE); const bf16* H2 = c.ws<bf16>(WS_H2); bf16* XB = c.ws<bf16>(WS_XB);
    if (c.tid == 0) { int acc = 0; for (int e = 0; e < NEXP; ++e) { const int n = (int)__hip_atomic_load(&CNT[e], __ATOMIC_RELAXED, __HIP_MEMORY_SCOPE_AGENT); tb[e] = acc; tb[64 + e] = n; acc += (n + 255) >> 8; } tb[32] = acc; }
    __syncthreads();
    if (blockIdx.x == 0) {
        for (int tile = c.tid; tile < tb[32]; tile += NTHREADS) { int e = 0; for (int q = 0; q < NEXP; ++q) if (tile >= tb[q]) e = q; TILE_E[tile] = e; }
        if (c.tid == 0) *NT = tb[32];
    }
    int* SLOT_TOK = c.ws<int>(WS_SLOT_TOK);
    for (size_t idx = c.gtid; idx < (size_t)T * 4; idx += c.nthreads) {
        const int t = (int)(idx >> 2), e = TE[idx], pos = TP[idx];
        const int slot = tb[e] * 256 + pos;
        TSLOT[idx] = slot; SGATE[slot] = TG[idx]; SLOT_TOK[slot] = t;
    }
    for (int e = 0; e < NEXP; ++e) {
        const int n = tb[64 + e], cap = (tb[e + 1] - tb[e]) * 256;
        for (int r = n + (int)c.gtid; r < cap; r += (int)c.nthreads) { const int slot = tb[e] * 256 + r; SLOT_TOK[slot] = 0; SGATE[slot] = 0.f; }
    }
}

__device__ __forceinline__ void ph_combine(const Ctx& c) {
    const float* X1 = c.ws<float>(WS_X1); const bf16* YS = c.ws<bf16>(WS_YS); const int* TSLOT = c.ws<int>(WS_TSLOT); const float* nw = c.P.in[I_NORM_FINAL]; float* out = c.P.out;
    const int lane = c.lane;
    for (int t = c.gwave; t < T; t += c.nwaves) {
        const int s0 = TSLOT[t * 4], s1 = TSLOT[t * 4 + 1], s2 = TSLOT[t * 4 + 2], s3 = TSLOT[t * 4 + 3];
        float4 v[4]; float ss = 0.f;
#pragma unroll
        for (int i = 0; i < 4; ++i) {
            const int col = 4 * (lane + 64 * i);
            v[i] = *(const float4*)(X1 + (size_t)t * D + col);
            const uint2 a = *(const uint2*)(YS + (size_t)s0 * 1024 + col), b = *(const uint2*)(YS + (size_t)s1 * 1024 + col), cc = *(const uint2*)(YS + (size_t)s2 * 1024 + col), d = *(const uint2*)(YS + (size_t)s3 * 1024 + col);
            v[i].x += bflo(a.x) + bflo(b.x) + bflo(cc.x) + bflo(d.x); v[i].y += bfhi(a.x) + bfhi(b.x) + bfhi(cc.x) + bfhi(d.x);
            v[i].z += bflo(a.y) + bflo(b.y) + bflo(cc.y) + bflo(d.y); v[i].w += bfhi(a.y) + bfhi(b.y) + bfhi(cc.y) + bfhi(d.y);
            ss += v[i].x * v[i].x + v[i].y * v[i].y + v[i].z * v[i].z + v[i].w * v[i].w;
        }
        ss = wsum(ss);
        const float rstd = rsqrtf(ss * (1.f / 1024.f) + 1e-6f);
#pragma unroll
        for (int i = 0; i < 4; ++i) { const float4 w4 = ((const float4*)nw)[lane + 64 * i];
            *(float4*)(out + (size_t)t * D + 4 * (lane + 64 * i)) = make_float4(v[i].x * rstd * w4.x, v[i].y * rstd * w4.y, v[i].z * rstd * w4.z, v[i].w * rstd * w4.w); }
    }
    if (TS_BEGIN >= 0 && blockIdx.x == 0 && c.tid == 0) { asm volatile("s_waitcnt vmcnt(0)" ::: "memory"); c.P.out[0] = (float)c.ws<unsigned>(WS_CTL)[CW_TS] * 0.01f; }
}


typedef short bf16x8_t __attribute__((ext_vector_type(8)));
typedef float f32x4_t __attribute__((ext_vector_type(4)));
#define MFMA16(a, b, c) __builtin_amdgcn_mfma_f32_16x16x32_bf16((a), (b), (c), 0, 0, 0)


__device__ __forceinline__ int frag_off(int row, int k, int KBn) { return (((row >> 4) * KBn + (k >> 5)) * 512) + (((k >> 3) & 3) * 128) + ((row & 15) * 8) + (k & 7); }
__device__ __forceinline__ int cfrag_off(int v, int r, int NRT) { return ((((v >> 4) * NRT + (r >> 4)) * 64 + ((r >> 2) & 3) * 16 + (v & 15)) * 4) + (r & 3); }

constexpr int GCL_HALF_BYTES = 71680;
__device__ __forceinline__ void ph_gcl(const Ctx& c) {
    const bf16* GQKV = c.ws<bf16>(WS_GQKV); const float* BETA = c.ws<float>(WS_BETA); const float* GGv = c.ws<float>(WS_GG); const float* cw = c.P.in[I_GDN_CONV];
    bf16* GA1 = c.ws<bf16>(WS_GA1); bf16* GX0 = c.ws<bf16>(WS_GX0); bf16* GA2 = c.ws<bf16>(WS_GA2); bf16* GA3 = c.ws<bf16>(WS_GA3); bf16* GA4 = c.ws<bf16>(WS_GA4); float* GGL = c.ws<float>(WS_GGL);
    for (int it0 = blockIdx.x * 2; it0 < 2048; it0 += gridDim.x * 2) {
        int tv = c.tid; asm volatile("" : "+v"(tv));
        const int half = tv >> 8, ht = tv & 255, lane = tv & 63, w4 = __builtin_amdgcn_readfirstlane((tv >> 6) & 3);
        unsigned char* base = c.lds + half * GCL_HALF_BYTES;
        bf16* QB = (bf16*)base;
        bf16* KB = QB + 64 * 136;
        bf16* VB = KB + 64 * 136;
        float* MM = (float*)(VB + 64 * 136);
        float* GC = MM + 64 * 64;
        float* BT = GC + 64;
        float* BE = BT + 64;
        const int item = it0 + half, n = item & 63, bh = item >> 6, h = bh & 7, b = bh >> 3;
        const int t0 = b * SEQ + n * 64;
        __syncthreads();
        if (w4 == 0) {
            float g = GGv[(size_t)(t0 + lane) * 8 + h]; const float be = BETA[(size_t)(t0 + lane) * 8 + h];
#pragma unroll
            for (int o = 1; o < 64; o <<= 1) { const float u = __shfl_up(g, o); if (lane >= o) g += u; }
            GC[lane] = g; BT[lane] = be; BE[lane] = be * __expf(g);
        }
        __syncthreads();
        {
            const int cg = ht & 15, rg = ht >> 4, r0 = rg * 4;
#pragma unroll
            for (int mat = 0; mat < 3; ++mat) {
                const int col0 = mat * 1024 + h * 128 + cg * 8;
                float4 xa[7], xb[7], wa[4], wb[4];
#pragma unroll
                for (int li = 0; li < 7; ++li) {
                    const bool valid = (n > 0) || (r0 - 3 + li >= 0);
                    uint4 xr = make_uint4(0, 0, 0, 0);
                    if (valid) xr = *(const uint4*)(GQKV + (size_t)(t0 + r0 - 3 + li) * 3072 + col0);
                    xa[li] = make_float4(bflo(xr.x), bfhi(xr.x), bflo(xr.y), bfhi(xr.y));
                    xb[li] = make_float4(bflo(xr.z), bfhi(xr.z), bflo(xr.w), bfhi(xr.w));
                }
#pragma unroll
                for (int j = 0; j < 4; ++j) { wa[j] = *(const float4*)(cw + j * 3072 + col0); wb[j] = *(const float4*)(cw + j * 3072 + col0 + 4); }
#pragma unroll
                for (int rr = 0; rr < 4; ++rr) {
                    float o[8] = {0.f, 0.f, 0.f, 0.f, 0.f, 0.f, 0.f, 0.f};
#pragma unroll
                    for (int j = 0; j < 4; ++j) { const float4 a = xa[rr + j], bq = xb[rr + j];
                        o[0] += wa[j].x * a.x; o[1] += wa[j].y * a.y; o[2] += wa[j].z * a.z; o[3] += wa[j].w * a.w;
                        o[4] += wb[j].x * bq.x; o[5] += wb[j].y * bq.y; o[6] += wb[j].z * bq.z; o[7] += wb[j].w * bq.w; }
                    float ss = 0.f;
#pragma unroll
                    for (int e = 0; e < 8; ++e) { o[e] *= fsigm(o[e]); ss += o[e] * o[e]; }
                    float sc = 1.f;
                    if (mat < 2) { ss = sum16(ss); sc = rsqrtf(ss + 1e-6f) * (mat == 0 ? 0.08838834764831845f : 1.f); }
                    const int r = r0 + rr;
                    uint4 w; w.x = pk2(o[0] * sc, o[1] * sc); w.y = pk2(o[2] * sc, o[3] * sc); w.z = pk2(o[4] * sc, o[5] * sc); w.w = pk2(o[6] * sc, o[7] * sc);
                    *(uint4*)((mat == 0 ? QB : (mat == 1 ? KB : VB)) + r * 136 + cg * 8) = w;
                    if (mat == 0) {
                        const float s2 = sc * __expf(GC[r]);
                        w.x = pk2(o[0] * s2, o[1] * s2); w.y = pk2(o[2] * s2, o[3] * s2); w.z = pk2(o[4] * s2, o[5] * s2); w.w = pk2(o[6] * s2, o[7] * s2);
                        *(uint4*)(GA2 + (size_t)item * 64 * 128 + frag_off(r, cg * 8, 4)) = w;
                    }
                }
            }
        }
        __syncthreads();
        {
            const int fr = lane & 15, fq = lane >> 4, a0 = w4 * 16;
            bf16x8_t ka[4];
#pragma unroll
            for (int kb = 0; kb < 4; ++kb) ka[kb] = *(const bf16x8_t*)(KB + (a0 + fr) * 136 + kb * 32 + fq * 8);
#pragma unroll
            for (int bt = 0; bt < 4; ++bt) {
                f32x4_t c1 = {0.f, 0.f, 0.f, 0.f}, c2 = {0.f, 0.f, 0.f, 0.f};
#pragma unroll
                for (int kb = 0; kb < 4; ++kb) {
                    const bf16x8_t kbf = *(const bf16x8_t*)(KB + (bt * 16 + fr) * 136 + kb * 32 + fq * 8);
                    const bf16x8_t qbf = *(const bf16x8_t*)(QB + (bt * 16 + fr) * 136 + kb * 32 + fq * 8);
                    c1 = MFMA16(ka[kb], kbf, c1); c2 = MFMA16(ka[kb], qbf, c2);
                }
                const int i = bt * 16 + fr, j0 = a0 + 4 * fq;
                const float gi = GC[i], bi = BT[i];
                float m[4], at[4];
#pragma unroll
                for (int rg = 0; rg < 4; ++rg) { const int j = j0 + rg; const float dec = __expf(fminf(gi - GC[j], 0.f));
                    m[rg] = (i > j) ? bi * c1[rg] * dec : 0.f; at[rg] = (i >= j) ? c2[rg] * dec : 0.f; }
                *(float4*)(MM + i * 64 + j0) = make_float4(m[0], m[1], m[2], m[3]);
                uint2 w; w.x = pk2(at[0], at[1]); w.y = pk2(at[2], at[3]);
                *(uint2*)(GA3 + (size_t)item * 64 * 64 + frag_off(i, j0, 2)) = w;
            }
        }
        __syncthreads();
        {
            const int cc = ht & 127; const bool isw = ht >= 128;
            const bf16* srcp = (isw ? KB : VB) + cc; const float* scl = isw ? BE : BT;
            float x[64];
#pragma unroll
            for (int i = 0; i < 64; ++i) x[i] = 0.f;
            float4 mc[16], mn[16];
#pragma unroll
            for (int q = 0; q < 16; ++q) { mc[q] = make_float4(0.f, 0.f, 0.f, 0.f); mn[q] = mc[q]; }
            float rhs_n = scl[0] * bf2f(srcp[0]);
#pragma unroll
            for (int i = 0; i < 64; ++i) {
                const float rhs = rhs_n;
                if (i + 1 < 64) {
#pragma unroll
                    for (int j4 = 0; j4 < (i + 4) / 4; ++j4) mn[j4] = *(const float4*)(MM + (i + 1) * 64 + 4 * j4);
                    rhs_n = scl[i + 1] * bf2f(srcp[(i + 1) * 136]);
                }
                float acc = rhs, ac1 = 0.f, ac2 = 0.f, ac3 = 0.f;
#pragma unroll
                for (int j4 = 0; j4 < (i + 3) / 4; ++j4) { acc -= mc[j4].x * x[4 * j4]; ac1 -= mc[j4].y * x[4 * j4 + 1]; ac2 -= mc[j4].z * x[4 * j4 + 2]; ac3 -= mc[j4].w * x[4 * j4 + 3]; }
                x[i] = (acc + ac1) + (ac2 + ac3);
#pragma unroll
                for (int j4 = 0; j4 < 16; ++j4) mc[j4] = mn[j4];
                asm volatile("" ::: "memory");
            }
            if (!isw) {
                bf16* up = GX0 + (size_t)item * 128 * 64;
#pragma unroll
                for (int q = 0; q < 16; ++q) { uint2 w; w.x = pk2(x[4 * q], x[4 * q + 1]); w.y = pk2(x[4 * q + 2], x[4 * q + 3]); *(uint2*)(up + cfrag_off(cc, 4 * q, 4)) = w; }
            }
            __syncthreads();
            if (isw) {
                bf16* a1s = (bf16*)MM;
#pragma unroll
                for (int i = 0; i < 64; ++i) a1s[i * 128 + cc] = f2bf(-x[i]);
            }
        }
        __syncthreads();
        {
            const bf16* a1s = (const bf16*)MM; bf16* wp = GA1 + (size_t)item * 64 * 128;
#pragma unroll
            for (int q = 0; q < 4; ++q) { const int p = ht + 256 * q, fr = p & 15, fq = (p >> 4) & 3, kb = (p >> 6) & 3, rt = p >> 8;
                *(uint4*)(wp + p * 8) = *(const uint4*)(a1s + (rt * 16 + fr) * 128 + kb * 32 + fq * 8); }
        }
        {
            const int dk = ht & 127, hh = ht >> 7; const float g63 = GC[63];
            unsigned w[16];
#pragma unroll
            for (int q = 0; q < 16; ++q) { const int ta = hh * 32 + 2 * q;
                w[q] = pk2(bf2f(KB[ta * 136 + dk]) * __expf(g63 - GC[ta]), bf2f(KB[(ta + 1) * 136 + dk]) * __expf(g63 - GC[ta + 1])); }
            bf16* dp = GA4 + (size_t)item * 128 * 64;
            *(uint4*)(dp + frag_off(dk, hh * 32, 2)) = make_uint4(w[0], w[1], w[2], w[3]); *(uint4*)(dp + frag_off(dk, hh * 32 + 8, 2)) = make_uint4(w[4], w[5], w[6], w[7]);
            *(uint4*)(dp + frag_off(dk, hh * 32 + 16, 2)) = make_uint4(w[8], w[9], w[10], w[11]); *(uint4*)(dp + frag_off(dk, hh * 32 + 24, 2)) = make_uint4(w[12], w[13], w[14], w[15]);
            if (ht == 0) GGL[item] = __expf(g63);
        }
    }
}

constexpr int RCL_HALF_BYTES = 75776;
__device__ __forceinline__ void ph_rcl(const Ctx& c) {
    const bf16* RKV = c.ws<bf16>(WS_RKV); const float* LW = c.ws<float>(WS_LW); const float* AAg = c.ws<float>(WS_AA);
    const float* mu = c.P.in[I_MU]; const float* k_k = c.P.in[I_KK]; const float* k_a = c.P.in[I_KA]; const float* r_k = c.P.in[I_RK];
    bf16* VP = c.ws<bf16>(WS_VP); float* SC = c.ws<float>(WS_SC);
    bf16* RA1 = c.ws<bf16>(WS_RA1); bf16* RX0 = c.ws<bf16>(WS_RX0); bf16* RA2 = c.ws<bf16>(WS_RA2); bf16* RA3 = c.ws<bf16>(WS_RA3); bf16* RO0 = c.ws<bf16>(WS_RO0);
    bf16* RA4 = c.ws<bf16>(WS_RA4); bf16* RS0 = c.ws<bf16>(WS_RS0); float* RDSC = c.ws<float>(WS_RDSC);
    unsigned long long ts_t0 = 0ull, ts_acc = 0ull;
#define TSMARK(k) do { if (TS_BEGIN >= 0 && blockIdx.x == 0 && c.tid == 0) { const unsigned long long now_ = __builtin_amdgcn_s_memrealtime(); \
        if ((k) == TS_END && ts_t0 != 0ull) ts_acc += now_ - ts_t0; if ((k) == TS_BEGIN) ts_t0 = now_; } } while (0)
    uint4 ur[2], uk[2], uv[2]; float4 a4v[4], l4v[4];
#define RCL_LOAD(ITEM, TID) do { const int it_ = (ITEM), ht_ = (TID) & 255, n_ = it_ & 63, bh_ = it_ >> 6, h_ = bh_ & 15, b_ = bh_ >> 4; \
        const int r_ = ht_ >> 2, c0_ = (ht_ & 3) * 16, t_ = b_ * SEQ + n_ * 64 + r_; \
        const bf16* cur_ = RKV + (size_t)t_ * 3072 + h_ * 64 + c0_; \
        _Pragma("unroll") for (int g = 0; g < 2; ++g) { ur[g] = *(const uint4*)(cur_ + 8 * g); uk[g] = *(const uint4*)(cur_ + 1024 + 8 * g); uv[g] = *(const uint4*)(cur_ + 2048 + 8 * g); } \
        _Pragma("unroll") for (int q = 0; q < 4; ++q) { l4v[q] = *(const float4*)(LW + (size_t)t_ * 1024 + h_ * 64 + c0_ + 4 * q); a4v[q] = *(const float4*)(AAg + (size_t)t_ * 1024 + h_ * 64 + c0_ + 4 * q); } \
    } while (0)
    if ((int)(blockIdx.x * 2) < 4096) RCL_LOAD(blockIdx.x * 2 + (c.tid >> 8), c.tid);
    for (int it0 = blockIdx.x * 2; it0 < 4096; it0 += gridDim.x * 2) {
        int tv = c.tid; asm volatile("" : "+v"(tv));
        const int half = tv >> 8, ht = tv & 255, lane = tv & 63, w4 = __builtin_amdgcn_readfirstlane((tv >> 6) & 3);
        unsigned char* base = c.lds + half * RCL_HALF_BYTES;
        bf16* AT = (bf16*)base;
        bf16* VT = AT + 64 * 72;
        bf16* KDT = VT + 64 * 72;
        float* AAB = (float*)(KDT + 64 * 72);
        float* TOT = AAB + 64 * 64;
        unsigned char* RX = (unsigned char*)(TOT + 256);
        bf16* RT = (bf16*)RX;
        bf16* BTL = RT + 64 * 72;
        bf16* KT = BTL + 64 * 72;
        bf16* AAK = (bf16*)RX;
        bf16* ARK = AAK + 64 * 72;
        float* RHS2 = (float*)RX;
        const int item = it0 + half, n = item & 63, bh = item >> 6, h = bh & 15, b = bh >> 4;
        const int t0 = b * SEQ + n * 64;
        __syncthreads();
        TSMARK(0);
        const int r = ht >> 2, seg = ht & 3, c0 = seg * 16, t = t0 + r; const bool first = (n == 0 && r == 0);
        float rr[16], kf[16], vv[16], kkv[16], aa[16], lwl[16], bdv[16];
        float ss = 0.f, scs = 0.f;
        {
            float4 mr[4], mk[4], mv[4], kkw[4], kaw[4], rkw[4];
            uint4 qr[2], qk[2], qv[2];
            {   const bf16* prv = RKV + (size_t)(t - 1) * 3072 + h * 64 + c0;
#pragma unroll
                for (int g = 0; g < 2; ++g) { qr[g] = make_uint4(0, 0, 0, 0); qk[g] = qr[g]; qv[g] = qr[g];
                    if (!first) { qr[g] = *(const uint4*)(prv + 8 * g); qk[g] = *(const uint4*)(prv + 1024 + 8 * g); qv[g] = *(const uint4*)(prv + 2048 + 8 * g); } } }
#pragma unroll
            for (int q = 0; q < 4; ++q) {
                mr[q] = *(const float4*)(mu + h * 64 + c0 + 4 * q); mk[q] = *(const float4*)(mu + 1024 + h * 64 + c0 + 4 * q); mv[q] = *(const float4*)(mu + 2048 + h * 64 + c0 + 4 * q);
                kkw[q] = *(const float4*)(k_k + h * 64 + c0 + 4 * q); kaw[q] = *(const float4*)(k_a + h * 64 + c0 + 4 * q); rkw[q] = *(const float4*)(r_k + h * 64 + c0 + 4 * q);
            }
#pragma unroll
            for (int q = 0; q < 4; ++q) *(float4*)(AAB + r * 64 + c0 + 4 * q) = l4v[q];
            __syncthreads();
            {
                const int ch = ht & 63, tq = ht >> 6;
                float run = 0.f;
#pragma unroll
                for (int i = 0; i < 16; ++i) { run += AAB[(tq * 16 + i) * 64 + ch]; AAB[(tq * 16 + i) * 64 + ch] = run; }
                TOT[tq * 64 + ch] = run;
            }
            __syncthreads();
            TSMARK(1);
#pragma unroll
            for (int q = 0; q < 4; ++q) {
                const int g = q >> 1; const bool hi = q & 1;
                const unsigned r_a = hi ? ur[g].z : ur[g].x, r_b = hi ? ur[g].w : ur[g].y, k_a_ = hi ? uk[g].z : uk[g].x, k_b_ = hi ? uk[g].w : uk[g].y, v_a = hi ? uv[g].z : uv[g].x, v_b = hi ? uv[g].w : uv[g].y;
                const unsigned pr_a = hi ? qr[g].z : qr[g].x, pr_b = hi ? qr[g].w : qr[g].y, pk_a = hi ? qk[g].z : qk[g].x, pk_b = hi ? qk[g].w : qk[g].y, pv_a = hi ? qv[g].z : qv[g].x, pv_b = hi ? qv[g].w : qv[g].y;
                const float r0a[4] = {bflo(r_a), bfhi(r_a), bflo(r_b), bfhi(r_b)}, k0a[4] = {bflo(k_a_), bfhi(k_a_), bflo(k_b_), bfhi(k_b_)}, v0a[4] = {bflo(v_a), bfhi(v_a), bflo(v_b), bfhi(v_b)};
                const float rpa[4] = {bflo(pr_a), bfhi(pr_a), bflo(pr_b), bfhi(pr_b)}, kpa[4] = {bflo(pk_a), bfhi(pk_a), bflo(pk_b), bfhi(pk_b)}, vpa[4] = {bflo(pv_a), bfhi(pv_a), bflo(pv_b), bfhi(pv_b)};
                const float mra[4] = {mr[q].x, mr[q].y, mr[q].z, mr[q].w}, mka[4] = {mk[q].x, mk[q].y, mk[q].z, mk[q].w}, mva[4] = {mv[q].x, mv[q].y, mv[q].z, mv[q].w};
                const float kka[4] = {kkw[q].x, kkw[q].y, kkw[q].z, kkw[q].w}, kaa[4] = {kaw[q].x, kaw[q].y, kaw[q].z, kaw[q].w}, rka[4] = {rkw[q].x, rkw[q].y, rkw[q].z, rkw[q].w};
                const float aaa[4] = {a4v[q].x, a4v[q].y, a4v[q].z, a4v[q].w}, lwa[4] = {l4v[q].x, l4v[q].y, l4v[q].z, l4v[q].w};
#pragma unroll
                for (int e = 0; e < 4; ++e) { const int i = 4 * q + e;
                    rr[i] = r0a[e] + (rpa[e] - r0a[e]) * mra[e]; const float kx = k0a[e] + (kpa[e] - k0a[e]) * mka[e]; vv[i] = v0a[e] + (vpa[e] - v0a[e]) * mva[e];
                    kkv[i] = kx * kka[e]; ss += kkv[i] * kkv[i]; aa[i] = aaa[e]; lwl[i] = lwa[e]; kf[i] = kx * (1.f + (aaa[e] - 1.f) * kaa[e]); scs += rr[i] * kf[i] * rka[e]; }
            }
        }
        {
            ss = sum4(ss); scs = sum4(scs);
            const float rn = rsqrtf(ss + 1e-6f);
            if (seg == 0) SC[(size_t)t * 16 + h] = scs;
            const int tq = r >> 4;
            unsigned wat[8], wbt[8], wkt[8], wrt[8], wvp[8];
            float atv[16], btv[16], ktv[16], rtv[16];
#pragma unroll
            for (int i = 0; i < 16; ++i) {
                const int ch = c0 + i;
                float off = 0.f;
#pragma unroll
                for (int q = 0; q < 3; ++q) off += (q < tq) ? TOT[q * 64 + ch] : 0.f;
                const float tot = TOT[ch] + TOT[64 + ch] + TOT[128 + ch] + TOT[192 + ch];
                const float cs = AAB[r * 64 + ch] + off;
                const float lwv = lwl[i];
                const float kk = kkv[i] * rn;
                const float e2 = __expf(-cs), e4 = __expf(tot - cs);
                atv[i] = kk * __expf(cs - lwv); btv[i] = -kk * aa[i] * e2; ktv[i] = kf[i] * e2; rtv[i] = rr[i] * __expf(cs);
                VT[ch * 72 + r] = f2bf(vv[i]);
                KDT[ch * 72 + r] = f2bf(kf[i] * e4);
                bdv[i] = -kk * aa[i] * e4;
                if (r == 63) RDSC[(size_t)item * 64 + ch] = __expf(tot);
            }
#pragma unroll
            for (int q = 0; q < 8; ++q) { wat[q] = pk2(atv[2 * q], atv[2 * q + 1]); wbt[q] = pk2(btv[2 * q], btv[2 * q + 1]); wkt[q] = pk2(ktv[2 * q], ktv[2 * q + 1]); wrt[q] = pk2(rtv[2 * q], rtv[2 * q + 1]); wvp[q] = pk2(vv[2 * q], vv[2 * q + 1]); }
            *(uint4*)(AT + r * 72 + c0) = make_uint4(wat[0], wat[1], wat[2], wat[3]); *(uint4*)(AT + r * 72 + c0 + 8) = make_uint4(wat[4], wat[5], wat[6], wat[7]);
            *(uint4*)(BTL + r * 72 + c0) = make_uint4(wbt[0], wbt[1], wbt[2], wbt[3]); *(uint4*)(BTL + r * 72 + c0 + 8) = make_uint4(wbt[4], wbt[5], wbt[6], wbt[7]);
            *(uint4*)(KT + r * 72 + c0) = make_uint4(wkt[0], wkt[1], wkt[2], wkt[3]); *(uint4*)(KT + r * 72 + c0 + 8) = make_uint4(wkt[4], wkt[5], wkt[6], wkt[7]);
            *(uint4*)(RT + r * 72 + c0) = make_uint4(wrt[0], wrt[1], wrt[2], wrt[3]); *(uint4*)(RT + r * 72 + c0 + 8) = make_uint4(wrt[4], wrt[5], wrt[6], wrt[7]);
            bf16* a2p = RA2 + (size_t)item * 64 * 64;
            *(uint4*)(a2p + frag_off(r, c0, 2)) = make_uint4(wrt[0], wrt[1], wrt[2], wrt[3]); *(uint4*)(a2p + frag_off(r, c0 + 8, 2)) = make_uint4(wrt[4], wrt[5], wrt[6], wrt[7]);
            bf16* vpp = VP + (size_t)t * 1024 + h * 64 + c0;
            *(uint4*)vpp = make_uint4(wvp[0], wvp[1], wvp[2], wvp[3]); *(uint4*)(vpp + 8) = make_uint4(wvp[4], wvp[5], wvp[6], wvp[7]);
        }
        __syncthreads();
        TSMARK(2);
        if (it0 + (int)gridDim.x * 2 < 4096) RCL_LOAD(item + (int)gridDim.x * 2, tv);
        {
            bf16* BDS = (bf16*)AAB;
#pragma unroll
            for (int i = 0; i < 16; ++i) BDS[(c0 + i) * 72 + r] = f2bf(bdv[i]);
        }
        const int fr = lane & 15, fq = lane >> 4;
        f32x4_t cab[4], cak[4], crb[4], crk[4];
        {
            const int j0t = w4 * 16;
            bf16x8_t bj[2], kj[2];
#pragma unroll
            for (int kb = 0; kb < 2; ++kb) { bj[kb] = *(const bf16x8_t*)(BTL + (j0t + fr) * 72 + kb * 32 + fq * 8); kj[kb] = *(const bf16x8_t*)(KT + (j0t + fr) * 72 + kb * 32 + fq * 8); }
#pragma unroll
            for (int it = 0; it < 4; ++it) {
                cab[it] = (f32x4_t){0.f, 0.f, 0.f, 0.f}; cak[it] = cab[it]; crb[it] = cab[it]; crk[it] = cab[it];
#pragma unroll
                for (int kb = 0; kb < 2; ++kb) {
                    const bf16x8_t ai = *(const bf16x8_t*)(AT + (it * 16 + fr) * 72 + kb * 32 + fq * 8);
                    const bf16x8_t ri = *(const bf16x8_t*)(RT + (it * 16 + fr) * 72 + kb * 32 + fq * 8);
                    cab[it] = MFMA16(bj[kb], ai, cab[it]); cak[it] = MFMA16(kj[kb], ai, cak[it]); crb[it] = MFMA16(bj[kb], ri, crb[it]); crk[it] = MFMA16(kj[kb], ri, crk[it]);
                }
            }
        }
        __syncthreads();
        {
            const bf16* BDS = (const bf16*)AAB; bf16* bp = RA4 + (size_t)item * 64 * 64;
#pragma unroll
            for (int q = 0; q < 2; ++q) { const int p = ht + 256 * q, pfr = p & 15, pfq = (p >> 4) & 3, pkb = (p >> 6) & 1, prt = p >> 7;
                *(uint4*)(bp + p * 8) = *(const uint4*)(BDS + (prt * 16 + pfr) * 72 + pkb * 32 + pfq * 8); }
        }
        __syncthreads();
        {
            const int j0 = w4 * 16 + 4 * fq;
#pragma unroll
            for (int it = 0; it < 4; ++it) {
                const int i = it * 16 + fr;
                float vab[4], vak[4], vrb[4], vrk[4];
#pragma unroll
                for (int rg = 0; rg < 4; ++rg) { const int j = j0 + rg; const bool st = i > j, in = i >= j;
                    vab[rg] = st ? cab[it][rg] : 0.f; vak[rg] = st ? cak[it][rg] : 0.f; vrb[rg] = in ? crb[it][rg] : 0.f; vrk[rg] = in ? crk[it][rg] : 0.f; }
                *(float4*)(AAB + i * 64 + j0) = make_float4(vab[0], vab[1], vab[2], vab[3]);
                uint2 w; w.x = pk2(vak[0], vak[1]); w.y = pk2(vak[2], vak[3]); *(uint2*)(AAK + i * 72 + j0) = w;
                w.x = pk2(vrk[0], vrk[1]); w.y = pk2(vrk[2], vrk[3]); *(uint2*)(ARK + i * 72 + j0) = w;
                w.x = pk2(vrb[0], vrb[1]); w.y = pk2(vrb[2], vrb[3]); *(uint2*)(RA3 + (size_t)item * 64 * 64 + frag_off(i, j0, 2)) = w;
            }
        }
        __syncthreads();
        f32x4_t cav[4], cov[4], ckv[4];
        {
            const int r0t = w4 * 16;
            bf16x8_t fa[2], fo[2], fk[2];
#pragma unroll
            for (int kb = 0; kb < 2; ++kb) { fa[kb] = *(const bf16x8_t*)(AAK + (r0t + fr) * 72 + kb * 32 + fq * 8); fo[kb] = *(const bf16x8_t*)(ARK + (r0t + fr) * 72 + kb * 32 + fq * 8); fk[kb] = *(const bf16x8_t*)(KDT + (r0t + fr) * 72 + kb * 32 + fq * 8); }
#pragma unroll
            for (int vt = 0; vt < 4; ++vt) {
                cav[vt] = (f32x4_t){0.f, 0.f, 0.f, 0.f}; cov[vt] = cav[vt]; ckv[vt] = cav[vt];
#pragma unroll
                for (int kb = 0; kb < 2; ++kb) { const bf16x8_t vb = *(const bf16x8_t*)(VT + (vt * 16 + fr) * 72 + kb * 32 + fq * 8);
                    cav[vt] = MFMA16(fa[kb], vb, cav[vt]); cov[vt] = MFMA16(fo[kb], vb, cov[vt]); ckv[vt] = MFMA16(fk[kb], vb, ckv[vt]); }
            }
        }
        __syncthreads();
        {
            const int r0 = w4 * 16 + 4 * fq;
#pragma unroll
            for (int vt = 0; vt < 4; ++vt) {
                const int v = vt * 16 + fr;
#pragma unroll
                for (int rg = 0; rg < 4; ++rg) RHS2[v * 65 + r0 + rg] = cav[vt][rg];
                { uint2 w; w.x = pk2(cov[vt][0], cov[vt][1]); w.y = pk2(cov[vt][2], cov[vt][3]); *(uint2*)(RO0 + (size_t)item * 64 * 64 + cfrag_off(v, r0, 4)) = w; }
                { uint2 w; w.x = pk2(ckv[vt][0], ckv[vt][1]); w.y = pk2(ckv[vt][2], ckv[vt][3]); *(uint2*)(RS0 + (size_t)item * 64 * 64 + cfrag_off(v, r0, 4)) = w; }
            }
        }
        __syncthreads();
        TSMARK(3);
        {
            const int col = ht >> 1, p = ht & 1, cc = col & 63; const bool isu = col >= 64;
            float xs[32];
#pragma unroll
            for (int i = 0; i < 32; ++i) xs[i] = 0.f;
            float4 mc[8], mn[8];
#pragma unroll
            for (int q = 0; q < 8; ++q) { mc[q] = make_float4(0.f, 0.f, 0.f, 0.f); mn[q] = mc[q]; }
            float rhs_n; { const float rv = RHS2[(isu ? cc : 0) * 65], av = bf2f(AT[(isu ? 0 : cc)]); rhs_n = isu ? rv : av; }
#pragma unroll
            for (int i = 0; i < 64; ++i) {
                const float rhs = rhs_n;
                if (i + 1 < 64) {
#pragma unroll
                    for (int q = 0; q < (i + 8) / 8; ++q) mn[q] = *(const float4*)(AAB + (i + 1) * 64 + 8 * q + 4 * p);
                    const float rv = RHS2[(isu ? cc : 0) * 65 + i + 1], av = bf2f(AT[(i + 1) * 72 + (isu ? 0 : cc)]); rhs_n = isu ? rv : av;
                }
                float a0 = 0.f, a1 = 0.f, a2 = 0.f, a3 = 0.f;
#pragma unroll
                for (int q = 0; q < (i + 7) / 8; ++q) { a0 += mc[q].x * xs[4 * q]; a1 += mc[q].y * xs[4 * q + 1]; a2 += mc[q].z * xs[4 * q + 2]; a3 += mc[q].w * xs[4 * q + 3]; }
                float tot = (a0 + a1) + (a2 + a3);
                tot += dpp_xor1(tot);
                const float xi = rhs + tot;
                const int g = i >> 2, slot = (g >> 1) * 4 + (i & 3);
                xs[slot] = (p == (g & 1)) ? xi : xs[slot];
#pragma unroll
                for (int q = 0; q < 8; ++q) mc[q] = mn[q];
                asm volatile("" ::: "memory");
            }
            if (isu) {
                bf16* up = RX0 + (size_t)item * 64 * 64;
#pragma unroll
                for (int q = 0; q < 8; ++q) { uint2 w; w.x = pk2(xs[4 * q], xs[4 * q + 1]); w.y = pk2(xs[4 * q + 2], xs[4 * q + 3]); *(uint2*)(up + cfrag_off(cc, 4 * (2 * q + p), 4)) = w; }
            }
            __syncthreads();
            TSMARK(4);
            if (!isu) {
#pragma unroll
                for (int q = 0; q < 8; ++q)
#pragma unroll
                    for (int e = 0; e < 4; ++e) AT[(4 * (2 * q + p) + e) * 72 + cc] = f2bf(xs[4 * q + e]);
            }
        }
        __syncthreads();
        {
            bf16* wp = RA1 + (size_t)item * 64 * 64;
#pragma unroll
            for (int q = 0; q < 2; ++q) { const int p = ht + 256 * q, fr = p & 15, fq = (p >> 4) & 3, kb = (p >> 6) & 1, rt = p >> 7;
                *(uint4*)(wp + p * 8) = *(const uint4*)(AT + (rt * 16 + fr) * 72 + kb * 32 + fq * 8); }
        }
    }
    if (TS_BEGIN >= 0 && blockIdx.x == 0 && c.tid == 0) c.ws<unsigned>(WS_CTL)[CW_TS] = (unsigned)ts_acc;
#undef TSMARK
#undef RCL_LOAD
}

template <int DK, bool RW>
struct ScanArgs { const bf16* A1; const bf16* X0; const bf16* A2; const bf16* A3; const bf16* O0; const bf16* A4; const bf16* S0; const float* DSC; bf16* OUT; int item0; int vs; int tok0; int ocol0; };
#define LBAR() do { asm volatile("s_waitcnt lgkmcnt(0)" ::: "memory"); __builtin_amdgcn_s_barrier(); asm volatile("" ::: "memory"); } while (0)
template <int DK, bool RW>
__device__ __forceinline__ void scan_run(const Ctx& c, const ScanArgs<DK, RW>& a) {
    constexpr int KB = DK / 32;
    constexpr int NST = DK / 64;
    constexpr int NV = RW ? 64 : 128;
    constexpr int SROW = DK + 8;
    bf16* ST = (bf16*)c.lds;
    bf16* XT = ST + 2 * 32 * SROW;
    const int lane = c.lane, w = c.wave, fr = lane & 15, fq = lane >> 4;
    const int tm = w >> 1, tn = w & 1;
    const int dkt = (NST == 2) ? w : (w >> 1);
    for (int i = c.tid; i < 32 * SROW / 2; i += NTHREADS) ((unsigned*)ST)[i] = 0u;
    f32x4_t accS[NST];
#pragma unroll
    for (int s = 0; s < NST; ++s) accS[s] = (f32x4_t){0.f, 0.f, 0.f, 0.f};
    bf16x8_t a1f[KB], a2f[KB], a3f[2], a4f[2]; f32x4_t x0v, o0v, s0v[NST], dscv;
#define SCAN_LOAD(IT) do { const size_t it_ = (size_t)(IT); \
        _Pragma("unroll") for (int kb = 0; kb < KB; ++kb) { a1f[kb] = *(const bf16x8_t*)(a.A1 + it_ * 64 * DK + ((tm * KB + kb) * 64 + lane) * 8); a2f[kb] = *(const bf16x8_t*)(a.A2 + it_ * 64 * DK + ((tm * KB + kb) * 64 + lane) * 8); } \
        _Pragma("unroll") for (int kb = 0; kb < 2; ++kb) { a3f[kb] = *(const bf16x8_t*)(a.A3 + it_ * 64 * 64 + ((tm * 2 + kb) * 64 + lane) * 8); a4f[kb] = *(const bf16x8_t*)(a.A4 + it_ * DK * 64 + ((dkt * 2 + kb) * 64 + lane) * 8); } \
        { const uint2 q_ = *(const uint2*)(a.X0 + it_ * NV * 64 + (((a.vs * 2 + tn) * 4 + tm) * 64 + lane) * 4); x0v = (f32x4_t){bflo(q_.x), bfhi(q_.x), bflo(q_.y), bfhi(q_.y)}; } \
        if (RW) { { const uint2 q_ = *(const uint2*)(a.O0 + it_ * NV * 64 + (((a.vs * 2 + tn) * 4 + tm) * 64 + lane) * 4); o0v = (f32x4_t){bflo(q_.x), bfhi(q_.x), bflo(q_.y), bfhi(q_.y)}; } \
                  _Pragma("unroll") for (int s = 0; s < NST; ++s) { const uint2 q_ = *(const uint2*)(a.S0 + it_ * 64 * DK + (((a.vs * 2 + (NST == 2 ? s : tn)) * (DK / 16) + dkt) * 64 + lane) * 4); s0v[s] = (f32x4_t){bflo(q_.x), bfhi(q_.x), bflo(q_.y), bfhi(q_.y)}; } \
                  dscv = *(const f32x4_t*)(a.DSC + it_ * DK + dkt * 16 + 4 * fq); } \
        else { const float g_ = a.DSC[it_]; dscv = (f32x4_t){g_, g_, g_, g_}; o0v = (f32x4_t){0.f, 0.f, 0.f, 0.f}; _Pragma("unroll") for (int s = 0; s < NST; ++s) s0v[s] = (f32x4_t){0.f, 0.f, 0.f, 0.f}; } \
    } while (0)
    SCAN_LOAD(a.item0);
    int cur = 0;
    for (int n = 0; n < 64; ++n) {
        bf16x8_t b1[KB], b2[KB], b3[2], b4[2];
#pragma unroll
        for (int kb = 0; kb < KB; ++kb) { b1[kb] = a1f[kb]; b2[kb] = a2f[kb]; }
        b3[0] = a3f[0]; b3[1] = a3f[1]; b4[0] = a4f[0]; b4[1] = a4f[1];
        f32x4_t accX = x0v, accO = o0v; const f32x4_t dv = dscv; f32x4_t sv[NST];
#pragma unroll
        for (int s = 0; s < NST; ++s) sv[s] = s0v[s];
        if (n + 1 < 64) SCAN_LOAD(a.item0 + n + 1);
        LBAR();
        const bf16* Sc = ST + cur * 32 * SROW; bf16* Sn = ST + (cur ^ 1) * 32 * SROW;
        bf16x8_t sf[KB];
#pragma unroll
        for (int kb = 0; kb < KB; ++kb) sf[kb] = *(const bf16x8_t*)(Sc + (tn * 16 + fr) * SROW + kb * 32 + fq * 8);
#pragma unroll
        for (int kb = 0; kb < KB; ++kb) accX = MFMA16(b1[kb], sf[kb], accX);
        { uint2 wv; wv.x = pk2(accX[0], accX[1]); wv.y = pk2(accX[2], accX[3]); *(uint2*)(XT + (tn * 16 + fr) * 72 + tm * 16 + 4 * fq) = wv; }
#pragma unroll
        for (int kb = 0; kb < KB; ++kb) accO = MFMA16(b2[kb], sf[kb], accO);
        LBAR();
        bf16x8_t xf[2];
#pragma unroll
        for (int kb = 0; kb < 2; ++kb) xf[kb] = *(const bf16x8_t*)(XT + (tn * 16 + fr) * 72 + kb * 32 + fq * 8);
        accO = MFMA16(b3[0], xf[0], accO); accO = MFMA16(b3[1], xf[1], accO);
        {
            bf16* op = a.OUT + (size_t)(a.tok0 + n * 64 + tm * 16 + 4 * fq) * 1024 + a.ocol0 + tn * 16 + fr;
            op[0] = f2bf(accO[0]); op[1024] = f2bf(accO[1]); op[2048] = f2bf(accO[2]); op[3072] = f2bf(accO[3]);
        }
#pragma unroll
        for (int s = 0; s < NST; ++s) {
            const int vt = (NST == 2) ? s : tn;
            bf16x8_t xg[2];
            if (vt == tn) { xg[0] = xf[0]; xg[1] = xf[1]; }
            else {
#pragma unroll
                for (int kb = 0; kb < 2; ++kb) xg[kb] = *(const bf16x8_t*)(XT + (vt * 16 + fr) * 72 + kb * 32 + fq * 8);
            }
            f32x4_t t = accS[s] * dv + sv[s];
            t = MFMA16(b4[0], xg[0], t); t = MFMA16(b4[1], xg[1], t);
            accS[s] = t;
            uint2 wv; wv.x = pk2(t[0], t[1]); wv.y = pk2(t[2], t[3]);
            *(uint2*)(Sn + (vt * 16 + fr) * SROW + dkt * 16 + 4 * fq) = wv;
        }
        cur ^= 1;
    }
#undef SCAN_LOAD
    __syncthreads();
}

__device__ __forceinline__ void ph_scan(const Ctx& c) {
    for (int wk = blockIdx.x; wk < 256; wk += gridDim.x) {
        const int xcd = wk & 7, j = wk >> 3;
        if (j < 16) {
            const int pair = xcd * 4 + (j >> 2), vs = j & 3, b = pair >> 3, h = pair & 7;
            ScanArgs<128, false> a{c.ws<bf16>(WS_GA1), c.ws<bf16>(WS_GX0), c.ws<bf16>(WS_GA2), c.ws<bf16>(WS_GA3), nullptr, c.ws<bf16>(WS_GA4), nullptr, c.ws<float>(WS_GGL),
                                   c.ws<bf16>(WS_OG), pair * 64, vs, b * SEQ, h * 128 + vs * 32};
            scan_run<128, false>(c, a);
        } else {
            const int pair = xcd * 8 + ((j - 16) >> 1), vs = (j - 16) & 1, b = pair >> 4, h = pair & 15;
            ScanArgs<64, true> a{c.ws<bf16>(WS_RA1), c.ws<bf16>(WS_RX0), c.ws<bf16>(WS_RA2), c.ws<bf16>(WS_RA3), c.ws<bf16>(WS_RO0), c.ws<bf16>(WS_RA4), c.ws<bf16>(WS_RS0), c.ws<float>(WS_RDSC),
                                 c.ws<bf16>(WS_ORW), pair * 64, vs, b * SEQ, h * 64 + vs * 32};
            scan_run<64, true>(c, a);
        }
    }
}

enum { PH_RMS0 = 0, PH_INPROJ, PH_GCL, PH_LORA, PH_RCL, PH_SCAN, PH_POST, PH_G2, PH_X1, PH_ROUTER, PH_DISPATCH, PH_MOE1, PH_MOE2, PH_COMBINE, PH_COUNT };

template <unsigned PHMASK>
__global__ void __launch_bounds__(NTHREADS) mk(Params P) {
    extern __shared__ __attribute__((aligned(16))) unsigned char lds[];
    volatile LAS unsigned* misc = (volatile LAS unsigned*)((LAS unsigned char*)lds + MISC_OFF);
    if (threadIdx.x < 64) misc[threadIdx.x] = 0u;
    __syncthreads();
    unsigned* ctl = (unsigned*)(P.ws + WS_CTL);
    XcdBarrier bar = xcd_barrier_post(ctl + CW_BAR + P.li * XCD_BAR_WORDS, misc);
#define MKCTX() int tv_ = threadIdx.x; asm volatile("" : "+v"(tv_)); const int wv_ = __builtin_amdgcn_readfirstlane(tv_ >> 6); \
    Ctx c{P, tv_, tv_ & 63, wv_, (int)(blockIdx.x * NWAVES + wv_), (int)(gridDim.x * NWAVES), (size_t)blockIdx.x * NTHREADS + tv_, (size_t)gridDim.x * NTHREADS, lds}
    bool first_seam = true;
#define IN(k) (((PHMASK >> (k)) & 1u) && P.ph_lo <= (k) && (k) < P.ph_hi)
#define SEAM(k) do { if ((k) + 1 < P.ph_hi) { xcd_barrier(bar); first_seam = false; } } while (0)
#define REP(k) for (int rep_ = 0; rep_ < ((k) == PROBE_REP ? 2 : 1); ++rep_)
    if (IN(PH_RMS0)) { MKCTX();
        REP(PH_RMS0) {
        ph_rms0(c);
        { WJob j{P.in[I_W_IN], NCOL_IN, 1024, 4096, c.ws<bf16>(WS_WIN_T), 1024, 1, 0, 0}; wconv_job(c, j); }
        { WJob j{P.in[I_W_IN] + 4112, NCOL_IN, 1024, 5376, c.ws<bf16>(WS_WIN_T) + (size_t)4096 * 1024, 1024, 1, 0, 0}; wconv_job(c, j); }
        lora_zero(c);
        { WJob j{P.in[I_W2], 1024, 64, 1024, c.ws<bf16>(WS_LORA_T), 256, 1, 0, 0}; wconv_job(c, j); }
        { WJob j{P.in[I_A2], 1024, 64, 1024, c.ws<bf16>(WS_LORA_T) + (size_t)1024 * 256 + 64, 256, 1, 0, 0}; wconv_job(c, j); }
        { WJob j{P.in[I_G2], 1024, 128, 1024, c.ws<bf16>(WS_LORA_T) + (size_t)2048 * 256 + 128, 256, 1, 0, 0}; wconv_job(c, j); }
        }
        SEAM(PH_RMS0);
    }
    if (IN(PH_INPROJ)) { MKCTX();
        REP(PH_INPROJ) {
        EpiInProj ep{c.ws<bf16>(WS_GQKV), c.ws<bf16>(WS_ZS), c.ws<bf16>(WS_RKV), c.ws<float>(WS_LIN), c.ws<bf16>(WS_GATES)};
        SchedInProj sc{(const char*)c.ws<bf16>(WS_HB), (const char*)c.ws<bf16>(WS_WIN_T), (int)gridDim.x, (int)blockIdx.x};
        pg8::gemm_phase((LAS unsigned char*)lds, 1024, sc, ep, c.tid);
        }
        SEAM(PH_INPROJ);
    }
    if (IN(PH_GCL)) { MKCTX(); REP(PH_GCL) { ph_gcl(c); ph_loraprep(c); } SEAM(PH_GCL); }
    if (IN(PH_LORA)) { MKCTX();
        REP(PH_LORA) {
        EpiLora ep{P.in[I_W0], P.in[I_A0], c.ws<float>(WS_LW), c.ws<float>(WS_AA), c.ws<bf16>(WS_GGR)};
        SchedLora sc{(const char*)c.ws<bf16>(WS_ALORA), (const char*)c.ws<bf16>(WS_LORA_T), (int)gridDim.x, (int)blockIdx.x};
        pg8::gemm_phase((LAS unsigned char*)lds, 256, sc, ep, c.tid);
        }
        SEAM(PH_LORA);
    }
    if (IN(PH_RCL)) { MKCTX(); REP(PH_RCL) { ph_rcl(c); } SEAM(PH_RCL); }
    if (IN(PH_SCAN)) { MKCTX(); REP(PH_SCAN) { ph_scan(c); } SEAM(PH_SCAN); }
    if (IN(PH_POST)) { MKCTX();
        REP(PH_POST) {
        ph_post(c);
        { WJob j{P.in[I_PROJ_A], 1024, 1024, 1024, c.ws<bf16>(WS_PROJ_T), 1024, 1, 0, 0}; wconv_job(c, j); }
        { WJob j{P.in[I_PROJ_B], 1024, 1024, 1024, c.ws<bf16>(WS_PROJ_T) + (size_t)1024 * 1024, 1024, 1, 0, 0}; wconv_job(c, j); }
        { WJob j{P.in[I_W_OUT], 1024, 1024, 1024, c.ws<bf16>(WS_WOUT_T), 1024, 1, 0, 0}; wconv_job(c, j); }
        }
        SEAM(PH_POST);
    }
    if (IN(PH_G2)) { MKCTX();
        REP(PH_G2) {
        EpiG2 ep{c.ws<bf16>(WS_GATES), c.ws<bf16>(WS_G2)};
        SchedG2 sc{(const char*)c.ws<bf16>(WS_YA), (const char*)c.ws<bf16>(WS_PROJ_T), (int)gridDim.x, (int)blockIdx.x};
        pg8::gemm_phase((LAS unsigned char*)lds, 1024, sc, ep, c.tid);
        }
        SEAM(PH_G2);
    }
    if (IN(PH_X1)) { MKCTX();
        REP(PH_X1) {
        EpiX1 ep{P.in[I_X], c.ws<float>(WS_X1)};
        SchedX1 sc{(const char*)c.ws<bf16>(WS_G2), (const char*)c.ws<bf16>(WS_WOUT_T), (int)gridDim.x, (int)blockIdx.x};
        pg8::gemm_phase((LAS unsigned char*)lds, 1024, sc, ep, c.tid);
        }
        SEAM(PH_X1);
    }
    if (IN(PH_ROUTER)) { MKCTX();
        ph_router(c);
        REP(PH_ROUTER) {
        { WJob j{P.in[I_W_GU], 2048, 1024, 2048, c.ws<bf16>(WS_WGU_T), 1024, 32, (size_t)1024 * 2048, (size_t)2048 * 1024}; wconv_job(c, j); }
        { WJob j{P.in[I_W_DOWN], 1024, 1024, 1024, c.ws<bf16>(WS_WDN_T), 1024, 32, (size_t)1024 * 1024, (size_t)1024 * 1024}; wconv_job(c, j); }
        }
        SEAM(PH_ROUTER);
    }
    if (IN(PH_DISPATCH)) { MKCTX(); REP(PH_DISPATCH) { ph_dispatch(c); } SEAM(PH_DISPATCH); }
    if (IN(PH_MOE1)) { MKCTX();
        REP(PH_MOE1) {
        const int nt = *c.ws<int>(WS_NT);
        EpiAct ep{P.in[I_B_GU], c.ws<bf16>(WS_ACT)};
        SchedMoe sc{(const char*)c.ws<bf16>(WS_H2), (const char*)c.ws<bf16>(WS_WGU_T), c.ws<int>(WS_TILE_E), c.ws<int>(WS_SLOT_TOK), nt, 8, (int)gridDim.x, (int)blockIdx.x};
        pg8::gemm_phase_t<true>((LAS unsigned char*)lds, 1024, sc, ep, c.tid);
        }
        SEAM(PH_MOE1);
    }
    if (IN(PH_MOE2)) { MKCTX();
        REP(PH_MOE2) {
        const int nt = *c.ws<int>(WS_NT);
        EpiYS ep{P.in[I_B_DOWN], c.ws<float>(WS_SGATE), c.ws<bf16>(WS_YS)};
        SchedMoe sc{(const char*)c.ws<bf16>(WS_ACT), (const char*)c.ws<bf16>(WS_WDN_T), c.ws<int>(WS_TILE_E), nullptr, nt, 4, (int)gridDim.x, (int)blockIdx.x};
        pg8::gemm_phase((LAS unsigned char*)lds, 1024, sc, ep, c.tid);
        }
        SEAM(PH_MOE2);
    }
    if (IN(PH_COMBINE)) { MKCTX(); REP(PH_COMBINE) { ph_combine(c); } }
#undef IN
#undef SEAM
#undef REP
#undef MKCTX
}

template <unsigned M> static void launch_one(const Params& p, int grid, hipStream_t stream) {
    static bool attr = false;
    if (!attr) { (void)hipFuncSetAttribute((const void*)mk<M>, hipFuncAttributeMaxDynamicSharedMemorySize, LDS_BYTES); attr = true; }
    hipLaunchKernelGGL(mk<M>, dim3(grid), dim3(NTHREADS), LDS_BYTES, stream, p);
}
template <int PH> static void launch_chain(Params& p, int grid, hipStream_t stream) {
    if constexpr (PH < PH_COUNT) { p.ph_lo = PH; p.ph_hi = PH + 1; p.li = 0; p.coop = 0; launch_one<(1u << PH)>(p, grid, stream); launch_chain<PH + 1>(p, grid, stream); }
}

extern "C" void kernel_launch(void* const* d_in, const int* in_sizes, int n_in, void* d_out, int out_size, void* d_ws, size_t ws_size, hipStream_t stream) {
    static int grid = 0;
    if (grid == 0) {
        int dev = 0, cus = 0, per_cu = 0;
        (void)hipGetDevice(&dev);
        (void)hipDeviceGetAttribute(&cus, hipDeviceAttributeMultiprocessorCount, dev);
#if MK_ONE_LAUNCH
        (void)hipFuncSetAttribute((const void*)mk<0xffffffffu>, hipFuncAttributeMaxDynamicSharedMemorySize, LDS_BYTES);
        (void)hipOccupancyMaxActiveBlocksPerMultiprocessor(&per_cu, (const void*)mk<0xffffffffu>, NTHREADS, LDS_BYTES);
#else
        per_cu = 1;
#endif
        if (n_in != 29 || ws_size < WS_END || per_cu < 1 || cus < 64) { fprintf(stderr, "kernel_launch: unexpected setup n_in %d ws %zu per_cu %d cus %d\n", n_in, ws_size, per_cu, cus); grid = -1; return; }
        grid = cus;
    }
    if (grid < 0) return;
    (void)hipMemsetAsync((char*)d_ws + WS_CTL, 0, CTL_BYTES, stream);
    Params p{};
    for (int i = 0; i < 29; ++i) p.in[i] = (const float*)d_in[i];
    p.out = (float*)d_out; p.ws = (unsigned char*)d_ws;
#if MK_ONE_LAUNCH
    p.ph_lo = 0; p.ph_hi = PH_COUNT; p.li = 0; p.coop = 1;
    void* args[] = {&p};
    hipError_t e = hipLaunchCooperativeKernel((const void*)mk<0xffffffffu>, dim3(grid), dim3(NTHREADS), args, LDS_BYTES, stream);
    if (e != hipSuccess) fprintf(stderr, "cooperative launch failed: %s (grid %d)\n", hipGetErrorString(e), grid);
#else
    launch_chain<0>(p, grid, stream);
#endif
}
```

```cpp
#include <hip/hip_runtime.h>
#include <hip/hip_cooperative_groups.h>
#include <cstdint>
#include <cstdio>
namespace cg = cooperative_groups;

#ifndef MK_ONE_LAUNCH
#define MK_ONE_LAUNCH 1
#endif

#define LAS __attribute__((address_space(3)))
#ifndef FAST_INPROJ
#define FAST_INPROJ 1
#endif
#ifndef FAST_MIX
#define FAST_MIX 1
#endif
#define TS_BEGIN -1
#define TS_END -1
#define PROBE_REP -1
constexpr int NTHREADS = 512;
constexpr int NWAVES = 8;
constexpr int LDS_BYTES = 155648;
constexpr int MISC_OFF = 153600;

constexpr int T = 16384, SEQ = 4096, D = 1024;
constexpr int NCOL_IN = 9488;
constexpr int NEXP = 32;
constexpr int MAXTILES = 288;
constexpr int MAXSLOTS = MAXTILES * 256;

enum { I_X = 0, I_NORM_MIX, I_W_IN, I_GDN_CONV, I_GDN_ALOG, I_GDN_DTB, I_GDN_NORM, I_MU, I_W0, I_W2, I_A0, I_A2, I_G2, I_KK, I_KA, I_RK,
       I_LNW, I_LNB, I_PROJ_A, I_PROJ_B, I_W_OUT, I_NORM_FFN, I_ROUTER_W, I_ROUTER_B, I_W_GU, I_B_GU, I_W_DOWN, I_B_DOWN, I_NORM_FINAL };

constexpr size_t MiB = 1u << 20;
constexpr size_t WS_CTL = 0, CTL_BYTES = 65536;
constexpr size_t WS_BETA = 1 * MiB;
constexpr size_t WS_GG = WS_BETA + 512 * 1024;
constexpr size_t WS_SC = 2 * MiB;
constexpr size_t WS_TE = 3 * MiB;
constexpr size_t WS_TG = WS_TE + 256 * 1024;
constexpr size_t WS_TP = WS_TG + 256 * 1024;
constexpr size_t WS_TSLOT = WS_TP + 256 * 1024;
constexpr size_t WS_SGATE = 4 * MiB;
constexpr size_t WS_SLOT_TOK = 4 * MiB + 512 * 1024;
constexpr size_t WS_TILE_E = 5 * MiB;
constexpr size_t WS_NT = WS_TILE_E + 4096;
constexpr size_t WS_HB = 8 * MiB;
constexpr size_t WS_H2 = WS_HB;
constexpr size_t WS_ZS = 40 * MiB;
constexpr size_t WS_GATES = 72 * MiB;
constexpr size_t WS_ALORA = 136 * MiB;
constexpr size_t WS_LW = 144 * MiB;
constexpr size_t WS_AA = 208 * MiB;
constexpr size_t WS_GGR = 272 * MiB;
constexpr size_t WS_VP = 304 * MiB;
constexpr size_t WS_Q = 336 * MiB;
constexpr size_t WS_QKVC = WS_Q;
constexpr size_t WS_RP = WS_Q, WS_KF = WS_Q + 64 * MiB, WS_KKN = WS_Q + 128 * MiB;
constexpr size_t WS_YA = WS_Q, WS_YB = WS_Q + 32 * MiB, WS_G2 = WS_Q + 64 * MiB, WS_X1 = WS_Q + 128 * MiB;
constexpr size_t WS_GQKV = 528 * MiB;
constexpr size_t WS_OG = 720 * MiB, WS_ORW = 784 * MiB;
constexpr size_t WS_RKV = 720 * MiB;
constexpr size_t WS_LIN = 912 * MiB;
constexpr size_t WS_DEC = 928 * MiB;
constexpr size_t WS_XB = 528 * MiB;
constexpr size_t WS_ACT = 672 * MiB;
constexpr size_t WS_YS = 816 * MiB;
constexpr size_t WS_WIN_T = 992 * MiB;
constexpr size_t WS_PROJ_T = 144 * MiB;
constexpr size_t WS_WOUT_T = 148 * MiB;
constexpr size_t WS_WGU_T = 72 * MiB;
constexpr size_t WS_WDN_T = 200 * MiB;
constexpr size_t WS_GA1 = 336 * MiB, WS_GX0 = 368 * MiB, WS_GA2 = 432 * MiB, WS_GA3 = 464 * MiB, WS_GA4 = 480 * MiB;
constexpr size_t WS_GGL = 6 * MiB;
constexpr size_t WS_RX0 = 528 * MiB, WS_RO0 = 592 * MiB, WS_RS0 = 656 * MiB;
constexpr size_t WS_RA1 = 8 * MiB, WS_RA2 = 928 * MiB, WS_RA3 = 960 * MiB, WS_RA4 = 992 * MiB;
constexpr size_t WS_RDSC = 7 * MiB;
constexpr size_t WS_LORA_T = 1012 * MiB;
constexpr size_t WS_END = 1024 * MiB;
constexpr int CW_BAR = 1024;
constexpr int CW_CNT = 256;
constexpr int CW_TS = 900;

#define XB_TMO      128
#define XB_XCNT(j)  (256  + 64 * (j))
#define XB_XSUB(j)  (1280 + 64 * (j))
#define XB_XGEN(j)  (2304 + 64 * (j))
#define XB_TOP      3328
#define XB_TOPGEN   3392
#define XCD_BAR_WORDS 3456
#define XB_SPIN_CAP (1u << 24)
__device__ __forceinline__ unsigned xb_ld(unsigned* p)              { return __hip_atomic_load(p, __ATOMIC_RELAXED, __HIP_MEMORY_SCOPE_AGENT); }
__device__ __forceinline__ unsigned xb_add(unsigned* p, unsigned v) { return __hip_atomic_fetch_add(p, v, __ATOMIC_RELAXED, __HIP_MEMORY_SCOPE_AGENT); }
__device__ __forceinline__ unsigned xb_xcc_id() { return (unsigned)__builtin_amdgcn_s_getreg((3 << 11) | 20) & 0xFu; }
#define XB_SPIN(cond, bar) do { unsigned _sp = 0; while (cond) { __builtin_amdgcn_s_sleep(1); \
    if ((++_sp & 255u) == 0u) { if (xb_ld(&(bar)[XB_TMO])) break; if (_sp > XB_SPIN_CAP) { atomicAdd(&(bar)[XB_TMO], 1u); break; } } } } while (0)
struct XcdBarrier { unsigned* bar; unsigned x; volatile LAS unsigned* st; };
__device__ __forceinline__ XcdBarrier xcd_barrier_post(unsigned* bar, volatile LAS unsigned* st) {
    XcdBarrier b; b.bar = bar; b.x = xb_xcc_id(); b.st = st;
    if (threadIdx.x == 0) (void)xb_add(&bar[XB_XCNT(b.x)], 1u);
    return b;
}
__device__ __forceinline__ void xcd_barrier_complete(unsigned* bar, unsigned x, unsigned& nloc, unsigned& nx) {
    const unsigned G = gridDim.x * gridDim.y * gridDim.z;
    unsigned sum, cnt, mine, sp = 0u;
    for (;;) {
        sum = 0u; cnt = 0u; mine = 0u;
#pragma unroll
        for (unsigned j = 0; j < 16; ++j) { const unsigned c = xb_ld(&bar[XB_XCNT(j)]); sum += c; cnt += (c > 0u) ? 1u : 0u; mine = (j == x) ? c : mine; }
        if (sum == G) break;
        __builtin_amdgcn_s_sleep(1);
        if ((++sp & 255u) == 0u) { if (xb_ld(&bar[XB_TMO])) break; if (sp > XB_SPIN_CAP) { atomicAdd(&bar[XB_TMO], 1u); break; } }
    }
    nloc = mine > 0u ? mine : 1u; nx = cnt > 0u ? cnt : 1u;
}
__device__ __forceinline__ void xcd_barrier(const XcdBarrier& b) {
    asm volatile("s_waitcnt vmcnt(0)" ::: "memory");
    __syncthreads();
    if (threadIdx.x == 0) {
        unsigned* bar = b.bar;
        __builtin_amdgcn_s_waitcnt(0);
        unsigned nloc = b.st[0], nx = b.st[1];
        if (nloc == 0u) { xcd_barrier_complete(bar, b.x, nloc, nx); b.st[0] = nloc; b.st[1] = nx; }
        const unsigned old = xb_add(&bar[XB_XSUB(b.x)], 1u);
        const unsigned gen = old / nloc;
        if (old + 1u == (gen + 1u) * nloc) {
            __builtin_amdgcn_fence(__ATOMIC_RELEASE, "agent");
            asm volatile("s_waitcnt vmcnt(0)" ::: "memory");
            const unsigned og = xb_add(&bar[XB_TOP], 1u);
            const unsigned tg = og / nx;
            if (og + 1u == (tg + 1u) * nx) xb_add(&bar[XB_TOPGEN], 1u);
            else XB_SPIN(xb_ld(&bar[XB_TOPGEN]) == tg, bar);
            __builtin_amdgcn_fence(__ATOMIC_ACQUIRE, "agent");
            xb_add(&bar[XB_XGEN(b.x)], 1u);
            asm volatile("s_waitcnt vmcnt(0)" ::: "memory");
        } else {
            XB_SPIN(xb_ld(&bar[XB_XGEN(b.x)]) == gen, bar);
            __builtin_amdgcn_fence(__ATOMIC_ACQUIRE, "agent");
            asm volatile("s_waitcnt vmcnt(0)" ::: "memory");
        }
    }
    __syncthreads();
}

typedef unsigned short bf16;
typedef __bf16 bf16x2_t __attribute__((ext_vector_type(2)));
__device__ __forceinline__ bf16 f2bf(float f) { return __builtin_bit_cast(unsigned short, (__bf16)f); }
__device__ __forceinline__ float bf2f(unsigned b) { return __uint_as_float(b << 16); }
__device__ __forceinline__ unsigned pk2(float lo, float hi) { bf16x2_t v; v[0] = (__bf16)lo; v[1] = (__bf16)hi; return __builtin_bit_cast(unsigned, v); }
__device__ __forceinline__ float bflo(unsigned w) { return __uint_as_float(w << 16); }
__device__ __forceinline__ float bfhi(unsigned w) { return __uint_as_float(w & 0xffff0000u); }
__device__ __forceinline__ float sigm(float x) { return 1.f / (1.f + expf(-x)); }
__device__ __forceinline__ float fsigm(float x) { return __builtin_amdgcn_rcpf(1.f + __expf(-x)); }
__device__ __forceinline__ float softplusf(float x) { return x > 20.f ? x : log1pf(expf(x)); }
__device__ __forceinline__ float dpp_xor1(float v) { return __int_as_float(__builtin_amdgcn_update_dpp(0, __float_as_int(v), 0xB1, 0xF, 0xF, false)); }
template <int CTRL, int ROWMASK>
__device__ __forceinline__ float dpp_add(float v) { return v + __int_as_float(__builtin_amdgcn_update_dpp(0, __float_as_int(v), CTRL, ROWMASK, 0xF, false)); }
__device__ __forceinline__ float sum4(float v)  { v = dpp_add<0xB1, 0xF>(v); return dpp_add<0x4E, 0xF>(v); }
__device__ __forceinline__ float sum8(float v)  { return dpp_add<0x141, 0xF>(sum4(v)); }
__device__ __forceinline__ float sum16(float v) { return dpp_add<0x140, 0xF>(sum8(v)); }
__device__ __forceinline__ float wsum(float v) {
    v = sum16(v);
    v = dpp_add<0x142, 0xA>(v);
    v = dpp_add<0x143, 0xC>(v);
    return __int_as_float(__builtin_amdgcn_readlane(__float_as_int(v), 63));
}

struct Params { const float* in[29]; float* out; unsigned char* ws; int ph_lo, ph_hi, li, coop; };

struct Ctx {
    const Params& P; int tid, lane, wave, gwave, nwaves; size_t gtid, nthreads; unsigned char* lds;
    template <class Tp> __device__ __forceinline__ Tp* ws(size_t off) const { return (Tp*)(P.ws + off); }
};

__device__ __forceinline__ void ph_rms0(const Ctx& c) {
    const float* x = c.P.in[I_X]; const float* nw = c.P.in[I_NORM_MIX]; const float* win = c.P.in[I_W_IN];
    const float* alog = c.P.in[I_GDN_ALOG]; const float* dtb = c.P.in[I_GDN_DTB];
    bf16* HB = c.ws<bf16>(WS_HB); float* BETA = c.ws<float>(WS_BETA); float* GGv = c.ws<float>(WS_GG);
    if (blockIdx.x == 0 && c.tid < NEXP) c.ws<unsigned>(WS_CTL)[CW_CNT + c.tid] = 0u;
    float4* tab = (float4*)c.lds;
    __syncthreads();
    for (int i = c.tid; i < 4096; i += NTHREADS) { const int k = i >> 2; tab[((k & 3) * 256 + (k >> 2)) * 5 + (i & 3)] = *(const float4*)(win + (size_t)k * NCOL_IN + 4096 + (i & 3) * 4); }
    __syncthreads();
    const int lane = c.lane;
    for (int t = c.gwave; t < T; t += c.nwaves) {
        float4 v[4]; float ss = 0.f;
#pragma unroll
        for (int i = 0; i < 4; ++i) { v[i] = ((const float4*)(x + (size_t)t * D))[lane + 64 * i]; ss += v[i].x * v[i].x + v[i].y * v[i].y + v[i].z * v[i].z + v[i].w * v[i].w; }
        ss = wsum(ss);
        const float rstd = rsqrtf(ss * (1.f / 1024.f) + 1e-6f);
        float acc[16];
#pragma unroll
        for (int j = 0; j < 16; ++j) acc[j] = 0.f;
#pragma unroll
        for (int i = 0; i < 4; ++i) {
            const float4 w4 = ((const float4*)nw)[lane + 64 * i];
            float h[4] = {v[i].x * rstd * w4.x, v[i].y * rstd * w4.y, v[i].z * rstd * w4.z, v[i].w * rstd * w4.w};
            uint2 st; st.x = pk2(h[0], h[1]); st.y = pk2(h[2], h[3]);
            *(uint2*)(HB + (size_t)t * D + 4 * (lane + 64 * i)) = st;
#pragma unroll
            for (int ii = 0; ii < 4; ++ii) {
                const int k = 4 * (lane + 64 * i) + ii;
#pragma unroll
                for (int q = 0; q < 4; ++q) { const float4 w = tab[(ii * 256 + (k >> 2)) * 5 + q]; acc[4 * q + 0] += h[ii] * w.x; acc[4 * q + 1] += h[ii] * w.y; acc[4 * q + 2] += h[ii] * w.z; acc[4 * q + 3] += h[ii] * w.w; }
                if (ii & 1) asm volatile("" ::: "memory");
            }
        }
        float mine = 0.f;
#pragma unroll
        for (int j = 0; j < 16; ++j) { const float s = wsum(acc[j]); mine = (lane == j) ? s : mine; }
        if (lane < 8) BETA[t * 8 + lane] = sigm(mine);
        else if (lane < 16) { const int h = lane - 8; GGv[t * 8 + h] = -expf(alog[h]) * softplusf(mine + dtb[h]); }
    }
    __syncthreads();
}

struct NoLd {};
struct EpiInProj {
    typedef NoLd Ld; static constexpr int MB = 1;
    bf16* GQKV; bf16* ZS; bf16* RKV; float* LIN; bf16* GATES;
    __device__ __forceinline__ void load(Ld&, int, int, int) const {}
    __device__ __forceinline__ void store8(int row, int col, const float (&v)[8], int, const Ld&) const {
        if (col < 3072) { uint4 w; w.x = pk2(v[0], v[1]); w.y = pk2(v[2], v[3]); w.z = pk2(v[4], v[5]); w.w = pk2(v[6], v[7]); *(uint4*)(GQKV + (size_t)row * 3072 + col) = w; }
        else if (col < 4096) { uint4 w; w.x = pk2(v[0] * fsigm(v[0]), v[1] * fsigm(v[1])); w.y = pk2(v[2] * fsigm(v[2]), v[3] * fsigm(v[3])); w.z = pk2(v[4] * fsigm(v[4]), v[5] * fsigm(v[5])); w.w = pk2(v[6] * fsigm(v[6]), v[7] * fsigm(v[7]));
            *(uint4*)(ZS + (size_t)row * 1024 + (col - 3072)) = w; }
        else if (col < 7168) { uint4 w; w.x = pk2(v[0], v[1]); w.y = pk2(v[2], v[3]); w.z = pk2(v[4], v[5]); w.w = pk2(v[6], v[7]); *(uint4*)(RKV + (size_t)row * 3072 + (col - 4096)) = w; }
        else if (col < 7424) { float* p = LIN + (size_t)row * 256 + (col - 7168); *(float4*)p = make_float4(v[0], v[1], v[2], v[3]); *(float4*)(p + 4) = make_float4(v[4], v[5], v[6], v[7]); }
        else { uint4 w; w.x = pk2(fsigm(v[0]), fsigm(v[1])); w.y = pk2(fsigm(v[2]), fsigm(v[3])); w.z = pk2(fsigm(v[4]), fsigm(v[5])); w.w = pk2(fsigm(v[6]), fsigm(v[7]));
            *(uint4*)(GATES + (size_t)row * 2048 + (col - 7424)) = w; }
    }
};
struct EpiG2 {
    struct Ld { uint4 g; uint4 p; }; static constexpr int MB = 1;
    const bf16* GATES; bf16* MG;
    __device__ __forceinline__ void load(Ld& l, int row, int col, int) const { l.g = *(const uint4*)(GATES + (size_t)row * 2048 + col); const uint4 q = *(const uint4*)(MG + (size_t)row * 1024 + (col & 1023)); const bool b = col >= 1024; l.p = make_uint4(b ? q.x : 0u, b ? q.y : 0u, b ? q.z : 0u, b ? q.w : 0u); }
    __device__ __forceinline__ void store8(int row, int col, const float (&v)[8], int, const Ld& l) const {
        const uint4 g = l.g, p = l.p;
        uint4 w; w.x = pk2(v[0] * bflo(g.x) + bflo(p.x), v[1] * bfhi(g.x) + bfhi(p.x)); w.y = pk2(v[2] * bflo(g.y) + bflo(p.y), v[3] * bfhi(g.y) + bfhi(p.y));
        w.z = pk2(v[4] * bflo(g.z) + bflo(p.z), v[5] * bfhi(g.z) + bfhi(p.z)); w.w = pk2(v[6] * bflo(g.w) + bflo(p.w), v[7] * bfhi(g.w) + bfhi(p.w));
        *(uint4*)(MG + (size_t)row * 1024 + (col & 1023)) = w;
    }
};
struct EpiX1 {
    struct Ld { float4 a, b; }; static constexpr int MB = 2;
    const float* X; float* X1;
    __device__ __forceinline__ void load(Ld& l, int row, int col, int) const { const float* xp = X + (size_t)row * 1024 + col; l.a = *(const float4*)xp; l.b = *(const float4*)(xp + 4); }
    __device__ __forceinline__ void store8(int row, int col, const float (&v)[8], int, const Ld& l) const {
        float* op = X1 + (size_t)row * 1024 + col;
        const float4 a = l.a, b = l.b;
        *(float4*)op = make_float4(a.x + v[0], a.y + v[1], a.z + v[2], a.w + v[3]); *(float4*)(op + 4) = make_float4(b.x + v[4], b.y + v[5], b.z + v[6], b.w + v[7]);
    }
};
struct EpiAct {
    struct Ld { float4 b0, b1; }; static constexpr int MB = 4;
    const float* BGU; bf16* ACT;
    __device__ __forceinline__ void load(Ld& l, int, int col, int e) const { const float* bp = BGU + (size_t)e * 2048 + col; l.b0 = *(const float4*)bp; l.b1 = *(const float4*)(bp + 4); }
    __device__ __forceinline__ void store8(int row, int col, const float (&v)[8], int e, const Ld& l) const {
        const float4 b0 = l.b0, b1 = l.b1;
        const float bb[8] = {b0.x, b0.y, b0.z, b0.w, b1.x, b1.y, b1.z, b1.w};
        float o[4];
#pragma unroll
        for (int p = 0; p < 4; ++p) { float glu = v[2 * p] + bb[2 * p], lin = v[2 * p + 1] + bb[2 * p + 1]; glu = fminf(glu, 7.f); lin = fminf(fmaxf(lin, -7.f), 7.f); o[p] = glu * fsigm(1.702f * glu) * (lin + 1.f); }
        uint2 w; w.x = pk2(o[0], o[1]); w.y = pk2(o[2], o[3]);
        *(uint2*)(ACT + (size_t)row * 1024 + (col >> 1)) = w;
    }
};
struct EpiYS {
    struct Ld { float4 b0, b1; float g; }; static constexpr int MB = 4;
    const float* BD; const float* SGATE; bf16* YS;
    __device__ __forceinline__ void load(Ld& l, int row, int col, int e) const { const float* bp = BD + (size_t)e * 1024 + col; l.g = SGATE[row]; l.b0 = *(const float4*)bp; l.b1 = *(const float4*)(bp + 4); }
    __device__ __forceinline__ void store8(int row, int col, const float (&v)[8], int e, const Ld& l) const {
        const float g = l.g; const float4 b0 = l.b0, b1 = l.b1;
        uint4 w; w.x = pk2((v[0] + b0.x) * g, (v[1] + b0.y) * g); w.y = pk2((v[2] + b0.z) * g, (v[3] + b0.w) * g); w.z = pk2((v[4] + b1.x) * g, (v[5] + b1.y) * g); w.w = pk2((v[6] + b1.z) * g, (v[7] + b1.w) * g);
        *(uint4*)(YS + (size_t)row * 1024 + col) = w;
    }
};


namespace pg8 {
typedef short bf16x8 __attribute__((ext_vector_type(8)));
typedef float f32x4 __attribute__((ext_vector_type(4)));
constexpr int BM = 256, BK = 64, HALF = 128, HTB = HALF * BK * 2, NXCD = 8, WGM = 8;
__host__ __device__ __forceinline__ int lds_byte(int r, int c) { const int st = (r >> 4) * 2 + (c >> 5), rr = r & 15, cc = c & 31, ob = rr * 64 + cc * 2; return st * 1024 + (ob ^ (((ob >> 9) & 1) << 5)); }
__host__ __device__ __forceinline__ void stage_rc(int b, int& R, int& C) { const int st = b / 1024, sb = b % 1024, swz = sb ^ (((sb >> 9) & 1) << 5); R = (st >> 1) * 16 + swz / 64; C = (st & 1) * 32 + (swz % 64) / 2; }
__host__ __device__ __forceinline__ int perm32(int rho) { const int n = rho >> 4, i = rho & 15; return 8 * (i >> 2) + 4 * n + (i & 3); }
struct Unit { const char* a; const char* b; const int* rowmap; int row0, col0, aux; };
__device__ __forceinline__ void tile_order(int L, int nM, int nN, int& pm, int& pn) {
    const int nwg = nM * nN; int wgid = L; { const int q = nwg / NXCD, r = nwg % NXCD, xcd = wgid % NXCD, off = wgid / NXCD; wgid = (xcd < r ? xcd * (q + 1) : r * (q + 1) + (xcd - r) * q) + off; }
    const int nig = WGM * nN, gid = wgid / nig, fm = gid * WGM, gsz = (nM - fm) < WGM ? (nM - fm) : WGM;
    pm = fm + ((wgid % nig) % gsz); pn = (wgid % nig) / gsz;
}
template <class Epi>
__device__ __forceinline__ void epi_apply(const Epi& E, const f32x4 (&acc)[2][2][4][2], const Unit& u, int wr, int wc, int fr, int fq) {
    constexpr int MB = Epi::MB;
#pragma unroll
    for (int ai = 0; ai < 2; ++ai)
#pragma unroll
        for (int mp = 0; mp < 4 / MB; ++mp) {
            typename Epi::Ld ld[MB][2];
#pragma unroll
            for (int mm = 0; mm < MB; ++mm)
#pragma unroll
                for (int bj = 0; bj < 2; ++bj) E.load(ld[mm][bj], u.row0 + ai * HALF + wr * 64 + (mp * MB + mm) * 16 + fr, u.col0 + bj * HALF + wc * 32 + 8 * fq, u.aux);
#pragma unroll
            for (int mm = 0; mm < MB; ++mm)
#pragma unroll
                for (int bj = 0; bj < 2; ++bj) {
                    const int m = mp * MB + mm;
                    const f32x4 x0 = acc[ai][bj][m][0], x1 = acc[ai][bj][m][1];
                    const float v[8] = {x0[0], x0[1], x0[2], x0[3], x1[0], x1[1], x1[2], x1[3]};
                    E.store8(u.row0 + ai * HALF + wr * 64 + m * 16 + fr, u.col0 + bj * HALF + wc * 32 + 8 * fq, v, u.aux, ld[mm][bj]);
                }
            asm volatile("" ::: "memory");
        }
}
template <bool GATHER, class Epi, class Sched>
__device__ __forceinline__ void gemm_phase_t(LAS unsigned char* lds, const int K_, const Sched& S, const Epi& E, const int tid) {
    int K = K_; asm volatile("" : "+s"(K));
    const int wid = __builtin_amdgcn_readfirstlane(tid >> 6), lane = tid & 63, wr = wid >> 2, wc = wid & 3, fr = lane & 15, fq = lane >> 4;
    const int nt = K / BK;
    unsigned voffA[2], voffB[2];
#pragma unroll
    for (int i = 0; i < 2; ++i) { int R, C; stage_rc(tid * 16 + i * 8192, R, C); const int Rb = (R & ~31) + perm32(R & 31);
        voffA[i] = (unsigned)(R * K + C) * 2u; voffB[i] = (unsigned)(Rb * K + C) * 2u; }
    const size_t kstep = (size_t)(BK * 2);
    const size_t hstep = (size_t)HALF * K * 2;
    const unsigned ldsw = (unsigned)wid * 1024u;
    const int aoff = lds_byte(wr * 64 + fr, fq * 8), boff = lds_byte(wc * 32 + fr, fq * 8);
#define PG8_SA(b, h) (((b) * 2 + (h)) * HTB)
#define PG8_SB(b, h) ((4 + (b) * 2 + (h)) * HTB)
#define PG8_STAGE(bufoff, gbase, voff) do { _Pragma("unroll") for (int _i = 0; _i < 2; ++_i) \
        __builtin_amdgcn_global_load_lds((const unsigned*)((const char*)(gbase) + (voff)[_i]), (LAS unsigned*)(lds + (bufoff) + ldsw + _i * 8192), 16, 0, 0); } while (0)
#define PG8_LDA(dst, b, h) do { _Pragma("unroll") for (int m = 0; m < 4; ++m) _Pragma("unroll") for (int k = 0; k < 2; ++k) dst[m][k] = *(const LAS bf16x8*)(lds + PG8_SA(b, h) + aoff + m * 2048 + k * 1024); } while (0)
#define PG8_LDB(dst, b, h) do { _Pragma("unroll") for (int n = 0; n < 2; ++n) _Pragma("unroll") for (int k = 0; k < 2; ++k) dst[n][k] = *(const LAS bf16x8*)(lds + PG8_SB(b, h) + boff + n * 2048 + k * 1024); } while (0)
#define PG8_MMA(ai, bj, At, Bt) do { __builtin_amdgcn_s_setprio(1); _Pragma("unroll") for (int m = 0; m < 4; ++m) _Pragma("unroll") for (int n = 0; n < 2; ++n) _Pragma("unroll") for (int k = 0; k < 2; ++k) \
        acc[ai][bj][m][n] = __builtin_amdgcn_mfma_f32_16x16x32_bf16(Bt[n][k], At[m][k], acc[ai][bj][m][n], 0, 0, 0); __builtin_amdgcn_s_setprio(0); } while (0)
#define PG8_WAIT_V(n) asm volatile("s_waitcnt vmcnt(" #n ")" ::: "memory")
#define PG8_WAIT_L(n) asm volatile("s_waitcnt lgkmcnt(" #n ")" ::: "memory")
#define PG8_BAR __builtin_amdgcn_s_barrier()
#define PG8_SCHED __builtin_amdgcn_sched_barrier(0)
    Unit cur, nxt; int ui = 0;
    if (!S.next(0, cur)) return;
    f32x4 acc[2][2][4][2];
#pragma unroll
    for (int a = 0; a < 2; ++a)
#pragma unroll
        for (int b = 0; b < 2; ++b)
#pragma unroll
            for (int m = 0; m < 4; ++m)
#pragma unroll
                for (int n = 0; n < 2; ++n) acc[a][b][m][n] = (f32x4){0.f, 0.f, 0.f, 0.f};
    bf16x8 At[4][2], B0[2][2], B1[2][2];
    const char* cA = cur.a; const char* cB = cur.b;
    unsigned oc_lo[2] = {0u, 0u}, oc_hi[2] = {0u, 0u}, on_lo[2] = {0u, 0u}, on_hi[2] = {0u, 0u};
#define PG8_ROWOFF(U, LO, HI) do { _Pragma("unroll") for (int _i = 0; _i < 2; ++_i) { int R_, C_; stage_rc(tid * 16 + _i * 8192, R_, C_); \
        LO[_i] = (unsigned)((U).rowmap[R_] * K + C_) * 2u; HI[_i] = (unsigned)((U).rowmap[R_ + 128] * K + C_) * 2u; } } while (0)
    if constexpr (GATHER) PG8_ROWOFF(cur, oc_lo, oc_hi);
    PG8_STAGE(PG8_SB(0, 0), cB, voffB);
    if constexpr (GATHER) PG8_STAGE(PG8_SA(0, 0), cA, oc_lo); else PG8_STAGE(PG8_SA(0, 0), cA, voffA);
    PG8_STAGE(PG8_SB(0, 1), cB + hstep, voffB);
    if constexpr (GATHER) PG8_STAGE(PG8_SA(0, 1), cA, oc_hi); else PG8_STAGE(PG8_SA(0, 1), cA + hstep, voffA);
    if (wr == 1) PG8_BAR;
    PG8_WAIT_V(4); PG8_BAR;
    PG8_STAGE(PG8_SB(1, 0), cB + kstep, voffB);
    if constexpr (GATHER) PG8_STAGE(PG8_SA(1, 0), cA + kstep, oc_lo); else PG8_STAGE(PG8_SA(1, 0), cA + kstep, voffA);
    PG8_STAGE(PG8_SB(1, 1), cB + hstep + kstep, voffB);
    PG8_WAIT_V(6); PG8_BAR;
    for (;;) {
        const bool has_next = S.next(ui + 1, nxt);
        const char* nA = has_next ? nxt.a : cA; const char* nB = has_next ? nxt.b : cB;
        if constexpr (GATHER) { if (has_next) PG8_ROWOFF(nxt, on_lo, on_hi); else { on_lo[0] = oc_lo[0]; on_lo[1] = oc_lo[1]; on_hi[0] = oc_hi[0]; on_hi[1] = oc_hi[1]; } }
#pragma unroll 1
        for (int t = 0; t < nt; t += 2) {
            const bool last = (t == nt - 2);
            const char* a1 = cA + (size_t)(t + 1) * kstep;
            const char* a2 = last ? nA : cA + (size_t)(t + 2) * kstep; const char* b2 = last ? nB : cB + (size_t)(t + 2) * kstep;
            const char* a3 = a2 + kstep; const char* b3 = b2 + kstep;
            unsigned o2lo[2], o2hi[2];
            o2lo[0] = last ? on_lo[0] : oc_lo[0]; o2lo[1] = last ? on_lo[1] : oc_lo[1]; o2hi[0] = last ? on_hi[0] : oc_hi[0]; o2hi[1] = last ? on_hi[1] : oc_hi[1];
            PG8_LDB(B0, 0, 0); PG8_SCHED; PG8_LDA(At, 0, 0); if constexpr (GATHER) PG8_STAGE(PG8_SA(1, 1), a1, oc_hi); else PG8_STAGE(PG8_SA(1, 1), a1 + hstep, voffA);
            PG8_WAIT_L(8); PG8_BAR; PG8_WAIT_L(0); PG8_MMA(0, 0, At, B0); PG8_BAR; PG8_SCHED;
            PG8_LDB(B1, 0, 1); PG8_STAGE(PG8_SB(0, 0), b2, voffB);
            PG8_BAR; PG8_WAIT_L(0); PG8_MMA(0, 1, At, B1); PG8_BAR;
            PG8_LDA(At, 0, 1); if constexpr (GATHER) PG8_STAGE(PG8_SA(0, 0), a2, o2lo); else PG8_STAGE(PG8_SA(0, 0), a2, voffA);
            PG8_BAR; PG8_WAIT_L(0); PG8_MMA(1, 0, At, B0); PG8_BAR; PG8_SCHED;
            PG8_STAGE(PG8_SB(0, 1), b2 + hstep, voffB);
            PG8_WAIT_V(6); PG8_BAR; PG8_MMA(1, 1, At, B1); PG8_BAR;
            PG8_LDB(B0, 1, 0); PG8_SCHED; PG8_LDA(At, 1, 0); if constexpr (GATHER) PG8_STAGE(PG8_SA(0, 1), a2, o2hi); else PG8_STAGE(PG8_SA(0, 1), a2 + hstep, voffA);
            PG8_WAIT_L(8); PG8_BAR; PG8_WAIT_L(0); PG8_MMA(0, 0, At, B0); PG8_BAR; PG8_SCHED;
            PG8_LDB(B1, 1, 1); PG8_STAGE(PG8_SB(1, 0), b3, voffB);
            PG8_BAR; PG8_WAIT_L(0); PG8_MMA(0, 1, At, B1); PG8_BAR;
            PG8_LDA(At, 1, 1); if constexpr (GATHER) PG8_STAGE(PG8_SA(1, 0), a3, o2lo); else PG8_STAGE(PG8_SA(1, 0), a3, voffA);
            PG8_BAR; PG8_WAIT_L(0); PG8_MMA(1, 0, At, B0); PG8_BAR; PG8_SCHED;
            PG8_STAGE(PG8_SB(1, 1), b3 + hstep, voffB);
            PG8_WAIT_V(6); PG8_BAR; PG8_MMA(1, 1, At, B1); PG8_BAR;
        }
        epi_apply(E, acc, cur, wr, wc, fr, fq);
        if (!has_next) break;
#pragma unroll
        for (int a = 0; a < 2; ++a)
#pragma unroll
            for (int b = 0; b < 2; ++b)
#pragma unroll
                for (int m = 0; m < 4; ++m)
#pragma unroll
                    for (int n = 0; n < 2; ++n) acc[a][b][m][n] = (f32x4){0.f, 0.f, 0.f, 0.f};
        cur = nxt; cA = nA; cB = nB; ++ui;
        if constexpr (GATHER) { oc_lo[0] = on_lo[0]; oc_lo[1] = on_lo[1]; oc_hi[0] = on_hi[0]; oc_hi[1] = on_hi[1]; }
    }
    PG8_WAIT_V(0);
    if (wr == 0) PG8_BAR;
    PG8_BAR;
#undef PG8_ROWOFF
#undef PG8_SA
#undef PG8_SB
#undef PG8_STAGE
#undef PG8_LDA
#undef PG8_LDB
#undef PG8_MMA
#undef PG8_WAIT_V
#undef PG8_WAIT_L
#undef PG8_BAR
#undef PG8_SCHED
}
template <class Epi, class Sched>
__device__ __forceinline__ void gemm_phase(LAS unsigned char* lds, const int K, const Sched& S, const Epi& E, const int tid) { gemm_phase_t<false>(lds, K, S, E, tid); }
}

struct SchedInProj { const char* A; const char* Bt; int G, c;
    __device__ __forceinline__ bool next(int i, pg8::Unit& u) const { const int L = i * G + c; if (L >= 64 * 37) return false; int pm, pn; pg8::tile_order(L, 64, 37, pm, pn);
        u.a = A + (size_t)pm * (256 * 1024 * 2); u.b = Bt + (size_t)pn * (256 * 1024 * 2); u.row0 = pm * 256; u.col0 = pn * 256; u.aux = 0; u.rowmap = nullptr; return true; } };

struct WJob { const float* src; int ld_src; int K; int ncols; bf16* dst; int ld_dst; int nb; size_t sstride, dstride; };
__device__ __forceinline__ void wconv_job(const Ctx& c, const WJob& j) {
    float* tl = (float*)c.lds;
    const int ntk = j.K >> 6, ntn = j.ncols >> 6, per = ntk * ntn, ntiles = per * j.nb;
    const int rk = c.tid >> 3, rseg = (c.tid & 7) * 8;
    int tile = blockIdx.x;
    float4 a = make_float4(0.f, 0.f, 0.f, 0.f), b = a;
    if (tile < ntiles) { const int bi = tile / per, tt = tile % per, tk = tt % ntk, tn = tt / ntk;
        const float* sp = j.src + (size_t)bi * j.sstride + (size_t)(tk * 64 + rk) * j.ld_src + tn * 64 + rseg; a = *(const float4*)sp; b = *(const float4*)(sp + 4); }
    for (; tile < ntiles; tile += gridDim.x) {
        const int bi = tile / per, tt = tile % per, tk = tt % ntk, tn = tt / ntk;
        const float4 ca = a, cb = b;
        const int nxt = tile + gridDim.x;
        if (nxt < ntiles) { const int bi2 = nxt / per, tt2 = nxt % per, tk2 = tt2 % ntk, tn2 = tt2 / ntk;
            const float* sp = j.src + (size_t)bi2 * j.sstride + (size_t)(tk2 * 64 + rk) * j.ld_src + tn2 * 64 + rseg; a = *(const float4*)sp; b = *(const float4*)(sp + 4); }
        asm volatile("s_waitcnt lgkmcnt(0)" ::: "memory"); __builtin_amdgcn_s_barrier(); asm volatile("" ::: "memory");
        float* row = tl + rk * 65 + rseg;
        row[0] = ca.x; row[1] = ca.y; row[2] = ca.z; row[3] = ca.w; row[4] = cb.x; row[5] = cb.y; row[6] = cb.z; row[7] = cb.w;
        asm volatile("s_waitcnt lgkmcnt(0)" ::: "memory"); __builtin_amdgcn_s_barrier(); asm volatile("" ::: "memory");
        const float* col = tl + rseg * 65 + rk;
        uint4 w; w.x = pk2(col[0], col[65]); w.y = pk2(col[130], col[195]); w.z = pk2(col[260], col[325]); w.w = pk2(col[390], col[455]);
        *(uint4*)(j.dst + (size_t)bi * j.dstride + (size_t)(tn * 64 + rk) * j.ld_dst + tk * 64 + rseg) = w;
    }
}
struct SchedG2 { const char* YA; const char* Bt; int G, c;
    __device__ __forceinline__ bool next(int i, pg8::Unit& u) const { const int L = (i >> 1) * G + c, ab = i & 1; if (L >= 64 * 4) return false; int pm, pn; pg8::tile_order(L, 64, 4, pm, pn);
        u.a = YA + (size_t)ab * (WS_YB - WS_YA) + (size_t)pm * (256 * 1024 * 2); u.b = Bt + (size_t)(ab * 4 + pn) * (256 * 1024 * 2); u.row0 = pm * 256; u.col0 = ab * 1024 + pn * 256; u.aux = 0; u.rowmap = nullptr; return true; } };
struct SchedX1 { const char* A; const char* Bt; int G, c;
    __device__ __forceinline__ bool next(int i, pg8::Unit& u) const { const int L = i * G + c; if (L >= 64 * 4) return false; int pm, pn; pg8::tile_order(L, 64, 4, pm, pn);
        u.a = A + (size_t)pm * (256 * 1024 * 2); u.b = Bt + (size_t)pn * (256 * 1024 * 2); u.row0 = pm * 256; u.col0 = pn * 256; u.aux = 0; u.rowmap = nullptr; return true; } };
struct SchedMoe { const char* A; const char* Bt; const int* TILE_E; const int* SLOT_TOK; int NT, NPN, G, c;
    __device__ __forceinline__ bool next(int i, pg8::Unit& u) const { const int L = i * G + c; if (L >= NT * NPN) return false; int tile, pn; pg8::tile_order(L, NT, NPN, tile, pn);
        const int e = TILE_E[tile];
        u.a = SLOT_TOK ? A : A + (size_t)tile * (256 * 1024 * 2); u.rowmap = SLOT_TOK ? SLOT_TOK + tile * 256 : nullptr;
        u.b = Bt + (size_t)(e * NPN + pn) * (256 * 1024 * 2); u.row0 = tile * 256; u.col0 = pn * 256; u.aux = e; return true; } };

struct EpiLora {
    typedef NoLd Ld; static constexpr int MB = 1;
    const float* w0; const float* a0; float* LW; float* AA; bf16* GGR;
    __device__ __forceinline__ void load(Ld&, int, int, int) const {}
    __device__ __forceinline__ void store8(int row, int col, const float (&v)[8], int, const Ld&) const {
        const float* bp = col < 1024 ? w0 + col : a0 + ((col - 1024) & 1023);
        const float4 b0 = *(const float4*)bp, b1 = *(const float4*)(bp + 4);
        const float bb[8] = {b0.x, b0.y, b0.z, b0.w, b1.x, b1.y, b1.z, b1.w};
        if (col < 1024) { float o[8];
#pragma unroll
            for (int i = 0; i < 8; ++i) o[i] = -0.6065306597126334f * fsigm(bb[i] + v[i]);
            float* p = LW + (size_t)row * 1024 + col; *(float4*)p = make_float4(o[0], o[1], o[2], o[3]); *(float4*)(p + 4) = make_float4(o[4], o[5], o[6], o[7]); }
        else if (col < 2048) { const int cc = col - 1024; float o[8];
#pragma unroll
            for (int i = 0; i < 8; ++i) o[i] = fsigm(bb[i] + v[i]);
            float* p = AA + (size_t)row * 1024 + cc; *(float4*)p = make_float4(o[0], o[1], o[2], o[3]); *(float4*)(p + 4) = make_float4(o[4], o[5], o[6], o[7]); }
        else { uint4 w; w.x = pk2(v[0], v[1]); w.y = pk2(v[2], v[3]); w.z = pk2(v[4], v[5]); w.w = pk2(v[6], v[7]); *(uint4*)(GGR + (size_t)row * 1024 + (col - 2048)) = w; }
    }
};
struct SchedLora { const char* A; const char* Bt; int G, c;
    __device__ __forceinline__ bool next(int i, pg8::Unit& u) const { const int L = i * G + c; if (L >= 64 * 12) return false; int pm, pn; pg8::tile_order(L, 64, 12, pm, pn);
        u.a = A + (size_t)pm * (256 * 256 * 2); u.b = Bt + (size_t)pn * (256 * 256 * 2); u.row0 = pm * 256; u.col0 = pn * 256; u.aux = 0; u.rowmap = nullptr; return true; } };
__device__ __forceinline__ void lora_zero(const Ctx& c) {
    uint4* LT = c.ws<uint4>(WS_LORA_T);
    for (size_t idx = c.gtid; idx < (size_t)3072 * 32; idx += c.nthreads) {
        const int row = (int)(idx >> 5), k8 = (int)(idx & 31) * 8;
        const bool data = row < 1024 ? (k8 < 64) : (row < 2048 ? (k8 >= 64 && k8 < 128) : (k8 >= 128));
        if (!data) LT[idx] = make_uint4(0, 0, 0, 0);
    }
}

__device__ __forceinline__ void ph_loraprep(const Ctx& c) {
    const float* LIN = c.ws<float>(WS_LIN); bf16* AL = c.ws<bf16>(WS_ALORA); const float* mu = c.P.in[I_MU];
    for (size_t idx = c.gtid; idx < (size_t)T * 256; idx += c.nthreads) {
        const int t = (int)(idx >> 8), cc = (int)(idx & 255);
        const float x = LIN[idx], xp = (t & (SEQ - 1)) ? LIN[idx - 256] : 0.f;
        const float xs = x + (xp - x) * mu[3072 + cc];
        const float r = cc < 64 ? tanhf(xs) : (cc < 128 ? xs : sigm(xs));
        AL[idx] = f2bf(r);
    }
}
__device__ __forceinline__ void ph_post(const Ctx& c) {
    const bf16* OG = c.ws<bf16>(WS_OG); const bf16* ORW = c.ws<bf16>(WS_ORW); const bf16* ZS = c.ws<bf16>(WS_ZS); const bf16* VP = c.ws<bf16>(WS_VP); const bf16* GGR = c.ws<bf16>(WS_GGR);
    const float* SC = c.ws<float>(WS_SC); bf16* YA = c.ws<bf16>(WS_YA); bf16* YB = c.ws<bf16>(WS_YB);
    const float* gnw = c.P.in[I_GDN_NORM]; const float* lnw = c.P.in[I_LNW]; const float* lnb = c.P.in[I_LNB];
    const int lane = c.lane, c0 = lane * 16;
    for (int t = c.gwave; t < T; t += c.nwaves) {
        {
            float o[16];
#pragma unroll
            for (int q = 0; q < 2; ++q) { const uint4 v = *(const uint4*)(OG + (size_t)t * 1024 + c0 + 8 * q); o[8 * q] = bflo(v.x); o[8 * q + 1] = bfhi(v.x); o[8 * q + 2] = bflo(v.y); o[8 * q + 3] = bfhi(v.y); o[8 * q + 4] = bflo(v.z); o[8 * q + 5] = bfhi(v.z); o[8 * q + 6] = bflo(v.w); o[8 * q + 7] = bfhi(v.w); }
            float ss = 0.f;
#pragma unroll
            for (int j = 0; j < 16; ++j) ss += o[j] * o[j];
            ss = sum8(ss);
            const float rstd = rsqrtf(ss * (1.f / 128.f) + 1e-6f);
            const uint4 z0 = *(const uint4*)(ZS + (size_t)t * 1024 + c0), z1 = *(const uint4*)(ZS + (size_t)t * 1024 + c0 + 8);
            const unsigned zz[8] = {z0.x, z0.y, z0.z, z0.w, z1.x, z1.y, z1.z, z1.w};
            unsigned w[8];
#pragma unroll
            for (int j = 0; j < 8; ++j) { const int cc = (c0 + 2 * j) & 127; w[j] = pk2(o[2 * j] * rstd * gnw[cc] * bflo(zz[j]), o[2 * j + 1] * rstd * gnw[cc + 1] * bfhi(zz[j])); }
            *(uint4*)(YA + (size_t)t * 1024 + c0) = make_uint4(w[0], w[1], w[2], w[3]); *(uint4*)(YA + (size_t)t * 1024 + c0 + 8) = make_uint4(w[4], w[5], w[6], w[7]);
        }
        {
            float o[16];
#pragma unroll
            for (int q = 0; q < 2; ++q) { const uint4 v = *(const uint4*)(ORW + (size_t)t * 1024 + c0 + 8 * q); o[8 * q] = bflo(v.x); o[8 * q + 1] = bfhi(v.x); o[8 * q + 2] = bflo(v.y); o[8 * q + 3] = bfhi(v.y); o[8 * q + 4] = bflo(v.z); o[8 * q + 5] = bfhi(v.z); o[8 * q + 6] = bflo(v.w); o[8 * q + 7] = bfhi(v.w); }
            float sm = 0.f;
#pragma unroll
            for (int j = 0; j < 16; ++j) sm += o[j];
            sm = sum4(sm);
            const float mean = sm * (1.f / 64.f);
            float sv = 0.f;
#pragma unroll
            for (int j = 0; j < 16; ++j) { const float dd = o[j] - mean; sv += dd * dd; }
            sv = sum4(sv);
            const float rstd = rsqrtf(sv * (1.f / 64.f) + 64e-5f);
            const float sc = SC[t * 16 + (c0 >> 6)];
            const uint4 v0 = *(const uint4*)(VP + (size_t)t * 1024 + c0), v1 = *(const uint4*)(VP + (size_t)t * 1024 + c0 + 8);
            const uint4 g0 = *(const uint4*)(GGR + (size_t)t * 1024 + c0), g1 = *(const uint4*)(GGR + (size_t)t * 1024 + c0 + 8);
            const unsigned vv[8] = {v0.x, v0.y, v0.z, v0.w, v1.x, v1.y, v1.z, v1.w};
            const unsigned gg[8] = {g0.x, g0.y, g0.z, g0.w, g1.x, g1.y, g1.z, g1.w};
            unsigned w[8];
#pragma unroll
            for (int j = 0; j < 8; ++j) { const int cc = c0 + 2 * j;
                const float y0 = ((o[2 * j] - mean) * rstd * lnw[cc] + lnb[cc] + sc * bflo(vv[j])) * bflo(gg[j]);
                const float y1 = ((o[2 * j + 1] - mean) * rstd * lnw[cc + 1] + lnb[cc + 1] + sc * bfhi(vv[j])) * bfhi(gg[j]);
                w[j] = pk2(y0, y1); }
            *(uint4*)(YB + (size_t)t * 1024 + c0) = make_uint4(w[0], w[1], w[2], w[3]); *(uint4*)(YB + (size_t)t * 1024 + c0 + 8) = make_uint4(w[4], w[5], w[6], w[7]);
        }
    }
}

__device__ __forceinline__ void ph_router(const Ctx& c) {
    const float* X1 = c.ws<float>(WS_X1); const float* nw = c.P.in[I_NORM_FFN]; const float* rw = c.P.in[I_ROUTER_W]; const float* rb = c.P.in[I_ROUTER_B];
    bf16* H2 = c.ws<bf16>(WS_H2); int* TE = c.ws<int>(WS_TE); float* TG = c.ws<float>(WS_TG); int* TP = c.ws<int>(WS_TP); unsigned* CNT = c.ws<unsigned>(WS_CTL) + CW_CNT;
    const int lane = c.lane;
    float4* tab = (float4*)c.lds;
    unsigned* lcnt = (unsigned*)(c.lds + 147456);
    __syncthreads();
    if (c.tid < 32) lcnt[c.tid] = 0u;
    for (int i = c.tid; i < 8192; i += NTHREADS) { const int k = i >> 3; tab[((k & 3) * 256 + (k >> 2)) * 9 + (i & 7)] = ((const float4*)rw)[i]; }
    __syncthreads();
    for (int t = c.gwave; t < T; t += c.nwaves) {
        float4 v[4]; float ss = 0.f;
#pragma unroll
        for (int i = 0; i < 4; ++i) { v[i] = ((const float4*)(X1 + (size_t)t * D))[lane + 64 * i]; ss += v[i].x * v[i].x + v[i].y * v[i].y + v[i].z * v[i].z + v[i].w * v[i].w; }
        ss = wsum(ss);
        const float rstd = rsqrtf(ss * (1.f / 1024.f) + 1e-6f);
        float lg[32];
#pragma unroll
        for (int j = 0; j < 32; ++j) lg[j] = 0.f;
#pragma unroll
        for (int i = 0; i < 4; ++i) {
            const float4 w4 = ((const float4*)nw)[lane + 64 * i];
            const float h[4] = {v[i].x * rstd * w4.x, v[i].y * rstd * w4.y, v[i].z * rstd * w4.z, v[i].w * rstd * w4.w};
            uint2 st; st.x = pk2(h[0], h[1]); st.y = pk2(h[2], h[3]);
            *(uint2*)(H2 + (size_t)t * D + 4 * (lane + 64 * i)) = st;
#pragma unroll
            for (int ii = 0; ii < 4; ++ii) {
                const float4* wr = tab + (size_t)(ii * 256 + lane + 64 * i) * 9;
#pragma unroll
                for (int q = 0; q < 8; ++q) { const float4 w = wr[q]; lg[4 * q] += h[ii] * w.x; lg[4 * q + 1] += h[ii] * w.y; lg[4 * q + 2] += h[ii] * w.z; lg[4 * q + 3] += h[ii] * w.w; }
                asm volatile("" ::: "memory");
            }
        }
#pragma unroll
        for (int j = 0; j < 32; ++j) lg[j] = wsum(lg[j]) + rb[j];
        int e0 = 0, e1 = 0, e2 = 0, e3 = 0; float v0 = -3e38f, v1 = -3e38f, v2 = -3e38f, v3 = -3e38f;
#pragma unroll
        for (int j = 0; j < 32; ++j) if (lg[j] > v0) { v0 = lg[j]; e0 = j; }
#pragma unroll
        for (int j = 0; j < 32; ++j) if (j != e0 && lg[j] > v1) { v1 = lg[j]; e1 = j; }
#pragma unroll
        for (int j = 0; j < 32; ++j) if (j != e0 && j != e1 && lg[j] > v2) { v2 = lg[j]; e2 = j; }
#pragma unroll
        for (int j = 0; j < 32; ++j) if (j != e0 && j != e1 && j != e2 && lg[j] > v3) { v3 = lg[j]; e3 = j; }
        const float x1 = expf(v1 - v0), x2 = expf(v2 - v0), x3 = expf(v3 - v0), inv = 1.f / (1.f + x1 + x2 + x3);
        if (lane < 4) {
            const int me = lane == 0 ? e0 : (lane == 1 ? e1 : (lane == 2 ? e2 : e3));
            const float mg = (lane == 0 ? 1.f : (lane == 1 ? x1 : (lane == 2 ? x2 : x3))) * inv;
            const unsigned pos = atomicAdd(&lcnt[me], 1u);
            TE[t * 4 + lane] = me; TG[t * 4 + lane] = mg; TP[t * 4 + lane] = (int)pos;
        }
    }
    __syncthreads();
    if (c.tid < 32) lcnt[32 + c.tid] = atomicAdd(&CNT[c.tid], lcnt[c.tid]);
    __syncthreads();
    if (lane < 4) for (int t = c.gwave; t < T; t += c.nwaves) TP[t * 4 + lane] += (int)lcnt[32 + TE[t * 4 + lane]];
    __syncthreads();
}

__device__ __forceinline__ void ph_dispatch(const Ctx& c) {
    int* tb = (int*)c.lds;
    const unsigned* CNT = c.ws<unsigned>(WS_CTL) + CW_CNT;
    int* TILE_E = c.ws<int>(WS_TILE_E); int* NT = c.ws<int>(WS_NT);
    const int* TE = c.ws<int>(WS_TE); const float* TG = c.ws<float>(WS_TG); const int* TP = c.ws<int>(WS_TP); int* TSLOT = c.ws<int>(WS_TSLOT);
    float* SGATE = c.ws<float>(WS_SGATE); const bf16* H2 = c.ws<bf16>(WS_H2); bf16* XB = c.ws<bf16>(WS_XB);
    if (c.tid == 0) { int acc = 0; for (int e = 0; e < NEXP; ++e) { const int n = (int)__hip_atomic_load(&CNT[e], __ATOMIC_RELAXED, __HIP_MEMORY_SCOPE_AGENT); tb[e] = acc; tb[64 + e] = n; acc += (n + 255) >> 8; } tb[32] = acc; }
    __syncthreads();
    if (blockIdx.x == 0) {
        for (int tile = c.tid; tile < tb[32]; tile += NTHREADS) { int e = 0; for (int q = 0; q < NEXP; ++q) if (tile >= tb[q]) e = q; TILE_E[tile] = e; }
        if (c.tid == 0) *NT = tb[32];
    }
    int* SLOT_TOK = c.ws<int>(WS_SLOT_TOK);
    for (size_t idx = c.gtid; idx < (size_t)T * 4; idx += c.nthreads) {
        const int t = (int)(idx >> 2), e = TE[idx], pos = TP[idx];
        const int slot = tb[e] * 256 + pos;
        TSLOT[idx] = slot; SGATE[slot] = TG[idx]; SLOT_TOK[slot] = t;
    }
    for (int e = 0; e < NEXP; ++e) {
        const int n = tb[64 + e], cap = (tb[e + 1] - tb[e]) * 256;
        for (int r = n + (int)c.gtid; r < cap; r += (int)c.nthreads) { const int slot = tb[e] * 256 + r; SLOT_TOK[slot] = 0; SGATE[slot] = 0.f; }
    }
}

__device__ __forceinline__ void ph_combine(const Ctx& c) {
    const float* X1 = c.ws<float>(WS_X1); const bf16* YS = c.ws<bf16>(WS_YS); const int* TSLOT = c.ws<int>(WS_TSLOT); const float* nw = c.P.in[I_NORM_FINAL]; float* out = c.P.out;
    const int lane = c.lane;
    for (int t = c.gwave; t < T; t += c.nwaves) {
        const int s0 = TSLOT[t * 4], s1 = TSLOT[t * 4 + 1], s2 = TSLOT[t * 4 + 2], s3 = TSLOT[t * 4 + 3];
        float4 v[4]; float ss = 0.f;
#pragma unroll
        for (int i = 0; i < 4; ++i) {
            const int col = 4 * (lane + 64 * i);
            v[i] = *(const float4*)(X1 + (size_t)t * D + col);
            const uint2 a = *(const uint2*)(YS + (size_t)s0 * 1024 + col), b = *(const uint2*)(YS + (size_t)s1 * 1024 + col), cc = *(const uint2*)(YS + (size_t)s2 * 1024 + col), d = *(const uint2*)(YS + (size_t)s3 * 1024 + col);
            v[i].x += bflo(a.x) + bflo(b.x) + bflo(cc.x) + bflo(d.x); v[i].y += bfhi(a.x) + bfhi(b.x) + bfhi(cc.x) + bfhi(d.x);
            v[i].z += bflo(a.y) + bflo(b.y) + bflo(cc.y) + bflo(d.y); v[i].w += bfhi(a.y) + bfhi(b.y) + bfhi(cc.y) + bfhi(d.y);
            ss += v[i].x * v[i].x + v[i].y * v[i].y + v[i].z * v[i].z + v[i].w * v[i].w;
        }
        ss = wsum(ss);
        const float rstd = rsqrtf(ss * (1.f / 1024.f) + 1e-6f);
#pragma unroll
        for (int i = 0; i < 4; ++i) { const float4 w4 = ((const float4*)nw)[lane + 64 * i];
            *(float4*)(out + (size_t)t * D + 4 * (lane + 64 * i)) = make_float4(v[i].x * rstd * w4.x, v[i].y * rstd * w4.y, v[i].z * rstd * w4.z, v[i].w * rstd * w4.w); }
    }
    if (TS_BEGIN >= 0 && blockIdx.x == 0 && c.tid == 0) { asm volatile("s_waitcnt vmcnt(0)" ::: "memory"); c.P.out[0] = (float)c.ws<unsigned>(WS_CTL)[CW_TS] * 0.01f; }
}


typedef short bf16x8_t __attribute__((ext_vector_type(8)));
typedef float f32x4_t __attribute__((ext_vector_type(4)));
#define MFMA16(a, b, c) __builtin_amdgcn_mfma_f32_16x16x32_bf16((a), (b), (c), 0, 0, 0)


__device__ __forceinline__ int frag_off(int row, int k, int KBn) { return (((row >> 4) * KBn + (k >> 5)) * 512) + (((k >> 3) & 3) * 128) + ((row & 15) * 8) + (k & 7); }
__device__ __forceinline__ int cfrag_off(int v, int r, int NRT) { return ((((v >> 4) * NRT + (r >> 4)) * 64 + ((r >> 2) & 3) * 16 + (v & 15)) * 4) + (r & 3); }


constexpr int TRI_LS = 68;
#define MFMA4(a, b, c) __builtin_amdgcn_mfma_f32_16x16x4f32((a), (b), (c), 0, 0, 0)
template <int SG>
__device__ __forceinline__ void tri_diag_inv(float* Lm, int lane) {
    const int b = lane >> 4, e = lane & 15;
    float* Lb = Lm + (16 * b) * TRI_LS + 16 * b;
    float x[16];
#pragma unroll
    for (int i = 0; i < 16; ++i) x[i] = 0.f;
#pragma unroll
    for (int i = 0; i < 16; ++i) {
        float a0 = (i == e) ? 1.f : 0.f, a1 = 0.f;
#pragma unroll
        for (int j4 = 0; j4 < (i + 3) / 4; ++j4) { const float4 m = *(const float4*)(Lb + i * TRI_LS + 4 * j4);
            a0 -= (float)SG * (m.x * x[4 * j4]); a1 -= (float)SG * (m.y * x[4 * j4 + 1]); a0 -= (float)SG * (m.z * x[4 * j4 + 2]); a1 -= (float)SG * (m.w * x[4 * j4 + 3]); }
        x[i] = a0 + a1;
    }
#pragma unroll
    for (int i = 0; i < 16; ++i) Lb[i * TRI_LS + e] = x[i];
}
template <int SG>
__device__ __forceinline__ void tri_col_inv(const float* Lm, int cb, int lane, f32x4_t (&Tb)[4]) {
    const int n = lane & 15, q = lane >> 4;
#pragma unroll
    for (int r = 0; r < 4; ++r) { Tb[r] = (f32x4_t){0.f, 0.f, 0.f, 0.f};
        if (r == cb) {
#pragma unroll
            for (int rr = 0; rr < 4; ++rr) Tb[r][rr] = Lm[(16 * r + 4 * q + rr) * TRI_LS + 16 * r + n]; } }
#pragma unroll
    for (int r = 1; r < 4; ++r) {
        if (r > cb) {
            f32x4_t P = {0.f, 0.f, 0.f, 0.f};
#pragma unroll
            for (int k = 0; k < r; ++k) {
                if (k >= cb) { const float4 a = *(const float4*)(Lm + (16 * r + n) * TRI_LS + 16 * k + 4 * q);
                    P = MFMA4(a.x, Tb[k][0], P); P = MFMA4(a.y, Tb[k][1], P); P = MFMA4(a.z, Tb[k][2], P); P = MFMA4(a.w, Tb[k][3], P); }
            }
#pragma unroll
            for (int rr = 0; rr < 4; ++rr) P[rr] *= -(float)SG;
            const float4 d = *(const float4*)(Lm + (16 * r + n) * TRI_LS + 16 * r + 4 * q);
            f32x4_t R = {0.f, 0.f, 0.f, 0.f};
            R = MFMA4(d.x, P[0], R); R = MFMA4(d.y, P[1], R); R = MFMA4(d.z, P[2], R); R = MFMA4(d.w, P[3], R);
            Tb[r] = R;
        }
    }
}

constexpr int GCL_HALF_BYTES = 71680;
__device__ __forceinline__ void ph_gcl(const Ctx& c) {
    const bf16* GQKV = c.ws<bf16>(WS_GQKV); const float* BETA = c.ws<float>(WS_BETA); const float* GGv = c.ws<float>(WS_GG); const float* cw = c.P.in[I_GDN_CONV];
    bf16* GA1 = c.ws<bf16>(WS_GA1); bf16* GX0 = c.ws<bf16>(WS_GX0); bf16* GA2 = c.ws<bf16>(WS_GA2); bf16* GA3 = c.ws<bf16>(WS_GA3); bf16* GA4 = c.ws<bf16>(WS_GA4); float* GGL = c.ws<float>(WS_GGL);
    for (int it0 = blockIdx.x * 2; it0 < 2048; it0 += gridDim.x * 2) {
        int tv = c.tid; asm volatile("" : "+v"(tv));
        const int half = tv >> 8, ht = tv & 255, lane = tv & 63, w4 = __builtin_amdgcn_readfirstlane((tv >> 6) & 3);
        unsigned char* base = c.lds + half * GCL_HALF_BYTES;
        bf16* QB = (bf16*)base;
        bf16* KB = QB + 64 * 136;
        bf16* VB = KB + 64 * 136;
        float* MM = (float*)(VB + 64 * 136);
        float* GC = MM + 64 * TRI_LS;
        float* BT = GC + 64;
        float* BE = BT + 64;
        const int item = it0 + half, n = item & 63, bh = item >> 6, h = bh & 7, b = bh >> 3;
        const int t0 = b * SEQ + n * 64;
        __syncthreads();
        if (w4 == 0) {
            float g = GGv[(size_t)(t0 + lane) * 8 + h]; const float be = BETA[(size_t)(t0 + lane) * 8 + h];
#pragma unroll
            for (int o = 1; o < 64; o <<= 1) { const float u = __shfl_up(g, o); if (lane >= o) g += u; }
            GC[lane] = g; BT[lane] = be; BE[lane] = be * __expf(g);
        }
        __syncthreads();
        {
            const int cg = ht & 15, rg = ht >> 4, r0 = rg * 4;
#pragma unroll
            for (int mat = 0; mat < 3; ++mat) {
                const int col0 = mat * 1024 + h * 128 + cg * 8;
                float4 xa[7], xb[7], wa[4], wb[4];
#pragma unroll
                for (int li = 0; li < 7; ++li) {
                    const bool valid = (n > 0) || (r0 - 3 + li >= 0);
                    uint4 xr = make_uint4(0, 0, 0, 0);
                    if (valid) xr = *(const uint4*)(GQKV + (size_t)(t0 + r0 - 3 + li) * 3072 + col0);
                    xa[li] = make_float4(bflo(xr.x), bfhi(xr.x), bflo(xr.y), bfhi(xr.y));
                    xb[li] = make_float4(bflo(xr.z), bfhi(xr.z), bflo(xr.w), bfhi(xr.w));
                }
#pragma unroll
                for (int j = 0; j < 4; ++j) { wa[j] = *(const float4*)(cw + j * 3072 + col0); wb[j] = *(const float4*)(cw + j * 3072 + col0 + 4); }
#pragma unroll
                for (int rr = 0; rr < 4; ++rr) {
                    float o[8] = {0.f, 0.f, 0.f, 0.f, 0.f, 0.f, 0.f, 0.f};
#pragma unroll
                    for (int j = 0; j < 4; ++j) { const float4 a = xa[rr + j], bq = xb[rr + j];
                        o[0] += wa[j].x * a.x; o[1] += wa[j].y * a.y; o[2] += wa[j].z * a.z; o[3] += wa[j].w * a.w;
                        o[4] += wb[j].x * bq.x; o[5] += wb[j].y * bq.y; o[6] += wb[j].z * bq.z; o[7] += wb[j].w * bq.w; }
                    float ss = 0.f;
#pragma unroll
                    for (int e = 0; e < 8; ++e) { o[e] *= fsigm(o[e]); ss += o[e] * o[e]; }
                    float sc = 1.f;
                    if (mat < 2) { ss = sum16(ss); sc = rsqrtf(ss + 1e-6f) * (mat == 0 ? 0.08838834764831845f : 1.f); }
                    const int r = r0 + rr;
                    uint4 w; w.x = pk2(o[0] * sc, o[1] * sc); w.y = pk2(o[2] * sc, o[3] * sc); w.z = pk2(o[4] * sc, o[5] * sc); w.w = pk2(o[6] * sc, o[7] * sc);
                    *(uint4*)((mat == 0 ? QB : (mat == 1 ? KB : VB)) + r * 136 + cg * 8) = w;
                    if (mat == 0) {
                        const float s2 = sc * __expf(GC[r]);
                        w.x = pk2(o[0] * s2, o[1] * s2); w.y = pk2(o[2] * s2, o[3] * s2); w.z = pk2(o[4] * s2, o[5] * s2); w.w = pk2(o[6] * s2, o[7] * s2);
                        *(uint4*)(GA2 + (size_t)item * 64 * 128 + frag_off(r, cg * 8, 4)) = w;
                    }
                }
            }
        }
        __syncthreads();
        {
            const int fr = lane & 15, fq = lane >> 4, a0 = w4 * 16;
            bf16x8_t ka[4];
#pragma unroll
            for (int kb = 0; kb < 4; ++kb) ka[kb] = *(const bf16x8_t*)(KB + (a0 + fr) * 136 + kb * 32 + fq * 8);
#pragma unroll
            for (int bt = 0; bt < 4; ++bt) {
                f32x4_t c1 = {0.f, 0.f, 0.f, 0.f}, c2 = {0.f, 0.f, 0.f, 0.f};
#pragma unroll
                for (int kb = 0; kb < 4; ++kb) {
                    const bf16x8_t kbf = *(const bf16x8_t*)(KB + (bt * 16 + fr) * 136 + kb * 32 + fq * 8);
                    const bf16x8_t qbf = *(const bf16x8_t*)(QB + (bt * 16 + fr) * 136 + kb * 32 + fq * 8);
                    c1 = MFMA16(ka[kb], kbf, c1); c2 = MFMA16(ka[kb], qbf, c2);
                }
                const int i = bt * 16 + fr, j0 = a0 + 4 * fq;
                const float gi = GC[i], bi = BT[i];
                float m[4], at[4];
#pragma unroll
                for (int rg = 0; rg < 4; ++rg) { const int j = j0 + rg; const float dec = __expf(fminf(gi - GC[j], 0.f));
                    m[rg] = (i > j) ? bi * c1[rg] * dec : 0.f; at[rg] = (i >= j) ? c2[rg] * dec : 0.f; }
                *(float4*)(MM + i * TRI_LS + j0) = make_float4(m[0], m[1], m[2], m[3]);
                uint2 w; w.x = pk2(at[0], at[1]); w.y = pk2(at[2], at[3]);
                *(uint2*)(GA3 + (size_t)item * 64 * 64 + frag_off(i, j0, 2)) = w;
            }
        }
        __syncthreads();
        if (w4 == 0) tri_diag_inv<1>(MM, lane);
        __syncthreads();
        bf16* TV = QB; bf16* TK = QB + 64 * 64;
        {
            f32x4_t Tb[4];
            tri_col_inv<1>(MM, w4, lane, Tb);
            const int tn = lane & 15, tq = lane >> 4, col = 16 * w4 + tn;
            const float sv = BT[col], sk = BE[col];
#pragma unroll
            for (int r = 0; r < 4; ++r) {
                if (r >= w4 || r + 1 == w4) {
#pragma unroll
                    for (int rr = 0; rr < 4; ++rr) { const int row = 16 * r + 4 * tq + rr; const int po = row * 64 + ((((col >> 3) ^ (row & 7)) << 3) | (col & 7));
                        TV[po] = f2bf(Tb[r][rr] * sv); TK[po] = f2bf(Tb[r][rr] * sk); }
                }
            }
        }
        __syncthreads();
        {
            const int fr = lane & 15, fq = lane >> 4;
            const bool isw = w4 >= 2; const bf16* TI = isw ? TK : TV; const bf16* src = isw ? KB : VB;
            const int cbase = (w4 & 1) * 64;
            bf16x8_t af[4][2];
#pragma unroll
            for (int it = 0; it < 4; ++it)
#pragma unroll
                for (int kb = 0; kb < 2; ++kb) { const int row = it * 16 + fr; af[it][kb] = *(const bf16x8_t*)(TI + row * 64 + (((kb * 4 + fq) ^ (row & 7)) << 3)); }
            bf16* up = GX0 + (size_t)item * 128 * 64; bf16* a1s = (bf16*)MM;
#pragma unroll
            for (int t = 0; t < 4; ++t) {
                const int cc = cbase + t * 16 + fr;
                bf16x8_t b0, b1;
#pragma unroll
                for (int e = 0; e < 8; ++e) { b0[e] = (short)src[(fq * 8 + e) * 136 + cc]; b1[e] = (short)src[(32 + fq * 8 + e) * 136 + cc]; }
#pragma unroll
                for (int it = 0; it < 4; ++it) {
                    f32x4_t acc = {0.f, 0.f, 0.f, 0.f};
                    acc = MFMA16(af[it][0], b0, acc);
                    if (it >= 2) acc = MFMA16(af[it][1], b1, acc);
                    if (!isw) { uint2 w; w.x = pk2(acc[0], acc[1]); w.y = pk2(acc[2], acc[3]); *(uint2*)(up + cfrag_off(cc, it * 16 + 4 * fq, 4)) = w; }
                    else {
#pragma unroll
                        for (int rr = 0; rr < 4; ++rr) a1s[(it * 16 + 4 * fq + rr) * 128 + cc] = f2bf(-acc[rr]); }
                }
            }
        }
        __syncthreads();
        {
            const bf16* a1s = (const bf16*)MM; bf16* wp = GA1 + (size_t)item * 64 * 128;
#pragma unroll
            for (int q = 0; q < 4; ++q) { const int p = ht + 256 * q, fr = p & 15, fq = (p >> 4) & 3, kb = (p >> 6) & 3, rt = p >> 8;
                *(uint4*)(wp + p * 8) = *(const uint4*)(a1s + (rt * 16 + fr) * 128 + kb * 32 + fq * 8); }
        }
        {
            const int dk = ht & 127, hh = ht >> 7; const float g63 = GC[63];
            unsigned w[16];
#pragma unroll
            for (int q = 0; q < 16; ++q) { const int ta = hh * 32 + 2 * q;
                w[q] = pk2(bf2f(KB[ta * 136 + dk]) * __expf(g63 - GC[ta]), bf2f(KB[(ta + 1) * 136 + dk]) * __expf(g63 - GC[ta + 1])); }
            bf16* dp = GA4 + (size_t)item * 128 * 64;
            *(uint4*)(dp + frag_off(dk, hh * 32, 2)) = make_uint4(w[0], w[1], w[2], w[3]); *(uint4*)(dp + frag_off(dk, hh * 32 + 8, 2)) = make_uint4(w[4], w[5], w[6], w[7]);
            *(uint4*)(dp + frag_off(dk, hh * 32 + 16, 2)) = make_uint4(w[8], w[9], w[10], w[11]); *(uint4*)(dp + frag_off(dk, hh * 32 + 24, 2)) = make_uint4(w[12], w[13], w[14], w[15]);
            if (ht == 0) GGL[item] = __expf(g63);
        }
    }
}

constexpr int RCL_HALF_BYTES = 75776;
__device__ __forceinline__ void ph_rcl(const Ctx& c) {
    const bf16* RKV = c.ws<bf16>(WS_RKV); const float* LW = c.ws<float>(WS_LW); const float* AAg = c.ws<float>(WS_AA);
    const float* mu = c.P.in[I_MU]; const float* k_k = c.P.in[I_KK]; const float* k_a = c.P.in[I_KA]; const float* r_k = c.P.in[I_RK];
    bf16* VP = c.ws<bf16>(WS_VP); float* SC = c.ws<float>(WS_SC);
    bf16* RA1 = c.ws<bf16>(WS_RA1); bf16* RX0 = c.ws<bf16>(WS_RX0); bf16* RA2 = c.ws<bf16>(WS_RA2); bf16* RA3 = c.ws<bf16>(WS_RA3); bf16* RO0 = c.ws<bf16>(WS_RO0);
    bf16* RA4 = c.ws<bf16>(WS_RA4); bf16* RS0 = c.ws<bf16>(WS_RS0); float* RDSC = c.ws<float>(WS_RDSC);
    unsigned long long ts_t0 = 0ull, ts_acc = 0ull;
#define TSMARK(k) do { if (TS_BEGIN >= 0 && blockIdx.x == 0 && c.tid == 0) { const unsigned long long now_ = __builtin_amdgcn_s_memrealtime(); \
        if ((k) == TS_END && ts_t0 != 0ull) ts_acc += now_ - ts_t0; if ((k) == TS_BEGIN) ts_t0 = now_; } } while (0)
    uint4 ur[2], uk[2], uv[2]; float4 a4v[4], l4v[4];
#define RCL_LOAD(ITEM, TID) do { const int it_ = (ITEM), ht_ = (TID) & 255, n_ = it_ & 63, bh_ = it_ >> 6, h_ = bh_ & 15, b_ = bh_ >> 4; \
        const int r_ = ht_ >> 2, c0_ = (ht_ & 3) * 16, t_ = b_ * SEQ + n_ * 64 + r_; \
        const bf16* cur_ = RKV + (size_t)t_ * 3072 + h_ * 64 + c0_; \
        _Pragma("unroll") for (int g = 0; g < 2; ++g) { ur[g] = *(const uint4*)(cur_ + 8 * g); uk[g] = *(const uint4*)(cur_ + 1024 + 8 * g); uv[g] = *(const uint4*)(cur_ + 2048 + 8 * g); } \
        _Pragma("unroll") for (int q = 0; q < 4; ++q) { l4v[q] = *(const float4*)(LW + (size_t)t_ * 1024 + h_ * 64 + c0_ + 4 * q); a4v[q] = *(const float4*)(AAg + (size_t)t_ * 1024 + h_ * 64 + c0_ + 4 * q); } \
    } while (0)
    if ((int)(blockIdx.x * 2) < 4096) RCL_LOAD(blockIdx.x * 2 + (c.tid >> 8), c.tid);
    for (int it0 = blockIdx.x * 2; it0 < 4096; it0 += gridDim.x * 2) {
        int tv = c.tid; asm volatile("" : "+v"(tv));
        const int half = tv >> 8, ht = tv & 255, lane = tv & 63, w4 = __builtin_amdgcn_readfirstlane((tv >> 6) & 3);
        unsigned char* base = c.lds + half * RCL_HALF_BYTES;
        bf16* AT = (bf16*)base;
        bf16* VT = AT + 64 * 72;
        bf16* KDT = VT + 64 * 72;
        float* AAB = (float*)(KDT + 64 * 72);
        float* TOT = AAB + 64 * 64;
        unsigned char* RX = (unsigned char*)(TOT + 256);
        bf16* RT = (bf16*)RX;
        bf16* BTL = RT + 64 * 72;
        bf16* KT = BTL + 64 * 72;
        bf16* AAK = (bf16*)RX;
        bf16* ARK = AAK + 64 * 72;
        float* RHS2 = (float*)RX;
        const int item = it0 + half, n = item & 63, bh = item >> 6, h = bh & 15, b = bh >> 4;
        const int t0 = b * SEQ + n * 64;
        __syncthreads();
        TSMARK(0);
        const int r = ht >> 2, seg = ht & 3, c0 = seg * 16, t = t0 + r; const bool first = (n == 0 && r == 0);
        float rr[16], kf[16], vv[16], kkv[16], aa[16], lwl[16], bdv[16];
        float ss = 0.f, scs = 0.f;
        {
            float4 mr[4], mk[4], mv[4], kkw[4], kaw[4], rkw[4];
            uint4 qr[2], qk[2], qv[2];
            {   const bf16* prv = RKV + (size_t)(t - 1) * 3072 + h * 64 + c0;
#pragma unroll
                for (int g = 0; g < 2; ++g) { qr[g] = make_uint4(0, 0, 0, 0); qk[g] = qr[g]; qv[g] = qr[g];
                    if (!first) { qr[g] = *(const uint4*)(prv + 8 * g); qk[g] = *(const uint4*)(prv + 1024 + 8 * g); qv[g] = *(const uint4*)(prv + 2048 + 8 * g); } } }
#pragma unroll
            for (int q = 0; q < 4; ++q) {
                mr[q] = *(const float4*)(mu + h * 64 + c0 + 4 * q); mk[q] = *(const float4*)(mu + 1024 + h * 64 + c0 + 4 * q); mv[q] = *(const float4*)(mu + 2048 + h * 64 + c0 + 4 * q);
                kkw[q] = *(const float4*)(k_k + h * 64 + c0 + 4 * q); kaw[q] = *(const float4*)(k_a + h * 64 + c0 + 4 * q); rkw[q] = *(const float4*)(r_k + h * 64 + c0 + 4 * q);
            }
#pragma unroll
            for (int q = 0; q < 4; ++q) *(float4*)(AAB + r * 64 + c0 + 4 * q) = l4v[q];
            __syncthreads();
            {
                const int ch = ht & 63, tq = ht >> 6;
                float run = 0.f;
#pragma unroll
                for (int i = 0; i < 16; ++i) { run += AAB[(tq * 16 + i) * 64 + ch]; AAB[(tq * 16 + i) * 64 + ch] = run; }
                TOT[tq * 64 + ch] = run;
            }
            __syncthreads();
            TSMARK(1);
#pragma unroll
            for (int q = 0; q < 4; ++q) {
                const int g = q >> 1; const bool hi = q & 1;
                const unsigned r_a = hi ? ur[g].z : ur[g].x, r_b = hi ? ur[g].w : ur[g].y, k_a_ = hi ? uk[g].z : uk[g].x, k_b_ = hi ? uk[g].w : uk[g].y, v_a = hi ? uv[g].z : uv[g].x, v_b = hi ? uv[g].w : uv[g].y;
                const unsigned pr_a = hi ? qr[g].z : qr[g].x, pr_b = hi ? qr[g].w : qr[g].y, pk_a = hi ? qk[g].z : qk[g].x, pk_b = hi ? qk[g].w : qk[g].y, pv_a = hi ? qv[g].z : qv[g].x, pv_b = hi ? qv[g].w : qv[g].y;
                const float r0a[4] = {bflo(r_a), bfhi(r_a), bflo(r_b), bfhi(r_b)}, k0a[4] = {bflo(k_a_), bfhi(k_a_), bflo(k_b_), bfhi(k_b_)}, v0a[4] = {bflo(v_a), bfhi(v_a), bflo(v_b), bfhi(v_b)};
                const float rpa[4] = {bflo(pr_a), bfhi(pr_a), bflo(pr_b), bfhi(pr_b)}, kpa[4] = {bflo(pk_a), bfhi(pk_a), bflo(pk_b), bfhi(pk_b)}, vpa[4] = {bflo(pv_a), bfhi(pv_a), bflo(pv_b), bfhi(pv_b)};
                const float mra[4] = {mr[q].x, mr[q].y, mr[q].z, mr[q].w}, mka[4] = {mk[q].x, mk[q].y, mk[q].z, mk[q].w}, mva[4] = {mv[q].x, mv[q].y, mv[q].z, mv[q].w};
                const float kka[4] = {kkw[q].x, kkw[q].y, kkw[q].z, kkw[q].w}, kaa[4] = {kaw[q].x, kaw[q].y, kaw[q].z, kaw[q].w}, rka[4] = {rkw[q].x, rkw[q].y, rkw[q].z, rkw[q].w};
                const float aaa[4] = {a4v[q].x, a4v[q].y, a4v[q].z, a4v[q].w}, lwa[4] = {l4v[q].x, l4v[q].y, l4v[q].z, l4v[q].w};
#pragma unroll
                for (int e = 0; e < 4; ++e) { const int i = 4 * q + e;
                    rr[i] = r0a[e] + (rpa[e] - r0a[e]) * mra[e]; const float kx = k0a[e] + (kpa[e] - k0a[e]) * mka[e]; vv[i] = v0a[e] + (vpa[e] - v0a[e]) * mva[e];
                    kkv[i] = kx * kka[e]; ss += kkv[i] * kkv[i]; aa[i] = aaa[e]; lwl[i] = lwa[e]; kf[i] = kx * (1.f + (aaa[e] - 1.f) * kaa[e]); scs += rr[i] * kf[i] * rka[e]; }
            }
        }
        {
            ss = sum4(ss); scs = sum4(scs);
            const float rn = rsqrtf(ss + 1e-6f);
            if (seg == 0) SC[(size_t)t * 16 + h] = scs;
            const int tq = r >> 4;
            unsigned wat[8], wbt[8], wkt[8], wrt[8], wvp[8];
            float atv[16], btv[16], ktv[16], rtv[16];
#pragma unroll
            for (int i = 0; i < 16; ++i) {
                const int ch = c0 + i;
                float off = 0.f;
#pragma unroll
                for (int q = 0; q < 3; ++q) off += (q < tq) ? TOT[q * 64 + ch] : 0.f;
                const float tot = TOT[ch] + TOT[64 + ch] + TOT[128 + ch] + TOT[192 + ch];
                const float cs = AAB[r * 64 + ch] + off;
                const float lwv = lwl[i];
                const float kk = kkv[i] * rn;
                const float e2 = __expf(-cs), e4 = __expf(tot - cs);
                atv[i] = kk * __expf(cs - lwv); btv[i] = -kk * aa[i] * e2; ktv[i] = kf[i] * e2; rtv[i] = rr[i] * __expf(cs);
                VT[ch * 72 + r] = f2bf(vv[i]);
                KDT[ch * 72 + r] = f2bf(kf[i] * e4);
                bdv[i] = -kk * aa[i] * e4;
                if (r == 63) RDSC[(size_t)item * 64 + ch] = __expf(tot);
            }
#pragma unroll
            for (int q = 0; q < 8; ++q) { wat[q] = pk2(atv[2 * q], atv[2 * q + 1]); wbt[q] = pk2(btv[2 * q], btv[2 * q + 1]); wkt[q] = pk2(ktv[2 * q], ktv[2 * q + 1]); wrt[q] = pk2(rtv[2 * q], rtv[2 * q + 1]); wvp[q] = pk2(vv[2 * q], vv[2 * q + 1]); }
            *(uint4*)(AT + r * 72 + c0) = make_uint4(wat[0], wat[1], wat[2], wat[3]); *(uint4*)(AT + r * 72 + c0 + 8) = make_uint4(wat[4], wat[5], wat[6], wat[7]);
            *(uint4*)(BTL + r * 72 + c0) = make_uint4(wbt[0], wbt[1], wbt[2], wbt[3]); *(uint4*)(BTL + r * 72 + c0 + 8) = make_uint4(wbt[4], wbt[5], wbt[6], wbt[7]);
            *(uint4*)(KT + r * 72 + c0) = make_uint4(wkt[0], wkt[1], wkt[2], wkt[3]); *(uint4*)(KT + r * 72 + c0 + 8) = make_uint4(wkt[4], wkt[5], wkt[6], wkt[7]);
            *(uint4*)(RT + r * 72 + c0) = make_uint4(wrt[0], wrt[1], wrt[2], wrt[3]); *(uint4*)(RT + r * 72 + c0 + 8) = make_uint4(wrt[4], wrt[5], wrt[6], wrt[7]);
            bf16* a2p = RA2 + (size_t)item * 64 * 64;
            *(uint4*)(a2p + frag_off(r, c0, 2)) = make_uint4(wrt[0], wrt[1], wrt[2], wrt[3]); *(uint4*)(a2p + frag_off(r, c0 + 8, 2)) = make_uint4(wrt[4], wrt[5], wrt[6], wrt[7]);
            bf16* vpp = VP + (size_t)t * 1024 + h * 64 + c0;
            *(uint4*)vpp = make_uint4(wvp[0], wvp[1], wvp[2], wvp[3]); *(uint4*)(vpp + 8) = make_uint4(wvp[4], wvp[5], wvp[6], wvp[7]);
        }
        __syncthreads();
        TSMARK(2);
        if (it0 + (int)gridDim.x * 2 < 4096) RCL_LOAD(item + (int)gridDim.x * 2, tv);
        {
            bf16* BDS = (bf16*)AAB;
#pragma unroll
            for (int i = 0; i < 16; ++i) BDS[(c0 + i) * 72 + r] = f2bf(bdv[i]);
        }
        const int fr = lane & 15, fq = lane >> 4;
        f32x4_t cab[4], cak[4], crb[4], crk[4];
        {
            const int j0t = w4 * 16;
            bf16x8_t bj[2], kj[2];
#pragma unroll
            for (int kb = 0; kb < 2; ++kb) { bj[kb] = *(const bf16x8_t*)(BTL + (j0t + fr) * 72 + kb * 32 + fq * 8); kj[kb] = *(const bf16x8_t*)(KT + (j0t + fr) * 72 + kb * 32 + fq * 8); }
#pragma unroll
            for (int it = 0; it < 4; ++it) {
                cab[it] = (f32x4_t){0.f, 0.f, 0.f, 0.f}; cak[it] = cab[it]; crb[it] = cab[it]; crk[it] = cab[it];
#pragma unroll
                for (int kb = 0; kb < 2; ++kb) {
                    const bf16x8_t ai = *(const bf16x8_t*)(AT + (it * 16 + fr) * 72 + kb * 32 + fq * 8);
                    const bf16x8_t ri = *(const bf16x8_t*)(RT + (it * 16 + fr) * 72 + kb * 32 + fq * 8);
                    cab[it] = MFMA16(bj[kb], ai, cab[it]); cak[it] = MFMA16(kj[kb], ai, cak[it]); crb[it] = MFMA16(bj[kb], ri, crb[it]); crk[it] = MFMA16(kj[kb], ri, crk[it]);
                }
            }
        }
        __syncthreads();
        {
            const bf16* BDS = (const bf16*)AAB; bf16* bp = RA4 + (size_t)item * 64 * 64;
#pragma unroll
            for (int q = 0; q < 2; ++q) { const int p = ht + 256 * q, pfr = p & 15, pfq = (p >> 4) & 3, pkb = (p >> 6) & 1, prt = p >> 7;
                *(uint4*)(bp + p * 8) = *(const uint4*)(BDS + (prt * 16 + pfr) * 72 + pkb * 32 + pfq * 8); }
        }
        __syncthreads();
        {
            const int j0 = w4 * 16 + 4 * fq;
#pragma unroll
            for (int it = 0; it < 4; ++it) {
                const int i = it * 16 + fr;
                float vab[4], vak[4], vrb[4], vrk[4];
#pragma unroll
                for (int rg = 0; rg < 4; ++rg) { const int j = j0 + rg; const bool st = i > j, in = i >= j;
                    vab[rg] = st ? cab[it][rg] : 0.f; vak[rg] = st ? cak[it][rg] : 0.f; vrb[rg] = in ? crb[it][rg] : 0.f; vrk[rg] = in ? crk[it][rg] : 0.f; }
                *(float4*)(AAB + i * 64 + j0) = make_float4(vab[0], vab[1], vab[2], vab[3]);
                uint2 w; w.x = pk2(vak[0], vak[1]); w.y = pk2(vak[2], vak[3]); *(uint2*)(AAK + i * 72 + j0) = w;
                w.x = pk2(vrk[0], vrk[1]); w.y = pk2(vrk[2], vrk[3]); *(uint2*)(ARK + i * 72 + j0) = w;
                w.x = pk2(vrb[0], vrb[1]); w.y = pk2(vrb[2], vrb[3]); *(uint2*)(RA3 + (size_t)item * 64 * 64 + frag_off(i, j0, 2)) = w;
            }
        }
        __syncthreads();
        f32x4_t cav[4], cov[4], ckv[4];
        {
            const int r0t = w4 * 16;
            bf16x8_t fa[2], fo[2], fk[2];
#pragma unroll
            for (int kb = 0; kb < 2; ++kb) { fa[kb] = *(const bf16x8_t*)(AAK + (r0t + fr) * 72 + kb * 32 + fq * 8); fo[kb] = *(const bf16x8_t*)(ARK + (r0t + fr) * 72 + kb * 32 + fq * 8); fk[kb] = *(const bf16x8_t*)(KDT + (r0t + fr) * 72 + kb * 32 + fq * 8); }
#pragma unroll
            for (int vt = 0; vt < 4; ++vt) {
                cav[vt] = (f32x4_t){0.f, 0.f, 0.f, 0.f}; cov[vt] = cav[vt]; ckv[vt] = cav[vt];
#pragma unroll
                for (int kb = 0; kb < 2; ++kb) { const bf16x8_t vb = *(const bf16x8_t*)(VT + (vt * 16 + fr) * 72 + kb * 32 + fq * 8);
                    cav[vt] = MFMA16(fa[kb], vb, cav[vt]); cov[vt] = MFMA16(fo[kb], vb, cov[vt]); ckv[vt] = MFMA16(fk[kb], vb, ckv[vt]); }
            }
        }
        __syncthreads();
        {
            const int r0 = w4 * 16 + 4 * fq;
#pragma unroll
            for (int vt = 0; vt < 4; ++vt) {
                const int v = vt * 16 + fr;
#pragma unroll
                for (int rg = 0; rg < 4; ++rg) RHS2[v * 65 + r0 + rg] = cav[vt][rg];
                { uint2 w; w.x = pk2(cov[vt][0], cov[vt][1]); w.y = pk2(cov[vt][2], cov[vt][3]); *(uint2*)(RO0 + (size_t)item * 64 * 64 + cfrag_off(v, r0, 4)) = w; }
                { uint2 w; w.x = pk2(ckv[vt][0], ckv[vt][1]); w.y = pk2(ckv[vt][2], ckv[vt][3]); *(uint2*)(RS0 + (size_t)item * 64 * 64 + cfrag_off(v, r0, 4)) = w; }
            }
        }
        __syncthreads();
        TSMARK(3);
        {
            const int col = ht >> 1, p = ht & 1, cc = col & 63; const bool isu = col >= 64;
            float xs[32];
#pragma unroll
            for (int i = 0; i < 32; ++i) xs[i] = 0.f;
            float4 mc[8], mn[8];
#pragma unroll
            for (int q = 0; q < 8; ++q) { mc[q] = make_float4(0.f, 0.f, 0.f, 0.f); mn[q] = mc[q]; }
            float rhs_n; { const float rv = RHS2[(isu ? cc : 0) * 65], av = bf2f(AT[(isu ? 0 : cc)]); rhs_n = isu ? rv : av; }
#pragma unroll
            for (int i = 0; i < 64; ++i) {
                const float rhs = rhs_n;
                if (i + 1 < 64) {
#pragma unroll
                    for (int q = 0; q < (i + 8) / 8; ++q) mn[q] = *(const float4*)(AAB + (i + 1) * 64 + 8 * q + 4 * p);
                    const float rv = RHS2[(isu ? cc : 0) * 65 + i + 1], av = bf2f(AT[(i + 1) * 72 + (isu ? 0 : cc)]); rhs_n = isu ? rv : av;
                }
                float a0 = 0.f, a1 = 0.f, a2 = 0.f, a3 = 0.f;
#pragma unroll
                for (int q = 0; q < (i + 7) / 8; ++q) { a0 += mc[q].x * xs[4 * q]; a1 += mc[q].y * xs[4 * q + 1]; a2 += mc[q].z * xs[4 * q + 2]; a3 += mc[q].w * xs[4 * q + 3]; }
                float tot = (a0 + a1) + (a2 + a3);
                tot += dpp_xor1(tot);
                const float xi = rhs + tot;
                const int g = i >> 2, slot = (g >> 1) * 4 + (i & 3);
                xs[slot] = (p == (g & 1)) ? xi : xs[slot];
#pragma unroll
                for (int q = 0; q < 8; ++q) mc[q] = mn[q];
                asm volatile("" ::: "memory");
            }
            if (isu) {
                bf16* up = RX0 + (size_t)item * 64 * 64;
#pragma unroll
                for (int q = 0; q < 8; ++q) { uint2 w; w.x = pk2(xs[4 * q], xs[4 * q + 1]); w.y = pk2(xs[4 * q + 2], xs[4 * q + 3]); *(uint2*)(up + cfrag_off(cc, 4 * (2 * q + p), 4)) = w; }
            }
            __syncthreads();
            TSMARK(4);
            if (!isu) {
#pragma unroll
                for (int q = 0; q < 8; ++q)
#pragma unroll
                    for (int e = 0; e < 4; ++e) AT[(4 * (2 * q + p) + e) * 72 + cc] = f2bf(xs[4 * q + e]);
            }
        }
        __syncthreads();
        {
            bf16* wp = RA1 + (size_t)item * 64 * 64;
#pragma unroll
            for (int q = 0; q < 2; ++q) { const int p = ht + 256 * q, fr = p & 15, fq = (p >> 4) & 3, kb = (p >> 6) & 1, rt = p >> 7;
                *(uint4*)(wp + p * 8) = *(const uint4*)(AT + (rt * 16 + fr) * 72 + kb * 32 + fq * 8); }
        }
    }
    if (TS_BEGIN >= 0 && blockIdx.x == 0 && c.tid == 0) c.ws<unsigned>(WS_CTL)[CW_TS] = (unsigned)ts_acc;
#undef TSMARK
#undef RCL_LOAD
}

template <int DK, bool RW>
struct ScanArgs { const bf16* A1; const bf16* X0; const bf16* A2; const bf16* A3; const bf16* O0; const bf16* A4; const bf16* S0; const float* DSC; bf16* OUT; int item0; int vs; int tok0; int ocol0; };
#define LBAR() do { asm volatile("s_waitcnt lgkmcnt(0)" ::: "memory"); __builtin_amdgcn_s_barrier(); asm volatile("" ::: "memory"); } while (0)
template <int DK, bool RW>
__device__ __forceinline__ void scan_run(const Ctx& c, const ScanArgs<DK, RW>& a) {
    constexpr int KB = DK / 32;
    constexpr int NST = DK / 64;
    constexpr int NV = RW ? 64 : 128;
    constexpr int SROW = DK + 8;
    bf16* ST = (bf16*)c.lds;
    bf16* XT = ST + 2 * 32 * SROW;
    const int lane = c.lane, w = c.wave, fr = lane & 15, fq = lane >> 4;
    const int tm = w >> 1, tn = w & 1;
    const int dkt = (NST == 2) ? w : (w >> 1);
    for (int i = c.tid; i < 32 * SROW / 2; i += NTHREADS) ((unsigned*)ST)[i] = 0u;
    f32x4_t accS[NST];
#pragma unroll
    for (int s = 0; s < NST; ++s) accS[s] = (f32x4_t){0.f, 0.f, 0.f, 0.f};
    bf16x8_t a1f[KB], a2f[KB], a3f[2], a4f[2]; f32x4_t x0v, o0v, s0v[NST], dscv;
#define SCAN_LOAD(IT) do { const size_t it_ = (size_t)(IT); \
        _Pragma("unroll") for (int kb = 0; kb < KB; ++kb) { a1f[kb] = *(const bf16x8_t*)(a.A1 + it_ * 64 * DK + ((tm * KB + kb) * 64 + lane) * 8); a2f[kb] = *(const bf16x8_t*)(a.A2 + it_ * 64 * DK + ((tm * KB + kb) * 64 + lane) * 8); } \
        _Pragma("unroll") for (int kb = 0; kb < 2; ++kb) { a3f[kb] = *(const bf16x8_t*)(a.A3 + it_ * 64 * 64 + ((tm * 2 + kb) * 64 + lane) * 8); a4f[kb] = *(const bf16x8_t*)(a.A4 + it_ * DK * 64 + ((dkt * 2 + kb) * 64 + lane) * 8); } \
        { const uint2 q_ = *(const uint2*)(a.X0 + it_ * NV * 64 + (((a.vs * 2 + tn) * 4 + tm) * 64 + lane) * 4); x0v = (f32x4_t){bflo(q_.x), bfhi(q_.x), bflo(q_.y), bfhi(q_.y)}; } \
        if (RW) { { const uint2 q_ = *(const uint2*)(a.O0 + it_ * NV * 64 + (((a.vs * 2 + tn) * 4 + tm) * 64 + lane) * 4); o0v = (f32x4_t){bflo(q_.x), bfhi(q_.x), bflo(q_.y), bfhi(q_.y)}; } \
                  _Pragma("unroll") for (int s = 0; s < NST; ++s) { const uint2 q_ = *(const uint2*)(a.S0 + it_ * 64 * DK + (((a.vs * 2 + (NST == 2 ? s : tn)) * (DK / 16) + dkt) * 64 + lane) * 4); s0v[s] = (f32x4_t){bflo(q_.x), bfhi(q_.x), bflo(q_.y), bfhi(q_.y)}; } \
                  dscv = *(const f32x4_t*)(a.DSC + it_ * DK + dkt * 16 + 4 * fq); } \
        else { const float g_ = a.DSC[it_]; dscv = (f32x4_t){g_, g_, g_, g_}; o0v = (f32x4_t){0.f, 0.f, 0.f, 0.f}; _Pragma("unroll") for (int s = 0; s < NST; ++s) s0v[s] = (f32x4_t){0.f, 0.f, 0.f, 0.f}; } \
    } while (0)
    SCAN_LOAD(a.item0);
    int cur = 0;
    for (int n = 0; n < 64; ++n) {
        bf16x8_t b1[KB], b2[KB], b3[2], b4[2];
#pragma unroll
        for (int kb = 0; kb < KB; ++kb) { b1[kb] = a1f[kb]; b2[kb] = a2f[kb]; }
        b3[0] = a3f[0]; b3[1] = a3f[1]; b4[0] = a4f[0]; b4[1] = a4f[1];
        f32x4_t accX = x0v, accO = o0v; const f32x4_t dv = dscv; f32x4_t sv[NST];
#pragma unroll
        for (int s = 0; s < NST; ++s) sv[s] = s0v[s];
        if (n + 1 < 64) SCAN_LOAD(a.item0 + n + 1);
        LBAR();
        const bf16* Sc = ST + cur * 32 * SROW; bf16* Sn = ST + (cur ^ 1) * 32 * SROW;
        bf16x8_t sf[KB];
#pragma unroll
        for (int kb = 0; kb < KB; ++kb) sf[kb] = *(const bf16x8_t*)(Sc + (tn * 16 + fr) * SROW + kb * 32 + fq * 8);
#pragma unroll
        for (int kb = 0; kb < KB; ++kb) accX = MFMA16(b1[kb], sf[kb], accX);
        { uint2 wv; wv.x = pk2(accX[0], accX[1]); wv.y = pk2(accX[2], accX[3]); *(uint2*)(XT + (tn * 16 + fr) * 72 + tm * 16 + 4 * fq) = wv; }
#pragma unroll
        for (int kb = 0; kb < KB; ++kb) accO = MFMA16(b2[kb], sf[kb], accO);
        LBAR();
        bf16x8_t xf[2];
#pragma unroll
        for (int kb = 0; kb < 2; ++kb) xf[kb] = *(const bf16x8_t*)(XT + (tn * 16 + fr) * 72 + kb * 32 + fq * 8);
        accO = MFMA16(b3[0], xf[0], accO); accO = MFMA16(b3[1], xf[1], accO);
        {
            bf16* op = a.OUT + (size_t)(a.tok0 + n * 64 + tm * 16 + 4 * fq) * 1024 + a.ocol0 + tn * 16 + fr;
            op[0] = f2bf(accO[0]); op[1024] = f2bf(accO[1]); op[2048] = f2bf(accO[2]); op[3072] = f2bf(accO[3]);
        }
#pragma unroll
        for (int s = 0; s < NST; ++s) {
            const int vt = (NST == 2) ? s : tn;
            bf16x8_t xg[2];
            if (vt == tn) { xg[0] = xf[0]; xg[1] = xf[1]; }
            else {
#pragma unroll
                for (int kb = 0; kb < 2; ++kb) xg[kb] = *(const bf16x8_t*)(XT + (vt * 16 + fr) * 72 + kb * 32 + fq * 8);
            }
            f32x4_t t = accS[s] * dv + sv[s];
            t = MFMA16(b4[0], xg[0], t); t = MFMA16(b4[1], xg[1], t);
            accS[s] = t;
            uint2 wv; wv.x = pk2(t[0], t[1]); wv.y = pk2(t[2], t[3]);
            *(uint2*)(Sn + (vt * 16 + fr) * SROW + dkt * 16 + 4 * fq) = wv;
        }
        cur ^= 1;
    }
#undef SCAN_LOAD
    __syncthreads();
}

__device__ __forceinline__ void ph_scan(const Ctx& c) {
    for (int wk = blockIdx.x; wk < 256; wk += gridDim.x) {
        const int xcd = wk & 7, j = wk >> 3;
        if (j < 16) {
            const int pair = xcd * 4 + (j >> 2), vs = j & 3, b = pair >> 3, h = pair & 7;
            ScanArgs<128, false> a{c.ws<bf16>(WS_GA1), c.ws<bf16>(WS_GX0), c.ws<bf16>(WS_GA2), c.ws<bf16>(WS_GA3), nullptr, c.ws<bf16>(WS_GA4), nullptr, c.ws<float>(WS_GGL),
                                   c.ws<bf16>(WS_OG), pair * 64, vs, b * SEQ, h * 128 + vs * 32};
            scan_run<128, false>(c, a);
        } else {
            const int pair = xcd * 8 + ((j - 16) >> 1), vs = (j - 16) & 1, b = pair >> 4, h = pair & 15;
            ScanArgs<64, true> a{c.ws<bf16>(WS_RA1), c.ws<bf16>(WS_RX0), c.ws<bf16>(WS_RA2), c.ws<bf16>(WS_RA3), c.ws<bf16>(WS_RO0), c.ws<bf16>(WS_RA4), c.ws<bf16>(WS_RS0), c.ws<float>(WS_RDSC),
                                 c.ws<bf16>(WS_ORW), pair * 64, vs, b * SEQ, h * 64 + vs * 32};
            scan_run<64, true>(c, a);
        }
    }
}

enum { PH_RMS0 = 0, PH_INPROJ, PH_GCL, PH_LORA, PH_RCL, PH_SCAN, PH_POST, PH_G2, PH_X1, PH_ROUTER, PH_DISPATCH, PH_MOE1, PH_MOE2, PH_COMBINE, PH_COUNT };

template <unsigned PHMASK>
__global__ void __launch_bounds__(NTHREADS) mk(Params P) {
    extern __shared__ __attribute__((aligned(16))) unsigned char lds[];
    volatile LAS unsigned* misc = (volatile LAS unsigned*)((LAS unsigned char*)lds + MISC_OFF);
    if (threadIdx.x < 64) misc[threadIdx.x] = 0u;
    __syncthreads();
    unsigned* ctl = (unsigned*)(P.ws + WS_CTL);
    XcdBarrier bar = xcd_barrier_post(ctl + CW_BAR + P.li * XCD_BAR_WORDS, misc);
#define MKCTX() int tv_ = threadIdx.x; asm volatile("" : "+v"(tv_)); const int wv_ = __builtin_amdgcn_readfirstlane(tv_ >> 6); \
    Ctx c{P, tv_, tv_ & 63, wv_, (int)(blockIdx.x * NWAVES + wv_), (int)(gridDim.x * NWAVES), (size_t)blockIdx.x * NTHREADS + tv_, (size_t)gridDim.x * NTHREADS, lds}
    bool first_seam = true;
#define IN(k) (((PHMASK >> (k)) & 1u) && P.ph_lo <= (k) && (k) < P.ph_hi)
#define SEAM(k) do { if ((k) + 1 < P.ph_hi) { xcd_barrier(bar); first_seam = false; } } while (0)
#define REP(k) for (int rep_ = 0; rep_ < ((k) == PROBE_REP ? 2 : 1); ++rep_)
    if (IN(PH_RMS0)) { MKCTX();
        REP(PH_RMS0) {
        ph_rms0(c);
        { WJob j{P.in[I_W_IN], NCOL_IN, 1024, 4096, c.ws<bf16>(WS_WIN_T), 1024, 1, 0, 0}; wconv_job(c, j); }
        { WJob j{P.in[I_W_IN] + 4112, NCOL_IN, 1024, 5376, c.ws<bf16>(WS_WIN_T) + (size_t)4096 * 1024, 1024, 1, 0, 0}; wconv_job(c, j); }
        lora_zero(c);
        { WJob j{P.in[I_W2], 1024, 64, 1024, c.ws<bf16>(WS_LORA_T), 256, 1, 0, 0}; wconv_job(c, j); }
        { WJob j{P.in[I_A2], 1024, 64, 1024, c.ws<bf16>(WS_LORA_T) + (size_t)1024 * 256 + 64, 256, 1, 0, 0}; wconv_job(c, j); }
        { WJob j{P.in[I_G2], 1024, 128, 1024, c.ws<bf16>(WS_LORA_T) + (size_t)2048 * 256 + 128, 256, 1, 0, 0}; wconv_job(c, j); }
        }
        SEAM(PH_RMS0);
    }
    if (IN(PH_INPROJ)) { MKCTX();
        REP(PH_INPROJ) {
        EpiInProj ep{c.ws<bf16>(WS_GQKV), c.ws<bf16>(WS_ZS), c.ws<bf16>(WS_RKV), c.ws<float>(WS_LIN), c.ws<bf16>(WS_GATES)};
        SchedInProj sc{(const char*)c.ws<bf16>(WS_HB), (const char*)c.ws<bf16>(WS_WIN_T), (int)gridDim.x, (int)blockIdx.x};
        pg8::gemm_phase((LAS unsigned char*)lds, 1024, sc, ep, c.tid);
        }
        SEAM(PH_INPROJ);
    }
    if (IN(PH_GCL)) { MKCTX(); REP(PH_GCL) { ph_gcl(c); ph_loraprep(c); } SEAM(PH_GCL); }
    if (IN(PH_LORA)) { MKCTX();
        REP(PH_LORA) {
        EpiLora ep{P.in[I_W0], P.in[I_A0], c.ws<float>(WS_LW), c.ws<float>(WS_AA), c.ws<bf16>(WS_GGR)};
        SchedLora sc{(const char*)c.ws<bf16>(WS_ALORA), (const char*)c.ws<bf16>(WS_LORA_T), (int)gridDim.x, (int)blockIdx.x};
        pg8::gemm_phase((LAS unsigned char*)lds, 256, sc, ep, c.tid);
        }
        SEAM(PH_LORA);
    }
    if (IN(PH_RCL)) { MKCTX(); REP(PH_RCL) { ph_rcl(c); } SEAM(PH_RCL); }
    if (IN(PH_SCAN)) { MKCTX(); REP(PH_SCAN) { ph_scan(c); } SEAM(PH_SCAN); }
    if (IN(PH_POST)) { MKCTX();
        REP(PH_POST) {
        ph_post(c);
        { WJob j{P.in[I_PROJ_A], 1024, 1024, 1024, c.ws<bf16>(WS_PROJ_T), 1024, 1, 0, 0}; wconv_job(c, j); }
        { WJob j{P.in[I_PROJ_B], 1024, 1024, 1024, c.ws<bf16>(WS_PROJ_T) + (size_t)1024 * 1024, 1024, 1, 0, 0}; wconv_job(c, j); }
        { WJob j{P.in[I_W_OUT], 1024, 1024, 1024, c.ws<bf16>(WS_WOUT_T), 1024, 1, 0, 0}; wconv_job(c, j); }
        }
        SEAM(PH_POST);
    }
    if (IN(PH_G2)) { MKCTX();
        REP(PH_G2) {
        EpiG2 ep{c.ws<bf16>(WS_GATES), c.ws<bf16>(WS_G2)};
        SchedG2 sc{(const char*)c.ws<bf16>(WS_YA), (const char*)c.ws<bf16>(WS_PROJ_T), (int)gridDim.x, (int)blockIdx.x};
        pg8::gemm_phase((LAS unsigned char*)lds, 1024, sc, ep, c.tid);
        }
        SEAM(PH_G2);
    }
    if (IN(PH_X1)) { MKCTX();
        REP(PH_X1) {
        EpiX1 ep{P.in[I_X], c.ws<float>(WS_X1)};
        SchedX1 sc{(const char*)c.ws<bf16>(WS_G2), (const char*)c.ws<bf16>(WS_WOUT_T), (int)gridDim.x, (int)blockIdx.x};
        pg8::gemm_phase((LAS unsigned char*)lds, 1024, sc, ep, c.tid);
        }
        SEAM(PH_X1);
    }
    if (IN(PH_ROUTER)) { MKCTX();
        ph_router(c);
        REP(PH_ROUTER) {
        { WJob j{P.in[I_W_GU], 2048, 1024, 2048, c.ws<bf16>(WS_WGU_T), 1024, 32, (size_t)1024 * 2048, (size_t)2048 * 1024}; wconv_job(c, j); }
        { WJob j{P.in[I_W_DOWN], 1024, 1024, 1024, c.ws<bf16>(WS_WDN_T), 1024, 32, (size_t)1024 * 1024, (size_t)1024 * 1024}; wconv_job(c, j); }
        }
        SEAM(PH_ROUTER);
    }
    if (IN(PH_DISPATCH)) { MKCTX(); REP(PH_DISPATCH) { ph_dispatch(c); } SEAM(PH_DISPATCH); }
    if (IN(PH_MOE1)) { MKCTX();
        REP(PH_MOE1) {
        const int nt = *c.ws<int>(WS_NT);
        EpiAct ep{P.in[I_B_GU], c.ws<bf16>(WS_ACT)};
        SchedMoe sc{(const char*)c.ws<bf16>(WS_H2), (const char*)c.ws<bf16>(WS_WGU_T), c.ws<int>(WS_TILE_E), c.ws<int>(WS_SLOT_TOK), nt, 8, (int)gridDim.x, (int)blockIdx.x};
        pg8::gemm_phase_t<true>((LAS unsigned char*)lds, 1024, sc, ep, c.tid);
        }
        SEAM(PH_MOE1);
    }
    if (IN(PH_MOE2)) { MKCTX();
        REP(PH_MOE2) {
        const int nt = *c.ws<int>(WS_NT);
        EpiYS ep{P.in[I_B_DOWN], c.ws<float>(WS_SGATE), c.ws<bf16>(WS_YS)};
        SchedMoe sc{(const char*)c.ws<bf16>(WS_ACT), (const char*)c.ws<bf16>(WS_WDN_T), c.ws<int>(WS_TILE_E), nullptr, nt, 4, (int)gridDim.x, (int)blockIdx.x};
        pg8::gemm_phase((LAS unsigned char*)lds, 1024, sc, ep, c.tid);
        }
        SEAM(PH_MOE2);
    }
    if (IN(PH_COMBINE)) { MKCTX(); REP(PH_COMBINE) { ph_combine(c); } }
#undef IN
#undef SEAM
#undef REP
#undef MKCTX
}

template <unsigned M> static void launch_one(const Params& p, int grid, hipStream_t stream) {
    static bool attr = false;
    if (!attr) { (void)hipFuncSetAttribute((const void*)mk<M>, hipFuncAttributeMaxDynamicSharedMemorySize, LDS_BYTES); attr = true; }
    hipLaunchKernelGGL(mk<M>, dim3(grid), dim3(NTHREADS), LDS_BYTES, stream, p);
}
template <int PH> static void launch_chain(Params& p, int grid, hipStream_t stream) {
    if constexpr (PH < PH_COUNT) { p.ph_lo = PH; p.ph_hi = PH + 1; p.li = 0; p.coop = 0; launch_one<(1u << PH)>(p, grid, stream); launch_chain<PH + 1>(p, grid, stream); }
}

extern "C" void kernel_launch(void* const* d_in, const int* in_sizes, int n_in, void* d_out, int out_size, void* d_ws, size_t ws_size, hipStream_t stream) {
    static int grid = 0;
    if (grid == 0) {
        int dev = 0, cus = 0, per_cu = 0;
        (void)hipGetDevice(&dev);
        (void)hipDeviceGetAttribute(&cus, hipDeviceAttributeMultiprocessorCount, dev);
#if MK_ONE_LAUNCH
        (void)hipFuncSetAttribute((const void*)mk<0xffffffffu>, hipFuncAttributeMaxDynamicSharedMemorySize, LDS_BYTES);
        (void)hipOccupancyMaxActiveBlocksPerMultiprocessor(&per_cu, (const void*)mk<0xffffffffu>, NTHREADS, LDS_BYTES);
#else
        per_cu = 1;
#endif
        if (n_in != 29 || ws_size < WS_END || per_cu < 1 || cus < 64) { fprintf(stderr, "kernel_launch: unexpected setup n_in %d ws %zu per_cu %d cus %d\n", n_in, ws_size, per_cu, cus); grid = -1; return; }
        grid = cus;
    }
    if (grid < 0) return;
    (void)hipMemsetAsync((char*)d_ws + WS_CTL, 0, CTL_BYTES, stream);
    Params p{};
    for (int i = 0; i < 29; ++i) p.in[i] = (const float*)d_in[i];
    p.out = (float*)d_out; p.ws = (unsigned char*)d_ws;
#if MK_ONE_LAUNCH
    p.ph_lo = 0; p.ph_hi = PH_COUNT; p.li = 0; p.coop = 1;
    void* args[] = {&p};
    hipError_t e = hipLaunchCooperativeKernel((const void*)mk<0xffffffffu>, dim3(grid), dim3(NTHREADS), args, LDS_BYTES, stream);
    if (e != hipSuccess) fprintf(stderr, "cooperative launch failed: %s (grid %d)\n", hipGetErrorString(e), grid);
#else
    launch_chain<0>(p, grid, stream);
#endif
}
```

```cpp
#include <hip/hip_runtime.h>
#include <hip/hip_cooperative_groups.h>
#include <cstdint>
#include <cstdio>
namespace cg = cooperative_groups;

#ifndef MK_ONE_LAUNCH
#define MK_ONE_LAUNCH 1
#endif

#define LAS __attribute__((address_space(3)))
#ifndef FAST_INPROJ
#define FAST_INPROJ 1
#endif
#ifndef FAST_MIX
#define FAST_MIX 1
#endif
#define TS_BEGIN -1
#define TS_END -1
#define PROBE_REP -1
constexpr int NTHREADS = 512;
constexpr int NWAVES = 8;
constexpr int LDS_BYTES = 155648;
constexpr int MISC_OFF = 153600;

constexpr int T = 16384, SEQ = 4096, D = 1024;
constexpr int NCOL_IN = 9488;
constexpr int NEXP = 32;
constexpr int MAXTILES = 288;
constexpr int MAXSLOTS = MAXTILES * 256;

enum { I_X = 0, I_NORM_MIX, I_W_IN, I_GDN_CONV, I_GDN_ALOG, I_GDN_DTB, I_GDN_NORM, I_MU, I_W0, I_W2, I_A0, I_A2, I_G2, I_KK, I_KA, I_RK,
       I_LNW, I_LNB, I_PROJ_A, I_PROJ_B, I_W_OUT, I_NORM_FFN, I_ROUTER_W, I_ROUTER_B, I_W_GU, I_B_GU, I_W_DOWN, I_B_DOWN, I_NORM_FINAL };

constexpr size_t MiB = 1u << 20;
constexpr size_t WS_CTL = 0, CTL_BYTES = 65536;
constexpr size_t WS_BETA = 1 * MiB;
constexpr size_t WS_GG = WS_BETA + 512 * 1024;
constexpr size_t WS_SC = 2 * MiB;
constexpr size_t WS_TE = 3 * MiB;
constexpr size_t WS_TG = WS_TE + 256 * 1024;
constexpr size_t WS_TP = WS_TG + 256 * 1024;
constexpr size_t WS_TSLOT = WS_TP + 256 * 1024;
constexpr size_t WS_SGATE = 4 * MiB;
constexpr size_t WS_SLOT_TOK = 4 * MiB + 512 * 1024;
constexpr size_t WS_TILE_E = 5 * MiB;
constexpr size_t WS_NT = WS_TILE_E + 4096;
constexpr size_t WS_HB = 8 * MiB;
constexpr size_t WS_H2 = WS_HB;
constexpr size_t WS_ZS = 40 * MiB;
constexpr size_t WS_GATES = 72 * MiB;
constexpr size_t WS_ALORA = 136 * MiB;
constexpr size_t WS_LW = 144 * MiB;
constexpr size_t WS_AA = 208 * MiB;
constexpr size_t WS_GGR = 272 * MiB;
constexpr size_t WS_VP = 304 * MiB;
constexpr size_t WS_Q = 336 * MiB;
constexpr size_t WS_QKVC = WS_Q;
constexpr size_t WS_RP = WS_Q, WS_KF = WS_Q + 64 * MiB, WS_KKN = WS_Q + 128 * MiB;
constexpr size_t WS_YA = WS_Q, WS_YB = WS_Q + 32 * MiB, WS_G2 = WS_Q + 64 * MiB, WS_X1 = WS_Q + 128 * MiB;
constexpr size_t WS_GQKV = 528 * MiB;
constexpr size_t WS_OG = 720 * MiB, WS_ORW = 784 * MiB;
constexpr size_t WS_RKV = 720 * MiB;
constexpr size_t WS_LIN = 912 * MiB;
constexpr size_t WS_DEC = 928 * MiB;
constexpr size_t WS_XB = 528 * MiB;
constexpr size_t WS_ACT = 672 * MiB;
constexpr size_t WS_YS = 816 * MiB;
constexpr size_t WS_WIN_T = 992 * MiB;
constexpr size_t WS_PROJ_T = 144 * MiB;
constexpr size_t WS_WOUT_T = 148 * MiB;
constexpr size_t WS_WGU_T = 72 * MiB;
constexpr size_t WS_WDN_T = 200 * MiB;
constexpr size_t WS_GA1 = 336 * MiB, WS_GX0 = 368 * MiB, WS_GA2 = 432 * MiB, WS_GA3 = 464 * MiB, WS_GA4 = 480 * MiB;
constexpr size_t WS_GGL = 6 * MiB;
constexpr size_t WS_RX0 = 528 * MiB, WS_RO0 = 592 * MiB, WS_RS0 = 656 * MiB;
constexpr size_t WS_RA1 = 8 * MiB, WS_RA2 = 928 * MiB, WS_RA3 = 960 * MiB, WS_RA4 = 992 * MiB;
constexpr size_t WS_RDSC = 7 * MiB;
constexpr size_t WS_LORA_T = 1012 * MiB;
constexpr size_t WS_END = 1024 * MiB;
constexpr int CW_BAR = 1024;
constexpr int CW_CNT = 256;
constexpr int CW_TS = 900;

#define XB_TMO      128
#define XB_XCNT(j)  (256  + 64 * (j))
#define XB_XSUB(j)  (1280 + 64 * (j))
#define XB_XGEN(j)  (2304 + 64 * (j))
#define XB_TOP      3328
#define XB_TOPGEN   3392
#define XCD_BAR_WORDS 3456
#define XB_SPIN_CAP (1u << 24)
__device__ __forceinline__ unsigned xb_ld(unsigned* p)              { return __hip_atomic_load(p, __ATOMIC_RELAXED, __HIP_MEMORY_SCOPE_AGENT); }
__device__ __forceinline__ unsigned xb_add(unsigned* p, unsigned v) { return __hip_atomic_fetch_add(p, v, __ATOMIC_RELAXED, __HIP_MEMORY_SCOPE_AGENT); }
__device__ __forceinline__ unsigned xb_xcc_id() { return (unsigned)__builtin_amdgcn_s_getreg((3 << 11) | 20) & 0xFu; }
#define XB_SPIN(cond, bar) do { unsigned _sp = 0; while (cond) { __builtin_amdgcn_s_sleep(1); \
    if ((++_sp & 255u) == 0u) { if (xb_ld(&(bar)[XB_TMO])) break; if (_sp > XB_SPIN_CAP) { atomicAdd(&(bar)[XB_TMO], 1u); break; } } } } while (0)
struct XcdBarrier { unsigned* bar; unsigned x; volatile LAS unsigned* st; };
__device__ __forceinline__ XcdBarrier xcd_barrier_post(unsigned* bar, volatile LAS unsigned* st) {
    XcdBarrier b; b.bar = bar; b.x = xb_xcc_id(); b.st = st;
    if (threadIdx.x == 0) (void)xb_add(&bar[XB_XCNT(b.x)], 1u);
    return b;
}
__device__ __forceinline__ void xcd_barrier_complete(unsigned* bar, unsigned x, unsigned& nloc, unsigned& nx) {
    const unsigned G = gridDim.x * gridDim.y * gridDim.z;
    unsigned sum, cnt, mine, sp = 0u;
    for (;;) {
        sum = 0u; cnt = 0u; mine = 0u;
#pragma unroll
        for (unsigned j = 0; j < 16; ++j) { const unsigned c = xb_ld(&bar[XB_XCNT(j)]); sum += c; cnt += (c > 0u) ? 1u : 0u; mine = (j == x) ? c : mine; }
        if (sum == G) break;
        __builtin_amdgcn_s_sleep(1);
        if ((++sp & 255u) == 0u) { if (xb_ld(&bar[XB_TMO])) break; if (sp > XB_SPIN_CAP) { atomicAdd(&bar[XB_TMO], 1u); break; } }
    }
    nloc = mine > 0u ? mine : 1u; nx = cnt > 0u ? cnt : 1u;
}
__device__ __forceinline__ void xcd_barrier(const XcdBarrier& b) {
    asm volatile("s_waitcnt vmcnt(0)" ::: "memory");
    __syncthreads();
    if (threadIdx.x == 0) {
        unsigned* bar = b.bar;
        __builtin_amdgcn_s_waitcnt(0);
        unsigned nloc = b.st[0], nx = b.st[1];
        if (nloc == 0u) { xcd_barrier_complete(bar, b.x, nloc, nx); b.st[0] = nloc; b.st[1] = nx; }
        const unsigned old = xb_add(&bar[XB_XSUB(b.x)], 1u);
        const unsigned gen = old / nloc;
        if (old + 1u == (gen + 1u) * nloc) {
            __builtin_amdgcn_fence(__ATOMIC_RELEASE, "agent");
            asm volatile("s_waitcnt vmcnt(0)" ::: "memory");
            const unsigned og = xb_add(&bar[XB_TOP], 1u);
            const unsigned tg = og / nx;
            if (og + 1u == (tg + 1u) * nx) xb_add(&bar[XB_TOPGEN], 1u);
            else XB_SPIN(xb_ld(&bar[XB_TOPGEN]) == tg, bar);
            __builtin_amdgcn_fence(__ATOMIC_ACQUIRE, "agent");
            xb_add(&bar[XB_XGEN(b.x)], 1u);
            asm volatile("s_waitcnt vmcnt(0)" ::: "memory");
        } else {
            XB_SPIN(xb_ld(&bar[XB_XGEN(b.x)]) == gen, bar);
            __builtin_amdgcn_fence(__ATOMIC_ACQUIRE, "agent");
            asm volatile("s_waitcnt vmcnt(0)" ::: "memory");
        }
    }
    __syncthreads();
}

typedef unsigned short bf16;
typedef __bf16 bf16x2_t __attribute__((ext_vector_type(2)));
__device__ __forceinline__ bf16 f2bf(float f) { return __builtin_bit_cast(unsigned short, (__bf16)f); }
__device__ __forceinline__ float bf2f(unsigned b) { return __uint_as_float(b << 16); }
__device__ __forceinline__ unsigned pk2(float lo, float hi) { bf16x2_t v; v[0] = (__bf16)lo; v[1] = (__bf16)hi; return __builtin_bit_cast(unsigned, v); }
__device__ __forceinline__ float bflo(unsigned w) { return __uint_as_float(w << 16); }
__device__ __forceinline__ float bfhi(unsigned w) { return __uint_as_float(w & 0xffff0000u); }
__device__ __forceinline__ float sigm(float x) { return 1.f / (1.f + expf(-x)); }
__device__ __forceinline__ float fsigm(float x) { return __builtin_amdgcn_rcpf(1.f + __expf(-x)); }
__device__ __forceinline__ float softplusf(float x) { return x > 20.f ? x : log1pf(expf(x)); }
__device__ __forceinline__ float dpp_xor1(float v) { return __int_as_float(__builtin_amdgcn_update_dpp(0, __float_as_int(v), 0xB1, 0xF, 0xF, false)); }
template <int CTRL, int ROWMASK>
__device__ __forceinline__ float dpp_add(float v) { return v + __int_as_float(__builtin_amdgcn_update_dpp(0, __float_as_int(v), CTRL, ROWMASK, 0xF, false)); }
__device__ __forceinline__ float sum4(float v)  { v = dpp_add<0xB1, 0xF>(v); return dpp_add<0x4E, 0xF>(v); }
__device__ __forceinline__ float sum8(float v)  { return dpp_add<0x141, 0xF>(sum4(v)); }
__device__ __forceinline__ float sum16(float v) { return dpp_add<0x140, 0xF>(sum8(v)); }
__device__ __forceinline__ float wsum(float v) {
    v = sum16(v);
    v = dpp_add<0x142, 0xA>(v);
    v = dpp_add<0x143, 0xC>(v);
    return __int_as_float(__builtin_amdgcn_readlane(__float_as_int(v), 63));
}

struct Params { const float* in[29]; float* out; unsigned char* ws; int ph_lo, ph_hi, li, coop; };

struct Ctx {
    const Params& P; int tid, lane, wave, gwave, nwaves; size_t gtid, nthreads; unsigned char* lds;
    template <class Tp> __device__ __forceinline__ Tp* ws(size_t off) const { return (Tp*)(P.ws + off); }
};

__device__ __forceinline__ void ph_rms0(const Ctx& c) {
    const float* x = c.P.in[I_X]; const float* nw = c.P.in[I_NORM_MIX]; const float* win = c.P.in[I_W_IN];
    const float* alog = c.P.in[I_GDN_ALOG]; const float* dtb = c.P.in[I_GDN_DTB];
    bf16* HB = c.ws<bf16>(WS_HB); float* BETA = c.ws<float>(WS_BETA); float* GGv = c.ws<float>(WS_GG);
    if (blockIdx.x == 0 && c.tid < NEXP) c.ws<unsigned>(WS_CTL)[CW_CNT + c.tid] = 0u;
    float4* tab = (float4*)c.lds;
    __syncthreads();
    for (int i = c.tid; i < 4096; i += NTHREADS) { const int k = i >> 2; tab[((k & 3) * 256 + (k >> 2)) * 5 + (i & 3)] = *(const float4*)(win + (size_t)k * NCOL_IN + 4096 + (i & 3) * 4); }
    __syncthreads();
    const int lane = c.lane;
    for (int t = c.gwave; t < T; t += c.nwaves) {
        float4 v[4]; float ss = 0.f;
#pragma unroll
        for (int i = 0; i < 4; ++i) { v[i] = ((const float4*)(x + (size_t)t * D))[lane + 64 * i]; ss += v[i].x * v[i].x + v[i].y * v[i].y + v[i].z * v[i].z + v[i].w * v[i].w; }
        ss = wsum(ss);
        const float rstd = rsqrtf(ss * (1.f / 1024.f) + 1e-6f);
        float acc[16];
#pragma unroll
        for (int j = 0; j < 16; ++j) acc[j] = 0.f;
#pragma unroll
        for (int i = 0; i < 4; ++i) {
            const float4 w4 = ((const float4*)nw)[lane + 64 * i];
            float h[4] = {v[i].x * rstd * w4.x, v[i].y * rstd * w4.y, v[i].z * rstd * w4.z, v[i].w * rstd * w4.w};
            uint2 st; st.x = pk2(h[0], h[1]); st.y = pk2(h[2], h[3]);
            *(uint2*)(HB + (size_t)t * D + 4 * (lane + 64 * i)) = st;
#pragma unroll
            for (int ii = 0; ii < 4; ++ii) {
                const int k = 4 * (lane + 64 * i) + ii;
#pragma unroll
                for (int q = 0; q < 4; ++q) { const float4 w = tab[(ii * 256 + (k >> 2)) * 5 + q]; acc[4 * q + 0] += h[ii] * w.x; acc[4 * q + 1] += h[ii] * w.y; acc[4 * q + 2] += h[ii] * w.z; acc[4 * q + 3] += h[ii] * w.w; }
                if (ii & 1) asm volatile("" ::: "memory");
            }
        }
        float mine = 0.f;
#pragma unroll
        for (int j = 0; j < 16; ++j) { const float s = wsum(acc[j]); mine = (lane == j) ? s : mine; }
        if (lane < 8) BETA[t * 8 + lane] = sigm(mine);
        else if (lane < 16) { const int h = lane - 8; GGv[t * 8 + h] = -expf(alog[h]) * softplusf(mine + dtb[h]); }
    }
    __syncthreads();
}

struct NoLd {};
struct EpiInProj {
    typedef NoLd Ld; static constexpr int MB = 1;
    bf16* GQKV; bf16* ZS; bf16* RKV; float* LIN; bf16* GATES;
    __device__ __forceinline__ void load(Ld&, int, int, int) const {}
    __device__ __forceinline__ void store8(int row, int col, const float (&v)[8], int, const Ld&) const {
        if (col < 3072) { uint4 w; w.x = pk2(v[0], v[1]); w.y = pk2(v[2], v[3]); w.z = pk2(v[4], v[5]); w.w = pk2(v[6], v[7]); *(uint4*)(GQKV + (size_t)row * 3072 + col) = w; }
        else if (col < 4096) { uint4 w; w.x = pk2(v[0] * fsigm(v[0]), v[1] * fsigm(v[1])); w.y = pk2(v[2] * fsigm(v[2]), v[3] * fsigm(v[3])); w.z = pk2(v[4] * fsigm(v[4]), v[5] * fsigm(v[5])); w.w = pk2(v[6] * fsigm(v[6]), v[7] * fsigm(v[7]));
            *(uint4*)(ZS + (size_t)row * 1024 + (col - 3072)) = w; }
        else if (col < 7168) { uint4 w; w.x = pk2(v[0], v[1]); w.y = pk2(v[2], v[3]); w.z = pk2(v[4], v[5]); w.w = pk2(v[6], v[7]); *(uint4*)(RKV + (size_t)row * 3072 + (col - 4096)) = w; }
        else if (col < 7424) { float* p = LIN + (size_t)row * 256 + (col - 7168); *(float4*)p = make_float4(v[0], v[1], v[2], v[3]); *(float4*)(p + 4) = make_float4(v[4], v[5], v[6], v[7]); }
        else { uint4 w; w.x = pk2(fsigm(v[0]), fsigm(v[1])); w.y = pk2(fsigm(v[2]), fsigm(v[3])); w.z = pk2(fsigm(v[4]), fsigm(v[5])); w.w = pk2(fsigm(v[6]), fsigm(v[7]));
            *(uint4*)(GATES + (size_t)row * 2048 + (col - 7424)) = w; }
    }
};
struct EpiG2 {
    struct Ld { uint4 g; uint4 p; }; static constexpr int MB = 1;
    const bf16* GATES; bf16* MG;
    __device__ __forceinline__ void load(Ld& l, int row, int col, int) const { l.g = *(const uint4*)(GATES + (size_t)row * 2048 + col); const uint4 q = *(const uint4*)(MG + (size_t)row * 1024 + (col & 1023)); const bool b = col >= 1024; l.p = make_uint4(b ? q.x : 0u, b ? q.y : 0u, b ? q.z : 0u, b ? q.w : 0u); }
    __device__ __forceinline__ void store8(int row, int col, const float (&v)[8], int, const Ld& l) const {
        const uint4 g = l.g, p = l.p;
        uint4 w; w.x = pk2(v[0] * bflo(g.x) + bflo(p.x), v[1] * bfhi(g.x) + bfhi(p.x)); w.y = pk2(v[2] * bflo(g.y) + bflo(p.y), v[3] * bfhi(g.y) + bfhi(p.y));
        w.z = pk2(v[4] * bflo(g.z) + bflo(p.z), v[5] * bfhi(g.z) + bfhi(p.z)); w.w = pk2(v[6] * bflo(g.w) + bflo(p.w), v[7] * bfhi(g.w) + bfhi(p.w));
        *(uint4*)(MG + (size_t)row * 1024 + (col & 1023)) = w;
    }
};
struct EpiX1 {
    struct Ld { float4 a, b; }; static constexpr int MB = 2;
    const float* X; float* X1;
    __device__ __forceinline__ void load(Ld& l, int row, int col, int) const { const float* xp = X + (size_t)row * 1024 + col; l.a = *(const float4*)xp; l.b = *(const float4*)(xp + 4); }
    __device__ __forceinline__ void store8(int row, int col, const float (&v)[8], int, const Ld& l) const {
        float* op = X1 + (size_t)row * 1024 + col;
        const float4 a = l.a, b = l.b;
        *(float4*)op = make_float4(a.x + v[0], a.y + v[1], a.z + v[2], a.w + v[3]); *(float4*)(op + 4) = make_float4(b.x + v[4], b.y + v[5], b.z + v[6], b.w + v[7]);
    }
};
struct EpiAct {
    struct Ld { float4 b0, b1; }; static constexpr int MB = 4;
    const float* BGU; bf16* ACT;
    __device__ __forceinline__ void load(Ld& l, int, int col, int e) const { const float* bp = BGU + (size_t)e * 2048 + col; l.b0 = *(const float4*)bp; l.b1 = *(const float4*)(bp + 4); }
    __device__ __forceinline__ void store8(int row, int col, const float (&v)[8], int e, const Ld& l) const {
        const float4 b0 = l.b0, b1 = l.b1;
        const float bb[8] = {b0.x, b0.y, b0.z, b0.w, b1.x, b1.y, b1.z, b1.w};
        float o[4];
#pragma unroll
        for (int p = 0; p < 4; ++p) { float glu = v[2 * p] + bb[2 * p], lin = v[2 * p + 1] + bb[2 * p + 1]; glu = fminf(glu, 7.f); lin = fminf(fmaxf(lin, -7.f), 7.f); o[p] = glu * fsigm(1.702f * glu) * (lin + 1.f); }
        uint2 w; w.x = pk2(o[0], o[1]); w.y = pk2(o[2], o[3]);
        *(uint2*)(ACT + (size_t)row * 1024 + (col >> 1)) = w;
    }
};
struct EpiYS {
    struct Ld { float4 b0, b1; float g; }; static constexpr int MB = 4;
    const float* BD; const float* SGATE; bf16* YS;
    __device__ __forceinline__ void load(Ld& l, int row, int col, int e) const { const float* bp = BD + (size_t)e * 1024 + col; l.g = SGATE[row]; l.b0 = *(const float4*)bp; l.b1 = *(const float4*)(bp + 4); }
    __device__ __forceinline__ void store8(int row, int col, const float (&v)[8], int e, const Ld& l) const {
        const float g = l.g; const float4 b0 = l.b0, b1 = l.b1;
        uint4 w; w.x = pk2((v[0] + b0.x) * g, (v[1] + b0.y) * g); w.y = pk2((v[2] + b0.z) * g, (v[3] + b0.w) * g); w.z = pk2((v[4] + b1.x) * g, (v[5] + b1.y) * g); w.w = pk2((v[6] + b1.z) * g, (v[7] + b1.w) * g);
        *(uint4*)(YS + (size_t)row * 1024 + col) = w;
    }
};


namespace pg8 {
typedef short bf16x8 __attribute__((ext_vector_type(8)));
typedef float f32x4 __attribute__((ext_vector_type(4)));
constexpr int BM = 256, BK = 64, HALF = 128, HTB = HALF * BK * 2, NXCD = 8, WGM = 8;
__host__ __device__ __forceinline__ int lds_byte(int r, int c) { const int st = (r >> 4) * 2 + (c >> 5), rr = r & 15, cc = c & 31, ob = rr * 64 + cc * 2; return st * 1024 + (ob ^ (((ob >> 9) & 1) << 5)); }
__host__ __device__ __forceinline__ void stage_rc(int b, int& R, int& C) { const int st = b / 1024, sb = b % 1024, swz = sb ^ (((sb >> 9) & 1) << 5); R = (st >> 1) * 16 + swz / 64; C = (st & 1) * 32 + (swz % 64) / 2; }
__host__ __device__ __forceinline__ int perm32(int rho) { const int n = rho >> 4, i = rho & 15; return 8 * (i >> 2) + 4 * n + (i & 3); }
struct Unit { const char* a; const char* b; const int* rowmap; int row0, col0, aux; };
__device__ __forceinline__ void tile_order(int L, int nM, int nN, int& pm, int& pn) {
    const int nwg = nM * nN; int wgid = L; { const int q = nwg / NXCD, r = nwg % NXCD, xcd = wgid % NXCD, off = wgid / NXCD; wgid = (xcd < r ? xcd * (q + 1) : r * (q + 1) + (xcd - r) * q) + off; }
    const int nig = WGM * nN, gid = wgid / nig, fm = gid * WGM, gsz = (nM - fm) < WGM ? (nM - fm) : WGM;
    pm = fm + ((wgid % nig) % gsz); pn = (wgid % nig) / gsz;
}
template <class Epi>
__device__ __forceinline__ void epi_apply(const Epi& E, const f32x4 (&acc)[2][2][4][2], const Unit& u, int wr, int wc, int fr, int fq) {
    constexpr int MB = Epi::MB;
#pragma unroll
    for (int ai = 0; ai < 2; ++ai)
#pragma unroll
        for (int mp = 0; mp < 4 / MB; ++mp) {
            typename Epi::Ld ld[MB][2];
#pragma unroll
            for (int mm = 0; mm < MB; ++mm)
#pragma unroll
                for (int bj = 0; bj < 2; ++bj) E.load(ld[mm][bj], u.row0 + ai * HALF + wr * 64 + (mp * MB + mm) * 16 + fr, u.col0 + bj * HALF + wc * 32 + 8 * fq, u.aux);
#pragma unroll
            for (int mm = 0; mm < MB; ++mm)
#pragma unroll
                for (int bj = 0; bj < 2; ++bj) {
                    const int m = mp * MB + mm;
                    const f32x4 x0 = acc[ai][bj][m][0], x1 = acc[ai][bj][m][1];
                    const float v[8] = {x0[0], x0[1], x0[2], x0[3], x1[0], x1[1], x1[2], x1[3]};
                    E.store8(u.row0 + ai * HALF + wr * 64 + m * 16 + fr, u.col0 + bj * HALF + wc * 32 + 8 * fq, v, u.aux, ld[mm][bj]);
                }
            asm volatile("" ::: "memory");
        }
}
template <bool GATHER, class Epi, class Sched>
__device__ __forceinline__ void gemm_phase_t(LAS unsigned char* lds, const int K_, const Sched& S, const Epi& E, const int tid) {
    int K = K_; asm volatile("" : "+s"(K));
    const int wid = __builtin_amdgcn_readfirstlane(tid >> 6), lane = tid & 63, wr = wid >> 2, wc = wid & 3, fr = lane & 15, fq = lane >> 4;
    const int nt = K / BK;
    unsigned voffA[2], voffB[2];
#pragma unroll
    for (int i = 0; i < 2; ++i) { int R, C; stage_rc(tid * 16 + i * 8192, R, C); const int Rb = (R & ~31) + perm32(R & 31);
        voffA[i] = (unsigned)(R * K + C) * 2u; voffB[i] = (unsigned)(Rb * K + C) * 2u; }
    const size_t kstep = (size_t)(BK * 2);
    const size_t hstep = (size_t)HALF * K * 2;
    const unsigned ldsw = (unsigned)wid * 1024u;
    const int aoff = lds_byte(wr * 64 + fr, fq * 8), boff = lds_byte(wc * 32 + fr, fq * 8);
#define PG8_SA(b, h) (((b) * 2 + (h)) * HTB)
#define PG8_SB(b, h) ((4 + (b) * 2 + (h)) * HTB)
#define PG8_STAGE(bufoff, gbase, voff) do { _Pragma("unroll") for (int _i = 0; _i < 2; ++_i) \
        __builtin_amdgcn_global_load_lds((const unsigned*)((const char*)(gbase) + (voff)[_i]), (LAS unsigned*)(lds + (bufoff) + ldsw + _i * 8192), 16, 0, 0); } while (0)
#define PG8_LDA(dst, b, h) do { _Pragma("unroll") for (int m = 0; m < 4; ++m) _Pragma("unroll") for (int k = 0; k < 2; ++k) dst[m][k] = *(const LAS bf16x8*)(lds + PG8_SA(b, h) + aoff + m * 2048 + k * 1024); } while (0)
#define PG8_LDB(dst, b, h) do { _Pragma("unroll") for (int n = 0; n < 2; ++n) _Pragma("unroll") for (int k = 0; k < 2; ++k) dst[n][k] = *(const LAS bf16x8*)(lds + PG8_SB(b, h) + boff + n * 2048 + k * 1024); } while (0)
#define PG8_MMA(ai, bj, At, Bt) do { __builtin_amdgcn_s_setprio(1); _Pragma("unroll") for (int m = 0; m < 4; ++m) _Pragma("unroll") for (int n = 0; n < 2; ++n) _Pragma("unroll") for (int k = 0; k < 2; ++k) \
        acc[ai][bj][m][n] = __builtin_amdgcn_mfma_f32_16x16x32_bf16(Bt[n][k], At[m][k], acc[ai][bj][m][n], 0, 0, 0); __builtin_amdgcn_s_setprio(0); } while (0)
#define PG8_WAIT_V(n) asm volatile("s_waitcnt vmcnt(" #n ")" ::: "memory")
#define PG8_WAIT_L(n) asm volatile("s_waitcnt lgkmcnt(" #n ")" ::: "memory")
#define PG8_BAR __builtin_amdgcn_s_barrier()
#define PG8_SCHED __builtin_amdgcn_sched_barrier(0)
    Unit cur, nxt; int ui = 0;
    if (!S.next(0, cur)) return;
    f32x4 acc[2][2][4][2];
#pragma unroll
    for (int a = 0; a < 2; ++a)
#pragma unroll
        for (int b = 0; b < 2; ++b)
#pragma unroll
            for (int m = 0; m < 4; ++m)
#pragma unroll
                for (int n = 0; n < 2; ++n) acc[a][b][m][n] = (f32x4){0.f, 0.f, 0.f, 0.f};
    bf16x8 At[4][2], B0[2][2], B1[2][2];
    const char* cA = cur.a; const char* cB = cur.b;
    unsigned oc_lo[2] = {0u, 0u}, oc_hi[2] = {0u, 0u}, on_lo[2] = {0u, 0u}, on_hi[2] = {0u, 0u};
#define PG8_ROWOFF(U, LO, HI) do { _Pragma("unroll") for (int _i = 0; _i < 2; ++_i) { int R_, C_; stage_rc(tid * 16 + _i * 8192, R_, C_); \
        LO[_i] = (unsigned)((U).rowmap[R_] * K + C_) * 2u; HI[_i] = (unsigned)((U).rowmap[R_ + 128] * K + C_) * 2u; } } while (0)
    if constexpr (GATHER) PG8_ROWOFF(cur, oc_lo, oc_hi);
    PG8_STAGE(PG8_SB(0, 0), cB, voffB);
    if constexpr (GATHER) PG8_STAGE(PG8_SA(0, 0), cA, oc_lo); else PG8_STAGE(PG8_SA(0, 0), cA, voffA);
    PG8_STAGE(PG8_SB(0, 1), cB + hstep, voffB);
    if constexpr (GATHER) PG8_STAGE(PG8_SA(0, 1), cA, oc_hi); else PG8_STAGE(PG8_SA(0, 1), cA + hstep, voffA);
    if (wr == 1) PG8_BAR;
    PG8_WAIT_V(4); PG8_BAR;
    PG8_STAGE(PG8_SB(1, 0), cB + kstep, voffB);
    if constexpr (GATHER) PG8_STAGE(PG8_SA(1, 0), cA + kstep, oc_lo); else PG8_STAGE(PG8_SA(1, 0), cA + kstep, voffA);
    PG8_STAGE(PG8_SB(1, 1), cB + hstep + kstep, voffB);
    PG8_WAIT_V(6); PG8_BAR;
    for (;;) {
        const bool has_next = S.next(ui + 1, nxt);
        const char* nA = has_next ? nxt.a : cA; const char* nB = has_next ? nxt.b : cB;
        if constexpr (GATHER) { if (has_next) PG8_ROWOFF(nxt, on_lo, on_hi); else { on_lo[0] = oc_lo[0]; on_lo[1] = oc_lo[1]; on_hi[0] = oc_hi[0]; on_hi[1] = oc_hi[1]; } }
#pragma unroll 1
        for (int t = 0; t < nt; t += 2) {
            const bool last = (t == nt - 2);
            const char* a1 = cA + (size_t)(t + 1) * kstep;
            const char* a2 = last ? nA : cA + (size_t)(t + 2) * kstep; const char* b2 = last ? nB : cB + (size_t)(t + 2) * kstep;
            const char* a3 = a2 + kstep; const char* b3 = b2 + kstep;
            unsigned o2lo[2], o2hi[2];
            o2lo[0] = last ? on_lo[0] : oc_lo[0]; o2lo[1] = last ? on_lo[1] : oc_lo[1]; o2hi[0] = last ? on_hi[0] : oc_hi[0]; o2hi[1] = last ? on_hi[1] : oc_hi[1];
            PG8_LDB(B0, 0, 0); PG8_SCHED; PG8_LDA(At, 0, 0); if constexpr (GATHER) PG8_STAGE(PG8_SA(1, 1), a1, oc_hi); else PG8_STAGE(PG8_SA(1, 1), a1 + hstep, voffA);
            PG8_WAIT_L(8); PG8_BAR; PG8_WAIT_L(0); PG8_MMA(0, 0, At, B0); PG8_BAR; PG8_SCHED;
            PG8_LDB(B1, 0, 1); PG8_STAGE(PG8_SB(0, 0), b2, voffB);
            PG8_BAR; PG8_WAIT_L(0); PG8_MMA(0, 1, At, B1); PG8_BAR;
            PG8_LDA(At, 0, 1); if constexpr (GATHER) PG8_STAGE(PG8_SA(0, 0), a2, o2lo); else PG8_STAGE(PG8_SA(0, 0), a2, voffA);
            PG8_BAR; PG8_WAIT_L(0); PG8_MMA(1, 0, At, B0); PG8_BAR; PG8_SCHED;
            PG8_STAGE(PG8_SB(0, 1), b2 + hstep, voffB);
            PG8_WAIT_V(6); PG8_BAR; PG8_MMA(1, 1, At, B1); PG8_BAR;
            PG8_LDB(B0, 1, 0); PG8_SCHED; PG8_LDA(At, 1, 0); if constexpr (GATHER) PG8_STAGE(PG8_SA(0, 1), a2, o2hi); else PG8_STAGE(PG8_SA(0, 1), a2 + hstep, voffA);
            PG8_WAIT_L(8); PG8_BAR; PG8_WAIT_L(0); PG8_MMA(0, 0, At, B0); PG8_BAR; PG8_SCHED;
            PG8_LDB(B1, 1, 1); PG8_STAGE(PG8_SB(1, 0), b3, voffB);
            PG8_BAR; PG8_WAIT_L(0); PG8_MMA(0, 1, At, B1); PG8_BAR;
            PG8_LDA(At, 1, 1); if constexpr (GATHER) PG8_STAGE(PG8_SA(1, 0), a3, o2lo); else PG8_STAGE(PG8_SA(1, 0), a3, voffA);
            PG8_BAR; PG8_WAIT_L(0); PG8_MMA(1, 0, At, B0); PG8_BAR; PG8_SCHED;
            PG8_STAGE(PG8_SB(1, 1), b3 + hstep, voffB);
            PG8_WAIT_V(6); PG8_BAR; PG8_MMA(1, 1, At, B1); PG8_BAR;
        }
        epi_apply(E, acc, cur, wr, wc, fr, fq);
        if (!has_next) break;
#pragma unroll
        for (int a = 0; a < 2; ++a)
#pragma unroll
            for (int b = 0; b < 2; ++b)
#pragma unroll
                for (int m = 0; m < 4; ++m)
#pragma unroll
                    for (int n = 0; n < 2; ++n) acc[a][b][m][n] = (f32x4){0.f, 0.f, 0.f, 0.f};
        cur = nxt; cA = nA; cB = nB; ++ui;
        if constexpr (GATHER) { oc_lo[0] = on_lo[0]; oc_lo[1] = on_lo[1]; oc_hi[0] = on_hi[0]; oc_hi[1] = on_hi[1]; }
    }
    PG8_WAIT_V(0);
    if (wr == 0) PG8_BAR;
    PG8_BAR;
#undef PG8_ROWOFF
#undef PG8_SA
#undef PG8_SB
#undef PG8_STAGE
#undef PG8_LDA
#undef PG8_LDB
#undef PG8_MMA
#undef PG8_WAIT_V
#undef PG8_WAIT_L
#undef PG8_BAR
#undef PG8_SCHED
}
template <class Epi, class Sched>
__device__ __forceinline__ void gemm_phase(LAS unsigned char* lds, const int K, const Sched& S, const Epi& E, const int tid) { gemm_phase_t<false>(lds, K, S, E, tid); }
}

struct SchedInProj { const char* A; const char* Bt; int G, c;
    __device__ __forceinline__ bool next(int i, pg8::Unit& u) const { const int L = i * G + c; if (L >= 64 * 37) return false; int pm, pn; pg8::tile_order(L, 64, 37, pm, pn);
        u.a = A + (size_t)pm * (256 * 1024 * 2); u.b = Bt + (size_t)pn * (256 * 1024 * 2); u.row0 = pm * 256; u.col0 = pn * 256; u.aux = 0; u.rowmap = nullptr; return true; } };

struct WJob { const float* src; int ld_src; int K; int ncols; bf16* dst; int ld_dst; int nb; size_t sstride, dstride; };
__device__ __forceinline__ void wconv_job(const Ctx& c, const WJob& j) {
    float* tl = (float*)c.lds;
    const int ntk = j.K >> 6, ntn = j.ncols >> 6, per = ntk * ntn, ntiles = per * j.nb;
    const int rk = c.tid >> 3, rseg = (c.tid & 7) * 8;
    int tile = blockIdx.x;
    float4 a = make_float4(0.f, 0.f, 0.f, 0.f), b = a;
    if (tile < ntiles) { const int bi = tile / per, tt = tile % per, tk = tt % ntk, tn = tt / ntk;
        const float* sp = j.src + (size_t)bi * j.sstride + (size_t)(tk * 64 + rk) * j.ld_src + tn * 64 + rseg; a = *(const float4*)sp; b = *(const float4*)(sp + 4); }
    for (; tile < ntiles; tile += gridDim.x) {
        const int bi = tile / per, tt = tile % per, tk = tt % ntk, tn = tt / ntk;
        const float4 ca = a, cb = b;
        const int nxt = tile + gridDim.x;
        if (nxt < ntiles) { const int bi2 = nxt / per, tt2 = nxt % per, tk2 = tt2 % ntk, tn2 = tt2 / ntk;
            const float* sp = j.src + (size_t)bi2 * j.sstride + (size_t)(tk2 * 64 + rk) * j.ld_src + tn2 * 64 + rseg; a = *(const float4*)sp; b = *(const float4*)(sp + 4); }
        asm volatile("s_waitcnt lgkmcnt(0)" ::: "memory"); __builtin_amdgcn_s_barrier(); asm volatile("" ::: "memory");
        float* row = tl + rk * 65 + rseg;
        row[0] = ca.x; row[1] = ca.y; row[2] = ca.z; row[3] = ca.w; row[4] = cb.x; row[5] = cb.y; row[6] = cb.z; row[7] = cb.w;
        asm volatile("s_waitcnt lgkmcnt(0)" ::: "memory"); __builtin_amdgcn_s_barrier(); asm volatile("" ::: "memory");
        const float* col = tl + rseg * 65 + rk;
        uint4 w; w.x = pk2(col[0], col[65]); w.y = pk2(col[130], col[195]); w.z = pk2(col[260], col[325]); w.w = pk2(col[390], col[455]);
        *(uint4*)(j.dst + (size_t)bi * j.dstride + (size_t)(tn * 64 + rk) * j.ld_dst + tk * 64 + rseg) = w;
    }
}
struct SchedG2 { const char* YA; const char* Bt; int G, c;
    __device__ __forceinline__ bool next(int i, pg8::Unit& u) const { const int L = (i >> 1) * G + c, ab = i & 1; if (L >= 64 * 4) return false; int pm, pn; pg8::tile_order(L, 64, 4, pm, pn);
        u.a = YA + (size_t)ab * (WS_YB - WS_YA) + (size_t)pm * (256 * 1024 * 2); u.b = Bt + (size_t)(ab * 4 + pn) * (256 * 1024 * 2); u.row0 = pm * 256; u.col0 = ab * 1024 + pn * 256; u.aux = 0; u.rowmap = nullptr; return true; } };
struct SchedX1 { const char* A; const char* Bt; int G, c;
    __device__ __forceinline__ bool next(int i, pg8::Unit& u) const { const int L = i * G + c; if (L >= 64 * 4) return false; int pm, pn; pg8::tile_order(L, 64, 4, pm, pn);
        u.a = A + (size_t)pm * (256 * 1024 * 2); u.b = Bt + (size_t)pn * (256 * 1024 * 2); u.row0 = pm * 256; u.col0 = pn * 256; u.aux = 0; u.rowmap = nullptr; return true; } };
struct SchedMoe { const char* A; const char* Bt; const int* TILE_E; const int* SLOT_TOK; int NT, NPN, G, c;
    __device__ __forceinline__ bool next(int i, pg8::Unit& u) const { const int L = i * G + c; if (L >= NT * NPN) return false; int tile, pn; pg8::tile_order(L, NT, NPN, tile, pn);
        const int e = TILE_E[tile];
        u.a = SLOT_TOK ? A : A + (size_t)tile * (256 * 1024 * 2); u.rowmap = SLOT_TOK ? SLOT_TOK + tile * 256 : nullptr;
        u.b = Bt + (size_t)(e * NPN + pn) * (256 * 1024 * 2); u.row0 = tile * 256; u.col0 = pn * 256; u.aux = e; return true; } };

struct EpiLora {
    typedef NoLd Ld; static constexpr int MB = 1;
    const float* w0; const float* a0; float* LW; float* AA; bf16* GGR;
    __device__ __forceinline__ void load(Ld&, int, int, int) const {}
    __device__ __forceinline__ void store8(int row, int col, const float (&v)[8], int, const Ld&) const {
        const float* bp = col < 1024 ? w0 + col : a0 + ((col - 1024) & 1023);
        const float4 b0 = *(const float4*)bp, b1 = *(const float4*)(bp + 4);
        const float bb[8] = {b0.x, b0.y, b0.z, b0.w, b1.x, b1.y, b1.z, b1.w};
        if (col < 1024) { float o[8];
#pragma unroll
            for (int i = 0; i < 8; ++i) o[i] = -0.6065306597126334f * fsigm(bb[i] + v[i]);
            float* p = LW + (size_t)row * 1024 + col; *(float4*)p = make_float4(o[0], o[1], o[2], o[3]); *(float4*)(p + 4) = make_float4(o[4], o[5], o[6], o[7]); }
        else if (col < 2048) { const int cc = col - 1024; float o[8];
#pragma unroll
            for (int i = 0; i < 8; ++i) o[i] = fsigm(bb[i] + v[i]);
            float* p = AA + (size_t)row * 1024 + cc; *(float4*)p = make_float4(o[0], o[1], o[2], o[3]); *(float4*)(p + 4) = make_float4(o[4], o[5], o[6], o[7]); }
        else { uint4 w; w.x = pk2(v[0], v[1]); w.y = pk2(v[2], v[3]); w.z = pk2(v[4], v[5]); w.w = pk2(v[6], v[7]); *(uint4*)(GGR + (size_t)row * 1024 + (col - 2048)) = w; }
    }
};
struct SchedLora { const char* A; const char* Bt; int G, c;
    __device__ __forceinline__ bool next(int i, pg8::Unit& u) const { const int L = i * G + c; if (L >= 64 * 12) return false; int pm, pn; pg8::tile_order(L, 64, 12, pm, pn);
        u.a = A + (size_t)pm * (256 * 256 * 2); u.b = Bt + (size_t)pn * (256 * 256 * 2); u.row0 = pm * 256; u.col0 = pn * 256; u.aux = 0; u.rowmap = nullptr; return true; } };
__device__ __forceinline__ void lora_zero(const Ctx& c) {
    uint4* LT = c.ws<uint4>(WS_LORA_T);
    for (size_t idx = c.gtid; idx < (size_t)3072 * 32; idx += c.nthreads) {
        const int row = (int)(idx >> 5), k8 = (int)(idx & 31) * 8;
        const bool data = row < 1024 ? (k8 < 64) : (row < 2048 ? (k8 >= 64 && k8 < 128) : (k8 >= 128));
        if (!data) LT[idx] = make_uint4(0, 0, 0, 0);
    }
}

__device__ __forceinline__ void ph_loraprep(const Ctx& c) {
    const float* LIN = c.ws<float>(WS_LIN); bf16* AL = c.ws<bf16>(WS_ALORA); const float* mu = c.P.in[I_MU];
    for (size_t idx = c.gtid; idx < (size_t)T * 256; idx += c.nthreads) {
        const int t = (int)(idx >> 8), cc = (int)(idx & 255);
        const float x = LIN[idx], xp = (t & (SEQ - 1)) ? LIN[idx - 256] : 0.f;
        const float xs = x + (xp - x) * mu[3072 + cc];
        const float r = cc < 64 ? tanhf(xs) : (cc < 128 ? xs : sigm(xs));
        AL[idx] = f2bf(r);
    }
}
__device__ __forceinline__ void ph_post(const Ctx& c) {
    const bf16* OG = c.ws<bf16>(WS_OG); const bf16* ORW = c.ws<bf16>(WS_ORW); const bf16* ZS = c.ws<bf16>(WS_ZS); const bf16* VP = c.ws<bf16>(WS_VP); const bf16* GGR = c.ws<bf16>(WS_GGR);
    const float* SC = c.ws<float>(WS_SC); bf16* YA = c.ws<bf16>(WS_YA); bf16* YB = c.ws<bf16>(WS_YB);
    const float* gnw = c.P.in[I_GDN_NORM]; const float* lnw = c.P.in[I_LNW]; const float* lnb = c.P.in[I_LNB];
    const int lane = c.lane, c0 = lane * 16;
    for (int t = c.gwave; t < T; t += c.nwaves) {
        {
            float o[16];
#pragma unroll
            for (int q = 0; q < 2; ++q) { const uint4 v = *(const uint4*)(OG + (size_t)t * 1024 + c0 + 8 * q); o[8 * q] = bflo(v.x); o[8 * q + 1] = bfhi(v.x); o[8 * q + 2] = bflo(v.y); o[8 * q + 3] = bfhi(v.y); o[8 * q + 4] = bflo(v.z); o[8 * q + 5] = bfhi(v.z); o[8 * q + 6] = bflo(v.w); o[8 * q + 7] = bfhi(v.w); }
            float ss = 0.f;
#pragma unroll
            for (int j = 0; j < 16; ++j) ss += o[j] * o[j];
            ss = sum8(ss);
            const float rstd = rsqrtf(ss * (1.f / 128.f) + 1e-6f);
            const uint4 z0 = *(const uint4*)(ZS + (size_t)t * 1024 + c0), z1 = *(const uint4*)(ZS + (size_t)t * 1024 + c0 + 8);
            const unsigned zz[8] = {z0.x, z0.y, z0.z, z0.w, z1.x, z1.y, z1.z, z1.w};
            unsigned w[8];
#pragma unroll
            for (int j = 0; j < 8; ++j) { const int cc = (c0 + 2 * j) & 127; w[j] = pk2(o[2 * j] * rstd * gnw[cc] * bflo(zz[j]), o[2 * j + 1] * rstd * gnw[cc + 1] * bfhi(zz[j])); }
            *(uint4*)(YA + (size_t)t * 1024 + c0) = make_uint4(w[0], w[1], w[2], w[3]); *(uint4*)(YA + (size_t)t * 1024 + c0 + 8) = make_uint4(w[4], w[5], w[6], w[7]);
        }
        {
            float o[16];
#pragma unroll
            for (int q = 0; q < 2; ++q) { const uint4 v = *(const uint4*)(ORW + (size_t)t * 1024 + c0 + 8 * q); o[8 * q] = bflo(v.x); o[8 * q + 1] = bfhi(v.x); o[8 * q + 2] = bflo(v.y); o[8 * q + 3] = bfhi(v.y); o[8 * q + 4] = bflo(v.z); o[8 * q + 5] = bfhi(v.z); o[8 * q + 6] = bflo(v.w); o[8 * q + 7] = bfhi(v.w); }
            float sm = 0.f;
#pragma unroll
            for (int j = 0; j < 16; ++j) sm += o[j];
            sm = sum4(sm);
            const float mean = sm * (1.f / 64.f);
            float sv = 0.f;
#pragma unroll
            for (int j = 0; j < 16; ++j) { const float dd = o[j] - mean; sv += dd * dd; }
            sv = sum4(sv);
            const float rstd = rsqrtf(sv * (1.f / 64.f) + 64e-5f);
            const float sc = SC[t * 16 + (c0 >> 6)];
            const uint4 v0 = *(const uint4*)(VP + (size_t)t * 1024 + c0), v1 = *(const uint4*)(VP + (size_t)t * 1024 + c0 + 8);
            const uint4 g0 = *(const uint4*)(GGR + (size_t)t * 1024 + c0), g1 = *(const uint4*)(GGR + (size_t)t * 1024 + c0 + 8);
            const unsigned vv[8] = {v0.x, v0.y, v0.z, v0.w, v1.x, v1.y, v1.z, v1.w};
            const unsigned gg[8] = {g0.x, g0.y, g0.z, g0.w, g1.x, g1.y, g1.z, g1.w};
            unsigned w[8];
#pragma unroll
            for (int j = 0; j < 8; ++j) { const int cc = c0 + 2 * j;
                const float y0 = ((o[2 * j] - mean) * rstd * lnw[cc] + lnb[cc] + sc * bflo(vv[j])) * bflo(gg[j]);
                const float y1 = ((o[2 * j + 1] - mean) * rstd * lnw[cc + 1] + lnb[cc + 1] + sc * bfhi(vv[j])) * bfhi(gg[j]);
                w[j] = pk2(y0, y1); }
            *(uint4*)(YB + (size_t)t * 1024 + c0) = make_uint4(w[0], w[1], w[2], w[3]); *(uint4*)(YB + (size_t)t * 1024 + c0 + 8) = make_uint4(w[4], w[5], w[6], w[7]);
        }
    }
}

__device__ __forceinline__ void ph_router(const Ctx& c) {
    const float* X1 = c.ws<float>(WS_X1); const float* nw = c.P.in[I_NORM_FFN]; const float* rw = c.P.in[I_ROUTER_W]; const float* rb = c.P.in[I_ROUTER_B];
    bf16* H2 = c.ws<bf16>(WS_H2); int* TE = c.ws<int>(WS_TE); float* TG = c.ws<float>(WS_TG); int* TP = c.ws<int>(WS_TP); unsigned* CNT = c.ws<unsigned>(WS_CTL) + CW_CNT;
    const int lane = c.lane;
    float4* tab = (float4*)c.lds;
    unsigned* lcnt = (unsigned*)(c.lds + 147456);
    __syncthreads();
    if (c.tid < 32) lcnt[c.tid] = 0u;
    for (int i = c.tid; i < 8192; i += NTHREADS) { const int k = i >> 3; tab[((k & 3) * 256 + (k >> 2)) * 9 + (i & 7)] = ((const float4*)rw)[i]; }
    __syncthreads();
    for (int t = c.gwave; t < T; t += c.nwaves) {
        float4 v[4]; float ss = 0.f;
#pragma unroll
        for (int i = 0; i < 4; ++i) { v[i] = ((const float4*)(X1 + (size_t)t * D))[lane + 64 * i]; ss += v[i].x * v[i].x + v[i].y * v[i].y + v[i].z * v[i].z + v[i].w * v[i].w; }
        ss = wsum(ss);
        const float rstd = rsqrtf(ss * (1.f / 1024.f) + 1e-6f);
        float lg[32];
#pragma unroll
        for (int j = 0; j < 32; ++j) lg[j] = 0.f;
#pragma unroll
        for (int i = 0; i < 4; ++i) {
            const float4 w4 = ((const float4*)nw)[lane + 64 * i];
            const float h[4] = {v[i].x * rstd * w4.x, v[i].y * rstd * w4.y, v[i].z * rstd * w4.z, v[i].w * rstd * w4.w};
            uint2 st; st.x = pk2(h[0], h[1]); st.y = pk2(h[2], h[3]);
            *(uint2*)(H2 + (size_t)t * D + 4 * (lane + 64 * i)) = st;
#pragma unroll
            for (int ii = 0; ii < 4; ++ii) {
                const float4* wr = tab + (size_t)(ii * 256 + lane + 64 * i) * 9;
#pragma unroll
                for (int q = 0; q < 8; ++q) { const float4 w = wr[q]; lg[4 * q] += h[ii] * w.x; lg[4 * q + 1] += h[ii] * w.y; lg[4 * q + 2] += h[ii] * w.z; lg[4 * q + 3] += h[ii] * w.w; }
                asm volatile("" ::: "memory");
            }
        }
#pragma unroll
        for (int j = 0; j < 32; ++j) lg[j] = wsum(lg[j]) + rb[j];
        int e0 = 0, e1 = 0, e2 = 0, e3 = 0; float v0 = -3e38f, v1 = -3e38f, v2 = -3e38f, v3 = -3e38f;
#pragma unroll
        for (int j = 0; j < 32; ++j) if (lg[j] > v0) { v0 = lg[j]; e0 = j; }
#pragma unroll
        for (int j = 0; j < 32; ++j) if (j != e0 && lg[j] > v1) { v1 = lg[j]; e1 = j; }
#pragma unroll
        for (int j = 0; j < 32; ++j) if (j != e0 && j != e1 && lg[j] > v2) { v2 = lg[j]; e2 = j; }
#pragma unroll
        for (int j = 0; j < 32; ++j) if (j != e0 && j != e1 && j != e2 && lg[j] > v3) { v3 = lg[j]; e3 = j; }
        const float x1 = expf(v1 - v0), x2 = expf(v2 - v0), x3 = expf(v3 - v0), inv = 1.f / (1.f + x1 + x2 + x3);
        if (lane < 4) {
            const int me = lane == 0 ? e0 : (lane == 1 ? e1 : (lane == 2 ? e2 : e3));
            const float mg = (lane == 0 ? 1.f : (lane == 1 ? x1 : (lane == 2 ? x2 : x3))) * inv;
            const unsigned pos = atomicAdd(&lcnt[me], 1u);
            TE[t * 4 + lane] = me; TG[t * 4 + lane] = mg; TP[t * 4 + lane] = (int)pos;
        }
    }
    __syncthreads();
    if (c.tid < 32) lcnt[32 + c.tid] = atomicAdd(&CNT[c.tid], lcnt[c.tid]);
    __syncthreads();
    if (lane < 4) for (int t = c.gwave; t < T; t += c.nwaves) TP[t * 4 + lane] += (int)lcnt[32 + TE[t * 4 + lane]];
    __syncthreads();
}

__device__ __forceinline__ void ph_dispatch(const Ctx& c) {
    int* tb = (int*)c.lds;
    const unsigned* CNT = c.ws<unsigned>(WS_CTL) + CW_CNT;
    int* TILE_E = c.ws<int>(WS_TILE_E); int* NT = c.ws<int>(WS_NT);
    const int* TE = c.ws<int>(WS_TE); const float* TG = c.ws<float>(WS_TG); const int* TP = c.ws<int>(WS_TP); int* TSLOT = c.ws<int>(WS_TSLOT);
    float* SGATE = c.ws<float>(WS_SGATE); const bf16* H2 = c.ws<bf16>(WS_H2); bf16* XB = c.ws<bf16>(WS_XB);
    if (c.tid == 0) { int acc = 0; for (int e = 0; e < NEXP; ++e) { const int n = (int)__hip_atomic_load(&CNT[e], __ATOMIC_RELAXED, __HIP_MEMORY_SCOPE_AGENT); tb[e] = acc; tb[64 + e] = n; acc += (n + 255) >> 8; } tb[32] = acc; }
    __syncthreads();
    if (blockIdx.x == 0) {
        for (int tile = c.tid; tile < tb[32]; tile += NTHREADS) { int e = 0; for (int q = 0; q < NEXP; ++q) if (tile >= tb[q]) e = q; TILE_E[tile] = e; }
        if (c.tid == 0) *NT = tb[32];
    }
    int* SLOT_TOK = c.ws<int>(WS_SLOT_TOK);
    for (size_t idx = c.gtid; idx < (size_t)T * 4; idx += c.nthreads) {
        const int t = (int)(idx >> 2), e = TE[idx], pos = TP[idx];
        const int slot = tb[e] * 256 + pos;
        TSLOT[idx] = slot; SGATE[slot] = TG[idx]; SLOT_TOK[slot] = t;
    }
    for (int e = 0; e < NEXP; ++e) {
        const int n = tb[64 + e], cap = (tb[e + 1] - tb[e]) * 256;
        for (int r = n + (int)c.gtid; r < cap; r += (int)c.nthreads) { const int slot = tb[e] * 256 + r; SLOT_TOK[slot] = 0; SGATE[slot] = 0.f; }
    }
}

__device__ __forceinline__ void ph_combine(const Ctx& c) {
    const float* X1 = c.ws<float>(WS_X1); const bf16* YS = c.ws<bf16>(WS_YS); const int* TSLOT = c.ws<int>(WS_TSLOT); const float* nw = c.P.in[I_NORM_FINAL]; float* out = c.P.out;
    const int lane = c.lane;
    for (int t = c.gwave; t < T; t += c.nwaves) {
        const int s0 = TSLOT[t * 4], s1 = TSLOT[t * 4 + 1], s2 = TSLOT[t * 4 + 2], s3 = TSLOT[t * 4 + 3];
        float4 v[4]; float ss = 0.f;
#pragma unroll
        for (int i = 0; i < 4; ++i) {
            const int col = 4 * (lane + 64 * i);
            v[i] = *(const float4*)(X1 + (size_t)t * D + col);
            const uint2 a = *(const uint2*)(YS + (size_t)s0 * 1024 + col), b = *(const uint2*)(YS + (size_t)s1 * 1024 + col), cc = *(const uint2*)(YS + (size_t)s2 * 1024 + col), d = *(const uint2*)(YS + (size_t)s3 * 1024 + col);
            v[i].x += bflo(a.x) + bflo(b.x) + bflo(cc.x) + bflo(d.x); v[i].y += bfhi(a.x) + bfhi(b.x) + bfhi(cc.x) + bfhi(d.x);
            v[i].z += bflo(a.y) + bflo(b.y) + bflo(cc.y) + bflo(d.y); v[i].w += bfhi(a.y) + bfhi(b.y) + bfhi(cc.y) + bfhi(d.y);
            ss += v[i].x * v[i].x + v[i].y * v[i].y + v[i].z * v[i].z + v[i].w * v[i].w;
        }
        ss = wsum(ss);
        const float rstd = rsqrtf(ss * (1.f / 1024.f) + 1e-6f);
#pragma unroll
        for (int i = 0; i < 4; ++i) { const float4 w4 = ((const float4*)nw)[lane + 64 * i];
            *(float4*)(out + (size_t)t * D + 4 * (lane + 64 * i)) = make_float4(v[i].x * rstd * w4.x, v[i].y * rstd * w4.y, v[i].z * rstd * w4.z, v[i].w * rstd * w4.w); }
    }
    if (TS_BEGIN >= 0 && blockIdx.x == 0 && c.tid == 0) { asm volatile("s_waitcnt vmcnt(0)" ::: "memory"); c.P.out[0] = (float)c.ws<unsigned>(WS_CTL)[CW_TS] * 0.01f; }
}


typedef short bf16x8_t __attribute__((ext_vector_type(8)));
typedef float f32x4_t __attribute__((ext_vector_type(4)));
#define MFMA16(a, b, c) __builtin_amdgcn_mfma_f32_16x16x32_bf16((a), (b), (c), 0, 0, 0)


__device__ __forceinline__ int frag_off(int row, int k, int KBn) { return (((row >> 4) * KBn + (k >> 5)) * 512) + (((k >> 3) & 3) * 128) + ((row & 15) * 8) + (k & 7); }
__device__ __forceinline__ int cfrag_off(int v, int r, int NRT) { return ((((v >> 4) * NRT + (r >> 4)) * 64 + ((r >> 2) & 3) * 16 + (v & 15)) * 4) + (r & 3); }


constexpr int TRI_LS = 68;
#define MFMA4(a, b, c) __builtin_amdgcn_mfma_f32_16x16x4f32((a), (b), (c), 0, 0, 0)
template <int SG>
__device__ __forceinline__ void tri_diag_inv(float* Lm, int lane) {
    const int b = lane >> 4, e = lane & 15;
    float* Lb = Lm + (16 * b) * TRI_LS + 16 * b;
    float x[16];
#pragma unroll
    for (int i = 0; i < 16; ++i) x[i] = 0.f;
#pragma unroll
    for (int i = 0; i < 16; ++i) {
        float a0 = (i == e) ? 1.f : 0.f, a1 = 0.f;
#pragma unroll
        for (int j4 = 0; j4 < (i + 3) / 4; ++j4) { const float4 m = *(const float4*)(Lb + i * TRI_LS + 4 * j4);
            a0 -= (float)SG * (m.x * x[4 * j4]); a1 -= (float)SG * (m.y * x[4 * j4 + 1]); a0 -= (float)SG * (m.z * x[4 * j4 + 2]); a1 -= (float)SG * (m.w * x[4 * j4 + 3]); }
        x[i] = a0 + a1;
    }
#pragma unroll
    for (int i = 0; i < 16; ++i) Lb[i * TRI_LS + e] = x[i];
}
template <int SG>
__device__ __forceinline__ void tri_col_inv(const float* Lm, int cb, int lane, f32x4_t (&Tb)[4]) {
    const int n = lane & 15, q = lane >> 4;
#pragma unroll
    for (int r = 0; r < 4; ++r) { Tb[r] = (f32x4_t){0.f, 0.f, 0.f, 0.f};
        if (r == cb) {
#pragma unroll
            for (int rr = 0; rr < 4; ++rr) Tb[r][rr] = Lm[(16 * r + 4 * q + rr) * TRI_LS + 16 * r + n]; } }
#pragma unroll
    for (int r = 1; r < 4; ++r) {
        if (r > cb) {
            f32x4_t P = {0.f, 0.f, 0.f, 0.f};
#pragma unroll
            for (int k = 0; k < r; ++k) {
                if (k >= cb) { const float4 a = *(const float4*)(Lm + (16 * r + n) * TRI_LS + 16 * k + 4 * q);
                    P = MFMA4(a.x, Tb[k][0], P); P = MFMA4(a.y, Tb[k][1], P); P = MFMA4(a.z, Tb[k][2], P); P = MFMA4(a.w, Tb[k][3], P); }
            }
#pragma unroll
            for (int rr = 0; rr < 4; ++rr) P[rr] *= -(float)SG;
            const float4 d = *(const float4*)(Lm + (16 * r + n) * TRI_LS + 16 * r + 4 * q);
            f32x4_t R = {0.f, 0.f, 0.f, 0.f};
            R = MFMA4(d.x, P[0], R); R = MFMA4(d.y, P[1], R); R = MFMA4(d.z, P[2], R); R = MFMA4(d.w, P[3], R);
            Tb[r] = R;
        }
    }
}

constexpr int GCL_HALF_BYTES = 71680;
__device__ __forceinline__ void ph_gcl(const Ctx& c) {
    const bf16* GQKV = c.ws<bf16>(WS_GQKV); const float* BETA = c.ws<float>(WS_BETA); const float* GGv = c.ws<float>(WS_GG); const float* cw = c.P.in[I_GDN_CONV];
    bf16* GA1 = c.ws<bf16>(WS_GA1); bf16* GX0 = c.ws<bf16>(WS_GX0); bf16* GA2 = c.ws<bf16>(WS_GA2); bf16* GA3 = c.ws<bf16>(WS_GA3); bf16* GA4 = c.ws<bf16>(WS_GA4); float* GGL = c.ws<float>(WS_GGL);
    for (int it0 = blockIdx.x * 2; it0 < 2048; it0 += gridDim.x * 2) {
        int tv = c.tid; asm volatile("" : "+v"(tv));
        const int half = tv >> 8, ht = tv & 255, lane = tv & 63, w4 = __builtin_amdgcn_readfirstlane((tv >> 6) & 3);
        unsigned char* base = c.lds + half * GCL_HALF_BYTES;
        bf16* QB = (bf16*)base;
        bf16* KB = QB + 64 * 136;
        bf16* VB = KB + 64 * 136;
        float* MM = (float*)(VB + 64 * 136);
        float* GC = MM + 64 * TRI_LS;
        float* BT = GC + 64;
        float* BE = BT + 64;
        const int item = it0 + half, n = item & 63, bh = item >> 6, h = bh & 7, b = bh >> 3;
        const int t0 = b * SEQ + n * 64;
        __syncthreads();
        if (w4 == 0) {
            float g = GGv[(size_t)(t0 + lane) * 8 + h]; const float be = BETA[(size_t)(t0 + lane) * 8 + h];
#pragma unroll
            for (int o = 1; o < 64; o <<= 1) { const float u = __shfl_up(g, o); if (lane >= o) g += u; }
            GC[lane] = g; BT[lane] = be; BE[lane] = be * __expf(g);
        }
        __syncthreads();
        {
            const int cg = ht & 15, rg = ht >> 4, r0 = rg * 4;
#pragma unroll
            for (int mat = 0; mat < 3; ++mat) {
                const int col0 = mat * 1024 + h * 128 + cg * 8;
                float4 xa[7], xb[7], wa[4], wb[4];
#pragma unroll
                for (int li = 0; li < 7; ++li) {
                    const bool valid = (n > 0) || (r0 - 3 + li >= 0);
                    uint4 xr = make_uint4(0, 0, 0, 0);
                    if (valid) xr = *(const uint4*)(GQKV + (size_t)(t0 + r0 - 3 + li) * 3072 + col0);
                    xa[li] = make_float4(bflo(xr.x), bfhi(xr.x), bflo(xr.y), bfhi(xr.y));
                    xb[li] = make_float4(bflo(xr.z), bfhi(xr.z), bflo(xr.w), bfhi(xr.w));
                }
#pragma unroll
                for (int j = 0; j < 4; ++j) { wa[j] = *(const float4*)(cw + j * 3072 + col0); wb[j] = *(const float4*)(cw + j * 3072 + col0 + 4); }
#pragma unroll
                for (int rr = 0; rr < 4; ++rr) {
                    float o[8] = {0.f, 0.f, 0.f, 0.f, 0.f, 0.f, 0.f, 0.f};
#pragma unroll
                    for (int j = 0; j < 4; ++j) { const float4 a = xa[rr + j], bq = xb[rr + j];
                        o[0] += wa[j].x * a.x; o[1] += wa[j].y * a.y; o[2] += wa[j].z * a.z; o[3] += wa[j].w * a.w;
                        o[4] += wb[j].x * bq.x; o[5] += wb[j].y * bq.y; o[6] += wb[j].z * bq.z; o[7] += wb[j].w * bq.w; }
                    float ss = 0.f;
#pragma unroll
                    for (int e = 0; e < 8; ++e) { o[e] *= fsigm(o[e]); ss += o[e] * o[e]; }
                    float sc = 1.f;
                    if (mat < 2) { ss = sum16(ss); sc = rsqrtf(ss + 1e-6f) * (mat == 0 ? 0.08838834764831845f : 1.f); }
                    const int r = r0 + rr;
                    uint4 w; w.x = pk2(o[0] * sc, o[1] * sc); w.y = pk2(o[2] * sc, o[3] * sc); w.z = pk2(o[4] * sc, o[5] * sc); w.w = pk2(o[6] * sc, o[7] * sc);
                    *(uint4*)((mat == 0 ? QB : (mat == 1 ? KB : VB)) + r * 136 + cg * 8) = w;
                    if (mat == 0) {
                        const float s2 = sc * __expf(GC[r]);
                        w.x = pk2(o[0] * s2, o[1] * s2); w.y = pk2(o[2] * s2, o[3] * s2); w.z = pk2(o[4] * s2, o[5] * s2); w.w = pk2(o[6] * s2, o[7] * s2);
                        *(uint4*)(GA2 + (size_t)item * 64 * 128 + frag_off(r, cg * 8, 4)) = w;
                    }
                }
            }
        }
        __syncthreads();
        {
            const int fr = lane & 15, fq = lane >> 4, a0 = w4 * 16;
            bf16x8_t ka[4];
#pragma unroll
            for (int kb = 0; kb < 4; ++kb) ka[kb] = *(const bf16x8_t*)(KB + (a0 + fr) * 136 + kb * 32 + fq * 8);
#pragma unroll
            for (int bt = 0; bt < 4; ++bt) {
                f32x4_t c1 = {0.f, 0.f, 0.f, 0.f}, c2 = {0.f, 0.f, 0.f, 0.f};
#pragma unroll
                for (int kb = 0; kb < 4; ++kb) {
                    const bf16x8_t kbf = *(const bf16x8_t*)(KB + (bt * 16 + fr) * 136 + kb * 32 + fq * 8);
                    const bf16x8_t qbf = *(const bf16x8_t*)(QB + (bt * 16 + fr) * 136 + kb * 32 + fq * 8);
                    c1 = MFMA16(ka[kb], kbf, c1); c2 = MFMA16(ka[kb], qbf, c2);
                }
                const int i = bt * 16 + fr, j0 = a0 + 4 * fq;
                const float gi = GC[i], bi = BT[i];
                float m[4], at[4];
#pragma unroll
                for (int rg = 0; rg < 4; ++rg) { const int j = j0 + rg; const float dec = __expf(fminf(gi - GC[j], 0.f));
                    m[rg] = (i > j) ? bi * c1[rg] * dec : 0.f; at[rg] = (i >= j) ? c2[rg] * dec : 0.f; }
                *(float4*)(MM + i * TRI_LS + j0) = make_float4(m[0], m[1], m[2], m[3]);
                uint2 w; w.x = pk2(at[0], at[1]); w.y = pk2(at[2], at[3]);
                *(uint2*)(GA3 + (size_t)item * 64 * 64 + frag_off(i, j0, 2)) = w;
            }
        }
        __syncthreads();
        if (w4 == 0) tri_diag_inv<1>(MM, lane);
        __syncthreads();
        bf16* TV = QB; bf16* TK = QB + 64 * 64;
        {
            f32x4_t Tb[4];
            tri_col_inv<1>(MM, w4, lane, Tb);
            const int tn = lane & 15, tq = lane >> 4, col = 16 * w4 + tn;
            const float sv = BT[col], sk = BE[col];
#pragma unroll
            for (int r = 0; r < 4; ++r) {
                if (r >= w4 || r + 1 == w4) {
#pragma unroll
                    for (int rr = 0; rr < 4; ++rr) { const int row = 16 * r + 4 * tq + rr; const int po = row * 64 + ((((col >> 3) ^ (row & 7)) << 3) | (col & 7));
                        TV[po] = f2bf(Tb[r][rr] * sv); TK[po] = f2bf(Tb[r][rr] * sk); }
                }
            }
        }
        __syncthreads();
        {
            const int fr = lane & 15, fq = lane >> 4;
            const bool isw = w4 >= 2; const bf16* TI = isw ? TK : TV; const bf16* src = isw ? KB : VB;
            const int cbase = (w4 & 1) * 64;
            bf16x8_t af[4][2];
#pragma unroll
            for (int it = 0; it < 4; ++it)
#pragma unroll
                for (int kb = 0; kb < 2; ++kb) { const int row = it * 16 + fr; af[it][kb] = *(const bf16x8_t*)(TI + row * 64 + (((kb * 4 + fq) ^ (row & 7)) << 3)); }
            bf16* up = GX0 + (size_t)item * 128 * 64; bf16* a1s = (bf16*)MM;
#pragma unroll
            for (int t = 0; t < 4; ++t) {
                const int cc = cbase + t * 16 + fr;
                bf16x8_t b0, b1;
#pragma unroll
                for (int e = 0; e < 8; ++e) { b0[e] = (short)src[(fq * 8 + e) * 136 + cc]; b1[e] = (short)src[(32 + fq * 8 + e) * 136 + cc]; }
#pragma unroll
                for (int it = 0; it < 4; ++it) {
                    f32x4_t acc = {0.f, 0.f, 0.f, 0.f};
                    acc = MFMA16(af[it][0], b0, acc);
                    if (it >= 2) acc = MFMA16(af[it][1], b1, acc);
                    if (!isw) { uint2 w; w.x = pk2(acc[0], acc[1]); w.y = pk2(acc[2], acc[3]); *(uint2*)(up + cfrag_off(cc, it * 16 + 4 * fq, 4)) = w; }
                    else {
#pragma unroll
                        for (int rr = 0; rr < 4; ++rr) a1s[(it * 16 + 4 * fq + rr) * 128 + cc] = f2bf(-acc[rr]); }
                }
            }
        }
        __syncthreads();
        {
            const bf16* a1s = (const bf16*)MM; bf16* wp = GA1 + (size_t)item * 64 * 128;
#pragma unroll
            for (int q = 0; q < 4; ++q) { const int p = ht + 256 * q, fr = p & 15, fq = (p >> 4) & 3, kb = (p >> 6) & 3, rt = p >> 8;
                *(uint4*)(wp + p * 8) = *(const uint4*)(a1s + (rt * 16 + fr) * 128 + kb * 32 + fq * 8); }
        }
        {
            const int dk = ht & 127, hh = ht >> 7; const float g63 = GC[63];
            unsigned w[16];
#pragma unroll
            for (int q = 0; q < 16; ++q) { const int ta = hh * 32 + 2 * q;
                w[q] = pk2(bf2f(KB[ta * 136 + dk]) * __expf(g63 - GC[ta]), bf2f(KB[(ta + 1) * 136 + dk]) * __expf(g63 - GC[ta + 1])); }
            bf16* dp = GA4 + (size_t)item * 128 * 64;
            *(uint4*)(dp + frag_off(dk, hh * 32, 2)) = make_uint4(w[0], w[1], w[2], w[3]); *(uint4*)(dp + frag_off(dk, hh * 32 + 8, 2)) = make_uint4(w[4], w[5], w[6], w[7]);
            *(uint4*)(dp + frag_off(dk, hh * 32 + 16, 2)) = make_uint4(w[8], w[9], w[10], w[11]); *(uint4*)(dp + frag_off(dk, hh * 32 + 24, 2)) = make_uint4(w[12], w[13], w[14], w[15]);
            if (ht == 0) GGL[item] = __expf(g63);
        }
    }
}

constexpr int RCL_HALF_BYTES = 75776;
__device__ __forceinline__ void ph_rcl(const Ctx& c) {
    const bf16* RKV = c.ws<bf16>(WS_RKV); const float* LW = c.ws<float>(WS_LW); const float* AAg = c.ws<float>(WS_AA);
    const float* mu = c.P.in[I_MU]; const float* k_k = c.P.in[I_KK]; const float* k_a = c.P.in[I_KA]; const float* r_k = c.P.in[I_RK];
    bf16* VP = c.ws<bf16>(WS_VP); float* SC = c.ws<float>(WS_SC);
    bf16* RA1 = c.ws<bf16>(WS_RA1); bf16* RX0 = c.ws<bf16>(WS_RX0); bf16* RA2 = c.ws<bf16>(WS_RA2); bf16* RA3 = c.ws<bf16>(WS_RA3); bf16* RO0 = c.ws<bf16>(WS_RO0);
    bf16* RA4 = c.ws<bf16>(WS_RA4); bf16* RS0 = c.ws<bf16>(WS_RS0); float* RDSC = c.ws<float>(WS_RDSC);
    unsigned long long ts_t0 = 0ull, ts_acc = 0ull;
#define TSMARK(k) do { if (TS_BEGIN >= 0 && blockIdx.x == 0 && c.tid == 0) { const unsigned long long now_ = __builtin_amdgcn_s_memrealtime(); \
        if ((k) == TS_END && ts_t0 != 0ull) ts_acc += now_ - ts_t0; if ((k) == TS_BEGIN) ts_t0 = now_; } } while (0)
    uint4 ur[2], uk[2], uv[2]; float4 a4v[4], l4v[4];
#define RCL_LOAD(ITEM, TID) do { const int it_ = (ITEM), ht_ = (TID) & 255, n_ = it_ & 63, bh_ = it_ >> 6, h_ = bh_ & 15, b_ = bh_ >> 4; \
        const int r_ = ht_ >> 2, c0_ = (ht_ & 3) * 16, t_ = b_ * SEQ + n_ * 64 + r_; \
        const bf16* cur_ = RKV + (size_t)t_ * 3072 + h_ * 64 + c0_; \
        _Pragma("unroll") for (int g = 0; g < 2; ++g) { ur[g] = *(const uint4*)(cur_ + 8 * g); uk[g] = *(const uint4*)(cur_ + 1024 + 8 * g); uv[g] = *(const uint4*)(cur_ + 2048 + 8 * g); } \
        _Pragma("unroll") for (int q = 0; q < 4; ++q) { l4v[q] = *(const float4*)(LW + (size_t)t_ * 1024 + h_ * 64 + c0_ + 4 * q); a4v[q] = *(const float4*)(AAg + (size_t)t_ * 1024 + h_ * 64 + c0_ + 4 * q); } \
    } while (0)
    if ((int)(blockIdx.x * 2) < 4096) RCL_LOAD(blockIdx.x * 2 + (c.tid >> 8), c.tid);
    for (int it0 = blockIdx.x * 2; it0 < 4096; it0 += gridDim.x * 2) {
        int tv = c.tid; asm volatile("" : "+v"(tv));
        const int half = tv >> 8, ht = tv & 255, lane = tv & 63, w4 = __builtin_amdgcn_readfirstlane((tv >> 6) & 3);
        unsigned char* base = c.lds + half * RCL_HALF_BYTES;
        bf16* AT = (bf16*)base;
        bf16* VT = AT + 64 * 72;
        bf16* KDT = VT + 64 * 72;
        float* AAB = (float*)(KDT + 64 * 72);
        float* TOT = AAB + 64 * 64;
        unsigned char* RX = (unsigned char*)(TOT + 256);
        bf16* RT = (bf16*)RX;
        bf16* BTL = RT + 64 * 72;
        bf16* KT = BTL + 64 * 72;
        bf16* AAK = (bf16*)RX;
        bf16* ARK = AAK + 64 * 72;
        float* RHS2 = (float*)RX;
        const int item = it0 + half, n = item & 63, bh = item >> 6, h = bh & 15, b = bh >> 4;
        const int t0 = b * SEQ + n * 64;
        __syncthreads();
        TSMARK(0);
        const int r = ht >> 2, seg = ht & 3, c0 = seg * 16, t = t0 + r; const bool first = (n == 0 && r == 0);
        float rr[16], kf[16], vv[16], kkv[16], aa[16], lwl[16], bdv[16];
        float ss = 0.f, scs = 0.f;
        {
            float4 mr[4], mk[4], mv[4], kkw[4], kaw[4], rkw[4];
            uint4 qr[2], qk[2], qv[2];
            {   const bf16* prv = RKV + (size_t)(t - 1) * 3072 + h * 64 + c0;
#pragma unroll
                for (int g = 0; g < 2; ++g) { qr[g] = make_uint4(0, 0, 0, 0); qk[g] = qr[g]; qv[g] = qr[g];
                    if (!first) { qr[g] = *(const uint4*)(prv + 8 * g); qk[g] = *(const uint4*)(prv + 1024 + 8 * g); qv[g] = *(const uint4*)(prv + 2048 + 8 * g); } } }
#pragma unroll
            for (int q = 0; q < 4; ++q) {
                mr[q] = *(const float4*)(mu + h * 64 + c0 + 4 * q); mk[q] = *(const float4*)(mu + 1024 + h * 64 + c0 + 4 * q); mv[q] = *(const float4*)(mu + 2048 + h * 64 + c0 + 4 * q);
                kkw[q] = *(const float4*)(k_k + h * 64 + c0 + 4 * q); kaw[q] = *(const float4*)(k_a + h * 64 + c0 + 4 * q); rkw[q] = *(const float4*)(r_k + h * 64 + c0 + 4 * q);
            }
#pragma unroll
            for (int q = 0; q < 4; ++q) *(float4*)(AAB + r * 64 + c0 + 4 * q) = l4v[q];
            __syncthreads();
            {
                const int ch = ht & 63, tq = ht >> 6;
                float run = 0.f;
#pragma unroll
                for (int i = 0; i < 16; ++i) { run += AAB[(tq * 16 + i) * 64 + ch]; AAB[(tq * 16 + i) * 64 + ch] = run; }
                TOT[tq * 64 + ch] = run;
            }
            __syncthreads();
            TSMARK(1);
#pragma unroll
            for (int q = 0; q < 4; ++q) {
                const int g = q >> 1; const bool hi = q & 1;
                const unsigned r_a = hi ? ur[g].z : ur[g].x, r_b = hi ? ur[g].w : ur[g].y, k_a_ = hi ? uk[g].z : uk[g].x, k_b_ = hi ? uk[g].w : uk[g].y, v_a = hi ? uv[g].z : uv[g].x, v_b = hi ? uv[g].w : uv[g].y;
                const unsigned pr_a = hi ? qr[g].z : qr[g].x, pr_b = hi ? qr[g].w : qr[g].y, pk_a = hi ? qk[g].z : qk[g].x, pk_b = hi ? qk[g].w : qk[g].y, pv_a = hi ? qv[g].z : qv[g].x, pv_b = hi ? qv[g].w : qv[g].y;
                const float r0a[4] = {bflo(r_a), bfhi(r_a), bflo(r_b), bfhi(r_b)}, k0a[4] = {bflo(k_a_), bfhi(k_a_), bflo(k_b_), bfhi(k_b_)}, v0a[4] = {bflo(v_a), bfhi(v_a), bflo(v_b), bfhi(v_b)};
                const float rpa[4] = {bflo(pr_a), bfhi(pr_a), bflo(pr_b), bfhi(pr_b)}, kpa[4] = {bflo(pk_a), bfhi(pk_a), bflo(pk_b), bfhi(pk_b)}, vpa[4] = {bflo(pv_a), bfhi(pv_a), bflo(pv_b), bfhi(pv_b)};
                const float mra[4] = {mr[q].x, mr[q].y, mr[q].z, mr[q].w}, mka[4] = {mk[q].x, mk[q].y, mk[q].z, mk[q].w}, mva[4] = {mv[q].x, mv[q].y, mv[q].z, mv[q].w};
                const float kka[4] = {kkw[q].x, kkw[q].y, kkw[q].z, kkw[q].w}, kaa[4] = {kaw[q].x, kaw[q].y, kaw[q].z, kaw[q].w}, rka[4] = {rkw[q].x, rkw[q].y, rkw[q].z, rkw[q].w};
                const float aaa[4] = {a4v[q].x, a4v[q].y, a4v[q].z, a4v[q].w}, lwa[4] = {l4v[q].x, l4v[q].y, l4v[q].z, l4v[q].w};
#pragma unroll
                for (int e = 0; e < 4; ++e) { const int i = 4 * q + e;
                    rr[i] = r0a[e] + (rpa[e] - r0a[e]) * mra[e]; const float kx = k0a[e] + (kpa[e] - k0a[e]) * mka[e]; vv[i] = v0a[e] + (vpa[e] - v0a[e]) * mva[e];
                    kkv[i] = kx * kka[e]; ss += kkv[i] * kkv[i]; aa[i] = aaa[e]; lwl[i] = lwa[e]; kf[i] = kx * (1.f + (aaa[e] - 1.f) * kaa[e]); scs += rr[i] * kf[i] * rka[e]; }
            }
        }
        {
            ss = sum4(ss); scs = sum4(scs);
            const float rn = rsqrtf(ss + 1e-6f);
            if (seg == 0) SC[(size_t)t * 16 + h] = scs;
            const int tq = r >> 4;
            unsigned wat[8], wbt[8], wkt[8], wrt[8], wvp[8];
            float atv[16], btv[16], ktv[16], rtv[16];
#pragma unroll
            for (int i = 0; i < 16; ++i) {
                const int ch = c0 + i;
                float off = 0.f;
#pragma unroll
                for (int q = 0; q < 3; ++q) off += (q < tq) ? TOT[q * 64 + ch] : 0.f;
                const float tot = TOT[ch] + TOT[64 + ch] + TOT[128 + ch] + TOT[192 + ch];
                const float cs = AAB[r * 64 + ch] + off;
                const float lwv = lwl[i];
                const float kk = kkv[i] * rn;
                const float e2 = __expf(-cs), e4 = __expf(tot - cs);
                atv[i] = kk * __expf(cs - lwv); btv[i] = -kk * aa[i] * e2; ktv[i] = kf[i] * e2; rtv[i] = rr[i] * __expf(cs);
                VT[ch * 72 + r] = f2bf(vv[i]);
                KDT[ch * 72 + r] = f2bf(kf[i] * e4);
                bdv[i] = -kk * aa[i] * e4;
                if (r == 63) RDSC[(size_t)item * 64 + ch] = __expf(tot);
            }
#pragma unroll
            for (int q = 0; q < 8; ++q) { wat[q] = pk2(atv[2 * q], atv[2 * q + 1]); wbt[q] = pk2(btv[2 * q], btv[2 * q + 1]); wkt[q] = pk2(ktv[2 * q], ktv[2 * q + 1]); wrt[q] = pk2(rtv[2 * q], rtv[2 * q + 1]); wvp[q] = pk2(vv[2 * q], vv[2 * q + 1]); }
            *(uint4*)(AT + r * 72 + c0) = make_uint4(wat[0], wat[1], wat[2], wat[3]); *(uint4*)(AT + r * 72 + c0 + 8) = make_uint4(wat[4], wat[5], wat[6], wat[7]);
            *(uint4*)(BTL + r * 72 + c0) = make_uint4(wbt[0], wbt[1], wbt[2], wbt[3]); *(uint4*)(BTL + r * 72 + c0 + 8) = make_uint4(wbt[4], wbt[5], wbt[6], wbt[7]);
            *(uint4*)(KT + r * 72 + c0) = make_uint4(wkt[0], wkt[1], wkt[2], wkt[3]); *(uint4*)(KT + r * 72 + c0 + 8) = make_uint4(wkt[4], wkt[5], wkt[6], wkt[7]);
            *(uint4*)(RT + r * 72 + c0) = make_uint4(wrt[0], wrt[1], wrt[2], wrt[3]); *(uint4*)(RT + r * 72 + c0 + 8) = make_uint4(wrt[4], wrt[5], wrt[6], wrt[7]);
            bf16* a2p = RA2 + (size_t)item * 64 * 64;
            *(uint4*)(a2p + frag_off(r, c0, 2)) = make_uint4(wrt[0], wrt[1], wrt[2], wrt[3]); *(uint4*)(a2p + frag_off(r, c0 + 8, 2)) = make_uint4(wrt[4], wrt[5], wrt[6], wrt[7]);
            bf16* vpp = VP + (size_t)t * 1024 + h * 64 + c0;
            *(uint4*)vpp = make_uint4(wvp[0], wvp[1], wvp[2], wvp[3]); *(uint4*)(vpp + 8) = make_uint4(wvp[4], wvp[5], wvp[6], wvp[7]);
        }
        __syncthreads();
        TSMARK(2);
        if (it0 + (int)gridDim.x * 2 < 4096) RCL_LOAD(item + (int)gridDim.x * 2, tv);
        {
            bf16* BDS = (bf16*)AAB;
#pragma unroll
            for (int i = 0; i < 16; ++i) BDS[(c0 + i) * 72 + r] = f2bf(bdv[i]);
        }
        const int fr = lane & 15, fq = lane >> 4;
        f32x4_t cab[4], cak[4], crb[4], crk[4];
        {
            const int j0t = w4 * 16;
            bf16x8_t bj[2], kj[2];
#pragma unroll
            for (int kb = 0; kb < 2; ++kb) { bj[kb] = *(const bf16x8_t*)(BTL + (j0t + fr) * 72 + kb * 32 + fq * 8); kj[kb] = *(const bf16x8_t*)(KT + (j0t + fr) * 72 + kb * 32 + fq * 8); }
#pragma unroll
            for (int it = 0; it < 4; ++it) {
                cab[it] = (f32x4_t){0.f, 0.f, 0.f, 0.f}; cak[it] = cab[it]; crb[it] = cab[it]; crk[it] = cab[it];
#pragma unroll
                for (int kb = 0; kb < 2; ++kb) {
                    const bf16x8_t ai = *(const bf16x8_t*)(AT + (it * 16 + fr) * 72 + kb * 32 + fq * 8);
                    const bf16x8_t ri = *(const bf16x8_t*)(RT + (it * 16 + fr) * 72 + kb * 32 + fq * 8);
                    cab[it] = MFMA16(bj[kb], ai, cab[it]); cak[it] = MFMA16(kj[kb], ai, cak[it]); crb[it] = MFMA16(bj[kb], ri, crb[it]); crk[it] = MFMA16(kj[kb], ri, crk[it]);
                }
            }
        }
        __syncthreads();
        {
            const bf16* BDS = (const bf16*)AAB; bf16* bp = RA4 + (size_t)item * 64 * 64;
#pragma unroll
            for (int q = 0; q < 2; ++q) { const int p = ht + 256 * q, pfr = p & 15, pfq = (p >> 4) & 3, pkb = (p >> 6) & 1, prt = p >> 7;
                *(uint4*)(bp + p * 8) = *(const uint4*)(BDS + (prt * 16 + pfr) * 72 + pkb * 32 + pfq * 8); }
        }
        __syncthreads();
        {
            const int j0 = w4 * 16 + 4 * fq;
#pragma unroll
            for (int it = 0; it < 4; ++it) {
                const int i = it * 16 + fr;
                float vab[4], vak[4], vrb[4], vrk[4];
#pragma unroll
                for (int rg = 0; rg < 4; ++rg) { const int j = j0 + rg; const bool st = i > j, in = i >= j;
                    vab[rg] = st ? cab[it][rg] : 0.f; vak[rg] = st ? cak[it][rg] : 0.f; vrb[rg] = in ? crb[it][rg] : 0.f; vrk[rg] = in ? crk[it][rg] : 0.f; }
                *(float4*)(AAB + i * TRI_LS + j0) = make_float4(vab[0], vab[1], vab[2], vab[3]);
                uint2 w; w.x = pk2(vak[0], vak[1]); w.y = pk2(vak[2], vak[3]); *(uint2*)(AAK + i * 72 + j0) = w;
                w.x = pk2(vrk[0], vrk[1]); w.y = pk2(vrk[2], vrk[3]); *(uint2*)(ARK + i * 72 + j0) = w;
                w.x = pk2(vrb[0], vrb[1]); w.y = pk2(vrb[2], vrb[3]); *(uint2*)(RA3 + (size_t)item * 64 * 64 + frag_off(i, j0, 2)) = w;
            }
        }
        __syncthreads();
        f32x4_t cav[4], cov[4], ckv[4];
        {
            const int r0t = w4 * 16;
            bf16x8_t fa[2], fo[2], fk[2];
#pragma unroll
            for (int kb = 0; kb < 2; ++kb) { fa[kb] = *(const bf16x8_t*)(AAK + (r0t + fr) * 72 + kb * 32 + fq * 8); fo[kb] = *(const bf16x8_t*)(ARK + (r0t + fr) * 72 + kb * 32 + fq * 8); fk[kb] = *(const bf16x8_t*)(KDT + (r0t + fr) * 72 + kb * 32 + fq * 8); }
#pragma unroll
            for (int vt = 0; vt < 4; ++vt) {
                cav[vt] = (f32x4_t){0.f, 0.f, 0.f, 0.f}; cov[vt] = cav[vt]; ckv[vt] = cav[vt];
#pragma unroll
                for (int kb = 0; kb < 2; ++kb) { const bf16x8_t vb = *(const bf16x8_t*)(VT + (vt * 16 + fr) * 72 + kb * 32 + fq * 8);
                    cav[vt] = MFMA16(fa[kb], vb, cav[vt]); cov[vt] = MFMA16(fo[kb], vb, cov[vt]); ckv[vt] = MFMA16(fk[kb], vb, ckv[vt]); }
            }
        }
        __syncthreads();
        {
            const int r0 = w4 * 16 + 4 * fq;
#pragma unroll
            for (int vt = 0; vt < 4; ++vt) {
                const int v = vt * 16 + fr;
#pragma unroll
                for (int rg = 0; rg < 4; ++rg) RHS2[v * 65 + r0 + rg] = cav[vt][rg];
                { uint2 w; w.x = pk2(cov[vt][0], cov[vt][1]); w.y = pk2(cov[vt][2], cov[vt][3]); *(uint2*)(RO0 + (size_t)item * 64 * 64 + cfrag_off(v, r0, 4)) = w; }
                { uint2 w; w.x = pk2(ckv[vt][0], ckv[vt][1]); w.y = pk2(ckv[vt][2], ckv[vt][3]); *(uint2*)(RS0 + (size_t)item * 64 * 64 + cfrag_off(v, r0, 4)) = w; }
            }
        }
        __syncthreads();
        TSMARK(3);
        if (w4 == 0) tri_diag_inv<-1>(AAB, lane);
        __syncthreads();
        bf16* TI = (bf16*)(RX + 16640);
        {
            f32x4_t Tb[4];
            tri_col_inv<-1>(AAB, w4, lane, Tb);
            const int tn = lane & 15, tq = lane >> 4, col = 16 * w4 + tn;
#pragma unroll
            for (int r = 0; r < 4; ++r) {
                if (r >= w4 || r + 1 == w4) {
#pragma unroll
                    for (int rr = 0; rr < 4; ++rr) TI[(16 * r + 4 * tq + rr) * 72 + col] = f2bf(Tb[r][rr]);
                }
            }
        }
        __syncthreads();
        bf16* WST = (bf16*)AAB;
        {
            const int cc = w4 * 16 + fr;
            bf16x8_t af[4][2];
#pragma unroll
            for (int it = 0; it < 4; ++it)
#pragma unroll
                for (int kb = 0; kb < 2; ++kb) af[it][kb] = *(const bf16x8_t*)(TI + (it * 16 + fr) * 72 + kb * 32 + fq * 8);
            bf16x8_t b0, b1, u0, u1;
#pragma unroll
            for (int e = 0; e < 8; ++e) { b0[e] = (short)AT[(fq * 8 + e) * 72 + cc]; b1[e] = (short)AT[(32 + fq * 8 + e) * 72 + cc]; }
#pragma unroll
            for (int e = 0; e < 8; e += 2) {
                const unsigned p0 = pk2(RHS2[cc * 65 + fq * 8 + e], RHS2[cc * 65 + fq * 8 + e + 1]), p1 = pk2(RHS2[cc * 65 + 32 + fq * 8 + e], RHS2[cc * 65 + 32 + fq * 8 + e + 1]);
                u0[e] = (short)(p0 & 0xffffu); u0[e + 1] = (short)(p0 >> 16); u1[e] = (short)(p1 & 0xffffu); u1[e + 1] = (short)(p1 >> 16);
            }
            bf16* up = RX0 + (size_t)item * 64 * 64;
#pragma unroll
            for (int it = 0; it < 4; ++it) {
                f32x4_t xa = {0.f, 0.f, 0.f, 0.f}, xu = {0.f, 0.f, 0.f, 0.f};
                xa = MFMA16(af[it][0], b0, xa); xu = MFMA16(af[it][0], u0, xu);
                if (it >= 2) { xa = MFMA16(af[it][1], b1, xa); xu = MFMA16(af[it][1], u1, xu); }
                { uint2 w; w.x = pk2(xu[0], xu[1]); w.y = pk2(xu[2], xu[3]); *(uint2*)(up + cfrag_off(cc, it * 16 + 4 * fq, 4)) = w; }
#pragma unroll
                for (int rr = 0; rr < 4; ++rr) WST[(it * 16 + 4 * fq + rr) * 72 + cc] = f2bf(xa[rr]);
            }
        }
        __syncthreads();
        TSMARK(4);
        {
            bf16* wp = RA1 + (size_t)item * 64 * 64;
#pragma unroll
            for (int q = 0; q < 2; ++q) { const int p = ht + 256 * q, pfr = p & 15, pfq = (p >> 4) & 3, pkb = (p >> 6) & 1, prt = p >> 7;
                *(uint4*)(wp + p * 8) = *(const uint4*)(WST + (prt * 16 + pfr) * 72 + pkb * 32 + pfq * 8); }
        }
    }
    if (TS_BEGIN >= 0 && blockIdx.x == 0 && c.tid == 0) c.ws<unsigned>(WS_CTL)[CW_TS] = (unsigned)ts_acc;
#undef TSMARK
#undef RCL_LOAD
}

template <int DK, bool RW>
struct ScanArgs { const bf16* A1; const bf16* X0; const bf16* A2; const bf16* A3; const bf16* O0; const bf16* A4; const bf16* S0; const float* DSC; bf16* OUT; int item0; int vs; int tok0; int ocol0; };
#define LBAR() do { asm volatile("s_waitcnt lgkmcnt(0)" ::: "memory"); __builtin_amdgcn_s_barrier(); asm volatile("" ::: "memory"); } while (0)
template <int DK, bool RW>
__device__ __forceinline__ void scan_run(const Ctx& c, const ScanArgs<DK, RW>& a) {
    constexpr int KB = DK / 32;
    constexpr int NST = DK / 64;
    constexpr int NV = RW ? 64 : 128;
    constexpr int SROW = DK + 8;
    bf16* ST = (bf16*)c.lds;
    bf16* XT = ST + 2 * 32 * SROW;
    const int lane = c.lane, w = c.wave, fr = lane & 15, fq = lane >> 4;
    const int tm = w >> 1, tn = w & 1;
    const int dkt = (NST == 2) ? w : (w >> 1);
    for (int i = c.tid; i < 32 * SROW / 2; i += NTHREADS) ((unsigned*)ST)[i] = 0u;
    f32x4_t accS[NST];
#pragma unroll
    for (int s = 0; s < NST; ++s) accS[s] = (f32x4_t){0.f, 0.f, 0.f, 0.f};
    bf16x8_t a1f[KB], a2f[KB], a3f[2], a4f[2]; f32x4_t x0v, o0v, s0v[NST], dscv;
#define SCAN_LOAD(IT) do { const size_t it_ = (size_t)(IT); \
        _Pragma("unroll") for (int kb = 0; kb < KB; ++kb) { a1f[kb] = *(const bf16x8_t*)(a.A1 + it_ * 64 * DK + ((tm * KB + kb) * 64 + lane) * 8); a2f[kb] = *(const bf16x8_t*)(a.A2 + it_ * 64 * DK + ((tm * KB + kb) * 64 + lane) * 8); } \
        _Pragma("unroll") for (int kb = 0; kb < 2; ++kb) { a3f[kb] = *(const bf16x8_t*)(a.A3 + it_ * 64 * 64 + ((tm * 2 + kb) * 64 + lane) * 8); a4f[kb] = *(const bf16x8_t*)(a.A4 + it_ * DK * 64 + ((dkt * 2 + kb) * 64 + lane) * 8); } \
        { const uint2 q_ = *(const uint2*)(a.X0 + it_ * NV * 64 + (((a.vs * 2 + tn) * 4 + tm) * 64 + lane) * 4); x0v = (f32x4_t){bflo(q_.x), bfhi(q_.x), bflo(q_.y), bfhi(q_.y)}; } \
        if (RW) { { const uint2 q_ = *(const uint2*)(a.O0 + it_ * NV * 64 + (((a.vs * 2 + tn) * 4 + tm) * 64 + lane) * 4); o0v = (f32x4_t){bflo(q_.x), bfhi(q_.x), bflo(q_.y), bfhi(q_.y)}; } \
                  _Pragma("unroll") for (int s = 0; s < NST; ++s) { const uint2 q_ = *(const uint2*)(a.S0 + it_ * 64 * DK + (((a.vs * 2 + (NST == 2 ? s : tn)) * (DK / 16) + dkt) * 64 + lane) * 4); s0v[s] = (f32x4_t){bflo(q_.x), bfhi(q_.x), bflo(q_.y), bfhi(q_.y)}; } \
                  dscv = *(const f32x4_t*)(a.DSC + it_ * DK + dkt * 16 + 4 * fq); } \
        else { const float g_ = a.DSC[it_]; dscv = (f32x4_t){g_, g_, g_, g_}; o0v = (f32x4_t){0.f, 0.f, 0.f, 0.f}; _Pragma("unroll") for (int s = 0; s < NST; ++s) s0v[s] = (f32x4_t){0.f, 0.f, 0.f, 0.f}; } \
    } while (0)
    SCAN_LOAD(a.item0);
    int cur = 0;
    for (int n = 0; n < 64; ++n) {
        bf16x8_t b1[KB], b2[KB], b3[2], b4[2];
#pragma unroll
        for (int kb = 0; kb < KB; ++kb) { b1[kb] = a1f[kb]; b2[kb] = a2f[kb]; }
        b3[0] = a3f[0]; b3[1] = a3f[1]; b4[0] = a4f[0]; b4[1] = a4f[1];
        f32x4_t accX = x0v, accO = o0v; const f32x4_t dv = dscv; f32x4_t sv[NST];
#pragma unroll
        for (int s = 0; s < NST; ++s) sv[s] = s0v[s];
        if (n + 1 < 64) SCAN_LOAD(a.item0 + n + 1);
        LBAR();
        const bf16* Sc = ST + cur * 32 * SROW; bf16* Sn = ST + (cur ^ 1) * 32 * SROW;
        bf16x8_t sf[KB];
#pragma unroll
        for (int kb = 0; kb < KB; ++kb) sf[kb] = *(const bf16x8_t*)(Sc + (tn * 16 + fr) * SROW + kb * 32 + fq * 8);
#pragma unroll
        for (int kb = 0; kb < KB; ++kb) accX = MFMA16(b1[kb], sf[kb], accX);
        { uint2 wv; wv.x = pk2(accX[0], accX[1]); wv.y = pk2(accX[2], accX[3]); *(uint2*)(XT + (tn * 16 + fr) * 72 + tm * 16 + 4 * fq) = wv; }
#pragma unroll
        for (int kb = 0; kb < KB; ++kb) accO = MFMA16(b2[kb], sf[kb], accO);
        LBAR();
        bf16x8_t xf[2];
#pragma unroll
        for (int kb = 0; kb < 2; ++kb) xf[kb] = *(const bf16x8_t*)(XT + (tn * 16 + fr) * 72 + kb * 32 + fq * 8);
        accO = MFMA16(b3[0], xf[0], accO); accO = MFMA16(b3[1], xf[1], accO);
        {
            bf16* op = a.OUT + (size_t)(a.tok0 + n * 64 + tm * 16 + 4 * fq) * 1024 + a.ocol0 + tn * 16 + fr;
            op[0] = f2bf(accO[0]); op[1024] = f2bf(accO[1]); op[2048] = f2bf(accO[2]); op[3072] = f2bf(accO[3]);
        }
#pragma unroll
        for (int s = 0; s < NST; ++s) {
            const int vt = (NST == 2) ? s : tn;
            bf16x8_t xg[2];
            if (vt == tn) { xg[0] = xf[0]; xg[1] = xf[1]; }
            else {
#pragma unroll
                for (int kb = 0; kb < 2; ++kb) xg[kb] = *(const bf16x8_t*)(XT + (vt * 16 + fr) * 72 + kb * 32 + fq * 8);
            }
            f32x4_t t = accS[s] * dv + sv[s];
            t = MFMA16(b4[0], xg[0], t); t = MFMA16(b4[1], xg[1], t);
            accS[s] = t;
            uint2 wv; wv.x = pk2(t[0], t[1]); wv.y = pk2(t[2], t[3]);
            *(uint2*)(Sn + (vt * 16 + fr) * SROW + dkt * 16 + 4 * fq) = wv;
        }
        cur ^= 1;
    }
#undef SCAN_LOAD
    __syncthreads();
}

__device__ __forceinline__ void ph_scan(const Ctx& c) {
    for (int wk = blockIdx.x; wk < 256; wk += gridDim.x) {
        const int xcd = wk & 7, j = wk >> 3;
        if (j < 16) {
            const int pair = xcd * 4 + (j >> 2), vs = j & 3, b = pair >> 3, h = pair & 7;
            ScanArgs<128, false> a{c.ws<bf16>(WS_GA1), c.ws<bf16>(WS_GX0), c.ws<bf16>(WS_GA2), c.ws<bf16>(WS_GA3), nullptr, c.ws<bf16>(WS_GA4), nullptr, c.ws<float>(WS_GGL),
                                   c.ws<bf16>(WS_OG), pair * 64, vs, b * SEQ, h * 128 + vs * 32};
            scan_run<128, false>(c, a);
        } else {
            const int pair = xcd * 8 + ((j - 16) >> 1), vs = (j - 16) & 1, b = pair >> 4, h = pair & 15;
            ScanArgs<64, true> a{c.ws<bf16>(WS_RA1), c.ws<bf16>(WS_RX0), c.ws<bf16>(WS_RA2), c.ws<bf16>(WS_RA3), c.ws<bf16>(WS_RO0), c.ws<bf16>(WS_RA4), c.ws<bf16>(WS_RS0), c.ws<float>(WS_RDSC),
                                 c.ws<bf16>(WS_ORW), pair * 64, vs, b * SEQ, h * 64 + vs * 32};
            scan_run<64, true>(c, a);
        }
    }
}

enum { PH_RMS0 = 0, PH_INPROJ, PH_GCL, PH_LORA, PH_RCL, PH_SCAN, PH_POST, PH_G2, PH_X1, PH_ROUTER, PH_DISPATCH, PH_MOE1, PH_MOE2, PH_COMBINE, PH_COUNT };

template <unsigned PHMASK>
__global__ void __launch_bounds__(NTHREADS) mk(Params P) {
    extern __shared__ __attribute__((aligned(16))) unsigned char lds[];
    volatile LAS unsigned* misc = (volatile LAS unsigned*)((LAS unsigned char*)lds + MISC_OFF);
    if (threadIdx.x < 64) misc[threadIdx.x] = 0u;
    __syncthreads();
    unsigned* ctl = (unsigned*)(P.ws + WS_CTL);
    XcdBarrier bar = xcd_barrier_post(ctl + CW_BAR + P.li * XCD_BAR_WORDS, misc);
#define MKCTX() int tv_ = threadIdx.x; asm volatile("" : "+v"(tv_)); const int wv_ = __builtin_amdgcn_readfirstlane(tv_ >> 6); \
    Ctx c{P, tv_, tv_ & 63, wv_, (int)(blockIdx.x * NWAVES + wv_), (int)(gridDim.x * NWAVES), (size_t)blockIdx.x * NTHREADS + tv_, (size_t)gridDim.x * NTHREADS, lds}
    bool first_seam = true;
#define IN(k) (((PHMASK >> (k)) & 1u) && P.ph_lo <= (k) && (k) < P.ph_hi)
#define SEAM(k) do { if ((k) + 1 < P.ph_hi) { xcd_barrier(bar); first_seam = false; } } while (0)
#define REP(k) for (int rep_ = 0; rep_ < ((k) == PROBE_REP ? 2 : 1); ++rep_)
    if (IN(PH_RMS0)) { MKCTX();
        REP(PH_RMS0) {
        ph_rms0(c);
        { WJob j{P.in[I_W_IN], NCOL_IN, 1024, 4096, c.ws<bf16>(WS_WIN_T), 1024, 1, 0, 0}; wconv_job(c, j); }
        { WJob j{P.in[I_W_IN] + 4112, NCOL_IN, 1024, 5376, c.ws<bf16>(WS_WIN_T) + (size_t)4096 * 1024, 1024, 1, 0, 0}; wconv_job(c, j); }
        lora_zero(c);
        { WJob j{P.in[I_W2], 1024, 64, 1024, c.ws<bf16>(WS_LORA_T), 256, 1, 0, 0}; wconv_job(c, j); }
        { WJob j{P.in[I_A2], 1024, 64, 1024, c.ws<bf16>(WS_LORA_T) + (size_t)1024 * 256 + 64, 256, 1, 0, 0}; wconv_job(c, j); }
        { WJob j{P.in[I_G2], 1024, 128, 1024, c.ws<bf16>(WS_LORA_T) + (size_t)2048 * 256 + 128, 256, 1, 0, 0}; wconv_job(c, j); }
        }
        SEAM(PH_RMS0);
    }
    if (IN(PH_INPROJ)) { MKCTX();
        REP(PH_INPROJ) {
        EpiInProj ep{c.ws<bf16>(WS_GQKV), c.ws<bf16>(WS_ZS), c.ws<bf16>(WS_RKV), c.ws<float>(WS_LIN), c.ws<bf16>(WS_GATES)};
        SchedInProj sc{(const char*)c.ws<bf16>(WS_HB), (const char*)c.ws<bf16>(WS_WIN_T), (int)gridDim.x, (int)blockIdx.x};
        pg8::gemm_phase((LAS unsigned char*)lds, 1024, sc, ep, c.tid);
        }
        SEAM(PH_INPROJ);
    }
    if (IN(PH_GCL)) { MKCTX(); REP(PH_GCL) { ph_gcl(c); ph_loraprep(c); } SEAM(PH_GCL); }
    if (IN(PH_LORA)) { MKCTX();
        REP(PH_LORA) {
        EpiLora ep{P.in[I_W0], P.in[I_A0], c.ws<float>(WS_LW), c.ws<float>(WS_AA), c.ws<bf16>(WS_GGR)};
        SchedLora sc{(const char*)c.ws<bf16>(WS_ALORA), (const char*)c.ws<bf16>(WS_LORA_T), (int)gridDim.x, (int)blockIdx.x};
        pg8::gemm_phase((LAS unsigned char*)lds, 256, sc, ep, c.tid);
        }
        SEAM(PH_LORA);
    }
    if (IN(PH_RCL)) { MKCTX(); REP(PH_RCL) { ph_rcl(c); } SEAM(PH_RCL); }
    if (IN(PH_SCAN)) { MKCTX(); REP(PH_SCAN) { ph_scan(c); } SEAM(PH_SCAN); }
    if (IN(PH_POST)) { MKCTX();
        REP(PH_POST) {
        ph_post(c);
        { WJob j{P.in[I_PROJ_A], 1024, 1024, 1024, c.ws<bf16>(WS_PROJ_T), 1024, 1, 0, 0}; wconv_job(c, j); }
        { WJob j{P.in[I_PROJ_B], 1024, 1024, 1024, c.ws<bf16>(WS_PROJ_T) + (size_t)1024 * 1024, 1024, 1, 0, 0}; wconv_job(c, j); }
        { WJob j{P.in[I_W_OUT], 1024, 1024, 1024, c.ws<bf16>(WS_WOUT_T), 1024, 1, 0, 0}; wconv_job(c, j); }
        }
        SEAM(PH_POST);
    }
    if (IN(PH_G2)) { MKCTX();
        REP(PH_G2) {
        EpiG2 ep{c.ws<bf16>(WS_GATES), c.ws<bf16>(WS_G2)};
        SchedG2 sc{(const char*)c.ws<bf16>(WS_YA), (const char*)c.ws<bf16>(WS_PROJ_T), (int)gridDim.x, (int)blockIdx.x};
        pg8::gemm_phase((LAS unsigned char*)lds, 1024, sc, ep, c.tid);
        }
        SEAM(PH_G2);
    }
    if (IN(PH_X1)) { MKCTX();
        REP(PH_X1) {
        EpiX1 ep{P.in[I_X], c.ws<float>(WS_X1)};
        SchedX1 sc{(const char*)c.ws<bf16>(WS_G2), (const char*)c.ws<bf16>(WS_WOUT_T), (int)gridDim.x, (int)blockIdx.x};
        pg8::gemm_phase((LAS unsigned char*)lds, 1024, sc, ep, c.tid);
        }
        SEAM(PH_X1);
    }
    if (IN(PH_ROUTER)) { MKCTX();
        ph_router(c);
        REP(PH_ROUTER) {
        { WJob j{P.in[I_W_GU], 2048, 1024, 2048, c.ws<bf16>(WS_WGU_T), 1024, 32, (size_t)1024 * 2048, (size_t)2048 * 1024}; wconv_job(c, j); }
        { WJob j{P.in[I_W_DOWN], 1024, 1024, 1024, c.ws<bf16>(WS_WDN_T), 1024, 32, (size_t)1024 * 1024, (size_t)1024 * 1024}; wconv_job(c, j); }
        }
        SEAM(PH_ROUTER);
    }
    if (IN(PH_DISPATCH)) { MKCTX(); REP(PH_DISPATCH) { ph_dispatch(c); } SEAM(PH_DISPATCH); }
    if (IN(PH_MOE1)) { MKCTX();
        REP(PH_MOE1) {
        const int nt = *c.ws<int>(WS_NT);
        EpiAct ep{P.in[I_B_GU], c.ws<bf16>(WS_ACT)};
        SchedMoe sc{(const char*)c.ws<bf16>(WS_H2), (const char*)c.ws<bf16>(WS_WGU_T), c.ws<int>(WS_TILE_E), c.ws<int>(WS_SLOT_TOK), nt, 8, (int)gridDim.x, (int)blockIdx.x};
        pg8::gemm_phase_t<true>((LAS unsigned char*)lds, 1024, sc, ep, c.tid);
        }
        SEAM(PH_MOE1);
    }
    if (IN(PH_MOE2)) { MKCTX();
        REP(PH_MOE2) {
        const int nt = *c.ws<int>(WS_NT);
        EpiYS ep{P.in[I_B_DOWN], c.ws<float>(WS_SGATE), c.ws<bf16>(WS_YS)};
        SchedMoe sc{(const char*)c.ws<bf16>(WS_ACT), (const char*)c.ws<bf16>(WS_WDN_T), c.ws<int>(WS_TILE_E), nullptr, nt, 4, (int)gridDim.x, (int)blockIdx.x};
        pg8::gemm_phase((LAS unsigned char*)lds, 1024, sc, ep, c.tid);
        }
        SEAM(PH_MOE2);
    }
    if (IN(PH_COMBINE)) { MKCTX(); REP(PH_COMBINE) { ph_combine(c); } }
#undef IN
#undef SEAM
#undef REP
#undef MKCTX
}

template <unsigned M> static void launch_one(const Params& p, int grid, hipStream_t stream) {
    static bool attr = false;
    if (!attr) { (void)hipFuncSetAttribute((const void*)mk<M>, hipFuncAttributeMaxDynamicSharedMemorySize, LDS_BYTES); attr = true; }
    hipLaunchKernelGGL(mk<M>, dim3(grid), dim3(NTHREADS), LDS_BYTES, stream, p);
}
template <int PH> static void launch_chain(Params& p, int grid, hipStream_t stream) {
    if constexpr (PH < PH_COUNT) { p.ph_lo = PH; p.ph_hi = PH + 1; p.li = 0; p.coop = 0; launch_one<(1u << PH)>(p, grid, stream); launch_chain<PH + 1>(p, grid, stream); }
}

extern "C" void kernel_launch(void* const* d_in, const int* in_sizes, int n_in, void* d_out, int out_size, void* d_ws, size_t ws_size, hipStream_t stream) {
    static int grid = 0;
    if (grid == 0) {
        int dev = 0, cus = 0, per_cu = 0;
        (void)hipGetDevice(&dev);
        (void)hipDeviceGetAttribute(&cus, hipDeviceAttributeMultiprocessorCount, dev);
#if MK_ONE_LAUNCH
        (void)hipFuncSetAttribute((const void*)mk<0xffffffffu>, hipFuncAttributeMaxDynamicSharedMemorySize, LDS_BYTES);
        (void)hipOccupancyMaxActiveBlocksPerMultiprocessor(&per_cu, (const void*)mk<0xffffffffu>, NTHREADS, LDS_BYTES);
#else
        per_cu = 1;
#endif
        if (n_in != 29 || ws_size < WS_END || per_cu < 1 || cus < 64) { fprintf(stderr, "kernel_launch: unexpected setup n_in %d ws %zu per_cu %d cus %d\n", n_in, ws_size, per_cu, cus); grid = -1; return; }
        grid = cus;
    }
    if (grid < 0) return;
    (void)hipMemsetAsync((char*)d_ws + WS_CTL, 0, CTL_BYTES, stream);
    Params p{};
    for (int i = 0; i < 29; ++i) p.in[i] = (const float*)d_in[i];
    p.out = (float*)d_out; p.ws = (unsigned char*)d_ws;
#if MK_ONE_LAUNCH
    p.ph_lo = 0; p.ph_hi = PH_COUNT; p.li = 0; p.coop = 1;
    void* args[] = {&p};
    hipError_t e = hipLaunchCooperativeKernel((const void*)mk<0xffffffffu>, dim3(grid), dim3(NTHREADS), args, LDS_BYTES, stream);
    if (e != hipSuccess) fprintf(stderr, "cooperative launch failed: %s (grid %d)\n", hipGetErrorString(e), grid);
#else
    launch_chain<0>(p, grid, stream);
#endif
}
```

```cpp
#include <hip/hip_runtime.h>
#include <hip/hip_cooperative_groups.h>
#include <cstdint>
#include <cstdio>
namespace cg = cooperative_groups;

#ifndef MK_ONE_LAUNCH
#define MK_ONE_LAUNCH 1
#endif

#define LAS __attribute__((address_space(3)))
#ifndef FAST_INPROJ
#define FAST_INPROJ 1
#endif
#ifndef FAST_MIX
#define FAST_MIX 1
#endif
#define TS_BEGIN -1
#define TS_END -1
#define PROBE_REP -1
constexpr int NTHREADS = 512;
constexpr int NWAVES = 8;
constexpr int LDS_BYTES = 155648;
constexpr int MISC_OFF = 153600;

constexpr int T = 16384, SEQ = 4096, D = 1024;
constexpr int NCOL_IN = 9488;
constexpr int NEXP = 32;
constexpr int MAXTILES = 288;
constexpr int MAXSLOTS = MAXTILES * 256;

enum { I_X = 0, I_NORM_MIX, I_W_IN, I_GDN_CONV, I_GDN_ALOG, I_GDN_DTB, I_GDN_NORM, I_MU, I_W0, I_W2, I_A0, I_A2, I_G2, I_KK, I_KA, I_RK,
       I_LNW, I_LNB, I_PROJ_A, I_PROJ_B, I_W_OUT, I_NORM_FFN, I_ROUTER_W, I_ROUTER_B, I_W_GU, I_B_GU, I_W_DOWN, I_B_DOWN, I_NORM_FINAL };

constexpr size_t MiB = 1u << 20;
constexpr size_t WS_CTL = 0, CTL_BYTES = 65536;
constexpr size_t WS_BETA = 1 * MiB;
constexpr size_t WS_GG = WS_BETA + 512 * 1024;
constexpr size_t WS_SC = 2 * MiB;
constexpr size_t WS_TE = 3 * MiB;
constexpr size_t WS_TG = WS_TE + 256 * 1024;
constexpr size_t WS_TP = WS_TG + 256 * 1024;
constexpr size_t WS_TSLOT = WS_TP + 256 * 1024;
constexpr size_t WS_SGATE = 4 * MiB;
constexpr size_t WS_SLOT_TOK = 4 * MiB + 512 * 1024;
constexpr size_t WS_TILE_E = 5 * MiB;
constexpr size_t WS_NT = WS_TILE_E + 4096;
constexpr size_t WS_HB = 8 * MiB;
constexpr size_t WS_H2 = WS_HB;
constexpr size_t WS_ZS = 40 * MiB;
constexpr size_t WS_GATES = 72 * MiB;
constexpr size_t WS_ALORA = 136 * MiB;
constexpr size_t WS_LW = 144 * MiB;
constexpr size_t WS_AA = 208 * MiB;
constexpr size_t WS_GGR = 272 * MiB;
constexpr size_t WS_VP = 304 * MiB;
constexpr size_t WS_Q = 336 * MiB;
constexpr size_t WS_QKVC = WS_Q;
constexpr size_t WS_RP = WS_Q, WS_KF = WS_Q + 64 * MiB, WS_KKN = WS_Q + 128 * MiB;
constexpr size_t WS_YA = WS_Q, WS_YB = WS_Q + 32 * MiB, WS_G2 = WS_Q + 64 * MiB, WS_X1 = WS_Q + 128 * MiB;
constexpr size_t WS_GQKV = 528 * MiB;
constexpr size_t WS_OG = 720 * MiB, WS_ORW = 784 * MiB;
constexpr size_t WS_RKV = 720 * MiB;
constexpr size_t WS_LIN = 912 * MiB;
constexpr size_t WS_DEC = 928 * MiB;
constexpr size_t WS_XB = 528 * MiB;
constexpr size_t WS_ACT = 672 * MiB;
constexpr size_t WS_YS = 816 * MiB;
constexpr size_t WS_WIN_T = 992 * MiB;
constexpr size_t WS_PROJ_T = 144 * MiB;
constexpr size_t WS_WOUT_T = 148 * MiB;
constexpr size_t WS_WGU_T = 72 * MiB;
constexpr size_t WS_WDN_T = 200 * MiB;
constexpr size_t WS_GA1 = 336 * MiB, WS_GX0 = 368 * MiB, WS_GA2 = 432 * MiB, WS_GA3 = 464 * MiB, WS_GA4 = 480 * MiB;
constexpr size_t WS_GGL = 6 * MiB;
constexpr size_t WS_RX0 = 528 * MiB, WS_RO0 = 592 * MiB, WS_RS0 = 656 * MiB;
constexpr size_t WS_RA1 = 8 * MiB, WS_RA2 = 928 * MiB, WS_RA3 = 960 * MiB, WS_RA4 = 992 * MiB;
constexpr size_t WS_RDSC = 7 * MiB;
constexpr size_t WS_LORA_T = 1012 * MiB;
constexpr size_t WS_END = 1024 * MiB;
constexpr int CW_BAR = 1024;
constexpr int CW_CNT = 256;
constexpr int CW_TS = 900;

#define XB_TMO      128
#define XB_XCNT(j)  (256  + 64 * (j))
#define XB_XSUB(j)  (1280 + 64 * (j))
#define XB_XGEN(j)  (2304 + 64 * (j))
#define XB_TOP      3328
#define XB_TOPGEN   3392
#define XCD_BAR_WORDS 3456
#define XB_SPIN_CAP (1u << 24)
__device__ __forceinline__ unsigned xb_ld(unsigned* p)              { return __hip_atomic_load(p, __ATOMIC_RELAXED, __HIP_MEMORY_SCOPE_AGENT); }
__device__ __forceinline__ unsigned xb_add(unsigned* p, unsigned v) { return __hip_atomic_fetch_add(p, v, __ATOMIC_RELAXED, __HIP_MEMORY_SCOPE_AGENT); }
__device__ __forceinline__ unsigned xb_xcc_id() { return (unsigned)__builtin_amdgcn_s_getreg((3 << 11) | 20) & 0xFu; }
#define XB_SPIN(cond, bar) do { unsigned _sp = 0; while (cond) { __builtin_amdgcn_s_sleep(1); \
    if ((++_sp & 255u) == 0u) { if (xb_ld(&(bar)[XB_TMO])) break; if (_sp > XB_SPIN_CAP) { atomicAdd(&(bar)[XB_TMO], 1u); break; } } } } while (0)
struct XcdBarrier { unsigned* bar; unsigned x; volatile LAS unsigned* st; };
__device__ __forceinline__ XcdBarrier xcd_barrier_post(unsigned* bar, volatile LAS unsigned* st) {
    XcdBarrier b; b.bar = bar; b.x = xb_xcc_id(); b.st = st;
    if (threadIdx.x == 0) (void)xb_add(&bar[XB_XCNT(b.x)], 1u);
    return b;
}
__device__ __forceinline__ void xcd_barrier_complete(unsigned* bar, unsigned x, unsigned& nloc, unsigned& nx) {
    const unsigned G = gridDim.x * gridDim.y * gridDim.z;
    unsigned sum, cnt, mine, sp = 0u;
    for (;;) {
        sum = 0u; cnt = 0u; mine = 0u;
#pragma unroll
        for (unsigned j = 0; j < 16; ++j) { const unsigned c = xb_ld(&bar[XB_XCNT(j)]); sum += c; cnt += (c > 0u) ? 1u : 0u; mine = (j == x) ? c : mine; }
        if (sum == G) break;
        __builtin_amdgcn_s_sleep(1);
        if ((++sp & 255u) == 0u) { if (xb_ld(&bar[XB_TMO])) break; if (sp > XB_SPIN_CAP) { atomicAdd(&bar[XB_TMO], 1u); break; } }
    }
    nloc = mine > 0u ? mine : 1u; nx = cnt > 0u ? cnt : 1u;
}
__device__ __forceinline__ void xcd_barrier(const XcdBarrier& b) {
    asm volatile("s_waitcnt vmcnt(0)" ::: "memory");
    __syncthreads();
    if (threadIdx.x == 0) {
        unsigned* bar = b.bar;
        __builtin_amdgcn_s_waitcnt(0);
        unsigned nloc = b.st[0], nx = b.st[1];
        if (nloc == 0u) { xcd_barrier_complete(bar, b.x, nloc, nx); b.st[0] = nloc; b.st[1] = nx; }
        const unsigned old = xb_add(&bar[XB_XSUB(b.x)], 1u);
        const unsigned gen = old / nloc;
        if (old + 1u == (gen + 1u) * nloc) {
            __builtin_amdgcn_fence(__ATOMIC_RELEASE, "agent");
            asm volatile("s_waitcnt vmcnt(0)" ::: "memory");
            const unsigned og = xb_add(&bar[XB_TOP], 1u);
            const unsigned tg = og / nx;
            if (og + 1u == (tg + 1u) * nx) xb_add(&bar[XB_TOPGEN], 1u);
            else XB_SPIN(xb_ld(&bar[XB_TOPGEN]) == tg, bar);
            __builtin_amdgcn_fence(__ATOMIC_ACQUIRE, "agent");
            xb_add(&bar[XB_XGEN(b.x)], 1u);
            asm volatile("s_waitcnt vmcnt(0)" ::: "memory");
        } else {
            XB_SPIN(xb_ld(&bar[XB_XGEN(b.x)]) == gen, bar);
            __builtin_amdgcn_fence(__ATOMIC_ACQUIRE, "agent");
            asm volatile("s_waitcnt vmcnt(0)" ::: "memory");
        }
    }
    __syncthreads();
}

typedef unsigned short bf16;
typedef __bf16 bf16x2_t __attribute__((ext_vector_type(2)));
__device__ __forceinline__ bf16 f2bf(float f) { return __builtin_bit_cast(unsigned short, (__bf16)f); }
__device__ __forceinline__ float bf2f(unsigned b) { return __uint_as_float(b << 16); }
__device__ __forceinline__ unsigned pk2(float lo, float hi) { bf16x2_t v; v[0] = (__bf16)lo; v[1] = (__bf16)hi; return __builtin_bit_cast(unsigned, v); }
__device__ __forceinline__ float bflo(unsigned w) { return __uint_as_float(w << 16); }
__device__ __forceinline__ float bfhi(unsigned w) { return __uint_as_float(w & 0xffff0000u); }
__device__ __forceinline__ float sigm(float x) { return 1.f / (1.f + expf(-x)); }
__device__ __forceinline__ float fsigm(float x) { return __builtin_amdgcn_rcpf(1.f + __expf(-x)); }
__device__ __forceinline__ float softplusf(float x) { return x > 20.f ? x : log1pf(expf(x)); }
__device__ __forceinline__ float dpp_xor1(float v) { return __int_as_float(__builtin_amdgcn_update_dpp(0, __float_as_int(v), 0xB1, 0xF, 0xF, false)); }
template <int CTRL, int ROWMASK>
__device__ __forceinline__ float dpp_add(float v) { return v + __int_as_float(__builtin_amdgcn_update_dpp(0, __float_as_int(v), CTRL, ROWMASK, 0xF, false)); }
__device__ __forceinline__ float sum4(float v)  { v = dpp_add<0xB1, 0xF>(v); return dpp_add<0x4E, 0xF>(v); }
__device__ __forceinline__ float sum8(float v)  { return dpp_add<0x141, 0xF>(sum4(v)); }
__device__ __forceinline__ float sum16(float v) { return dpp_add<0x140, 0xF>(sum8(v)); }
__device__ __forceinline__ float wsum(float v) {
    v = sum16(v);
    v = dpp_add<0x142, 0xA>(v);
    v = dpp_add<0x143, 0xC>(v);
    return __int_as_float(__builtin_amdgcn_readlane(__float_as_int(v), 63));
}

struct Params { const float* in[29]; float* out; unsigned char* ws; int ph_lo, ph_hi, li, coop; };

struct Ctx {
    const Params& P; int tid, lane, wave, gwave, nwaves; size_t gtid, nthreads; unsigned char* lds;
    template <class Tp> __device__ __forceinline__ Tp* ws(size_t off) const { return (Tp*)(P.ws + off); }
};

__device__ __forceinline__ void ph_rms0(const Ctx& c) {
    const float* x = c.P.in[I_X]; const float* nw = c.P.in[I_NORM_MIX]; const float* win = c.P.in[I_W_IN];
    const float* alog = c.P.in[I_GDN_ALOG]; const float* dtb = c.P.in[I_GDN_DTB];
    bf16* HB = c.ws<bf16>(WS_HB); float* BETA = c.ws<float>(WS_BETA); float* GGv = c.ws<float>(WS_GG);
    if (blockIdx.x == 0 && c.tid < NEXP) c.ws<unsigned>(WS_CTL)[CW_CNT + c.tid] = 0u;
    float4* tab = (float4*)c.lds;
    __syncthreads();
    for (int i = c.tid; i < 4096; i += NTHREADS) { const int k = i >> 2; tab[((k & 3) * 256 + (k >> 2)) * 5 + (i & 3)] = *(const float4*)(win + (size_t)k * NCOL_IN + 4096 + (i & 3) * 4); }
    __syncthreads();
    const int lane = c.lane;
    for (int t = c.gwave; t < T; t += c.nwaves) {
        float4 v[4]; float ss = 0.f;
#pragma unroll
        for (int i = 0; i < 4; ++i) { v[i] = ((const float4*)(x + (size_t)t * D))[lane + 64 * i]; ss += v[i].x * v[i].x + v[i].y * v[i].y + v[i].z * v[i].z + v[i].w * v[i].w; }
        ss = wsum(ss);
        const float rstd = rsqrtf(ss * (1.f / 1024.f) + 1e-6f);
        float acc[16];
#pragma unroll
        for (int j = 0; j < 16; ++j) acc[j] = 0.f;
#pragma unroll
        for (int i = 0; i < 4; ++i) {
            const float4 w4 = ((const float4*)nw)[lane + 64 * i];
            float h[4] = {v[i].x * rstd * w4.x, v[i].y * rstd * w4.y, v[i].z * rstd * w4.z, v[i].w * rstd * w4.w};
            uint2 st; st.x = pk2(h[0], h[1]); st.y = pk2(h[2], h[3]);
            *(uint2*)(HB + (size_t)t * D + 4 * (lane + 64 * i)) = st;
#pragma unroll
            for (int ii = 0; ii < 4; ++ii) {
                const int k = 4 * (lane + 64 * i) + ii;
#pragma unroll
                for (int q = 0; q < 4; ++q) { const float4 w = tab[(ii * 256 + (k >> 2)) * 5 + q]; acc[4 * q + 0] += h[ii] * w.x; acc[4 * q + 1] += h[ii] * w.y; acc[4 * q + 2] += h[ii] * w.z; acc[4 * q + 3] += h[ii] * w.w; }
                if (ii & 1) asm volatile("" ::: "memory");
            }
        }
        float mine = 0.f;
#pragma unroll
        for (int j = 0; j < 16; ++j) { const float s = wsum(acc[j]); mine = (lane == j) ? s : mine; }
        if (lane < 8) BETA[t * 8 + lane] = sigm(mine);
        else if (lane < 16) { const int h = lane - 8; GGv[t * 8 + h] = -expf(alog[h]) * softplusf(mine + dtb[h]); }
    }
    __syncthreads();
}

struct NoLd {};
struct EpiInProj {
    typedef NoLd Ld; static constexpr int MB = 1;
    bf16* GQKV; bf16* ZS; bf16* RKV; float* LIN; bf16* GATES;
    __device__ __forceinline__ void load(Ld&, int, int, int) const {}
    __device__ __forceinline__ void store8(int row, int col, const float (&v)[8], int, const Ld&) const {
        if (col < 3072) { uint4 w; w.x = pk2(v[0], v[1]); w.y = pk2(v[2], v[3]); w.z = pk2(v[4], v[5]); w.w = pk2(v[6], v[7]); *(uint4*)(GQKV + (size_t)row * 3072 + col) = w; }
        else if (col < 4096) { uint4 w; w.x = pk2(v[0] * fsigm(v[0]), v[1] * fsigm(v[1])); w.y = pk2(v[2] * fsigm(v[2]), v[3] * fsigm(v[3])); w.z = pk2(v[4] * fsigm(v[4]), v[5] * fsigm(v[5])); w.w = pk2(v[6] * fsigm(v[6]), v[7] * fsigm(v[7]));
            *(uint4*)(ZS + (size_t)row * 1024 + (col - 3072)) = w; }
        else if (col < 7168) { uint4 w; w.x = pk2(v[0], v[1]); w.y = pk2(v[2], v[3]); w.z = pk2(v[4], v[5]); w.w = pk2(v[6], v[7]); *(uint4*)(RKV + (size_t)row * 3072 + (col - 4096)) = w; }
        else if (col < 7424) { float* p = LIN + (size_t)row * 256 + (col - 7168); *(float4*)p = make_float4(v[0], v[1], v[2], v[3]); *(float4*)(p + 4) = make_float4(v[4], v[5], v[6], v[7]); }
        else { uint4 w; w.x = pk2(fsigm(v[0]), fsigm(v[1])); w.y = pk2(fsigm(v[2]), fsigm(v[3])); w.z = pk2(fsigm(v[4]), fsigm(v[5])); w.w = pk2(fsigm(v[6]), fsigm(v[7]));
            *(uint4*)(GATES + (size_t)row * 2048 + (col - 7424)) = w; }
    }
};
struct EpiG2 {
    struct Ld { uint4 g; uint4 p; }; static constexpr int MB = 1;
    const bf16* GATES; bf16* MG;
    __device__ __forceinline__ void load(Ld& l, int row, int col, int) const { l.g = *(const uint4*)(GATES + (size_t)row * 2048 + col); const uint4 q = *(const uint4*)(MG + (size_t)row * 1024 + (col & 1023)); const bool b = col >= 1024; l.p = make_uint4(b ? q.x : 0u, b ? q.y : 0u, b ? q.z : 0u, b ? q.w : 0u); }
    __device__ __forceinline__ void store8(int row, int col, const float (&v)[8], int, const Ld& l) const {
        const uint4 g = l.g, p = l.p;
        uint4 w; w.x = pk2(v[0] * bflo(g.x) + bflo(p.x), v[1] * bfhi(g.x) + bfhi(p.x)); w.y = pk2(v[2] * bflo(g.y) + bflo(p.y), v[3] * bfhi(g.y) + bfhi(p.y));
        w.z = pk2(v[4] * bflo(g.z) + bflo(p.z), v[5] * bfhi(g.z) + bfhi(p.z)); w.w = pk2(v[6] * bflo(g.w) + bflo(p.w), v[7] * bfhi(g.w) + bfhi(p.w));
        *(uint4*)(MG + (size_t)row * 1024 + (col & 1023)) = w;
    }
};
struct EpiX1 {
    struct Ld { float4 a, b; }; static constexpr int MB = 2;
    const float* X; float* X1;
    __device__ __forceinline__ void load(Ld& l, int row, int col, int) const { const float* xp = X + (size_t)row * 1024 + col; l.a = *(const float4*)xp; l.b = *(const float4*)(xp + 4); }
    __device__ __forceinline__ void store8(int row, int col, const float (&v)[8], int, const Ld& l) const {
        float* op = X1 + (size_t)row * 1024 + col;
        const float4 a = l.a, b = l.b;
        *(float4*)op = make_float4(a.x + v[0], a.y + v[1], a.z + v[2], a.w + v[3]); *(float4*)(op + 4) = make_float4(b.x + v[4], b.y + v[5], b.z + v[6], b.w + v[7]);
    }
};
struct EpiAct {
    struct Ld { float4 b0, b1; }; static constexpr int MB = 4;
    const float* BGU; bf16* ACT;
    __device__ __forceinline__ void load(Ld& l, int, int col, int e) const { const float* bp = BGU + (size_t)e * 2048 + col; l.b0 = *(const float4*)bp; l.b1 = *(const float4*)(bp + 4); }
    __device__ __forceinline__ void store8(int row, int col, const float (&v)[8], int e, const Ld& l) const {
        const float4 b0 = l.b0, b1 = l.b1;
        const float bb[8] = {b0.x, b0.y, b0.z, b0.w, b1.x, b1.y, b1.z, b1.w};
        float o[4];
#pragma unroll
        for (int p = 0; p < 4; ++p) { float glu = v[2 * p] + bb[2 * p], lin = v[2 * p + 1] + bb[2 * p + 1]; glu = fminf(glu, 7.f); lin = fminf(fmaxf(lin, -7.f), 7.f); o[p] = glu * fsigm(1.702f * glu) * (lin + 1.f); }
        uint2 w; w.x = pk2(o[0], o[1]); w.y = pk2(o[2], o[3]);
        *(uint2*)(ACT + (size_t)row * 1024 + (col >> 1)) = w;
    }
};
struct EpiYS {
    struct Ld { float4 b0, b1; float g; }; static constexpr int MB = 4;
    const float* BD; const float* SGATE; bf16* YS;
    __device__ __forceinline__ void load(Ld& l, int row, int col, int e) const { const float* bp = BD + (size_t)e * 1024 + col; l.g = SGATE[row]; l.b0 = *(const float4*)bp; l.b1 = *(const float4*)(bp + 4); }
    __device__ __forceinline__ void store8(int row, int col, const float (&v)[8], int e, const Ld& l) const {
        const float g = l.g; const float4 b0 = l.b0, b1 = l.b1;
        uint4 w; w.x = pk2((v[0] + b0.x) * g, (v[1] + b0.y) * g); w.y = pk2((v[2] + b0.z) * g, (v[3] + b0.w) * g); w.z = pk2((v[4] + b1.x) * g, (v[5] + b1.y) * g); w.w = pk2((v[6] + b1.z) * g, (v[7] + b1.w) * g);
        *(uint4*)(YS + (size_t)row * 1024 + col) = w;
    }
};


namespace pg8 {
typedef short bf16x8 __attribute__((ext_vector_type(8)));
typedef float f32x4 __attribute__((ext_vector_type(4)));
constexpr int BM = 256, BK = 64, HALF = 128, HTB = HALF * BK * 2, NXCD = 8, WGM = 8;
__host__ __device__ __forceinline__ int lds_byte(int r, int c) { const int st = (r >> 4) * 2 + (c >> 5), rr = r & 15, cc = c & 31, ob = rr * 64 + cc * 2; return st * 1024 + (ob ^ (((ob >> 9) & 1) << 5)); }
__host__ __device__ __forceinline__ void stage_rc(int b, int& R, int& C) { const int st = b / 1024, sb = b % 1024, swz = sb ^ (((sb >> 9) & 1) << 5); R = (st >> 1) * 16 + swz / 64; C = (st & 1) * 32 + (swz % 64) / 2; }
__host__ __device__ __forceinline__ int perm32(int rho) { const int n = rho >> 4, i = rho & 15; return 8 * (i >> 2) + 4 * n + (i & 3); }
struct Unit { const char* a; const char* b; const int* rowmap; int row0, col0, aux, half; };
__device__ __forceinline__ void tile_order(int L, int nM, int nN, int& pm, int& pn) {
    const int nwg = nM * nN; int wgid = L; { const int q = nwg / NXCD, r = nwg % NXCD, xcd = wgid % NXCD, off = wgid / NXCD; wgid = (xcd < r ? xcd * (q + 1) : r * (q + 1) + (xcd - r) * q) + off; }
    const int nig = WGM * nN, gid = wgid / nig, fm = gid * WGM, gsz = (nM - fm) < WGM ? (nM - fm) : WGM;
    pm = fm + ((wgid % nig) % gsz); pn = (wgid % nig) / gsz;
}
template <class Epi>
__device__ __forceinline__ void epi_apply(const Epi& E, const f32x4 (&acc)[2][2][4][2], const Unit& u, int wr, int wc, int fr, int fq, const bool full) {
    constexpr int MB = Epi::MB;
#pragma unroll
    for (int ai = 0; ai < 2; ++ai) {
        if (ai == 1 && !full) break;
#pragma unroll
        for (int mp = 0; mp < 4 / MB; ++mp) {
            typename Epi::Ld ld[MB][2];
#pragma unroll
            for (int mm = 0; mm < MB; ++mm)
#pragma unroll
                for (int bj = 0; bj < 2; ++bj) E.load(ld[mm][bj], u.row0 + ai * HALF + wr * 64 + (mp * MB + mm) * 16 + fr, u.col0 + bj * HALF + wc * 32 + 8 * fq, u.aux);
#pragma unroll
            for (int mm = 0; mm < MB; ++mm)
#pragma unroll
                for (int bj = 0; bj < 2; ++bj) {
                    const int m = mp * MB + mm;
                    const f32x4 x0 = acc[ai][bj][m][0], x1 = acc[ai][bj][m][1];
                    const float v[8] = {x0[0], x0[1], x0[2], x0[3], x1[0], x1[1], x1[2], x1[3]};
                    E.store8(u.row0 + ai * HALF + wr * 64 + m * 16 + fr, u.col0 + bj * HALF + wc * 32 + 8 * fq, v, u.aux, ld[mm][bj]);
                }
            asm volatile("" ::: "memory");
        }
    }
}
template <bool GATHER, class Epi, class Sched>
__device__ __forceinline__ void gemm_phase_t(LAS unsigned char* lds, const int K_, const Sched& S, const Epi& E, const int tid) {
    int K = K_; asm volatile("" : "+s"(K));
    const int wid = __builtin_amdgcn_readfirstlane(tid >> 6), lane = tid & 63, wr = wid >> 2, wc = wid & 3, fr = lane & 15, fq = lane >> 4;
    const int nt = K / BK;
    unsigned voffA[2], voffB[2];
#pragma unroll
    for (int i = 0; i < 2; ++i) { int R, C; stage_rc(tid * 16 + i * 8192, R, C); const int Rb = (R & ~31) + perm32(R & 31);
        voffA[i] = (unsigned)(R * K + C) * 2u; voffB[i] = (unsigned)(Rb * K + C) * 2u; }
    const size_t kstep = (size_t)(BK * 2);
    const size_t hstep = (size_t)HALF * K * 2;
    const unsigned ldsw = (unsigned)wid * 1024u;
    const int aoff = lds_byte(wr * 64 + fr, fq * 8), boff = lds_byte(wc * 32 + fr, fq * 8);
#define PG8_SA(b, h) (((b) * 2 + (h)) * HTB)
#define PG8_SB(b, h) ((4 + (b) * 2 + (h)) * HTB)
#define PG8_STAGE(bufoff, gbase, voff) do { _Pragma("unroll") for (int _i = 0; _i < 2; ++_i) \
        __builtin_amdgcn_global_load_lds((const unsigned*)((const char*)(gbase) + (voff)[_i]), (LAS unsigned*)(lds + (bufoff) + ldsw + _i * 8192), 16, 0, 0); } while (0)
#define PG8_LDA(dst, b, h) do { _Pragma("unroll") for (int m = 0; m < 4; ++m) _Pragma("unroll") for (int k = 0; k < 2; ++k) dst[m][k] = *(const LAS bf16x8*)(lds + PG8_SA(b, h) + aoff + m * 2048 + k * 1024); } while (0)
#define PG8_LDB(dst, b, h) do { _Pragma("unroll") for (int n = 0; n < 2; ++n) _Pragma("unroll") for (int k = 0; k < 2; ++k) dst[n][k] = *(const LAS bf16x8*)(lds + PG8_SB(b, h) + boff + n * 2048 + k * 1024); } while (0)
#define PG8_MMA(ai, bj, At, Bt) do { __builtin_amdgcn_s_setprio(1); _Pragma("unroll") for (int m = 0; m < 4; ++m) _Pragma("unroll") for (int n = 0; n < 2; ++n) _Pragma("unroll") for (int k = 0; k < 2; ++k) \
        acc[ai][bj][m][n] = __builtin_amdgcn_mfma_f32_16x16x32_bf16(Bt[n][k], At[m][k], acc[ai][bj][m][n], 0, 0, 0); __builtin_amdgcn_s_setprio(0); } while (0)
#define PG8_WAIT_V(n) asm volatile("s_waitcnt vmcnt(" #n ")" ::: "memory")
#define PG8_WAIT_L(n) asm volatile("s_waitcnt lgkmcnt(" #n ")" ::: "memory")
#define PG8_BAR __builtin_amdgcn_s_barrier()
#define PG8_SCHED __builtin_amdgcn_sched_barrier(0)
    Unit cur, nxt; int ui = 0;
    if (!S.next(0, cur)) return;
    f32x4 acc[2][2][4][2];
#pragma unroll
    for (int a = 0; a < 2; ++a)
#pragma unroll
        for (int b = 0; b < 2; ++b)
#pragma unroll
            for (int m = 0; m < 4; ++m)
#pragma unroll
                for (int n = 0; n < 2; ++n) acc[a][b][m][n] = (f32x4){0.f, 0.f, 0.f, 0.f};
    bf16x8 At[4][2], B0[2][2], B1[2][2];
    const char* cA = cur.a; const char* cB = cur.b;
    unsigned oc_lo[2] = {0u, 0u}, oc_hi[2] = {0u, 0u}, on_lo[2] = {0u, 0u}, on_hi[2] = {0u, 0u};
#define PG8_ROWOFF(U, LO, HI) do { _Pragma("unroll") for (int _i = 0; _i < 2; ++_i) { int R_, C_; stage_rc(tid * 16 + _i * 8192, R_, C_); \
        LO[_i] = (unsigned)((U).rowmap[R_] * K + C_) * 2u; HI[_i] = (unsigned)((U).rowmap[R_ + ((U).half ? 0 : 128)] * K + C_) * 2u; } } while (0)
    if constexpr (GATHER) PG8_ROWOFF(cur, oc_lo, oc_hi);
    PG8_STAGE(PG8_SB(0, 0), cB, voffB);
    if constexpr (GATHER) PG8_STAGE(PG8_SA(0, 0), cA, oc_lo); else PG8_STAGE(PG8_SA(0, 0), cA, voffA);
    PG8_STAGE(PG8_SB(0, 1), cB + hstep, voffB);
    if constexpr (GATHER) PG8_STAGE(PG8_SA(0, 1), cA, oc_hi); else PG8_STAGE(PG8_SA(0, 1), cA + hstep, voffA);
    if (wr == 1) PG8_BAR;
    PG8_WAIT_V(4); PG8_BAR;
    PG8_STAGE(PG8_SB(1, 0), cB + kstep, voffB);
    if constexpr (GATHER) PG8_STAGE(PG8_SA(1, 0), cA + kstep, oc_lo); else PG8_STAGE(PG8_SA(1, 0), cA + kstep, voffA);
    PG8_STAGE(PG8_SB(1, 1), cB + hstep + kstep, voffB);
    PG8_WAIT_V(6); PG8_BAR;
    for (;;) {
        const bool has_next = S.next(ui + 1, nxt);
        const char* nA = has_next ? nxt.a : cA; const char* nB = has_next ? nxt.b : cB;
        if constexpr (GATHER) { if (has_next) PG8_ROWOFF(nxt, on_lo, on_hi); else { on_lo[0] = oc_lo[0]; on_lo[1] = oc_lo[1]; on_hi[0] = oc_hi[0]; on_hi[1] = oc_hi[1]; } }
        const bool full = __builtin_amdgcn_readfirstlane(cur.half) == 0;
#pragma unroll 1
        for (int t = 0; t < nt; t += 2) {
            const bool last = (t == nt - 2);
            const char* a1 = cA + (size_t)(t + 1) * kstep;
            const char* a2 = last ? nA : cA + (size_t)(t + 2) * kstep; const char* b2 = last ? nB : cB + (size_t)(t + 2) * kstep;
            const char* a3 = a2 + kstep; const char* b3 = b2 + kstep;
            unsigned o2lo[2], o2hi[2];
            o2lo[0] = last ? on_lo[0] : oc_lo[0]; o2lo[1] = last ? on_lo[1] : oc_lo[1]; o2hi[0] = last ? on_hi[0] : oc_hi[0]; o2hi[1] = last ? on_hi[1] : oc_hi[1];
            PG8_LDB(B0, 0, 0); PG8_SCHED; PG8_LDA(At, 0, 0); if constexpr (GATHER) PG8_STAGE(PG8_SA(1, 1), a1, oc_hi); else PG8_STAGE(PG8_SA(1, 1), a1 + hstep, voffA);
            PG8_WAIT_L(8); PG8_BAR; PG8_WAIT_L(0); PG8_MMA(0, 0, At, B0); PG8_BAR; PG8_SCHED;
            PG8_LDB(B1, 0, 1); PG8_STAGE(PG8_SB(0, 0), b2, voffB);
            PG8_BAR; PG8_WAIT_L(0); PG8_MMA(0, 1, At, B1); PG8_BAR;
            if (full) PG8_LDA(At, 0, 1); if constexpr (GATHER) PG8_STAGE(PG8_SA(0, 0), a2, o2lo); else PG8_STAGE(PG8_SA(0, 0), a2, voffA);
            PG8_BAR; PG8_WAIT_L(0); if (full) PG8_MMA(1, 0, At, B0); PG8_BAR; PG8_SCHED;
            PG8_STAGE(PG8_SB(0, 1), b2 + hstep, voffB);
            PG8_WAIT_V(6); PG8_BAR; if (full) PG8_MMA(1, 1, At, B1); PG8_BAR;
            PG8_LDB(B0, 1, 0); PG8_SCHED; PG8_LDA(At, 1, 0); if constexpr (GATHER) PG8_STAGE(PG8_SA(0, 1), a2, o2hi); else PG8_STAGE(PG8_SA(0, 1), a2 + hstep, voffA);
            PG8_WAIT_L(8); PG8_BAR; PG8_WAIT_L(0); PG8_MMA(0, 0, At, B0); PG8_BAR; PG8_SCHED;
            PG8_LDB(B1, 1, 1); PG8_STAGE(PG8_SB(1, 0), b3, voffB);
            PG8_BAR; PG8_WAIT_L(0); PG8_MMA(0, 1, At, B1); PG8_BAR;
            if (full) PG8_LDA(At, 1, 1); if constexpr (GATHER) PG8_STAGE(PG8_SA(1, 0), a3, o2lo); else PG8_STAGE(PG8_SA(1, 0), a3, voffA);
            PG8_BAR; PG8_WAIT_L(0); if (full) PG8_MMA(1, 0, At, B0); PG8_BAR; PG8_SCHED;
            PG8_STAGE(PG8_SB(1, 1), b3 + hstep, voffB);
            PG8_WAIT_V(6); PG8_BAR; if (full) PG8_MMA(1, 1, At, B1); PG8_BAR;
        }
        epi_apply(E, acc, cur, wr, wc, fr, fq, full);
        if (!has_next) break;
#pragma unroll
        for (int a = 0; a < 2; ++a)
#pragma unroll
            for (int b = 0; b < 2; ++b)
#pragma unroll
                for (int m = 0; m < 4; ++m)
#pragma unroll
                    for (int n = 0; n < 2; ++n) acc[a][b][m][n] = (f32x4){0.f, 0.f, 0.f, 0.f};
        cur = nxt; cA = nA; cB = nB; ++ui;
        if constexpr (GATHER) { oc_lo[0] = on_lo[0]; oc_lo[1] = on_lo[1]; oc_hi[0] = on_hi[0]; oc_hi[1] = on_hi[1]; }
    }
    PG8_WAIT_V(0);
    if (wr == 0) PG8_BAR;
    PG8_BAR;
#undef PG8_ROWOFF
#undef PG8_SA
#undef PG8_SB
#undef PG8_STAGE
#undef PG8_LDA
#undef PG8_LDB
#undef PG8_MMA
#undef PG8_WAIT_V
#undef PG8_WAIT_L
#undef PG8_BAR
#undef PG8_SCHED
}
template <class Epi, class Sched>
__device__ __forceinline__ void gemm_phase(LAS unsigned char* lds, const int K, const Sched& S, const Epi& E, const int tid) { gemm_phase_t<false>(lds, K, S, E, tid); }
}

struct SchedInProj { const char* A; const char* Bt; int G, c;
    __device__ __forceinline__ bool next(int i, pg8::Unit& u) const { const int UT = 64 * 37, nfr = UT / G, r0 = UT - nfr * G; int L = i * G + c, half = 0, hs = 0;
        if (2 * r0 <= G && i >= nfr) { const int hL = (i - nfr) * G + c; if (hL >= 2 * r0) return false; L = nfr * G + (hL >> 1); half = 1; hs = hL & 1; }
        if (L >= UT) return false; int pm, pn; pg8::tile_order(L, 64, 37, pm, pn);
        u.a = A + (size_t)pm * (256 * 1024 * 2) + (size_t)hs * (128 * 1024 * 2); u.b = Bt + (size_t)pn * (256 * 1024 * 2); u.row0 = pm * 256 + hs * 128; u.col0 = pn * 256; u.aux = 0; u.rowmap = nullptr; u.half = half; return true; } };

struct WJob { const float* src; int ld_src; int K; int ncols; bf16* dst; int ld_dst; int nb; size_t sstride, dstride; };
__device__ __forceinline__ void wconv_job(const Ctx& c, const WJob& j) {
    float* tl = (float*)c.lds;
    const int ntk = j.K >> 6, ntn = j.ncols >> 6, per = ntk * ntn, ntiles = per * j.nb;
    const int rk = c.tid >> 3, rseg = (c.tid & 7) * 8;
    int tile = blockIdx.x;
    float4 a = make_float4(0.f, 0.f, 0.f, 0.f), b = a;
    if (tile < ntiles) { const int bi = tile / per, tt = tile % per, tk = tt % ntk, tn = tt / ntk;
        const float* sp = j.src + (size_t)bi * j.sstride + (size_t)(tk * 64 + rk) * j.ld_src + tn * 64 + rseg; a = *(const float4*)sp; b = *(const float4*)(sp + 4); }
    for (; tile < ntiles; tile += gridDim.x) {
        const int bi = tile / per, tt = tile % per, tk = tt % ntk, tn = tt / ntk;
        const float4 ca = a, cb = b;
        const int nxt = tile + gridDim.x;
        if (nxt < ntiles) { const int bi2 = nxt / per, tt2 = nxt % per, tk2 = tt2 % ntk, tn2 = tt2 / ntk;
            const float* sp = j.src + (size_t)bi2 * j.sstride + (size_t)(tk2 * 64 + rk) * j.ld_src + tn2 * 64 + rseg; a = *(const float4*)sp; b = *(const float4*)(sp + 4); }
        asm volatile("s_waitcnt lgkmcnt(0)" ::: "memory"); __builtin_amdgcn_s_barrier(); asm volatile("" ::: "memory");
        float* row = tl + rk * 65 + rseg;
        row[0] = ca.x; row[1] = ca.y; row[2] = ca.z; row[3] = ca.w; row[4] = cb.x; row[5] = cb.y; row[6] = cb.z; row[7] = cb.w;
        asm volatile("s_waitcnt lgkmcnt(0)" ::: "memory"); __builtin_amdgcn_s_barrier(); asm volatile("" ::: "memory");
        const float* col = tl + rseg * 65 + rk;
        uint4 w; w.x = pk2(col[0], col[65]); w.y = pk2(col[130], col[195]); w.z = pk2(col[260], col[325]); w.w = pk2(col[390], col[455]);
        *(uint4*)(j.dst + (size_t)bi * j.dstride + (size_t)(tn * 64 + rk) * j.ld_dst + tk * 64 + rseg) = w;
    }
}
struct SchedG2 { const char* YA; const char* Bt; int G, c;
    __device__ __forceinline__ bool next(int i, pg8::Unit& u) const { const int L = (i >> 1) * G + c, ab = i & 1; if (L >= 64 * 4) return false; int pm, pn; pg8::tile_order(L, 64, 4, pm, pn);
        u.a = YA + (size_t)ab * (WS_YB - WS_YA) + (size_t)pm * (256 * 1024 * 2); u.b = Bt + (size_t)(ab * 4 + pn) * (256 * 1024 * 2); u.row0 = pm * 256; u.col0 = ab * 1024 + pn * 256; u.aux = 0; u.rowmap = nullptr; u.half = 0; return true; } };
struct SchedX1 { const char* A; const char* Bt; int G, c;
    __device__ __forceinline__ bool next(int i, pg8::Unit& u) const { const int L = i * G + c; if (L >= 64 * 4) return false; int pm, pn; pg8::tile_order(L, 64, 4, pm, pn);
        u.a = A + (size_t)pm * (256 * 1024 * 2); u.b = Bt + (size_t)pn * (256 * 1024 * 2); u.row0 = pm * 256; u.col0 = pn * 256; u.aux = 0; u.rowmap = nullptr; u.half = 0; return true; } };
struct SchedMoe { const char* A; const char* Bt; const int* TILE_E; const int* SLOT_TOK; int NT, NPN, G, c;
    __device__ __forceinline__ bool next(int i, pg8::Unit& u) const { const int UT = NT * NPN, nfr = UT / G, r0 = UT - nfr * G; int L = i * G + c, half = 0, hs = 0;
        if (2 * r0 <= G && i >= nfr) { const int hL = (i - nfr) * G + c; if (hL >= 2 * r0) return false; L = nfr * G + (hL >> 1); half = 1; hs = hL & 1; }
        if (L >= UT) return false; int tile, pn; pg8::tile_order(L, NT, NPN, tile, pn);
        const int e = TILE_E[tile];
        u.a = SLOT_TOK ? A : A + (size_t)tile * (256 * 1024 * 2) + (size_t)hs * (128 * 1024 * 2); u.rowmap = SLOT_TOK ? SLOT_TOK + tile * 256 + hs * 128 : nullptr;
        u.b = Bt + (size_t)(e * NPN + pn) * (256 * 1024 * 2); u.row0 = tile * 256 + hs * 128; u.col0 = pn * 256; u.aux = e; u.half = half; return true; } };

struct EpiLora {
    typedef NoLd Ld; static constexpr int MB = 1;
    const float* w0; const float* a0; float* LW; float* AA; bf16* GGR;
    __device__ __forceinline__ void load(Ld&, int, int, int) const {}
    __device__ __forceinline__ void store8(int row, int col, const float (&v)[8], int, const Ld&) const {
        const float* bp = col < 1024 ? w0 + col : a0 + ((col - 1024) & 1023);
        const float4 b0 = *(const float4*)bp, b1 = *(const float4*)(bp + 4);
        const float bb[8] = {b0.x, b0.y, b0.z, b0.w, b1.x, b1.y, b1.z, b1.w};
        if (col < 1024) { float o[8];
#pragma unroll
            for (int i = 0; i < 8; ++i) o[i] = -0.6065306597126334f * fsigm(bb[i] + v[i]);
            float* p = LW + (size_t)row * 1024 + col; *(float4*)p = make_float4(o[0], o[1], o[2], o[3]); *(float4*)(p + 4) = make_float4(o[4], o[5], o[6], o[7]); }
        else if (col < 2048) { const int cc = col - 1024; float o[8];
#pragma unroll
            for (int i = 0; i < 8; ++i) o[i] = fsigm(bb[i] + v[i]);
            float* p = AA + (size_t)row * 1024 + cc; *(float4*)p = make_float4(o[0], o[1], o[2], o[3]); *(float4*)(p + 4) = make_float4(o[4], o[5], o[6], o[7]); }
        else { uint4 w; w.x = pk2(v[0], v[1]); w.y = pk2(v[2], v[3]); w.z = pk2(v[4], v[5]); w.w = pk2(v[6], v[7]); *(uint4*)(GGR + (size_t)row * 1024 + (col - 2048)) = w; }
    }
};
struct SchedLora { const char* A; const char* Bt; int G, c;
    __device__ __forceinline__ bool next(int i, pg8::Unit& u) const { const int L = i * G + c; if (L >= 64 * 12) return false; int pm, pn; pg8::tile_order(L, 64, 12, pm, pn);
        u.a = A + (size_t)pm * (256 * 256 * 2); u.b = Bt + (size_t)pn * (256 * 256 * 2); u.row0 = pm * 256; u.col0 = pn * 256; u.aux = 0; u.rowmap = nullptr; u.half = 0; return true; } };
__device__ __forceinline__ void lora_zero(const Ctx& c) {
    uint4* LT = c.ws<uint4>(WS_LORA_T);
    for (size_t idx = c.gtid; idx < (size_t)3072 * 32; idx += c.nthreads) {
        const int row = (int)(idx >> 5), k8 = (int)(idx & 31) * 8;
        const bool data = row < 1024 ? (k8 < 64) : (row < 2048 ? (k8 >= 64 && k8 < 128) : (k8 >= 128));
        if (!data) LT[idx] = make_uint4(0, 0, 0, 0);
    }
}

__device__ __forceinline__ void ph_loraprep(const Ctx& c) {
    const float* LIN = c.ws<float>(WS_LIN); bf16* AL = c.ws<bf16>(WS_ALORA); const float* mu = c.P.in[I_MU];
    for (size_t idx = c.gtid; idx < (size_t)T * 256; idx += c.nthreads) {
        const int t = (int)(idx >> 8), cc = (int)(idx & 255);
        const float x = LIN[idx], xp = (t & (SEQ - 1)) ? LIN[idx - 256] : 0.f;
        const float xs = x + (xp - x) * mu[3072 + cc];
        const float r = cc < 64 ? tanhf(xs) : (cc < 128 ? xs : sigm(xs));
        AL[idx] = f2bf(r);
    }
}
__device__ __forceinline__ void ph_post(const Ctx& c) {
    const bf16* OG = c.ws<bf16>(WS_OG); const bf16* ORW = c.ws<bf16>(WS_ORW); const bf16* ZS = c.ws<bf16>(WS_ZS); const bf16* VP = c.ws<bf16>(WS_VP); const bf16* GGR = c.ws<bf16>(WS_GGR);
    const float* SC = c.ws<float>(WS_SC); bf16* YA = c.ws<bf16>(WS_YA); bf16* YB = c.ws<bf16>(WS_YB);
    const float* gnw = c.P.in[I_GDN_NORM]; const float* lnw = c.P.in[I_LNW]; const float* lnb = c.P.in[I_LNB];
    const int lane = c.lane, c0 = lane * 16;
    for (int t = c.gwave; t < T; t += c.nwaves) {
        {
            float o[16];
#pragma unroll
            for (int q = 0; q < 2; ++q) { const uint4 v = *(const uint4*)(OG + (size_t)t * 1024 + c0 + 8 * q); o[8 * q] = bflo(v.x); o[8 * q + 1] = bfhi(v.x); o[8 * q + 2] = bflo(v.y); o[8 * q + 3] = bfhi(v.y); o[8 * q + 4] = bflo(v.z); o[8 * q + 5] = bfhi(v.z); o[8 * q + 6] = bflo(v.w); o[8 * q + 7] = bfhi(v.w); }
            float ss = 0.f;
#pragma unroll
            for (int j = 0; j < 16; ++j) ss += o[j] * o[j];
            ss = sum8(ss);
            const float rstd = rsqrtf(ss * (1.f / 128.f) + 1e-6f);
            const uint4 z0 = *(const uint4*)(ZS + (size_t)t * 1024 + c0), z1 = *(const uint4*)(ZS + (size_t)t * 1024 + c0 + 8);
            const unsigned zz[8] = {z0.x, z0.y, z0.z, z0.w, z1.x, z1.y, z1.z, z1.w};
            unsigned w[8];
#pragma unroll
            for (int j = 0; j < 8; ++j) { const int cc = (c0 + 2 * j) & 127; w[j] = pk2(o[2 * j] * rstd * gnw[cc] * bflo(zz[j]), o[2 * j + 1] * rstd * gnw[cc + 1] * bfhi(zz[j])); }
            *(uint4*)(YA + (size_t)t * 1024 + c0) = make_uint4(w[0], w[1], w[2], w[3]); *(uint4*)(YA + (size_t)t * 1024 + c0 + 8) = make_uint4(w[4], w[5], w[6], w[7]);
        }
        {
            float o[16];
#pragma unroll
            for (int q = 0; q < 2; ++q) { const uint4 v = *(const uint4*)(ORW + (size_t)t * 1024 + c0 + 8 * q); o[8 * q] = bflo(v.x); o[8 * q + 1] = bfhi(v.x); o[8 * q + 2] = bflo(v.y); o[8 * q + 3] = bfhi(v.y); o[8 * q + 4] = bflo(v.z); o[8 * q + 5] = bfhi(v.z); o[8 * q + 6] = bflo(v.w); o[8 * q + 7] = bfhi(v.w); }
            float sm = 0.f;
#pragma unroll
            for (int j = 0; j < 16; ++j) sm += o[j];
            sm = sum4(sm);
            const float mean = sm * (1.f / 64.f);
            float sv = 0.f;
#pragma unroll
            for (int j = 0; j < 16; ++j) { const float dd = o[j] - mean; sv += dd * dd; }
            sv = sum4(sv);
            const float rstd = rsqrtf(sv * (1.f / 64.f) + 64e-5f);
            const float sc = SC[t * 16 + (c0 >> 6)];
            const uint4 v0 = *(const uint4*)(VP + (size_t)t * 1024 + c0), v1 = *(const uint4*)(VP + (size_t)t * 1024 + c0 + 8);
            const uint4 g0 = *(const uint4*)(GGR + (size_t)t * 1024 + c0), g1 = *(const uint4*)(GGR + (size_t)t * 1024 + c0 + 8);
            const unsigned vv[8] = {v0.x, v0.y, v0.z, v0.w, v1.x, v1.y, v1.z, v1.w};
            const unsigned gg[8] = {g0.x, g0.y, g0.z, g0.w, g1.x, g1.y, g1.z, g1.w};
            unsigned w[8];
#pragma unroll
            for (int j = 0; j < 8; ++j) { const int cc = c0 + 2 * j;
                const float y0 = ((o[2 * j] - mean) * rstd * lnw[cc] + lnb[cc] + sc * bflo(vv[j])) * bflo(gg[j]);
                const float y1 = ((o[2 * j + 1] - mean) * rstd * lnw[cc + 1] + lnb[cc + 1] + sc * bfhi(vv[j])) * bfhi(gg[j]);
                w[j] = pk2(y0, y1); }
            *(uint4*)(YB + (size_t)t * 1024 + c0) = make_uint4(w[0], w[1], w[2], w[3]); *(uint4*)(YB + (size_t)t * 1024 + c0 + 8) = make_uint4(w[4], w[5], w[6], w[7]);
        }
    }
}

__device__ __forceinline__ void ph_router(const Ctx& c) {
    const float* X1 = c.ws<float>(WS_X1); const float* nw = c.P.in[I_NORM_FFN]; const float* rw = c.P.in[I_ROUTER_W]; const float* rb = c.P.in[I_ROUTER_B];
    bf16* H2 = c.ws<bf16>(WS_H2); int* TE = c.ws<int>(WS_TE); float* TG = c.ws<float>(WS_TG); int* TP = c.ws<int>(WS_TP); unsigned* CNT = c.ws<unsigned>(WS_CTL) + CW_CNT;
    const int lane = c.lane;
    float4* tab = (float4*)c.lds;
    unsigned* lcnt = (unsigned*)(c.lds + 147456);
    __syncthreads();
    if (c.tid < 32) lcnt[c.tid] = 0u;
    for (int i = c.tid; i < 8192; i += NTHREADS) { const int k = i >> 3; tab[((k & 3) * 256 + (k >> 2)) * 9 + (i & 7)] = ((const float4*)rw)[i]; }
    __syncthreads();
    for (int t = c.gwave; t < T; t += c.nwaves) {
        float4 v[4]; float ss = 0.f;
#pragma unroll
        for (int i = 0; i < 4; ++i) { v[i] = ((const float4*)(X1 + (size_t)t * D))[lane + 64 * i]; ss += v[i].x * v[i].x + v[i].y * v[i].y + v[i].z * v[i].z + v[i].w * v[i].w; }
        ss = wsum(ss);
        const float rstd = rsqrtf(ss * (1.f / 1024.f) + 1e-6f);
        float lg[32];
#pragma unroll
        for (int j = 0; j < 32; ++j) lg[j] = 0.f;
#pragma unroll
        for (int i = 0; i < 4; ++i) {
            const float4 w4 = ((const float4*)nw)[lane + 64 * i];
            const float h[4] = {v[i].x * rstd * w4.x, v[i].y * rstd * w4.y, v[i].z * rstd * w4.z, v[i].w * rstd * w4.w};
            uint2 st; st.x = pk2(h[0], h[1]); st.y = pk2(h[2], h[3]);
            *(uint2*)(H2 + (size_t)t * D + 4 * (lane + 64 * i)) = st;
#pragma unroll
            for (int ii = 0; ii < 4; ++ii) {
                const float4* wr = tab + (size_t)(ii * 256 + lane + 64 * i) * 9;
#pragma unroll
                for (int q = 0; q < 8; ++q) { const float4 w = wr[q]; lg[4 * q] += h[ii] * w.x; lg[4 * q + 1] += h[ii] * w.y; lg[4 * q + 2] += h[ii] * w.z; lg[4 * q + 3] += h[ii] * w.w; }
                asm volatile("" ::: "memory");
            }
        }
#pragma unroll
        for (int j = 0; j < 32; ++j) lg[j] = wsum(lg[j]) + rb[j];
        int e0 = 0, e1 = 0, e2 = 0, e3 = 0; float v0 = -3e38f, v1 = -3e38f, v2 = -3e38f, v3 = -3e38f;
#pragma unroll
        for (int j = 0; j < 32; ++j) if (lg[j] > v0) { v0 = lg[j]; e0 = j; }
#pragma unroll
        for (int j = 0; j < 32; ++j) if (j != e0 && lg[j] > v1) { v1 = lg[j]; e1 = j; }
#pragma unroll
        for (int j = 0; j < 32; ++j) if (j != e0 && j != e1 && lg[j] > v2) { v2 = lg[j]; e2 = j; }
#pragma unroll
        for (int j = 0; j < 32; ++j) if (j != e0 && j != e1 && j != e2 && lg[j] > v3) { v3 = lg[j]; e3 = j; }
        const float x1 = expf(v1 - v0), x2 = expf(v2 - v0), x3 = expf(v3 - v0), inv = 1.f / (1.f + x1 + x2 + x3);
        if (lane < 4) {
            const int me = lane == 0 ? e0 : (lane == 1 ? e1 : (lane == 2 ? e2 : e3));
            const float mg = (lane == 0 ? 1.f : (lane == 1 ? x1 : (lane == 2 ? x2 : x3))) * inv;
            const unsigned pos = atomicAdd(&lcnt[me], 1u);
            TE[t * 4 + lane] = me; TG[t * 4 + lane] = mg; TP[t * 4 + lane] = (int)pos;
        }
    }
    __syncthreads();
    if (c.tid < 32) lcnt[32 + c.tid] = atomicAdd(&CNT[c.tid], lcnt[c.tid]);
    __syncthreads();
    if (lane < 4) for (int t = c.gwave; t < T; t += c.nwaves) TP[t * 4 + lane] += (int)lcnt[32 + TE[t * 4 + lane]];
    __syncthreads();
}

__device__ __forceinline__ void ph_dispatch(const Ctx& c) {
    int* tb = (int*)c.lds;
    const unsigned* CNT = c.ws<unsigned>(WS_CTL) + CW_CNT;
    int* TILE_E = c.ws<int>(WS_TILE_E); int* NT = c.ws<int>(WS_NT);
    const int* TE = c.ws<int>(WS_TE); const float* TG = c.ws<float>(WS_TG); const int* TP = c.ws<int>(WS_TP); int* TSLOT = c.ws<int>(WS_TSLOT);
    float* SGATE = c.ws<float>(WS_SGATE); const bf16* H2 = c.ws<bf16>(WS_H2); bf16* XB = c.ws<bf16>(WS_XB);
    if (c.tid == 0) { int acc = 0; for (int e = 0; e < NEXP; ++e) { const int n = (int)__hip_atomic_load(&CNT[e], __ATOMIC_RELAXED, __HIP_MEMORY_SCOPE_AGENT); tb[e] = acc; tb[64 + e] = n; acc += (n + 255) >> 8; } tb[32] = acc; }
    __syncthreads();
    if (blockIdx.x == 0) {
        for (int tile = c.tid; tile < tb[32]; tile += NTHREADS) { int e = 0; for (int q = 0; q < NEXP; ++q) if (tile >= tb[q]) e = q; TILE_E[tile] = e; }
        if (c.tid == 0) *NT = tb[32];
    }
    int* SLOT_TOK = c.ws<int>(WS_SLOT_TOK);
    for (size_t idx = c.gtid; idx < (size_t)T * 4; idx += c.nthreads) {
        const int t = (int)(idx >> 2), e = TE[idx], pos = TP[idx];
        const int slot = tb[e] * 256 + pos;
        TSLOT[idx] = slot; SGATE[slot] = TG[idx]; SLOT_TOK[slot] = t;
    }
    for (int e = 0; e < NEXP; ++e) {
        const int n = tb[64 + e], cap = (tb[e + 1] - tb[e]) * 256;
        for (int r = n + (int)c.gtid; r < cap; r += (int)c.nthreads) { const int slot = tb[e] * 256 + r; SLOT_TOK[slot] = 0; SGATE[slot] = 0.f; }
    }
}

__device__ __forceinline__ void ph_combine(const Ctx& c) {
    const float* X1 = c.ws<float>(WS_X1); const bf16* YS = c.ws<bf16>(WS_YS); const int* TSLOT = c.ws<int>(WS_TSLOT); const float* nw = c.P.in[I_NORM_FINAL]; float* out = c.P.out;
    const int lane = c.lane;
    for (int t = c.gwave; t < T; t += c.nwaves) {
        const int s0 = TSLOT[t * 4], s1 = TSLOT[t * 4 + 1], s2 = TSLOT[t * 4 + 2], s3 = TSLOT[t * 4 + 3];
        float4 v[4]; float ss = 0.f;
#pragma unroll
        for (int i = 0; i < 4; ++i) {
            const int col = 4 * (lane + 64 * i);
            v[i] = *(const float4*)(X1 + (size_t)t * D + col);
            const uint2 a = *(const uint2*)(YS + (size_t)s0 * 1024 + col), b = *(const uint2*)(YS + (size_t)s1 * 1024 + col), cc = *(const uint2*)(YS + (size_t)s2 * 1024 + col), d = *(const uint2*)(YS + (size_t)s3 * 1024 + col);
            v[i].x += bflo(a.x) + bflo(b.x) + bflo(cc.x) + bflo(d.x); v[i].y += bfhi(a.x) + bfhi(b.x) + bfhi(cc.x) + bfhi(d.x);
            v[i].z += bflo(a.y) + bflo(b.y) + bflo(cc.y) + bflo(d.y); v[i].w += bfhi(a.y) + bfhi(b.y) + bfhi(cc.y) + bfhi(d.y);
            ss += v[i].x * v[i].x + v[i].y * v[i].y + v[i].z * v[i].z + v[i].w * v[i].w;
        }
        ss = wsum(ss);
        const float rstd = rsqrtf(ss * (1.f / 1024.f) + 1e-6f);
#pragma unroll
        for (int i = 0; i < 4; ++i) { const float4 w4 = ((const float4*)nw)[lane + 64 * i];
            *(float4*)(out + (size_t)t * D + 4 * (lane + 64 * i)) = make_float4(v[i].x * rstd * w4.x, v[i].y * rstd * w4.y, v[i].z * rstd * w4.z, v[i].w * rstd * w4.w); }
    }
    if (TS_BEGIN >= 0 && blockIdx.x == 0 && c.tid == 0) { asm volatile("s_waitcnt vmcnt(0)" ::: "memory"); c.P.out[0] = (float)c.ws<unsigned>(WS_CTL)[CW_TS] * 0.01f; }
}


typedef short bf16x8_t __attribute__((ext_vector_type(8)));
typedef float f32x4_t __attribute__((ext_vector_type(4)));
#define MFMA16(a, b, c) __builtin_amdgcn_mfma_f32_16x16x32_bf16((a), (b), (c), 0, 0, 0)


__device__ __forceinline__ int frag_off(int row, int k, int KBn) { return (((row >> 4) * KBn + (k >> 5)) * 512) + (((k >> 3) & 3) * 128) + ((row & 15) * 8) + (k & 7); }
__device__ __forceinline__ int cfrag_off(int v, int r, int NRT) { return ((((v >> 4) * NRT + (r >> 4)) * 64 + ((r >> 2) & 3) * 16 + (v & 15)) * 4) + (r & 3); }


constexpr int TRI_LS = 68;
#define MFMA4(a, b, c) __builtin_amdgcn_mfma_f32_16x16x4f32((a), (b), (c), 0, 0, 0)
template <int SG>
__device__ __forceinline__ void tri_diag_inv(float* Lm, int lane) {
    const int b = lane >> 4, e = lane & 15;
    float* Lb = Lm + (16 * b) * TRI_LS + 16 * b;
    float x[16];
#pragma unroll
    for (int i = 0; i < 16; ++i) x[i] = 0.f;
#pragma unroll
    for (int i = 0; i < 16; ++i) {
        float a0 = (i == e) ? 1.f : 0.f, a1 = 0.f;
#pragma unroll
        for (int j4 = 0; j4 < (i + 3) / 4; ++j4) { const float4 m = *(const float4*)(Lb + i * TRI_LS + 4 * j4);
            a0 -= (float)SG * (m.x * x[4 * j4]); a1 -= (float)SG * (m.y * x[4 * j4 + 1]); a0 -= (float)SG * (m.z * x[4 * j4 + 2]); a1 -= (float)SG * (m.w * x[4 * j4 + 3]); }
        x[i] = a0 + a1;
    }
#pragma unroll
    for (int i = 0; i < 16; ++i) Lb[i * TRI_LS + e] = x[i];
}
template <int SG>
__device__ __forceinline__ void tri_col_inv(const float* Lm, int cb, int lane, f32x4_t (&Tb)[4]) {
    const int n = lane & 15, q = lane >> 4;
#pragma unroll
    for (int r = 0; r < 4; ++r) { Tb[r] = (f32x4_t){0.f, 0.f, 0.f, 0.f};
        if (r == cb) {
#pragma unroll
            for (int rr = 0; rr < 4; ++rr) Tb[r][rr] = Lm[(16 * r + 4 * q + rr) * TRI_LS + 16 * r + n]; } }
#pragma unroll
    for (int r = 1; r < 4; ++r) {
        if (r > cb) {
            f32x4_t P = {0.f, 0.f, 0.f, 0.f};
#pragma unroll
            for (int k = 0; k < r; ++k) {
                if (k >= cb) { const float4 a = *(const float4*)(Lm + (16 * r + n) * TRI_LS + 16 * k + 4 * q);
                    P = MFMA4(a.x, Tb[k][0], P); P = MFMA4(a.y, Tb[k][1], P); P = MFMA4(a.z, Tb[k][2], P); P = MFMA4(a.w, Tb[k][3], P); }
            }
#pragma unroll
            for (int rr = 0; rr < 4; ++rr) P[rr] *= -(float)SG;
            const float4 d = *(const float4*)(Lm + (16 * r + n) * TRI_LS + 16 * r + 4 * q);
            f32x4_t R = {0.f, 0.f, 0.f, 0.f};
            R = MFMA4(d.x, P[0], R); R = MFMA4(d.y, P[1], R); R = MFMA4(d.z, P[2], R); R = MFMA4(d.w, P[3], R);
            Tb[r] = R;
        }
    }
}

constexpr int GCL_HALF_BYTES = 71680;
__device__ __forceinline__ void ph_gcl(const Ctx& c) {
    const bf16* GQKV = c.ws<bf16>(WS_GQKV); const float* BETA = c.ws<float>(WS_BETA); const float* GGv = c.ws<float>(WS_GG); const float* cw = c.P.in[I_GDN_CONV];
    bf16* GA1 = c.ws<bf16>(WS_GA1); bf16* GX0 = c.ws<bf16>(WS_GX0); bf16* GA2 = c.ws<bf16>(WS_GA2); bf16* GA3 = c.ws<bf16>(WS_GA3); bf16* GA4 = c.ws<bf16>(WS_GA4); float* GGL = c.ws<float>(WS_GGL);
    for (int it0 = blockIdx.x * 2; it0 < 2048; it0 += gridDim.x * 2) {
        int tv = c.tid; asm volatile("" : "+v"(tv));
        const int half = tv >> 8, ht = tv & 255, lane = tv & 63, w4 = __builtin_amdgcn_readfirstlane((tv >> 6) & 3);
        unsigned char* base = c.lds + half * GCL_HALF_BYTES;
        bf16* QB = (bf16*)base;
        bf16* KB = QB + 64 * 136;
        bf16* VB = KB + 64 * 136;
        float* MM = (float*)(VB + 64 * 136);
        float* GC = MM + 64 * TRI_LS;
        float* BT = GC + 64;
        float* BE = BT + 64;
        const int item = it0 + half, n = item & 63, bh = item >> 6, h = bh & 7, b = bh >> 3;
        const int t0 = b * SEQ + n * 64;
        __syncthreads();
        if (w4 == 0) {
            float g = GGv[(size_t)(t0 + lane) * 8 + h]; const float be = BETA[(size_t)(t0 + lane) * 8 + h];
#pragma unroll
            for (int o = 1; o < 64; o <<= 1) { const float u = __shfl_up(g, o); if (lane >= o) g += u; }
            GC[lane] = g; BT[lane] = be; BE[lane] = be * __expf(g);
        }
        __syncthreads();
        {
            const int cg = ht & 15, rg = ht >> 4, r0 = rg * 4;
#pragma unroll
            for (int mat = 0; mat < 3; ++mat) {
                const int col0 = mat * 1024 + h * 128 + cg * 8;
                float4 xa[7], xb[7], wa[4], wb[4];
#pragma unroll
                for (int li = 0; li < 7; ++li) {
                    const bool valid = (n > 0) || (r0 - 3 + li >= 0);
                    uint4 xr = make_uint4(0, 0, 0, 0);
                    if (valid) xr = *(const uint4*)(GQKV + (size_t)(t0 + r0 - 3 + li) * 3072 + col0);
                    xa[li] = make_float4(bflo(xr.x), bfhi(xr.x), bflo(xr.y), bfhi(xr.y));
                    xb[li] = make_float4(bflo(xr.z), bfhi(xr.z), bflo(xr.w), bfhi(xr.w));
                }
#pragma unroll
                for (int j = 0; j < 4; ++j) { wa[j] = *(const float4*)(cw + j * 3072 + col0); wb[j] = *(const float4*)(cw + j * 3072 + col0 + 4); }
#pragma unroll
                for (int rr = 0; rr < 4; ++rr) {
                    float o[8] = {0.f, 0.f, 0.f, 0.f, 0.f, 0.f, 0.f, 0.f};
#pragma unroll
                    for (int j = 0; j < 4; ++j) { const float4 a = xa[rr + j], bq = xb[rr + j];
                        o[0] += wa[j].x * a.x; o[1] += wa[j].y * a.y; o[2] += wa[j].z * a.z; o[3] += wa[j].w * a.w;
                        o[4] += wb[j].x * bq.x; o[5] += wb[j].y * bq.y; o[6] += wb[j].z * bq.z; o[7] += wb[j].w * bq.w; }
                    float ss = 0.f;
#pragma unroll
                    for (int e = 0; e < 8; ++e) { o[e] *= fsigm(o[e]); ss += o[e] * o[e]; }
                    float sc = 1.f;
                    if (mat < 2) { ss = sum16(ss); sc = rsqrtf(ss + 1e-6f) * (mat == 0 ? 0.08838834764831845f : 1.f); }
                    const int r = r0 + rr;
                    uint4 w; w.x = pk2(o[0] * sc, o[1] * sc); w.y = pk2(o[2] * sc, o[3] * sc); w.z = pk2(o[4] * sc, o[5] * sc); w.w = pk2(o[6] * sc, o[7] * sc);
                    *(uint4*)((mat == 0 ? QB : (mat == 1 ? KB : VB)) + r * 136 + cg * 8) = w;
                    if (mat == 0) {
                        const float s2 = sc * __expf(GC[r]);
                        w.x = pk2(o[0] * s2, o[1] * s2); w.y = pk2(o[2] * s2, o[3] * s2); w.z = pk2(o[4] * s2, o[5] * s2); w.w = pk2(o[6] * s2, o[7] * s2);
                        *(uint4*)(GA2 + (size_t)item * 64 * 128 + frag_off(r, cg * 8, 4)) = w;
                    }
                }
            }
        }
        __syncthreads();
        {
            const int fr = lane & 15, fq = lane >> 4, a0 = w4 * 16;
            bf16x8_t ka[4];
#pragma unroll
            for (int kb = 0; kb < 4; ++kb) ka[kb] = *(const bf16x8_t*)(KB + (a0 + fr) * 136 + kb * 32 + fq * 8);
#pragma unroll
            for (int bt = 0; bt < 4; ++bt) {
                f32x4_t c1 = {0.f, 0.f, 0.f, 0.f}, c2 = {0.f, 0.f, 0.f, 0.f};
#pragma unroll
                for (int kb = 0; kb < 4; ++kb) {
                    const bf16x8_t kbf = *(const bf16x8_t*)(KB + (bt * 16 + fr) * 136 + kb * 32 + fq * 8);
                    const bf16x8_t qbf = *(const bf16x8_t*)(QB + (bt * 16 + fr) * 136 + kb * 32 + fq * 8);
                    c1 = MFMA16(ka[kb], kbf, c1); c2 = MFMA16(ka[kb], qbf, c2);
                }
                const int i = bt * 16 + fr, j0 = a0 + 4 * fq;
                const float gi = GC[i], bi = BT[i];
                float m[4], at[4];
#pragma unroll
                for (int rg = 0; rg < 4; ++rg) { const int j = j0 + rg; const float dec = __expf(fminf(gi - GC[j], 0.f));
                    m[rg] = (i > j) ? bi * c1[rg] * dec : 0.f; at[rg] = (i >= j) ? c2[rg] * dec : 0.f; }
                *(float4*)(MM + i * TRI_LS + j0) = make_float4(m[0], m[1], m[2], m[3]);
                uint2 w; w.x = pk2(at[0], at[1]); w.y = pk2(at[2], at[3]);
                *(uint2*)(GA3 + (size_t)item * 64 * 64 + frag_off(i, j0, 2)) = w;
            }
        }
        __syncthreads();
        if (w4 == 0) tri_diag_inv<1>(MM, lane);
        __syncthreads();
        bf16* TV = QB; bf16* TK = QB + 64 * 64;
        {
            f32x4_t Tb[4];
            tri_col_inv<1>(MM, w4, lane, Tb);
            const int tn = lane & 15, tq = lane >> 4, col = 16 * w4 + tn;
            const float sv = BT[col], sk = BE[col];
#pragma unroll
            for (int r = 0; r < 4; ++r) {
                if (r >= w4 || r + 1 == w4) {
#pragma unroll
                    for (int rr = 0; rr < 4; ++rr) { const int row = 16 * r + 4 * tq + rr; const int po = row * 64 + ((((col >> 3) ^ (row & 7)) << 3) | (col & 7));
                        TV[po] = f2bf(Tb[r][rr] * sv); TK[po] = f2bf(Tb[r][rr] * sk); }
                }
            }
        }
        __syncthreads();
        {
            const int fr = lane & 15, fq = lane >> 4;
            const bool isw = w4 >= 2; const bf16* TI = isw ? TK : TV; const bf16* src = isw ? KB : VB;
            const int cbase = (w4 & 1) * 64;
            bf16x8_t af[4][2];
#pragma unroll
            for (int it = 0; it < 4; ++it)
#pragma unroll
                for (int kb = 0; kb < 2; ++kb) { const int row = it * 16 + fr; af[it][kb] = *(const bf16x8_t*)(TI + row * 64 + (((kb * 4 + fq) ^ (row & 7)) << 3)); }
            bf16* up = GX0 + (size_t)item * 128 * 64; bf16* a1s = (bf16*)MM;
#pragma unroll
            for (int t = 0; t < 4; ++t) {
                const int cc = cbase + t * 16 + fr;
                bf16x8_t b0, b1;
#pragma unroll
                for (int e = 0; e < 8; ++e) { b0[e] = (short)src[(fq * 8 + e) * 136 + cc]; b1[e] = (short)src[(32 + fq * 8 + e) * 136 + cc]; }
#pragma unroll
                for (int it = 0; it < 4; ++it) {
                    f32x4_t acc = {0.f, 0.f, 0.f, 0.f};
                    acc = MFMA16(af[it][0], b0, acc);
                    if (it >= 2) acc = MFMA16(af[it][1], b1, acc);
                    if (!isw) { uint2 w; w.x = pk2(acc[0], acc[1]); w.y = pk2(acc[2], acc[3]); *(uint2*)(up + cfrag_off(cc, it * 16 + 4 * fq, 4)) = w; }
                    else {
#pragma unroll
                        for (int rr = 0; rr < 4; ++rr) a1s[(it * 16 + 4 * fq + rr) * 128 + cc] = f2bf(-acc[rr]); }
                }
            }
        }
        __syncthreads();
        {
            const bf16* a1s = (const bf16*)MM; bf16* wp = GA1 + (size_t)item * 64 * 128;
#pragma unroll
            for (int q = 0; q < 4; ++q) { const int p = ht + 256 * q, fr = p & 15, fq = (p >> 4) & 3, kb = (p >> 6) & 3, rt = p >> 8;
                *(uint4*)(wp + p * 8) = *(const uint4*)(a1s + (rt * 16 + fr) * 128 + kb * 32 + fq * 8); }
        }
        {
            const int dk = ht & 127, hh = ht >> 7; const float g63 = GC[63];
            unsigned w[16];
#pragma unroll
            for (int q = 0; q < 16; ++q) { const int ta = hh * 32 + 2 * q;
                w[q] = pk2(bf2f(KB[ta * 136 + dk]) * __expf(g63 - GC[ta]), bf2f(KB[(ta + 1) * 136 + dk]) * __expf(g63 - GC[ta + 1])); }
            bf16* dp = GA4 + (size_t)item * 128 * 64;
            *(uint4*)(dp + frag_off(dk, hh * 32, 2)) = make_uint4(w[0], w[1], w[2], w[3]); *(uint4*)(dp + frag_off(dk, hh * 32 + 8, 2)) = make_uint4(w[4], w[5], w[6], w[7]);
            *(uint4*)(dp + frag_off(dk, hh * 32 + 16, 2)) = make_uint4(w[8], w[9], w[10], w[11]); *(uint4*)(dp + frag_off(dk, hh * 32 + 24, 2)) = make_uint4(w[12], w[13], w[14], w[15]);
            if (ht == 0) GGL[item] = __expf(g63);
        }
    }
}

constexpr int RCL_HALF_BYTES = 75776;
__device__ __forceinline__ void ph_rcl(const Ctx& c) {
    const bf16* RKV = c.ws<bf16>(WS_RKV); const float* LW = c.ws<float>(WS_LW); const float* AAg = c.ws<float>(WS_AA);
    const float* mu = c.P.in[I_MU]; const float* k_k = c.P.in[I_KK]; const float* k_a = c.P.in[I_KA]; const float* r_k = c.P.in[I_RK];
    bf16* VP = c.ws<bf16>(WS_VP); float* SC = c.ws<float>(WS_SC);
    bf16* RA1 = c.ws<bf16>(WS_RA1); bf16* RX0 = c.ws<bf16>(WS_RX0); bf16* RA2 = c.ws<bf16>(WS_RA2); bf16* RA3 = c.ws<bf16>(WS_RA3); bf16* RO0 = c.ws<bf16>(WS_RO0);
    bf16* RA4 = c.ws<bf16>(WS_RA4); bf16* RS0 = c.ws<bf16>(WS_RS0); float* RDSC = c.ws<float>(WS_RDSC);
    unsigned long long ts_t0 = 0ull, ts_acc = 0ull;
#define TSMARK(k) do { if (TS_BEGIN >= 0 && blockIdx.x == 0 && c.tid == 0) { const unsigned long long now_ = __builtin_amdgcn_s_memrealtime(); \
        if ((k) == TS_END && ts_t0 != 0ull) ts_acc += now_ - ts_t0; if ((k) == TS_BEGIN) ts_t0 = now_; } } while (0)
    uint4 ur[2], uk[2], uv[2]; float4 a4v[4], l4v[4];
#define RCL_LOAD(ITEM, TID) do { const int it_ = (ITEM), ht_ = (TID) & 255, n_ = it_ & 63, bh_ = it_ >> 6, h_ = bh_ & 15, b_ = bh_ >> 4; \
        const int r_ = ht_ >> 2, c0_ = (ht_ & 3) * 16, t_ = b_ * SEQ + n_ * 64 + r_; \
        const bf16* cur_ = RKV + (size_t)t_ * 3072 + h_ * 64 + c0_; \
        _Pragma("unroll") for (int g = 0; g < 2; ++g) { ur[g] = *(const uint4*)(cur_ + 8 * g); uk[g] = *(const uint4*)(cur_ + 1024 + 8 * g); uv[g] = *(const uint4*)(cur_ + 2048 + 8 * g); } \
        _Pragma("unroll") for (int q = 0; q < 4; ++q) { l4v[q] = *(const float4*)(LW + (size_t)t_ * 1024 + h_ * 64 + c0_ + 4 * q); a4v[q] = *(const float4*)(AAg + (size_t)t_ * 1024 + h_ * 64 + c0_ + 4 * q); } \
    } while (0)
    if ((int)(blockIdx.x * 2) < 4096) RCL_LOAD(blockIdx.x * 2 + (c.tid >> 8), c.tid);
    for (int it0 = blockIdx.x * 2; it0 < 4096; it0 += gridDim.x * 2) {
        int tv = c.tid; asm volatile("" : "+v"(tv));
        const int half = tv >> 8, ht = tv & 255, lane = tv & 63, w4 = __builtin_amdgcn_readfirstlane((tv >> 6) & 3);
        unsigned char* base = c.lds + half * RCL_HALF_BYTES;
        bf16* AT = (bf16*)base;
        bf16* VT = AT + 64 * 72;
        bf16* KDT = VT + 64 * 72;
        float* AAB = (float*)(KDT + 64 * 72);
        float* TOT = AAB + 64 * 64;
        unsigned char* RX = (unsigned char*)(TOT + 256);
        bf16* RT = (bf16*)RX;
        bf16* BTL = RT + 64 * 72;
        bf16* KT = BTL + 64 * 72;
        bf16* AAK = (bf16*)RX;
        bf16* ARK = AAK + 64 * 72;
        float* RHS2 = (float*)RX;
        const int item = it0 + half, n = item & 63, bh = item >> 6, h = bh & 15, b = bh >> 4;
        const int t0 = b * SEQ + n * 64;
        __syncthreads();
        TSMARK(0);
        const int r = ht >> 2, seg = ht & 3, c0 = seg * 16, t = t0 + r; const bool first = (n == 0 && r == 0);
        float rr[16], kf[16], vv[16], kkv[16], aa[16], lwl[16], bdv[16];
        float ss = 0.f, scs = 0.f;
        {
            float4 mr[4], mk[4], mv[4], kkw[4], kaw[4], rkw[4];
            uint4 qr[2], qk[2], qv[2];
            {   const bf16* prv = RKV + (size_t)(t - 1) * 3072 + h * 64 + c0;
#pragma unroll
                for (int g = 0; g < 2; ++g) { qr[g] = make_uint4(0, 0, 0, 0); qk[g] = qr[g]; qv[g] = qr[g];
                    if (!first) { qr[g] = *(const uint4*)(prv + 8 * g); qk[g] = *(const uint4*)(prv + 1024 + 8 * g); qv[g] = *(const uint4*)(prv + 2048 + 8 * g); } } }
#pragma unroll
            for (int q = 0; q < 4; ++q) {
                mr[q] = *(const float4*)(mu + h * 64 + c0 + 4 * q); mk[q] = *(const float4*)(mu + 1024 + h * 64 + c0 + 4 * q); mv[q] = *(const float4*)(mu + 2048 + h * 64 + c0 + 4 * q);
                kkw[q] = *(const float4*)(k_k + h * 64 + c0 + 4 * q); kaw[q] = *(const float4*)(k_a + h * 64 + c0 + 4 * q); rkw[q] = *(const float4*)(r_k + h * 64 + c0 + 4 * q);
            }
#pragma unroll
            for (int q = 0; q < 4; ++q) *(float4*)(AAB + r * 64 + c0 + 4 * q) = l4v[q];
            __syncthreads();
            {
                const int ch = ht & 63, tq = ht >> 6;
                float run = 0.f;
#pragma unroll
                for (int i = 0; i < 16; ++i) { run += AAB[(tq * 16 + i) * 64 + ch]; AAB[(tq * 16 + i) * 64 + ch] = run; }
                TOT[tq * 64 + ch] = run;
            }
            __syncthreads();
            TSMARK(1);
#pragma unroll
            for (int q = 0; q < 4; ++q) {
                const int g = q >> 1; const bool hi = q & 1;
                const unsigned r_a = hi ? ur[g].z : ur[g].x, r_b = hi ? ur[g].w : ur[g].y, k_a_ = hi ? uk[g].z : uk[g].x, k_b_ = hi ? uk[g].w : uk[g].y, v_a = hi ? uv[g].z : uv[g].x, v_b = hi ? uv[g].w : uv[g].y;
                const unsigned pr_a = hi ? qr[g].z : qr[g].x, pr_b = hi ? qr[g].w : qr[g].y, pk_a = hi ? qk[g].z : qk[g].x, pk_b = hi ? qk[g].w : qk[g].y, pv_a = hi ? qv[g].z : qv[g].x, pv_b = hi ? qv[g].w : qv[g].y;
                const float r0a[4] = {bflo(r_a), bfhi(r_a), bflo(r_b), bfhi(r_b)}, k0a[4] = {bflo(k_a_), bfhi(k_a_), bflo(k_b_), bfhi(k_b_)}, v0a[4] = {bflo(v_a), bfhi(v_a), bflo(v_b), bfhi(v_b)};
                const float rpa[4] = {bflo(pr_a), bfhi(pr_a), bflo(pr_b), bfhi(pr_b)}, kpa[4] = {bflo(pk_a), bfhi(pk_a), bflo(pk_b), bfhi(pk_b)}, vpa[4] = {bflo(pv_a), bfhi(pv_a), bflo(pv_b), bfhi(pv_b)};
                const float mra[4] = {mr[q].x, mr[q].y, mr[q].z, mr[q].w}, mka[4] = {mk[q].x, mk[q].y, mk[q].z, mk[q].w}, mva[4] = {mv[q].x, mv[q].y, mv[q].z, mv[q].w};
                const float kka[4] = {kkw[q].x, kkw[q].y, kkw[q].z, kkw[q].w}, kaa[4] = {kaw[q].x, kaw[q].y, kaw[q].z, kaw[q].w}, rka[4] = {rkw[q].x, rkw[q].y, rkw[q].z, rkw[q].w};
                const float aaa[4] = {a4v[q].x, a4v[q].y, a4v[q].z, a4v[q].w}, lwa[4] = {l4v[q].x, l4v[q].y, l4v[q].z, l4v[q].w};
#pragma unroll
                for (int e = 0; e < 4; ++e) { const int i = 4 * q + e;
                    rr[i] = r0a[e] + (rpa[e] - r0a[e]) * mra[e]; const float kx = k0a[e] + (kpa[e] - k0a[e]) * mka[e]; vv[i] = v0a[e] + (vpa[e] - v0a[e]) * mva[e];
                    kkv[i] = kx * kka[e]; ss += kkv[i] * kkv[i]; aa[i] = aaa[e]; lwl[i] = lwa[e]; kf[i] = kx * (1.f + (aaa[e] - 1.f) * kaa[e]); scs += rr[i] * kf[i] * rka[e]; }
            }
        }
        {
            ss = sum4(ss); scs = sum4(scs);
            const float rn = rsqrtf(ss + 1e-6f);
            if (seg == 0) SC[(size_t)t * 16 + h] = scs;
            const int tq = r >> 4;
            unsigned wat[8], wbt[8], wkt[8], wrt[8], wvp[8];
            float atv[16], btv[16], ktv[16], rtv[16];
#pragma unroll
            for (int i = 0; i < 16; ++i) {
                const int ch = c0 + i;
                float off = 0.f;
#pragma unroll
                for (int q = 0; q < 3; ++q) off += (q < tq) ? TOT[q * 64 + ch] : 0.f;
                const float tot = TOT[ch] + TOT[64 + ch] + TOT[128 + ch] + TOT[192 + ch];
                const float cs = AAB[r * 64 + ch] + off;
                const float lwv = lwl[i];
                const float kk = kkv[i] * rn;
                const float e2 = __expf(-cs), e4 = __expf(tot - cs);
                atv[i] = kk * __expf(cs - lwv); btv[i] = -kk * aa[i] * e2; ktv[i] = kf[i] * e2; rtv[i] = rr[i] * __expf(cs);
                VT[ch * 72 + r] = f2bf(vv[i]);
                KDT[ch * 72 + r] = f2bf(kf[i] * e4);
                bdv[i] = -kk * aa[i] * e4;
                if (r == 63) RDSC[(size_t)item * 64 + ch] = __expf(tot);
            }
#pragma unroll
            for (int q = 0; q < 8; ++q) { wat[q] = pk2(atv[2 * q], atv[2 * q + 1]); wbt[q] = pk2(btv[2 * q], btv[2 * q + 1]); wkt[q] = pk2(ktv[2 * q], ktv[2 * q + 1]); wrt[q] = pk2(rtv[2 * q], rtv[2 * q + 1]); wvp[q] = pk2(vv[2 * q], vv[2 * q + 1]); }
            *(uint4*)(AT + r * 72 + c0) = make_uint4(wat[0], wat[1], wat[2], wat[3]); *(uint4*)(AT + r * 72 + c0 + 8) = make_uint4(wat[4], wat[5], wat[6], wat[7]);
            *(uint4*)(BTL + r * 72 + c0) = make_uint4(wbt[0], wbt[1], wbt[2], wbt[3]); *(uint4*)(BTL + r * 72 + c0 + 8) = make_uint4(wbt[4], wbt[5], wbt[6], wbt[7]);
            *(uint4*)(KT + r * 72 + c0) = make_uint4(wkt[0], wkt[1], wkt[2], wkt[3]); *(uint4*)(KT + r * 72 + c0 + 8) = make_uint4(wkt[4], wkt[5], wkt[6], wkt[7]);
            *(uint4*)(RT + r * 72 + c0) = make_uint4(wrt[0], wrt[1], wrt[2], wrt[3]); *(uint4*)(RT + r * 72 + c0 + 8) = make_uint4(wrt[4], wrt[5], wrt[6], wrt[7]);
            bf16* a2p = RA2 + (size_t)item * 64 * 64;
            *(uint4*)(a2p + frag_off(r, c0, 2)) = make_uint4(wrt[0], wrt[1], wrt[2], wrt[3]); *(uint4*)(a2p + frag_off(r, c0 + 8, 2)) = make_uint4(wrt[4], wrt[5], wrt[6], wrt[7]);
            bf16* vpp = VP + (size_t)t * 1024 + h * 64 + c0;
            *(uint4*)vpp = make_uint4(wvp[0], wvp[1], wvp[2], wvp[3]); *(uint4*)(vpp + 8) = make_uint4(wvp[4], wvp[5], wvp[6], wvp[7]);
        }
        __syncthreads();
        TSMARK(2);
        if (it0 + (int)gridDim.x * 2 < 4096) RCL_LOAD(item + (int)gridDim.x * 2, tv);
        {
            bf16* BDS = (bf16*)AAB;
#pragma unroll
            for (int i = 0; i < 16; ++i) BDS[(c0 + i) * 72 + r] = f2bf(bdv[i]);
        }
        const int fr = lane & 15, fq = lane >> 4;
        f32x4_t cab[4], cak[4], crb[4], crk[4];
        {
            const int j0t = w4 * 16;
            bf16x8_t bj[2], kj[2];
#pragma unroll
            for (int kb = 0; kb < 2; ++kb) { bj[kb] = *(const bf16x8_t*)(BTL + (j0t + fr) * 72 + kb * 32 + fq * 8); kj[kb] = *(const bf16x8_t*)(KT + (j0t + fr) * 72 + kb * 32 + fq * 8); }
#pragma unroll
            for (int it = 0; it < 4; ++it) {
                cab[it] = (f32x4_t){0.f, 0.f, 0.f, 0.f}; cak[it] = cab[it]; crb[it] = cab[it]; crk[it] = cab[it];
#pragma unroll
                for (int kb = 0; kb < 2; ++kb) {
                    const bf16x8_t ai = *(const bf16x8_t*)(AT + (it * 16 + fr) * 72 + kb * 32 + fq * 8);
                    const bf16x8_t ri = *(const bf16x8_t*)(RT + (it * 16 + fr) * 72 + kb * 32 + fq * 8);
                    cab[it] = MFMA16(bj[kb], ai, cab[it]); cak[it] = MFMA16(kj[kb], ai, cak[it]); crb[it] = MFMA16(bj[kb], ri, crb[it]); crk[it] = MFMA16(kj[kb], ri, crk[it]);
                }
            }
        }
        __syncthreads();
        {
            const bf16* BDS = (const bf16*)AAB; bf16* bp = RA4 + (size_t)item * 64 * 64;
#pragma unroll
            for (int q = 0; q < 2; ++q) { const int p = ht + 256 * q, pfr = p & 15, pfq = (p >> 4) & 3, pkb = (p >> 6) & 1, prt = p >> 7;
                *(uint4*)(bp + p * 8) = *(const uint4*)(BDS + (prt * 16 + pfr) * 72 + pkb * 32 + pfq * 8); }
        }
        __syncthreads();
        {
            const int j0 = w4 * 16 + 4 * fq;
#pragma unroll
            for (int it = 0; it < 4; ++it) {
                const int i = it * 16 + fr;
                float vab[4], vak[4], vrb[4], vrk[4];
#pragma unroll
                for (int rg = 0; rg < 4; ++rg) { const int j = j0 + rg; const bool st = i > j, in = i >= j;
                    vab[rg] = st ? cab[it][rg] : 0.f; vak[rg] = st ? cak[it][rg] : 0.f; vrb[rg] = in ? crb[it][rg] : 0.f; vrk[rg] = in ? crk[it][rg] : 0.f; }
                *(float4*)(AAB + i * TRI_LS + j0) = make_float4(vab[0], vab[1], vab[2], vab[3]);
                uint2 w; w.x = pk2(vak[0], vak[1]); w.y = pk2(vak[2], vak[3]); *(uint2*)(AAK + i * 72 + j0) = w;
                w.x = pk2(vrk[0], vrk[1]); w.y = pk2(vrk[2], vrk[3]); *(uint2*)(ARK + i * 72 + j0) = w;
                w.x = pk2(vrb[0], vrb[1]); w.y = pk2(vrb[2], vrb[3]); *(uint2*)(RA3 + (size_t)item * 64 * 64 + frag_off(i, j0, 2)) = w;
            }
        }
        __syncthreads();
        f32x4_t cav[4], cov[4], ckv[4];
        {
            const int r0t = w4 * 16;
            bf16x8_t fa[2], fo[2], fk[2];
#pragma unroll
            for (int kb = 0; kb < 2; ++kb) { fa[kb] = *(const bf16x8_t*)(AAK + (r0t + fr) * 72 + kb * 32 + fq * 8); fo[kb] = *(const bf16x8_t*)(ARK + (r0t + fr) * 72 + kb * 32 + fq * 8); fk[kb] = *(const bf16x8_t*)(KDT + (r0t + fr) * 72 + kb * 32 + fq * 8); }
#pragma unroll
            for (int vt = 0; vt < 4; ++vt) {
                cav[vt] = (f32x4_t){0.f, 0.f, 0.f, 0.f}; cov[vt] = cav[vt]; ckv[vt] = cav[vt];
#pragma unroll
                for (int kb = 0; kb < 2; ++kb) { const bf16x8_t vb = *(const bf16x8_t*)(VT + (vt * 16 + fr) * 72 + kb * 32 + fq * 8);
                    cav[vt] = MFMA16(fa[kb], vb, cav[vt]); cov[vt] = MFMA16(fo[kb], vb, cov[vt]); ckv[vt] = MFMA16(fk[kb], vb, ckv[vt]); }
            }
        }
        __syncthreads();
        {
            const int r0 = w4 * 16 + 4 * fq;
#pragma unroll
            for (int vt = 0; vt < 4; ++vt) {
                const int v = vt * 16 + fr;
#pragma unroll
                for (int rg = 0; rg < 4; ++rg) RHS2[v * 65 + r0 + rg] = cav[vt][rg];
                { uint2 w; w.x = pk2(cov[vt][0], cov[vt][1]); w.y = pk2(cov[vt][2], cov[vt][3]); *(uint2*)(RO0 + (size_t)item * 64 * 64 + cfrag_off(v, r0, 4)) = w; }
                { uint2 w; w.x = pk2(ckv[vt][0], ckv[vt][1]); w.y = pk2(ckv[vt][2], ckv[vt][3]); *(uint2*)(RS0 + (size_t)item * 64 * 64 + cfrag_off(v, r0, 4)) = w; }
            }
        }
        __syncthreads();
        TSMARK(3);
        if (w4 == 0) tri_diag_inv<-1>(AAB, lane);
        __syncthreads();
        bf16* TI = (bf16*)(RX + 16640);
        {
            f32x4_t Tb[4];
            tri_col_inv<-1>(AAB, w4, lane, Tb);
            const int tn = lane & 15, tq = lane >> 4, col = 16 * w4 + tn;
#pragma unroll
            for (int r = 0; r < 4; ++r) {
                if (r >= w4 || r + 1 == w4) {
#pragma unroll
                    for (int rr = 0; rr < 4; ++rr) TI[(16 * r + 4 * tq + rr) * 72 + col] = f2bf(Tb[r][rr]);
                }
            }
        }
        __syncthreads();
        bf16* WST = (bf16*)AAB;
        {
            const int cc = w4 * 16 + fr;
            bf16x8_t af[4][2];
#pragma unroll
            for (int it = 0; it < 4; ++it)
#pragma unroll
                for (int kb = 0; kb < 2; ++kb) af[it][kb] = *(const bf16x8_t*)(TI + (it * 16 + fr) * 72 + kb * 32 + fq * 8);
            bf16x8_t b0, b1, u0, u1;
#pragma unroll
            for (int e = 0; e < 8; ++e) { b0[e] = (short)AT[(fq * 8 + e) * 72 + cc]; b1[e] = (short)AT[(32 + fq * 8 + e) * 72 + cc]; }
#pragma unroll
            for (int e = 0; e < 8; e += 2) {
                const unsigned p0 = pk2(RHS2[cc * 65 + fq * 8 + e], RHS2[cc * 65 + fq * 8 + e + 1]), p1 = pk2(RHS2[cc * 65 + 32 + fq * 8 + e], RHS2[cc * 65 + 32 + fq * 8 + e + 1]);
                u0[e] = (short)(p0 & 0xffffu); u0[e + 1] = (short)(p0 >> 16); u1[e] = (short)(p1 & 0xffffu); u1[e + 1] = (short)(p1 >> 16);
            }
            bf16* up = RX0 + (size_t)item * 64 * 64;
#pragma unroll
            for (int it = 0; it < 4; ++it) {
                f32x4_t xa = {0.f, 0.f, 0.f, 0.f}, xu = {0.f, 0.f, 0.f, 0.f};
                xa = MFMA16(af[it][0], b0, xa); xu = MFMA16(af[it][0], u0, xu);
                if (it >= 2) { xa = MFMA16(af[it][1], b1, xa); xu = MFMA16(af[it][1], u1, xu); }
                { uint2 w; w.x = pk2(xu[0], xu[1]); w.y = pk2(xu[2], xu[3]); *(uint2*)(up + cfrag_off(cc, it * 16 + 4 * fq, 4)) = w; }
#pragma unroll
                for (int rr = 0; rr < 4; ++rr) WST[(it * 16 + 4 * fq + rr) * 72 + cc] = f2bf(xa[rr]);
            }
        }
        __syncthreads();
        TSMARK(4);
        {
            bf16* wp = RA1 + (size_t)item * 64 * 64;
#pragma unroll
            for (int q = 0; q < 2; ++q) { const int p = ht + 256 * q, pfr = p & 15, pfq = (p >> 4) & 3, pkb = (p >> 6) & 1, prt = p >> 7;
                *(uint4*)(wp + p * 8) = *(const uint4*)(WST + (prt * 16 + pfr) * 72 + pkb * 32 + pfq * 8); }
        }
    }
    if (TS_BEGIN >= 0 && blockIdx.x == 0 && c.tid == 0) c.ws<unsigned>(WS_CTL)[CW_TS] = (unsigned)ts_acc;
#undef TSMARK
#undef RCL_LOAD
}

template <int DK, bool RW>
struct ScanArgs { const bf16* A1; const bf16* X0; const bf16* A2; const bf16* A3; const bf16* O0; const bf16* A4; const bf16* S0; const float* DSC; bf16* OUT; int item0; int vs; int tok0; int ocol0; };
#define LBAR() do { asm volatile("s_waitcnt lgkmcnt(0)" ::: "memory"); __builtin_amdgcn_s_barrier(); asm volatile("" ::: "memory"); } while (0)
template <int DK, bool RW>
__device__ __forceinline__ void scan_run(const Ctx& c, const ScanArgs<DK, RW>& a) {
    constexpr int KB = DK / 32;
    constexpr int NST = DK / 64;
    constexpr int NV = RW ? 64 : 128;
    constexpr int SROW = DK + 8;
    bf16* ST = (bf16*)c.lds;
    bf16* XT = ST + 2 * 32 * SROW;
    const int lane = c.lane, w = c.wave, fr = lane & 15, fq = lane >> 4;
    const int tm = w >> 1, tn = w & 1;
    const int dkt = (NST == 2) ? w : (w >> 1);
    for (int i = c.tid; i < 32 * SROW / 2; i += NTHREADS) ((unsigned*)ST)[i] = 0u;
    f32x4_t accS[NST];
#pragma unroll
    for (int s = 0; s < NST; ++s) accS[s] = (f32x4_t){0.f, 0.f, 0.f, 0.f};
    bf16x8_t a1f[KB], a2f[KB], a3f[2], a4f[2]; f32x4_t x0v, o0v, s0v[NST], dscv;
#define SCAN_LOAD(IT) do { const size_t it_ = (size_t)(IT); \
        _Pragma("unroll") for (int kb = 0; kb < KB; ++kb) { a1f[kb] = *(const bf16x8_t*)(a.A1 + it_ * 64 * DK + ((tm * KB + kb) * 64 + lane) * 8); a2f[kb] = *(const bf16x8_t*)(a.A2 + it_ * 64 * DK + ((tm * KB + kb) * 64 + lane) * 8); } \
        _Pragma("unroll") for (int kb = 0; kb < 2; ++kb) { a3f[kb] = *(const bf16x8_t*)(a.A3 + it_ * 64 * 64 + ((tm * 2 + kb) * 64 + lane) * 8); a4f[kb] = *(const bf16x8_t*)(a.A4 + it_ * DK * 64 + ((dkt * 2 + kb) * 64 + lane) * 8); } \
        { const uint2 q_ = *(const uint2*)(a.X0 + it_ * NV * 64 + (((a.vs * 2 + tn) * 4 + tm) * 64 + lane) * 4); x0v = (f32x4_t){bflo(q_.x), bfhi(q_.x), bflo(q_.y), bfhi(q_.y)}; } \
        if (RW) { { const uint2 q_ = *(const uint2*)(a.O0 + it_ * NV * 64 + (((a.vs * 2 + tn) * 4 + tm) * 64 + lane) * 4); o0v = (f32x4_t){bflo(q_.x), bfhi(q_.x), bflo(q_.y), bfhi(q_.y)}; } \
                  _Pragma("unroll") for (int s = 0; s < NST; ++s) { const uint2 q_ = *(const uint2*)(a.S0 + it_ * 64 * DK + (((a.vs * 2 + (NST == 2 ? s : tn)) * (DK / 16) + dkt) * 64 + lane) * 4); s0v[s] = (f32x4_t){bflo(q_.x), bfhi(q_.x), bflo(q_.y), bfhi(q_.y)}; } \
                  dscv = *(const f32x4_t*)(a.DSC + it_ * DK + dkt * 16 + 4 * fq); } \
        else { const float g_ = a.DSC[it_]; dscv = (f32x4_t){g_, g_, g_, g_}; o0v = (f32x4_t){0.f, 0.f, 0.f, 0.f}; _Pragma("unroll") for (int s = 0; s < NST; ++s) s0v[s] = (f32x4_t){0.f, 0.f, 0.f, 0.f}; } \
    } while (0)
    SCAN_LOAD(a.item0);
    int cur = 0;
    for (int n = 0; n < 64; ++n) {
        bf16x8_t b1[KB], b2[KB], b3[2], b4[2];
#pragma unroll
        for (int kb = 0; kb < KB; ++kb) { b1[kb] = a1f[kb]; b2[kb] = a2f[kb]; }
        b3[0] = a3f[0]; b3[1] = a3f[1]; b4[0] = a4f[0]; b4[1] = a4f[1];
        f32x4_t accX = x0v, accO = o0v; const f32x4_t dv = dscv; f32x4_t sv[NST];
#pragma unroll
        for (int s = 0; s < NST; ++s) sv[s] = s0v[s];
        if (n + 1 < 64) SCAN_LOAD(a.item0 + n + 1);
        LBAR();
        const bf16* Sc = ST + cur * 32 * SROW; bf16* Sn = ST + (cur ^ 1) * 32 * SROW;
        bf16x8_t sf[KB];
#pragma unroll
        for (int kb = 0; kb < KB; ++kb) sf[kb] = *(const bf16x8_t*)(Sc + (tn * 16 + fr) * SROW + kb * 32 + fq * 8);
#pragma unroll
        for (int kb = 0; kb < KB; ++kb) accX = MFMA16(b1[kb], sf[kb], accX);
        { uint2 wv; wv.x = pk2(accX[0], accX[1]); wv.y = pk2(accX[2], accX[3]); *(uint2*)(XT + (tn * 16 + fr) * 72 + tm * 16 + 4 * fq) = wv; }
#pragma unroll
        for (int kb = 0; kb < KB; ++kb) accO = MFMA16(b2[kb], sf[kb], accO);
        LBAR();
        bf16x8_t xf[2];
#pragma unroll
        for (int kb = 0; kb < 2; ++kb) xf[kb] = *(const bf16x8_t*)(XT + (tn * 16 + fr) * 72 + kb * 32 + fq * 8);
        accO = MFMA16(b3[0], xf[0], accO); accO = MFMA16(b3[1], xf[1], accO);
        {
            bf16* op = a.OUT + (size_t)(a.tok0 + n * 64 + tm * 16 + 4 * fq) * 1024 + a.ocol0 + tn * 16 + fr;
            op[0] = f2bf(accO[0]); op[1024] = f2bf(accO[1]); op[2048] = f2bf(accO[2]); op[3072] = f2bf(accO[3]);
        }
#pragma unroll
        for (int s = 0; s < NST; ++s) {
            const int vt = (NST == 2) ? s : tn;
            bf16x8_t xg[2];
            if (vt == tn) { xg[0] = xf[0]; xg[1] = xf[1]; }
            else {
#pragma unroll
                for (int kb = 0; kb < 2; ++kb) xg[kb] = *(const bf16x8_t*)(XT + (vt * 16 + fr) * 72 + kb * 32 + fq * 8);
            }
            f32x4_t t = accS[s] * dv + sv[s];
            t = MFMA16(b4[0], xg[0], t); t = MFMA16(b4[1], xg[1], t);
            accS[s] = t;
            uint2 wv; wv.x = pk2(t[0], t[1]); wv.y = pk2(t[2], t[3]);
            *(uint2*)(Sn + (vt * 16 + fr) * SROW + dkt * 16 + 4 * fq) = wv;
        }
        cur ^= 1;
    }
#undef SCAN_LOAD
    __syncthreads();
}

__device__ __forceinline__ void ph_scan(const Ctx& c) {
    for (int wk = blockIdx.x; wk < 256; wk += gridDim.x) {
        const int xcd = wk & 7, j = wk >> 3;
        if (j < 16) {
            const int pair = xcd * 4 + (j >> 2), vs = j & 3, b = pair >> 3, h = pair & 7;
            ScanArgs<128, false> a{c.ws<bf16>(WS_GA1), c.ws<bf16>(WS_GX0), c.ws<bf16>(WS_GA2), c.ws<bf16>(WS_GA3), nullptr, c.ws<bf16>(WS_GA4), nullptr, c.ws<float>(WS_GGL),
                                   c.ws<bf16>(WS_OG), pair * 64, vs, b * SEQ, h * 128 + vs * 32};
            scan_run<128, false>(c, a);
        } else {
            const int pair = xcd * 8 + ((j - 16) >> 1), vs = (j - 16) & 1, b = pair >> 4, h = pair & 15;
            ScanArgs<64, true> a{c.ws<bf16>(WS_RA1), c.ws<bf16>(WS_RX0), c.ws<bf16>(WS_RA2), c.ws<bf16>(WS_RA3), c.ws<bf16>(WS_RO0), c.ws<bf16>(WS_RA4), c.ws<bf16>(WS_RS0), c.ws<float>(WS_RDSC),
                                 c.ws<bf16>(WS_ORW), pair * 64, vs, b * SEQ, h * 64 + vs * 32};
            scan_run<64, true>(c, a);
        }
    }
}

enum { PH_RMS0 = 0, PH_INPROJ, PH_GCL, PH_LORA, PH_RCL, PH_SCAN, PH_POST, PH_G2, PH_X1, PH_ROUTER, PH_DISPATCH, PH_MOE1, PH_MOE2, PH_COMBINE, PH_COUNT };

template <unsigned PHMASK>
__global__ void __launch_bounds__(NTHREADS) mk(Params P) {
    extern __shared__ __attribute__((aligned(16))) unsigned char lds[];
    volatile LAS unsigned* misc = (volatile LAS unsigned*)((LAS unsigned char*)lds + MISC_OFF);
    if (threadIdx.x < 64) misc[threadIdx.x] = 0u;
    __syncthreads();
    unsigned* ctl = (unsigned*)(P.ws + WS_CTL);
    XcdBarrier bar = xcd_barrier_post(ctl + CW_BAR + P.li * XCD_BAR_WORDS, misc);
#define MKCTX() int tv_ = threadIdx.x; asm volatile("" : "+v"(tv_)); const int wv_ = __builtin_amdgcn_readfirstlane(tv_ >> 6); \
    Ctx c{P, tv_, tv_ & 63, wv_, (int)(blockIdx.x * NWAVES + wv_), (int)(gridDim.x * NWAVES), (size_t)blockIdx.x * NTHREADS + tv_, (size_t)gridDim.x * NTHREADS, lds}
    bool first_seam = true;
#define IN(k) (((PHMASK >> (k)) & 1u) && P.ph_lo <= (k) && (k) < P.ph_hi)
#define SEAM(k) do { if ((k) + 1 < P.ph_hi) { xcd_barrier(bar); first_seam = false; } } while (0)
#define REP(k) for (int rep_ = 0; rep_ < ((k) == PROBE_REP ? 2 : 1); ++rep_)
    if (IN(PH_RMS0)) { MKCTX();
        REP(PH_RMS0) {
        ph_rms0(c);
        { WJob j{P.in[I_W_IN], NCOL_IN, 1024, 4096, c.ws<bf16>(WS_WIN_T), 1024, 1, 0, 0}; wconv_job(c, j); }
        { WJob j{P.in[I_W_IN] + 4112, NCOL_IN, 1024, 5376, c.ws<bf16>(WS_WIN_T) + (size_t)4096 * 1024, 1024, 1, 0, 0}; wconv_job(c, j); }
        lora_zero(c);
        { WJob j{P.in[I_W2], 1024, 64, 1024, c.ws<bf16>(WS_LORA_T), 256, 1, 0, 0}; wconv_job(c, j); }
        { WJob j{P.in[I_A2], 1024, 64, 1024, c.ws<bf16>(WS_LORA_T) + (size_t)1024 * 256 + 64, 256, 1, 0, 0}; wconv_job(c, j); }
        { WJob j{P.in[I_G2], 1024, 128, 1024, c.ws<bf16>(WS_LORA_T) + (size_t)2048 * 256 + 128, 256, 1, 0, 0}; wconv_job(c, j); }
        }
        SEAM(PH_RMS0);
    }
    if (IN(PH_INPROJ)) { MKCTX();
        REP(PH_INPROJ) {
        EpiInProj ep{c.ws<bf16>(WS_GQKV), c.ws<bf16>(WS_ZS), c.ws<bf16>(WS_RKV), c.ws<float>(WS_LIN), c.ws<bf16>(WS_GATES)};
        SchedInProj sc{(const char*)c.ws<bf16>(WS_HB), (const char*)c.ws<bf16>(WS_WIN_T), (int)gridDim.x, (int)blockIdx.x};
        pg8::gemm_phase((LAS unsigned char*)lds, 1024, sc, ep, c.tid);
        }
        SEAM(PH_INPROJ);
    }
    if (IN(PH_GCL)) { MKCTX(); REP(PH_GCL) { ph_gcl(c); ph_loraprep(c); } SEAM(PH_GCL); }
    if (IN(PH_LORA)) { MKCTX();
        REP(PH_LORA) {
        EpiLora ep{P.in[I_W0], P.in[I_A0], c.ws<float>(WS_LW), c.ws<float>(WS_AA), c.ws<bf16>(WS_GGR)};
        SchedLora sc{(const char*)c.ws<bf16>(WS_ALORA), (const char*)c.ws<bf16>(WS_LORA_T), (int)gridDim.x, (int)blockIdx.x};
        pg8::gemm_phase((LAS unsigned char*)lds, 256, sc, ep, c.tid);
        }
        SEAM(PH_LORA);
    }
    if (IN(PH_RCL)) { MKCTX(); REP(PH_RCL) { ph_rcl(c); } SEAM(PH_RCL); }
    if (IN(PH_SCAN)) { MKCTX(); REP(PH_SCAN) { ph_scan(c); } SEAM(PH_SCAN); }
    if (IN(PH_POST)) { MKCTX();
        REP(PH_POST) {
        ph_post(c);
        { WJob j{P.in[I_PROJ_A], 1024, 1024, 1024, c.ws<bf16>(WS_PROJ_T), 1024, 1, 0, 0}; wconv_job(c, j); }
        { WJob j{P.in[I_PROJ_B], 1024, 1024, 1024, c.ws<bf16>(WS_PROJ_T) + (size_t)1024 * 1024, 1024, 1, 0, 0}; wconv_job(c, j); }
        { WJob j{P.in[I_W_OUT], 1024, 1024, 1024, c.ws<bf16>(WS_WOUT_T), 1024, 1, 0, 0}; wconv_job(c, j); }
        }
        SEAM(PH_POST);
    }
    if (IN(PH_G2)) { MKCTX();
        REP(PH_G2) {
        EpiG2 ep{c.ws<bf16>(WS_GATES), c.ws<bf16>(WS_G2)};
        SchedG2 sc{(const char*)c.ws<bf16>(WS_YA), (const char*)c.ws<bf16>(WS_PROJ_T), (int)gridDim.x, (int)blockIdx.x};
        pg8::gemm_phase((LAS unsigned char*)lds, 1024, sc, ep, c.tid);
        }
        SEAM(PH_G2);
    }
    if (IN(PH_X1)) { MKCTX();
        REP(PH_X1) {
        EpiX1 ep{P.in[I_X], c.ws<float>(WS_X1)};
        SchedX1 sc{(const char*)c.ws<bf16>(WS_G2), (const char*)c.ws<bf16>(WS_WOUT_T), (int)gridDim.x, (int)blockIdx.x};
        pg8::gemm_phase((LAS unsigned char*)lds, 1024, sc, ep, c.tid);
        }
        SEAM(PH_X1);
    }
    if (IN(PH_ROUTER)) { MKCTX();
        ph_router(c);
        REP(PH_ROUTER) {
        { WJob j{P.in[I_W_GU], 2048, 1024, 2048, c.ws<bf16>(WS_WGU_T), 1024, 32, (size_t)1024 * 2048, (size_t)2048 * 1024}; wconv_job(c, j); }
        { WJob j{P.in[I_W_DOWN], 1024, 1024, 1024, c.ws<bf16>(WS_WDN_T), 1024, 32, (size_t)1024 * 1024, (size_t)1024 * 1024}; wconv_job(c, j); }
        }
        SEAM(PH_ROUTER);
    }
    if (IN(PH_DISPATCH)) { MKCTX(); REP(PH_DISPATCH) { ph_dispatch(c); } SEAM(PH_DISPATCH); }
    if (IN(PH_MOE1)) { MKCTX();
        REP(PH_MOE1) {
        const int nt = *c.ws<int>(WS_NT);
        EpiAct ep{P.in[I_B_GU], c.ws<bf16>(WS_ACT)};
        SchedMoe sc{(const char*)c.ws<bf16>(WS_H2), (const char*)c.ws<bf16>(WS_WGU_T), c.ws<int>(WS_TILE_E), c.ws<int>(WS_SLOT_TOK), nt, 8, (int)gridDim.x, (int)blockIdx.x};
        pg8::gemm_phase_t<true>((LAS unsigned char*)lds, 1024, sc, ep, c.tid);
        }
        SEAM(PH_MOE1);
    }
    if (IN(PH_MOE2)) { MKCTX();
        REP(PH_MOE2) {
        const int nt = *c.ws<int>(WS_NT);
        EpiYS ep{P.in[I_B_DOWN], c.ws<float>(WS_SGATE), c.ws<bf16>(WS_YS)};
        SchedMoe sc{(const char*)c.ws<bf16>(WS_ACT), (const char*)c.ws<bf16>(WS_WDN_T), c.ws<int>(WS_TILE_E), nullptr, nt, 4, (int)gridDim.x, (int)blockIdx.x};
        pg8::gemm_phase((LAS unsigned char*)lds, 1024, sc, ep, c.tid);
        }
        SEAM(PH_MOE2);
    }
    if (IN(PH_COMBINE)) { MKCTX(); REP(PH_COMBINE) { ph_combine(c); } }
#undef IN
#undef SEAM
#undef REP
#undef MKCTX
}

template <unsigned M> static void launch_one(const Params& p, int grid, hipStream_t stream) {
    static bool attr = false;
    if (!attr) { (void)hipFuncSetAttribute((const void*)mk<M>, hipFuncAttributeMaxDynamicSharedMemorySize, LDS_BYTES); attr = true; }
    hipLaunchKernelGGL(mk<M>, dim3(grid), dim3(NTHREADS), LDS_BYTES, stream, p);
}
template <int PH> static void launch_chain(Params& p, int grid, hipStream_t stream) {
    if constexpr (PH < PH_COUNT) { p.ph_lo = PH; p.ph_hi = PH + 1; p.li = 0; p.coop = 0; launch_one<(1u << PH)>(p, grid, stream); launch_chain<PH + 1>(p, grid, stream); }
}

extern "C" void kernel_launch(void* const* d_in, const int* in_sizes, int n_in, void* d_out, int out_size, void* d_ws, size_t ws_size, hipStream_t stream) {
    static int grid = 0;
    if (grid == 0) {
        int dev = 0, cus = 0, per_cu = 0;
        (void)hipGetDevice(&dev);
        (void)hipDeviceGetAttribute(&cus, hipDeviceAttributeMultiprocessorCount, dev);
#if MK_ONE_LAUNCH
        (void)hipFuncSetAttribute((const void*)mk<0xffffffffu>, hipFuncAttributeMaxDynamicSharedMemorySize, LDS_BYTES);
        (void)hipOccupancyMaxActiveBlocksPerMultiprocessor(&per_cu, (const void*)mk<0xffffffffu>, NTHREADS, LDS_BYTES);
#else
        per_cu = 1;
#endif
        if (n_in != 29 || ws_size < WS_END || per_cu < 1 || cus < 64) { fprintf(stderr, "kernel_launch: unexpected setup n_in %d ws %zu per_cu %d cus %d\n", n_in, ws_size, per_cu, cus); grid = -1; return; }
        grid = cus;
    }
    if (grid < 0) return;
    (void)hipMemsetAsync((char*)d_ws + WS_CTL, 0, CTL_BYTES, stream);
    Params p{};
    for (int i = 0; i < 29; ++i) p.in[i] = (const float*)d_in[i];
    p.out = (float*)d_out; p.ws = (unsigned char*)d_ws;
#if MK_ONE_LAUNCH
    p.ph_lo = 0; p.ph_hi = PH_COUNT; p.li = 0; p.coop = 1;
    void* args[] = {&p};
    hipError_t e = hipLaunchCooperativeKernel((const void*)mk<0xffffffffu>, dim3(grid), dim3(NTHREADS), args, LDS_BYTES, stream);
    if (e != hipSuccess) fprintf(stderr, "cooperative launch failed: %s (grid %d)\n", hipGetErrorString(e), grid);
#else
    launch_chain<0>(p, grid, stream);
#endif
}
```
